# Optimizing an MI355X kernel written in HIP

```python
import numpy as np
import jax
import jax.numpy as jnp
from jax import lax

D_MODEL = 2048
BATCH = 8
SEQ = 2048
DEPTH = 2

DN_ALPHA = (2 * DEPTH) ** 0.25
DN_BETA = (8 * DEPTH) ** -0.25
LN_EPS = 1e-5
NORM_EPS = 1e-6
ROPE_BASE = 10000.0
NEG_INF = -1e30
FORCE_SCORE = 1e4

POOL_WINDOWS = (2, 4, 8, 16)
POOL_GROUP = D_MODEL // 16
POOL_WIDTH = 4 * POOL_GROUP

RET_HEADS = 6
RET_DK = D_MODEL // 16
RET_DV = 2 * RET_DK
RET_CHUNK = 128

AB_S1 = POOL_WIDTH
AB_S2 = AB_S1 + RET_HEADS * RET_DK
AB_S3 = AB_S2 + RET_HEADS * RET_DK
AB_S4 = AB_S3 + RET_HEADS * RET_DV
AB_IN = AB_S4 + RET_HEADS * RET_DV
AB_OUT = POOL_WIDTH + RET_HEADS * RET_DV

NSA_HEADS = 8
NSA_GROUPS = 2
NSA_HPG = NSA_HEADS // NSA_GROUPS
NSA_DK = D_MODEL // 16
NSA_CMP_LEN = 32
NSA_CMP_STRIDE = 16
NSA_CMP_HIDDEN = NSA_DK
NSA_SLC_LEN = 64
NSA_SLC_TOPN = 16
NSA_WINDOW = 512
NSA_QBLOCK = 32

MLA_HEADS = 8
MLA_Q_RANK = 384
MLA_KV_RANK = 512
MLA_NOPE = 128
MLA_ROPE = 64
MLA_DV = 128
ATTN_QBLOCK = 128

CD_S1 = NSA_HEADS * NSA_DK
CD_S2 = CD_S1 + 3 * 2 * NSA_GROUPS * NSA_DK
CD_S3 = CD_S2 + 3 * NSA_HEADS
CD_S4 = CD_S3 + MLA_Q_RANK
CD_S5 = CD_S4 + MLA_KV_RANK
CD_IN = CD_S5 + MLA_ROPE
CD_OUT = NSA_HEADS * NSA_DK + MLA_HEADS * MLA_DV

N_EXPERTS = 64
TOP_K = 8
N_GROUPS = 8
TOPK_GROUPS = 4
EXPERT_FF = 512
SHARED_FF = 512
ROUTED_SCALE = 2.5

N_EVEN = (DEPTH + 1) // 2
N_ODD = DEPTH // 2

kernel_name = 'hybrid_pool_retnet_nsa_mla_moe_deepnorm'


def layer_norm(x, g, b):
    xf = x.astype(jnp.float32)
    mu = jnp.mean(xf, axis=-1, keepdims=True)
    var = jnp.mean(jnp.square(xf - mu), axis=-1, keepdims=True)
    return ((xf - mu) * lax.rsqrt(var + LN_EPS) * g + b).astype(x.dtype)


def rms_norm(x, g):
    xf = x.astype(jnp.float32)
    y = xf * lax.rsqrt(jnp.mean(jnp.square(xf), axis=-1, keepdims=True) + NORM_EPS)
    return (y * g).astype(x.dtype)


def rope(x, positions):
    d = x.shape[-1]
    inv_freq = ROPE_BASE ** (-jnp.arange(0, d, 2, dtype=jnp.float32) / d)
    ang = positions.astype(jnp.float32)[..., None] * inv_freq
    cos = jnp.cos(ang)[:, :, None, :]
    sin = jnp.sin(ang)[:, :, None, :]
    xf = x.astype(jnp.float32)
    x1, x2 = xf[..., : d // 2], xf[..., d // 2:]
    return jnp.concatenate([x1 * cos - x2 * sin, x1 * sin + x2 * cos], axis=-1).astype(x.dtype)


def pool_mixer(u, pool_w, pool_scale):
    B, S, _ = u.shape
    uf = u.astype(jnp.float32)
    cs = jnp.concatenate([jnp.zeros((B, 1, POOL_WIDTH), jnp.float32), jnp.cumsum(uf, axis=1)], axis=1)
    t = jnp.arange(S)
    outs = []
    for gi, w in enumerate(POOL_WINDOWS):
        sl = slice(gi * POOL_GROUP, (gi + 1) * POOL_GROUP)
        lo = jnp.maximum(t + 1 - w, 0)
        cnt = jnp.minimum(t + 1, w).astype(jnp.float32)
        mean = (cs[:, 1:, sl] - cs[:, lo, sl]) / cnt[None, :, None]
        outs.append(mean - uf[:, :, sl])
    pooled = jnp.stack(outs, axis=2).astype(u.dtype)
    mixed = jnp.einsum('bsgc,gcd->bsgd', pooled, pool_w).reshape(B, S, POOL_WIDTH)
    return mixed * pool_scale


def retention(q, k, v, g, positions):
    B, S, H, DK = q.shape
    DV = v.shape[-1]
    C = RET_CHUNK
    N = S // C
    q = rope(q, positions)
    k = rope(k, positions) * (DK ** -0.5)
    log_gamma = jnp.log1p(-(2.0 ** (-5.0 - jnp.arange(H, dtype=jnp.float32))))
    idx = jnp.arange(C, dtype=jnp.float32)
    diff = idx[:, None] - idx[None, :]
    decay_in = jnp.where(diff >= 0, jnp.exp(log_gamma[:, None, None] * jnp.maximum(diff, 0.0)), 0.0)
    xi = jnp.exp(log_gamma[:, None] * (idx + 1.0))
    zeta = jnp.exp(log_gamma[:, None] * (C - 1.0 - idx))
    gamma_c = jnp.exp(log_gamma * C)
    qc = q.reshape(B, N, C, H, DK)
    kc = k.reshape(B, N, C, H, DK)
    vc = v.reshape(B, N, C, H, DV)
    scores = jnp.einsum('bnihd,bnjhd->bnhij', qc, kc) * decay_in
    inner = jnp.einsum('bnhij,bnjhv->bnihv', scores, vc)
    kv = jnp.einsum('bnjhd,hj,bnjhv->nbhdv', kc, zeta, vc)

    def step(state, kv_n):
        return gamma_c[None, :, None, None] * state + kv_n, state

    _, state_prev = lax.scan(step, jnp.zeros((B, H, DK, DV), kv.dtype), kv)
    cross = jnp.einsum('bnihd,hi,nbhdv->bnihv', qc, xi, state_prev)
    y = (inner + cross).reshape(B, S, H, DV).astype(jnp.float32)
    mu = jnp.mean(y, axis=-1, keepdims=True)
    var = jnp.mean(jnp.square(y - mu), axis=-1, keepdims=True)
    yn = (y - mu) * lax.rsqrt(var + NORM_EPS)
    out = yn * jax.nn.silu(g.astype(jnp.float32))
    return out.reshape(B, S, H * DV).astype(v.dtype)


def pool_retention_mixer(x, positions, w_in, pool_w, pool_scale, w_out):
    B, S, _ = x.shape
    u, q, k, v, g = jnp.split(x @ w_in, [AB_S1, AB_S2, AB_S3, AB_S4], axis=-1)
    a = pool_mixer(u, pool_w, pool_scale)
    r = retention(q.reshape(B, S, RET_HEADS, RET_DK), k.reshape(B, S, RET_HEADS, RET_DK),
                  v.reshape(B, S, RET_HEADS, RET_DV), g.reshape(B, S, RET_HEADS, RET_DV), positions)
    return jnp.concatenate([a, r], axis=-1) @ w_out


def nsa_mixer(q, kv, gates, cmp_pos, cmp_w1, cmp_w2):
    B, S, H, dk = q.shape
    G, R = NSA_GROUPS, NSA_HPG
    scale = dk ** -0.5
    t = jnp.arange(S)
    qg = q.reshape(B, S, G, R, dk).transpose(0, 2, 3, 1, 4)
    kv = kv.transpose(2, 3, 0, 4, 1, 5)

    r = NSA_CMP_LEN // NSA_CMP_STRIDE
    n_chunk = S // NSA_CMP_STRIDE
    nbc = n_chunk - r + 1
    chunks = kv[0].reshape(2, B, G, n_chunk, NSA_CMP_STRIDE, dk)
    blocks = jnp.concatenate([chunks[:, :, :, m:m + nbc] for m in range(r)], axis=4)
    blocks = blocks + cmp_pos[:, None, None, None]
    hid = jax.nn.gelu(jnp.einsum('kbgnf,kfh->kbgnh', blocks.reshape(2, B, G, nbc, NSA_CMP_LEN * dk), cmp_w1))
    kv_cmp = jnp.einsum('kbgnh,khd->kbgnd', hid, cmp_w2)
    cmask = (jnp.arange(nbc) * NSA_CMP_STRIDE + NSA_CMP_LEN - 1)[None, :] <= t[:, None]
    s_cmp = jnp.einsum('bgrsd,bgnd->bgrsn', qg, kv_cmp[0]).astype(jnp.float32) * scale
    p_cmp = jax.nn.softmax(jnp.where(cmask, s_cmp, NEG_INF), axis=-1) * cmask
    o_cmp = jnp.einsum('bgrsn,bgnd->bgrsd', p_cmp.astype(kv_cmp.dtype), kv_cmp[1])

    nbs = S // NSA_SLC_LEN
    n_sel = min(NSA_SLC_TOPN, nbs)
    cps = NSA_SLC_LEN // NSA_CMP_STRIDE
    chunk_ids = np.arange(nbc)[:, None] + np.arange(r)[None, :]
    cmp_to_slc = np.sum((chunk_ids[:, :, None] // cps) == np.arange(nbs)[None, None, :], axis=1).astype(np.float32)
    imp = jnp.einsum('bgrsn,nj->bgsj', p_cmp, jnp.asarray(cmp_to_slc))
    j = jnp.arange(nbs)[None, :]
    cur = (t // NSA_SLC_LEN)[:, None]
    forced = (j == 0) | (j == cur) | (j == cur - 1)
    score = jnp.where(forced, FORCE_SCORE, jnp.where(j * NSA_SLC_LEN <= t[:, None], imp, NEG_INF))
    _, sel = lax.top_k(score, n_sel)
    kb = kv[1, 0].reshape(B, G, nbs, NSA_SLC_LEN * dk)
    vb = kv[1, 1].reshape(B, G, nbs, NSA_SLC_LEN * dk)
    nq = S // NSA_QBLOCK
    q_blocks = qg.reshape(B, G, R, nq, NSA_QBLOCK, dk).transpose(3, 0, 1, 2, 4, 5)
    sel_blocks = sel.reshape(B, G, nq, NSA_QBLOCK, n_sel).transpose(2, 0, 1, 3, 4)
    t_blocks = t.reshape(nq, NSA_QBLOCK)
    bi = jnp.arange(B)[:, None, None, None]
    gi = jnp.arange(G)[None, :, None, None]
    n_keys = n_sel * NSA_SLC_LEN

    def slc_block(args):
        qb, ib, tb = args
        kg = kb[bi, gi, ib].reshape(B, G, NSA_QBLOCK, n_keys, dk)
        vg = vb[bi, gi, ib].reshape(B, G, NSA_QBLOCK, n_keys, dk)
        kpos = (ib[..., None] * NSA_SLC_LEN + jnp.arange(NSA_SLC_LEN)).reshape(B, G, NSA_QBLOCK, n_keys)
        m = kpos <= tb[None, None, :, None]
        s = jnp.einsum('bgrqd,bgqkd->bgrqk', qb, kg).astype(jnp.float32) * scale
        p = jax.nn.softmax(jnp.where(m[:, :, None], s, NEG_INF), axis=-1)
        return jnp.einsum('bgrqk,bgqkd->bgrqd', p.astype(vg.dtype), vg)

    o_slc = lax.map(slc_block, (q_blocks, sel_blocks, t_blocks))
    o_slc = o_slc.transpose(1, 2, 3, 0, 4, 5).reshape(B, G, R, S, dk)

    wb = ATTN_QBLOCK
    nw = NSA_WINDOW // wb
    nqw = S // wb
    pad = ((0, 0), (0, 0), (nw, 0), (0, 0), (0, 0))
    kp = jnp.pad(kv[2, 0].reshape(B, G, nqw, wb, dk), pad)
    vp = jnp.pad(kv[2, 1].reshape(B, G, nqw, wb, dk), pad)
    kwin = jnp.concatenate([kp[:, :, m:m + nqw] for m in range(nw + 1)], axis=3)
    vwin = jnp.concatenate([vp[:, :, m:m + nqw] for m in range(nw + 1)], axis=3)
    qw = qg.reshape(B, G, R, nqw, wb, dk)
    s_win = jnp.einsum('bgrnqd,bgnkd->bgrnqk', qw, kwin).astype(jnp.float32) * scale
    qpos = t.reshape(nqw, wb)
    kpos = (jnp.arange(nqw)[:, None] - nw) * wb + jnp.arange((nw + 1) * wb)[None, :]
    dpos = qpos[:, :, None] - kpos[:, None, :]
    wmask = (kpos[:, None, :] >= 0) & (dpos >= 0) & (dpos < NSA_WINDOW)
    p_win = jax.nn.softmax(jnp.where(wmask, s_win, NEG_INF), axis=-1)
    o_win = jnp.einsum('bgrnqk,bgnkd->bgrnqd', p_win.astype(vwin.dtype), vwin).reshape(B, G, R, S, dk)

    gt = jax.nn.sigmoid(gates.reshape(B, S, G, R, 3).transpose(0, 2, 3, 1, 4))
    o = gt[..., 0:1] * o_cmp + gt[..., 1:2] * o_slc + gt[..., 2:3] * o_win
    return o.transpose(0, 3, 1, 2, 4).reshape(B, S, H * dk)


def mla_mixer(c_q, c_kv, k_pe, positions, q_norm, w_uq, kv_norm, w_ukv):
    B, S, _ = c_q.shape
    H = MLA_HEADS
    q = (rms_norm(c_q, q_norm) @ w_uq).reshape(B, S, H, MLA_NOPE + MLA_ROPE)
    q_nope, q_pe = q[..., :MLA_NOPE], rope(q[..., MLA_NOPE:], positions)
    kvu = (rms_norm(c_kv, kv_norm) @ w_ukv).reshape(B, S, H, MLA_NOPE + MLA_DV)
    k_nope, v = kvu[..., :MLA_NOPE], kvu[..., MLA_NOPE:]
    k_rot = rope(k_pe[:, :, None, :], positions)[:, :, 0]
    scale = (MLA_NOPE + MLA_ROPE) ** -0.5
    nq = S // ATTN_QBLOCK
    qn_b = q_nope.reshape(B, nq, ATTN_QBLOCK, H, MLA_NOPE).transpose(1, 0, 2, 3, 4)
    qp_b = q_pe.reshape(B, nq, ATTN_QBLOCK, H, MLA_ROPE).transpose(1, 0, 2, 3, 4)
    t_b = jnp.arange(S).reshape(nq, ATTN_QBLOCK)
    kpos = jnp.arange(S)

    def attend(args):
        qn, qp, tb = args
        s = (jnp.einsum('bqhd,bkhd->bhqk', qn, k_nope) + jnp.einsum('bqhd,bkd->bhqk', qp, k_rot)).astype(jnp.float32) * scale
        s = jnp.where(kpos[None, :] <= tb[:, None], s, NEG_INF)
        p = jax.nn.softmax(s, axis=-1)
        return jnp.einsum('bhqk,bkhd->bqhd', p.astype(v.dtype), v)

    o = lax.map(attend, (qn_b, qp_b, t_b))
    return o.transpose(1, 0, 2, 3, 4).reshape(B, S, H * MLA_DV)


def nsa_mla_mixer(x, positions, w_in, cmp_pos, cmp_w1, cmp_w2, q_norm, w_uq, kv_norm, w_ukv, w_out):
    B, S, _ = x.shape
    nq, nkv, ngate, cq, ckv, kpe = jnp.split(x @ w_in, [CD_S1, CD_S2, CD_S3, CD_S4, CD_S5], axis=-1)
    o_c = nsa_mixer(nq.reshape(B, S, NSA_HEADS, NSA_DK), nkv.reshape(B, S, 3, 2, NSA_GROUPS, NSA_DK),
                    ngate.reshape(B, S, NSA_HEADS, 3), cmp_pos, cmp_w1, cmp_w2)
    o_d = mla_mixer(cq, ckv, kpe, positions, q_norm, w_uq, kv_norm, w_ukv)
    return jnp.concatenate([o_c, o_d], axis=-1) @ w_out


def moe_ffn(h, router_w, router_bias, w1, w3, w2, sw1, sw3, sw2):
    B, S, D = h.shape
    xt = h.reshape(B * S, D)
    T = xt.shape[0]
    scores = jax.nn.sigmoid((xt @ router_w).astype(jnp.float32))
    biased = scores + router_bias.astype(jnp.float32)
    grp = biased.reshape(T, N_GROUPS, N_EXPERTS // N_GROUPS)
    grp_score = jnp.sum(lax.top_k(grp, 2)[0], axis=-1)
    _, top_grp = lax.top_k(grp_score, TOPK_GROUPS)
    grp_mask = jnp.sum(jax.nn.one_hot(top_grp, N_GROUPS, dtype=jnp.float32), axis=1) > 0
    expert_mask = jnp.repeat(grp_mask, N_EXPERTS // N_GROUPS, axis=1)
    _, top_e = lax.top_k(jnp.where(expert_mask, biased, NEG_INF), TOP_K)
    w_sel = jnp.take_along_axis(scores, top_e, axis=1)
    w_sel = w_sel / jnp.sum(w_sel, axis=-1, keepdims=True) * ROUTED_SCALE
    gate = jnp.einsum('tk,tke->te', w_sel, jax.nn.one_hot(top_e, N_EXPERTS, dtype=jnp.float32)).astype(h.dtype)

    def expert_step(acc, params):
        e_w1, e_w3, e_w2, e_gate = params
        y = (jax.nn.silu(xt @ e_w1) * (xt @ e_w3)) @ e_w2
        return acc + e_gate[:, None] * y, None

    routed, _ = lax.scan(expert_step, jnp.zeros_like(xt), (w1, w3, w2, gate.T))
    shared = (jax.nn.silu(xt @ sw1) * (xt @ sw3)) @ sw2
    return (routed + shared).reshape(B, S, D)


def setup_inputs(seed: int = 0) -> dict:
    key = jax.random.key(seed)
    ks = jax.random.split(key, 32)
    D = D_MODEL

    def nrm(k, shape, scale):
        return jax.random.normal(k, shape, jnp.float32) * scale

    inp = {}
    inp['x'] = nrm(ks[0], (BATCH, SEQ, D), 1.0)
    inp['positions'] = jnp.arange(SEQ, dtype=jnp.int32)[None, :] + jax.random.randint(ks[1], (BATCH, 1), 0, 1024, dtype=jnp.int32)
    inp['ab_w_in'] = nrm(ks[2], (N_EVEN, D, AB_IN), D ** -0.5)
    inp['ab_pool_w'] = nrm(ks[3], (N_EVEN, 4, POOL_GROUP, POOL_GROUP), POOL_GROUP ** -0.5)
    inp['ab_pool_scale'] = 1.0 + nrm(ks[4], (N_EVEN, POOL_WIDTH), 0.1)
    inp['ab_w_out'] = nrm(ks[5], (N_EVEN, AB_OUT, D), AB_OUT ** -0.5 * DN_BETA)
    inp['cd_w_in'] = nrm(ks[6], (N_ODD, D, CD_IN), D ** -0.5)
    inp['nsa_cmp_pos'] = nrm(ks[7], (N_ODD, 2, NSA_CMP_LEN, NSA_DK), 0.1)
    inp['nsa_cmp_w1'] = nrm(ks[8], (N_ODD, 2, NSA_CMP_LEN * NSA_DK, NSA_CMP_HIDDEN), (NSA_CMP_LEN * NSA_DK) ** -0.5)
    inp['nsa_cmp_w2'] = nrm(ks[9], (N_ODD, 2, NSA_CMP_HIDDEN, NSA_DK), NSA_CMP_HIDDEN ** -0.5)
    inp['mla_q_norm'] = 1.0 + nrm(ks[10], (N_ODD, MLA_Q_RANK), 0.02)
    inp['mla_w_uq'] = nrm(ks[11], (N_ODD, MLA_Q_RANK, MLA_HEADS * (MLA_NOPE + MLA_ROPE)), MLA_Q_RANK ** -0.5)
    inp['mla_kv_norm'] = 1.0 + nrm(ks[12], (N_ODD, MLA_KV_RANK), 0.02)
    inp['mla_w_ukv'] = nrm(ks[13], (N_ODD, MLA_KV_RANK, MLA_HEADS * (MLA_NOPE + MLA_DV)), MLA_KV_RANK ** -0.5)
    inp['cd_w_out'] = nrm(ks[14], (N_ODD, CD_OUT, D), CD_OUT ** -0.5 * DN_BETA)
    inp['ln1_g'] = 1.0 + nrm(ks[15], (DEPTH, D), 0.02)
    inp['ln1_b'] = nrm(ks[16], (DEPTH, D), 0.02)
    inp['ln2_g'] = 1.0 + nrm(ks[17], (DEPTH, D), 0.02)
    inp['ln2_b'] = nrm(ks[18], (DEPTH, D), 0.02)
    inp['moe_router'] = nrm(ks[19], (DEPTH, D, N_EXPERTS), D ** -0.5)
    inp['moe_router_bias'] = nrm(ks[20], (DEPTH, N_EXPERTS), 0.01)
    inp['moe_w1'] = nrm(ks[21], (DEPTH, N_EXPERTS, D, EXPERT_FF), D ** -0.5)
    inp['moe_w3'] = nrm(ks[22], (DEPTH, N_EXPERTS, D, EXPERT_FF), D ** -0.5)
    inp['moe_w2'] = nrm(ks[23], (DEPTH, N_EXPERTS, EXPERT_FF, D), EXPERT_FF ** -0.5 * DN_BETA)
    inp['shared_w1'] = nrm(ks[24], (DEPTH, D, SHARED_FF), D ** -0.5)
    inp['shared_w3'] = nrm(ks[25], (DEPTH, D, SHARED_FF), D ** -0.5)
    inp['shared_w2'] = nrm(ks[26], (DEPTH, SHARED_FF, D), SHARED_FF ** -0.5 * DN_BETA)
    return inp


def reference(x, positions, ab_w_in, ab_pool_w, ab_pool_scale, ab_w_out, cd_w_in, nsa_cmp_pos,
              nsa_cmp_w1, nsa_cmp_w2, mla_q_norm, mla_w_uq, mla_kv_norm, mla_w_ukv, cd_w_out,
              ln1_g, ln1_b, ln2_g, ln2_b, moe_router, moe_router_bias, moe_w1, moe_w3, moe_w2,
              shared_w1, shared_w3, shared_w2):
    for i in range(DEPTH):
        j = i // 2
        if i % 2 == 0:
            mix = pool_retention_mixer(x, positions, ab_w_in[j], ab_pool_w[j], ab_pool_scale[j], ab_w_out[j])
        else:
            mix = nsa_mla_mixer(x, positions, cd_w_in[j], nsa_cmp_pos[j], nsa_cmp_w1[j], nsa_cmp_w2[j],
                                mla_q_norm[j], mla_w_uq[j], mla_kv_norm[j], mla_w_ukv[j], cd_w_out[j])
        x = layer_norm(DN_ALPHA * x + mix, ln1_g[i], ln1_b[i])
        ffn = moe_ffn(x, moe_router[i], moe_router_bias[i], moe_w1[i], moe_w3[i], moe_w2[i],
                      shared_w1[i], shared_w3[i], shared_w2[i])
        x = layer_norm(DN_ALPHA * x + ffn, ln2_g[i], ln2_b[i])
    return x
```

```cpp
#include <hip/hip_runtime.h>
#include <cstdio>
#include <cstdint>

#ifndef MK_ONE_LAUNCH
#define MK_ONE_LAUNCH 1
#endif

#define GAS __attribute__((address_space(1)))
#define LAS __attribute__((address_space(3)))
typedef unsigned short bf16;
typedef unsigned v4u __attribute__((ext_vector_type(4)));
typedef unsigned v2u __attribute__((ext_vector_type(2)));
typedef float f32x4 __attribute__((ext_vector_type(4)));
typedef float f32x2 __attribute__((ext_vector_type(2)));
typedef short bf16x8 __attribute__((ext_vector_type(8)));

constexpr int NB = 8, NS = 2048, ND = 2048, NT = NB * NS;
constexpr float DN_ALPHA = 1.41421356237309505f;
constexpr float LN_EPS = 1e-5f, NORM_EPS = 1e-6f;
constexpr int AB_IN = 5120, CD_IN = 3544, CD_INP = 3584;
constexpr int NEXP = 64, EFF = 512;
constexpr int MAXROWS = NT * 8 + NEXP * 256;
constexpr int MAXTILES = MAXROWS / 256;
constexpr int SH_ROW0 = MAXROWS;

constexpr size_t MiB = 1u << 20;
constexpr size_t WS_CTL = 0, CTL_ZERO_BYTES = 1 * MiB;
constexpr size_t WS_TOPE = 1 * MiB, WS_WSEL = WS_TOPE + 512 * 1024, WS_SLOT = 2 * MiB, WS_SORTED = WS_SLOT + 512 * 1024;
constexpr size_t WS_CMPB = 3 * MiB + 256 * 1024, WS_SELM = 3 * MiB + 512 * 1024;
constexpr size_t WS_KVCMP = 4 * MiB;
constexpr size_t WS_HID = 6 * MiB;
constexpr size_t WS_WABIN = 16 * MiB, WS_WABOUT = 36 * MiB, WS_WCDIN = 44 * MiB, WS_WCDOUT = 58 * MiB, WS_WUQ = 66 * MiB, WS_WUKV = 68 * MiB, WS_CW1 = 70 * MiB, WS_RT = 72 * MiB;
constexpr size_t WS_W13 = 74 * MiB, WS_W2 = 334 * MiB;
constexpr size_t WS_XB0 = 464 * MiB, WS_X1B = 528 * MiB, WS_X2B = 592 * MiB, WS_PROJ = 656 * MiB, WS_MIXIN = 816 * MiB, WS_MIXO = 880 * MiB;
constexpr size_t WS_H = 944 * MiB, WS_Y2 = 1104 * MiB, WS_END = 1744 * MiB;
constexpr size_t WS_QR = 944 * MiB, WS_KR = 968 * MiB;
constexpr size_t WS_CQN = 944 * MiB, WS_CKVN = 956 * MiB, WS_KROT = 972 * MiB, WS_QMLA = 976 * MiB, WS_KVU = 1024 * MiB, WS_CMPKV = 1088 * MiB, WS_OCMP = 1108 * MiB;
constexpr size_t WS_LOGITS = 1104 * MiB;
constexpr int CW_TMO = 0, CW_CODE = 1, CW_BAR = 4096, CW_CNT = 16384;

constexpr int RING_BYTES = 131072, LDSCTL_OFF = RING_BYTES, MISC_OFF = LDSCTL_OFF + 320, TAB_OFF = LDSCTL_OFF + 512;
constexpr int LDS_BYTES = 147456;
constexpr int NWAVES = 8;

#define LDS_WAIT() asm volatile("s_waitcnt lgkmcnt(0)" ::: "memory")
#define VM_WAIT() asm volatile("s_waitcnt vmcnt(0)" ::: "memory")
__device__ __forceinline__ unsigned f2bf(float f) { unsigned u = __builtin_bit_cast(unsigned, f); return (u + 0x7fffu + ((u >> 16) & 1u)) >> 16; }
__device__ __forceinline__ unsigned pk2(float lo, float hi) { return f2bf(lo) | (f2bf(hi) << 16); }
__device__ __forceinline__ float bflo(unsigned w) { return __builtin_bit_cast(float, w << 16); }
__device__ __forceinline__ float bfhi(unsigned w) { return __builtin_bit_cast(float, w & 0xffff0000u); }
__device__ __forceinline__ float bf1(bf16 v) { return __builtin_bit_cast(float, ((unsigned)v) << 16); }
__device__ __forceinline__ float wave_sum(float v) {
#pragma unroll
    for (int o = 1; o < 64; o <<= 1) v += __shfl_xor(v, o);
    return v;
}
__device__ __forceinline__ float wave_max(float v) {
#pragma unroll
    for (int o = 1; o < 64; o <<= 1) v = fmaxf(v, __shfl_xor(v, o));
    return v;
}
__device__ __forceinline__ float sigmoidf_(float x) { return 1.0f / (1.0f + __expf(-x)); }
__device__ __forceinline__ float siluf_(float x) { return x / (1.0f + __expf(-x)); }
__device__ __forceinline__ void unpack8(const v4u w, float (&f)[8]) {
    f[0] = bflo(w.x); f[1] = bfhi(w.x); f[2] = bflo(w.y); f[3] = bfhi(w.y); f[4] = bflo(w.z); f[5] = bfhi(w.z); f[6] = bflo(w.w); f[7] = bfhi(w.w);
}

#define XB_TMO      128
#define XB_XCNT(j)  (256  + 64 * (j))
#define XB_XSUB(j)  (1280 + 64 * (j))
#define XB_XGEN(j)  (2304 + 64 * (j))
#define XB_TOP      3328
#define XB_TOPGEN   3392
#define XCD_BAR_WORDS 3456
#define XB_SPIN_CAP (1u << 18)
__device__ __forceinline__ unsigned xb_ld(unsigned* p)              { return __hip_atomic_load(p, __ATOMIC_RELAXED, __HIP_MEMORY_SCOPE_AGENT); }
__device__ __forceinline__ unsigned xb_add(unsigned* p, unsigned v) { return __hip_atomic_fetch_add(p, v, __ATOMIC_RELAXED, __HIP_MEMORY_SCOPE_AGENT); }
__device__ __forceinline__ unsigned xb_xcc_id() { return (unsigned)__builtin_amdgcn_s_getreg((3 << 11) | 20) & 0xFu; }
#define XB_SPIN(cond, bar) do { unsigned _sp = 0; while (cond) { __builtin_amdgcn_s_sleep(1); \
    if ((++_sp & 255u) == 0u) { if (xb_ld(&(bar)[XB_TMO])) break; if (_sp > XB_SPIN_CAP) { atomicAdd(&(bar)[XB_TMO], 1u); break; } } } } while (0)
struct XcdBarrier { unsigned* bar; unsigned x; volatile LAS unsigned* st; };
__device__ __forceinline__ XcdBarrier xcd_barrier_post(unsigned* bar, volatile LAS unsigned* st) {
    XcdBarrier b; b.bar = bar; b.x = xb_xcc_id(); b.st = st;
    if (threadIdx.x == 0) (void)xb_add(&bar[XB_XCNT(b.x)], 1u);
    return b;
}
__device__ __forceinline__ void xcd_barrier_complete(unsigned* bar, unsigned x, unsigned& nloc, unsigned& nx) {
    const unsigned G = gridDim.x * gridDim.y * gridDim.z;
    unsigned sum, cnt, mine, sp = 0u;
    for (;;) {
        sum = 0u; cnt = 0u; mine = 0u;
#pragma unroll
        for (unsigned j = 0; j < 16; ++j) { const unsigned c = xb_ld(&bar[XB_XCNT(j)]); sum += c; cnt += (c > 0u) ? 1u : 0u; mine = (j == x) ? c : mine; }
        if (sum == G) break;
        __builtin_amdgcn_s_sleep(1);
        if ((++sp & 255u) == 0u) { if (xb_ld(&bar[XB_TMO])) break; if (sp > XB_SPIN_CAP) { atomicAdd(&bar[XB_TMO], 1u); break; } }
    }
    nloc = mine > 0u ? mine : 1u; nx = cnt > 0u ? cnt : 1u;
}
__device__ __forceinline__ void xcd_barrier(const XcdBarrier& b) {
    asm volatile("s_waitcnt vmcnt(0)" ::: "memory");
    __syncthreads();
    if (threadIdx.x == 0) {
        unsigned* bar = b.bar;
        __builtin_amdgcn_s_waitcnt(0);
        unsigned nloc = b.st[0], nx = b.st[1];
        if (nloc == 0u) { xcd_barrier_complete(bar, b.x, nloc, nx); b.st[0] = nloc; b.st[1] = nx; }
        const unsigned old = xb_add(&bar[XB_XSUB(b.x)], 1u);
        const unsigned gen = old / nloc;
        if (old + 1u == (gen + 1u) * nloc) {
            __builtin_amdgcn_fence(__ATOMIC_RELEASE, "agent");
            asm volatile("s_waitcnt vmcnt(0)" ::: "memory");
            const unsigned og = xb_add(&bar[XB_TOP], 1u);
            const unsigned tg = og / nx;
            if (og + 1u == (tg + 1u) * nx) xb_add(&bar[XB_TOPGEN], 1u);
            else XB_SPIN(xb_ld(&bar[XB_TOPGEN]) == tg, bar);
            __builtin_amdgcn_fence(__ATOMIC_ACQUIRE, "agent");
            xb_add(&bar[XB_XGEN(b.x)], 1u);
            asm volatile("s_waitcnt vmcnt(0)" ::: "memory");
        } else {
            XB_SPIN(xb_ld(&bar[XB_XGEN(b.x)]) == gen, bar);
            __builtin_amdgcn_fence(__ATOMIC_ACQUIRE, "agent");
            asm volatile("s_waitcnt vmcnt(0)" ::: "memory");
        }
    }
    __syncthreads();
}

namespace pg8 {
constexpr int BM = 256, BK = 64, HALF = 128, HTB = HALF * BK * 2, STAGE_BYTES = 8 * HTB, NXCD = 8, WGM = 8;
__host__ __device__ __forceinline__ int lds_byte(int r, int c) { const int st = (r >> 4) * 2 + (c >> 5), rr = r & 15, cc = c & 31, ob = rr * 64 + cc * 2; return st * 1024 + (ob ^ (((ob >> 9) & 1) << 5)); }
__host__ __device__ __forceinline__ void stage_rc(int b, int& R, int& C) { const int st = b / 1024, sb = b % 1024, swz = sb ^ (((sb >> 9) & 1) << 5); R = (st >> 1) * 16 + swz / 64; C = (st & 1) * 32 + (swz % 64) / 2; }
__host__ __device__ __forceinline__ int perm32(int rho) { const int n = rho >> 4, i = rho & 15; return 8 * (i >> 2) + 4 * n + (i & 3); }
struct Unit { int pm, pn, e; };

__device__ __forceinline__ unsigned cvt_pk_bf16(float lo, float hi) { unsigned r; asm volatile("v_cvt_pk_bf16_f32 %0, %1, %2" : "=v"(r) : "v"(lo), "v"(hi)); return r; }

struct EpiBf16 {
    static constexpr bool PERM = true;
    bf16* O; int ldc;
    __device__ __forceinline__ void operator()(const f32x4 (&acc)[2][2][4][2], const Unit& u, int wr, int wc, int fr, int fq) const {
        const int row0 = u.pm * BM + wr * 64 + fr, col0 = u.pn * BM + wc * 32 + 8 * fq;
#pragma unroll
        for (int ai = 0; ai < 2; ++ai)
#pragma unroll
            for (int m = 0; m < 4; ++m) { bf16* rowp = O + (size_t)(row0 + ai * HALF + m * 16) * ldc + col0;
#pragma unroll
                for (int bj = 0; bj < 2; ++bj) { const f32x4 v0 = acc[ai][bj][m][0], v1 = acc[ai][bj][m][1];
                    v4u w; w.x = cvt_pk_bf16(v0[0], v0[1]); w.y = cvt_pk_bf16(v0[2], v0[3]); w.z = cvt_pk_bf16(v1[0], v1[1]); w.w = cvt_pk_bf16(v1[2], v1[3]);
                    *(v4u*)(rowp + bj * HALF) = w; } }
    }
};
struct EpiF32 {
    static constexpr bool PERM = false;
    float* C; int ldc; const float* bias;
    __device__ __forceinline__ void operator()(const f32x4 (&acc)[2][2][4][2], const Unit& u, int wr, int wc, int fr, int fq) const {
        const int row0 = u.pm * BM + wr * 64 + fr, col0 = u.pn * BM + wc * 32 + 4 * fq;
        f32x4 bv[2][2];
#pragma unroll
        for (int bj = 0; bj < 2; ++bj)
#pragma unroll
            for (int n = 0; n < 2; ++n) bv[bj][n] = bias ? *(const f32x4*)(bias + col0 + bj * HALF + n * 16) : (f32x4){0.f, 0.f, 0.f, 0.f};
#pragma unroll
        for (int ai = 0; ai < 2; ++ai)
#pragma unroll
            for (int m = 0; m < 4; ++m) { float* rowp = C + (size_t)(row0 + ai * HALF + m * 16) * ldc + col0;
#pragma unroll
                for (int bj = 0; bj < 2; ++bj)
#pragma unroll
                    for (int n = 0; n < 2; ++n) *(f32x4*)(rowp + bj * HALF + n * 16) = acc[ai][bj][m][n] + bv[bj][n]; }
    }
};
struct EpiSwiglu {
    static constexpr bool PERM = true;
    bf16* H;
    __device__ __forceinline__ void operator()(const f32x4 (&acc)[2][2][4][2], const Unit& u, int wr, int wc, int fr, int fq) const {
        const int row0 = u.pm * BM + wr * 64 + fr, col0 = u.pn * HALF + wc * 32 + 8 * fq;
#pragma unroll
        for (int ai = 0; ai < 2; ++ai)
#pragma unroll
            for (int m = 0; m < 4; ++m) { bf16* rowp = H + (size_t)(row0 + ai * HALF + m * 16) * EFF + col0;
                float o[8];
#pragma unroll
                for (int n = 0; n < 2; ++n)
#pragma unroll
                    for (int j = 0; j < 4; ++j) { const float h1 = acc[ai][0][m][n][j], h3 = acc[ai][1][m][n][j]; o[n * 4 + j] = siluf_(h1) * h3; }
                v4u w; w.x = cvt_pk_bf16(o[0], o[1]); w.y = cvt_pk_bf16(o[2], o[3]); w.z = cvt_pk_bf16(o[4], o[5]); w.w = cvt_pk_bf16(o[6], o[7]);
                *(v4u*)rowp = w; }
    }
};

template <class Epi, class Prob, bool ALIGN_EPI>
__device__ __forceinline__ void gemm_phase(LAS unsigned char* lds, const Prob& P, const Epi& E) {
    const int tid = threadIdx.x, wid = __builtin_amdgcn_readfirstlane(tid >> 6), lane = tid & 63, wr = wid >> 2, wc = wid & 3, fr = lane & 15, fq = lane >> 4;
    const int K = P.K, nt = K / BK;
    int RA[2], CA[2]; unsigned voffB[2];
#pragma unroll
    for (int i = 0; i < 2; ++i) { int R, C; stage_rc(tid * 16 + i * 8192, R, C); const int Rb = Epi::PERM ? ((R & ~31) + perm32(R & 31)) : R;
        RA[i] = R; CA[i] = C; voffB[i] = (unsigned)(Rb * K + C) * 2u; }
    const size_t kstep = (size_t)(BK * 2);
    const size_t hstep = (size_t)HALF * K * 2;
    const unsigned ldsw = (unsigned)wid * 1024u;
    const int aoff = lds_byte(wr * 64 + fr, fq * 8), boff = lds_byte(wc * 32 + fr, fq * 8);
    const char* const Ab = P.Abase;
#define PG8_SA(b, h) (((b) * 2 + (h)) * HTB)
#define PG8_SB(b, h) ((4 + (b) * 2 + (h)) * HTB)
#define PG8_STAGE(bufoff, gbase, voff) do { _Pragma("unroll") for (int _i = 0; _i < 2; ++_i) \
        __builtin_amdgcn_global_load_lds((const unsigned*)((const char*)(gbase) + (voff)[_i]), (LAS unsigned*)(lds + (bufoff) + ldsw + _i * 8192), 16, 0, 0); } while (0)
#define PG8_STAGE_A(bufoff, kb, o0, o1) do { \
        __builtin_amdgcn_global_load_lds((const unsigned*)(Ab + (kb) + (o0)), (LAS unsigned*)(lds + (bufoff) + ldsw), 16, 0, 0); \
        __builtin_amdgcn_global_load_lds((const unsigned*)(Ab + (kb) + (o1)), (LAS unsigned*)(lds + (bufoff) + ldsw + 8192), 16, 0, 0); } while (0)
#define PG8_LDA(dst, b, h) do { _Pragma("unroll") for (int m = 0; m < 4; ++m) _Pragma("unroll") for (int k = 0; k < 2; ++k) dst[m][k] = *(const LAS bf16x8*)(lds + PG8_SA(b, h) + aoff + m * 2048 + k * 1024); } while (0)
#define PG8_LDB(dst, b, h) do { _Pragma("unroll") for (int n = 0; n < 2; ++n) _Pragma("unroll") for (int k = 0; k < 2; ++k) dst[n][k] = *(const LAS bf16x8*)(lds + PG8_SB(b, h) + boff + n * 2048 + k * 1024); } while (0)
#define PG8_MMA(ai, bj, At, Bt) do { __builtin_amdgcn_s_setprio(1); _Pragma("unroll") for (int m = 0; m < 4; ++m) _Pragma("unroll") for (int n = 0; n < 2; ++n) _Pragma("unroll") for (int k = 0; k < 2; ++k) \
        acc[ai][bj][m][n] = __builtin_amdgcn_mfma_f32_16x16x32_bf16(Bt[n][k], At[m][k], acc[ai][bj][m][n], 0, 0, 0); __builtin_amdgcn_s_setprio(0); } while (0)
#define PG8_WAIT_V(n) asm volatile("s_waitcnt vmcnt(" #n ")" ::: "memory")
#define PG8_WAIT_L(n) asm volatile("s_waitcnt lgkmcnt(" #n ")" ::: "memory")
#define PG8_BAR __builtin_amdgcn_s_barrier()
#define PG8_SCHED __builtin_amdgcn_sched_barrier(0)
    Unit cur, nxt; int ui = 0;
    if (!P.next(0, cur)) return;
    f32x4 acc[2][2][4][2];
#pragma unroll
    for (int a = 0; a < 2; ++a)
#pragma unroll
        for (int b = 0; b < 2; ++b)
#pragma unroll
            for (int m = 0; m < 4; ++m)
#pragma unroll
                for (int n = 0; n < 2; ++n) acc[a][b][m][n] = (f32x4){0.f, 0.f, 0.f, 0.f};
    bf16x8 At[4][2], B0[2][2], B1[2][2];
    unsigned oc[4], on[4];
    P.aoffs(cur, RA, CA, oc);
    const char* cB = P.bbase(cur);
    PG8_STAGE(PG8_SB(0, 0), cB, voffB); PG8_STAGE(PG8_SB(0, 1), cB + hstep, voffB); PG8_STAGE_A(PG8_SA(0, 0), (size_t)0, oc[0], oc[1]); PG8_STAGE_A(PG8_SA(0, 1), (size_t)0, oc[2], oc[3]);
    if (wr == 1) PG8_BAR;
    PG8_WAIT_V(2); PG8_BAR;
    PG8_STAGE(PG8_SB(1, 0), cB + kstep, voffB); PG8_STAGE_A(PG8_SA(1, 0), kstep, oc[0], oc[1]); PG8_STAGE(PG8_SB(1, 1), cB + hstep + kstep, voffB);
    PG8_WAIT_V(6); PG8_BAR;
    for (;;) {
        const bool has_next = P.next(ui + 1, nxt);
        const char* nB = cB;
        if (has_next) { P.aoffs(nxt, RA, CA, on); nB = P.bbase(nxt); }
        else { on[0] = oc[0]; on[1] = oc[1]; on[2] = oc[2]; on[3] = oc[3]; }
        for (int t = 0; t < nt; t += 2) {
            const bool last = (t == nt - 2);
            const size_t kb1 = (size_t)(t + 1) * kstep;
            const size_t kb2 = last ? (size_t)0 : (size_t)(t + 2) * kstep, kb3 = kb2 + kstep;
            const char* b2 = last ? nB : cB + (size_t)(t + 2) * kstep; const char* b3 = b2 + kstep;
            const unsigned o20 = last ? on[0] : oc[0], o21 = last ? on[1] : oc[1], o22 = last ? on[2] : oc[2], o23 = last ? on[3] : oc[3];
            PG8_LDB(B0, 0, 0); PG8_LDB(B1, 0, 1); PG8_SCHED; PG8_LDA(At, 0, 0); PG8_STAGE_A(PG8_SA(1, 1), kb1, oc[2], oc[3]);
            PG8_WAIT_V(8); PG8_WAIT_L(0); PG8_BAR; PG8_MMA(0, 0, At, B0); PG8_MMA(0, 1, At, B1); PG8_BAR; PG8_SCHED;
            PG8_LDA(At, 0, 1); PG8_STAGE(PG8_SB(0, 0), b2, voffB); PG8_STAGE(PG8_SB(0, 1), b2 + hstep, voffB); PG8_STAGE_A(PG8_SA(0, 0), kb2, o20, o21);
            PG8_WAIT_V(8); PG8_WAIT_L(0); PG8_BAR; PG8_MMA(1, 0, At, B0); PG8_MMA(1, 1, At, B1); PG8_BAR; PG8_SCHED;
            PG8_LDB(B0, 1, 0); PG8_LDB(B1, 1, 1); PG8_SCHED; PG8_LDA(At, 1, 0); PG8_STAGE_A(PG8_SA(0, 1), kb2, o22, o23);
            PG8_WAIT_V(8); PG8_WAIT_L(0); PG8_BAR; PG8_MMA(0, 0, At, B0); PG8_MMA(0, 1, At, B1); PG8_BAR; PG8_SCHED;
            PG8_LDA(At, 1, 1); PG8_STAGE(PG8_SB(1, 0), b3, voffB); PG8_STAGE(PG8_SB(1, 1), b3 + hstep, voffB); PG8_STAGE_A(PG8_SA(1, 0), kb3, o20, o21);
            PG8_WAIT_V(8); PG8_WAIT_L(0); PG8_BAR; PG8_MMA(1, 0, At, B0); PG8_MMA(1, 1, At, B1); PG8_BAR; PG8_SCHED;
        }
        if constexpr (ALIGN_EPI) { if (wr == 0) PG8_BAR; }
        E(acc, cur, wr, wc, fr, fq);
        if (!has_next) break;
#pragma unroll
        for (int a = 0; a < 2; ++a)
#pragma unroll
            for (int b = 0; b < 2; ++b)
#pragma unroll
                for (int m = 0; m < 4; ++m)
#pragma unroll
                    for (int n = 0; n < 2; ++n) acc[a][b][m][n] = (f32x4){0.f, 0.f, 0.f, 0.f};
        cur = nxt; cB = nB; oc[0] = on[0]; oc[1] = on[1]; oc[2] = on[2]; oc[3] = on[3]; ++ui;
        if constexpr (ALIGN_EPI) { if (wr == 1) PG8_BAR; }
    }
    PG8_WAIT_V(0);
    if constexpr (!ALIGN_EPI) { if (wr == 0) PG8_BAR; }
    PG8_BAR;
#undef PG8_SA
#undef PG8_SB
#undef PG8_STAGE
#undef PG8_STAGE_A
#undef PG8_LDA
#undef PG8_LDB
#undef PG8_MMA
#undef PG8_WAIT_V
#undef PG8_WAIT_L
#undef PG8_BAR
#undef PG8_SCHED
}

struct DenseProb {
    int K; const char* Abase; const char* Bt; int lda; int nM, nN, nwg, G, c;
    __device__ __forceinline__ void init(const bf16* A, int lda_, const bf16* B, int M, int N, int K_, int G_, int c_) { Abase = (const char*)A; Bt = (const char*)B; lda = lda_; K = K_; nM = M / BM; nN = N / BM; nwg = nM * nN; G = G_; c = c_; }
    __device__ __forceinline__ bool next(int i, Unit& u) const {
        const long L = (long)i * G + c; if (L >= nwg) return false;
        int wgid = (int)L; { const int q = nwg / NXCD, r = nwg % NXCD, xcd = wgid % NXCD, off = wgid / NXCD; wgid = (xcd < r ? xcd * (q + 1) : r * (q + 1) + (xcd - r) * q) + off; }
        const int nig = WGM * nN, gid = wgid / nig, fm = gid * WGM, gsz = (nM - fm) < WGM ? (nM - fm) : WGM;
        u.pm = fm + ((wgid % nig) % gsz); u.pn = (wgid % nig) / gsz; u.e = 0; return true;
    }
    __device__ __forceinline__ const char* bbase(const Unit& u) const { return Bt + (size_t)u.pn * BM * K * 2; }
    __device__ __forceinline__ void aoffs(const Unit& u, const int (&R)[2], const int (&C)[2], unsigned (&o)[4]) const {
#pragma unroll
        for (int h = 0; h < 2; ++h)
#pragma unroll
            for (int i = 0; i < 2; ++i) o[2 * h + i] = (unsigned)(((size_t)(u.pm * BM + h * HALF + R[i]) * lda + C[i]) * 2);
    }
};
__device__ __forceinline__ bool xcd_range_unit(int i, int nunits, int G, int c, int& L) {
    const int x = c % NXCD, cc = c / NXCD, per = G / NXCD, q = nunits / NXCD, r = nunits % NXCD;
    const int start = x * q + (x < r ? x : r), cnt = q + (x < r ? 1 : 0), li = i * per + cc;
    if (li >= cnt) return false; L = start + li; return true;
}
struct MoeUpProb {
    int K; const char* Abase; const char* W13; const int* sorted; const LAS int* tile_e; int ntiles, nunits, G, c;
    __device__ __forceinline__ bool next(int i, Unit& u) const {
        int L; if (!xcd_range_unit(i, nunits, G, c, L)) return false;
        const int tile = L >> 2; u.pn = L & 3;
        if (tile < ntiles) { u.pm = tile; u.e = __builtin_amdgcn_readfirstlane(tile_e[tile]); } else { u.pm = MAXTILES + (tile - ntiles); u.e = NEXP; }
        return true;
    }
    __device__ __forceinline__ const char* bbase(const Unit& u) const { return W13 + ((size_t)u.e * 1024 + (size_t)u.pn * BM) * 2048 * 2; }
    __device__ __forceinline__ void aoffs(const Unit& u, const int (&R)[2], const int (&C)[2], unsigned (&o)[4]) const {
#pragma unroll
        for (int h = 0; h < 2; ++h)
#pragma unroll
            for (int i = 0; i < 2; ++i) { int row;
                if (u.e == NEXP) row = (u.pm - MAXTILES) * BM + h * HALF + R[i];
                else row = sorted[u.pm * BM + h * HALF + R[i]];
                o[2 * h + i] = (unsigned)(((size_t)row * 2048 + C[i]) * 2); }
    }
};
struct MoeDownProb {
    int K; const char* Abase; const char* W2; const LAS int* tile_e; int ntiles, nunits, G, c;
    __device__ __forceinline__ bool next(int i, Unit& u) const {
        int L; if (!xcd_range_unit(i, nunits, G, c, L)) return false;
        const int tile = L >> 3; u.pn = L & 7;
        if (tile < ntiles) { u.pm = tile; u.e = __builtin_amdgcn_readfirstlane(tile_e[tile]); } else { u.pm = MAXTILES + (tile - ntiles); u.e = NEXP; }
        return true;
    }
    __device__ __forceinline__ const char* bbase(const Unit& u) const { return W2 + ((size_t)u.e * 2048 + (size_t)u.pn * BM) * EFF * 2; }
    __device__ __forceinline__ void aoffs(const Unit& u, const int (&R)[2], const int (&C)[2], unsigned (&o)[4]) const {
#pragma unroll
        for (int h = 0; h < 2; ++h)
#pragma unroll
            for (int i = 0; i < 2; ++i) o[2 * h + i] = (unsigned)(((size_t)(u.pm * BM + h * HALF + R[i]) * EFF + C[i]) * 2);
    }
};
struct CmpProb {
    int K; const char* Abase; const char* Bt; int G, c;
    __device__ __forceinline__ bool next(int i, Unit& u) const { const int L = i * G + c; if (L >= 16) return false; u.pm = L; u.pn = 0; u.e = 0; return true; }
    __device__ __forceinline__ const char* bbase(const Unit&) const { return Bt; }
    __device__ __forceinline__ void aoffs(const Unit& u, const int (&R)[2], const int (&C)[2], unsigned (&o)[4]) const {
#pragma unroll
        for (int h = 0; h < 2; ++h)
#pragma unroll
            for (int i = 0; i < 2; ++i) { const int m = u.pm * BM + h * HALF + R[i], seq = m >> 7, n = m & 127;
                o[2 * h + i] = (unsigned)((((size_t)seq * NS + 16 * n) * 128 + C[i]) * 2); }
    }
};
}

struct Args { const float* in[27]; float* out; unsigned char* ws; int ph_lo, ph_hi; };
typedef const __attribute__((address_space(4))) Args* CArgs;
__device__ __forceinline__ const float* kin(int i) { CArgs p = (CArgs)__builtin_amdgcn_kernarg_segment_ptr(); asm volatile("" : "+s"(p)); return p->in[i]; }
struct Frame {
    LAS unsigned char* lds;
    volatile LAS unsigned* MISC;
    unsigned* ctl;
    unsigned char* ws;
    int tid, lane, wave, vcu, G, gw, NGW;
    float* out;
};

__device__ __forceinline__ void tr_item(const float* W, int ldw, int k0, int n0, int nvalid, bf16* WT, int ldt, int drow0, LAS float* scr, int lane) {
#pragma unroll 8
    for (int i = 0; i < 32; ++i) { const int kk = 2 * i + (lane >> 5), n = lane & 31; scr[kk * 33 + n] = (n < nvalid) ? W[(size_t)(k0 + kk) * ldw + n0 + n] : 0.f; }
    LDS_WAIT(); asm volatile("" ::: "memory");
    const int c = lane & 7;
#pragma unroll
    for (int j = 0; j < 4; ++j) { const int n = (lane >> 3) + 8 * j; const LAS float* s = scr + (8 * c) * 33 + n;
        v4u o; o.x = pk2(s[0 * 33], s[1 * 33]); o.y = pk2(s[2 * 33], s[3 * 33]); o.z = pk2(s[4 * 33], s[5 * 33]); o.w = pk2(s[6 * 33], s[7 * 33]);
        if (n < nvalid) *(v4u*)(WT + (size_t)(drow0 + n) * ldt + k0 + 8 * c) = o; }
    LDS_WAIT(); asm volatile("" ::: "memory");
}
__device__ __forceinline__ bool tr_matrix(int& it, const float* W, int ldw, int K, int c0, int ncols, bf16* WT, int drow0, LAS float* scr, int lane) {
    const int nb = (ncols + 31) / 32, items = (K / 64) * nb;
    if (it >= items) { it -= items; return false; }
    const int kb = it / nb, b = it % nb, nv = ncols - 32 * b;
    tr_item(W, ldw, 64 * kb, c0 + 32 * b, nv < 32 ? nv : 32, WT, K, drow0 + 32 * b, scr, lane);
    return true;
}
__device__ __forceinline__ void zero_rows(Frame& F, bf16* base, size_t nelem) {
    for (size_t i = ((size_t)F.gw * 64 + F.lane) * 8; i < nelem; i += (size_t)F.NGW * 64 * 8) *(v4u*)(base + i) = (v4u){0u, 0u, 0u, 0u};
}

__device__ __forceinline__ void p_prologue(Frame& F) {
    LAS float* scr = (LAS float*)(F.lds + F.wave * 16384);
    unsigned char* ws = F.ws;
    {
        LAS float* wl = (LAS float*)F.lds;
        LAS float* pl = (LAS float*)(F.lds + 32768);
        const float* w_in = kin(2); const float* pool_w = kin(3); const float* pscale = kin(4);
        bf16* WT = (bf16*)(ws + WS_WABIN);
        for (int it = blockIdx.x; it < 4 * 32; it += F.G) {
            const int g = it >> 5, k0 = (it & 31) * 64;
            for (int i = F.tid; i < 64 * 128; i += 512) wl[i] = w_in[(size_t)(k0 + (i >> 7)) * AB_IN + g * 128 + (i & 127)];
            for (int i = F.tid; i < 128 * 128; i += 512) pl[i] = pool_w[(size_t)g * 16384 + i];
            __syncthreads();
            const int d = F.tid & 127, kg = F.tid >> 7; const float sc = pscale[g * 128 + d];
            for (int kk = 0; kk < 16; kk += 8) {
                float a[8];
#pragma unroll
                for (int j = 0; j < 8; ++j) a[j] = 0.f;
                for (int c = 0; c < 128; ++c) { const float pw = pl[c * 128 + d];
#pragma unroll
                    for (int j = 0; j < 8; ++j) a[j] += wl[(kg * 16 + kk + j) * 128 + c] * pw; }
                v4u o; o.x = pk2(a[0] * sc, a[1] * sc); o.y = pk2(a[2] * sc, a[3] * sc); o.z = pk2(a[4] * sc, a[5] * sc); o.w = pk2(a[6] * sc, a[7] * sc);
                *(v4u*)(WT + (size_t)(g * 128 + d) * ND + k0 + kg * 16 + kk) = o;
            }
            __syncthreads();
        }
    }
    __syncthreads();
    for (int it0 = F.gw; ; it0 += F.NGW) {
        int it = it0;
        if (tr_matrix(it, kin(2), AB_IN, ND, 512, AB_IN - 512, (bf16*)(ws + WS_WABIN), 512, scr, F.lane)) continue;
        if (tr_matrix(it, kin(5), ND, ND, 0, ND, (bf16*)(ws + WS_WABOUT), 0, scr, F.lane)) continue;
        if (tr_matrix(it, kin(6), CD_IN, ND, 0, CD_IN, (bf16*)(ws + WS_WCDIN), 0, scr, F.lane)) continue;
        if (tr_matrix(it, kin(14), ND, ND, 0, ND, (bf16*)(ws + WS_WCDOUT), 0, scr, F.lane)) continue;
        if (tr_matrix(it, kin(11), 1536, 384, 0, 1536, (bf16*)(ws + WS_WUQ), 0, scr, F.lane)) continue;
        if (tr_matrix(it, kin(13), 2048, 512, 0, 2048, (bf16*)(ws + WS_WUKV), 0, scr, F.lane)) continue;
        if (tr_matrix(it, kin(8), 128, 4096, 0, 128, (bf16*)(ws + WS_CW1), 0, scr, F.lane)) continue;
        if (tr_matrix(it, kin(8) + (size_t)4096 * 128, 128, 4096, 0, 128, (bf16*)(ws + WS_CW1), 128, scr, F.lane)) continue;
        break;
    }
    zero_rows(F, (bf16*)(ws + WS_WCDIN) + (size_t)CD_IN * ND, (size_t)(CD_INP - CD_IN) * ND);
    { const float* x = kin(0); bf16* xb = (bf16*)(ws + WS_XB0);
      for (size_t i = ((size_t)F.gw * 64 + F.lane) * 8; i < (size_t)NT * ND; i += (size_t)F.NGW * 64 * 8) {
          const f32x4 a = *(const f32x4*)(x + i), b = *(const f32x4*)(x + i + 4);
          v4u o; o.x = pk2(a[0], a[1]); o.y = pk2(a[2], a[3]); o.z = pk2(b[0], b[1]); o.w = pk2(b[2], b[3]); *(v4u*)(xb + i) = o; } }
    if (blockIdx.x == 0 && F.tid < 256) { const int kv = F.tid >> 7, h = F.tid & 127; const float* pos = kin(7) + (size_t)kv * 4096; const float* w1 = kin(8) + (size_t)kv * 4096 * 128;
        float s = 0.f; for (int f = 0; f < 4096; ++f) s += pos[f] * w1[(size_t)f * 128 + h];
        ((float*)(ws + WS_CMPB))[F.tid] = s; }
}
__device__ __forceinline__ void p_moe_weights(Frame& F, int l) {
    LAS float* scr = (LAS float*)(F.lds + F.wave * 16384);
    unsigned char* ws = F.ws;
    bf16* W13 = (bf16*)(ws + WS_W13); bf16* W2 = (bf16*)(ws + WS_W2); bf16* RT = (bf16*)(ws + WS_RT);
    const int total = 65 * 1536 + 32 * 2;
    for (int it = F.gw; it < total; it += F.NGW) {
        if (it >= 65 * 1536) { const int r = it - 65 * 1536, kb = r >> 1, b = r & 1;
            tr_item(kin(19) + (size_t)l * ND * NEXP, NEXP, 64 * kb, 32 * b, 32, RT, ND, 32 * b, scr, F.lane); continue; }
        const int e = it / 1536, r = it % 1536;
        const float *w1, *w3, *w2;
        if (e < NEXP) { const size_t o = ((size_t)l * NEXP + e) * ND * EFF; w1 = kin(21) + o; w3 = kin(22) + o; w2 = kin(23) + o; }
        else { const size_t o = (size_t)l * ND * EFF; w1 = kin(24) + o; w3 = kin(25) + o; w2 = kin(26) + o; }
        if (r < 1024) { const int which = r >> 9, rr = r & 511, kb = rr >> 4, nb = rr & 15;
            const int j = nb >> 2, drow = j * 256 + which * 128 + (nb & 3) * 32;
            tr_item(which ? w3 : w1, EFF, 64 * kb, 32 * nb, 32, W13 + (size_t)e * 1024 * ND, ND, drow, scr, F.lane); }
        else { const int rr = r - 1024, kb = rr >> 6, nb = rr & 63;
            tr_item(w2, ND, 64 * kb, 32 * nb, 32, W2 + (size_t)e * ND * EFF, EFF, 32 * nb, scr, F.lane); }
    }
    zero_rows(F, RT + (size_t)NEXP * ND, (size_t)(256 - NEXP) * ND);
}

__device__ __forceinline__ void ln_finish(float (&v)[4][8], const float* g, const float* b, int lane, bf16* ob, float* of) {
    float s = 0.f;
#pragma unroll
    for (int j = 0; j < 4; ++j)
#pragma unroll
        for (int i = 0; i < 8; ++i) s += v[j][i];
    const float mean = wave_sum(s) * (1.f / ND); float s2 = 0.f;
#pragma unroll
    for (int j = 0; j < 4; ++j)
#pragma unroll
        for (int i = 0; i < 8; ++i) { v[j][i] -= mean; s2 += v[j][i] * v[j][i]; }
    const float rstd = 1.f / sqrtf(wave_sum(s2) * (1.f / ND) + LN_EPS);
#pragma unroll
    for (int j = 0; j < 4; ++j) { const int c0 = (j * 64 + lane) * 8;
        const f32x4 g0 = *(const f32x4*)(g + c0), g1 = *(const f32x4*)(g + c0 + 4), b0 = *(const f32x4*)(b + c0), b1 = *(const f32x4*)(b + c0 + 4);
        float o[8];
#pragma unroll
        for (int i = 0; i < 4; ++i) { o[i] = v[j][i] * rstd * g0[i] + b0[i]; o[4 + i] = v[j][4 + i] * rstd * g1[i] + b1[i]; }
        if (ob) { v4u w; w.x = pk2(o[0], o[1]); w.y = pk2(o[2], o[3]); w.z = pk2(o[4], o[5]); w.w = pk2(o[6], o[7]); *(v4u*)(ob + c0) = w; }
        if (of) { *(f32x4*)(of + c0) = (f32x4){o[0], o[1], o[2], o[3]}; *(f32x4*)(of + c0 + 4) = (f32x4){o[4], o[5], o[6], o[7]}; } }
}
__device__ __forceinline__ void p_ln1(Frame& F, const bf16* xin, const bf16* mixo, const float* g, const float* b, bf16* xo) {
    for (int m = F.gw; m < NT; m += F.NGW) {
        float v[4][8];
#pragma unroll
        for (int j = 0; j < 4; ++j) { const size_t o = (size_t)m * ND + (j * 64 + F.lane) * 8; float a[8], c[8]; unpack8(*(const v4u*)(xin + o), a); unpack8(*(const v4u*)(mixo + o), c);
#pragma unroll
            for (int i = 0; i < 8; ++i) v[j][i] = DN_ALPHA * a[i] + c[i]; }
        ln_finish(v, g, b, F.lane, xo + (size_t)m * ND, nullptr);
    }
}
__device__ __forceinline__ void p_combine_ln2(Frame& F, const bf16* x1, const bf16* y2, const int* slot, const float* wsel, const float* g, const float* b, bf16* xo, float* fo) {
    for (int m = F.gw; m < NT; m += F.NGW) {
        float v[4][8];
#pragma unroll
        for (int j = 0; j < 4; ++j) { const size_t o = (size_t)m * ND + (j * 64 + F.lane) * 8; float a[8], c[8]; unpack8(*(const v4u*)(x1 + o), a);
            unpack8(*(const v4u*)(y2 + (size_t)(SH_ROW0 + m) * ND + (j * 64 + F.lane) * 8), c);
#pragma unroll
            for (int i = 0; i < 8; ++i) v[j][i] = DN_ALPHA * a[i] + c[i]; }
        for (int k = 0; k < 8; ++k) { const int row = slot[m * 8 + k]; const float w = wsel[m * 8 + k];
#pragma unroll
            for (int j = 0; j < 4; ++j) { float c[8]; unpack8(*(const v4u*)(y2 + (size_t)row * ND + (j * 64 + F.lane) * 8), c);
#pragma unroll
                for (int i = 0; i < 8; ++i) v[j][i] += w * c[i]; } }
        ln_finish(v, g, b, F.lane, xo ? xo + (size_t)m * ND : nullptr, fo ? fo + (size_t)m * ND : nullptr);
    }
}

__device__ __forceinline__ void p_pool_rope(Frame& F) {
    const bf16* proj = (const bf16*)(F.ws + WS_PROJ); bf16* mixin = (bf16*)(F.ws + WS_MIXIN); bf16* qr = (bf16*)(F.ws + WS_QR); bf16* kr = (bf16*)(F.ws + WS_KR);
    const int* pos = (const int*)kin(1);
    for (int m = F.gw; m < NT; m += F.NGW) {
        const int s = m & (NS - 1);
        { const int g = F.lane >> 4, w = 2 << g; const int lo = (s + 1 - w) > 0 ? (s + 1 - w) : 0; const float cnt = (float)((s + 1) < w ? (s + 1) : w);
          float acc[8], cur[8];
#pragma unroll
          for (int i = 0; i < 8; ++i) acc[i] = 0.f;
          for (int j = lo; j <= s; ++j) { float t[8]; unpack8(*(const v4u*)(proj + (size_t)(m - s + j) * AB_IN + F.lane * 8), t);
#pragma unroll
              for (int i = 0; i < 8; ++i) acc[i] += t[i]; }
          unpack8(*(const v4u*)(proj + (size_t)m * AB_IN + F.lane * 8), cur);
          float o[8];
#pragma unroll
          for (int i = 0; i < 8; ++i) o[i] = acc[i] / cnt - cur[i];
          v4u wv; wv.x = pk2(o[0], o[1]); wv.y = pk2(o[2], o[3]); wv.z = pk2(o[4], o[5]); wv.w = pk2(o[6], o[7]); *(v4u*)(mixin + (size_t)m * ND + F.lane * 8) = wv; }
        { const float p = (float)pos[m]; const float invf = exp2f(-(float)F.lane * (13.287712379549449f / 64.f));
          float sn, cs; sincosf(p * invf, &sn, &cs);
          const bf16* qrow = proj + (size_t)m * AB_IN + 512; const bf16* krow = proj + (size_t)m * AB_IN + 1280;
#pragma unroll
          for (int h = 0; h < 6; ++h) {
              const float q1 = bf1(qrow[h * 128 + F.lane]), q2 = bf1(qrow[h * 128 + 64 + F.lane]);
              qr[(size_t)m * 768 + h * 128 + F.lane] = (bf16)f2bf(q1 * cs - q2 * sn); qr[(size_t)m * 768 + h * 128 + 64 + F.lane] = (bf16)f2bf(q1 * sn + q2 * cs);
              const float k1 = bf1(krow[h * 128 + F.lane]), k2 = bf1(krow[h * 128 + 64 + F.lane]); const float ksc = 0.08838834764831845f;
              kr[(size_t)m * 768 + h * 128 + F.lane] = (bf16)f2bf((k1 * cs - k2 * sn) * ksc); kr[(size_t)m * 768 + h * 128 + 64 + F.lane] = (bf16)f2bf((k1 * sn + k2 * cs) * ksc);
          } }
    }
}
__device__ __forceinline__ void p_retention(Frame& F) {
    const bf16* proj = (const bf16*)(F.ws + WS_PROJ); bf16* mixin = (bf16*)(F.ws + WS_MIXIN); const bf16* qr = (const bf16*)(F.ws + WS_QR); const bf16* kr = (const bf16*)(F.ws + WS_KR);
    LAS float* qs = (LAS float*)F.lds;
    LAS float* ks = qs + 16 * 128;
    LAS float* vs = ks + 16 * 128;
    LAS float* part = vs + 16 * 256;
    for (int bh = blockIdx.x; bh < NB * 6; bh += F.G) {
        const int b = bh / 6, h = bh % 6; const float gamma = 1.0f - exp2f(-5.0f - (float)h);
        const int v = F.tid & 255, dh = F.tid >> 8;
        float S[64];
#pragma unroll
        for (int i = 0; i < 64; ++i) S[i] = 0.f;
        for (int tb = 0; tb < NS / 16; ++tb) {
            const int m0 = b * NS + tb * 16;
            { const int which = F.tid >> 8, tok = (F.tid >> 4) & 15, dc = F.tid & 15; const bf16* src = (which ? kr : qr) + (size_t)(m0 + tok) * 768 + h * 128 + dc * 8;
              float t[8]; unpack8(*(const v4u*)src, t); LAS float* dst = (which ? ks : qs) + tok * 128 + dc * 8;
#pragma unroll
              for (int i = 0; i < 8; ++i) dst[i] = t[i]; }
            for (int i = F.tid; i < 16 * 256; i += 512) vs[i] = bf1(proj[(size_t)(m0 + (i >> 8)) * AB_IN + 2048 + h * 256 + (i & 255)]);
            __syncthreads();
            for (int tt = 0; tt < 16; ++tt) {
                const float vv = vs[tt * 256 + v]; float y = 0.f;
#pragma unroll
                for (int d4 = 0; d4 < 16; ++d4) { const f32x4 k4 = *(const LAS f32x4*)(ks + tt * 128 + dh * 64 + d4 * 4), q4 = *(const LAS f32x4*)(qs + tt * 128 + dh * 64 + d4 * 4);
#pragma unroll
                    for (int j = 0; j < 4; ++j) { S[d4 * 4 + j] = gamma * S[d4 * 4 + j] + k4[j] * vv; y += q4[j] * S[d4 * 4 + j]; } }
                part[(tt * 2 + dh) * 256 + v] = y;
            }
            __syncthreads();
#pragma unroll
            for (int r = 0; r < 2; ++r) { const int tt = F.wave * 2 + r, m = m0 + tt; float y[4]; float s = 0.f;
#pragma unroll
                for (int j = 0; j < 4; ++j) { y[j] = part[(tt * 2) * 256 + j * 64 + F.lane] + part[(tt * 2 + 1) * 256 + j * 64 + F.lane]; s += y[j]; }
                const float mean = wave_sum(s) * (1.f / 256.f); float s2 = 0.f;
#pragma unroll
                for (int j = 0; j < 4; ++j) { y[j] -= mean; s2 += y[j] * y[j]; }
                const float rstd = 1.f / sqrtf(wave_sum(s2) * (1.f / 256.f) + NORM_EPS);
#pragma unroll
                for (int j = 0; j < 4; ++j) { const float gt = bf1(proj[(size_t)m * AB_IN + 3584 + h * 256 + j * 64 + F.lane]);
                    mixin[(size_t)m * ND + 512 + h * 256 + j * 64 + F.lane] = (bf16)f2bf(y[j] * rstd * siluf_(gt)); } }
            __syncthreads();
        }
    }
}

__device__ __forceinline__ void p_route(Frame& F, int l) {
    const float* logits = (const float*)(F.ws + WS_LOGITS); const float* rbias = kin(20) + l * NEXP;
    int* tope = (int*)(F.ws + WS_TOPE); float* wsel = (float*)(F.ws + WS_WSEL); int* posb = (int*)(F.ws + WS_SLOT); unsigned* cnt = F.ctl + CW_CNT + l * 64;
    const float bias = rbias[F.lane];
    for (int m = F.gw; m < NT; m += F.NGW) {
        const float sc = sigmoidf_(logits[(size_t)m * 256 + F.lane]), bi = sc + bias;
        const int grp = F.lane >> 3;
        int rk = 0;
#pragma unroll
        for (int j = 1; j < 8; ++j) { const int o = (F.lane & ~7) | ((F.lane + j) & 7); const float ov = __shfl(bi, o); rk += ((ov > bi) || (ov == bi && o < F.lane)) ? 1 : 0; }
        float gs = rk < 2 ? bi : 0.f; gs += __shfl_xor(gs, 1); gs += __shfl_xor(gs, 2); gs += __shfl_xor(gs, 4);
        int grk = 0;
#pragma unroll
        for (int gg = 0; gg < 8; ++gg) { const float ov = __shfl(gs, gg * 8); grk += (gg != grp && ((ov > gs) || (ov == gs && gg < grp))) ? 1 : 0; }
        const float mv = grk < 4 ? bi : -1e30f;
        int erk = 0;
        for (int j = 0; j < 64; ++j) { const float ov = __shfl(mv, j); erk += ((ov > mv) || (ov == mv && j < F.lane)) ? 1 : 0; }
        const bool sel = erk < 8;
        const float wsum = wave_sum(sel ? sc : 0.f);
        if (sel) { const unsigned p = atomicAdd(&cnt[F.lane], 1u); tope[m * 8 + erk] = F.lane; wsel[m * 8 + erk] = sc / wsum * 2.5f; posb[m * 8 + erk] = (int)p; }
    }
}
__device__ __forceinline__ void load_offsets(Frame& F, int l) {
    volatile LAS int* tab = (volatile LAS int*)(F.lds + TAB_OFF);
    __syncthreads();
    if (F.tid < NEXP) tab[66 + F.tid] = (int)__hip_atomic_load(F.ctl + CW_CNT + l * 64 + F.tid, __ATOMIC_RELAXED, __HIP_MEMORY_SCOPE_AGENT);
    __syncthreads();
    if (F.tid == 0) { int o = 0; for (int e = 0; e < NEXP; ++e) { tab[e] = o; int c = tab[66 + e]; if (c > NT) c = NT; const int nt_ = (c + 255) >> 8; for (int t = 0; t < nt_; ++t) { const int ti = (o >> 8) + t; if (ti < MAXTILES) tab[160 + ti] = e; } o += nt_ << 8; if (o > MAXROWS) o = MAXROWS; }
        tab[64] = o; tab[65] = o >> 8; }
    __syncthreads();
}
__device__ __forceinline__ void p_scatter(Frame& F, int l) {
    load_offsets(F, l);
    const LAS int* tab = (const LAS int*)(F.lds + TAB_OFF);
    const int* tope = (const int*)(F.ws + WS_TOPE); int* slot = (int*)(F.ws + WS_SLOT); int* sorted = (int*)(F.ws + WS_SORTED);
    for (int i = F.gw * 64 + F.lane; i < NT * 8; i += F.NGW * 64) { const int e = tope[i]; const int row = tab[e] + slot[i]; sorted[row] = i >> 3; slot[i] = row; }
    for (int i = F.gw * 64 + F.lane; i < NEXP * 256; i += F.NGW * 64) { const int e = i >> 8, j = i & 255; const int r = tab[e] + tab[66 + e] + j; if (r < tab[e + 1]) sorted[r] = 0; }
}

__device__ __forceinline__ void p_l1_thin_a(Frame& F) {
    const bf16* proj = (const bf16*)(F.ws + WS_PROJ); const int* pos = (const int*)kin(1);
    bf16* cqn = (bf16*)(F.ws + WS_CQN); bf16* ckvn = (bf16*)(F.ws + WS_CKVN); bf16* krot = (bf16*)(F.ws + WS_KROT); bf16* cmpkv = (bf16*)(F.ws + WS_CMPKV);
    const float* qn = kin(10); const float* kvn = kin(12);
    for (int m = F.gw; m < NT; m += F.NGW) {
        const bf16* row = proj + (size_t)m * CD_INP;
        { float x[6]; float s = 0.f;
#pragma unroll
          for (int j = 0; j < 6; ++j) { x[j] = bf1(row[2584 + j * 64 + F.lane]); s += x[j] * x[j]; }
          const float r = 1.f / sqrtf(wave_sum(s) * (1.f / 384.f) + NORM_EPS);
#pragma unroll
          for (int j = 0; j < 6; ++j) cqn[(size_t)m * 384 + j * 64 + F.lane] = (bf16)f2bf(x[j] * r * qn[j * 64 + F.lane]); }
        { float x[8]; float s = 0.f;
#pragma unroll
          for (int j = 0; j < 8; ++j) { x[j] = bf1(row[2968 + j * 64 + F.lane]); s += x[j] * x[j]; }
          const float r = 1.f / sqrtf(wave_sum(s) * (1.f / 512.f) + NORM_EPS);
#pragma unroll
          for (int j = 0; j < 8; ++j) ckvn[(size_t)m * 512 + j * 64 + F.lane] = (bf16)f2bf(x[j] * r * kvn[j * 64 + F.lane]); }
        { const int i = F.lane & 31; const float p = (float)pos[m]; const float invf = exp2f(-(float)i * (13.287712379549449f / 32.f));
          float sn, cs; sincosf(p * invf, &sn, &cs);
          const float x1 = bf1(row[3480 + i]), x2 = bf1(row[3480 + 32 + i]);
          if (F.lane < 32) krot[(size_t)m * 64 + i] = (bf16)f2bf(x1 * cs - x2 * sn); else krot[(size_t)m * 64 + 32 + i] = (bf16)f2bf(x1 * sn + x2 * cs); }
        { const int b = m >> 11, s = m & (NS - 1);
          const int q4 = F.lane >> 4, c = F.lane & 15, kv = q4 >> 1, g = q4 & 1;
          const v4u w = *(const v4u*)(row + 1024 + q4 * 128 + c * 8);
          *(v4u*)(cmpkv + ((size_t)((kv * 16 + b * 2 + g) * NS + s)) * 128 + c * 8) = w; }
    }
}
__device__ __forceinline__ void p_l1_thin_b(Frame& F) {
    bf16* qmla = (bf16*)(F.ws + WS_QMLA); const int* pos = (const int*)kin(1);
    for (int m = F.gw; m < NT; m += F.NGW) {
        const int i = F.lane & 31; const float p = (float)pos[m]; const float invf = exp2f(-(float)i * (13.287712379549449f / 32.f));
        float sn, cs; sincosf(p * invf, &sn, &cs);
#pragma unroll
        for (int hh = 0; hh < 4; ++hh) { const int h = hh * 2 + (F.lane >> 5); bf16* q = qmla + (size_t)m * 1536 + h * 192 + 128;
            const float x1 = bf1(q[i]), x2 = bf1(q[32 + i]); q[i] = (bf16)f2bf(x1 * cs - x2 * sn); q[32 + i] = (bf16)f2bf(x1 * sn + x2 * cs); }
    }
    const float* hid = (const float*)(F.ws + WS_HID); const float* w2 = kin(9); float* kvc = (float*)(F.ws + WS_KVCMP);
    for (int m = F.gw; m < 4096; m += F.NGW) {
        const int kv = m >> 11;
        float h0 = hid[(size_t)m * 256 + kv * 128 + F.lane], h1 = hid[(size_t)m * 256 + kv * 128 + 64 + F.lane];
        h0 = 0.5f * h0 * (1.f + tanhf(0.7978845608028654f * (h0 + 0.044715f * h0 * h0 * h0)));
        h1 = 0.5f * h1 * (1.f + tanhf(0.7978845608028654f * (h1 + 0.044715f * h1 * h1 * h1)));
        const float* w = w2 + (size_t)kv * 128 * 128; float o0 = 0.f, o1 = 0.f;
        for (int c = 0; c < 64; ++c) { const float a = __shfl(h0, c), bq = __shfl(h1, c);
            o0 += a * w[c * 128 + F.lane] + bq * w[(c + 64) * 128 + F.lane]; o1 += a * w[c * 128 + 64 + F.lane] + bq * w[(c + 64) * 128 + 64 + F.lane]; }
        kvc[(size_t)m * 128 + F.lane] = o0; kvc[(size_t)m * 128 + 64 + F.lane] = o1;
    }
}
__device__ __forceinline__ void p_nsa_cmp(Frame& F) {
    const bf16* proj = (const bf16*)(F.ws + WS_PROJ); const float* kvc = (const float*)(F.ws + WS_KVCMP); float* ocmp = (float*)(F.ws + WS_OCMP); unsigned* selm = (unsigned*)(F.ws + WS_SELM);
    LAS float* qs = (LAS float*)(F.lds + F.wave * 2048);
    LAS float* ps = qs + 128;
    const float scale = 0.08838834764831845f;
    for (int it = F.gw; it < NT * 2; it += F.NGW) {
        const int m = it >> 1, g = it & 1, b = m >> 11, s = m & (NS - 1);
        const int nvalid = (s >= 31) ? ((s - 31) / 16 + 1) : 0;
        const float* kc = kvc + (size_t)((0 * 16 + b * 2 + g) * 128) * 128; const float* vc = kvc + (size_t)((1 * 16 + b * 2 + g) * 128) * 128;
        float psum0 = 0.f, psum1 = 0.f;
        for (int r = 0; r < 4; ++r) {
            const int h = g * 4 + r;
            qs[F.lane] = bf1(proj[(size_t)m * CD_INP + h * 128 + F.lane]); qs[64 + F.lane] = bf1(proj[(size_t)m * CD_INP + h * 128 + 64 + F.lane]);
            LDS_WAIT(); asm volatile("" ::: "memory");
            float s0 = 0.f, s1 = 0.f;
            if (nvalid > 0) {
                const float* k0 = kc + (size_t)F.lane * 128; const float* k1 = kc + (size_t)(64 + F.lane) * 128;
                for (int d = 0; d < 128; d += 4) { const f32x4 q4 = *(const LAS f32x4*)(qs + d); const f32x4 a = *(const f32x4*)(k0 + d), c = *(const f32x4*)(k1 + d);
                    s0 += q4[0] * a[0] + q4[1] * a[1] + q4[2] * a[2] + q4[3] * a[3]; s1 += q4[0] * c[0] + q4[1] * c[1] + q4[2] * c[2] + q4[3] * c[3]; }
            }
            const bool v0 = F.lane < nvalid, v1 = (64 + F.lane) < nvalid;
            s0 = v0 ? s0 * scale : -1e30f; s1 = v1 ? s1 * scale : -1e30f;
            const float mx = wave_max(fmaxf(s0, s1));
            float p0 = v0 ? __expf(s0 - mx) : 0.f, p1 = v1 ? __expf(s1 - mx) : 0.f;
            const float den = wave_sum(p0 + p1); const float inv = den > 0.f ? 1.f / den : 0.f;
            p0 *= inv; p1 *= inv; psum0 += p0; psum1 += p1;
            float o0 = 0.f, o1 = 0.f;
            for (int n = 0; n < nvalid; ++n) { const float pn = n < 64 ? __shfl(p0, n) : __shfl(p1, n - 64); const f32x2 vv = *(const f32x2*)(vc + (size_t)n * 128 + F.lane * 2); o0 += pn * vv[0]; o1 += pn * vv[1]; }
            const float gt = sigmoidf_(bf1(proj[(size_t)m * CD_INP + 2560 + h * 3 + 0]));
            *(f32x2*)(ocmp + (size_t)m * 1024 + h * 128 + F.lane * 2) = (f32x2){gt * o0, gt * o1};
            asm volatile("" ::: "memory");
        }
        ps[F.lane] = psum0; ps[64 + F.lane] = psum1;
        LDS_WAIT(); asm volatile("" ::: "memory");
        const int j = F.lane & 31, cur = s >> 6;
        float imp = 0.f;
#pragma unroll
        for (int k = 0; k < 4; ++k) { const int n1 = 4 * j + k; if (n1 <= 126) imp += ps[n1]; const int n2 = 4 * j - 1 + k; if (n2 >= 0 && n2 <= 126) imp += ps[n2]; }
        const bool forced = (j == 0) || (j == cur) || (j == cur - 1);
        float score = forced ? 1e4f : ((j * 64 <= s) ? imp : -1e30f);
        if (F.lane >= 32) score = -3e38f;
        int rk = 0;
        for (int jj = 0; jj < 32; ++jj) { const float ov = __shfl(score, jj); rk += ((ov > score) || (ov == score && jj < j)) ? 1 : 0; }
        const bool sel = (F.lane < 32) && (rk < 16) && (j <= cur);
        const unsigned long long bal = __ballot(sel);
        if (F.lane == 0) selm[m * 2 + g] = (unsigned)bal;
        asm volatile("" ::: "memory");
    }
}
template <bool HAS2>
__device__ __forceinline__ void attn_row(const LAS float* qs, const bf16* K1, size_t ks1, const bf16* K2, size_t ks2, const bf16* V, size_t vs,
                                         int c_lo, int c_hi, int k_lo, int k_hi, unsigned cmask, float scale, int lane, float& o0, float& o1) {
    float mrun = -1e30f, lrun = 0.f; o0 = 0.f; o1 = 0.f;
    for (int ch = c_lo; ch <= c_hi; ++ch) {
        if (!((cmask >> ch) & 1u)) continue;
        const int kpos = ch * 64 + lane; const bool valid = kpos >= k_lo && kpos <= k_hi;
        float sc = 0.f;
        { const bf16* kp = K1 + (size_t)kpos * ks1;
#pragma unroll 4
          for (int d = 0; d < 128; d += 8) { float kf[8]; unpack8(*(const v4u*)(kp + d), kf); const f32x4 qa = *(const LAS f32x4*)(qs + d), qb = *(const LAS f32x4*)(qs + d + 4);
              sc += qa[0] * kf[0] + qa[1] * kf[1] + qa[2] * kf[2] + qa[3] * kf[3] + qb[0] * kf[4] + qb[1] * kf[5] + qb[2] * kf[6] + qb[3] * kf[7]; } }
        if (HAS2) { const bf16* kp = K2 + (size_t)kpos * ks2;
#pragma unroll 4
          for (int d = 0; d < 64; d += 8) { float kf[8]; unpack8(*(const v4u*)(kp + d), kf); const f32x4 qa = *(const LAS f32x4*)(qs + 128 + d), qb = *(const LAS f32x4*)(qs + 128 + d + 4);
              sc += qa[0] * kf[0] + qa[1] * kf[1] + qa[2] * kf[2] + qa[3] * kf[3] + qb[0] * kf[4] + qb[1] * kf[5] + qb[2] * kf[6] + qb[3] * kf[7]; } }
        sc = valid ? sc * scale : -1e30f;
        const float mnew = fmaxf(mrun, wave_max(sc));
        const float alpha = __expf(mrun - mnew);
        const float p = valid ? __expf(sc - mnew) : 0.f;
        lrun = lrun * alpha + wave_sum(p); o0 *= alpha; o1 *= alpha; mrun = mnew;
        const bf16* vb = V + (size_t)(ch * 64) * vs + lane * 2;
        for (int j = 0; j < 64; ++j) { const float pj = __shfl(p, j); if (pj != 0.f) { const unsigned w = *(const unsigned*)(vb + (size_t)j * vs); o0 += pj * bflo(w); o1 += pj * bfhi(w); } }
    }
    const float inv = lrun > 0.f ? 1.f / lrun : 0.f; o0 *= inv; o1 *= inv;
}
__device__ __forceinline__ void p_attn_l1(Frame& F) {
    const bf16* proj = (const bf16*)(F.ws + WS_PROJ); bf16* mixin = (bf16*)(F.ws + WS_MIXIN); const float* ocmp = (const float*)(F.ws + WS_OCMP); const unsigned* selm = (const unsigned*)(F.ws + WS_SELM);
    const bf16* qmla = (const bf16*)(F.ws + WS_QMLA); const bf16* kvu = (const bf16*)(F.ws + WS_KVU); const bf16* krot = (const bf16*)(F.ws + WS_KROT);
    LAS float* qs = (LAS float*)(F.lds + F.wave * 2048);
    for (int it = F.gw; it < NT * 16; it += F.NGW) {
        const int m = it >> 4, hh = it & 15, b = m >> 11, s = m & (NS - 1);
        if (hh < 8) {
            const int h = hh, g = h >> 2;
            qs[F.lane] = bf1(proj[(size_t)m * CD_INP + h * 128 + F.lane]); qs[64 + F.lane] = bf1(proj[(size_t)m * CD_INP + h * 128 + 64 + F.lane]);
            LDS_WAIT(); asm volatile("" ::: "memory");
            const bf16* base = proj + (size_t)(b * NS) * CD_INP;
            float a0, a1, w0, w1;
            attn_row<false>(qs, base + 1024 + ((1 * 2 + 0) * 2 + g) * 128, CD_INP, nullptr, 0, base + 1024 + ((1 * 2 + 1) * 2 + g) * 128, CD_INP,
                            0, s >> 6, 0, s, selm[m * 2 + g], 0.08838834764831845f, F.lane, a0, a1);
            const int klo = s - 511 > 0 ? s - 511 : 0;
            attn_row<false>(qs, base + 1024 + ((2 * 2 + 0) * 2 + g) * 128, CD_INP, nullptr, 0, base + 1024 + ((2 * 2 + 1) * 2 + g) * 128, CD_INP,
                            klo >> 6, s >> 6, klo, s, 0xffffffffu, 0.08838834764831845f, F.lane, w0, w1);
            const float g1 = sigmoidf_(bf1(proj[(size_t)m * CD_INP + 2560 + h * 3 + 1])), g2 = sigmoidf_(bf1(proj[(size_t)m * CD_INP + 2560 + h * 3 + 2]));
            const f32x2 oc = *(const f32x2*)(ocmp + (size_t)m * 1024 + h * 128 + F.lane * 2);
            *(unsigned*)(mixin + (size_t)m * ND + h * 128 + F.lane * 2) = pk2(oc[0] + g1 * a0 + g2 * w0, oc[1] + g1 * a1 + g2 * w1);
        } else {
            const int h = hh - 8;
            const bf16* q = qmla + (size_t)m * 1536 + h * 192;
            qs[F.lane] = bf1(q[F.lane]); qs[64 + F.lane] = bf1(q[64 + F.lane]); qs[128 + F.lane] = bf1(q[128 + F.lane]);
            LDS_WAIT(); asm volatile("" ::: "memory");
            float a0, a1;
            attn_row<true>(qs, kvu + (size_t)(b * NS) * 2048 + h * 256, 2048, krot + (size_t)(b * NS) * 64, 64, kvu + (size_t)(b * NS) * 2048 + h * 256 + 128, 2048,
                           0, s >> 6, 0, s, 0xffffffffu, 0.07216878364870322f, F.lane, a0, a1);
            *(unsigned*)(mixin + (size_t)m * ND + 1024 + h * 128 + F.lane * 2) = pk2(a0, a1);
        }
        asm volatile("" ::: "memory");
    }
}

constexpr int NPHASE = 33;


#define IN(k) (lo <= (k) && (k) < hi)
#define SEAM(k) do { if (IN(k) && IN((k) + 1)) { if (MK_ONE_LAUNCH) xcd_barrier(bar); else if (F.tid == 0) __hip_atomic_store(F.ctl + CW_TMO, 0xBAD0u | (unsigned)(k), __ATOMIC_RELAXED, __HIP_MEMORY_SCOPE_AGENT); } } while (0)
template <int l>
__device__ __forceinline__ void layer_body(Frame& F, const XcdBarrier& bar, const int lo, const int hi) {
    unsigned char* ws = F.ws;
    bf16* const XB0 = (bf16*)(ws + WS_XB0); bf16* const X1B = (bf16*)(ws + WS_X1B); bf16* const X2B = (bf16*)(ws + WS_X2B);
    bf16* const PROJ = (bf16*)(ws + WS_PROJ); bf16* const MIXIN = (bf16*)(ws + WS_MIXIN); bf16* const MIXO = (bf16*)(ws + WS_MIXO);
    bf16* const HB = (bf16*)(ws + WS_H); bf16* const Y2 = (bf16*)(ws + WS_Y2);
        const int pb = 1 + l * 16;
        const bf16* xin = l == 0 ? XB0 : X2B;
        if (IN(pb + 0)) {
            p_moe_weights(F, l);
            __syncthreads();
            if (l == 0) { pg8::DenseProb P; P.init(xin, ND, (const bf16*)(ws + WS_WABIN), NT, AB_IN, ND, F.G, (int)blockIdx.x); pg8::EpiBf16 E{PROJ, AB_IN};
                pg8::gemm_phase<pg8::EpiBf16, pg8::DenseProb, true>(F.lds, P, E); }
            else { pg8::DenseProb P; P.init(xin, ND, (const bf16*)(ws + WS_WCDIN), NT, CD_INP, ND, F.G, (int)blockIdx.x); pg8::EpiBf16 E{PROJ, CD_INP};
                pg8::gemm_phase<pg8::EpiBf16, pg8::DenseProb, true>(F.lds, P, E); }
        } SEAM(pb + 0);
        if (l == 0) {
            if (IN(pb + 1)) { p_pool_rope(F); } SEAM(pb + 1);
            if (IN(pb + 2)) { p_retention(F); } SEAM(pb + 2);
            SEAM(pb + 3); SEAM(pb + 4); SEAM(pb + 5);
        } else {
            if (IN(pb + 1)) { p_l1_thin_a(F); } SEAM(pb + 1);
            if (IN(pb + 2)) {
                { pg8::CmpProb P; P.K = 4096; P.Abase = (const char*)(ws + WS_CMPKV); P.Bt = (const char*)(ws + WS_CW1); P.G = F.G; P.c = (int)blockIdx.x;
                  pg8::EpiF32 E{(float*)(ws + WS_HID), 256, (const float*)(ws + WS_CMPB)};
                  pg8::gemm_phase<pg8::EpiF32, pg8::CmpProb, true>(F.lds, P, E); }
                { pg8::DenseProb P; P.init((const bf16*)(ws + WS_CQN), 384, (const bf16*)(ws + WS_WUQ), NT, 1536, 384, F.G, (int)blockIdx.x); pg8::EpiBf16 E{(bf16*)(ws + WS_QMLA), 1536};
                  pg8::gemm_phase<pg8::EpiBf16, pg8::DenseProb, true>(F.lds, P, E); }
                { pg8::DenseProb P; P.init((const bf16*)(ws + WS_CKVN), 512, (const bf16*)(ws + WS_WUKV), NT, 2048, 512, F.G, (int)blockIdx.x); pg8::EpiBf16 E{(bf16*)(ws + WS_KVU), 2048};
                  pg8::gemm_phase<pg8::EpiBf16, pg8::DenseProb, true>(F.lds, P, E); }
            } SEAM(pb + 2);
            if (IN(pb + 3)) { p_l1_thin_b(F); } SEAM(pb + 3);
            if (IN(pb + 4)) { p_nsa_cmp(F); } SEAM(pb + 4);
            if (IN(pb + 5)) { p_attn_l1(F); } SEAM(pb + 5);
        }
        if (IN(pb + 6)) { pg8::DenseProb P; P.init(MIXIN, ND, (const bf16*)(ws + (l == 0 ? WS_WABOUT : WS_WCDOUT)), NT, ND, ND, F.G, (int)blockIdx.x); pg8::EpiBf16 E{MIXO, ND};
            pg8::gemm_phase<pg8::EpiBf16, pg8::DenseProb, true>(F.lds, P, E); } SEAM(pb + 6);
        if (IN(pb + 7)) { p_ln1(F, xin, MIXO, kin(15) + l * ND, kin(16) + l * ND, X1B); } SEAM(pb + 7);
        if (IN(pb + 8)) { pg8::DenseProb P; P.init(X1B, ND, (const bf16*)(ws + WS_RT), NT, 256, ND, F.G, (int)blockIdx.x); pg8::EpiF32 E{(float*)(ws + WS_LOGITS), 256, nullptr};
            pg8::gemm_phase<pg8::EpiF32, pg8::DenseProb, true>(F.lds, P, E); } SEAM(pb + 8);
        if (IN(pb + 9)) { p_route(F, l); } SEAM(pb + 9);
        if (IN(pb + 10)) { p_scatter(F, l); } SEAM(pb + 10);
        if (IN(pb + 11)) { load_offsets(F, l); const LAS int* tab = (const LAS int*)(F.lds + TAB_OFF);
            pg8::MoeUpProb P; P.K = ND; P.Abase = (const char*)X1B; P.W13 = (const char*)(ws + WS_W13); P.sorted = (const int*)(ws + WS_SORTED); P.tile_e = tab + 160; P.ntiles = __builtin_amdgcn_readfirstlane(tab[65]);
            P.nunits = (P.ntiles + NT / 256) * 4; P.G = F.G; P.c = (int)blockIdx.x;
            pg8::EpiSwiglu E{HB};
            pg8::gemm_phase<pg8::EpiSwiglu, pg8::MoeUpProb, true>(F.lds, P, E); } SEAM(pb + 11);
        if (IN(pb + 12)) { load_offsets(F, l); const LAS int* tab = (const LAS int*)(F.lds + TAB_OFF);
            pg8::MoeDownProb P; P.K = EFF; P.Abase = (const char*)HB; P.W2 = (const char*)(ws + WS_W2); P.tile_e = tab + 160; P.ntiles = __builtin_amdgcn_readfirstlane(tab[65]);
            P.nunits = (P.ntiles + NT / 256) * 8; P.G = F.G; P.c = (int)blockIdx.x;
            pg8::EpiBf16 E{Y2, ND};
            pg8::gemm_phase<pg8::EpiBf16, pg8::MoeDownProb, true>(F.lds, P, E); } SEAM(pb + 12);
        if (IN(pb + 13)) { p_combine_ln2(F, X1B, Y2, (const int*)(ws + WS_SLOT), (const float*)(ws + WS_WSEL), kin(17) + l * ND, kin(18) + l * ND, l == 0 ? X2B : nullptr, l == 0 ? nullptr : F.out); } SEAM(pb + 13);
        SEAM(pb + 14); SEAM(pb + 15);
    }
__global__ void __launch_bounds__(NWAVES * 64, 2) mk_fwd(Args args) {
    extern __shared__ __attribute__((aligned(16))) unsigned char lds[];
    Frame F;
    F.lds = (LAS unsigned char*)lds;
    F.MISC = (volatile LAS unsigned*)(F.lds + MISC_OFF);
    F.tid = threadIdx.x; F.lane = F.tid & 63; F.wave = __builtin_amdgcn_readfirstlane(F.tid >> 6);
    F.G = gridDim.x; { const int bx = blockIdx.x; F.vcu = (F.G % 8 == 0) ? (bx % 8) * (F.G / 8) + bx / 8 : bx; }
    F.gw = F.vcu * NWAVES + F.wave; F.NGW = F.G * NWAVES;
    F.ws = args.ws; F.ctl = (unsigned*)(args.ws + WS_CTL); F.out = args.out;
    for (int u = F.tid; u < (LDS_BYTES - LDSCTL_OFF) / 4; u += NWAVES * 64) ((LAS unsigned*)(F.lds + LDSCTL_OFF))[u] = 0u;
    __syncthreads();
    XcdBarrier bar; bar.bar = F.ctl + CW_BAR; bar.x = 0; bar.st = nullptr;
    if (MK_ONE_LAUNCH) bar = xcd_barrier_post(F.ctl + CW_BAR, F.MISC + 8);
    const int lo = args.ph_lo, hi = args.ph_hi;
    unsigned char* ws = args.ws;
    bf16* const XB0 = (bf16*)(ws + WS_XB0); bf16* const X1B = (bf16*)(ws + WS_X1B); bf16* const X2B = (bf16*)(ws + WS_X2B);
    bf16* const PROJ = (bf16*)(ws + WS_PROJ); bf16* const MIXIN = (bf16*)(ws + WS_MIXIN); bf16* const MIXO = (bf16*)(ws + WS_MIXO);
    bf16* const HB = (bf16*)(ws + WS_H); bf16* const Y2 = (bf16*)(ws + WS_Y2);

    if (IN(0)) { p_prologue(F); } SEAM(0);

    layer_body<0>(F, bar, lo, hi);
    layer_body<1>(F, bar, lo, hi);
#undef IN
#undef SEAM
}

extern "C" void kernel_launch(void* const* d_in, const int* in_sizes, int n_in, void* d_out, int out_size, void* d_ws, size_t ws_size, hipStream_t stream) {
    static int grid = 0;
    if (grid == 0) {
        if (n_in != 27 || in_sizes[0] != NT * ND || out_size != NT * ND || ws_size < WS_END) { fprintf(stderr, "kernel_launch: unexpected problem (n_in %d, in0 %d, out %d, ws %zu < %zu); nothing launched\n", n_in, n_in > 0 ? in_sizes[0] : -1, out_size, ws_size, (size_t)WS_END); grid = -1; return; }
        int dev = 0, cus = 0, per_cu = 0;
        if (hipGetDevice(&dev) != hipSuccess || hipDeviceGetAttribute(&cus, hipDeviceAttributeMultiprocessorCount, dev) != hipSuccess) { fprintf(stderr, "kernel_launch: device query failed\n"); grid = -1; return; }
        if (hipFuncSetAttribute((const void*)mk_fwd, hipFuncAttributeMaxDynamicSharedMemorySize, LDS_BYTES) != hipSuccess) { fprintf(stderr, "kernel_launch: hipFuncSetAttribute failed\n"); grid = -1; return; }
        if (hipOccupancyMaxActiveBlocksPerMultiprocessor(&per_cu, (const void*)mk_fwd, NWAVES * 64, LDS_BYTES) != hipSuccess || per_cu < 1) fprintf(stderr, "kernel_launch: note: occupancy query reports %d\n", per_cu);
        (void)hipGetLastError();
        grid = cus;
    }
    if (grid < 0) return;
    if (hipMemsetAsync((char*)d_ws + WS_CTL, 0, CTL_ZERO_BYTES, stream) != hipSuccess) { fprintf(stderr, "kernel_launch: memset failed\n"); return; }
    Args a{};
    for (int i = 0; i < 27; ++i) a.in[i] = (const float*)d_in[i];
    a.out = (float*)d_out; a.ws = (unsigned char*)d_ws;
#if MK_ONE_LAUNCH
    a.ph_lo = 0; a.ph_hi = NPHASE;
    hipLaunchKernelGGL(mk_fwd, dim3(grid), dim3(NWAVES * 64), LDS_BYTES, stream, a);
#else
    for (int p = 0; p < NPHASE; ++p) {
        const int lp = (p - 1) & 15;
        if (p >= 1) { const int l = (p - 1) >> 4; if (lp >= 14) continue; if (l == 0 && lp >= 3 && lp <= 5) continue; }
        a.ph_lo = p; a.ph_hi = p + 1;
        hipLaunchKernelGGL(mk_fwd, dim3(grid), dim3(NWAVES * 64), LDS_BYTES, stream, a);
    }
#endif
    const hipError_t le = hipPeekAtLastError();
    if (le != hipSuccess) fprintf(stderr, "kernel_launch: launch failed: %s\n", hipGetErrorName(le));
}
```

```cpp
#include <hip/hip_runtime.h>
#include <cstdio>
#include <cstdint>

#ifndef MK_ONE_LAUNCH
#define MK_ONE_LAUNCH 1
#endif

#define GAS __attribute__((address_space(1)))
#define LAS __attribute__((address_space(3)))
typedef unsigned short bf16;
typedef unsigned v4u __attribute__((ext_vector_type(4)));
typedef unsigned v2u __attribute__((ext_vector_type(2)));
typedef float f32x4 __attribute__((ext_vector_type(4)));
typedef float f32x2 __attribute__((ext_vector_type(2)));
typedef short bf16x8 __attribute__((ext_vector_type(8)));

constexpr int NB = 8, NS = 2048, ND = 2048, NT = NB * NS;
constexpr float DN_ALPHA = 1.41421356237309505f;
constexpr float LN_EPS = 1e-5f, NORM_EPS = 1e-6f;
constexpr int AB_IN = 5120, CD_IN = 3544, CD_INP = 3584;
constexpr int NEXP = 64, EFF = 512;
constexpr int MAXROWS = NT * 8 + NEXP * 256;
constexpr int MAXTILES = MAXROWS / 256;
constexpr int SH_ROW0 = MAXROWS;

constexpr size_t MiB = 1u << 20;
constexpr size_t WS_CTL = 0, CTL_ZERO_BYTES = 1 * MiB;
constexpr size_t WS_TOPE = 1 * MiB, WS_WSEL = WS_TOPE + 512 * 1024, WS_SLOT = 2 * MiB, WS_SORTED = WS_SLOT + 512 * 1024;
constexpr size_t WS_CMPB = 3 * MiB + 256 * 1024, WS_SELM = 3 * MiB + 512 * 1024;
constexpr size_t WS_KVCMP = 4 * MiB;
constexpr size_t WS_HID = 6 * MiB;
constexpr size_t WS_WABIN = 16 * MiB, WS_WABOUT = 36 * MiB, WS_WCDIN = 44 * MiB, WS_WCDOUT = 58 * MiB, WS_WUQ = 66 * MiB, WS_WUKV = 68 * MiB, WS_CW1 = 70 * MiB, WS_RT = 72 * MiB;
constexpr size_t WS_W13 = 74 * MiB, WS_W2 = 334 * MiB;
constexpr size_t WS_XB0 = 464 * MiB, WS_X1B = 528 * MiB, WS_X2B = 592 * MiB, WS_PROJ = 656 * MiB, WS_MIXIN = 816 * MiB, WS_MIXO = 880 * MiB;
constexpr size_t WS_H = 944 * MiB, WS_Y2 = 1104 * MiB, WS_END = 1744 * MiB;
constexpr size_t WS_QR = 944 * MiB, WS_KR = 968 * MiB;
constexpr size_t WS_CQN = 944 * MiB, WS_CKVN = 956 * MiB, WS_KROT = 972 * MiB, WS_QMLA = 976 * MiB, WS_KVU = 1024 * MiB, WS_CMPKV = 1088 * MiB, WS_OCMP = 1108 * MiB;
constexpr size_t WS_LOGITS = 1104 * MiB;
constexpr int CW_TMO = 0, CW_CODE = 1, CW_BAR = 4096, CW_CNT = 16384;

constexpr int RING_BYTES = 131072, LDSCTL_OFF = RING_BYTES, MISC_OFF = LDSCTL_OFF + 320, TAB_OFF = LDSCTL_OFF + 512;
constexpr int LDS_BYTES = 147456;
constexpr int NWAVES = 8;

#define LDS_WAIT() asm volatile("s_waitcnt lgkmcnt(0)" ::: "memory")
#define VM_WAIT() asm volatile("s_waitcnt vmcnt(0)" ::: "memory")
__device__ __forceinline__ unsigned f2bf(float f) { unsigned u = __builtin_bit_cast(unsigned, f); return (u + 0x7fffu + ((u >> 16) & 1u)) >> 16; }
__device__ __forceinline__ unsigned pk2(float lo, float hi) { return f2bf(lo) | (f2bf(hi) << 16); }
__device__ __forceinline__ float bflo(unsigned w) { return __builtin_bit_cast(float, w << 16); }
__device__ __forceinline__ float bfhi(unsigned w) { return __builtin_bit_cast(float, w & 0xffff0000u); }
__device__ __forceinline__ float bf1(bf16 v) { return __builtin_bit_cast(float, ((unsigned)v) << 16); }
__device__ __forceinline__ float wave_sum(float v) {
#pragma unroll
    for (int o = 1; o < 64; o <<= 1) v += __shfl_xor(v, o);
    return v;
}
__device__ __forceinline__ float wave_max(float v) {
#pragma unroll
    for (int o = 1; o < 64; o <<= 1) v = fmaxf(v, __shfl_xor(v, o));
    return v;
}
__device__ __forceinline__ float sigmoidf_(float x) { return 1.0f / (1.0f + __expf(-x)); }
__device__ __forceinline__ float siluf_(float x) { return x / (1.0f + __expf(-x)); }
__device__ __forceinline__ void unpack8(const v4u w, float (&f)[8]) {
    f[0] = bflo(w.x); f[1] = bfhi(w.x); f[2] = bflo(w.y); f[3] = bfhi(w.y); f[4] = bflo(w.z); f[5] = bfhi(w.z); f[6] = bflo(w.w); f[7] = bfhi(w.w);
}

#define XB_TMO      128
#define XB_XCNT(j)  (256  + 64 * (j))
#define XB_XSUB(j)  (1280 + 64 * (j))
#define XB_XGEN(j)  (2304 + 64 * (j))
#define XB_TOP      3328
#define XB_TOPGEN   3392
#define XCD_BAR_WORDS 3456
#define XB_SPIN_CAP (1u << 18)
__device__ __forceinline__ unsigned xb_ld(unsigned* p)              { return __hip_atomic_load(p, __ATOMIC_RELAXED, __HIP_MEMORY_SCOPE_AGENT); }
__device__ __forceinline__ unsigned xb_add(unsigned* p, unsigned v) { return __hip_atomic_fetch_add(p, v, __ATOMIC_RELAXED, __HIP_MEMORY_SCOPE_AGENT); }
__device__ __forceinline__ unsigned xb_xcc_id() { return (unsigned)__builtin_amdgcn_s_getreg((3 << 11) | 20) & 0xFu; }
#define XB_SPIN(cond, bar) do { unsigned _sp = 0; while (cond) { __builtin_amdgcn_s_sleep(1); \
    if ((++_sp & 255u) == 0u) { if (xb_ld(&(bar)[XB_TMO])) break; if (_sp > XB_SPIN_CAP) { atomicAdd(&(bar)[XB_TMO], 1u); break; } } } } while (0)
struct XcdBarrier { unsigned* bar; unsigned x; volatile LAS unsigned* st; };
__device__ __forceinline__ XcdBarrier xcd_barrier_post(unsigned* bar, volatile LAS unsigned* st) {
    XcdBarrier b; b.bar = bar; b.x = xb_xcc_id(); b.st = st;
    if (threadIdx.x == 0) (void)xb_add(&bar[XB_XCNT(b.x)], 1u);
    return b;
}
__device__ __forceinline__ void xcd_barrier_complete(unsigned* bar, unsigned x, unsigned& nloc, unsigned& nx) {
    const unsigned G = gridDim.x * gridDim.y * gridDim.z;
    unsigned sum, cnt, mine, sp = 0u;
    for (;;) {
        sum = 0u; cnt = 0u; mine = 0u;
#pragma unroll
        for (unsigned j = 0; j < 16; ++j) { const unsigned c = xb_ld(&bar[XB_XCNT(j)]); sum += c; cnt += (c > 0u) ? 1u : 0u; mine = (j == x) ? c : mine; }
        if (sum == G) break;
        __builtin_amdgcn_s_sleep(1);
        if ((++sp & 255u) == 0u) { if (xb_ld(&bar[XB_TMO])) break; if (sp > XB_SPIN_CAP) { atomicAdd(&bar[XB_TMO], 1u); break; } }
    }
    nloc = mine > 0u ? mine : 1u; nx = cnt > 0u ? cnt : 1u;
}
__device__ __forceinline__ void xcd_barrier(const XcdBarrier& b) {
    asm volatile("s_waitcnt vmcnt(0)" ::: "memory");
    __syncthreads();
    if (threadIdx.x == 0) {
        unsigned* bar = b.bar;
        __builtin_amdgcn_s_waitcnt(0);
        unsigned nloc = b.st[0], nx = b.st[1];
        if (nloc == 0u) { xcd_barrier_complete(bar, b.x, nloc, nx); b.st[0] = nloc; b.st[1] = nx; }
        const unsigned old = xb_add(&bar[XB_XSUB(b.x)], 1u);
        const unsigned gen = old / nloc;
        if (old + 1u == (gen + 1u) * nloc) {
            __builtin_amdgcn_fence(__ATOMIC_RELEASE, "agent");
            asm volatile("s_waitcnt vmcnt(0)" ::: "memory");
            const unsigned og = xb_add(&bar[XB_TOP], 1u);
            const unsigned tg = og / nx;
            if (og + 1u == (tg + 1u) * nx) xb_add(&bar[XB_TOPGEN], 1u);
            else XB_SPIN(xb_ld(&bar[XB_TOPGEN]) == tg, bar);
            __builtin_amdgcn_fence(__ATOMIC_ACQUIRE, "agent");
            xb_add(&bar[XB_XGEN(b.x)], 1u);
            asm volatile("s_waitcnt vmcnt(0)" ::: "memory");
        } else {
            XB_SPIN(xb_ld(&bar[XB_XGEN(b.x)]) == gen, bar);
            __builtin_amdgcn_fence(__ATOMIC_ACQUIRE, "agent");
            asm volatile("s_waitcnt vmcnt(0)" ::: "memory");
        }
    }
    __syncthreads();
}

namespace pg8 {
constexpr int BM = 256, BK = 64, HALF = 128, HTB = HALF * BK * 2, STAGE_BYTES = 8 * HTB, NXCD = 8, WGM = 8;
__host__ __device__ __forceinline__ int lds_byte(int r, int c) { const int st = (r >> 4) * 2 + (c >> 5), rr = r & 15, cc = c & 31, ob = rr * 64 + cc * 2; return st * 1024 + (ob ^ (((ob >> 9) & 1) << 5)); }
__host__ __device__ __forceinline__ void stage_rc(int b, int& R, int& C) { const int st = b / 1024, sb = b % 1024, swz = sb ^ (((sb >> 9) & 1) << 5); R = (st >> 1) * 16 + swz / 64; C = (st & 1) * 32 + (swz % 64) / 2; }
__host__ __device__ __forceinline__ int perm32(int rho) { const int n = rho >> 4, i = rho & 15; return 8 * (i >> 2) + 4 * n + (i & 3); }
struct Unit { int pm, pn, e; };

__device__ __forceinline__ unsigned cvt_pk_bf16(float lo, float hi) { unsigned r; asm volatile("v_cvt_pk_bf16_f32 %0, %1, %2" : "=v"(r) : "v"(lo), "v"(hi)); return r; }

struct EpiBf16 {
    static constexpr bool PERM = true;
    bf16* O; int ldc;
    __device__ __forceinline__ void operator()(const f32x4 (&acc)[2][2][4][2], const Unit& u, int wr, int wc, int fr, int fq) const {
        const int row0 = u.pm * BM + wr * 64 + fr, col0 = u.pn * BM + wc * 32 + 8 * fq;
#pragma unroll
        for (int ai = 0; ai < 2; ++ai)
#pragma unroll
            for (int m = 0; m < 4; ++m) { bf16* rowp = O + (size_t)(row0 + ai * HALF + m * 16) * ldc + col0;
#pragma unroll
                for (int bj = 0; bj < 2; ++bj) { const f32x4 v0 = acc[ai][bj][m][0], v1 = acc[ai][bj][m][1];
                    v4u w; w.x = cvt_pk_bf16(v0[0], v0[1]); w.y = cvt_pk_bf16(v0[2], v0[3]); w.z = cvt_pk_bf16(v1[0], v1[1]); w.w = cvt_pk_bf16(v1[2], v1[3]);
                    *(v4u*)(rowp + bj * HALF) = w; } }
    }
};
struct EpiF32 {
    static constexpr bool PERM = false;
    float* C; int ldc; const float* bias;
    __device__ __forceinline__ void operator()(const f32x4 (&acc)[2][2][4][2], const Unit& u, int wr, int wc, int fr, int fq) const {
        const int row0 = u.pm * BM + wr * 64 + fr, col0 = u.pn * BM + wc * 32 + 4 * fq;
        f32x4 bv[2][2];
#pragma unroll
        for (int bj = 0; bj < 2; ++bj)
#pragma unroll
            for (int n = 0; n < 2; ++n) bv[bj][n] = bias ? *(const f32x4*)(bias + col0 + bj * HALF + n * 16) : (f32x4){0.f, 0.f, 0.f, 0.f};
#pragma unroll
        for (int ai = 0; ai < 2; ++ai)
#pragma unroll
            for (int m = 0; m < 4; ++m) { float* rowp = C + (size_t)(row0 + ai * HALF + m * 16) * ldc + col0;
#pragma unroll
                for (int bj = 0; bj < 2; ++bj)
#pragma unroll
                    for (int n = 0; n < 2; ++n) *(f32x4*)(rowp + bj * HALF + n * 16) = acc[ai][bj][m][n] + bv[bj][n]; }
    }
};
struct EpiSwiglu {
    static constexpr bool PERM = true;
    bf16* H;
    __device__ __forceinline__ void operator()(const f32x4 (&acc)[2][2][4][2], const Unit& u, int wr, int wc, int fr, int fq) const {
        const int row0 = u.pm * BM + wr * 64 + fr, col0 = u.pn * HALF + wc * 32 + 8 * fq;
#pragma unroll
        for (int ai = 0; ai < 2; ++ai)
#pragma unroll
            for (int m = 0; m < 4; ++m) { bf16* rowp = H + (size_t)(row0 + ai * HALF + m * 16) * EFF + col0;
                float o[8];
#pragma unroll
                for (int n = 0; n < 2; ++n)
#pragma unroll
                    for (int j = 0; j < 4; ++j) { const float h1 = acc[ai][0][m][n][j], h3 = acc[ai][1][m][n][j]; o[n * 4 + j] = siluf_(h1) * h3; }
                v4u w; w.x = cvt_pk_bf16(o[0], o[1]); w.y = cvt_pk_bf16(o[2], o[3]); w.z = cvt_pk_bf16(o[4], o[5]); w.w = cvt_pk_bf16(o[6], o[7]);
                *(v4u*)rowp = w; }
    }
};

template <class Epi, class Prob, bool ALIGN_EPI>
__device__ __forceinline__ void gemm_phase(LAS unsigned char* lds, const Prob& P, const Epi& E) {
    const int tid = threadIdx.x, wid = __builtin_amdgcn_readfirstlane(tid >> 6), lane = tid & 63, wr = wid >> 2, wc = wid & 3, fr = lane & 15, fq = lane >> 4;
    const int K = P.K, nt = K / BK;
    int RA[2], CA[2]; unsigned voffB[2];
#pragma unroll
    for (int i = 0; i < 2; ++i) { int R, C; stage_rc(tid * 16 + i * 8192, R, C); const int Rb = Epi::PERM ? ((R & ~31) + perm32(R & 31)) : R;
        RA[i] = R; CA[i] = C; voffB[i] = (unsigned)(Rb * K + C) * 2u; }
    const size_t kstep = (size_t)(BK * 2);
    const size_t hstep = (size_t)HALF * K * 2;
    const unsigned ldsw = (unsigned)wid * 1024u;
    const int aoff = lds_byte(wr * 64 + fr, fq * 8), boff = lds_byte(wc * 32 + fr, fq * 8);
    const char* const Ab = P.Abase;
#define PG8_SA(b, h) (((b) * 2 + (h)) * HTB)
#define PG8_SB(b, h) ((4 + (b) * 2 + (h)) * HTB)
#define PG8_STAGE(bufoff, gbase, voff) do { _Pragma("unroll") for (int _i = 0; _i < 2; ++_i) \
        __builtin_amdgcn_global_load_lds((const unsigned*)((const char*)(gbase) + (voff)[_i]), (LAS unsigned*)(lds + (bufoff) + ldsw + _i * 8192), 16, 0, 0); } while (0)
#define PG8_STAGE_A(bufoff, kb, o0, o1) do { \
        __builtin_amdgcn_global_load_lds((const unsigned*)(Ab + (kb) + (o0)), (LAS unsigned*)(lds + (bufoff) + ldsw), 16, 0, 0); \
        __builtin_amdgcn_global_load_lds((const unsigned*)(Ab + (kb) + (o1)), (LAS unsigned*)(lds + (bufoff) + ldsw + 8192), 16, 0, 0); } while (0)
#define PG8_LDA(dst, b, h) do { _Pragma("unroll") for (int m = 0; m < 4; ++m) _Pragma("unroll") for (int k = 0; k < 2; ++k) dst[m][k] = *(const LAS bf16x8*)(lds + PG8_SA(b, h) + aoff + m * 2048 + k * 1024); } while (0)
#define PG8_LDB(dst, b, h) do { _Pragma("unroll") for (int n = 0; n < 2; ++n) _Pragma("unroll") for (int k = 0; k < 2; ++k) dst[n][k] = *(const LAS bf16x8*)(lds + PG8_SB(b, h) + boff + n * 2048 + k * 1024); } while (0)
#define PG8_MMA(ai, bj, At, Bt) do { __builtin_amdgcn_s_setprio(1); _Pragma("unroll") for (int m = 0; m < 4; ++m) _Pragma("unroll") for (int n = 0; n < 2; ++n) _Pragma("unroll") for (int k = 0; k < 2; ++k) \
        acc[ai][bj][m][n] = __builtin_amdgcn_mfma_f32_16x16x32_bf16(Bt[n][k], At[m][k], acc[ai][bj][m][n], 0, 0, 0); __builtin_amdgcn_s_setprio(0); } while (0)
#define PG8_WAIT_V(n) asm volatile("s_waitcnt vmcnt(" #n ")" ::: "memory")
#define PG8_WAIT_L(n) asm volatile("s_waitcnt lgkmcnt(" #n ")" ::: "memory")
#define PG8_BAR __builtin_amdgcn_s_barrier()
#define PG8_SCHED __builtin_amdgcn_sched_barrier(0)
    Unit cur, nxt; int ui = 0;
    if (!P.next(0, cur)) return;
    f32x4 acc[2][2][4][2];
#pragma unroll
    for (int a = 0; a < 2; ++a)
#pragma unroll
        for (int b = 0; b < 2; ++b)
#pragma unroll
            for (int m = 0; m < 4; ++m)
#pragma unroll
                for (int n = 0; n < 2; ++n) acc[a][b][m][n] = (f32x4){0.f, 0.f, 0.f, 0.f};
    bf16x8 At[4][2], B0[2][2], B1[2][2];
    unsigned oc[4], on[4];
    P.aoffs(cur, RA, CA, oc);
    const char* cB = P.bbase(cur);
    PG8_STAGE(PG8_SB(0, 0), cB, voffB); PG8_STAGE(PG8_SB(0, 1), cB + hstep, voffB); PG8_STAGE_A(PG8_SA(0, 0), (size_t)0, oc[0], oc[1]); PG8_STAGE_A(PG8_SA(0, 1), (size_t)0, oc[2], oc[3]);
    if (wr == 1) PG8_BAR;
    PG8_WAIT_V(2); PG8_BAR;
    PG8_STAGE(PG8_SB(1, 0), cB + kstep, voffB); PG8_STAGE_A(PG8_SA(1, 0), kstep, oc[0], oc[1]); PG8_STAGE(PG8_SB(1, 1), cB + hstep + kstep, voffB);
    PG8_WAIT_V(6); PG8_BAR;
    for (;;) {
        const bool has_next = P.next(ui + 1, nxt);
        const char* nB = cB;
        if (has_next) { P.aoffs(nxt, RA, CA, on); nB = P.bbase(nxt); }
        else { on[0] = oc[0]; on[1] = oc[1]; on[2] = oc[2]; on[3] = oc[3]; }
        for (int t = 0; t < nt; t += 2) {
            const bool last = (t == nt - 2);
            const size_t kb1 = (size_t)(t + 1) * kstep;
            const size_t kb2 = last ? (size_t)0 : (size_t)(t + 2) * kstep, kb3 = kb2 + kstep;
            const char* b2 = last ? nB : cB + (size_t)(t + 2) * kstep; const char* b3 = b2 + kstep;
            const unsigned o20 = last ? on[0] : oc[0], o21 = last ? on[1] : oc[1], o22 = last ? on[2] : oc[2], o23 = last ? on[3] : oc[3];
            PG8_LDB(B0, 0, 0); PG8_LDB(B1, 0, 1); PG8_SCHED; PG8_LDA(At, 0, 0); PG8_STAGE_A(PG8_SA(1, 1), kb1, oc[2], oc[3]);
            PG8_WAIT_V(8); PG8_WAIT_L(0); PG8_BAR; PG8_MMA(0, 0, At, B0); PG8_MMA(0, 1, At, B1); PG8_BAR; PG8_SCHED;
            PG8_LDA(At, 0, 1); PG8_STAGE(PG8_SB(0, 0), b2, voffB); PG8_STAGE(PG8_SB(0, 1), b2 + hstep, voffB); PG8_STAGE_A(PG8_SA(0, 0), kb2, o20, o21);
            PG8_WAIT_V(8); PG8_WAIT_L(0); PG8_BAR; PG8_MMA(1, 0, At, B0); PG8_MMA(1, 1, At, B1); PG8_BAR; PG8_SCHED;
            PG8_LDB(B0, 1, 0); PG8_LDB(B1, 1, 1); PG8_SCHED; PG8_LDA(At, 1, 0); PG8_STAGE_A(PG8_SA(0, 1), kb2, o22, o23);
            PG8_WAIT_V(8); PG8_WAIT_L(0); PG8_BAR; PG8_MMA(0, 0, At, B0); PG8_MMA(0, 1, At, B1); PG8_BAR; PG8_SCHED;
            PG8_LDA(At, 1, 1); PG8_STAGE(PG8_SB(1, 0), b3, voffB); PG8_STAGE(PG8_SB(1, 1), b3 + hstep, voffB); PG8_STAGE_A(PG8_SA(1, 0), kb3, o20, o21);
            PG8_WAIT_V(8); PG8_WAIT_L(0); PG8_BAR; PG8_MMA(1, 0, At, B0); PG8_MMA(1, 1, At, B1); PG8_BAR; PG8_SCHED;
        }
        if constexpr (ALIGN_EPI) { if (wr == 0) PG8_BAR; }
        E(acc, cur, wr, wc, fr, fq);
        if (!has_next) break;
#pragma unroll
        for (int a = 0; a < 2; ++a)
#pragma unroll
            for (int b = 0; b < 2; ++b)
#pragma unroll
                for (int m = 0; m < 4; ++m)
#pragma unroll
                    for (int n = 0; n < 2; ++n) acc[a][b][m][n] = (f32x4){0.f, 0.f, 0.f, 0.f};
        cur = nxt; cB = nB; oc[0] = on[0]; oc[1] = on[1]; oc[2] = on[2]; oc[3] = on[3]; ++ui;
        if constexpr (ALIGN_EPI) { if (wr == 1) PG8_BAR; }
    }
    PG8_WAIT_V(0);
    if constexpr (!ALIGN_EPI) { if (wr == 0) PG8_BAR; }
    PG8_BAR;
#undef PG8_SA
#undef PG8_SB
#undef PG8_STAGE
#undef PG8_STAGE_A
#undef PG8_LDA
#undef PG8_LDB
#undef PG8_MMA
#undef PG8_WAIT_V
#undef PG8_WAIT_L
#undef PG8_BAR
#undef PG8_SCHED
}

struct DenseProb {
    int K; const char* Abase; const char* Bt; int lda; int nM, nN, nwg, G, c;
    __device__ __forceinline__ void init(const bf16* A, int lda_, const bf16* B, int M, int N, int K_, int G_, int c_) { Abase = (const char*)A; Bt = (const char*)B; lda = lda_; K = K_; nM = M / BM; nN = N / BM; nwg = nM * nN; G = G_; c = c_; }
    __device__ __forceinline__ bool next(int i, Unit& u) const {
        const long L = (long)i * G + c; if (L >= nwg) return false;
        int wgid = (int)L; { const int q = nwg / NXCD, r = nwg % NXCD, xcd = wgid % NXCD, off = wgid / NXCD; wgid = (xcd < r ? xcd * (q + 1) : r * (q + 1) + (xcd - r) * q) + off; }
        const int nig = WGM * nN, gid = wgid / nig, fm = gid * WGM, gsz = (nM - fm) < WGM ? (nM - fm) : WGM;
        u.pm = fm + ((wgid % nig) % gsz); u.pn = (wgid % nig) / gsz; u.e = 0; return true;
    }
    __device__ __forceinline__ const char* bbase(const Unit& u) const { return Bt + (size_t)u.pn * BM * K * 2; }
    __device__ __forceinline__ void aoffs(const Unit& u, const int (&R)[2], const int (&C)[2], unsigned (&o)[4]) const {
#pragma unroll
        for (int h = 0; h < 2; ++h)
#pragma unroll
            for (int i = 0; i < 2; ++i) o[2 * h + i] = (unsigned)(((size_t)(u.pm * BM + h * HALF + R[i]) * lda + C[i]) * 2);
    }
};
__device__ __forceinline__ bool xcd_range_unit(int i, int nunits, int G, int c, int& L) {
    const int x = c % NXCD, cc = c / NXCD, per = G / NXCD, q = nunits / NXCD, r = nunits % NXCD;
    const int start = x * q + (x < r ? x : r), cnt = q + (x < r ? 1 : 0), li = i * per + cc;
    if (li >= cnt) return false; L = start + li; return true;
}
struct MoeUpProb {
    int K; const char* Abase; const char* W13; const int* sorted; const LAS int* tile_e; int ntiles, nunits, G, c;
    __device__ __forceinline__ bool next(int i, Unit& u) const {
        int L; if (!xcd_range_unit(i, nunits, G, c, L)) return false;
        const int tile = L >> 2; u.pn = L & 3;
        if (tile < ntiles) { u.pm = tile; u.e = __builtin_amdgcn_readfirstlane(tile_e[tile]); } else { u.pm = MAXTILES + (tile - ntiles); u.e = NEXP; }
        return true;
    }
    __device__ __forceinline__ const char* bbase(const Unit& u) const { return W13 + ((size_t)u.e * 1024 + (size_t)u.pn * BM) * 2048 * 2; }
    __device__ __forceinline__ void aoffs(const Unit& u, const int (&R)[2], const int (&C)[2], unsigned (&o)[4]) const {
#pragma unroll
        for (int h = 0; h < 2; ++h)
#pragma unroll
            for (int i = 0; i < 2; ++i) { int row;
                if (u.e == NEXP) row = (u.pm - MAXTILES) * BM + h * HALF + R[i];
                else row = sorted[u.pm * BM + h * HALF + R[i]];
                o[2 * h + i] = (unsigned)(((size_t)row * 2048 + C[i]) * 2); }
    }
};
struct MoeDownProb {
    int K; const char* Abase; const char* W2; const LAS int* tile_e; int ntiles, nunits, G, c;
    __device__ __forceinline__ bool next(int i, Unit& u) const {
        int L; if (!xcd_range_unit(i, nunits, G, c, L)) return false;
        const int tile = L >> 3; u.pn = L & 7;
        if (tile < ntiles) { u.pm = tile; u.e = __builtin_amdgcn_readfirstlane(tile_e[tile]); } else { u.pm = MAXTILES + (tile - ntiles); u.e = NEXP; }
        return true;
    }
    __device__ __forceinline__ const char* bbase(const Unit& u) const { return W2 + ((size_t)u.e * 2048 + (size_t)u.pn * BM) * EFF * 2; }
    __device__ __forceinline__ void aoffs(const Unit& u, const int (&R)[2], const int (&C)[2], unsigned (&o)[4]) const {
#pragma unroll
        for (int h = 0; h < 2; ++h)
#pragma unroll
            for (int i = 0; i < 2; ++i) o[2 * h + i] = (unsigned)(((size_t)(u.pm * BM + h * HALF + R[i]) * EFF + C[i]) * 2);
    }
};
struct CmpProb {
    int K; const char* Abase; const char* Bt; int G, c;
    __device__ __forceinline__ bool next(int i, Unit& u) const { const int L = i * G + c; if (L >= 16) return false; u.pm = L; u.pn = 0; u.e = 0; return true; }
    __device__ __forceinline__ const char* bbase(const Unit&) const { return Bt; }
    __device__ __forceinline__ void aoffs(const Unit& u, const int (&R)[2], const int (&C)[2], unsigned (&o)[4]) const {
#pragma unroll
        for (int h = 0; h < 2; ++h)
#pragma unroll
            for (int i = 0; i < 2; ++i) { const int m = u.pm * BM + h * HALF + R[i], seq = m >> 7, n = m & 127;
                o[2 * h + i] = (unsigned)((((size_t)seq * NS + 16 * n) * 128 + C[i]) * 2); }
    }
};
}

struct Args { const float* in[27]; float* out; unsigned char* ws; int ph_lo, ph_hi; };
typedef const __attribute__((address_space(4))) Args* CArgs;
__device__ __forceinline__ const float* kin(int i) { CArgs p = (CArgs)__builtin_amdgcn_kernarg_segment_ptr(); asm volatile("" : "+s"(p)); return p->in[i]; }
struct Frame {
    LAS unsigned char* lds;
    volatile LAS unsigned* MISC;
    unsigned* ctl;
    unsigned char* ws;
    int tid, lane, wave, vcu, G, gw, NGW;
    float* out;
};

__device__ __forceinline__ void tr_item(const float* W, int ldw, int k0, int n0, int nvalid, bf16* WT, int ldt, int drow0, LAS float* scr, int lane) {
#pragma unroll 8
    for (int i = 0; i < 32; ++i) { const int kk = 2 * i + (lane >> 5), n = lane & 31; scr[kk * 33 + n] = (n < nvalid) ? W[(size_t)(k0 + kk) * ldw + n0 + n] : 0.f; }
    LDS_WAIT(); asm volatile("" ::: "memory");
    const int c = lane & 7;
#pragma unroll
    for (int j = 0; j < 4; ++j) { const int n = (lane >> 3) + 8 * j; const LAS float* s = scr + (8 * c) * 33 + n;
        v4u o; o.x = pk2(s[0 * 33], s[1 * 33]); o.y = pk2(s[2 * 33], s[3 * 33]); o.z = pk2(s[4 * 33], s[5 * 33]); o.w = pk2(s[6 * 33], s[7 * 33]);
        if (n < nvalid) *(v4u*)(WT + (size_t)(drow0 + n) * ldt + k0 + 8 * c) = o; }
    LDS_WAIT(); asm volatile("" ::: "memory");
}
__device__ __forceinline__ bool tr_matrix(int& it, const float* W, int ldw, int K, int c0, int ncols, bf16* WT, int drow0, LAS float* scr, int lane) {
    const int nb = (ncols + 31) / 32, items = (K / 64) * nb;
    if (it >= items) { it -= items; return false; }
    const int kb = it / nb, b = it % nb, nv = ncols - 32 * b;
    tr_item(W, ldw, 64 * kb, c0 + 32 * b, nv < 32 ? nv : 32, WT, K, drow0 + 32 * b, scr, lane);
    return true;
}
__device__ __forceinline__ void zero_rows(Frame& F, bf16* base, size_t nelem) {
    for (size_t i = ((size_t)F.gw * 64 + F.lane) * 8; i < nelem; i += (size_t)F.NGW * 64 * 8) *(v4u*)(base + i) = (v4u){0u, 0u, 0u, 0u};
}

__device__ __forceinline__ void p_prologue(Frame& F) {
    LAS float* scr = (LAS float*)(F.lds + F.wave * 16384);
    unsigned char* ws = F.ws;
    {
        LAS float* wl = (LAS float*)F.lds;
        LAS float* pl = (LAS float*)(F.lds + 32768);
        const float* w_in = kin(2); const float* pool_w = kin(3); const float* pscale = kin(4);
        bf16* WT = (bf16*)(ws + WS_WABIN);
        for (int it = blockIdx.x; it < 4 * 32; it += F.G) {
            const int g = it >> 5, k0 = (it & 31) * 64;
            for (int i = F.tid; i < 64 * 128; i += 512) wl[i] = w_in[(size_t)(k0 + (i >> 7)) * AB_IN + g * 128 + (i & 127)];
            for (int i = F.tid; i < 128 * 128; i += 512) pl[i] = pool_w[(size_t)g * 16384 + i];
            __syncthreads();
            const int d = F.tid & 127, kg = F.tid >> 7; const float sc = pscale[g * 128 + d];
            for (int kk = 0; kk < 16; kk += 8) {
                float a[8];
#pragma unroll
                for (int j = 0; j < 8; ++j) a[j] = 0.f;
                for (int c = 0; c < 128; ++c) { const float pw = pl[c * 128 + d];
#pragma unroll
                    for (int j = 0; j < 8; ++j) a[j] += wl[(kg * 16 + kk + j) * 128 + c] * pw; }
                v4u o; o.x = pk2(a[0] * sc, a[1] * sc); o.y = pk2(a[2] * sc, a[3] * sc); o.z = pk2(a[4] * sc, a[5] * sc); o.w = pk2(a[6] * sc, a[7] * sc);
                *(v4u*)(WT + (size_t)(g * 128 + d) * ND + k0 + kg * 16 + kk) = o;
            }
            __syncthreads();
        }
    }
    __syncthreads();
    for (int it0 = F.gw; ; it0 += F.NGW) {
        int it = it0;
        if (tr_matrix(it, kin(2), AB_IN, ND, 512, AB_IN - 512, (bf16*)(ws + WS_WABIN), 512, scr, F.lane)) continue;
        if (tr_matrix(it, kin(5), ND, ND, 0, ND, (bf16*)(ws + WS_WABOUT), 0, scr, F.lane)) continue;
        if (tr_matrix(it, kin(6), CD_IN, ND, 0, CD_IN, (bf16*)(ws + WS_WCDIN), 0, scr, F.lane)) continue;
        if (tr_matrix(it, kin(14), ND, ND, 0, ND, (bf16*)(ws + WS_WCDOUT), 0, scr, F.lane)) continue;
        if (tr_matrix(it, kin(11), 1536, 384, 0, 1536, (bf16*)(ws + WS_WUQ), 0, scr, F.lane)) continue;
        if (tr_matrix(it, kin(13), 2048, 512, 0, 2048, (bf16*)(ws + WS_WUKV), 0, scr, F.lane)) continue;
        if (tr_matrix(it, kin(8), 128, 4096, 0, 128, (bf16*)(ws + WS_CW1), 0, scr, F.lane)) continue;
        if (tr_matrix(it, kin(8) + (size_t)4096 * 128, 128, 4096, 0, 128, (bf16*)(ws + WS_CW1), 128, scr, F.lane)) continue;
        break;
    }
    zero_rows(F, (bf16*)(ws + WS_WCDIN) + (size_t)CD_IN * ND, (size_t)(CD_INP - CD_IN) * ND);
    { const float* x = kin(0); bf16* xb = (bf16*)(ws + WS_XB0);
      for (size_t i = ((size_t)F.gw * 64 + F.lane) * 8; i < (size_t)NT * ND; i += (size_t)F.NGW * 64 * 8) {
          const f32x4 a = *(const f32x4*)(x + i), b = *(const f32x4*)(x + i + 4);
          v4u o; o.x = pk2(a[0], a[1]); o.y = pk2(a[2], a[3]); o.z = pk2(b[0], b[1]); o.w = pk2(b[2], b[3]); *(v4u*)(xb + i) = o; } }
    if (blockIdx.x == 0 && F.tid < 256) { const int kv = F.tid >> 7, h = F.tid & 127; const float* pos = kin(7) + (size_t)kv * 4096; const float* w1 = kin(8) + (size_t)kv * 4096 * 128;
        float s = 0.f; for (int f = 0; f < 4096; ++f) s += pos[f] * w1[(size_t)f * 128 + h];
        ((float*)(ws + WS_CMPB))[F.tid] = s; }
}
__device__ __forceinline__ void p_moe_weights(Frame& F, int l) {
    LAS float* scr = (LAS float*)(F.lds + F.wave * 16384);
    unsigned char* ws = F.ws;
    bf16* W13 = (bf16*)(ws + WS_W13); bf16* W2 = (bf16*)(ws + WS_W2); bf16* RT = (bf16*)(ws + WS_RT);
    const int total = 65 * 1536 + 32 * 2;
    for (int it = F.gw; it < total; it += F.NGW) {
        if (it >= 65 * 1536) { const int r = it - 65 * 1536, kb = r >> 1, b = r & 1;
            tr_item(kin(19) + (size_t)l * ND * NEXP, NEXP, 64 * kb, 32 * b, 32, RT, ND, 32 * b, scr, F.lane); continue; }
        const int e = it / 1536, r = it % 1536;
        const float *w1, *w3, *w2;
        if (e < NEXP) { const size_t o = ((size_t)l * NEXP + e) * ND * EFF; w1 = kin(21) + o; w3 = kin(22) + o; w2 = kin(23) + o; }
        else { const size_t o = (size_t)l * ND * EFF; w1 = kin(24) + o; w3 = kin(25) + o; w2 = kin(26) + o; }
        if (r < 1024) { const int which = r >> 9, rr = r & 511, kb = rr >> 4, nb = rr & 15;
            const int j = nb >> 2, drow = j * 256 + which * 128 + (nb & 3) * 32;
            tr_item(which ? w3 : w1, EFF, 64 * kb, 32 * nb, 32, W13 + (size_t)e * 1024 * ND, ND, drow, scr, F.lane); }
        else { const int rr = r - 1024, kb = rr >> 6, nb = rr & 63;
            tr_item(w2, ND, 64 * kb, 32 * nb, 32, W2 + (size_t)e * ND * EFF, EFF, 32 * nb, scr, F.lane); }
    }
    zero_rows(F, RT + (size_t)NEXP * ND, (size_t)(256 - NEXP) * ND);
}

__device__ __forceinline__ void ln_finish(float (&v)[4][8], const float* g, const float* b, int lane, bf16* ob, float* of) {
    float s = 0.f;
#pragma unroll
    for (int j = 0; j < 4; ++j)
#pragma unroll
        for (int i = 0; i < 8; ++i) s += v[j][i];
    const float mean = wave_sum(s) * (1.f / ND); float s2 = 0.f;
#pragma unroll
    for (int j = 0; j < 4; ++j)
#pragma unroll
        for (int i = 0; i < 8; ++i) { v[j][i] -= mean; s2 += v[j][i] * v[j][i]; }
    const float rstd = 1.f / sqrtf(wave_sum(s2) * (1.f / ND) + LN_EPS);
#pragma unroll
    for (int j = 0; j < 4; ++j) { const int c0 = (j * 64 + lane) * 8;
        const f32x4 g0 = *(const f32x4*)(g + c0), g1 = *(const f32x4*)(g + c0 + 4), b0 = *(const f32x4*)(b + c0), b1 = *(const f32x4*)(b + c0 + 4);
        float o[8];
#pragma unroll
        for (int i = 0; i < 4; ++i) { o[i] = v[j][i] * rstd * g0[i] + b0[i]; o[4 + i] = v[j][4 + i] * rstd * g1[i] + b1[i]; }
        if (ob) { v4u w; w.x = pk2(o[0], o[1]); w.y = pk2(o[2], o[3]); w.z = pk2(o[4], o[5]); w.w = pk2(o[6], o[7]); *(v4u*)(ob + c0) = w; }
        if (of) { *(f32x4*)(of + c0) = (f32x4){o[0], o[1], o[2], o[3]}; *(f32x4*)(of + c0 + 4) = (f32x4){o[4], o[5], o[6], o[7]}; } }
}
__device__ __forceinline__ void p_ln1(Frame& F, const bf16* xin, const bf16* mixo, const float* g, const float* b, bf16* xo) {
    for (int m = F.gw; m < NT; m += F.NGW) {
        float v[4][8];
#pragma unroll
        for (int j = 0; j < 4; ++j) { const size_t o = (size_t)m * ND + (j * 64 + F.lane) * 8; float a[8], c[8]; unpack8(*(const v4u*)(xin + o), a); unpack8(*(const v4u*)(mixo + o), c);
#pragma unroll
            for (int i = 0; i < 8; ++i) v[j][i] = DN_ALPHA * a[i] + c[i]; }
        ln_finish(v, g, b, F.lane, xo + (size_t)m * ND, nullptr);
    }
}
__device__ __forceinline__ void p_combine_ln2(Frame& F, const bf16* x1, const bf16* y2, const int* slot, const float* wsel, const float* g, const float* b, bf16* xo, float* fo) {
    for (int m = F.gw; m < NT; m += F.NGW) {
        float v[4][8];
#pragma unroll
        for (int j = 0; j < 4; ++j) { const size_t o = (size_t)m * ND + (j * 64 + F.lane) * 8; float a[8], c[8]; unpack8(*(const v4u*)(x1 + o), a);
            unpack8(*(const v4u*)(y2 + (size_t)(SH_ROW0 + m) * ND + (j * 64 + F.lane) * 8), c);
#pragma unroll
            for (int i = 0; i < 8; ++i) v[j][i] = DN_ALPHA * a[i] + c[i]; }
        for (int k = 0; k < 8; ++k) { const int row = slot[m * 8 + k]; const float w = wsel[m * 8 + k];
#pragma unroll
            for (int j = 0; j < 4; ++j) { float c[8]; unpack8(*(const v4u*)(y2 + (size_t)row * ND + (j * 64 + F.lane) * 8), c);
#pragma unroll
                for (int i = 0; i < 8; ++i) v[j][i] += w * c[i]; } }
        ln_finish(v, g, b, F.lane, xo ? xo + (size_t)m * ND : nullptr, fo ? fo + (size_t)m * ND : nullptr);
    }
}

__device__ __forceinline__ void p_pool_rope(Frame& F) {
    const bf16* proj = (const bf16*)(F.ws + WS_PROJ); bf16* mixin = (bf16*)(F.ws + WS_MIXIN); bf16* qr = (bf16*)(F.ws + WS_QR); bf16* kr = (bf16*)(F.ws + WS_KR);
    const int* pos = (const int*)kin(1);
    for (int m = F.gw; m < NT; m += F.NGW) {
        const int s = m & (NS - 1);
        { const int g = F.lane >> 4, w = 2 << g; const int lo = (s + 1 - w) > 0 ? (s + 1 - w) : 0; const float cnt = (float)((s + 1) < w ? (s + 1) : w);
          float acc[8], cur[8];
#pragma unroll
          for (int i = 0; i < 8; ++i) acc[i] = 0.f;
          for (int j = lo; j <= s; ++j) { float t[8]; unpack8(*(const v4u*)(proj + (size_t)(m - s + j) * AB_IN + F.lane * 8), t);
#pragma unroll
              for (int i = 0; i < 8; ++i) acc[i] += t[i]; }
          unpack8(*(const v4u*)(proj + (size_t)m * AB_IN + F.lane * 8), cur);
          float o[8];
#pragma unroll
          for (int i = 0; i < 8; ++i) o[i] = acc[i] / cnt - cur[i];
          v4u wv; wv.x = pk2(o[0], o[1]); wv.y = pk2(o[2], o[3]); wv.z = pk2(o[4], o[5]); wv.w = pk2(o[6], o[7]); *(v4u*)(mixin + (size_t)m * ND + F.lane * 8) = wv; }
        { const float p = (float)pos[m]; const float invf = exp2f(-(float)F.lane * (13.287712379549449f / 64.f));
          float sn, cs; sincosf(p * invf, &sn, &cs);
          const bf16* qrow = proj + (size_t)m * AB_IN + 512; const bf16* krow = proj + (size_t)m * AB_IN + 1280;
#pragma unroll
          for (int h = 0; h < 6; ++h) {
              const float q1 = bf1(qrow[h * 128 + F.lane]), q2 = bf1(qrow[h * 128 + 64 + F.lane]);
              qr[(size_t)m * 768 + h * 128 + F.lane] = (bf16)f2bf(q1 * cs - q2 * sn); qr[(size_t)m * 768 + h * 128 + 64 + F.lane] = (bf16)f2bf(q1 * sn + q2 * cs);
              const float k1 = bf1(krow[h * 128 + F.lane]), k2 = bf1(krow[h * 128 + 64 + F.lane]); const float ksc = 0.08838834764831845f;
              kr[(size_t)m * 768 + h * 128 + F.lane] = (bf16)f2bf((k1 * cs - k2 * sn) * ksc); kr[(size_t)m * 768 + h * 128 + 64 + F.lane] = (bf16)f2bf((k1 * sn + k2 * cs) * ksc);
          } }
    }
}
__device__ __forceinline__ void p_retention(Frame& F) {
    const bf16* proj = (const bf16*)(F.ws + WS_PROJ); bf16* mixin = (bf16*)(F.ws + WS_MIXIN); const bf16* qr = (const bf16*)(F.ws + WS_QR); const bf16* kr = (const bf16*)(F.ws + WS_KR);
    LAS float* qs = (LAS float*)F.lds;
    LAS float* ks = qs + 16 * 128;
    LAS float* vs = ks + 16 * 128;
    LAS float* part = vs + 16 * 256;
    for (int bh = blockIdx.x; bh < NB * 6; bh += F.G) {
        const int b = bh / 6, h = bh % 6; const float gamma = 1.0f - exp2f(-5.0f - (float)h);
        const int v = F.tid & 255, dh = F.tid >> 8;
        float S[64];
#pragma unroll
        for (int i = 0; i < 64; ++i) S[i] = 0.f;
        for (int tb = 0; tb < NS / 16; ++tb) {
            const int m0 = b * NS + tb * 16;
            { const int which = F.tid >> 8, tok = (F.tid >> 4) & 15, dc = F.tid & 15; const bf16* src = (which ? kr : qr) + (size_t)(m0 + tok) * 768 + h * 128 + dc * 8;
              float t[8]; unpack8(*(const v4u*)src, t); LAS float* dst = (which ? ks : qs) + tok * 128 + dc * 8;
#pragma unroll
              for (int i = 0; i < 8; ++i) dst[i] = t[i]; }
            for (int i = F.tid; i < 16 * 256; i += 512) vs[i] = bf1(proj[(size_t)(m0 + (i >> 8)) * AB_IN + 2048 + h * 256 + (i & 255)]);
            __syncthreads();
            for (int tt = 0; tt < 16; ++tt) {
                const float vv = vs[tt * 256 + v]; float y = 0.f;
#pragma unroll
                for (int d4 = 0; d4 < 16; ++d4) { const f32x4 k4 = *(const LAS f32x4*)(ks + tt * 128 + dh * 64 + d4 * 4), q4 = *(const LAS f32x4*)(qs + tt * 128 + dh * 64 + d4 * 4);
#pragma unroll
                    for (int j = 0; j < 4; ++j) { S[d4 * 4 + j] = gamma * S[d4 * 4 + j] + k4[j] * vv; y += q4[j] * S[d4 * 4 + j]; } }
                part[(tt * 2 + dh) * 256 + v] = y;
            }
            __syncthreads();
#pragma unroll
            for (int r = 0; r < 2; ++r) { const int tt = F.wave * 2 + r, m = m0 + tt; float y[4]; float s = 0.f;
#pragma unroll
                for (int j = 0; j < 4; ++j) { y[j] = part[(tt * 2) * 256 + j * 64 + F.lane] + part[(tt * 2 + 1) * 256 + j * 64 + F.lane]; s += y[j]; }
                const float mean = wave_sum(s) * (1.f / 256.f); float s2 = 0.f;
#pragma unroll
                for (int j = 0; j < 4; ++j) { y[j] -= mean; s2 += y[j] * y[j]; }
                const float rstd = 1.f / sqrtf(wave_sum(s2) * (1.f / 256.f) + NORM_EPS);
#pragma unroll
                for (int j = 0; j < 4; ++j) { const float gt = bf1(proj[(size_t)m * AB_IN + 3584 + h * 256 + j * 64 + F.lane]);
                    mixin[(size_t)m * ND + 512 + h * 256 + j * 64 + F.lane] = (bf16)f2bf(y[j] * rstd * siluf_(gt)); } }
            __syncthreads();
        }
    }
}

__device__ __forceinline__ void p_route(Frame& F, int l) {
    const float* logits = (const float*)(F.ws + WS_LOGITS); const float* rbias = kin(20) + l * NEXP;
    int* tope = (int*)(F.ws + WS_TOPE); float* wsel = (float*)(F.ws + WS_WSEL); int* posb = (int*)(F.ws + WS_SLOT); unsigned* cnt = F.ctl + CW_CNT + l * 64;
    const float bias = rbias[F.lane];
    for (int m = F.gw; m < NT; m += F.NGW) {
        const float sc = sigmoidf_(logits[(size_t)m * 256 + F.lane]), bi = sc + bias;
        const int grp = F.lane >> 3;
        int rk = 0;
#pragma unroll
        for (int j = 1; j < 8; ++j) { const int o = (F.lane & ~7) | ((F.lane + j) & 7); const float ov = __shfl(bi, o); rk += ((ov > bi) || (ov == bi && o < F.lane)) ? 1 : 0; }
        float gs = rk < 2 ? bi : 0.f; gs += __shfl_xor(gs, 1); gs += __shfl_xor(gs, 2); gs += __shfl_xor(gs, 4);
        int grk = 0;
#pragma unroll
        for (int gg = 0; gg < 8; ++gg) { const float ov = __shfl(gs, gg * 8); grk += (gg != grp && ((ov > gs) || (ov == gs && gg < grp))) ? 1 : 0; }
        const float mv = grk < 4 ? bi : -1e30f;
        int erk = 0;
        for (int j = 0; j < 64; ++j) { const float ov = __shfl(mv, j); erk += ((ov > mv) || (ov == mv && j < F.lane)) ? 1 : 0; }
        const bool sel = erk < 8;
        const float wsum = wave_sum(sel ? sc : 0.f);
        if (sel) { const unsigned p = atomicAdd(&cnt[F.lane], 1u); tope[m * 8 + erk] = F.lane; wsel[m * 8 + erk] = sc / wsum * 2.5f; posb[m * 8 + erk] = (int)p; }
    }
}
__device__ __forceinline__ void load_offsets(Frame& F, int l) {
    volatile LAS int* tab = (volatile LAS int*)(F.lds + TAB_OFF);
    __syncthreads();
    if (F.tid < NEXP) tab[66 + F.tid] = (int)__hip_atomic_load(F.ctl + CW_CNT + l * 64 + F.tid, __ATOMIC_RELAXED, __HIP_MEMORY_SCOPE_AGENT);
    __syncthreads();
    if (F.tid == 0) { int o = 0; for (int e = 0; e < NEXP; ++e) { tab[e] = o; int c = tab[66 + e]; if (c > NT) c = NT; const int nt_ = (c + 255) >> 8; for (int t = 0; t < nt_; ++t) { const int ti = (o >> 8) + t; if (ti < MAXTILES) tab[160 + ti] = e; } o += nt_ << 8; if (o > MAXROWS) o = MAXROWS; }
        tab[64] = o; tab[65] = o >> 8; }
    __syncthreads();
}
__device__ __forceinline__ void p_scatter(Frame& F, int l) {
    load_offsets(F, l);
    const LAS int* tab = (const LAS int*)(F.lds + TAB_OFF);
    const int* tope = (const int*)(F.ws + WS_TOPE); int* slot = (int*)(F.ws + WS_SLOT); int* sorted = (int*)(F.ws + WS_SORTED);
    for (int i = F.gw * 64 + F.lane; i < NT * 8; i += F.NGW * 64) { const int e = tope[i]; const int row = tab[e] + slot[i]; sorted[row] = i >> 3; slot[i] = row; }
    for (int i = F.gw * 64 + F.lane; i < NEXP * 256; i += F.NGW * 64) { const int e = i >> 8, j = i & 255; const int r = tab[e] + tab[66 + e] + j; if (r < tab[e + 1]) sorted[r] = 0; }
}

__device__ __forceinline__ void p_l1_thin_a(Frame& F) {
    const bf16* proj = (const bf16*)(F.ws + WS_PROJ); const int* pos = (const int*)kin(1);
    bf16* cqn = (bf16*)(F.ws + WS_CQN); bf16* ckvn = (bf16*)(F.ws + WS_CKVN); bf16* krot = (bf16*)(F.ws + WS_KROT); bf16* cmpkv = (bf16*)(F.ws + WS_CMPKV);
    const float* qn = kin(10); const float* kvn = kin(12);
    for (int m = F.gw; m < NT; m += F.NGW) {
        const bf16* row = proj + (size_t)m * CD_INP;
        { float x[6]; float s = 0.f;
#pragma unroll
          for (int j = 0; j < 6; ++j) { x[j] = bf1(row[2584 + j * 64 + F.lane]); s += x[j] * x[j]; }
          const float r = 1.f / sqrtf(wave_sum(s) * (1.f / 384.f) + NORM_EPS);
#pragma unroll
          for (int j = 0; j < 6; ++j) cqn[(size_t)m * 384 + j * 64 + F.lane] = (bf16)f2bf(x[j] * r * qn[j * 64 + F.lane]); }
        { float x[8]; float s = 0.f;
#pragma unroll
          for (int j = 0; j < 8; ++j) { x[j] = bf1(row[2968 + j * 64 + F.lane]); s += x[j] * x[j]; }
          const float r = 1.f / sqrtf(wave_sum(s) * (1.f / 512.f) + NORM_EPS);
#pragma unroll
          for (int j = 0; j < 8; ++j) ckvn[(size_t)m * 512 + j * 64 + F.lane] = (bf16)f2bf(x[j] * r * kvn[j * 64 + F.lane]); }
        { const int i = F.lane & 31; const float p = (float)pos[m]; const float invf = exp2f(-(float)i * (13.287712379549449f / 32.f));
          float sn, cs; sincosf(p * invf, &sn, &cs);
          const float x1 = bf1(row[3480 + i]), x2 = bf1(row[3480 + 32 + i]);
          if (F.lane < 32) krot[(size_t)m * 64 + i] = (bf16)f2bf(x1 * cs - x2 * sn); else krot[(size_t)m * 64 + 32 + i] = (bf16)f2bf(x1 * sn + x2 * cs); }
        { const int b = m >> 11, s = m & (NS - 1);
          const int q4 = F.lane >> 4, c = F.lane & 15, kv = q4 >> 1, g = q4 & 1;
          const v4u w = *(const v4u*)(row + 1024 + q4 * 128 + c * 8);
          *(v4u*)(cmpkv + ((size_t)((kv * 16 + b * 2 + g) * NS + s)) * 128 + c * 8) = w; }
    }
}
__device__ __forceinline__ void p_l1_thin_b(Frame& F) {
    bf16* qmla = (bf16*)(F.ws + WS_QMLA); const int* pos = (const int*)kin(1);
    for (int m = F.gw; m < NT; m += F.NGW) {
        const int i = F.lane & 31; const float p = (float)pos[m]; const float invf = exp2f(-(float)i * (13.287712379549449f / 32.f));
        float sn, cs; sincosf(p * invf, &sn, &cs);
#pragma unroll
        for (int hh = 0; hh < 4; ++hh) { const int h = hh * 2 + (F.lane >> 5); bf16* q = qmla + (size_t)m * 1536 + h * 192 + 128;
            const float x1 = bf1(q[i]), x2 = bf1(q[32 + i]); q[i] = (bf16)f2bf(x1 * cs - x2 * sn); q[32 + i] = (bf16)f2bf(x1 * sn + x2 * cs); }
    }
    const float* hid = (const float*)(F.ws + WS_HID); const float* w2 = kin(9); float* kvc = (float*)(F.ws + WS_KVCMP);
    for (int m = F.gw; m < 4096; m += F.NGW) {
        const int kv = m >> 11;
        float h0 = hid[(size_t)m * 256 + kv * 128 + F.lane], h1 = hid[(size_t)m * 256 + kv * 128 + 64 + F.lane];
        h0 = 0.5f * h0 * (1.f + tanhf(0.7978845608028654f * (h0 + 0.044715f * h0 * h0 * h0)));
        h1 = 0.5f * h1 * (1.f + tanhf(0.7978845608028654f * (h1 + 0.044715f * h1 * h1 * h1)));
        const float* w = w2 + (size_t)kv * 128 * 128; float o0 = 0.f, o1 = 0.f;
        for (int c = 0; c < 64; ++c) { const float a = __shfl(h0, c), bq = __shfl(h1, c);
            o0 += a * w[c * 128 + F.lane] + bq * w[(c + 64) * 128 + F.lane]; o1 += a * w[c * 128 + 64 + F.lane] + bq * w[(c + 64) * 128 + 64 + F.lane]; }
        kvc[(size_t)m * 128 + F.lane] = o0; kvc[(size_t)m * 128 + 64 + F.lane] = o1;
    }
}
__device__ __forceinline__ void p_nsa_cmp(Frame& F) {
    const bf16* proj = (const bf16*)(F.ws + WS_PROJ); const float* kvc = (const float*)(F.ws + WS_KVCMP); float* ocmp = (float*)(F.ws + WS_OCMP); unsigned* selm = (unsigned*)(F.ws + WS_SELM);
    LAS float* qs = (LAS float*)(F.lds + F.wave * 2048);
    LAS float* ps = qs + 128;
    const float scale = 0.08838834764831845f;
    for (int it = F.gw; it < NT * 2; it += F.NGW) {
        const int m = it >> 1, g = it & 1, b = m >> 11, s = m & (NS - 1);
        const int nvalid = (s >= 31) ? ((s - 31) / 16 + 1) : 0;
        const float* kc = kvc + (size_t)((0 * 16 + b * 2 + g) * 128) * 128; const float* vc = kvc + (size_t)((1 * 16 + b * 2 + g) * 128) * 128;
        float psum0 = 0.f, psum1 = 0.f;
        for (int r = 0; r < 4; ++r) {
            const int h = g * 4 + r;
            qs[F.lane] = bf1(proj[(size_t)m * CD_INP + h * 128 + F.lane]); qs[64 + F.lane] = bf1(proj[(size_t)m * CD_INP + h * 128 + 64 + F.lane]);
            LDS_WAIT(); asm volatile("" ::: "memory");
            float s0 = 0.f, s1 = 0.f;
            if (nvalid > 0) {
                const float* k0 = kc + (size_t)F.lane * 128; const float* k1 = kc + (size_t)(64 + F.lane) * 128;
                for (int d = 0; d < 128; d += 4) { const f32x4 q4 = *(const LAS f32x4*)(qs + d); const f32x4 a = *(const f32x4*)(k0 + d), c = *(const f32x4*)(k1 + d);
                    s0 += q4[0] * a[0] + q4[1] * a[1] + q4[2] * a[2] + q4[3] * a[3]; s1 += q4[0] * c[0] + q4[1] * c[1] + q4[2] * c[2] + q4[3] * c[3]; }
            }
            const bool v0 = F.lane < nvalid, v1 = (64 + F.lane) < nvalid;
            s0 = v0 ? s0 * scale : -1e30f; s1 = v1 ? s1 * scale : -1e30f;
            const float mx = wave_max(fmaxf(s0, s1));
            float p0 = v0 ? __expf(s0 - mx) : 0.f, p1 = v1 ? __expf(s1 - mx) : 0.f;
            const float den = wave_sum(p0 + p1); const float inv = den > 0.f ? 1.f / den : 0.f;
            p0 *= inv; p1 *= inv; psum0 += p0; psum1 += p1;
            float o0 = 0.f, o1 = 0.f;
            for (int n = 0; n < nvalid; ++n) { const float pn = n < 64 ? __shfl(p0, n) : __shfl(p1, n - 64); const f32x2 vv = *(const f32x2*)(vc + (size_t)n * 128 + F.lane * 2); o0 += pn * vv[0]; o1 += pn * vv[1]; }
            const float gt = sigmoidf_(bf1(proj[(size_t)m * CD_INP + 2560 + h * 3 + 0]));
            *(f32x2*)(ocmp + (size_t)m * 1024 + h * 128 + F.lane * 2) = (f32x2){gt * o0, gt * o1};
            asm volatile("" ::: "memory");
        }
        ps[F.lane] = psum0; ps[64 + F.lane] = psum1;
        LDS_WAIT(); asm volatile("" ::: "memory");
        const int j = F.lane & 31, cur = s >> 6;
        float imp = 0.f;
#pragma unroll
        for (int k = 0; k < 4; ++k) { const int n1 = 4 * j + k; if (n1 <= 126) imp += ps[n1]; const int n2 = 4 * j - 1 + k; if (n2 >= 0 && n2 <= 126) imp += ps[n2]; }
        const bool forced = (j == 0) || (j == cur) || (j == cur - 1);
        float score = forced ? 1e4f : ((j * 64 <= s) ? imp : -1e30f);
        if (F.lane >= 32) score = -3e38f;
        int rk = 0;
        for (int jj = 0; jj < 32; ++jj) { const float ov = __shfl(score, jj); rk += ((ov > score) || (ov == score && jj < j)) ? 1 : 0; }
        const bool sel = (F.lane < 32) && (rk < 16) && (j <= cur);
        const unsigned long long bal = __ballot(sel);
        if (F.lane == 0) selm[m * 2 + g] = (unsigned)bal;
        asm volatile("" ::: "memory");
    }
}
namespace fa {
typedef short v4i16_t __attribute__((ext_vector_type(4)));
struct Src { const bf16* k1; size_t ks1; const bf16* k2; size_t ks2; const bf16* v; size_t vs; };
template <int DQK> struct Cfg { static constexpr int KPITCH = (DQK + 8) * 2, KBYTES = 64 * KPITCH, VPITCH = 272, VBYTES = 64 * VPITCH, BUF = KBYTES + VBYTES, NKS = DQK / 32, KCH = DQK / 8, NKR = DQK / 64; };

template <int DQK>
__device__ __forceinline__ void load_tile(const Src& S, int k0, int tid, v4u (&kr)[Cfg<DQK>::NKR], v4u (&vr)[2]) {
    constexpr int KCH = Cfg<DQK>::KCH;
#pragma unroll
    for (int i = 0; i < Cfg<DQK>::NKR; ++i) { const int c = tid + 512 * i, row = c / KCH, c8 = c % KCH;
        const bf16* src = (DQK == 192 && c8 >= 16) ? S.k2 + (size_t)(k0 + row) * S.ks2 + (c8 - 16) * 8 : S.k1 + (size_t)(k0 + row) * S.ks1 + c8 * 8;
        kr[i] = *(const v4u*)src; }
#pragma unroll
    for (int i = 0; i < 2; ++i) { const int c = tid + 512 * i, row = c >> 4, c8 = c & 15; vr[i] = *(const v4u*)(S.v + (size_t)(k0 + row) * S.vs + c8 * 8); }
}
template <int DQK>
__device__ __forceinline__ void store_tile(LAS unsigned char* buf, int tid, const v4u (&kr)[Cfg<DQK>::NKR], const v4u (&vr)[2]) {
    constexpr int KCH = Cfg<DQK>::KCH;
#pragma unroll
    for (int i = 0; i < Cfg<DQK>::NKR; ++i) { const int c = tid + 512 * i, row = c / KCH, c8 = c % KCH; *(LAS v4u*)(buf + row * Cfg<DQK>::KPITCH + c8 * 16) = kr[i]; }
#pragma unroll
    for (int i = 0; i < 2; ++i) { const int c = tid + 512 * i, row = c >> 4, c8 = c & 15; *(LAS v4u*)(buf + Cfg<DQK>::KBYTES + row * Cfg<DQK>::VPITCH + c8 * 16) = vr[i]; }
}
template <int DQK, int MODE>
__device__ __forceinline__ void fa_pass(LAS unsigned char* lds, const Src& S, const bf16x8 (&qf)[Cfg<DQK>::NKS], unsigned tmask, int spos, unsigned rowmask, float sscale,
                                        f32x4 (&O)[8], float& m_run, float& l_run, int tid, int lane) {
    typedef Cfg<DQK> C;
    const int i16 = lane & 15, g = lane >> 4, q4 = (lane & 15) >> 2, p4 = lane & 3;
#pragma unroll
    for (int nt = 0; nt < 8; ++nt) O[nt] = (f32x4){0.f, 0.f, 0.f, 0.f};
    m_run = -1e30f; l_run = 0.f;
    unsigned rem = tmask;
    if (rem == 0u) return;
    v4u kr[C::NKR], vr[2];
    int t = __builtin_ctz(rem); rem &= rem - 1u;
    load_tile<DQK>(S, t * 64, tid, kr, vr);
    __syncthreads();
    store_tile<DQK>(lds, tid, kr, vr);
    __syncthreads();
    int cur = 0;
    for (;;) {
        const bool has_next = rem != 0u; int tn = 0;
        if (has_next) { tn = __builtin_ctz(rem); rem &= rem - 1u; load_tile<DQK>(S, tn * 64, tid, kr, vr); }
        LAS unsigned char* kb = lds + cur * C::BUF; LAS unsigned char* vb = kb + C::KBYTES;
        f32x4 sc[4];
#pragma unroll
        for (int mt = 0; mt < 4; ++mt) { sc[mt] = (f32x4){0.f, 0.f, 0.f, 0.f};
#pragma unroll
            for (int ks = 0; ks < C::NKS; ++ks) { const bf16x8 kf = *(const LAS bf16x8*)(kb + (16 * mt + i16) * C::KPITCH + (32 * ks + 8 * g) * 2);
                sc[mt] = __builtin_amdgcn_mfma_f32_16x16x32_bf16(kf, qf[ks], sc[mt], 0, 0, 0); } }
        float mx = -1e30f; bool vl[4][4];
#pragma unroll
        for (int mt = 0; mt < 4; ++mt)
#pragma unroll
            for (int r = 0; r < 4; ++r) { const int kp = t * 64 + 16 * mt + 4 * g + r; bool ok = kp <= spos;
                if (MODE == 1) ok = ok && ((rowmask >> t) & 1u);
                if (MODE == 2) ok = ok && (kp + 512 > spos);
                vl[mt][r] = ok; const float x = ok ? sc[mt][r] * sscale : -1e30f; sc[mt][r] = x; mx = fmaxf(mx, x); }
        mx = fmaxf(mx, __shfl_xor(mx, 16)); mx = fmaxf(mx, __shfl_xor(mx, 32));
        const float m_new = fmaxf(m_run, mx), alpha = __builtin_amdgcn_exp2f(m_run - m_new); m_run = m_new;
        float ps = 0.f;
#pragma unroll
        for (int mt = 0; mt < 4; ++mt)
#pragma unroll
            for (int r = 0; r < 4; ++r) { const float pv = vl[mt][r] ? __builtin_amdgcn_exp2f(sc[mt][r] - m_new) : 0.f; sc[mt][r] = pv; ps += pv; }
        l_run = l_run * alpha + ps;
        float ar[4];
#pragma unroll
        for (int r = 0; r < 4; ++r) ar[r] = __shfl(alpha, 4 * g + r);
#pragma unroll
        for (int nt = 0; nt < 8; ++nt)
#pragma unroll
            for (int r = 0; r < 4; ++r) O[nt][r] *= ar[r];
        bf16x8 pf[2];
#pragma unroll
        for (int k2 = 0; k2 < 2; ++k2) { v4u w; w.x = pk2(sc[2 * k2][0], sc[2 * k2][1]); w.y = pk2(sc[2 * k2][2], sc[2 * k2][3]); w.z = pk2(sc[2 * k2 + 1][0], sc[2 * k2 + 1][1]); w.w = pk2(sc[2 * k2 + 1][2], sc[2 * k2 + 1][3]);
            pf[k2] = __builtin_bit_cast(bf16x8, w); }
#pragma unroll
        for (int nt = 0; nt < 8; ++nt)
#pragma unroll
            for (int k2 = 0; k2 < 2; ++k2) {
                const v4i16_t a = __builtin_amdgcn_ds_read_tr16_b64_v4i16((LAS v4i16_t*)(vb + (32 * k2 + 4 * g + q4) * C::VPITCH + (16 * nt + 4 * p4) * 2));
                const v4i16_t b = __builtin_amdgcn_ds_read_tr16_b64_v4i16((LAS v4i16_t*)(vb + (32 * k2 + 16 + 4 * g + q4) * C::VPITCH + (16 * nt + 4 * p4) * 2));
                const bf16x8 vf = (bf16x8){a[0], a[1], a[2], a[3], b[0], b[1], b[2], b[3]};
                O[nt] = __builtin_amdgcn_mfma_f32_16x16x32_bf16(pf[k2], vf, O[nt], 0, 0, 0); }
        if (has_next) store_tile<DQK>(lds + (cur ^ 1) * C::BUF, tid, kr, vr);
        __syncthreads();
        if (!has_next) break;
        t = tn; cur ^= 1;
    }
}
__device__ __forceinline__ void row_inv(float l_run, int lane, float (&inv)[4]) {
    float l = l_run; l += __shfl_xor(l, 16); l += __shfl_xor(l, 32);
    const float li = l > 0.f ? 1.f / l : 0.f; const int g = lane >> 4;
#pragma unroll
    for (int r = 0; r < 4; ++r) inv[r] = __shfl(li, 4 * g + r);
}
}

constexpr int FA_NUNITS = 2048;
__device__ __forceinline__ void p_attn_mfma(Frame& F, unsigned* queue) {
    const bf16* proj = (const bf16*)(F.ws + WS_PROJ); bf16* mixin = (bf16*)(F.ws + WS_MIXIN); const float* ocmp = (const float*)(F.ws + WS_OCMP); const unsigned* selm = (const unsigned*)(F.ws + WS_SELM);
    const bf16* qmla = (const bf16*)(F.ws + WS_QMLA); const bf16* kvu = (const bf16*)(F.ws + WS_KVU); const bf16* krot = (const bf16*)(F.ws + WS_KROT);
    volatile LAS unsigned* qslot = (volatile LAS unsigned*)(F.lds + LDSCTL_OFF);
    const int lane = F.lane, w = F.wave, i16 = lane & 15, g4 = lane >> 4;
    for (;;) {
        __syncthreads();
        if (F.tid == 0) qslot[0] = atomicAdd(queue, 1u);
        __syncthreads();
        const int u = __builtin_amdgcn_readfirstlane((int)qslot[0]);
        if (u >= FA_NUNITS) break;
        if (u < 1024) {
            const int qt = 15 - (u >> 6), bh = u & 63, b = bh >> 3, h = bh & 7, q0 = qt * 128, spos = q0 + 16 * w + i16;
            bf16x8 qf[6];
#pragma unroll
            for (int ks = 0; ks < 6; ++ks) qf[ks] = *(const bf16x8*)(qmla + (size_t)(b * NS + spos) * 1536 + h * 192 + 32 * ks + 8 * g4);
            fa::Src S; S.k1 = kvu + (size_t)(b * NS) * 2048 + h * 256; S.ks1 = 2048; S.k2 = krot + (size_t)(b * NS) * 64; S.ks2 = 64; S.v = S.k1 + 128; S.vs = 2048;
            const int last = (q0 + 127) >> 6; const unsigned tmask = last >= 31 ? 0xffffffffu : ((1u << (last + 1)) - 1u);
            f32x4 O[8]; float m_run, l_run;
            fa::fa_pass<192, 0>(F.lds, S, qf, tmask, spos, 0u, 0.07216878364870322f * 1.4426950408889634f, O, m_run, l_run, F.tid, lane);
            float inv[4]; fa::row_inv(l_run, lane, inv);
#pragma unroll
            for (int r = 0; r < 4; ++r) { bf16* orow = mixin + (size_t)(b * NS + q0 + 16 * w + 4 * g4 + r) * ND + 1024 + h * 128 + i16;
#pragma unroll
                for (int nt = 0; nt < 8; ++nt) orow[16 * nt] = (bf16)f2bf(O[nt][r] * inv[r]); }
        } else {
            const int v = u - 1024, qt = 63 - (v >> 4), bg = v & 15, b = bg >> 1, gq = bg & 1, q0 = qt * 32;
            const int h = gq * 4 + (w >> 1), spos = q0 + (w & 1) * 16 + i16;
            bf16x8 qf[4];
#pragma unroll
            for (int ks = 0; ks < 4; ++ks) qf[ks] = *(const bf16x8*)(proj + (size_t)(b * NS + spos) * CD_INP + h * 128 + 32 * ks + 8 * g4);
            const unsigned rowmask = selm[(size_t)(b * NS + spos) * 2 + gq];
            unsigned um = selm[(size_t)(b * NS + q0 + (lane & 31)) * 2 + gq];
#pragma unroll
            for (int o = 1; o < 32; o <<= 1) um |= (unsigned)__shfl_xor((int)um, o);
            um = (unsigned)__builtin_amdgcn_readfirstlane((int)um);
            const bf16* base = proj + (size_t)(b * NS) * CD_INP;
            const float sscale = 0.08838834764831845f * 1.4426950408889634f;
            f32x4 O[8], Ot[8]; float m_run, l_run, inv[4];
            { fa::Src S; S.k1 = base + 1024 + ((1 * 2 + 0) * 2 + gq) * 128; S.ks1 = CD_INP; S.k2 = nullptr; S.ks2 = 0; S.v = base + 1024 + ((1 * 2 + 1) * 2 + gq) * 128; S.vs = CD_INP;
              fa::fa_pass<128, 1>(F.lds, S, qf, um, spos, rowmask, sscale, O, m_run, l_run, F.tid, lane); }
            fa::row_inv(l_run, lane, inv);
#pragma unroll
            for (int r = 0; r < 4; ++r) { const int sq = q0 + (w & 1) * 16 + 4 * g4 + r; const float g1 = sigmoidf_(bf1(proj[(size_t)(b * NS + sq) * CD_INP + 2560 + h * 3 + 1])) * inv[r];
#pragma unroll
                for (int nt = 0; nt < 8; ++nt) Ot[nt][r] = O[nt][r] * g1; }
            { fa::Src S; S.k1 = base + 1024 + ((2 * 2 + 0) * 2 + gq) * 128; S.ks1 = CD_INP; S.k2 = nullptr; S.ks2 = 0; S.v = base + 1024 + ((2 * 2 + 1) * 2 + gq) * 128; S.vs = CD_INP;
              const int klo = q0 - 511 > 0 ? q0 - 511 : 0, tlo = klo >> 6, thi = (q0 + 31) >> 6;
              const unsigned hm = thi >= 31 ? 0xffffffffu : ((1u << (thi + 1)) - 1u); const unsigned tmask = hm & ~((1u << tlo) - 1u);
              fa::fa_pass<128, 2>(F.lds, S, qf, tmask, spos, 0u, sscale, O, m_run, l_run, F.tid, lane); }
            fa::row_inv(l_run, lane, inv);
#pragma unroll
            for (int r = 0; r < 4; ++r) { const int sq = q0 + (w & 1) * 16 + 4 * g4 + r; const size_t m = (size_t)(b * NS + sq);
                const float g2 = sigmoidf_(bf1(proj[m * CD_INP + 2560 + h * 3 + 2])) * inv[r];
#pragma unroll
                for (int nt = 0; nt < 8; ++nt) { const float oc = ocmp[m * 1024 + h * 128 + 16 * nt + i16]; mixin[m * ND + h * 128 + 16 * nt + i16] = (bf16)f2bf(oc + Ot[nt][r] + O[nt][r] * g2); } }
        }
    }
}

constexpr int NPHASE = 33;


#define IN(k) (lo <= (k) && (k) < hi)
#define SEAM(k) do { if (IN(k) && IN((k) + 1)) { if (MK_ONE_LAUNCH) xcd_barrier(bar); else if (F.tid == 0) __hip_atomic_store(F.ctl + CW_TMO, 0xBAD0u | (unsigned)(k), __ATOMIC_RELAXED, __HIP_MEMORY_SCOPE_AGENT); } } while (0)
template <int l>
__device__ __forceinline__ void layer_body(Frame& F, const XcdBarrier& bar, const int lo, const int hi) {
    unsigned char* ws = F.ws;
    bf16* const XB0 = (bf16*)(ws + WS_XB0); bf16* const X1B = (bf16*)(ws + WS_X1B); bf16* const X2B = (bf16*)(ws + WS_X2B);
    bf16* const PROJ = (bf16*)(ws + WS_PROJ); bf16* const MIXIN = (bf16*)(ws + WS_MIXIN); bf16* const MIXO = (bf16*)(ws + WS_MIXO);
    bf16* const HB = (bf16*)(ws + WS_H); bf16* const Y2 = (bf16*)(ws + WS_Y2);
        const int pb = 1 + l * 16;
        const bf16* xin = l == 0 ? XB0 : X2B;
        if (IN(pb + 0)) {
            p_moe_weights(F, l);
            __syncthreads();
            if (l == 0) { pg8::DenseProb P; P.init(xin, ND, (const bf16*)(ws + WS_WABIN), NT, AB_IN, ND, F.G, (int)blockIdx.x); pg8::EpiBf16 E{PROJ, AB_IN};
                pg8::gemm_phase<pg8::EpiBf16, pg8::DenseProb, true>(F.lds, P, E); }
            else { pg8::DenseProb P; P.init(xin, ND, (const bf16*)(ws + WS_WCDIN), NT, CD_INP, ND, F.G, (int)blockIdx.x); pg8::EpiBf16 E{PROJ, CD_INP};
                pg8::gemm_phase<pg8::EpiBf16, pg8::DenseProb, true>(F.lds, P, E); }
        } SEAM(pb + 0);
        if (l == 0) {
            if (IN(pb + 1)) { p_pool_rope(F); } SEAM(pb + 1);
            if (IN(pb + 2)) { p_retention(F); } SEAM(pb + 2);
            SEAM(pb + 3); SEAM(pb + 4); SEAM(pb + 5);
        } else {
            if (IN(pb + 1)) { p_l1_thin_a(F); } SEAM(pb + 1);
            if (IN(pb + 2)) {
                { pg8::CmpProb P; P.K = 4096; P.Abase = (const char*)(ws + WS_CMPKV); P.Bt = (const char*)(ws + WS_CW1); P.G = F.G; P.c = (int)blockIdx.x;
                  pg8::EpiF32 E{(float*)(ws + WS_HID), 256, (const float*)(ws + WS_CMPB)};
                  pg8::gemm_phase<pg8::EpiF32, pg8::CmpProb, true>(F.lds, P, E); }
                { pg8::DenseProb P; P.init((const bf16*)(ws + WS_CQN), 384, (const bf16*)(ws + WS_WUQ), NT, 1536, 384, F.G, (int)blockIdx.x); pg8::EpiBf16 E{(bf16*)(ws + WS_QMLA), 1536};
                  pg8::gemm_phase<pg8::EpiBf16, pg8::DenseProb, true>(F.lds, P, E); }
                { pg8::DenseProb P; P.init((const bf16*)(ws + WS_CKVN), 512, (const bf16*)(ws + WS_WUKV), NT, 2048, 512, F.G, (int)blockIdx.x); pg8::EpiBf16 E{(bf16*)(ws + WS_KVU), 2048};
                  pg8::gemm_phase<pg8::EpiBf16, pg8::DenseProb, true>(F.lds, P, E); }
            } SEAM(pb + 2);
            if (IN(pb + 3)) { p_l1_thin_b(F); } SEAM(pb + 3);
            if (IN(pb + 4)) { p_nsa_cmp(F); } SEAM(pb + 4);
            if (IN(pb + 5)) { p_attn_mfma(F, F.ctl + CW_CNT + 256); } SEAM(pb + 5);
        }
        if (IN(pb + 6)) { pg8::DenseProb P; P.init(MIXIN, ND, (const bf16*)(ws + (l == 0 ? WS_WABOUT : WS_WCDOUT)), NT, ND, ND, F.G, (int)blockIdx.x); pg8::EpiBf16 E{MIXO, ND};
            pg8::gemm_phase<pg8::EpiBf16, pg8::DenseProb, true>(F.lds, P, E); } SEAM(pb + 6);
        if (IN(pb + 7)) { p_ln1(F, xin, MIXO, kin(15) + l * ND, kin(16) + l * ND, X1B); } SEAM(pb + 7);
        if (IN(pb + 8)) { pg8::DenseProb P; P.init(X1B, ND, (const bf16*)(ws + WS_RT), NT, 256, ND, F.G, (int)blockIdx.x); pg8::EpiF32 E{(float*)(ws + WS_LOGITS), 256, nullptr};
            pg8::gemm_phase<pg8::EpiF32, pg8::DenseProb, true>(F.lds, P, E); } SEAM(pb + 8);
        if (IN(pb + 9)) { p_route(F, l); } SEAM(pb + 9);
        if (IN(pb + 10)) { p_scatter(F, l); } SEAM(pb + 10);
        if (IN(pb + 11)) { load_offsets(F, l); const LAS int* tab = (const LAS int*)(F.lds + TAB_OFF);
            pg8::MoeUpProb P; P.K = ND; P.Abase = (const char*)X1B; P.W13 = (const char*)(ws + WS_W13); P.sorted = (const int*)(ws + WS_SORTED); P.tile_e = tab + 160; P.ntiles = __builtin_amdgcn_readfirstlane(tab[65]);
            P.nunits = (P.ntiles + NT / 256) * 4; P.G = F.G; P.c = (int)blockIdx.x;
            pg8::EpiSwiglu E{HB};
            pg8::gemm_phase<pg8::EpiSwiglu, pg8::MoeUpProb, true>(F.lds, P, E); } SEAM(pb + 11);
        if (IN(pb + 12)) { load_offsets(F, l); const LAS int* tab = (const LAS int*)(F.lds + TAB_OFF);
            pg8::MoeDownProb P; P.K = EFF; P.Abase = (const char*)HB; P.W2 = (const char*)(ws + WS_W2); P.tile_e = tab + 160; P.ntiles = __builtin_amdgcn_readfirstlane(tab[65]);
            P.nunits = (P.ntiles + NT / 256) * 8; P.G = F.G; P.c = (int)blockIdx.x;
            pg8::EpiBf16 E{Y2, ND};
            pg8::gemm_phase<pg8::EpiBf16, pg8::MoeDownProb, true>(F.lds, P, E); } SEAM(pb + 12);
        if (IN(pb + 13)) { p_combine_ln2(F, X1B, Y2, (const int*)(ws + WS_SLOT), (const float*)(ws + WS_WSEL), kin(17) + l * ND, kin(18) + l * ND, l == 0 ? X2B : nullptr, l == 0 ? nullptr : F.out); } SEAM(pb + 13);
        SEAM(pb + 14); SEAM(pb + 15);
    }
__global__ void __launch_bounds__(NWAVES * 64, 2) mk_fwd(Args args) {
    extern __shared__ __attribute__((aligned(16))) unsigned char lds[];
    Frame F;
    F.lds = (LAS unsigned char*)lds;
    F.MISC = (volatile LAS unsigned*)(F.lds + MISC_OFF);
    F.tid = threadIdx.x; F.lane = F.tid & 63; F.wave = __builtin_amdgcn_readfirstlane(F.tid >> 6);
    F.G = gridDim.x; { const int bx = blockIdx.x; F.vcu = (F.G % 8 == 0) ? (bx % 8) * (F.G / 8) + bx / 8 : bx; }
    F.gw = F.vcu * NWAVES + F.wave; F.NGW = F.G * NWAVES;
    F.ws = args.ws; F.ctl = (unsigned*)(args.ws + WS_CTL); F.out = args.out;
    for (int u = F.tid; u < (LDS_BYTES - LDSCTL_OFF) / 4; u += NWAVES * 64) ((LAS unsigned*)(F.lds + LDSCTL_OFF))[u] = 0u;
    __syncthreads();
    XcdBarrier bar; bar.bar = F.ctl + CW_BAR; bar.x = 0; bar.st = nullptr;
    if (MK_ONE_LAUNCH) bar = xcd_barrier_post(F.ctl + CW_BAR, F.MISC + 8);
    const int lo = args.ph_lo, hi = args.ph_hi;
    unsigned char* ws = args.ws;
    bf16* const XB0 = (bf16*)(ws + WS_XB0); bf16* const X1B = (bf16*)(ws + WS_X1B); bf16* const X2B = (bf16*)(ws + WS_X2B);
    bf16* const PROJ = (bf16*)(ws + WS_PROJ); bf16* const MIXIN = (bf16*)(ws + WS_MIXIN); bf16* const MIXO = (bf16*)(ws + WS_MIXO);
    bf16* const HB = (bf16*)(ws + WS_H); bf16* const Y2 = (bf16*)(ws + WS_Y2);

    if (IN(0)) { p_prologue(F); } SEAM(0);

    layer_body<0>(F, bar, lo, hi);
    layer_body<1>(F, bar, lo, hi);
#undef IN
#undef SEAM
}

extern "C" void kernel_launch(void* const* d_in, const int* in_sizes, int n_in, void* d_out, int out_size, void* d_ws, size_t ws_size, hipStream_t stream) {
    static int grid = 0;
    if (grid == 0) {
        if (n_in != 27 || in_sizes[0] != NT * ND || out_size != NT * ND || ws_size < WS_END) { fprintf(stderr, "kernel_launch: unexpected problem (n_in %d, in0 %d, out %d, ws %zu < %zu); nothing launched\n", n_in, n_in > 0 ? in_sizes[0] : -1, out_size, ws_size, (size_t)WS_END); grid = -1; return; }
        int dev = 0, cus = 0, per_cu = 0;
        if (hipGetDevice(&dev) != hipSuccess || hipDeviceGetAttribute(&cus, hipDeviceAttributeMultiprocessorCount, dev) != hipSuccess) { fprintf(stderr, "kernel_launch: device query failed\n"); grid = -1; return; }
        if (hipFuncSetAttribute((const void*)mk_fwd, hipFuncAttributeMaxDynamicSharedMemorySize, LDS_BYTES) != hipSuccess) { fprintf(stderr, "kernel_launch: hipFuncSetAttribute failed\n"); grid = -1; return; }
        if (hipOccupancyMaxActiveBlocksPerMultiprocessor(&per_cu, (const void*)mk_fwd, NWAVES * 64, LDS_BYTES) != hipSuccess || per_cu < 1) fprintf(stderr, "kernel_launch: note: occupancy query reports %d\n", per_cu);
        (void)hipGetLastError();
        grid = cus;
    }
    if (grid < 0) return;
    if (hipMemsetAsync((char*)d_ws + WS_CTL, 0, CTL_ZERO_BYTES, stream) != hipSuccess) { fprintf(stderr, "kernel_launch: memset failed\n"); return; }
    Args a{};
    for (int i = 0; i < 27; ++i) a.in[i] = (const float*)d_in[i];
    a.out = (float*)d_out; a.ws = (unsigned char*)d_ws;
#if MK_ONE_LAUNCH
    a.ph_lo = 0; a.ph_hi = NPHASE;
    hipLaunchKernelGGL(mk_fwd, dim3(grid), dim3(NWAVES * 64), LDS_BYTES, stream, a);
#else
    for (int p = 0; p < NPHASE; ++p) {
        const int lp = (p - 1) & 15;
        if (p >= 1) { const int l = (p - 1) >> 4; if (lp >= 14) continue; if (l == 0 && lp >= 3 && lp <= 5) continue; }
        a.ph_lo = p; a.ph_hi = p + 1;
        hipLaunchKernelGGL(mk_fwd, dim3(grid), dim3(NWAVES * 64), LDS_BYTES, stream, a);
    }
#endif
    const hipError_t le = hipPeekAtLastError();
    if (le != hipSuccess) fprintf(stderr, "kernel_launch: launch failed: %s\n", hipGetErrorName(le));
}
```

```cpp
#include <hip/hip_runtime.h>
#include <cstdio>
#include <cstdint>

#ifndef MK_ONE_LAUNCH
#define MK_ONE_LAUNCH 1
#endif

#define GAS __attribute__((address_space(1)))
#define LAS __attribute__((address_space(3)))
typedef unsigned short bf16;
typedef unsigned v4u __attribute__((ext_vector_type(4)));
typedef unsigned v2u __attribute__((ext_vector_type(2)));
typedef float f32x4 __attribute__((ext_vector_type(4)));
typedef float f32x2 __attribute__((ext_vector_type(2)));
typedef short bf16x8 __attribute__((ext_vector_type(8)));

constexpr int NB = 8, NS = 2048, ND = 2048, NT = NB * NS;
constexpr float DN_ALPHA = 1.41421356237309505f;
constexpr float LN_EPS = 1e-5f, NORM_EPS = 1e-6f;
constexpr int AB_IN = 5120, CD_IN = 3544, CD_INP = 3584;
constexpr int NEXP = 64, EFF = 512;
constexpr int MAXROWS = NT * 8 + NEXP * 256;
constexpr int MAXTILES = MAXROWS / 256;
constexpr int SH_ROW0 = MAXROWS;

constexpr size_t MiB = 1u << 20;
constexpr size_t WS_CTL = 0, CTL_ZERO_BYTES = 1 * MiB;
constexpr size_t WS_TOPE = 1 * MiB, WS_WSEL = WS_TOPE + 512 * 1024, WS_SLOT = 2 * MiB, WS_SORTED = WS_SLOT + 512 * 1024;
constexpr size_t WS_CMPB = 3 * MiB + 256 * 1024, WS_SELM = 3 * MiB + 512 * 1024;
constexpr size_t WS_KVCMP = 4 * MiB;
constexpr size_t WS_HID = 6 * MiB;
constexpr size_t WS_WABIN = 16 * MiB, WS_WABOUT = 36 * MiB, WS_WCDIN = 44 * MiB, WS_WCDOUT = 58 * MiB, WS_WUQ = 66 * MiB, WS_WUKV = 68 * MiB, WS_CW1 = 70 * MiB, WS_RT = 72 * MiB;
constexpr size_t WS_W13 = 74 * MiB, WS_W2 = 334 * MiB, WS_MOE_LSTRIDE = 390 * MiB;
constexpr size_t WS_XB0 = 854 * MiB, WS_X2B = 854 * MiB, WS_X1B = 918 * MiB;
constexpr size_t WS_H = 982 * MiB, WS_Y2 = 1142 * MiB, WS_END = 1782 * MiB;
constexpr size_t WS_PROJ = 982 * MiB, WS_MIXIN = 1142 * MiB, WS_MIXO = 1206 * MiB;
constexpr size_t WS_QR = 1270 * MiB, WS_KR = 1294 * MiB;
constexpr size_t WS_CQN = 1270 * MiB, WS_CKVN = 1282 * MiB, WS_KROT = 1298 * MiB, WS_QMLA = 1302 * MiB, WS_KVU = 1350 * MiB, WS_CMPKV = 1414 * MiB, WS_OCMP = 1434 * MiB;
constexpr size_t WS_LOGITS = 1142 * MiB;
constexpr int CW_TMO = 0, CW_CODE = 1, CW_BAR = 4096, CW_CNT = 16384;

constexpr int RING_BYTES = 131072, LDSCTL_OFF = RING_BYTES, MISC_OFF = LDSCTL_OFF + 320, TAB_OFF = LDSCTL_OFF + 512;
constexpr int LDS_BYTES = 147456;
constexpr int NWAVES = 8;

#define LDS_WAIT() asm volatile("s_waitcnt lgkmcnt(0)" ::: "memory")
#define VM_WAIT() asm volatile("s_waitcnt vmcnt(0)" ::: "memory")
__device__ __forceinline__ unsigned f2bf(float f) { unsigned u = __builtin_bit_cast(unsigned, f); return (u + 0x7fffu + ((u >> 16) & 1u)) >> 16; }
__device__ __forceinline__ unsigned pk2(float lo, float hi) { return f2bf(lo) | (f2bf(hi) << 16); }
__device__ __forceinline__ float bflo(unsigned w) { return __builtin_bit_cast(float, w << 16); }
__device__ __forceinline__ float bfhi(unsigned w) { return __builtin_bit_cast(float, w & 0xffff0000u); }
__device__ __forceinline__ float bf1(bf16 v) { return __builtin_bit_cast(float, ((unsigned)v) << 16); }
__device__ __forceinline__ float wave_sum(float v) {
#pragma unroll
    for (int o = 1; o < 64; o <<= 1) v += __shfl_xor(v, o);
    return v;
}
__device__ __forceinline__ float wave_max(float v) {
#pragma unroll
    for (int o = 1; o < 64; o <<= 1) v = fmaxf(v, __shfl_xor(v, o));
    return v;
}
__device__ __forceinline__ float sigmoidf_(float x) { return 1.0f / (1.0f + __expf(-x)); }
__device__ __forceinline__ float siluf_(float x) { return x / (1.0f + __expf(-x)); }
__device__ __forceinline__ void unpack8(const v4u w, float (&f)[8]) {
    f[0] = bflo(w.x); f[1] = bfhi(w.x); f[2] = bflo(w.y); f[3] = bfhi(w.y); f[4] = bflo(w.z); f[5] = bfhi(w.z); f[6] = bflo(w.w); f[7] = bfhi(w.w);
}

#define XB_TMO      128
#define XB_XCNT(j)  (256  + 64 * (j))
#define XB_XSUB(j)  (1280 + 64 * (j))
#define XB_XGEN(j)  (2304 + 64 * (j))
#define XB_TOP      3328
#define XB_TOPGEN   3392
#define XCD_BAR_WORDS 3456
#define XB_SPIN_CAP (1u << 18)
__device__ __forceinline__ unsigned xb_ld(unsigned* p)              { return __hip_atomic_load(p, __ATOMIC_RELAXED, __HIP_MEMORY_SCOPE_AGENT); }
__device__ __forceinline__ unsigned xb_add(unsigned* p, unsigned v) { return __hip_atomic_fetch_add(p, v, __ATOMIC_RELAXED, __HIP_MEMORY_SCOPE_AGENT); }
__device__ __forceinline__ unsigned xb_xcc_id() { return (unsigned)__builtin_amdgcn_s_getreg((3 << 11) | 20) & 0xFu; }
#define XB_SPIN(cond, bar) do { unsigned _sp = 0; while (cond) { __builtin_amdgcn_s_sleep(1); \
    if ((++_sp & 255u) == 0u) { if (xb_ld(&(bar)[XB_TMO])) break; if (_sp > XB_SPIN_CAP) { atomicAdd(&(bar)[XB_TMO], 1u); break; } } } } while (0)
struct XcdBarrier { unsigned* bar; unsigned x; volatile LAS unsigned* st; };
__device__ __forceinline__ XcdBarrier xcd_barrier_post(unsigned* bar, volatile LAS unsigned* st) {
    XcdBarrier b; b.bar = bar; b.x = xb_xcc_id(); b.st = st;
    if (threadIdx.x == 0) (void)xb_add(&bar[XB_XCNT(b.x)], 1u);
    return b;
}
__device__ __forceinline__ void xcd_barrier_complete(unsigned* bar, unsigned x, unsigned& nloc, unsigned& nx) {
    const unsigned G = gridDim.x * gridDim.y * gridDim.z;
    unsigned sum, cnt, mine, sp = 0u;
    for (;;) {
        sum = 0u; cnt = 0u; mine = 0u;
#pragma unroll
        for (unsigned j = 0; j < 16; ++j) { const unsigned c = xb_ld(&bar[XB_XCNT(j)]); sum += c; cnt += (c > 0u) ? 1u : 0u; mine = (j == x) ? c : mine; }
        if (sum == G) break;
        __builtin_amdgcn_s_sleep(1);
        if ((++sp & 255u) == 0u) { if (xb_ld(&bar[XB_TMO])) break; if (sp > XB_SPIN_CAP) { atomicAdd(&bar[XB_TMO], 1u); break; } }
    }
    nloc = mine > 0u ? mine : 1u; nx = cnt > 0u ? cnt : 1u;
}
__device__ __forceinline__ void xcd_barrier(const XcdBarrier& b) {
    asm volatile("s_waitcnt vmcnt(0)" ::: "memory");
    __syncthreads();
    if (threadIdx.x == 0) {
        unsigned* bar = b.bar;
        __builtin_amdgcn_s_waitcnt(0);
        unsigned nloc = b.st[0], nx = b.st[1];
        if (nloc == 0u) { xcd_barrier_complete(bar, b.x, nloc, nx); b.st[0] = nloc; b.st[1] = nx; }
        const unsigned old = xb_add(&bar[XB_XSUB(b.x)], 1u);
        const unsigned gen = old / nloc;
        if (old + 1u == (gen + 1u) * nloc) {
            __builtin_amdgcn_fence(__ATOMIC_RELEASE, "agent");
            asm volatile("s_waitcnt vmcnt(0)" ::: "memory");
            const unsigned og = xb_add(&bar[XB_TOP], 1u);
            const unsigned tg = og / nx;
            if (og + 1u == (tg + 1u) * nx) xb_add(&bar[XB_TOPGEN], 1u);
            else XB_SPIN(xb_ld(&bar[XB_TOPGEN]) == tg, bar);
            __builtin_amdgcn_fence(__ATOMIC_ACQUIRE, "agent");
            xb_add(&bar[XB_XGEN(b.x)], 1u);
            asm volatile("s_waitcnt vmcnt(0)" ::: "memory");
        } else {
            XB_SPIN(xb_ld(&bar[XB_XGEN(b.x)]) == gen, bar);
            __builtin_amdgcn_fence(__ATOMIC_ACQUIRE, "agent");
            asm volatile("s_waitcnt vmcnt(0)" ::: "memory");
        }
    }
    __syncthreads();
}

namespace pg8 {
constexpr int BM = 256, BK = 64, HALF = 128, HTB = HALF * BK * 2, STAGE_BYTES = 8 * HTB, NXCD = 8, WGM = 8;
__host__ __device__ __forceinline__ int lds_byte(int r, int c) { const int st = (r >> 4) * 2 + (c >> 5), rr = r & 15, cc = c & 31, ob = rr * 64 + cc * 2; return st * 1024 + (ob ^ (((ob >> 9) & 1) << 5)); }
__host__ __device__ __forceinline__ void stage_rc(int b, int& R, int& C) { const int st = b / 1024, sb = b % 1024, swz = sb ^ (((sb >> 9) & 1) << 5); R = (st >> 1) * 16 + swz / 64; C = (st & 1) * 32 + (swz % 64) / 2; }
__host__ __device__ __forceinline__ int perm32(int rho) { const int n = rho >> 4, i = rho & 15; return 8 * (i >> 2) + 4 * n + (i & 3); }
struct Unit { int pm, pn, e; };

__device__ __forceinline__ unsigned cvt_pk_bf16(float lo, float hi) { unsigned r; asm volatile("v_cvt_pk_bf16_f32 %0, %1, %2" : "=v"(r) : "v"(lo), "v"(hi)); return r; }

struct EpiBf16 {
    static constexpr bool PERM = true;
    bf16* O; int ldc;
    __device__ __forceinline__ void operator()(const f32x4 (&acc)[2][2][4][2], const Unit& u, int wr, int wc, int fr, int fq) const {
        const int row0 = u.pm * BM + wr * 64 + fr, col0 = u.pn * BM + wc * 32 + 8 * fq;
#pragma unroll
        for (int ai = 0; ai < 2; ++ai)
#pragma unroll
            for (int m = 0; m < 4; ++m) { bf16* rowp = O + (size_t)(row0 + ai * HALF + m * 16) * ldc + col0;
#pragma unroll
                for (int bj = 0; bj < 2; ++bj) { const f32x4 v0 = acc[ai][bj][m][0], v1 = acc[ai][bj][m][1];
                    v4u w; w.x = cvt_pk_bf16(v0[0], v0[1]); w.y = cvt_pk_bf16(v0[2], v0[3]); w.z = cvt_pk_bf16(v1[0], v1[1]); w.w = cvt_pk_bf16(v1[2], v1[3]);
                    *(v4u*)(rowp + bj * HALF) = w; } }
    }
};
struct EpiF32 {
    static constexpr bool PERM = false;
    float* C; int ldc; const float* bias;
    __device__ __forceinline__ void operator()(const f32x4 (&acc)[2][2][4][2], const Unit& u, int wr, int wc, int fr, int fq) const {
        const int row0 = u.pm * BM + wr * 64 + fr, col0 = u.pn * BM + wc * 32 + 4 * fq;
        f32x4 bv[2][2];
#pragma unroll
        for (int bj = 0; bj < 2; ++bj)
#pragma unroll
            for (int n = 0; n < 2; ++n) bv[bj][n] = bias ? *(const f32x4*)(bias + col0 + bj * HALF + n * 16) : (f32x4){0.f, 0.f, 0.f, 0.f};
#pragma unroll
        for (int ai = 0; ai < 2; ++ai)
#pragma unroll
            for (int m = 0; m < 4; ++m) { float* rowp = C + (size_t)(row0 + ai * HALF + m * 16) * ldc + col0;
#pragma unroll
                for (int bj = 0; bj < 2; ++bj)
#pragma unroll
                    for (int n = 0; n < 2; ++n) *(f32x4*)(rowp + bj * HALF + n * 16) = acc[ai][bj][m][n] + bv[bj][n]; }
    }
};
struct EpiSwiglu {
    static constexpr bool PERM = true;
    bf16* H;
    __device__ __forceinline__ void operator()(const f32x4 (&acc)[2][2][4][2], const Unit& u, int wr, int wc, int fr, int fq) const {
        const int row0 = u.pm * BM + wr * 64 + fr, col0 = u.pn * HALF + wc * 32 + 8 * fq;
#pragma unroll
        for (int ai = 0; ai < 2; ++ai)
#pragma unroll
            for (int m = 0; m < 4; ++m) { bf16* rowp = H + (size_t)(row0 + ai * HALF + m * 16) * EFF + col0;
                float o[8];
#pragma unroll
                for (int n = 0; n < 2; ++n)
#pragma unroll
                    for (int j = 0; j < 4; ++j) { const float h1 = acc[ai][0][m][n][j], h3 = acc[ai][1][m][n][j]; o[n * 4 + j] = siluf_(h1) * h3; }
                v4u w; w.x = cvt_pk_bf16(o[0], o[1]); w.y = cvt_pk_bf16(o[2], o[3]); w.z = cvt_pk_bf16(o[4], o[5]); w.w = cvt_pk_bf16(o[6], o[7]);
                *(v4u*)rowp = w; }
    }
};

template <class Epi, class Prob, bool ALIGN_EPI>
__device__ __forceinline__ void gemm_phase(LAS unsigned char* lds, const Prob& P, const Epi& E) {
    const int tid = threadIdx.x, wid = __builtin_amdgcn_readfirstlane(tid >> 6), lane = tid & 63, wr = wid >> 2, wc = wid & 3, fr = lane & 15, fq = lane >> 4;
    const int K = P.K, nt = K / BK;
    int RA[2], CA[2]; unsigned voffB[2];
#pragma unroll
    for (int i = 0; i < 2; ++i) { int R, C; stage_rc(tid * 16 + i * 8192, R, C); const int Rb = Epi::PERM ? ((R & ~31) + perm32(R & 31)) : R;
        RA[i] = R; CA[i] = C; voffB[i] = (unsigned)(Rb * K + C) * 2u; }
    const size_t kstep = (size_t)(BK * 2);
    const size_t hstep = (size_t)HALF * K * 2;
    const unsigned ldsw = (unsigned)wid * 1024u;
    const int aoff = lds_byte(wr * 64 + fr, fq * 8), boff = lds_byte(wc * 32 + fr, fq * 8);
    const char* const Ab = P.Abase;
#define PG8_SA(b, h) (((b) * 2 + (h)) * HTB)
#define PG8_SB(b, h) ((4 + (b) * 2 + (h)) * HTB)
#define PG8_STAGE(bufoff, gbase, voff) do { _Pragma("unroll") for (int _i = 0; _i < 2; ++_i) \
        __builtin_amdgcn_global_load_lds((const unsigned*)((const char*)(gbase) + (voff)[_i]), (LAS unsigned*)(lds + (bufoff) + ldsw + _i * 8192), 16, 0, 0); } while (0)
#define PG8_STAGE_A(bufoff, kb, o0, o1) do { \
        __builtin_amdgcn_global_load_lds((const unsigned*)(Ab + (kb) + (o0)), (LAS unsigned*)(lds + (bufoff) + ldsw), 16, 0, 0); \
        __builtin_amdgcn_global_load_lds((const unsigned*)(Ab + (kb) + (o1)), (LAS unsigned*)(lds + (bufoff) + ldsw + 8192), 16, 0, 0); } while (0)
#define PG8_LDA(dst, b, h) do { _Pragma("unroll") for (int m = 0; m < 4; ++m) _Pragma("unroll") for (int k = 0; k < 2; ++k) dst[m][k] = *(const LAS bf16x8*)(lds + PG8_SA(b, h) + aoff + m * 2048 + k * 1024); } while (0)
#define PG8_LDB(dst, b, h) do { _Pragma("unroll") for (int n = 0; n < 2; ++n) _Pragma("unroll") for (int k = 0; k < 2; ++k) dst[n][k] = *(const LAS bf16x8*)(lds + PG8_SB(b, h) + boff + n * 2048 + k * 1024); } while (0)
#define PG8_MMA(ai, bj, At, Bt) do { __builtin_amdgcn_s_setprio(1); _Pragma("unroll") for (int m = 0; m < 4; ++m) _Pragma("unroll") for (int n = 0; n < 2; ++n) _Pragma("unroll") for (int k = 0; k < 2; ++k) \
        acc[ai][bj][m][n] = __builtin_amdgcn_mfma_f32_16x16x32_bf16(Bt[n][k], At[m][k], acc[ai][bj][m][n], 0, 0, 0); __builtin_amdgcn_s_setprio(0); } while (0)
#define PG8_WAIT_V(n) asm volatile("s_waitcnt vmcnt(" #n ")" ::: "memory")
#define PG8_WAIT_L(n) asm volatile("s_waitcnt lgkmcnt(" #n ")" ::: "memory")
#define PG8_BAR __builtin_amdgcn_s_barrier()
#define PG8_SCHED __builtin_amdgcn_sched_barrier(0)
    Unit cur, nxt; int ui = 0;
    if (!P.next(0, cur)) return;
    f32x4 acc[2][2][4][2];
#pragma unroll
    for (int a = 0; a < 2; ++a)
#pragma unroll
        for (int b = 0; b < 2; ++b)
#pragma unroll
            for (int m = 0; m < 4; ++m)
#pragma unroll
                for (int n = 0; n < 2; ++n) acc[a][b][m][n] = (f32x4){0.f, 0.f, 0.f, 0.f};
    bf16x8 At[4][2], B0[2][2], B1[2][2];
    unsigned oc[4], on[4];
    P.aoffs(cur, RA, CA, oc);
    const char* cB = P.bbase(cur);
    PG8_STAGE(PG8_SB(0, 0), cB, voffB); PG8_STAGE(PG8_SB(0, 1), cB + hstep, voffB); PG8_STAGE_A(PG8_SA(0, 0), (size_t)0, oc[0], oc[1]); PG8_STAGE_A(PG8_SA(0, 1), (size_t)0, oc[2], oc[3]);
    if (wr == 1) PG8_BAR;
    PG8_WAIT_V(2); PG8_BAR;
    PG8_STAGE(PG8_SB(1, 0), cB + kstep, voffB); PG8_STAGE_A(PG8_SA(1, 0), kstep, oc[0], oc[1]); PG8_STAGE(PG8_SB(1, 1), cB + hstep + kstep, voffB);
    PG8_WAIT_V(6); PG8_BAR;
    for (;;) {
        const bool has_next = P.next(ui + 1, nxt);
        const char* nB = cB;
        if (has_next) { P.aoffs(nxt, RA, CA, on); nB = P.bbase(nxt); }
        else { on[0] = oc[0]; on[1] = oc[1]; on[2] = oc[2]; on[3] = oc[3]; }
        for (int t = 0; t < nt; t += 2) {
            const bool last = (t == nt - 2);
            const size_t kb1 = (size_t)(t + 1) * kstep;
            const size_t kb2 = last ? (size_t)0 : (size_t)(t + 2) * kstep, kb3 = kb2 + kstep;
            const char* b2 = last ? nB : cB + (size_t)(t + 2) * kstep; const char* b3 = b2 + kstep;
            const unsigned o20 = last ? on[0] : oc[0], o21 = last ? on[1] : oc[1], o22 = last ? on[2] : oc[2], o23 = last ? on[3] : oc[3];
            PG8_LDB(B0, 0, 0); PG8_LDB(B1, 0, 1); PG8_SCHED; PG8_LDA(At, 0, 0); PG8_STAGE_A(PG8_SA(1, 1), kb1, oc[2], oc[3]);
            PG8_WAIT_V(8); PG8_WAIT_L(0); PG8_BAR; PG8_MMA(0, 0, At, B0); PG8_MMA(0, 1, At, B1); PG8_BAR; PG8_SCHED;
            PG8_LDA(At, 0, 1); PG8_STAGE(PG8_SB(0, 0), b2, voffB); PG8_STAGE(PG8_SB(0, 1), b2 + hstep, voffB); PG8_STAGE_A(PG8_SA(0, 0), kb2, o20, o21);
            PG8_WAIT_V(8); PG8_WAIT_L(0); PG8_BAR; PG8_MMA(1, 0, At, B0); PG8_MMA(1, 1, At, B1); PG8_BAR; PG8_SCHED;
            PG8_LDB(B0, 1, 0); PG8_LDB(B1, 1, 1); PG8_SCHED; PG8_LDA(At, 1, 0); PG8_STAGE_A(PG8_SA(0, 1), kb2, o22, o23);
            PG8_WAIT_V(8); PG8_WAIT_L(0); PG8_BAR; PG8_MMA(0, 0, At, B0); PG8_MMA(0, 1, At, B1); PG8_BAR; PG8_SCHED;
            PG8_LDA(At, 1, 1); PG8_STAGE(PG8_SB(1, 0), b3, voffB); PG8_STAGE(PG8_SB(1, 1), b3 + hstep, voffB); PG8_STAGE_A(PG8_SA(1, 0), kb3, o20, o21);
            PG8_WAIT_V(8); PG8_WAIT_L(0); PG8_BAR; PG8_MMA(1, 0, At, B0); PG8_MMA(1, 1, At, B1); PG8_BAR; PG8_SCHED;
        }
        if constexpr (ALIGN_EPI) { if (wr == 0) PG8_BAR; }
        E(acc, cur, wr, wc, fr, fq);
        if (!has_next) break;
#pragma unroll
        for (int a = 0; a < 2; ++a)
#pragma unroll
            for (int b = 0; b < 2; ++b)
#pragma unroll
                for (int m = 0; m < 4; ++m)
#pragma unroll
                    for (int n = 0; n < 2; ++n) acc[a][b][m][n] = (f32x4){0.f, 0.f, 0.f, 0.f};
        cur = nxt; cB = nB; oc[0] = on[0]; oc[1] = on[1]; oc[2] = on[2]; oc[3] = on[3]; ++ui;
        if constexpr (ALIGN_EPI) { if (wr == 1) PG8_BAR; }
    }
    PG8_WAIT_V(0);
    if constexpr (!ALIGN_EPI) { if (wr == 0) PG8_BAR; }
    PG8_BAR;
#undef PG8_SA
#undef PG8_SB
#undef PG8_STAGE
#undef PG8_STAGE_A
#undef PG8_LDA
#undef PG8_LDB
#undef PG8_MMA
#undef PG8_WAIT_V
#undef PG8_WAIT_L
#undef PG8_BAR
#undef PG8_SCHED
}

struct DenseProb {
    int K; const char* Abase; const char* Bt; int lda; int nM, nN, nwg, G, c;
    __device__ __forceinline__ void init(const bf16* A, int lda_, const bf16* B, int M, int N, int K_, int G_, int c_) { Abase = (const char*)A; Bt = (const char*)B; lda = lda_; K = K_; nM = M / BM; nN = N / BM; nwg = nM * nN; G = G_; c = c_; }
    __device__ __forceinline__ bool next(int i, Unit& u) const {
        const long L = (long)i * G + c; if (L >= nwg) return false;
        int wgid = (int)L; { const int q = nwg / NXCD, r = nwg % NXCD, xcd = wgid % NXCD, off = wgid / NXCD; wgid = (xcd < r ? xcd * (q + 1) : r * (q + 1) + (xcd - r) * q) + off; }
        const int nig = WGM * nN, gid = wgid / nig, fm = gid * WGM, gsz = (nM - fm) < WGM ? (nM - fm) : WGM;
        u.pm = fm + ((wgid % nig) % gsz); u.pn = (wgid % nig) / gsz; u.e = 0; return true;
    }
    __device__ __forceinline__ const char* bbase(const Unit& u) const { return Bt + (size_t)u.pn * BM * K * 2; }
    __device__ __forceinline__ void aoffs(const Unit& u, const int (&R)[2], const int (&C)[2], unsigned (&o)[4]) const {
#pragma unroll
        for (int h = 0; h < 2; ++h)
#pragma unroll
            for (int i = 0; i < 2; ++i) o[2 * h + i] = (unsigned)(((size_t)(u.pm * BM + h * HALF + R[i]) * lda + C[i]) * 2);
    }
};
__device__ __forceinline__ bool xcd_range_unit(int i, int nunits, int G, int c, int& L) {
    const int x = c % NXCD, cc = c / NXCD, per = G / NXCD, q = nunits / NXCD, r = nunits % NXCD;
    const int start = x * q + (x < r ? x : r), cnt = q + (x < r ? 1 : 0), li = i * per + cc;
    if (li >= cnt) return false; L = start + li; return true;
}
struct MoeUpProb {
    int K; const char* Abase; const char* W13; const int* sorted; const LAS int* tile_e; int ntiles, nunits, G, c;
    __device__ __forceinline__ bool next(int i, Unit& u) const {
        int L; if (!xcd_range_unit(i, nunits, G, c, L)) return false;
        const int tile = L >> 2; u.pn = L & 3;
        if (tile < ntiles) { u.pm = tile; u.e = __builtin_amdgcn_readfirstlane(tile_e[tile]); } else { u.pm = MAXTILES + (tile - ntiles); u.e = NEXP; }
        return true;
    }
    __device__ __forceinline__ const char* bbase(const Unit& u) const { return W13 + ((size_t)u.e * 1024 + (size_t)u.pn * BM) * 2048 * 2; }
    __device__ __forceinline__ void aoffs(const Unit& u, const int (&R)[2], const int (&C)[2], unsigned (&o)[4]) const {
#pragma unroll
        for (int h = 0; h < 2; ++h)
#pragma unroll
            for (int i = 0; i < 2; ++i) { int row;
                if (u.e == NEXP) row = (u.pm - MAXTILES) * BM + h * HALF + R[i];
                else row = sorted[u.pm * BM + h * HALF + R[i]];
                o[2 * h + i] = (unsigned)(((size_t)row * 2048 + C[i]) * 2); }
    }
};
struct MoeDownProb {
    int K; const char* Abase; const char* W2; const LAS int* tile_e; int ntiles, nunits, G, c;
    __device__ __forceinline__ bool next(int i, Unit& u) const {
        int L; if (!xcd_range_unit(i, nunits, G, c, L)) return false;
        const int tile = L >> 3; u.pn = L & 7;
        if (tile < ntiles) { u.pm = tile; u.e = __builtin_amdgcn_readfirstlane(tile_e[tile]); } else { u.pm = MAXTILES + (tile - ntiles); u.e = NEXP; }
        return true;
    }
    __device__ __forceinline__ const char* bbase(const Unit& u) const { return W2 + ((size_t)u.e * 2048 + (size_t)u.pn * BM) * EFF * 2; }
    __device__ __forceinline__ void aoffs(const Unit& u, const int (&R)[2], const int (&C)[2], unsigned (&o)[4]) const {
#pragma unroll
        for (int h = 0; h < 2; ++h)
#pragma unroll
            for (int i = 0; i < 2; ++i) o[2 * h + i] = (unsigned)(((size_t)(u.pm * BM + h * HALF + R[i]) * EFF + C[i]) * 2);
    }
};
struct CmpProb {
    int K; const char* Abase; const char* Bt; int G, c;
    __device__ __forceinline__ bool next(int i, Unit& u) const { const int L = i * G + c; if (L >= 16) return false; u.pm = L; u.pn = 0; u.e = 0; return true; }
    __device__ __forceinline__ const char* bbase(const Unit&) const { return Bt; }
    __device__ __forceinline__ void aoffs(const Unit& u, const int (&R)[2], const int (&C)[2], unsigned (&o)[4]) const {
#pragma unroll
        for (int h = 0; h < 2; ++h)
#pragma unroll
            for (int i = 0; i < 2; ++i) { const int m = u.pm * BM + h * HALF + R[i], seq = m >> 7, n = m & 127;
                o[2 * h + i] = (unsigned)((((size_t)seq * NS + 16 * n) * 128 + C[i]) * 2); }
    }
};
}

struct Args { const float* in[27]; float* out; unsigned char* ws; int ph_lo, ph_hi; };
typedef const __attribute__((address_space(4))) Args* CArgs;
__device__ __forceinline__ const float* kin(int i) { CArgs p = (CArgs)__builtin_amdgcn_kernarg_segment_ptr(); asm volatile("" : "+s"(p)); return p->in[i]; }
struct Frame {
    LAS unsigned char* lds;
    volatile LAS unsigned* MISC;
    unsigned* ctl;
    unsigned char* ws;
    int tid, lane, wave, vcu, G, gw, NGW;
    float* out;
};

__device__ __forceinline__ void tr_item(const float* W, int ldw, int k0, int n0, int nvalid, bf16* WT, int ldt, int drow0, LAS float* scr, int lane) {
    float v[32]; const int n = lane & 31; const bool okn = n < nvalid; const float* src = W + (size_t)(k0 + (lane >> 5)) * ldw + n0 + n;
#pragma unroll
    for (int i = 0; i < 32; ++i) v[i] = okn ? src[(size_t)(2 * i) * ldw] : 0.f;
#pragma unroll
    for (int i = 0; i < 32; ++i) scr[(2 * i + (lane >> 5)) * 33 + n] = v[i];
    LDS_WAIT(); asm volatile("" ::: "memory");
    const int c = lane & 7;
#pragma unroll
    for (int j = 0; j < 4; ++j) { const int nn = (lane >> 3) + 8 * j; const LAS float* sp = scr + (8 * c) * 33 + nn;
        v4u o; o.x = pk2(sp[0 * 33], sp[1 * 33]); o.y = pk2(sp[2 * 33], sp[3 * 33]); o.z = pk2(sp[4 * 33], sp[5 * 33]); o.w = pk2(sp[6 * 33], sp[7 * 33]);
        if (nn < nvalid) *(v4u*)(WT + (size_t)(drow0 + nn) * ldt + k0 + 8 * c) = o; }
    LDS_WAIT(); asm volatile("" ::: "memory");
}
__device__ __forceinline__ bool tr_matrix(int& it, const float* W, int ldw, int K, int c0, int ncols, bf16* WT, int drow0, LAS float* scr, int lane) {
    const int nb = (ncols + 31) / 32, items = (K / 64) * nb;
    if (it >= items) { it -= items; return false; }
    const int kb = it / nb, b = it % nb, nv = ncols - 32 * b;
    tr_item(W, ldw, 64 * kb, c0 + 32 * b, nv < 32 ? nv : 32, WT, K, drow0 + 32 * b, scr, lane);
    return true;
}
__device__ __forceinline__ void zero_rows(Frame& F, bf16* base, size_t nelem) {
    for (size_t i = ((size_t)F.gw * 64 + F.lane) * 8; i < nelem; i += (size_t)F.NGW * 64 * 8) *(v4u*)(base + i) = (v4u){0u, 0u, 0u, 0u};
}

__device__ __forceinline__ void p_prologue(Frame& F) {
    LAS float* scr = (LAS float*)(F.lds + F.wave * 16384);
    unsigned char* ws = F.ws;
    {
        LAS float* wl = (LAS float*)F.lds;
        LAS float* pl = (LAS float*)(F.lds + 32768);
        const float* w_in = kin(2); const float* pool_w = kin(3); const float* pscale = kin(4);
        bf16* WT = (bf16*)(ws + WS_WABIN);
        for (int it = blockIdx.x; it < 4 * 32; it += F.G) {
            const int g = it >> 5, k0 = (it & 31) * 64;
            for (int i = F.tid; i < 64 * 128; i += 512) wl[i] = w_in[(size_t)(k0 + (i >> 7)) * AB_IN + g * 128 + (i & 127)];
            for (int i = F.tid; i < 128 * 128; i += 512) pl[i] = pool_w[(size_t)g * 16384 + i];
            __syncthreads();
            const int d = F.tid & 127, kg = F.tid >> 7; const float sc = pscale[g * 128 + d];
            for (int kk = 0; kk < 16; kk += 8) {
                float a[8];
#pragma unroll
                for (int j = 0; j < 8; ++j) a[j] = 0.f;
                for (int c = 0; c < 128; ++c) { const float pw = pl[c * 128 + d];
#pragma unroll
                    for (int j = 0; j < 8; ++j) a[j] += wl[(kg * 16 + kk + j) * 128 + c] * pw; }
                v4u o; o.x = pk2(a[0] * sc, a[1] * sc); o.y = pk2(a[2] * sc, a[3] * sc); o.z = pk2(a[4] * sc, a[5] * sc); o.w = pk2(a[6] * sc, a[7] * sc);
                *(v4u*)(WT + (size_t)(g * 128 + d) * ND + k0 + kg * 16 + kk) = o;
            }
            __syncthreads();
        }
    }
    __syncthreads();
    for (int it0 = F.gw; ; it0 += F.NGW) {
        int it = it0;
        if (tr_matrix(it, kin(2), AB_IN, ND, 512, AB_IN - 512, (bf16*)(ws + WS_WABIN), 512, scr, F.lane)) continue;
        if (tr_matrix(it, kin(5), ND, ND, 0, ND, (bf16*)(ws + WS_WABOUT), 0, scr, F.lane)) continue;
        if (tr_matrix(it, kin(6), CD_IN, ND, 0, CD_IN, (bf16*)(ws + WS_WCDIN), 0, scr, F.lane)) continue;
        if (tr_matrix(it, kin(14), ND, ND, 0, ND, (bf16*)(ws + WS_WCDOUT), 0, scr, F.lane)) continue;
        if (tr_matrix(it, kin(11), 1536, 384, 0, 1536, (bf16*)(ws + WS_WUQ), 0, scr, F.lane)) continue;
        if (tr_matrix(it, kin(13), 2048, 512, 0, 2048, (bf16*)(ws + WS_WUKV), 0, scr, F.lane)) continue;
        if (tr_matrix(it, kin(8), 128, 4096, 0, 128, (bf16*)(ws + WS_CW1), 0, scr, F.lane)) continue;
        if (tr_matrix(it, kin(8) + (size_t)4096 * 128, 128, 4096, 0, 128, (bf16*)(ws + WS_CW1), 128, scr, F.lane)) continue;
        break;
    }
    zero_rows(F, (bf16*)(ws + WS_WCDIN) + (size_t)CD_IN * ND, (size_t)(CD_INP - CD_IN) * ND);
    { const float* x = kin(0); bf16* xb = (bf16*)(ws + WS_XB0);
      for (size_t i = ((size_t)F.gw * 64 + F.lane) * 8; i < (size_t)NT * ND; i += (size_t)F.NGW * 64 * 8) {
          const f32x4 a = *(const f32x4*)(x + i), b = *(const f32x4*)(x + i + 4);
          v4u o; o.x = pk2(a[0], a[1]); o.y = pk2(a[2], a[3]); o.z = pk2(b[0], b[1]); o.w = pk2(b[2], b[3]); *(v4u*)(xb + i) = o; } }
    if (blockIdx.x == 0 && F.tid < 256) { const int kv = F.tid >> 7, h = F.tid & 127; const float* pos = kin(7) + (size_t)kv * 4096; const float* w1 = kin(8) + (size_t)kv * 4096 * 128;
        float s = 0.f; for (int f = 0; f < 4096; ++f) s += pos[f] * w1[(size_t)f * 128 + h];
        ((float*)(ws + WS_CMPB))[F.tid] = s; }
}
constexpr int MW_ITEMS_L = 65 * 1536 + 64;
__device__ __forceinline__ void moe_weight_item(int l, int it, unsigned char* ws, LAS float* scr, int lane) {
    bf16* W13 = (bf16*)(ws + WS_W13 + (size_t)l * WS_MOE_LSTRIDE); bf16* W2 = (bf16*)(ws + WS_W2 + (size_t)l * WS_MOE_LSTRIDE); bf16* RT = (bf16*)(ws + WS_RT + (size_t)l * MiB);
    if (it >= 65 * 1536) { const int r = it - 65 * 1536, kb = r >> 1, b = r & 1;
        tr_item(kin(19) + (size_t)l * ND * NEXP, NEXP, 64 * kb, 32 * b, 32, RT, ND, 32 * b, scr, lane); return; }
    const int e = it / 1536, r = it % 1536;
    const float *w1, *w3, *w2;
    if (e < NEXP) { const size_t o = ((size_t)l * NEXP + e) * ND * EFF; w1 = kin(21) + o; w3 = kin(22) + o; w2 = kin(23) + o; }
    else { const size_t o = (size_t)l * ND * EFF; w1 = kin(24) + o; w3 = kin(25) + o; w2 = kin(26) + o; }
    if (r < 1024) { const int which = r >> 9, rr = r & 511, kb = rr >> 4, nb = rr & 15;
        const int j = nb >> 2, drow = j * 256 + which * 128 + (nb & 3) * 32;
        tr_item(which ? w3 : w1, EFF, 64 * kb, 32 * nb, 32, W13 + (size_t)e * 1024 * ND, ND, drow, scr, lane); }
    else { const int rr = r - 1024, kb = rr >> 6, nb = rr & 63;
        tr_item(w2, ND, 64 * kb, 32 * nb, 32, W2 + (size_t)e * ND * EFF, EFF, 32 * nb, scr, lane); }
}
__device__ __forceinline__ void p_moe_weights_queue(Frame& F, unsigned* queue) {
    LAS float* scr = (LAS float*)(F.lds + F.wave * 16384);
    constexpr int BATCH = 16, NB_ = (2 * MW_ITEMS_L + BATCH - 1) / BATCH;
    for (;;) {
        unsigned bq = 0; if (F.lane == 0) bq = atomicAdd(queue, 1u);
        const int bi = __builtin_amdgcn_readfirstlane((int)bq);
        if (bi >= NB_) break;
        for (int k = 0; k < BATCH; ++k) { const int it = bi * BATCH + k; if (it >= 2 * MW_ITEMS_L) break; const int l = it >= MW_ITEMS_L ? 1 : 0; moe_weight_item(l, it - l * MW_ITEMS_L, F.ws, scr, F.lane); }
    }
    for (int l = 0; l < 2; ++l) zero_rows(F, (bf16*)(F.ws + WS_RT + (size_t)l * MiB) + (size_t)NEXP * ND, (size_t)(256 - NEXP) * ND);
}

__device__ __forceinline__ void ln_finish(float (&v)[4][8], const float* g, const float* b, int lane, bf16* ob, float* of) {
    float s = 0.f;
#pragma unroll
    for (int j = 0; j < 4; ++j)
#pragma unroll
        for (int i = 0; i < 8; ++i) s += v[j][i];
    const float mean = wave_sum(s) * (1.f / ND); float s2 = 0.f;
#pragma unroll
    for (int j = 0; j < 4; ++j)
#pragma unroll
        for (int i = 0; i < 8; ++i) { v[j][i] -= mean; s2 += v[j][i] * v[j][i]; }
    const float rstd = 1.f / sqrtf(wave_sum(s2) * (1.f / ND) + LN_EPS);
#pragma unroll
    for (int j = 0; j < 4; ++j) { const int c0 = (j * 64 + lane) * 8;
        const f32x4 g0 = *(const f32x4*)(g + c0), g1 = *(const f32x4*)(g + c0 + 4), b0 = *(const f32x4*)(b + c0), b1 = *(const f32x4*)(b + c0 + 4);
        float o[8];
#pragma unroll
        for (int i = 0; i < 4; ++i) { o[i] = v[j][i] * rstd * g0[i] + b0[i]; o[4 + i] = v[j][4 + i] * rstd * g1[i] + b1[i]; }
        if (ob) { v4u w; w.x = pk2(o[0], o[1]); w.y = pk2(o[2], o[3]); w.z = pk2(o[4], o[5]); w.w = pk2(o[6], o[7]); *(v4u*)(ob + c0) = w; }
        if (of) { *(f32x4*)(of + c0) = (f32x4){o[0], o[1], o[2], o[3]}; *(f32x4*)(of + c0 + 4) = (f32x4){o[4], o[5], o[6], o[7]}; } }
}
__device__ __forceinline__ void p_ln1(Frame& F, const bf16* xin, const bf16* mixo, const float* g, const float* b, bf16* xo) {
    for (int m = F.gw; m < NT; m += F.NGW) {
        float v[4][8];
#pragma unroll
        for (int j = 0; j < 4; ++j) { const size_t o = (size_t)m * ND + (j * 64 + F.lane) * 8; float a[8], c[8]; unpack8(*(const v4u*)(xin + o), a); unpack8(*(const v4u*)(mixo + o), c);
#pragma unroll
            for (int i = 0; i < 8; ++i) v[j][i] = DN_ALPHA * a[i] + c[i]; }
        ln_finish(v, g, b, F.lane, xo + (size_t)m * ND, nullptr);
    }
}
__device__ __forceinline__ void p_combine_ln2(Frame& F, const bf16* x1, const bf16* y2, const int* slot, const float* wsel, const float* g, const float* b, bf16* xo, float* fo) {
    for (int m = F.gw; m < NT; m += F.NGW) {
        float v[4][8];
#pragma unroll
        for (int j = 0; j < 4; ++j) { const size_t o = (size_t)m * ND + (j * 64 + F.lane) * 8; float a[8], c[8]; unpack8(*(const v4u*)(x1 + o), a);
            unpack8(*(const v4u*)(y2 + (size_t)(SH_ROW0 + m) * ND + (j * 64 + F.lane) * 8), c);
#pragma unroll
            for (int i = 0; i < 8; ++i) v[j][i] = DN_ALPHA * a[i] + c[i]; }
        for (int k = 0; k < 8; ++k) { const int row = slot[m * 8 + k]; const float w = wsel[m * 8 + k];
#pragma unroll
            for (int j = 0; j < 4; ++j) { float c[8]; unpack8(*(const v4u*)(y2 + (size_t)row * ND + (j * 64 + F.lane) * 8), c);
#pragma unroll
                for (int i = 0; i < 8; ++i) v[j][i] += w * c[i]; } }
        ln_finish(v, g, b, F.lane, xo ? xo + (size_t)m * ND : nullptr, fo ? fo + (size_t)m * ND : nullptr);
    }
}

__device__ __forceinline__ void p_pool_rope(Frame& F) {
    const bf16* proj = (const bf16*)(F.ws + WS_PROJ); bf16* mixin = (bf16*)(F.ws + WS_MIXIN); bf16* qr = (bf16*)(F.ws + WS_QR); bf16* kr = (bf16*)(F.ws + WS_KR);
    const int* pos = (const int*)kin(1);
    for (int m = F.gw; m < NT; m += F.NGW) {
        const int s = m & (NS - 1);
        { const int g = F.lane >> 4, w = 2 << g; const int lo = (s + 1 - w) > 0 ? (s + 1 - w) : 0; const float cnt = (float)((s + 1) < w ? (s + 1) : w);
          float acc[8], cur[8];
#pragma unroll
          for (int i = 0; i < 8; ++i) acc[i] = 0.f;
          for (int j = lo; j <= s; ++j) { float t[8]; unpack8(*(const v4u*)(proj + (size_t)(m - s + j) * AB_IN + F.lane * 8), t);
#pragma unroll
              for (int i = 0; i < 8; ++i) acc[i] += t[i]; }
          unpack8(*(const v4u*)(proj + (size_t)m * AB_IN + F.lane * 8), cur);
          float o[8];
#pragma unroll
          for (int i = 0; i < 8; ++i) o[i] = acc[i] / cnt - cur[i];
          v4u wv; wv.x = pk2(o[0], o[1]); wv.y = pk2(o[2], o[3]); wv.z = pk2(o[4], o[5]); wv.w = pk2(o[6], o[7]); *(v4u*)(mixin + (size_t)m * ND + F.lane * 8) = wv; }
        { const float p = (float)pos[m]; const float invf = exp2f(-(float)F.lane * (13.287712379549449f / 64.f));
          float sn, cs; sincosf(p * invf, &sn, &cs);
          const bf16* qrow = proj + (size_t)m * AB_IN + 512; const bf16* krow = proj + (size_t)m * AB_IN + 1280;
#pragma unroll
          for (int h = 0; h < 6; ++h) {
              const float q1 = bf1(qrow[h * 128 + F.lane]), q2 = bf1(qrow[h * 128 + 64 + F.lane]);
              qr[(size_t)m * 768 + h * 128 + F.lane] = (bf16)f2bf(q1 * cs - q2 * sn); qr[(size_t)m * 768 + h * 128 + 64 + F.lane] = (bf16)f2bf(q1 * sn + q2 * cs);
              const float k1 = bf1(krow[h * 128 + F.lane]), k2 = bf1(krow[h * 128 + 64 + F.lane]); const float ksc = 0.08838834764831845f;
              kr[(size_t)m * 768 + h * 128 + F.lane] = (bf16)f2bf((k1 * cs - k2 * sn) * ksc); kr[(size_t)m * 768 + h * 128 + 64 + F.lane] = (bf16)f2bf((k1 * sn + k2 * cs) * ksc);
          } }
    }
}
namespace ret {
typedef short v4i16_t __attribute__((ext_vector_type(4)));
constexpr int PITCH = 272, TILE = 128 * PITCH;
__device__ __forceinline__ bf16x8 trfrag(LAS unsigned char* trb, int r0, int r1, int c0) {
    const v4i16_t a = __builtin_amdgcn_ds_read_tr16_b64_v4i16((LAS v4i16_t*)(trb + r0 * PITCH + c0 * 2));
    const v4i16_t b = __builtin_amdgcn_ds_read_tr16_b64_v4i16((LAS v4i16_t*)(trb + r1 * PITCH + c0 * 2));
    return (bf16x8){a[0], a[1], a[2], a[3], b[0], b[1], b[2], b[3]};
}
}
__device__ __forceinline__ void p_retention_mfma(Frame& F, int bh) {
    const bf16* proj = (const bf16*)(F.ws + WS_PROJ); bf16* mixin = (bf16*)(F.ws + WS_MIXIN); const bf16* qr = (const bf16*)(F.ws + WS_QR); const bf16* kr = (const bf16*)(F.ws + WS_KR);
    constexpr int P = ret::PITCH;
    LAS unsigned char* KT = F.lds; LAS unsigned char* VT = F.lds + ret::TILE; LAS unsigned char* ST = F.lds + 2 * ret::TILE;
    const int b = bh / 6, h = bh % 6, w = F.wave, lane = F.lane, i16 = lane & 15, g = lane >> 4, q4 = (lane & 15) >> 2, p4 = lane & 3;
    const float lg = log2f(1.0f - exp2f(-5.0f - (float)h)), gc = exp2f(128.f * lg);
    const int rowb = i16 * P + 16 * g;
    const int trl = q4 * P + 8 * p4;
    LAS unsigned char* const trV4 = VT + trl + 4 * g * P;
    LAS unsigned char* const trV8 = VT + trl + 8 * g * P;
    LAS unsigned char* const trK8 = KT + trl + 8 * g * P;
    f32x4 T[2][8];
#pragma unroll
    for (int a = 0; a < 2; ++a)
#pragma unroll
        for (int d = 0; d < 8; ++d) T[a][d] = (f32x4){0.f, 0.f, 0.f, 0.f};
    const int srow = F.tid >> 2, scb = (F.tid & 3) * 4;
    for (int n = 0; n < NS / 128; ++n) {
        const size_t m0 = (size_t)b * NS + n * 128;
        { const float fk = exp2f(-(float)srow * lg);
#pragma unroll
          for (int c = 0; c < 4; ++c) { const int c8 = scb + c; float t[8];
              unpack8(*(const v4u*)(kr + (m0 + srow) * 768 + h * 128 + c8 * 8), t);
              v4u o; o.x = pk2(t[0] * fk, t[1] * fk); o.y = pk2(t[2] * fk, t[3] * fk); o.z = pk2(t[4] * fk, t[5] * fk); o.w = pk2(t[6] * fk, t[7] * fk); *(LAS v4u*)(KT + srow * P + c8 * 16) = o; } }
        bf16x8 qf[4], pf[4]; float rs[4] = {0.f, 0.f, 0.f, 0.f}, rq[4] = {0.f, 0.f, 0.f, 0.f};
        { const float fq = exp2f((float)(16 * w + i16) * lg);
#pragma unroll
          for (int ks = 0; ks < 4; ++ks) { float t[8]; unpack8(*(const v4u*)(qr + (m0 + 16 * w + i16) * 768 + h * 128 + 32 * ks + 8 * g), t);
              v4u o; o.x = pk2(t[0] * fq, t[1] * fq); o.y = pk2(t[2] * fq, t[3] * fq); o.z = pk2(t[4] * fq, t[5] * fq); o.w = pk2(t[6] * fq, t[7] * fq); qf[ks] = __builtin_bit_cast(bf16x8, o); } }
#pragma unroll
        for (int hv = 0; hv < 2; ++hv) {
            if (hv == 1) __syncthreads();
#pragma unroll
            for (int c = 0; c < 4; ++c) { const int c8 = scb + c; *(LAS v4u*)(VT + srow * P + c8 * 16) = *(const v4u*)(proj + (m0 + srow) * AB_IN + 2048 + h * 256 + hv * 128 + c8 * 8); }
            { LAS unsigned char* stw = ST + (16 * w + 4 * g) * P + i16 * 2;
#pragma unroll
              for (int dt = 0; dt < 8; ++dt)
#pragma unroll
                for (int r = 0; r < 4; ++r) { T[hv][dt][r] *= gc; *(LAS bf16*)(stw + r * P + dt * 32) = (bf16)f2bf(T[hv][dt][r]); } }
            __syncthreads();
            if (hv == 0) {
                f32x4 sc[8];
#pragma unroll
                for (int mt = 0; mt < 8; ++mt) { sc[mt] = (f32x4){0.f, 0.f, 0.f, 0.f};
                    if (mt <= w) {
#pragma unroll
                        for (int ks = 0; ks < 4; ++ks) { const bf16x8 kf = *(const LAS bf16x8*)(KT + rowb + mt * 16 * P + ks * 64); sc[mt] = __builtin_amdgcn_mfma_f32_16x16x32_bf16(kf, qf[ks], sc[mt], 0, 0, 0); }
                        if (mt == w) {
#pragma unroll
                            for (int r = 0; r < 4; ++r) sc[mt][r] = (4 * g + r <= i16) ? sc[mt][r] : 0.f; } } }
#pragma unroll
                for (int k2 = 0; k2 < 4; ++k2) { v4u wv; wv.x = pk2(sc[2 * k2][0], sc[2 * k2][1]); wv.y = pk2(sc[2 * k2][2], sc[2 * k2][3]); wv.z = pk2(sc[2 * k2 + 1][0], sc[2 * k2 + 1][1]); wv.w = pk2(sc[2 * k2 + 1][2], sc[2 * k2 + 1][3]);
                    pf[k2] = __builtin_bit_cast(bf16x8, wv); }
            }
#pragma unroll
            for (int nt = 0; nt < 8; ++nt) { f32x4 acc = (f32x4){0.f, 0.f, 0.f, 0.f};
#pragma unroll
                for (int k2 = 0; k2 < 4; ++k2) if (2 * k2 <= w) { const bf16x8 vf = ret::trfrag(trV4, 32 * k2, 32 * k2 + 16, 16 * nt); acc = __builtin_amdgcn_mfma_f32_16x16x32_bf16(pf[k2], vf, acc, 0, 0, 0); }
#pragma unroll
                for (int ks = 0; ks < 4; ++ks) { const bf16x8 sf = *(const LAS bf16x8*)(ST + rowb + nt * 16 * P + ks * 64); acc = __builtin_amdgcn_mfma_f32_16x16x32_bf16(qf[ks], sf, acc, 0, 0, 0); }
#pragma unroll
                for (int r = 0; r < 4; ++r) { rs[r] += acc[r]; rq[r] += acc[r] * acc[r]; mixin[(m0 + 16 * w + 4 * g + r) * ND + 512 + h * 256 + hv * 128 + 16 * nt + i16] = (bf16)f2bf(acc[r]); } }
#pragma unroll
            for (int ks = 0; ks < 4; ++ks) { const bf16x8 af = ret::trfrag(trV8, 32 * ks, 32 * ks + 4, 16 * w);
#pragma unroll
                for (int dt = 0; dt < 8; ++dt) { const bf16x8 bfr = ret::trfrag(trK8, 32 * ks, 32 * ks + 4, 16 * dt); T[hv][dt] = __builtin_amdgcn_mfma_f32_16x16x32_bf16(af, bfr, T[hv][dt], 0, 0, 0); } }
        }
#pragma unroll
        for (int r = 0; r < 4; ++r) { float sm = rs[r], s2 = rq[r];
            sm += __shfl_xor(sm, 1); sm += __shfl_xor(sm, 2); sm += __shfl_xor(sm, 4); sm += __shfl_xor(sm, 8);
            s2 += __shfl_xor(s2, 1); s2 += __shfl_xor(s2, 2); s2 += __shfl_xor(s2, 4); s2 += __shfl_xor(s2, 8);
            const float mean = sm * (1.f / 256.f); const float var = fmaxf(s2 * (1.f / 256.f) - mean * mean, 0.f);
            const float rstd = 1.f / sqrtf(var + NORM_EPS);
            const size_t m = m0 + 16 * w + 4 * g + r;
#pragma unroll
            for (int t = 0; t < 16; ++t) { bf16* yp = mixin + m * ND + 512 + h * 256 + 16 * t + i16; const float gt = bf1(proj[m * AB_IN + 3584 + h * 256 + 16 * t + i16]);
                *yp = (bf16)f2bf((bf1(*yp) - mean) * rstd * siluf_(gt)); } }
        __syncthreads();
    }
}

__device__ __forceinline__ void p_route(Frame& F, int l) {
    const float* logits = (const float*)(F.ws + WS_LOGITS); const float* rbias = kin(20) + l * NEXP;
    int* tope = (int*)(F.ws + WS_TOPE); float* wsel = (float*)(F.ws + WS_WSEL); int* posb = (int*)(F.ws + WS_SLOT); unsigned* cnt = F.ctl + CW_CNT + l * 64;
    const float bias = rbias[F.lane];
    for (int m = F.gw; m < NT; m += F.NGW) {
        const float sc = sigmoidf_(logits[(size_t)m * 256 + F.lane]), bi = sc + bias;
        const int grp = F.lane >> 3;
        int rk = 0;
#pragma unroll
        for (int j = 1; j < 8; ++j) { const int o = (F.lane & ~7) | ((F.lane + j) & 7); const float ov = __shfl(bi, o); rk += ((ov > bi) || (ov == bi && o < F.lane)) ? 1 : 0; }
        float gs = rk < 2 ? bi : 0.f; gs += __shfl_xor(gs, 1); gs += __shfl_xor(gs, 2); gs += __shfl_xor(gs, 4);
        int grk = 0;
#pragma unroll
        for (int gg = 0; gg < 8; ++gg) { const float ov = __shfl(gs, gg * 8); grk += (gg != grp && ((ov > gs) || (ov == gs && gg < grp))) ? 1 : 0; }
        const float mv = grk < 4 ? bi : -1e30f;
        int erk = 0;
        for (int j = 0; j < 64; ++j) { const float ov = __shfl(mv, j); erk += ((ov > mv) || (ov == mv && j < F.lane)) ? 1 : 0; }
        const bool sel = erk < 8;
        const float wsum = wave_sum(sel ? sc : 0.f);
        if (sel) { const unsigned p = atomicAdd(&cnt[F.lane], 1u); tope[m * 8 + erk] = F.lane; wsel[m * 8 + erk] = sc / wsum * 2.5f; posb[m * 8 + erk] = (int)p; }
    }
}
__device__ __forceinline__ void load_offsets(Frame& F, int l) {
    volatile LAS int* tab = (volatile LAS int*)(F.lds + TAB_OFF);
    __syncthreads();
    if (F.tid < NEXP) tab[66 + F.tid] = (int)__hip_atomic_load(F.ctl + CW_CNT + l * 64 + F.tid, __ATOMIC_RELAXED, __HIP_MEMORY_SCOPE_AGENT);
    __syncthreads();
    if (F.tid == 0) { int o = 0; for (int e = 0; e < NEXP; ++e) { tab[e] = o; int c = tab[66 + e]; if (c > NT) c = NT; const int nt_ = (c + 255) >> 8; for (int t = 0; t < nt_; ++t) { const int ti = (o >> 8) + t; if (ti < MAXTILES) tab[160 + ti] = e; } o += nt_ << 8; if (o > MAXROWS) o = MAXROWS; }
        tab[64] = o; tab[65] = o >> 8; }
    __syncthreads();
}
__device__ __forceinline__ void p_scatter(Frame& F, int l) {
    load_offsets(F, l);
    const LAS int* tab = (const LAS int*)(F.lds + TAB_OFF);
    const int* tope = (const int*)(F.ws + WS_TOPE); int* slot = (int*)(F.ws + WS_SLOT); int* sorted = (int*)(F.ws + WS_SORTED);
    for (int i = F.gw * 64 + F.lane; i < NT * 8; i += F.NGW * 64) { const int e = tope[i]; const int row = tab[e] + slot[i]; sorted[row] = i >> 3; slot[i] = row; }
    for (int i = F.gw * 64 + F.lane; i < NEXP * 256; i += F.NGW * 64) { const int e = i >> 8, j = i & 255; const int r = tab[e] + tab[66 + e] + j; if (r < tab[e + 1]) sorted[r] = 0; }
}

__device__ __forceinline__ void p_l1_thin_a(Frame& F) {
    const bf16* proj = (const bf16*)(F.ws + WS_PROJ); const int* pos = (const int*)kin(1);
    bf16* cqn = (bf16*)(F.ws + WS_CQN); bf16* ckvn = (bf16*)(F.ws + WS_CKVN); bf16* krot = (bf16*)(F.ws + WS_KROT); bf16* cmpkv = (bf16*)(F.ws + WS_CMPKV);
    const float* qn = kin(10); const float* kvn = kin(12);
    for (int m = F.gw; m < NT; m += F.NGW) {
        const bf16* row = proj + (size_t)m * CD_INP;
        { float x[6]; float s = 0.f;
#pragma unroll
          for (int j = 0; j < 6; ++j) { x[j] = bf1(row[2584 + j * 64 + F.lane]); s += x[j] * x[j]; }
          const float r = 1.f / sqrtf(wave_sum(s) * (1.f / 384.f) + NORM_EPS);
#pragma unroll
          for (int j = 0; j < 6; ++j) cqn[(size_t)m * 384 + j * 64 + F.lane] = (bf16)f2bf(x[j] * r * qn[j * 64 + F.lane]); }
        { float x[8]; float s = 0.f;
#pragma unroll
          for (int j = 0; j < 8; ++j) { x[j] = bf1(row[2968 + j * 64 + F.lane]); s += x[j] * x[j]; }
          const float r = 1.f / sqrtf(wave_sum(s) * (1.f / 512.f) + NORM_EPS);
#pragma unroll
          for (int j = 0; j < 8; ++j) ckvn[(size_t)m * 512 + j * 64 + F.lane] = (bf16)f2bf(x[j] * r * kvn[j * 64 + F.lane]); }
        { const int i = F.lane & 31; const float p = (float)pos[m]; const float invf = exp2f(-(float)i * (13.287712379549449f / 32.f));
          float sn, cs; sincosf(p * invf, &sn, &cs);
          const float x1 = bf1(row[3480 + i]), x2 = bf1(row[3480 + 32 + i]);
          if (F.lane < 32) krot[(size_t)m * 64 + i] = (bf16)f2bf(x1 * cs - x2 * sn); else krot[(size_t)m * 64 + 32 + i] = (bf16)f2bf(x1 * sn + x2 * cs); }
        { const int b = m >> 11, s = m & (NS - 1);
          const int q4 = F.lane >> 4, c = F.lane & 15, kv = q4 >> 1, g = q4 & 1;
          const v4u w = *(const v4u*)(row + 1024 + q4 * 128 + c * 8);
          *(v4u*)(cmpkv + ((size_t)((kv * 16 + b * 2 + g) * NS + s)) * 128 + c * 8) = w; }
    }
}
__device__ __forceinline__ void p_l1_thin_b(Frame& F) {
    bf16* qmla = (bf16*)(F.ws + WS_QMLA); const int* pos = (const int*)kin(1);
    for (int m = F.gw; m < NT; m += F.NGW) {
        const int i = F.lane & 31; const float p = (float)pos[m]; const float invf = exp2f(-(float)i * (13.287712379549449f / 32.f));
        float sn, cs; sincosf(p * invf, &sn, &cs);
#pragma unroll
        for (int hh = 0; hh < 4; ++hh) { const int h = hh * 2 + (F.lane >> 5); bf16* q = qmla + (size_t)m * 1536 + h * 192 + 128;
            const float x1 = bf1(q[i]), x2 = bf1(q[32 + i]); q[i] = (bf16)f2bf(x1 * cs - x2 * sn); q[32 + i] = (bf16)f2bf(x1 * sn + x2 * cs); }
    }
    const float* hid = (const float*)(F.ws + WS_HID); const float* w2 = kin(9); float* kvc = (float*)(F.ws + WS_KVCMP);
    for (int m = F.gw; m < 4096; m += F.NGW) {
        const int kv = m >> 11;
        float h0 = hid[(size_t)m * 256 + kv * 128 + F.lane], h1 = hid[(size_t)m * 256 + kv * 128 + 64 + F.lane];
        h0 = 0.5f * h0 * (1.f + tanhf(0.7978845608028654f * (h0 + 0.044715f * h0 * h0 * h0)));
        h1 = 0.5f * h1 * (1.f + tanhf(0.7978845608028654f * (h1 + 0.044715f * h1 * h1 * h1)));
        const float* w = w2 + (size_t)kv * 128 * 128; float o0 = 0.f, o1 = 0.f;
        for (int c = 0; c < 64; ++c) { const float a = __shfl(h0, c), bq = __shfl(h1, c);
            o0 += a * w[c * 128 + F.lane] + bq * w[(c + 64) * 128 + F.lane]; o1 += a * w[c * 128 + 64 + F.lane] + bq * w[(c + 64) * 128 + 64 + F.lane]; }
        kvc[(size_t)m * 128 + F.lane] = o0; kvc[(size_t)m * 128 + 64 + F.lane] = o1;
    }
}
__device__ __forceinline__ void p_nsa_cmp(Frame& F) {
    const bf16* proj = (const bf16*)(F.ws + WS_PROJ); const float* kvc = (const float*)(F.ws + WS_KVCMP); float* ocmp = (float*)(F.ws + WS_OCMP); unsigned* selm = (unsigned*)(F.ws + WS_SELM);
    LAS float* qs = (LAS float*)(F.lds + F.wave * 2048);
    LAS float* ps = qs + 128;
    const float scale = 0.08838834764831845f;
    for (int it = F.gw; it < NT * 2; it += F.NGW) {
        const int m = it >> 1, g = it & 1, b = m >> 11, s = m & (NS - 1);
        const int nvalid = (s >= 31) ? ((s - 31) / 16 + 1) : 0;
        const float* kc = kvc + (size_t)((0 * 16 + b * 2 + g) * 128) * 128; const float* vc = kvc + (size_t)((1 * 16 + b * 2 + g) * 128) * 128;
        float psum0 = 0.f, psum1 = 0.f;
        for (int r = 0; r < 4; ++r) {
            const int h = g * 4 + r;
            qs[F.lane] = bf1(proj[(size_t)m * CD_INP + h * 128 + F.lane]); qs[64 + F.lane] = bf1(proj[(size_t)m * CD_INP + h * 128 + 64 + F.lane]);
            LDS_WAIT(); asm volatile("" ::: "memory");
            float s0 = 0.f, s1 = 0.f;
            if (nvalid > 0) {
                const float* k0 = kc + (size_t)F.lane * 128; const float* k1 = kc + (size_t)(64 + F.lane) * 128;
                for (int d = 0; d < 128; d += 4) { const f32x4 q4 = *(const LAS f32x4*)(qs + d); const f32x4 a = *(const f32x4*)(k0 + d), c = *(const f32x4*)(k1 + d);
                    s0 += q4[0] * a[0] + q4[1] * a[1] + q4[2] * a[2] + q4[3] * a[3]; s1 += q4[0] * c[0] + q4[1] * c[1] + q4[2] * c[2] + q4[3] * c[3]; }
            }
            const bool v0 = F.lane < nvalid, v1 = (64 + F.lane) < nvalid;
            s0 = v0 ? s0 * scale : -1e30f; s1 = v1 ? s1 * scale : -1e30f;
            const float mx = wave_max(fmaxf(s0, s1));
            float p0 = v0 ? __expf(s0 - mx) : 0.f, p1 = v1 ? __expf(s1 - mx) : 0.f;
            const float den = wave_sum(p0 + p1); const float inv = den > 0.f ? 1.f / den : 0.f;
            p0 *= inv; p1 *= inv; psum0 += p0; psum1 += p1;
            float o0 = 0.f, o1 = 0.f;
            for (int n = 0; n < nvalid; ++n) { const float pn = n < 64 ? __shfl(p0, n) : __shfl(p1, n - 64); const f32x2 vv = *(const f32x2*)(vc + (size_t)n * 128 + F.lane * 2); o0 += pn * vv[0]; o1 += pn * vv[1]; }
            const float gt = sigmoidf_(bf1(proj[(size_t)m * CD_INP + 2560 + h * 3 + 0]));
            *(f32x2*)(ocmp + (size_t)m * 1024 + h * 128 + F.lane * 2) = (f32x2){gt * o0, gt * o1};
            asm volatile("" ::: "memory");
        }
        ps[F.lane] = psum0; ps[64 + F.lane] = psum1;
        LDS_WAIT(); asm volatile("" ::: "memory");
        const int j = F.lane & 31, cur = s >> 6;
        float imp = 0.f;
#pragma unroll
        for (int k = 0; k < 4; ++k) { const int n1 = 4 * j + k; if (n1 <= 126) imp += ps[n1]; const int n2 = 4 * j - 1 + k; if (n2 >= 0 && n2 <= 126) imp += ps[n2]; }
        const bool forced = (j == 0) || (j == cur) || (j == cur - 1);
        float score = forced ? 1e4f : ((j * 64 <= s) ? imp : -1e30f);
        if (F.lane >= 32) score = -3e38f;
        int rk = 0;
        for (int jj = 0; jj < 32; ++jj) { const float ov = __shfl(score, jj); rk += ((ov > score) || (ov == score && jj < j)) ? 1 : 0; }
        const bool sel = (F.lane < 32) && (rk < 16) && (j <= cur);
        const unsigned long long bal = __ballot(sel);
        if (F.lane == 0) selm[m * 2 + g] = (unsigned)bal;
        asm volatile("" ::: "memory");
    }
}
namespace fa {
typedef short v4i16_t __attribute__((ext_vector_type(4)));
struct Src { const bf16* k1; size_t ks1; const bf16* k2; size_t ks2; const bf16* v; size_t vs; };
template <int DQK> struct Cfg { static constexpr int KPITCH = (DQK + 8) * 2, KBYTES = 64 * KPITCH, VPITCH = 272, VBYTES = 64 * VPITCH, BUF = KBYTES + VBYTES, NKS = DQK / 32, KCH = DQK / 8, NKR = DQK / 64; };

template <int DQK>
__device__ __forceinline__ void load_tile(const Src& S, int k0, int tid, v4u (&kr)[Cfg<DQK>::NKR], v4u (&vr)[2]) {
    constexpr int KCH = Cfg<DQK>::KCH;
#pragma unroll
    for (int i = 0; i < Cfg<DQK>::NKR; ++i) { const int c = tid + 512 * i, row = c / KCH, c8 = c % KCH;
        const bf16* src = (DQK == 192 && c8 >= 16) ? S.k2 + (size_t)(k0 + row) * S.ks2 + (c8 - 16) * 8 : S.k1 + (size_t)(k0 + row) * S.ks1 + c8 * 8;
        kr[i] = *(const v4u*)src; }
#pragma unroll
    for (int i = 0; i < 2; ++i) { const int c = tid + 512 * i, row = c >> 4, c8 = c & 15; vr[i] = *(const v4u*)(S.v + (size_t)(k0 + row) * S.vs + c8 * 8); }
}
template <int DQK>
__device__ __forceinline__ void store_tile(LAS unsigned char* buf, int tid, const v4u (&kr)[Cfg<DQK>::NKR], const v4u (&vr)[2]) {
    constexpr int KCH = Cfg<DQK>::KCH;
#pragma unroll
    for (int i = 0; i < Cfg<DQK>::NKR; ++i) { const int c = tid + 512 * i, row = c / KCH, c8 = c % KCH; *(LAS v4u*)(buf + row * Cfg<DQK>::KPITCH + c8 * 16) = kr[i]; }
#pragma unroll
    for (int i = 0; i < 2; ++i) { const int c = tid + 512 * i, row = c >> 4, c8 = c & 15; *(LAS v4u*)(buf + Cfg<DQK>::KBYTES + row * Cfg<DQK>::VPITCH + c8 * 16) = vr[i]; }
}
template <int DQK, int MODE>
__device__ __forceinline__ void fa_pass(LAS unsigned char* lds, const Src& S, const bf16x8 (&qf)[Cfg<DQK>::NKS], unsigned tmask, int spos, unsigned rowmask, float sscale,
                                        f32x4 (&O)[8], float& m_run, float& l_run, int tid, int lane) {
    typedef Cfg<DQK> C;
    const int i16 = lane & 15, g = lane >> 4, q4 = (lane & 15) >> 2, p4 = lane & 3;
#pragma unroll
    for (int nt = 0; nt < 8; ++nt) O[nt] = (f32x4){0.f, 0.f, 0.f, 0.f};
    m_run = -1e30f; l_run = 0.f;
    unsigned rem = tmask;
    if (rem == 0u) return;
    v4u kr[C::NKR], vr[2];
    int t = __builtin_ctz(rem); rem &= rem - 1u;
    load_tile<DQK>(S, t * 64, tid, kr, vr);
    __syncthreads();
    store_tile<DQK>(lds, tid, kr, vr);
    __syncthreads();
    int cur = 0;
    for (;;) {
        const bool has_next = rem != 0u; int tn = 0;
        if (has_next) { tn = __builtin_ctz(rem); rem &= rem - 1u; load_tile<DQK>(S, tn * 64, tid, kr, vr); }
        LAS unsigned char* kb = lds + cur * C::BUF; LAS unsigned char* vb = kb + C::KBYTES;
        f32x4 sc[4];
#pragma unroll
        for (int mt = 0; mt < 4; ++mt) { sc[mt] = (f32x4){0.f, 0.f, 0.f, 0.f};
#pragma unroll
            for (int ks = 0; ks < C::NKS; ++ks) { const bf16x8 kf = *(const LAS bf16x8*)(kb + (16 * mt + i16) * C::KPITCH + (32 * ks + 8 * g) * 2);
                sc[mt] = __builtin_amdgcn_mfma_f32_16x16x32_bf16(kf, qf[ks], sc[mt], 0, 0, 0); } }
        float mx = -1e30f; bool vl[4][4];
#pragma unroll
        for (int mt = 0; mt < 4; ++mt)
#pragma unroll
            for (int r = 0; r < 4; ++r) { const int kp = t * 64 + 16 * mt + 4 * g + r; bool ok = kp <= spos;
                if (MODE == 1) ok = ok && ((rowmask >> t) & 1u);
                if (MODE == 2) ok = ok && (kp + 512 > spos);
                vl[mt][r] = ok; const float x = ok ? sc[mt][r] * sscale : -1e30f; sc[mt][r] = x; mx = fmaxf(mx, x); }
        mx = fmaxf(mx, __shfl_xor(mx, 16)); mx = fmaxf(mx, __shfl_xor(mx, 32));
        const float m_new = fmaxf(m_run, mx), alpha = __builtin_amdgcn_exp2f(m_run - m_new); m_run = m_new;
        float ps = 0.f;
#pragma unroll
        for (int mt = 0; mt < 4; ++mt)
#pragma unroll
            for (int r = 0; r < 4; ++r) { const float pv = vl[mt][r] ? __builtin_amdgcn_exp2f(sc[mt][r] - m_new) : 0.f; sc[mt][r] = pv; ps += pv; }
        l_run = l_run * alpha + ps;
        float ar[4];
#pragma unroll
        for (int r = 0; r < 4; ++r) ar[r] = __shfl(alpha, 4 * g + r);
#pragma unroll
        for (int nt = 0; nt < 8; ++nt)
#pragma unroll
            for (int r = 0; r < 4; ++r) O[nt][r] *= ar[r];
        bf16x8 pf[2];
#pragma unroll
        for (int k2 = 0; k2 < 2; ++k2) { v4u w; w.x = pk2(sc[2 * k2][0], sc[2 * k2][1]); w.y = pk2(sc[2 * k2][2], sc[2 * k2][3]); w.z = pk2(sc[2 * k2 + 1][0], sc[2 * k2 + 1][1]); w.w = pk2(sc[2 * k2 + 1][2], sc[2 * k2 + 1][3]);
            pf[k2] = __builtin_bit_cast(bf16x8, w); }
#pragma unroll
        for (int nt = 0; nt < 8; ++nt)
#pragma unroll
            for (int k2 = 0; k2 < 2; ++k2) {
                const v4i16_t a = __builtin_amdgcn_ds_read_tr16_b64_v4i16((LAS v4i16_t*)(vb + (32 * k2 + 4 * g + q4) * C::VPITCH + (16 * nt + 4 * p4) * 2));
                const v4i16_t b = __builtin_amdgcn_ds_read_tr16_b64_v4i16((LAS v4i16_t*)(vb + (32 * k2 + 16 + 4 * g + q4) * C::VPITCH + (16 * nt + 4 * p4) * 2));
                const bf16x8 vf = (bf16x8){a[0], a[1], a[2], a[3], b[0], b[1], b[2], b[3]};
                O[nt] = __builtin_amdgcn_mfma_f32_16x16x32_bf16(pf[k2], vf, O[nt], 0, 0, 0); }
        if (has_next) store_tile<DQK>(lds + (cur ^ 1) * C::BUF, tid, kr, vr);
        __syncthreads();
        if (!has_next) break;
        t = tn; cur ^= 1;
    }
}
__device__ __forceinline__ void row_inv(float l_run, int lane, float (&inv)[4]) {
    float l = l_run; l += __shfl_xor(l, 16); l += __shfl_xor(l, 32);
    const float li = l > 0.f ? 1.f / l : 0.f; const int g = lane >> 4;
#pragma unroll
    for (int r = 0; r < 4; ++r) inv[r] = __shfl(li, 4 * g + r);
}
}

constexpr int FA_NUNITS = 2048;
__device__ __forceinline__ void p_attn_mfma(Frame& F, unsigned* queue) {
    const bf16* proj = (const bf16*)(F.ws + WS_PROJ); bf16* mixin = (bf16*)(F.ws + WS_MIXIN); const float* ocmp = (const float*)(F.ws + WS_OCMP); const unsigned* selm = (const unsigned*)(F.ws + WS_SELM);
    const bf16* qmla = (const bf16*)(F.ws + WS_QMLA); const bf16* kvu = (const bf16*)(F.ws + WS_KVU); const bf16* krot = (const bf16*)(F.ws + WS_KROT);
    volatile LAS unsigned* qslot = (volatile LAS unsigned*)(F.lds + LDSCTL_OFF);
    const int lane = F.lane, w = F.wave, i16 = lane & 15, g4 = lane >> 4;
    for (;;) {
        __syncthreads();
        if (F.tid == 0) qslot[0] = atomicAdd(queue, 1u);
        __syncthreads();
        const int u = __builtin_amdgcn_readfirstlane((int)qslot[0]);
        if (u >= FA_NUNITS) break;
        if (u < 1024) {
            const int qt = 15 - (u >> 6), bh = u & 63, b = bh >> 3, h = bh & 7, q0 = qt * 128, spos = q0 + 16 * w + i16;
            bf16x8 qf[6];
#pragma unroll
            for (int ks = 0; ks < 6; ++ks) qf[ks] = *(const bf16x8*)(qmla + (size_t)(b * NS + spos) * 1536 + h * 192 + 32 * ks + 8 * g4);
            fa::Src S; S.k1 = kvu + (size_t)(b * NS) * 2048 + h * 256; S.ks1 = 2048; S.k2 = krot + (size_t)(b * NS) * 64; S.ks2 = 64; S.v = S.k1 + 128; S.vs = 2048;
            const int last = (q0 + 127) >> 6; const unsigned tmask = last >= 31 ? 0xffffffffu : ((1u << (last + 1)) - 1u);
            f32x4 O[8]; float m_run, l_run;
            fa::fa_pass<192, 0>(F.lds, S, qf, tmask, spos, 0u, 0.07216878364870322f * 1.4426950408889634f, O, m_run, l_run, F.tid, lane);
            float inv[4]; fa::row_inv(l_run, lane, inv);
#pragma unroll
            for (int r = 0; r < 4; ++r) { bf16* orow = mixin + (size_t)(b * NS + q0 + 16 * w + 4 * g4 + r) * ND + 1024 + h * 128 + i16;
#pragma unroll
                for (int nt = 0; nt < 8; ++nt) orow[16 * nt] = (bf16)f2bf(O[nt][r] * inv[r]); }
        } else {
            const int v = u - 1024, qt = 63 - (v >> 4), bg = v & 15, b = bg >> 1, gq = bg & 1, q0 = qt * 32;
            const int h = gq * 4 + (w >> 1), spos = q0 + (w & 1) * 16 + i16;
            bf16x8 qf[4];
#pragma unroll
            for (int ks = 0; ks < 4; ++ks) qf[ks] = *(const bf16x8*)(proj + (size_t)(b * NS + spos) * CD_INP + h * 128 + 32 * ks + 8 * g4);
            const unsigned rowmask = selm[(size_t)(b * NS + spos) * 2 + gq];
            unsigned um = selm[(size_t)(b * NS + q0 + (lane & 31)) * 2 + gq];
#pragma unroll
            for (int o = 1; o < 32; o <<= 1) um |= (unsigned)__shfl_xor((int)um, o);
            um = (unsigned)__builtin_amdgcn_readfirstlane((int)um);
            const bf16* base = proj + (size_t)(b * NS) * CD_INP;
            const float sscale = 0.08838834764831845f * 1.4426950408889634f;
            f32x4 O[8], Ot[8]; float m_run, l_run, inv[4];
            { fa::Src S; S.k1 = base + 1024 + ((1 * 2 + 0) * 2 + gq) * 128; S.ks1 = CD_INP; S.k2 = nullptr; S.ks2 = 0; S.v = base + 1024 + ((1 * 2 + 1) * 2 + gq) * 128; S.vs = CD_INP;
              fa::fa_pass<128, 1>(F.lds, S, qf, um, spos, rowmask, sscale, O, m_run, l_run, F.tid, lane); }
            fa::row_inv(l_run, lane, inv);
#pragma unroll
            for (int r = 0; r < 4; ++r) { const int sq = q0 + (w & 1) * 16 + 4 * g4 + r; const float g1 = sigmoidf_(bf1(proj[(size_t)(b * NS + sq) * CD_INP + 2560 + h * 3 + 1])) * inv[r];
#pragma unroll
                for (int nt = 0; nt < 8; ++nt) Ot[nt][r] = O[nt][r] * g1; }
            { fa::Src S; S.k1 = base + 1024 + ((2 * 2 + 0) * 2 + gq) * 128; S.ks1 = CD_INP; S.k2 = nullptr; S.ks2 = 0; S.v = base + 1024 + ((2 * 2 + 1) * 2 + gq) * 128; S.vs = CD_INP;
              const int klo = q0 - 511 > 0 ? q0 - 511 : 0, tlo = klo >> 6, thi = (q0 + 31) >> 6;
              const unsigned hm = thi >= 31 ? 0xffffffffu : ((1u << (thi + 1)) - 1u); const unsigned tmask = hm & ~((1u << tlo) - 1u);
              fa::fa_pass<128, 2>(F.lds, S, qf, tmask, spos, 0u, sscale, O, m_run, l_run, F.tid, lane); }
            fa::row_inv(l_run, lane, inv);
#pragma unroll
            for (int r = 0; r < 4; ++r) { const int sq = q0 + (w & 1) * 16 + 4 * g4 + r; const size_t m = (size_t)(b * NS + sq);
                const float g2 = sigmoidf_(bf1(proj[m * CD_INP + 2560 + h * 3 + 2])) * inv[r];
#pragma unroll
                for (int nt = 0; nt < 8; ++nt) { const float oc = ocmp[m * 1024 + h * 128 + 16 * nt + i16]; mixin[m * ND + h * 128 + 16 * nt + i16] = (bf16)f2bf(oc + Ot[nt][r] + O[nt][r] * g2); } }
        }
    }
}

constexpr int NPHASE = 33;


#define IN(k) (lo <= (k) && (k) < hi)
#define SEAM(k) do { if (IN(k) && IN((k) + 1)) { if (MK_ONE_LAUNCH) xcd_barrier(bar); else if (F.tid == 0) __hip_atomic_store(F.ctl + CW_TMO, 0xBAD0u | (unsigned)(k), __ATOMIC_RELAXED, __HIP_MEMORY_SCOPE_AGENT); } } while (0)
template <int l>
__device__ __forceinline__ void layer_body(Frame& F, const XcdBarrier& bar, const int lo, const int hi) {
    unsigned char* ws = F.ws;
    bf16* const XB0 = (bf16*)(ws + WS_XB0); bf16* const X1B = (bf16*)(ws + WS_X1B); bf16* const X2B = (bf16*)(ws + WS_X2B);
    bf16* const PROJ = (bf16*)(ws + WS_PROJ); bf16* const MIXIN = (bf16*)(ws + WS_MIXIN); bf16* const MIXO = (bf16*)(ws + WS_MIXO);
    bf16* const HB = (bf16*)(ws + WS_H); bf16* const Y2 = (bf16*)(ws + WS_Y2);
        const int pb = 1 + l * 16;
        const bf16* xin = l == 0 ? XB0 : X2B;
        if (IN(pb + 0)) {
            if (l == 0) { pg8::DenseProb P; P.init(xin, ND, (const bf16*)(ws + WS_WABIN), NT, AB_IN, ND, F.G, (int)blockIdx.x); pg8::EpiBf16 E{PROJ, AB_IN};
                pg8::gemm_phase<pg8::EpiBf16, pg8::DenseProb, true>(F.lds, P, E); }
            else { pg8::DenseProb P; P.init(xin, ND, (const bf16*)(ws + WS_WCDIN), NT, CD_INP, ND, F.G, (int)blockIdx.x); pg8::EpiBf16 E{PROJ, CD_INP};
                pg8::gemm_phase<pg8::EpiBf16, pg8::DenseProb, true>(F.lds, P, E); }
        } SEAM(pb + 0);
        if (l == 0) {
            if (IN(pb + 1)) { p_pool_rope(F); } SEAM(pb + 1);
            if (IN(pb + 2)) { if (blockIdx.x < NB * 6) p_retention_mfma(F, (int)blockIdx.x); __syncthreads(); p_moe_weights_queue(F, F.ctl + CW_CNT + 320); } SEAM(pb + 2);
            SEAM(pb + 3); SEAM(pb + 4); SEAM(pb + 5);
        } else {
            if (IN(pb + 1)) { p_l1_thin_a(F); } SEAM(pb + 1);
            if (IN(pb + 2)) {
                { pg8::CmpProb P; P.K = 4096; P.Abase = (const char*)(ws + WS_CMPKV); P.Bt = (const char*)(ws + WS_CW1); P.G = F.G; P.c = (int)blockIdx.x;
                  pg8::EpiF32 E{(float*)(ws + WS_HID), 256, (const float*)(ws + WS_CMPB)};
                  pg8::gemm_phase<pg8::EpiF32, pg8::CmpProb, true>(F.lds, P, E); }
                { pg8::DenseProb P; P.init((const bf16*)(ws + WS_CQN), 384, (const bf16*)(ws + WS_WUQ), NT, 1536, 384, F.G, (int)blockIdx.x); pg8::EpiBf16 E{(bf16*)(ws + WS_QMLA), 1536};
                  pg8::gemm_phase<pg8::EpiBf16, pg8::DenseProb, true>(F.lds, P, E); }
                { pg8::DenseProb P; P.init((const bf16*)(ws + WS_CKVN), 512, (const bf16*)(ws + WS_WUKV), NT, 2048, 512, F.G, (int)blockIdx.x); pg8::EpiBf16 E{(bf16*)(ws + WS_KVU), 2048};
                  pg8::gemm_phase<pg8::EpiBf16, pg8::DenseProb, true>(F.lds, P, E); }
            } SEAM(pb + 2);
            if (IN(pb + 3)) { p_l1_thin_b(F); } SEAM(pb + 3);
            if (IN(pb + 4)) { p_nsa_cmp(F); } SEAM(pb + 4);
            if (IN(pb + 5)) { p_attn_mfma(F, F.ctl + CW_CNT + 256); } SEAM(pb + 5);
        }
        if (IN(pb + 6)) { pg8::DenseProb P; P.init(MIXIN, ND, (const bf16*)(ws + (l == 0 ? WS_WABOUT : WS_WCDOUT)), NT, ND, ND, F.G, (int)blockIdx.x); pg8::EpiBf16 E{MIXO, ND};
            pg8::gemm_phase<pg8::EpiBf16, pg8::DenseProb, true>(F.lds, P, E); } SEAM(pb + 6);
        if (IN(pb + 7)) { p_ln1(F, xin, MIXO, kin(15) + l * ND, kin(16) + l * ND, X1B); } SEAM(pb + 7);
        if (IN(pb + 8)) { pg8::DenseProb P; P.init(X1B, ND, (const bf16*)(ws + WS_RT + (size_t)l * MiB), NT, 256, ND, F.G, (int)blockIdx.x); pg8::EpiF32 E{(float*)(ws + WS_LOGITS), 256, nullptr};
            pg8::gemm_phase<pg8::EpiF32, pg8::DenseProb, true>(F.lds, P, E); } SEAM(pb + 8);
        if (IN(pb + 9)) { p_route(F, l); } SEAM(pb + 9);
        if (IN(pb + 10)) { p_scatter(F, l); } SEAM(pb + 10);
        if (IN(pb + 11)) { load_offsets(F, l); const LAS int* tab = (const LAS int*)(F.lds + TAB_OFF);
            pg8::MoeUpProb P; P.K = ND; P.Abase = (const char*)X1B; P.W13 = (const char*)(ws + WS_W13 + (size_t)l * WS_MOE_LSTRIDE); P.sorted = (const int*)(ws + WS_SORTED); P.tile_e = tab + 160; P.ntiles = __builtin_amdgcn_readfirstlane(tab[65]);
            P.nunits = (P.ntiles + NT / 256) * 4; P.G = F.G; P.c = (int)blockIdx.x;
            pg8::EpiSwiglu E{HB};
            pg8::gemm_phase<pg8::EpiSwiglu, pg8::MoeUpProb, true>(F.lds, P, E); } SEAM(pb + 11);
        if (IN(pb + 12)) { load_offsets(F, l); const LAS int* tab = (const LAS int*)(F.lds + TAB_OFF);
            pg8::MoeDownProb P; P.K = EFF; P.Abase = (const char*)HB; P.W2 = (const char*)(ws + WS_W2 + (size_t)l * WS_MOE_LSTRIDE); P.tile_e = tab + 160; P.ntiles = __builtin_amdgcn_readfirstlane(tab[65]);
            P.nunits = (P.ntiles + NT / 256) * 8; P.G = F.G; P.c = (int)blockIdx.x;
            pg8::EpiBf16 E{Y2, ND};
            pg8::gemm_phase<pg8::EpiBf16, pg8::MoeDownProb, true>(F.lds, P, E); } SEAM(pb + 12);
        if (IN(pb + 13)) { p_combine_ln2(F, X1B, Y2, (const int*)(ws + WS_SLOT), (const float*)(ws + WS_WSEL), kin(17) + l * ND, kin(18) + l * ND, l == 0 ? X2B : nullptr, l == 0 ? nullptr : F.out); } SEAM(pb + 13);
        SEAM(pb + 14); SEAM(pb + 15);
    }
__global__ void __launch_bounds__(NWAVES * 64, 2) mk_fwd(Args args) {
    extern __shared__ __attribute__((aligned(16))) unsigned char lds[];
    Frame F;
    F.lds = (LAS unsigned char*)lds;
    F.MISC = (volatile LAS unsigned*)(F.lds + MISC_OFF);
    F.tid = threadIdx.x; F.lane = F.tid & 63; F.wave = __builtin_amdgcn_readfirstlane(F.tid >> 6);
    F.G = gridDim.x; { const int bx = blockIdx.x; F.vcu = (F.G % 8 == 0) ? (bx % 8) * (F.G / 8) + bx / 8 : bx; }
    F.gw = F.vcu * NWAVES + F.wave; F.NGW = F.G * NWAVES;
    F.ws = args.ws; F.ctl = (unsigned*)(args.ws + WS_CTL); F.out = args.out;
    for (int u = F.tid; u < (LDS_BYTES - LDSCTL_OFF) / 4; u += NWAVES * 64) ((LAS unsigned*)(F.lds + LDSCTL_OFF))[u] = 0u;
    __syncthreads();
    XcdBarrier bar; bar.bar = F.ctl + CW_BAR; bar.x = 0; bar.st = nullptr;
    if (MK_ONE_LAUNCH) bar = xcd_barrier_post(F.ctl + CW_BAR, F.MISC + 8);
    const int lo = args.ph_lo, hi = args.ph_hi;
    unsigned char* ws = args.ws;
    bf16* const XB0 = (bf16*)(ws + WS_XB0); bf16* const X1B = (bf16*)(ws + WS_X1B); bf16* const X2B = (bf16*)(ws + WS_X2B);
    bf16* const PROJ = (bf16*)(ws + WS_PROJ); bf16* const MIXIN = (bf16*)(ws + WS_MIXIN); bf16* const MIXO = (bf16*)(ws + WS_MIXO);
    bf16* const HB = (bf16*)(ws + WS_H); bf16* const Y2 = (bf16*)(ws + WS_Y2);

    if (IN(0)) { p_prologue(F); } SEAM(0);

    layer_body<0>(F, bar, lo, hi);
    layer_body<1>(F, bar, lo, hi);
#undef IN
#undef SEAM
}

extern "C" void kernel_launch(void* const* d_in, const int* in_sizes, int n_in, void* d_out, int out_size, void* d_ws, size_t ws_size, hipStream_t stream) {
    static int grid = 0;
    if (grid == 0) {
        if (n_in != 27 || in_sizes[0] != NT * ND || out_size != NT * ND || ws_size < WS_END) { fprintf(stderr, "kernel_launch: unexpected problem (n_in %d, in0 %d, out %d, ws %zu < %zu); nothing launched\n", n_in, n_in > 0 ? in_sizes[0] : -1, out_size, ws_size, (size_t)WS_END); grid = -1; return; }
        int dev = 0, cus = 0, per_cu = 0;
        if (hipGetDevice(&dev) != hipSuccess || hipDeviceGetAttribute(&cus, hipDeviceAttributeMultiprocessorCount, dev) != hipSuccess) { fprintf(stderr, "kernel_launch: device query failed\n"); grid = -1; return; }
        if (hipFuncSetAttribute((const void*)mk_fwd, hipFuncAttributeMaxDynamicSharedMemorySize, LDS_BYTES) != hipSuccess) { fprintf(stderr, "kernel_launch: hipFuncSetAttribute failed\n"); grid = -1; return; }
        if (hipOccupancyMaxActiveBlocksPerMultiprocessor(&per_cu, (const void*)mk_fwd, NWAVES * 64, LDS_BYTES) != hipSuccess || per_cu < 1) fprintf(stderr, "kernel_launch: note: occupancy query reports %d\n", per_cu);
        (void)hipGetLastError();
        grid = cus;
    }
    if (grid < 0) return;
    if (hipMemsetAsync((char*)d_ws + WS_CTL, 0, CTL_ZERO_BYTES, stream) != hipSuccess) { fprintf(stderr, "kernel_launch: memset failed\n"); return; }
    Args a{};
    for (int i = 0; i < 27; ++i) a.in[i] = (const float*)d_in[i];
    a.out = (float*)d_out; a.ws = (unsigned char*)d_ws;
#if MK_ONE_LAUNCH
    a.ph_lo = 0; a.ph_hi = NPHASE;
    hipLaunchKernelGGL(mk_fwd, dim3(grid), dim3(NWAVES * 64), LDS_BYTES, stream, a);
#else
    for (int p = 0; p < NPHASE; ++p) {
        const int lp = (p - 1) & 15;
        if (p >= 1) { const int l = (p - 1) >> 4; if (lp >= 14) continue; if (l == 0 && lp >= 3 && lp <= 5) continue; }
        a.ph_lo = p; a.ph_hi = p + 1;
        hipLaunchKernelGGL(mk_fwd, dim3(grid), dim3(NWAVES * 64), LDS_BYTES, stream, a);
    }
#endif
    const hipError_t le = hipPeekAtLastError();
    if (le != hipSuccess) fprintf(stderr, "kernel_launch: launch failed: %s\n", hipGetErrorName(le));
}
```

```cpp
#include <hip/hip_runtime.h>
#include <cstdio>
#include <cstdint>

#ifndef MK_ONE_LAUNCH
#define MK_ONE_LAUNCH 1
#endif
#ifndef MK_PROBE_PHASE
#define MK_PROBE_PHASE -1
#endif
#ifndef MK_PROBE_AMP
#define MK_PROBE_AMP 4
#endif

#define GAS __attribute__((address_space(1)))
#define LAS __attribute__((address_space(3)))
typedef unsigned short bf16;
typedef unsigned v4u __attribute__((ext_vector_type(4)));
typedef unsigned v2u __attribute__((ext_vector_type(2)));
typedef float f32x4 __attribute__((ext_vector_type(4)));
typedef float f32x2 __attribute__((ext_vector_type(2)));
typedef short bf16x8 __attribute__((ext_vector_type(8)));

constexpr int NB = 8, NS = 2048, ND = 2048, NT = NB * NS;
constexpr float DN_ALPHA = 1.41421356237309505f;
constexpr float LN_EPS = 1e-5f, NORM_EPS = 1e-6f;
constexpr int AB_IN = 5120, CD_IN = 3544, CD_INP = 3584;
constexpr int NEXP = 64, EFF = 512;
constexpr int MAXROWS = NT * 8 + NEXP * 256;
constexpr int MAXTILES = MAXROWS / 256;
constexpr int SH_ROW0 = MAXROWS;

constexpr size_t MiB = 1u << 20;
constexpr size_t WS_CTL = 0, CTL_ZERO_BYTES = 1 * MiB;
constexpr size_t WS_TOPE = 1 * MiB, WS_WSEL = WS_TOPE + 512 * 1024, WS_SLOT = 2 * MiB, WS_SORTED = WS_SLOT + 512 * 1024;
constexpr size_t WS_CMPB = 3 * MiB + 256 * 1024, WS_SELM = 3 * MiB + 512 * 1024;
constexpr size_t WS_KVCMP = 4 * MiB;
constexpr size_t WS_HID = 6 * MiB;
constexpr size_t WS_WABIN = 16 * MiB, WS_WABOUT = 36 * MiB, WS_WCDIN = 44 * MiB, WS_WCDOUT = 58 * MiB, WS_WUQ = 66 * MiB, WS_WUKV = 68 * MiB, WS_CW1 = 70 * MiB, WS_RT = 72 * MiB;
constexpr size_t WS_W13 = 74 * MiB, WS_W2 = 334 * MiB, WS_MOE_LSTRIDE = 390 * MiB;
constexpr size_t WS_XB0 = 854 * MiB, WS_X2B = 854 * MiB, WS_X1B = 918 * MiB;
constexpr size_t WS_H = 982 * MiB, WS_Y2 = 1142 * MiB, WS_END = 1782 * MiB;
constexpr size_t WS_PROJ = 982 * MiB, WS_MIXIN = 1142 * MiB, WS_MIXO = 1206 * MiB;
constexpr size_t WS_QR = 1270 * MiB, WS_KR = 1294 * MiB;
constexpr size_t WS_CQN = 1270 * MiB, WS_CKVN = 1282 * MiB, WS_KROT = 1298 * MiB, WS_QMLA = 1302 * MiB, WS_KVU = 1350 * MiB, WS_CMPKV = 1414 * MiB, WS_OCMP = 1434 * MiB;
constexpr size_t WS_LOGITS = 1142 * MiB;
constexpr int CW_TMO = 0, CW_CODE = 1, CW_BAR = 4096, CW_CNT = 16384;

constexpr int RING_BYTES = 131072, LDSCTL_OFF = RING_BYTES, MISC_OFF = LDSCTL_OFF + 320, TAB_OFF = LDSCTL_OFF + 512;
constexpr int LDS_BYTES = 147456;
constexpr int NWAVES = 8;

#define LDS_WAIT() asm volatile("s_waitcnt lgkmcnt(0)" ::: "memory")
#define VM_WAIT() asm volatile("s_waitcnt vmcnt(0)" ::: "memory")
__device__ __forceinline__ unsigned f2bf(float f) { unsigned u = __builtin_bit_cast(unsigned, f); return (u + 0x7fffu + ((u >> 16) & 1u)) >> 16; }
__device__ __forceinline__ unsigned pk2(float lo, float hi) { return f2bf(lo) | (f2bf(hi) << 16); }
__device__ __forceinline__ float bflo(unsigned w) { return __builtin_bit_cast(float, w << 16); }
__device__ __forceinline__ float bfhi(unsigned w) { return __builtin_bit_cast(float, w & 0xffff0000u); }
__device__ __forceinline__ float bf1(bf16 v) { return __builtin_bit_cast(float, ((unsigned)v) << 16); }
__device__ __forceinline__ float wave_sum(float v) {
#pragma unroll
    for (int o = 1; o < 64; o <<= 1) v += __shfl_xor(v, o);
    return v;
}
__device__ __forceinline__ float wave_max(float v) {
#pragma unroll
    for (int o = 1; o < 64; o <<= 1) v = fmaxf(v, __shfl_xor(v, o));
    return v;
}
__device__ __forceinline__ float sigmoidf_(float x) { return 1.0f / (1.0f + __expf(-x)); }
__device__ __forceinline__ float siluf_(float x) { return x / (1.0f + __expf(-x)); }
__device__ __forceinline__ void unpack8(const v4u w, float (&f)[8]) {
    f[0] = bflo(w.x); f[1] = bfhi(w.x); f[2] = bflo(w.y); f[3] = bfhi(w.y); f[4] = bflo(w.z); f[5] = bfhi(w.z); f[6] = bflo(w.w); f[7] = bfhi(w.w);
}

#define XB_TMO      128
#define XB_XCNT(j)  (256  + 64 * (j))
#define XB_XSUB(j)  (1280 + 64 * (j))
#define XB_XGEN(j)  (2304 + 64 * (j))
#define XB_TOP      3328
#define XB_TOPGEN   3392
#define XCD_BAR_WORDS 3456
#define XB_SPIN_CAP (1u << 18)
__device__ __forceinline__ unsigned xb_ld(unsigned* p)              { return __hip_atomic_load(p, __ATOMIC_RELAXED, __HIP_MEMORY_SCOPE_AGENT); }
__device__ __forceinline__ unsigned xb_add(unsigned* p, unsigned v) { return __hip_atomic_fetch_add(p, v, __ATOMIC_RELAXED, __HIP_MEMORY_SCOPE_AGENT); }
__device__ __forceinline__ unsigned xb_xcc_id() { return (unsigned)__builtin_amdgcn_s_getreg((3 << 11) | 20) & 0xFu; }
#define XB_SPIN(cond, bar) do { unsigned _sp = 0; while (cond) { __builtin_amdgcn_s_sleep(1); \
    if ((++_sp & 255u) == 0u) { if (xb_ld(&(bar)[XB_TMO])) break; if (_sp > XB_SPIN_CAP) { atomicAdd(&(bar)[XB_TMO], 1u); break; } } } } while (0)
struct XcdBarrier { unsigned* bar; unsigned x; volatile LAS unsigned* st; };
__device__ __forceinline__ XcdBarrier xcd_barrier_post(unsigned* bar, volatile LAS unsigned* st) {
    XcdBarrier b; b.bar = bar; b.x = xb_xcc_id(); b.st = st;
    if (threadIdx.x == 0) (void)xb_add(&bar[XB_XCNT(b.x)], 1u);
    return b;
}
__device__ __forceinline__ void xcd_barrier_complete(unsigned* bar, unsigned x, unsigned& nloc, unsigned& nx) {
    const unsigned G = gridDim.x * gridDim.y * gridDim.z;
    unsigned sum, cnt, mine, sp = 0u;
    for (;;) {
        sum = 0u; cnt = 0u; mine = 0u;
#pragma unroll
        for (unsigned j = 0; j < 16; ++j) { const unsigned c = xb_ld(&bar[XB_XCNT(j)]); sum += c; cnt += (c > 0u) ? 1u : 0u; mine = (j == x) ? c : mine; }
        if (sum == G) break;
        __builtin_amdgcn_s_sleep(1);
        if ((++sp & 255u) == 0u) { if (xb_ld(&bar[XB_TMO])) break; if (sp > XB_SPIN_CAP) { atomicAdd(&bar[XB_TMO], 1u); break; } }
    }
    nloc = mine > 0u ? mine : 1u; nx = cnt > 0u ? cnt : 1u;
}
__device__ __forceinline__ void xcd_barrier(const XcdBarrier& b) {
    asm volatile("s_waitcnt vmcnt(0)" ::: "memory");
    __syncthreads();
    if (threadIdx.x == 0) {
        unsigned* bar = b.bar;
        __builtin_amdgcn_s_waitcnt(0);
        unsigned nloc = b.st[0], nx = b.st[1];
        if (nloc == 0u) { xcd_barrier_complete(bar, b.x, nloc, nx); b.st[0] = nloc; b.st[1] = nx; }
        const unsigned old = xb_add(&bar[XB_XSUB(b.x)], 1u);
        const unsigned gen = old / nloc;
        if (old + 1u == (gen + 1u) * nloc) {
            __builtin_amdgcn_fence(__ATOMIC_RELEASE, "agent");
            asm volatile("s_waitcnt vmcnt(0)" ::: "memory");
            const unsigned og = xb_add(&bar[XB_TOP], 1u);
            const unsigned tg = og / nx;
            if (og + 1u == (tg + 1u) * nx) xb_add(&bar[XB_TOPGEN], 1u);
            else XB_SPIN(xb_ld(&bar[XB_TOPGEN]) == tg, bar);
            __builtin_amdgcn_fence(__ATOMIC_ACQUIRE, "agent");
            xb_add(&bar[XB_XGEN(b.x)], 1u);
            asm volatile("s_waitcnt vmcnt(0)" ::: "memory");
        } else {
            XB_SPIN(xb_ld(&bar[XB_XGEN(b.x)]) == gen, bar);
            __builtin_amdgcn_fence(__ATOMIC_ACQUIRE, "agent");
            asm volatile("s_waitcnt vmcnt(0)" ::: "memory");
        }
    }
    __syncthreads();
}

namespace pg8 {
constexpr int BM = 256, BK = 64, HALF = 128, HTB = HALF * BK * 2, STAGE_BYTES = 8 * HTB, NXCD = 8, WGM = 8;
__host__ __device__ __forceinline__ int lds_byte(int r, int c) { const int st = (r >> 4) * 2 + (c >> 5), rr = r & 15, cc = c & 31, ob = rr * 64 + cc * 2; return st * 1024 + (ob ^ (((ob >> 9) & 1) << 5)); }
__host__ __device__ __forceinline__ void stage_rc(int b, int& R, int& C) { const int st = b / 1024, sb = b % 1024, swz = sb ^ (((sb >> 9) & 1) << 5); R = (st >> 1) * 16 + swz / 64; C = (st & 1) * 32 + (swz % 64) / 2; }
__host__ __device__ __forceinline__ int perm32(int rho) { const int n = rho >> 4, i = rho & 15; return 8 * (i >> 2) + 4 * n + (i & 3); }
struct Unit { int pm, pn, e; };

__device__ __forceinline__ unsigned cvt_pk_bf16(float lo, float hi) { unsigned r; asm volatile("v_cvt_pk_bf16_f32 %0, %1, %2" : "=v"(r) : "v"(lo), "v"(hi)); return r; }

struct EpiBf16 {
    static constexpr bool PERM = true;
    bf16* O; int ldc;
    __device__ __forceinline__ void operator()(const f32x4 (&acc)[2][2][4][2], const Unit& u, int wr, int wc, int fr, int fq) const {
        const int row0 = u.pm * BM + wr * 64 + fr, col0 = u.pn * BM + wc * 32 + 8 * fq;
#pragma unroll
        for (int ai = 0; ai < 2; ++ai)
#pragma unroll
            for (int m = 0; m < 4; ++m) { bf16* rowp = O + (size_t)(row0 + ai * HALF + m * 16) * ldc + col0;
#pragma unroll
                for (int bj = 0; bj < 2; ++bj) { const f32x4 v0 = acc[ai][bj][m][0], v1 = acc[ai][bj][m][1];
                    v4u w; w.x = cvt_pk_bf16(v0[0], v0[1]); w.y = cvt_pk_bf16(v0[2], v0[3]); w.z = cvt_pk_bf16(v1[0], v1[1]); w.w = cvt_pk_bf16(v1[2], v1[3]);
                    *(v4u*)(rowp + bj * HALF) = w; } }
    }
};
struct EpiF32 {
    static constexpr bool PERM = false;
    float* C; int ldc; const float* bias;
    __device__ __forceinline__ void operator()(const f32x4 (&acc)[2][2][4][2], const Unit& u, int wr, int wc, int fr, int fq) const {
        const int row0 = u.pm * BM + wr * 64 + fr, col0 = u.pn * BM + wc * 32 + 4 * fq;
        f32x4 bv[2][2];
#pragma unroll
        for (int bj = 0; bj < 2; ++bj)
#pragma unroll
            for (int n = 0; n < 2; ++n) bv[bj][n] = bias ? *(const f32x4*)(bias + col0 + bj * HALF + n * 16) : (f32x4){0.f, 0.f, 0.f, 0.f};
#pragma unroll
        for (int ai = 0; ai < 2; ++ai)
#pragma unroll
            for (int m = 0; m < 4; ++m) { float* rowp = C + (size_t)(row0 + ai * HALF + m * 16) * ldc + col0;
#pragma unroll
                for (int bj = 0; bj < 2; ++bj)
#pragma unroll
                    for (int n = 0; n < 2; ++n) *(f32x4*)(rowp + bj * HALF + n * 16) = acc[ai][bj][m][n] + bv[bj][n]; }
    }
};
struct EpiSwiglu {
    static constexpr bool PERM = true;
    bf16* H;
    __device__ __forceinline__ void operator()(const f32x4 (&acc)[2][2][4][2], const Unit& u, int wr, int wc, int fr, int fq) const {
        const int row0 = u.pm * BM + wr * 64 + fr, col0 = u.pn * HALF + wc * 32 + 8 * fq;
#pragma unroll
        for (int ai = 0; ai < 2; ++ai)
#pragma unroll
            for (int m = 0; m < 4; ++m) { bf16* rowp = H + (size_t)(row0 + ai * HALF + m * 16) * EFF + col0;
                float o[8];
#pragma unroll
                for (int n = 0; n < 2; ++n)
#pragma unroll
                    for (int j = 0; j < 4; ++j) { const float h1 = acc[ai][0][m][n][j], h3 = acc[ai][1][m][n][j]; o[n * 4 + j] = siluf_(h1) * h3; }
                v4u w; w.x = cvt_pk_bf16(o[0], o[1]); w.y = cvt_pk_bf16(o[2], o[3]); w.z = cvt_pk_bf16(o[4], o[5]); w.w = cvt_pk_bf16(o[6], o[7]);
                *(v4u*)rowp = w; }
    }
};

template <class Epi, class Prob, bool ALIGN_EPI>
__device__ __forceinline__ void gemm_phase(LAS unsigned char* lds, const Prob& P, const Epi& E) {
    const int tid = threadIdx.x, wid = __builtin_amdgcn_readfirstlane(tid >> 6), lane = tid & 63, wr = wid >> 2, wc = wid & 3, fr = lane & 15, fq = lane >> 4;
    const int K = P.K, nt = K / BK;
    int RA[2], CA[2]; unsigned voffB[2];
#pragma unroll
    for (int i = 0; i < 2; ++i) { int R, C; stage_rc(tid * 16 + i * 8192, R, C); const int Rb = Epi::PERM ? ((R & ~31) + perm32(R & 31)) : R;
        RA[i] = R; CA[i] = C; voffB[i] = (unsigned)(Rb * K + C) * 2u; }
    const size_t kstep = (size_t)(BK * 2);
    const size_t hstep = (size_t)HALF * K * 2;
    const unsigned ldsw = (unsigned)wid * 1024u;
    const int aoff = lds_byte(wr * 64 + fr, fq * 8), boff = lds_byte(wc * 32 + fr, fq * 8);
    const char* const Ab = P.Abase;
#define PG8_SA(b, h) (((b) * 2 + (h)) * HTB)
#define PG8_SB(b, h) ((4 + (b) * 2 + (h)) * HTB)
#define PG8_STAGE(bufoff, gbase, voff) do { _Pragma("unroll") for (int _i = 0; _i < 2; ++_i) \
        __builtin_amdgcn_global_load_lds((const unsigned*)((const char*)(gbase) + (voff)[_i]), (LAS unsigned*)(lds + (bufoff) + ldsw + _i * 8192), 16, 0, 0); } while (0)
#define PG8_STAGE_A(bufoff, kb, o0, o1) do { \
        __builtin_amdgcn_global_load_lds((const unsigned*)(Ab + (kb) + (o0)), (LAS unsigned*)(lds + (bufoff) + ldsw), 16, 0, 0); \
        __builtin_amdgcn_global_load_lds((const unsigned*)(Ab + (kb) + (o1)), (LAS unsigned*)(lds + (bufoff) + ldsw + 8192), 16, 0, 0); } while (0)
#define PG8_LDA(dst, b, h) do { _Pragma("unroll") for (int m = 0; m < 4; ++m) _Pragma("unroll") for (int k = 0; k < 2; ++k) dst[m][k] = *(const LAS bf16x8*)(lds + PG8_SA(b, h) + aoff + m * 2048 + k * 1024); } while (0)
#define PG8_LDB(dst, b, h) do { _Pragma("unroll") for (int n = 0; n < 2; ++n) _Pragma("unroll") for (int k = 0; k < 2; ++k) dst[n][k] = *(const LAS bf16x8*)(lds + PG8_SB(b, h) + boff + n * 2048 + k * 1024); } while (0)
#define PG8_MMA(ai, bj, At, Bt) do { __builtin_amdgcn_s_setprio(1); _Pragma("unroll") for (int m = 0; m < 4; ++m) _Pragma("unroll") for (int n = 0; n < 2; ++n) _Pragma("unroll") for (int k = 0; k < 2; ++k) \
        acc[ai][bj][m][n] = __builtin_amdgcn_mfma_f32_16x16x32_bf16(Bt[n][k], At[m][k], acc[ai][bj][m][n], 0, 0, 0); __builtin_amdgcn_s_setprio(0); } while (0)
#define PG8_WAIT_V(n) asm volatile("s_waitcnt vmcnt(" #n ")" ::: "memory")
#define PG8_WAIT_L(n) asm volatile("s_waitcnt lgkmcnt(" #n ")" ::: "memory")
#define PG8_BAR __builtin_amdgcn_s_barrier()
#define PG8_SCHED __builtin_amdgcn_sched_barrier(0)
    Unit cur, nxt; int ui = 0;
    if (!P.next(0, cur)) return;
    f32x4 acc[2][2][4][2];
#pragma unroll
    for (int a = 0; a < 2; ++a)
#pragma unroll
        for (int b = 0; b < 2; ++b)
#pragma unroll
            for (int m = 0; m < 4; ++m)
#pragma unroll
                for (int n = 0; n < 2; ++n) acc[a][b][m][n] = (f32x4){0.f, 0.f, 0.f, 0.f};
    bf16x8 At[4][2], B0[2][2], B1[2][2];
    unsigned oc[4], on[4];
    P.aoffs(cur, RA, CA, oc);
    const char* cB = P.bbase(cur);
    PG8_STAGE(PG8_SB(0, 0), cB, voffB); PG8_STAGE(PG8_SB(0, 1), cB + hstep, voffB); PG8_STAGE_A(PG8_SA(0, 0), (size_t)0, oc[0], oc[1]); PG8_STAGE_A(PG8_SA(0, 1), (size_t)0, oc[2], oc[3]);
    if (wr == 1) PG8_BAR;
    PG8_WAIT_V(2); PG8_BAR;
    PG8_STAGE(PG8_SB(1, 0), cB + kstep, voffB); PG8_STAGE_A(PG8_SA(1, 0), kstep, oc[0], oc[1]); PG8_STAGE(PG8_SB(1, 1), cB + hstep + kstep, voffB);
    PG8_WAIT_V(6); PG8_BAR;
    for (;;) {
        const bool has_next = P.next(ui + 1, nxt);
        const char* nB = cB;
        if (has_next) { P.aoffs(nxt, RA, CA, on); nB = P.bbase(nxt); }
        else { on[0] = oc[0]; on[1] = oc[1]; on[2] = oc[2]; on[3] = oc[3]; }
        for (int t = 0; t < nt; t += 2) {
            const bool last = (t == nt - 2);
            const size_t kb1 = (size_t)(t + 1) * kstep;
            const size_t kb2 = last ? (size_t)0 : (size_t)(t + 2) * kstep, kb3 = kb2 + kstep;
            const char* b2 = last ? nB : cB + (size_t)(t + 2) * kstep; const char* b3 = b2 + kstep;
            const unsigned o20 = last ? on[0] : oc[0], o21 = last ? on[1] : oc[1], o22 = last ? on[2] : oc[2], o23 = last ? on[3] : oc[3];
            PG8_LDB(B0, 0, 0); PG8_LDB(B1, 0, 1); PG8_SCHED; PG8_LDA(At, 0, 0); PG8_STAGE_A(PG8_SA(1, 1), kb1, oc[2], oc[3]);
            PG8_WAIT_V(8); PG8_WAIT_L(0); PG8_BAR; PG8_MMA(0, 0, At, B0); PG8_MMA(0, 1, At, B1); PG8_BAR; PG8_SCHED;
            PG8_LDA(At, 0, 1); PG8_STAGE(PG8_SB(0, 0), b2, voffB); PG8_STAGE(PG8_SB(0, 1), b2 + hstep, voffB); PG8_STAGE_A(PG8_SA(0, 0), kb2, o20, o21);
            PG8_WAIT_V(8); PG8_WAIT_L(0); PG8_BAR; PG8_MMA(1, 0, At, B0); PG8_MMA(1, 1, At, B1); PG8_BAR; PG8_SCHED;
            PG8_LDB(B0, 1, 0); PG8_LDB(B1, 1, 1); PG8_SCHED; PG8_LDA(At, 1, 0); PG8_STAGE_A(PG8_SA(0, 1), kb2, o22, o23);
            PG8_WAIT_V(8); PG8_WAIT_L(0); PG8_BAR; PG8_MMA(0, 0, At, B0); PG8_MMA(0, 1, At, B1); PG8_BAR; PG8_SCHED;
            PG8_LDA(At, 1, 1); PG8_STAGE(PG8_SB(1, 0), b3, voffB); PG8_STAGE(PG8_SB(1, 1), b3 + hstep, voffB); PG8_STAGE_A(PG8_SA(1, 0), kb3, o20, o21);
            PG8_WAIT_V(8); PG8_WAIT_L(0); PG8_BAR; PG8_MMA(1, 0, At, B0); PG8_MMA(1, 1, At, B1); PG8_BAR; PG8_SCHED;
        }
        if constexpr (ALIGN_EPI) { if (wr == 0) PG8_BAR; }
        E(acc, cur, wr, wc, fr, fq);
        if (!has_next) break;
#pragma unroll
        for (int a = 0; a < 2; ++a)
#pragma unroll
            for (int b = 0; b < 2; ++b)
#pragma unroll
                for (int m = 0; m < 4; ++m)
#pragma unroll
                    for (int n = 0; n < 2; ++n) acc[a][b][m][n] = (f32x4){0.f, 0.f, 0.f, 0.f};
        cur = nxt; cB = nB; oc[0] = on[0]; oc[1] = on[1]; oc[2] = on[2]; oc[3] = on[3]; ++ui;
        if constexpr (ALIGN_EPI) { if (wr == 1) PG8_BAR; }
    }
    PG8_WAIT_V(0);
    if constexpr (!ALIGN_EPI) { if (wr == 0) PG8_BAR; }
    PG8_BAR;
#undef PG8_SA
#undef PG8_SB
#undef PG8_STAGE
#undef PG8_STAGE_A
#undef PG8_LDA
#undef PG8_LDB
#undef PG8_MMA
#undef PG8_WAIT_V
#undef PG8_WAIT_L
#undef PG8_BAR
#undef PG8_SCHED
}

struct DenseProb {
    int K; const char* Abase; const char* Bt; int lda; int nM, nN, nwg, G, c;
    __device__ __forceinline__ void init(const bf16* A, int lda_, const bf16* B, int M, int N, int K_, int G_, int c_) { Abase = (const char*)A; Bt = (const char*)B; lda = lda_; K = K_; nM = M / BM; nN = N / BM; nwg = nM * nN; G = G_; c = c_; }
    __device__ __forceinline__ bool next(int i, Unit& u) const {
        const long L = (long)i * G + c; if (L >= nwg) return false;
        int wgid = (int)L; { const int q = nwg / NXCD, r = nwg % NXCD, xcd = wgid % NXCD, off = wgid / NXCD; wgid = (xcd < r ? xcd * (q + 1) : r * (q + 1) + (xcd - r) * q) + off; }
        const int nig = WGM * nN, gid = wgid / nig, fm = gid * WGM, gsz = (nM - fm) < WGM ? (nM - fm) : WGM;
        u.pm = fm + ((wgid % nig) % gsz); u.pn = (wgid % nig) / gsz; u.e = 0; return true;
    }
    __device__ __forceinline__ const char* bbase(const Unit& u) const { return Bt + (size_t)u.pn * BM * K * 2; }
    __device__ __forceinline__ void aoffs(const Unit& u, const int (&R)[2], const int (&C)[2], unsigned (&o)[4]) const {
#pragma unroll
        for (int h = 0; h < 2; ++h)
#pragma unroll
            for (int i = 0; i < 2; ++i) o[2 * h + i] = (unsigned)(((size_t)(u.pm * BM + h * HALF + R[i]) * lda + C[i]) * 2);
    }
};
__device__ __forceinline__ bool xcd_range_unit(int i, int nunits, int G, int c, int& L) {
    const int x = c % NXCD, cc = c / NXCD, per = G / NXCD, q = nunits / NXCD, r = nunits % NXCD;
    const int start = x * q + (x < r ? x : r), cnt = q + (x < r ? 1 : 0), li = i * per + cc;
    if (li >= cnt) return false; L = start + li; return true;
}
struct MoeUpProb {
    int K; const char* Abase; const char* W13; const int* sorted; const LAS int* tile_e; int ntiles, nunits, G, c;
    __device__ __forceinline__ bool next(int i, Unit& u) const {
        int L; if (!xcd_range_unit(i, nunits, G, c, L)) return false;
        const int tile = L >> 2; u.pn = L & 3;
        if (tile < ntiles) { u.pm = tile; u.e = __builtin_amdgcn_readfirstlane(tile_e[tile]); } else { u.pm = MAXTILES + (tile - ntiles); u.e = NEXP; }
        return true;
    }
    __device__ __forceinline__ const char* bbase(const Unit& u) const { return W13 + ((size_t)u.e * 1024 + (size_t)u.pn * BM) * 2048 * 2; }
    __device__ __forceinline__ void aoffs(const Unit& u, const int (&R)[2], const int (&C)[2], unsigned (&o)[4]) const {
#pragma unroll
        for (int h = 0; h < 2; ++h)
#pragma unroll
            for (int i = 0; i < 2; ++i) { int row;
                if (u.e == NEXP) row = (u.pm - MAXTILES) * BM + h * HALF + R[i];
                else row = sorted[u.pm * BM + h * HALF + R[i]];
                o[2 * h + i] = (unsigned)(((size_t)row * 2048 + C[i]) * 2); }
    }
};
struct MoeDownProb {
    int K; const char* Abase; const char* W2; const LAS int* tile_e; int ntiles, nunits, G, c;
    __device__ __forceinline__ bool next(int i, Unit& u) const {
        int L; if (!xcd_range_unit(i, nunits, G, c, L)) return false;
        const int tile = L >> 3; u.pn = L & 7;
        if (tile < ntiles) { u.pm = tile; u.e = __builtin_amdgcn_readfirstlane(tile_e[tile]); } else { u.pm = MAXTILES + (tile - ntiles); u.e = NEXP; }
        return true;
    }
    __device__ __forceinline__ const char* bbase(const Unit& u) const { return W2 + ((size_t)u.e * 2048 + (size_t)u.pn * BM) * EFF * 2; }
    __device__ __forceinline__ void aoffs(const Unit& u, const int (&R)[2], const int (&C)[2], unsigned (&o)[4]) const {
#pragma unroll
        for (int h = 0; h < 2; ++h)
#pragma unroll
            for (int i = 0; i < 2; ++i) o[2 * h + i] = (unsigned)(((size_t)(u.pm * BM + h * HALF + R[i]) * EFF + C[i]) * 2);
    }
};
struct CmpProb {
    int K; const char* Abase; const char* Bt; int G, c;
    __device__ __forceinline__ bool next(int i, Unit& u) const { const int L = i * G + c; if (L >= 16) return false; u.pm = L; u.pn = 0; u.e = 0; return true; }
    __device__ __forceinline__ const char* bbase(const Unit&) const { return Bt; }
    __device__ __forceinline__ void aoffs(const Unit& u, const int (&R)[2], const int (&C)[2], unsigned (&o)[4]) const {
#pragma unroll
        for (int h = 0; h < 2; ++h)
#pragma unroll
            for (int i = 0; i < 2; ++i) { const int m = u.pm * BM + h * HALF + R[i], seq = m >> 7, n = m & 127;
                o[2 * h + i] = (unsigned)((((size_t)seq * NS + 16 * n) * 128 + C[i]) * 2); }
    }
};
}

struct Args { const float* in[27]; float* out; unsigned char* ws; int ph_lo, ph_hi; };
typedef const __attribute__((address_space(4))) Args* CArgs;
__device__ __forceinline__ const float* kin(int i) { CArgs p = (CArgs)__builtin_amdgcn_kernarg_segment_ptr(); asm volatile("" : "+s"(p)); return p->in[i]; }
struct Frame {
    LAS unsigned char* lds;
    volatile LAS unsigned* MISC;
    unsigned* ctl;
    unsigned char* ws;
    int tid, lane, wave, vcu, G, gw, NGW;
    float* out;
};

__device__ __forceinline__ void tr_item(const float* W, int ldw, int k0, int n0, int nvalid, bf16* WT, int ldt, int drow0, LAS float* scr, int lane) {
    float v[32]; const int n = lane & 31; const bool okn = n < nvalid; const float* src = W + (size_t)(k0 + (lane >> 5)) * ldw + n0 + n;
#pragma unroll
    for (int i = 0; i < 32; ++i) v[i] = okn ? src[(size_t)(2 * i) * ldw] : 0.f;
#pragma unroll
    for (int i = 0; i < 32; ++i) scr[(2 * i + (lane >> 5)) * 33 + n] = v[i];
    LDS_WAIT(); asm volatile("" ::: "memory");
    const int c = lane & 7;
#pragma unroll
    for (int j = 0; j < 4; ++j) { const int nn = (lane >> 3) + 8 * j; const LAS float* sp = scr + (8 * c) * 33 + nn;
        v4u o; o.x = pk2(sp[0 * 33], sp[1 * 33]); o.y = pk2(sp[2 * 33], sp[3 * 33]); o.z = pk2(sp[4 * 33], sp[5 * 33]); o.w = pk2(sp[6 * 33], sp[7 * 33]);
        if (nn < nvalid) *(v4u*)(WT + (size_t)(drow0 + nn) * ldt + k0 + 8 * c) = o; }
    LDS_WAIT(); asm volatile("" ::: "memory");
}
__device__ __forceinline__ bool tr_matrix(int& it, const float* W, int ldw, int K, int c0, int ncols, bf16* WT, int drow0, LAS float* scr, int lane) {
    const int nb = (ncols + 31) / 32, items = (K / 64) * nb;
    if (it >= items) { it -= items; return false; }
    const int kb = it / nb, b = it % nb, nv = ncols - 32 * b;
    tr_item(W, ldw, 64 * kb, c0 + 32 * b, nv < 32 ? nv : 32, WT, K, drow0 + 32 * b, scr, lane);
    return true;
}
__device__ __forceinline__ void zero_rows(Frame& F, bf16* base, size_t nelem) {
    for (size_t i = ((size_t)F.gw * 64 + F.lane) * 8; i < nelem; i += (size_t)F.NGW * 64 * 8) *(v4u*)(base + i) = (v4u){0u, 0u, 0u, 0u};
}

__device__ __forceinline__ void p_prologue(Frame& F) {
    LAS float* scr = (LAS float*)(F.lds + F.wave * 16384);
    unsigned char* ws = F.ws;
    {
        LAS float* wl = (LAS float*)F.lds;
        LAS float* pl = (LAS float*)(F.lds + 32768);
        const float* w_in = kin(2); const float* pool_w = kin(3); const float* pscale = kin(4);
        bf16* WT = (bf16*)(ws + WS_WABIN);
        for (int it = blockIdx.x; it < 4 * 32; it += F.G) {
            const int g = it >> 5, k0 = (it & 31) * 64;
            for (int i = F.tid; i < 64 * 128; i += 512) wl[i] = w_in[(size_t)(k0 + (i >> 7)) * AB_IN + g * 128 + (i & 127)];
            for (int i = F.tid; i < 128 * 128; i += 512) pl[i] = pool_w[(size_t)g * 16384 + i];
            __syncthreads();
            const int d = F.tid & 127, kg = F.tid >> 7; const float sc = pscale[g * 128 + d];
            for (int kk = 0; kk < 16; kk += 8) {
                float a[8];
#pragma unroll
                for (int j = 0; j < 8; ++j) a[j] = 0.f;
                for (int c = 0; c < 128; ++c) { const float pw = pl[c * 128 + d];
#pragma unroll
                    for (int j = 0; j < 8; ++j) a[j] += wl[(kg * 16 + kk + j) * 128 + c] * pw; }
                v4u o; o.x = pk2(a[0] * sc, a[1] * sc); o.y = pk2(a[2] * sc, a[3] * sc); o.z = pk2(a[4] * sc, a[5] * sc); o.w = pk2(a[6] * sc, a[7] * sc);
                *(v4u*)(WT + (size_t)(g * 128 + d) * ND + k0 + kg * 16 + kk) = o;
            }
            __syncthreads();
        }
    }
    __syncthreads();
    for (int it0 = F.gw; ; it0 += F.NGW) {
        int it = it0;
        if (tr_matrix(it, kin(2), AB_IN, ND, 512, AB_IN - 512, (bf16*)(ws + WS_WABIN), 512, scr, F.lane)) continue;
        if (tr_matrix(it, kin(5), ND, ND, 0, ND, (bf16*)(ws + WS_WABOUT), 0, scr, F.lane)) continue;
        if (tr_matrix(it, kin(6), CD_IN, ND, 0, CD_IN, (bf16*)(ws + WS_WCDIN), 0, scr, F.lane)) continue;
        if (tr_matrix(it, kin(14), ND, ND, 0, ND, (bf16*)(ws + WS_WCDOUT), 0, scr, F.lane)) continue;
        if (tr_matrix(it, kin(11), 1536, 384, 0, 1536, (bf16*)(ws + WS_WUQ), 0, scr, F.lane)) continue;
        if (tr_matrix(it, kin(13), 2048, 512, 0, 2048, (bf16*)(ws + WS_WUKV), 0, scr, F.lane)) continue;
        if (tr_matrix(it, kin(8), 128, 4096, 0, 128, (bf16*)(ws + WS_CW1), 0, scr, F.lane)) continue;
        if (tr_matrix(it, kin(8) + (size_t)4096 * 128, 128, 4096, 0, 128, (bf16*)(ws + WS_CW1), 128, scr, F.lane)) continue;
        break;
    }
    zero_rows(F, (bf16*)(ws + WS_WCDIN) + (size_t)CD_IN * ND, (size_t)(CD_INP - CD_IN) * ND);
    { const float* x = kin(0); bf16* xb = (bf16*)(ws + WS_XB0);
      for (size_t i = ((size_t)F.gw * 64 + F.lane) * 8; i < (size_t)NT * ND; i += (size_t)F.NGW * 64 * 8) {
          const f32x4 a = *(const f32x4*)(x + i), b = *(const f32x4*)(x + i + 4);
          v4u o; o.x = pk2(a[0], a[1]); o.y = pk2(a[2], a[3]); o.z = pk2(b[0], b[1]); o.w = pk2(b[2], b[3]); *(v4u*)(xb + i) = o; } }
    if (blockIdx.x == 0 && F.tid < 256) { const int kv = F.tid >> 7, h = F.tid & 127; const float* pos = kin(7) + (size_t)kv * 4096; const float* w1 = kin(8) + (size_t)kv * 4096 * 128;
        float s = 0.f; for (int f = 0; f < 4096; ++f) s += pos[f] * w1[(size_t)f * 128 + h];
        ((float*)(ws + WS_CMPB))[F.tid] = s; }
}
constexpr int MW_ITEMS_L = 65 * 1536 + 64;
__device__ __forceinline__ void moe_weight_item(int l, int it, unsigned char* ws, LAS float* scr, int lane) {
    bf16* W13 = (bf16*)(ws + WS_W13 + (size_t)l * WS_MOE_LSTRIDE); bf16* W2 = (bf16*)(ws + WS_W2 + (size_t)l * WS_MOE_LSTRIDE); bf16* RT = (bf16*)(ws + WS_RT + (size_t)l * MiB);
    if (it >= 65 * 1536) { const int r = it - 65 * 1536, kb = r >> 1, b = r & 1;
        tr_item(kin(19) + (size_t)l * ND * NEXP, NEXP, 64 * kb, 32 * b, 32, RT, ND, 32 * b, scr, lane); return; }
    const int e = it / 1536, r = it % 1536;
    const float *w1, *w3, *w2;
    if (e < NEXP) { const size_t o = ((size_t)l * NEXP + e) * ND * EFF; w1 = kin(21) + o; w3 = kin(22) + o; w2 = kin(23) + o; }
    else { const size_t o = (size_t)l * ND * EFF; w1 = kin(24) + o; w3 = kin(25) + o; w2 = kin(26) + o; }
    if (r < 1024) { const int which = r >> 9, rr = r & 511, kb = rr >> 4, nb = rr & 15;
        const int j = nb >> 2, drow = j * 256 + which * 128 + (nb & 3) * 32;
        tr_item(which ? w3 : w1, EFF, 64 * kb, 32 * nb, 32, W13 + (size_t)e * 1024 * ND, ND, drow, scr, lane); }
    else { const int rr = r - 1024, kb = rr >> 6, nb = rr & 63;
        tr_item(w2, ND, 64 * kb, 32 * nb, 32, W2 + (size_t)e * ND * EFF, EFF, 32 * nb, scr, lane); }
}
__device__ __forceinline__ void p_moe_weights_queue(Frame& F, unsigned* queue) {
    LAS float* scr = (LAS float*)(F.lds + F.wave * 16384);
    constexpr int BATCH = 16, NB_ = (2 * MW_ITEMS_L + BATCH - 1) / BATCH;
    for (;;) {
        unsigned bq = 0; if (F.lane == 0) bq = atomicAdd(queue, 1u);
        const int bi = __builtin_amdgcn_readfirstlane((int)bq);
        if (bi >= NB_) break;
        for (int k = 0; k < BATCH; ++k) { const int it = bi * BATCH + k; if (it >= 2 * MW_ITEMS_L) break; const int l = it >= MW_ITEMS_L ? 1 : 0; moe_weight_item(l, it - l * MW_ITEMS_L, F.ws, scr, F.lane); }
    }
    for (int l = 0; l < 2; ++l) zero_rows(F, (bf16*)(F.ws + WS_RT + (size_t)l * MiB) + (size_t)NEXP * ND, (size_t)(256 - NEXP) * ND);
}

__device__ __forceinline__ void ln_finish(float (&v)[4][8], const float* g, const float* b, int lane, bf16* ob, float* of) {
    float s = 0.f;
#pragma unroll
    for (int j = 0; j < 4; ++j)
#pragma unroll
        for (int i = 0; i < 8; ++i) s += v[j][i];
    const float mean = wave_sum(s) * (1.f / ND); float s2 = 0.f;
#pragma unroll
    for (int j = 0; j < 4; ++j)
#pragma unroll
        for (int i = 0; i < 8; ++i) { v[j][i] -= mean; s2 += v[j][i] * v[j][i]; }
    const float rstd = 1.f / sqrtf(wave_sum(s2) * (1.f / ND) + LN_EPS);
#pragma unroll
    for (int j = 0; j < 4; ++j) { const int c0 = (j * 64 + lane) * 8;
        const f32x4 g0 = *(const f32x4*)(g + c0), g1 = *(const f32x4*)(g + c0 + 4), b0 = *(const f32x4*)(b + c0), b1 = *(const f32x4*)(b + c0 + 4);
        float o[8];
#pragma unroll
        for (int i = 0; i < 4; ++i) { o[i] = v[j][i] * rstd * g0[i] + b0[i]; o[4 + i] = v[j][4 + i] * rstd * g1[i] + b1[i]; }
        if (ob) { v4u w; w.x = pk2(o[0], o[1]); w.y = pk2(o[2], o[3]); w.z = pk2(o[4], o[5]); w.w = pk2(o[6], o[7]); *(v4u*)(ob + c0) = w; }
        if (of) { *(f32x4*)(of + c0) = (f32x4){o[0], o[1], o[2], o[3]}; *(f32x4*)(of + c0 + 4) = (f32x4){o[4], o[5], o[6], o[7]}; } }
}
__device__ __forceinline__ void p_ln1(Frame& F, const bf16* xin, const bf16* mixo, const float* g, const float* b, bf16* xo) {
    for (int m = F.gw; m < NT; m += F.NGW) {
        float v[4][8];
#pragma unroll
        for (int j = 0; j < 4; ++j) { const size_t o = (size_t)m * ND + (j * 64 + F.lane) * 8; float a[8], c[8]; unpack8(*(const v4u*)(xin + o), a); unpack8(*(const v4u*)(mixo + o), c);
#pragma unroll
            for (int i = 0; i < 8; ++i) v[j][i] = DN_ALPHA * a[i] + c[i]; }
        ln_finish(v, g, b, F.lane, xo + (size_t)m * ND, nullptr);
    }
}
__device__ __forceinline__ void p_combine_ln2(Frame& F, const bf16* x1, const bf16* y2, const int* slot, const float* wsel, const float* g, const float* b, bf16* xo, float* fo) {
    for (int m = F.gw; m < NT; m += F.NGW) {
        float v[4][8];
#pragma unroll
        for (int j = 0; j < 4; ++j) { const size_t o = (size_t)m * ND + (j * 64 + F.lane) * 8; float a[8], c[8]; unpack8(*(const v4u*)(x1 + o), a);
            unpack8(*(const v4u*)(y2 + (size_t)(SH_ROW0 + m) * ND + (j * 64 + F.lane) * 8), c);
#pragma unroll
            for (int i = 0; i < 8; ++i) v[j][i] = DN_ALPHA * a[i] + c[i]; }
        for (int k = 0; k < 8; ++k) { const int row = slot[m * 8 + k]; const float w = wsel[m * 8 + k];
#pragma unroll
            for (int j = 0; j < 4; ++j) { float c[8]; unpack8(*(const v4u*)(y2 + (size_t)row * ND + (j * 64 + F.lane) * 8), c);
#pragma unroll
                for (int i = 0; i < 8; ++i) v[j][i] += w * c[i]; } }
        ln_finish(v, g, b, F.lane, xo ? xo + (size_t)m * ND : nullptr, fo ? fo + (size_t)m * ND : nullptr);
    }
}

__device__ __forceinline__ void p_pool_rope(Frame& F) {
    const bf16* proj = (const bf16*)(F.ws + WS_PROJ); bf16* mixin = (bf16*)(F.ws + WS_MIXIN); bf16* qr = (bf16*)(F.ws + WS_QR); bf16* kr = (bf16*)(F.ws + WS_KR);
    const int* pos = (const int*)kin(1);
    for (int m = F.gw; m < NT; m += F.NGW) {
        const int s = m & (NS - 1);
        { const int g = F.lane >> 4, w = 2 << g; const int lo = (s + 1 - w) > 0 ? (s + 1 - w) : 0; const float cnt = (float)((s + 1) < w ? (s + 1) : w);
          float acc[8], cur[8];
#pragma unroll
          for (int i = 0; i < 8; ++i) acc[i] = 0.f;
          for (int j = lo; j <= s; ++j) { float t[8]; unpack8(*(const v4u*)(proj + (size_t)(m - s + j) * AB_IN + F.lane * 8), t);
#pragma unroll
              for (int i = 0; i < 8; ++i) acc[i] += t[i]; }
          unpack8(*(const v4u*)(proj + (size_t)m * AB_IN + F.lane * 8), cur);
          float o[8];
#pragma unroll
          for (int i = 0; i < 8; ++i) o[i] = acc[i] / cnt - cur[i];
          v4u wv; wv.x = pk2(o[0], o[1]); wv.y = pk2(o[2], o[3]); wv.z = pk2(o[4], o[5]); wv.w = pk2(o[6], o[7]); *(v4u*)(mixin + (size_t)m * ND + F.lane * 8) = wv; }
        { const float p = (float)pos[m]; const float invf = exp2f(-(float)F.lane * (13.287712379549449f / 64.f));
          float sn, cs; sincosf(p * invf, &sn, &cs);
          const bf16* qrow = proj + (size_t)m * AB_IN + 512; const bf16* krow = proj + (size_t)m * AB_IN + 1280;
#pragma unroll
          for (int h = 0; h < 6; ++h) {
              const float q1 = bf1(qrow[h * 128 + F.lane]), q2 = bf1(qrow[h * 128 + 64 + F.lane]);
              qr[(size_t)m * 768 + h * 128 + F.lane] = (bf16)f2bf(q1 * cs - q2 * sn); qr[(size_t)m * 768 + h * 128 + 64 + F.lane] = (bf16)f2bf(q1 * sn + q2 * cs);
              const float k1 = bf1(krow[h * 128 + F.lane]), k2 = bf1(krow[h * 128 + 64 + F.lane]); const float ksc = 0.08838834764831845f;
              kr[(size_t)m * 768 + h * 128 + F.lane] = (bf16)f2bf((k1 * cs - k2 * sn) * ksc); kr[(size_t)m * 768 + h * 128 + 64 + F.lane] = (bf16)f2bf((k1 * sn + k2 * cs) * ksc);
          } }
    }
}
namespace ret {
typedef short v4i16_t __attribute__((ext_vector_type(4)));
constexpr int PITCH = 272, TILE = 128 * PITCH;
__device__ __forceinline__ bf16x8 trfrag(LAS unsigned char* trb, int r0, int r1, int c0) {
    const v4i16_t a = __builtin_amdgcn_ds_read_tr16_b64_v4i16((LAS v4i16_t*)(trb + r0 * PITCH + c0 * 2));
    const v4i16_t b = __builtin_amdgcn_ds_read_tr16_b64_v4i16((LAS v4i16_t*)(trb + r1 * PITCH + c0 * 2));
    return (bf16x8){a[0], a[1], a[2], a[3], b[0], b[1], b[2], b[3]};
}
}
__device__ __forceinline__ void p_retention_mfma(Frame& F, int bh) {
    const bf16* proj = (const bf16*)(F.ws + WS_PROJ); bf16* mixin = (bf16*)(F.ws + WS_MIXIN); const bf16* qr = (const bf16*)(F.ws + WS_QR); const bf16* kr = (const bf16*)(F.ws + WS_KR);
    constexpr int P = ret::PITCH;
    LAS unsigned char* KT = F.lds; LAS unsigned char* VT = F.lds + ret::TILE; LAS unsigned char* ST = F.lds + 2 * ret::TILE;
    const int b = bh / 6, h = bh % 6, w = F.wave, lane = F.lane, i16 = lane & 15, g = lane >> 4, q4 = (lane & 15) >> 2, p4 = lane & 3;
    const float lg = log2f(1.0f - exp2f(-5.0f - (float)h)), gc = exp2f(128.f * lg);
    const int rowb = i16 * P + 16 * g;
    const int trl = q4 * P + 8 * p4;
    LAS unsigned char* const trV4 = VT + trl + 4 * g * P;
    LAS unsigned char* const trV8 = VT + trl + 8 * g * P;
    LAS unsigned char* const trK8 = KT + trl + 8 * g * P;
    f32x4 T[2][8];
#pragma unroll
    for (int a = 0; a < 2; ++a)
#pragma unroll
        for (int d = 0; d < 8; ++d) T[a][d] = (f32x4){0.f, 0.f, 0.f, 0.f};
    const int srow = F.tid >> 2, scb = (F.tid & 3) * 4;
    for (int n = 0; n < NS / 128; ++n) {
        const size_t m0 = (size_t)b * NS + n * 128;
        { const float fk = exp2f(-(float)srow * lg);
#pragma unroll
          for (int c = 0; c < 4; ++c) { const int c8 = scb + c; float t[8];
              unpack8(*(const v4u*)(kr + (m0 + srow) * 768 + h * 128 + c8 * 8), t);
              v4u o; o.x = pk2(t[0] * fk, t[1] * fk); o.y = pk2(t[2] * fk, t[3] * fk); o.z = pk2(t[4] * fk, t[5] * fk); o.w = pk2(t[6] * fk, t[7] * fk); *(LAS v4u*)(KT + srow * P + c8 * 16) = o; } }
        bf16x8 qf[4], pf[4]; float rs[4] = {0.f, 0.f, 0.f, 0.f}, rq[4] = {0.f, 0.f, 0.f, 0.f};
        { const float fq = exp2f((float)(16 * w + i16) * lg);
#pragma unroll
          for (int ks = 0; ks < 4; ++ks) { float t[8]; unpack8(*(const v4u*)(qr + (m0 + 16 * w + i16) * 768 + h * 128 + 32 * ks + 8 * g), t);
              v4u o; o.x = pk2(t[0] * fq, t[1] * fq); o.y = pk2(t[2] * fq, t[3] * fq); o.z = pk2(t[4] * fq, t[5] * fq); o.w = pk2(t[6] * fq, t[7] * fq); qf[ks] = __builtin_bit_cast(bf16x8, o); } }
#pragma unroll
        for (int hv = 0; hv < 2; ++hv) {
            if (hv == 1) __syncthreads();
#pragma unroll
            for (int c = 0; c < 4; ++c) { const int c8 = scb + c; *(LAS v4u*)(VT + srow * P + c8 * 16) = *(const v4u*)(proj + (m0 + srow) * AB_IN + 2048 + h * 256 + hv * 128 + c8 * 8); }
            { LAS unsigned char* stw = ST + (16 * w + 4 * g) * P + i16 * 2;
#pragma unroll
              for (int dt = 0; dt < 8; ++dt)
#pragma unroll
                for (int r = 0; r < 4; ++r) { T[hv][dt][r] *= gc; *(LAS bf16*)(stw + r * P + dt * 32) = (bf16)f2bf(T[hv][dt][r]); } }
            __syncthreads();
            if (hv == 0) {
                f32x4 sc[8];
#pragma unroll
                for (int mt = 0; mt < 8; ++mt) { sc[mt] = (f32x4){0.f, 0.f, 0.f, 0.f};
                    if (mt <= w) {
#pragma unroll
                        for (int ks = 0; ks < 4; ++ks) { const bf16x8 kf = *(const LAS bf16x8*)(KT + rowb + mt * 16 * P + ks * 64); sc[mt] = __builtin_amdgcn_mfma_f32_16x16x32_bf16(kf, qf[ks], sc[mt], 0, 0, 0); }
                        if (mt == w) {
#pragma unroll
                            for (int r = 0; r < 4; ++r) sc[mt][r] = (4 * g + r <= i16) ? sc[mt][r] : 0.f; } } }
#pragma unroll
                for (int k2 = 0; k2 < 4; ++k2) { v4u wv; wv.x = pk2(sc[2 * k2][0], sc[2 * k2][1]); wv.y = pk2(sc[2 * k2][2], sc[2 * k2][3]); wv.z = pk2(sc[2 * k2 + 1][0], sc[2 * k2 + 1][1]); wv.w = pk2(sc[2 * k2 + 1][2], sc[2 * k2 + 1][3]);
                    pf[k2] = __builtin_bit_cast(bf16x8, wv); }
            }
#pragma unroll
            for (int nt = 0; nt < 8; ++nt) { f32x4 acc = (f32x4){0.f, 0.f, 0.f, 0.f};
#pragma unroll
                for (int k2 = 0; k2 < 4; ++k2) if (2 * k2 <= w) { const bf16x8 vf = ret::trfrag(trV4, 32 * k2, 32 * k2 + 16, 16 * nt); acc = __builtin_amdgcn_mfma_f32_16x16x32_bf16(pf[k2], vf, acc, 0, 0, 0); }
#pragma unroll
                for (int ks = 0; ks < 4; ++ks) { const bf16x8 sf = *(const LAS bf16x8*)(ST + rowb + nt * 16 * P + ks * 64); acc = __builtin_amdgcn_mfma_f32_16x16x32_bf16(qf[ks], sf, acc, 0, 0, 0); }
#pragma unroll
                for (int r = 0; r < 4; ++r) { rs[r] += acc[r]; rq[r] += acc[r] * acc[r]; mixin[(m0 + 16 * w + 4 * g + r) * ND + 512 + h * 256 + hv * 128 + 16 * nt + i16] = (bf16)f2bf(acc[r]); } }
#pragma unroll
            for (int ks = 0; ks < 4; ++ks) { const bf16x8 af = ret::trfrag(trV8, 32 * ks, 32 * ks + 4, 16 * w);
#pragma unroll
                for (int dt = 0; dt < 8; ++dt) { const bf16x8 bfr = ret::trfrag(trK8, 32 * ks, 32 * ks + 4, 16 * dt); T[hv][dt] = __builtin_amdgcn_mfma_f32_16x16x32_bf16(af, bfr, T[hv][dt], 0, 0, 0); } }
        }
#pragma unroll
        for (int r = 0; r < 4; ++r) { float sm = rs[r], s2 = rq[r];
            sm += __shfl_xor(sm, 1); sm += __shfl_xor(sm, 2); sm += __shfl_xor(sm, 4); sm += __shfl_xor(sm, 8);
            s2 += __shfl_xor(s2, 1); s2 += __shfl_xor(s2, 2); s2 += __shfl_xor(s2, 4); s2 += __shfl_xor(s2, 8);
            const float mean = sm * (1.f / 256.f); const float var = fmaxf(s2 * (1.f / 256.f) - mean * mean, 0.f);
            const float rstd = 1.f / sqrtf(var + NORM_EPS);
            const size_t m = m0 + 16 * w + 4 * g + r;
#pragma unroll
            for (int t = 0; t < 16; ++t) { bf16* yp = mixin + m * ND + 512 + h * 256 + 16 * t + i16; const float gt = bf1(proj[m * AB_IN + 3584 + h * 256 + 16 * t + i16]);
                *yp = (bf16)f2bf((bf1(*yp) - mean) * rstd * siluf_(gt)); } }
        __syncthreads();
    }
}

__device__ __forceinline__ void p_route(Frame& F, int l) {
    const float* logits = (const float*)(F.ws + WS_LOGITS); const float* rbias = kin(20) + l * NEXP;
    int* tope = (int*)(F.ws + WS_TOPE); float* wsel = (float*)(F.ws + WS_WSEL); int* posb = (int*)(F.ws + WS_SLOT); unsigned* cnt = F.ctl + CW_CNT + l * 64;
    const float bias = rbias[F.lane];
    for (int m = F.gw; m < NT; m += F.NGW) {
        const float sc = sigmoidf_(logits[(size_t)m * 256 + F.lane]), bi = sc + bias;
        const int grp = F.lane >> 3;
        int rk = 0;
#pragma unroll
        for (int j = 1; j < 8; ++j) { const int o = (F.lane & ~7) | ((F.lane + j) & 7); const float ov = __shfl(bi, o); rk += ((ov > bi) || (ov == bi && o < F.lane)) ? 1 : 0; }
        float gs = rk < 2 ? bi : 0.f; gs += __shfl_xor(gs, 1); gs += __shfl_xor(gs, 2); gs += __shfl_xor(gs, 4);
        int grk = 0;
#pragma unroll
        for (int gg = 0; gg < 8; ++gg) { const float ov = __shfl(gs, gg * 8); grk += (gg != grp && ((ov > gs) || (ov == gs && gg < grp))) ? 1 : 0; }
        const float mv = grk < 4 ? bi : -1e30f;
        int erk = 0;
        for (int j = 0; j < 64; ++j) { const float ov = __shfl(mv, j); erk += ((ov > mv) || (ov == mv && j < F.lane)) ? 1 : 0; }
        const bool sel = erk < 8;
        const float wsum = wave_sum(sel ? sc : 0.f);
        if (sel) { const unsigned p = atomicAdd(&cnt[F.lane], 1u); tope[m * 8 + erk] = F.lane; wsel[m * 8 + erk] = sc / wsum * 2.5f; posb[m * 8 + erk] = (int)p; }
    }
}
__device__ __forceinline__ void load_offsets(Frame& F, int l) {
    volatile LAS int* tab = (volatile LAS int*)(F.lds + TAB_OFF);
    __syncthreads();
    if (F.tid < NEXP) tab[66 + F.tid] = (int)__hip_atomic_load(F.ctl + CW_CNT + l * 64 + F.tid, __ATOMIC_RELAXED, __HIP_MEMORY_SCOPE_AGENT);
    __syncthreads();
    if (F.tid == 0) { int o = 0; for (int e = 0; e < NEXP; ++e) { tab[e] = o; int c = tab[66 + e]; if (c > NT) c = NT; const int nt_ = (c + 255) >> 8; for (int t = 0; t < nt_; ++t) { const int ti = (o >> 8) + t; if (ti < MAXTILES) tab[160 + ti] = e; } o += nt_ << 8; if (o > MAXROWS) o = MAXROWS; }
        tab[64] = o; tab[65] = o >> 8; }
    __syncthreads();
}
__device__ __forceinline__ void p_scatter(Frame& F, int l) {
    load_offsets(F, l);
    const LAS int* tab = (const LAS int*)(F.lds + TAB_OFF);
    const int* tope = (const int*)(F.ws + WS_TOPE); int* slot = (int*)(F.ws + WS_SLOT); int* sorted = (int*)(F.ws + WS_SORTED);
    for (int i = F.gw * 64 + F.lane; i < NT * 8; i += F.NGW * 64) { const int e = tope[i]; const int row = tab[e] + slot[i]; sorted[row] = i >> 3; slot[i] = row; }
    for (int i = F.gw * 64 + F.lane; i < NEXP * 256; i += F.NGW * 64) { const int e = i >> 8, j = i & 255; const int r = tab[e] + tab[66 + e] + j; if (r < tab[e + 1]) sorted[r] = 0; }
}

__device__ __forceinline__ void p_l1_thin_a(Frame& F) {
    const bf16* proj = (const bf16*)(F.ws + WS_PROJ); const int* pos = (const int*)kin(1);
    bf16* cqn = (bf16*)(F.ws + WS_CQN); bf16* ckvn = (bf16*)(F.ws + WS_CKVN); bf16* krot = (bf16*)(F.ws + WS_KROT); bf16* cmpkv = (bf16*)(F.ws + WS_CMPKV);
    const float* qn = kin(10); const float* kvn = kin(12);
    for (int m = F.gw; m < NT; m += F.NGW) {
        const bf16* row = proj + (size_t)m * CD_INP;
        { float x[6]; float s = 0.f;
#pragma unroll
          for (int j = 0; j < 6; ++j) { x[j] = bf1(row[2584 + j * 64 + F.lane]); s += x[j] * x[j]; }
          const float r = 1.f / sqrtf(wave_sum(s) * (1.f / 384.f) + NORM_EPS);
#pragma unroll
          for (int j = 0; j < 6; ++j) cqn[(size_t)m * 384 + j * 64 + F.lane] = (bf16)f2bf(x[j] * r * qn[j * 64 + F.lane]); }
        { float x[8]; float s = 0.f;
#pragma unroll
          for (int j = 0; j < 8; ++j) { x[j] = bf1(row[2968 + j * 64 + F.lane]); s += x[j] * x[j]; }
          const float r = 1.f / sqrtf(wave_sum(s) * (1.f / 512.f) + NORM_EPS);
#pragma unroll
          for (int j = 0; j < 8; ++j) ckvn[(size_t)m * 512 + j * 64 + F.lane] = (bf16)f2bf(x[j] * r * kvn[j * 64 + F.lane]); }
        { const int i = F.lane & 31; const float p = (float)pos[m]; const float invf = exp2f(-(float)i * (13.287712379549449f / 32.f));
          float sn, cs; sincosf(p * invf, &sn, &cs);
          const float x1 = bf1(row[3480 + i]), x2 = bf1(row[3480 + 32 + i]);
          if (F.lane < 32) krot[(size_t)m * 64 + i] = (bf16)f2bf(x1 * cs - x2 * sn); else krot[(size_t)m * 64 + 32 + i] = (bf16)f2bf(x1 * sn + x2 * cs); }
        { const int b = m >> 11, s = m & (NS - 1);
          const int q4 = F.lane >> 4, c = F.lane & 15, kv = q4 >> 1, g = q4 & 1;
          const v4u w = *(const v4u*)(row + 1024 + q4 * 128 + c * 8);
          *(v4u*)(cmpkv + ((size_t)((kv * 16 + b * 2 + g) * NS + s)) * 128 + c * 8) = w; }
    }
}
__device__ __forceinline__ void p_l1_thin_b(Frame& F) {
    bf16* qmla = (bf16*)(F.ws + WS_QMLA); const int* pos = (const int*)kin(1);
    for (int m = F.gw; m < NT; m += F.NGW) {
        const int i = F.lane & 31; const float p = (float)pos[m]; const float invf = exp2f(-(float)i * (13.287712379549449f / 32.f));
        float sn, cs; sincosf(p * invf, &sn, &cs);
#pragma unroll
        for (int hh = 0; hh < 4; ++hh) { const int h = hh * 2 + (F.lane >> 5); bf16* q = qmla + (size_t)m * 1536 + h * 192 + 128;
            const float x1 = bf1(q[i]), x2 = bf1(q[32 + i]); q[i] = (bf16)f2bf(x1 * cs - x2 * sn); q[32 + i] = (bf16)f2bf(x1 * sn + x2 * cs); }
    }
    const float* hid = (const float*)(F.ws + WS_HID); const float* w2 = kin(9); bf16* kvc = (bf16*)(F.ws + WS_KVCMP);
    for (int m = F.gw; m < 4096; m += F.NGW) {
        const int kv = m >> 11;
        float h0 = hid[(size_t)m * 256 + kv * 128 + F.lane], h1 = hid[(size_t)m * 256 + kv * 128 + 64 + F.lane];
        h0 = 0.5f * h0 * (1.f + tanhf(0.7978845608028654f * (h0 + 0.044715f * h0 * h0 * h0)));
        h1 = 0.5f * h1 * (1.f + tanhf(0.7978845608028654f * (h1 + 0.044715f * h1 * h1 * h1)));
        const float* w = w2 + (size_t)kv * 128 * 128; float o0 = 0.f, o1 = 0.f;
        for (int c = 0; c < 64; ++c) { const float a = __shfl(h0, c), bq = __shfl(h1, c);
            o0 += a * w[c * 128 + F.lane] + bq * w[(c + 64) * 128 + F.lane]; o1 += a * w[c * 128 + 64 + F.lane] + bq * w[(c + 64) * 128 + 64 + F.lane]; }
        kvc[(size_t)m * 128 + F.lane] = (bf16)f2bf(o0); kvc[(size_t)m * 128 + 64 + F.lane] = (bf16)f2bf(o1);
    }
}
__device__ __forceinline__ void p_nsa_cmp_mfma(Frame& F) {
    typedef short v4i16_t __attribute__((ext_vector_type(4)));
    const bf16* proj = (const bf16*)(F.ws + WS_PROJ); const bf16* kvc = (const bf16*)(F.ws + WS_KVCMP); float* ocmp = (float*)(F.ws + WS_OCMP); unsigned* selm = (unsigned*)(F.ws + WS_SELM);
    constexpr int P = 272;
    LAS unsigned char* KT = F.lds; LAS unsigned char* VT = F.lds + 128 * P; LAS float* PS = (LAS float*)(F.lds + 2 * 128 * P);
    const int w = F.wave, lane = F.lane, i16 = lane & 15, g = lane >> 4, q4 = (lane & 15) >> 2, p4 = lane & 3;
    const float sscale = 0.08838834764831845f * 1.4426950408889634f;
    for (int bu = blockIdx.x; bu < 256; bu += F.G) {
        const int bg = bu >> 4, qg = bu & 15, b = bg >> 1, gq = bg & 1;
        __syncthreads();
#pragma unroll
        for (int c = 0; c < 4; ++c) { const int idx = F.tid + 512 * c, row = idx >> 4, c8 = idx & 15;
            v4u kk = (v4u){0u, 0u, 0u, 0u}, vv = (v4u){0u, 0u, 0u, 0u};
            if (row < 127) { kk = *(const v4u*)(kvc + ((size_t)(0 * 16 + bg) * 128 + row) * 128 + c8 * 8); vv = *(const v4u*)(kvc + ((size_t)(1 * 16 + bg) * 128 + row) * 128 + c8 * 8); }
            *(LAS v4u*)(KT + row * P + c8 * 16) = kk; *(LAS v4u*)(VT + row * P + c8 * 16) = vv; }
        for (int k = 0; k < 4; ++k) {
            const int q0 = (qg * 4 + k) * 32, h = gq * 4 + (w >> 1), ql = (w & 1) * 16 + i16, spos = q0 + ql;
            bf16x8 qf[4];
#pragma unroll
            for (int ks = 0; ks < 4; ++ks) qf[ks] = *(const bf16x8*)(proj + (size_t)(b * NS + spos) * CD_INP + h * 128 + 32 * ks + 8 * g);
            __syncthreads();
            const int nvalid = spos >= 31 ? ((spos - 31) >> 4) + 1 : 0;
            f32x4 sc[8]; float mx = -1e30f;
#pragma unroll
            for (int mt = 0; mt < 8; ++mt) { sc[mt] = (f32x4){0.f, 0.f, 0.f, 0.f};
#pragma unroll
                for (int ks = 0; ks < 4; ++ks) { const bf16x8 kf = *(const LAS bf16x8*)(KT + (16 * mt + i16) * P + (32 * ks + 8 * g) * 2); sc[mt] = __builtin_amdgcn_mfma_f32_16x16x32_bf16(kf, qf[ks], sc[mt], 0, 0, 0); }
#pragma unroll
                for (int r = 0; r < 4; ++r) { const bool ok = (16 * mt + 4 * g + r) < nvalid; const float x = ok ? sc[mt][r] * sscale : -1e30f; sc[mt][r] = x; mx = fmaxf(mx, x); } }
            mx = fmaxf(mx, __shfl_xor(mx, 16)); mx = fmaxf(mx, __shfl_xor(mx, 32));
            float ps = 0.f;
#pragma unroll
            for (int mt = 0; mt < 8; ++mt)
#pragma unroll
                for (int r = 0; r < 4; ++r) { const bool ok = (16 * mt + 4 * g + r) < nvalid; const float pv = ok ? __builtin_amdgcn_exp2f(sc[mt][r] - mx) : 0.f; sc[mt][r] = pv; ps += pv; }
            ps += __shfl_xor(ps, 16); ps += __shfl_xor(ps, 32);
            const float inv = ps > 0.f ? 1.f / ps : 0.f;
#pragma unroll
            for (int mt = 0; mt < 8; ++mt)
#pragma unroll
                for (int r = 0; r < 4; ++r) sc[mt][r] *= inv;
            { LAS float* slab = PS + (w >> 2) * 4096 + ql * 128 + 4 * g;
              if (((w >> 1) & 1) == 0) {
#pragma unroll
                  for (int mt = 0; mt < 8; ++mt) *(LAS f32x4*)(slab + 16 * mt) = sc[mt]; }
              __syncthreads();
              if (((w >> 1) & 1) == 1) {
#pragma unroll
                  for (int mt = 0; mt < 8; ++mt) { const f32x4 t = *(const LAS f32x4*)(slab + 16 * mt); *(LAS f32x4*)(slab + 16 * mt) = t + sc[mt]; } } }
            f32x4 O[8];
#pragma unroll
            for (int nt = 0; nt < 8; ++nt) O[nt] = (f32x4){0.f, 0.f, 0.f, 0.f};
#pragma unroll
            for (int k2 = 0; k2 < 4; ++k2) { v4u wv; wv.x = pk2(sc[2 * k2][0], sc[2 * k2][1]); wv.y = pk2(sc[2 * k2][2], sc[2 * k2][3]); wv.z = pk2(sc[2 * k2 + 1][0], sc[2 * k2 + 1][1]); wv.w = pk2(sc[2 * k2 + 1][2], sc[2 * k2 + 1][3]);
                const bf16x8 pf = __builtin_bit_cast(bf16x8, wv);
#pragma unroll
                for (int nt = 0; nt < 8; ++nt) {
                    const v4i16_t a = __builtin_amdgcn_ds_read_tr16_b64_v4i16((LAS v4i16_t*)(VT + (32 * k2 + 4 * g + q4) * P + (16 * nt + 4 * p4) * 2));
                    const v4i16_t c = __builtin_amdgcn_ds_read_tr16_b64_v4i16((LAS v4i16_t*)(VT + (32 * k2 + 16 + 4 * g + q4) * P + (16 * nt + 4 * p4) * 2));
                    const bf16x8 vf = (bf16x8){a[0], a[1], a[2], a[3], c[0], c[1], c[2], c[3]};
                    O[nt] = __builtin_amdgcn_mfma_f32_16x16x32_bf16(pf, vf, O[nt], 0, 0, 0); } }
#pragma unroll
            for (int r = 0; r < 4; ++r) { const size_t m = (size_t)(b * NS + q0 + (w & 1) * 16 + 4 * g + r); const float gt = sigmoidf_(bf1(proj[m * CD_INP + 2560 + h * 3 + 0]));
#pragma unroll
                for (int nt = 0; nt < 8; ++nt) ocmp[m * 1024 + h * 128 + 16 * nt + i16] = gt * O[nt][r]; }
            __syncthreads();
#pragma unroll
            for (int qq = 0; qq < 4; ++qq) { const int qi = 4 * w + qq, s = q0 + qi, cur = s >> 6, j = lane & 31;
                float imp = 0.f;
#pragma unroll
                for (int kk = 0; kk < 4; ++kk) { const int n1 = 4 * j + kk; if (n1 <= 126) imp += PS[qi * 128 + n1] + PS[4096 + qi * 128 + n1]; const int n2 = 4 * j - 1 + kk; if (n2 >= 0 && n2 <= 126) imp += PS[qi * 128 + n2] + PS[4096 + qi * 128 + n2]; }
                const bool forced = (j == 0) || (j == cur) || (j == cur - 1);
                const float score = forced ? 1e4f : ((j * 64 <= s) ? imp : -1e30f);
                int rk = 0;
                for (int jj = 0; jj < 32; ++jj) { const float ov = __shfl(score, jj); rk += ((ov > score) || (ov == score && jj < j)) ? 1 : 0; }
                const bool sel = (lane < 32) && (rk < 16) && (j <= cur);
                const unsigned long long bal = __ballot(sel);
                if (lane == 0) selm[(size_t)(b * NS + s) * 2 + gq] = (unsigned)bal; }
        }
    }
}

namespace fa {
typedef short v4i16_t __attribute__((ext_vector_type(4)));
struct Src { const bf16* k1; size_t ks1; const bf16* k2; size_t ks2; const bf16* v; size_t vs; };
template <int DQK> struct Cfg { static constexpr int KPITCH = (DQK + 8) * 2, KBYTES = 64 * KPITCH, VPITCH = 272, VBYTES = 64 * VPITCH, BUF = KBYTES + VBYTES, NKS = DQK / 32, KCH = DQK / 8, NKR = DQK / 64; };

template <int DQK>
__device__ __forceinline__ void load_tile(const Src& S, int k0, int tid, v4u (&kr)[Cfg<DQK>::NKR], v4u (&vr)[2]) {
    constexpr int KCH = Cfg<DQK>::KCH;
#pragma unroll
    for (int i = 0; i < Cfg<DQK>::NKR; ++i) { const int c = tid + 512 * i, row = c / KCH, c8 = c % KCH;
        const bf16* src = (DQK == 192 && c8 >= 16) ? S.k2 + (size_t)(k0 + row) * S.ks2 + (c8 - 16) * 8 : S.k1 + (size_t)(k0 + row) * S.ks1 + c8 * 8;
        kr[i] = *(const v4u*)src; }
#pragma unroll
    for (int i = 0; i < 2; ++i) { const int c = tid + 512 * i, row = c >> 4, c8 = c & 15; vr[i] = *(const v4u*)(S.v + (size_t)(k0 + row) * S.vs + c8 * 8); }
}
template <int DQK>
__device__ __forceinline__ void store_tile(LAS unsigned char* buf, int tid, const v4u (&kr)[Cfg<DQK>::NKR], const v4u (&vr)[2]) {
    constexpr int KCH = Cfg<DQK>::KCH;
#pragma unroll
    for (int i = 0; i < Cfg<DQK>::NKR; ++i) { const int c = tid + 512 * i, row = c / KCH, c8 = c % KCH; *(LAS v4u*)(buf + row * Cfg<DQK>::KPITCH + c8 * 16) = kr[i]; }
#pragma unroll
    for (int i = 0; i < 2; ++i) { const int c = tid + 512 * i, row = c >> 4, c8 = c & 15; *(LAS v4u*)(buf + Cfg<DQK>::KBYTES + row * Cfg<DQK>::VPITCH + c8 * 16) = vr[i]; }
}
template <int DQK, int MODE>
__device__ __forceinline__ void fa_pass(LAS unsigned char* lds, const Src& S, const bf16x8 (&qf)[Cfg<DQK>::NKS], unsigned tmask, int spos, unsigned rowmask, float sscale,
                                        f32x4 (&O)[8], float& m_run, float& l_run, int tid, int lane) {
    typedef Cfg<DQK> C;
    const int i16 = lane & 15, g = lane >> 4, q4 = (lane & 15) >> 2, p4 = lane & 3;
#pragma unroll
    for (int nt = 0; nt < 8; ++nt) O[nt] = (f32x4){0.f, 0.f, 0.f, 0.f};
    m_run = -1e30f; l_run = 0.f;
    unsigned rem = tmask;
    if (rem == 0u) return;
    v4u kr[C::NKR], vr[2];
    int t = __builtin_ctz(rem); rem &= rem - 1u;
    load_tile<DQK>(S, t * 64, tid, kr, vr);
    __syncthreads();
    store_tile<DQK>(lds, tid, kr, vr);
    __syncthreads();
    int cur = 0;
    for (;;) {
        const bool has_next = rem != 0u; int tn = 0;
        if (has_next) { tn = __builtin_ctz(rem); rem &= rem - 1u; load_tile<DQK>(S, tn * 64, tid, kr, vr); }
        LAS unsigned char* kb = lds + cur * C::BUF; LAS unsigned char* vb = kb + C::KBYTES;
        f32x4 sc[4];
#pragma unroll
        for (int mt = 0; mt < 4; ++mt) { sc[mt] = (f32x4){0.f, 0.f, 0.f, 0.f};
#pragma unroll
            for (int ks = 0; ks < C::NKS; ++ks) { const bf16x8 kf = *(const LAS bf16x8*)(kb + (16 * mt + i16) * C::KPITCH + (32 * ks + 8 * g) * 2);
                sc[mt] = __builtin_amdgcn_mfma_f32_16x16x32_bf16(kf, qf[ks], sc[mt], 0, 0, 0); } }
        float mx = -1e30f; bool vl[4][4];
#pragma unroll
        for (int mt = 0; mt < 4; ++mt)
#pragma unroll
            for (int r = 0; r < 4; ++r) { const int kp = t * 64 + 16 * mt + 4 * g + r; bool ok = kp <= spos;
                if (MODE == 1) ok = ok && ((rowmask >> t) & 1u);
                if (MODE == 2) ok = ok && (kp + 512 > spos);
                vl[mt][r] = ok; const float x = ok ? sc[mt][r] * sscale : -1e30f; sc[mt][r] = x; mx = fmaxf(mx, x); }
        mx = fmaxf(mx, __shfl_xor(mx, 16)); mx = fmaxf(mx, __shfl_xor(mx, 32));
        const float m_new = fmaxf(m_run, mx), alpha = __builtin_amdgcn_exp2f(m_run - m_new); m_run = m_new;
        float ps = 0.f;
#pragma unroll
        for (int mt = 0; mt < 4; ++mt)
#pragma unroll
            for (int r = 0; r < 4; ++r) { const float pv = vl[mt][r] ? __builtin_amdgcn_exp2f(sc[mt][r] - m_new) : 0.f; sc[mt][r] = pv; ps += pv; }
        l_run = l_run * alpha + ps;
        float ar[4];
#pragma unroll
        for (int r = 0; r < 4; ++r) ar[r] = __shfl(alpha, 4 * g + r);
#pragma unroll
        for (int nt = 0; nt < 8; ++nt)
#pragma unroll
            for (int r = 0; r < 4; ++r) O[nt][r] *= ar[r];
        bf16x8 pf[2];
#pragma unroll
        for (int k2 = 0; k2 < 2; ++k2) { v4u w; w.x = pk2(sc[2 * k2][0], sc[2 * k2][1]); w.y = pk2(sc[2 * k2][2], sc[2 * k2][3]); w.z = pk2(sc[2 * k2 + 1][0], sc[2 * k2 + 1][1]); w.w = pk2(sc[2 * k2 + 1][2], sc[2 * k2 + 1][3]);
            pf[k2] = __builtin_bit_cast(bf16x8, w); }
#pragma unroll
        for (int nt = 0; nt < 8; ++nt)
#pragma unroll
            for (int k2 = 0; k2 < 2; ++k2) {
                const v4i16_t a = __builtin_amdgcn_ds_read_tr16_b64_v4i16((LAS v4i16_t*)(vb + (32 * k2 + 4 * g + q4) * C::VPITCH + (16 * nt + 4 * p4) * 2));
                const v4i16_t b = __builtin_amdgcn_ds_read_tr16_b64_v4i16((LAS v4i16_t*)(vb + (32 * k2 + 16 + 4 * g + q4) * C::VPITCH + (16 * nt + 4 * p4) * 2));
                const bf16x8 vf = (bf16x8){a[0], a[1], a[2], a[3], b[0], b[1], b[2], b[3]};
                O[nt] = __builtin_amdgcn_mfma_f32_16x16x32_bf16(pf[k2], vf, O[nt], 0, 0, 0); }
        if (has_next) store_tile<DQK>(lds + (cur ^ 1) * C::BUF, tid, kr, vr);
        __syncthreads();
        if (!has_next) break;
        t = tn; cur ^= 1;
    }
}
__device__ __forceinline__ void row_inv(float l_run, int lane, float (&inv)[4]) {
    float l = l_run; l += __shfl_xor(l, 16); l += __shfl_xor(l, 32);
    const float li = l > 0.f ? 1.f / l : 0.f; const int g = lane >> 4;
#pragma unroll
    for (int r = 0; r < 4; ++r) inv[r] = __shfl(li, 4 * g + r);
}
}

constexpr int FA_NUNITS = 2048;
__device__ __forceinline__ void p_attn_mfma(Frame& F, unsigned* queue) {
    const bf16* proj = (const bf16*)(F.ws + WS_PROJ); bf16* mixin = (bf16*)(F.ws + WS_MIXIN); const float* ocmp = (const float*)(F.ws + WS_OCMP); const unsigned* selm = (const unsigned*)(F.ws + WS_SELM);
    const bf16* qmla = (const bf16*)(F.ws + WS_QMLA); const bf16* kvu = (const bf16*)(F.ws + WS_KVU); const bf16* krot = (const bf16*)(F.ws + WS_KROT);
    volatile LAS unsigned* qslot = (volatile LAS unsigned*)(F.lds + LDSCTL_OFF);
    const int lane = F.lane, w = F.wave, i16 = lane & 15, g4 = lane >> 4;
    for (;;) {
        __syncthreads();
        if (F.tid == 0) qslot[0] = atomicAdd(queue, 1u);
        __syncthreads();
        const int u = __builtin_amdgcn_readfirstlane((int)qslot[0]);
        if (u >= FA_NUNITS) break;
        if (u < 1024) {
            const int qt = 15 - (u >> 6), bh = u & 63, b = bh >> 3, h = bh & 7, q0 = qt * 128, spos = q0 + 16 * w + i16;
            bf16x8 qf[6];
#pragma unroll
            for (int ks = 0; ks < 6; ++ks) qf[ks] = *(const bf16x8*)(qmla + (size_t)(b * NS + spos) * 1536 + h * 192 + 32 * ks + 8 * g4);
            fa::Src S; S.k1 = kvu + (size_t)(b * NS) * 2048 + h * 256; S.ks1 = 2048; S.k2 = krot + (size_t)(b * NS) * 64; S.ks2 = 64; S.v = S.k1 + 128; S.vs = 2048;
            const int last = (q0 + 127) >> 6; const unsigned tmask = last >= 31 ? 0xffffffffu : ((1u << (last + 1)) - 1u);
            f32x4 O[8]; float m_run, l_run;
            fa::fa_pass<192, 0>(F.lds, S, qf, tmask, spos, 0u, 0.07216878364870322f * 1.4426950408889634f, O, m_run, l_run, F.tid, lane);
            float inv[4]; fa::row_inv(l_run, lane, inv);
#pragma unroll
            for (int r = 0; r < 4; ++r) { bf16* orow = mixin + (size_t)(b * NS + q0 + 16 * w + 4 * g4 + r) * ND + 1024 + h * 128 + i16;
#pragma unroll
                for (int nt = 0; nt < 8; ++nt) orow[16 * nt] = (bf16)f2bf(O[nt][r] * inv[r]); }
        } else {
            const int v = u - 1024, qt = 63 - (v >> 4), bg = v & 15, b = bg >> 1, gq = bg & 1, q0 = qt * 32;
            const int h = gq * 4 + (w >> 1), spos = q0 + (w & 1) * 16 + i16;
            bf16x8 qf[4];
#pragma unroll
            for (int ks = 0; ks < 4; ++ks) qf[ks] = *(const bf16x8*)(proj + (size_t)(b * NS + spos) * CD_INP + h * 128 + 32 * ks + 8 * g4);
            const unsigned rowmask = selm[(size_t)(b * NS + spos) * 2 + gq];
            unsigned um = selm[(size_t)(b * NS + q0 + (lane & 31)) * 2 + gq];
#pragma unroll
            for (int o = 1; o < 32; o <<= 1) um |= (unsigned)__shfl_xor((int)um, o);
            um = (unsigned)__builtin_amdgcn_readfirstlane((int)um);
            const bf16* base = proj + (size_t)(b * NS) * CD_INP;
            const float sscale = 0.08838834764831845f * 1.4426950408889634f;
            f32x4 O[8], Ot[8]; float m_run, l_run, inv[4];
            { fa::Src S; S.k1 = base + 1024 + ((1 * 2 + 0) * 2 + gq) * 128; S.ks1 = CD_INP; S.k2 = nullptr; S.ks2 = 0; S.v = base + 1024 + ((1 * 2 + 1) * 2 + gq) * 128; S.vs = CD_INP;
              fa::fa_pass<128, 1>(F.lds, S, qf, um, spos, rowmask, sscale, O, m_run, l_run, F.tid, lane); }
            fa::row_inv(l_run, lane, inv);
#pragma unroll
            for (int r = 0; r < 4; ++r) { const int sq = q0 + (w & 1) * 16 + 4 * g4 + r; const float g1 = sigmoidf_(bf1(proj[(size_t)(b * NS + sq) * CD_INP + 2560 + h * 3 + 1])) * inv[r];
#pragma unroll
                for (int nt = 0; nt < 8; ++nt) Ot[nt][r] = O[nt][r] * g1; }
            { fa::Src S; S.k1 = base + 1024 + ((2 * 2 + 0) * 2 + gq) * 128; S.ks1 = CD_INP; S.k2 = nullptr; S.ks2 = 0; S.v = base + 1024 + ((2 * 2 + 1) * 2 + gq) * 128; S.vs = CD_INP;
              const int klo = q0 - 511 > 0 ? q0 - 511 : 0, tlo = klo >> 6, thi = (q0 + 31) >> 6;
              const unsigned hm = thi >= 31 ? 0xffffffffu : ((1u << (thi + 1)) - 1u); const unsigned tmask = hm & ~((1u << tlo) - 1u);
              fa::fa_pass<128, 2>(F.lds, S, qf, tmask, spos, 0u, sscale, O, m_run, l_run, F.tid, lane); }
            fa::row_inv(l_run, lane, inv);
#pragma unroll
            for (int r = 0; r < 4; ++r) { const int sq = q0 + (w & 1) * 16 + 4 * g4 + r; const size_t m = (size_t)(b * NS + sq);
                const float g2 = sigmoidf_(bf1(proj[m * CD_INP + 2560 + h * 3 + 2])) * inv[r];
#pragma unroll
                for (int nt = 0; nt < 8; ++nt) { const float oc = ocmp[m * 1024 + h * 128 + 16 * nt + i16]; mixin[m * ND + h * 128 + 16 * nt + i16] = (bf16)f2bf(oc + Ot[nt][r] + O[nt][r] * g2); } }
        }
    }
}

constexpr int NPHASE = 33;


#define IN(k) (lo <= (k) && (k) < hi)
#define SEAM(k) do { if (IN(k) && IN((k) + 1)) { if (MK_ONE_LAUNCH) xcd_barrier(bar); else if (F.tid == 0) __hip_atomic_store(F.ctl + CW_TMO, 0xBAD0u | (unsigned)(k), __ATOMIC_RELAXED, __HIP_MEMORY_SCOPE_AGENT); \
    if (MK_PROBE_PHASE >= 0 && blockIdx.x == 0 && F.tid == 0) { if ((k) == MK_PROBE_PHASE - 1) ((volatile LAS unsigned long long*)(F.lds + LDSCTL_OFF + 64))[0] = __builtin_amdgcn_s_memrealtime(); \
        if ((k) == MK_PROBE_PHASE) ((volatile LAS unsigned long long*)(F.lds + LDSCTL_OFF + 64))[1] = __builtin_amdgcn_s_memrealtime(); } } } while (0)
template <int l>
__device__ __forceinline__ void layer_body(Frame& F, const XcdBarrier& bar, const int lo, const int hi) {
    unsigned char* ws = F.ws;
    bf16* const XB0 = (bf16*)(ws + WS_XB0); bf16* const X1B = (bf16*)(ws + WS_X1B); bf16* const X2B = (bf16*)(ws + WS_X2B);
    bf16* const PROJ = (bf16*)(ws + WS_PROJ); bf16* const MIXIN = (bf16*)(ws + WS_MIXIN); bf16* const MIXO = (bf16*)(ws + WS_MIXO);
    bf16* const HB = (bf16*)(ws + WS_H); bf16* const Y2 = (bf16*)(ws + WS_Y2);
        const int pb = 1 + l * 16;
        const bf16* xin = l == 0 ? XB0 : X2B;
        if (IN(pb + 0)) {
            if (l == 0) { pg8::DenseProb P; P.init(xin, ND, (const bf16*)(ws + WS_WABIN), NT, AB_IN, ND, F.G, (int)blockIdx.x); pg8::EpiBf16 E{PROJ, AB_IN};
                pg8::gemm_phase<pg8::EpiBf16, pg8::DenseProb, true>(F.lds, P, E); }
            else { pg8::DenseProb P; P.init(xin, ND, (const bf16*)(ws + WS_WCDIN), NT, CD_INP, ND, F.G, (int)blockIdx.x); pg8::EpiBf16 E{PROJ, CD_INP};
                pg8::gemm_phase<pg8::EpiBf16, pg8::DenseProb, true>(F.lds, P, E); }
        } SEAM(pb + 0);
        if (l == 0) {
            if (IN(pb + 1)) { p_pool_rope(F); } SEAM(pb + 1);
            if (IN(pb + 2)) { if (blockIdx.x < NB * 6) p_retention_mfma(F, (int)blockIdx.x); __syncthreads(); p_moe_weights_queue(F, F.ctl + CW_CNT + 320); } SEAM(pb + 2);
            SEAM(pb + 3); SEAM(pb + 4); SEAM(pb + 5);
        } else {
            if (IN(pb + 1)) { p_l1_thin_a(F); } SEAM(pb + 1);
            if (IN(pb + 2)) {
                { pg8::CmpProb P; P.K = 4096; P.Abase = (const char*)(ws + WS_CMPKV); P.Bt = (const char*)(ws + WS_CW1); P.G = F.G; P.c = (int)blockIdx.x;
                  pg8::EpiF32 E{(float*)(ws + WS_HID), 256, (const float*)(ws + WS_CMPB)};
                  pg8::gemm_phase<pg8::EpiF32, pg8::CmpProb, true>(F.lds, P, E); }
                { pg8::DenseProb P; P.init((const bf16*)(ws + WS_CQN), 384, (const bf16*)(ws + WS_WUQ), NT, 1536, 384, F.G, (int)blockIdx.x); pg8::EpiBf16 E{(bf16*)(ws + WS_QMLA), 1536};
                  pg8::gemm_phase<pg8::EpiBf16, pg8::DenseProb, true>(F.lds, P, E); }
                { pg8::DenseProb P; P.init((const bf16*)(ws + WS_CKVN), 512, (const bf16*)(ws + WS_WUKV), NT, 2048, 512, F.G, (int)blockIdx.x); pg8::EpiBf16 E{(bf16*)(ws + WS_KVU), 2048};
                  pg8::gemm_phase<pg8::EpiBf16, pg8::DenseProb, true>(F.lds, P, E); }
            } SEAM(pb + 2);
            if (IN(pb + 3)) { p_l1_thin_b(F); } SEAM(pb + 3);
            if (IN(pb + 4)) { p_nsa_cmp_mfma(F); } SEAM(pb + 4);
            if (IN(pb + 5)) { p_attn_mfma(F, F.ctl + CW_CNT + 256); } SEAM(pb + 5);
        }
        if (IN(pb + 6)) { pg8::DenseProb P; P.init(MIXIN, ND, (const bf16*)(ws + (l == 0 ? WS_WABOUT : WS_WCDOUT)), NT, ND, ND, F.G, (int)blockIdx.x); pg8::EpiBf16 E{MIXO, ND};
            pg8::gemm_phase<pg8::EpiBf16, pg8::DenseProb, true>(F.lds, P, E); } SEAM(pb + 6);
        if (IN(pb + 7)) { p_ln1(F, xin, MIXO, kin(15) + l * ND, kin(16) + l * ND, X1B); } SEAM(pb + 7);
        if (IN(pb + 8)) { pg8::DenseProb P; P.init(X1B, ND, (const bf16*)(ws + WS_RT + (size_t)l * MiB), NT, 256, ND, F.G, (int)blockIdx.x); pg8::EpiF32 E{(float*)(ws + WS_LOGITS), 256, nullptr};
            pg8::gemm_phase<pg8::EpiF32, pg8::DenseProb, true>(F.lds, P, E); } SEAM(pb + 8);
        if (IN(pb + 9)) { p_route(F, l); } SEAM(pb + 9);
        if (IN(pb + 10)) { p_scatter(F, l); } SEAM(pb + 10);
        if (IN(pb + 11)) { load_offsets(F, l); const LAS int* tab = (const LAS int*)(F.lds + TAB_OFF);
            pg8::MoeUpProb P; P.K = ND; P.Abase = (const char*)X1B; P.W13 = (const char*)(ws + WS_W13 + (size_t)l * WS_MOE_LSTRIDE); P.sorted = (const int*)(ws + WS_SORTED); P.tile_e = tab + 160; P.ntiles = __builtin_amdgcn_readfirstlane(tab[65]);
            P.nunits = (P.ntiles + NT / 256) * 4; P.G = F.G; P.c = (int)blockIdx.x;
            pg8::EpiSwiglu E{HB};
            pg8::gemm_phase<pg8::EpiSwiglu, pg8::MoeUpProb, true>(F.lds, P, E); } SEAM(pb + 11);
        if (IN(pb + 12)) { load_offsets(F, l); const LAS int* tab = (const LAS int*)(F.lds + TAB_OFF);
            pg8::MoeDownProb P; P.K = EFF; P.Abase = (const char*)HB; P.W2 = (const char*)(ws + WS_W2 + (size_t)l * WS_MOE_LSTRIDE); P.tile_e = tab + 160; P.ntiles = __builtin_amdgcn_readfirstlane(tab[65]);
            P.nunits = (P.ntiles + NT / 256) * 8; P.G = F.G; P.c = (int)blockIdx.x;
            pg8::EpiBf16 E{Y2, ND};
            pg8::gemm_phase<pg8::EpiBf16, pg8::MoeDownProb, true>(F.lds, P, E); } SEAM(pb + 12);
        if (IN(pb + 13)) { p_combine_ln2(F, X1B, Y2, (const int*)(ws + WS_SLOT), (const float*)(ws + WS_WSEL), kin(17) + l * ND, kin(18) + l * ND, l == 0 ? X2B : nullptr, l == 0 ? nullptr : F.out); } SEAM(pb + 13);
        SEAM(pb + 14); SEAM(pb + 15);
    }
__global__ void __launch_bounds__(NWAVES * 64, 2) mk_fwd(Args args) {
    extern __shared__ __attribute__((aligned(16))) unsigned char lds[];
    Frame F;
    F.lds = (LAS unsigned char*)lds;
    F.MISC = (volatile LAS unsigned*)(F.lds + MISC_OFF);
    F.tid = threadIdx.x; F.lane = F.tid & 63; F.wave = __builtin_amdgcn_readfirstlane(F.tid >> 6);
    F.G = gridDim.x; { const int bx = blockIdx.x; F.vcu = (F.G % 8 == 0) ? (bx % 8) * (F.G / 8) + bx / 8 : bx; }
    F.gw = F.vcu * NWAVES + F.wave; F.NGW = F.G * NWAVES;
    F.ws = args.ws; F.ctl = (unsigned*)(args.ws + WS_CTL); F.out = args.out;
    for (int u = F.tid; u < (LDS_BYTES - LDSCTL_OFF) / 4; u += NWAVES * 64) ((LAS unsigned*)(F.lds + LDSCTL_OFF))[u] = 0u;
    __syncthreads();
    XcdBarrier bar; bar.bar = F.ctl + CW_BAR; bar.x = 0; bar.st = nullptr;
    if (MK_ONE_LAUNCH) bar = xcd_barrier_post(F.ctl + CW_BAR, F.MISC + 8);
    const int lo = args.ph_lo, hi = args.ph_hi;
    if (MK_PROBE_PHASE == 0 && blockIdx.x == 0 && F.tid == 0) ((volatile LAS unsigned long long*)(F.lds + LDSCTL_OFF + 64))[0] = __builtin_amdgcn_s_memrealtime();
    unsigned char* ws = args.ws;
    bf16* const XB0 = (bf16*)(ws + WS_XB0); bf16* const X1B = (bf16*)(ws + WS_X1B); bf16* const X2B = (bf16*)(ws + WS_X2B);
    bf16* const PROJ = (bf16*)(ws + WS_PROJ); bf16* const MIXIN = (bf16*)(ws + WS_MIXIN); bf16* const MIXO = (bf16*)(ws + WS_MIXO);
    bf16* const HB = (bf16*)(ws + WS_H); bf16* const Y2 = (bf16*)(ws + WS_Y2);

    if (IN(0)) { p_prologue(F); } SEAM(0);

    layer_body<0>(F, bar, lo, hi);
    layer_body<1>(F, bar, lo, hi);
    if (MK_PROBE_PHASE >= 0 && blockIdx.x == 0 && F.tid == 0) {
        volatile LAS unsigned long long* tsl = (volatile LAS unsigned long long*)(F.lds + LDSCTL_OFF + 64);
        if (MK_PROBE_PHASE == 30) tsl[1] = __builtin_amdgcn_s_memrealtime();
        const unsigned long long span = (tsl[1] - tsl[0]) * MK_PROBE_AMP, t0 = __builtin_amdgcn_s_memrealtime();
        while (__builtin_amdgcn_s_memrealtime() - t0 < span) __builtin_amdgcn_s_sleep(8);
    }
#undef IN
#undef SEAM
}

extern "C" void kernel_launch(void* const* d_in, const int* in_sizes, int n_in, void* d_out, int out_size, void* d_ws, size_t ws_size, hipStream_t stream) {
    static int grid = 0;
    if (grid == 0) {
        if (n_in != 27 || in_sizes[0] != NT * ND || out_size != NT * ND || ws_size < WS_END) { fprintf(stderr, "kernel_launch: unexpected problem (n_in %d, in0 %d, out %d, ws %zu < %zu); nothing launched\n", n_in, n_in > 0 ? in_sizes[0] : -1, out_size, ws_size, (size_t)WS_END); grid = -1; return; }
        int dev = 0, cus = 0, per_cu = 0;
        if (hipGetDevice(&dev) != hipSuccess || hipDeviceGetAttribute(&cus, hipDeviceAttributeMultiprocessorCount, dev) != hipSuccess) { fprintf(stderr, "kernel_launch: device query failed\n"); grid = -1; return; }
        if (hipFuncSetAttribute((const void*)mk_fwd, hipFuncAttributeMaxDynamicSharedMemorySize, LDS_BYTES) != hipSuccess) { fprintf(stderr, "kernel_launch: hipFuncSetAttribute failed\n"); grid = -1; return; }
        if (hipOccupancyMaxActiveBlocksPerMultiprocessor(&per_cu, (const void*)mk_fwd, NWAVES * 64, LDS_BYTES) != hipSuccess || per_cu < 1) fprintf(stderr, "kernel_launch: note: occupancy query reports %d\n", per_cu);
        (void)hipGetLastError();
        grid = cus;
    }
    if (grid < 0) return;
    if (hipMemsetAsync((char*)d_ws + WS_CTL, 0, CTL_ZERO_BYTES, stream) != hipSuccess) { fprintf(stderr, "kernel_launch: memset failed\n"); return; }
    Args a{};
    for (int i = 0; i < 27; ++i) a.in[i] = (const float*)d_in[i];
    a.out = (float*)d_out; a.ws = (unsigned char*)d_ws;
#if MK_ONE_LAUNCH
    a.ph_lo = 0; a.ph_hi = NPHASE;
    hipLaunchKernelGGL(mk_fwd, dim3(grid), dim3(NWAVES * 64), LDS_BYTES, stream, a);
#else
    for (int p = 0; p < NPHASE; ++p) {
        const int lp = (p - 1) & 15;
        if (p >= 1) { const int l = (p - 1) >> 4; if (lp >= 14) continue; if (l == 0 && lp >= 3 && lp <= 5) continue; }
        a.ph_lo = p; a.ph_hi = p + 1;
        hipLaunchKernelGGL(mk_fwd, dim3(grid), dim3(NWAVES * 64), LDS_BYTES, stream, a);
    }
#endif
    const hipError_t le = hipPeekAtLastError();
    if (le != hipSuccess) fprintf(stderr, "kernel_launch: launch failed: %s\n", hipGetErrorName(le));
}
```

```cpp
#include <hip/hip_runtime.h>
#include <cstdio>
#include <cstdint>

#ifndef MK_ONE_LAUNCH
#define MK_ONE_LAUNCH 1
#endif
#ifndef MK_PROBE_PHASE
#define MK_PROBE_PHASE -1
#endif
#ifndef MK_PROBE_LAST
#define MK_PROBE_LAST MK_PROBE_PHASE
#endif
#ifndef MK_PROBE_AMP
#define MK_PROBE_AMP 4
#endif

#define GAS __attribute__((address_space(1)))
#define LAS __attribute__((address_space(3)))
typedef unsigned short bf16;
typedef unsigned v4u __attribute__((ext_vector_type(4)));
typedef unsigned v2u __attribute__((ext_vector_type(2)));
typedef float f32x4 __attribute__((ext_vector_type(4)));
typedef float f32x2 __attribute__((ext_vector_type(2)));
typedef short bf16x8 __attribute__((ext_vector_type(8)));

constexpr int NB = 8, NS = 2048, ND = 2048, NT = NB * NS;
constexpr float DN_ALPHA = 1.41421356237309505f;
constexpr float LN_EPS = 1e-5f, NORM_EPS = 1e-6f;
constexpr int AB_IN = 5120, CD_IN = 3544, CD_INP = 3584;
constexpr int NEXP = 64, EFF = 512;
constexpr int MAXROWS = NT * 8 + NEXP * 256;
constexpr int MAXTILES = MAXROWS / 256;
constexpr int SH_ROW0 = MAXROWS;

constexpr size_t MiB = 1u << 20;
constexpr size_t WS_CTL = 0, CTL_ZERO_BYTES = 1 * MiB;
constexpr size_t WS_TOPE = 1 * MiB, WS_WSEL = WS_TOPE + 512 * 1024, WS_SLOT = 2 * MiB, WS_SORTED = WS_SLOT + 512 * 1024;
constexpr size_t WS_CMPB = 3 * MiB + 256 * 1024, WS_SELM = 3 * MiB + 512 * 1024;
constexpr size_t WS_KVCMP = 4 * MiB;
constexpr size_t WS_HID = 6 * MiB;
constexpr size_t WS_WABIN = 16 * MiB, WS_WABOUT = 36 * MiB, WS_WCDIN = 44 * MiB, WS_WCDOUT = 58 * MiB, WS_WUQ = 66 * MiB, WS_WUKV = 68 * MiB, WS_CW1 = 70 * MiB, WS_RT = 72 * MiB;
constexpr size_t WS_W13 = 74 * MiB, WS_W2 = 334 * MiB, WS_MOE_LSTRIDE = 390 * MiB;
constexpr size_t WS_XB0 = 854 * MiB, WS_X2B = 854 * MiB, WS_X1B = 918 * MiB;
constexpr size_t WS_H = 982 * MiB, WS_Y2 = 1142 * MiB, WS_END = 1782 * MiB;
constexpr size_t WS_PROJ = 982 * MiB, WS_MIXIN = 1142 * MiB, WS_MIXO = 1206 * MiB;
constexpr size_t WS_QR = 1270 * MiB, WS_KR = 1294 * MiB;
constexpr size_t WS_CQN = 1270 * MiB, WS_CKVN = 1282 * MiB, WS_KROT = 1298 * MiB, WS_QMLA = 1302 * MiB, WS_KVU = 1350 * MiB, WS_CMPKV = 1414 * MiB, WS_OCMP = 1434 * MiB;
constexpr size_t WS_LOGITS = 1142 * MiB;
constexpr int CW_TMO = 0, CW_CODE = 1, CW_BAR = 4096, CW_CNT = 16384;

constexpr int RING_BYTES = 131072, LDSCTL_OFF = RING_BYTES, MISC_OFF = LDSCTL_OFF + 320, TAB_OFF = LDSCTL_OFF + 512;
constexpr int LDS_BYTES = 147456;
constexpr int NWAVES = 8;

#define LDS_WAIT() asm volatile("s_waitcnt lgkmcnt(0)" ::: "memory")
#define VM_WAIT() asm volatile("s_waitcnt vmcnt(0)" ::: "memory")
__device__ __forceinline__ unsigned f2bf(float f) { unsigned u = __builtin_bit_cast(unsigned, f); return (u + 0x7fffu + ((u >> 16) & 1u)) >> 16; }
__device__ __forceinline__ unsigned pk2(float lo, float hi) { return f2bf(lo) | (f2bf(hi) << 16); }
__device__ __forceinline__ float bflo(unsigned w) { return __builtin_bit_cast(float, w << 16); }
__device__ __forceinline__ float bfhi(unsigned w) { return __builtin_bit_cast(float, w & 0xffff0000u); }
__device__ __forceinline__ float bf1(bf16 v) { return __builtin_bit_cast(float, ((unsigned)v) << 16); }
__device__ __forceinline__ float wave_sum(float v) {
#pragma unroll
    for (int o = 1; o < 64; o <<= 1) v += __shfl_xor(v, o);
    return v;
}
__device__ __forceinline__ float wave_max(float v) {
#pragma unroll
    for (int o = 1; o < 64; o <<= 1) v = fmaxf(v, __shfl_xor(v, o));
    return v;
}
__device__ __forceinline__ float sigmoidf_(float x) { return 1.0f / (1.0f + __expf(-x)); }
__device__ __forceinline__ float siluf_(float x) { return x / (1.0f + __expf(-x)); }
__device__ __forceinline__ void unpack8(const v4u w, float (&f)[8]) {
    f[0] = bflo(w.x); f[1] = bfhi(w.x); f[2] = bflo(w.y); f[3] = bfhi(w.y); f[4] = bflo(w.z); f[5] = bfhi(w.z); f[6] = bflo(w.w); f[7] = bfhi(w.w);
}

#define XB_TMO      128
#define XB_XCNT(j)  (256  + 64 * (j))
#define XB_XSUB(j)  (1280 + 64 * (j))
#define XB_XGEN(j)  (2304 + 64 * (j))
#define XB_TOP      3328
#define XB_TOPGEN   3392
#define XCD_BAR_WORDS 3456
#define XB_SPIN_CAP (1u << 18)
__device__ __forceinline__ unsigned xb_ld(unsigned* p)              { return __hip_atomic_load(p, __ATOMIC_RELAXED, __HIP_MEMORY_SCOPE_AGENT); }
__device__ __forceinline__ unsigned xb_add(unsigned* p, unsigned v) { return __hip_atomic_fetch_add(p, v, __ATOMIC_RELAXED, __HIP_MEMORY_SCOPE_AGENT); }
__device__ __forceinline__ unsigned xb_xcc_id() { return (unsigned)__builtin_amdgcn_s_getreg((3 << 11) | 20) & 0xFu; }
#define XB_SPIN(cond, bar) do { unsigned _sp = 0; while (cond) { __builtin_amdgcn_s_sleep(1); \
    if ((++_sp & 255u) == 0u) { if (xb_ld(&(bar)[XB_TMO])) break; if (_sp > XB_SPIN_CAP) { atomicAdd(&(bar)[XB_TMO], 1u); break; } } } } while (0)
struct XcdBarrier { unsigned* bar; unsigned x; volatile LAS unsigned* st; };
__device__ __forceinline__ XcdBarrier xcd_barrier_post(unsigned* bar, volatile LAS unsigned* st) {
    XcdBarrier b; b.bar = bar; b.x = xb_xcc_id(); b.st = st;
    if (threadIdx.x == 0) (void)xb_add(&bar[XB_XCNT(b.x)], 1u);
    return b;
}
__device__ __forceinline__ void xcd_barrier_complete(unsigned* bar, unsigned x, unsigned& nloc, unsigned& nx) {
    const unsigned G = gridDim.x * gridDim.y * gridDim.z;
    unsigned sum, cnt, mine, sp = 0u;
    for (;;) {
        sum = 0u; cnt = 0u; mine = 0u;
#pragma unroll
        for (unsigned j = 0; j < 16; ++j) { const unsigned c = xb_ld(&bar[XB_XCNT(j)]); sum += c; cnt += (c > 0u) ? 1u : 0u; mine = (j == x) ? c : mine; }
        if (sum == G) break;
        __builtin_amdgcn_s_sleep(1);
        if ((++sp & 255u) == 0u) { if (xb_ld(&bar[XB_TMO])) break; if (sp > XB_SPIN_CAP) { atomicAdd(&bar[XB_TMO], 1u); break; } }
    }
    nloc = mine > 0u ? mine : 1u; nx = cnt > 0u ? cnt : 1u;
}
__device__ __forceinline__ void xcd_barrier(const XcdBarrier& b) {
    asm volatile("s_waitcnt vmcnt(0)" ::: "memory");
    __syncthreads();
    if (threadIdx.x == 0) {
        unsigned* bar = b.bar;
        __builtin_amdgcn_s_waitcnt(0);
        unsigned nloc = b.st[0], nx = b.st[1];
        if (nloc == 0u) { xcd_barrier_complete(bar, b.x, nloc, nx); b.st[0] = nloc; b.st[1] = nx; }
        const unsigned old = xb_add(&bar[XB_XSUB(b.x)], 1u);
        const unsigned gen = old / nloc;
        if (old + 1u == (gen + 1u) * nloc) {
            __builtin_amdgcn_fence(__ATOMIC_RELEASE, "agent");
            asm volatile("s_waitcnt vmcnt(0)" ::: "memory");
            const unsigned og = xb_add(&bar[XB_TOP], 1u);
            const unsigned tg = og / nx;
            if (og + 1u == (tg + 1u) * nx) xb_add(&bar[XB_TOPGEN], 1u);
            else XB_SPIN(xb_ld(&bar[XB_TOPGEN]) == tg, bar);
            __builtin_amdgcn_fence(__ATOMIC_ACQUIRE, "agent");
            xb_add(&bar[XB_XGEN(b.x)], 1u);
            asm volatile("s_waitcnt vmcnt(0)" ::: "memory");
        } else {
            XB_SPIN(xb_ld(&bar[XB_XGEN(b.x)]) == gen, bar);
            __builtin_amdgcn_fence(__ATOMIC_ACQUIRE, "agent");
            asm volatile("s_waitcnt vmcnt(0)" ::: "memory");
        }
    }
    __syncthreads();
}

namespace pg8 {
constexpr int BM = 256, BK = 64, HALF = 128, HTB = HALF * BK * 2, STAGE_BYTES = 8 * HTB, NXCD = 8, WGM = 8;
__host__ __device__ __forceinline__ int lds_byte(int r, int c) { const int st = (r >> 4) * 2 + (c >> 5), rr = r & 15, cc = c & 31, ob = rr * 64 + cc * 2; return st * 1024 + (ob ^ (((ob >> 9) & 1) << 5)); }
__host__ __device__ __forceinline__ void stage_rc(int b, int& R, int& C) { const int st = b / 1024, sb = b % 1024, swz = sb ^ (((sb >> 9) & 1) << 5); R = (st >> 1) * 16 + swz / 64; C = (st & 1) * 32 + (swz % 64) / 2; }
__host__ __device__ __forceinline__ int perm32(int rho) { const int n = rho >> 4, i = rho & 15; return 8 * (i >> 2) + 4 * n + (i & 3); }
struct Unit { int pm, pn, e; };

__device__ __forceinline__ unsigned cvt_pk_bf16(float lo, float hi) { unsigned r; asm volatile("v_cvt_pk_bf16_f32 %0, %1, %2" : "=v"(r) : "v"(lo), "v"(hi)); return r; }

struct EpiBf16 {
    static constexpr bool PERM = true;
    bf16* O; int ldc;
    __device__ __forceinline__ void operator()(const f32x4 (&acc)[2][2][4][2], const Unit& u, int wr, int wc, int fr, int fq) const {
        const int row0 = u.pm * BM + wr * 64 + fr, col0 = u.pn * BM + wc * 32 + 8 * fq;
#pragma unroll
        for (int ai = 0; ai < 2; ++ai)
#pragma unroll
            for (int m = 0; m < 4; ++m) { bf16* rowp = O + (size_t)(row0 + ai * HALF + m * 16) * ldc + col0;
#pragma unroll
                for (int bj = 0; bj < 2; ++bj) { const f32x4 v0 = acc[ai][bj][m][0], v1 = acc[ai][bj][m][1];
                    v4u w; w.x = cvt_pk_bf16(v0[0], v0[1]); w.y = cvt_pk_bf16(v0[2], v0[3]); w.z = cvt_pk_bf16(v1[0], v1[1]); w.w = cvt_pk_bf16(v1[2], v1[3]);
                    *(v4u*)(rowp + bj * HALF) = w; } }
    }
};
struct EpiF32 {
    static constexpr bool PERM = false;
    float* C; int ldc; const float* bias;
    __device__ __forceinline__ void operator()(const f32x4 (&acc)[2][2][4][2], const Unit& u, int wr, int wc, int fr, int fq) const {
        const int row0 = u.pm * BM + wr * 64 + fr, col0 = u.pn * BM + wc * 32 + 4 * fq;
        f32x4 bv[2][2];
#pragma unroll
        for (int bj = 0; bj < 2; ++bj)
#pragma unroll
            for (int n = 0; n < 2; ++n) bv[bj][n] = bias ? *(const f32x4*)(bias + col0 + bj * HALF + n * 16) : (f32x4){0.f, 0.f, 0.f, 0.f};
#pragma unroll
        for (int ai = 0; ai < 2; ++ai)
#pragma unroll
            for (int m = 0; m < 4; ++m) { float* rowp = C + (size_t)(row0 + ai * HALF + m * 16) * ldc + col0;
#pragma unroll
                for (int bj = 0; bj < 2; ++bj)
#pragma unroll
                    for (int n = 0; n < 2; ++n) *(f32x4*)(rowp + bj * HALF + n * 16) = acc[ai][bj][m][n] + bv[bj][n]; }
    }
};
struct EpiSwiglu {
    static constexpr bool PERM = true;
    bf16* H;
    __device__ __forceinline__ void operator()(const f32x4 (&acc)[2][2][4][2], const Unit& u, int wr, int wc, int fr, int fq) const {
        const int row0 = u.pm * BM + wr * 64 + fr, col0 = u.pn * HALF + wc * 32 + 8 * fq;
#pragma unroll
        for (int ai = 0; ai < 2; ++ai)
#pragma unroll
            for (int m = 0; m < 4; ++m) { bf16* rowp = H + (size_t)(row0 + ai * HALF + m * 16) * EFF + col0;
                float o[8];
#pragma unroll
                for (int n = 0; n < 2; ++n)
#pragma unroll
                    for (int j = 0; j < 4; ++j) { const float h1 = acc[ai][0][m][n][j], h3 = acc[ai][1][m][n][j]; o[n * 4 + j] = siluf_(h1) * h3; }
                v4u w; w.x = cvt_pk_bf16(o[0], o[1]); w.y = cvt_pk_bf16(o[2], o[3]); w.z = cvt_pk_bf16(o[4], o[5]); w.w = cvt_pk_bf16(o[6], o[7]);
                *(v4u*)rowp = w; }
    }
};

template <class Epi, class Prob, bool ALIGN_EPI>
__device__ __forceinline__ void gemm_phase(LAS unsigned char* lds, const Prob& P, const Epi& E) {
    const int tid = threadIdx.x, wid = __builtin_amdgcn_readfirstlane(tid >> 6), lane = tid & 63, wr = wid >> 2, wc = wid & 3, fr = lane & 15, fq = lane >> 4;
    const int K = P.K, nt = K / BK;
    int RA[2], CA[2]; unsigned voffB[2];
#pragma unroll
    for (int i = 0; i < 2; ++i) { int R, C; stage_rc(tid * 16 + i * 8192, R, C); const int Rb = Epi::PERM ? ((R & ~31) + perm32(R & 31)) : R;
        RA[i] = R; CA[i] = C; voffB[i] = (unsigned)(Rb * K + C) * 2u; }
    const size_t kstep = (size_t)(BK * 2);
    const size_t hstep = (size_t)HALF * K * 2;
    const unsigned ldsw = (unsigned)wid * 1024u;
    const int aoff = lds_byte(wr * 64 + fr, fq * 8), boff = lds_byte(wc * 32 + fr, fq * 8);
    const char* const Ab = P.Abase;
#define PG8_SA(b, h) (((b) * 2 + (h)) * HTB)
#define PG8_SB(b, h) ((4 + (b) * 2 + (h)) * HTB)
#define PG8_STAGE(bufoff, gbase, voff) do { _Pragma("unroll") for (int _i = 0; _i < 2; ++_i) \
        __builtin_amdgcn_global_load_lds((const unsigned*)((const char*)(gbase) + (voff)[_i]), (LAS unsigned*)(lds + (bufoff) + ldsw + _i * 8192), 16, 0, 0); } while (0)
#define PG8_STAGE_A(bufoff, kb, o0, o1) do { \
        __builtin_amdgcn_global_load_lds((const unsigned*)(Ab + (kb) + (o0)), (LAS unsigned*)(lds + (bufoff) + ldsw), 16, 0, 0); \
        __builtin_amdgcn_global_load_lds((const unsigned*)(Ab + (kb) + (o1)), (LAS unsigned*)(lds + (bufoff) + ldsw + 8192), 16, 0, 0); } while (0)
#define PG8_LDA(dst, b, h) do { _Pragma("unroll") for (int m = 0; m < 4; ++m) _Pragma("unroll") for (int k = 0; k < 2; ++k) dst[m][k] = *(const LAS bf16x8*)(lds + PG8_SA(b, h) + aoff + m * 2048 + k * 1024); } while (0)
#define PG8_LDB(dst, b, h) do { _Pragma("unroll") for (int n = 0; n < 2; ++n) _Pragma("unroll") for (int k = 0; k < 2; ++k) dst[n][k] = *(const LAS bf16x8*)(lds + PG8_SB(b, h) + boff + n * 2048 + k * 1024); } while (0)
#define PG8_MMA(ai, bj, At, Bt) do { __builtin_amdgcn_s_setprio(1); _Pragma("unroll") for (int m = 0; m < 4; ++m) _Pragma("unroll") for (int n = 0; n < 2; ++n) _Pragma("unroll") for (int k = 0; k < 2; ++k) \
        acc[ai][bj][m][n] = __builtin_amdgcn_mfma_f32_16x16x32_bf16(Bt[n][k], At[m][k], acc[ai][bj][m][n], 0, 0, 0); __builtin_amdgcn_s_setprio(0); } while (0)
#define PG8_WAIT_V(n) asm volatile("s_waitcnt vmcnt(" #n ")" ::: "memory")
#define PG8_WAIT_L(n) asm volatile("s_waitcnt lgkmcnt(" #n ")" ::: "memory")
#define PG8_BAR __builtin_amdgcn_s_barrier()
#define PG8_SCHED __builtin_amdgcn_sched_barrier(0)
    Unit cur, nxt; int ui = 0;
    if (!P.next(0, cur)) return;
    f32x4 acc[2][2][4][2];
#pragma unroll
    for (int a = 0; a < 2; ++a)
#pragma unroll
        for (int b = 0; b < 2; ++b)
#pragma unroll
            for (int m = 0; m < 4; ++m)
#pragma unroll
                for (int n = 0; n < 2; ++n) acc[a][b][m][n] = (f32x4){0.f, 0.f, 0.f, 0.f};
    bf16x8 At[4][2], B0[2][2], B1[2][2];
    unsigned oc[4], on[4];
    P.aoffs(cur, RA, CA, oc);
    const char* cB = P.bbase(cur);
    PG8_STAGE(PG8_SB(0, 0), cB, voffB); PG8_STAGE(PG8_SB(0, 1), cB + hstep, voffB); PG8_STAGE_A(PG8_SA(0, 0), (size_t)0, oc[0], oc[1]); PG8_STAGE_A(PG8_SA(0, 1), (size_t)0, oc[2], oc[3]);
    if (wr == 1) PG8_BAR;
    PG8_WAIT_V(2); PG8_BAR;
    PG8_STAGE(PG8_SB(1, 0), cB + kstep, voffB); PG8_STAGE_A(PG8_SA(1, 0), kstep, oc[0], oc[1]); PG8_STAGE(PG8_SB(1, 1), cB + hstep + kstep, voffB);
    PG8_WAIT_V(6); PG8_BAR;
    for (;;) {
        const bool has_next = P.next(ui + 1, nxt);
        const char* nB = cB;
        if (has_next) { P.aoffs(nxt, RA, CA, on); nB = P.bbase(nxt); }
        else { on[0] = oc[0]; on[1] = oc[1]; on[2] = oc[2]; on[3] = oc[3]; }
        for (int t = 0; t < nt; t += 2) {
            const bool last = (t == nt - 2);
            const size_t kb1 = (size_t)(t + 1) * kstep;
            const size_t kb2 = last ? (size_t)0 : (size_t)(t + 2) * kstep, kb3 = kb2 + kstep;
            const char* b2 = last ? nB : cB + (size_t)(t + 2) * kstep; const char* b3 = b2 + kstep;
            const unsigned o20 = last ? on[0] : oc[0], o21 = last ? on[1] : oc[1], o22 = last ? on[2] : oc[2], o23 = last ? on[3] : oc[3];
            PG8_LDB(B0, 0, 0); PG8_LDB(B1, 0, 1); PG8_SCHED; PG8_LDA(At, 0, 0); PG8_STAGE_A(PG8_SA(1, 1), kb1, oc[2], oc[3]);
            PG8_WAIT_V(8); PG8_WAIT_L(0); PG8_BAR; PG8_MMA(0, 0, At, B0); PG8_MMA(0, 1, At, B1); PG8_BAR; PG8_SCHED;
            PG8_LDA(At, 0, 1); PG8_STAGE(PG8_SB(0, 0), b2, voffB); PG8_STAGE(PG8_SB(0, 1), b2 + hstep, voffB); PG8_STAGE_A(PG8_SA(0, 0), kb2, o20, o21);
            PG8_WAIT_V(8); PG8_WAIT_L(0); PG8_BAR; PG8_MMA(1, 0, At, B0); PG8_MMA(1, 1, At, B1); PG8_BAR; PG8_SCHED;
            PG8_LDB(B0, 1, 0); PG8_LDB(B1, 1, 1); PG8_SCHED; PG8_LDA(At, 1, 0); PG8_STAGE_A(PG8_SA(0, 1), kb2, o22, o23);
            PG8_WAIT_V(8); PG8_WAIT_L(0); PG8_BAR; PG8_MMA(0, 0, At, B0); PG8_MMA(0, 1, At, B1); PG8_BAR; PG8_SCHED;
            PG8_LDA(At, 1, 1); PG8_STAGE(PG8_SB(1, 0), b3, voffB); PG8_STAGE(PG8_SB(1, 1), b3 + hstep, voffB); PG8_STAGE_A(PG8_SA(1, 0), kb3, o20, o21);
            PG8_WAIT_V(8); PG8_WAIT_L(0); PG8_BAR; PG8_MMA(1, 0, At, B0); PG8_MMA(1, 1, At, B1); PG8_BAR; PG8_SCHED;
        }
        if constexpr (ALIGN_EPI) { if (wr == 0) PG8_BAR; }
        E(acc, cur, wr, wc, fr, fq);
        if (!has_next) break;
#pragma unroll
        for (int a = 0; a < 2; ++a)
#pragma unroll
            for (int b = 0; b < 2; ++b)
#pragma unroll
                for (int m = 0; m < 4; ++m)
#pragma unroll
                    for (int n = 0; n < 2; ++n) acc[a][b][m][n] = (f32x4){0.f, 0.f, 0.f, 0.f};
        cur = nxt; cB = nB; oc[0] = on[0]; oc[1] = on[1]; oc[2] = on[2]; oc[3] = on[3]; ++ui;
        if constexpr (ALIGN_EPI) { if (wr == 1) PG8_BAR; }
    }
    PG8_WAIT_V(0);
    if constexpr (!ALIGN_EPI) { if (wr == 0) PG8_BAR; }
    PG8_BAR;
#undef PG8_SA
#undef PG8_SB
#undef PG8_STAGE
#undef PG8_STAGE_A
#undef PG8_LDA
#undef PG8_LDB
#undef PG8_MMA
#undef PG8_WAIT_V
#undef PG8_WAIT_L
#undef PG8_BAR
#undef PG8_SCHED
}

struct DenseProb {
    int K; const char* Abase; const char* Bt; int lda; int nM, nN, nwg, G, c;
    __device__ __forceinline__ void init(const bf16* A, int lda_, const bf16* B, int M, int N, int K_, int G_, int c_) { Abase = (const char*)A; Bt = (const char*)B; lda = lda_; K = K_; nM = M / BM; nN = N / BM; nwg = nM * nN; G = G_; c = c_; }
    __device__ __forceinline__ bool next(int i, Unit& u) const {
        const long L = (long)i * G + c; if (L >= nwg) return false;
        int wgid = (int)L; { const int q = nwg / NXCD, r = nwg % NXCD, xcd = wgid % NXCD, off = wgid / NXCD; wgid = (xcd < r ? xcd * (q + 1) : r * (q + 1) + (xcd - r) * q) + off; }
        const int nig = WGM * nN, gid = wgid / nig, fm = gid * WGM, gsz = (nM - fm) < WGM ? (nM - fm) : WGM;
        u.pm = fm + ((wgid % nig) % gsz); u.pn = (wgid % nig) / gsz; u.e = 0; return true;
    }
    __device__ __forceinline__ const char* bbase(const Unit& u) const { return Bt + (size_t)u.pn * BM * K * 2; }
    __device__ __forceinline__ void aoffs(const Unit& u, const int (&R)[2], const int (&C)[2], unsigned (&o)[4]) const {
#pragma unroll
        for (int h = 0; h < 2; ++h)
#pragma unroll
            for (int i = 0; i < 2; ++i) o[2 * h + i] = (unsigned)(((size_t)(u.pm * BM + h * HALF + R[i]) * lda + C[i]) * 2);
    }
};
__device__ __forceinline__ bool xcd_range_unit(int i, int nunits, int G, int c, int& L) {
    const int x = c % NXCD, cc = c / NXCD, per = G / NXCD, q = nunits / NXCD, r = nunits % NXCD;
    const int start = x * q + (x < r ? x : r), cnt = q + (x < r ? 1 : 0), li = i * per + cc;
    if (li >= cnt) return false; L = start + li; return true;
}
struct MoeUpProb {
    int K; const char* Abase; const char* W13; const int* sorted; const LAS int* tile_e; int ntiles, nunits, G, c;
    __device__ __forceinline__ bool next(int i, Unit& u) const {
        int L; if (!xcd_range_unit(i, nunits, G, c, L)) return false;
        const int tile = L >> 2; u.pn = L & 3;
        if (tile < ntiles) { u.pm = tile; u.e = __builtin_amdgcn_readfirstlane(tile_e[tile]); } else { u.pm = MAXTILES + (tile - ntiles); u.e = NEXP; }
        return true;
    }
    __device__ __forceinline__ const char* bbase(const Unit& u) const { return W13 + ((size_t)u.e * 1024 + (size_t)u.pn * BM) * 2048 * 2; }
    __device__ __forceinline__ void aoffs(const Unit& u, const int (&R)[2], const int (&C)[2], unsigned (&o)[4]) const {
#pragma unroll
        for (int h = 0; h < 2; ++h)
#pragma unroll
            for (int i = 0; i < 2; ++i) { int row;
                if (u.e == NEXP) row = (u.pm - MAXTILES) * BM + h * HALF + R[i];
                else row = sorted[u.pm * BM + h * HALF + R[i]];
                o[2 * h + i] = (unsigned)(((size_t)row * 2048 + C[i]) * 2); }
    }
};
struct MoeDownProb {
    int K; const char* Abase; const char* W2; const LAS int* tile_e; int ntiles, nunits, G, c;
    __device__ __forceinline__ bool next(int i, Unit& u) const {
        int L; if (!xcd_range_unit(i, nunits, G, c, L)) return false;
        const int tile = L >> 3; u.pn = L & 7;
        if (tile < ntiles) { u.pm = tile; u.e = __builtin_amdgcn_readfirstlane(tile_e[tile]); } else { u.pm = MAXTILES + (tile - ntiles); u.e = NEXP; }
        return true;
    }
    __device__ __forceinline__ const char* bbase(const Unit& u) const { return W2 + ((size_t)u.e * 2048 + (size_t)u.pn * BM) * EFF * 2; }
    __device__ __forceinline__ void aoffs(const Unit& u, const int (&R)[2], const int (&C)[2], unsigned (&o)[4]) const {
#pragma unroll
        for (int h = 0; h < 2; ++h)
#pragma unroll
            for (int i = 0; i < 2; ++i) o[2 * h + i] = (unsigned)(((size_t)(u.pm * BM + h * HALF + R[i]) * EFF + C[i]) * 2);
    }
};
struct CmpProb {
    int K; const char* Abase; const char* Bt; int G, c;
    __device__ __forceinline__ bool next(int i, Unit& u) const { const int L = i * G + c; if (L >= 16) return false; u.pm = L; u.pn = 0; u.e = 0; return true; }
    __device__ __forceinline__ const char* bbase(const Unit&) const { return Bt; }
    __device__ __forceinline__ void aoffs(const Unit& u, const int (&R)[2], const int (&C)[2], unsigned (&o)[4]) const {
#pragma unroll
        for (int h = 0; h < 2; ++h)
#pragma unroll
            for (int i = 0; i < 2; ++i) { const int m = u.pm * BM + h * HALF + R[i], seq = m >> 7, n = m & 127;
                o[2 * h + i] = (unsigned)((((size_t)seq * NS + 16 * n) * 128 + C[i]) * 2); }
    }
};
}

struct Args { const float* in[27]; float* out; unsigned char* ws; int ph_lo, ph_hi; };
typedef const __attribute__((address_space(4))) Args* CArgs;
__device__ __forceinline__ const float* kin(int i) { CArgs p = (CArgs)__builtin_amdgcn_kernarg_segment_ptr(); asm volatile("" : "+s"(p)); return p->in[i]; }
struct Frame {
    LAS unsigned char* lds;
    volatile LAS unsigned* MISC;
    unsigned* ctl;
    unsigned char* ws;
    int tid, lane, wave, vcu, G, gw, NGW;
    float* out;
};

__device__ __forceinline__ void tr_item(const float* W, int ldw, int k0, int n0, int nvalid, bf16* WT, int ldt, int drow0, LAS float* scr, int lane) {
    float v[32]; const int n = lane & 31; const bool okn = n < nvalid; const float* src = W + (size_t)(k0 + (lane >> 5)) * ldw + n0 + n;
#pragma unroll
    for (int i = 0; i < 32; ++i) v[i] = okn ? src[(size_t)(2 * i) * ldw] : 0.f;
#pragma unroll
    for (int i = 0; i < 32; ++i) scr[(2 * i + (lane >> 5)) * 33 + n] = v[i];
    LDS_WAIT(); asm volatile("" ::: "memory");
    const int c = lane & 7;
#pragma unroll
    for (int j = 0; j < 4; ++j) { const int nn = (lane >> 3) + 8 * j; const LAS float* sp = scr + (8 * c) * 33 + nn;
        v4u o; o.x = pk2(sp[0 * 33], sp[1 * 33]); o.y = pk2(sp[2 * 33], sp[3 * 33]); o.z = pk2(sp[4 * 33], sp[5 * 33]); o.w = pk2(sp[6 * 33], sp[7 * 33]);
        if (nn < nvalid) *(v4u*)(WT + (size_t)(drow0 + nn) * ldt + k0 + 8 * c) = o; }
    LDS_WAIT(); asm volatile("" ::: "memory");
}
__device__ __forceinline__ bool tr_matrix(int& it, const float* W, int ldw, int K, int c0, int ncols, bf16* WT, int drow0, LAS float* scr, int lane) {
    const int nb = (ncols + 31) / 32, items = (K / 64) * nb;
    if (it >= items) { it -= items; return false; }
    const int kb = it / nb, b = it % nb, nv = ncols - 32 * b;
    tr_item(W, ldw, 64 * kb, c0 + 32 * b, nv < 32 ? nv : 32, WT, K, drow0 + 32 * b, scr, lane);
    return true;
}
__device__ __forceinline__ void zero_rows(Frame& F, bf16* base, size_t nelem) {
    for (size_t i = ((size_t)F.gw * 64 + F.lane) * 8; i < nelem; i += (size_t)F.NGW * 64 * 8) *(v4u*)(base + i) = (v4u){0u, 0u, 0u, 0u};
}

__device__ __forceinline__ void p_prologue(Frame& F) {
    LAS float* scr = (LAS float*)(F.lds + F.wave * 16384);
    unsigned char* ws = F.ws;
    {
        LAS float* wl = (LAS float*)F.lds;
        LAS float* pl = (LAS float*)(F.lds + 32768);
        const float* w_in = kin(2); const float* pool_w = kin(3); const float* pscale = kin(4);
        bf16* WT = (bf16*)(ws + WS_WABIN);
        for (int it = blockIdx.x; it < 4 * 32; it += F.G) {
            const int g = it >> 5, k0 = (it & 31) * 64;
            for (int i = F.tid; i < 64 * 128; i += 512) wl[i] = w_in[(size_t)(k0 + (i >> 7)) * AB_IN + g * 128 + (i & 127)];
            for (int i = F.tid; i < 128 * 128; i += 512) pl[i] = pool_w[(size_t)g * 16384 + i];
            __syncthreads();
            const int d = F.tid & 127, kg = F.tid >> 7; const float sc = pscale[g * 128 + d];
            for (int kk = 0; kk < 16; kk += 8) {
                float a[8];
#pragma unroll
                for (int j = 0; j < 8; ++j) a[j] = 0.f;
                for (int c = 0; c < 128; ++c) { const float pw = pl[c * 128 + d];
#pragma unroll
                    for (int j = 0; j < 8; ++j) a[j] += wl[(kg * 16 + kk + j) * 128 + c] * pw; }
                v4u o; o.x = pk2(a[0] * sc, a[1] * sc); o.y = pk2(a[2] * sc, a[3] * sc); o.z = pk2(a[4] * sc, a[5] * sc); o.w = pk2(a[6] * sc, a[7] * sc);
                *(v4u*)(WT + (size_t)(g * 128 + d) * ND + k0 + kg * 16 + kk) = o;
            }
            __syncthreads();
        }
    }
    __syncthreads();
    for (int it0 = F.gw; ; it0 += F.NGW) {
        int it = it0;
        if (tr_matrix(it, kin(2), AB_IN, ND, 512, AB_IN - 512, (bf16*)(ws + WS_WABIN), 512, scr, F.lane)) continue;
        if (tr_matrix(it, kin(5), ND, ND, 0, ND, (bf16*)(ws + WS_WABOUT), 0, scr, F.lane)) continue;
        if (tr_matrix(it, kin(6), CD_IN, ND, 0, CD_IN, (bf16*)(ws + WS_WCDIN), 0, scr, F.lane)) continue;
        if (tr_matrix(it, kin(14), ND, ND, 0, ND, (bf16*)(ws + WS_WCDOUT), 0, scr, F.lane)) continue;
        if (tr_matrix(it, kin(11), 1536, 384, 0, 1536, (bf16*)(ws + WS_WUQ), 0, scr, F.lane)) continue;
        if (tr_matrix(it, kin(13), 2048, 512, 0, 2048, (bf16*)(ws + WS_WUKV), 0, scr, F.lane)) continue;
        if (tr_matrix(it, kin(8), 128, 4096, 0, 128, (bf16*)(ws + WS_CW1), 0, scr, F.lane)) continue;
        if (tr_matrix(it, kin(8) + (size_t)4096 * 128, 128, 4096, 0, 128, (bf16*)(ws + WS_CW1), 128, scr, F.lane)) continue;
        break;
    }
    zero_rows(F, (bf16*)(ws + WS_WCDIN) + (size_t)CD_IN * ND, (size_t)(CD_INP - CD_IN) * ND);
    { const float* x = kin(0); bf16* xb = (bf16*)(ws + WS_XB0);
      for (size_t i = ((size_t)F.gw * 64 + F.lane) * 8; i < (size_t)NT * ND; i += (size_t)F.NGW * 64 * 8) {
          const f32x4 a = *(const f32x4*)(x + i), b = *(const f32x4*)(x + i + 4);
          v4u o; o.x = pk2(a[0], a[1]); o.y = pk2(a[2], a[3]); o.z = pk2(b[0], b[1]); o.w = pk2(b[2], b[3]); *(v4u*)(xb + i) = o; } }
    for (int o = F.gw; o < 256; o += F.NGW) { const int kv = o >> 7, h = o & 127; const float* pos = kin(7) + (size_t)kv * 4096; const float* w1 = kin(8) + (size_t)kv * 4096 * 128;
        float sacc = 0.f; for (int f = F.lane; f < 4096; f += 64) sacc += pos[f] * w1[(size_t)f * 128 + h];
        sacc = wave_sum(sacc); if (F.lane == 0) ((float*)(ws + WS_CMPB))[o] = sacc; }
}
constexpr int MW_ITEMS_L = 65 * 1536 + 64;
__device__ __forceinline__ void moe_weight_item(int l, int it, unsigned char* ws, LAS float* scr, int lane) {
    bf16* W13 = (bf16*)(ws + WS_W13 + (size_t)l * WS_MOE_LSTRIDE); bf16* W2 = (bf16*)(ws + WS_W2 + (size_t)l * WS_MOE_LSTRIDE); bf16* RT = (bf16*)(ws + WS_RT + (size_t)l * MiB);
    if (it >= 65 * 1536) { const int r = it - 65 * 1536, kb = r >> 1, b = r & 1;
        tr_item(kin(19) + (size_t)l * ND * NEXP, NEXP, 64 * kb, 32 * b, 32, RT, ND, 32 * b, scr, lane); return; }
    const int e = it / 1536, r = it % 1536;
    const float *w1, *w3, *w2;
    if (e < NEXP) { const size_t o = ((size_t)l * NEXP + e) * ND * EFF; w1 = kin(21) + o; w3 = kin(22) + o; w2 = kin(23) + o; }
    else { const size_t o = (size_t)l * ND * EFF; w1 = kin(24) + o; w3 = kin(25) + o; w2 = kin(26) + o; }
    if (r < 1024) { const int which = r >> 9, rr = r & 511, kb = rr >> 4, nb = rr & 15;
        const int j = nb >> 2, drow = j * 256 + which * 128 + (nb & 3) * 32;
        tr_item(which ? w3 : w1, EFF, 64 * kb, 32 * nb, 32, W13 + (size_t)e * 1024 * ND, ND, drow, scr, lane); }
    else { const int rr = r - 1024, kb = rr >> 6, nb = rr & 63;
        tr_item(w2, ND, 64 * kb, 32 * nb, 32, W2 + (size_t)e * ND * EFF, EFF, 32 * nb, scr, lane); }
}
__device__ __forceinline__ void p_moe_weights_queue(Frame& F, unsigned* queue) {
    LAS float* scr = (LAS float*)(F.lds + F.wave * 16384);
    constexpr int BATCH = 16, NB_ = (2 * MW_ITEMS_L + BATCH - 1) / BATCH;
    for (;;) {
        unsigned bq = 0; if (F.lane == 0) bq = atomicAdd(queue, 1u);
        const int bi = __builtin_amdgcn_readfirstlane((int)bq);
        if (bi >= NB_) break;
        for (int k = 0; k < BATCH; ++k) { const int it = bi * BATCH + k; if (it >= 2 * MW_ITEMS_L) break; const int l = it >= MW_ITEMS_L ? 1 : 0; moe_weight_item(l, it - l * MW_ITEMS_L, F.ws, scr, F.lane); }
    }
    for (int l = 0; l < 2; ++l) zero_rows(F, (bf16*)(F.ws + WS_RT + (size_t)l * MiB) + (size_t)NEXP * ND, (size_t)(256 - NEXP) * ND);
}

__device__ __forceinline__ void ln_finish(float (&v)[4][8], const float* g, const float* b, int lane, bf16* ob, float* of) {
    float s = 0.f;
#pragma unroll
    for (int j = 0; j < 4; ++j)
#pragma unroll
        for (int i = 0; i < 8; ++i) s += v[j][i];
    const float mean = wave_sum(s) * (1.f / ND); float s2 = 0.f;
#pragma unroll
    for (int j = 0; j < 4; ++j)
#pragma unroll
        for (int i = 0; i < 8; ++i) { v[j][i] -= mean; s2 += v[j][i] * v[j][i]; }
    const float rstd = 1.f / sqrtf(wave_sum(s2) * (1.f / ND) + LN_EPS);
#pragma unroll
    for (int j = 0; j < 4; ++j) { const int c0 = (j * 64 + lane) * 8;
        const f32x4 g0 = *(const f32x4*)(g + c0), g1 = *(const f32x4*)(g + c0 + 4), b0 = *(const f32x4*)(b + c0), b1 = *(const f32x4*)(b + c0 + 4);
        float o[8];
#pragma unroll
        for (int i = 0; i < 4; ++i) { o[i] = v[j][i] * rstd * g0[i] + b0[i]; o[4 + i] = v[j][4 + i] * rstd * g1[i] + b1[i]; }
        if (ob) { v4u w; w.x = pk2(o[0], o[1]); w.y = pk2(o[2], o[3]); w.z = pk2(o[4], o[5]); w.w = pk2(o[6], o[7]); *(v4u*)(ob + c0) = w; }
        if (of) { *(f32x4*)(of + c0) = (f32x4){o[0], o[1], o[2], o[3]}; *(f32x4*)(of + c0 + 4) = (f32x4){o[4], o[5], o[6], o[7]}; } }
}
__device__ __forceinline__ void p_ln1(Frame& F, const bf16* xin, const bf16* mixo, const float* g, const float* b, bf16* xo) {
    for (int m = F.gw; m < NT; m += F.NGW) {
        float v[4][8];
#pragma unroll
        for (int j = 0; j < 4; ++j) { const size_t o = (size_t)m * ND + (j * 64 + F.lane) * 8; float a[8], c[8]; unpack8(*(const v4u*)(xin + o), a); unpack8(*(const v4u*)(mixo + o), c);
#pragma unroll
            for (int i = 0; i < 8; ++i) v[j][i] = DN_ALPHA * a[i] + c[i]; }
        ln_finish(v, g, b, F.lane, xo + (size_t)m * ND, nullptr);
    }
}
__device__ __forceinline__ void p_combine_ln2(Frame& F, const bf16* x1, const bf16* y2, const int* slot, const float* wsel, const float* g, const float* b, bf16* xo, float* fo) {
    for (int m = F.gw; m < NT; m += F.NGW) {
        float v[4][8];
#pragma unroll
        for (int j = 0; j < 4; ++j) { const size_t o = (size_t)m * ND + (j * 64 + F.lane) * 8; float a[8], c[8]; unpack8(*(const v4u*)(x1 + o), a);
            unpack8(*(const v4u*)(y2 + (size_t)(SH_ROW0 + m) * ND + (j * 64 + F.lane) * 8), c);
#pragma unroll
            for (int i = 0; i < 8; ++i) v[j][i] = DN_ALPHA * a[i] + c[i]; }
        for (int k = 0; k < 8; ++k) { const int row = slot[m * 8 + k]; const float w = wsel[m * 8 + k];
#pragma unroll
            for (int j = 0; j < 4; ++j) { float c[8]; unpack8(*(const v4u*)(y2 + (size_t)row * ND + (j * 64 + F.lane) * 8), c);
#pragma unroll
                for (int i = 0; i < 8; ++i) v[j][i] += w * c[i]; } }
        ln_finish(v, g, b, F.lane, xo ? xo + (size_t)m * ND : nullptr, fo ? fo + (size_t)m * ND : nullptr);
    }
}

__device__ __forceinline__ void p_pool_rope(Frame& F) {
    const bf16* proj = (const bf16*)(F.ws + WS_PROJ); bf16* mixin = (bf16*)(F.ws + WS_MIXIN); bf16* qr = (bf16*)(F.ws + WS_QR); bf16* kr = (bf16*)(F.ws + WS_KR);
    const int* pos = (const int*)kin(1);
    for (int m = F.gw; m < NT; m += F.NGW) {
        const int s = m & (NS - 1);
        { const int g = F.lane >> 4, w = 2 << g; const int lo = (s + 1 - w) > 0 ? (s + 1 - w) : 0; const float cnt = (float)((s + 1) < w ? (s + 1) : w);
          float acc[8], cur[8];
#pragma unroll
          for (int i = 0; i < 8; ++i) acc[i] = 0.f;
          for (int j = lo; j <= s; ++j) { float t[8]; unpack8(*(const v4u*)(proj + (size_t)(m - s + j) * AB_IN + F.lane * 8), t);
#pragma unroll
              for (int i = 0; i < 8; ++i) acc[i] += t[i]; }
          unpack8(*(const v4u*)(proj + (size_t)m * AB_IN + F.lane * 8), cur);
          float o[8];
#pragma unroll
          for (int i = 0; i < 8; ++i) o[i] = acc[i] / cnt - cur[i];
          v4u wv; wv.x = pk2(o[0], o[1]); wv.y = pk2(o[2], o[3]); wv.z = pk2(o[4], o[5]); wv.w = pk2(o[6], o[7]); *(v4u*)(mixin + (size_t)m * ND + F.lane * 8) = wv; }
        { const float p = (float)pos[m]; const float invf = exp2f(-(float)F.lane * (13.287712379549449f / 64.f));
          float sn, cs; sincosf(p * invf, &sn, &cs);
          const bf16* qrow = proj + (size_t)m * AB_IN + 512; const bf16* krow = proj + (size_t)m * AB_IN + 1280;
#pragma unroll
          for (int h = 0; h < 6; ++h) {
              const float q1 = bf1(qrow[h * 128 + F.lane]), q2 = bf1(qrow[h * 128 + 64 + F.lane]);
              qr[(size_t)m * 768 + h * 128 + F.lane] = (bf16)f2bf(q1 * cs - q2 * sn); qr[(size_t)m * 768 + h * 128 + 64 + F.lane] = (bf16)f2bf(q1 * sn + q2 * cs);
              const float k1 = bf1(krow[h * 128 + F.lane]), k2 = bf1(krow[h * 128 + 64 + F.lane]); const float ksc = 0.08838834764831845f;
              kr[(size_t)m * 768 + h * 128 + F.lane] = (bf16)f2bf((k1 * cs - k2 * sn) * ksc); kr[(size_t)m * 768 + h * 128 + 64 + F.lane] = (bf16)f2bf((k1 * sn + k2 * cs) * ksc);
          } }
    }
}
namespace ret {
typedef short v4i16_t __attribute__((ext_vector_type(4)));
constexpr int PITCH = 272, TILE = 128 * PITCH;
__device__ __forceinline__ bf16x8 trfrag(LAS unsigned char* trb, int r0, int r1, int c0) {
    const v4i16_t a = __builtin_amdgcn_ds_read_tr16_b64_v4i16((LAS v4i16_t*)(trb + r0 * PITCH + c0 * 2));
    const v4i16_t b = __builtin_amdgcn_ds_read_tr16_b64_v4i16((LAS v4i16_t*)(trb + r1 * PITCH + c0 * 2));
    return (bf16x8){a[0], a[1], a[2], a[3], b[0], b[1], b[2], b[3]};
}
}
__device__ __forceinline__ void p_retention_mfma(Frame& F, int bh) {
    const bf16* proj = (const bf16*)(F.ws + WS_PROJ); bf16* mixin = (bf16*)(F.ws + WS_MIXIN); const bf16* qr = (const bf16*)(F.ws + WS_QR); const bf16* kr = (const bf16*)(F.ws + WS_KR);
    constexpr int P = ret::PITCH;
    LAS unsigned char* KT = F.lds; LAS unsigned char* VT = F.lds + ret::TILE; LAS unsigned char* ST = F.lds + 2 * ret::TILE;
    const int b = bh / 6, h = bh % 6, w = F.wave, lane = F.lane, i16 = lane & 15, g = lane >> 4, q4 = (lane & 15) >> 2, p4 = lane & 3;
    const float lg = log2f(1.0f - exp2f(-5.0f - (float)h)), gc = exp2f(128.f * lg);
    const int rowb = i16 * P + 16 * g;
    const int trl = q4 * P + 8 * p4;
    LAS unsigned char* const trV4 = VT + trl + 4 * g * P;
    LAS unsigned char* const trV8 = VT + trl + 8 * g * P;
    LAS unsigned char* const trK8 = KT + trl + 8 * g * P;
    f32x4 T[2][8];
#pragma unroll
    for (int a = 0; a < 2; ++a)
#pragma unroll
        for (int d = 0; d < 8; ++d) T[a][d] = (f32x4){0.f, 0.f, 0.f, 0.f};
    const int srow = F.tid >> 2, scb = (F.tid & 3) * 4;
    for (int n = 0; n < NS / 128; ++n) {
        const size_t m0 = (size_t)b * NS + n * 128;
        { const float fk = exp2f(-(float)srow * lg);
#pragma unroll
          for (int c = 0; c < 4; ++c) { const int c8 = scb + c; float t[8];
              unpack8(*(const v4u*)(kr + (m0 + srow) * 768 + h * 128 + c8 * 8), t);
              v4u o; o.x = pk2(t[0] * fk, t[1] * fk); o.y = pk2(t[2] * fk, t[3] * fk); o.z = pk2(t[4] * fk, t[5] * fk); o.w = pk2(t[6] * fk, t[7] * fk); *(LAS v4u*)(KT + srow * P + c8 * 16) = o; } }
        bf16x8 qf[4], pf[4]; float rs[4] = {0.f, 0.f, 0.f, 0.f}, rq[4] = {0.f, 0.f, 0.f, 0.f};
        { const float fq = exp2f((float)(16 * w + i16) * lg);
#pragma unroll
          for (int ks = 0; ks < 4; ++ks) { float t[8]; unpack8(*(const v4u*)(qr + (m0 + 16 * w + i16) * 768 + h * 128 + 32 * ks + 8 * g), t);
              v4u o; o.x = pk2(t[0] * fq, t[1] * fq); o.y = pk2(t[2] * fq, t[3] * fq); o.z = pk2(t[4] * fq, t[5] * fq); o.w = pk2(t[6] * fq, t[7] * fq); qf[ks] = __builtin_bit_cast(bf16x8, o); } }
#pragma unroll
        for (int hv = 0; hv < 2; ++hv) {
            if (hv == 1) __syncthreads();
#pragma unroll
            for (int c = 0; c < 4; ++c) { const int c8 = scb + c; *(LAS v4u*)(VT + srow * P + c8 * 16) = *(const v4u*)(proj + (m0 + srow) * AB_IN + 2048 + h * 256 + hv * 128 + c8 * 8); }
            { LAS unsigned char* stw = ST + (16 * w + 4 * g) * P + i16 * 2;
#pragma unroll
              for (int dt = 0; dt < 8; ++dt)
#pragma unroll
                for (int r = 0; r < 4; ++r) { T[hv][dt][r] *= gc; *(LAS bf16*)(stw + r * P + dt * 32) = (bf16)f2bf(T[hv][dt][r]); } }
            __syncthreads();
            if (hv == 0) {
                f32x4 sc[8];
#pragma unroll
                for (int mt = 0; mt < 8; ++mt) { sc[mt] = (f32x4){0.f, 0.f, 0.f, 0.f};
                    if (mt <= w) {
#pragma unroll
                        for (int ks = 0; ks < 4; ++ks) { const bf16x8 kf = *(const LAS bf16x8*)(KT + rowb + mt * 16 * P + ks * 64); sc[mt] = __builtin_amdgcn_mfma_f32_16x16x32_bf16(kf, qf[ks], sc[mt], 0, 0, 0); }
                        if (mt == w) {
#pragma unroll
                            for (int r = 0; r < 4; ++r) sc[mt][r] = (4 * g + r <= i16) ? sc[mt][r] : 0.f; } } }
#pragma unroll
                for (int k2 = 0; k2 < 4; ++k2) { v4u wv; wv.x = pk2(sc[2 * k2][0], sc[2 * k2][1]); wv.y = pk2(sc[2 * k2][2], sc[2 * k2][3]); wv.z = pk2(sc[2 * k2 + 1][0], sc[2 * k2 + 1][1]); wv.w = pk2(sc[2 * k2 + 1][2], sc[2 * k2 + 1][3]);
                    pf[k2] = __builtin_bit_cast(bf16x8, wv); }
            }
#pragma unroll
            for (int nt = 0; nt < 8; ++nt) { f32x4 acc = (f32x4){0.f, 0.f, 0.f, 0.f};
#pragma unroll
                for (int k2 = 0; k2 < 4; ++k2) if (2 * k2 <= w) { const bf16x8 vf = ret::trfrag(trV4, 32 * k2, 32 * k2 + 16, 16 * nt); acc = __builtin_amdgcn_mfma_f32_16x16x32_bf16(pf[k2], vf, acc, 0, 0, 0); }
#pragma unroll
                for (int ks = 0; ks < 4; ++ks) { const bf16x8 sf = *(const LAS bf16x8*)(ST + rowb + nt * 16 * P + ks * 64); acc = __builtin_amdgcn_mfma_f32_16x16x32_bf16(qf[ks], sf, acc, 0, 0, 0); }
#pragma unroll
                for (int r = 0; r < 4; ++r) { rs[r] += acc[r]; rq[r] += acc[r] * acc[r]; mixin[(m0 + 16 * w + 4 * g + r) * ND + 512 + h * 256 + hv * 128 + 16 * nt + i16] = (bf16)f2bf(acc[r]); } }
#pragma unroll
            for (int ks = 0; ks < 4; ++ks) { const bf16x8 af = ret::trfrag(trV8, 32 * ks, 32 * ks + 4, 16 * w);
#pragma unroll
                for (int dt = 0; dt < 8; ++dt) { const bf16x8 bfr = ret::trfrag(trK8, 32 * ks, 32 * ks + 4, 16 * dt); T[hv][dt] = __builtin_amdgcn_mfma_f32_16x16x32_bf16(af, bfr, T[hv][dt], 0, 0, 0); } }
        }
#pragma unroll
        for (int r = 0; r < 4; ++r) { float sm = rs[r], s2 = rq[r];
            sm += __shfl_xor(sm, 1); sm += __shfl_xor(sm, 2); sm += __shfl_xor(sm, 4); sm += __shfl_xor(sm, 8);
            s2 += __shfl_xor(s2, 1); s2 += __shfl_xor(s2, 2); s2 += __shfl_xor(s2, 4); s2 += __shfl_xor(s2, 8);
            const float mean = sm * (1.f / 256.f); const float var = fmaxf(s2 * (1.f / 256.f) - mean * mean, 0.f);
            const float rstd = 1.f / sqrtf(var + NORM_EPS);
            const size_t m = m0 + 16 * w + 4 * g + r;
#pragma unroll
            for (int t = 0; t < 16; ++t) { bf16* yp = mixin + m * ND + 512 + h * 256 + 16 * t + i16; const float gt = bf1(proj[m * AB_IN + 3584 + h * 256 + 16 * t + i16]);
                *yp = (bf16)f2bf((bf1(*yp) - mean) * rstd * siluf_(gt)); } }
        __syncthreads();
    }
}

__device__ __forceinline__ void p_route(Frame& F, int l) {
    const float* logits = (const float*)(F.ws + WS_LOGITS); const float* rbias = kin(20) + l * NEXP;
    int* tope = (int*)(F.ws + WS_TOPE); float* wsel = (float*)(F.ws + WS_WSEL); int* posb = (int*)(F.ws + WS_SLOT); unsigned* cnt = F.ctl + CW_CNT + l * 64;
    LAS unsigned* lcnt = (LAS unsigned*)F.lds; LAS unsigned* lbase = lcnt + 64; LAS int* le = (LAS int*)(lcnt + 128); LAS unsigned* lp = (LAS unsigned*)(lcnt + 128 + 512);
    const float bias = rbias[F.lane]; const int lane = F.lane;
    for (int chunk = blockIdx.x; chunk < NT / 64; chunk += F.G) {
        __syncthreads();
        if (F.tid < 64) lcnt[F.tid] = 0u;
        __syncthreads();
        for (int t = 0; t < 8; ++t) {
            const int tl = F.wave * 8 + t, m = chunk * 64 + tl;
            const float sc = sigmoidf_(logits[(size_t)m * 256 + lane]), bi = sc + bias;
            const int grp = lane >> 3;
            int rk = 0;
#pragma unroll
            for (int j = 1; j < 8; ++j) { const int o = lane ^ j; const float ov = __shfl_xor(bi, j); rk += ((ov > bi) || (ov == bi && o < lane)) ? 1 : 0; }
            float gs = rk < 2 ? bi : 0.f; gs += __shfl_xor(gs, 1); gs += __shfl_xor(gs, 2); gs += __shfl_xor(gs, 4);
            int grk = 0;
#pragma unroll
            for (int gg = 0; gg < 8; ++gg) { const float ov = __builtin_bit_cast(float, __builtin_amdgcn_readlane(__builtin_bit_cast(int, gs), gg * 8)); grk += (gg != grp && ((ov > gs) || (ov == gs && gg < grp))) ? 1 : 0; }
            const float mv = grk < 4 ? bi : -1e30f;
            int erk = 0;
#pragma unroll 16
            for (int j = 0; j < 64; ++j) { const float ov = __builtin_bit_cast(float, __builtin_amdgcn_readlane(__builtin_bit_cast(int, mv), j)); erk += ((ov > mv) || (ov == mv && j < lane)) ? 1 : 0; }
            const bool sel = erk < 8;
            const float wsum = wave_sum(sel ? sc : 0.f);
            if (sel) { const unsigned q = __hip_atomic_fetch_add(lcnt + lane, 1u, __ATOMIC_RELAXED, __HIP_MEMORY_SCOPE_WORKGROUP);
                tope[m * 8 + erk] = lane; wsel[m * 8 + erk] = sc / wsum * 2.5f; le[tl * 8 + erk] = lane; lp[tl * 8 + erk] = q; }
        }
        __syncthreads();
        if (F.tid < 64) lbase[F.tid] = atomicAdd(&cnt[F.tid], lcnt[F.tid]);
        __syncthreads();
        posb[chunk * 512 + F.tid] = (int)(lbase[le[F.tid]] + lp[F.tid]);
    }
}
__device__ __forceinline__ void load_offsets(Frame& F, int l) {
    volatile LAS int* tab = (volatile LAS int*)(F.lds + TAB_OFF);
    __syncthreads();
    if (F.tid < NEXP) tab[66 + F.tid] = (int)__hip_atomic_load(F.ctl + CW_CNT + l * 64 + F.tid, __ATOMIC_RELAXED, __HIP_MEMORY_SCOPE_AGENT);
    __syncthreads();
    if (F.tid == 0) { int o = 0; for (int e = 0; e < NEXP; ++e) { tab[e] = o; int c = tab[66 + e]; if (c > NT) c = NT; const int nt_ = (c + 255) >> 8; for (int t = 0; t < nt_; ++t) { const int ti = (o >> 8) + t; if (ti < MAXTILES) tab[160 + ti] = e; } o += nt_ << 8; if (o > MAXROWS) o = MAXROWS; }
        tab[64] = o; tab[65] = o >> 8; }
    __syncthreads();
}
__device__ __forceinline__ void p_scatter(Frame& F, int l) {
    load_offsets(F, l);
    const LAS int* tab = (const LAS int*)(F.lds + TAB_OFF);
    const int* tope = (const int*)(F.ws + WS_TOPE); int* slot = (int*)(F.ws + WS_SLOT); int* sorted = (int*)(F.ws + WS_SORTED);
    for (int i = F.gw * 64 + F.lane; i < NT * 8; i += F.NGW * 64) { const int e = tope[i]; const int row = tab[e] + slot[i]; sorted[row] = i >> 3; slot[i] = row; }
    for (int i = F.gw * 64 + F.lane; i < NEXP * 256; i += F.NGW * 64) { const int e = i >> 8, j = i & 255; const int r = tab[e] + tab[66 + e] + j; if (r < tab[e + 1]) sorted[r] = 0; }
}

__device__ __forceinline__ void p_l1_thin_a(Frame& F) {
    const bf16* proj = (const bf16*)(F.ws + WS_PROJ); const int* pos = (const int*)kin(1);
    bf16* cqn = (bf16*)(F.ws + WS_CQN); bf16* ckvn = (bf16*)(F.ws + WS_CKVN); bf16* krot = (bf16*)(F.ws + WS_KROT); bf16* cmpkv = (bf16*)(F.ws + WS_CMPKV);
    const float* qn = kin(10); const float* kvn = kin(12);
    for (int m = F.gw; m < NT; m += F.NGW) {
        const bf16* row = proj + (size_t)m * CD_INP;
        { float x[6]; float s = 0.f;
#pragma unroll
          for (int j = 0; j < 6; ++j) { x[j] = bf1(row[2584 + j * 64 + F.lane]); s += x[j] * x[j]; }
          const float r = 1.f / sqrtf(wave_sum(s) * (1.f / 384.f) + NORM_EPS);
#pragma unroll
          for (int j = 0; j < 6; ++j) cqn[(size_t)m * 384 + j * 64 + F.lane] = (bf16)f2bf(x[j] * r * qn[j * 64 + F.lane]); }
        { float x[8]; float s = 0.f;
#pragma unroll
          for (int j = 0; j < 8; ++j) { x[j] = bf1(row[2968 + j * 64 + F.lane]); s += x[j] * x[j]; }
          const float r = 1.f / sqrtf(wave_sum(s) * (1.f / 512.f) + NORM_EPS);
#pragma unroll
          for (int j = 0; j < 8; ++j) ckvn[(size_t)m * 512 + j * 64 + F.lane] = (bf16)f2bf(x[j] * r * kvn[j * 64 + F.lane]); }
        { const int i = F.lane & 31; const float p = (float)pos[m]; const float invf = exp2f(-(float)i * (13.287712379549449f / 32.f));
          float sn, cs; sincosf(p * invf, &sn, &cs);
          const float x1 = bf1(row[3480 + i]), x2 = bf1(row[3480 + 32 + i]);
          if (F.lane < 32) krot[(size_t)m * 64 + i] = (bf16)f2bf(x1 * cs - x2 * sn); else krot[(size_t)m * 64 + 32 + i] = (bf16)f2bf(x1 * sn + x2 * cs); }
        { const int b = m >> 11, s = m & (NS - 1);
          const int q4 = F.lane >> 4, c = F.lane & 15, kv = q4 >> 1, g = q4 & 1;
          const v4u w = *(const v4u*)(row + 1024 + q4 * 128 + c * 8);
          *(v4u*)(cmpkv + ((size_t)((kv * 16 + b * 2 + g) * NS + s)) * 128 + c * 8) = w; }
    }
}
__device__ __forceinline__ void p_l1_thin_b(Frame& F) {
    bf16* qmla = (bf16*)(F.ws + WS_QMLA); const int* pos = (const int*)kin(1);
    for (int m = F.gw; m < NT; m += F.NGW) {
        const int i = F.lane & 31; const float p = (float)pos[m]; const float invf = exp2f(-(float)i * (13.287712379549449f / 32.f));
        float sn, cs; sincosf(p * invf, &sn, &cs);
#pragma unroll
        for (int hh = 0; hh < 4; ++hh) { const int h = hh * 2 + (F.lane >> 5); bf16* q = qmla + (size_t)m * 1536 + h * 192 + 128;
            const float x1 = bf1(q[i]), x2 = bf1(q[32 + i]); q[i] = (bf16)f2bf(x1 * cs - x2 * sn); q[32 + i] = (bf16)f2bf(x1 * sn + x2 * cs); }
    }
    const float* hid = (const float*)(F.ws + WS_HID); const float* w2 = kin(9); bf16* kvc = (bf16*)(F.ws + WS_KVCMP);
    for (int m = F.gw; m < 4096; m += F.NGW) {
        const int kv = m >> 11;
        float h0 = hid[(size_t)m * 256 + kv * 128 + F.lane], h1 = hid[(size_t)m * 256 + kv * 128 + 64 + F.lane];
        h0 = 0.5f * h0 * (1.f + tanhf(0.7978845608028654f * (h0 + 0.044715f * h0 * h0 * h0)));
        h1 = 0.5f * h1 * (1.f + tanhf(0.7978845608028654f * (h1 + 0.044715f * h1 * h1 * h1)));
        const float* w = w2 + (size_t)kv * 128 * 128; float o0 = 0.f, o1 = 0.f;
        for (int c = 0; c < 64; ++c) { const float a = __shfl(h0, c), bq = __shfl(h1, c);
            o0 += a * w[c * 128 + F.lane] + bq * w[(c + 64) * 128 + F.lane]; o1 += a * w[c * 128 + 64 + F.lane] + bq * w[(c + 64) * 128 + 64 + F.lane]; }
        kvc[(size_t)m * 128 + F.lane] = (bf16)f2bf(o0); kvc[(size_t)m * 128 + 64 + F.lane] = (bf16)f2bf(o1);
    }
}
__device__ __forceinline__ void p_nsa_cmp_mfma(Frame& F) {
    typedef short v4i16_t __attribute__((ext_vector_type(4)));
    const bf16* proj = (const bf16*)(F.ws + WS_PROJ); const bf16* kvc = (const bf16*)(F.ws + WS_KVCMP); float* ocmp = (float*)(F.ws + WS_OCMP); unsigned* selm = (unsigned*)(F.ws + WS_SELM);
    constexpr int P = 272;
    LAS unsigned char* KT = F.lds; LAS unsigned char* VT = F.lds + 128 * P; LAS float* PS = (LAS float*)(F.lds + 2 * 128 * P);
    const int w = F.wave, lane = F.lane, i16 = lane & 15, g = lane >> 4, q4 = (lane & 15) >> 2, p4 = lane & 3;
    const float sscale = 0.08838834764831845f * 1.4426950408889634f;
    for (int bu = blockIdx.x; bu < 256; bu += F.G) {
        const int bg = bu >> 4, qg = bu & 15, b = bg >> 1, gq = bg & 1;
        __syncthreads();
#pragma unroll
        for (int c = 0; c < 4; ++c) { const int idx = F.tid + 512 * c, row = idx >> 4, c8 = idx & 15;
            v4u kk = (v4u){0u, 0u, 0u, 0u}, vv = (v4u){0u, 0u, 0u, 0u};
            if (row < 127) { kk = *(const v4u*)(kvc + ((size_t)(0 * 16 + bg) * 128 + row) * 128 + c8 * 8); vv = *(const v4u*)(kvc + ((size_t)(1 * 16 + bg) * 128 + row) * 128 + c8 * 8); }
            *(LAS v4u*)(KT + row * P + c8 * 16) = kk; *(LAS v4u*)(VT + row * P + c8 * 16) = vv; }
        for (int k = 0; k < 4; ++k) {
            const int q0 = (qg * 4 + k) * 32, h = gq * 4 + (w >> 1), ql = (w & 1) * 16 + i16, spos = q0 + ql;
            bf16x8 qf[4];
#pragma unroll
            for (int ks = 0; ks < 4; ++ks) qf[ks] = *(const bf16x8*)(proj + (size_t)(b * NS + spos) * CD_INP + h * 128 + 32 * ks + 8 * g);
            __syncthreads();
            const int nvalid = spos >= 31 ? ((spos - 31) >> 4) + 1 : 0;
            f32x4 sc[8]; float mx = -1e30f;
#pragma unroll
            for (int mt = 0; mt < 8; ++mt) { sc[mt] = (f32x4){0.f, 0.f, 0.f, 0.f};
#pragma unroll
                for (int ks = 0; ks < 4; ++ks) { const bf16x8 kf = *(const LAS bf16x8*)(KT + (16 * mt + i16) * P + (32 * ks + 8 * g) * 2); sc[mt] = __builtin_amdgcn_mfma_f32_16x16x32_bf16(kf, qf[ks], sc[mt], 0, 0, 0); }
#pragma unroll
                for (int r = 0; r < 4; ++r) { const bool ok = (16 * mt + 4 * g + r) < nvalid; const float x = ok ? sc[mt][r] * sscale : -1e30f; sc[mt][r] = x; mx = fmaxf(mx, x); } }
            mx = fmaxf(mx, __shfl_xor(mx, 16)); mx = fmaxf(mx, __shfl_xor(mx, 32));
            float ps = 0.f;
#pragma unroll
            for (int mt = 0; mt < 8; ++mt)
#pragma unroll
                for (int r = 0; r < 4; ++r) { const bool ok = (16 * mt + 4 * g + r) < nvalid; const float pv = ok ? __builtin_amdgcn_exp2f(sc[mt][r] - mx) : 0.f; sc[mt][r] = pv; ps += pv; }
            ps += __shfl_xor(ps, 16); ps += __shfl_xor(ps, 32);
            const float inv = ps > 0.f ? 1.f / ps : 0.f;
#pragma unroll
            for (int mt = 0; mt < 8; ++mt)
#pragma unroll
                for (int r = 0; r < 4; ++r) sc[mt][r] *= inv;
            { LAS float* slab = PS + (w >> 2) * 4096 + ql * 128 + 4 * g;
              if (((w >> 1) & 1) == 0) {
#pragma unroll
                  for (int mt = 0; mt < 8; ++mt) *(LAS f32x4*)(slab + 16 * mt) = sc[mt]; }
              __syncthreads();
              if (((w >> 1) & 1) == 1) {
#pragma unroll
                  for (int mt = 0; mt < 8; ++mt) { const f32x4 t = *(const LAS f32x4*)(slab + 16 * mt); *(LAS f32x4*)(slab + 16 * mt) = t + sc[mt]; } } }
            f32x4 O[8];
#pragma unroll
            for (int nt = 0; nt < 8; ++nt) O[nt] = (f32x4){0.f, 0.f, 0.f, 0.f};
#pragma unroll
            for (int k2 = 0; k2 < 4; ++k2) { v4u wv; wv.x = pk2(sc[2 * k2][0], sc[2 * k2][1]); wv.y = pk2(sc[2 * k2][2], sc[2 * k2][3]); wv.z = pk2(sc[2 * k2 + 1][0], sc[2 * k2 + 1][1]); wv.w = pk2(sc[2 * k2 + 1][2], sc[2 * k2 + 1][3]);
                const bf16x8 pf = __builtin_bit_cast(bf16x8, wv);
#pragma unroll
                for (int nt = 0; nt < 8; ++nt) {
                    const v4i16_t a = __builtin_amdgcn_ds_read_tr16_b64_v4i16((LAS v4i16_t*)(VT + (32 * k2 + 4 * g + q4) * P + (16 * nt + 4 * p4) * 2));
                    const v4i16_t c = __builtin_amdgcn_ds_read_tr16_b64_v4i16((LAS v4i16_t*)(VT + (32 * k2 + 16 + 4 * g + q4) * P + (16 * nt + 4 * p4) * 2));
                    const bf16x8 vf = (bf16x8){a[0], a[1], a[2], a[3], c[0], c[1], c[2], c[3]};
                    O[nt] = __builtin_amdgcn_mfma_f32_16x16x32_bf16(pf, vf, O[nt], 0, 0, 0); } }
#pragma unroll
            for (int r = 0; r < 4; ++r) { const size_t m = (size_t)(b * NS + q0 + (w & 1) * 16 + 4 * g + r); const float gt = sigmoidf_(bf1(proj[m * CD_INP + 2560 + h * 3 + 0]));
#pragma unroll
                for (int nt = 0; nt < 8; ++nt) ocmp[m * 1024 + h * 128 + 16 * nt + i16] = gt * O[nt][r]; }
            __syncthreads();
#pragma unroll
            for (int qq = 0; qq < 4; ++qq) { const int qi = 4 * w + qq, s = q0 + qi, cur = s >> 6, j = lane & 31;
                float imp = 0.f;
#pragma unroll
                for (int kk = 0; kk < 4; ++kk) { const int n1 = 4 * j + kk; if (n1 <= 126) imp += PS[qi * 128 + n1] + PS[4096 + qi * 128 + n1]; const int n2 = 4 * j - 1 + kk; if (n2 >= 0 && n2 <= 126) imp += PS[qi * 128 + n2] + PS[4096 + qi * 128 + n2]; }
                const bool forced = (j == 0) || (j == cur) || (j == cur - 1);
                const float score = forced ? 1e4f : ((j * 64 <= s) ? imp : -1e30f);
                int rk = 0;
                for (int jj = 0; jj < 32; ++jj) { const float ov = __shfl(score, jj); rk += ((ov > score) || (ov == score && jj < j)) ? 1 : 0; }
                const bool sel = (lane < 32) && (rk < 16) && (j <= cur);
                const unsigned long long bal = __ballot(sel);
                if (lane == 0) selm[(size_t)(b * NS + s) * 2 + gq] = (unsigned)bal; }
        }
    }
}

namespace fa {
typedef short v4i16_t __attribute__((ext_vector_type(4)));
struct Src { const bf16* k1; size_t ks1; const bf16* k2; size_t ks2; const bf16* v; size_t vs; };
template <int DQK> struct Cfg { static constexpr int KPITCH = (DQK + 8) * 2, KBYTES = 64 * KPITCH, VPITCH = 272, VBYTES = 64 * VPITCH, BUF = KBYTES + VBYTES, NKS = DQK / 32, KCH = DQK / 8, NKR = DQK / 64; };

template <int DQK>
__device__ __forceinline__ void load_tile(const Src& S, int k0, int tid, v4u (&kr)[Cfg<DQK>::NKR], v4u (&vr)[2]) {
    constexpr int KCH = Cfg<DQK>::KCH;
#pragma unroll
    for (int i = 0; i < Cfg<DQK>::NKR; ++i) { const int c = tid + 512 * i, row = c / KCH, c8 = c % KCH;
        const bf16* src = (DQK == 192 && c8 >= 16) ? S.k2 + (size_t)(k0 + row) * S.ks2 + (c8 - 16) * 8 : S.k1 + (size_t)(k0 + row) * S.ks1 + c8 * 8;
        kr[i] = *(const v4u*)src; }
#pragma unroll
    for (int i = 0; i < 2; ++i) { const int c = tid + 512 * i, row = c >> 4, c8 = c & 15; vr[i] = *(const v4u*)(S.v + (size_t)(k0 + row) * S.vs + c8 * 8); }
}
template <int DQK>
__device__ __forceinline__ void store_tile(LAS unsigned char* buf, int tid, const v4u (&kr)[Cfg<DQK>::NKR], const v4u (&vr)[2]) {
    constexpr int KCH = Cfg<DQK>::KCH;
#pragma unroll
    for (int i = 0; i < Cfg<DQK>::NKR; ++i) { const int c = tid + 512 * i, row = c / KCH, c8 = c % KCH; *(LAS v4u*)(buf + row * Cfg<DQK>::KPITCH + c8 * 16) = kr[i]; }
#pragma unroll
    for (int i = 0; i < 2; ++i) { const int c = tid + 512 * i, row = c >> 4, c8 = c & 15; *(LAS v4u*)(buf + Cfg<DQK>::KBYTES + row * Cfg<DQK>::VPITCH + c8 * 16) = vr[i]; }
}
template <int DQK, int MODE>
__device__ __forceinline__ void fa_pass(LAS unsigned char* lds, const Src& S, const bf16x8 (&qf)[Cfg<DQK>::NKS], unsigned tmask, int spos, unsigned rowmask, float sscale,
                                        f32x4 (&O)[8], float& m_run, float& l_run, int tid, int lane) {
    typedef Cfg<DQK> C;
    const int i16 = lane & 15, g = lane >> 4, q4 = (lane & 15) >> 2, p4 = lane & 3;
#pragma unroll
    for (int nt = 0; nt < 8; ++nt) O[nt] = (f32x4){0.f, 0.f, 0.f, 0.f};
    m_run = -1e30f; l_run = 0.f;
    unsigned rem = tmask;
    if (rem == 0u) return;
    v4u kr[C::NKR], vr[2];
    int t = __builtin_ctz(rem); rem &= rem - 1u;
    load_tile<DQK>(S, t * 64, tid, kr, vr);
    __syncthreads();
    store_tile<DQK>(lds, tid, kr, vr);
    __syncthreads();
    int cur = 0;
    for (;;) {
        const bool has_next = rem != 0u; int tn = 0;
        if (has_next) { tn = __builtin_ctz(rem); rem &= rem - 1u; load_tile<DQK>(S, tn * 64, tid, kr, vr); }
        LAS unsigned char* kb = lds + cur * C::BUF; LAS unsigned char* vb = kb + C::KBYTES;
        f32x4 sc[4];
#pragma unroll
        for (int mt = 0; mt < 4; ++mt) { sc[mt] = (f32x4){0.f, 0.f, 0.f, 0.f};
#pragma unroll
            for (int ks = 0; ks < C::NKS; ++ks) { const bf16x8 kf = *(const LAS bf16x8*)(kb + (16 * mt + i16) * C::KPITCH + (32 * ks + 8 * g) * 2);
                sc[mt] = __builtin_amdgcn_mfma_f32_16x16x32_bf16(kf, qf[ks], sc[mt], 0, 0, 0); } }
        float mx = -1e30f; bool vl[4][4];
#pragma unroll
        for (int mt = 0; mt < 4; ++mt)
#pragma unroll
            for (int r = 0; r < 4; ++r) { const int kp = t * 64 + 16 * mt + 4 * g + r; bool ok = kp <= spos;
                if (MODE == 1) ok = ok && ((rowmask >> t) & 1u);
                if (MODE == 2) ok = ok && (kp + 512 > spos);
                vl[mt][r] = ok; const float x = ok ? sc[mt][r] * sscale : -1e30f; sc[mt][r] = x; mx = fmaxf(mx, x); }
        mx = fmaxf(mx, __shfl_xor(mx, 16)); mx = fmaxf(mx, __shfl_xor(mx, 32));
        const float m_new = fmaxf(m_run, mx), alpha = __builtin_amdgcn_exp2f(m_run - m_new); m_run = m_new;
        float ps = 0.f;
#pragma unroll
        for (int mt = 0; mt < 4; ++mt)
#pragma unroll
            for (int r = 0; r < 4; ++r) { const float pv = vl[mt][r] ? __builtin_amdgcn_exp2f(sc[mt][r] - m_new) : 0.f; sc[mt][r] = pv; ps += pv; }
        l_run = l_run * alpha + ps;
        float ar[4];
#pragma unroll
        for (int r = 0; r < 4; ++r) ar[r] = __shfl(alpha, 4 * g + r);
#pragma unroll
        for (int nt = 0; nt < 8; ++nt)
#pragma unroll
            for (int r = 0; r < 4; ++r) O[nt][r] *= ar[r];
        bf16x8 pf[2];
#pragma unroll
        for (int k2 = 0; k2 < 2; ++k2) { v4u w; w.x = pk2(sc[2 * k2][0], sc[2 * k2][1]); w.y = pk2(sc[2 * k2][2], sc[2 * k2][3]); w.z = pk2(sc[2 * k2 + 1][0], sc[2 * k2 + 1][1]); w.w = pk2(sc[2 * k2 + 1][2], sc[2 * k2 + 1][3]);
            pf[k2] = __builtin_bit_cast(bf16x8, w); }
#pragma unroll
        for (int nt = 0; nt < 8; ++nt)
#pragma unroll
            for (int k2 = 0; k2 < 2; ++k2) {
                const v4i16_t a = __builtin_amdgcn_ds_read_tr16_b64_v4i16((LAS v4i16_t*)(vb + (32 * k2 + 4 * g + q4) * C::VPITCH + (16 * nt + 4 * p4) * 2));
                const v4i16_t b = __builtin_amdgcn_ds_read_tr16_b64_v4i16((LAS v4i16_t*)(vb + (32 * k2 + 16 + 4 * g + q4) * C::VPITCH + (16 * nt + 4 * p4) * 2));
                const bf16x8 vf = (bf16x8){a[0], a[1], a[2], a[3], b[0], b[1], b[2], b[3]};
                O[nt] = __builtin_amdgcn_mfma_f32_16x16x32_bf16(pf[k2], vf, O[nt], 0, 0, 0); }
        if (has_next) store_tile<DQK>(lds + (cur ^ 1) * C::BUF, tid, kr, vr);
        __syncthreads();
        if (!has_next) break;
        t = tn; cur ^= 1;
    }
}
__device__ __forceinline__ void row_inv(float l_run, int lane, float (&inv)[4]) {
    float l = l_run; l += __shfl_xor(l, 16); l += __shfl_xor(l, 32);
    const float li = l > 0.f ? 1.f / l : 0.f; const int g = lane >> 4;
#pragma unroll
    for (int r = 0; r < 4; ++r) inv[r] = __shfl(li, 4 * g + r);
}
}

constexpr int FA_NUNITS = 2048;
__device__ __forceinline__ void p_attn_mfma(Frame& F, unsigned* queue) {
    const bf16* proj = (const bf16*)(F.ws + WS_PROJ); bf16* mixin = (bf16*)(F.ws + WS_MIXIN); const float* ocmp = (const float*)(F.ws + WS_OCMP); const unsigned* selm = (const unsigned*)(F.ws + WS_SELM);
    const bf16* qmla = (const bf16*)(F.ws + WS_QMLA); const bf16* kvu = (const bf16*)(F.ws + WS_KVU); const bf16* krot = (const bf16*)(F.ws + WS_KROT);
    volatile LAS unsigned* qslot = (volatile LAS unsigned*)(F.lds + LDSCTL_OFF);
    const int lane = F.lane, w = F.wave, i16 = lane & 15, g4 = lane >> 4;
    for (;;) {
        __syncthreads();
        if (F.tid == 0) qslot[0] = atomicAdd(queue, 1u);
        __syncthreads();
        const int u = __builtin_amdgcn_readfirstlane((int)qslot[0]);
        if (u >= FA_NUNITS) break;
        if (u < 1024) {
            const int qt = 15 - (u >> 6), bh = u & 63, b = bh >> 3, h = bh & 7, q0 = qt * 128, spos = q0 + 16 * w + i16;
            bf16x8 qf[6];
#pragma unroll
            for (int ks = 0; ks < 6; ++ks) qf[ks] = *(const bf16x8*)(qmla + (size_t)(b * NS + spos) * 1536 + h * 192 + 32 * ks + 8 * g4);
            fa::Src S; S.k1 = kvu + (size_t)(b * NS) * 2048 + h * 256; S.ks1 = 2048; S.k2 = krot + (size_t)(b * NS) * 64; S.ks2 = 64; S.v = S.k1 + 128; S.vs = 2048;
            const int last = (q0 + 127) >> 6; const unsigned tmask = last >= 31 ? 0xffffffffu : ((1u << (last + 1)) - 1u);
            f32x4 O[8]; float m_run, l_run;
            fa::fa_pass<192, 0>(F.lds, S, qf, tmask, spos, 0u, 0.07216878364870322f * 1.4426950408889634f, O, m_run, l_run, F.tid, lane);
            float inv[4]; fa::row_inv(l_run, lane, inv);
#pragma unroll
            for (int r = 0; r < 4; ++r) { bf16* orow = mixin + (size_t)(b * NS + q0 + 16 * w + 4 * g4 + r) * ND + 1024 + h * 128 + i16;
#pragma unroll
                for (int nt = 0; nt < 8; ++nt) orow[16 * nt] = (bf16)f2bf(O[nt][r] * inv[r]); }
        } else {
            const int v = u - 1024, qt = 63 - (v >> 4), bg = v & 15, b = bg >> 1, gq = bg & 1, q0 = qt * 32;
            const int h = gq * 4 + (w >> 1), spos = q0 + (w & 1) * 16 + i16;
            bf16x8 qf[4];
#pragma unroll
            for (int ks = 0; ks < 4; ++ks) qf[ks] = *(const bf16x8*)(proj + (size_t)(b * NS + spos) * CD_INP + h * 128 + 32 * ks + 8 * g4);
            const unsigned rowmask = selm[(size_t)(b * NS + spos) * 2 + gq];
            unsigned um = selm[(size_t)(b * NS + q0 + (lane & 31)) * 2 + gq];
#pragma unroll
            for (int o = 1; o < 32; o <<= 1) um |= (unsigned)__shfl_xor((int)um, o);
            um = (unsigned)__builtin_amdgcn_readfirstlane((int)um);
            const bf16* base = proj + (size_t)(b * NS) * CD_INP;
            const float sscale = 0.08838834764831845f * 1.4426950408889634f;
            f32x4 O[8], Ot[8]; float m_run, l_run, inv[4];
            { fa::Src S; S.k1 = base + 1024 + ((1 * 2 + 0) * 2 + gq) * 128; S.ks1 = CD_INP; S.k2 = nullptr; S.ks2 = 0; S.v = base + 1024 + ((1 * 2 + 1) * 2 + gq) * 128; S.vs = CD_INP;
              fa::fa_pass<128, 1>(F.lds, S, qf, um, spos, rowmask, sscale, O, m_run, l_run, F.tid, lane); }
            fa::row_inv(l_run, lane, inv);
#pragma unroll
            for (int r = 0; r < 4; ++r) { const int sq = q0 + (w & 1) * 16 + 4 * g4 + r; const float g1 = sigmoidf_(bf1(proj[(size_t)(b * NS + sq) * CD_INP + 2560 + h * 3 + 1])) * inv[r];
#pragma unroll
                for (int nt = 0; nt < 8; ++nt) Ot[nt][r] = O[nt][r] * g1; }
            { fa::Src S; S.k1 = base + 1024 + ((2 * 2 + 0) * 2 + gq) * 128; S.ks1 = CD_INP; S.k2 = nullptr; S.ks2 = 0; S.v = base + 1024 + ((2 * 2 + 1) * 2 + gq) * 128; S.vs = CD_INP;
              const int klo = q0 - 511 > 0 ? q0 - 511 : 0, tlo = klo >> 6, thi = (q0 + 31) >> 6;
              const unsigned hm = thi >= 31 ? 0xffffffffu : ((1u << (thi + 1)) - 1u); const unsigned tmask = hm & ~((1u << tlo) - 1u);
              fa::fa_pass<128, 2>(F.lds, S, qf, tmask, spos, 0u, sscale, O, m_run, l_run, F.tid, lane); }
            fa::row_inv(l_run, lane, inv);
#pragma unroll
            for (int r = 0; r < 4; ++r) { const int sq = q0 + (w & 1) * 16 + 4 * g4 + r; const size_t m = (size_t)(b * NS + sq);
                const float g2 = sigmoidf_(bf1(proj[m * CD_INP + 2560 + h * 3 + 2])) * inv[r];
#pragma unroll
                for (int nt = 0; nt < 8; ++nt) { const float oc = ocmp[m * 1024 + h * 128 + 16 * nt + i16]; mixin[m * ND + h * 128 + 16 * nt + i16] = (bf16)f2bf(oc + Ot[nt][r] + O[nt][r] * g2); } }
        }
    }
}

constexpr int NPHASE = 33;


#define IN(k) (lo <= (k) && (k) < hi)
#define SEAM(k) do { if (IN(k) && IN((k) + 1)) { if (MK_ONE_LAUNCH) xcd_barrier(bar); else if (F.tid == 0) __hip_atomic_store(F.ctl + CW_TMO, 0xBAD0u | (unsigned)(k), __ATOMIC_RELAXED, __HIP_MEMORY_SCOPE_AGENT); \
    if (MK_PROBE_PHASE >= 0 && blockIdx.x == 0 && F.tid == 0) { if ((k) == MK_PROBE_PHASE - 1) ((volatile LAS unsigned long long*)(F.lds + LDSCTL_OFF + 64))[0] = __builtin_amdgcn_s_memrealtime(); \
        if ((k) == MK_PROBE_LAST) ((volatile LAS unsigned long long*)(F.lds + LDSCTL_OFF + 64))[1] = __builtin_amdgcn_s_memrealtime(); } } } while (0)
template <int l>
__device__ __forceinline__ void layer_body(Frame& F, const XcdBarrier& bar, const int lo, const int hi) {
    unsigned char* ws = F.ws;
    bf16* const XB0 = (bf16*)(ws + WS_XB0); bf16* const X1B = (bf16*)(ws + WS_X1B); bf16* const X2B = (bf16*)(ws + WS_X2B);
    bf16* const PROJ = (bf16*)(ws + WS_PROJ); bf16* const MIXIN = (bf16*)(ws + WS_MIXIN); bf16* const MIXO = (bf16*)(ws + WS_MIXO);
    bf16* const HB = (bf16*)(ws + WS_H); bf16* const Y2 = (bf16*)(ws + WS_Y2);
        const int pb = 1 + l * 16;
        const bf16* xin = l == 0 ? XB0 : X2B;
        if (IN(pb + 0)) {
            if (l == 0) { pg8::DenseProb P; P.init(xin, ND, (const bf16*)(ws + WS_WABIN), NT, AB_IN, ND, F.G, (int)blockIdx.x); pg8::EpiBf16 E{PROJ, AB_IN};
                pg8::gemm_phase<pg8::EpiBf16, pg8::DenseProb, true>(F.lds, P, E); }
            else { pg8::DenseProb P; P.init(xin, ND, (const bf16*)(ws + WS_WCDIN), NT, CD_INP, ND, F.G, (int)blockIdx.x); pg8::EpiBf16 E{PROJ, CD_INP};
                pg8::gemm_phase<pg8::EpiBf16, pg8::DenseProb, true>(F.lds, P, E); }
        } SEAM(pb + 0);
        if (l == 0) {
            if (IN(pb + 1)) { p_pool_rope(F); } SEAM(pb + 1);
            if (IN(pb + 2)) { if (blockIdx.x < NB * 6) p_retention_mfma(F, (int)blockIdx.x); __syncthreads(); p_moe_weights_queue(F, F.ctl + CW_CNT + 320); } SEAM(pb + 2);
            SEAM(pb + 3); SEAM(pb + 4); SEAM(pb + 5);
        } else {
            if (IN(pb + 1)) { p_l1_thin_a(F); } SEAM(pb + 1);
            if (IN(pb + 2)) {
                { pg8::CmpProb P; P.K = 4096; P.Abase = (const char*)(ws + WS_CMPKV); P.Bt = (const char*)(ws + WS_CW1); P.G = F.G; P.c = (int)blockIdx.x;
                  pg8::EpiF32 E{(float*)(ws + WS_HID), 256, (const float*)(ws + WS_CMPB)};
                  pg8::gemm_phase<pg8::EpiF32, pg8::CmpProb, true>(F.lds, P, E); }
                { pg8::DenseProb P; P.init((const bf16*)(ws + WS_CQN), 384, (const bf16*)(ws + WS_WUQ), NT, 1536, 384, F.G, (int)blockIdx.x); pg8::EpiBf16 E{(bf16*)(ws + WS_QMLA), 1536};
                  pg8::gemm_phase<pg8::EpiBf16, pg8::DenseProb, true>(F.lds, P, E); }
                { pg8::DenseProb P; P.init((const bf16*)(ws + WS_CKVN), 512, (const bf16*)(ws + WS_WUKV), NT, 2048, 512, F.G, (int)blockIdx.x); pg8::EpiBf16 E{(bf16*)(ws + WS_KVU), 2048};
                  pg8::gemm_phase<pg8::EpiBf16, pg8::DenseProb, true>(F.lds, P, E); }
            } SEAM(pb + 2);
            if (IN(pb + 3)) { p_l1_thin_b(F); } SEAM(pb + 3);
            if (IN(pb + 4)) { p_nsa_cmp_mfma(F); } SEAM(pb + 4);
            if (IN(pb + 5)) { p_attn_mfma(F, F.ctl + CW_CNT + 256); } SEAM(pb + 5);
        }
        if (IN(pb + 6)) { pg8::DenseProb P; P.init(MIXIN, ND, (const bf16*)(ws + (l == 0 ? WS_WABOUT : WS_WCDOUT)), NT, ND, ND, F.G, (int)blockIdx.x); pg8::EpiBf16 E{MIXO, ND};
            pg8::gemm_phase<pg8::EpiBf16, pg8::DenseProb, true>(F.lds, P, E); } SEAM(pb + 6);
        if (IN(pb + 7)) { p_ln1(F, xin, MIXO, kin(15) + l * ND, kin(16) + l * ND, X1B); } SEAM(pb + 7);
        if (IN(pb + 8)) { pg8::DenseProb P; P.init(X1B, ND, (const bf16*)(ws + WS_RT + (size_t)l * MiB), NT, 256, ND, F.G, (int)blockIdx.x); pg8::EpiF32 E{(float*)(ws + WS_LOGITS), 256, nullptr};
            pg8::gemm_phase<pg8::EpiF32, pg8::DenseProb, true>(F.lds, P, E); } SEAM(pb + 8);
        if (IN(pb + 9)) { p_route(F, l); } SEAM(pb + 9);
        if (IN(pb + 10)) { p_scatter(F, l); } SEAM(pb + 10);
        if (IN(pb + 11)) { load_offsets(F, l); const LAS int* tab = (const LAS int*)(F.lds + TAB_OFF);
            pg8::MoeUpProb P; P.K = ND; P.Abase = (const char*)X1B; P.W13 = (const char*)(ws + WS_W13 + (size_t)l * WS_MOE_LSTRIDE); P.sorted = (const int*)(ws + WS_SORTED); P.tile_e = tab + 160; P.ntiles = __builtin_amdgcn_readfirstlane(tab[65]);
            P.nunits = (P.ntiles + NT / 256) * 4; P.G = F.G; P.c = (int)blockIdx.x;
            pg8::EpiSwiglu E{HB};
            pg8::gemm_phase<pg8::EpiSwiglu, pg8::MoeUpProb, true>(F.lds, P, E); } SEAM(pb + 11);
        if (IN(pb + 12)) { load_offsets(F, l); const LAS int* tab = (const LAS int*)(F.lds + TAB_OFF);
            pg8::MoeDownProb P; P.K = EFF; P.Abase = (const char*)HB; P.W2 = (const char*)(ws + WS_W2 + (size_t)l * WS_MOE_LSTRIDE); P.tile_e = tab + 160; P.ntiles = __builtin_amdgcn_readfirstlane(tab[65]);
            P.nunits = (P.ntiles + NT / 256) * 8; P.G = F.G; P.c = (int)blockIdx.x;
            pg8::EpiBf16 E{Y2, ND};
            pg8::gemm_phase<pg8::EpiBf16, pg8::MoeDownProb, true>(F.lds, P, E); } SEAM(pb + 12);
        if (IN(pb + 13)) { p_combine_ln2(F, X1B, Y2, (const int*)(ws + WS_SLOT), (const float*)(ws + WS_WSEL), kin(17) + l * ND, kin(18) + l * ND, l == 0 ? X2B : nullptr, l == 0 ? nullptr : F.out); } SEAM(pb + 13);
        SEAM(pb + 14); SEAM(pb + 15);
    }
__global__ void __launch_bounds__(NWAVES * 64, 2) mk_fwd(Args args) {
    extern __shared__ __attribute__((aligned(16))) unsigned char lds[];
    Frame F;
    F.lds = (LAS unsigned char*)lds;
    F.MISC = (volatile LAS unsigned*)(F.lds + MISC_OFF);
    F.tid = threadIdx.x; F.lane = F.tid & 63; F.wave = __builtin_amdgcn_readfirstlane(F.tid >> 6);
    F.G = gridDim.x; { const int bx = blockIdx.x; F.vcu = (F.G % 8 == 0) ? (bx % 8) * (F.G / 8) + bx / 8 : bx; }
    F.gw = F.vcu * NWAVES + F.wave; F.NGW = F.G * NWAVES;
    F.ws = args.ws; F.ctl = (unsigned*)(args.ws + WS_CTL); F.out = args.out;
    for (int u = F.tid; u < (LDS_BYTES - LDSCTL_OFF) / 4; u += NWAVES * 64) ((LAS unsigned*)(F.lds + LDSCTL_OFF))[u] = 0u;
    __syncthreads();
    XcdBarrier bar; bar.bar = F.ctl + CW_BAR; bar.x = 0; bar.st = nullptr;
    if (MK_ONE_LAUNCH) bar = xcd_barrier_post(F.ctl + CW_BAR, F.MISC + 8);
    const int lo = args.ph_lo, hi = args.ph_hi;
    if (MK_PROBE_PHASE == 0 && blockIdx.x == 0 && F.tid == 0) ((volatile LAS unsigned long long*)(F.lds + LDSCTL_OFF + 64))[0] = __builtin_amdgcn_s_memrealtime();
    unsigned char* ws = args.ws;
    bf16* const XB0 = (bf16*)(ws + WS_XB0); bf16* const X1B = (bf16*)(ws + WS_X1B); bf16* const X2B = (bf16*)(ws + WS_X2B);
    bf16* const PROJ = (bf16*)(ws + WS_PROJ); bf16* const MIXIN = (bf16*)(ws + WS_MIXIN); bf16* const MIXO = (bf16*)(ws + WS_MIXO);
    bf16* const HB = (bf16*)(ws + WS_H); bf16* const Y2 = (bf16*)(ws + WS_Y2);

    if (IN(0)) { p_prologue(F); } SEAM(0);

    layer_body<0>(F, bar, lo, hi);
    layer_body<1>(F, bar, lo, hi);
    if (MK_PROBE_PHASE >= 0 && blockIdx.x == 0 && F.tid == 0) {
        volatile LAS unsigned long long* tsl = (volatile LAS unsigned long long*)(F.lds + LDSCTL_OFF + 64);
        if (MK_PROBE_LAST == 30) tsl[1] = __builtin_amdgcn_s_memrealtime();
        const unsigned long long span = (tsl[1] - tsl[0]) * MK_PROBE_AMP, t0 = __builtin_amdgcn_s_memrealtime();
        while (__builtin_amdgcn_s_memrealtime() - t0 < span) __builtin_amdgcn_s_sleep(8);
    }
#undef IN
#undef SEAM
}

extern "C" void kernel_launch(void* const* d_in, const int* in_sizes, int n_in, void* d_out, int out_size, void* d_ws, size_t ws_size, hipStream_t stream) {
    static int grid = 0;
    if (grid == 0) {
        if (n_in != 27 || in_sizes[0] != NT * ND || out_size != NT * ND || ws_size < WS_END) { fprintf(stderr, "kernel_launch: unexpected problem (n_in %d, in0 %d, out %d, ws %zu < %zu); nothing launched\n", n_in, n_in > 0 ? in_sizes[0] : -1, out_size, ws_size, (size_t)WS_END); grid = -1; return; }
        int dev = 0, cus = 0, per_cu = 0;
        if (hipGetDevice(&dev) != hipSuccess || hipDeviceGetAttribute(&cus, hipDeviceAttributeMultiprocessorCount, dev) != hipSuccess) { fprintf(stderr, "kernel_launch: device query failed\n"); grid = -1; return; }
        if (hipFuncSetAttribute((const void*)mk_fwd, hipFuncAttributeMaxDynamicSharedMemorySize, LDS_BYTES) != hipSuccess) { fprintf(stderr, "kernel_launch: hipFuncSetAttribute failed\n"); grid = -1; return; }
        if (hipOccupancyMaxActiveBlocksPerMultiprocessor(&per_cu, (const void*)mk_fwd, NWAVES * 64, LDS_BYTES) != hipSuccess || per_cu < 1) fprintf(stderr, "kernel_launch: note: occupancy query reports %d\n", per_cu);
        (void)hipGetLastError();
        grid = cus;
    }
    if (grid < 0) return;
    if (hipMemsetAsync((char*)d_ws + WS_CTL, 0, CTL_ZERO_BYTES, stream) != hipSuccess) { fprintf(stderr, "kernel_launch: memset failed\n"); return; }
    Args a{};
    for (int i = 0; i < 27; ++i) a.in[i] = (const float*)d_in[i];
    a.out = (float*)d_out; a.ws = (unsigned char*)d_ws;
#if MK_ONE_LAUNCH
    a.ph_lo = 0; a.ph_hi = NPHASE;
    hipLaunchKernelGGL(mk_fwd, dim3(grid), dim3(NWAVES * 64), LDS_BYTES, stream, a);
#else
    for (int p = 0; p < NPHASE; ++p) {
        const int lp = (p - 1) & 15;
        if (p >= 1) { const int l = (p - 1) >> 4; if (lp >= 14) continue; if (l == 0 && lp >= 3 && lp <= 5) continue; }
        a.ph_lo = p; a.ph_hi = p + 1;
        hipLaunchKernelGGL(mk_fwd, dim3(grid), dim3(NWAVES * 64), LDS_BYTES, stream, a);
    }
#endif
    const hipError_t le = hipPeekAtLastError();
    if (le != hipSuccess) fprintf(stderr, "kernel_launch: launch failed: %s\n", hipGetErrorName(le));
}
```

```cpp
#include <hip/hip_runtime.h>
#include <cstdio>
#include <cstdint>

#ifndef MK_ONE_LAUNCH
#define MK_ONE_LAUNCH 1
#endif
#ifndef MK_PROBE_PHASE
#define MK_PROBE_PHASE -1
#endif
#ifndef MK_PROBE_LAST
#define MK_PROBE_LAST MK_PROBE_PHASE
#endif
#ifndef MK_PROBE_AMP
#define MK_PROBE_AMP 4
#endif

#define GAS __attribute__((address_space(1)))
#define LAS __attribute__((address_space(3)))
typedef unsigned short bf16;
typedef unsigned v4u __attribute__((ext_vector_type(4)));
typedef unsigned v2u __attribute__((ext_vector_type(2)));
typedef float f32x4 __attribute__((ext_vector_type(4)));
typedef float f32x2 __attribute__((ext_vector_type(2)));
typedef short bf16x8 __attribute__((ext_vector_type(8)));

constexpr int NB = 8, NS = 2048, ND = 2048, NT = NB * NS;
constexpr float DN_ALPHA = 1.41421356237309505f;
constexpr float LN_EPS = 1e-5f, NORM_EPS = 1e-6f;
constexpr int AB_IN = 5120, CD_IN = 3544, CD_INP = 3584;
constexpr int NEXP = 64, EFF = 512;
constexpr int MAXROWS = NT * 8 + NEXP * 256;
constexpr int MAXTILES = MAXROWS / 256;
constexpr int SH_ROW0 = MAXROWS;

constexpr size_t MiB = 1u << 20;
constexpr size_t WS_CTL = 0, CTL_ZERO_BYTES = 1 * MiB;
constexpr size_t WS_TOPE = 1 * MiB, WS_WSEL = WS_TOPE + 512 * 1024, WS_SLOT = 2 * MiB, WS_SORTED = WS_SLOT + 512 * 1024;
constexpr size_t WS_CMPB = 3 * MiB + 256 * 1024, WS_SELM = 3 * MiB + 512 * 1024;
constexpr size_t WS_KVCMP = 4 * MiB;
constexpr size_t WS_HID = 6 * MiB;
constexpr size_t WS_WABIN = 16 * MiB, WS_WABOUT = 36 * MiB, WS_WCDIN = 44 * MiB, WS_WCDOUT = 58 * MiB, WS_WUQ = 66 * MiB, WS_WUKV = 68 * MiB, WS_CW1 = 70 * MiB, WS_RT = 72 * MiB;
constexpr size_t WS_W13 = 74 * MiB, WS_W2 = 334 * MiB, WS_MOE_LSTRIDE = 390 * MiB;
constexpr size_t WS_XB0 = 854 * MiB, WS_X2B = 854 * MiB, WS_X1B = 918 * MiB;
constexpr size_t WS_H = 982 * MiB, WS_Y2 = 1142 * MiB, WS_END = 1782 * MiB;
constexpr size_t WS_PROJ = 982 * MiB, WS_MIXIN = 1142 * MiB, WS_MIXO = 1206 * MiB;
constexpr size_t WS_QR = 1270 * MiB, WS_KR = 1294 * MiB;
constexpr size_t WS_CQN = 1270 * MiB, WS_CKVN = 1282 * MiB, WS_KROT = 1298 * MiB, WS_QMLA = 1302 * MiB, WS_KVU = 1350 * MiB, WS_CMPKV = 1414 * MiB, WS_OCMP = 1434 * MiB;
constexpr size_t WS_LOGITS = 1142 * MiB;
constexpr int CW_TMO = 0, CW_CODE = 1, CW_BAR = 4096, CW_CNT = 16384;

constexpr int RING_BYTES = 131072, LDSCTL_OFF = RING_BYTES, MISC_OFF = LDSCTL_OFF + 320, TAB_OFF = LDSCTL_OFF + 512;
constexpr int LDS_BYTES = 147456;
constexpr int NWAVES = 8;

#define LDS_WAIT() asm volatile("s_waitcnt lgkmcnt(0)" ::: "memory")
#define VM_WAIT() asm volatile("s_waitcnt vmcnt(0)" ::: "memory")
typedef __bf16 hwbf16x2 __attribute__((ext_vector_type(2)));
__device__ __forceinline__ unsigned pk2(float lo, float hi) { const f32x2 v = {lo, hi}; const hwbf16x2 b = __builtin_convertvector(v, hwbf16x2); return __builtin_bit_cast(unsigned, b); }
__device__ __forceinline__ unsigned f2bf(float f) { return pk2(f, 0.f) & 0xffffu; }
__device__ __forceinline__ void fast_sincos(float ang, float& sn, float& cs) { const float r = __builtin_amdgcn_fractf(ang * 0.15915494309189535f); sn = __builtin_amdgcn_sinf(r); cs = __builtin_amdgcn_cosf(r); }
__device__ __forceinline__ float bflo(unsigned w) { return __builtin_bit_cast(float, w << 16); }
__device__ __forceinline__ float bfhi(unsigned w) { return __builtin_bit_cast(float, w & 0xffff0000u); }
__device__ __forceinline__ float bf1(bf16 v) { return __builtin_bit_cast(float, ((unsigned)v) << 16); }
__device__ __forceinline__ float wave_sum(float v) {
#pragma unroll
    for (int o = 1; o < 64; o <<= 1) v += __shfl_xor(v, o);
    return v;
}
__device__ __forceinline__ float wave_max(float v) {
#pragma unroll
    for (int o = 1; o < 64; o <<= 1) v = fmaxf(v, __shfl_xor(v, o));
    return v;
}
__device__ __forceinline__ float sigmoidf_(float x) { return 1.0f / (1.0f + __expf(-x)); }
__device__ __forceinline__ float siluf_(float x) { return x / (1.0f + __expf(-x)); }
__device__ __forceinline__ void unpack8(const v4u w, float (&f)[8]) {
    f[0] = bflo(w.x); f[1] = bfhi(w.x); f[2] = bflo(w.y); f[3] = bfhi(w.y); f[4] = bflo(w.z); f[5] = bfhi(w.z); f[6] = bflo(w.w); f[7] = bfhi(w.w);
}

#define XB_TMO      128
#define XB_XCNT(j)  (256  + 64 * (j))
#define XB_XSUB(j)  (1280 + 64 * (j))
#define XB_XGEN(j)  (2304 + 64 * (j))
#define XB_TOP      3328
#define XB_TOPGEN   3392
#define XCD_BAR_WORDS 3456
#define XB_SPIN_CAP (1u << 18)
__device__ __forceinline__ unsigned xb_ld(unsigned* p)              { return __hip_atomic_load(p, __ATOMIC_RELAXED, __HIP_MEMORY_SCOPE_AGENT); }
__device__ __forceinline__ unsigned xb_add(unsigned* p, unsigned v) { return __hip_atomic_fetch_add(p, v, __ATOMIC_RELAXED, __HIP_MEMORY_SCOPE_AGENT); }
__device__ __forceinline__ unsigned xb_xcc_id() { return (unsigned)__builtin_amdgcn_s_getreg((3 << 11) | 20) & 0xFu; }
#define XB_SPIN(cond, bar) do { unsigned _sp = 0; while (cond) { __builtin_amdgcn_s_sleep(1); \
    if ((++_sp & 255u) == 0u) { if (xb_ld(&(bar)[XB_TMO])) break; if (_sp > XB_SPIN_CAP) { atomicAdd(&(bar)[XB_TMO], 1u); break; } } } } while (0)
struct XcdBarrier { unsigned* bar; unsigned x; volatile LAS unsigned* st; };
__device__ __forceinline__ XcdBarrier xcd_barrier_post(unsigned* bar, volatile LAS unsigned* st) {
    XcdBarrier b; b.bar = bar; b.x = xb_xcc_id(); b.st = st;
    if (threadIdx.x == 0) (void)xb_add(&bar[XB_XCNT(b.x)], 1u);
    return b;
}
__device__ __forceinline__ void xcd_barrier_complete(unsigned* bar, unsigned x, unsigned& nloc, unsigned& nx) {
    const unsigned G = gridDim.x * gridDim.y * gridDim.z;
    unsigned sum, cnt, mine, sp = 0u;
    for (;;) {
        sum = 0u; cnt = 0u; mine = 0u;
#pragma unroll
        for (unsigned j = 0; j < 16; ++j) { const unsigned c = xb_ld(&bar[XB_XCNT(j)]); sum += c; cnt += (c > 0u) ? 1u : 0u; mine = (j == x) ? c : mine; }
        if (sum == G) break;
        __builtin_amdgcn_s_sleep(1);
        if ((++sp & 255u) == 0u) { if (xb_ld(&bar[XB_TMO])) break; if (sp > XB_SPIN_CAP) { atomicAdd(&bar[XB_TMO], 1u); break; } }
    }
    nloc = mine > 0u ? mine : 1u; nx = cnt > 0u ? cnt : 1u;
}
__device__ __forceinline__ void xcd_barrier(const XcdBarrier& b) {
    asm volatile("s_waitcnt vmcnt(0)" ::: "memory");
    __syncthreads();
    if (threadIdx.x == 0) {
        unsigned* bar = b.bar;
        __builtin_amdgcn_s_waitcnt(0);
        unsigned nloc = b.st[0], nx = b.st[1];
        if (nloc == 0u) { xcd_barrier_complete(bar, b.x, nloc, nx); b.st[0] = nloc; b.st[1] = nx; }
        const unsigned old = xb_add(&bar[XB_XSUB(b.x)], 1u);
        const unsigned gen = old / nloc;
        if (old + 1u == (gen + 1u) * nloc) {
            __builtin_amdgcn_fence(__ATOMIC_RELEASE, "agent");
            asm volatile("s_waitcnt vmcnt(0)" ::: "memory");
            const unsigned og = xb_add(&bar[XB_TOP], 1u);
            const unsigned tg = og / nx;
            if (og + 1u == (tg + 1u) * nx) xb_add(&bar[XB_TOPGEN], 1u);
            else XB_SPIN(xb_ld(&bar[XB_TOPGEN]) == tg, bar);
            __builtin_amdgcn_fence(__ATOMIC_ACQUIRE, "agent");
            xb_add(&bar[XB_XGEN(b.x)], 1u);
            asm volatile("s_waitcnt vmcnt(0)" ::: "memory");
        } else {
            XB_SPIN(xb_ld(&bar[XB_XGEN(b.x)]) == gen, bar);
            __builtin_amdgcn_fence(__ATOMIC_ACQUIRE, "agent");
            asm volatile("s_waitcnt vmcnt(0)" ::: "memory");
        }
    }
    __syncthreads();
}

namespace pg8 {
constexpr int BM = 256, BK = 64, HALF = 128, HTB = HALF * BK * 2, STAGE_BYTES = 8 * HTB, NXCD = 8, WGM = 8;
__host__ __device__ __forceinline__ int lds_byte(int r, int c) { const int st = (r >> 4) * 2 + (c >> 5), rr = r & 15, cc = c & 31, ob = rr * 64 + cc * 2; return st * 1024 + (ob ^ (((ob >> 9) & 1) << 5)); }
__host__ __device__ __forceinline__ void stage_rc(int b, int& R, int& C) { const int st = b / 1024, sb = b % 1024, swz = sb ^ (((sb >> 9) & 1) << 5); R = (st >> 1) * 16 + swz / 64; C = (st & 1) * 32 + (swz % 64) / 2; }
__host__ __device__ __forceinline__ int perm32(int rho) { const int n = rho >> 4, i = rho & 15; return 8 * (i >> 2) + 4 * n + (i & 3); }
struct Unit { int pm, pn, e; };

__device__ __forceinline__ unsigned cvt_pk_bf16(float lo, float hi) { unsigned r; asm volatile("v_cvt_pk_bf16_f32 %0, %1, %2" : "=v"(r) : "v"(lo), "v"(hi)); return r; }

struct EpiBf16 {
    static constexpr bool PERM = true;
    bf16* O; int ldc;
    __device__ __forceinline__ void operator()(const f32x4 (&acc)[2][2][4][2], const Unit& u, int wr, int wc, int fr, int fq) const {
        const int row0 = u.pm * BM + wr * 64 + fr, col0 = u.pn * BM + wc * 32 + 8 * fq;
#pragma unroll
        for (int ai = 0; ai < 2; ++ai)
#pragma unroll
            for (int m = 0; m < 4; ++m) { bf16* rowp = O + (size_t)(row0 + ai * HALF + m * 16) * ldc + col0;
#pragma unroll
                for (int bj = 0; bj < 2; ++bj) { const f32x4 v0 = acc[ai][bj][m][0], v1 = acc[ai][bj][m][1];
                    v4u w; w.x = cvt_pk_bf16(v0[0], v0[1]); w.y = cvt_pk_bf16(v0[2], v0[3]); w.z = cvt_pk_bf16(v1[0], v1[1]); w.w = cvt_pk_bf16(v1[2], v1[3]);
                    *(v4u*)(rowp + bj * HALF) = w; } }
    }
};
struct EpiF32 {
    static constexpr bool PERM = false;
    float* C; int ldc; const float* bias;
    __device__ __forceinline__ void operator()(const f32x4 (&acc)[2][2][4][2], const Unit& u, int wr, int wc, int fr, int fq) const {
        const int row0 = u.pm * BM + wr * 64 + fr, col0 = u.pn * BM + wc * 32 + 4 * fq;
        f32x4 bv[2][2];
#pragma unroll
        for (int bj = 0; bj < 2; ++bj)
#pragma unroll
            for (int n = 0; n < 2; ++n) bv[bj][n] = bias ? *(const f32x4*)(bias + col0 + bj * HALF + n * 16) : (f32x4){0.f, 0.f, 0.f, 0.f};
#pragma unroll
        for (int ai = 0; ai < 2; ++ai)
#pragma unroll
            for (int m = 0; m < 4; ++m) { float* rowp = C + (size_t)(row0 + ai * HALF + m * 16) * ldc + col0;
#pragma unroll
                for (int bj = 0; bj < 2; ++bj)
#pragma unroll
                    for (int n = 0; n < 2; ++n) *(f32x4*)(rowp + bj * HALF + n * 16) = acc[ai][bj][m][n] + bv[bj][n]; }
    }
};
struct EpiSwiglu {
    static constexpr bool PERM = true;
    bf16* H;
    __device__ __forceinline__ void operator()(const f32x4 (&acc)[2][2][4][2], const Unit& u, int wr, int wc, int fr, int fq) const {
        const int row0 = u.pm * BM + wr * 64 + fr, col0 = u.pn * HALF + wc * 32 + 8 * fq;
#pragma unroll
        for (int ai = 0; ai < 2; ++ai)
#pragma unroll
            for (int m = 0; m < 4; ++m) { bf16* rowp = H + (size_t)(row0 + ai * HALF + m * 16) * EFF + col0;
                float o[8];
#pragma unroll
                for (int n = 0; n < 2; ++n)
#pragma unroll
                    for (int j = 0; j < 4; ++j) { const float h1 = acc[ai][0][m][n][j], h3 = acc[ai][1][m][n][j]; o[n * 4 + j] = siluf_(h1) * h3; }
                v4u w; w.x = cvt_pk_bf16(o[0], o[1]); w.y = cvt_pk_bf16(o[2], o[3]); w.z = cvt_pk_bf16(o[4], o[5]); w.w = cvt_pk_bf16(o[6], o[7]);
                *(v4u*)rowp = w; }
    }
};

template <class Epi, class Prob, bool ALIGN_EPI>
__device__ __forceinline__ void gemm_phase(LAS unsigned char* lds, const Prob& P, const Epi& E) {
    const int tid = threadIdx.x, wid = __builtin_amdgcn_readfirstlane(tid >> 6), lane = tid & 63, wr = wid >> 2, wc = wid & 3, fr = lane & 15, fq = lane >> 4;
    const int K = P.K, nt = K / BK;
    int RA[2], CA[2]; unsigned voffB[2];
#pragma unroll
    for (int i = 0; i < 2; ++i) { int R, C; stage_rc(tid * 16 + i * 8192, R, C); const int Rb = Epi::PERM ? ((R & ~31) + perm32(R & 31)) : R;
        RA[i] = R; CA[i] = C; voffB[i] = (unsigned)(Rb * K + C) * 2u; }
    const size_t kstep = (size_t)(BK * 2);
    const size_t hstep = (size_t)HALF * K * 2;
    const unsigned ldsw = (unsigned)wid * 1024u;
    const int aoff = lds_byte(wr * 64 + fr, fq * 8), boff = lds_byte(wc * 32 + fr, fq * 8);
    const char* const Ab = P.Abase;
#define PG8_SA(b, h) (((b) * 2 + (h)) * HTB)
#define PG8_SB(b, h) ((4 + (b) * 2 + (h)) * HTB)
#define PG8_STAGE(bufoff, gbase, voff) do { _Pragma("unroll") for (int _i = 0; _i < 2; ++_i) \
        __builtin_amdgcn_global_load_lds((const unsigned*)((const char*)(gbase) + (voff)[_i]), (LAS unsigned*)(lds + (bufoff) + ldsw + _i * 8192), 16, 0, 0); } while (0)
#define PG8_STAGE_A(bufoff, kb, o0, o1) do { \
        __builtin_amdgcn_global_load_lds((const unsigned*)(Ab + (kb) + (o0)), (LAS unsigned*)(lds + (bufoff) + ldsw), 16, 0, 0); \
        __builtin_amdgcn_global_load_lds((const unsigned*)(Ab + (kb) + (o1)), (LAS unsigned*)(lds + (bufoff) + ldsw + 8192), 16, 0, 0); } while (0)
#define PG8_LDA(dst, b, h) do { _Pragma("unroll") for (int m = 0; m < 4; ++m) _Pragma("unroll") for (int k = 0; k < 2; ++k) dst[m][k] = *(const LAS bf16x8*)(lds + PG8_SA(b, h) + aoff + m * 2048 + k * 1024); } while (0)
#define PG8_LDB(dst, b, h) do { _Pragma("unroll") for (int n = 0; n < 2; ++n) _Pragma("unroll") for (int k = 0; k < 2; ++k) dst[n][k] = *(const LAS bf16x8*)(lds + PG8_SB(b, h) + boff + n * 2048 + k * 1024); } while (0)
#define PG8_MMA(ai, bj, At, Bt) do { __builtin_amdgcn_s_setprio(1); _Pragma("unroll") for (int m = 0; m < 4; ++m) _Pragma("unroll") for (int n = 0; n < 2; ++n) _Pragma("unroll") for (int k = 0; k < 2; ++k) \
        acc[ai][bj][m][n] = __builtin_amdgcn_mfma_f32_16x16x32_bf16(Bt[n][k], At[m][k], acc[ai][bj][m][n], 0, 0, 0); __builtin_amdgcn_s_setprio(0); } while (0)
#define PG8_WAIT_V(n) asm volatile("s_waitcnt vmcnt(" #n ")" ::: "memory")
#define PG8_WAIT_L(n) asm volatile("s_waitcnt lgkmcnt(" #n ")" ::: "memory")
#define PG8_BAR __builtin_amdgcn_s_barrier()
#define PG8_SCHED __builtin_amdgcn_sched_barrier(0)
    Unit cur, nxt; int ui = 0;
    if (!P.next(0, cur)) return;
    f32x4 acc[2][2][4][2];
#pragma unroll
    for (int a = 0; a < 2; ++a)
#pragma unroll
        for (int b = 0; b < 2; ++b)
#pragma unroll
            for (int m = 0; m < 4; ++m)
#pragma unroll
                for (int n = 0; n < 2; ++n) acc[a][b][m][n] = (f32x4){0.f, 0.f, 0.f, 0.f};
    bf16x8 At[4][2], B0[2][2], B1[2][2];
    unsigned oc[4], on[4];
    P.aoffs(cur, RA, CA, oc);
    const char* cB = P.bbase(cur);
    PG8_STAGE(PG8_SB(0, 0), cB, voffB); PG8_STAGE(PG8_SB(0, 1), cB + hstep, voffB); PG8_STAGE_A(PG8_SA(0, 0), (size_t)0, oc[0], oc[1]); PG8_STAGE_A(PG8_SA(0, 1), (size_t)0, oc[2], oc[3]);
    if (wr == 1) PG8_BAR;
    PG8_WAIT_V(2); PG8_BAR;
    PG8_STAGE(PG8_SB(1, 0), cB + kstep, voffB); PG8_STAGE_A(PG8_SA(1, 0), kstep, oc[0], oc[1]); PG8_STAGE(PG8_SB(1, 1), cB + hstep + kstep, voffB);
    PG8_WAIT_V(6); PG8_BAR;
    for (;;) {
        const bool has_next = P.next(ui + 1, nxt);
        const char* nB = cB;
        if (has_next) { P.aoffs(nxt, RA, CA, on); nB = P.bbase(nxt); }
        else { on[0] = oc[0]; on[1] = oc[1]; on[2] = oc[2]; on[3] = oc[3]; }
        for (int t = 0; t < nt; t += 2) {
            const bool last = (t == nt - 2);
            const size_t kb1 = (size_t)(t + 1) * kstep;
            const size_t kb2 = last ? (size_t)0 : (size_t)(t + 2) * kstep, kb3 = kb2 + kstep;
            const char* b2 = last ? nB : cB + (size_t)(t + 2) * kstep; const char* b3 = b2 + kstep;
            const unsigned o20 = last ? on[0] : oc[0], o21 = last ? on[1] : oc[1], o22 = last ? on[2] : oc[2], o23 = last ? on[3] : oc[3];
            PG8_LDB(B0, 0, 0); PG8_LDB(B1, 0, 1); PG8_SCHED; PG8_LDA(At, 0, 0); PG8_STAGE_A(PG8_SA(1, 1), kb1, oc[2], oc[3]);
            PG8_WAIT_V(8); PG8_WAIT_L(0); PG8_BAR; PG8_MMA(0, 0, At, B0); PG8_MMA(0, 1, At, B1); PG8_BAR; PG8_SCHED;
            PG8_LDA(At, 0, 1); PG8_STAGE(PG8_SB(0, 0), b2, voffB); PG8_STAGE(PG8_SB(0, 1), b2 + hstep, voffB); PG8_STAGE_A(PG8_SA(0, 0), kb2, o20, o21);
            PG8_WAIT_V(8); PG8_WAIT_L(0); PG8_BAR; PG8_MMA(1, 0, At, B0); PG8_MMA(1, 1, At, B1); PG8_BAR; PG8_SCHED;
            PG8_LDB(B0, 1, 0); PG8_LDB(B1, 1, 1); PG8_SCHED; PG8_LDA(At, 1, 0); PG8_STAGE_A(PG8_SA(0, 1), kb2, o22, o23);
            PG8_WAIT_V(8); PG8_WAIT_L(0); PG8_BAR; PG8_MMA(0, 0, At, B0); PG8_MMA(0, 1, At, B1); PG8_BAR; PG8_SCHED;
            PG8_LDA(At, 1, 1); PG8_STAGE(PG8_SB(1, 0), b3, voffB); PG8_STAGE(PG8_SB(1, 1), b3 + hstep, voffB); PG8_STAGE_A(PG8_SA(1, 0), kb3, o20, o21);
            PG8_WAIT_V(8); PG8_WAIT_L(0); PG8_BAR; PG8_MMA(1, 0, At, B0); PG8_MMA(1, 1, At, B1); PG8_BAR; PG8_SCHED;
        }
        if constexpr (ALIGN_EPI) { if (wr == 0) PG8_BAR; }
        E(acc, cur, wr, wc, fr, fq);
        if (!has_next) break;
#pragma unroll
        for (int a = 0; a < 2; ++a)
#pragma unroll
            for (int b = 0; b < 2; ++b)
#pragma unroll
                for (int m = 0; m < 4; ++m)
#pragma unroll
                    for (int n = 0; n < 2; ++n) acc[a][b][m][n] = (f32x4){0.f, 0.f, 0.f, 0.f};
        cur = nxt; cB = nB; oc[0] = on[0]; oc[1] = on[1]; oc[2] = on[2]; oc[3] = on[3]; ++ui;
        if constexpr (ALIGN_EPI) { if (wr == 1) PG8_BAR; }
    }
    PG8_WAIT_V(0);
    if constexpr (!ALIGN_EPI) { if (wr == 0) PG8_BAR; }
    PG8_BAR;
#undef PG8_SA
#undef PG8_SB
#undef PG8_STAGE
#undef PG8_STAGE_A
#undef PG8_LDA
#undef PG8_LDB
#undef PG8_MMA
#undef PG8_WAIT_V
#undef PG8_WAIT_L
#undef PG8_BAR
#undef PG8_SCHED
}

struct DenseProb {
    int K; const char* Abase; const char* Bt; int lda; int nM, nN, nwg, G, c;
    __device__ __forceinline__ void init(const bf16* A, int lda_, const bf16* B, int M, int N, int K_, int G_, int c_) { Abase = (const char*)A; Bt = (const char*)B; lda = lda_; K = K_; nM = M / BM; nN = N / BM; nwg = nM * nN; G = G_; c = c_; }
    __device__ __forceinline__ bool next(int i, Unit& u) const {
        const long L = (long)i * G + c; if (L >= nwg) return false;
        int wgid = (int)L; { const int q = nwg / NXCD, r = nwg % NXCD, xcd = wgid % NXCD, off = wgid / NXCD; wgid = (xcd < r ? xcd * (q + 1) : r * (q + 1) + (xcd - r) * q) + off; }
        const int nig = WGM * nN, gid = wgid / nig, fm = gid * WGM, gsz = (nM - fm) < WGM ? (nM - fm) : WGM;
        u.pm = fm + ((wgid % nig) % gsz); u.pn = (wgid % nig) / gsz; u.e = 0; return true;
    }
    __device__ __forceinline__ const char* bbase(const Unit& u) const { return Bt + (size_t)u.pn * BM * K * 2; }
    __device__ __forceinline__ void aoffs(const Unit& u, const int (&R)[2], const int (&C)[2], unsigned (&o)[4]) const {
#pragma unroll
        for (int h = 0; h < 2; ++h)
#pragma unroll
            for (int i = 0; i < 2; ++i) o[2 * h + i] = (unsigned)(((size_t)(u.pm * BM + h * HALF + R[i]) * lda + C[i]) * 2);
    }
};
__device__ __forceinline__ bool xcd_range_unit(int i, int nunits, int G, int c, int& L) {
    const int x = c % NXCD, cc = c / NXCD, per = G / NXCD, q = nunits / NXCD, r = nunits % NXCD;
    const int start = x * q + (x < r ? x : r), cnt = q + (x < r ? 1 : 0), li = i * per + cc;
    if (li >= cnt) return false; L = start + li; return true;
}
struct MoeUpProb {
    int K; const char* Abase; const char* W13; const int* sorted; const LAS int* tile_e; int ntiles, nunits, G, c;
    __device__ __forceinline__ bool next(int i, Unit& u) const {
        int L; if (!xcd_range_unit(i, nunits, G, c, L)) return false;
        const int tile = L >> 2; u.pn = L & 3;
        if (tile < ntiles) { u.pm = tile; u.e = __builtin_amdgcn_readfirstlane(tile_e[tile]); } else { u.pm = MAXTILES + (tile - ntiles); u.e = NEXP; }
        return true;
    }
    __device__ __forceinline__ const char* bbase(const Unit& u) const { return W13 + ((size_t)u.e * 1024 + (size_t)u.pn * BM) * 2048 * 2; }
    __device__ __forceinline__ void aoffs(const Unit& u, const int (&R)[2], const int (&C)[2], unsigned (&o)[4]) const {
#pragma unroll
        for (int h = 0; h < 2; ++h)
#pragma unroll
            for (int i = 0; i < 2; ++i) { int row;
                if (u.e == NEXP) row = (u.pm - MAXTILES) * BM + h * HALF + R[i];
                else row = sorted[u.pm * BM + h * HALF + R[i]];
                o[2 * h + i] = (unsigned)(((size_t)row * 2048 + C[i]) * 2); }
    }
};
struct MoeDownProb {
    int K; const char* Abase; const char* W2; const LAS int* tile_e; int ntiles, nunits, G, c;
    __device__ __forceinline__ bool next(int i, Unit& u) const {
        int L; if (!xcd_range_unit(i, nunits, G, c, L)) return false;
        const int tile = L >> 3; u.pn = L & 7;
        if (tile < ntiles) { u.pm = tile; u.e = __builtin_amdgcn_readfirstlane(tile_e[tile]); } else { u.pm = MAXTILES + (tile - ntiles); u.e = NEXP; }
        return true;
    }
    __device__ __forceinline__ const char* bbase(const Unit& u) const { return W2 + ((size_t)u.e * 2048 + (size_t)u.pn * BM) * EFF * 2; }
    __device__ __forceinline__ void aoffs(const Unit& u, const int (&R)[2], const int (&C)[2], unsigned (&o)[4]) const {
#pragma unroll
        for (int h = 0; h < 2; ++h)
#pragma unroll
            for (int i = 0; i < 2; ++i) o[2 * h + i] = (unsigned)(((size_t)(u.pm * BM + h * HALF + R[i]) * EFF + C[i]) * 2);
    }
};
struct CmpProb {
    int K; const char* Abase; const char* Bt; int G, c;
    __device__ __forceinline__ bool next(int i, Unit& u) const { const int L = i * G + c; if (L >= 16) return false; u.pm = L; u.pn = 0; u.e = 0; return true; }
    __device__ __forceinline__ const char* bbase(const Unit&) const { return Bt; }
    __device__ __forceinline__ void aoffs(const Unit& u, const int (&R)[2], const int (&C)[2], unsigned (&o)[4]) const {
#pragma unroll
        for (int h = 0; h < 2; ++h)
#pragma unroll
            for (int i = 0; i < 2; ++i) { const int m = u.pm * BM + h * HALF + R[i], seq = m >> 7, n = m & 127;
                o[2 * h + i] = (unsigned)((((size_t)seq * NS + 16 * n) * 128 + C[i]) * 2); }
    }
};
}

struct Args { const float* in[27]; float* out; unsigned char* ws; int ph_lo, ph_hi; };
typedef const __attribute__((address_space(4))) Args* CArgs;
__device__ __forceinline__ const float* kin(int i) { CArgs p = (CArgs)__builtin_amdgcn_kernarg_segment_ptr(); asm volatile("" : "+s"(p)); return p->in[i]; }
struct Frame {
    LAS unsigned char* lds;
    volatile LAS unsigned* MISC;
    unsigned* ctl;
    unsigned char* ws;
    int tid, lane, wave, vcu, G, gw, NGW;
    float* out;
};

__device__ __forceinline__ void tr_item(const float* W, int ldw, int k0, int n0, int nvalid, bf16* WT, int ldt, int drow0, LAS float* scr, int lane) {
    float v[32]; const int n = lane & 31; const bool okn = n < nvalid; const float* src = W + (size_t)(k0 + (lane >> 5)) * ldw + n0 + n;
#pragma unroll
    for (int i = 0; i < 32; ++i) v[i] = okn ? src[(size_t)(2 * i) * ldw] : 0.f;
#pragma unroll
    for (int i = 0; i < 32; ++i) scr[(2 * i + (lane >> 5)) * 33 + n] = v[i];
    LDS_WAIT(); asm volatile("" ::: "memory");
    const int c = lane & 7;
#pragma unroll
    for (int j = 0; j < 4; ++j) { const int nn = (lane >> 3) + 8 * j; const LAS float* sp = scr + (8 * c) * 33 + nn;
        v4u o; o.x = pk2(sp[0 * 33], sp[1 * 33]); o.y = pk2(sp[2 * 33], sp[3 * 33]); o.z = pk2(sp[4 * 33], sp[5 * 33]); o.w = pk2(sp[6 * 33], sp[7 * 33]);
        if (nn < nvalid) *(v4u*)(WT + (size_t)(drow0 + nn) * ldt + k0 + 8 * c) = o; }
    LDS_WAIT(); asm volatile("" ::: "memory");
}
__device__ __forceinline__ bool tr_matrix(int& it, const float* W, int ldw, int K, int c0, int ncols, bf16* WT, int drow0, LAS float* scr, int lane) {
    const int nb = (ncols + 31) / 32, items = (K / 64) * nb;
    if (it >= items) { it -= items; return false; }
    const int kb = it / nb, b = it % nb, nv = ncols - 32 * b;
    tr_item(W, ldw, 64 * kb, c0 + 32 * b, nv < 32 ? nv : 32, WT, K, drow0 + 32 * b, scr, lane);
    return true;
}
__device__ __forceinline__ void zero_rows(Frame& F, bf16* base, size_t nelem) {
    for (size_t i = ((size_t)F.gw * 64 + F.lane) * 8; i < nelem; i += (size_t)F.NGW * 64 * 8) *(v4u*)(base + i) = (v4u){0u, 0u, 0u, 0u};
}

__device__ __forceinline__ void p_prologue(Frame& F) {
    LAS float* scr = (LAS float*)(F.lds + F.wave * 16384);
    unsigned char* ws = F.ws;
    {
        LAS float* wl = (LAS float*)F.lds;
        LAS float* pl = (LAS float*)(F.lds + 32768);
        const float* w_in = kin(2); const float* pool_w = kin(3); const float* pscale = kin(4);
        bf16* WT = (bf16*)(ws + WS_WABIN);
        for (int it = blockIdx.x; it < 4 * 32; it += F.G) {
            const int g = it >> 5, k0 = (it & 31) * 64;
            for (int i = F.tid; i < 64 * 128; i += 512) wl[i] = w_in[(size_t)(k0 + (i >> 7)) * AB_IN + g * 128 + (i & 127)];
            for (int i = F.tid; i < 128 * 128; i += 512) pl[i] = pool_w[(size_t)g * 16384 + i];
            __syncthreads();
            const int d = F.tid & 127, kg = F.tid >> 7; const float sc = pscale[g * 128 + d];
            for (int kk = 0; kk < 16; kk += 8) {
                float a[8];
#pragma unroll
                for (int j = 0; j < 8; ++j) a[j] = 0.f;
                for (int c = 0; c < 128; ++c) { const float pw = pl[c * 128 + d];
#pragma unroll
                    for (int j = 0; j < 8; ++j) a[j] += wl[(kg * 16 + kk + j) * 128 + c] * pw; }
                v4u o; o.x = pk2(a[0] * sc, a[1] * sc); o.y = pk2(a[2] * sc, a[3] * sc); o.z = pk2(a[4] * sc, a[5] * sc); o.w = pk2(a[6] * sc, a[7] * sc);
                *(v4u*)(WT + (size_t)(g * 128 + d) * ND + k0 + kg * 16 + kk) = o;
            }
            __syncthreads();
        }
    }
    __syncthreads();
    for (int it0 = F.gw; ; it0 += F.NGW) {
        int it = it0;
        if (tr_matrix(it, kin(2), AB_IN, ND, 512, AB_IN - 512, (bf16*)(ws + WS_WABIN), 512, scr, F.lane)) continue;
        if (tr_matrix(it, kin(5), ND, ND, 0, ND, (bf16*)(ws + WS_WABOUT), 0, scr, F.lane)) continue;
        if (tr_matrix(it, kin(6), CD_IN, ND, 0, CD_IN, (bf16*)(ws + WS_WCDIN), 0, scr, F.lane)) continue;
        if (tr_matrix(it, kin(14), ND, ND, 0, ND, (bf16*)(ws + WS_WCDOUT), 0, scr, F.lane)) continue;
        if (tr_matrix(it, kin(11), 1536, 384, 0, 1536, (bf16*)(ws + WS_WUQ), 0, scr, F.lane)) continue;
        if (tr_matrix(it, kin(13), 2048, 512, 0, 2048, (bf16*)(ws + WS_WUKV), 0, scr, F.lane)) continue;
        if (tr_matrix(it, kin(8), 128, 4096, 0, 128, (bf16*)(ws + WS_CW1), 0, scr, F.lane)) continue;
        if (tr_matrix(it, kin(8) + (size_t)4096 * 128, 128, 4096, 0, 128, (bf16*)(ws + WS_CW1), 128, scr, F.lane)) continue;
        break;
    }
    zero_rows(F, (bf16*)(ws + WS_WCDIN) + (size_t)CD_IN * ND, (size_t)(CD_INP - CD_IN) * ND);
    { const float* x = kin(0); bf16* xb = (bf16*)(ws + WS_XB0);
      for (size_t i = ((size_t)F.gw * 64 + F.lane) * 8; i < (size_t)NT * ND; i += (size_t)F.NGW * 64 * 8) {
          const f32x4 a = *(const f32x4*)(x + i), b = *(const f32x4*)(x + i + 4);
          v4u o; o.x = pk2(a[0], a[1]); o.y = pk2(a[2], a[3]); o.z = pk2(b[0], b[1]); o.w = pk2(b[2], b[3]); *(v4u*)(xb + i) = o; } }
    for (int o = F.gw; o < 256; o += F.NGW) { const int kv = o >> 7, h = o & 127; const float* pos = kin(7) + (size_t)kv * 4096; const float* w1 = kin(8) + (size_t)kv * 4096 * 128;
        float sacc = 0.f; for (int f = F.lane; f < 4096; f += 64) sacc += pos[f] * w1[(size_t)f * 128 + h];
        sacc = wave_sum(sacc); if (F.lane == 0) ((float*)(ws + WS_CMPB))[o] = sacc; }
}
constexpr int MW_ITEMS_L = 65 * 1536 + 64;
__device__ __forceinline__ void moe_weight_item(int l, int it, unsigned char* ws, LAS float* scr, int lane) {
    bf16* W13 = (bf16*)(ws + WS_W13 + (size_t)l * WS_MOE_LSTRIDE); bf16* W2 = (bf16*)(ws + WS_W2 + (size_t)l * WS_MOE_LSTRIDE); bf16* RT = (bf16*)(ws + WS_RT + (size_t)l * MiB);
    if (it >= 65 * 1536) { const int r = it - 65 * 1536, kb = r >> 1, b = r & 1;
        tr_item(kin(19) + (size_t)l * ND * NEXP, NEXP, 64 * kb, 32 * b, 32, RT, ND, 32 * b, scr, lane); return; }
    const int e = it / 1536, r = it % 1536;
    const float *w1, *w3, *w2;
    if (e < NEXP) { const size_t o = ((size_t)l * NEXP + e) * ND * EFF; w1 = kin(21) + o; w3 = kin(22) + o; w2 = kin(23) + o; }
    else { const size_t o = (size_t)l * ND * EFF; w1 = kin(24) + o; w3 = kin(25) + o; w2 = kin(26) + o; }
    if (r < 1024) { const int which = r >> 9, rr = r & 511, kb = rr >> 4, nb = rr & 15;
        const int j = nb >> 2, drow = j * 256 + which * 128 + (nb & 3) * 32;
        tr_item(which ? w3 : w1, EFF, 64 * kb, 32 * nb, 32, W13 + (size_t)e * 1024 * ND, ND, drow, scr, lane); }
    else { const int rr = r - 1024, kb = rr >> 6, nb = rr & 63;
        tr_item(w2, ND, 64 * kb, 32 * nb, 32, W2 + (size_t)e * ND * EFF, EFF, 32 * nb, scr, lane); }
}
__device__ __forceinline__ void p_moe_weights_queue(Frame& F, unsigned* queue) {
    LAS float* scr = (LAS float*)(F.lds + F.wave * 16384);
    constexpr int BATCH = 16, NB_ = (2 * MW_ITEMS_L + BATCH - 1) / BATCH;
    for (;;) {
        unsigned bq = 0; if (F.lane == 0) bq = atomicAdd(queue, 1u);
        const int bi = __builtin_amdgcn_readfirstlane((int)bq);
        if (bi >= NB_) break;
        for (int k = 0; k < BATCH; ++k) { const int it = bi * BATCH + k; if (it >= 2 * MW_ITEMS_L) break; const int l = it >= MW_ITEMS_L ? 1 : 0; moe_weight_item(l, it - l * MW_ITEMS_L, F.ws, scr, F.lane); }
    }
    for (int l = 0; l < 2; ++l) zero_rows(F, (bf16*)(F.ws + WS_RT + (size_t)l * MiB) + (size_t)NEXP * ND, (size_t)(256 - NEXP) * ND);
}

__device__ __forceinline__ void ln_finish(float (&v)[4][8], const float* g, const float* b, int lane, bf16* ob, float* of) {
    float s = 0.f;
#pragma unroll
    for (int j = 0; j < 4; ++j)
#pragma unroll
        for (int i = 0; i < 8; ++i) s += v[j][i];
    const float mean = wave_sum(s) * (1.f / ND); float s2 = 0.f;
#pragma unroll
    for (int j = 0; j < 4; ++j)
#pragma unroll
        for (int i = 0; i < 8; ++i) { v[j][i] -= mean; s2 += v[j][i] * v[j][i]; }
    const float rstd = 1.f / sqrtf(wave_sum(s2) * (1.f / ND) + LN_EPS);
#pragma unroll
    for (int j = 0; j < 4; ++j) { const int c0 = (j * 64 + lane) * 8;
        const f32x4 g0 = *(const f32x4*)(g + c0), g1 = *(const f32x4*)(g + c0 + 4), b0 = *(const f32x4*)(b + c0), b1 = *(const f32x4*)(b + c0 + 4);
        float o[8];
#pragma unroll
        for (int i = 0; i < 4; ++i) { o[i] = v[j][i] * rstd * g0[i] + b0[i]; o[4 + i] = v[j][4 + i] * rstd * g1[i] + b1[i]; }
        if (ob) { v4u w; w.x = pk2(o[0], o[1]); w.y = pk2(o[2], o[3]); w.z = pk2(o[4], o[5]); w.w = pk2(o[6], o[7]); *(v4u*)(ob + c0) = w; }
        if (of) { *(f32x4*)(of + c0) = (f32x4){o[0], o[1], o[2], o[3]}; *(f32x4*)(of + c0 + 4) = (f32x4){o[4], o[5], o[6], o[7]}; } }
}
__device__ __forceinline__ void p_ln1(Frame& F, const bf16* xin, const bf16* mixo, const float* g, const float* b, bf16* xo) {
    for (int m = F.gw; m < NT; m += F.NGW) {
        float v[4][8];
#pragma unroll
        for (int j = 0; j < 4; ++j) { const size_t o = (size_t)m * ND + (j * 64 + F.lane) * 8; float a[8], c[8]; unpack8(*(const v4u*)(xin + o), a); unpack8(*(const v4u*)(mixo + o), c);
#pragma unroll
            for (int i = 0; i < 8; ++i) v[j][i] = DN_ALPHA * a[i] + c[i]; }
        ln_finish(v, g, b, F.lane, xo + (size_t)m * ND, nullptr);
    }
}
__device__ __forceinline__ void p_combine_ln2(Frame& F, const bf16* x1, const bf16* y2, const int* slot, const float* wsel, const float* g, const float* b, bf16* xo, float* fo) {
    for (int m = F.gw; m < NT; m += F.NGW) {
        float v[4][8];
#pragma unroll
        for (int j = 0; j < 4; ++j) { const size_t o = (size_t)m * ND + (j * 64 + F.lane) * 8; float a[8], c[8]; unpack8(*(const v4u*)(x1 + o), a);
            unpack8(*(const v4u*)(y2 + (size_t)(SH_ROW0 + m) * ND + (j * 64 + F.lane) * 8), c);
#pragma unroll
            for (int i = 0; i < 8; ++i) v[j][i] = DN_ALPHA * a[i] + c[i]; }
        for (int k = 0; k < 8; ++k) { const int row = slot[m * 8 + k]; const float w = wsel[m * 8 + k];
#pragma unroll
            for (int j = 0; j < 4; ++j) { float c[8]; unpack8(*(const v4u*)(y2 + (size_t)row * ND + (j * 64 + F.lane) * 8), c);
#pragma unroll
                for (int i = 0; i < 8; ++i) v[j][i] += w * c[i]; } }
        ln_finish(v, g, b, F.lane, xo ? xo + (size_t)m * ND : nullptr, fo ? fo + (size_t)m * ND : nullptr);
    }
}

__device__ __forceinline__ void p_pool_rope(Frame& F) {
    const bf16* proj = (const bf16*)(F.ws + WS_PROJ); bf16* mixin = (bf16*)(F.ws + WS_MIXIN); bf16* qr = (bf16*)(F.ws + WS_QR); bf16* kr = (bf16*)(F.ws + WS_KR);
    const int* pos = (const int*)kin(1);
    for (int m = F.gw; m < NT; m += F.NGW) {
        const int s = m & (NS - 1);
        { const int g = F.lane >> 4, w = 2 << g; const int lo = (s + 1 - w) > 0 ? (s + 1 - w) : 0; const float cnt = (float)((s + 1) < w ? (s + 1) : w);
          float acc[8], cur[8];
#pragma unroll
          for (int i = 0; i < 8; ++i) acc[i] = 0.f;
          for (int j = lo; j <= s; ++j) { float t[8]; unpack8(*(const v4u*)(proj + (size_t)(m - s + j) * AB_IN + F.lane * 8), t);
#pragma unroll
              for (int i = 0; i < 8; ++i) acc[i] += t[i]; }
          unpack8(*(const v4u*)(proj + (size_t)m * AB_IN + F.lane * 8), cur);
          float o[8];
#pragma unroll
          for (int i = 0; i < 8; ++i) o[i] = acc[i] / cnt - cur[i];
          v4u wv; wv.x = pk2(o[0], o[1]); wv.y = pk2(o[2], o[3]); wv.z = pk2(o[4], o[5]); wv.w = pk2(o[6], o[7]); *(v4u*)(mixin + (size_t)m * ND + F.lane * 8) = wv; }
        { const float p = (float)pos[m]; const float invf = exp2f(-(float)F.lane * (13.287712379549449f / 64.f));
          float sn, cs; fast_sincos(p * invf, sn, cs);
          const bf16* qrow = proj + (size_t)m * AB_IN + 512; const bf16* krow = proj + (size_t)m * AB_IN + 1280;
#pragma unroll
          for (int h = 0; h < 6; ++h) {
              const float q1 = bf1(qrow[h * 128 + F.lane]), q2 = bf1(qrow[h * 128 + 64 + F.lane]);
              qr[(size_t)m * 768 + h * 128 + F.lane] = (bf16)f2bf(q1 * cs - q2 * sn); qr[(size_t)m * 768 + h * 128 + 64 + F.lane] = (bf16)f2bf(q1 * sn + q2 * cs);
              const float k1 = bf1(krow[h * 128 + F.lane]), k2 = bf1(krow[h * 128 + 64 + F.lane]); const float ksc = 0.08838834764831845f;
              kr[(size_t)m * 768 + h * 128 + F.lane] = (bf16)f2bf((k1 * cs - k2 * sn) * ksc); kr[(size_t)m * 768 + h * 128 + 64 + F.lane] = (bf16)f2bf((k1 * sn + k2 * cs) * ksc);
          } }
    }
}
namespace ret {
typedef short v4i16_t __attribute__((ext_vector_type(4)));
constexpr int PITCH = 272, TILE = 128 * PITCH;
__device__ __forceinline__ bf16x8 trfrag(LAS unsigned char* trb, int r0, int r1, int c0) {
    const v4i16_t a = __builtin_amdgcn_ds_read_tr16_b64_v4i16((LAS v4i16_t*)(trb + r0 * PITCH + c0 * 2));
    const v4i16_t b = __builtin_amdgcn_ds_read_tr16_b64_v4i16((LAS v4i16_t*)(trb + r1 * PITCH + c0 * 2));
    return (bf16x8){a[0], a[1], a[2], a[3], b[0], b[1], b[2], b[3]};
}
}
__device__ __forceinline__ void p_retention_mfma(Frame& F, int bh) {
    const bf16* proj = (const bf16*)(F.ws + WS_PROJ); bf16* mixin = (bf16*)(F.ws + WS_MIXIN); const bf16* qr = (const bf16*)(F.ws + WS_QR); const bf16* kr = (const bf16*)(F.ws + WS_KR);
    constexpr int P = ret::PITCH;
    LAS unsigned char* KT = F.lds; LAS unsigned char* VT = F.lds + ret::TILE; LAS unsigned char* ST = F.lds + 2 * ret::TILE;
    const int b = bh / 6, h = bh % 6, w = F.wave, lane = F.lane, i16 = lane & 15, g = lane >> 4, q4 = (lane & 15) >> 2, p4 = lane & 3;
    const float lg = log2f(1.0f - exp2f(-5.0f - (float)h)), gc = exp2f(128.f * lg);
    const int rowb = i16 * P + 16 * g;
    const int trl = q4 * P + 8 * p4;
    LAS unsigned char* const trV4 = VT + trl + 4 * g * P;
    LAS unsigned char* const trV8 = VT + trl + 8 * g * P;
    LAS unsigned char* const trK8 = KT + trl + 8 * g * P;
    f32x4 T[2][8];
#pragma unroll
    for (int a = 0; a < 2; ++a)
#pragma unroll
        for (int d = 0; d < 8; ++d) T[a][d] = (f32x4){0.f, 0.f, 0.f, 0.f};
    const int srow = F.tid >> 2, scb = (F.tid & 3) * 4;
    for (int n = 0; n < NS / 128; ++n) {
        const size_t m0 = (size_t)b * NS + n * 128;
        { const float fk = exp2f(-(float)srow * lg);
#pragma unroll
          for (int c = 0; c < 4; ++c) { const int c8 = scb + c; float t[8];
              unpack8(*(const v4u*)(kr + (m0 + srow) * 768 + h * 128 + c8 * 8), t);
              v4u o; o.x = pk2(t[0] * fk, t[1] * fk); o.y = pk2(t[2] * fk, t[3] * fk); o.z = pk2(t[4] * fk, t[5] * fk); o.w = pk2(t[6] * fk, t[7] * fk); *(LAS v4u*)(KT + srow * P + c8 * 16) = o; } }
        bf16x8 qf[4], pf[4]; float rs[4] = {0.f, 0.f, 0.f, 0.f}, rq[4] = {0.f, 0.f, 0.f, 0.f};
        { const float fq = exp2f((float)(16 * w + i16) * lg);
#pragma unroll
          for (int ks = 0; ks < 4; ++ks) { float t[8]; unpack8(*(const v4u*)(qr + (m0 + 16 * w + i16) * 768 + h * 128 + 32 * ks + 8 * g), t);
              v4u o; o.x = pk2(t[0] * fq, t[1] * fq); o.y = pk2(t[2] * fq, t[3] * fq); o.z = pk2(t[4] * fq, t[5] * fq); o.w = pk2(t[6] * fq, t[7] * fq); qf[ks] = __builtin_bit_cast(bf16x8, o); } }
#pragma unroll
        for (int hv = 0; hv < 2; ++hv) {
            if (hv == 1) __syncthreads();
#pragma unroll
            for (int c = 0; c < 4; ++c) { const int c8 = scb + c; *(LAS v4u*)(VT + srow * P + c8 * 16) = *(const v4u*)(proj + (m0 + srow) * AB_IN + 2048 + h * 256 + hv * 128 + c8 * 8); }
            { LAS unsigned char* stw = ST + (16 * w + 4 * g) * P + i16 * 2;
#pragma unroll
              for (int dt = 0; dt < 8; ++dt)
#pragma unroll
                for (int r = 0; r < 4; ++r) { T[hv][dt][r] *= gc; *(LAS bf16*)(stw + r * P + dt * 32) = (bf16)f2bf(T[hv][dt][r]); } }
            __syncthreads();
            if (hv == 0) {
                f32x4 sc[8];
#pragma unroll
                for (int mt = 0; mt < 8; ++mt) { sc[mt] = (f32x4){0.f, 0.f, 0.f, 0.f};
                    if (mt <= w) {
#pragma unroll
                        for (int ks = 0; ks < 4; ++ks) { const bf16x8 kf = *(const LAS bf16x8*)(KT + rowb + mt * 16 * P + ks * 64); sc[mt] = __builtin_amdgcn_mfma_f32_16x16x32_bf16(kf, qf[ks], sc[mt], 0, 0, 0); }
                        if (mt == w) {
#pragma unroll
                            for (int r = 0; r < 4; ++r) sc[mt][r] = (4 * g + r <= i16) ? sc[mt][r] : 0.f; } } }
#pragma unroll
                for (int k2 = 0; k2 < 4; ++k2) { v4u wv; wv.x = pk2(sc[2 * k2][0], sc[2 * k2][1]); wv.y = pk2(sc[2 * k2][2], sc[2 * k2][3]); wv.z = pk2(sc[2 * k2 + 1][0], sc[2 * k2 + 1][1]); wv.w = pk2(sc[2 * k2 + 1][2], sc[2 * k2 + 1][3]);
                    pf[k2] = __builtin_bit_cast(bf16x8, wv); }
            }
#pragma unroll
            for (int nt = 0; nt < 8; ++nt) { f32x4 acc = (f32x4){0.f, 0.f, 0.f, 0.f};
#pragma unroll
                for (int k2 = 0; k2 < 4; ++k2) if (2 * k2 <= w) { const bf16x8 vf = ret::trfrag(trV4, 32 * k2, 32 * k2 + 16, 16 * nt); acc = __builtin_amdgcn_mfma_f32_16x16x32_bf16(pf[k2], vf, acc, 0, 0, 0); }
#pragma unroll
                for (int ks = 0; ks < 4; ++ks) { const bf16x8 sf = *(const LAS bf16x8*)(ST + rowb + nt * 16 * P + ks * 64); acc = __builtin_amdgcn_mfma_f32_16x16x32_bf16(qf[ks], sf, acc, 0, 0, 0); }
#pragma unroll
                for (int r = 0; r < 4; ++r) { rs[r] += acc[r]; rq[r] += acc[r] * acc[r]; mixin[(m0 + 16 * w + 4 * g + r) * ND + 512 + h * 256 + hv * 128 + 16 * nt + i16] = (bf16)f2bf(acc[r]); } }
#pragma unroll
            for (int ks = 0; ks < 4; ++ks) { const bf16x8 af = ret::trfrag(trV8, 32 * ks, 32 * ks + 4, 16 * w);
#pragma unroll
                for (int dt = 0; dt < 8; ++dt) { const bf16x8 bfr = ret::trfrag(trK8, 32 * ks, 32 * ks + 4, 16 * dt); T[hv][dt] = __builtin_amdgcn_mfma_f32_16x16x32_bf16(af, bfr, T[hv][dt], 0, 0, 0); } }
        }
#pragma unroll
        for (int r = 0; r < 4; ++r) { float sm = rs[r], s2 = rq[r];
            sm += __shfl_xor(sm, 1); sm += __shfl_xor(sm, 2); sm += __shfl_xor(sm, 4); sm += __shfl_xor(sm, 8);
            s2 += __shfl_xor(s2, 1); s2 += __shfl_xor(s2, 2); s2 += __shfl_xor(s2, 4); s2 += __shfl_xor(s2, 8);
            const float mean = sm * (1.f / 256.f); const float var = fmaxf(s2 * (1.f / 256.f) - mean * mean, 0.f);
            const float rstd = 1.f / sqrtf(var + NORM_EPS);
            const size_t m = m0 + 16 * w + 4 * g + r;
#pragma unroll
            for (int t = 0; t < 16; ++t) { bf16* yp = mixin + m * ND + 512 + h * 256 + 16 * t + i16; const float gt = bf1(proj[m * AB_IN + 3584 + h * 256 + 16 * t + i16]);
                *yp = (bf16)f2bf((bf1(*yp) - mean) * rstd * siluf_(gt)); } }
        __syncthreads();
    }
}

__device__ __forceinline__ void p_route(Frame& F, int l) {
    const float* logits = (const float*)(F.ws + WS_LOGITS); const float* rbias = kin(20) + l * NEXP;
    int* tope = (int*)(F.ws + WS_TOPE); float* wsel = (float*)(F.ws + WS_WSEL); int* posb = (int*)(F.ws + WS_SLOT); unsigned* cnt = F.ctl + CW_CNT + l * 64;
    LAS unsigned* lcnt = (LAS unsigned*)F.lds; LAS unsigned* lbase = lcnt + 64; LAS int* le = (LAS int*)(lcnt + 128); LAS unsigned* lp = (LAS unsigned*)(lcnt + 128 + 512);
    const float bias = rbias[F.lane]; const int lane = F.lane;
    for (int chunk = blockIdx.x; chunk < NT / 64; chunk += F.G) {
        __syncthreads();
        if (F.tid < 64) lcnt[F.tid] = 0u;
        __syncthreads();
        for (int t = 0; t < 8; ++t) {
            const int tl = F.wave * 8 + t, m = chunk * 64 + tl;
            const float sc = sigmoidf_(logits[(size_t)m * 256 + lane]), bi = sc + bias;
            const int grp = lane >> 3;
            int rk = 0;
#pragma unroll
            for (int j = 1; j < 8; ++j) { const int o = lane ^ j; const float ov = __shfl_xor(bi, j); rk += ((ov > bi) || (ov == bi && o < lane)) ? 1 : 0; }
            float gs = rk < 2 ? bi : 0.f; gs += __shfl_xor(gs, 1); gs += __shfl_xor(gs, 2); gs += __shfl_xor(gs, 4);
            int grk = 0;
#pragma unroll
            for (int gg = 0; gg < 8; ++gg) { const float ov = __builtin_bit_cast(float, __builtin_amdgcn_readlane(__builtin_bit_cast(int, gs), gg * 8)); grk += (gg != grp && ((ov > gs) || (ov == gs && gg < grp))) ? 1 : 0; }
            const float mv = grk < 4 ? bi : -1e30f;
            int erk = 0;
#pragma unroll 16
            for (int j = 0; j < 64; ++j) { const float ov = __builtin_bit_cast(float, __builtin_amdgcn_readlane(__builtin_bit_cast(int, mv), j)); erk += ((ov > mv) || (ov == mv && j < lane)) ? 1 : 0; }
            const bool sel = erk < 8;
            const float wsum = wave_sum(sel ? sc : 0.f);
            if (sel) { const unsigned q = __hip_atomic_fetch_add(lcnt + lane, 1u, __ATOMIC_RELAXED, __HIP_MEMORY_SCOPE_WORKGROUP);
                tope[m * 8 + erk] = lane; wsel[m * 8 + erk] = sc / wsum * 2.5f; le[tl * 8 + erk] = lane; lp[tl * 8 + erk] = q; }
        }
        __syncthreads();
        if (F.tid < 64) lbase[F.tid] = atomicAdd(&cnt[F.tid], lcnt[F.tid]);
        __syncthreads();
        posb[chunk * 512 + F.tid] = (int)(lbase[le[F.tid]] + lp[F.tid]);
    }
}
__device__ __forceinline__ void load_offsets(Frame& F, int l) {
    volatile LAS int* tab = (volatile LAS int*)(F.lds + TAB_OFF);
    __syncthreads();
    if (F.tid < NEXP) tab[66 + F.tid] = (int)__hip_atomic_load(F.ctl + CW_CNT + l * 64 + F.tid, __ATOMIC_RELAXED, __HIP_MEMORY_SCOPE_AGENT);
    __syncthreads();
    if (F.tid == 0) { int o = 0; for (int e = 0; e < NEXP; ++e) { tab[e] = o; int c = tab[66 + e]; if (c > NT) c = NT; const int nt_ = (c + 255) >> 8; for (int t = 0; t < nt_; ++t) { const int ti = (o >> 8) + t; if (ti < MAXTILES) tab[160 + ti] = e; } o += nt_ << 8; if (o > MAXROWS) o = MAXROWS; }
        tab[64] = o; tab[65] = o >> 8; }
    __syncthreads();
}
__device__ __forceinline__ void p_scatter(Frame& F, int l) {
    load_offsets(F, l);
    const LAS int* tab = (const LAS int*)(F.lds + TAB_OFF);
    const int* tope = (const int*)(F.ws + WS_TOPE); int* slot = (int*)(F.ws + WS_SLOT); int* sorted = (int*)(F.ws + WS_SORTED);
    for (int i = F.gw * 64 + F.lane; i < NT * 8; i += F.NGW * 64) { const int e = tope[i]; const int row = tab[e] + slot[i]; sorted[row] = i >> 3; slot[i] = row; }
    for (int i = F.gw * 64 + F.lane; i < NEXP * 256; i += F.NGW * 64) { const int e = i >> 8, j = i & 255; const int r = tab[e] + tab[66 + e] + j; if (r < tab[e + 1]) sorted[r] = 0; }
}

__device__ __forceinline__ void p_l1_thin_a(Frame& F) {
    const bf16* proj = (const bf16*)(F.ws + WS_PROJ); const int* pos = (const int*)kin(1);
    bf16* cqn = (bf16*)(F.ws + WS_CQN); bf16* ckvn = (bf16*)(F.ws + WS_CKVN); bf16* krot = (bf16*)(F.ws + WS_KROT); bf16* cmpkv = (bf16*)(F.ws + WS_CMPKV);
    const float* qn = kin(10); const float* kvn = kin(12);
    for (int m = F.gw; m < NT; m += F.NGW) {
        const bf16* row = proj + (size_t)m * CD_INP;
        { float x[6]; float s = 0.f;
#pragma unroll
          for (int j = 0; j < 6; ++j) { x[j] = bf1(row[2584 + j * 64 + F.lane]); s += x[j] * x[j]; }
          const float r = 1.f / sqrtf(wave_sum(s) * (1.f / 384.f) + NORM_EPS);
#pragma unroll
          for (int j = 0; j < 6; ++j) cqn[(size_t)m * 384 + j * 64 + F.lane] = (bf16)f2bf(x[j] * r * qn[j * 64 + F.lane]); }
        { float x[8]; float s = 0.f;
#pragma unroll
          for (int j = 0; j < 8; ++j) { x[j] = bf1(row[2968 + j * 64 + F.lane]); s += x[j] * x[j]; }
          const float r = 1.f / sqrtf(wave_sum(s) * (1.f / 512.f) + NORM_EPS);
#pragma unroll
          for (int j = 0; j < 8; ++j) ckvn[(size_t)m * 512 + j * 64 + F.lane] = (bf16)f2bf(x[j] * r * kvn[j * 64 + F.lane]); }
        { const int i = F.lane & 31; const float p = (float)pos[m]; const float invf = exp2f(-(float)i * (13.287712379549449f / 32.f));
          float sn, cs; fast_sincos(p * invf, sn, cs);
          const float x1 = bf1(row[3480 + i]), x2 = bf1(row[3480 + 32 + i]);
          if (F.lane < 32) krot[(size_t)m * 64 + i] = (bf16)f2bf(x1 * cs - x2 * sn); else krot[(size_t)m * 64 + 32 + i] = (bf16)f2bf(x1 * sn + x2 * cs); }
        { const int b = m >> 11, s = m & (NS - 1);
          const int q4 = F.lane >> 4, c = F.lane & 15, kv = q4 >> 1, g = q4 & 1;
          const v4u w = *(const v4u*)(row + 1024 + q4 * 128 + c * 8);
          *(v4u*)(cmpkv + ((size_t)((kv * 16 + b * 2 + g) * NS + s)) * 128 + c * 8) = w; }
    }
}
__device__ __forceinline__ void p_l1_thin_b(Frame& F) {
    bf16* qmla = (bf16*)(F.ws + WS_QMLA); const int* pos = (const int*)kin(1);
    for (int m = F.gw; m < NT; m += F.NGW) {
        const int i = F.lane & 31; const float p = (float)pos[m]; const float invf = exp2f(-(float)i * (13.287712379549449f / 32.f));
        float sn, cs; fast_sincos(p * invf, sn, cs);
#pragma unroll
        for (int hh = 0; hh < 4; ++hh) { const int h = hh * 2 + (F.lane >> 5); bf16* q = qmla + (size_t)m * 1536 + h * 192 + 128;
            const float x1 = bf1(q[i]), x2 = bf1(q[32 + i]); q[i] = (bf16)f2bf(x1 * cs - x2 * sn); q[32 + i] = (bf16)f2bf(x1 * sn + x2 * cs); }
    }
    const float* hid = (const float*)(F.ws + WS_HID); const float* w2 = kin(9); bf16* kvc = (bf16*)(F.ws + WS_KVCMP);
    for (int m = F.gw; m < 4096; m += F.NGW) {
        const int kv = m >> 11;
        float h0 = hid[(size_t)m * 256 + kv * 128 + F.lane], h1 = hid[(size_t)m * 256 + kv * 128 + 64 + F.lane];
        h0 = 0.5f * h0 * (1.f + tanhf(0.7978845608028654f * (h0 + 0.044715f * h0 * h0 * h0)));
        h1 = 0.5f * h1 * (1.f + tanhf(0.7978845608028654f * (h1 + 0.044715f * h1 * h1 * h1)));
        const float* w = w2 + (size_t)kv * 128 * 128; float o0 = 0.f, o1 = 0.f;
        for (int c = 0; c < 64; ++c) { const float a = __shfl(h0, c), bq = __shfl(h1, c);
            o0 += a * w[c * 128 + F.lane] + bq * w[(c + 64) * 128 + F.lane]; o1 += a * w[c * 128 + 64 + F.lane] + bq * w[(c + 64) * 128 + 64 + F.lane]; }
        kvc[(size_t)m * 128 + F.lane] = (bf16)f2bf(o0); kvc[(size_t)m * 128 + 64 + F.lane] = (bf16)f2bf(o1);
    }
}
__device__ __forceinline__ void p_nsa_cmp_mfma(Frame& F) {
    typedef short v4i16_t __attribute__((ext_vector_type(4)));
    const bf16* proj = (const bf16*)(F.ws + WS_PROJ); const bf16* kvc = (const bf16*)(F.ws + WS_KVCMP); float* ocmp = (float*)(F.ws + WS_OCMP); unsigned* selm = (unsigned*)(F.ws + WS_SELM);
    constexpr int P = 272;
    LAS unsigned char* KT = F.lds; LAS unsigned char* VT = F.lds + 128 * P; LAS float* PS = (LAS float*)(F.lds + 2 * 128 * P);
    const int w = F.wave, lane = F.lane, i16 = lane & 15, g = lane >> 4, q4 = (lane & 15) >> 2, p4 = lane & 3;
    const float sscale = 0.08838834764831845f * 1.4426950408889634f;
    for (int bu = blockIdx.x; bu < 256; bu += F.G) {
        const int bg = bu >> 4, qg = bu & 15, b = bg >> 1, gq = bg & 1;
        __syncthreads();
#pragma unroll
        for (int c = 0; c < 4; ++c) { const int idx = F.tid + 512 * c, row = idx >> 4, c8 = idx & 15;
            v4u kk = (v4u){0u, 0u, 0u, 0u}, vv = (v4u){0u, 0u, 0u, 0u};
            if (row < 127) { kk = *(const v4u*)(kvc + ((size_t)(0 * 16 + bg) * 128 + row) * 128 + c8 * 8); vv = *(const v4u*)(kvc + ((size_t)(1 * 16 + bg) * 128 + row) * 128 + c8 * 8); }
            *(LAS v4u*)(KT + row * P + c8 * 16) = kk; *(LAS v4u*)(VT + row * P + c8 * 16) = vv; }
        for (int k = 0; k < 4; ++k) {
            const int q0 = (qg * 4 + k) * 32, h = gq * 4 + (w >> 1), ql = (w & 1) * 16 + i16, spos = q0 + ql;
            bf16x8 qf[4];
#pragma unroll
            for (int ks = 0; ks < 4; ++ks) qf[ks] = *(const bf16x8*)(proj + (size_t)(b * NS + spos) * CD_INP + h * 128 + 32 * ks + 8 * g);
            __syncthreads();
            const int nvalid = spos >= 31 ? ((spos - 31) >> 4) + 1 : 0;
            f32x4 sc[8]; float mx = -1e30f;
#pragma unroll
            for (int mt = 0; mt < 8; ++mt) { sc[mt] = (f32x4){0.f, 0.f, 0.f, 0.f};
#pragma unroll
                for (int ks = 0; ks < 4; ++ks) { const bf16x8 kf = *(const LAS bf16x8*)(KT + (16 * mt + i16) * P + (32 * ks + 8 * g) * 2); sc[mt] = __builtin_amdgcn_mfma_f32_16x16x32_bf16(kf, qf[ks], sc[mt], 0, 0, 0); }
#pragma unroll
                for (int r = 0; r < 4; ++r) { const bool ok = (16 * mt + 4 * g + r) < nvalid; const float x = ok ? sc[mt][r] * sscale : -1e30f; sc[mt][r] = x; mx = fmaxf(mx, x); } }
            mx = fmaxf(mx, __shfl_xor(mx, 16)); mx = fmaxf(mx, __shfl_xor(mx, 32));
            float ps = 0.f;
#pragma unroll
            for (int mt = 0; mt < 8; ++mt)
#pragma unroll
                for (int r = 0; r < 4; ++r) { const bool ok = (16 * mt + 4 * g + r) < nvalid; const float pv = ok ? __builtin_amdgcn_exp2f(sc[mt][r] - mx) : 0.f; sc[mt][r] = pv; ps += pv; }
            ps += __shfl_xor(ps, 16); ps += __shfl_xor(ps, 32);
            const float inv = ps > 0.f ? 1.f / ps : 0.f;
#pragma unroll
            for (int mt = 0; mt < 8; ++mt)
#pragma unroll
                for (int r = 0; r < 4; ++r) sc[mt][r] *= inv;
            { LAS float* slab = PS + (w >> 2) * 4096 + ql * 128 + 4 * g;
              if (((w >> 1) & 1) == 0) {
#pragma unroll
                  for (int mt = 0; mt < 8; ++mt) *(LAS f32x4*)(slab + 16 * mt) = sc[mt]; }
              __syncthreads();
              if (((w >> 1) & 1) == 1) {
#pragma unroll
                  for (int mt = 0; mt < 8; ++mt) { const f32x4 t = *(const LAS f32x4*)(slab + 16 * mt); *(LAS f32x4*)(slab + 16 * mt) = t + sc[mt]; } } }
            f32x4 O[8];
#pragma unroll
            for (int nt = 0; nt < 8; ++nt) O[nt] = (f32x4){0.f, 0.f, 0.f, 0.f};
#pragma unroll
            for (int k2 = 0; k2 < 4; ++k2) { v4u wv; wv.x = pk2(sc[2 * k2][0], sc[2 * k2][1]); wv.y = pk2(sc[2 * k2][2], sc[2 * k2][3]); wv.z = pk2(sc[2 * k2 + 1][0], sc[2 * k2 + 1][1]); wv.w = pk2(sc[2 * k2 + 1][2], sc[2 * k2 + 1][3]);
                const bf16x8 pf = __builtin_bit_cast(bf16x8, wv);
#pragma unroll
                for (int nt = 0; nt < 8; ++nt) {
                    const v4i16_t a = __builtin_amdgcn_ds_read_tr16_b64_v4i16((LAS v4i16_t*)(VT + (32 * k2 + 4 * g + q4) * P + (16 * nt + 4 * p4) * 2));
                    const v4i16_t c = __builtin_amdgcn_ds_read_tr16_b64_v4i16((LAS v4i16_t*)(VT + (32 * k2 + 16 + 4 * g + q4) * P + (16 * nt + 4 * p4) * 2));
                    const bf16x8 vf = (bf16x8){a[0], a[1], a[2], a[3], c[0], c[1], c[2], c[3]};
                    O[nt] = __builtin_amdgcn_mfma_f32_16x16x32_bf16(pf, vf, O[nt], 0, 0, 0); } }
#pragma unroll
            for (int r = 0; r < 4; ++r) { const size_t m = (size_t)(b * NS + q0 + (w & 1) * 16 + 4 * g + r); const float gt = sigmoidf_(bf1(proj[m * CD_INP + 2560 + h * 3 + 0]));
#pragma unroll
                for (int nt = 0; nt < 8; ++nt) ocmp[m * 1024 + h * 128 + 16 * nt + i16] = gt * O[nt][r]; }
            __syncthreads();
#pragma unroll
            for (int qq = 0; qq < 4; ++qq) { const int qi = 4 * w + qq, s = q0 + qi, cur = s >> 6, j = lane & 31;
                float imp = 0.f;
#pragma unroll
                for (int kk = 0; kk < 4; ++kk) { const int n1 = 4 * j + kk; if (n1 <= 126) imp += PS[qi * 128 + n1] + PS[4096 + qi * 128 + n1]; const int n2 = 4 * j - 1 + kk; if (n2 >= 0 && n2 <= 126) imp += PS[qi * 128 + n2] + PS[4096 + qi * 128 + n2]; }
                const bool forced = (j == 0) || (j == cur) || (j == cur - 1);
                const float score = forced ? 1e4f : ((j * 64 <= s) ? imp : -1e30f);
                int rk = 0;
                for (int jj = 0; jj < 32; ++jj) { const float ov = __shfl(score, jj); rk += ((ov > score) || (ov == score && jj < j)) ? 1 : 0; }
                const bool sel = (lane < 32) && (rk < 16) && (j <= cur);
                const unsigned long long bal = __ballot(sel);
                if (lane == 0) selm[(size_t)(b * NS + s) * 2 + gq] = (unsigned)bal; }
        }
    }
}

namespace fa {
typedef short v4i16_t __attribute__((ext_vector_type(4)));
struct Src { const bf16* k1; size_t ks1; const bf16* k2; size_t ks2; const bf16* v; size_t vs; };
template <int DQK> struct Cfg { static constexpr int KPITCH = (DQK + 8) * 2, KBYTES = 64 * KPITCH, VPITCH = 272, VBYTES = 64 * VPITCH, BUF = KBYTES + VBYTES, NKS = DQK / 32, KCH = DQK / 8, NKR = DQK / 64; };

template <int DQK>
__device__ __forceinline__ void load_tile(const Src& S, int k0, int tid, v4u (&kr)[Cfg<DQK>::NKR], v4u (&vr)[2]) {
    constexpr int KCH = Cfg<DQK>::KCH;
#pragma unroll
    for (int i = 0; i < Cfg<DQK>::NKR; ++i) { const int c = tid + 512 * i, row = c / KCH, c8 = c % KCH;
        const bf16* src = (DQK == 192 && c8 >= 16) ? S.k2 + (size_t)(k0 + row) * S.ks2 + (c8 - 16) * 8 : S.k1 + (size_t)(k0 + row) * S.ks1 + c8 * 8;
        kr[i] = *(const v4u*)src; }
#pragma unroll
    for (int i = 0; i < 2; ++i) { const int c = tid + 512 * i, row = c >> 4, c8 = c & 15; vr[i] = *(const v4u*)(S.v + (size_t)(k0 + row) * S.vs + c8 * 8); }
}
template <int DQK>
__device__ __forceinline__ void store_tile(LAS unsigned char* buf, int tid, const v4u (&kr)[Cfg<DQK>::NKR], const v4u (&vr)[2]) {
    constexpr int KCH = Cfg<DQK>::KCH;
#pragma unroll
    for (int i = 0; i < Cfg<DQK>::NKR; ++i) { const int c = tid + 512 * i, row = c / KCH, c8 = c % KCH; *(LAS v4u*)(buf + row * Cfg<DQK>::KPITCH + c8 * 16) = kr[i]; }
#pragma unroll
    for (int i = 0; i < 2; ++i) { const int c = tid + 512 * i, row = c >> 4, c8 = c & 15; *(LAS v4u*)(buf + Cfg<DQK>::KBYTES + row * Cfg<DQK>::VPITCH + c8 * 16) = vr[i]; }
}
template <int DQK, int MODE>
__device__ __forceinline__ void fa_pass(LAS unsigned char* lds, const Src& S, const bf16x8 (&qf)[Cfg<DQK>::NKS], unsigned tmask, int spos, unsigned rowmask, float sscale,
                                        f32x4 (&O)[8], float& m_run, float& l_run, int tid, int lane) {
    typedef Cfg<DQK> C;
    const int i16 = lane & 15, g = lane >> 4, q4 = (lane & 15) >> 2, p4 = lane & 3;
#pragma unroll
    for (int nt = 0; nt < 8; ++nt) O[nt] = (f32x4){0.f, 0.f, 0.f, 0.f};
    m_run = -1e30f; l_run = 0.f;
    unsigned rem = tmask;
    if (rem == 0u) return;
    v4u kr[C::NKR], vr[2];
    int t = __builtin_ctz(rem); rem &= rem - 1u;
    load_tile<DQK>(S, t * 64, tid, kr, vr);
    __syncthreads();
    store_tile<DQK>(lds, tid, kr, vr);
    __syncthreads();
    int cur = 0;
    for (;;) {
        const bool has_next = rem != 0u; int tn = 0;
        if (has_next) { tn = __builtin_ctz(rem); rem &= rem - 1u; load_tile<DQK>(S, tn * 64, tid, kr, vr); }
        LAS unsigned char* kb = lds + cur * C::BUF; LAS unsigned char* vb = kb + C::KBYTES;
        bool row_any = (t * 64 <= spos);
        if (MODE == 1) row_any = row_any && ((rowmask >> t) & 1u);
        if (MODE == 2) row_any = row_any && (t * 64 + 63 + 512 > spos);
        if (__ballot(row_any) != 0ull) {
        f32x4 sc[4];
#pragma unroll
        for (int mt = 0; mt < 4; ++mt) { sc[mt] = (f32x4){0.f, 0.f, 0.f, 0.f};
#pragma unroll
            for (int ks = 0; ks < C::NKS; ++ks) { const bf16x8 kf = *(const LAS bf16x8*)(kb + (16 * mt + i16) * C::KPITCH + (32 * ks + 8 * g) * 2);
                sc[mt] = __builtin_amdgcn_mfma_f32_16x16x32_bf16(kf, qf[ks], sc[mt], 0, 0, 0); } }
        float mx = -1e30f; bool vl[4][4];
#pragma unroll
        for (int mt = 0; mt < 4; ++mt)
#pragma unroll
            for (int r = 0; r < 4; ++r) { const int kp = t * 64 + 16 * mt + 4 * g + r; bool ok = kp <= spos;
                if (MODE == 1) ok = ok && ((rowmask >> t) & 1u);
                if (MODE == 2) ok = ok && (kp + 512 > spos);
                vl[mt][r] = ok; const float x = ok ? sc[mt][r] * sscale : -1e30f; sc[mt][r] = x; mx = fmaxf(mx, x); }
        mx = fmaxf(mx, __shfl_xor(mx, 16)); mx = fmaxf(mx, __shfl_xor(mx, 32));
        if (__ballot(mx > m_run + 8.0f) != 0ull) {
            const float m_new = fmaxf(m_run, mx), alpha = __builtin_amdgcn_exp2f(m_run - m_new); m_run = m_new;
            l_run *= alpha;
            float ar[4];
#pragma unroll
            for (int r = 0; r < 4; ++r) ar[r] = __shfl(alpha, 4 * g + r);
#pragma unroll
            for (int nt = 0; nt < 8; ++nt)
#pragma unroll
                for (int r = 0; r < 4; ++r) O[nt][r] *= ar[r];
        }
        float ps = 0.f;
#pragma unroll
        for (int mt = 0; mt < 4; ++mt)
#pragma unroll
            for (int r = 0; r < 4; ++r) { const float pv = vl[mt][r] ? __builtin_amdgcn_exp2f(sc[mt][r] - m_run) : 0.f; sc[mt][r] = pv; ps += pv; }
        l_run += ps;
        bf16x8 pf[2];
#pragma unroll
        for (int k2 = 0; k2 < 2; ++k2) { v4u w; w.x = pk2(sc[2 * k2][0], sc[2 * k2][1]); w.y = pk2(sc[2 * k2][2], sc[2 * k2][3]); w.z = pk2(sc[2 * k2 + 1][0], sc[2 * k2 + 1][1]); w.w = pk2(sc[2 * k2 + 1][2], sc[2 * k2 + 1][3]);
            pf[k2] = __builtin_bit_cast(bf16x8, w); }
#pragma unroll
        for (int nt = 0; nt < 8; ++nt)
#pragma unroll
            for (int k2 = 0; k2 < 2; ++k2) {
                const v4i16_t a = __builtin_amdgcn_ds_read_tr16_b64_v4i16((LAS v4i16_t*)(vb + (32 * k2 + 4 * g + q4) * C::VPITCH + (16 * nt + 4 * p4) * 2));
                const v4i16_t b = __builtin_amdgcn_ds_read_tr16_b64_v4i16((LAS v4i16_t*)(vb + (32 * k2 + 16 + 4 * g + q4) * C::VPITCH + (16 * nt + 4 * p4) * 2));
                const bf16x8 vf = (bf16x8){a[0], a[1], a[2], a[3], b[0], b[1], b[2], b[3]};
                O[nt] = __builtin_amdgcn_mfma_f32_16x16x32_bf16(pf[k2], vf, O[nt], 0, 0, 0); }
        }
        if (has_next) store_tile<DQK>(lds + (cur ^ 1) * C::BUF, tid, kr, vr);
        __syncthreads();
        if (!has_next) break;
        t = tn; cur ^= 1;
    }
}
__device__ __forceinline__ void row_inv(float l_run, int lane, float (&inv)[4]) {
    float l = l_run; l += __shfl_xor(l, 16); l += __shfl_xor(l, 32);
    const float li = l > 0.f ? 1.f / l : 0.f; const int g = lane >> 4;
#pragma unroll
    for (int r = 0; r < 4; ++r) inv[r] = __shfl(li, 4 * g + r);
}
}

constexpr int FA_NUNITS = 2048;
__device__ __forceinline__ void p_attn_mfma(Frame& F, unsigned* queue) {
    const bf16* proj = (const bf16*)(F.ws + WS_PROJ); bf16* mixin = (bf16*)(F.ws + WS_MIXIN); const float* ocmp = (const float*)(F.ws + WS_OCMP); const unsigned* selm = (const unsigned*)(F.ws + WS_SELM);
    const bf16* qmla = (const bf16*)(F.ws + WS_QMLA); const bf16* kvu = (const bf16*)(F.ws + WS_KVU); const bf16* krot = (const bf16*)(F.ws + WS_KROT);
    volatile LAS unsigned* qslot = (volatile LAS unsigned*)(F.lds + LDSCTL_OFF);
    const int lane = F.lane, w = F.wave, i16 = lane & 15, g4 = lane >> 4;
    for (;;) {
        __syncthreads();
        if (F.tid == 0) qslot[0] = atomicAdd(queue, 1u);
        __syncthreads();
        const int u = __builtin_amdgcn_readfirstlane((int)qslot[0]);
        if (u >= FA_NUNITS) break;
        if (u < 1024) {
            const int qt = 15 - (u >> 6), bh = u & 63, b = bh >> 3, h = bh & 7, q0 = qt * 128, spos = q0 + 16 * w + i16;
            bf16x8 qf[6];
#pragma unroll
            for (int ks = 0; ks < 6; ++ks) qf[ks] = *(const bf16x8*)(qmla + (size_t)(b * NS + spos) * 1536 + h * 192 + 32 * ks + 8 * g4);
            fa::Src S; S.k1 = kvu + (size_t)(b * NS) * 2048 + h * 256; S.ks1 = 2048; S.k2 = krot + (size_t)(b * NS) * 64; S.ks2 = 64; S.v = S.k1 + 128; S.vs = 2048;
            const int last = (q0 + 127) >> 6; const unsigned tmask = last >= 31 ? 0xffffffffu : ((1u << (last + 1)) - 1u);
            f32x4 O[8]; float m_run, l_run;
            fa::fa_pass<192, 0>(F.lds, S, qf, tmask, spos, 0u, 0.07216878364870322f * 1.4426950408889634f, O, m_run, l_run, F.tid, lane);
            float inv[4]; fa::row_inv(l_run, lane, inv);
#pragma unroll
            for (int r = 0; r < 4; ++r) { bf16* orow = mixin + (size_t)(b * NS + q0 + 16 * w + 4 * g4 + r) * ND + 1024 + h * 128 + i16;
#pragma unroll
                for (int nt = 0; nt < 8; ++nt) orow[16 * nt] = (bf16)f2bf(O[nt][r] * inv[r]); }
        } else {
            const int v = u - 1024, qt = 63 - (v >> 4), bg = v & 15, b = bg >> 1, gq = bg & 1, q0 = qt * 32;
            const int h = gq * 4 + (w >> 1), spos = q0 + (w & 1) * 16 + i16;
            bf16x8 qf[4];
#pragma unroll
            for (int ks = 0; ks < 4; ++ks) qf[ks] = *(const bf16x8*)(proj + (size_t)(b * NS + spos) * CD_INP + h * 128 + 32 * ks + 8 * g4);
            const unsigned rowmask = selm[(size_t)(b * NS + spos) * 2 + gq];
            unsigned um = selm[(size_t)(b * NS + q0 + (lane & 31)) * 2 + gq];
#pragma unroll
            for (int o = 1; o < 32; o <<= 1) um |= (unsigned)__shfl_xor((int)um, o);
            um = (unsigned)__builtin_amdgcn_readfirstlane((int)um);
            const bf16* base = proj + (size_t)(b * NS) * CD_INP;
            const float sscale = 0.08838834764831845f * 1.4426950408889634f;
            f32x4 O[8], Ot[8]; float m_run, l_run, inv[4];
            { fa::Src S; S.k1 = base + 1024 + ((1 * 2 + 0) * 2 + gq) * 128; S.ks1 = CD_INP; S.k2 = nullptr; S.ks2 = 0; S.v = base + 1024 + ((1 * 2 + 1) * 2 + gq) * 128; S.vs = CD_INP;
              fa::fa_pass<128, 1>(F.lds, S, qf, um, spos, rowmask, sscale, O, m_run, l_run, F.tid, lane); }
            fa::row_inv(l_run, lane, inv);
#pragma unroll
            for (int r = 0; r < 4; ++r) { const int sq = q0 + (w & 1) * 16 + 4 * g4 + r; const float g1 = sigmoidf_(bf1(proj[(size_t)(b * NS + sq) * CD_INP + 2560 + h * 3 + 1])) * inv[r];
#pragma unroll
                for (int nt = 0; nt < 8; ++nt) Ot[nt][r] = O[nt][r] * g1; }
            { fa::Src S; S.k1 = base + 1024 + ((2 * 2 + 0) * 2 + gq) * 128; S.ks1 = CD_INP; S.k2 = nullptr; S.ks2 = 0; S.v = base + 1024 + ((2 * 2 + 1) * 2 + gq) * 128; S.vs = CD_INP;
              const int klo = q0 - 511 > 0 ? q0 - 511 : 0, tlo = klo >> 6, thi = (q0 + 31) >> 6;
              const unsigned hm = thi >= 31 ? 0xffffffffu : ((1u << (thi + 1)) - 1u); const unsigned tmask = hm & ~((1u << tlo) - 1u);
              fa::fa_pass<128, 2>(F.lds, S, qf, tmask, spos, 0u, sscale, O, m_run, l_run, F.tid, lane); }
            fa::row_inv(l_run, lane, inv);
#pragma unroll
            for (int r = 0; r < 4; ++r) { const int sq = q0 + (w & 1) * 16 + 4 * g4 + r; const size_t m = (size_t)(b * NS + sq);
                const float g2 = sigmoidf_(bf1(proj[m * CD_INP + 2560 + h * 3 + 2])) * inv[r];
#pragma unroll
                for (int nt = 0; nt < 8; ++nt) { const float oc = ocmp[m * 1024 + h * 128 + 16 * nt + i16]; mixin[m * ND + h * 128 + 16 * nt + i16] = (bf16)f2bf(oc + Ot[nt][r] + O[nt][r] * g2); } }
        }
    }
}

constexpr int NPHASE = 33;


#define IN(k) (lo <= (k) && (k) < hi)
#define SEAM(k) do { if (IN(k) && IN((k) + 1)) { if (MK_ONE_LAUNCH) xcd_barrier(bar); else if (F.tid == 0) __hip_atomic_store(F.ctl + CW_TMO, 0xBAD0u | (unsigned)(k), __ATOMIC_RELAXED, __HIP_MEMORY_SCOPE_AGENT); \
    if (MK_PROBE_PHASE >= 0 && blockIdx.x == 0 && F.tid == 0) { if ((k) == MK_PROBE_PHASE - 1) ((volatile LAS unsigned long long*)(F.lds + LDSCTL_OFF + 64))[0] = __builtin_amdgcn_s_memrealtime(); \
        if ((k) == MK_PROBE_LAST) ((volatile LAS unsigned long long*)(F.lds + LDSCTL_OFF + 64))[1] = __builtin_amdgcn_s_memrealtime(); } } } while (0)
template <int l>
__device__ __forceinline__ void layer_body(Frame& F, const XcdBarrier& bar, const int lo, const int hi) {
    unsigned char* ws = F.ws;
    bf16* const XB0 = (bf16*)(ws + WS_XB0); bf16* const X1B = (bf16*)(ws + WS_X1B); bf16* const X2B = (bf16*)(ws + WS_X2B);
    bf16* const PROJ = (bf16*)(ws + WS_PROJ); bf16* const MIXIN = (bf16*)(ws + WS_MIXIN); bf16* const MIXO = (bf16*)(ws + WS_MIXO);
    bf16* const HB = (bf16*)(ws + WS_H); bf16* const Y2 = (bf16*)(ws + WS_Y2);
        const int pb = 1 + l * 16;
        const bf16* xin = l == 0 ? XB0 : X2B;
        if (IN(pb + 0)) {
            if (l == 0) { pg8::DenseProb P; P.init(xin, ND, (const bf16*)(ws + WS_WABIN), NT, AB_IN, ND, F.G, (int)blockIdx.x); pg8::EpiBf16 E{PROJ, AB_IN};
                pg8::gemm_phase<pg8::EpiBf16, pg8::DenseProb, true>(F.lds, P, E); }
            else { pg8::DenseProb P; P.init(xin, ND, (const bf16*)(ws + WS_WCDIN), NT, CD_INP, ND, F.G, (int)blockIdx.x); pg8::EpiBf16 E{PROJ, CD_INP};
                pg8::gemm_phase<pg8::EpiBf16, pg8::DenseProb, true>(F.lds, P, E); }
        } SEAM(pb + 0);
        if (l == 0) {
            if (IN(pb + 1)) { p_pool_rope(F); } SEAM(pb + 1);
            if (IN(pb + 2)) { if (blockIdx.x < NB * 6) p_retention_mfma(F, (int)blockIdx.x); __syncthreads(); p_moe_weights_queue(F, F.ctl + CW_CNT + 320); } SEAM(pb + 2);
            SEAM(pb + 3); SEAM(pb + 4); SEAM(pb + 5);
        } else {
            if (IN(pb + 1)) { p_l1_thin_a(F); } SEAM(pb + 1);
            if (IN(pb + 2)) {
                { pg8::CmpProb P; P.K = 4096; P.Abase = (const char*)(ws + WS_CMPKV); P.Bt = (const char*)(ws + WS_CW1); P.G = F.G; P.c = (int)blockIdx.x;
                  pg8::EpiF32 E{(float*)(ws + WS_HID), 256, (const float*)(ws + WS_CMPB)};
                  pg8::gemm_phase<pg8::EpiF32, pg8::CmpProb, true>(F.lds, P, E); }
                { pg8::DenseProb P; P.init((const bf16*)(ws + WS_CQN), 384, (const bf16*)(ws + WS_WUQ), NT, 1536, 384, F.G, (int)blockIdx.x); pg8::EpiBf16 E{(bf16*)(ws + WS_QMLA), 1536};
                  pg8::gemm_phase<pg8::EpiBf16, pg8::DenseProb, true>(F.lds, P, E); }
                { pg8::DenseProb P; P.init((const bf16*)(ws + WS_CKVN), 512, (const bf16*)(ws + WS_WUKV), NT, 2048, 512, F.G, (int)blockIdx.x); pg8::EpiBf16 E{(bf16*)(ws + WS_KVU), 2048};
                  pg8::gemm_phase<pg8::EpiBf16, pg8::DenseProb, true>(F.lds, P, E); }
            } SEAM(pb + 2);
            if (IN(pb + 3)) { p_l1_thin_b(F); } SEAM(pb + 3);
            if (IN(pb + 4)) { p_nsa_cmp_mfma(F); } SEAM(pb + 4);
            if (IN(pb + 5)) { p_attn_mfma(F, F.ctl + CW_CNT + 256); } SEAM(pb + 5);
        }
        if (IN(pb + 6)) { pg8::DenseProb P; P.init(MIXIN, ND, (const bf16*)(ws + (l == 0 ? WS_WABOUT : WS_WCDOUT)), NT, ND, ND, F.G, (int)blockIdx.x); pg8::EpiBf16 E{MIXO, ND};
            pg8::gemm_phase<pg8::EpiBf16, pg8::DenseProb, true>(F.lds, P, E); } SEAM(pb + 6);
        if (IN(pb + 7)) { p_ln1(F, xin, MIXO, kin(15) + l * ND, kin(16) + l * ND, X1B); } SEAM(pb + 7);
        if (IN(pb + 8)) { pg8::DenseProb P; P.init(X1B, ND, (const bf16*)(ws + WS_RT + (size_t)l * MiB), NT, 256, ND, F.G, (int)blockIdx.x); pg8::EpiF32 E{(float*)(ws + WS_LOGITS), 256, nullptr};
            pg8::gemm_phase<pg8::EpiF32, pg8::DenseProb, true>(F.lds, P, E); } SEAM(pb + 8);
        if (IN(pb + 9)) { p_route(F, l); } SEAM(pb + 9);
        if (IN(pb + 10)) { p_scatter(F, l); } SEAM(pb + 10);
        if (IN(pb + 11)) { load_offsets(F, l); const LAS int* tab = (const LAS int*)(F.lds + TAB_OFF);
            pg8::MoeUpProb P; P.K = ND; P.Abase = (const char*)X1B; P.W13 = (const char*)(ws + WS_W13 + (size_t)l * WS_MOE_LSTRIDE); P.sorted = (const int*)(ws + WS_SORTED); P.tile_e = tab + 160; P.ntiles = __builtin_amdgcn_readfirstlane(tab[65]);
            P.nunits = (P.ntiles + NT / 256) * 4; P.G = F.G; P.c = (int)blockIdx.x;
            pg8::EpiSwiglu E{HB};
            pg8::gemm_phase<pg8::EpiSwiglu, pg8::MoeUpProb, true>(F.lds, P, E); } SEAM(pb + 11);
        if (IN(pb + 12)) { load_offsets(F, l); const LAS int* tab = (const LAS int*)(F.lds + TAB_OFF);
            pg8::MoeDownProb P; P.K = EFF; P.Abase = (const char*)HB; P.W2 = (const char*)(ws + WS_W2 + (size_t)l * WS_MOE_LSTRIDE); P.tile_e = tab + 160; P.ntiles = __builtin_amdgcn_readfirstlane(tab[65]);
            P.nunits = (P.ntiles + NT / 256) * 8; P.G = F.G; P.c = (int)blockIdx.x;
            pg8::EpiBf16 E{Y2, ND};
            pg8::gemm_phase<pg8::EpiBf16, pg8::MoeDownProb, true>(F.lds, P, E); } SEAM(pb + 12);
        if (IN(pb + 13)) { p_combine_ln2(F, X1B, Y2, (const int*)(ws + WS_SLOT), (const float*)(ws + WS_WSEL), kin(17) + l * ND, kin(18) + l * ND, l == 0 ? X2B : nullptr, l == 0 ? nullptr : F.out); } SEAM(pb + 13);
        SEAM(pb + 14); SEAM(pb + 15);
    }
__global__ void __launch_bounds__(NWAVES * 64, 2) mk_fwd(Args args) {
    extern __shared__ __attribute__((aligned(16))) unsigned char lds[];
    Frame F;
    F.lds = (LAS unsigned char*)lds;
    F.MISC = (volatile LAS unsigned*)(F.lds + MISC_OFF);
    F.tid = threadIdx.x; F.lane = F.tid & 63; F.wave = __builtin_amdgcn_readfirstlane(F.tid >> 6);
    F.G = gridDim.x; { const int bx = blockIdx.x; F.vcu = (F.G % 8 == 0) ? (bx % 8) * (F.G / 8) + bx / 8 : bx; }
    F.gw = F.vcu * NWAVES + F.wave; F.NGW = F.G * NWAVES;
    F.ws = args.ws; F.ctl = (unsigned*)(args.ws + WS_CTL); F.out = args.out;
    for (int u = F.tid; u < (LDS_BYTES - LDSCTL_OFF) / 4; u += NWAVES * 64) ((LAS unsigned*)(F.lds + LDSCTL_OFF))[u] = 0u;
    __syncthreads();
    XcdBarrier bar; bar.bar = F.ctl + CW_BAR; bar.x = 0; bar.st = nullptr;
    if (MK_ONE_LAUNCH) bar = xcd_barrier_post(F.ctl + CW_BAR, F.MISC + 8);
    const int lo = args.ph_lo, hi = args.ph_hi;
    if (MK_PROBE_PHASE == 0 && blockIdx.x == 0 && F.tid == 0) ((volatile LAS unsigned long long*)(F.lds + LDSCTL_OFF + 64))[0] = __builtin_amdgcn_s_memrealtime();
    unsigned char* ws = args.ws;
    bf16* const XB0 = (bf16*)(ws + WS_XB0); bf16* const X1B = (bf16*)(ws + WS_X1B); bf16* const X2B = (bf16*)(ws + WS_X2B);
    bf16* const PROJ = (bf16*)(ws + WS_PROJ); bf16* const MIXIN = (bf16*)(ws + WS_MIXIN); bf16* const MIXO = (bf16*)(ws + WS_MIXO);
    bf16* const HB = (bf16*)(ws + WS_H); bf16* const Y2 = (bf16*)(ws + WS_Y2);

    if (IN(0)) { p_prologue(F); } SEAM(0);

    layer_body<0>(F, bar, lo, hi);
    layer_body<1>(F, bar, lo, hi);
    if (MK_PROBE_PHASE >= 0 && blockIdx.x == 0 && F.tid == 0) {
        volatile LAS unsigned long long* tsl = (volatile LAS unsigned long long*)(F.lds + LDSCTL_OFF + 64);
        if (MK_PROBE_LAST == 30) tsl[1] = __builtin_amdgcn_s_memrealtime();
        const unsigned long long span = (tsl[1] - tsl[0]) * MK_PROBE_AMP, t0 = __builtin_amdgcn_s_memrealtime();
        while (__builtin_amdgcn_s_memrealtime() - t0 < span) __builtin_amdgcn_s_sleep(8);
    }
#undef IN
#undef SEAM
}

extern "C" void kernel_launch(void* const* d_in, const int* in_sizes, int n_in, void* d_out, int out_size, void* d_ws, size_t ws_size, hipStream_t stream) {
    static int grid = 0;
    if (grid == 0) {
        if (n_in != 27 || in_sizes[0] != NT * ND || out_size != NT * ND || ws_size < WS_END) { fprintf(stderr, "kernel_launch: unexpected problem (n_in %d, in0 %d, out %d, ws %zu < %zu); nothing launched\n", n_in, n_in > 0 ? in_sizes[0] : -1, out_size, ws_size, (size_t)WS_END); grid = -1; return; }
        int dev = 0, cus = 0, per_cu = 0;
        if (hipGetDevice(&dev) != hipSuccess || hipDeviceGetAttribute(&cus, hipDeviceAttributeMultiprocessorCount, dev) != hipSuccess) { fprintf(stderr, "kernel_launch: device query failed\n"); grid = -1; return; }
        if (hipFuncSetAttribute((const void*)mk_fwd, hipFuncAttributeMaxDynamicSharedMemorySize, LDS_BYTES) != hipSuccess) { fprintf(stderr, "kernel_launch: hipFuncSetAttribute failed\n"); grid = -1; return; }
        if (hipOccupancyMaxActiveBlocksPerMultiprocessor(&per_cu, (const void*)mk_fwd, NWAVES * 64, LDS_BYTES) != hipSuccess || per_cu < 1) fprintf(stderr, "kernel_launch: note: occupancy query reports %d\n", per_cu);
        (void)hipGetLastError();
        grid = cus;
    }
    if (grid < 0) return;
    if (hipMemsetAsync((char*)d_ws + WS_CTL, 0, CTL_ZERO_BYTES, stream) != hipSuccess) { fprintf(stderr, "kernel_launch: memset failed\n"); return; }
    Args a{};
    for (int i = 0; i < 27; ++i) a.in[i] = (const float*)d_in[i];
    a.out = (float*)d_out; a.ws = (unsigned char*)d_ws;
#if MK_ONE_LAUNCH
    a.ph_lo = 0; a.ph_hi = NPHASE;
    hipLaunchKernelGGL(mk_fwd, dim3(grid), dim3(NWAVES * 64), LDS_BYTES, stream, a);
#else
    for (int p = 0; p < NPHASE; ++p) {
        const int lp = (p - 1) & 15;
        if (p >= 1) { const int l = (p - 1) >> 4; if (lp >= 14) continue; if (l == 0 && lp >= 3 && lp <= 5) continue; }
        a.ph_lo = p; a.ph_hi = p + 1;
        hipLaunchKernelGGL(mk_fwd, dim3(grid), dim3(NWAVES * 64), LDS_BYTES, stream, a);
    }
#endif
    const hipError_t le = hipPeekAtLastError();
    if (le != hipSuccess) fprintf(stderr, "kernel_launch: launch failed: %s\n", hipGetErrorName(le));
}
```

```cpp
#include <hip/hip_runtime.h>
#include <cstdio>
#include <cstdint>

#ifndef MK_ONE_LAUNCH
#define MK_ONE_LAUNCH 1
#endif
#ifndef MK_PROBE_PHASE
#define MK_PROBE_PHASE -1
#endif
#ifndef MK_PROBE_LAST
#define MK_PROBE_LAST MK_PROBE_PHASE
#endif
#ifndef MK_PROBE_AMP
#define MK_PROBE_AMP 4
#endif

#define GAS __attribute__((address_space(1)))
#define LAS __attribute__((address_space(3)))
typedef unsigned short bf16;
typedef unsigned v4u __attribute__((ext_vector_type(4)));
typedef unsigned v2u __attribute__((ext_vector_type(2)));
typedef float f32x4 __attribute__((ext_vector_type(4)));
typedef float f32x2 __attribute__((ext_vector_type(2)));
typedef short bf16x8 __attribute__((ext_vector_type(8)));

constexpr int NB = 8, NS = 2048, ND = 2048, NT = NB * NS;
constexpr float DN_ALPHA = 1.41421356237309505f;
constexpr float LN_EPS = 1e-5f, NORM_EPS = 1e-6f;
constexpr int AB_IN = 5120, CD_IN = 3544, CD_INP = 3584;
constexpr int NEXP = 64, EFF = 512;
constexpr int MAXROWS = NT * 8 + NEXP * 256;
constexpr int MAXTILES = MAXROWS / 256;
constexpr int SH_ROW0 = MAXROWS;

constexpr size_t MiB = 1u << 20;
constexpr size_t WS_CTL = 0, CTL_ZERO_BYTES = 1 * MiB;
constexpr size_t WS_TOPE = 1 * MiB, WS_WSEL = WS_TOPE + 512 * 1024, WS_SLOT = 2 * MiB, WS_SORTED = WS_SLOT + 512 * 1024;
constexpr size_t WS_CMPB = 3 * MiB + 256 * 1024, WS_SELM = 3 * MiB + 512 * 1024;
constexpr size_t WS_KVCMP = 4 * MiB;
constexpr size_t WS_HID = 6 * MiB;
constexpr size_t WS_WABIN = 16 * MiB, WS_WABOUT = 36 * MiB, WS_WCDIN = 44 * MiB, WS_WCDOUT = 58 * MiB, WS_WUQ = 66 * MiB, WS_WUKV = 68 * MiB, WS_CW1 = 70 * MiB, WS_RT = 72 * MiB;
constexpr size_t WS_W13 = 74 * MiB, WS_W2 = 334 * MiB, WS_MOE_LSTRIDE = 390 * MiB;
constexpr size_t WS_XB0 = 854 * MiB, WS_X2B = 854 * MiB, WS_X1B = 918 * MiB;
constexpr size_t WS_H = 982 * MiB, WS_Y2 = 1142 * MiB, WS_END = 1782 * MiB;
constexpr size_t WS_PROJ = 982 * MiB, WS_MIXIN = 1142 * MiB, WS_MIXO = 1206 * MiB;
constexpr size_t WS_QR = 1270 * MiB, WS_KR = 1294 * MiB;
constexpr size_t WS_CQN = 1270 * MiB, WS_CKVN = 1282 * MiB, WS_KROT = 1298 * MiB, WS_QMLA = 1302 * MiB, WS_KVU = 1350 * MiB, WS_CMPKV = 1414 * MiB, WS_OCMP = 1434 * MiB;
constexpr size_t WS_LOGITS = 1142 * MiB;
constexpr int CW_TMO = 0, CW_CODE = 1, CW_BAR = 4096, CW_CNT = 16384;

constexpr int RING_BYTES = 131072, LDSCTL_OFF = RING_BYTES, MISC_OFF = LDSCTL_OFF + 320, TAB_OFF = LDSCTL_OFF + 512;
constexpr int LDS_BYTES = 147456;
constexpr int NWAVES = 8;

#define LDS_WAIT() asm volatile("s_waitcnt lgkmcnt(0)" ::: "memory")
#define VM_WAIT() asm volatile("s_waitcnt vmcnt(0)" ::: "memory")
typedef __bf16 hwbf16x2 __attribute__((ext_vector_type(2)));
__device__ __forceinline__ unsigned pk2(float lo, float hi) { const f32x2 v = {lo, hi}; const hwbf16x2 b = __builtin_convertvector(v, hwbf16x2); return __builtin_bit_cast(unsigned, b); }
__device__ __forceinline__ unsigned f2bf(float f) { return pk2(f, 0.f) & 0xffffu; }
__device__ __forceinline__ void fast_sincos(float ang, float& sn, float& cs) { const float r = __builtin_amdgcn_fractf(ang * 0.15915494309189535f); sn = __builtin_amdgcn_sinf(r); cs = __builtin_amdgcn_cosf(r); }
__device__ __forceinline__ float bflo(unsigned w) { return __builtin_bit_cast(float, w << 16); }
__device__ __forceinline__ float bfhi(unsigned w) { return __builtin_bit_cast(float, w & 0xffff0000u); }
__device__ __forceinline__ float bf1(bf16 v) { return __builtin_bit_cast(float, ((unsigned)v) << 16); }
__device__ __forceinline__ float wave_sum(float v) {
#pragma unroll
    for (int o = 1; o < 64; o <<= 1) v += __shfl_xor(v, o);
    return v;
}
__device__ __forceinline__ float wave_max(float v) {
#pragma unroll
    for (int o = 1; o < 64; o <<= 1) v = fmaxf(v, __shfl_xor(v, o));
    return v;
}
__device__ __forceinline__ float sigmoidf_(float x) { return 1.0f / (1.0f + __expf(-x)); }
__device__ __forceinline__ float siluf_(float x) { return x / (1.0f + __expf(-x)); }
__device__ __forceinline__ void unpack8(const v4u w, float (&f)[8]) {
    f[0] = bflo(w.x); f[1] = bfhi(w.x); f[2] = bflo(w.y); f[3] = bfhi(w.y); f[4] = bflo(w.z); f[5] = bfhi(w.z); f[6] = bflo(w.w); f[7] = bfhi(w.w);
}

#define XB_TMO      128
#define XB_XCNT(j)  (256  + 64 * (j))
#define XB_XSUB(j)  (1280 + 64 * (j))
#define XB_XGEN(j)  (2304 + 64 * (j))
#define XB_TOP      3328
#define XB_TOPGEN   3392
#define XCD_BAR_WORDS 3456
#define XB_SPIN_CAP (1u << 18)
__device__ __forceinline__ unsigned xb_ld(unsigned* p)              { return __hip_atomic_load(p, __ATOMIC_RELAXED, __HIP_MEMORY_SCOPE_AGENT); }
__device__ __forceinline__ unsigned xb_add(unsigned* p, unsigned v) { return __hip_atomic_fetch_add(p, v, __ATOMIC_RELAXED, __HIP_MEMORY_SCOPE_AGENT); }
__device__ __forceinline__ unsigned xb_xcc_id() { return (unsigned)__builtin_amdgcn_s_getreg((3 << 11) | 20) & 0xFu; }
#define XB_SPIN(cond, bar) do { unsigned _sp = 0; while (cond) { __builtin_amdgcn_s_sleep(1); \
    if ((++_sp & 255u) == 0u) { if (xb_ld(&(bar)[XB_TMO])) break; if (_sp > XB_SPIN_CAP) { atomicAdd(&(bar)[XB_TMO], 1u); break; } } } } while (0)
struct XcdBarrier { unsigned* bar; unsigned x; volatile LAS unsigned* st; };
__device__ __forceinline__ XcdBarrier xcd_barrier_post(unsigned* bar, volatile LAS unsigned* st) {
    XcdBarrier b; b.bar = bar; b.x = xb_xcc_id(); b.st = st;
    if (threadIdx.x == 0) (void)xb_add(&bar[XB_XCNT(b.x)], 1u);
    return b;
}
__device__ __forceinline__ void xcd_barrier_complete(unsigned* bar, unsigned x, unsigned& nloc, unsigned& nx) {
    const unsigned G = gridDim.x * gridDim.y * gridDim.z;
    unsigned sum, cnt, mine, sp = 0u;
    for (;;) {
        sum = 0u; cnt = 0u; mine = 0u;
#pragma unroll
        for (unsigned j = 0; j < 16; ++j) { const unsigned c = xb_ld(&bar[XB_XCNT(j)]); sum += c; cnt += (c > 0u) ? 1u : 0u; mine = (j == x) ? c : mine; }
        if (sum == G) break;
        __builtin_amdgcn_s_sleep(1);
        if ((++sp & 255u) == 0u) { if (xb_ld(&bar[XB_TMO])) break; if (sp > XB_SPIN_CAP) { atomicAdd(&bar[XB_TMO], 1u); break; } }
    }
    nloc = mine > 0u ? mine : 1u; nx = cnt > 0u ? cnt : 1u;
}
__device__ __forceinline__ void xcd_barrier(const XcdBarrier& b) {
    asm volatile("s_waitcnt vmcnt(0)" ::: "memory");
    __syncthreads();
    if (threadIdx.x == 0) {
        unsigned* bar = b.bar;
        __builtin_amdgcn_s_waitcnt(0);
        unsigned nloc = b.st[0], nx = b.st[1];
        if (nloc == 0u) { xcd_barrier_complete(bar, b.x, nloc, nx); b.st[0] = nloc; b.st[1] = nx; }
        const unsigned old = xb_add(&bar[XB_XSUB(b.x)], 1u);
        const unsigned gen = old / nloc;
        if (old + 1u == (gen + 1u) * nloc) {
            __builtin_amdgcn_fence(__ATOMIC_RELEASE, "agent");
            asm volatile("s_waitcnt vmcnt(0)" ::: "memory");
            const unsigned og = xb_add(&bar[XB_TOP], 1u);
            const unsigned tg = og / nx;
            if (og + 1u == (tg + 1u) * nx) xb_add(&bar[XB_TOPGEN], 1u);
            else XB_SPIN(xb_ld(&bar[XB_TOPGEN]) == tg, bar);
            __builtin_amdgcn_fence(__ATOMIC_ACQUIRE, "agent");
            xb_add(&bar[XB_XGEN(b.x)], 1u);
            asm volatile("s_waitcnt vmcnt(0)" ::: "memory");
        } else {
            XB_SPIN(xb_ld(&bar[XB_XGEN(b.x)]) == gen, bar);
            __builtin_amdgcn_fence(__ATOMIC_ACQUIRE, "agent");
            asm volatile("s_waitcnt vmcnt(0)" ::: "memory");
        }
    }
    __syncthreads();
}

namespace pg8 {
constexpr int BM = 256, BK = 64, HALF = 128, HTB = HALF * BK * 2, STAGE_BYTES = 8 * HTB, NXCD = 8, WGM = 8;
__host__ __device__ __forceinline__ int lds_byte(int r, int c) { const int st = (r >> 4) * 2 + (c >> 5), rr = r & 15, cc = c & 31, ob = rr * 64 + cc * 2; return st * 1024 + (ob ^ (((ob >> 9) & 1) << 5)); }
__host__ __device__ __forceinline__ void stage_rc(int b, int& R, int& C) { const int st = b / 1024, sb = b % 1024, swz = sb ^ (((sb >> 9) & 1) << 5); R = (st >> 1) * 16 + swz / 64; C = (st & 1) * 32 + (swz % 64) / 2; }
__host__ __device__ __forceinline__ int perm32(int rho) { const int n = rho >> 4, i = rho & 15; return 8 * (i >> 2) + 4 * n + (i & 3); }
struct Unit { int pm, pn, e; };

__device__ __forceinline__ unsigned cvt_pk_bf16(float lo, float hi) { unsigned r; asm volatile("v_cvt_pk_bf16_f32 %0, %1, %2" : "=v"(r) : "v"(lo), "v"(hi)); return r; }

struct EpiBf16 {
    static constexpr bool PERM = true;
    bf16* O; int ldc;
    __device__ __forceinline__ void operator()(const f32x4 (&acc)[2][2][4][2], const Unit& u, int wr, int wc, int fr, int fq) const {
        const int row0 = u.pm * BM + wr * 64 + fr, col0 = u.pn * BM + wc * 32 + 8 * fq;
#pragma unroll
        for (int ai = 0; ai < 2; ++ai)
#pragma unroll
            for (int m = 0; m < 4; ++m) { bf16* rowp = O + (size_t)(row0 + ai * HALF + m * 16) * ldc + col0;
#pragma unroll
                for (int bj = 0; bj < 2; ++bj) { const f32x4 v0 = acc[ai][bj][m][0], v1 = acc[ai][bj][m][1];
                    v4u w; w.x = cvt_pk_bf16(v0[0], v0[1]); w.y = cvt_pk_bf16(v0[2], v0[3]); w.z = cvt_pk_bf16(v1[0], v1[1]); w.w = cvt_pk_bf16(v1[2], v1[3]);
                    *(v4u*)(rowp + bj * HALF) = w; } }
    }
};
struct EpiF32 {
    static constexpr bool PERM = false;
    float* C; int ldc; const float* bias;
    __device__ __forceinline__ void operator()(const f32x4 (&acc)[2][2][4][2], const Unit& u, int wr, int wc, int fr, int fq) const {
        const int row0 = u.pm * BM + wr * 64 + fr, col0 = u.pn * BM + wc * 32 + 4 * fq;
        f32x4 bv[2][2];
#pragma unroll
        for (int bj = 0; bj < 2; ++bj)
#pragma unroll
            for (int n = 0; n < 2; ++n) bv[bj][n] = bias ? *(const f32x4*)(bias + col0 + bj * HALF + n * 16) : (f32x4){0.f, 0.f, 0.f, 0.f};
#pragma unroll
        for (int ai = 0; ai < 2; ++ai)
#pragma unroll
            for (int m = 0; m < 4; ++m) { float* rowp = C + (size_t)(row0 + ai * HALF + m * 16) * ldc + col0;
#pragma unroll
                for (int bj = 0; bj < 2; ++bj)
#pragma unroll
                    for (int n = 0; n < 2; ++n) *(f32x4*)(rowp + bj * HALF + n * 16) = acc[ai][bj][m][n] + bv[bj][n]; }
    }
};
struct EpiSwiglu {
    static constexpr bool PERM = true;
    bf16* H;
    __device__ __forceinline__ void operator()(const f32x4 (&acc)[2][2][4][2], const Unit& u, int wr, int wc, int fr, int fq) const {
        const int row0 = u.pm * BM + wr * 64 + fr, col0 = u.pn * HALF + wc * 32 + 8 * fq;
#pragma unroll
        for (int ai = 0; ai < 2; ++ai)
#pragma unroll
            for (int m = 0; m < 4; ++m) { bf16* rowp = H + (size_t)(row0 + ai * HALF + m * 16) * EFF + col0;
                float o[8];
#pragma unroll
                for (int n = 0; n < 2; ++n)
#pragma unroll
                    for (int j = 0; j < 4; ++j) { const float h1 = acc[ai][0][m][n][j], h3 = acc[ai][1][m][n][j]; o[n * 4 + j] = siluf_(h1) * h3; }
                v4u w; w.x = cvt_pk_bf16(o[0], o[1]); w.y = cvt_pk_bf16(o[2], o[3]); w.z = cvt_pk_bf16(o[4], o[5]); w.w = cvt_pk_bf16(o[6], o[7]);
                *(v4u*)rowp = w; }
    }
};

template <class Epi, class Prob, bool ALIGN_EPI>
__device__ __forceinline__ void gemm_phase(LAS unsigned char* lds, const Prob& P, const Epi& E) {
    const int tid = threadIdx.x, wid = __builtin_amdgcn_readfirstlane(tid >> 6), lane = tid & 63, wr = wid >> 2, wc = wid & 3, fr = lane & 15, fq = lane >> 4;
    const int K = P.K, nt = K / BK;
    int RA[2], CA[2]; unsigned voffB[2];
#pragma unroll
    for (int i = 0; i < 2; ++i) { int R, C; stage_rc(tid * 16 + i * 8192, R, C); const int Rb = Epi::PERM ? ((R & ~31) + perm32(R & 31)) : R;
        RA[i] = R; CA[i] = C; voffB[i] = (unsigned)(Rb * K + C) * 2u; }
    const size_t kstep = (size_t)(BK * 2);
    const size_t hstep = (size_t)HALF * K * 2;
    const unsigned ldsw = (unsigned)wid * 1024u;
    const int aoff = lds_byte(wr * 64 + fr, fq * 8), boff = lds_byte(wc * 32 + fr, fq * 8);
    const char* const Ab = P.Abase;
#define PG8_SA(b, h) (((b) * 2 + (h)) * HTB)
#define PG8_SB(b, h) ((4 + (b) * 2 + (h)) * HTB)
#define PG8_STAGE(bufoff, gbase, voff) do { _Pragma("unroll") for (int _i = 0; _i < 2; ++_i) \
        __builtin_amdgcn_global_load_lds((const unsigned*)((const char*)(gbase) + (voff)[_i]), (LAS unsigned*)(lds + (bufoff) + ldsw + _i * 8192), 16, 0, 0); } while (0)
#define PG8_STAGE_A(bufoff, kb, o0, o1) do { \
        __builtin_amdgcn_global_load_lds((const unsigned*)(Ab + (kb) + (o0)), (LAS unsigned*)(lds + (bufoff) + ldsw), 16, 0, 0); \
        __builtin_amdgcn_global_load_lds((const unsigned*)(Ab + (kb) + (o1)), (LAS unsigned*)(lds + (bufoff) + ldsw + 8192), 16, 0, 0); } while (0)
#define PG8_LDA(dst, b, h) do { _Pragma("unroll") for (int m = 0; m < 4; ++m) _Pragma("unroll") for (int k = 0; k < 2; ++k) dst[m][k] = *(const LAS bf16x8*)(lds + PG8_SA(b, h) + aoff + m * 2048 + k * 1024); } while (0)
#define PG8_LDB(dst, b, h) do { _Pragma("unroll") for (int n = 0; n < 2; ++n) _Pragma("unroll") for (int k = 0; k < 2; ++k) dst[n][k] = *(const LAS bf16x8*)(lds + PG8_SB(b, h) + boff + n * 2048 + k * 1024); } while (0)
#define PG8_MMA(ai, bj, At, Bt) do { __builtin_amdgcn_s_setprio(1); _Pragma("unroll") for (int m = 0; m < 4; ++m) _Pragma("unroll") for (int n = 0; n < 2; ++n) _Pragma("unroll") for (int k = 0; k < 2; ++k) \
        acc[ai][bj][m][n] = __builtin_amdgcn_mfma_f32_16x16x32_bf16(Bt[n][k], At[m][k], acc[ai][bj][m][n], 0, 0, 0); __builtin_amdgcn_s_setprio(0); } while (0)
#define PG8_WAIT_V(n) asm volatile("s_waitcnt vmcnt(" #n ")" ::: "memory")
#define PG8_WAIT_L(n) asm volatile("s_waitcnt lgkmcnt(" #n ")" ::: "memory")
#define PG8_BAR __builtin_amdgcn_s_barrier()
#define PG8_SCHED __builtin_amdgcn_sched_barrier(0)
    Unit cur, nxt; int ui = 0;
    if (!P.next(0, cur)) return;
    f32x4 acc[2][2][4][2];
#pragma unroll
    for (int a = 0; a < 2; ++a)
#pragma unroll
        for (int b = 0; b < 2; ++b)
#pragma unroll
            for (int m = 0; m < 4; ++m)
#pragma unroll
                for (int n = 0; n < 2; ++n) acc[a][b][m][n] = (f32x4){0.f, 0.f, 0.f, 0.f};
    bf16x8 At[4][2], B0[2][2], B1[2][2];
    unsigned oc[4], on[4];
    P.aoffs(cur, RA, CA, oc);
    const char* cB = P.bbase(cur);
    PG8_STAGE(PG8_SB(0, 0), cB, voffB); PG8_STAGE(PG8_SB(0, 1), cB + hstep, voffB); PG8_STAGE_A(PG8_SA(0, 0), (size_t)0, oc[0], oc[1]); PG8_STAGE_A(PG8_SA(0, 1), (size_t)0, oc[2], oc[3]);
    if (wr == 1) PG8_BAR;
    PG8_WAIT_V(2); PG8_BAR;
    PG8_STAGE(PG8_SB(1, 0), cB + kstep, voffB); PG8_STAGE_A(PG8_SA(1, 0), kstep, oc[0], oc[1]); PG8_STAGE(PG8_SB(1, 1), cB + hstep + kstep, voffB);
    PG8_WAIT_V(6); PG8_BAR;
    for (;;) {
        const bool has_next = P.next(ui + 1, nxt);
        const char* nB = cB;
        if (has_next) { P.aoffs(nxt, RA, CA, on); nB = P.bbase(nxt); }
        else { on[0] = oc[0]; on[1] = oc[1]; on[2] = oc[2]; on[3] = oc[3]; }
        for (int t = 0; t < nt; t += 2) {
            const bool last = (t == nt - 2);
            const size_t kb1 = (size_t)(t + 1) * kstep;
            const size_t kb2 = last ? (size_t)0 : (size_t)(t + 2) * kstep, kb3 = kb2 + kstep;
            const char* b2 = last ? nB : cB + (size_t)(t + 2) * kstep; const char* b3 = b2 + kstep;
            const unsigned o20 = last ? on[0] : oc[0], o21 = last ? on[1] : oc[1], o22 = last ? on[2] : oc[2], o23 = last ? on[3] : oc[3];
            PG8_LDB(B0, 0, 0); PG8_LDB(B1, 0, 1); PG8_SCHED; PG8_LDA(At, 0, 0); PG8_STAGE_A(PG8_SA(1, 1), kb1, oc[2], oc[3]);
            PG8_WAIT_V(8); PG8_WAIT_L(0); PG8_BAR; PG8_MMA(0, 0, At, B0); PG8_MMA(0, 1, At, B1); PG8_BAR; PG8_SCHED;
            PG8_LDA(At, 0, 1); PG8_STAGE(PG8_SB(0, 0), b2, voffB); PG8_STAGE(PG8_SB(0, 1), b2 + hstep, voffB); PG8_STAGE_A(PG8_SA(0, 0), kb2, o20, o21);
            PG8_WAIT_V(8); PG8_WAIT_L(0); PG8_BAR; PG8_MMA(1, 0, At, B0); PG8_MMA(1, 1, At, B1); PG8_BAR; PG8_SCHED;
            PG8_LDB(B0, 1, 0); PG8_LDB(B1, 1, 1); PG8_SCHED; PG8_LDA(At, 1, 0); PG8_STAGE_A(PG8_SA(0, 1), kb2, o22, o23);
            PG8_WAIT_V(8); PG8_WAIT_L(0); PG8_BAR; PG8_MMA(0, 0, At, B0); PG8_MMA(0, 1, At, B1); PG8_BAR; PG8_SCHED;
            PG8_LDA(At, 1, 1); PG8_STAGE(PG8_SB(1, 0), b3, voffB); PG8_STAGE(PG8_SB(1, 1), b3 + hstep, voffB); PG8_STAGE_A(PG8_SA(1, 0), kb3, o20, o21);
            PG8_WAIT_V(8); PG8_WAIT_L(0); PG8_BAR; PG8_MMA(1, 0, At, B0); PG8_MMA(1, 1, At, B1); PG8_BAR; PG8_SCHED;
        }
        if constexpr (ALIGN_EPI) { if (wr == 0) PG8_BAR; }
        E(acc, cur, wr, wc, fr, fq);
        if (!has_next) break;
#pragma unroll
        for (int a = 0; a < 2; ++a)
#pragma unroll
            for (int b = 0; b < 2; ++b)
#pragma unroll
                for (int m = 0; m < 4; ++m)
#pragma unroll
                    for (int n = 0; n < 2; ++n) acc[a][b][m][n] = (f32x4){0.f, 0.f, 0.f, 0.f};
        cur = nxt; cB = nB; oc[0] = on[0]; oc[1] = on[1]; oc[2] = on[2]; oc[3] = on[3]; ++ui;
        if constexpr (ALIGN_EPI) { if (wr == 1) PG8_BAR; }
    }
    PG8_WAIT_V(0);
    if constexpr (!ALIGN_EPI) { if (wr == 0) PG8_BAR; }
    PG8_BAR;
#undef PG8_SA
#undef PG8_SB
#undef PG8_STAGE
#undef PG8_STAGE_A
#undef PG8_LDA
#undef PG8_LDB
#undef PG8_MMA
#undef PG8_WAIT_V
#undef PG8_WAIT_L
#undef PG8_BAR
#undef PG8_SCHED
}

struct DenseProb {
    int K; const char* Abase; const char* Bt; int lda; int nM, nN, nwg, G, c;
    __device__ __forceinline__ void init(const bf16* A, int lda_, const bf16* B, int M, int N, int K_, int G_, int c_) { Abase = (const char*)A; Bt = (const char*)B; lda = lda_; K = K_; nM = M / BM; nN = N / BM; nwg = nM * nN; G = G_; c = c_; }
    __device__ __forceinline__ bool next(int i, Unit& u) const {
        const long L = (long)i * G + c; if (L >= nwg) return false;
        int wgid = (int)L; { const int q = nwg / NXCD, r = nwg % NXCD, xcd = wgid % NXCD, off = wgid / NXCD; wgid = (xcd < r ? xcd * (q + 1) : r * (q + 1) + (xcd - r) * q) + off; }
        const int nig = WGM * nN, gid = wgid / nig, fm = gid * WGM, gsz = (nM - fm) < WGM ? (nM - fm) : WGM;
        u.pm = fm + ((wgid % nig) % gsz); u.pn = (wgid % nig) / gsz; u.e = 0; return true;
    }
    __device__ __forceinline__ const char* bbase(const Unit& u) const { return Bt + (size_t)u.pn * BM * K * 2; }
    __device__ __forceinline__ void aoffs(const Unit& u, const int (&R)[2], const int (&C)[2], unsigned (&o)[4]) const {
#pragma unroll
        for (int h = 0; h < 2; ++h)
#pragma unroll
            for (int i = 0; i < 2; ++i) o[2 * h + i] = (unsigned)(((size_t)(u.pm * BM + h * HALF + R[i]) * lda + C[i]) * 2);
    }
};
__device__ __forceinline__ bool xcd_range_unit(int i, int nunits, int G, int c, int& L) {
    const int x = c % NXCD, cc = c / NXCD, per = G / NXCD, q = nunits / NXCD, r = nunits % NXCD;
    const int start = x * q + (x < r ? x : r), cnt = q + (x < r ? 1 : 0), li = i * per + cc;
    if (li >= cnt) return false; L = start + li; return true;
}
struct MoeUpProb {
    int K; const char* Abase; const char* W13; const int* sorted; const LAS int* tile_e; int ntiles, nunits, G, c;
    __device__ __forceinline__ bool next(int i, Unit& u) const {
        int L; if (!xcd_range_unit(i, nunits, G, c, L)) return false;
        const int tile = L >> 2; u.pn = L & 3;
        if (tile < ntiles) { u.pm = tile; u.e = __builtin_amdgcn_readfirstlane(tile_e[tile]); } else { u.pm = MAXTILES + (tile - ntiles); u.e = NEXP; }
        return true;
    }
    __device__ __forceinline__ const char* bbase(const Unit& u) const { return W13 + ((size_t)u.e * 1024 + (size_t)u.pn * BM) * 2048 * 2; }
    __device__ __forceinline__ void aoffs(const Unit& u, const int (&R)[2], const int (&C)[2], unsigned (&o)[4]) const {
#pragma unroll
        for (int h = 0; h < 2; ++h)
#pragma unroll
            for (int i = 0; i < 2; ++i) { int row;
                if (u.e == NEXP) row = (u.pm - MAXTILES) * BM + h * HALF + R[i];
                else row = sorted[u.pm * BM + h * HALF + R[i]];
                o[2 * h + i] = (unsigned)(((size_t)row * 2048 + C[i]) * 2); }
    }
};
struct MoeDownProb {
    int K; const char* Abase; const char* W2; const LAS int* tile_e; int ntiles, nunits, G, c;
    __device__ __forceinline__ bool next(int i, Unit& u) const {
        int L; if (!xcd_range_unit(i, nunits, G, c, L)) return false;
        const int tile = L >> 3; u.pn = L & 7;
        if (tile < ntiles) { u.pm = tile; u.e = __builtin_amdgcn_readfirstlane(tile_e[tile]); } else { u.pm = MAXTILES + (tile - ntiles); u.e = NEXP; }
        return true;
    }
    __device__ __forceinline__ const char* bbase(const Unit& u) const { return W2 + ((size_t)u.e * 2048 + (size_t)u.pn * BM) * EFF * 2; }
    __device__ __forceinline__ void aoffs(const Unit& u, const int (&R)[2], const int (&C)[2], unsigned (&o)[4]) const {
#pragma unroll
        for (int h = 0; h < 2; ++h)
#pragma unroll
            for (int i = 0; i < 2; ++i) o[2 * h + i] = (unsigned)(((size_t)(u.pm * BM + h * HALF + R[i]) * EFF + C[i]) * 2);
    }
};
struct CmpProb {
    int K; const char* Abase; const char* Bt; int G, c;
    __device__ __forceinline__ bool next(int i, Unit& u) const { const int L = i * G + c; if (L >= 16) return false; u.pm = L; u.pn = 0; u.e = 0; return true; }
    __device__ __forceinline__ const char* bbase(const Unit&) const { return Bt; }
    __device__ __forceinline__ void aoffs(const Unit& u, const int (&R)[2], const int (&C)[2], unsigned (&o)[4]) const {
#pragma unroll
        for (int h = 0; h < 2; ++h)
#pragma unroll
            for (int i = 0; i < 2; ++i) { const int m = u.pm * BM + h * HALF + R[i], seq = m >> 7, n = m & 127;
                o[2 * h + i] = (unsigned)((((size_t)seq * NS + 16 * n) * 128 + C[i]) * 2); }
    }
};
}

struct Args { const float* in[27]; float* out; unsigned char* ws; int ph_lo, ph_hi; };
typedef const __attribute__((address_space(4))) Args* CArgs;
__device__ __forceinline__ const float* kin(int i) { CArgs p = (CArgs)__builtin_amdgcn_kernarg_segment_ptr(); asm volatile("" : "+s"(p)); return p->in[i]; }
struct Frame {
    LAS unsigned char* lds;
    volatile LAS unsigned* MISC;
    unsigned* ctl;
    unsigned char* ws;
    int tid, lane, wave, vcu, G, gw, NGW;
    float* out;
};

__device__ __forceinline__ void tr_item(const float* W, int ldw, int k0, int n0, int nvalid, bf16* WT, int ldt, int drow0, LAS float* scr, int lane) {
    float v[32]; const int n = lane & 31; const bool okn = n < nvalid; const float* src = W + (size_t)(k0 + (lane >> 5)) * ldw + n0 + n;
#pragma unroll
    for (int i = 0; i < 32; ++i) v[i] = okn ? src[(size_t)(2 * i) * ldw] : 0.f;
#pragma unroll
    for (int i = 0; i < 32; ++i) scr[(2 * i + (lane >> 5)) * 33 + n] = v[i];
    LDS_WAIT(); asm volatile("" ::: "memory");
    const int c = lane & 7;
#pragma unroll
    for (int j = 0; j < 4; ++j) { const int nn = (lane >> 3) + 8 * j; const LAS float* sp = scr + (8 * c) * 33 + nn;
        v4u o; o.x = pk2(sp[0 * 33], sp[1 * 33]); o.y = pk2(sp[2 * 33], sp[3 * 33]); o.z = pk2(sp[4 * 33], sp[5 * 33]); o.w = pk2(sp[6 * 33], sp[7 * 33]);
        if (nn < nvalid) *(v4u*)(WT + (size_t)(drow0 + nn) * ldt + k0 + 8 * c) = o; }
    LDS_WAIT(); asm volatile("" ::: "memory");
}
__device__ __forceinline__ bool tr_matrix(int& it, const float* W, int ldw, int K, int c0, int ncols, bf16* WT, int drow0, LAS float* scr, int lane) {
    const int nb = (ncols + 31) / 32, items = (K / 64) * nb;
    if (it >= items) { it -= items; return false; }
    const int kb = it / nb, b = it % nb, nv = ncols - 32 * b;
    tr_item(W, ldw, 64 * kb, c0 + 32 * b, nv < 32 ? nv : 32, WT, K, drow0 + 32 * b, scr, lane);
    return true;
}
__device__ __forceinline__ void zero_rows(Frame& F, bf16* base, size_t nelem) {
    for (size_t i = ((size_t)F.gw * 64 + F.lane) * 8; i < nelem; i += (size_t)F.NGW * 64 * 8) *(v4u*)(base + i) = (v4u){0u, 0u, 0u, 0u};
}

__device__ __forceinline__ void p_prologue(Frame& F) {
    LAS float* scr = (LAS float*)(F.lds + F.wave * 16384);
    unsigned char* ws = F.ws;
    {
        LAS float* wl = (LAS float*)F.lds;
        LAS float* pl = (LAS float*)(F.lds + 32768);
        const float* w_in = kin(2); const float* pool_w = kin(3); const float* pscale = kin(4);
        bf16* WT = (bf16*)(ws + WS_WABIN);
        for (int it = blockIdx.x; it < 4 * 32; it += F.G) {
            const int g = it >> 5, k0 = (it & 31) * 64;
            for (int i = F.tid; i < 64 * 128; i += 512) wl[i] = w_in[(size_t)(k0 + (i >> 7)) * AB_IN + g * 128 + (i & 127)];
            for (int i = F.tid; i < 128 * 128; i += 512) pl[i] = pool_w[(size_t)g * 16384 + i];
            __syncthreads();
            const int d = F.tid & 127, kg = F.tid >> 7; const float sc = pscale[g * 128 + d];
            for (int kk = 0; kk < 16; kk += 8) {
                float a[8];
#pragma unroll
                for (int j = 0; j < 8; ++j) a[j] = 0.f;
                for (int c = 0; c < 128; ++c) { const float pw = pl[c * 128 + d];
#pragma unroll
                    for (int j = 0; j < 8; ++j) a[j] += wl[(kg * 16 + kk + j) * 128 + c] * pw; }
                v4u o; o.x = pk2(a[0] * sc, a[1] * sc); o.y = pk2(a[2] * sc, a[3] * sc); o.z = pk2(a[4] * sc, a[5] * sc); o.w = pk2(a[6] * sc, a[7] * sc);
                *(v4u*)(WT + (size_t)(g * 128 + d) * ND + k0 + kg * 16 + kk) = o;
            }
            __syncthreads();
        }
    }
    __syncthreads();
    for (int it0 = F.gw; ; it0 += F.NGW) {
        int it = it0;
        if (tr_matrix(it, kin(2), AB_IN, ND, 512, AB_IN - 512, (bf16*)(ws + WS_WABIN), 512, scr, F.lane)) continue;
        if (tr_matrix(it, kin(5), ND, ND, 0, ND, (bf16*)(ws + WS_WABOUT), 0, scr, F.lane)) continue;
        if (tr_matrix(it, kin(6), CD_IN, ND, 0, CD_IN, (bf16*)(ws + WS_WCDIN), 0, scr, F.lane)) continue;
        if (tr_matrix(it, kin(14), ND, ND, 0, ND, (bf16*)(ws + WS_WCDOUT), 0, scr, F.lane)) continue;
        if (tr_matrix(it, kin(11), 1536, 384, 0, 1536, (bf16*)(ws + WS_WUQ), 0, scr, F.lane)) continue;
        if (tr_matrix(it, kin(13), 2048, 512, 0, 2048, (bf16*)(ws + WS_WUKV), 0, scr, F.lane)) continue;
        if (tr_matrix(it, kin(8), 128, 4096, 0, 128, (bf16*)(ws + WS_CW1), 0, scr, F.lane)) continue;
        if (tr_matrix(it, kin(8) + (size_t)4096 * 128, 128, 4096, 0, 128, (bf16*)(ws + WS_CW1), 128, scr, F.lane)) continue;
        break;
    }
    zero_rows(F, (bf16*)(ws + WS_WCDIN) + (size_t)CD_IN * ND, (size_t)(CD_INP - CD_IN) * ND);
    { const float* x = kin(0); bf16* xb = (bf16*)(ws + WS_XB0);
      for (size_t i = ((size_t)F.gw * 64 + F.lane) * 8; i < (size_t)NT * ND; i += (size_t)F.NGW * 64 * 8) {
          const f32x4 a = *(const f32x4*)(x + i), b = *(const f32x4*)(x + i + 4);
          v4u o; o.x = pk2(a[0], a[1]); o.y = pk2(a[2], a[3]); o.z = pk2(b[0], b[1]); o.w = pk2(b[2], b[3]); *(v4u*)(xb + i) = o; } }
    for (int o = F.gw; o < 256; o += F.NGW) { const int kv = o >> 7, h = o & 127; const float* pos = kin(7) + (size_t)kv * 4096; const float* w1 = kin(8) + (size_t)kv * 4096 * 128;
        float sacc = 0.f; for (int f = F.lane; f < 4096; f += 64) sacc += pos[f] * w1[(size_t)f * 128 + h];
        sacc = wave_sum(sacc); if (F.lane == 0) ((float*)(ws + WS_CMPB))[o] = sacc; }
}
constexpr int MW_ITEMS_L = 65 * 1536 + 64;
__device__ __forceinline__ void moe_weight_item(int l, int it, unsigned char* ws, LAS float* scr, int lane) {
    bf16* W13 = (bf16*)(ws + WS_W13 + (size_t)l * WS_MOE_LSTRIDE); bf16* W2 = (bf16*)(ws + WS_W2 + (size_t)l * WS_MOE_LSTRIDE); bf16* RT = (bf16*)(ws + WS_RT + (size_t)l * MiB);
    if (it >= 65 * 1536) { const int r = it - 65 * 1536, kb = r >> 1, b = r & 1;
        tr_item(kin(19) + (size_t)l * ND * NEXP, NEXP, 64 * kb, 32 * b, 32, RT, ND, 32 * b, scr, lane); return; }
    const int e = it / 1536, r = it % 1536;
    const float *w1, *w3, *w2;
    if (e < NEXP) { const size_t o = ((size_t)l * NEXP + e) * ND * EFF; w1 = kin(21) + o; w3 = kin(22) + o; w2 = kin(23) + o; }
    else { const size_t o = (size_t)l * ND * EFF; w1 = kin(24) + o; w3 = kin(25) + o; w2 = kin(26) + o; }
    if (r < 1024) { const int which = r >> 9, rr = r & 511, kb = rr >> 4, nb = rr & 15;
        const int j = nb >> 2, drow = j * 256 + which * 128 + (nb & 3) * 32;
        tr_item(which ? w3 : w1, EFF, 64 * kb, 32 * nb, 32, W13 + (size_t)e * 1024 * ND, ND, drow, scr, lane); }
    else { const int rr = r - 1024, kb = rr >> 6, nb = rr & 63;
        tr_item(w2, ND, 64 * kb, 32 * nb, 32, W2 + (size_t)e * ND * EFF, EFF, 32 * nb, scr, lane); }
}
__device__ __forceinline__ void p_moe_weights_queue(Frame& F, unsigned* queue) {
    LAS float* scr = (LAS float*)(F.lds + F.wave * 16384);
    constexpr int BATCH = 16, NB_ = (2 * MW_ITEMS_L + BATCH - 1) / BATCH;
    for (;;) {
        unsigned bq = 0; if (F.lane == 0) bq = atomicAdd(queue, 1u);
        const int bi = __builtin_amdgcn_readfirstlane((int)bq);
        if (bi >= NB_) break;
        for (int k = 0; k < BATCH; ++k) { const int it = bi * BATCH + k; if (it >= 2 * MW_ITEMS_L) break; const int l = it >= MW_ITEMS_L ? 1 : 0; moe_weight_item(l, it - l * MW_ITEMS_L, F.ws, scr, F.lane); }
    }
    for (int l = 0; l < 2; ++l) zero_rows(F, (bf16*)(F.ws + WS_RT + (size_t)l * MiB) + (size_t)NEXP * ND, (size_t)(256 - NEXP) * ND);
}

__device__ __forceinline__ void ln_finish(float (&v)[4][8], const float* g, const float* b, int lane, bf16* ob, float* of) {
    float s = 0.f;
#pragma unroll
    for (int j = 0; j < 4; ++j)
#pragma unroll
        for (int i = 0; i < 8; ++i) s += v[j][i];
    const float mean = wave_sum(s) * (1.f / ND); float s2 = 0.f;
#pragma unroll
    for (int j = 0; j < 4; ++j)
#pragma unroll
        for (int i = 0; i < 8; ++i) { v[j][i] -= mean; s2 += v[j][i] * v[j][i]; }
    const float rstd = 1.f / sqrtf(wave_sum(s2) * (1.f / ND) + LN_EPS);
#pragma unroll
    for (int j = 0; j < 4; ++j) { const int c0 = (j * 64 + lane) * 8;
        const f32x4 g0 = *(const f32x4*)(g + c0), g1 = *(const f32x4*)(g + c0 + 4), b0 = *(const f32x4*)(b + c0), b1 = *(const f32x4*)(b + c0 + 4);
        float o[8];
#pragma unroll
        for (int i = 0; i < 4; ++i) { o[i] = v[j][i] * rstd * g0[i] + b0[i]; o[4 + i] = v[j][4 + i] * rstd * g1[i] + b1[i]; }
        if (ob) { v4u w; w.x = pk2(o[0], o[1]); w.y = pk2(o[2], o[3]); w.z = pk2(o[4], o[5]); w.w = pk2(o[6], o[7]); *(v4u*)(ob + c0) = w; }
        if (of) { *(f32x4*)(of + c0) = (f32x4){o[0], o[1], o[2], o[3]}; *(f32x4*)(of + c0 + 4) = (f32x4){o[4], o[5], o[6], o[7]}; } }
}
__device__ __forceinline__ void p_ln1(Frame& F, const bf16* xin, const bf16* mixo, const float* g, const float* b, bf16* xo) {
    for (int m = F.gw; m < NT; m += F.NGW) {
        float v[4][8];
#pragma unroll
        for (int j = 0; j < 4; ++j) { const size_t o = (size_t)m * ND + (j * 64 + F.lane) * 8; float a[8], c[8]; unpack8(*(const v4u*)(xin + o), a); unpack8(*(const v4u*)(mixo + o), c);
#pragma unroll
            for (int i = 0; i < 8; ++i) v[j][i] = DN_ALPHA * a[i] + c[i]; }
        ln_finish(v, g, b, F.lane, xo + (size_t)m * ND, nullptr);
    }
}
__device__ __forceinline__ void p_combine_ln2(Frame& F, const bf16* x1, const bf16* y2, const int* slot, const float* wsel, const float* g, const float* b, bf16* xo, float* fo) {
    for (int m = F.gw; m < NT; m += F.NGW) {
        float v[4][8];
#pragma unroll
        for (int j = 0; j < 4; ++j) { const size_t o = (size_t)m * ND + (j * 64 + F.lane) * 8; float a[8], c[8]; unpack8(*(const v4u*)(x1 + o), a);
            unpack8(*(const v4u*)(y2 + (size_t)(SH_ROW0 + m) * ND + (j * 64 + F.lane) * 8), c);
#pragma unroll
            for (int i = 0; i < 8; ++i) v[j][i] = DN_ALPHA * a[i] + c[i]; }
        for (int k = 0; k < 8; ++k) { const int row = slot[m * 8 + k]; const float w = wsel[m * 8 + k];
#pragma unroll
            for (int j = 0; j < 4; ++j) { float c[8]; unpack8(*(const v4u*)(y2 + (size_t)row * ND + (j * 64 + F.lane) * 8), c);
#pragma unroll
                for (int i = 0; i < 8; ++i) v[j][i] += w * c[i]; } }
        ln_finish(v, g, b, F.lane, xo ? xo + (size_t)m * ND : nullptr, fo ? fo + (size_t)m * ND : nullptr);
    }
}

__device__ __forceinline__ void p_pool_rope(Frame& F) {
    const bf16* proj = (const bf16*)(F.ws + WS_PROJ); bf16* mixin = (bf16*)(F.ws + WS_MIXIN); bf16* qr = (bf16*)(F.ws + WS_QR); bf16* kr = (bf16*)(F.ws + WS_KR);
    const int* pos = (const int*)kin(1);
    for (int m = F.gw; m < NT; m += F.NGW) {
        const int s = m & (NS - 1);
        { const int g = F.lane >> 4, w = 2 << g; const int lo = (s + 1 - w) > 0 ? (s + 1 - w) : 0; const float cnt = (float)((s + 1) < w ? (s + 1) : w);
          float acc[8], cur[8];
#pragma unroll
          for (int i = 0; i < 8; ++i) acc[i] = 0.f;
          for (int j = lo; j <= s; ++j) { float t[8]; unpack8(*(const v4u*)(proj + (size_t)(m - s + j) * AB_IN + F.lane * 8), t);
#pragma unroll
              for (int i = 0; i < 8; ++i) acc[i] += t[i]; }
          unpack8(*(const v4u*)(proj + (size_t)m * AB_IN + F.lane * 8), cur);
          float o[8];
#pragma unroll
          for (int i = 0; i < 8; ++i) o[i] = acc[i] / cnt - cur[i];
          v4u wv; wv.x = pk2(o[0], o[1]); wv.y = pk2(o[2], o[3]); wv.z = pk2(o[4], o[5]); wv.w = pk2(o[6], o[7]); *(v4u*)(mixin + (size_t)m * ND + F.lane * 8) = wv; }
        { const float p = (float)pos[m]; const float invf = exp2f(-(float)F.lane * (13.287712379549449f / 64.f));
          float sn, cs; fast_sincos(p * invf, sn, cs);
          const bf16* qrow = proj + (size_t)m * AB_IN + 512; const bf16* krow = proj + (size_t)m * AB_IN + 1280;
#pragma unroll
          for (int h = 0; h < 6; ++h) {
              const float q1 = bf1(qrow[h * 128 + F.lane]), q2 = bf1(qrow[h * 128 + 64 + F.lane]);
              qr[(size_t)m * 768 + h * 128 + F.lane] = (bf16)f2bf(q1 * cs - q2 * sn); qr[(size_t)m * 768 + h * 128 + 64 + F.lane] = (bf16)f2bf(q1 * sn + q2 * cs);
              const float k1 = bf1(krow[h * 128 + F.lane]), k2 = bf1(krow[h * 128 + 64 + F.lane]); const float ksc = 0.08838834764831845f;
              kr[(size_t)m * 768 + h * 128 + F.lane] = (bf16)f2bf((k1 * cs - k2 * sn) * ksc); kr[(size_t)m * 768 + h * 128 + 64 + F.lane] = (bf16)f2bf((k1 * sn + k2 * cs) * ksc);
          } }
    }
}
namespace ret {
typedef short v4i16_t __attribute__((ext_vector_type(4)));
constexpr int PITCH = 272, TILE = 128 * PITCH;
__device__ __forceinline__ bf16x8 trfrag(LAS unsigned char* trb, int r0, int r1, int c0) {
    const v4i16_t a = __builtin_amdgcn_ds_read_tr16_b64_v4i16((LAS v4i16_t*)(trb + r0 * PITCH + c0 * 2));
    const v4i16_t b = __builtin_amdgcn_ds_read_tr16_b64_v4i16((LAS v4i16_t*)(trb + r1 * PITCH + c0 * 2));
    return (bf16x8){a[0], a[1], a[2], a[3], b[0], b[1], b[2], b[3]};
}
}
__device__ __forceinline__ void p_retention_mfma(Frame& F, int bh) {
    const bf16* proj = (const bf16*)(F.ws + WS_PROJ); bf16* mixin = (bf16*)(F.ws + WS_MIXIN); const bf16* qr = (const bf16*)(F.ws + WS_QR); const bf16* kr = (const bf16*)(F.ws + WS_KR);
    constexpr int P = ret::PITCH;
    LAS unsigned char* KT = F.lds; LAS unsigned char* VT = F.lds + ret::TILE; LAS unsigned char* ST = F.lds + 2 * ret::TILE;
    const int b = bh / 6, h = bh % 6, w = F.wave, lane = F.lane, i16 = lane & 15, g = lane >> 4, q4 = (lane & 15) >> 2, p4 = lane & 3;
    const float lg = log2f(1.0f - exp2f(-5.0f - (float)h)), gc = exp2f(128.f * lg);
    const int rowb = i16 * P + 16 * g;
    const int trl = q4 * P + 8 * p4;
    LAS unsigned char* const trV4 = VT + trl + 4 * g * P;
    LAS unsigned char* const trV8 = VT + trl + 8 * g * P;
    LAS unsigned char* const trK8 = KT + trl + 8 * g * P;
    f32x4 T[2][8];
#pragma unroll
    for (int a = 0; a < 2; ++a)
#pragma unroll
        for (int d = 0; d < 8; ++d) T[a][d] = (f32x4){0.f, 0.f, 0.f, 0.f};
    const int srow = F.tid >> 2, scb = (F.tid & 3) * 4;
    for (int n = 0; n < NS / 128; ++n) {
        const size_t m0 = (size_t)b * NS + n * 128;
        { const float fk = exp2f(-(float)srow * lg);
#pragma unroll
          for (int c = 0; c < 4; ++c) { const int c8 = scb + c; float t[8];
              unpack8(*(const v4u*)(kr + (m0 + srow) * 768 + h * 128 + c8 * 8), t);
              v4u o; o.x = pk2(t[0] * fk, t[1] * fk); o.y = pk2(t[2] * fk, t[3] * fk); o.z = pk2(t[4] * fk, t[5] * fk); o.w = pk2(t[6] * fk, t[7] * fk); *(LAS v4u*)(KT + srow * P + c8 * 16) = o; } }
        bf16x8 qf[4], pf[4]; float rs[4] = {0.f, 0.f, 0.f, 0.f}, rq[4] = {0.f, 0.f, 0.f, 0.f};
        { const float fq = exp2f((float)(16 * w + i16) * lg);
#pragma unroll
          for (int ks = 0; ks < 4; ++ks) { float t[8]; unpack8(*(const v4u*)(qr + (m0 + 16 * w + i16) * 768 + h * 128 + 32 * ks + 8 * g), t);
              v4u o; o.x = pk2(t[0] * fq, t[1] * fq); o.y = pk2(t[2] * fq, t[3] * fq); o.z = pk2(t[4] * fq, t[5] * fq); o.w = pk2(t[6] * fq, t[7] * fq); qf[ks] = __builtin_bit_cast(bf16x8, o); } }
#pragma unroll
        for (int hv = 0; hv < 2; ++hv) {
            if (hv == 1) __syncthreads();
#pragma unroll
            for (int c = 0; c < 4; ++c) { const int c8 = scb + c; *(LAS v4u*)(VT + srow * P + c8 * 16) = *(const v4u*)(proj + (m0 + srow) * AB_IN + 2048 + h * 256 + hv * 128 + c8 * 8); }
            { LAS unsigned char* stw = ST + (16 * w + 4 * g) * P + i16 * 2;
#pragma unroll
              for (int dt = 0; dt < 8; ++dt)
#pragma unroll
                for (int r = 0; r < 4; ++r) { T[hv][dt][r] *= gc; *(LAS bf16*)(stw + r * P + dt * 32) = (bf16)f2bf(T[hv][dt][r]); } }
            __syncthreads();
            if (hv == 0) {
                f32x4 sc[8];
#pragma unroll
                for (int mt = 0; mt < 8; ++mt) { sc[mt] = (f32x4){0.f, 0.f, 0.f, 0.f};
                    if (mt <= w) {
#pragma unroll
                        for (int ks = 0; ks < 4; ++ks) { const bf16x8 kf = *(const LAS bf16x8*)(KT + rowb + mt * 16 * P + ks * 64); sc[mt] = __builtin_amdgcn_mfma_f32_16x16x32_bf16(kf, qf[ks], sc[mt], 0, 0, 0); }
                        if (mt == w) {
#pragma unroll
                            for (int r = 0; r < 4; ++r) sc[mt][r] = (4 * g + r <= i16) ? sc[mt][r] : 0.f; } } }
#pragma unroll
                for (int k2 = 0; k2 < 4; ++k2) { v4u wv; wv.x = pk2(sc[2 * k2][0], sc[2 * k2][1]); wv.y = pk2(sc[2 * k2][2], sc[2 * k2][3]); wv.z = pk2(sc[2 * k2 + 1][0], sc[2 * k2 + 1][1]); wv.w = pk2(sc[2 * k2 + 1][2], sc[2 * k2 + 1][3]);
                    pf[k2] = __builtin_bit_cast(bf16x8, wv); }
            }
#pragma unroll
            for (int nt = 0; nt < 8; ++nt) { f32x4 acc = (f32x4){0.f, 0.f, 0.f, 0.f};
#pragma unroll
                for (int k2 = 0; k2 < 4; ++k2) if (2 * k2 <= w) { const bf16x8 vf = ret::trfrag(trV4, 32 * k2, 32 * k2 + 16, 16 * nt); acc = __builtin_amdgcn_mfma_f32_16x16x32_bf16(pf[k2], vf, acc, 0, 0, 0); }
#pragma unroll
                for (int ks = 0; ks < 4; ++ks) { const bf16x8 sf = *(const LAS bf16x8*)(ST + rowb + nt * 16 * P + ks * 64); acc = __builtin_amdgcn_mfma_f32_16x16x32_bf16(qf[ks], sf, acc, 0, 0, 0); }
#pragma unroll
                for (int r = 0; r < 4; ++r) { rs[r] += acc[r]; rq[r] += acc[r] * acc[r]; mixin[(m0 + 16 * w + 4 * g + r) * ND + 512 + h * 256 + hv * 128 + 16 * nt + i16] = (bf16)f2bf(acc[r]); } }
#pragma unroll
            for (int ks = 0; ks < 4; ++ks) { const bf16x8 af = ret::trfrag(trV8, 32 * ks, 32 * ks + 4, 16 * w);
#pragma unroll
                for (int dt = 0; dt < 8; ++dt) { const bf16x8 bfr = ret::trfrag(trK8, 32 * ks, 32 * ks + 4, 16 * dt); T[hv][dt] = __builtin_amdgcn_mfma_f32_16x16x32_bf16(af, bfr, T[hv][dt], 0, 0, 0); } }
        }
#pragma unroll
        for (int r = 0; r < 4; ++r) { float sm = rs[r], s2 = rq[r];
            sm += __shfl_xor(sm, 1); sm += __shfl_xor(sm, 2); sm += __shfl_xor(sm, 4); sm += __shfl_xor(sm, 8);
            s2 += __shfl_xor(s2, 1); s2 += __shfl_xor(s2, 2); s2 += __shfl_xor(s2, 4); s2 += __shfl_xor(s2, 8);
            const float mean = sm * (1.f / 256.f); const float var = fmaxf(s2 * (1.f / 256.f) - mean * mean, 0.f);
            const float rstd = 1.f / sqrtf(var + NORM_EPS);
            const size_t m = m0 + 16 * w + 4 * g + r;
#pragma unroll
            for (int t = 0; t < 16; ++t) { bf16* yp = mixin + m * ND + 512 + h * 256 + 16 * t + i16; const float gt = bf1(proj[m * AB_IN + 3584 + h * 256 + 16 * t + i16]);
                *yp = (bf16)f2bf((bf1(*yp) - mean) * rstd * siluf_(gt)); } }
        __syncthreads();
    }
}

__device__ __forceinline__ void p_route(Frame& F, int l) {
    const float* logits = (const float*)(F.ws + WS_LOGITS); const float* rbias = kin(20) + l * NEXP;
    int* tope = (int*)(F.ws + WS_TOPE); float* wsel = (float*)(F.ws + WS_WSEL); int* posb = (int*)(F.ws + WS_SLOT); unsigned* cnt = F.ctl + CW_CNT + l * 64;
    LAS unsigned* lcnt = (LAS unsigned*)F.lds; LAS unsigned* lbase = lcnt + 64; LAS int* le = (LAS int*)(lcnt + 128); LAS unsigned* lp = (LAS unsigned*)(lcnt + 128 + 512);
    const float bias = rbias[F.lane]; const int lane = F.lane;
    for (int chunk = blockIdx.x; chunk < NT / 64; chunk += F.G) {
        __syncthreads();
        if (F.tid < 64) lcnt[F.tid] = 0u;
        __syncthreads();
        for (int t = 0; t < 8; ++t) {
            const int tl = F.wave * 8 + t, m = chunk * 64 + tl;
            const float sc = sigmoidf_(logits[(size_t)m * 256 + lane]), bi = sc + bias;
            const int grp = lane >> 3;
            int rk = 0;
#pragma unroll
            for (int j = 1; j < 8; ++j) { const int o = lane ^ j; const float ov = __shfl_xor(bi, j); rk += ((ov > bi) || (ov == bi && o < lane)) ? 1 : 0; }
            float gs = rk < 2 ? bi : 0.f; gs += __shfl_xor(gs, 1); gs += __shfl_xor(gs, 2); gs += __shfl_xor(gs, 4);
            int grk = 0;
#pragma unroll
            for (int gg = 0; gg < 8; ++gg) { const float ov = __builtin_bit_cast(float, __builtin_amdgcn_readlane(__builtin_bit_cast(int, gs), gg * 8)); grk += (gg != grp && ((ov > gs) || (ov == gs && gg < grp))) ? 1 : 0; }
            const float mv = grk < 4 ? bi : -1e30f;
            int erk = 0;
#pragma unroll 16
            for (int j = 0; j < 64; ++j) { const float ov = __builtin_bit_cast(float, __builtin_amdgcn_readlane(__builtin_bit_cast(int, mv), j)); erk += ((ov > mv) || (ov == mv && j < lane)) ? 1 : 0; }
            const bool sel = erk < 8;
            const float wsum = wave_sum(sel ? sc : 0.f);
            if (sel) { const unsigned q = __hip_atomic_fetch_add(lcnt + lane, 1u, __ATOMIC_RELAXED, __HIP_MEMORY_SCOPE_WORKGROUP);
                tope[m * 8 + erk] = lane; wsel[m * 8 + erk] = sc / wsum * 2.5f; le[tl * 8 + erk] = lane; lp[tl * 8 + erk] = q; }
        }
        __syncthreads();
        if (F.tid < 64) lbase[F.tid] = atomicAdd(&cnt[F.tid], lcnt[F.tid]);
        __syncthreads();
        posb[chunk * 512 + F.tid] = (int)(lbase[le[F.tid]] + lp[F.tid]);
    }
}
__device__ __forceinline__ void load_offsets(Frame& F, int l) {
    volatile LAS int* tab = (volatile LAS int*)(F.lds + TAB_OFF);
    __syncthreads();
    if (F.tid < NEXP) tab[66 + F.tid] = (int)__hip_atomic_load(F.ctl + CW_CNT + l * 64 + F.tid, __ATOMIC_RELAXED, __HIP_MEMORY_SCOPE_AGENT);
    __syncthreads();
    if (F.tid == 0) { int o = 0; for (int e = 0; e < NEXP; ++e) { tab[e] = o; int c = tab[66 + e]; if (c > NT) c = NT; const int nt_ = (c + 255) >> 8; for (int t = 0; t < nt_; ++t) { const int ti = (o >> 8) + t; if (ti < MAXTILES) tab[160 + ti] = e; } o += nt_ << 8; if (o > MAXROWS) o = MAXROWS; }
        tab[64] = o; tab[65] = o >> 8; }
    __syncthreads();
}
__device__ __forceinline__ void p_scatter(Frame& F, int l) {
    load_offsets(F, l);
    const LAS int* tab = (const LAS int*)(F.lds + TAB_OFF);
    const int* tope = (const int*)(F.ws + WS_TOPE); int* slot = (int*)(F.ws + WS_SLOT); int* sorted = (int*)(F.ws + WS_SORTED);
    for (int i = F.gw * 64 + F.lane; i < NT * 8; i += F.NGW * 64) { const int e = tope[i]; const int row = tab[e] + slot[i]; sorted[row] = i >> 3; slot[i] = row; }
    for (int i = F.gw * 64 + F.lane; i < NEXP * 256; i += F.NGW * 64) { const int e = i >> 8, j = i & 255; const int r = tab[e] + tab[66 + e] + j; if (r < tab[e + 1]) sorted[r] = 0; }
}

__device__ __forceinline__ void p_l1_thin_a(Frame& F) {
    const bf16* proj = (const bf16*)(F.ws + WS_PROJ); const int* pos = (const int*)kin(1);
    bf16* cqn = (bf16*)(F.ws + WS_CQN); bf16* ckvn = (bf16*)(F.ws + WS_CKVN); bf16* krot = (bf16*)(F.ws + WS_KROT); bf16* cmpkv = (bf16*)(F.ws + WS_CMPKV);
    const float* qn = kin(10); const float* kvn = kin(12);
    for (int m = F.gw; m < NT; m += F.NGW) {
        const bf16* row = proj + (size_t)m * CD_INP;
        { float x[6]; float s = 0.f;
#pragma unroll
          for (int j = 0; j < 6; ++j) { x[j] = bf1(row[2584 + j * 64 + F.lane]); s += x[j] * x[j]; }
          const float r = 1.f / sqrtf(wave_sum(s) * (1.f / 384.f) + NORM_EPS);
#pragma unroll
          for (int j = 0; j < 6; ++j) cqn[(size_t)m * 384 + j * 64 + F.lane] = (bf16)f2bf(x[j] * r * qn[j * 64 + F.lane]); }
        { float x[8]; float s = 0.f;
#pragma unroll
          for (int j = 0; j < 8; ++j) { x[j] = bf1(row[2968 + j * 64 + F.lane]); s += x[j] * x[j]; }
          const float r = 1.f / sqrtf(wave_sum(s) * (1.f / 512.f) + NORM_EPS);
#pragma unroll
          for (int j = 0; j < 8; ++j) ckvn[(size_t)m * 512 + j * 64 + F.lane] = (bf16)f2bf(x[j] * r * kvn[j * 64 + F.lane]); }
        { const int i = F.lane & 31; const float p = (float)pos[m]; const float invf = exp2f(-(float)i * (13.287712379549449f / 32.f));
          float sn, cs; fast_sincos(p * invf, sn, cs);
          const float x1 = bf1(row[3480 + i]), x2 = bf1(row[3480 + 32 + i]);
          if (F.lane < 32) krot[(size_t)m * 64 + i] = (bf16)f2bf(x1 * cs - x2 * sn); else krot[(size_t)m * 64 + 32 + i] = (bf16)f2bf(x1 * sn + x2 * cs); }
        { const int b = m >> 11, s = m & (NS - 1);
          const int q4 = F.lane >> 4, c = F.lane & 15, kv = q4 >> 1, g = q4 & 1;
          const v4u w = *(const v4u*)(row + 1024 + q4 * 128 + c * 8);
          *(v4u*)(cmpkv + ((size_t)((kv * 16 + b * 2 + g) * NS + s)) * 128 + c * 8) = w; }
    }
}
__device__ __forceinline__ void p_l1_thin_b(Frame& F) {
    const float* hid = (const float*)(F.ws + WS_HID); const float* w2 = kin(9); bf16* kvc = (bf16*)(F.ws + WS_KVCMP);
    for (int m = F.gw; m < 4096; m += F.NGW) {
        const int kv = m >> 11;
        float h0 = hid[(size_t)m * 256 + kv * 128 + F.lane], h1 = hid[(size_t)m * 256 + kv * 128 + 64 + F.lane];
        h0 = 0.5f * h0 * (1.f + tanhf(0.7978845608028654f * (h0 + 0.044715f * h0 * h0 * h0)));
        h1 = 0.5f * h1 * (1.f + tanhf(0.7978845608028654f * (h1 + 0.044715f * h1 * h1 * h1)));
        const float* w = w2 + (size_t)kv * 128 * 128; float o0 = 0.f, o1 = 0.f;
        for (int c = 0; c < 64; ++c) { const float a = __shfl(h0, c), bq = __shfl(h1, c);
            o0 += a * w[c * 128 + F.lane] + bq * w[(c + 64) * 128 + F.lane]; o1 += a * w[c * 128 + 64 + F.lane] + bq * w[(c + 64) * 128 + 64 + F.lane]; }
        kvc[(size_t)m * 128 + F.lane] = (bf16)f2bf(o0); kvc[(size_t)m * 128 + 64 + F.lane] = (bf16)f2bf(o1);
    }
}
__device__ __forceinline__ void p_nsa_cmp_mfma(Frame& F) {
    typedef short v4i16_t __attribute__((ext_vector_type(4)));
    const bf16* proj = (const bf16*)(F.ws + WS_PROJ); const bf16* kvc = (const bf16*)(F.ws + WS_KVCMP); float* ocmp = (float*)(F.ws + WS_OCMP); unsigned* selm = (unsigned*)(F.ws + WS_SELM);
    constexpr int P = 272;
    LAS unsigned char* KT = F.lds; LAS unsigned char* VT = F.lds + 128 * P; LAS float* PS = (LAS float*)(F.lds + 2 * 128 * P);
    const int w = F.wave, lane = F.lane, i16 = lane & 15, g = lane >> 4, q4 = (lane & 15) >> 2, p4 = lane & 3;
    const float sscale = 0.08838834764831845f * 1.4426950408889634f;
    for (int bu = blockIdx.x; bu < 256; bu += F.G) {
        const int bg = bu >> 4, qg = bu & 15, b = bg >> 1, gq = bg & 1;
        __syncthreads();
#pragma unroll
        for (int c = 0; c < 4; ++c) { const int idx = F.tid + 512 * c, row = idx >> 4, c8 = idx & 15;
            v4u kk = (v4u){0u, 0u, 0u, 0u}, vv = (v4u){0u, 0u, 0u, 0u};
            if (row < 127) { kk = *(const v4u*)(kvc + ((size_t)(0 * 16 + bg) * 128 + row) * 128 + c8 * 8); vv = *(const v4u*)(kvc + ((size_t)(1 * 16 + bg) * 128 + row) * 128 + c8 * 8); }
            *(LAS v4u*)(KT + row * P + c8 * 16) = kk; *(LAS v4u*)(VT + row * P + c8 * 16) = vv; }
        for (int k = 0; k < 4; ++k) {
            const int q0 = (qg * 4 + k) * 32, h = gq * 4 + (w >> 1), ql = (w & 1) * 16 + i16, spos = q0 + ql;
            bf16x8 qf[4];
#pragma unroll
            for (int ks = 0; ks < 4; ++ks) qf[ks] = *(const bf16x8*)(proj + (size_t)(b * NS + spos) * CD_INP + h * 128 + 32 * ks + 8 * g);
            __syncthreads();
            const int nvalid = spos >= 31 ? ((spos - 31) >> 4) + 1 : 0;
            f32x4 sc[8]; float mx = -1e30f;
#pragma unroll
            for (int mt = 0; mt < 8; ++mt) { sc[mt] = (f32x4){0.f, 0.f, 0.f, 0.f};
#pragma unroll
                for (int ks = 0; ks < 4; ++ks) { const bf16x8 kf = *(const LAS bf16x8*)(KT + (16 * mt + i16) * P + (32 * ks + 8 * g) * 2); sc[mt] = __builtin_amdgcn_mfma_f32_16x16x32_bf16(kf, qf[ks], sc[mt], 0, 0, 0); }
#pragma unroll
                for (int r = 0; r < 4; ++r) { const bool ok = (16 * mt + 4 * g + r) < nvalid; const float x = ok ? sc[mt][r] * sscale : -1e30f; sc[mt][r] = x; mx = fmaxf(mx, x); } }
            mx = fmaxf(mx, __shfl_xor(mx, 16)); mx = fmaxf(mx, __shfl_xor(mx, 32));
            float ps = 0.f;
#pragma unroll
            for (int mt = 0; mt < 8; ++mt)
#pragma unroll
                for (int r = 0; r < 4; ++r) { const bool ok = (16 * mt + 4 * g + r) < nvalid; const float pv = ok ? __builtin_amdgcn_exp2f(sc[mt][r] - mx) : 0.f; sc[mt][r] = pv; ps += pv; }
            ps += __shfl_xor(ps, 16); ps += __shfl_xor(ps, 32);
            const float inv = ps > 0.f ? 1.f / ps : 0.f;
#pragma unroll
            for (int mt = 0; mt < 8; ++mt)
#pragma unroll
                for (int r = 0; r < 4; ++r) sc[mt][r] *= inv;
            { LAS float* slab = PS + (w >> 2) * 4096 + ql * 128 + 4 * g;
              if (((w >> 1) & 1) == 0) {
#pragma unroll
                  for (int mt = 0; mt < 8; ++mt) *(LAS f32x4*)(slab + 16 * mt) = sc[mt]; }
              __syncthreads();
              if (((w >> 1) & 1) == 1) {
#pragma unroll
                  for (int mt = 0; mt < 8; ++mt) { const f32x4 t = *(const LAS f32x4*)(slab + 16 * mt); *(LAS f32x4*)(slab + 16 * mt) = t + sc[mt]; } } }
            f32x4 O[8];
#pragma unroll
            for (int nt = 0; nt < 8; ++nt) O[nt] = (f32x4){0.f, 0.f, 0.f, 0.f};
#pragma unroll
            for (int k2 = 0; k2 < 4; ++k2) { v4u wv; wv.x = pk2(sc[2 * k2][0], sc[2 * k2][1]); wv.y = pk2(sc[2 * k2][2], sc[2 * k2][3]); wv.z = pk2(sc[2 * k2 + 1][0], sc[2 * k2 + 1][1]); wv.w = pk2(sc[2 * k2 + 1][2], sc[2 * k2 + 1][3]);
                const bf16x8 pf = __builtin_bit_cast(bf16x8, wv);
#pragma unroll
                for (int nt = 0; nt < 8; ++nt) {
                    const v4i16_t a = __builtin_amdgcn_ds_read_tr16_b64_v4i16((LAS v4i16_t*)(VT + (32 * k2 + 4 * g + q4) * P + (16 * nt + 4 * p4) * 2));
                    const v4i16_t c = __builtin_amdgcn_ds_read_tr16_b64_v4i16((LAS v4i16_t*)(VT + (32 * k2 + 16 + 4 * g + q4) * P + (16 * nt + 4 * p4) * 2));
                    const bf16x8 vf = (bf16x8){a[0], a[1], a[2], a[3], c[0], c[1], c[2], c[3]};
                    O[nt] = __builtin_amdgcn_mfma_f32_16x16x32_bf16(pf, vf, O[nt], 0, 0, 0); } }
#pragma unroll
            for (int r = 0; r < 4; ++r) { const size_t m = (size_t)(b * NS + q0 + (w & 1) * 16 + 4 * g + r); const float gt = sigmoidf_(bf1(proj[m * CD_INP + 2560 + h * 3 + 0]));
#pragma unroll
                for (int nt = 0; nt < 8; ++nt) ocmp[m * 1024 + h * 128 + 16 * nt + i16] = gt * O[nt][r]; }
            __syncthreads();
#pragma unroll
            for (int qq = 0; qq < 4; ++qq) { const int qi = 4 * w + qq, s = q0 + qi, cur = s >> 6, j = lane & 31;
                float imp = 0.f;
#pragma unroll
                for (int kk = 0; kk < 4; ++kk) { const int n1 = 4 * j + kk; if (n1 <= 126) imp += PS[qi * 128 + n1] + PS[4096 + qi * 128 + n1]; const int n2 = 4 * j - 1 + kk; if (n2 >= 0 && n2 <= 126) imp += PS[qi * 128 + n2] + PS[4096 + qi * 128 + n2]; }
                const bool forced = (j == 0) || (j == cur) || (j == cur - 1);
                const float score = forced ? 1e4f : ((j * 64 <= s) ? imp : -1e30f);
                int rk = 0;
                for (int jj = 0; jj < 32; ++jj) { const float ov = __shfl(score, jj); rk += ((ov > score) || (ov == score && jj < j)) ? 1 : 0; }
                const bool sel = (lane < 32) && (rk < 16) && (j <= cur);
                const unsigned long long bal = __ballot(sel);
                if (lane == 0) selm[(size_t)(b * NS + s) * 2 + gq] = (unsigned)bal; }
        }
    }
}

namespace fa {
typedef short v4i16_t __attribute__((ext_vector_type(4)));
struct Src { const bf16* k1; size_t ks1; const bf16* k2; size_t ks2; const bf16* v; size_t vs; };
template <int DQK> struct Cfg { static constexpr int KPITCH = (DQK + 8) * 2, KBYTES = 64 * KPITCH, VPITCH = 272, VBYTES = 64 * VPITCH, BUF = KBYTES + VBYTES, NKS = DQK / 32, KCH = DQK / 8, NKR = DQK / 64; };

template <int DQK> struct TileOff { unsigned gk[Cfg<DQK>::NKR], gv[2], lk[Cfg<DQK>::NKR], lv[2]; };
template <int DQK>
__device__ __forceinline__ void tile_offsets(const Src& S, int tid, TileOff<DQK>& T) {
#pragma unroll
    for (int i = 0; i < 2; ++i) { const int c = tid + 512 * i, row = c >> 4, c8 = c & 15;
        T.gk[i] = (unsigned)(row * (int)S.ks1 + c8 * 8) * 2u; T.gv[i] = (unsigned)(row * (int)S.vs + c8 * 8) * 2u;
        T.lk[i] = (unsigned)(row * Cfg<DQK>::KPITCH + c8 * 16); T.lv[i] = (unsigned)(Cfg<DQK>::KBYTES + row * Cfg<DQK>::VPITCH + c8 * 16); }
    if (DQK == 192) { const int row = tid >> 3, c8 = tid & 7; T.gk[Cfg<DQK>::NKR - 1] = (unsigned)(row * (int)S.ks2 + c8 * 8) * 2u; T.lk[Cfg<DQK>::NKR - 1] = (unsigned)(row * Cfg<DQK>::KPITCH + 256 + c8 * 16); }
}
template <int DQK>
__device__ __forceinline__ void load_tile(const Src& S, int k0, const TileOff<DQK>& T, v4u (&kr)[Cfg<DQK>::NKR], v4u (&vr)[2]) {
    const char* kb1 = (const char*)S.k1 + (size_t)k0 * S.ks1 * 2; const char* vb = (const char*)S.v + (size_t)k0 * S.vs * 2;
#pragma unroll
    for (int i = 0; i < 2; ++i) { kr[i] = *(const v4u*)(kb1 + T.gk[i]); vr[i] = *(const v4u*)(vb + T.gv[i]); }
    if (DQK == 192) { const char* kb2 = (const char*)S.k2 + (size_t)k0 * S.ks2 * 2; kr[Cfg<DQK>::NKR - 1] = *(const v4u*)(kb2 + T.gk[Cfg<DQK>::NKR - 1]); }
}
template <int DQK>
__device__ __forceinline__ void store_tile(LAS unsigned char* buf, const TileOff<DQK>& T, const v4u (&kr)[Cfg<DQK>::NKR], const v4u (&vr)[2]) {
#pragma unroll
    for (int i = 0; i < Cfg<DQK>::NKR; ++i) *(LAS v4u*)(buf + T.lk[i]) = kr[i];
#pragma unroll
    for (int i = 0; i < 2; ++i) *(LAS v4u*)(buf + T.lv[i]) = vr[i];
}
struct RowState { int spos; unsigned rowmask; float m_run, l_run; };
template <int MODE> __device__ __forceinline__ bool group_needs(int t, const RowState& R) {
    bool row_any = (t * 64 <= R.spos);
    if (MODE == 1) row_any = row_any && ((R.rowmask >> t) & 1u);
    if (MODE == 2) row_any = row_any && (t * 64 + 63 + 512 > R.spos);
    return __ballot(row_any) != 0ull;
}
template <int MODE>
__device__ __forceinline__ void softmax_group(f32x4 (&sc)[4], int t, RowState& R, float sscale, f32x4 (&O)[8], bf16x8 (&pf)[2], int g) {
    float mx = -1e30f;
#pragma unroll
    for (int mt = 0; mt < 4; ++mt)
#pragma unroll
        for (int r = 0; r < 4; ++r) { const int kp = t * 64 + 16 * mt + 4 * g + r; bool ok = kp <= R.spos;
            if (MODE == 1) ok = ok && ((R.rowmask >> t) & 1u);
            if (MODE == 2) ok = ok && (kp + 512 > R.spos);
            const float x = ok ? sc[mt][r] * sscale : -3e38f; sc[mt][r] = x; mx = fmaxf(mx, x); }
    mx = fmaxf(mx, -1e30f);
    mx = fmaxf(mx, __shfl_xor(mx, 16)); mx = fmaxf(mx, __shfl_xor(mx, 32));
    if (__ballot(mx > R.m_run + 8.0f) != 0ull) {
        const float m_new = fmaxf(R.m_run, mx), alpha = __builtin_amdgcn_exp2f(R.m_run - m_new); R.m_run = m_new;
        R.l_run *= alpha;
        float ar[4];
#pragma unroll
        for (int r = 0; r < 4; ++r) ar[r] = __shfl(alpha, 4 * g + r);
#pragma unroll
        for (int nt = 0; nt < 8; ++nt)
#pragma unroll
            for (int r = 0; r < 4; ++r) O[nt][r] *= ar[r];
    }
    float ps = 0.f;
#pragma unroll
    for (int mt = 0; mt < 4; ++mt)
#pragma unroll
        for (int r = 0; r < 4; ++r) { const float pv = __builtin_amdgcn_exp2f(sc[mt][r] - R.m_run); sc[mt][r] = pv; ps += pv; }
    R.l_run += ps;
#pragma unroll
    for (int k2 = 0; k2 < 2; ++k2) { v4u w; w.x = pk2(sc[2 * k2][0], sc[2 * k2][1]); w.y = pk2(sc[2 * k2][2], sc[2 * k2][3]); w.z = pk2(sc[2 * k2 + 1][0], sc[2 * k2 + 1][1]); w.w = pk2(sc[2 * k2 + 1][2], sc[2 * k2 + 1][3]);
        pf[k2] = __builtin_bit_cast(bf16x8, w); }
}
template <int DQK, int MODE>
__device__ __forceinline__ void fa_compute(LAS unsigned char* kb, LAS unsigned char* vb, const bf16x8 (&qf0)[Cfg<DQK>::NKS], const bf16x8 (&qf1)[Cfg<DQK>::NKS], int t, RowState& R0, RowState& R1, float sscale,
                                           f32x4 (&O0)[8], f32x4 (&O1)[8], int i16, int g, int q4, int p4) {
    typedef Cfg<DQK> C;
    const bool n0 = group_needs<MODE>(t, R0), n1 = group_needs<MODE>(t, R1);
    if (!n0 && !n1) return;
    f32x4 s0[4], s1[4];
#pragma unroll
    for (int mt = 0; mt < 4; ++mt) { s0[mt] = (f32x4){0.f, 0.f, 0.f, 0.f}; s1[mt] = (f32x4){0.f, 0.f, 0.f, 0.f};
#pragma unroll
        for (int ks = 0; ks < C::NKS; ++ks) { const bf16x8 kf = *(const LAS bf16x8*)(kb + (16 * mt + i16) * C::KPITCH + (32 * ks + 8 * g) * 2);
            s0[mt] = __builtin_amdgcn_mfma_f32_16x16x32_bf16(kf, qf0[ks], s0[mt], 0, 0, 0);
            s1[mt] = __builtin_amdgcn_mfma_f32_16x16x32_bf16(kf, qf1[ks], s1[mt], 0, 0, 0); } }
    bf16x8 p0[2], p1[2];
    if (n0) softmax_group<MODE>(s0, t, R0, sscale, O0, p0, g); else { p0[0] = (bf16x8){0, 0, 0, 0, 0, 0, 0, 0}; p0[1] = p0[0]; }
    if (n1) softmax_group<MODE>(s1, t, R1, sscale, O1, p1, g); else { p1[0] = (bf16x8){0, 0, 0, 0, 0, 0, 0, 0}; p1[1] = p1[0]; }
#pragma unroll
    for (int nt = 0; nt < 8; ++nt)
#pragma unroll
        for (int k2 = 0; k2 < 2; ++k2) {
            const v4i16_t a = __builtin_amdgcn_ds_read_tr16_b64_v4i16((LAS v4i16_t*)(vb + (32 * k2 + 4 * g + q4) * C::VPITCH + (16 * nt + 4 * p4) * 2));
            const v4i16_t b = __builtin_amdgcn_ds_read_tr16_b64_v4i16((LAS v4i16_t*)(vb + (32 * k2 + 16 + 4 * g + q4) * C::VPITCH + (16 * nt + 4 * p4) * 2));
            const bf16x8 vf = (bf16x8){a[0], a[1], a[2], a[3], b[0], b[1], b[2], b[3]};
            O0[nt] = __builtin_amdgcn_mfma_f32_16x16x32_bf16(p0[k2], vf, O0[nt], 0, 0, 0);
            O1[nt] = __builtin_amdgcn_mfma_f32_16x16x32_bf16(p1[k2], vf, O1[nt], 0, 0, 0); }
}
template <int DQK, int MODE>
__device__ __forceinline__ void fa_pass(LAS unsigned char* lds, const Src& S, const bf16x8 (&qf0)[Cfg<DQK>::NKS], const bf16x8 (&qf1)[Cfg<DQK>::NKS], unsigned tmask, RowState& R0, RowState& R1, float sscale,
                                        f32x4 (&O0)[8], f32x4 (&O1)[8], int tid, int lane) {
    typedef Cfg<DQK> C;
    const int i16 = lane & 15, g = lane >> 4, q4 = (lane & 15) >> 2, p4 = lane & 3;
#pragma unroll
    for (int nt = 0; nt < 8; ++nt) { O0[nt] = (f32x4){0.f, 0.f, 0.f, 0.f}; O1[nt] = (f32x4){0.f, 0.f, 0.f, 0.f}; }
    R0.m_run = -1e30f; R0.l_run = 0.f; R1.m_run = -1e30f; R1.l_run = 0.f;
    unsigned rem = tmask;
    if (rem == 0u) return;
    v4u kr[C::NKR], vr[2]; TileOff<DQK> TO; tile_offsets<DQK>(S, tid, TO);
    int t = __builtin_ctz(rem); rem &= rem - 1u;
    load_tile<DQK>(S, t * 64, TO, kr, vr);
    __syncthreads();
    store_tile<DQK>(lds, TO, kr, vr);
    __syncthreads();
    int cur = 0;
    for (;;) {
        const bool has_next = rem != 0u; int tn = 0;
        if (has_next) { tn = __builtin_ctz(rem); rem &= rem - 1u; load_tile<DQK>(S, tn * 64, TO, kr, vr); }
        LAS unsigned char* kb = lds + cur * C::BUF;
        fa_compute<DQK, MODE>(kb, kb + C::KBYTES, qf0, qf1, t, R0, R1, sscale, O0, O1, i16, g, q4, p4);
        if (has_next) store_tile<DQK>(lds + (cur ^ 1) * C::BUF, TO, kr, vr);
        __syncthreads();
        if (!has_next) break;
        t = tn; cur ^= 1;
    }
}
__device__ __forceinline__ void row_inv(float l_run, int lane, float (&inv)[4]) {
    float l = l_run; l += __shfl_xor(l, 16); l += __shfl_xor(l, 32);
    const float li = l > 0.f ? 1.f / l : 0.f; const int g = lane >> 4;
#pragma unroll
    for (int r = 0; r < 4; ++r) inv[r] = __shfl(li, 4 * g + r);
}
__device__ __forceinline__ void rope_qpe(bf16x8& f4, bf16x8& f5, float pz, int g4) {
    v4u w1 = __builtin_bit_cast(v4u, f4), w2 = __builtin_bit_cast(v4u, f5); float x1[8], x2[8]; unpack8(w1, x1); unpack8(w2, x2);
#pragma unroll
    for (int jj = 0; jj < 8; ++jj) { const float invf = exp2f(-(float)(8 * g4 + jj) * (13.287712379549449f / 32.f)); float sn, cs; fast_sincos(pz * invf, sn, cs);
        const float a = x1[jj] * cs - x2[jj] * sn, c = x1[jj] * sn + x2[jj] * cs; x1[jj] = a; x2[jj] = c; }
    w1.x = pk2(x1[0], x1[1]); w1.y = pk2(x1[2], x1[3]); w1.z = pk2(x1[4], x1[5]); w1.w = pk2(x1[6], x1[7]);
    w2.x = pk2(x2[0], x2[1]); w2.y = pk2(x2[2], x2[3]); w2.z = pk2(x2[4], x2[5]); w2.w = pk2(x2[6], x2[7]);
    f4 = __builtin_bit_cast(bf16x8, w1); f5 = __builtin_bit_cast(bf16x8, w2);
}
}

__device__ __forceinline__ void p_attn_mla(Frame& F, unsigned* queue) {
    const bf16* proj = (const bf16*)(F.ws + WS_PROJ); bf16* mixin = (bf16*)(F.ws + WS_MIXIN); const float* ocmp = (const float*)(F.ws + WS_OCMP); const unsigned* selm = (const unsigned*)(F.ws + WS_SELM);
    const bf16* qmla = (const bf16*)(F.ws + WS_QMLA); const bf16* kvu = (const bf16*)(F.ws + WS_KVU); const bf16* krot = (const bf16*)(F.ws + WS_KROT);
    volatile LAS unsigned* qslot = (volatile LAS unsigned*)(F.lds + LDSCTL_OFF);
    const int lane = F.lane, w = F.wave, i16 = lane & 15, g4 = lane >> 4;
    for (;;) {
        __syncthreads();
        if (F.tid == 0) qslot[0] = atomicAdd(queue, 1u);
        __syncthreads();
        const int u = __builtin_amdgcn_readfirstlane((int)qslot[0]);
        if (u >= 512) break;
        {
            const int qt = 7 - (u >> 6), bh = u & 63, b = bh >> 3, h = bh & 7, q0 = qt * 256;
            fa::RowState R0, R1; R0.spos = q0 + 32 * w + i16; R1.spos = R0.spos + 16; R0.rowmask = 0u; R1.rowmask = 0u;
            bf16x8 qf0[6], qf1[6];
#pragma unroll
            for (int ks = 0; ks < 6; ++ks) { qf0[ks] = *(const bf16x8*)(qmla + (size_t)(b * NS + R0.spos) * 1536 + h * 192 + 32 * ks + 8 * g4); qf1[ks] = *(const bf16x8*)(qmla + (size_t)(b * NS + R1.spos) * 1536 + h * 192 + 32 * ks + 8 * g4); }
            fa::rope_qpe(qf0[4], qf0[5], (float)((const int*)kin(1))[b * NS + R0.spos], g4);
            fa::rope_qpe(qf1[4], qf1[5], (float)((const int*)kin(1))[b * NS + R1.spos], g4);
            fa::Src S; S.k1 = kvu + (size_t)(b * NS) * 2048 + h * 256; S.ks1 = 2048; S.k2 = krot + (size_t)(b * NS) * 64; S.ks2 = 64; S.v = S.k1 + 128; S.vs = 2048;
            const int last = (q0 + 255) >> 6; const unsigned tmask = last >= 31 ? 0xffffffffu : ((1u << (last + 1)) - 1u);
            f32x4 O0[8], O1[8];
            fa::fa_pass<192, 0>(F.lds, S, qf0, qf1, tmask, R0, R1, 0.07216878364870322f * 1.4426950408889634f, O0, O1, F.tid, lane);
            float inv[4];
            fa::row_inv(R0.l_run, lane, inv);
#pragma unroll
            for (int r = 0; r < 4; ++r) { bf16* orow = mixin + (size_t)(b * NS + q0 + 32 * w + 4 * g4 + r) * ND + 1024 + h * 128 + i16;
#pragma unroll
                for (int nt = 0; nt < 8; ++nt) orow[16 * nt] = (bf16)f2bf(O0[nt][r] * inv[r]); }
            fa::row_inv(R1.l_run, lane, inv);
#pragma unroll
            for (int r = 0; r < 4; ++r) { bf16* orow = mixin + (size_t)(b * NS + q0 + 32 * w + 16 + 4 * g4 + r) * ND + 1024 + h * 128 + i16;
#pragma unroll
                for (int nt = 0; nt < 8; ++nt) orow[16 * nt] = (bf16)f2bf(O1[nt][r] * inv[r]); }
        }
    }
    (void)proj; (void)ocmp; (void)selm;
}
__device__ __forceinline__ void p_attn_nsa(Frame& F, unsigned* queue) {
    const bf16* proj = (const bf16*)(F.ws + WS_PROJ); bf16* mixin = (bf16*)(F.ws + WS_MIXIN); const float* ocmp = (const float*)(F.ws + WS_OCMP); const unsigned* selm = (const unsigned*)(F.ws + WS_SELM);
    const bf16* qmla = (const bf16*)(F.ws + WS_QMLA); const bf16* kvu = (const bf16*)(F.ws + WS_KVU); const bf16* krot = (const bf16*)(F.ws + WS_KROT);
    volatile LAS unsigned* qslot = (volatile LAS unsigned*)(F.lds + LDSCTL_OFF);
    const int lane = F.lane, w = F.wave, i16 = lane & 15, g4 = lane >> 4;
    for (;;) {
        __syncthreads();
        if (F.tid == 0) qslot[0] = atomicAdd(queue, 1u);
        __syncthreads();
        const int u = __builtin_amdgcn_readfirstlane((int)qslot[0]);
        if (u >= 512) break;
        {
            const int v = u;
            const int qt = 31 - (v >> 4), bg = v & 15, b = bg >> 1, gq = bg & 1, q0 = qt * 64;
            const int h = gq * 4 + (w >> 1), qb = q0 + (w & 1) * 32;
            fa::RowState R0, R1; R0.spos = qb + i16; R1.spos = qb + 16 + i16;
            bf16x8 qf0[4], qf1[4];
#pragma unroll
            for (int ks = 0; ks < 4; ++ks) { qf0[ks] = *(const bf16x8*)(proj + (size_t)(b * NS + R0.spos) * CD_INP + h * 128 + 32 * ks + 8 * g4); qf1[ks] = *(const bf16x8*)(proj + (size_t)(b * NS + R1.spos) * CD_INP + h * 128 + 32 * ks + 8 * g4); }
            R0.rowmask = selm[(size_t)(b * NS + R0.spos) * 2 + gq]; R1.rowmask = selm[(size_t)(b * NS + R1.spos) * 2 + gq];
            unsigned um = selm[(size_t)(b * NS + q0 + lane) * 2 + gq];
#pragma unroll
            for (int o = 1; o < 64; o <<= 1) um |= (unsigned)__shfl_xor((int)um, o);
            um = (unsigned)__builtin_amdgcn_readfirstlane((int)um);
            const bf16* base = proj + (size_t)(b * NS) * CD_INP;
            const float sscale = 0.08838834764831845f * 1.4426950408889634f;
            f32x4 O0[8], O1[8]; float inv[4];
            { fa::Src S; S.k1 = base + 1024 + ((1 * 2 + 0) * 2 + gq) * 128; S.ks1 = CD_INP; S.k2 = nullptr; S.ks2 = 0; S.v = base + 1024 + ((1 * 2 + 1) * 2 + gq) * 128; S.vs = CD_INP;
              fa::fa_pass<128, 1>(F.lds, S, qf0, qf1, um, R0, R1, sscale, O0, O1, F.tid, lane); }
            fa::row_inv(R0.l_run, lane, inv);
#pragma unroll
            for (int r = 0; r < 4; ++r) { const size_t m = (size_t)(b * NS + qb + 4 * g4 + r); const float g1 = sigmoidf_(bf1(proj[m * CD_INP + 2560 + h * 3 + 1])) * inv[r];
#pragma unroll
                for (int nt = 0; nt < 8; ++nt) mixin[m * ND + h * 128 + 16 * nt + i16] = (bf16)f2bf(ocmp[m * 1024 + h * 128 + 16 * nt + i16] + O0[nt][r] * g1); }
            fa::row_inv(R1.l_run, lane, inv);
#pragma unroll
            for (int r = 0; r < 4; ++r) { const size_t m = (size_t)(b * NS + qb + 16 + 4 * g4 + r); const float g1 = sigmoidf_(bf1(proj[m * CD_INP + 2560 + h * 3 + 1])) * inv[r];
#pragma unroll
                for (int nt = 0; nt < 8; ++nt) mixin[m * ND + h * 128 + 16 * nt + i16] = (bf16)f2bf(ocmp[m * 1024 + h * 128 + 16 * nt + i16] + O1[nt][r] * g1); }
            { fa::Src S; S.k1 = base + 1024 + ((2 * 2 + 0) * 2 + gq) * 128; S.ks1 = CD_INP; S.k2 = nullptr; S.ks2 = 0; S.v = base + 1024 + ((2 * 2 + 1) * 2 + gq) * 128; S.vs = CD_INP;
              const int klo = q0 - 511 > 0 ? q0 - 511 : 0, tlo = klo >> 6, thi = (q0 + 63) >> 6;
              const unsigned hm = thi >= 31 ? 0xffffffffu : ((1u << (thi + 1)) - 1u); const unsigned tmask = hm & ~((1u << tlo) - 1u);
              fa::fa_pass<128, 2>(F.lds, S, qf0, qf1, tmask, R0, R1, sscale, O0, O1, F.tid, lane); }
            fa::row_inv(R0.l_run, lane, inv);
#pragma unroll
            for (int r = 0; r < 4; ++r) { const size_t m = (size_t)(b * NS + qb + 4 * g4 + r); const float g2 = sigmoidf_(bf1(proj[m * CD_INP + 2560 + h * 3 + 2])) * inv[r];
#pragma unroll
                for (int nt = 0; nt < 8; ++nt) { bf16* op = mixin + m * ND + h * 128 + 16 * nt + i16; *op = (bf16)f2bf(bf1(*op) + O0[nt][r] * g2); } }
            fa::row_inv(R1.l_run, lane, inv);
#pragma unroll
            for (int r = 0; r < 4; ++r) { const size_t m = (size_t)(b * NS + qb + 16 + 4 * g4 + r); const float g2 = sigmoidf_(bf1(proj[m * CD_INP + 2560 + h * 3 + 2])) * inv[r];
#pragma unroll
                for (int nt = 0; nt < 8; ++nt) { bf16* op = mixin + m * ND + h * 128 + 16 * nt + i16; *op = (bf16)f2bf(bf1(*op) + O1[nt][r] * g2); } }
        }
    }
    (void)qmla; (void)kvu; (void)krot;
}

constexpr int NPHASE = 33;


#define IN(k) (lo <= (k) && (k) < hi)
#define SEAM(k) do { if (IN(k) && IN((k) + 1)) { if (MK_ONE_LAUNCH) xcd_barrier(bar); else if (F.tid == 0) __hip_atomic_store(F.ctl + CW_TMO, 0xBAD0u | (unsigned)(k), __ATOMIC_RELAXED, __HIP_MEMORY_SCOPE_AGENT); \
    if (MK_PROBE_PHASE >= 0 && blockIdx.x == 0 && F.tid == 0) { if ((k) == MK_PROBE_PHASE - 1) ((volatile LAS unsigned long long*)(F.lds + LDSCTL_OFF + 64))[0] = __builtin_amdgcn_s_memrealtime(); \
        if ((k) == MK_PROBE_LAST) ((volatile LAS unsigned long long*)(F.lds + LDSCTL_OFF + 64))[1] = __builtin_amdgcn_s_memrealtime(); } } } while (0)
template <int l>
__device__ __forceinline__ void layer_body(Frame& F, const XcdBarrier& bar, const int lo, const int hi) {
    unsigned char* ws = F.ws;
    bf16* const XB0 = (bf16*)(ws + WS_XB0); bf16* const X1B = (bf16*)(ws + WS_X1B); bf16* const X2B = (bf16*)(ws + WS_X2B);
    bf16* const PROJ = (bf16*)(ws + WS_PROJ); bf16* const MIXIN = (bf16*)(ws + WS_MIXIN); bf16* const MIXO = (bf16*)(ws + WS_MIXO);
    bf16* const HB = (bf16*)(ws + WS_H); bf16* const Y2 = (bf16*)(ws + WS_Y2);
        const int pb = 1 + l * 16;
        const bf16* xin = l == 0 ? XB0 : X2B;
        if (IN(pb + 0)) {
            if (l == 0) { pg8::DenseProb P; P.init(xin, ND, (const bf16*)(ws + WS_WABIN), NT, AB_IN, ND, F.G, (int)blockIdx.x); pg8::EpiBf16 E{PROJ, AB_IN};
                pg8::gemm_phase<pg8::EpiBf16, pg8::DenseProb, true>(F.lds, P, E); }
            else { pg8::DenseProb P; P.init(xin, ND, (const bf16*)(ws + WS_WCDIN), NT, CD_INP, ND, F.G, (int)blockIdx.x); pg8::EpiBf16 E{PROJ, CD_INP};
                pg8::gemm_phase<pg8::EpiBf16, pg8::DenseProb, true>(F.lds, P, E); }
        } SEAM(pb + 0);
        if (l == 0) {
            if (IN(pb + 1)) { p_pool_rope(F); } SEAM(pb + 1);
            if (IN(pb + 2)) { if (blockIdx.x < NB * 6) p_retention_mfma(F, (int)blockIdx.x); __syncthreads(); p_moe_weights_queue(F, F.ctl + CW_CNT + 320); } SEAM(pb + 2);
            SEAM(pb + 3); SEAM(pb + 4); SEAM(pb + 5);
        } else {
            if (IN(pb + 1)) { p_l1_thin_a(F); } SEAM(pb + 1);
            if (IN(pb + 2)) {
                if (blockIdx.x < 16) { pg8::CmpProb P; P.K = 4096; P.Abase = (const char*)(ws + WS_CMPKV); P.Bt = (const char*)(ws + WS_CW1); P.G = 16; P.c = (int)blockIdx.x;
                  pg8::EpiF32 E{(float*)(ws + WS_HID), 256, (const float*)(ws + WS_CMPB)};
                  pg8::gemm_phase<pg8::EpiF32, pg8::CmpProb, true>(F.lds, P, E); }
                else {
                { pg8::DenseProb P; P.init((const bf16*)(ws + WS_CQN), 384, (const bf16*)(ws + WS_WUQ), NT, 1536, 384, F.G - 16, (int)blockIdx.x - 16); pg8::EpiBf16 E{(bf16*)(ws + WS_QMLA), 1536};
                  pg8::gemm_phase<pg8::EpiBf16, pg8::DenseProb, true>(F.lds, P, E); }
                { pg8::DenseProb P; P.init((const bf16*)(ws + WS_CKVN), 512, (const bf16*)(ws + WS_WUKV), NT, 2048, 512, F.G - 16, (int)blockIdx.x - 16); pg8::EpiBf16 E{(bf16*)(ws + WS_KVU), 2048};
                  pg8::gemm_phase<pg8::EpiBf16, pg8::DenseProb, true>(F.lds, P, E); }
                }
            } SEAM(pb + 2);
            if (IN(pb + 3)) { p_l1_thin_b(F); } SEAM(pb + 3);
            if (IN(pb + 4)) { p_nsa_cmp_mfma(F); } SEAM(pb + 4);
            if (IN(pb + 5)) { p_attn_mla(F, F.ctl + CW_CNT + 256); p_attn_nsa(F, F.ctl + CW_CNT + 257); } SEAM(pb + 5);
        }
        if (IN(pb + 6)) { pg8::DenseProb P; P.init(MIXIN, ND, (const bf16*)(ws + (l == 0 ? WS_WABOUT : WS_WCDOUT)), NT, ND, ND, F.G, (int)blockIdx.x); pg8::EpiBf16 E{MIXO, ND};
            pg8::gemm_phase<pg8::EpiBf16, pg8::DenseProb, true>(F.lds, P, E); } SEAM(pb + 6);
        if (IN(pb + 7)) { p_ln1(F, xin, MIXO, kin(15) + l * ND, kin(16) + l * ND, X1B); } SEAM(pb + 7);
        if (IN(pb + 8)) { pg8::DenseProb P; P.init(X1B, ND, (const bf16*)(ws + WS_RT + (size_t)l * MiB), NT, 256, ND, F.G, (int)blockIdx.x); pg8::EpiF32 E{(float*)(ws + WS_LOGITS), 256, nullptr};
            pg8::gemm_phase<pg8::EpiF32, pg8::DenseProb, true>(F.lds, P, E); } SEAM(pb + 8);
        if (IN(pb + 9)) { p_route(F, l); } SEAM(pb + 9);
        if (IN(pb + 10)) { p_scatter(F, l); } SEAM(pb + 10);
        if (IN(pb + 11)) { load_offsets(F, l); const LAS int* tab = (const LAS int*)(F.lds + TAB_OFF);
            pg8::MoeUpProb P; P.K = ND; P.Abase = (const char*)X1B; P.W13 = (const char*)(ws + WS_W13 + (size_t)l * WS_MOE_LSTRIDE); P.sorted = (const int*)(ws + WS_SORTED); P.tile_e = tab + 160; P.ntiles = __builtin_amdgcn_readfirstlane(tab[65]);
            P.nunits = (P.ntiles + NT / 256) * 4; P.G = F.G; P.c = (int)blockIdx.x;
            pg8::EpiSwiglu E{HB};
            pg8::gemm_phase<pg8::EpiSwiglu, pg8::MoeUpProb, true>(F.lds, P, E); } SEAM(pb + 11);
        if (IN(pb + 12)) { load_offsets(F, l); const LAS int* tab = (const LAS int*)(F.lds + TAB_OFF);
            pg8::MoeDownProb P; P.K = EFF; P.Abase = (const char*)HB; P.W2 = (const char*)(ws + WS_W2 + (size_t)l * WS_MOE_LSTRIDE); P.tile_e = tab + 160; P.ntiles = __builtin_amdgcn_readfirstlane(tab[65]);
            P.nunits = (P.ntiles + NT / 256) * 8; P.G = F.G; P.c = (int)blockIdx.x;
            pg8::EpiBf16 E{Y2, ND};
            pg8::gemm_phase<pg8::EpiBf16, pg8::MoeDownProb, true>(F.lds, P, E); } SEAM(pb + 12);
        if (IN(pb + 13)) { p_combine_ln2(F, X1B, Y2, (const int*)(ws + WS_SLOT), (const float*)(ws + WS_WSEL), kin(17) + l * ND, kin(18) + l * ND, l == 0 ? X2B : nullptr, l == 0 ? nullptr : F.out); } SEAM(pb + 13);
        SEAM(pb + 14); SEAM(pb + 15);
    }
__global__ void __launch_bounds__(NWAVES * 64, 2) mk_fwd(Args args) {
    extern __shared__ __attribute__((aligned(16))) unsigned char lds[];
    Frame F;
    F.lds = (LAS unsigned char*)lds;
    F.MISC = (volatile LAS unsigned*)(F.lds + MISC_OFF);
    F.tid = threadIdx.x; F.lane = F.tid & 63; F.wave = __builtin_amdgcn_readfirstlane(F.tid >> 6);
    F.G = gridDim.x; { const int bx = blockIdx.x; F.vcu = (F.G % 8 == 0) ? (bx % 8) * (F.G / 8) + bx / 8 : bx; }
    F.gw = F.vcu * NWAVES + F.wave; F.NGW = F.G * NWAVES;
    F.ws = args.ws; F.ctl = (unsigned*)(args.ws + WS_CTL); F.out = args.out;
    for (int u = F.tid; u < (LDS_BYTES - LDSCTL_OFF) / 4; u += NWAVES * 64) ((LAS unsigned*)(F.lds + LDSCTL_OFF))[u] = 0u;
    __syncthreads();
    XcdBarrier bar; bar.bar = F.ctl + CW_BAR; bar.x = 0; bar.st = nullptr;
    if (MK_ONE_LAUNCH) bar = xcd_barrier_post(F.ctl + CW_BAR, F.MISC + 8);
    const int lo = args.ph_lo, hi = args.ph_hi;
    if (MK_PROBE_PHASE == 0 && blockIdx.x == 0 && F.tid == 0) ((volatile LAS unsigned long long*)(F.lds + LDSCTL_OFF + 64))[0] = __builtin_amdgcn_s_memrealtime();
    unsigned char* ws = args.ws;
    bf16* const XB0 = (bf16*)(ws + WS_XB0); bf16* const X1B = (bf16*)(ws + WS_X1B); bf16* const X2B = (bf16*)(ws + WS_X2B);
    bf16* const PROJ = (bf16*)(ws + WS_PROJ); bf16* const MIXIN = (bf16*)(ws + WS_MIXIN); bf16* const MIXO = (bf16*)(ws + WS_MIXO);
    bf16* const HB = (bf16*)(ws + WS_H); bf16* const Y2 = (bf16*)(ws + WS_Y2);

    if (IN(0)) { p_prologue(F); } SEAM(0);

    layer_body<0>(F, bar, lo, hi);
    layer_body<1>(F, bar, lo, hi);
    if (MK_PROBE_PHASE >= 0 && blockIdx.x == 0 && F.tid == 0) {
        volatile LAS unsigned long long* tsl = (volatile LAS unsigned long long*)(F.lds + LDSCTL_OFF + 64);
        if (MK_PROBE_LAST == 30) tsl[1] = __builtin_amdgcn_s_memrealtime();
        const unsigned long long span = (tsl[1] - tsl[0]) * MK_PROBE_AMP, t0 = __builtin_amdgcn_s_memrealtime();
        while (__builtin_amdgcn_s_memrealtime() - t0 < span) __builtin_amdgcn_s_sleep(8);
    }
#undef IN
#undef SEAM
}

extern "C" void kernel_launch(void* const* d_in, const int* in_sizes, int n_in, void* d_out, int out_size, void* d_ws, size_t ws_size, hipStream_t stream) {
    static int grid = 0;
    if (grid == 0) {
        if (n_in != 27 || in_sizes[0] != NT * ND || out_size != NT * ND || ws_size < WS_END) { fprintf(stderr, "kernel_launch: unexpected problem (n_in %d, in0 %d, out %d, ws %zu < %zu); nothing launched\n", n_in, n_in > 0 ? in_sizes[0] : -1, out_size, ws_size, (size_t)WS_END); grid = -1; return; }
        int dev = 0, cus = 0, per_cu = 0;
        if (hipGetDevice(&dev) != hipSuccess || hipDeviceGetAttribute(&cus, hipDeviceAttributeMultiprocessorCount, dev) != hipSuccess) { fprintf(stderr, "kernel_launch: device query failed\n"); grid = -1; return; }
        if (hipFuncSetAttribute((const void*)mk_fwd, hipFuncAttributeMaxDynamicSharedMemorySize, LDS_BYTES) != hipSuccess) { fprintf(stderr, "kernel_launch: hipFuncSetAttribute failed\n"); grid = -1; return; }
        if (hipOccupancyMaxActiveBlocksPerMultiprocessor(&per_cu, (const void*)mk_fwd, NWAVES * 64, LDS_BYTES) != hipSuccess || per_cu < 1) fprintf(stderr, "kernel_launch: note: occupancy query reports %d\n", per_cu);
        (void)hipGetLastError();
        grid = cus;
    }
    if (grid < 0) return;
    if (hipMemsetAsync((char*)d_ws + WS_CTL, 0, CTL_ZERO_BYTES, stream) != hipSuccess) { fprintf(stderr, "kernel_launch: memset failed\n"); return; }
    Args a{};
    for (int i = 0; i < 27; ++i) a.in[i] = (const float*)d_in[i];
    a.out = (float*)d_out; a.ws = (unsigned char*)d_ws;
#if MK_ONE_LAUNCH
    a.ph_lo = 0; a.ph_hi = NPHASE;
    hipLaunchKernelGGL(mk_fwd, dim3(grid), dim3(NWAVES * 64), LDS_BYTES, stream, a);
#else
    for (int p = 0; p < NPHASE; ++p) {
        const int lp = (p - 1) & 15;
        if (p >= 1) { const int l = (p - 1) >> 4; if (lp >= 14) continue; if (l == 0 && lp >= 3 && lp <= 5) continue; }
        a.ph_lo = p; a.ph_hi = p + 1;
        hipLaunchKernelGGL(mk_fwd, dim3(grid), dim3(NWAVES * 64), LDS_BYTES, stream, a);
    }
#endif
    const hipError_t le = hipPeekAtLastError();
    if (le != hipSuccess) fprintf(stderr, "kernel_launch: launch failed: %s\n", hipGetErrorName(le));
}
```

```cpp
#include <hip/hip_runtime.h>
#include <cstdio>
#include <cstdint>

#ifndef MK_ONE_LAUNCH
#define MK_ONE_LAUNCH 1
#endif
#ifndef MK_PROBE_PHASE
#define MK_PROBE_PHASE -1
#endif
#ifndef MK_PROBE_LAST
#define MK_PROBE_LAST MK_PROBE_PHASE
#endif
#ifndef MK_PROBE_AMP
#define MK_PROBE_AMP 4
#endif

#define GAS __attribute__((address_space(1)))
#define LAS __attribute__((address_space(3)))
typedef unsigned short bf16;
typedef unsigned v4u __attribute__((ext_vector_type(4)));
typedef unsigned v2u __attribute__((ext_vector_type(2)));
typedef float f32x4 __attribute__((ext_vector_type(4)));
typedef float f32x2 __attribute__((ext_vector_type(2)));
typedef short bf16x8 __attribute__((ext_vector_type(8)));

constexpr int NB = 8, NS = 2048, ND = 2048, NT = NB * NS;
constexpr float DN_ALPHA = 1.41421356237309505f;
constexpr float LN_EPS = 1e-5f, NORM_EPS = 1e-6f;
constexpr int AB_IN = 5120, CD_IN = 3544, CD_INP = 3584;
constexpr int NEXP = 64, EFF = 512;
constexpr int MAXROWS = NT * 8 + NEXP * 256;
constexpr int MAXTILES = MAXROWS / 256;
constexpr int SH_ROW0 = MAXROWS;

constexpr size_t MiB = 1u << 20;
constexpr size_t WS_CTL = 0, CTL_ZERO_BYTES = 1 * MiB;
constexpr size_t WS_TOPE = 1 * MiB, WS_WSEL = WS_TOPE + 512 * 1024, WS_SLOT = 2 * MiB, WS_SORTED = WS_SLOT + 512 * 1024;
constexpr size_t WS_CMPB = 3 * MiB + 256 * 1024, WS_SELM = 3 * MiB + 512 * 1024;
constexpr size_t WS_KVCMP = 4 * MiB;
constexpr size_t WS_HID = 6 * MiB;
constexpr size_t WS_WABIN = 16 * MiB, WS_WABOUT = 36 * MiB, WS_WCDIN = 44 * MiB, WS_WCDOUT = 58 * MiB, WS_WUQ = 66 * MiB, WS_WUKV = 68 * MiB, WS_CW1 = 70 * MiB, WS_RT = 72 * MiB;
constexpr size_t WS_W13 = 74 * MiB, WS_W2 = 334 * MiB, WS_MOE_LSTRIDE = 390 * MiB;
constexpr size_t WS_XB0 = 854 * MiB, WS_X2B = 854 * MiB, WS_X1B = 918 * MiB;
constexpr size_t WS_H = 982 * MiB, WS_Y2 = 1142 * MiB, WS_END = 1782 * MiB;
constexpr size_t WS_PROJ = 982 * MiB, WS_MIXIN = 1142 * MiB, WS_MIXO = 1206 * MiB;
constexpr size_t WS_QR = 1270 * MiB, WS_KR = 1294 * MiB;
constexpr size_t WS_CQN = 1270 * MiB, WS_CKVN = 1282 * MiB, WS_KROT = 1298 * MiB, WS_QMLA = 1302 * MiB, WS_KVU = 1350 * MiB, WS_CMPKV = 1414 * MiB, WS_OCMP = 1434 * MiB;
constexpr size_t WS_LOGITS = 1142 * MiB;
constexpr int CW_TMO = 0, CW_CODE = 1, CW_BAR = 4096, CW_CNT = 16384;

constexpr int RING_BYTES = 131072, LDSCTL_OFF = RING_BYTES, MISC_OFF = LDSCTL_OFF + 320, TAB_OFF = LDSCTL_OFF + 512;
constexpr int LDS_BYTES = 147456;
constexpr int NWAVES = 8;

#define LDS_WAIT() asm volatile("s_waitcnt lgkmcnt(0)" ::: "memory")
#define VM_WAIT() asm volatile("s_waitcnt vmcnt(0)" ::: "memory")
typedef __bf16 hwbf16x2 __attribute__((ext_vector_type(2)));
__device__ __forceinline__ unsigned pk2(float lo, float hi) { const f32x2 v = {lo, hi}; const hwbf16x2 b = __builtin_convertvector(v, hwbf16x2); return __builtin_bit_cast(unsigned, b); }
__device__ __forceinline__ unsigned f2bf(float f) { return pk2(f, 0.f) & 0xffffu; }
__device__ __forceinline__ void fast_sincos(float ang, float& sn, float& cs) { const float r = __builtin_amdgcn_fractf(ang * 0.15915494309189535f); sn = __builtin_amdgcn_sinf(r); cs = __builtin_amdgcn_cosf(r); }
__device__ __forceinline__ float bflo(unsigned w) { return __builtin_bit_cast(float, w << 16); }
__device__ __forceinline__ float bfhi(unsigned w) { return __builtin_bit_cast(float, w & 0xffff0000u); }
__device__ __forceinline__ float bf1(bf16 v) { return __builtin_bit_cast(float, ((unsigned)v) << 16); }
__device__ __forceinline__ float wave_sum(float v) {
#pragma unroll
    for (int o = 1; o < 64; o <<= 1) v += __shfl_xor(v, o);
    return v;
}
__device__ __forceinline__ float wave_max(float v) {
#pragma unroll
    for (int o = 1; o < 64; o <<= 1) v = fmaxf(v, __shfl_xor(v, o));
    return v;
}
__device__ __forceinline__ float sigmoidf_(float x) { return 1.0f / (1.0f + __expf(-x)); }
__device__ __forceinline__ float siluf_(float x) { return x / (1.0f + __expf(-x)); }
__device__ __forceinline__ void unpack8(const v4u w, float (&f)[8]) {
    f[0] = bflo(w.x); f[1] = bfhi(w.x); f[2] = bflo(w.y); f[3] = bfhi(w.y); f[4] = bflo(w.z); f[5] = bfhi(w.z); f[6] = bflo(w.w); f[7] = bfhi(w.w);
}

#define XB_TMO      128
#define XB_XCNT(j)  (256  + 64 * (j))
#define XB_XSUB(j)  (1280 + 64 * (j))
#define XB_XGEN(j)  (2304 + 64 * (j))
#define XB_TOP      3328
#define XB_TOPGEN   3392
#define XCD_BAR_WORDS 3456
#define XB_SPIN_CAP (1u << 18)
__device__ __forceinline__ unsigned xb_ld(unsigned* p)              { return __hip_atomic_load(p, __ATOMIC_RELAXED, __HIP_MEMORY_SCOPE_AGENT); }
__device__ __forceinline__ unsigned xb_add(unsigned* p, unsigned v) { return __hip_atomic_fetch_add(p, v, __ATOMIC_RELAXED, __HIP_MEMORY_SCOPE_AGENT); }
__device__ __forceinline__ unsigned xb_xcc_id() { return (unsigned)__builtin_amdgcn_s_getreg((3 << 11) | 20) & 0xFu; }
#define XB_SPIN(cond, bar) do { unsigned _sp = 0; while (cond) { __builtin_amdgcn_s_sleep(1); \
    if ((++_sp & 255u) == 0u) { if (xb_ld(&(bar)[XB_TMO])) break; if (_sp > XB_SPIN_CAP) { atomicAdd(&(bar)[XB_TMO], 1u); break; } } } } while (0)
struct XcdBarrier { unsigned* bar; unsigned x; volatile LAS unsigned* st; };
__device__ __forceinline__ XcdBarrier xcd_barrier_post(unsigned* bar, volatile LAS unsigned* st) {
    XcdBarrier b; b.bar = bar; b.x = xb_xcc_id(); b.st = st;
    if (threadIdx.x == 0) (void)xb_add(&bar[XB_XCNT(b.x)], 1u);
    return b;
}
__device__ __forceinline__ void xcd_barrier_complete(unsigned* bar, unsigned x, unsigned& nloc, unsigned& nx) {
    const unsigned G = gridDim.x * gridDim.y * gridDim.z;
    unsigned sum, cnt, mine, sp = 0u;
    for (;;) {
        sum = 0u; cnt = 0u; mine = 0u;
#pragma unroll
        for (unsigned j = 0; j < 16; ++j) { const unsigned c = xb_ld(&bar[XB_XCNT(j)]); sum += c; cnt += (c > 0u) ? 1u : 0u; mine = (j == x) ? c : mine; }
        if (sum == G) break;
        __builtin_amdgcn_s_sleep(1);
        if ((++sp & 255u) == 0u) { if (xb_ld(&bar[XB_TMO])) break; if (sp > XB_SPIN_CAP) { atomicAdd(&bar[XB_TMO], 1u); break; } }
    }
    nloc = mine > 0u ? mine : 1u; nx = cnt > 0u ? cnt : 1u;
}
__device__ __forceinline__ void xcd_barrier(const XcdBarrier& b) {
    asm volatile("s_waitcnt vmcnt(0)" ::: "memory");
    __syncthreads();
    if (threadIdx.x == 0) {
        unsigned* bar = b.bar;
        __builtin_amdgcn_s_waitcnt(0);
        unsigned nloc = b.st[0], nx = b.st[1];
        if (nloc == 0u) { xcd_barrier_complete(bar, b.x, nloc, nx); b.st[0] = nloc; b.st[1] = nx; }
        const unsigned old = xb_add(&bar[XB_XSUB(b.x)], 1u);
        const unsigned gen = old / nloc;
        if (old + 1u == (gen + 1u) * nloc) {
            __builtin_amdgcn_fence(__ATOMIC_RELEASE, "agent");
            asm volatile("s_waitcnt vmcnt(0)" ::: "memory");
            const unsigned og = xb_add(&bar[XB_TOP], 1u);
            const unsigned tg = og / nx;
            if (og + 1u == (tg + 1u) * nx) xb_add(&bar[XB_TOPGEN], 1u);
            else XB_SPIN(xb_ld(&bar[XB_TOPGEN]) == tg, bar);
            __builtin_amdgcn_fence(__ATOMIC_ACQUIRE, "agent");
            xb_add(&bar[XB_XGEN(b.x)], 1u);
            asm volatile("s_waitcnt vmcnt(0)" ::: "memory");
        } else {
            XB_SPIN(xb_ld(&bar[XB_XGEN(b.x)]) == gen, bar);
            __builtin_amdgcn_fence(__ATOMIC_ACQUIRE, "agent");
            asm volatile("s_waitcnt vmcnt(0)" ::: "memory");
        }
    }
    __syncthreads();
}

namespace pg8 {
constexpr int BM = 256, BK = 64, HALF = 128, HTB = HALF * BK * 2, STAGE_BYTES = 8 * HTB, NXCD = 8, WGM = 8;
__host__ __device__ __forceinline__ int lds_byte(int r, int c) { const int st = (r >> 4) * 2 + (c >> 5), rr = r & 15, cc = c & 31, ob = rr * 64 + cc * 2; return st * 1024 + (ob ^ (((ob >> 9) & 1) << 5)); }
__host__ __device__ __forceinline__ void stage_rc(int b, int& R, int& C) { const int st = b / 1024, sb = b % 1024, swz = sb ^ (((sb >> 9) & 1) << 5); R = (st >> 1) * 16 + swz / 64; C = (st & 1) * 32 + (swz % 64) / 2; }
__host__ __device__ __forceinline__ int perm32(int rho) { const int n = rho >> 4, i = rho & 15; return 8 * (i >> 2) + 4 * n + (i & 3); }
struct Unit { int pm, pn, e; };

__device__ __forceinline__ unsigned cvt_pk_bf16(float lo, float hi) { unsigned r; asm volatile("v_cvt_pk_bf16_f32 %0, %1, %2" : "=v"(r) : "v"(lo), "v"(hi)); return r; }

struct EpiBf16 {
    static constexpr bool PERM = true;
    bf16* O; int ldc;
    __device__ __forceinline__ void operator()(const f32x4 (&acc)[2][2][4][2], const Unit& u, int wr, int wc, int fr, int fq) const {
        const int row0 = u.pm * BM + wr * 64 + fr, col0 = u.pn * BM + wc * 32 + 8 * fq;
#pragma unroll
        for (int ai = 0; ai < 2; ++ai)
#pragma unroll
            for (int m = 0; m < 4; ++m) { bf16* rowp = O + (size_t)(row0 + ai * HALF + m * 16) * ldc + col0;
#pragma unroll
                for (int bj = 0; bj < 2; ++bj) { const f32x4 v0 = acc[ai][bj][m][0], v1 = acc[ai][bj][m][1];
                    v4u w; w.x = cvt_pk_bf16(v0[0], v0[1]); w.y = cvt_pk_bf16(v0[2], v0[3]); w.z = cvt_pk_bf16(v1[0], v1[1]); w.w = cvt_pk_bf16(v1[2], v1[3]);
                    *(v4u*)(rowp + bj * HALF) = w; } }
    }
};
struct EpiFp8 {
    static constexpr bool PERM = true;
    unsigned char* O; int ldc;
    __device__ __forceinline__ void operator()(const f32x4 (&acc)[2][2][4][2], const Unit& u, int wr, int wc, int fr, int fq) const {
        const int row0 = u.pm * BM + wr * 64 + fr, col0 = u.pn * BM + wc * 32 + 8 * fq;
#pragma unroll
        for (int ai = 0; ai < 2; ++ai)
#pragma unroll
            for (int m = 0; m < 4; ++m) { unsigned char* rowp = O + (size_t)(row0 + ai * HALF + m * 16) * ldc + col0;
#pragma unroll
                for (int bj = 0; bj < 2; ++bj) { float v[8];
#pragma unroll
                    for (int n = 0; n < 2; ++n)
#pragma unroll
                        for (int j = 0; j < 4; ++j) v[n * 4 + j] = fminf(fmaxf(acc[ai][bj][m][n][j] * 16.0f, -448.0f), 448.0f);
                    int w0 = __builtin_amdgcn_cvt_pk_fp8_f32(v[0], v[1], 0, false); w0 = __builtin_amdgcn_cvt_pk_fp8_f32(v[2], v[3], w0, true);
                    int w1 = __builtin_amdgcn_cvt_pk_fp8_f32(v[4], v[5], 0, false); w1 = __builtin_amdgcn_cvt_pk_fp8_f32(v[6], v[7], w1, true);
                    *(v2u*)(rowp + bj * HALF) = (v2u){(unsigned)w0, (unsigned)w1}; } }
    }
};
struct EpiF32 {
    static constexpr bool PERM = false;
    float* C; int ldc; const float* bias;
    __device__ __forceinline__ void operator()(const f32x4 (&acc)[2][2][4][2], const Unit& u, int wr, int wc, int fr, int fq) const {
        const int row0 = u.pm * BM + wr * 64 + fr, col0 = u.pn * BM + wc * 32 + 4 * fq;
        f32x4 bv[2][2];
#pragma unroll
        for (int bj = 0; bj < 2; ++bj)
#pragma unroll
            for (int n = 0; n < 2; ++n) bv[bj][n] = bias ? *(const f32x4*)(bias + col0 + bj * HALF + n * 16) : (f32x4){0.f, 0.f, 0.f, 0.f};
#pragma unroll
        for (int ai = 0; ai < 2; ++ai)
#pragma unroll
            for (int m = 0; m < 4; ++m) { float* rowp = C + (size_t)(row0 + ai * HALF + m * 16) * ldc + col0;
#pragma unroll
                for (int bj = 0; bj < 2; ++bj)
#pragma unroll
                    for (int n = 0; n < 2; ++n) *(f32x4*)(rowp + bj * HALF + n * 16) = acc[ai][bj][m][n] + bv[bj][n]; }
    }
};
struct EpiSwiglu {
    static constexpr bool PERM = true;
    bf16* H;
    __device__ __forceinline__ void operator()(const f32x4 (&acc)[2][2][4][2], const Unit& u, int wr, int wc, int fr, int fq) const {
        const int row0 = u.pm * BM + wr * 64 + fr, col0 = u.pn * HALF + wc * 32 + 8 * fq;
#pragma unroll
        for (int ai = 0; ai < 2; ++ai)
#pragma unroll
            for (int m = 0; m < 4; ++m) { bf16* rowp = H + (size_t)(row0 + ai * HALF + m * 16) * EFF + col0;
                float o[8];
#pragma unroll
                for (int n = 0; n < 2; ++n)
#pragma unroll
                    for (int j = 0; j < 4; ++j) { const float h1 = acc[ai][0][m][n][j], h3 = acc[ai][1][m][n][j]; o[n * 4 + j] = siluf_(h1) * h3; }
                v4u w; w.x = cvt_pk_bf16(o[0], o[1]); w.y = cvt_pk_bf16(o[2], o[3]); w.z = cvt_pk_bf16(o[4], o[5]); w.w = cvt_pk_bf16(o[6], o[7]);
                *(v4u*)rowp = w; }
    }
};

template <class Epi, class Prob, bool ALIGN_EPI>
__device__ __forceinline__ void gemm_phase(LAS unsigned char* lds, const Prob& P, const Epi& E) {
    const int tid = threadIdx.x, wid = __builtin_amdgcn_readfirstlane(tid >> 6), lane = tid & 63, wr = wid >> 2, wc = wid & 3, fr = lane & 15, fq = lane >> 4;
    const int K = P.K, nt = K / BK, ldb = P.ldb;
    int RA[2], CA[2]; unsigned voffB[2];
#pragma unroll
    for (int i = 0; i < 2; ++i) { int R, C; stage_rc(tid * 16 + i * 8192, R, C); const int Rb = Epi::PERM ? ((R & ~31) + perm32(R & 31)) : R;
        RA[i] = R; CA[i] = C; voffB[i] = (unsigned)(Rb * ldb + C) * 2u; }
    const size_t kstep = (size_t)(BK * 2);
    const size_t hstep = (size_t)HALF * ldb * 2;
    const unsigned ldsw = (unsigned)wid * 1024u;
    const int aoff = lds_byte(wr * 64 + fr, fq * 8), boff = lds_byte(wc * 32 + fr, fq * 8);
    const char* const Ab = P.Abase;
#define PG8_SA(b, h) (((b) * 2 + (h)) * HTB)
#define PG8_SB(b, h) ((4 + (b) * 2 + (h)) * HTB)
#define PG8_STAGE(bufoff, gbase, voff) do { _Pragma("unroll") for (int _i = 0; _i < 2; ++_i) \
        __builtin_amdgcn_global_load_lds((const unsigned*)((const char*)(gbase) + (voff)[_i]), (LAS unsigned*)(lds + (bufoff) + ldsw + _i * 8192), 16, 0, 0); } while (0)
#define PG8_STAGE_A(bufoff, kb, o0, o1) do { \
        __builtin_amdgcn_global_load_lds((const unsigned*)(Ab + (kb) + (o0)), (LAS unsigned*)(lds + (bufoff) + ldsw), 16, 0, 0); \
        __builtin_amdgcn_global_load_lds((const unsigned*)(Ab + (kb) + (o1)), (LAS unsigned*)(lds + (bufoff) + ldsw + 8192), 16, 0, 0); } while (0)
#define PG8_LDA(dst, b, h) do { _Pragma("unroll") for (int m = 0; m < 4; ++m) _Pragma("unroll") for (int k = 0; k < 2; ++k) dst[m][k] = *(const LAS bf16x8*)(lds + PG8_SA(b, h) + aoff + m * 2048 + k * 1024); } while (0)
#define PG8_LDB(dst, b, h) do { _Pragma("unroll") for (int n = 0; n < 2; ++n) _Pragma("unroll") for (int k = 0; k < 2; ++k) dst[n][k] = *(const LAS bf16x8*)(lds + PG8_SB(b, h) + boff + n * 2048 + k * 1024); } while (0)
#define PG8_MMA(ai, bj, At, Bt) do { __builtin_amdgcn_s_setprio(1); _Pragma("unroll") for (int m = 0; m < 4; ++m) _Pragma("unroll") for (int n = 0; n < 2; ++n) _Pragma("unroll") for (int k = 0; k < 2; ++k) \
        acc[ai][bj][m][n] = __builtin_amdgcn_mfma_f32_16x16x32_bf16(Bt[n][k], At[m][k], acc[ai][bj][m][n], 0, 0, 0); __builtin_amdgcn_s_setprio(0); } while (0)
#define PG8_WAIT_V(n) asm volatile("s_waitcnt vmcnt(" #n ")" ::: "memory")
#define PG8_WAIT_L(n) asm volatile("s_waitcnt lgkmcnt(" #n ")" ::: "memory")
#define PG8_BAR __builtin_amdgcn_s_barrier()
#define PG8_SCHED __builtin_amdgcn_sched_barrier(0)
    Unit cur, nxt; int ui = 0;
    if (!P.next(0, cur)) return;
    f32x4 acc[2][2][4][2];
#pragma unroll
    for (int a = 0; a < 2; ++a)
#pragma unroll
        for (int b = 0; b < 2; ++b)
#pragma unroll
            for (int m = 0; m < 4; ++m)
#pragma unroll
                for (int n = 0; n < 2; ++n) acc[a][b][m][n] = (f32x4){0.f, 0.f, 0.f, 0.f};
    bf16x8 At[4][2], B0[2][2], B1[2][2];
    unsigned oc[4], on[4];
    P.aoffs(cur, RA, CA, oc);
    const char* cB = P.bbase(cur);
    PG8_STAGE(PG8_SB(0, 0), cB, voffB); PG8_STAGE(PG8_SB(0, 1), cB + hstep, voffB); PG8_STAGE_A(PG8_SA(0, 0), (size_t)0, oc[0], oc[1]); PG8_STAGE_A(PG8_SA(0, 1), (size_t)0, oc[2], oc[3]);
    if (wr == 1) PG8_BAR;
    PG8_WAIT_V(2); PG8_BAR;
    PG8_STAGE(PG8_SB(1, 0), cB + kstep, voffB); PG8_STAGE_A(PG8_SA(1, 0), kstep, oc[0], oc[1]); PG8_STAGE(PG8_SB(1, 1), cB + hstep + kstep, voffB);
    PG8_WAIT_V(6); PG8_BAR;
    for (;;) {
        const bool has_next = P.next(ui + 1, nxt);
        const char* nB = cB;
        if (has_next) { P.aoffs(nxt, RA, CA, on); nB = P.bbase(nxt); }
        else { on[0] = oc[0]; on[1] = oc[1]; on[2] = oc[2]; on[3] = oc[3]; }
        for (int t = 0; t < nt; t += 2) {
            const bool last = (t == nt - 2);
            const size_t kb1 = (size_t)(t + 1) * kstep;
            const size_t kb2 = last ? (size_t)0 : (size_t)(t + 2) * kstep, kb3 = kb2 + kstep;
            const char* b2 = last ? nB : cB + (size_t)(t + 2) * kstep; const char* b3 = b2 + kstep;
            const unsigned o20 = last ? on[0] : oc[0], o21 = last ? on[1] : oc[1], o22 = last ? on[2] : oc[2], o23 = last ? on[3] : oc[3];
            PG8_LDB(B0, 0, 0); PG8_LDB(B1, 0, 1); PG8_SCHED; PG8_LDA(At, 0, 0); PG8_STAGE_A(PG8_SA(1, 1), kb1, oc[2], oc[3]);
            PG8_WAIT_V(8); PG8_WAIT_L(0); PG8_BAR; PG8_MMA(0, 0, At, B0); PG8_MMA(0, 1, At, B1); PG8_BAR; PG8_SCHED;
            PG8_LDA(At, 0, 1); PG8_STAGE(PG8_SB(0, 0), b2, voffB); PG8_STAGE(PG8_SB(0, 1), b2 + hstep, voffB); PG8_STAGE_A(PG8_SA(0, 0), kb2, o20, o21);
            PG8_WAIT_V(8); PG8_WAIT_L(0); PG8_BAR; PG8_MMA(1, 0, At, B0); PG8_MMA(1, 1, At, B1); PG8_BAR; PG8_SCHED;
            PG8_LDB(B0, 1, 0); PG8_LDB(B1, 1, 1); PG8_SCHED; PG8_LDA(At, 1, 0); PG8_STAGE_A(PG8_SA(0, 1), kb2, o22, o23);
            PG8_WAIT_V(8); PG8_WAIT_L(0); PG8_BAR; PG8_MMA(0, 0, At, B0); PG8_MMA(0, 1, At, B1); PG8_BAR; PG8_SCHED;
            PG8_LDA(At, 1, 1); PG8_STAGE(PG8_SB(1, 0), b3, voffB); PG8_STAGE(PG8_SB(1, 1), b3 + hstep, voffB); PG8_STAGE_A(PG8_SA(1, 0), kb3, o20, o21);
            PG8_WAIT_V(8); PG8_WAIT_L(0); PG8_BAR; PG8_MMA(1, 0, At, B0); PG8_MMA(1, 1, At, B1); PG8_BAR; PG8_SCHED;
        }
        if constexpr (ALIGN_EPI) { if (wr == 0) PG8_BAR; }
        E(acc, cur, wr, wc, fr, fq);
        if (!has_next) break;
#pragma unroll
        for (int a = 0; a < 2; ++a)
#pragma unroll
            for (int b = 0; b < 2; ++b)
#pragma unroll
                for (int m = 0; m < 4; ++m)
#pragma unroll
                    for (int n = 0; n < 2; ++n) acc[a][b][m][n] = (f32x4){0.f, 0.f, 0.f, 0.f};
        cur = nxt; cB = nB; oc[0] = on[0]; oc[1] = on[1]; oc[2] = on[2]; oc[3] = on[3]; ++ui;
        if constexpr (ALIGN_EPI) { if (wr == 1) PG8_BAR; }
    }
    PG8_WAIT_V(0);
    if constexpr (!ALIGN_EPI) { if (wr == 0) PG8_BAR; }
    PG8_BAR;
#undef PG8_SA
#undef PG8_SB
#undef PG8_STAGE
#undef PG8_STAGE_A
#undef PG8_LDA
#undef PG8_LDB
#undef PG8_MMA
#undef PG8_WAIT_V
#undef PG8_WAIT_L
#undef PG8_BAR
#undef PG8_SCHED
}

struct DenseProb {
    int K, ldb; const char* Abase; const char* Bt; int lda; int nM, nN, nwg, G, c;
    __device__ __forceinline__ void init(const bf16* A, int lda_, const bf16* B, int M, int N, int K_, int G_, int c_) { Abase = (const char*)A; Bt = (const char*)B; lda = lda_; K = K_; ldb = K_; nM = M / BM; nN = N / BM; nwg = nM * nN; G = G_; c = c_; }
    __device__ __forceinline__ bool next(int i, Unit& u) const {
        const long L = (long)i * G + c; if (L >= nwg) return false;
        int wgid = (int)L; { const int q = nwg / NXCD, r = nwg % NXCD, xcd = wgid % NXCD, off = wgid / NXCD; wgid = (xcd < r ? xcd * (q + 1) : r * (q + 1) + (xcd - r) * q) + off; }
        const int nig = WGM * nN, gid = wgid / nig, fm = gid * WGM, gsz = (nM - fm) < WGM ? (nM - fm) : WGM;
        u.pm = fm + ((wgid % nig) % gsz); u.pn = (wgid % nig) / gsz; u.e = 0; return true;
    }
    __device__ __forceinline__ const char* bbase(const Unit& u) const { return Bt + (size_t)u.pn * BM * K * 2; }
    __device__ __forceinline__ void aoffs(const Unit& u, const int (&R)[2], const int (&C)[2], unsigned (&o)[4]) const {
#pragma unroll
        for (int h = 0; h < 2; ++h)
#pragma unroll
            for (int i = 0; i < 2; ++i) o[2 * h + i] = (unsigned)(((size_t)(u.pm * BM + h * HALF + R[i]) * lda + C[i]) * 2);
    }
};
__device__ __forceinline__ bool xcd_range_unit(int i, int nunits, int G, int c, int& L) {
    const int x = c % NXCD, cc = c / NXCD, per = G / NXCD, q = nunits / NXCD, r = nunits % NXCD;
    const int start = x * q + (x < r ? x : r), cnt = q + (x < r ? 1 : 0), li = i * per + cc;
    if (li >= cnt) return false; L = start + li; return true;
}
struct MoeUpProb {
    int K, ldb; const char* Abase; const char* W13; const int* sorted; const LAS int* tile_e; int ntiles, nunits, G, c;
    __device__ __forceinline__ bool next(int i, Unit& u) const {
        int L; if (!xcd_range_unit(i, nunits, G, c, L)) return false;
        const int tile = L >> 2; u.pn = L & 3;
        if (tile < ntiles) { u.pm = tile; u.e = __builtin_amdgcn_readfirstlane(tile_e[tile]); } else { u.pm = MAXTILES + (tile - ntiles); u.e = NEXP; }
        return true;
    }
    __device__ __forceinline__ const char* bbase(const Unit& u) const { return W13 + ((size_t)u.e * 1024 + (size_t)u.pn * BM) * 2048 * 2; }
    __device__ __forceinline__ void aoffs(const Unit& u, const int (&R)[2], const int (&C)[2], unsigned (&o)[4]) const {
#pragma unroll
        for (int h = 0; h < 2; ++h)
#pragma unroll
            for (int i = 0; i < 2; ++i) { int row;
                if (u.e == NEXP) row = (u.pm - MAXTILES) * BM + h * HALF + R[i];
                else row = sorted[u.pm * BM + h * HALF + R[i]];
                o[2 * h + i] = (unsigned)(((size_t)row * 2048 + C[i]) * 2); }
    }
};
struct MoeDownProb {
    int K, ldb; const char* Abase; const char* W2; const LAS int* tile_e; int ntiles, nunits, G, c;
    __device__ __forceinline__ bool next(int i, Unit& u) const {
        int L; if (!xcd_range_unit(i, nunits, G, c, L)) return false;
        const int tile = L >> 3; u.pn = L & 7;
        if (tile < ntiles) { u.pm = tile; u.e = __builtin_amdgcn_readfirstlane(tile_e[tile]); } else { u.pm = MAXTILES + (tile - ntiles); u.e = NEXP; }
        return true;
    }
    __device__ __forceinline__ const char* bbase(const Unit& u) const { return W2 + ((size_t)u.e * 2048 + (size_t)u.pn * BM) * EFF * 2; }
    __device__ __forceinline__ void aoffs(const Unit& u, const int (&R)[2], const int (&C)[2], unsigned (&o)[4]) const {
#pragma unroll
        for (int h = 0; h < 2; ++h)
#pragma unroll
            for (int i = 0; i < 2; ++i) o[2 * h + i] = (unsigned)(((size_t)(u.pm * BM + h * HALF + R[i]) * EFF + C[i]) * 2);
    }
};
struct CmpProb {
    int K, ldb; const char* Abase; const char* Bt; int G, c;
    __device__ __forceinline__ bool next(int i, Unit& u) const { const int L = i * G + c; if (L >= 16) return false; u.pm = L; u.pn = 0; u.e = 0; return true; }
    __device__ __forceinline__ const char* bbase(const Unit&) const { return Bt; }
    __device__ __forceinline__ void aoffs(const Unit& u, const int (&R)[2], const int (&C)[2], unsigned (&o)[4]) const {
#pragma unroll
        for (int h = 0; h < 2; ++h)
#pragma unroll
            for (int i = 0; i < 2; ++i) { const int m = u.pm * BM + h * HALF + R[i], seq = m >> 7, n = m & 127;
                o[2 * h + i] = (unsigned)((((size_t)seq * NS + 16 * n) * 128 + C[i]) * 2); }
    }
};
struct RouterProb {
    int K, ldb; const char* Abase; const char* Bt; int G, c;
    __device__ __forceinline__ bool next(int i, Unit& u) const { const int L = i * G + c; if (L >= (NT / BM) * 4) return false; u.pm = L >> 2; u.pn = 0; u.e = L & 3; return true; }
    __device__ __forceinline__ const char* bbase(const Unit& u) const { return Bt + (size_t)u.e * 512 * 2; }
    __device__ __forceinline__ void aoffs(const Unit& u, const int (&R)[2], const int (&C)[2], unsigned (&o)[4]) const {
#pragma unroll
        for (int h = 0; h < 2; ++h)
#pragma unroll
            for (int i = 0; i < 2; ++i) o[2 * h + i] = (unsigned)(((size_t)(u.pm * BM + h * HALF + R[i]) * ND + u.e * 512 + C[i]) * 2);
    }
};
struct EpiF32N64 {
    static constexpr bool PERM = false;
    float* C;
    __device__ __forceinline__ void operator()(const f32x4 (&acc)[2][2][4][2], const Unit& u, int wr, int wc, int fr, int fq) const {
        if (wc >= 2) return;
        const int row0 = u.pm * BM + wr * 64 + fr, col0 = wc * 32 + 4 * fq;
#pragma unroll
        for (int ai = 0; ai < 2; ++ai)
#pragma unroll
            for (int m = 0; m < 4; ++m) { float* rowp = C + ((size_t)u.e * NT + row0 + ai * HALF + m * 16) * 64 + col0;
#pragma unroll
                for (int n = 0; n < 2; ++n) *(f32x4*)(rowp + n * 16) = acc[ai][0][m][n]; }
    }
};
}

struct Args { const float* in[27]; float* out; unsigned char* ws; int ph_lo, ph_hi; };
typedef const __attribute__((address_space(4))) Args* CArgs;
__device__ __forceinline__ const float* kin(int i) { CArgs p = (CArgs)__builtin_amdgcn_kernarg_segment_ptr(); asm volatile("" : "+s"(p)); return p->in[i]; }
struct Frame {
    LAS unsigned char* lds;
    volatile LAS unsigned* MISC;
    unsigned* ctl;
    unsigned char* ws;
    int tid, lane, wave, vcu, G, gw, NGW;
    float* out;
};

__device__ __forceinline__ void tr_item(const float* W, int ldw, int k0, int n0, int nvalid, bf16* WT, int ldt, int drow0, LAS float* scr, int lane) {
    float v[32]; const int n = lane & 31; const bool okn = n < nvalid; const float* src = W + (size_t)(k0 + (lane >> 5)) * ldw + n0 + n;
#pragma unroll
    for (int i = 0; i < 32; ++i) v[i] = okn ? src[(size_t)(2 * i) * ldw] : 0.f;
#pragma unroll
    for (int i = 0; i < 32; ++i) scr[(2 * i + (lane >> 5)) * 33 + n] = v[i];
    LDS_WAIT(); asm volatile("" ::: "memory");
    const int c = lane & 7;
#pragma unroll
    for (int j = 0; j < 4; ++j) { const int nn = (lane >> 3) + 8 * j; const LAS float* sp = scr + (8 * c) * 33 + nn;
        v4u o; o.x = pk2(sp[0 * 33], sp[1 * 33]); o.y = pk2(sp[2 * 33], sp[3 * 33]); o.z = pk2(sp[4 * 33], sp[5 * 33]); o.w = pk2(sp[6 * 33], sp[7 * 33]);
        if (nn < nvalid) *(v4u*)(WT + (size_t)(drow0 + nn) * ldt + k0 + 8 * c) = o; }
    LDS_WAIT(); asm volatile("" ::: "memory");
}
__device__ __forceinline__ bool tr_matrix(int& it, const float* W, int ldw, int K, int c0, int ncols, bf16* WT, int drow0, LAS float* scr, int lane) {
    const int nb = (ncols + 31) / 32, items = (K / 64) * nb;
    if (it >= items) { it -= items; return false; }
    const int kb = it / nb, b = it % nb, nv = ncols - 32 * b;
    tr_item(W, ldw, 64 * kb, c0 + 32 * b, nv < 32 ? nv : 32, WT, K, drow0 + 32 * b, scr, lane);
    return true;
}
__device__ __forceinline__ void zero_rows(Frame& F, bf16* base, size_t nelem) {
    for (size_t i = ((size_t)F.gw * 64 + F.lane) * 8; i < nelem; i += (size_t)F.NGW * 64 * 8) *(v4u*)(base + i) = (v4u){0u, 0u, 0u, 0u};
}

__device__ __forceinline__ void p_prologue(Frame& F) {
    LAS float* scr = (LAS float*)(F.lds + F.wave * 16384);
    unsigned char* ws = F.ws;
    {
        LAS float* wl = (LAS float*)F.lds;
        LAS float* pl = (LAS float*)(F.lds + 32768);
        const float* w_in = kin(2); const float* pool_w = kin(3); const float* pscale = kin(4);
        bf16* WT = (bf16*)(ws + WS_WABIN);
        for (int it = blockIdx.x; it < 4 * 32; it += F.G) {
            const int g = it >> 5, k0 = (it & 31) * 64;
            for (int i = F.tid; i < 64 * 128; i += 512) wl[i] = w_in[(size_t)(k0 + (i >> 7)) * AB_IN + g * 128 + (i & 127)];
            for (int i = F.tid; i < 128 * 128; i += 512) pl[i] = pool_w[(size_t)g * 16384 + i];
            __syncthreads();
            const int d = F.tid & 127, kg = F.tid >> 7; const float sc = pscale[g * 128 + d];
            for (int kk = 0; kk < 16; kk += 8) {
                float a[8];
#pragma unroll
                for (int j = 0; j < 8; ++j) a[j] = 0.f;
                for (int c = 0; c < 128; ++c) { const float pw = pl[c * 128 + d];
#pragma unroll
                    for (int j = 0; j < 8; ++j) a[j] += wl[(kg * 16 + kk + j) * 128 + c] * pw; }
                v4u o; o.x = pk2(a[0] * sc, a[1] * sc); o.y = pk2(a[2] * sc, a[3] * sc); o.z = pk2(a[4] * sc, a[5] * sc); o.w = pk2(a[6] * sc, a[7] * sc);
                *(v4u*)(WT + (size_t)(g * 128 + d) * ND + k0 + kg * 16 + kk) = o;
            }
            __syncthreads();
        }
    }
    __syncthreads();
    for (int it0 = F.gw; ; it0 += F.NGW) {
        int it = it0;
        if (tr_matrix(it, kin(2), AB_IN, ND, 512, AB_IN - 512, (bf16*)(ws + WS_WABIN), 512, scr, F.lane)) continue;
        if (tr_matrix(it, kin(5), ND, ND, 0, ND, (bf16*)(ws + WS_WABOUT), 0, scr, F.lane)) continue;
        if (tr_matrix(it, kin(6), CD_IN, ND, 0, CD_IN, (bf16*)(ws + WS_WCDIN), 0, scr, F.lane)) continue;
        if (tr_matrix(it, kin(14), ND, ND, 0, ND, (bf16*)(ws + WS_WCDOUT), 0, scr, F.lane)) continue;
        if (tr_matrix(it, kin(11), 1536, 384, 0, 1536, (bf16*)(ws + WS_WUQ), 0, scr, F.lane)) continue;
        if (tr_matrix(it, kin(13), 2048, 512, 0, 2048, (bf16*)(ws + WS_WUKV), 0, scr, F.lane)) continue;
        if (tr_matrix(it, kin(8), 128, 4096, 0, 128, (bf16*)(ws + WS_CW1), 0, scr, F.lane)) continue;
        if (tr_matrix(it, kin(8) + (size_t)4096 * 128, 128, 4096, 0, 128, (bf16*)(ws + WS_CW1), 128, scr, F.lane)) continue;
        break;
    }
    zero_rows(F, (bf16*)(ws + WS_WCDIN) + (size_t)CD_IN * ND, (size_t)(CD_INP - CD_IN) * ND);
    { const float* x = kin(0); bf16* xb = (bf16*)(ws + WS_XB0); const size_t stride = (size_t)F.NGW * 64 * 8;
      for (size_t i = ((size_t)F.gw * 64 + F.lane) * 8; i < (size_t)NT * ND; i += 4 * stride) {
          f32x4 a[4], c[4];
#pragma unroll
          for (int u = 0; u < 4; ++u) if (i + u * stride < (size_t)NT * ND) { a[u] = *(const f32x4*)(x + i + u * stride); c[u] = *(const f32x4*)(x + i + u * stride + 4); }
#pragma unroll
          for (int u = 0; u < 4; ++u) if (i + u * stride < (size_t)NT * ND) { v4u o; o.x = pk2(a[u][0], a[u][1]); o.y = pk2(a[u][2], a[u][3]); o.z = pk2(c[u][0], c[u][1]); o.w = pk2(c[u][2], c[u][3]); *(v4u*)(xb + i + u * stride) = o; } } }
    for (int o = F.gw; o < 128; o += F.NGW) { const int kv = o >> 6, fc = o & 63; const float* pos = kin(7) + (size_t)kv * 4096 + fc * 64; const float* w1 = kin(8) + ((size_t)kv * 4096 + fc * 64) * 128;
        float s0 = 0.f, s1 = 0.f;
#pragma unroll 8
        for (int f = 0; f < 64; ++f) { const float pf_ = pos[f]; const f32x2 wv = *(const f32x2*)(w1 + (size_t)f * 128 + F.lane * 2); s0 += pf_ * wv[0]; s1 += pf_ * wv[1]; }
        *(f32x2*)((float*)(ws + WS_CMPB) + 256 + (size_t)o * 128 + F.lane * 2) = (f32x2){s0, s1}; }
}
__device__ __forceinline__ void cmp_bias_finish(Frame& F) {
    if (blockIdx.x == 0 && F.tid < 256) { const int kv = F.tid >> 7, h = F.tid & 127; const float* part = (const float*)(F.ws + WS_CMPB) + 256 + (size_t)kv * 64 * 128 + h;
        float sacc = 0.f; for (int fc = 0; fc < 64; ++fc) sacc += part[fc * 128];
        ((float*)(F.ws + WS_CMPB))[F.tid] = sacc; }
}
constexpr int MW_ITEMS_L = 65 * 1536 + 64;
__device__ __forceinline__ void moe_weight_item(int l, int it, unsigned char* ws, LAS float* scr, int lane) {
    bf16* W13 = (bf16*)(ws + WS_W13 + (size_t)l * WS_MOE_LSTRIDE); bf16* W2 = (bf16*)(ws + WS_W2 + (size_t)l * WS_MOE_LSTRIDE); bf16* RT = (bf16*)(ws + WS_RT + (size_t)l * MiB);
    if (it >= 65 * 1536) { const int r = it - 65 * 1536, kb = r >> 1, b = r & 1;
        tr_item(kin(19) + (size_t)l * ND * NEXP, NEXP, 64 * kb, 32 * b, 32, RT, ND, 32 * b, scr, lane); return; }
    const int e = it / 1536, r = it % 1536;
    const float *w1, *w3, *w2;
    if (e < NEXP) { const size_t o = ((size_t)l * NEXP + e) * ND * EFF; w1 = kin(21) + o; w3 = kin(22) + o; w2 = kin(23) + o; }
    else { const size_t o = (size_t)l * ND * EFF; w1 = kin(24) + o; w3 = kin(25) + o; w2 = kin(26) + o; }
    if (r < 1024) { const int which = r >> 9, rr = r & 511, kb = rr >> 4, nb = rr & 15;
        const int j = nb >> 2, drow = j * 256 + which * 128 + (nb & 3) * 32;
        tr_item(which ? w3 : w1, EFF, 64 * kb, 32 * nb, 32, W13 + (size_t)e * 1024 * ND, ND, drow, scr, lane); }
    else { const int rr = r - 1024, kb = rr >> 6, nb = rr & 63;
        tr_item(w2, ND, 64 * kb, 32 * nb, 32, W2 + (size_t)e * ND * EFF, EFF, 32 * nb, scr, lane); }
}
__device__ __forceinline__ void p_moe_weights_queue(Frame& F, unsigned* queue) {
    LAS float* scr = (LAS float*)(F.lds + F.wave * 16384);
    constexpr int BATCH = 16, NB_ = (2 * MW_ITEMS_L + BATCH - 1) / BATCH;
    for (;;) {
        unsigned bq = 0; if (F.lane == 0) bq = atomicAdd(queue, 1u);
        const int bi = __builtin_amdgcn_readfirstlane((int)bq);
        if (bi >= NB_) break;
        for (int k = 0; k < BATCH; ++k) { const int it = bi * BATCH + k; if (it >= 2 * MW_ITEMS_L) break; const int l = it >= MW_ITEMS_L ? 1 : 0; moe_weight_item(l, it - l * MW_ITEMS_L, F.ws, scr, F.lane); }
    }
    for (int l = 0; l < 2; ++l) zero_rows(F, (bf16*)(F.ws + WS_RT + (size_t)l * MiB) + (size_t)NEXP * ND, (size_t)(256 - NEXP) * ND);
}

__device__ __forceinline__ void ln_finish(float (&v)[4][8], const float* g, const float* b, int lane, bf16* ob, float* of) {
    float s = 0.f;
#pragma unroll
    for (int j = 0; j < 4; ++j)
#pragma unroll
        for (int i = 0; i < 8; ++i) s += v[j][i];
    const float mean = wave_sum(s) * (1.f / ND); float s2 = 0.f;
#pragma unroll
    for (int j = 0; j < 4; ++j)
#pragma unroll
        for (int i = 0; i < 8; ++i) { v[j][i] -= mean; s2 += v[j][i] * v[j][i]; }
    const float rstd = 1.f / sqrtf(wave_sum(s2) * (1.f / ND) + LN_EPS);
#pragma unroll
    for (int j = 0; j < 4; ++j) { unsigned c0 = (unsigned)(j * 64 + lane) * 8u; asm volatile("" : "+v"(c0));
        const f32x4 g0 = *(const f32x4*)((const char*)g + c0 * 4u), g1 = *(const f32x4*)((const char*)g + c0 * 4u + 16u), b0 = *(const f32x4*)((const char*)b + c0 * 4u), b1 = *(const f32x4*)((const char*)b + c0 * 4u + 16u);
        float o[8];
#pragma unroll
        for (int i = 0; i < 4; ++i) { o[i] = v[j][i] * rstd * g0[i] + b0[i]; o[4 + i] = v[j][4 + i] * rstd * g1[i] + b1[i]; }
        if (ob) { v4u w; w.x = pk2(o[0], o[1]); w.y = pk2(o[2], o[3]); w.z = pk2(o[4], o[5]); w.w = pk2(o[6], o[7]); *(v4u*)((char*)ob + c0 * 2u) = w; }
        if (of) { *(f32x4*)((char*)of + c0 * 4u) = (f32x4){o[0], o[1], o[2], o[3]}; *(f32x4*)((char*)of + c0 * 4u + 16u) = (f32x4){o[4], o[5], o[6], o[7]}; } }
}
__device__ __forceinline__ void p_ln1(Frame& F, const bf16* xin, const bf16* mixo, const float* g, const float* b, bf16* xo) {
    for (int m = F.gw; m < NT; m += F.NGW) {
        float v[4][8];
#pragma unroll
        for (int j = 0; j < 4; ++j) { const size_t o = (size_t)m * ND + (j * 64 + F.lane) * 8; float a[8], c[8]; unpack8(*(const v4u*)(xin + o), a); unpack8(*(const v4u*)(mixo + o), c);
#pragma unroll
            for (int i = 0; i < 8; ++i) v[j][i] = DN_ALPHA * a[i] + c[i]; }
        ln_finish(v, g, b, F.lane, xo + (size_t)m * ND, nullptr);
    }
}
__device__ __forceinline__ void unpack8_fp8(const v2u w, float (&f)[8]) {
    const f32x2 a = __builtin_amdgcn_cvt_pk_f32_fp8((int)w.x, false), b = __builtin_amdgcn_cvt_pk_f32_fp8((int)w.x, true), c = __builtin_amdgcn_cvt_pk_f32_fp8((int)w.y, false), d = __builtin_amdgcn_cvt_pk_f32_fp8((int)w.y, true);
    f[0] = a[0]; f[1] = a[1]; f[2] = b[0]; f[3] = b[1]; f[4] = c[0]; f[5] = c[1]; f[6] = d[0]; f[7] = d[1];
}
__device__ __forceinline__ void p_combine_ln2(Frame& F, const bf16* x1, const unsigned char* y2, const int* slot, const float* wsel, const float* g, const float* b, bf16* xo, float* fo) {
    for (int m = F.gw; m < NT; m += F.NGW) {
        const int myrow = slot[m * 8 + (F.lane & 7)]; const float myw = wsel[m * 8 + (F.lane & 7)] * (1.0f / 16.0f);
        float v[4][8];
        { v4u xa[4]; v2u sa[4];
#pragma unroll
          for (int j = 0; j < 4; ++j) { xa[j] = *(const v4u*)(x1 + (size_t)m * ND + (j * 64 + F.lane) * 8); sa[j] = *(const v2u*)(y2 + (size_t)(SH_ROW0 + m) * ND + (j * 64 + F.lane) * 8); }
#pragma unroll
          for (int j = 0; j < 4; ++j) { float a[8], c[8]; unpack8(xa[j], a); unpack8_fp8(sa[j], c);
#pragma unroll
              for (int i = 0; i < 8; ++i) v[j][i] = DN_ALPHA * a[i] + c[i] * (1.0f / 16.0f); } }
#pragma unroll
        for (int kg = 0; kg < 2; ++kg) { v2u ra[4][4]; float wk[4];
#pragma unroll
            for (int k = 0; k < 4; ++k) { const int row = __builtin_amdgcn_readlane(myrow, kg * 4 + k); wk[k] = __builtin_bit_cast(float, __builtin_amdgcn_readlane(__builtin_bit_cast(int, myw), kg * 4 + k));
#pragma unroll
                for (int j = 0; j < 4; ++j) ra[k][j] = *(const v2u*)(y2 + (size_t)row * ND + (j * 64 + F.lane) * 8); }
#pragma unroll
            for (int k = 0; k < 4; ++k)
#pragma unroll
                for (int j = 0; j < 4; ++j) { float c[8]; unpack8_fp8(ra[k][j], c);
#pragma unroll
                    for (int i = 0; i < 8; ++i) v[j][i] += wk[k] * c[i]; } }
        ln_finish(v, g, b, F.lane, xo ? xo + (size_t)m * ND : nullptr, fo ? fo + (size_t)m * ND : nullptr);
    }
}

__device__ __forceinline__ void p_pool(Frame& F, int wid, int nw) {
    const bf16* proj = (const bf16*)(F.ws + WS_PROJ); bf16* mixin = (bf16*)(F.ws + WS_MIXIN);
    for (int m = wid; m < NT; m += nw) {
        const int s = m & (NS - 1);
        const int g = F.lane >> 4, w = 2 << g; const int lo = (s + 1 - w) > 0 ? (s + 1 - w) : 0; const float cnt = (float)((s + 1) < w ? (s + 1) : w);
        float acc[8], cur[8];
#pragma unroll
        for (int i = 0; i < 8; ++i) acc[i] = 0.f;
        for (int j = lo; j <= s; ++j) { float t[8]; unpack8(*(const v4u*)(proj + (size_t)(m - s + j) * AB_IN + F.lane * 8), t);
#pragma unroll
            for (int i = 0; i < 8; ++i) acc[i] += t[i]; }
        unpack8(*(const v4u*)(proj + (size_t)m * AB_IN + F.lane * 8), cur);
        float o[8];
#pragma unroll
        for (int i = 0; i < 8; ++i) o[i] = acc[i] / cnt - cur[i];
        v4u wv; wv.x = pk2(o[0], o[1]); wv.y = pk2(o[2], o[3]); wv.z = pk2(o[4], o[5]); wv.w = pk2(o[6], o[7]); *(v4u*)(mixin + (size_t)m * ND + F.lane * 8) = wv;
    }
}
namespace ret {
typedef short v4i16_t __attribute__((ext_vector_type(4)));
constexpr int PITCH = 272, TILE = 128 * PITCH;
__device__ __forceinline__ bf16x8 trfrag(LAS unsigned char* trb, int r0, int r1, int c0) {
    const v4i16_t a = __builtin_amdgcn_ds_read_tr16_b64_v4i16((LAS v4i16_t*)(trb + r0 * PITCH + c0 * 2));
    const v4i16_t b = __builtin_amdgcn_ds_read_tr16_b64_v4i16((LAS v4i16_t*)(trb + r1 * PITCH + c0 * 2));
    return (bf16x8){a[0], a[1], a[2], a[3], b[0], b[1], b[2], b[3]};
}
}
__device__ __forceinline__ void p_retention_mfma(Frame& F, int bh) {
    const bf16* proj = (const bf16*)(F.ws + WS_PROJ); bf16* mixin = (bf16*)(F.ws + WS_MIXIN); const int* posv = (const int*)kin(1);
    constexpr int P = ret::PITCH;
    LAS unsigned char* KT = F.lds; LAS unsigned char* VT = F.lds + ret::TILE; LAS unsigned char* ST = F.lds + 2 * ret::TILE;
    const int b = bh / 6, h = bh % 6, w = F.wave, lane = F.lane, i16 = lane & 15, g = lane >> 4, q4 = (lane & 15) >> 2, p4 = lane & 3;
    const float lg = log2f(1.0f - exp2f(-5.0f - (float)h)), gc = exp2f(128.f * lg);
    const int rowb = i16 * P + 16 * g;
    const int trl = q4 * P + 8 * p4;
    LAS unsigned char* const trV4 = VT + trl + 4 * g * P;
    LAS unsigned char* const trV8 = VT + trl + 8 * g * P;
    LAS unsigned char* const trK8 = KT + trl + 8 * g * P;
    f32x4 T[2][8];
#pragma unroll
    for (int a = 0; a < 2; ++a)
#pragma unroll
        for (int d = 0; d < 8; ++d) T[a][d] = (f32x4){0.f, 0.f, 0.f, 0.f};
    const int srow = F.tid >> 2, scb = (F.tid & 3) * 4;
    for (int n = 0; n < NS / 128; ++n) {
        const size_t m0 = (size_t)b * NS + n * 128;
        {
          const float fk = exp2f(-(float)srow * lg) * 0.08838834764831845f, pz = (float)posv[m0 + srow]; const int t4 = F.tid & 3;
          const bf16* krow = proj + (m0 + srow) * AB_IN + 1280 + h * 128;
#pragma unroll
          for (int c = 0; c < 2; ++c) { const int c8 = 2 * t4 + c; float x1[8], x2[8];
              unpack8(*(const v4u*)(krow + c8 * 8), x1); unpack8(*(const v4u*)(krow + 64 + c8 * 8), x2);
#pragma unroll
              for (int j = 0; j < 8; ++j) { const float invf = exp2f(-(float)(c8 * 8 + j) * (13.287712379549449f / 64.f)); float sn, cs; fast_sincos(pz * invf, sn, cs);
                  const float a = (x1[j] * cs - x2[j] * sn) * fk, bq = (x1[j] * sn + x2[j] * cs) * fk; x1[j] = a; x2[j] = bq; }
              v4u o; o.x = pk2(x1[0], x1[1]); o.y = pk2(x1[2], x1[3]); o.z = pk2(x1[4], x1[5]); o.w = pk2(x1[6], x1[7]); *(LAS v4u*)(KT + srow * P + c8 * 16) = o;
              o.x = pk2(x2[0], x2[1]); o.y = pk2(x2[2], x2[3]); o.z = pk2(x2[4], x2[5]); o.w = pk2(x2[6], x2[7]); *(LAS v4u*)(KT + srow * P + (c8 + 8) * 16) = o; } }
        bf16x8 qf[4], pf[4]; float rs[4] = {0.f, 0.f, 0.f, 0.f}, rq[4] = {0.f, 0.f, 0.f, 0.f};
        {
          const float fq = exp2f((float)(16 * w + i16) * lg), pz = (float)posv[m0 + 16 * w + i16];
          const bf16* qrow = proj + (m0 + 16 * w + i16) * AB_IN + 512 + h * 128;
#pragma unroll
          for (int ks = 0; ks < 2; ++ks) { float x1[8], x2[8]; unpack8(*(const v4u*)(qrow + 32 * ks + 8 * g), x1); unpack8(*(const v4u*)(qrow + 64 + 32 * ks + 8 * g), x2);
#pragma unroll
              for (int j = 0; j < 8; ++j) { const float invf = exp2f(-(float)(32 * ks + 8 * g + j) * (13.287712379549449f / 64.f)); float sn, cs; fast_sincos(pz * invf, sn, cs);
                  const float a = (x1[j] * cs - x2[j] * sn) * fq, bq = (x1[j] * sn + x2[j] * cs) * fq; x1[j] = a; x2[j] = bq; }
              v4u o; o.x = pk2(x1[0], x1[1]); o.y = pk2(x1[2], x1[3]); o.z = pk2(x1[4], x1[5]); o.w = pk2(x1[6], x1[7]); qf[ks] = __builtin_bit_cast(bf16x8, o);
              o.x = pk2(x2[0], x2[1]); o.y = pk2(x2[2], x2[3]); o.z = pk2(x2[4], x2[5]); o.w = pk2(x2[6], x2[7]); qf[ks + 2] = __builtin_bit_cast(bf16x8, o); } }
#pragma unroll
        for (int hv = 0; hv < 2; ++hv) {
            if (hv == 1) __syncthreads();
#pragma unroll
            for (int c = 0; c < 4; ++c) { const int c8 = scb + c; *(LAS v4u*)(VT + srow * P + c8 * 16) = *(const v4u*)(proj + (m0 + srow) * AB_IN + 2048 + h * 256 + hv * 128 + c8 * 8); }
            { LAS unsigned char* stw = ST + (16 * w + 4 * g) * P + i16 * 2;
#pragma unroll
              for (int dt = 0; dt < 8; ++dt)
#pragma unroll
                for (int r = 0; r < 4; ++r) { T[hv][dt][r] *= gc; *(LAS bf16*)(stw + r * P + dt * 32) = (bf16)f2bf(T[hv][dt][r]); } }
            __syncthreads();
            if (hv == 0) {
                f32x4 sc[8];
#pragma unroll
                for (int mt = 0; mt < 8; ++mt) { sc[mt] = (f32x4){0.f, 0.f, 0.f, 0.f};
                    if (mt <= w) {
#pragma unroll
                        for (int ks = 0; ks < 4; ++ks) { const bf16x8 kf = *(const LAS bf16x8*)(KT + rowb + mt * 16 * P + ks * 64); sc[mt] = __builtin_amdgcn_mfma_f32_16x16x32_bf16(kf, qf[ks], sc[mt], 0, 0, 0); }
                        if (mt == w) {
#pragma unroll
                            for (int r = 0; r < 4; ++r) sc[mt][r] = (4 * g + r <= i16) ? sc[mt][r] : 0.f; } } }
#pragma unroll
                for (int k2 = 0; k2 < 4; ++k2) { v4u wv; wv.x = pk2(sc[2 * k2][0], sc[2 * k2][1]); wv.y = pk2(sc[2 * k2][2], sc[2 * k2][3]); wv.z = pk2(sc[2 * k2 + 1][0], sc[2 * k2 + 1][1]); wv.w = pk2(sc[2 * k2 + 1][2], sc[2 * k2 + 1][3]);
                    pf[k2] = __builtin_bit_cast(bf16x8, wv); }
            }
#pragma unroll
            for (int nt = 0; nt < 8; ++nt) { f32x4 acc = (f32x4){0.f, 0.f, 0.f, 0.f};
#pragma unroll
                for (int k2 = 0; k2 < 4; ++k2) if (2 * k2 <= w) { const bf16x8 vf = ret::trfrag(trV4, 32 * k2, 32 * k2 + 16, 16 * nt); acc = __builtin_amdgcn_mfma_f32_16x16x32_bf16(pf[k2], vf, acc, 0, 0, 0); }
#pragma unroll
                for (int ks = 0; ks < 4; ++ks) { const bf16x8 sf = *(const LAS bf16x8*)(ST + rowb + nt * 16 * P + ks * 64); acc = __builtin_amdgcn_mfma_f32_16x16x32_bf16(qf[ks], sf, acc, 0, 0, 0); }
#pragma unroll
                for (int r = 0; r < 4; ++r) { rs[r] += acc[r]; rq[r] += acc[r] * acc[r]; mixin[(m0 + 16 * w + 4 * g + r) * ND + 512 + h * 256 + hv * 128 + 16 * nt + i16] = (bf16)f2bf(acc[r]); } }
#pragma unroll
            for (int ks = 0; ks < 4; ++ks) { const bf16x8 af = ret::trfrag(trV8, 32 * ks, 32 * ks + 4, 16 * w);
#pragma unroll
                for (int dt = 0; dt < 8; ++dt) { const bf16x8 bfr = ret::trfrag(trK8, 32 * ks, 32 * ks + 4, 16 * dt); T[hv][dt] = __builtin_amdgcn_mfma_f32_16x16x32_bf16(af, bfr, T[hv][dt], 0, 0, 0); } }
        }
#pragma unroll
        for (int r = 0; r < 4; ++r) { float sm = rs[r], s2 = rq[r];
            sm += __shfl_xor(sm, 1); sm += __shfl_xor(sm, 2); sm += __shfl_xor(sm, 4); sm += __shfl_xor(sm, 8);
            s2 += __shfl_xor(s2, 1); s2 += __shfl_xor(s2, 2); s2 += __shfl_xor(s2, 4); s2 += __shfl_xor(s2, 8);
            const float mean = sm * (1.f / 256.f); const float var = fmaxf(s2 * (1.f / 256.f) - mean * mean, 0.f);
            const float rstd = 1.f / sqrtf(var + NORM_EPS);
            const size_t m = m0 + 16 * w + 4 * g + r;
#pragma unroll
            for (int t = 0; t < 16; ++t) { bf16* yp = mixin + m * ND + 512 + h * 256 + 16 * t + i16; const float gt = bf1(proj[m * AB_IN + 3584 + h * 256 + 16 * t + i16]);
                *yp = (bf16)f2bf((bf1(*yp) - mean) * rstd * siluf_(gt)); } }
        __syncthreads();
    }
}

__device__ __forceinline__ void p_route(Frame& F, int l) {
    const float* logits = (const float*)(F.ws + WS_LOGITS); const float* rbias = kin(20) + l * NEXP;
    int* tope = (int*)(F.ws + WS_TOPE); float* wsel = (float*)(F.ws + WS_WSEL); int* posb = (int*)(F.ws + WS_SLOT); unsigned* cnt = F.ctl + CW_CNT + l * 64;
    LAS unsigned* lcnt = (LAS unsigned*)F.lds; LAS unsigned* lbase = lcnt + 64; LAS int* le = (LAS int*)(lcnt + 128); LAS unsigned* lp = (LAS unsigned*)(lcnt + 128 + 512);
    const float bias = rbias[F.lane]; const int lane = F.lane;
    for (int chunk = blockIdx.x; chunk < NT / 64; chunk += F.G) {
        __syncthreads();
        if (F.tid < 64) lcnt[F.tid] = 0u;
        __syncthreads();
        for (int t = 0; t < 8; ++t) {
            const int tl = F.wave * 8 + t, m = chunk * 64 + tl;
            const float lg = (logits[(size_t)m * 64 + lane] + logits[((size_t)NT + m) * 64 + lane]) + (logits[((size_t)2 * NT + m) * 64 + lane] + logits[((size_t)3 * NT + m) * 64 + lane]);
            const float sc = sigmoidf_(lg), bi = sc + bias;
            const int grp = lane >> 3;
            int rk = 0;
#pragma unroll
            for (int j = 1; j < 8; ++j) { const int o = lane ^ j; const float ov = __shfl_xor(bi, j); rk += ((ov > bi) || (ov == bi && o < lane)) ? 1 : 0; }
            float gs = rk < 2 ? bi : 0.f; gs += __shfl_xor(gs, 1); gs += __shfl_xor(gs, 2); gs += __shfl_xor(gs, 4);
            int grk = 0;
#pragma unroll
            for (int gg = 0; gg < 8; ++gg) { const float ov = __builtin_bit_cast(float, __builtin_amdgcn_readlane(__builtin_bit_cast(int, gs), gg * 8)); grk += (gg != grp && ((ov > gs) || (ov == gs && gg < grp))) ? 1 : 0; }
            const float mv = grk < 4 ? bi : -1e30f;
            int erk = 0;
#pragma unroll 16
            for (int j = 0; j < 64; ++j) { const float ov = __builtin_bit_cast(float, __builtin_amdgcn_readlane(__builtin_bit_cast(int, mv), j)); erk += ((ov > mv) || (ov == mv && j < lane)) ? 1 : 0; }
            const bool sel = erk < 8;
            const float wsum = wave_sum(sel ? sc : 0.f);
            if (sel) { const unsigned q = __hip_atomic_fetch_add(lcnt + lane, 1u, __ATOMIC_RELAXED, __HIP_MEMORY_SCOPE_WORKGROUP);
                tope[m * 8 + erk] = lane; wsel[m * 8 + erk] = sc / wsum * 2.5f; le[tl * 8 + erk] = lane; lp[tl * 8 + erk] = q; }
        }
        __syncthreads();
        if (F.tid < 64) lbase[F.tid] = atomicAdd(&cnt[F.tid], lcnt[F.tid]);
        __syncthreads();
        posb[chunk * 512 + F.tid] = (int)(lbase[le[F.tid]] + lp[F.tid]);
    }
}
__device__ __forceinline__ void load_offsets(Frame& F, int l) {
    volatile LAS int* tab = (volatile LAS int*)(F.lds + TAB_OFF);
    __syncthreads();
    if (F.tid < NEXP) tab[66 + F.tid] = (int)__hip_atomic_load(F.ctl + CW_CNT + l * 64 + F.tid, __ATOMIC_RELAXED, __HIP_MEMORY_SCOPE_AGENT);
    __syncthreads();
    if (F.tid == 0) { int o = 0; for (int e = 0; e < NEXP; ++e) { tab[e] = o; int c = tab[66 + e]; if (c > NT) c = NT; const int nt_ = (c + 255) >> 8; for (int t = 0; t < nt_; ++t) { const int ti = (o >> 8) + t; if (ti < MAXTILES) tab[160 + ti] = e; } o += nt_ << 8; if (o > MAXROWS) o = MAXROWS; }
        tab[64] = o; tab[65] = o >> 8; }
    __syncthreads();
}
__device__ __forceinline__ void p_scatter(Frame& F, int l) {
    load_offsets(F, l);
    const LAS int* tab = (const LAS int*)(F.lds + TAB_OFF);
    const int* tope = (const int*)(F.ws + WS_TOPE); int* slot = (int*)(F.ws + WS_SLOT); int* sorted = (int*)(F.ws + WS_SORTED);
    for (int i = F.gw * 64 + F.lane; i < NT * 8; i += F.NGW * 64) { const int e = tope[i]; const int row = tab[e] + slot[i]; sorted[row] = i >> 3; slot[i] = row; }
    for (int i = F.gw * 64 + F.lane; i < NEXP * 256; i += F.NGW * 64) { const int e = i >> 8, j = i & 255; const int r = tab[e] + tab[66 + e] + j; if (r < tab[e + 1]) sorted[r] = 0; }
}

__device__ __forceinline__ void p_l1_thin_a(Frame& F) {
    const bf16* proj = (const bf16*)(F.ws + WS_PROJ); const int* pos = (const int*)kin(1);
    bf16* cqn = (bf16*)(F.ws + WS_CQN); bf16* ckvn = (bf16*)(F.ws + WS_CKVN); bf16* krot = (bf16*)(F.ws + WS_KROT); bf16* cmpkv = (bf16*)(F.ws + WS_CMPKV);
    const float* qn = kin(10); const float* kvn = kin(12);
    for (int m = F.gw; m < NT; m += F.NGW) {
        const bf16* row = proj + (size_t)m * CD_INP;
        { float x[6]; float s = 0.f;
#pragma unroll
          for (int j = 0; j < 6; ++j) { x[j] = bf1(row[2584 + j * 64 + F.lane]); s += x[j] * x[j]; }
          const float r = 1.f / sqrtf(wave_sum(s) * (1.f / 384.f) + NORM_EPS);
#pragma unroll
          for (int j = 0; j < 6; ++j) cqn[(size_t)m * 384 + j * 64 + F.lane] = (bf16)f2bf(x[j] * r * qn[j * 64 + F.lane]); }
        { float x[8]; float s = 0.f;
#pragma unroll
          for (int j = 0; j < 8; ++j) { x[j] = bf1(row[2968 + j * 64 + F.lane]); s += x[j] * x[j]; }
          const float r = 1.f / sqrtf(wave_sum(s) * (1.f / 512.f) + NORM_EPS);
#pragma unroll
          for (int j = 0; j < 8; ++j) ckvn[(size_t)m * 512 + j * 64 + F.lane] = (bf16)f2bf(x[j] * r * kvn[j * 64 + F.lane]); }
        { const int i = F.lane & 31; const float p = (float)pos[m]; const float invf = exp2f(-(float)i * (13.287712379549449f / 32.f));
          float sn, cs; fast_sincos(p * invf, sn, cs);
          const float x1 = bf1(row[3480 + i]), x2 = bf1(row[3480 + 32 + i]);
          if (F.lane < 32) krot[(size_t)m * 64 + i] = (bf16)f2bf(x1 * cs - x2 * sn); else krot[(size_t)m * 64 + 32 + i] = (bf16)f2bf(x1 * sn + x2 * cs); }
        { const int b = m >> 11, s = m & (NS - 1);
          const int q4 = F.lane >> 4, c = F.lane & 15, kv = q4 >> 1, g = q4 & 1;
          const v4u w = *(const v4u*)(row + 1024 + q4 * 128 + c * 8);
          *(v4u*)(cmpkv + ((size_t)((kv * 16 + b * 2 + g) * NS + s)) * 128 + c * 8) = w; }
    }
}
__device__ __forceinline__ void p_l1_thin_b(Frame& F) {
    const float* hid = (const float*)(F.ws + WS_HID); const float* w2 = kin(9); bf16* kvc = (bf16*)(F.ws + WS_KVCMP);
    for (int m = F.gw; m < 4096; m += F.NGW) {
        const int kv = m >> 11;
        float h0 = hid[(size_t)m * 256 + kv * 128 + F.lane], h1 = hid[(size_t)m * 256 + kv * 128 + 64 + F.lane];
        h0 = 0.5f * h0 * (1.f + tanhf(0.7978845608028654f * (h0 + 0.044715f * h0 * h0 * h0)));
        h1 = 0.5f * h1 * (1.f + tanhf(0.7978845608028654f * (h1 + 0.044715f * h1 * h1 * h1)));
        const float* w = w2 + (size_t)kv * 128 * 128; float o0 = 0.f, o1 = 0.f;
        for (int c = 0; c < 64; ++c) { const float a = __shfl(h0, c), bq = __shfl(h1, c);
            o0 += a * w[c * 128 + F.lane] + bq * w[(c + 64) * 128 + F.lane]; o1 += a * w[c * 128 + 64 + F.lane] + bq * w[(c + 64) * 128 + 64 + F.lane]; }
        kvc[(size_t)m * 128 + F.lane] = (bf16)f2bf(o0); kvc[(size_t)m * 128 + 64 + F.lane] = (bf16)f2bf(o1);
    }
}
__device__ __forceinline__ void p_nsa_cmp_mfma(Frame& F) {
    typedef short v4i16_t __attribute__((ext_vector_type(4)));
    const bf16* proj = (const bf16*)(F.ws + WS_PROJ); const bf16* kvc = (const bf16*)(F.ws + WS_KVCMP); float* ocmp = (float*)(F.ws + WS_OCMP); unsigned* selm = (unsigned*)(F.ws + WS_SELM);
    constexpr int P = 272;
    LAS unsigned char* KT = F.lds; LAS unsigned char* VT = F.lds + 128 * P; LAS float* PS = (LAS float*)(F.lds + 2 * 128 * P);
    const int w = F.wave, lane = F.lane, i16 = lane & 15, g = lane >> 4, q4 = (lane & 15) >> 2, p4 = lane & 3;
    const float sscale = 0.08838834764831845f * 1.4426950408889634f;
    for (int bu = blockIdx.x; bu < 256; bu += F.G) {
        const int bg = bu >> 4, qg = bu & 15, b = bg >> 1, gq = bg & 1;
        __syncthreads();
#pragma unroll
        for (int c = 0; c < 4; ++c) { const int idx = F.tid + 512 * c, row = idx >> 4, c8 = idx & 15;
            v4u kk = (v4u){0u, 0u, 0u, 0u}, vv = (v4u){0u, 0u, 0u, 0u};
            if (row < 127) { kk = *(const v4u*)(kvc + ((size_t)(0 * 16 + bg) * 128 + row) * 128 + c8 * 8); vv = *(const v4u*)(kvc + ((size_t)(1 * 16 + bg) * 128 + row) * 128 + c8 * 8); }
            *(LAS v4u*)(KT + row * P + c8 * 16) = kk; *(LAS v4u*)(VT + row * P + c8 * 16) = vv; }
        for (int k = 0; k < 4; ++k) {
            const int q0 = (qg * 4 + k) * 32, h = gq * 4 + (w >> 1), ql = (w & 1) * 16 + i16, spos = q0 + ql;
            bf16x8 qf[4];
#pragma unroll
            for (int ks = 0; ks < 4; ++ks) qf[ks] = *(const bf16x8*)(proj + (size_t)(b * NS + spos) * CD_INP + h * 128 + 32 * ks + 8 * g);
            __syncthreads();
            const int nvalid = spos >= 31 ? ((spos - 31) >> 4) + 1 : 0;
            f32x4 sc[8]; float mx = -1e30f;
#pragma unroll
            for (int mt = 0; mt < 8; ++mt) { sc[mt] = (f32x4){0.f, 0.f, 0.f, 0.f};
#pragma unroll
                for (int ks = 0; ks < 4; ++ks) { const bf16x8 kf = *(const LAS bf16x8*)(KT + (16 * mt + i16) * P + (32 * ks + 8 * g) * 2); sc[mt] = __builtin_amdgcn_mfma_f32_16x16x32_bf16(kf, qf[ks], sc[mt], 0, 0, 0); }
#pragma unroll
                for (int r = 0; r < 4; ++r) { const bool ok = (16 * mt + 4 * g + r) < nvalid; const float x = ok ? sc[mt][r] * sscale : -1e30f; sc[mt][r] = x; mx = fmaxf(mx, x); } }
            mx = fmaxf(mx, __shfl_xor(mx, 16)); mx = fmaxf(mx, __shfl_xor(mx, 32));
            float ps = 0.f;
#pragma unroll
            for (int mt = 0; mt < 8; ++mt)
#pragma unroll
                for (int r = 0; r < 4; ++r) { const bool ok = (16 * mt + 4 * g + r) < nvalid; const float pv = ok ? __builtin_amdgcn_exp2f(sc[mt][r] - mx) : 0.f; sc[mt][r] = pv; ps += pv; }
            ps += __shfl_xor(ps, 16); ps += __shfl_xor(ps, 32);
            const float inv = ps > 0.f ? 1.f / ps : 0.f;
#pragma unroll
            for (int mt = 0; mt < 8; ++mt)
#pragma unroll
                for (int r = 0; r < 4; ++r) sc[mt][r] *= inv;
            { LAS float* slab = PS + (w >> 2) * 4096 + ql * 128 + 4 * g;
              if (((w >> 1) & 1) == 0) {
#pragma unroll
                  for (int mt = 0; mt < 8; ++mt) *(LAS f32x4*)(slab + 16 * mt) = sc[mt]; }
              __syncthreads();
              if (((w >> 1) & 1) == 1) {
#pragma unroll
                  for (int mt = 0; mt < 8; ++mt) { const f32x4 t = *(const LAS f32x4*)(slab + 16 * mt); *(LAS f32x4*)(slab + 16 * mt) = t + sc[mt]; } } }
            f32x4 O[8];
#pragma unroll
            for (int nt = 0; nt < 8; ++nt) O[nt] = (f32x4){0.f, 0.f, 0.f, 0.f};
#pragma unroll
            for (int k2 = 0; k2 < 4; ++k2) { v4u wv; wv.x = pk2(sc[2 * k2][0], sc[2 * k2][1]); wv.y = pk2(sc[2 * k2][2], sc[2 * k2][3]); wv.z = pk2(sc[2 * k2 + 1][0], sc[2 * k2 + 1][1]); wv.w = pk2(sc[2 * k2 + 1][2], sc[2 * k2 + 1][3]);
                const bf16x8 pf = __builtin_bit_cast(bf16x8, wv);
#pragma unroll
                for (int nt = 0; nt < 8; ++nt) {
                    const v4i16_t a = __builtin_amdgcn_ds_read_tr16_b64_v4i16((LAS v4i16_t*)(VT + (32 * k2 + 4 * g + q4) * P + (16 * nt + 4 * p4) * 2));
                    const v4i16_t c = __builtin_amdgcn_ds_read_tr16_b64_v4i16((LAS v4i16_t*)(VT + (32 * k2 + 16 + 4 * g + q4) * P + (16 * nt + 4 * p4) * 2));
                    const bf16x8 vf = (bf16x8){a[0], a[1], a[2], a[3], c[0], c[1], c[2], c[3]};
                    O[nt] = __builtin_amdgcn_mfma_f32_16x16x32_bf16(pf, vf, O[nt], 0, 0, 0); } }
#pragma unroll
            for (int r = 0; r < 4; ++r) { const size_t m = (size_t)(b * NS + q0 + (w & 1) * 16 + 4 * g + r); const float gt = sigmoidf_(bf1(proj[m * CD_INP + 2560 + h * 3 + 0]));
#pragma unroll
                for (int nt = 0; nt < 8; ++nt) ocmp[m * 1024 + h * 128 + 16 * nt + i16] = gt * O[nt][r]; }
            __syncthreads();
#pragma unroll
            for (int qq = 0; qq < 4; ++qq) { const int qi = 4 * w + qq, s = q0 + qi, cur = s >> 6, j = lane & 31;
                float imp = 0.f;
#pragma unroll
                for (int kk = 0; kk < 4; ++kk) { const int n1 = 4 * j + kk; if (n1 <= 126) imp += PS[qi * 128 + n1] + PS[4096 + qi * 128 + n1]; const int n2 = 4 * j - 1 + kk; if (n2 >= 0 && n2 <= 126) imp += PS[qi * 128 + n2] + PS[4096 + qi * 128 + n2]; }
                const bool forced = (j == 0) || (j == cur) || (j == cur - 1);
                const float score = forced ? 1e4f : ((j * 64 <= s) ? imp : -1e30f);
                int rk = 0;
                for (int jj = 0; jj < 32; ++jj) { const float ov = __shfl(score, jj); rk += ((ov > score) || (ov == score && jj < j)) ? 1 : 0; }
                const bool sel = (lane < 32) && (rk < 16) && (j <= cur);
                const unsigned long long bal = __ballot(sel);
                if (lane == 0) selm[(size_t)(b * NS + s) * 2 + gq] = (unsigned)bal; }
        }
    }
}

namespace fa {
typedef short v4i16_t __attribute__((ext_vector_type(4)));
struct Src { const bf16* k1; size_t ks1; const bf16* k2; size_t ks2; const bf16* v; size_t vs; };
template <int DQK> struct Cfg { static constexpr int KPITCH = (DQK + 8) * 2, KBYTES = 64 * KPITCH, VPITCH = 272, VBYTES = 64 * VPITCH, BUF = KBYTES + VBYTES, NKS = DQK / 32, KCH = DQK / 8, NKR = DQK / 64; };

template <int DQK> struct TileOff { unsigned gk[Cfg<DQK>::NKR], gv[2], lk[Cfg<DQK>::NKR], lv[2]; };
template <int DQK>
__device__ __forceinline__ void tile_offsets(const Src& S, int tid, TileOff<DQK>& T) {
#pragma unroll
    for (int i = 0; i < 2; ++i) { const int c = tid + 512 * i, row = c >> 4, c8 = c & 15;
        T.gk[i] = (unsigned)(row * (int)S.ks1 + c8 * 8) * 2u; T.gv[i] = (unsigned)(row * (int)S.vs + c8 * 8) * 2u;
        T.lk[i] = (unsigned)(row * Cfg<DQK>::KPITCH + c8 * 16); T.lv[i] = (unsigned)(Cfg<DQK>::KBYTES + row * Cfg<DQK>::VPITCH + c8 * 16); }
    if (DQK == 192) { const int row = tid >> 3, c8 = tid & 7; T.gk[Cfg<DQK>::NKR - 1] = (unsigned)(row * (int)S.ks2 + c8 * 8) * 2u; T.lk[Cfg<DQK>::NKR - 1] = (unsigned)(row * Cfg<DQK>::KPITCH + 256 + c8 * 16); }
}
template <int DQK>
__device__ __forceinline__ void load_tile(const Src& S, int k0, const TileOff<DQK>& T, v4u (&kr)[Cfg<DQK>::NKR], v4u (&vr)[2]) {
    const char* kb1 = (const char*)S.k1 + (size_t)k0 * S.ks1 * 2; const char* vb = (const char*)S.v + (size_t)k0 * S.vs * 2;
#pragma unroll
    for (int i = 0; i < 2; ++i) { kr[i] = *(const v4u*)(kb1 + T.gk[i]); vr[i] = *(const v4u*)(vb + T.gv[i]); }
    if (DQK == 192) { const char* kb2 = (const char*)S.k2 + (size_t)k0 * S.ks2 * 2; kr[Cfg<DQK>::NKR - 1] = *(const v4u*)(kb2 + T.gk[Cfg<DQK>::NKR - 1]); }
}
template <int DQK>
__device__ __forceinline__ void store_tile(LAS unsigned char* buf, const TileOff<DQK>& T, const v4u (&kr)[Cfg<DQK>::NKR], const v4u (&vr)[2]) {
#pragma unroll
    for (int i = 0; i < Cfg<DQK>::NKR; ++i) *(LAS v4u*)(buf + T.lk[i]) = kr[i];
#pragma unroll
    for (int i = 0; i < 2; ++i) *(LAS v4u*)(buf + T.lv[i]) = vr[i];
}
struct RowState { int spos; unsigned rowmask; float m_run, l_run; };
template <int MODE> __device__ __forceinline__ bool group_needs(int t, const RowState& R) {
    bool row_any = (t * 64 <= R.spos);
    if (MODE == 1) row_any = row_any && ((R.rowmask >> t) & 1u);
    if (MODE == 2) row_any = row_any && (t * 64 + 63 + 512 > R.spos);
    return __ballot(row_any) != 0ull;
}
template <int MODE>
__device__ __forceinline__ void softmax_group(f32x4 (&sc)[4], int t, RowState& R, float sscale, f32x4 (&O)[8], bf16x8 (&pf)[2], int g) {
    float mx = -1e30f;
#pragma unroll
    for (int mt = 0; mt < 4; ++mt)
#pragma unroll
        for (int r = 0; r < 4; ++r) { const int kp = t * 64 + 16 * mt + 4 * g + r; bool ok = kp <= R.spos;
            if (MODE == 1) ok = ok && ((R.rowmask >> t) & 1u);
            if (MODE == 2) ok = ok && (kp + 512 > R.spos);
            const float x = ok ? sc[mt][r] * sscale : -3e38f; sc[mt][r] = x; mx = fmaxf(mx, x); }
    mx = fmaxf(mx, -1e30f);
    mx = fmaxf(mx, __shfl_xor(mx, 16)); mx = fmaxf(mx, __shfl_xor(mx, 32));
    if (__ballot(mx > R.m_run + 8.0f) != 0ull) {
        const float m_new = fmaxf(R.m_run, mx), alpha = __builtin_amdgcn_exp2f(R.m_run - m_new); R.m_run = m_new;
        R.l_run *= alpha;
        float ar[4];
#pragma unroll
        for (int r = 0; r < 4; ++r) ar[r] = __shfl(alpha, 4 * g + r);
#pragma unroll
        for (int nt = 0; nt < 8; ++nt)
#pragma unroll
            for (int r = 0; r < 4; ++r) O[nt][r] *= ar[r];
    }
    float ps = 0.f;
#pragma unroll
    for (int mt = 0; mt < 4; ++mt)
#pragma unroll
        for (int r = 0; r < 4; ++r) { const float pv = __builtin_amdgcn_exp2f(sc[mt][r] - R.m_run); sc[mt][r] = pv; ps += pv; }
    R.l_run += ps;
#pragma unroll
    for (int k2 = 0; k2 < 2; ++k2) { v4u w; w.x = pk2(sc[2 * k2][0], sc[2 * k2][1]); w.y = pk2(sc[2 * k2][2], sc[2 * k2][3]); w.z = pk2(sc[2 * k2 + 1][0], sc[2 * k2 + 1][1]); w.w = pk2(sc[2 * k2 + 1][2], sc[2 * k2 + 1][3]);
        pf[k2] = __builtin_bit_cast(bf16x8, w); }
}
template <int DQK, int MODE>
__device__ __forceinline__ void fa_compute(LAS unsigned char* kb, LAS unsigned char* vb, const bf16x8 (&qf0)[Cfg<DQK>::NKS], const bf16x8 (&qf1)[Cfg<DQK>::NKS], int t, RowState& R0, RowState& R1, float sscale,
                                           f32x4 (&O0)[8], f32x4 (&O1)[8], int i16, int g, int q4, int p4) {
    typedef Cfg<DQK> C;
    const bool n0 = group_needs<MODE>(t, R0), n1 = group_needs<MODE>(t, R1);
    if (!n0 && !n1) return;
    f32x4 s0[4], s1[4];
#pragma unroll
    for (int mt = 0; mt < 4; ++mt) { s0[mt] = (f32x4){0.f, 0.f, 0.f, 0.f}; s1[mt] = (f32x4){0.f, 0.f, 0.f, 0.f};
#pragma unroll
        for (int ks = 0; ks < C::NKS; ++ks) { const bf16x8 kf = *(const LAS bf16x8*)(kb + (16 * mt + i16) * C::KPITCH + (32 * ks + 8 * g) * 2);
            s0[mt] = __builtin_amdgcn_mfma_f32_16x16x32_bf16(kf, qf0[ks], s0[mt], 0, 0, 0);
            s1[mt] = __builtin_amdgcn_mfma_f32_16x16x32_bf16(kf, qf1[ks], s1[mt], 0, 0, 0); } }
    bf16x8 p0[2], p1[2];
    if (n0) softmax_group<MODE>(s0, t, R0, sscale, O0, p0, g); else { p0[0] = (bf16x8){0, 0, 0, 0, 0, 0, 0, 0}; p0[1] = p0[0]; }
    if (n1) softmax_group<MODE>(s1, t, R1, sscale, O1, p1, g); else { p1[0] = (bf16x8){0, 0, 0, 0, 0, 0, 0, 0}; p1[1] = p1[0]; }
#pragma unroll
    for (int nt = 0; nt < 8; ++nt)
#pragma unroll
        for (int k2 = 0; k2 < 2; ++k2) {
            const v4i16_t a = __builtin_amdgcn_ds_read_tr16_b64_v4i16((LAS v4i16_t*)(vb + (32 * k2 + 4 * g + q4) * C::VPITCH + (16 * nt + 4 * p4) * 2));
            const v4i16_t b = __builtin_amdgcn_ds_read_tr16_b64_v4i16((LAS v4i16_t*)(vb + (32 * k2 + 16 + 4 * g + q4) * C::VPITCH + (16 * nt + 4 * p4) * 2));
            const bf16x8 vf = (bf16x8){a[0], a[1], a[2], a[3], b[0], b[1], b[2], b[3]};
            O0[nt] = __builtin_amdgcn_mfma_f32_16x16x32_bf16(p0[k2], vf, O0[nt], 0, 0, 0);
            O1[nt] = __builtin_amdgcn_mfma_f32_16x16x32_bf16(p1[k2], vf, O1[nt], 0, 0, 0); }
}
template <int DQK, int MODE>
__device__ __forceinline__ void fa_pass(LAS unsigned char* lds, const Src& S, const bf16x8 (&qf0)[Cfg<DQK>::NKS], const bf16x8 (&qf1)[Cfg<DQK>::NKS], unsigned tmask, RowState& R0, RowState& R1, float sscale,
                                        f32x4 (&O0)[8], f32x4 (&O1)[8], int tid, int lane) {
    typedef Cfg<DQK> C;
    const int i16 = lane & 15, g = lane >> 4, q4 = (lane & 15) >> 2, p4 = lane & 3;
#pragma unroll
    for (int nt = 0; nt < 8; ++nt) { O0[nt] = (f32x4){0.f, 0.f, 0.f, 0.f}; O1[nt] = (f32x4){0.f, 0.f, 0.f, 0.f}; }
    R0.m_run = -1e30f; R0.l_run = 0.f; R1.m_run = -1e30f; R1.l_run = 0.f;
    unsigned rem = tmask;
    if (rem == 0u) return;
    v4u kr[C::NKR], vr[2]; TileOff<DQK> TO; tile_offsets<DQK>(S, tid, TO);
    int t = __builtin_ctz(rem); rem &= rem - 1u;
    load_tile<DQK>(S, t * 64, TO, kr, vr);
    __syncthreads();
    store_tile<DQK>(lds, TO, kr, vr);
    __syncthreads();
    int cur = 0;
    for (;;) {
        const bool has_next = rem != 0u; int tn = 0;
        if (has_next) { tn = __builtin_ctz(rem); rem &= rem - 1u; load_tile<DQK>(S, tn * 64, TO, kr, vr); }
        LAS unsigned char* kb = lds + cur * C::BUF;
        fa_compute<DQK, MODE>(kb, kb + C::KBYTES, qf0, qf1, t, R0, R1, sscale, O0, O1, i16, g, q4, p4);
        if (has_next) store_tile<DQK>(lds + (cur ^ 1) * C::BUF, TO, kr, vr);
        __syncthreads();
        if (!has_next) break;
        t = tn; cur ^= 1;
    }
}
__device__ __forceinline__ void row_inv(float l_run, int lane, float (&inv)[4]) {
    float l = l_run; l += __shfl_xor(l, 16); l += __shfl_xor(l, 32);
    const float li = l > 0.f ? 1.f / l : 0.f; const int g = lane >> 4;
#pragma unroll
    for (int r = 0; r < 4; ++r) inv[r] = __shfl(li, 4 * g + r);
}
__device__ __forceinline__ void rope_qpe(bf16x8& f4, bf16x8& f5, float pz, int g4) {
    v4u w1 = __builtin_bit_cast(v4u, f4), w2 = __builtin_bit_cast(v4u, f5); float x1[8], x2[8]; unpack8(w1, x1); unpack8(w2, x2);
#pragma unroll
    for (int jj = 0; jj < 8; ++jj) { const float invf = exp2f(-(float)(8 * g4 + jj) * (13.287712379549449f / 32.f)); float sn, cs; fast_sincos(pz * invf, sn, cs);
        const float a = x1[jj] * cs - x2[jj] * sn, c = x1[jj] * sn + x2[jj] * cs; x1[jj] = a; x2[jj] = c; }
    w1.x = pk2(x1[0], x1[1]); w1.y = pk2(x1[2], x1[3]); w1.z = pk2(x1[4], x1[5]); w1.w = pk2(x1[6], x1[7]);
    w2.x = pk2(x2[0], x2[1]); w2.y = pk2(x2[2], x2[3]); w2.z = pk2(x2[4], x2[5]); w2.w = pk2(x2[6], x2[7]);
    f4 = __builtin_bit_cast(bf16x8, w1); f5 = __builtin_bit_cast(bf16x8, w2);
}
}

__device__ __forceinline__ void p_attn_mla(Frame& F, unsigned* queue) {
    const bf16* proj = (const bf16*)(F.ws + WS_PROJ); bf16* mixin = (bf16*)(F.ws + WS_MIXIN); const float* ocmp = (const float*)(F.ws + WS_OCMP); const unsigned* selm = (const unsigned*)(F.ws + WS_SELM);
    const bf16* qmla = (const bf16*)(F.ws + WS_QMLA); const bf16* kvu = (const bf16*)(F.ws + WS_KVU); const bf16* krot = (const bf16*)(F.ws + WS_KROT);
    volatile LAS unsigned* qslot = (volatile LAS unsigned*)(F.lds + LDSCTL_OFF);
    const int lane = F.lane, w = F.wave, i16 = lane & 15, g4 = lane >> 4;
    for (;;) {
        __syncthreads();
        if (F.tid == 0) qslot[0] = atomicAdd(queue, 1u);
        __syncthreads();
        const int u = __builtin_amdgcn_readfirstlane((int)qslot[0]);
        if (u >= 512) break;
        {
            const int qt = 7 - (u >> 6), bh = u & 63, b = bh >> 3, h = bh & 7, q0 = qt * 256;
            fa::RowState R0, R1; R0.spos = q0 + 32 * w + i16; R1.spos = R0.spos + 16; R0.rowmask = 0u; R1.rowmask = 0u;
            bf16x8 qf0[6], qf1[6];
#pragma unroll
            for (int ks = 0; ks < 6; ++ks) { qf0[ks] = *(const bf16x8*)(qmla + (size_t)(b * NS + R0.spos) * 1536 + h * 192 + 32 * ks + 8 * g4); qf1[ks] = *(const bf16x8*)(qmla + (size_t)(b * NS + R1.spos) * 1536 + h * 192 + 32 * ks + 8 * g4); }
            fa::rope_qpe(qf0[4], qf0[5], (float)((const int*)kin(1))[b * NS + R0.spos], g4);
            fa::rope_qpe(qf1[4], qf1[5], (float)((const int*)kin(1))[b * NS + R1.spos], g4);
            fa::Src S; S.k1 = kvu + (size_t)(b * NS) * 2048 + h * 256; S.ks1 = 2048; S.k2 = krot + (size_t)(b * NS) * 64; S.ks2 = 64; S.v = S.k1 + 128; S.vs = 2048;
            const int last = (q0 + 255) >> 6; const unsigned tmask = last >= 31 ? 0xffffffffu : ((1u << (last + 1)) - 1u);
            f32x4 O0[8], O1[8];
            fa::fa_pass<192, 0>(F.lds, S, qf0, qf1, tmask, R0, R1, 0.07216878364870322f * 1.4426950408889634f, O0, O1, F.tid, lane);
            float inv[4];
            fa::row_inv(R0.l_run, lane, inv);
#pragma unroll
            for (int r = 0; r < 4; ++r) { bf16* orow = mixin + (size_t)(b * NS + q0 + 32 * w + 4 * g4 + r) * ND + 1024 + h * 128 + i16;
#pragma unroll
                for (int nt = 0; nt < 8; ++nt) orow[16 * nt] = (bf16)f2bf(O0[nt][r] * inv[r]); }
            fa::row_inv(R1.l_run, lane, inv);
#pragma unroll
            for (int r = 0; r < 4; ++r) { bf16* orow = mixin + (size_t)(b * NS + q0 + 32 * w + 16 + 4 * g4 + r) * ND + 1024 + h * 128 + i16;
#pragma unroll
                for (int nt = 0; nt < 8; ++nt) orow[16 * nt] = (bf16)f2bf(O1[nt][r] * inv[r]); }
        }
    }
    (void)proj; (void)ocmp; (void)selm;
}
__device__ __forceinline__ void p_attn_nsa(Frame& F, unsigned* queue) {
    const bf16* proj = (const bf16*)(F.ws + WS_PROJ); bf16* mixin = (bf16*)(F.ws + WS_MIXIN); const float* ocmp = (const float*)(F.ws + WS_OCMP); const unsigned* selm = (const unsigned*)(F.ws + WS_SELM);
    const bf16* qmla = (const bf16*)(F.ws + WS_QMLA); const bf16* kvu = (const bf16*)(F.ws + WS_KVU); const bf16* krot = (const bf16*)(F.ws + WS_KROT);
    volatile LAS unsigned* qslot = (volatile LAS unsigned*)(F.lds + LDSCTL_OFF);
    const int lane = F.lane, w = F.wave, i16 = lane & 15, g4 = lane >> 4;
    for (;;) {
        __syncthreads();
        if (F.tid == 0) qslot[0] = atomicAdd(queue, 1u);
        __syncthreads();
        const int u = __builtin_amdgcn_readfirstlane((int)qslot[0]);
        if (u >= 512) break;
        {
            const int v = u;
            const int qt = 31 - (v >> 4), bg = v & 15, b = bg >> 1, gq = bg & 1, q0 = qt * 64;
            const int h = gq * 4 + (w >> 1), qb = q0 + (w & 1) * 32;
            fa::RowState R0, R1; R0.spos = qb + i16; R1.spos = qb + 16 + i16;
            bf16x8 qf0[4], qf1[4];
#pragma unroll
            for (int ks = 0; ks < 4; ++ks) { qf0[ks] = *(const bf16x8*)(proj + (size_t)(b * NS + R0.spos) * CD_INP + h * 128 + 32 * ks + 8 * g4); qf1[ks] = *(const bf16x8*)(proj + (size_t)(b * NS + R1.spos) * CD_INP + h * 128 + 32 * ks + 8 * g4); }
            R0.rowmask = selm[(size_t)(b * NS + R0.spos) * 2 + gq]; R1.rowmask = selm[(size_t)(b * NS + R1.spos) * 2 + gq];
            unsigned um = selm[(size_t)(b * NS + q0 + lane) * 2 + gq];
#pragma unroll
            for (int o = 1; o < 64; o <<= 1) um |= (unsigned)__shfl_xor((int)um, o);
            um = (unsigned)__builtin_amdgcn_readfirstlane((int)um);
            const bf16* base = proj + (size_t)(b * NS) * CD_INP;
            const float sscale = 0.08838834764831845f * 1.4426950408889634f;
            f32x4 O0[8], O1[8]; float inv[4];
            { fa::Src S; S.k1 = base + 1024 + ((1 * 2 + 0) * 2 + gq) * 128; S.ks1 = CD_INP; S.k2 = nullptr; S.ks2 = 0; S.v = base + 1024 + ((1 * 2 + 1) * 2 + gq) * 128; S.vs = CD_INP;
              fa::fa_pass<128, 1>(F.lds, S, qf0, qf1, um, R0, R1, sscale, O0, O1, F.tid, lane); }
            fa::row_inv(R0.l_run, lane, inv);
#pragma unroll
            for (int r = 0; r < 4; ++r) { const size_t m = (size_t)(b * NS + qb + 4 * g4 + r); const float g1 = sigmoidf_(bf1(proj[m * CD_INP + 2560 + h * 3 + 1])) * inv[r];
#pragma unroll
                for (int nt = 0; nt < 8; ++nt) mixin[m * ND + h * 128 + 16 * nt + i16] = (bf16)f2bf(ocmp[m * 1024 + h * 128 + 16 * nt + i16] + O0[nt][r] * g1); }
            fa::row_inv(R1.l_run, lane, inv);
#pragma unroll
            for (int r = 0; r < 4; ++r) { const size_t m = (size_t)(b * NS + qb + 16 + 4 * g4 + r); const float g1 = sigmoidf_(bf1(proj[m * CD_INP + 2560 + h * 3 + 1])) * inv[r];
#pragma unroll
                for (int nt = 0; nt < 8; ++nt) mixin[m * ND + h * 128 + 16 * nt + i16] = (bf16)f2bf(ocmp[m * 1024 + h * 128 + 16 * nt + i16] + O1[nt][r] * g1); }
            { fa::Src S; S.k1 = base + 1024 + ((2 * 2 + 0) * 2 + gq) * 128; S.ks1 = CD_INP; S.k2 = nullptr; S.ks2 = 0; S.v = base + 1024 + ((2 * 2 + 1) * 2 + gq) * 128; S.vs = CD_INP;
              const int klo = q0 - 511 > 0 ? q0 - 511 : 0, tlo = klo >> 6, thi = (q0 + 63) >> 6;
              const unsigned hm = thi >= 31 ? 0xffffffffu : ((1u << (thi + 1)) - 1u); const unsigned tmask = hm & ~((1u << tlo) - 1u);
              fa::fa_pass<128, 2>(F.lds, S, qf0, qf1, tmask, R0, R1, sscale, O0, O1, F.tid, lane); }
            fa::row_inv(R0.l_run, lane, inv);
#pragma unroll
            for (int r = 0; r < 4; ++r) { const size_t m = (size_t)(b * NS + qb + 4 * g4 + r); const float g2 = sigmoidf_(bf1(proj[m * CD_INP + 2560 + h * 3 + 2])) * inv[r];
#pragma unroll
                for (int nt = 0; nt < 8; ++nt) { bf16* op = mixin + m * ND + h * 128 + 16 * nt + i16; *op = (bf16)f2bf(bf1(*op) + O0[nt][r] * g2); } }
            fa::row_inv(R1.l_run, lane, inv);
#pragma unroll
            for (int r = 0; r < 4; ++r) { const size_t m = (size_t)(b * NS + qb + 16 + 4 * g4 + r); const float g2 = sigmoidf_(bf1(proj[m * CD_INP + 2560 + h * 3 + 2])) * inv[r];
#pragma unroll
                for (int nt = 0; nt < 8; ++nt) { bf16* op = mixin + m * ND + h * 128 + 16 * nt + i16; *op = (bf16)f2bf(bf1(*op) + O1[nt][r] * g2); } }
        }
    }
    (void)qmla; (void)kvu; (void)krot;
}

constexpr int NPHASE = 33;


#define IN(k) (lo <= (k) && (k) < hi)
#define SEAM(k) do { if (IN(k) && IN((k) + 1)) { if (MK_ONE_LAUNCH) xcd_barrier(bar); else if (F.tid == 0) __hip_atomic_store(F.ctl + CW_TMO, 0xBAD0u | (unsigned)(k), __ATOMIC_RELAXED, __HIP_MEMORY_SCOPE_AGENT); \
    if (MK_PROBE_PHASE >= 0 && blockIdx.x == 0 && F.tid == 0) { if ((k) == MK_PROBE_PHASE - 1) ((volatile LAS unsigned long long*)(F.lds + LDSCTL_OFF + 64))[0] = __builtin_amdgcn_s_memrealtime(); \
        if ((k) == MK_PROBE_LAST) ((volatile LAS unsigned long long*)(F.lds + LDSCTL_OFF + 64))[1] = __builtin_amdgcn_s_memrealtime(); } } } while (0)
template <int l>
__device__ __forceinline__ void layer_body(Frame& F, const XcdBarrier& bar, const int lo, const int hi) {
    unsigned char* ws = F.ws;
    bf16* const XB0 = (bf16*)(ws + WS_XB0); bf16* const X1B = (bf16*)(ws + WS_X1B); bf16* const X2B = (bf16*)(ws + WS_X2B);
    bf16* const PROJ = (bf16*)(ws + WS_PROJ); bf16* const MIXIN = (bf16*)(ws + WS_MIXIN); bf16* const MIXO = (bf16*)(ws + WS_MIXO);
    bf16* const HB = (bf16*)(ws + WS_H); bf16* const Y2 = (bf16*)(ws + WS_Y2);
        const int pb = 1 + l * 16;
        const bf16* xin = l == 0 ? XB0 : X2B;
        if (IN(pb + 0)) {
            if (l == 0) { pg8::DenseProb P; P.init(xin, ND, (const bf16*)(ws + WS_WABIN), NT, AB_IN, ND, F.G, (int)blockIdx.x); pg8::EpiBf16 E{PROJ, AB_IN};
                pg8::gemm_phase<pg8::EpiBf16, pg8::DenseProb, true>(F.lds, P, E); }
            else { pg8::DenseProb P; P.init(xin, ND, (const bf16*)(ws + WS_WCDIN), NT, CD_INP, ND, F.G, (int)blockIdx.x); pg8::EpiBf16 E{PROJ, CD_INP};
                pg8::gemm_phase<pg8::EpiBf16, pg8::DenseProb, true>(F.lds, P, E); }
        } SEAM(pb + 0);
        if (l == 0) {
            if (IN(pb + 2)) { if (blockIdx.x < NB * 6) p_retention_mfma(F, (int)blockIdx.x); else p_pool(F, ((int)blockIdx.x - NB * 6) * NWAVES + F.wave, (F.G - NB * 6) * NWAVES);
                __syncthreads(); p_moe_weights_queue(F, F.ctl + CW_CNT + 320); } SEAM(pb + 2);
        } else {
            if (IN(pb + 1)) { cmp_bias_finish(F); p_l1_thin_a(F); } SEAM(pb + 1);
            if (IN(pb + 2)) {
                if (blockIdx.x < 16) { pg8::CmpProb P; P.K = 4096; P.ldb = 4096; P.Abase = (const char*)(ws + WS_CMPKV); P.Bt = (const char*)(ws + WS_CW1); P.G = 16; P.c = (int)blockIdx.x;
                  pg8::EpiF32 E{(float*)(ws + WS_HID), 256, (const float*)(ws + WS_CMPB)};
                  pg8::gemm_phase<pg8::EpiF32, pg8::CmpProb, true>(F.lds, P, E); }
                else {
                { pg8::DenseProb P; P.init((const bf16*)(ws + WS_CQN), 384, (const bf16*)(ws + WS_WUQ), NT, 1536, 384, F.G - 16, (int)blockIdx.x - 16); pg8::EpiBf16 E{(bf16*)(ws + WS_QMLA), 1536};
                  pg8::gemm_phase<pg8::EpiBf16, pg8::DenseProb, true>(F.lds, P, E); }
                { pg8::DenseProb P; P.init((const bf16*)(ws + WS_CKVN), 512, (const bf16*)(ws + WS_WUKV), NT, 2048, 512, F.G - 16, (int)blockIdx.x - 16); pg8::EpiBf16 E{(bf16*)(ws + WS_KVU), 2048};
                  pg8::gemm_phase<pg8::EpiBf16, pg8::DenseProb, true>(F.lds, P, E); }
                }
            } SEAM(pb + 2);
            if (IN(pb + 3)) { p_l1_thin_b(F); } SEAM(pb + 3);
            if (IN(pb + 4)) { p_nsa_cmp_mfma(F); } SEAM(pb + 4);
            if (IN(pb + 5)) { p_attn_mla(F, F.ctl + CW_CNT + 256); p_attn_nsa(F, F.ctl + CW_CNT + 257); } SEAM(pb + 5);
        }
        if (IN(pb + 6)) { pg8::DenseProb P; P.init(MIXIN, ND, (const bf16*)(ws + (l == 0 ? WS_WABOUT : WS_WCDOUT)), NT, ND, ND, F.G, (int)blockIdx.x); pg8::EpiBf16 E{MIXO, ND};
            pg8::gemm_phase<pg8::EpiBf16, pg8::DenseProb, true>(F.lds, P, E); } SEAM(pb + 6);
        if (IN(pb + 7)) { p_ln1(F, xin, MIXO, kin(15) + l * ND, kin(16) + l * ND, X1B); } SEAM(pb + 7);
        if (IN(pb + 8)) { pg8::RouterProb P; P.K = 512; P.ldb = ND; P.Abase = (const char*)X1B; P.Bt = (const char*)(ws + WS_RT + (size_t)l * MiB); P.G = F.G; P.c = (int)blockIdx.x;
            pg8::EpiF32N64 E{(float*)(ws + WS_LOGITS)};
            pg8::gemm_phase<pg8::EpiF32N64, pg8::RouterProb, true>(F.lds, P, E); } SEAM(pb + 8);
        if (IN(pb + 9)) { p_route(F, l); } SEAM(pb + 9);
        if (IN(pb + 10)) { p_scatter(F, l); } SEAM(pb + 10);
        if (IN(pb + 11)) { load_offsets(F, l); const LAS int* tab = (const LAS int*)(F.lds + TAB_OFF);
            pg8::MoeUpProb P; P.K = ND; P.ldb = ND; P.Abase = (const char*)X1B; P.W13 = (const char*)(ws + WS_W13 + (size_t)l * WS_MOE_LSTRIDE); P.sorted = (const int*)(ws + WS_SORTED); P.tile_e = tab + 160; P.ntiles = __builtin_amdgcn_readfirstlane(tab[65]);
            P.nunits = (P.ntiles + NT / 256) * 4; P.G = F.G; P.c = (int)blockIdx.x;
            pg8::EpiSwiglu E{HB};
            pg8::gemm_phase<pg8::EpiSwiglu, pg8::MoeUpProb, true>(F.lds, P, E); } SEAM(pb + 11);
        if (IN(pb + 12)) { load_offsets(F, l); const LAS int* tab = (const LAS int*)(F.lds + TAB_OFF);
            pg8::MoeDownProb P; P.K = EFF; P.ldb = EFF; P.Abase = (const char*)HB; P.W2 = (const char*)(ws + WS_W2 + (size_t)l * WS_MOE_LSTRIDE); P.tile_e = tab + 160; P.ntiles = __builtin_amdgcn_readfirstlane(tab[65]);
            P.nunits = (P.ntiles + NT / 256) * 8; P.G = F.G; P.c = (int)blockIdx.x;
            pg8::EpiFp8 E{(unsigned char*)Y2, ND};
            pg8::gemm_phase<pg8::EpiFp8, pg8::MoeDownProb, true>(F.lds, P, E); } SEAM(pb + 12);
        if (IN(pb + 13)) { p_combine_ln2(F, X1B, (const unsigned char*)Y2, (const int*)(ws + WS_SLOT), (const float*)(ws + WS_WSEL), kin(17) + l * ND, kin(18) + l * ND, l == 0 ? X2B : nullptr, l == 0 ? nullptr : F.out); } SEAM(pb + 13);
    }
__global__ void __launch_bounds__(NWAVES * 64, 2) mk_fwd(Args args) {
    extern __shared__ __attribute__((aligned(16))) unsigned char lds[];
    Frame F;
    F.lds = (LAS unsigned char*)lds;
    F.MISC = (volatile LAS unsigned*)(F.lds + MISC_OFF);
    F.tid = threadIdx.x; F.lane = F.tid & 63; F.wave = __builtin_amdgcn_readfirstlane(F.tid >> 6);
    F.G = gridDim.x; { const int bx = blockIdx.x; F.vcu = (F.G % 8 == 0) ? (bx % 8) * (F.G / 8) + bx / 8 : bx; }
    F.gw = F.vcu * NWAVES + F.wave; F.NGW = F.G * NWAVES;
    F.ws = args.ws; F.ctl = (unsigned*)(args.ws + WS_CTL); F.out = args.out;
    for (int u = F.tid; u < (LDS_BYTES - LDSCTL_OFF) / 4; u += NWAVES * 64) ((LAS unsigned*)(F.lds + LDSCTL_OFF))[u] = 0u;
    __syncthreads();
    XcdBarrier bar; bar.bar = F.ctl + CW_BAR; bar.x = 0; bar.st = nullptr;
    if (MK_ONE_LAUNCH) bar = xcd_barrier_post(F.ctl + CW_BAR, F.MISC + 8);
    const int lo = args.ph_lo, hi = args.ph_hi;
    if (MK_PROBE_PHASE == 0 && blockIdx.x == 0 && F.tid == 0) ((volatile LAS unsigned long long*)(F.lds + LDSCTL_OFF + 64))[0] = __builtin_amdgcn_s_memrealtime();
    unsigned char* ws = args.ws;
    bf16* const XB0 = (bf16*)(ws + WS_XB0); bf16* const X1B = (bf16*)(ws + WS_X1B); bf16* const X2B = (bf16*)(ws + WS_X2B);
    bf16* const PROJ = (bf16*)(ws + WS_PROJ); bf16* const MIXIN = (bf16*)(ws + WS_MIXIN); bf16* const MIXO = (bf16*)(ws + WS_MIXO);
    bf16* const HB = (bf16*)(ws + WS_H); bf16* const Y2 = (bf16*)(ws + WS_Y2);

    if (IN(0)) { p_prologue(F); } SEAM(0);

    layer_body<0>(F, bar, lo, hi);
    layer_body<1>(F, bar, lo, hi);
    if (MK_PROBE_PHASE >= 0 && blockIdx.x == 0 && F.tid == 0) {
        volatile LAS unsigned long long* tsl = (volatile LAS unsigned long long*)(F.lds + LDSCTL_OFF + 64);
        if (MK_PROBE_LAST == 30) tsl[1] = __builtin_amdgcn_s_memrealtime();
        const unsigned long long span = (tsl[1] - tsl[0]) * MK_PROBE_AMP, t0 = __builtin_amdgcn_s_memrealtime();
        while (__builtin_amdgcn_s_memrealtime() - t0 < span) __builtin_amdgcn_s_sleep(8);
    }
#undef IN
#undef SEAM
}

extern "C" void kernel_launch(void* const* d_in, const int* in_sizes, int n_in, void* d_out, int out_size, void* d_ws, size_t ws_size, hipStream_t stream) {
    static int grid = 0;
    if (grid == 0) {
        if (n_in != 27 || in_sizes[0] != NT * ND || out_size != NT * ND || ws_size < WS_END) { fprintf(stderr, "kernel_launch: unexpected problem (n_in %d, in0 %d, out %d, ws %zu < %zu); nothing launched\n", n_in, n_in > 0 ? in_sizes[0] : -1, out_size, ws_size, (size_t)WS_END); grid = -1; return; }
        int dev = 0, cus = 0, per_cu = 0;
        if (hipGetDevice(&dev) != hipSuccess || hipDeviceGetAttribute(&cus, hipDeviceAttributeMultiprocessorCount, dev) != hipSuccess) { fprintf(stderr, "kernel_launch: device query failed\n"); grid = -1; return; }
        if (hipFuncSetAttribute((const void*)mk_fwd, hipFuncAttributeMaxDynamicSharedMemorySize, LDS_BYTES) != hipSuccess) { fprintf(stderr, "kernel_launch: hipFuncSetAttribute failed\n"); grid = -1; return; }
        if (hipOccupancyMaxActiveBlocksPerMultiprocessor(&per_cu, (const void*)mk_fwd, NWAVES * 64, LDS_BYTES) != hipSuccess || per_cu < 1) fprintf(stderr, "kernel_launch: note: occupancy query reports %d\n", per_cu);
        (void)hipGetLastError();
        grid = cus;
    }
    if (grid < 0) return;
    if (hipMemsetAsync((char*)d_ws + WS_CTL, 0, CTL_ZERO_BYTES, stream) != hipSuccess) { fprintf(stderr, "kernel_launch: memset failed\n"); return; }
    Args a{};
    for (int i = 0; i < 27; ++i) a.in[i] = (const float*)d_in[i];
    a.out = (float*)d_out; a.ws = (unsigned char*)d_ws;
#if MK_ONE_LAUNCH
    a.ph_lo = 0; a.ph_hi = NPHASE;
    hipLaunchKernelGGL(mk_fwd, dim3(grid), dim3(NWAVES * 64), LDS_BYTES, stream, a);
#else
    for (int p = 0; p < NPHASE; ++p) {
        const int lp = (p - 1) & 15;
        if (p >= 1) { const int l = (p - 1) >> 4; if (lp >= 14) continue; if (l == 0 && lp >= 3 && lp <= 5) continue; }
        a.ph_lo = p; a.ph_hi = p + 1;
        hipLaunchKernelGGL(mk_fwd, dim3(grid), dim3(NWAVES * 64), LDS_BYTES, stream, a);
    }
#endif
    const hipError_t le = hipPeekAtLastError();
    if (le != hipSuccess) fprintf(stderr, "kernel_launch: launch failed: %s\n", hipGetErrorName(le));
}
```

```cpp
#include <hip/hip_runtime.h>
#include <cstdio>
#include <cstdint>

#ifndef MK_ONE_LAUNCH
#define MK_ONE_LAUNCH 1
#endif
#ifndef MK_FP8_MOE
#define MK_FP8_MOE 1
#endif
#ifndef MK_PROBE_PHASE
#define MK_PROBE_PHASE -1
#endif
#ifndef MK_PROBE_LAST
#define MK_PROBE_LAST MK_PROBE_PHASE
#endif
#ifndef MK_PROBE_AMP
#define MK_PROBE_AMP 4
#endif

#define GAS __attribute__((address_space(1)))
#define LAS __attribute__((address_space(3)))
typedef unsigned short bf16;
typedef unsigned v4u __attribute__((ext_vector_type(4)));
typedef unsigned v2u __attribute__((ext_vector_type(2)));
typedef float f32x4 __attribute__((ext_vector_type(4)));
typedef float f32x2 __attribute__((ext_vector_type(2)));
typedef short bf16x8 __attribute__((ext_vector_type(8)));

constexpr int NB = 8, NS = 2048, ND = 2048, NT = NB * NS;
constexpr float DN_ALPHA = 1.41421356237309505f;
constexpr float LN_EPS = 1e-5f, NORM_EPS = 1e-6f;
constexpr int AB_IN = 5120, CD_IN = 3544, CD_INP = 3584;
constexpr int NEXP = 64, EFF = 512;
constexpr int MAXROWS = NT * 8 + NEXP * 256;
constexpr int MAXTILES = MAXROWS / 256;
constexpr int SH_ROW0 = MAXROWS;

constexpr size_t MiB = 1u << 20;
constexpr size_t WS_CTL = 0, CTL_ZERO_BYTES = 1 * MiB;
constexpr size_t WS_TOPE = 1 * MiB, WS_WSEL = WS_TOPE + 512 * 1024, WS_SLOT = 2 * MiB, WS_SORTED = WS_SLOT + 512 * 1024;
constexpr size_t WS_CMPB = 3 * MiB + 256 * 1024, WS_SELM = 3 * MiB + 512 * 1024;
constexpr size_t WS_KVCMP = 4 * MiB;
constexpr size_t WS_HID = 6 * MiB;
constexpr size_t WS_WABIN = 16 * MiB, WS_WABOUT = 36 * MiB, WS_WCDIN = 44 * MiB, WS_WCDOUT = 58 * MiB, WS_WUQ = 66 * MiB, WS_WUKV = 68 * MiB, WS_CW1 = 70 * MiB, WS_RT = 72 * MiB;
constexpr size_t WS_W13 = 74 * MiB, WS_W2 = 334 * MiB, WS_MOE_LSTRIDE = 390 * MiB;
constexpr size_t WS_XB0 = 854 * MiB, WS_X2B = 854 * MiB, WS_X1B = 918 * MiB;
constexpr size_t WS_H = 982 * MiB, WS_Y2 = 1142 * MiB, WS_X1F8 = 1782 * MiB, WS_END = 1814 * MiB;
constexpr size_t WS_PROJ = 982 * MiB, WS_MIXIN = 1142 * MiB, WS_MIXO = 1206 * MiB;
constexpr size_t WS_QR = 1270 * MiB, WS_KR = 1294 * MiB;
constexpr size_t WS_CQN = 1270 * MiB, WS_CKVN = 1282 * MiB, WS_KROT = 1298 * MiB, WS_QMLA = 1302 * MiB, WS_KVU = 1350 * MiB, WS_CMPKV = 1414 * MiB, WS_OCMP = 1434 * MiB;
constexpr size_t WS_LOGITS = 1142 * MiB;
constexpr int CW_TMO = 0, CW_CODE = 1, CW_BAR = 4096, CW_CNT = 16384;

constexpr int RING_BYTES = 131072, LDSCTL_OFF = RING_BYTES, MISC_OFF = LDSCTL_OFF + 320, TAB_OFF = LDSCTL_OFF + 512;
constexpr int LDS_BYTES = 147456;
constexpr int NWAVES = 8;

#define LDS_WAIT() asm volatile("s_waitcnt lgkmcnt(0)" ::: "memory")
#define VM_WAIT() asm volatile("s_waitcnt vmcnt(0)" ::: "memory")
typedef __bf16 hwbf16x2 __attribute__((ext_vector_type(2)));
__device__ __forceinline__ unsigned pk2(float lo, float hi) { const f32x2 v = {lo, hi}; const hwbf16x2 b = __builtin_convertvector(v, hwbf16x2); return __builtin_bit_cast(unsigned, b); }
__device__ __forceinline__ unsigned f2bf(float f) { return pk2(f, 0.f) & 0xffffu; }
__device__ __forceinline__ void fast_sincos(float ang, float& sn, float& cs) { const float r = __builtin_amdgcn_fractf(ang * 0.15915494309189535f); sn = __builtin_amdgcn_sinf(r); cs = __builtin_amdgcn_cosf(r); }
__device__ __forceinline__ float bflo(unsigned w) { return __builtin_bit_cast(float, w << 16); }
__device__ __forceinline__ float bfhi(unsigned w) { return __builtin_bit_cast(float, w & 0xffff0000u); }
__device__ __forceinline__ float bf1(bf16 v) { return __builtin_bit_cast(float, ((unsigned)v) << 16); }
__device__ __forceinline__ float wave_sum(float v) {
#pragma unroll
    for (int o = 1; o < 64; o <<= 1) v += __shfl_xor(v, o);
    return v;
}
__device__ __forceinline__ float wave_max(float v) {
#pragma unroll
    for (int o = 1; o < 64; o <<= 1) v = fmaxf(v, __shfl_xor(v, o));
    return v;
}
__device__ __forceinline__ float sigmoidf_(float x) { return 1.0f / (1.0f + __expf(-x)); }
__device__ __forceinline__ float siluf_(float x) { return x / (1.0f + __expf(-x)); }
__device__ __forceinline__ void unpack8(const v4u w, float (&f)[8]) {
    f[0] = bflo(w.x); f[1] = bfhi(w.x); f[2] = bflo(w.y); f[3] = bfhi(w.y); f[4] = bflo(w.z); f[5] = bfhi(w.z); f[6] = bflo(w.w); f[7] = bfhi(w.w);
}

#define XB_TMO      128
#define XB_XCNT(j)  (256  + 64 * (j))
#define XB_XSUB(j)  (1280 + 64 * (j))
#define XB_XGEN(j)  (2304 + 64 * (j))
#define XB_TOP      3328
#define XB_TOPGEN   3392
#define XCD_BAR_WORDS 3456
#define XB_SPIN_CAP (1u << 18)
__device__ __forceinline__ unsigned xb_ld(unsigned* p)              { return __hip_atomic_load(p, __ATOMIC_RELAXED, __HIP_MEMORY_SCOPE_AGENT); }
__device__ __forceinline__ unsigned xb_add(unsigned* p, unsigned v) { return __hip_atomic_fetch_add(p, v, __ATOMIC_RELAXED, __HIP_MEMORY_SCOPE_AGENT); }
__device__ __forceinline__ unsigned xb_xcc_id() { return (unsigned)__builtin_amdgcn_s_getreg((3 << 11) | 20) & 0xFu; }
#define XB_SPIN(cond, bar) do { unsigned _sp = 0; while (cond) { __builtin_amdgcn_s_sleep(1); \
    if ((++_sp & 255u) == 0u) { if (xb_ld(&(bar)[XB_TMO])) break; if (_sp > XB_SPIN_CAP) { atomicAdd(&(bar)[XB_TMO], 1u); break; } } } } while (0)
struct XcdBarrier { unsigned* bar; unsigned x; volatile LAS unsigned* st; };
__device__ __forceinline__ XcdBarrier xcd_barrier_post(unsigned* bar, volatile LAS unsigned* st) {
    XcdBarrier b; b.bar = bar; b.x = xb_xcc_id(); b.st = st;
    if (threadIdx.x == 0) (void)xb_add(&bar[XB_XCNT(b.x)], 1u);
    return b;
}
__device__ __forceinline__ void xcd_barrier_complete(unsigned* bar, unsigned x, unsigned& nloc, unsigned& nx) {
    const unsigned G = gridDim.x * gridDim.y * gridDim.z;
    unsigned sum, cnt, mine, sp = 0u;
    for (;;) {
        sum = 0u; cnt = 0u; mine = 0u;
#pragma unroll
        for (unsigned j = 0; j < 16; ++j) { const unsigned c = xb_ld(&bar[XB_XCNT(j)]); sum += c; cnt += (c > 0u) ? 1u : 0u; mine = (j == x) ? c : mine; }
        if (sum == G) break;
        __builtin_amdgcn_s_sleep(1);
        if ((++sp & 255u) == 0u) { if (xb_ld(&bar[XB_TMO])) break; if (sp > XB_SPIN_CAP) { atomicAdd(&bar[XB_TMO], 1u); break; } }
    }
    nloc = mine > 0u ? mine : 1u; nx = cnt > 0u ? cnt : 1u;
}
__device__ __forceinline__ void xcd_barrier(const XcdBarrier& b) {
    asm volatile("s_waitcnt vmcnt(0)" ::: "memory");
    __syncthreads();
    if (threadIdx.x == 0) {
        unsigned* bar = b.bar;
        __builtin_amdgcn_s_waitcnt(0);
        unsigned nloc = b.st[0], nx = b.st[1];
        if (nloc == 0u) { xcd_barrier_complete(bar, b.x, nloc, nx); b.st[0] = nloc; b.st[1] = nx; }
        const unsigned old = xb_add(&bar[XB_XSUB(b.x)], 1u);
        const unsigned gen = old / nloc;
        if (old + 1u == (gen + 1u) * nloc) {
            __builtin_amdgcn_fence(__ATOMIC_RELEASE, "agent");
            asm volatile("s_waitcnt vmcnt(0)" ::: "memory");
            const unsigned og = xb_add(&bar[XB_TOP], 1u);
            const unsigned tg = og / nx;
            if (og + 1u == (tg + 1u) * nx) xb_add(&bar[XB_TOPGEN], 1u);
            else XB_SPIN(xb_ld(&bar[XB_TOPGEN]) == tg, bar);
            __builtin_amdgcn_fence(__ATOMIC_ACQUIRE, "agent");
            xb_add(&bar[XB_XGEN(b.x)], 1u);
            asm volatile("s_waitcnt vmcnt(0)" ::: "memory");
        } else {
            XB_SPIN(xb_ld(&bar[XB_XGEN(b.x)]) == gen, bar);
            __builtin_amdgcn_fence(__ATOMIC_ACQUIRE, "agent");
            asm volatile("s_waitcnt vmcnt(0)" ::: "memory");
        }
    }
    __syncthreads();
}

namespace pg8 {
typedef int v4i_t __attribute__((ext_vector_type(4)));
constexpr int BM = 256, BK = 64, HALF = 128, HTB = HALF * BK * 2, STAGE_BYTES = 8 * HTB, NXCD = 8, WGM = 8;
__host__ __device__ __forceinline__ int lds_byte(int r, int c) { const int st = (r >> 4) * 2 + (c >> 5), rr = r & 15, cc = c & 31, ob = rr * 64 + cc * 2; return st * 1024 + (ob ^ (((ob >> 9) & 1) << 5)); }
__host__ __device__ __forceinline__ void stage_rc(int b, int& R, int& C) { const int st = b / 1024, sb = b % 1024, swz = sb ^ (((sb >> 9) & 1) << 5); R = (st >> 1) * 16 + swz / 64; C = (st & 1) * 32 + (swz % 64) / 2; }
__host__ __device__ __forceinline__ int perm32(int rho) { const int n = rho >> 4, i = rho & 15; return 8 * (i >> 2) + 4 * n + (i & 3); }
struct Unit { int pm, pn, e; };

__device__ __forceinline__ unsigned cvt_pk_bf16(float lo, float hi) { unsigned r; asm volatile("v_cvt_pk_bf16_f32 %0, %1, %2" : "=v"(r) : "v"(lo), "v"(hi)); return r; }

struct EpiBf16 {
    static constexpr bool PERM = true;
    bf16* O; int ldc;
    __device__ __forceinline__ void operator()(const f32x4 (&acc)[2][2][4][2], const Unit& u, int wr, int wc, int fr, int fq) const {
        const int row0 = u.pm * BM + wr * 64 + fr, col0 = u.pn * BM + wc * 32 + 8 * fq;
#pragma unroll
        for (int ai = 0; ai < 2; ++ai)
#pragma unroll
            for (int m = 0; m < 4; ++m) { bf16* rowp = O + (size_t)(row0 + ai * HALF + m * 16) * ldc + col0;
#pragma unroll
                for (int bj = 0; bj < 2; ++bj) { const f32x4 v0 = acc[ai][bj][m][0], v1 = acc[ai][bj][m][1];
                    v4u w; w.x = cvt_pk_bf16(v0[0], v0[1]); w.y = cvt_pk_bf16(v0[2], v0[3]); w.z = cvt_pk_bf16(v1[0], v1[1]); w.w = cvt_pk_bf16(v1[2], v1[3]);
                    *(v4u*)(rowp + bj * HALF) = w; } }
    }
};
struct EpiFp8 {
    static constexpr bool PERM = true;
    unsigned char* O; int ldc; float mul;
    __device__ __forceinline__ void operator()(const f32x4 (&acc)[2][2][4][2], const Unit& u, int wr, int wc, int fr, int fq) const {
        const int row0 = u.pm * BM + wr * 64 + fr, col0 = u.pn * BM + wc * 32 + 8 * fq;
#pragma unroll
        for (int ai = 0; ai < 2; ++ai)
#pragma unroll
            for (int m = 0; m < 4; ++m) { unsigned char* rowp = O + (size_t)(row0 + ai * HALF + m * 16) * ldc + col0;
#pragma unroll
                for (int bj = 0; bj < 2; ++bj) { float v[8];
#pragma unroll
                    for (int n = 0; n < 2; ++n)
#pragma unroll
                        for (int j = 0; j < 4; ++j) v[n * 4 + j] = fminf(fmaxf(acc[ai][bj][m][n][j] * mul, -448.0f), 448.0f);
                    int w0 = __builtin_amdgcn_cvt_pk_fp8_f32(v[0], v[1], 0, false); w0 = __builtin_amdgcn_cvt_pk_fp8_f32(v[2], v[3], w0, true);
                    int w1 = __builtin_amdgcn_cvt_pk_fp8_f32(v[4], v[5], 0, false); w1 = __builtin_amdgcn_cvt_pk_fp8_f32(v[6], v[7], w1, true);
                    *(v2u*)(rowp + bj * HALF) = (v2u){(unsigned)w0, (unsigned)w1}; } }
    }
};
struct EpiF32 {
    static constexpr bool PERM = false;
    float* C; int ldc; const float* bias;
    __device__ __forceinline__ void operator()(const f32x4 (&acc)[2][2][4][2], const Unit& u, int wr, int wc, int fr, int fq) const {
        const int row0 = u.pm * BM + wr * 64 + fr, col0 = u.pn * BM + wc * 32 + 4 * fq;
        f32x4 bv[2][2];
#pragma unroll
        for (int bj = 0; bj < 2; ++bj)
#pragma unroll
            for (int n = 0; n < 2; ++n) bv[bj][n] = bias ? *(const f32x4*)(bias + col0 + bj * HALF + n * 16) : (f32x4){0.f, 0.f, 0.f, 0.f};
#pragma unroll
        for (int ai = 0; ai < 2; ++ai)
#pragma unroll
            for (int m = 0; m < 4; ++m) { float* rowp = C + (size_t)(row0 + ai * HALF + m * 16) * ldc + col0;
#pragma unroll
                for (int bj = 0; bj < 2; ++bj)
#pragma unroll
                    for (int n = 0; n < 2; ++n) *(f32x4*)(rowp + bj * HALF + n * 16) = acc[ai][bj][m][n] + bv[bj][n]; }
    }
};
struct EpiSwiglu {
    static constexpr bool PERM = true;
    bf16* H;
    __device__ __forceinline__ void operator()(const f32x4 (&acc)[2][2][4][2], const Unit& u, int wr, int wc, int fr, int fq) const {
        const int row0 = u.pm * BM + wr * 64 + fr, col0 = u.pn * HALF + wc * 32 + 8 * fq;
#pragma unroll
        for (int ai = 0; ai < 2; ++ai)
#pragma unroll
            for (int m = 0; m < 4; ++m) { bf16* rowp = H + (size_t)(row0 + ai * HALF + m * 16) * EFF + col0;
                float o[8];
#pragma unroll
                for (int n = 0; n < 2; ++n)
#pragma unroll
                    for (int j = 0; j < 4; ++j) { const float h1 = acc[ai][0][m][n][j], h3 = acc[ai][1][m][n][j]; o[n * 4 + j] = siluf_(h1) * h3; }
                v4u w; w.x = cvt_pk_bf16(o[0], o[1]); w.y = cvt_pk_bf16(o[2], o[3]); w.z = cvt_pk_bf16(o[4], o[5]); w.w = cvt_pk_bf16(o[6], o[7]);
                *(v4u*)rowp = w; }
    }
};

template <class Epi, class Prob, bool ALIGN_EPI, bool F8 = false>
__device__ __forceinline__ void gemm_phase(LAS unsigned char* lds, const Prob& P, const Epi& E) {
    const int tid = threadIdx.x, wid = __builtin_amdgcn_readfirstlane(tid >> 6), lane = tid & 63, wr = wid >> 2, wc = wid & 3, fr = lane & 15, fq = lane >> 4;
    const int K = P.K, nt = K / BK, ldb = P.ldb;
    unsigned voffB[2];
#pragma unroll
    for (int i = 0; i < 2; ++i) { int R, C; stage_rc(tid * 16 + i * 8192, R, C); const int Rb = Epi::PERM ? ((R & ~31) + perm32(R & 31)) : R;
        voffB[i] = (unsigned)(Rb * ldb + C) * 2u; }
    const size_t kstep = (size_t)(BK * 2);
    const size_t hstep = (size_t)HALF * ldb * 2;
    const unsigned ldsw = (unsigned)wid * 1024u;
    const int aoff = lds_byte(wr * 64 + fr, fq * 8), boff = lds_byte(wc * 32 + fr, fq * 8);
    const char* const Ab = P.Abase;
#define PG8_SA(b, h) (((b) * 2 + (h)) * HTB)
#define PG8_SB(b, h) ((4 + (b) * 2 + (h)) * HTB)
#define PG8_STAGE(bufoff, gbase, voff) do { _Pragma("unroll") for (int _i = 0; _i < 2; ++_i) \
        __builtin_amdgcn_global_load_lds((const unsigned*)((const char*)(gbase) + (voff)[_i]), (LAS unsigned*)(lds + (bufoff) + ldsw + _i * 8192), 16, 0, 0); } while (0)
#define PG8_STAGE_A(bufoff, kb, o0, o1) do { \
        __builtin_amdgcn_global_load_lds((const unsigned*)(Ab + (kb) + (o0)), (LAS unsigned*)(lds + (bufoff) + ldsw), 16, 0, 0); \
        __builtin_amdgcn_global_load_lds((const unsigned*)(Ab + (kb) + (o1)), (LAS unsigned*)(lds + (bufoff) + ldsw + 8192), 16, 0, 0); } while (0)
#define PG8_LDA(dst, b, h) do { _Pragma("unroll") for (int m = 0; m < 4; ++m) _Pragma("unroll") for (int k = 0; k < 2; ++k) dst[m][k] = *(const LAS bf16x8*)(lds + PG8_SA(b, h) + aoff + m * 2048 + k * 1024); } while (0)
#define PG8_LDB(dst, b, h) do { _Pragma("unroll") for (int n = 0; n < 2; ++n) _Pragma("unroll") for (int k = 0; k < 2; ++k) dst[n][k] = *(const LAS bf16x8*)(lds + PG8_SB(b, h) + boff + n * 2048 + k * 1024); } while (0)
#define PG8_CAT(lo, hi) __builtin_shufflevector(__builtin_bit_cast(v4i_t, lo), __builtin_bit_cast(v4i_t, hi), 0, 1, 2, 3, 4, 5, 6, 7)
#define PG8_MMA(ai, bj, At, Bt) do { __builtin_amdgcn_s_setprio(1); \
        if constexpr (F8) { _Pragma("unroll") for (int m = 0; m < 4; ++m) _Pragma("unroll") for (int n = 0; n < 2; ++n) \
            acc[ai][bj][m][n] = __builtin_amdgcn_mfma_scale_f32_16x16x128_f8f6f4(PG8_CAT(Bt[n][0], Bt[n][1]), PG8_CAT(At[m][0], At[m][1]), acc[ai][bj][m][n], 0, 0, 0, 0x7F7F7F7F, 0, 0x7F7F7F7F); } \
        else { _Pragma("unroll") for (int m = 0; m < 4; ++m) _Pragma("unroll") for (int n = 0; n < 2; ++n) _Pragma("unroll") for (int k = 0; k < 2; ++k) \
            acc[ai][bj][m][n] = __builtin_amdgcn_mfma_f32_16x16x32_bf16(Bt[n][k], At[m][k], acc[ai][bj][m][n], 0, 0, 0); } \
        __builtin_amdgcn_s_setprio(0); } while (0)
#define PG8_WAIT_V(n) asm volatile("s_waitcnt vmcnt(" #n ")" ::: "memory")
#define PG8_WAIT_L(n) asm volatile("s_waitcnt lgkmcnt(" #n ")" ::: "memory")
#define PG8_BAR __builtin_amdgcn_s_barrier()
#define PG8_SCHED __builtin_amdgcn_sched_barrier(0)
    Unit cur, nxt; int ui = 0;
    if (!P.next(0, cur)) return;
    f32x4 acc[2][2][4][2];
#pragma unroll
    for (int a = 0; a < 2; ++a)
#pragma unroll
        for (int b = 0; b < 2; ++b)
#pragma unroll
            for (int m = 0; m < 4; ++m)
#pragma unroll
                for (int n = 0; n < 2; ++n) acc[a][b][m][n] = (f32x4){0.f, 0.f, 0.f, 0.f};
    bf16x8 At[4][2], B0[2][2], B1[2][2];
    unsigned oc[4], on[4];
    { int RA[2], CA[2]; stage_rc(tid * 16, RA[0], CA[0]); stage_rc(tid * 16 + 8192, RA[1], CA[1]); P.aoffs(cur, RA, CA, oc); }
    const char* cB = P.bbase(cur);
    if constexpr (F8) {
        PG8_STAGE(PG8_SB(0, 0), cB, voffB); PG8_STAGE_A(PG8_SA(0, 0), (size_t)0, oc[0], oc[1]); PG8_STAGE_A(PG8_SA(0, 1), (size_t)0, oc[2], oc[3]);
        if (wr == 1) PG8_BAR;
        PG8_WAIT_V(2); PG8_BAR;
        PG8_STAGE(PG8_SB(1, 0), cB + kstep, voffB); PG8_STAGE_A(PG8_SA(1, 0), kstep, oc[0], oc[1]);
        PG8_WAIT_V(4); PG8_BAR;
    } else {
    PG8_STAGE(PG8_SB(0, 0), cB, voffB); PG8_STAGE(PG8_SB(0, 1), cB + hstep, voffB); PG8_STAGE_A(PG8_SA(0, 0), (size_t)0, oc[0], oc[1]); PG8_STAGE_A(PG8_SA(0, 1), (size_t)0, oc[2], oc[3]);
    if (wr == 1) PG8_BAR;
    PG8_WAIT_V(2); PG8_BAR;
    PG8_STAGE(PG8_SB(1, 0), cB + kstep, voffB); PG8_STAGE_A(PG8_SA(1, 0), kstep, oc[0], oc[1]); PG8_STAGE(PG8_SB(1, 1), cB + hstep + kstep, voffB);
    PG8_WAIT_V(6); PG8_BAR;
    }
    for (;;) {
        const bool has_next = P.next(ui + 1, nxt);
        const char* nB = cB;
        if (has_next) { int RA[2], CA[2]; stage_rc(tid * 16, RA[0], CA[0]); stage_rc(tid * 16 + 8192, RA[1], CA[1]); P.aoffs(nxt, RA, CA, on); nB = P.bbase(nxt); }
        else { on[0] = oc[0]; on[1] = oc[1]; on[2] = oc[2]; on[3] = oc[3]; }
#pragma clang loop unroll(disable)
        for (int t = 0; t < nt; t += 2) {
            const bool last = (t == nt - 2);
            const size_t kb1 = (size_t)(t + 1) * kstep;
            const size_t kb2 = last ? (size_t)0 : (size_t)(t + 2) * kstep, kb3 = kb2 + kstep;
            const char* b2 = last ? nB : cB + (size_t)(t + 2) * kstep; const char* b3 = b2 + kstep;
            const unsigned o20 = last ? on[0] : oc[0], o21 = last ? on[1] : oc[1], o22 = last ? on[2] : oc[2], o23 = last ? on[3] : oc[3];
            if constexpr (F8) {
            PG8_LDB(B0, 0, 0); PG8_SCHED; PG8_LDA(At, 0, 0); PG8_STAGE_A(PG8_SA(1, 1), kb1, oc[2], oc[3]);
            PG8_WAIT_V(6); PG8_WAIT_L(0); PG8_BAR; PG8_MMA(0, 0, At, B0); PG8_BAR; PG8_SCHED;
            PG8_LDA(At, 0, 1); PG8_STAGE(PG8_SB(0, 0), b2, voffB); PG8_STAGE_A(PG8_SA(0, 0), kb2, o20, o21);
            PG8_WAIT_V(6); PG8_WAIT_L(0); PG8_BAR; PG8_MMA(1, 0, At, B0); PG8_BAR; PG8_SCHED;
            PG8_LDB(B0, 1, 0); PG8_SCHED; PG8_LDA(At, 1, 0); PG8_STAGE_A(PG8_SA(0, 1), kb2, o22, o23);
            PG8_WAIT_V(6); PG8_WAIT_L(0); PG8_BAR; PG8_MMA(0, 0, At, B0); PG8_BAR; PG8_SCHED;
            PG8_LDA(At, 1, 1); PG8_STAGE(PG8_SB(1, 0), b3, voffB); PG8_STAGE_A(PG8_SA(1, 0), kb3, o20, o21);
            PG8_WAIT_V(6); PG8_WAIT_L(0); PG8_BAR; PG8_MMA(1, 0, At, B0); PG8_BAR; PG8_SCHED;
            } else {
            PG8_LDB(B0, 0, 0); PG8_LDB(B1, 0, 1); PG8_SCHED; PG8_LDA(At, 0, 0); PG8_STAGE_A(PG8_SA(1, 1), kb1, oc[2], oc[3]);
            PG8_WAIT_V(8); PG8_WAIT_L(0); PG8_BAR; PG8_MMA(0, 0, At, B0); PG8_MMA(0, 1, At, B1); PG8_BAR; PG8_SCHED;
            PG8_LDA(At, 0, 1); PG8_STAGE(PG8_SB(0, 0), b2, voffB); PG8_STAGE(PG8_SB(0, 1), b2 + hstep, voffB); PG8_STAGE_A(PG8_SA(0, 0), kb2, o20, o21);
            PG8_WAIT_V(8); PG8_WAIT_L(0); PG8_BAR; PG8_MMA(1, 0, At, B0); PG8_MMA(1, 1, At, B1); PG8_BAR; PG8_SCHED;
            PG8_LDB(B0, 1, 0); PG8_LDB(B1, 1, 1); PG8_SCHED; PG8_LDA(At, 1, 0); PG8_STAGE_A(PG8_SA(0, 1), kb2, o22, o23);
            PG8_WAIT_V(8); PG8_WAIT_L(0); PG8_BAR; PG8_MMA(0, 0, At, B0); PG8_MMA(0, 1, At, B1); PG8_BAR; PG8_SCHED;
            PG8_LDA(At, 1, 1); PG8_STAGE(PG8_SB(1, 0), b3, voffB); PG8_STAGE(PG8_SB(1, 1), b3 + hstep, voffB); PG8_STAGE_A(PG8_SA(1, 0), kb3, o20, o21);
            PG8_WAIT_V(8); PG8_WAIT_L(0); PG8_BAR; PG8_MMA(1, 0, At, B0); PG8_MMA(1, 1, At, B1); PG8_BAR; PG8_SCHED;
            }
        }
        if constexpr (ALIGN_EPI) { if (wr == 0) PG8_BAR; }
        E(acc, cur, wr, wc, fr, fq);
        if (!has_next) break;
#pragma unroll
        for (int a = 0; a < 2; ++a)
#pragma unroll
            for (int b = 0; b < 2; ++b)
#pragma unroll
                for (int m = 0; m < 4; ++m)
#pragma unroll
                    for (int n = 0; n < 2; ++n) acc[a][b][m][n] = (f32x4){0.f, 0.f, 0.f, 0.f};
        cur = nxt; cB = nB; oc[0] = on[0]; oc[1] = on[1]; oc[2] = on[2]; oc[3] = on[3]; ++ui;
        if constexpr (ALIGN_EPI) { if (wr == 1) PG8_BAR; }
    }
    PG8_WAIT_V(0);
    if constexpr (!ALIGN_EPI) { if (wr == 0) PG8_BAR; }
    PG8_BAR;
#undef PG8_SA
#undef PG8_SB
#undef PG8_STAGE
#undef PG8_STAGE_A
#undef PG8_LDA
#undef PG8_LDB
#undef PG8_MMA
#undef PG8_CAT
#undef PG8_WAIT_V
#undef PG8_WAIT_L
#undef PG8_BAR
#undef PG8_SCHED
}

struct DenseProb {
    int K, ldb; const char* Abase; const char* Bt; int lda; int nM, nN, nwg, G, c;
    __device__ __forceinline__ void init(const bf16* A, int lda_, const bf16* B, int M, int N, int K_, int G_, int c_) { Abase = (const char*)A; Bt = (const char*)B; lda = lda_; K = K_; ldb = K_; nM = M / BM; nN = N / BM; nwg = nM * nN; G = G_; c = c_; }
    __device__ __forceinline__ bool next(int i, Unit& u) const {
        const long L = (long)i * G + c; if (L >= nwg) return false;
        int wgid = (int)L; { const int q = nwg / NXCD, r = nwg % NXCD, xcd = wgid % NXCD, off = wgid / NXCD; wgid = (xcd < r ? xcd * (q + 1) : r * (q + 1) + (xcd - r) * q) + off; }
        const int nig = WGM * nN, gid = wgid / nig, fm = gid * WGM, gsz = (nM - fm) < WGM ? (nM - fm) : WGM;
        u.pm = fm + ((wgid % nig) % gsz); u.pn = (wgid % nig) / gsz; u.e = 0; return true;
    }
    __device__ __forceinline__ const char* bbase(const Unit& u) const { return Bt + (size_t)u.pn * BM * K * 2; }
    __device__ __forceinline__ void aoffs(const Unit& u, const int (&R)[2], const int (&C)[2], unsigned (&o)[4]) const {
#pragma unroll
        for (int h = 0; h < 2; ++h)
#pragma unroll
            for (int i = 0; i < 2; ++i) o[2 * h + i] = (unsigned)(((size_t)(u.pm * BM + h * HALF + R[i]) * lda + C[i]) * 2);
    }
};
__device__ __forceinline__ bool xcd_range_unit(int i, int nunits, int G, int c, int& L) {
    const int x = c % NXCD, cc = c / NXCD, per = G / NXCD, q = nunits / NXCD, r = nunits % NXCD;
    const int start = x * q + (x < r ? x : r), cnt = q + (x < r ? 1 : 0), li = i * per + cc;
    if (li >= cnt) return false; L = start + li; return true;
}
struct MoeUpProb {
    int K, ldb; int arow, brow;
    int pshift, btile;
    const char* Abase; const char* W13; const int* sorted; const LAS int* tile_e; int ntiles, nunits, G, c;
    __device__ __forceinline__ bool next(int i, Unit& u) const {
        int L; if (!xcd_range_unit(i, nunits, G, c, L)) return false;
        const int tile = L >> pshift; u.pn = L & ((1 << pshift) - 1);
        if (tile < ntiles) { u.pm = tile; u.e = __builtin_amdgcn_readfirstlane(tile_e[tile]); } else { u.pm = MAXTILES + (tile - ntiles); u.e = NEXP; }
        return true;
    }
    __device__ __forceinline__ const char* bbase(const Unit& u) const { return W13 + ((size_t)u.e * 1024 + (size_t)u.pn * btile) * brow; }
    __device__ __forceinline__ void aoffs(const Unit& u, const int (&R)[2], const int (&C)[2], unsigned (&o)[4]) const {
#pragma unroll
        for (int h = 0; h < 2; ++h)
#pragma unroll
            for (int i = 0; i < 2; ++i) { int row;
                if (u.e == NEXP) row = (u.pm - MAXTILES) * BM + h * HALF + R[i];
                else row = sorted[u.pm * BM + h * HALF + R[i]];
                o[2 * h + i] = (unsigned)((size_t)row * arow + C[i] * 2); }
    }
};
struct MoeDownProb {
    int K, ldb; int arow, brow, pshift, btile; const char* Abase; const char* W2; const LAS int* tile_e; int ntiles, nunits, G, c;
    __device__ __forceinline__ bool next(int i, Unit& u) const {
        int L; if (!xcd_range_unit(i, nunits, G, c, L)) return false;
        const int tile = L >> pshift; u.pn = L & ((1 << pshift) - 1);
        if (tile < ntiles) { u.pm = tile; u.e = __builtin_amdgcn_readfirstlane(tile_e[tile]); } else { u.pm = MAXTILES + (tile - ntiles); u.e = NEXP; }
        return true;
    }
    __device__ __forceinline__ const char* bbase(const Unit& u) const { return W2 + ((size_t)u.e * 2048 + (size_t)u.pn * btile) * brow; }
    __device__ __forceinline__ void aoffs(const Unit& u, const int (&R)[2], const int (&C)[2], unsigned (&o)[4]) const {
#pragma unroll
        for (int h = 0; h < 2; ++h)
#pragma unroll
            for (int i = 0; i < 2; ++i) o[2 * h + i] = (unsigned)((size_t)(u.pm * BM + h * HALF + R[i]) * arow + C[i] * 2);
    }
};
struct CmpProb {
    int K, ldb; const char* Abase; const char* Bt; int G, c;
    __device__ __forceinline__ bool next(int i, Unit& u) const { const int L = i * G + c; if (L >= 16) return false; u.pm = L; u.pn = 0; u.e = 0; return true; }
    __device__ __forceinline__ const char* bbase(const Unit&) const { return Bt; }
    __device__ __forceinline__ void aoffs(const Unit& u, const int (&R)[2], const int (&C)[2], unsigned (&o)[4]) const {
#pragma unroll
        for (int h = 0; h < 2; ++h)
#pragma unroll
            for (int i = 0; i < 2; ++i) { const int m = u.pm * BM + h * HALF + R[i], seq = m >> 7, n = m & 127;
                o[2 * h + i] = (unsigned)((((size_t)seq * NS + 16 * n) * 128 + C[i]) * 2); }
    }
};
struct RouterProb {
    int K, ldb; const char* Abase; const char* Bt; int G, c;
    __device__ __forceinline__ bool next(int i, Unit& u) const { const int L = i * G + c; if (L >= (NT / BM) * 4) return false; u.pm = L >> 2; u.pn = 0; u.e = L & 3; return true; }
    __device__ __forceinline__ const char* bbase(const Unit& u) const { return Bt + (size_t)u.e * 512 * 2; }
    __device__ __forceinline__ void aoffs(const Unit& u, const int (&R)[2], const int (&C)[2], unsigned (&o)[4]) const {
#pragma unroll
        for (int h = 0; h < 2; ++h)
#pragma unroll
            for (int i = 0; i < 2; ++i) o[2 * h + i] = (unsigned)(((size_t)(u.pm * BM + h * HALF + R[i]) * ND + u.e * 512 + C[i]) * 2);
    }
};
struct EpiF32N64 {
    static constexpr bool PERM = false;
    float* C;
    __device__ __forceinline__ void operator()(const f32x4 (&acc)[2][2][4][2], const Unit& u, int wr, int wc, int fr, int fq) const {
        if (wc >= 2) return;
        const int row0 = u.pm * BM + wr * 64 + fr, col0 = wc * 32 + 4 * fq;
#pragma unroll
        for (int ai = 0; ai < 2; ++ai)
#pragma unroll
            for (int m = 0; m < 4; ++m) { float* rowp = C + ((size_t)u.e * NT + row0 + ai * HALF + m * 16) * 64 + col0;
#pragma unroll
                for (int n = 0; n < 2; ++n) *(f32x4*)(rowp + n * 16) = acc[ai][0][m][n]; }
    }
};
struct EpiSwigluF8 {
    static constexpr bool PERM = true;
    unsigned char* H; float inmul;
    __device__ __forceinline__ void operator()(const f32x4 (&acc)[2][2][4][2], const Unit& u, int wr, int wc, int fr, int fq) const {
        const int row0 = u.pm * BM + wr * 64 + fr, col0 = u.pn * 64 + wc * 16 + 4 * fq;
#pragma unroll
        for (int ai = 0; ai < 2; ++ai)
#pragma unroll
            for (int m = 0; m < 4; ++m) { unsigned char* rowp = H + (size_t)(row0 + ai * HALF + m * 16) * EFF + col0;
                float o[4];
#pragma unroll
                for (int j = 0; j < 4; ++j) { const float h1 = acc[ai][0][m][0][j] * inmul, h3 = acc[ai][0][m][1][j] * inmul; o[j] = fminf(fmaxf(siluf_(h1) * h3 * 8.0f, -448.0f), 448.0f); }
                int w0 = __builtin_amdgcn_cvt_pk_fp8_f32(o[0], o[1], 0, false); w0 = __builtin_amdgcn_cvt_pk_fp8_f32(o[2], o[3], w0, true);
                *(unsigned*)rowp = (unsigned)w0; }
    }
};
struct EpiFp8N128 {
    static constexpr bool PERM = true;
    unsigned char* O; int ldc; float mul;
    __device__ __forceinline__ void operator()(const f32x4 (&acc)[2][2][4][2], const Unit& u, int wr, int wc, int fr, int fq) const {
        const int row0 = u.pm * BM + wr * 64 + fr, col0 = u.pn * HALF + wc * 32 + 8 * fq;
#pragma unroll
        for (int ai = 0; ai < 2; ++ai)
#pragma unroll
            for (int m = 0; m < 4; ++m) { unsigned char* rowp = O + (size_t)(row0 + ai * HALF + m * 16) * ldc + col0; float v[8];
#pragma unroll
                for (int n = 0; n < 2; ++n)
#pragma unroll
                    for (int j = 0; j < 4; ++j) v[n * 4 + j] = fminf(fmaxf(acc[ai][0][m][n][j] * mul, -448.0f), 448.0f);
                int w0 = __builtin_amdgcn_cvt_pk_fp8_f32(v[0], v[1], 0, false); w0 = __builtin_amdgcn_cvt_pk_fp8_f32(v[2], v[3], w0, true);
                int w1 = __builtin_amdgcn_cvt_pk_fp8_f32(v[4], v[5], 0, false); w1 = __builtin_amdgcn_cvt_pk_fp8_f32(v[6], v[7], w1, true);
                *(v2u*)rowp = (v2u){(unsigned)w0, (unsigned)w1}; }
    }
};
}

struct Args { const float* in[27]; float* out; unsigned char* ws; int ph_lo, ph_hi; };
typedef const __attribute__((address_space(4))) Args* CArgs;
__device__ __forceinline__ const float* kin(int i) { CArgs p = (CArgs)__builtin_amdgcn_kernarg_segment_ptr(); asm volatile("" : "+s"(p)); return p->in[i]; }
struct Frame {
    LAS unsigned char* lds;
    volatile LAS unsigned* MISC;
    unsigned* ctl;
    unsigned char* ws;
    int tid, lane, wave, vcu, G, gw, NGW;
    float* out;
};

__device__ __forceinline__ void tr_item(const float* W, int ldw, int k0, int n0, int nvalid, bf16* WT, int ldt, int drow0, LAS float* scr, int lane) {
    float v[32]; const int n = lane & 31; const bool okn = n < nvalid; const float* src = W + (size_t)(k0 + (lane >> 5)) * ldw + n0 + n;
#pragma unroll
    for (int i = 0; i < 32; ++i) v[i] = okn ? src[(size_t)(2 * i) * ldw] : 0.f;
#pragma unroll
    for (int i = 0; i < 32; ++i) scr[(2 * i + (lane >> 5)) * 33 + n] = v[i];
    LDS_WAIT(); asm volatile("" ::: "memory");
    const int c = lane & 7;
#pragma unroll
    for (int j = 0; j < 4; ++j) { const int nn = (lane >> 3) + 8 * j; const LAS float* sp = scr + (8 * c) * 33 + nn;
        v4u o; o.x = pk2(sp[0 * 33], sp[1 * 33]); o.y = pk2(sp[2 * 33], sp[3 * 33]); o.z = pk2(sp[4 * 33], sp[5 * 33]); o.w = pk2(sp[6 * 33], sp[7 * 33]);
        if (nn < nvalid) *(v4u*)(WT + (size_t)(drow0 + nn) * ldt + k0 + 8 * c) = o; }
    LDS_WAIT(); asm volatile("" ::: "memory");
}
__device__ __forceinline__ void tr_item_f8(const float* W, int ldw, int k0, int n0, unsigned char* WT8, int ldt, int drow0, int rowmode, float mul, LAS float* scr, int lane) {
    float v[32]; const int n = lane & 31; const float* src = W + (size_t)(k0 + (lane >> 5)) * ldw + n0 + n;
#pragma unroll
    for (int i = 0; i < 32; ++i) v[i] = src[(size_t)(2 * i) * ldw];
#pragma unroll
    for (int i = 0; i < 32; ++i) scr[(2 * i + (lane >> 5)) * 33 + n] = v[i];
    LDS_WAIT(); asm volatile("" ::: "memory");
    const int c = lane & 3;
#pragma unroll
    for (int j = 0; j < 2; ++j) { const int nn = (lane >> 2) + 16 * j; const LAS float* sp = scr + (16 * c) * 33 + nn; int w[4];
#pragma unroll
        for (int q = 0; q < 4; ++q) { const float a0 = fminf(fmaxf(sp[(4 * q + 0) * 33] * mul, -448.f), 448.f), a1 = fminf(fmaxf(sp[(4 * q + 1) * 33] * mul, -448.f), 448.f),
                                                  a2 = fminf(fmaxf(sp[(4 * q + 2) * 33] * mul, -448.f), 448.f), a3 = fminf(fmaxf(sp[(4 * q + 3) * 33] * mul, -448.f), 448.f);
            w[q] = __builtin_amdgcn_cvt_pk_fp8_f32(a0, a1, 0, false); w[q] = __builtin_amdgcn_cvt_pk_fp8_f32(a2, a3, w[q], true); }
        const int drow = rowmode ? drow0 + (nn >> 2) * 8 + (nn & 3) : drow0 + nn;
        *(v4u*)(WT8 + (size_t)drow * ldt + k0 + 16 * c) = (v4u){(unsigned)w[0], (unsigned)w[1], (unsigned)w[2], (unsigned)w[3]}; }
    LDS_WAIT(); asm volatile("" ::: "memory");
}
__device__ __forceinline__ bool tr_matrix(int& it, const float* W, int ldw, int K, int c0, int ncols, bf16* WT, int drow0, LAS float* scr, int lane) {
    const int nb = (ncols + 31) / 32, items = (K / 64) * nb;
    if (it >= items) { it -= items; return false; }
    const int kb = it / nb, b = it % nb, nv = ncols - 32 * b;
    tr_item(W, ldw, 64 * kb, c0 + 32 * b, nv < 32 ? nv : 32, WT, K, drow0 + 32 * b, scr, lane);
    return true;
}
__device__ __forceinline__ void zero_rows(Frame& F, bf16* base, size_t nelem) {
    for (size_t i = ((size_t)F.gw * 64 + F.lane) * 8; i < nelem; i += (size_t)F.NGW * 64 * 8) *(v4u*)(base + i) = (v4u){0u, 0u, 0u, 0u};
}

__device__ __forceinline__ void p_prologue(Frame& F) {
    LAS float* scr = (LAS float*)(F.lds + F.wave * 16384);
    unsigned char* ws = F.ws;
    {
        LAS float* wl = (LAS float*)F.lds;
        LAS float* pl = (LAS float*)(F.lds + 32768);
        const float* w_in = kin(2); const float* pool_w = kin(3); const float* pscale = kin(4);
        bf16* WT = (bf16*)(ws + WS_WABIN);
        for (int it = blockIdx.x; it < 4 * 32; it += F.G) {
            const int g = it >> 5, k0 = (it & 31) * 64;
            for (int i = F.tid; i < 64 * 128; i += 512) wl[i] = w_in[(size_t)(k0 + (i >> 7)) * AB_IN + g * 128 + (i & 127)];
            for (int i = F.tid; i < 128 * 128; i += 512) pl[i] = pool_w[(size_t)g * 16384 + i];
            __syncthreads();
            const int d = F.tid & 127, kg = F.tid >> 7; const float sc = pscale[g * 128 + d];
            for (int kk = 0; kk < 16; kk += 8) {
                float a[8];
#pragma unroll
                for (int j = 0; j < 8; ++j) a[j] = 0.f;
                for (int c = 0; c < 128; ++c) { const float pw = pl[c * 128 + d];
#pragma unroll
                    for (int j = 0; j < 8; ++j) a[j] += wl[(kg * 16 + kk + j) * 128 + c] * pw; }
                v4u o; o.x = pk2(a[0] * sc, a[1] * sc); o.y = pk2(a[2] * sc, a[3] * sc); o.z = pk2(a[4] * sc, a[5] * sc); o.w = pk2(a[6] * sc, a[7] * sc);
                *(v4u*)(WT + (size_t)(g * 128 + d) * ND + k0 + kg * 16 + kk) = o;
            }
            __syncthreads();
        }
    }
    __syncthreads();
    for (int it0 = F.gw; ; it0 += F.NGW) {
        int it = it0;
        if (tr_matrix(it, kin(2), AB_IN, ND, 512, AB_IN - 512, (bf16*)(ws + WS_WABIN), 512, scr, F.lane)) continue;
        if (tr_matrix(it, kin(5), ND, ND, 0, ND, (bf16*)(ws + WS_WABOUT), 0, scr, F.lane)) continue;
        if (tr_matrix(it, kin(6), CD_IN, ND, 0, CD_IN, (bf16*)(ws + WS_WCDIN), 0, scr, F.lane)) continue;
        if (tr_matrix(it, kin(14), ND, ND, 0, ND, (bf16*)(ws + WS_WCDOUT), 0, scr, F.lane)) continue;
        if (tr_matrix(it, kin(11), 1536, 384, 0, 1536, (bf16*)(ws + WS_WUQ), 0, scr, F.lane)) continue;
        if (tr_matrix(it, kin(13), 2048, 512, 0, 2048, (bf16*)(ws + WS_WUKV), 0, scr, F.lane)) continue;
        if (tr_matrix(it, kin(8), 128, 4096, 0, 128, (bf16*)(ws + WS_CW1), 0, scr, F.lane)) continue;
        if (tr_matrix(it, kin(8) + (size_t)4096 * 128, 128, 4096, 0, 128, (bf16*)(ws + WS_CW1), 128, scr, F.lane)) continue;
        break;
    }
    zero_rows(F, (bf16*)(ws + WS_WCDIN) + (size_t)CD_IN * ND, (size_t)(CD_INP - CD_IN) * ND);
    { const float* x = kin(0); bf16* xb = (bf16*)(ws + WS_XB0); const size_t stride = (size_t)F.NGW * 64 * 8;
      for (size_t i = ((size_t)F.gw * 64 + F.lane) * 8; i < (size_t)NT * ND; i += 4 * stride) {
          f32x4 a[4], c[4];
#pragma unroll
          for (int u = 0; u < 4; ++u) if (i + u * stride < (size_t)NT * ND) { a[u] = *(const f32x4*)(x + i + u * stride); c[u] = *(const f32x4*)(x + i + u * stride + 4); }
#pragma unroll
          for (int u = 0; u < 4; ++u) if (i + u * stride < (size_t)NT * ND) { v4u o; o.x = pk2(a[u][0], a[u][1]); o.y = pk2(a[u][2], a[u][3]); o.z = pk2(c[u][0], c[u][1]); o.w = pk2(c[u][2], c[u][3]); *(v4u*)(xb + i + u * stride) = o; } } }
    for (int o = F.gw; o < 128; o += F.NGW) { const int kv = o >> 6, fc = o & 63; const float* pos = kin(7) + (size_t)kv * 4096 + fc * 64; const float* w1 = kin(8) + ((size_t)kv * 4096 + fc * 64) * 128;
        float s0 = 0.f, s1 = 0.f;
#pragma unroll 8
        for (int f = 0; f < 64; ++f) { const float pf_ = pos[f]; const f32x2 wv = *(const f32x2*)(w1 + (size_t)f * 128 + F.lane * 2); s0 += pf_ * wv[0]; s1 += pf_ * wv[1]; }
        *(f32x2*)((float*)(ws + WS_CMPB) + 256 + (size_t)o * 128 + F.lane * 2) = (f32x2){s0, s1}; }
}
__device__ __forceinline__ void cmp_bias_finish(Frame& F) {
    if (blockIdx.x == 0 && F.tid < 256) { const int kv = F.tid >> 7, h = F.tid & 127; const float* part = (const float*)(F.ws + WS_CMPB) + 256 + (size_t)kv * 64 * 128 + h;
        float sacc = 0.f; for (int fc = 0; fc < 64; ++fc) sacc += part[fc * 128];
        ((float*)(F.ws + WS_CMPB))[F.tid] = sacc; }
}
constexpr int MW_ITEMS_L = 65 * 1536 + 64;
__device__ __forceinline__ void moe_weight_item(int l, int it, unsigned char* ws, LAS float* scr, int lane) {
    bf16* W13 = (bf16*)(ws + WS_W13 + (size_t)l * WS_MOE_LSTRIDE); bf16* W2 = (bf16*)(ws + WS_W2 + (size_t)l * WS_MOE_LSTRIDE); bf16* RT = (bf16*)(ws + WS_RT + (size_t)l * MiB);
    if (it >= 65 * 1536) { const int r = it - 65 * 1536, kb = r >> 1, b = r & 1;
        tr_item(kin(19) + (size_t)l * ND * NEXP, NEXP, 64 * kb, 32 * b, 32, RT, ND, 32 * b, scr, lane); return; }
    const int e = it / 1536, r = it % 1536;
    const float *w1, *w3, *w2;
    if (e < NEXP) { const size_t o = ((size_t)l * NEXP + e) * ND * EFF; w1 = kin(21) + o; w3 = kin(22) + o; w2 = kin(23) + o; }
    else { const size_t o = (size_t)l * ND * EFF; w1 = kin(24) + o; w3 = kin(25) + o; w2 = kin(26) + o; }
    if (r < 1024) { const int which = r >> 9, rr = r & 511, kb = rr >> 4, nb = rr & 15;
        const int j = nb >> 2, drow = j * 256 + which * 128 + (nb & 3) * 32;
        if (MK_FP8_MOE) tr_item_f8(which ? w3 : w1, EFF, 64 * kb, 32 * nb, (unsigned char*)W13 + (size_t)e * 1024 * ND, ND, (nb >> 1) * 128 + (nb & 1) * 64 + which * 4, 1, 64.0f, scr, lane);
        else tr_item(which ? w3 : w1, EFF, 64 * kb, 32 * nb, 32, W13 + (size_t)e * 1024 * ND, ND, drow, scr, lane); }
    else { const int rr = r - 1024, kb = rr >> 6, nb = rr & 63;
        if (MK_FP8_MOE) tr_item_f8(w2, ND, 64 * kb, 32 * nb, (unsigned char*)W2 + (size_t)e * ND * EFF, EFF, 32 * nb, 0, 64.0f, scr, lane);
        else tr_item(w2, ND, 64 * kb, 32 * nb, 32, W2 + (size_t)e * ND * EFF, EFF, 32 * nb, scr, lane); }
}
__device__ __forceinline__ void p_moe_weights_queue(Frame& F, unsigned* queue) {
    LAS float* scr = (LAS float*)(F.lds + F.wave * 16384);
    constexpr int BATCH = 16, NB_ = (2 * MW_ITEMS_L + BATCH - 1) / BATCH;
    for (;;) {
        unsigned bq = 0; if (F.lane == 0) bq = atomicAdd(queue, 1u);
        const int bi = __builtin_amdgcn_readfirstlane((int)bq);
        if (bi >= NB_) break;
        for (int k = 0; k < BATCH; ++k) { const int it = bi * BATCH + k; if (it >= 2 * MW_ITEMS_L) break; const int l = it >= MW_ITEMS_L ? 1 : 0; moe_weight_item(l, it - l * MW_ITEMS_L, F.ws, scr, F.lane); }
    }
    for (int l = 0; l < 2; ++l) zero_rows(F, (bf16*)(F.ws + WS_RT + (size_t)l * MiB) + (size_t)NEXP * ND, (size_t)(256 - NEXP) * ND);
}

__device__ __forceinline__ void ln_finish(float (&v)[4][8], const float* g, const float* b, int lane, bf16* ob, float* of, unsigned char* o8 = nullptr) {
    float s = 0.f;
#pragma unroll
    for (int j = 0; j < 4; ++j)
#pragma unroll
        for (int i = 0; i < 8; ++i) s += v[j][i];
    const float mean = wave_sum(s) * (1.f / ND); float s2 = 0.f;
#pragma unroll
    for (int j = 0; j < 4; ++j)
#pragma unroll
        for (int i = 0; i < 8; ++i) { v[j][i] -= mean; s2 += v[j][i] * v[j][i]; }
    const float rstd = 1.f / sqrtf(wave_sum(s2) * (1.f / ND) + LN_EPS);
#pragma unroll
    for (int j = 0; j < 4; ++j) { unsigned c0 = (unsigned)(j * 64 + lane) * 8u; asm volatile("" : "+v"(c0));
        const f32x4 g0 = *(const f32x4*)((const char*)g + c0 * 4u), g1 = *(const f32x4*)((const char*)g + c0 * 4u + 16u), b0 = *(const f32x4*)((const char*)b + c0 * 4u), b1 = *(const f32x4*)((const char*)b + c0 * 4u + 16u);
        float o[8];
#pragma unroll
        for (int i = 0; i < 4; ++i) { o[i] = v[j][i] * rstd * g0[i] + b0[i]; o[4 + i] = v[j][4 + i] * rstd * g1[i] + b1[i]; }
        if (ob) { v4u w; w.x = pk2(o[0], o[1]); w.y = pk2(o[2], o[3]); w.z = pk2(o[4], o[5]); w.w = pk2(o[6], o[7]); *(v4u*)((char*)ob + c0 * 2u) = w; }
        if (of) { *(f32x4*)((char*)of + c0 * 4u) = (f32x4){o[0], o[1], o[2], o[3]}; *(f32x4*)((char*)of + c0 * 4u + 16u) = (f32x4){o[4], o[5], o[6], o[7]}; }
        if (o8) { int w0 = __builtin_amdgcn_cvt_pk_fp8_f32(o[0], o[1], 0, false); w0 = __builtin_amdgcn_cvt_pk_fp8_f32(o[2], o[3], w0, true);
            int w1 = __builtin_amdgcn_cvt_pk_fp8_f32(o[4], o[5], 0, false); w1 = __builtin_amdgcn_cvt_pk_fp8_f32(o[6], o[7], w1, true);
            *(v2u*)(o8 + c0) = (v2u){(unsigned)w0, (unsigned)w1}; } }
}
__device__ __forceinline__ void p_ln1(Frame& F, const bf16* xin, const bf16* mixo, const float* g, const float* b, bf16* xo, unsigned char* xo8) {
    for (int m = F.gw; m < NT; m += F.NGW) {
        float v[4][8];
#pragma unroll
        for (int j = 0; j < 4; ++j) { const size_t o = (size_t)m * ND + (j * 64 + F.lane) * 8; float a[8], c[8]; unpack8(*(const v4u*)(xin + o), a); unpack8(*(const v4u*)(mixo + o), c);
#pragma unroll
            for (int i = 0; i < 8; ++i) v[j][i] = DN_ALPHA * a[i] + c[i]; }
        ln_finish(v, g, b, F.lane, xo + (size_t)m * ND, nullptr, xo8 ? xo8 + (size_t)m * ND : nullptr);
    }
}
__device__ __forceinline__ void unpack8_fp8(const v2u w, float (&f)[8]) {
    const f32x2 a = __builtin_amdgcn_cvt_pk_f32_fp8((int)w.x, false), b = __builtin_amdgcn_cvt_pk_f32_fp8((int)w.x, true), c = __builtin_amdgcn_cvt_pk_f32_fp8((int)w.y, false), d = __builtin_amdgcn_cvt_pk_f32_fp8((int)w.y, true);
    f[0] = a[0]; f[1] = a[1]; f[2] = b[0]; f[3] = b[1]; f[4] = c[0]; f[5] = c[1]; f[6] = d[0]; f[7] = d[1];
}
__device__ __forceinline__ void p_combine_ln2(Frame& F, const bf16* x1, const unsigned char* y2, const int* slot, const float* wsel, const float* g, const float* b, bf16* xo, float* fo) {
    for (int m = F.gw; m < NT; m += F.NGW) {
        const int myrow = slot[m * 8 + (F.lane & 7)]; const float myw = wsel[m * 8 + (F.lane & 7)] * (1.0f / 16.0f);
        float v[4][8];
        { v4u xa[4]; v2u sa[4];
#pragma unroll
          for (int j = 0; j < 4; ++j) { xa[j] = *(const v4u*)(x1 + (size_t)m * ND + (j * 64 + F.lane) * 8); sa[j] = *(const v2u*)(y2 + (size_t)(SH_ROW0 + m) * ND + (j * 64 + F.lane) * 8); }
#pragma unroll
          for (int j = 0; j < 4; ++j) { float a[8], c[8]; unpack8(xa[j], a); unpack8_fp8(sa[j], c);
#pragma unroll
              for (int i = 0; i < 8; ++i) v[j][i] = DN_ALPHA * a[i] + c[i] * (1.0f / 16.0f); } }
#pragma unroll
        for (int kg = 0; kg < 2; ++kg) { v2u ra[4][4]; float wk[4];
#pragma unroll
            for (int k = 0; k < 4; ++k) { const int row = __builtin_amdgcn_readlane(myrow, kg * 4 + k); wk[k] = __builtin_bit_cast(float, __builtin_amdgcn_readlane(__builtin_bit_cast(int, myw), kg * 4 + k));
#pragma unroll
                for (int j = 0; j < 4; ++j) ra[k][j] = *(const v2u*)(y2 + (size_t)row * ND + (j * 64 + F.lane) * 8); }
#pragma unroll
            for (int k = 0; k < 4; ++k)
#pragma unroll
                for (int j = 0; j < 4; ++j) { float c[8]; unpack8_fp8(ra[k][j], c);
#pragma unroll
                    for (int i = 0; i < 8; ++i) v[j][i] += wk[k] * c[i]; } }
        ln_finish(v, g, b, F.lane, xo ? xo + (size_t)m * ND : nullptr, fo ? fo + (size_t)m * ND : nullptr);
    }
}

__device__ __forceinline__ void p_pool(Frame& F, int wid, int nw) {
    const bf16* proj = (const bf16*)(F.ws + WS_PROJ); bf16* mixin = (bf16*)(F.ws + WS_MIXIN);
    for (int m = wid; m < NT; m += nw) {
        const int s = m & (NS - 1);
        const int g = F.lane >> 4, w = 2 << g; const int lo = (s + 1 - w) > 0 ? (s + 1 - w) : 0; const float cnt = (float)((s + 1) < w ? (s + 1) : w);
        float acc[8], cur[8];
#pragma unroll
        for (int i = 0; i < 8; ++i) acc[i] = 0.f;
        for (int j = lo; j <= s; ++j) { float t[8]; unpack8(*(const v4u*)(proj + (size_t)(m - s + j) * AB_IN + F.lane * 8), t);
#pragma unroll
            for (int i = 0; i < 8; ++i) acc[i] += t[i]; }
        unpack8(*(const v4u*)(proj + (size_t)m * AB_IN + F.lane * 8), cur);
        float o[8];
#pragma unroll
        for (int i = 0; i < 8; ++i) o[i] = acc[i] / cnt - cur[i];
        v4u wv; wv.x = pk2(o[0], o[1]); wv.y = pk2(o[2], o[3]); wv.z = pk2(o[4], o[5]); wv.w = pk2(o[6], o[7]); *(v4u*)(mixin + (size_t)m * ND + F.lane * 8) = wv;
    }
}
namespace ret {
typedef short v4i16_t __attribute__((ext_vector_type(4)));
constexpr int PITCH = 272, TILE = 128 * PITCH;
__device__ __forceinline__ bf16x8 trfrag(LAS unsigned char* trb, int r0, int r1, int c0) {
    const v4i16_t a = __builtin_amdgcn_ds_read_tr16_b64_v4i16((LAS v4i16_t*)(trb + r0 * PITCH + c0 * 2));
    const v4i16_t b = __builtin_amdgcn_ds_read_tr16_b64_v4i16((LAS v4i16_t*)(trb + r1 * PITCH + c0 * 2));
    return (bf16x8){a[0], a[1], a[2], a[3], b[0], b[1], b[2], b[3]};
}
}
__device__ __forceinline__ void p_retention_mfma(Frame& F, int bh) {
    const bf16* proj = (const bf16*)(F.ws + WS_PROJ); bf16* mixin = (bf16*)(F.ws + WS_MIXIN); const int* posv = (const int*)kin(1);
    constexpr int P = ret::PITCH;
    LAS unsigned char* KT = F.lds; LAS unsigned char* VT = F.lds + ret::TILE; LAS unsigned char* ST = F.lds + 2 * ret::TILE;
    const int b = bh / 6, h = bh % 6, w = F.wave, lane = F.lane, i16 = lane & 15, g = lane >> 4, q4 = (lane & 15) >> 2, p4 = lane & 3;
    const float lg = log2f(1.0f - exp2f(-5.0f - (float)h)), gc = exp2f(128.f * lg);
    const int rowb = i16 * P + 16 * g;
    const int trl = q4 * P + 8 * p4;
    LAS unsigned char* const trV4 = VT + trl + 4 * g * P;
    LAS unsigned char* const trV8 = VT + trl + 8 * g * P;
    LAS unsigned char* const trK8 = KT + trl + 8 * g * P;
    f32x4 T[2][8];
#pragma unroll
    for (int a = 0; a < 2; ++a)
#pragma unroll
        for (int d = 0; d < 8; ++d) T[a][d] = (f32x4){0.f, 0.f, 0.f, 0.f};
    const int srow = F.tid >> 2, scb = (F.tid & 3) * 4;
    for (int n = 0; n < NS / 128; ++n) {
        const size_t m0 = (size_t)b * NS + n * 128;
        {
          const float fk = exp2f(-(float)srow * lg) * 0.08838834764831845f, pz = (float)posv[m0 + srow]; const int t4 = F.tid & 3;
          const bf16* krow = proj + (m0 + srow) * AB_IN + 1280 + h * 128;
#pragma unroll
          for (int c = 0; c < 2; ++c) { const int c8 = 2 * t4 + c; float x1[8], x2[8];
              unpack8(*(const v4u*)(krow + c8 * 8), x1); unpack8(*(const v4u*)(krow + 64 + c8 * 8), x2);
#pragma unroll
              for (int j = 0; j < 8; ++j) { const float invf = exp2f(-(float)(c8 * 8 + j) * (13.287712379549449f / 64.f)); float sn, cs; fast_sincos(pz * invf, sn, cs);
                  const float a = (x1[j] * cs - x2[j] * sn) * fk, bq = (x1[j] * sn + x2[j] * cs) * fk; x1[j] = a; x2[j] = bq; }
              v4u o; o.x = pk2(x1[0], x1[1]); o.y = pk2(x1[2], x1[3]); o.z = pk2(x1[4], x1[5]); o.w = pk2(x1[6], x1[7]); *(LAS v4u*)(KT + srow * P + c8 * 16) = o;
              o.x = pk2(x2[0], x2[1]); o.y = pk2(x2[2], x2[3]); o.z = pk2(x2[4], x2[5]); o.w = pk2(x2[6], x2[7]); *(LAS v4u*)(KT + srow * P + (c8 + 8) * 16) = o; } }
        bf16x8 qf[4], pf[4]; float rs[4] = {0.f, 0.f, 0.f, 0.f}, rq[4] = {0.f, 0.f, 0.f, 0.f};
        {
          const float fq = exp2f((float)(16 * w + i16) * lg), pz = (float)posv[m0 + 16 * w + i16];
          const bf16* qrow = proj + (m0 + 16 * w + i16) * AB_IN + 512 + h * 128;
#pragma unroll
          for (int ks = 0; ks < 2; ++ks) { float x1[8], x2[8]; unpack8(*(const v4u*)(qrow + 32 * ks + 8 * g), x1); unpack8(*(const v4u*)(qrow + 64 + 32 * ks + 8 * g), x2);
#pragma unroll
              for (int j = 0; j < 8; ++j) { const float invf = exp2f(-(float)(32 * ks + 8 * g + j) * (13.287712379549449f / 64.f)); float sn, cs; fast_sincos(pz * invf, sn, cs);
                  const float a = (x1[j] * cs - x2[j] * sn) * fq, bq = (x1[j] * sn + x2[j] * cs) * fq; x1[j] = a; x2[j] = bq; }
              v4u o; o.x = pk2(x1[0], x1[1]); o.y = pk2(x1[2], x1[3]); o.z = pk2(x1[4], x1[5]); o.w = pk2(x1[6], x1[7]); qf[ks] = __builtin_bit_cast(bf16x8, o);
              o.x = pk2(x2[0], x2[1]); o.y = pk2(x2[2], x2[3]); o.z = pk2(x2[4], x2[5]); o.w = pk2(x2[6], x2[7]); qf[ks + 2] = __builtin_bit_cast(bf16x8, o); } }
#pragma unroll
        for (int hv = 0; hv < 2; ++hv) {
            if (hv == 1) __syncthreads();
#pragma unroll
            for (int c = 0; c < 4; ++c) { const int c8 = scb + c; *(LAS v4u*)(VT + srow * P + c8 * 16) = *(const v4u*)(proj + (m0 + srow) * AB_IN + 2048 + h * 256 + hv * 128 + c8 * 8); }
            { LAS unsigned char* stw = ST + (16 * w + 4 * g) * P + i16 * 2;
#pragma unroll
              for (int dt = 0; dt < 8; ++dt)
#pragma unroll
                for (int r = 0; r < 4; ++r) { T[hv][dt][r] *= gc; *(LAS bf16*)(stw + r * P + dt * 32) = (bf16)f2bf(T[hv][dt][r]); } }
            __syncthreads();
            if (hv == 0) {
                f32x4 sc[8];
#pragma unroll
                for (int mt = 0; mt < 8; ++mt) { sc[mt] = (f32x4){0.f, 0.f, 0.f, 0.f};
                    if (mt <= w) {
#pragma unroll
                        for (int ks = 0; ks < 4; ++ks) { const bf16x8 kf = *(const LAS bf16x8*)(KT + rowb + mt * 16 * P + ks * 64); sc[mt] = __builtin_amdgcn_mfma_f32_16x16x32_bf16(kf, qf[ks], sc[mt], 0, 0, 0); }
                        if (mt == w) {
#pragma unroll
                            for (int r = 0; r < 4; ++r) sc[mt][r] = (4 * g + r <= i16) ? sc[mt][r] : 0.f; } } }
#pragma unroll
                for (int k2 = 0; k2 < 4; ++k2) { v4u wv; wv.x = pk2(sc[2 * k2][0], sc[2 * k2][1]); wv.y = pk2(sc[2 * k2][2], sc[2 * k2][3]); wv.z = pk2(sc[2 * k2 + 1][0], sc[2 * k2 + 1][1]); wv.w = pk2(sc[2 * k2 + 1][2], sc[2 * k2 + 1][3]);
                    pf[k2] = __builtin_bit_cast(bf16x8, wv); }
            }
#pragma unroll
            for (int nt = 0; nt < 8; ++nt) { f32x4 acc = (f32x4){0.f, 0.f, 0.f, 0.f};
#pragma unroll
                for (int k2 = 0; k2 < 4; ++k2) if (2 * k2 <= w) { const bf16x8 vf = ret::trfrag(trV4, 32 * k2, 32 * k2 + 16, 16 * nt); acc = __builtin_amdgcn_mfma_f32_16x16x32_bf16(pf[k2], vf, acc, 0, 0, 0); }
#pragma unroll
                for (int ks = 0; ks < 4; ++ks) { const bf16x8 sf = *(const LAS bf16x8*)(ST + rowb + nt * 16 * P + ks * 64); acc = __builtin_amdgcn_mfma_f32_16x16x32_bf16(qf[ks], sf, acc, 0, 0, 0); }
#pragma unroll
                for (int r = 0; r < 4; ++r) { rs[r] += acc[r]; rq[r] += acc[r] * acc[r]; mixin[(m0 + 16 * w + 4 * g + r) * ND + 512 + h * 256 + hv * 128 + 16 * nt + i16] = (bf16)f2bf(acc[r]); } }
#pragma unroll
            for (int ks = 0; ks < 4; ++ks) { const bf16x8 af = ret::trfrag(trV8, 32 * ks, 32 * ks + 4, 16 * w);
#pragma unroll
                for (int dt = 0; dt < 8; ++dt) { const bf16x8 bfr = ret::trfrag(trK8, 32 * ks, 32 * ks + 4, 16 * dt); T[hv][dt] = __builtin_amdgcn_mfma_f32_16x16x32_bf16(af, bfr, T[hv][dt], 0, 0, 0); } }
        }
#pragma unroll
        for (int r = 0; r < 4; ++r) { float sm = rs[r], s2 = rq[r];
            sm += __shfl_xor(sm, 1); sm += __shfl_xor(sm, 2); sm += __shfl_xor(sm, 4); sm += __shfl_xor(sm, 8);
            s2 += __shfl_xor(s2, 1); s2 += __shfl_xor(s2, 2); s2 += __shfl_xor(s2, 4); s2 += __shfl_xor(s2, 8);
            const float mean = sm * (1.f / 256.f); const float var = fmaxf(s2 * (1.f / 256.f) - mean * mean, 0.f);
            const float rstd = 1.f / sqrtf(var + NORM_EPS);
            const size_t m = m0 + 16 * w + 4 * g + r;
#pragma unroll
            for (int t = 0; t < 16; ++t) { bf16* yp = mixin + m * ND + 512 + h * 256 + 16 * t + i16; const float gt = bf1(proj[m * AB_IN + 3584 + h * 256 + 16 * t + i16]);
                *yp = (bf16)f2bf((bf1(*yp) - mean) * rstd * siluf_(gt)); } }
        __syncthreads();
    }
}

__device__ __forceinline__ void p_route(Frame& F, int l) {
    const float* logits = (const float*)(F.ws + WS_LOGITS); const float* rbias = kin(20) + l * NEXP;
    int* tope = (int*)(F.ws + WS_TOPE); float* wsel = (float*)(F.ws + WS_WSEL); int* posb = (int*)(F.ws + WS_SLOT); unsigned* cnt = F.ctl + CW_CNT + l * 64;
    LAS unsigned* lcnt = (LAS unsigned*)F.lds; LAS unsigned* lbase = lcnt + 64; LAS int* le = (LAS int*)(lcnt + 128); LAS unsigned* lp = (LAS unsigned*)(lcnt + 128 + 512);
    const float bias = rbias[F.lane]; const int lane = F.lane;
    for (int chunk = blockIdx.x; chunk < NT / 64; chunk += F.G) {
        __syncthreads();
        if (F.tid < 64) lcnt[F.tid] = 0u;
        __syncthreads();
        for (int t = 0; t < 8; ++t) {
            const int tl = F.wave * 8 + t, m = chunk * 64 + tl;
            const float lg = (logits[(size_t)m * 64 + lane] + logits[((size_t)NT + m) * 64 + lane]) + (logits[((size_t)2 * NT + m) * 64 + lane] + logits[((size_t)3 * NT + m) * 64 + lane]);
            const float sc = sigmoidf_(lg), bi = sc + bias;
            const int grp = lane >> 3;
            int rk = 0;
#pragma unroll
            for (int j = 1; j < 8; ++j) { const int o = lane ^ j; const float ov = __shfl_xor(bi, j); rk += ((ov > bi) || (ov == bi && o < lane)) ? 1 : 0; }
            float gs = rk < 2 ? bi : 0.f; gs += __shfl_xor(gs, 1); gs += __shfl_xor(gs, 2); gs += __shfl_xor(gs, 4);
            int grk = 0;
#pragma unroll
            for (int gg = 0; gg < 8; ++gg) { const float ov = __builtin_bit_cast(float, __builtin_amdgcn_readlane(__builtin_bit_cast(int, gs), gg * 8)); grk += (gg != grp && ((ov > gs) || (ov == gs && gg < grp))) ? 1 : 0; }
            const float mv = grk < 4 ? bi : -1e30f;
            int erk = 0;
#pragma unroll 16
            for (int j = 0; j < 64; ++j) { const float ov = __builtin_bit_cast(float, __builtin_amdgcn_readlane(__builtin_bit_cast(int, mv), j)); erk += ((ov > mv) || (ov == mv && j < lane)) ? 1 : 0; }
            const bool sel = erk < 8;
            const float wsum = wave_sum(sel ? sc : 0.f);
            if (sel) { const unsigned q = __hip_atomic_fetch_add(lcnt + lane, 1u, __ATOMIC_RELAXED, __HIP_MEMORY_SCOPE_WORKGROUP);
                tope[m * 8 + erk] = lane; wsel[m * 8 + erk] = sc / wsum * 2.5f; le[tl * 8 + erk] = lane; lp[tl * 8 + erk] = q; }
        }
        __syncthreads();
        if (F.tid < 64) lbase[F.tid] = atomicAdd(&cnt[F.tid], lcnt[F.tid]);
        __syncthreads();
        posb[chunk * 512 + F.tid] = (int)(lbase[le[F.tid]] + lp[F.tid]);
    }
}
__device__ __forceinline__ void load_offsets(Frame& F, int l) {
    volatile LAS int* tab = (volatile LAS int*)(F.lds + TAB_OFF);
    __syncthreads();
    if (F.tid < NEXP) tab[66 + F.tid] = (int)__hip_atomic_load(F.ctl + CW_CNT + l * 64 + F.tid, __ATOMIC_RELAXED, __HIP_MEMORY_SCOPE_AGENT);
    __syncthreads();
    if (F.tid == 0) { int o = 0; for (int e = 0; e < NEXP; ++e) { tab[e] = o; int c = tab[66 + e]; if (c > NT) c = NT; const int nt_ = (c + 255) >> 8; for (int t = 0; t < nt_; ++t) { const int ti = (o >> 8) + t; if (ti < MAXTILES) tab[160 + ti] = e; } o += nt_ << 8; if (o > MAXROWS) o = MAXROWS; }
        tab[64] = o; tab[65] = o >> 8; }
    __syncthreads();
}
__device__ __forceinline__ void p_scatter(Frame& F, int l) {
    load_offsets(F, l);
    const LAS int* tab = (const LAS int*)(F.lds + TAB_OFF);
    const int* tope = (const int*)(F.ws + WS_TOPE); int* slot = (int*)(F.ws + WS_SLOT); int* sorted = (int*)(F.ws + WS_SORTED);
    for (int i = F.gw * 64 + F.lane; i < NT * 8; i += F.NGW * 64) { const int e = tope[i]; const int row = tab[e] + slot[i]; sorted[row] = i >> 3; slot[i] = row; }
    for (int i = F.gw * 64 + F.lane; i < NEXP * 256; i += F.NGW * 64) { const int e = i >> 8, j = i & 255; const int r = tab[e] + tab[66 + e] + j; if (r < tab[e + 1]) sorted[r] = 0; }
}

__device__ __forceinline__ void p_l1_thin_a(Frame& F) {
    const bf16* proj = (const bf16*)(F.ws + WS_PROJ); const int* pos = (const int*)kin(1);
    bf16* cqn = (bf16*)(F.ws + WS_CQN); bf16* ckvn = (bf16*)(F.ws + WS_CKVN); bf16* krot = (bf16*)(F.ws + WS_KROT); bf16* cmpkv = (bf16*)(F.ws + WS_CMPKV);
    const float* qn = kin(10); const float* kvn = kin(12);
    for (int m = F.gw; m < NT; m += F.NGW) {
        const bf16* row = proj + (size_t)m * CD_INP;
        { float x[6]; float s = 0.f;
#pragma unroll
          for (int j = 0; j < 6; ++j) { x[j] = bf1(row[2584 + j * 64 + F.lane]); s += x[j] * x[j]; }
          const float r = 1.f / sqrtf(wave_sum(s) * (1.f / 384.f) + NORM_EPS);
#pragma unroll
          for (int j = 0; j < 6; ++j) cqn[(size_t)m * 384 + j * 64 + F.lane] = (bf16)f2bf(x[j] * r * qn[j * 64 + F.lane]); }
        { float x[8]; float s = 0.f;
#pragma unroll
          for (int j = 0; j < 8; ++j) { x[j] = bf1(row[2968 + j * 64 + F.lane]); s += x[j] * x[j]; }
          const float r = 1.f / sqrtf(wave_sum(s) * (1.f / 512.f) + NORM_EPS);
#pragma unroll
          for (int j = 0; j < 8; ++j) ckvn[(size_t)m * 512 + j * 64 + F.lane] = (bf16)f2bf(x[j] * r * kvn[j * 64 + F.lane]); }
        { const int i = F.lane & 31; const float p = (float)pos[m]; const float invf = exp2f(-(float)i * (13.287712379549449f / 32.f));
          float sn, cs; fast_sincos(p * invf, sn, cs);
          const float x1 = bf1(row[3480 + i]), x2 = bf1(row[3480 + 32 + i]);
          if (F.lane < 32) krot[(size_t)m * 64 + i] = (bf16)f2bf(x1 * cs - x2 * sn); else krot[(size_t)m * 64 + 32 + i] = (bf16)f2bf(x1 * sn + x2 * cs); }
        { const int b = m >> 11, s = m & (NS - 1);
          const int q4 = F.lane >> 4, c = F.lane & 15, kv = q4 >> 1, g = q4 & 1;
          const v4u w = *(const v4u*)(row + 1024 + q4 * 128 + c * 8);
          *(v4u*)(cmpkv + ((size_t)((kv * 16 + b * 2 + g) * NS + s)) * 128 + c * 8) = w; }
    }
}
__device__ __forceinline__ void p_l1_thin_b(Frame& F) {
    const float* hid = (const float*)(F.ws + WS_HID); const float* w2 = kin(9); bf16* kvc = (bf16*)(F.ws + WS_KVCMP);
    for (int m = F.gw; m < 4096; m += F.NGW) {
        const int kv = m >> 11;
        float h0 = hid[(size_t)m * 256 + kv * 128 + F.lane], h1 = hid[(size_t)m * 256 + kv * 128 + 64 + F.lane];
        h0 = 0.5f * h0 * (1.f + tanhf(0.7978845608028654f * (h0 + 0.044715f * h0 * h0 * h0)));
        h1 = 0.5f * h1 * (1.f + tanhf(0.7978845608028654f * (h1 + 0.044715f * h1 * h1 * h1)));
        const float* w = w2 + (size_t)kv * 128 * 128; float o0 = 0.f, o1 = 0.f;
        for (int c = 0; c < 64; ++c) { const float a = __shfl(h0, c), bq = __shfl(h1, c);
            o0 += a * w[c * 128 + F.lane] + bq * w[(c + 64) * 128 + F.lane]; o1 += a * w[c * 128 + 64 + F.lane] + bq * w[(c + 64) * 128 + 64 + F.lane]; }
        kvc[(size_t)m * 128 + F.lane] = (bf16)f2bf(o0); kvc[(size_t)m * 128 + 64 + F.lane] = (bf16)f2bf(o1);
    }
}
__device__ __forceinline__ void p_nsa_cmp_mfma(Frame& F) {
    typedef short v4i16_t __attribute__((ext_vector_type(4)));
    const bf16* proj = (const bf16*)(F.ws + WS_PROJ); const bf16* kvc = (const bf16*)(F.ws + WS_KVCMP); float* ocmp = (float*)(F.ws + WS_OCMP); unsigned* selm = (unsigned*)(F.ws + WS_SELM);
    constexpr int P = 272;
    LAS unsigned char* KT = F.lds; LAS unsigned char* VT = F.lds + 128 * P; LAS float* PS = (LAS float*)(F.lds + 2 * 128 * P);
    const int w = F.wave, lane = F.lane, i16 = lane & 15, g = lane >> 4, q4 = (lane & 15) >> 2, p4 = lane & 3;
    const float sscale = 0.08838834764831845f * 1.4426950408889634f;
    for (int bu = blockIdx.x; bu < 256; bu += F.G) {
        const int bg = bu >> 4, qg = bu & 15, b = bg >> 1, gq = bg & 1;
        __syncthreads();
#pragma unroll
        for (int c = 0; c < 4; ++c) { const int idx = F.tid + 512 * c, row = idx >> 4, c8 = idx & 15;
            v4u kk = (v4u){0u, 0u, 0u, 0u}, vv = (v4u){0u, 0u, 0u, 0u};
            if (row < 127) { kk = *(const v4u*)(kvc + ((size_t)(0 * 16 + bg) * 128 + row) * 128 + c8 * 8); vv = *(const v4u*)(kvc + ((size_t)(1 * 16 + bg) * 128 + row) * 128 + c8 * 8); }
            *(LAS v4u*)(KT + row * P + c8 * 16) = kk; *(LAS v4u*)(VT + row * P + c8 * 16) = vv; }
        for (int k = 0; k < 4; ++k) {
            const int q0 = (qg * 4 + k) * 32, h = gq * 4 + (w >> 1), ql = (w & 1) * 16 + i16, spos = q0 + ql;
            bf16x8 qf[4];
#pragma unroll
            for (int ks = 0; ks < 4; ++ks) qf[ks] = *(const bf16x8*)(proj + (size_t)(b * NS + spos) * CD_INP + h * 128 + 32 * ks + 8 * g);
            __syncthreads();
            const int nvalid = spos >= 31 ? ((spos - 31) >> 4) + 1 : 0;
            f32x4 sc[8]; float mx = -1e30f;
#pragma unroll
            for (int mt = 0; mt < 8; ++mt) { sc[mt] = (f32x4){0.f, 0.f, 0.f, 0.f};
#pragma unroll
                for (int ks = 0; ks < 4; ++ks) { const bf16x8 kf = *(const LAS bf16x8*)(KT + (16 * mt + i16) * P + (32 * ks + 8 * g) * 2); sc[mt] = __builtin_amdgcn_mfma_f32_16x16x32_bf16(kf, qf[ks], sc[mt], 0, 0, 0); }
#pragma unroll
                for (int r = 0; r < 4; ++r) { const bool ok = (16 * mt + 4 * g + r) < nvalid; const float x = ok ? sc[mt][r] * sscale : -1e30f; sc[mt][r] = x; mx = fmaxf(mx, x); } }
            mx = fmaxf(mx, __shfl_xor(mx, 16)); mx = fmaxf(mx, __shfl_xor(mx, 32));
            float ps = 0.f;
#pragma unroll
            for (int mt = 0; mt < 8; ++mt)
#pragma unroll
                for (int r = 0; r < 4; ++r) { const bool ok = (16 * mt + 4 * g + r) < nvalid; const float pv = ok ? __builtin_amdgcn_exp2f(sc[mt][r] - mx) : 0.f; sc[mt][r] = pv; ps += pv; }
            ps += __shfl_xor(ps, 16); ps += __shfl_xor(ps, 32);
            const float inv = ps > 0.f ? 1.f / ps : 0.f;
#pragma unroll
            for (int mt = 0; mt < 8; ++mt)
#pragma unroll
                for (int r = 0; r < 4; ++r) sc[mt][r] *= inv;
            { LAS float* slab = PS + (w >> 2) * 4096 + ql * 128 + 4 * g;
              if (((w >> 1) & 1) == 0) {
#pragma unroll
                  for (int mt = 0; mt < 8; ++mt) *(LAS f32x4*)(slab + 16 * mt) = sc[mt]; }
              __syncthreads();
              if (((w >> 1) & 1) == 1) {
#pragma unroll
                  for (int mt = 0; mt < 8; ++mt) { const f32x4 t = *(const LAS f32x4*)(slab + 16 * mt); *(LAS f32x4*)(slab + 16 * mt) = t + sc[mt]; } } }
            f32x4 O[8];
#pragma unroll
            for (int nt = 0; nt < 8; ++nt) O[nt] = (f32x4){0.f, 0.f, 0.f, 0.f};
#pragma unroll
            for (int k2 = 0; k2 < 4; ++k2) { v4u wv; wv.x = pk2(sc[2 * k2][0], sc[2 * k2][1]); wv.y = pk2(sc[2 * k2][2], sc[2 * k2][3]); wv.z = pk2(sc[2 * k2 + 1][0], sc[2 * k2 + 1][1]); wv.w = pk2(sc[2 * k2 + 1][2], sc[2 * k2 + 1][3]);
                const bf16x8 pf = __builtin_bit_cast(bf16x8, wv);
#pragma unroll
                for (int nt = 0; nt < 8; ++nt) {
                    const v4i16_t a = __builtin_amdgcn_ds_read_tr16_b64_v4i16((LAS v4i16_t*)(VT + (32 * k2 + 4 * g + q4) * P + (16 * nt + 4 * p4) * 2));
                    const v4i16_t c = __builtin_amdgcn_ds_read_tr16_b64_v4i16((LAS v4i16_t*)(VT + (32 * k2 + 16 + 4 * g + q4) * P + (16 * nt + 4 * p4) * 2));
                    const bf16x8 vf = (bf16x8){a[0], a[1], a[2], a[3], c[0], c[1], c[2], c[3]};
                    O[nt] = __builtin_amdgcn_mfma_f32_16x16x32_bf16(pf, vf, O[nt], 0, 0, 0); } }
#pragma unroll
            for (int r = 0; r < 4; ++r) { const size_t m = (size_t)(b * NS + q0 + (w & 1) * 16 + 4 * g + r); const float gt = sigmoidf_(bf1(proj[m * CD_INP + 2560 + h * 3 + 0]));
#pragma unroll
                for (int nt = 0; nt < 8; ++nt) ocmp[m * 1024 + h * 128 + 16 * nt + i16] = gt * O[nt][r]; }
            __syncthreads();
#pragma unroll
            for (int qq = 0; qq < 4; ++qq) { const int qi = 4 * w + qq, s = q0 + qi, cur = s >> 6, j = lane & 31;
                float imp = 0.f;
#pragma unroll
                for (int kk = 0; kk < 4; ++kk) { const int n1 = 4 * j + kk; if (n1 <= 126) imp += PS[qi * 128 + n1] + PS[4096 + qi * 128 + n1]; const int n2 = 4 * j - 1 + kk; if (n2 >= 0 && n2 <= 126) imp += PS[qi * 128 + n2] + PS[4096 + qi * 128 + n2]; }
                const bool forced = (j == 0) || (j == cur) || (j == cur - 1);
                const float score = forced ? 1e4f : ((j * 64 <= s) ? imp : -1e30f);
                int rk = 0;
                for (int jj = 0; jj < 32; ++jj) { const float ov = __shfl(score, jj); rk += ((ov > score) || (ov == score && jj < j)) ? 1 : 0; }
                const bool sel = (lane < 32) && (rk < 16) && (j <= cur);
                const unsigned long long bal = __ballot(sel);
                if (lane == 0) selm[(size_t)(b * NS + s) * 2 + gq] = (unsigned)bal; }
        }
    }
}

namespace fa {
typedef short v4i16_t __attribute__((ext_vector_type(4)));
struct Src { const bf16* k1; size_t ks1; const bf16* k2; size_t ks2; const bf16* v; size_t vs; };
template <int DQK> struct Cfg { static constexpr int KPITCH = (DQK + 8) * 2, KBYTES = 64 * KPITCH, VPITCH = 272, VBYTES = 64 * VPITCH, BUF = KBYTES + VBYTES, NKS = DQK / 32, KCH = DQK / 8, NKR = DQK / 64; };

template <int DQK> struct TileOff { unsigned gk[Cfg<DQK>::NKR], gv[2], lk[Cfg<DQK>::NKR], lv[2]; };
template <int DQK>
__device__ __forceinline__ void tile_offsets(const Src& S, int tid, TileOff<DQK>& T) {
#pragma unroll
    for (int i = 0; i < 2; ++i) { const int c = tid + 512 * i, row = c >> 4, c8 = c & 15;
        T.gk[i] = (unsigned)(row * (int)S.ks1 + c8 * 8) * 2u; T.gv[i] = (unsigned)(row * (int)S.vs + c8 * 8) * 2u;
        T.lk[i] = (unsigned)(row * Cfg<DQK>::KPITCH + c8 * 16); T.lv[i] = (unsigned)(Cfg<DQK>::KBYTES + row * Cfg<DQK>::VPITCH + c8 * 16); }
    if (DQK == 192) { const int row = tid >> 3, c8 = tid & 7; T.gk[Cfg<DQK>::NKR - 1] = (unsigned)(row * (int)S.ks2 + c8 * 8) * 2u; T.lk[Cfg<DQK>::NKR - 1] = (unsigned)(row * Cfg<DQK>::KPITCH + 256 + c8 * 16); }
}
template <int DQK>
__device__ __forceinline__ void load_tile(const Src& S, int k0, const TileOff<DQK>& T, v4u (&kr)[Cfg<DQK>::NKR], v4u (&vr)[2]) {
    const char* kb1 = (const char*)S.k1 + (size_t)k0 * S.ks1 * 2; const char* vb = (const char*)S.v + (size_t)k0 * S.vs * 2;
#pragma unroll
    for (int i = 0; i < 2; ++i) { kr[i] = *(const v4u*)(kb1 + T.gk[i]); vr[i] = *(const v4u*)(vb + T.gv[i]); }
    if (DQK == 192) { const char* kb2 = (const char*)S.k2 + (size_t)k0 * S.ks2 * 2; kr[Cfg<DQK>::NKR - 1] = *(const v4u*)(kb2 + T.gk[Cfg<DQK>::NKR - 1]); }
}
template <int DQK>
__device__ __forceinline__ void store_tile(LAS unsigned char* buf, const TileOff<DQK>& T, const v4u (&kr)[Cfg<DQK>::NKR], const v4u (&vr)[2]) {
#pragma unroll
    for (int i = 0; i < Cfg<DQK>::NKR; ++i) *(LAS v4u*)(buf + T.lk[i]) = kr[i];
#pragma unroll
    for (int i = 0; i < 2; ++i) *(LAS v4u*)(buf + T.lv[i]) = vr[i];
}
struct RowState { int spos; unsigned rowmask; float m_run, l_run; };
template <int MODE> __device__ __forceinline__ bool group_needs(int t, const RowState& R) {
    bool row_any = (t * 64 <= R.spos);
    if (MODE == 1) row_any = row_any && ((R.rowmask >> t) & 1u);
    if (MODE == 2) row_any = row_any && (t * 64 + 63 + 512 > R.spos);
    return __ballot(row_any) != 0ull;
}
template <int MODE>
__device__ __forceinline__ void softmax_group(f32x4 (&sc)[4], int t, RowState& R, float sscale, f32x4 (&O)[8], bf16x8 (&pf)[2], int g) {
    float mx = -1e30f;
#pragma unroll
    for (int mt = 0; mt < 4; ++mt)
#pragma unroll
        for (int r = 0; r < 4; ++r) { const int kp = t * 64 + 16 * mt + 4 * g + r; bool ok = kp <= R.spos;
            if (MODE == 1) ok = ok && ((R.rowmask >> t) & 1u);
            if (MODE == 2) ok = ok && (kp + 512 > R.spos);
            const float x = ok ? sc[mt][r] * sscale : -3e38f; sc[mt][r] = x; mx = fmaxf(mx, x); }
    mx = fmaxf(mx, -1e30f);
    mx = fmaxf(mx, __shfl_xor(mx, 16)); mx = fmaxf(mx, __shfl_xor(mx, 32));
    if (__ballot(mx > R.m_run + 8.0f) != 0ull) {
        const float m_new = fmaxf(R.m_run, mx), alpha = __builtin_amdgcn_exp2f(R.m_run - m_new); R.m_run = m_new;
        R.l_run *= alpha;
        float ar[4];
#pragma unroll
        for (int r = 0; r < 4; ++r) ar[r] = __shfl(alpha, 4 * g + r);
#pragma unroll
        for (int nt = 0; nt < 8; ++nt)
#pragma unroll
            for (int r = 0; r < 4; ++r) O[nt][r] *= ar[r];
    }
    float ps = 0.f;
#pragma unroll
    for (int mt = 0; mt < 4; ++mt)
#pragma unroll
        for (int r = 0; r < 4; ++r) { const float pv = __builtin_amdgcn_exp2f(sc[mt][r] - R.m_run); sc[mt][r] = pv; ps += pv; }
    R.l_run += ps;
#pragma unroll
    for (int k2 = 0; k2 < 2; ++k2) { v4u w; w.x = pk2(sc[2 * k2][0], sc[2 * k2][1]); w.y = pk2(sc[2 * k2][2], sc[2 * k2][3]); w.z = pk2(sc[2 * k2 + 1][0], sc[2 * k2 + 1][1]); w.w = pk2(sc[2 * k2 + 1][2], sc[2 * k2 + 1][3]);
        pf[k2] = __builtin_bit_cast(bf16x8, w); }
}
template <int DQK, int MODE>
__device__ __forceinline__ void fa_compute(LAS unsigned char* kb, LAS unsigned char* vb, const bf16x8 (&qf0)[Cfg<DQK>::NKS], const bf16x8 (&qf1)[Cfg<DQK>::NKS], int t, RowState& R0, RowState& R1, float sscale,
                                           f32x4 (&O0)[8], f32x4 (&O1)[8], int i16, int g, int q4, int p4) {
    typedef Cfg<DQK> C;
    const bool n0 = group_needs<MODE>(t, R0), n1 = group_needs<MODE>(t, R1);
    if (!n0 && !n1) return;
    f32x4 s0[4], s1[4];
#pragma unroll
    for (int mt = 0; mt < 4; ++mt) { s0[mt] = (f32x4){0.f, 0.f, 0.f, 0.f}; s1[mt] = (f32x4){0.f, 0.f, 0.f, 0.f};
#pragma unroll
        for (int ks = 0; ks < C::NKS; ++ks) { const bf16x8 kf = *(const LAS bf16x8*)(kb + (16 * mt + i16) * C::KPITCH + (32 * ks + 8 * g) * 2);
            s0[mt] = __builtin_amdgcn_mfma_f32_16x16x32_bf16(kf, qf0[ks], s0[mt], 0, 0, 0);
            s1[mt] = __builtin_amdgcn_mfma_f32_16x16x32_bf16(kf, qf1[ks], s1[mt], 0, 0, 0); } }
    bf16x8 p0[2], p1[2];
    if (n0) softmax_group<MODE>(s0, t, R0, sscale, O0, p0, g); else { p0[0] = (bf16x8){0, 0, 0, 0, 0, 0, 0, 0}; p0[1] = p0[0]; }
    if (n1) softmax_group<MODE>(s1, t, R1, sscale, O1, p1, g); else { p1[0] = (bf16x8){0, 0, 0, 0, 0, 0, 0, 0}; p1[1] = p1[0]; }
#pragma unroll
    for (int nt = 0; nt < 8; ++nt)
#pragma unroll
        for (int k2 = 0; k2 < 2; ++k2) {
            const v4i16_t a = __builtin_amdgcn_ds_read_tr16_b64_v4i16((LAS v4i16_t*)(vb + (32 * k2 + 4 * g + q4) * C::VPITCH + (16 * nt + 4 * p4) * 2));
            const v4i16_t b = __builtin_amdgcn_ds_read_tr16_b64_v4i16((LAS v4i16_t*)(vb + (32 * k2 + 16 + 4 * g + q4) * C::VPITCH + (16 * nt + 4 * p4) * 2));
            const bf16x8 vf = (bf16x8){a[0], a[1], a[2], a[3], b[0], b[1], b[2], b[3]};
            O0[nt] = __builtin_amdgcn_mfma_f32_16x16x32_bf16(p0[k2], vf, O0[nt], 0, 0, 0);
            O1[nt] = __builtin_amdgcn_mfma_f32_16x16x32_bf16(p1[k2], vf, O1[nt], 0, 0, 0); }
}
template <int DQK, int MODE>
__device__ __forceinline__ void fa_pass(LAS unsigned char* lds, const Src& S, const bf16x8 (&qf0)[Cfg<DQK>::NKS], const bf16x8 (&qf1)[Cfg<DQK>::NKS], unsigned tmask, RowState& R0, RowState& R1, float sscale,
                                        f32x4 (&O0)[8], f32x4 (&O1)[8], int tid, int lane) {
    typedef Cfg<DQK> C;
    const int i16 = lane & 15, g = lane >> 4, q4 = (lane & 15) >> 2, p4 = lane & 3;
#pragma unroll
    for (int nt = 0; nt < 8; ++nt) { O0[nt] = (f32x4){0.f, 0.f, 0.f, 0.f}; O1[nt] = (f32x4){0.f, 0.f, 0.f, 0.f}; }
    R0.m_run = -1e30f; R0.l_run = 0.f; R1.m_run = -1e30f; R1.l_run = 0.f;
    unsigned rem = tmask;
    if (rem == 0u) return;
    v4u kr[C::NKR], vr[2]; TileOff<DQK> TO; tile_offsets<DQK>(S, tid, TO);
    int t = __builtin_ctz(rem); rem &= rem - 1u;
    load_tile<DQK>(S, t * 64, TO, kr, vr);
    __syncthreads();
    store_tile<DQK>(lds, TO, kr, vr);
    __syncthreads();
    int cur = 0;
    for (;;) {
        const bool has_next = rem != 0u; int tn = 0;
        if (has_next) { tn = __builtin_ctz(rem); rem &= rem - 1u; load_tile<DQK>(S, tn * 64, TO, kr, vr); }
        LAS unsigned char* kb = lds + cur * C::BUF;
        fa_compute<DQK, MODE>(kb, kb + C::KBYTES, qf0, qf1, t, R0, R1, sscale, O0, O1, i16, g, q4, p4);
        if (has_next) store_tile<DQK>(lds + (cur ^ 1) * C::BUF, TO, kr, vr);
        __syncthreads();
        if (!has_next) break;
        t = tn; cur ^= 1;
    }
}
__device__ __forceinline__ void row_inv(float l_run, int lane, float (&inv)[4]) {
    float l = l_run; l += __shfl_xor(l, 16); l += __shfl_xor(l, 32);
    const float li = l > 0.f ? 1.f / l : 0.f; const int g = lane >> 4;
#pragma unroll
    for (int r = 0; r < 4; ++r) inv[r] = __shfl(li, 4 * g + r);
}
__device__ __forceinline__ void rope_qpe(bf16x8& f4, bf16x8& f5, float pz, int g4) {
    v4u w1 = __builtin_bit_cast(v4u, f4), w2 = __builtin_bit_cast(v4u, f5); float x1[8], x2[8]; unpack8(w1, x1); unpack8(w2, x2);
#pragma unroll
    for (int jj = 0; jj < 8; ++jj) { const float invf = exp2f(-(float)(8 * g4 + jj) * (13.287712379549449f / 32.f)); float sn, cs; fast_sincos(pz * invf, sn, cs);
        const float a = x1[jj] * cs - x2[jj] * sn, c = x1[jj] * sn + x2[jj] * cs; x1[jj] = a; x2[jj] = c; }
    w1.x = pk2(x1[0], x1[1]); w1.y = pk2(x1[2], x1[3]); w1.z = pk2(x1[4], x1[5]); w1.w = pk2(x1[6], x1[7]);
    w2.x = pk2(x2[0], x2[1]); w2.y = pk2(x2[2], x2[3]); w2.z = pk2(x2[4], x2[5]); w2.w = pk2(x2[6], x2[7]);
    f4 = __builtin_bit_cast(bf16x8, w1); f5 = __builtin_bit_cast(bf16x8, w2);
}
}

__device__ __forceinline__ void p_attn_mla(Frame& F, unsigned* queue) {
    const bf16* proj = (const bf16*)(F.ws + WS_PROJ); bf16* mixin = (bf16*)(F.ws + WS_MIXIN); const float* ocmp = (const float*)(F.ws + WS_OCMP); const unsigned* selm = (const unsigned*)(F.ws + WS_SELM);
    const bf16* qmla = (const bf16*)(F.ws + WS_QMLA); const bf16* kvu = (const bf16*)(F.ws + WS_KVU); const bf16* krot = (const bf16*)(F.ws + WS_KROT);
    volatile LAS unsigned* qslot = (volatile LAS unsigned*)(F.lds + LDSCTL_OFF);
    const int lane = F.lane, w = F.wave, i16 = lane & 15, g4 = lane >> 4;
    for (;;) {
        __syncthreads();
        if (F.tid == 0) qslot[0] = atomicAdd(queue, 1u);
        __syncthreads();
        const int u = __builtin_amdgcn_readfirstlane((int)qslot[0]);
        if (u >= 512) break;
        {
            const int qt = 7 - (u >> 6), bh = u & 63, b = bh >> 3, h = bh & 7, q0 = qt * 256;
            fa::RowState R0, R1; R0.spos = q0 + 32 * w + i16; R1.spos = R0.spos + 16; R0.rowmask = 0u; R1.rowmask = 0u;
            bf16x8 qf0[6], qf1[6];
#pragma unroll
            for (int ks = 0; ks < 6; ++ks) { qf0[ks] = *(const bf16x8*)(qmla + (size_t)(b * NS + R0.spos) * 1536 + h * 192 + 32 * ks + 8 * g4); qf1[ks] = *(const bf16x8*)(qmla + (size_t)(b * NS + R1.spos) * 1536 + h * 192 + 32 * ks + 8 * g4); }
            fa::rope_qpe(qf0[4], qf0[5], (float)((const int*)kin(1))[b * NS + R0.spos], g4);
            fa::rope_qpe(qf1[4], qf1[5], (float)((const int*)kin(1))[b * NS + R1.spos], g4);
            fa::Src S; S.k1 = kvu + (size_t)(b * NS) * 2048 + h * 256; S.ks1 = 2048; S.k2 = krot + (size_t)(b * NS) * 64; S.ks2 = 64; S.v = S.k1 + 128; S.vs = 2048;
            const int last = (q0 + 255) >> 6; const unsigned tmask = last >= 31 ? 0xffffffffu : ((1u << (last + 1)) - 1u);
            f32x4 O0[8], O1[8];
            fa::fa_pass<192, 0>(F.lds, S, qf0, qf1, tmask, R0, R1, 0.07216878364870322f * 1.4426950408889634f, O0, O1, F.tid, lane);
            float inv[4];
            fa::row_inv(R0.l_run, lane, inv);
#pragma unroll
            for (int r = 0; r < 4; ++r) { bf16* orow = mixin + (size_t)(b * NS + q0 + 32 * w + 4 * g4 + r) * ND + 1024 + h * 128 + i16;
#pragma unroll
                for (int nt = 0; nt < 8; ++nt) orow[16 * nt] = (bf16)f2bf(O0[nt][r] * inv[r]); }
            fa::row_inv(R1.l_run, lane, inv);
#pragma unroll
            for (int r = 0; r < 4; ++r) { bf16* orow = mixin + (size_t)(b * NS + q0 + 32 * w + 16 + 4 * g4 + r) * ND + 1024 + h * 128 + i16;
#pragma unroll
                for (int nt = 0; nt < 8; ++nt) orow[16 * nt] = (bf16)f2bf(O1[nt][r] * inv[r]); }
        }
    }
    (void)proj; (void)ocmp; (void)selm;
}
__device__ __forceinline__ void p_attn_nsa(Frame& F, unsigned* queue) {
    const bf16* proj = (const bf16*)(F.ws + WS_PROJ); bf16* mixin = (bf16*)(F.ws + WS_MIXIN); const float* ocmp = (const float*)(F.ws + WS_OCMP); const unsigned* selm = (const unsigned*)(F.ws + WS_SELM);
    const bf16* qmla = (const bf16*)(F.ws + WS_QMLA); const bf16* kvu = (const bf16*)(F.ws + WS_KVU); const bf16* krot = (const bf16*)(F.ws + WS_KROT);
    volatile LAS unsigned* qslot = (volatile LAS unsigned*)(F.lds + LDSCTL_OFF);
    const int lane = F.lane, w = F.wave, i16 = lane & 15, g4 = lane >> 4;
    for (;;) {
        __syncthreads();
        if (F.tid == 0) qslot[0] = atomicAdd(queue, 1u);
        __syncthreads();
        const int u = __builtin_amdgcn_readfirstlane((int)qslot[0]);
        if (u >= 512) break;
        {
            const int v = u;
            const int qt = 31 - (v >> 4), bg = v & 15, b = bg >> 1, gq = bg & 1, q0 = qt * 64;
            const int h = gq * 4 + (w >> 1), qb = q0 + (w & 1) * 32;
            fa::RowState R0, R1; R0.spos = qb + i16; R1.spos = qb + 16 + i16;
            bf16x8 qf0[4], qf1[4];
#pragma unroll
            for (int ks = 0; ks < 4; ++ks) { qf0[ks] = *(const bf16x8*)(proj + (size_t)(b * NS + R0.spos) * CD_INP + h * 128 + 32 * ks + 8 * g4); qf1[ks] = *(const bf16x8*)(proj + (size_t)(b * NS + R1.spos) * CD_INP + h * 128 + 32 * ks + 8 * g4); }
            R0.rowmask = selm[(size_t)(b * NS + R0.spos) * 2 + gq]; R1.rowmask = selm[(size_t)(b * NS + R1.spos) * 2 + gq];
            unsigned um = selm[(size_t)(b * NS + q0 + lane) * 2 + gq];
#pragma unroll
            for (int o = 1; o < 64; o <<= 1) um |= (unsigned)__shfl_xor((int)um, o);
            um = (unsigned)__builtin_amdgcn_readfirstlane((int)um);
            const bf16* base = proj + (size_t)(b * NS) * CD_INP;
            const float sscale = 0.08838834764831845f * 1.4426950408889634f;
            f32x4 O0[8], O1[8]; float inv[4];
            { fa::Src S; S.k1 = base + 1024 + ((1 * 2 + 0) * 2 + gq) * 128; S.ks1 = CD_INP; S.k2 = nullptr; S.ks2 = 0; S.v = base + 1024 + ((1 * 2 + 1) * 2 + gq) * 128; S.vs = CD_INP;
              fa::fa_pass<128, 1>(F.lds, S, qf0, qf1, um, R0, R1, sscale, O0, O1, F.tid, lane); }
            fa::row_inv(R0.l_run, lane, inv);
#pragma unroll
            for (int r = 0; r < 4; ++r) { const size_t m = (size_t)(b * NS + qb + 4 * g4 + r); const float g1 = sigmoidf_(bf1(proj[m * CD_INP + 2560 + h * 3 + 1])) * inv[r];
#pragma unroll
                for (int nt = 0; nt < 8; ++nt) mixin[m * ND + h * 128 + 16 * nt + i16] = (bf16)f2bf(ocmp[m * 1024 + h * 128 + 16 * nt + i16] + O0[nt][r] * g1); }
            fa::row_inv(R1.l_run, lane, inv);
#pragma unroll
            for (int r = 0; r < 4; ++r) { const size_t m = (size_t)(b * NS + qb + 16 + 4 * g4 + r); const float g1 = sigmoidf_(bf1(proj[m * CD_INP + 2560 + h * 3 + 1])) * inv[r];
#pragma unroll
                for (int nt = 0; nt < 8; ++nt) mixin[m * ND + h * 128 + 16 * nt + i16] = (bf16)f2bf(ocmp[m * 1024 + h * 128 + 16 * nt + i16] + O1[nt][r] * g1); }
            { fa::Src S; S.k1 = base + 1024 + ((2 * 2 + 0) * 2 + gq) * 128; S.ks1 = CD_INP; S.k2 = nullptr; S.ks2 = 0; S.v = base + 1024 + ((2 * 2 + 1) * 2 + gq) * 128; S.vs = CD_INP;
              const int klo = q0 - 511 > 0 ? q0 - 511 : 0, tlo = klo >> 6, thi = (q0 + 63) >> 6;
              const unsigned hm = thi >= 31 ? 0xffffffffu : ((1u << (thi + 1)) - 1u); const unsigned tmask = hm & ~((1u << tlo) - 1u);
              fa::fa_pass<128, 2>(F.lds, S, qf0, qf1, tmask, R0, R1, sscale, O0, O1, F.tid, lane); }
            fa::row_inv(R0.l_run, lane, inv);
#pragma unroll
            for (int r = 0; r < 4; ++r) { const size_t m = (size_t)(b * NS + qb + 4 * g4 + r); const float g2 = sigmoidf_(bf1(proj[m * CD_INP + 2560 + h * 3 + 2])) * inv[r];
#pragma unroll
                for (int nt = 0; nt < 8; ++nt) { bf16* op = mixin + m * ND + h * 128 + 16 * nt + i16; *op = (bf16)f2bf(bf1(*op) + O0[nt][r] * g2); } }
            fa::row_inv(R1.l_run, lane, inv);
#pragma unroll
            for (int r = 0; r < 4; ++r) { const size_t m = (size_t)(b * NS + qb + 16 + 4 * g4 + r); const float g2 = sigmoidf_(bf1(proj[m * CD_INP + 2560 + h * 3 + 2])) * inv[r];
#pragma unroll
                for (int nt = 0; nt < 8; ++nt) { bf16* op = mixin + m * ND + h * 128 + 16 * nt + i16; *op = (bf16)f2bf(bf1(*op) + O1[nt][r] * g2); } }
        }
    }
    (void)qmla; (void)kvu; (void)krot;
}

constexpr int NPHASE = 33;


#define IN(k) (lo <= (k) && (k) < hi)
#define SEAM(k) do { if (IN(k) && IN((k) + 1)) { if (MK_ONE_LAUNCH) xcd_barrier(bar); else if (F.tid == 0) __hip_atomic_store(F.ctl + CW_TMO, 0xBAD0u | (unsigned)(k), __ATOMIC_RELAXED, __HIP_MEMORY_SCOPE_AGENT); \
    if (MK_PROBE_PHASE >= 0 && blockIdx.x == 0 && F.tid == 0) { if ((k) == MK_PROBE_PHASE - 1) ((volatile LAS unsigned long long*)(F.lds + LDSCTL_OFF + 64))[0] = __builtin_amdgcn_s_memrealtime(); \
        if ((k) == MK_PROBE_LAST) ((volatile LAS unsigned long long*)(F.lds + LDSCTL_OFF + 64))[1] = __builtin_amdgcn_s_memrealtime(); } } } while (0)
template <int l>
__device__ __forceinline__ void layer_body(Frame& F, const XcdBarrier& bar, const int lo, const int hi) {
    unsigned char* ws = F.ws;
    bf16* const XB0 = (bf16*)(ws + WS_XB0); bf16* const X1B = (bf16*)(ws + WS_X1B); bf16* const X2B = (bf16*)(ws + WS_X2B);
    bf16* const PROJ = (bf16*)(ws + WS_PROJ); bf16* const MIXIN = (bf16*)(ws + WS_MIXIN); bf16* const MIXO = (bf16*)(ws + WS_MIXO);
    bf16* const HB = (bf16*)(ws + WS_H); bf16* const Y2 = (bf16*)(ws + WS_Y2);
        const int pb = 1 + l * 16;
        const bf16* xin = l == 0 ? XB0 : X2B;
        if (IN(pb + 0)) {
            if (l == 0) { pg8::DenseProb P; P.init(xin, ND, (const bf16*)(ws + WS_WABIN), NT, AB_IN, ND, F.G, (int)blockIdx.x); pg8::EpiBf16 E{PROJ, AB_IN};
                pg8::gemm_phase<pg8::EpiBf16, pg8::DenseProb, true>(F.lds, P, E); }
            else { pg8::DenseProb P; P.init(xin, ND, (const bf16*)(ws + WS_WCDIN), NT, CD_INP, ND, F.G, (int)blockIdx.x); pg8::EpiBf16 E{PROJ, CD_INP};
                pg8::gemm_phase<pg8::EpiBf16, pg8::DenseProb, true>(F.lds, P, E); }
        } SEAM(pb + 0);
        if (l == 0) {
            if (IN(pb + 2)) { if (blockIdx.x < NB * 6) p_retention_mfma(F, (int)blockIdx.x); else p_pool(F, ((int)blockIdx.x - NB * 6) * NWAVES + F.wave, (F.G - NB * 6) * NWAVES);
                __syncthreads(); p_moe_weights_queue(F, F.ctl + CW_CNT + 320); } SEAM(pb + 2);
        } else {
            if (IN(pb + 1)) { cmp_bias_finish(F); p_l1_thin_a(F); } SEAM(pb + 1);
            if (IN(pb + 2)) {
                if (blockIdx.x < 16) { pg8::CmpProb P; P.K = 4096; P.ldb = 4096; P.Abase = (const char*)(ws + WS_CMPKV); P.Bt = (const char*)(ws + WS_CW1); P.G = 16; P.c = (int)blockIdx.x;
                  pg8::EpiF32 E{(float*)(ws + WS_HID), 256, (const float*)(ws + WS_CMPB)};
                  pg8::gemm_phase<pg8::EpiF32, pg8::CmpProb, true>(F.lds, P, E); }
                else {
                { pg8::DenseProb P; P.init((const bf16*)(ws + WS_CQN), 384, (const bf16*)(ws + WS_WUQ), NT, 1536, 384, F.G - 16, (int)blockIdx.x - 16); pg8::EpiBf16 E{(bf16*)(ws + WS_QMLA), 1536};
                  pg8::gemm_phase<pg8::EpiBf16, pg8::DenseProb, true>(F.lds, P, E); }
                { pg8::DenseProb P; P.init((const bf16*)(ws + WS_CKVN), 512, (const bf16*)(ws + WS_WUKV), NT, 2048, 512, F.G - 16, (int)blockIdx.x - 16); pg8::EpiBf16 E{(bf16*)(ws + WS_KVU), 2048};
                  pg8::gemm_phase<pg8::EpiBf16, pg8::DenseProb, true>(F.lds, P, E); }
                }
            } SEAM(pb + 2);
            if (IN(pb + 3)) { p_l1_thin_b(F); } SEAM(pb + 3);
            if (IN(pb + 4)) { p_nsa_cmp_mfma(F); } SEAM(pb + 4);
            if (IN(pb + 5)) { p_attn_mla(F, F.ctl + CW_CNT + 256); p_attn_nsa(F, F.ctl + CW_CNT + 257); } SEAM(pb + 5);
        }
        if (IN(pb + 6)) { pg8::DenseProb P; P.init(MIXIN, ND, (const bf16*)(ws + (l == 0 ? WS_WABOUT : WS_WCDOUT)), NT, ND, ND, F.G, (int)blockIdx.x); pg8::EpiBf16 E{MIXO, ND};
            pg8::gemm_phase<pg8::EpiBf16, pg8::DenseProb, true>(F.lds, P, E); } SEAM(pb + 6);
        if (IN(pb + 7)) { p_ln1(F, xin, MIXO, kin(15) + l * ND, kin(16) + l * ND, X1B, MK_FP8_MOE ? (unsigned char*)(ws + WS_X1F8) : nullptr); } SEAM(pb + 7);
        if (IN(pb + 8)) { pg8::RouterProb P; P.K = 512; P.ldb = ND; P.Abase = (const char*)X1B; P.Bt = (const char*)(ws + WS_RT + (size_t)l * MiB); P.G = F.G; P.c = (int)blockIdx.x;
            pg8::EpiF32N64 E{(float*)(ws + WS_LOGITS)};
            pg8::gemm_phase<pg8::EpiF32N64, pg8::RouterProb, true>(F.lds, P, E); } SEAM(pb + 8);
        if (IN(pb + 9)) { p_route(F, l); } SEAM(pb + 9);
        if (IN(pb + 10)) { p_scatter(F, l); } SEAM(pb + 10);
        if (IN(pb + 11)) { load_offsets(F, l); const LAS int* tab = (const LAS int*)(F.lds + TAB_OFF);
            pg8::MoeUpProb P; P.W13 = (const char*)(ws + WS_W13 + (size_t)l * WS_MOE_LSTRIDE); P.sorted = (const int*)(ws + WS_SORTED); P.tile_e = tab + 160; P.ntiles = __builtin_amdgcn_readfirstlane(tab[65]);
            P.G = F.G; P.c = (int)blockIdx.x;
            if (MK_FP8_MOE) { P.K = ND / 2; P.ldb = ND / 2; P.arow = ND; P.brow = ND; P.pshift = 3; P.btile = 128; P.nunits = (P.ntiles + NT / 256) * 8; P.Abase = (const char*)(ws + WS_X1F8);
                pg8::EpiSwigluF8 E{(unsigned char*)HB, 1.0f / 64.0f};
                pg8::gemm_phase<pg8::EpiSwigluF8, pg8::MoeUpProb, true, true>(F.lds, P, E); }
            else { P.K = ND; P.ldb = ND; P.arow = ND * 2; P.brow = ND * 2; P.pshift = 2; P.btile = 256; P.nunits = (P.ntiles + NT / 256) * 4; P.Abase = (const char*)X1B;
                pg8::EpiSwiglu E{HB};
                pg8::gemm_phase<pg8::EpiSwiglu, pg8::MoeUpProb, true>(F.lds, P, E); } } SEAM(pb + 11);
        if (IN(pb + 12)) { load_offsets(F, l); const LAS int* tab = (const LAS int*)(F.lds + TAB_OFF);
            pg8::MoeDownProb P; P.Abase = (const char*)HB; P.W2 = (const char*)(ws + WS_W2 + (size_t)l * WS_MOE_LSTRIDE); P.tile_e = tab + 160; P.ntiles = __builtin_amdgcn_readfirstlane(tab[65]);
            P.G = F.G; P.c = (int)blockIdx.x;
            if (MK_FP8_MOE) { P.K = EFF / 2; P.ldb = EFF / 2; P.arow = EFF; P.brow = EFF; P.pshift = 4; P.btile = 128; P.nunits = (P.ntiles + NT / 256) * 16;
                pg8::EpiFp8N128 E{(unsigned char*)Y2, ND, 16.0f / (64.0f * 8.0f)};
                pg8::gemm_phase<pg8::EpiFp8N128, pg8::MoeDownProb, true, true>(F.lds, P, E); }
            else { P.K = EFF; P.ldb = EFF; P.arow = EFF * 2; P.brow = EFF * 2; P.pshift = 3; P.btile = 256; P.nunits = (P.ntiles + NT / 256) * 8;
                pg8::EpiFp8 E{(unsigned char*)Y2, ND, 16.0f};
                pg8::gemm_phase<pg8::EpiFp8, pg8::MoeDownProb, true>(F.lds, P, E); } } SEAM(pb + 12);
        if (IN(pb + 13)) { p_combine_ln2(F, X1B, (const unsigned char*)Y2, (const int*)(ws + WS_SLOT), (const float*)(ws + WS_WSEL), kin(17) + l * ND, kin(18) + l * ND, l == 0 ? X2B : nullptr, l == 0 ? nullptr : F.out); } SEAM(pb + 13);
    }
__global__ void __launch_bounds__(NWAVES * 64, 2) mk_fwd(Args args) {
    extern __shared__ __attribute__((aligned(16))) unsigned char lds[];
    Frame F;
    F.lds = (LAS unsigned char*)lds;
    F.MISC = (volatile LAS unsigned*)(F.lds + MISC_OFF);
    F.tid = threadIdx.x; F.lane = F.tid & 63; F.wave = __builtin_amdgcn_readfirstlane(F.tid >> 6);
    F.G = gridDim.x; { const int bx = blockIdx.x; F.vcu = (F.G % 8 == 0) ? (bx % 8) * (F.G / 8) + bx / 8 : bx; }
    F.gw = F.vcu * NWAVES + F.wave; F.NGW = F.G * NWAVES;
    F.ws = args.ws; F.ctl = (unsigned*)(args.ws + WS_CTL); F.out = args.out;
    for (int u = F.tid; u < (LDS_BYTES - LDSCTL_OFF) / 4; u += NWAVES * 64) ((LAS unsigned*)(F.lds + LDSCTL_OFF))[u] = 0u;
    __syncthreads();
    XcdBarrier bar; bar.bar = F.ctl + CW_BAR; bar.x = 0; bar.st = nullptr;
    if (MK_ONE_LAUNCH) bar = xcd_barrier_post(F.ctl + CW_BAR, F.MISC + 8);
    const int lo = args.ph_lo, hi = args.ph_hi;
    if (MK_PROBE_PHASE == 0 && blockIdx.x == 0 && F.tid == 0) ((volatile LAS unsigned long long*)(F.lds + LDSCTL_OFF + 64))[0] = __builtin_amdgcn_s_memrealtime();
    unsigned char* ws = args.ws;
    bf16* const XB0 = (bf16*)(ws + WS_XB0); bf16* const X1B = (bf16*)(ws + WS_X1B); bf16* const X2B = (bf16*)(ws + WS_X2B);
    bf16* const PROJ = (bf16*)(ws + WS_PROJ); bf16* const MIXIN = (bf16*)(ws + WS_MIXIN); bf16* const MIXO = (bf16*)(ws + WS_MIXO);
    bf16* const HB = (bf16*)(ws + WS_H); bf16* const Y2 = (bf16*)(ws + WS_Y2);

    if (IN(0)) { p_prologue(F); } SEAM(0);

    layer_body<0>(F, bar, lo, hi);
    layer_body<1>(F, bar, lo, hi);
    if (MK_PROBE_PHASE >= 0 && blockIdx.x == 0 && F.tid == 0) {
        volatile LAS unsigned long long* tsl = (volatile LAS unsigned long long*)(F.lds + LDSCTL_OFF + 64);
        if (MK_PROBE_LAST == 30) tsl[1] = __builtin_amdgcn_s_memrealtime();
        const unsigned long long span = (tsl[1] - tsl[0]) * MK_PROBE_AMP, t0 = __builtin_amdgcn_s_memrealtime();
        while (__builtin_amdgcn_s_memrealtime() - t0 < span) __builtin_amdgcn_s_sleep(8);
    }
#undef IN
#undef SEAM
}

extern "C" void kernel_launch(void* const* d_in, const int* in_sizes, int n_in, void* d_out, int out_size, void* d_ws, size_t ws_size, hipStream_t stream) {
    static int grid = 0;
    if (grid == 0) {
        if (n_in != 27 || in_sizes[0] != NT * ND || out_size != NT * ND || ws_size < WS_END) { fprintf(stderr, "kernel_launch: unexpected problem (n_in %d, in0 %d, out %d, ws %zu < %zu); nothing launched\n", n_in, n_in > 0 ? in_sizes[0] : -1, out_size, ws_size, (size_t)WS_END); grid = -1; return; }
        int dev = 0, cus = 0, per_cu = 0;
        if (hipGetDevice(&dev) != hipSuccess || hipDeviceGetAttribute(&cus, hipDeviceAttributeMultiprocessorCount, dev) != hipSuccess) { fprintf(stderr, "kernel_launch: device query failed\n"); grid = -1; return; }
        if (hipFuncSetAttribute((const void*)mk_fwd, hipFuncAttributeMaxDynamicSharedMemorySize, LDS_BYTES) != hipSuccess) { fprintf(stderr, "kernel_launch: hipFuncSetAttribute failed\n"); grid = -1; return; }
        if (hipOccupancyMaxActiveBlocksPerMultiprocessor(&per_cu, (const void*)mk_fwd, NWAVES * 64, LDS_BYTES) != hipSuccess || per_cu < 1) fprintf(stderr, "kernel_launch: note: occupancy query reports %d\n", per_cu);
        (void)hipGetLastError();
        grid = cus;
    }
    if (grid < 0) return;
    if (hipMemsetAsync((char*)d_ws + WS_CTL, 0, CTL_ZERO_BYTES, stream) != hipSuccess) { fprintf(stderr, "kernel_launch: memset failed\n"); return; }
    Args a{};
    for (int i = 0; i < 27; ++i) a.in[i] = (const float*)d_in[i];
    a.out = (float*)d_out; a.ws = (unsigned char*)d_ws;
#if MK_ONE_LAUNCH
    a.ph_lo = 0; a.ph_hi = NPHASE;
    hipLaunchKernelGGL(mk_fwd, dim3(grid), dim3(NWAVES * 64), LDS_BYTES, stream, a);
#else
    for (int p = 0; p < NPHASE; ++p) {
        const int lp = (p - 1) & 15;
        if (p >= 1) { const int l = (p - 1) >> 4; if (lp >= 14) continue; if (l == 0 && lp >= 3 && lp <= 5) continue; }
        a.ph_lo = p; a.ph_hi = p + 1;
        hipLaunchKernelGGL(mk_fwd, dim3(grid), dim3(NWAVES * 64), LDS_BYTES, stream, a);
    }
#endif
    const hipError_t le = hipPeekAtLastError();
    if (le != hipSuccess) fprintf(stderr, "kernel_launch: launch failed: %s\n", hipGetErrorName(le));
}
```

```cpp
#include <hip/hip_runtime.h>
#include <cstdio>
#include <cstdint>

#ifndef MK_ONE_LAUNCH
#define MK_ONE_LAUNCH 1
#endif
#ifndef MK_FP8_MOE
#define MK_FP8_MOE 1
#endif
#ifndef MK_PROBE_PHASE
#define MK_PROBE_PHASE -1
#endif
#ifndef MK_PROBE_LAST
#define MK_PROBE_LAST MK_PROBE_PHASE
#endif
#ifndef MK_PROBE_AMP
#define MK_PROBE_AMP 4
#endif

#define GAS __attribute__((address_space(1)))
#define LAS __attribute__((address_space(3)))
typedef unsigned short bf16;
typedef unsigned v4u __attribute__((ext_vector_type(4)));
typedef unsigned v2u __attribute__((ext_vector_type(2)));
typedef float f32x4 __attribute__((ext_vector_type(4)));
typedef float f32x2 __attribute__((ext_vector_type(2)));
typedef short bf16x8 __attribute__((ext_vector_type(8)));

constexpr int NB = 8, NS = 2048, ND = 2048, NT = NB * NS;
constexpr float DN_ALPHA = 1.41421356237309505f;
constexpr float LN_EPS = 1e-5f, NORM_EPS = 1e-6f;
constexpr int AB_IN = 5120, CD_IN = 3544, CD_INP = 3584;
constexpr int NEXP = 64, EFF = 512;
constexpr int MAXROWS = NT * 8 + NEXP * 256;
constexpr int MAXTILES = MAXROWS / 256;
constexpr int SH_ROW0 = MAXROWS;

constexpr size_t MiB = 1u << 20;
constexpr size_t WS_CTL = 0, CTL_ZERO_BYTES = 1 * MiB;
constexpr size_t WS_TOPE = 1 * MiB, WS_WSEL = WS_TOPE + 512 * 1024, WS_SLOT = 2 * MiB, WS_SORTED = WS_SLOT + 512 * 1024;
constexpr size_t WS_CMPB = 3 * MiB + 256 * 1024, WS_SELM = 3 * MiB + 512 * 1024;
constexpr size_t WS_KVCMP = 4 * MiB;
constexpr size_t WS_HID = 6 * MiB;
constexpr size_t WS_WABIN = 16 * MiB, WS_WABOUT = 36 * MiB, WS_WCDIN = 44 * MiB, WS_WCDOUT = 58 * MiB, WS_WUQ = 66 * MiB, WS_WUKV = 68 * MiB, WS_CW1 = 70 * MiB, WS_RT = 72 * MiB;
constexpr size_t WS_W13 = 74 * MiB, WS_W2 = 334 * MiB, WS_MOE_LSTRIDE = 390 * MiB;
constexpr size_t WS_XB0 = 854 * MiB, WS_X2B = 854 * MiB, WS_X1B = 918 * MiB;
constexpr size_t WS_H = 982 * MiB, WS_Y2 = 1142 * MiB, WS_X1F8 = 1782 * MiB, WS_END = 1814 * MiB;
constexpr size_t WS_PROJ = 982 * MiB, WS_MIXIN = 1142 * MiB, WS_MIXO = 1206 * MiB;
constexpr size_t WS_QR = 1270 * MiB, WS_KR = 1294 * MiB;
constexpr size_t WS_CQN = 1270 * MiB, WS_CKVN = 1282 * MiB, WS_KROT = 1298 * MiB, WS_QMLA = 1302 * MiB, WS_KVU = 1350 * MiB, WS_CMPKV = 1414 * MiB, WS_OCMP = 1434 * MiB;
constexpr size_t WS_LOGITS = 1142 * MiB;
constexpr int CW_TMO = 0, CW_CODE = 1, CW_BAR = 4096, CW_CNT = 16384;

constexpr int RING_BYTES = 131072, LDSCTL_OFF = RING_BYTES, MISC_OFF = LDSCTL_OFF + 320, TAB_OFF = LDSCTL_OFF + 512;
constexpr int LDS_BYTES = 147456;
constexpr int NWAVES = 8;

#define LDS_WAIT() asm volatile("s_waitcnt lgkmcnt(0)" ::: "memory")
#define VM_WAIT() asm volatile("s_waitcnt vmcnt(0)" ::: "memory")
typedef __bf16 hwbf16x2 __attribute__((ext_vector_type(2)));
__device__ __forceinline__ unsigned pk2(float lo, float hi) { const f32x2 v = {lo, hi}; const hwbf16x2 b = __builtin_convertvector(v, hwbf16x2); return __builtin_bit_cast(unsigned, b); }
__device__ __forceinline__ unsigned f2bf(float f) { return pk2(f, 0.f) & 0xffffu; }
__device__ __forceinline__ void fast_sincos(float ang, float& sn, float& cs) { const float r = __builtin_amdgcn_fractf(ang * 0.15915494309189535f); sn = __builtin_amdgcn_sinf(r); cs = __builtin_amdgcn_cosf(r); }
__device__ __forceinline__ float bflo(unsigned w) { return __builtin_bit_cast(float, w << 16); }
__device__ __forceinline__ float bfhi(unsigned w) { return __builtin_bit_cast(float, w & 0xffff0000u); }
__device__ __forceinline__ float bf1(bf16 v) { return __builtin_bit_cast(float, ((unsigned)v) << 16); }
__device__ __forceinline__ float wave_sum(float v) {
#pragma unroll
    for (int o = 1; o < 64; o <<= 1) v += __shfl_xor(v, o);
    return v;
}
__device__ __forceinline__ float wave_max(float v) {
#pragma unroll
    for (int o = 1; o < 64; o <<= 1) v = fmaxf(v, __shfl_xor(v, o));
    return v;
}
__device__ __forceinline__ float sigmoidf_(float x) { return 1.0f / (1.0f + __expf(-x)); }
__device__ __forceinline__ float siluf_(float x) { return x / (1.0f + __expf(-x)); }
__device__ __forceinline__ void unpack8(const v4u w, float (&f)[8]) {
    f[0] = bflo(w.x); f[1] = bfhi(w.x); f[2] = bflo(w.y); f[3] = bfhi(w.y); f[4] = bflo(w.z); f[5] = bfhi(w.z); f[6] = bflo(w.w); f[7] = bfhi(w.w);
}

#define XB_TMO      128
#define XB_XCNT(j)  (256  + 64 * (j))
#define XB_XSUB(j)  (1280 + 64 * (j))
#define XB_XGEN(j)  (2304 + 64 * (j))
#define XB_TOP      3328
#define XB_TOPGEN   3392
#define XCD_BAR_WORDS 3456
#define XB_SPIN_CAP (1u << 18)
__device__ __forceinline__ unsigned xb_ld(unsigned* p)              { return __hip_atomic_load(p, __ATOMIC_RELAXED, __HIP_MEMORY_SCOPE_AGENT); }
__device__ __forceinline__ unsigned xb_add(unsigned* p, unsigned v) { return __hip_atomic_fetch_add(p, v, __ATOMIC_RELAXED, __HIP_MEMORY_SCOPE_AGENT); }
__device__ __forceinline__ unsigned xb_xcc_id() { return (unsigned)__builtin_amdgcn_s_getreg((3 << 11) | 20) & 0xFu; }
#define XB_SPIN(cond, bar) do { unsigned _sp = 0; while (cond) { __builtin_amdgcn_s_sleep(1); \
    if ((++_sp & 255u) == 0u) { if (xb_ld(&(bar)[XB_TMO])) break; if (_sp > XB_SPIN_CAP) { atomicAdd(&(bar)[XB_TMO], 1u); break; } } } } while (0)
struct XcdBarrier { unsigned* bar; unsigned x; volatile LAS unsigned* st; };
__device__ __forceinline__ XcdBarrier xcd_barrier_post(unsigned* bar, volatile LAS unsigned* st) {
    XcdBarrier b; b.bar = bar; b.x = xb_xcc_id(); b.st = st;
    if (threadIdx.x == 0) (void)xb_add(&bar[XB_XCNT(b.x)], 1u);
    return b;
}
__device__ __forceinline__ void xcd_barrier_complete(unsigned* bar, unsigned x, unsigned& nloc, unsigned& nx) {
    const unsigned G = gridDim.x * gridDim.y * gridDim.z;
    unsigned sum, cnt, mine, sp = 0u;
    for (;;) {
        sum = 0u; cnt = 0u; mine = 0u;
#pragma unroll
        for (unsigned j = 0; j < 16; ++j) { const unsigned c = xb_ld(&bar[XB_XCNT(j)]); sum += c; cnt += (c > 0u) ? 1u : 0u; mine = (j == x) ? c : mine; }
        if (sum == G) break;
        __builtin_amdgcn_s_sleep(1);
        if ((++sp & 255u) == 0u) { if (xb_ld(&bar[XB_TMO])) break; if (sp > XB_SPIN_CAP) { atomicAdd(&bar[XB_TMO], 1u); break; } }
    }
    nloc = mine > 0u ? mine : 1u; nx = cnt > 0u ? cnt : 1u;
}
__device__ __forceinline__ void xcd_barrier(const XcdBarrier& b) {
    asm volatile("s_waitcnt vmcnt(0)" ::: "memory");
    __syncthreads();
    if (threadIdx.x == 0) {
        unsigned* bar = b.bar;
        __builtin_amdgcn_s_waitcnt(0);
        unsigned nloc = b.st[0], nx = b.st[1];
        if (nloc == 0u) { xcd_barrier_complete(bar, b.x, nloc, nx); b.st[0] = nloc; b.st[1] = nx; }
        const unsigned old = xb_add(&bar[XB_XSUB(b.x)], 1u);
        const unsigned gen = old / nloc;
        if (old + 1u == (gen + 1u) * nloc) {
            __builtin_amdgcn_fence(__ATOMIC_RELEASE, "agent");
            asm volatile("s_waitcnt vmcnt(0)" ::: "memory");
            const unsigned og = xb_add(&bar[XB_TOP], 1u);
            const unsigned tg = og / nx;
            if (og + 1u == (tg + 1u) * nx) xb_add(&bar[XB_TOPGEN], 1u);
            else XB_SPIN(xb_ld(&bar[XB_TOPGEN]) == tg, bar);
            __builtin_amdgcn_fence(__ATOMIC_ACQUIRE, "agent");
            xb_add(&bar[XB_XGEN(b.x)], 1u);
            asm volatile("s_waitcnt vmcnt(0)" ::: "memory");
        } else {
            XB_SPIN(xb_ld(&bar[XB_XGEN(b.x)]) == gen, bar);
            __builtin_amdgcn_fence(__ATOMIC_ACQUIRE, "agent");
            asm volatile("s_waitcnt vmcnt(0)" ::: "memory");
        }
    }
    __syncthreads();
}

namespace pg8 {
typedef int v4i_t __attribute__((ext_vector_type(4)));
constexpr int BM = 256, BK = 64, HALF = 128, HTB = HALF * BK * 2, STAGE_BYTES = 8 * HTB, NXCD = 8, WGM = 8;
__host__ __device__ __forceinline__ int lds_byte(int r, int c) { const int st = (r >> 4) * 2 + (c >> 5), rr = r & 15, cc = c & 31, ob = rr * 64 + cc * 2; return st * 1024 + (ob ^ (((ob >> 9) & 1) << 5)); }
__host__ __device__ __forceinline__ void stage_rc(int b, int& R, int& C) { const int st = b / 1024, sb = b % 1024, swz = sb ^ (((sb >> 9) & 1) << 5); R = (st >> 1) * 16 + swz / 64; C = (st & 1) * 32 + (swz % 64) / 2; }
__host__ __device__ __forceinline__ int perm32(int rho) { const int n = rho >> 4, i = rho & 15; return 8 * (i >> 2) + 4 * n + (i & 3); }
struct Unit { int pm, pn, e; };

__device__ __forceinline__ unsigned cvt_pk_bf16(float lo, float hi) { unsigned r; asm volatile("v_cvt_pk_bf16_f32 %0, %1, %2" : "=v"(r) : "v"(lo), "v"(hi)); return r; }

struct EpiBf16 {
    static constexpr bool PERM = true;
    bf16* O; int ldc;
    __device__ __forceinline__ void operator()(const f32x4 (&acc)[2][2][4][2], const Unit& u, int wr, int wc, int fr, int fq) const {
        const int row0 = u.pm * BM + wr * 64 + fr, col0 = u.pn * BM + wc * 32 + 8 * fq;
#pragma unroll
        for (int ai = 0; ai < 2; ++ai)
#pragma unroll
            for (int m = 0; m < 4; ++m) { bf16* rowp = O + (size_t)(row0 + ai * HALF + m * 16) * ldc + col0;
#pragma unroll
                for (int bj = 0; bj < 2; ++bj) { const f32x4 v0 = acc[ai][bj][m][0], v1 = acc[ai][bj][m][1];
                    v4u w; w.x = cvt_pk_bf16(v0[0], v0[1]); w.y = cvt_pk_bf16(v0[2], v0[3]); w.z = cvt_pk_bf16(v1[0], v1[1]); w.w = cvt_pk_bf16(v1[2], v1[3]);
                    *(v4u*)(rowp + bj * HALF) = w; } }
    }
};
struct EpiFp8 {
    static constexpr bool PERM = true;
    unsigned char* O; int ldc; float mul;
    __device__ __forceinline__ void operator()(const f32x4 (&acc)[2][2][4][2], const Unit& u, int wr, int wc, int fr, int fq) const {
        const int row0 = u.pm * BM + wr * 64 + fr, col0 = u.pn * BM + wc * 32 + 8 * fq;
#pragma unroll
        for (int ai = 0; ai < 2; ++ai)
#pragma unroll
            for (int m = 0; m < 4; ++m) { unsigned char* rowp = O + (size_t)(row0 + ai * HALF + m * 16) * ldc + col0;
#pragma unroll
                for (int bj = 0; bj < 2; ++bj) { float v[8];
#pragma unroll
                    for (int n = 0; n < 2; ++n)
#pragma unroll
                        for (int j = 0; j < 4; ++j) v[n * 4 + j] = fminf(fmaxf(acc[ai][bj][m][n][j] * mul, -448.0f), 448.0f);
                    int w0 = __builtin_amdgcn_cvt_pk_fp8_f32(v[0], v[1], 0, false); w0 = __builtin_amdgcn_cvt_pk_fp8_f32(v[2], v[3], w0, true);
                    int w1 = __builtin_amdgcn_cvt_pk_fp8_f32(v[4], v[5], 0, false); w1 = __builtin_amdgcn_cvt_pk_fp8_f32(v[6], v[7], w1, true);
                    *(v2u*)(rowp + bj * HALF) = (v2u){(unsigned)w0, (unsigned)w1}; } }
    }
};
struct EpiF32 {
    static constexpr bool PERM = false;
    float* C; int ldc; const float* bias;
    __device__ __forceinline__ void operator()(const f32x4 (&acc)[2][2][4][2], const Unit& u, int wr, int wc, int fr, int fq) const {
        const int row0 = u.pm * BM + wr * 64 + fr, col0 = u.pn * BM + wc * 32 + 4 * fq;
        f32x4 bv[2][2];
#pragma unroll
        for (int bj = 0; bj < 2; ++bj)
#pragma unroll
            for (int n = 0; n < 2; ++n) bv[bj][n] = bias ? *(const f32x4*)(bias + col0 + bj * HALF + n * 16) : (f32x4){0.f, 0.f, 0.f, 0.f};
#pragma unroll
        for (int ai = 0; ai < 2; ++ai)
#pragma unroll
            for (int m = 0; m < 4; ++m) { float* rowp = C + (size_t)(row0 + ai * HALF + m * 16) * ldc + col0;
#pragma unroll
                for (int bj = 0; bj < 2; ++bj)
#pragma unroll
                    for (int n = 0; n < 2; ++n) *(f32x4*)(rowp + bj * HALF + n * 16) = acc[ai][bj][m][n] + bv[bj][n]; }
    }
};
struct EpiSwiglu {
    static constexpr bool PERM = true;
    bf16* H;
    __device__ __forceinline__ void operator()(const f32x4 (&acc)[2][2][4][2], const Unit& u, int wr, int wc, int fr, int fq) const {
        const int row0 = u.pm * BM + wr * 64 + fr, col0 = u.pn * HALF + wc * 32 + 8 * fq;
#pragma unroll
        for (int ai = 0; ai < 2; ++ai)
#pragma unroll
            for (int m = 0; m < 4; ++m) { bf16* rowp = H + (size_t)(row0 + ai * HALF + m * 16) * EFF + col0;
                float o[8];
#pragma unroll
                for (int n = 0; n < 2; ++n)
#pragma unroll
                    for (int j = 0; j < 4; ++j) { const float h1 = acc[ai][0][m][n][j], h3 = acc[ai][1][m][n][j]; o[n * 4 + j] = siluf_(h1) * h3; }
                v4u w; w.x = cvt_pk_bf16(o[0], o[1]); w.y = cvt_pk_bf16(o[2], o[3]); w.z = cvt_pk_bf16(o[4], o[5]); w.w = cvt_pk_bf16(o[6], o[7]);
                *(v4u*)rowp = w; }
    }
};

template <class Epi, class Prob, bool ALIGN_EPI, bool F8 = false>
__device__ __forceinline__ void gemm_phase(LAS unsigned char* lds, const Prob& P, const Epi& E) {
    const int tid = threadIdx.x, wid = __builtin_amdgcn_readfirstlane(tid >> 6), lane = tid & 63, wr = wid >> 2, wc = wid & 3, fr = lane & 15, fq = lane >> 4;
    const int K = P.K, nt = K / BK, ldb = P.ldb;
    unsigned voffB[2];
#pragma unroll
    for (int i = 0; i < 2; ++i) { int R, C; stage_rc(tid * 16 + i * 8192, R, C); const int Rb = Epi::PERM ? ((R & ~31) + perm32(R & 31)) : R;
        voffB[i] = (unsigned)(Rb * ldb + C) * 2u; }
    const size_t kstep = (size_t)(BK * 2);
    const size_t hstep = (size_t)HALF * ldb * 2;
    const unsigned ldsw = (unsigned)wid * 1024u;
    const int aoff = lds_byte(wr * 64 + fr, fq * 8), boff = lds_byte(wc * 32 + fr, fq * 8);
    const char* const Ab = P.Abase;
#define PG8_SA(b, h) (((b) * 2 + (h)) * HTB)
#define PG8_SB(b, h) ((4 + (b) * 2 + (h)) * HTB)
#define PG8_STAGE(bufoff, gbase, voff) do { _Pragma("unroll") for (int _i = 0; _i < 2; ++_i) \
        __builtin_amdgcn_global_load_lds((const unsigned*)((const char*)(gbase) + (voff)[_i]), (LAS unsigned*)(lds + (bufoff) + ldsw + _i * 8192), 16, 0, 0); } while (0)
#define PG8_STAGE_A(bufoff, kb, o0, o1) do { \
        __builtin_amdgcn_global_load_lds((const unsigned*)(Ab + (kb) + (o0)), (LAS unsigned*)(lds + (bufoff) + ldsw), 16, 0, 0); \
        __builtin_amdgcn_global_load_lds((const unsigned*)(Ab + (kb) + (o1)), (LAS unsigned*)(lds + (bufoff) + ldsw + 8192), 16, 0, 0); } while (0)
#define PG8_LDA(dst, b, h) do { _Pragma("unroll") for (int m = 0; m < 4; ++m) _Pragma("unroll") for (int k = 0; k < 2; ++k) dst[m][k] = *(const LAS bf16x8*)(lds + PG8_SA(b, h) + aoff + m * 2048 + k * 1024); } while (0)
#define PG8_LDB(dst, b, h) do { _Pragma("unroll") for (int n = 0; n < 2; ++n) _Pragma("unroll") for (int k = 0; k < 2; ++k) dst[n][k] = *(const LAS bf16x8*)(lds + PG8_SB(b, h) + boff + n * 2048 + k * 1024); } while (0)
#define PG8_CAT(lo, hi) __builtin_shufflevector(__builtin_bit_cast(v4i_t, lo), __builtin_bit_cast(v4i_t, hi), 0, 1, 2, 3, 4, 5, 6, 7)
#define PG8_MMA(ai, bj, At, Bt) do { __builtin_amdgcn_s_setprio(1); \
        if constexpr (F8) { _Pragma("unroll") for (int m = 0; m < 4; ++m) _Pragma("unroll") for (int n = 0; n < 2; ++n) \
            acc[ai][bj][m][n] = __builtin_amdgcn_mfma_scale_f32_16x16x128_f8f6f4(PG8_CAT(Bt[n][0], Bt[n][1]), PG8_CAT(At[m][0], At[m][1]), acc[ai][bj][m][n], 0, 0, 0, 0x7F7F7F7F, 0, 0x7F7F7F7F); } \
        else { _Pragma("unroll") for (int m = 0; m < 4; ++m) _Pragma("unroll") for (int n = 0; n < 2; ++n) _Pragma("unroll") for (int k = 0; k < 2; ++k) \
            acc[ai][bj][m][n] = __builtin_amdgcn_mfma_f32_16x16x32_bf16(Bt[n][k], At[m][k], acc[ai][bj][m][n], 0, 0, 0); } \
        __builtin_amdgcn_s_setprio(0); } while (0)
#define PG8_WAIT_V(n) asm volatile("s_waitcnt vmcnt(" #n ")" ::: "memory")
#define PG8_WAIT_L(n) asm volatile("s_waitcnt lgkmcnt(" #n ")" ::: "memory")
#define PG8_BAR __builtin_amdgcn_s_barrier()
#define PG8_SCHED __builtin_amdgcn_sched_barrier(0)
    Unit cur, nxt; int ui = 0;
    if (!P.next(0, cur)) return;
    f32x4 acc[2][2][4][2];
#pragma unroll
    for (int a = 0; a < 2; ++a)
#pragma unroll
        for (int b = 0; b < 2; ++b)
#pragma unroll
            for (int m = 0; m < 4; ++m)
#pragma unroll
                for (int n = 0; n < 2; ++n) acc[a][b][m][n] = (f32x4){0.f, 0.f, 0.f, 0.f};
    bf16x8 At[4][2], B0[2][2], B1[2][2];
    unsigned oc[4], on[4];
    { int RA[2], CA[2]; stage_rc(tid * 16, RA[0], CA[0]); stage_rc(tid * 16 + 8192, RA[1], CA[1]); P.aoffs(cur, RA, CA, oc); }
    const char* cB = P.bbase(cur);
    if constexpr (F8) {
        PG8_STAGE(PG8_SB(0, 0), cB, voffB); PG8_STAGE_A(PG8_SA(0, 0), (size_t)0, oc[0], oc[1]); PG8_STAGE_A(PG8_SA(0, 1), (size_t)0, oc[2], oc[3]);
        if (wr == 1) PG8_BAR;
        PG8_WAIT_V(2); PG8_BAR;
        PG8_STAGE(PG8_SB(1, 0), cB + kstep, voffB); PG8_STAGE_A(PG8_SA(1, 0), kstep, oc[0], oc[1]);
        PG8_WAIT_V(4); PG8_BAR;
    } else {
    PG8_STAGE(PG8_SB(0, 0), cB, voffB); PG8_STAGE(PG8_SB(0, 1), cB + hstep, voffB); PG8_STAGE_A(PG8_SA(0, 0), (size_t)0, oc[0], oc[1]); PG8_STAGE_A(PG8_SA(0, 1), (size_t)0, oc[2], oc[3]);
    if (wr == 1) PG8_BAR;
    PG8_WAIT_V(2); PG8_BAR;
    PG8_STAGE(PG8_SB(1, 0), cB + kstep, voffB); PG8_STAGE_A(PG8_SA(1, 0), kstep, oc[0], oc[1]); PG8_STAGE(PG8_SB(1, 1), cB + hstep + kstep, voffB);
    PG8_WAIT_V(6); PG8_BAR;
    }
    for (;;) {
        const bool has_next = P.next(ui + 1, nxt);
        const char* nB = cB;
        if (has_next) { int RA[2], CA[2]; stage_rc(tid * 16, RA[0], CA[0]); stage_rc(tid * 16 + 8192, RA[1], CA[1]); P.aoffs(nxt, RA, CA, on); nB = P.bbase(nxt); }
        else { on[0] = oc[0]; on[1] = oc[1]; on[2] = oc[2]; on[3] = oc[3]; }
#pragma clang loop unroll(disable)
        for (int t = 0; t < nt; t += 2) {
            const bool last = (t == nt - 2);
            const size_t kb1 = (size_t)(t + 1) * kstep;
            const size_t kb2 = last ? (size_t)0 : (size_t)(t + 2) * kstep, kb3 = kb2 + kstep;
            const char* b2 = last ? nB : cB + (size_t)(t + 2) * kstep; const char* b3 = b2 + kstep;
            const unsigned o20 = last ? on[0] : oc[0], o21 = last ? on[1] : oc[1], o22 = last ? on[2] : oc[2], o23 = last ? on[3] : oc[3];
            if constexpr (F8) {
            PG8_LDB(B0, 0, 0); PG8_SCHED; PG8_LDA(At, 0, 0); PG8_STAGE_A(PG8_SA(1, 1), kb1, oc[2], oc[3]);
            PG8_WAIT_V(6); PG8_WAIT_L(0); PG8_BAR; PG8_MMA(0, 0, At, B0); PG8_BAR; PG8_SCHED;
            PG8_LDA(At, 0, 1); PG8_STAGE(PG8_SB(0, 0), b2, voffB); PG8_STAGE_A(PG8_SA(0, 0), kb2, o20, o21);
            PG8_WAIT_V(6); PG8_WAIT_L(0); PG8_BAR; PG8_MMA(1, 0, At, B0); PG8_BAR; PG8_SCHED;
            PG8_LDB(B0, 1, 0); PG8_SCHED; PG8_LDA(At, 1, 0); PG8_STAGE_A(PG8_SA(0, 1), kb2, o22, o23);
            PG8_WAIT_V(6); PG8_WAIT_L(0); PG8_BAR; PG8_MMA(0, 0, At, B0); PG8_BAR; PG8_SCHED;
            PG8_LDA(At, 1, 1); PG8_STAGE(PG8_SB(1, 0), b3, voffB); PG8_STAGE_A(PG8_SA(1, 0), kb3, o20, o21);
            PG8_WAIT_V(6); PG8_WAIT_L(0); PG8_BAR; PG8_MMA(1, 0, At, B0); PG8_BAR; PG8_SCHED;
            } else {
            PG8_LDB(B0, 0, 0); PG8_LDB(B1, 0, 1); PG8_SCHED; PG8_LDA(At, 0, 0); PG8_STAGE_A(PG8_SA(1, 1), kb1, oc[2], oc[3]);
            PG8_WAIT_V(8); PG8_WAIT_L(0); PG8_BAR; PG8_MMA(0, 0, At, B0); PG8_MMA(0, 1, At, B1); PG8_BAR; PG8_SCHED;
            PG8_LDA(At, 0, 1); PG8_STAGE(PG8_SB(0, 0), b2, voffB); PG8_STAGE(PG8_SB(0, 1), b2 + hstep, voffB); PG8_STAGE_A(PG8_SA(0, 0), kb2, o20, o21);
            PG8_WAIT_V(8); PG8_WAIT_L(0); PG8_BAR; PG8_MMA(1, 0, At, B0); PG8_MMA(1, 1, At, B1); PG8_BAR; PG8_SCHED;
            PG8_LDB(B0, 1, 0); PG8_LDB(B1, 1, 1); PG8_SCHED; PG8_LDA(At, 1, 0); PG8_STAGE_A(PG8_SA(0, 1), kb2, o22, o23);
            PG8_WAIT_V(8); PG8_WAIT_L(0); PG8_BAR; PG8_MMA(0, 0, At, B0); PG8_MMA(0, 1, At, B1); PG8_BAR; PG8_SCHED;
            PG8_LDA(At, 1, 1); PG8_STAGE(PG8_SB(1, 0), b3, voffB); PG8_STAGE(PG8_SB(1, 1), b3 + hstep, voffB); PG8_STAGE_A(PG8_SA(1, 0), kb3, o20, o21);
            PG8_WAIT_V(8); PG8_WAIT_L(0); PG8_BAR; PG8_MMA(1, 0, At, B0); PG8_MMA(1, 1, At, B1); PG8_BAR; PG8_SCHED;
            }
        }
        if constexpr (ALIGN_EPI) { if (wr == 0) PG8_BAR; }
        E(acc, cur, wr, wc, fr, fq);
        if (!has_next) break;
#pragma unroll
        for (int a = 0; a < 2; ++a)
#pragma unroll
            for (int b = 0; b < 2; ++b)
#pragma unroll
                for (int m = 0; m < 4; ++m)
#pragma unroll
                    for (int n = 0; n < 2; ++n) acc[a][b][m][n] = (f32x4){0.f, 0.f, 0.f, 0.f};
        cur = nxt; cB = nB; oc[0] = on[0]; oc[1] = on[1]; oc[2] = on[2]; oc[3] = on[3]; ++ui;
        if constexpr (ALIGN_EPI) { if (wr == 1) PG8_BAR; }
    }
    PG8_WAIT_V(0);
    if constexpr (!ALIGN_EPI) { if (wr == 0) PG8_BAR; }
    PG8_BAR;
#undef PG8_SA
#undef PG8_SB
#undef PG8_STAGE
#undef PG8_STAGE_A
#undef PG8_LDA
#undef PG8_LDB
#undef PG8_MMA
#undef PG8_CAT
#undef PG8_WAIT_V
#undef PG8_WAIT_L
#undef PG8_BAR
#undef PG8_SCHED
}

struct DenseProb {
    int K, ldb; const char* Abase; const char* Bt; int lda; int nM, nN, nwg, G, c;
    __device__ __forceinline__ void init(const bf16* A, int lda_, const bf16* B, int M, int N, int K_, int G_, int c_) { Abase = (const char*)A; Bt = (const char*)B; lda = lda_; K = K_; ldb = K_; nM = M / BM; nN = N / BM; nwg = nM * nN; G = G_; c = c_; }
    __device__ __forceinline__ bool next(int i, Unit& u) const {
        const long L = (long)i * G + c; if (L >= nwg) return false;
        int wgid = (int)L; { const int q = nwg / NXCD, r = nwg % NXCD, xcd = wgid % NXCD, off = wgid / NXCD; wgid = (xcd < r ? xcd * (q + 1) : r * (q + 1) + (xcd - r) * q) + off; }
        const int nig = WGM * nN, gid = wgid / nig, fm = gid * WGM, gsz = (nM - fm) < WGM ? (nM - fm) : WGM;
        u.pm = fm + ((wgid % nig) % gsz); u.pn = (wgid % nig) / gsz; u.e = 0; return true;
    }
    __device__ __forceinline__ const char* bbase(const Unit& u) const { return Bt + (size_t)u.pn * BM * K * 2; }
    __device__ __forceinline__ void aoffs(const Unit& u, const int (&R)[2], const int (&C)[2], unsigned (&o)[4]) const {
#pragma unroll
        for (int h = 0; h < 2; ++h)
#pragma unroll
            for (int i = 0; i < 2; ++i) o[2 * h + i] = (unsigned)(((size_t)(u.pm * BM + h * HALF + R[i]) * lda + C[i]) * 2);
    }
};
__device__ __forceinline__ bool xcd_range_unit(int i, int nunits, int G, int c, int& L) {
    const int x = c % NXCD, cc = c / NXCD, per = G / NXCD, q = nunits / NXCD, r = nunits % NXCD;
    const int start = x * q + (x < r ? x : r), cnt = q + (x < r ? 1 : 0), li = i * per + cc;
    if (li >= cnt) return false; L = start + li; return true;
}
struct MoeUpProb {
    int K, ldb; int arow, brow;
    int pshift, btile;
    const char* Abase; const char* W13; const int* sorted; const LAS int* tile_e; int ntiles, nunits, G, c;
    __device__ __forceinline__ bool next(int i, Unit& u) const {
        int L; if (!xcd_range_unit(i, nunits, G, c, L)) return false;
        const int tile = L >> pshift; u.pn = L & ((1 << pshift) - 1);
        if (tile < ntiles) { u.pm = tile; u.e = __builtin_amdgcn_readfirstlane(tile_e[tile]); } else { u.pm = MAXTILES + (tile - ntiles); u.e = NEXP; }
        return true;
    }
    __device__ __forceinline__ const char* bbase(const Unit& u) const { return W13 + ((size_t)u.e * 1024 + (size_t)u.pn * btile) * brow; }
    __device__ __forceinline__ void aoffs(const Unit& u, const int (&R)[2], const int (&C)[2], unsigned (&o)[4]) const {
#pragma unroll
        for (int h = 0; h < 2; ++h)
#pragma unroll
            for (int i = 0; i < 2; ++i) { int row;
                if (u.e == NEXP) row = (u.pm - MAXTILES) * BM + h * HALF + R[i];
                else row = sorted[u.pm * BM + h * HALF + R[i]];
                o[2 * h + i] = (unsigned)((size_t)row * arow + C[i] * 2); }
    }
};
struct MoeDownProb {
    int K, ldb; int arow, brow, pshift, btile; const char* Abase; const char* W2; const LAS int* tile_e; int ntiles, nunits, G, c;
    __device__ __forceinline__ bool next(int i, Unit& u) const {
        int L; if (!xcd_range_unit(i, nunits, G, c, L)) return false;
        const int tile = L >> pshift; u.pn = L & ((1 << pshift) - 1);
        if (tile < ntiles) { u.pm = tile; u.e = __builtin_amdgcn_readfirstlane(tile_e[tile]); } else { u.pm = MAXTILES + (tile - ntiles); u.e = NEXP; }
        return true;
    }
    __device__ __forceinline__ const char* bbase(const Unit& u) const { return W2 + ((size_t)u.e * 2048 + (size_t)u.pn * btile) * brow; }
    __device__ __forceinline__ void aoffs(const Unit& u, const int (&R)[2], const int (&C)[2], unsigned (&o)[4]) const {
#pragma unroll
        for (int h = 0; h < 2; ++h)
#pragma unroll
            for (int i = 0; i < 2; ++i) o[2 * h + i] = (unsigned)((size_t)(u.pm * BM + h * HALF + R[i]) * arow + C[i] * 2);
    }
};
struct CmpProb {
    int K, ldb; const char* Abase; const char* Bt; int G, c;
    __device__ __forceinline__ bool next(int i, Unit& u) const { const int L = i * G + c; if (L >= 16) return false; u.pm = L; u.pn = 0; u.e = 0; return true; }
    __device__ __forceinline__ const char* bbase(const Unit&) const { return Bt; }
    __device__ __forceinline__ void aoffs(const Unit& u, const int (&R)[2], const int (&C)[2], unsigned (&o)[4]) const {
#pragma unroll
        for (int h = 0; h < 2; ++h)
#pragma unroll
            for (int i = 0; i < 2; ++i) { const int m = u.pm * BM + h * HALF + R[i], seq = m >> 7, n = m & 127;
                o[2 * h + i] = (unsigned)((((size_t)seq * NS + 16 * n) * 128 + C[i]) * 2); }
    }
};
struct RouterProb {
    int K, ldb; const char* Abase; const char* Bt; int G, c;
    __device__ __forceinline__ bool next(int i, Unit& u) const { const int L = i * G + c; if (L >= (NT / BM) * 4) return false; u.pm = L >> 2; u.pn = 0; u.e = L & 3; return true; }
    __device__ __forceinline__ const char* bbase(const Unit& u) const { return Bt + (size_t)u.e * 512 * 2; }
    __device__ __forceinline__ void aoffs(const Unit& u, const int (&R)[2], const int (&C)[2], unsigned (&o)[4]) const {
#pragma unroll
        for (int h = 0; h < 2; ++h)
#pragma unroll
            for (int i = 0; i < 2; ++i) o[2 * h + i] = (unsigned)(((size_t)(u.pm * BM + h * HALF + R[i]) * ND + u.e * 512 + C[i]) * 2);
    }
};
struct EpiF32N64 {
    static constexpr bool PERM = false;
    float* C;
    __device__ __forceinline__ void operator()(const f32x4 (&acc)[2][2][4][2], const Unit& u, int wr, int wc, int fr, int fq) const {
        if (wc >= 2) return;
        const int row0 = u.pm * BM + wr * 64 + fr, col0 = wc * 32 + 4 * fq;
#pragma unroll
        for (int ai = 0; ai < 2; ++ai)
#pragma unroll
            for (int m = 0; m < 4; ++m) { float* rowp = C + ((size_t)u.e * NT + row0 + ai * HALF + m * 16) * 64 + col0;
#pragma unroll
                for (int n = 0; n < 2; ++n) *(f32x4*)(rowp + n * 16) = acc[ai][0][m][n]; }
    }
};
struct EpiSwigluF8 {
    static constexpr bool PERM = true;
    unsigned char* H; float inmul;
    __device__ __forceinline__ void operator()(const f32x4 (&acc)[2][2][4][2], const Unit& u, int wr, int wc, int fr, int fq) const {
        const int row0 = u.pm * BM + wr * 64 + fr, col0 = u.pn * 64 + wc * 16 + 4 * fq;
#pragma unroll
        for (int ai = 0; ai < 2; ++ai)
#pragma unroll
            for (int m = 0; m < 4; ++m) { unsigned char* rowp = H + (size_t)(row0 + ai * HALF + m * 16) * EFF + col0;
                float o[4];
#pragma unroll
                for (int j = 0; j < 4; ++j) { const float h1 = acc[ai][0][m][0][j] * inmul, h3 = acc[ai][0][m][1][j] * inmul; o[j] = fminf(fmaxf(siluf_(h1) * h3 * 8.0f, -448.0f), 448.0f); }
                int w0 = __builtin_amdgcn_cvt_pk_fp8_f32(o[0], o[1], 0, false); w0 = __builtin_amdgcn_cvt_pk_fp8_f32(o[2], o[3], w0, true);
                *(unsigned*)rowp = (unsigned)w0; }
    }
};
struct EpiFp8N128 {
    static constexpr bool PERM = true;
    unsigned char* O; int ldc; float mul;
    __device__ __forceinline__ void operator()(const f32x4 (&acc)[2][2][4][2], const Unit& u, int wr, int wc, int fr, int fq) const {
        const int row0 = u.pm * BM + wr * 64 + fr, col0 = u.pn * HALF + wc * 32 + 8 * fq;
#pragma unroll
        for (int ai = 0; ai < 2; ++ai)
#pragma unroll
            for (int m = 0; m < 4; ++m) { unsigned char* rowp = O + (size_t)(row0 + ai * HALF + m * 16) * ldc + col0; float v[8];
#pragma unroll
                for (int n = 0; n < 2; ++n)
#pragma unroll
                    for (int j = 0; j < 4; ++j) v[n * 4 + j] = fminf(fmaxf(acc[ai][0][m][n][j] * mul, -448.0f), 448.0f);
                int w0 = __builtin_amdgcn_cvt_pk_fp8_f32(v[0], v[1], 0, false); w0 = __builtin_amdgcn_cvt_pk_fp8_f32(v[2], v[3], w0, true);
                int w1 = __builtin_amdgcn_cvt_pk_fp8_f32(v[4], v[5], 0, false); w1 = __builtin_amdgcn_cvt_pk_fp8_f32(v[6], v[7], w1, true);
                *(v2u*)rowp = (v2u){(unsigned)w0, (unsigned)w1}; }
    }
};
}

struct Args { const float* in[27]; float* out; unsigned char* ws; int ph_lo, ph_hi; };
typedef const __attribute__((address_space(4))) Args* CArgs;
__device__ __forceinline__ const float* kin(int i) { CArgs p = (CArgs)__builtin_amdgcn_kernarg_segment_ptr(); asm volatile("" : "+s"(p)); return p->in[i]; }
struct Frame {
    LAS unsigned char* lds;
    volatile LAS unsigned* MISC;
    unsigned* ctl;
    unsigned char* ws;
    int tid, lane, wave, vcu, G, gw, NGW;
    float* out;
};

__device__ __forceinline__ void tr_item(const float* W, int ldw, int k0, int n0, int nvalid, bf16* WT, int ldt, int drow0, LAS float* scr, int lane) {
    float v[32]; const int n = lane & 31; const bool okn = n < nvalid; const float* src = W + (size_t)(k0 + (lane >> 5)) * ldw + n0 + n;
#pragma unroll
    for (int i = 0; i < 32; ++i) v[i] = okn ? src[(size_t)(2 * i) * ldw] : 0.f;
#pragma unroll
    for (int i = 0; i < 32; ++i) scr[(2 * i + (lane >> 5)) * 33 + n] = v[i];
    LDS_WAIT(); asm volatile("" ::: "memory");
    const int c = lane & 7;
#pragma unroll
    for (int j = 0; j < 4; ++j) { const int nn = (lane >> 3) + 8 * j; const LAS float* sp = scr + (8 * c) * 33 + nn;
        v4u o; o.x = pk2(sp[0 * 33], sp[1 * 33]); o.y = pk2(sp[2 * 33], sp[3 * 33]); o.z = pk2(sp[4 * 33], sp[5 * 33]); o.w = pk2(sp[6 * 33], sp[7 * 33]);
        if (nn < nvalid) *(v4u*)(WT + (size_t)(drow0 + nn) * ldt + k0 + 8 * c) = o; }
    LDS_WAIT(); asm volatile("" ::: "memory");
}
__device__ __forceinline__ void tr_item_f8(const float* W, int ldw, int k0, int n0, unsigned char* WT8, int ldt, int drow0, int rowmode, float mul, LAS float* scr, int lane) {
    float v[32]; const int n = lane & 31; const float* src = W + (size_t)(k0 + (lane >> 5)) * ldw + n0 + n;
#pragma unroll
    for (int i = 0; i < 32; ++i) v[i] = src[(size_t)(2 * i) * ldw];
#pragma unroll
    for (int i = 0; i < 32; ++i) scr[(2 * i + (lane >> 5)) * 33 + n] = v[i];
    LDS_WAIT(); asm volatile("" ::: "memory");
    const int c = lane & 3;
#pragma unroll
    for (int j = 0; j < 2; ++j) { const int nn = (lane >> 2) + 16 * j; const LAS float* sp = scr + (16 * c) * 33 + nn; int w[4];
#pragma unroll
        for (int q = 0; q < 4; ++q) { const float a0 = fminf(fmaxf(sp[(4 * q + 0) * 33] * mul, -448.f), 448.f), a1 = fminf(fmaxf(sp[(4 * q + 1) * 33] * mul, -448.f), 448.f),
                                                  a2 = fminf(fmaxf(sp[(4 * q + 2) * 33] * mul, -448.f), 448.f), a3 = fminf(fmaxf(sp[(4 * q + 3) * 33] * mul, -448.f), 448.f);
            w[q] = __builtin_amdgcn_cvt_pk_fp8_f32(a0, a1, 0, false); w[q] = __builtin_amdgcn_cvt_pk_fp8_f32(a2, a3, w[q], true); }
        const int drow = rowmode ? drow0 + (nn >> 2) * 8 + (nn & 3) : drow0 + nn;
        *(v4u*)(WT8 + (size_t)drow * ldt + k0 + 16 * c) = (v4u){(unsigned)w[0], (unsigned)w[1], (unsigned)w[2], (unsigned)w[3]}; }
    LDS_WAIT(); asm volatile("" ::: "memory");
}
__device__ __forceinline__ bool tr_matrix(int& it, const float* W, int ldw, int K, int c0, int ncols, bf16* WT, int drow0, LAS float* scr, int lane) {
    const int nb = (ncols + 31) / 32, items = (K / 64) * nb;
    if (it >= items) { it -= items; return false; }
    const int kb = it / nb, b = it % nb, nv = ncols - 32 * b;
    tr_item(W, ldw, 64 * kb, c0 + 32 * b, nv < 32 ? nv : 32, WT, K, drow0 + 32 * b, scr, lane);
    return true;
}
__device__ __forceinline__ void zero_rows(Frame& F, bf16* base, size_t nelem) {
    for (size_t i = ((size_t)F.gw * 64 + F.lane) * 8; i < nelem; i += (size_t)F.NGW * 64 * 8) *(v4u*)(base + i) = (v4u){0u, 0u, 0u, 0u};
}

__device__ __forceinline__ void p_prologue(Frame& F) {
    LAS float* scr = (LAS float*)(F.lds + F.wave * 16384);
    unsigned char* ws = F.ws;
    {
        LAS float* wl = (LAS float*)F.lds;
        LAS float* pl = (LAS float*)(F.lds + 32768);
        const float* w_in = kin(2); const float* pool_w = kin(3); const float* pscale = kin(4);
        bf16* WT = (bf16*)(ws + WS_WABIN);
        for (int it = blockIdx.x; it < 4 * 32; it += F.G) {
            const int g = it >> 5, k0 = (it & 31) * 64;
            for (int i = F.tid; i < 64 * 128; i += 512) wl[i] = w_in[(size_t)(k0 + (i >> 7)) * AB_IN + g * 128 + (i & 127)];
            for (int i = F.tid; i < 128 * 128; i += 512) pl[i] = pool_w[(size_t)g * 16384 + i];
            __syncthreads();
            const int d = F.tid & 127, kg = F.tid >> 7; const float sc = pscale[g * 128 + d];
            for (int kk = 0; kk < 16; kk += 8) {
                float a[8];
#pragma unroll
                for (int j = 0; j < 8; ++j) a[j] = 0.f;
                for (int c = 0; c < 128; ++c) { const float pw = pl[c * 128 + d];
#pragma unroll
                    for (int j = 0; j < 8; ++j) a[j] += wl[(kg * 16 + kk + j) * 128 + c] * pw; }
                v4u o; o.x = pk2(a[0] * sc, a[1] * sc); o.y = pk2(a[2] * sc, a[3] * sc); o.z = pk2(a[4] * sc, a[5] * sc); o.w = pk2(a[6] * sc, a[7] * sc);
                *(v4u*)(WT + (size_t)(g * 128 + d) * ND + k0 + kg * 16 + kk) = o;
            }
            __syncthreads();
        }
    }
    __syncthreads();
    for (int it0 = F.gw; ; it0 += F.NGW) {
        int it = it0;
        if (tr_matrix(it, kin(2), AB_IN, ND, 512, AB_IN - 512, (bf16*)(ws + WS_WABIN), 512, scr, F.lane)) continue;
        if (tr_matrix(it, kin(5), ND, ND, 0, ND, (bf16*)(ws + WS_WABOUT), 0, scr, F.lane)) continue;
        if (tr_matrix(it, kin(6), CD_IN, ND, 0, CD_IN, (bf16*)(ws + WS_WCDIN), 0, scr, F.lane)) continue;
        if (tr_matrix(it, kin(14), ND, ND, 0, ND, (bf16*)(ws + WS_WCDOUT), 0, scr, F.lane)) continue;
        if (tr_matrix(it, kin(11), 1536, 384, 0, 1536, (bf16*)(ws + WS_WUQ), 0, scr, F.lane)) continue;
        if (tr_matrix(it, kin(13), 2048, 512, 0, 2048, (bf16*)(ws + WS_WUKV), 0, scr, F.lane)) continue;
        if (tr_matrix(it, kin(8), 128, 4096, 0, 128, (bf16*)(ws + WS_CW1), 0, scr, F.lane)) continue;
        if (tr_matrix(it, kin(8) + (size_t)4096 * 128, 128, 4096, 0, 128, (bf16*)(ws + WS_CW1), 128, scr, F.lane)) continue;
        break;
    }
    zero_rows(F, (bf16*)(ws + WS_WCDIN) + (size_t)CD_IN * ND, (size_t)(CD_INP - CD_IN) * ND);
    { const float* x = kin(0); bf16* xb = (bf16*)(ws + WS_XB0); const size_t stride = (size_t)F.NGW * 64 * 8;
      for (size_t i = ((size_t)F.gw * 64 + F.lane) * 8; i < (size_t)NT * ND; i += 4 * stride) {
          f32x4 a[4], c[4];
#pragma unroll
          for (int u = 0; u < 4; ++u) if (i + u * stride < (size_t)NT * ND) { a[u] = *(const f32x4*)(x + i + u * stride); c[u] = *(const f32x4*)(x + i + u * stride + 4); }
#pragma unroll
          for (int u = 0; u < 4; ++u) if (i + u * stride < (size_t)NT * ND) { v4u o; o.x = pk2(a[u][0], a[u][1]); o.y = pk2(a[u][2], a[u][3]); o.z = pk2(c[u][0], c[u][1]); o.w = pk2(c[u][2], c[u][3]); *(v4u*)(xb + i + u * stride) = o; } } }
    for (int o = F.gw; o < 128; o += F.NGW) { const int kv = o >> 6, fc = o & 63; const float* pos = kin(7) + (size_t)kv * 4096 + fc * 64; const float* w1 = kin(8) + ((size_t)kv * 4096 + fc * 64) * 128;
        float s0 = 0.f, s1 = 0.f;
#pragma unroll 8
        for (int f = 0; f < 64; ++f) { const float pf_ = pos[f]; const f32x2 wv = *(const f32x2*)(w1 + (size_t)f * 128 + F.lane * 2); s0 += pf_ * wv[0]; s1 += pf_ * wv[1]; }
        *(f32x2*)((float*)(ws + WS_CMPB) + 256 + (size_t)o * 128 + F.lane * 2) = (f32x2){s0, s1}; }
}
__device__ __forceinline__ void cmp_bias_finish(Frame& F) {
    if (blockIdx.x == 0 && F.tid < 256) { const int kv = F.tid >> 7, h = F.tid & 127; const float* part = (const float*)(F.ws + WS_CMPB) + 256 + (size_t)kv * 64 * 128 + h;
        float sacc = 0.f; for (int fc = 0; fc < 64; ++fc) sacc += part[fc * 128];
        ((float*)(F.ws + WS_CMPB))[F.tid] = sacc; }
}
constexpr int MW_ITEMS_L = 65 * 1536 + 64;
__device__ __forceinline__ void moe_weight_item(int l, int it, unsigned char* ws, LAS float* scr, int lane) {
    bf16* W13 = (bf16*)(ws + WS_W13 + (size_t)l * WS_MOE_LSTRIDE); bf16* W2 = (bf16*)(ws + WS_W2 + (size_t)l * WS_MOE_LSTRIDE); bf16* RT = (bf16*)(ws + WS_RT + (size_t)l * MiB);
    if (it >= 65 * 1536) { const int r = it - 65 * 1536, kb = r >> 1, b = r & 1;
        tr_item(kin(19) + (size_t)l * ND * NEXP, NEXP, 64 * kb, 32 * b, 32, RT, ND, 32 * b, scr, lane); return; }
    const int e = it / 1536, r = it % 1536;
    const float *w1, *w3, *w2;
    if (e < NEXP) { const size_t o = ((size_t)l * NEXP + e) * ND * EFF; w1 = kin(21) + o; w3 = kin(22) + o; w2 = kin(23) + o; }
    else { const size_t o = (size_t)l * ND * EFF; w1 = kin(24) + o; w3 = kin(25) + o; w2 = kin(26) + o; }
    if (r < 1024) { const int which = r >> 9, rr = r & 511, kb = rr >> 4, nb = rr & 15;
        const int j = nb >> 2, drow = j * 256 + which * 128 + (nb & 3) * 32;
        if (MK_FP8_MOE) tr_item_f8(which ? w3 : w1, EFF, 64 * kb, 32 * nb, (unsigned char*)W13 + (size_t)e * 1024 * ND, ND, (nb >> 1) * 128 + (nb & 1) * 64 + which * 4, 1, 64.0f, scr, lane);
        else tr_item(which ? w3 : w1, EFF, 64 * kb, 32 * nb, 32, W13 + (size_t)e * 1024 * ND, ND, drow, scr, lane); }
    else { const int rr = r - 1024, kb = rr >> 6, nb = rr & 63;
        if (MK_FP8_MOE) tr_item_f8(w2, ND, 64 * kb, 32 * nb, (unsigned char*)W2 + (size_t)e * ND * EFF, EFF, 32 * nb, 0, 64.0f, scr, lane);
        else tr_item(w2, ND, 64 * kb, 32 * nb, 32, W2 + (size_t)e * ND * EFF, EFF, 32 * nb, scr, lane); }
}
struct ConvDesc { const float* src; unsigned char* dst; int ldw, ldt, k0, drow0, rowmode, kind; };
__device__ __forceinline__ ConvDesc conv_desc(int id, unsigned char* ws) {
    ConvDesc d; d.kind = -1; d.src = nullptr; d.dst = nullptr; d.ldw = 0; d.ldt = 0; d.k0 = 0; d.drow0 = 0; d.rowmode = 0;
    if (id >= 2 * MW_ITEMS_L) return d;
    const int l = id >= MW_ITEMS_L ? 1 : 0, it = id - l * MW_ITEMS_L;
    if (it >= 65 * 1536 || !MK_FP8_MOE) { d.kind = 1; d.k0 = it; d.drow0 = l; return d; }
    const int e = it / 1536, r = it % 1536;
    const float *w1, *w3, *w2;
    if (e < NEXP) { const size_t o = ((size_t)l * NEXP + e) * ND * EFF; w1 = kin(21) + o; w3 = kin(22) + o; w2 = kin(23) + o; }
    else { const size_t o = (size_t)l * ND * EFF; w1 = kin(24) + o; w3 = kin(25) + o; w2 = kin(26) + o; }
    d.kind = 0;
    if (r < 1024) { const int which = r >> 9, rr = r & 511, kb = rr >> 4, nb = rr & 15;
        d.src = (which ? w3 : w1) + (size_t)(64 * kb) * EFF + 32 * nb; d.ldw = EFF; d.k0 = 64 * kb;
        d.dst = ws + WS_W13 + (size_t)l * WS_MOE_LSTRIDE + (size_t)e * 1024 * ND; d.ldt = ND; d.drow0 = (nb >> 1) * 128 + (nb & 1) * 64 + which * 4; d.rowmode = 1; }
    else { const int rr = r - 1024, kb = rr >> 6, nb = rr & 63;
        d.src = w2 + (size_t)(64 * kb) * ND + 32 * nb; d.ldw = ND; d.k0 = 64 * kb;
        d.dst = ws + WS_W2 + (size_t)l * WS_MOE_LSTRIDE + (size_t)e * ND * EFF; d.ldt = EFF; d.drow0 = 32 * nb; d.rowmode = 0; }
    return d;
}
__device__ __forceinline__ void conv_load(const ConvDesc& d, float (&v)[32], int lane) {
    if (d.kind != 0) return;
    const float* src = d.src + (size_t)(lane >> 5) * d.ldw + (lane & 31);
#pragma unroll
    for (int i = 0; i < 32; ++i) v[i] = src[(size_t)(2 * i) * d.ldw];
}
__device__ __forceinline__ void conv_finish(const ConvDesc& d, const float (&v)[32], unsigned char* ws, LAS float* scr, int lane) {
    if (d.kind == 1) { moe_weight_item(d.drow0, d.k0, ws, scr, lane); return; }
    if (d.kind != 0) return;
    const int n = lane & 31;
#pragma unroll
    for (int i = 0; i < 32; ++i) scr[(2 * i + (lane >> 5)) * 33 + n] = v[i];
    LDS_WAIT(); asm volatile("" ::: "memory");
    const int c = lane & 3;
#pragma unroll
    for (int j = 0; j < 2; ++j) { const int nn = (lane >> 2) + 16 * j; const LAS float* sp = scr + (16 * c) * 33 + nn; int w[4];
#pragma unroll
        for (int q = 0; q < 4; ++q) { const float a0 = fminf(fmaxf(sp[(4 * q + 0) * 33] * 64.0f, -448.f), 448.f), a1 = fminf(fmaxf(sp[(4 * q + 1) * 33] * 64.0f, -448.f), 448.f),
                                                  a2 = fminf(fmaxf(sp[(4 * q + 2) * 33] * 64.0f, -448.f), 448.f), a3 = fminf(fmaxf(sp[(4 * q + 3) * 33] * 64.0f, -448.f), 448.f);
            w[q] = __builtin_amdgcn_cvt_pk_fp8_f32(a0, a1, 0, false); w[q] = __builtin_amdgcn_cvt_pk_fp8_f32(a2, a3, w[q], true); }
        const int drow = d.rowmode ? d.drow0 + (nn >> 2) * 8 + (nn & 3) : d.drow0 + nn;
        *(v4u*)(d.dst + (size_t)drow * d.ldt + d.k0 + 16 * c) = (v4u){(unsigned)w[0], (unsigned)w[1], (unsigned)w[2], (unsigned)w[3]}; }
    LDS_WAIT(); asm volatile("" ::: "memory");
}
__device__ __forceinline__ void p_moe_weights_queue(Frame& F, unsigned* queue) {
    LAS float* scr = (LAS float*)(F.lds + F.wave * 16384);
    constexpr int BATCH = 16, NB_ = (2 * MW_ITEMS_L + BATCH - 1) / BATCH;
    for (;;) {
        unsigned bq = 0; if (F.lane == 0) bq = atomicAdd(queue, 1u);
        const int bi = __builtin_amdgcn_readfirstlane((int)bq);
        if (bi >= NB_) break;
        const int s0 = bi * BATCH;
        float va[32], vb[32];
        ConvDesc dA = conv_desc(s0, F.ws); conv_load(dA, va, F.lane);
        for (int k = 0; k < BATCH; k += 2) {
            ConvDesc dB = conv_desc(s0 + k + 1, F.ws); conv_load(dB, vb, F.lane);
            conv_finish(dA, va, F.ws, scr, F.lane);
            dA = conv_desc(k + 2 < BATCH ? s0 + k + 2 : 2 * MW_ITEMS_L, F.ws); conv_load(dA, va, F.lane);
            conv_finish(dB, vb, F.ws, scr, F.lane);
        }
    }
    for (int l = 0; l < 2; ++l) zero_rows(F, (bf16*)(F.ws + WS_RT + (size_t)l * MiB) + (size_t)NEXP * ND, (size_t)(256 - NEXP) * ND);
}

__device__ __forceinline__ void ln_finish(float (&v)[4][8], const float* g, const float* b, int lane, bf16* ob, float* of, unsigned char* o8 = nullptr) {
    float s = 0.f;
#pragma unroll
    for (int j = 0; j < 4; ++j)
#pragma unroll
        for (int i = 0; i < 8; ++i) s += v[j][i];
    const float mean = wave_sum(s) * (1.f / ND); float s2 = 0.f;
#pragma unroll
    for (int j = 0; j < 4; ++j)
#pragma unroll
        for (int i = 0; i < 8; ++i) { v[j][i] -= mean; s2 += v[j][i] * v[j][i]; }
    const float rstd = 1.f / sqrtf(wave_sum(s2) * (1.f / ND) + LN_EPS);
#pragma unroll
    for (int j = 0; j < 4; ++j) { unsigned c0 = (unsigned)(j * 64 + lane) * 8u; asm volatile("" : "+v"(c0));
        const f32x4 g0 = *(const f32x4*)((const char*)g + c0 * 4u), g1 = *(const f32x4*)((const char*)g + c0 * 4u + 16u), b0 = *(const f32x4*)((const char*)b + c0 * 4u), b1 = *(const f32x4*)((const char*)b + c0 * 4u + 16u);
        float o[8];
#pragma unroll
        for (int i = 0; i < 4; ++i) { o[i] = v[j][i] * rstd * g0[i] + b0[i]; o[4 + i] = v[j][4 + i] * rstd * g1[i] + b1[i]; }
        if (ob) { v4u w; w.x = pk2(o[0], o[1]); w.y = pk2(o[2], o[3]); w.z = pk2(o[4], o[5]); w.w = pk2(o[6], o[7]); *(v4u*)((char*)ob + c0 * 2u) = w; }
        if (of) { *(f32x4*)((char*)of + c0 * 4u) = (f32x4){o[0], o[1], o[2], o[3]}; *(f32x4*)((char*)of + c0 * 4u + 16u) = (f32x4){o[4], o[5], o[6], o[7]}; }
        if (o8) { int w0 = __builtin_amdgcn_cvt_pk_fp8_f32(o[0], o[1], 0, false); w0 = __builtin_amdgcn_cvt_pk_fp8_f32(o[2], o[3], w0, true);
            int w1 = __builtin_amdgcn_cvt_pk_fp8_f32(o[4], o[5], 0, false); w1 = __builtin_amdgcn_cvt_pk_fp8_f32(o[6], o[7], w1, true);
            *(v2u*)(o8 + c0) = (v2u){(unsigned)w0, (unsigned)w1}; } }
}
__device__ __forceinline__ void p_ln1(Frame& F, const bf16* xin, const bf16* mixo, const float* g, const float* b, bf16* xo, unsigned char* xo8) {
    for (int m = F.gw; m < NT; m += F.NGW) {
        float v[4][8];
#pragma unroll
        for (int j = 0; j < 4; ++j) { const size_t o = (size_t)m * ND + (j * 64 + F.lane) * 8; float a[8], c[8]; unpack8(*(const v4u*)(xin + o), a); unpack8(*(const v4u*)(mixo + o), c);
#pragma unroll
            for (int i = 0; i < 8; ++i) v[j][i] = DN_ALPHA * a[i] + c[i]; }
        ln_finish(v, g, b, F.lane, xo + (size_t)m * ND, nullptr, xo8 ? xo8 + (size_t)m * ND : nullptr);
    }
}
__device__ __forceinline__ void unpack8_fp8(const v2u w, float (&f)[8]) {
    const f32x2 a = __builtin_amdgcn_cvt_pk_f32_fp8((int)w.x, false), b = __builtin_amdgcn_cvt_pk_f32_fp8((int)w.x, true), c = __builtin_amdgcn_cvt_pk_f32_fp8((int)w.y, false), d = __builtin_amdgcn_cvt_pk_f32_fp8((int)w.y, true);
    f[0] = a[0]; f[1] = a[1]; f[2] = b[0]; f[3] = b[1]; f[4] = c[0]; f[5] = c[1]; f[6] = d[0]; f[7] = d[1];
}
__device__ __forceinline__ void p_combine_ln2(Frame& F, const bf16* x1, const unsigned char* y2, const int* slot, const float* wsel, const float* g, const float* b, bf16* xo, float* fo) {
    for (int m = F.gw; m < NT; m += F.NGW) {
        const int myrow = slot[m * 8 + (F.lane & 7)]; const float myw = wsel[m * 8 + (F.lane & 7)] * (1.0f / 16.0f);
        float v[4][8];
        { v4u xa[4]; v2u sa[4];
#pragma unroll
          for (int j = 0; j < 4; ++j) { xa[j] = *(const v4u*)(x1 + (size_t)m * ND + (j * 64 + F.lane) * 8); sa[j] = *(const v2u*)(y2 + (size_t)(SH_ROW0 + m) * ND + (j * 64 + F.lane) * 8); }
#pragma unroll
          for (int j = 0; j < 4; ++j) { float a[8], c[8]; unpack8(xa[j], a); unpack8_fp8(sa[j], c);
#pragma unroll
              for (int i = 0; i < 8; ++i) v[j][i] = DN_ALPHA * a[i] + c[i] * (1.0f / 16.0f); } }
#pragma unroll
        for (int kg = 0; kg < 2; ++kg) { v2u ra[4][4]; float wk[4];
#pragma unroll
            for (int k = 0; k < 4; ++k) { const int row = __builtin_amdgcn_readlane(myrow, kg * 4 + k); wk[k] = __builtin_bit_cast(float, __builtin_amdgcn_readlane(__builtin_bit_cast(int, myw), kg * 4 + k));
#pragma unroll
                for (int j = 0; j < 4; ++j) ra[k][j] = *(const v2u*)(y2 + (size_t)row * ND + (j * 64 + F.lane) * 8); }
#pragma unroll
            for (int k = 0; k < 4; ++k)
#pragma unroll
                for (int j = 0; j < 4; ++j) { float c[8]; unpack8_fp8(ra[k][j], c);
#pragma unroll
                    for (int i = 0; i < 8; ++i) v[j][i] += wk[k] * c[i]; } }
        ln_finish(v, g, b, F.lane, xo ? xo + (size_t)m * ND : nullptr, fo ? fo + (size_t)m * ND : nullptr);
    }
}

__device__ __forceinline__ void p_pool(Frame& F, int wid, int nw) {
    const bf16* proj = (const bf16*)(F.ws + WS_PROJ); bf16* mixin = (bf16*)(F.ws + WS_MIXIN);
    for (int m = wid; m < NT; m += nw) {
        const int s = m & (NS - 1);
        const int g = F.lane >> 4, w = 2 << g; const int lo = (s + 1 - w) > 0 ? (s + 1 - w) : 0; const float cnt = (float)((s + 1) < w ? (s + 1) : w);
        float acc[8], cur[8];
#pragma unroll
        for (int i = 0; i < 8; ++i) acc[i] = 0.f;
        for (int j = lo; j <= s; ++j) { float t[8]; unpack8(*(const v4u*)(proj + (size_t)(m - s + j) * AB_IN + F.lane * 8), t);
#pragma unroll
            for (int i = 0; i < 8; ++i) acc[i] += t[i]; }
        unpack8(*(const v4u*)(proj + (size_t)m * AB_IN + F.lane * 8), cur);
        float o[8];
#pragma unroll
        for (int i = 0; i < 8; ++i) o[i] = acc[i] / cnt - cur[i];
        v4u wv; wv.x = pk2(o[0], o[1]); wv.y = pk2(o[2], o[3]); wv.z = pk2(o[4], o[5]); wv.w = pk2(o[6], o[7]); *(v4u*)(mixin + (size_t)m * ND + F.lane * 8) = wv;
    }
}
namespace ret {
typedef short v4i16_t __attribute__((ext_vector_type(4)));
constexpr int PITCH = 272, TILE = 128 * PITCH;
__device__ __forceinline__ bf16x8 trfrag(LAS unsigned char* trb, int r0, int r1, int c0) {
    const v4i16_t a = __builtin_amdgcn_ds_read_tr16_b64_v4i16((LAS v4i16_t*)(trb + r0 * PITCH + c0 * 2));
    const v4i16_t b = __builtin_amdgcn_ds_read_tr16_b64_v4i16((LAS v4i16_t*)(trb + r1 * PITCH + c0 * 2));
    return (bf16x8){a[0], a[1], a[2], a[3], b[0], b[1], b[2], b[3]};
}
}
__device__ __forceinline__ void p_retention_mfma(Frame& F, int bh) {
    const bf16* proj = (const bf16*)(F.ws + WS_PROJ); bf16* mixin = (bf16*)(F.ws + WS_MIXIN); const int* posv = (const int*)kin(1);
    constexpr int P = ret::PITCH;
    LAS unsigned char* KT = F.lds; LAS unsigned char* VT = F.lds + ret::TILE; LAS unsigned char* ST = F.lds + 2 * ret::TILE;
    const int b = bh / 6, h = bh % 6, w = F.wave, lane = F.lane, i16 = lane & 15, g = lane >> 4, q4 = (lane & 15) >> 2, p4 = lane & 3;
    const float lg = log2f(1.0f - exp2f(-5.0f - (float)h)), gc = exp2f(128.f * lg);
    const int rowb = i16 * P + 16 * g;
    const int trl = q4 * P + 8 * p4;
    LAS unsigned char* const trV4 = VT + trl + 4 * g * P;
    LAS unsigned char* const trV8 = VT + trl + 8 * g * P;
    LAS unsigned char* const trK8 = KT + trl + 8 * g * P;
    f32x4 T[2][8];
#pragma unroll
    for (int a = 0; a < 2; ++a)
#pragma unroll
        for (int d = 0; d < 8; ++d) T[a][d] = (f32x4){0.f, 0.f, 0.f, 0.f};
    const int srow = F.tid >> 2, scb = (F.tid & 3) * 4;
    for (int n = 0; n < NS / 128; ++n) {
        const size_t m0 = (size_t)b * NS + n * 128;
        {
          const float fk = exp2f(-(float)srow * lg) * 0.08838834764831845f, pz = (float)posv[m0 + srow]; const int t4 = F.tid & 3;
          const bf16* krow = proj + (m0 + srow) * AB_IN + 1280 + h * 128;
#pragma unroll
          for (int c = 0; c < 2; ++c) { const int c8 = 2 * t4 + c; float x1[8], x2[8];
              unpack8(*(const v4u*)(krow + c8 * 8), x1); unpack8(*(const v4u*)(krow + 64 + c8 * 8), x2);
#pragma unroll
              for (int j = 0; j < 8; ++j) { const float invf = exp2f(-(float)(c8 * 8 + j) * (13.287712379549449f / 64.f)); float sn, cs; fast_sincos(pz * invf, sn, cs);
                  const float a = (x1[j] * cs - x2[j] * sn) * fk, bq = (x1[j] * sn + x2[j] * cs) * fk; x1[j] = a; x2[j] = bq; }
              v4u o; o.x = pk2(x1[0], x1[1]); o.y = pk2(x1[2], x1[3]); o.z = pk2(x1[4], x1[5]); o.w = pk2(x1[6], x1[7]); *(LAS v4u*)(KT + srow * P + c8 * 16) = o;
              o.x = pk2(x2[0], x2[1]); o.y = pk2(x2[2], x2[3]); o.z = pk2(x2[4], x2[5]); o.w = pk2(x2[6], x2[7]); *(LAS v4u*)(KT + srow * P + (c8 + 8) * 16) = o; } }
        bf16x8 qf[4], pf[4]; float rs[4] = {0.f, 0.f, 0.f, 0.f}, rq[4] = {0.f, 0.f, 0.f, 0.f};
        {
          const float fq = exp2f((float)(16 * w + i16) * lg), pz = (float)posv[m0 + 16 * w + i16];
          const bf16* qrow = proj + (m0 + 16 * w + i16) * AB_IN + 512 + h * 128;
#pragma unroll
          for (int ks = 0; ks < 2; ++ks) { float x1[8], x2[8]; unpack8(*(const v4u*)(qrow + 32 * ks + 8 * g), x1); unpack8(*(const v4u*)(qrow + 64 + 32 * ks + 8 * g), x2);
#pragma unroll
              for (int j = 0; j < 8; ++j) { const float invf = exp2f(-(float)(32 * ks + 8 * g + j) * (13.287712379549449f / 64.f)); float sn, cs; fast_sincos(pz * invf, sn, cs);
                  const float a = (x1[j] * cs - x2[j] * sn) * fq, bq = (x1[j] * sn + x2[j] * cs) * fq; x1[j] = a; x2[j] = bq; }
              v4u o; o.x = pk2(x1[0], x1[1]); o.y = pk2(x1[2], x1[3]); o.z = pk2(x1[4], x1[5]); o.w = pk2(x1[6], x1[7]); qf[ks] = __builtin_bit_cast(bf16x8, o);
              o.x = pk2(x2[0], x2[1]); o.y = pk2(x2[2], x2[3]); o.z = pk2(x2[4], x2[5]); o.w = pk2(x2[6], x2[7]); qf[ks + 2] = __builtin_bit_cast(bf16x8, o); } }
#pragma unroll
        for (int hv = 0; hv < 2; ++hv) {
            if (hv == 1) __syncthreads();
#pragma unroll
            for (int c = 0; c < 4; ++c) { const int c8 = scb + c; *(LAS v4u*)(VT + srow * P + c8 * 16) = *(const v4u*)(proj + (m0 + srow) * AB_IN + 2048 + h * 256 + hv * 128 + c8 * 8); }
            { LAS unsigned char* stw = ST + (16 * w + 4 * g) * P + i16 * 2;
#pragma unroll
              for (int dt = 0; dt < 8; ++dt)
#pragma unroll
                for (int r = 0; r < 4; ++r) { T[hv][dt][r] *= gc; *(LAS bf16*)(stw + r * P + dt * 32) = (bf16)f2bf(T[hv][dt][r]); } }
            __syncthreads();
            if (hv == 0) {
                f32x4 sc[8];
#pragma unroll
                for (int mt = 0; mt < 8; ++mt) { sc[mt] = (f32x4){0.f, 0.f, 0.f, 0.f};
                    if (mt <= w) {
#pragma unroll
                        for (int ks = 0; ks < 4; ++ks) { const bf16x8 kf = *(const LAS bf16x8*)(KT + rowb + mt * 16 * P + ks * 64); sc[mt] = __builtin_amdgcn_mfma_f32_16x16x32_bf16(kf, qf[ks], sc[mt], 0, 0, 0); }
                        if (mt == w) {
#pragma unroll
                            for (int r = 0; r < 4; ++r) sc[mt][r] = (4 * g + r <= i16) ? sc[mt][r] : 0.f; } } }
#pragma unroll
                for (int k2 = 0; k2 < 4; ++k2) { v4u wv; wv.x = pk2(sc[2 * k2][0], sc[2 * k2][1]); wv.y = pk2(sc[2 * k2][2], sc[2 * k2][3]); wv.z = pk2(sc[2 * k2 + 1][0], sc[2 * k2 + 1][1]); wv.w = pk2(sc[2 * k2 + 1][2], sc[2 * k2 + 1][3]);
                    pf[k2] = __builtin_bit_cast(bf16x8, wv); }
            }
#pragma unroll
            for (int nt = 0; nt < 8; ++nt) { f32x4 acc = (f32x4){0.f, 0.f, 0.f, 0.f};
#pragma unroll
                for (int k2 = 0; k2 < 4; ++k2) if (2 * k2 <= w) { const bf16x8 vf = ret::trfrag(trV4, 32 * k2, 32 * k2 + 16, 16 * nt); acc = __builtin_amdgcn_mfma_f32_16x16x32_bf16(pf[k2], vf, acc, 0, 0, 0); }
#pragma unroll
                for (int ks = 0; ks < 4; ++ks) { const bf16x8 sf = *(const LAS bf16x8*)(ST + rowb + nt * 16 * P + ks * 64); acc = __builtin_amdgcn_mfma_f32_16x16x32_bf16(qf[ks], sf, acc, 0, 0, 0); }
#pragma unroll
                for (int r = 0; r < 4; ++r) { rs[r] += acc[r]; rq[r] += acc[r] * acc[r]; mixin[(m0 + 16 * w + 4 * g + r) * ND + 512 + h * 256 + hv * 128 + 16 * nt + i16] = (bf16)f2bf(acc[r]); } }
#pragma unroll
            for (int ks = 0; ks < 4; ++ks) { const bf16x8 af = ret::trfrag(trV8, 32 * ks, 32 * ks + 4, 16 * w);
#pragma unroll
                for (int dt = 0; dt < 8; ++dt) { const bf16x8 bfr = ret::trfrag(trK8, 32 * ks, 32 * ks + 4, 16 * dt); T[hv][dt] = __builtin_amdgcn_mfma_f32_16x16x32_bf16(af, bfr, T[hv][dt], 0, 0, 0); } }
        }
#pragma unroll
        for (int r = 0; r < 4; ++r) { float sm = rs[r], s2 = rq[r];
            sm += __shfl_xor(sm, 1); sm += __shfl_xor(sm, 2); sm += __shfl_xor(sm, 4); sm += __shfl_xor(sm, 8);
            s2 += __shfl_xor(s2, 1); s2 += __shfl_xor(s2, 2); s2 += __shfl_xor(s2, 4); s2 += __shfl_xor(s2, 8);
            const float mean = sm * (1.f / 256.f); const float var = fmaxf(s2 * (1.f / 256.f) - mean * mean, 0.f);
            const float rstd = 1.f / sqrtf(var + NORM_EPS);
            const size_t m = m0 + 16 * w + 4 * g + r;
#pragma unroll
            for (int t = 0; t < 16; ++t) { bf16* yp = mixin + m * ND + 512 + h * 256 + 16 * t + i16; const float gt = bf1(proj[m * AB_IN + 3584 + h * 256 + 16 * t + i16]);
                *yp = (bf16)f2bf((bf1(*yp) - mean) * rstd * siluf_(gt)); } }
        __syncthreads();
    }
}

__device__ __forceinline__ void p_route(Frame& F, int l) {
    const float* logits = (const float*)(F.ws + WS_LOGITS); const float* rbias = kin(20) + l * NEXP;
    int* tope = (int*)(F.ws + WS_TOPE); float* wsel = (float*)(F.ws + WS_WSEL); int* posb = (int*)(F.ws + WS_SLOT); unsigned* cnt = F.ctl + CW_CNT + l * 64;
    LAS unsigned* lcnt = (LAS unsigned*)F.lds; LAS unsigned* lbase = lcnt + 64; LAS int* le = (LAS int*)(lcnt + 128); LAS unsigned* lp = (LAS unsigned*)(lcnt + 128 + 512);
    const float bias = rbias[F.lane]; const int lane = F.lane;
    for (int chunk = blockIdx.x; chunk < NT / 64; chunk += F.G) {
        __syncthreads();
        if (F.tid < 64) lcnt[F.tid] = 0u;
        __syncthreads();
        for (int t = 0; t < 8; ++t) {
            const int tl = F.wave * 8 + t, m = chunk * 64 + tl;
            const float lg = (logits[(size_t)m * 64 + lane] + logits[((size_t)NT + m) * 64 + lane]) + (logits[((size_t)2 * NT + m) * 64 + lane] + logits[((size_t)3 * NT + m) * 64 + lane]);
            const float sc = sigmoidf_(lg), bi = sc + bias;
            const int grp = lane >> 3;
            int rk = 0;
#pragma unroll
            for (int j = 1; j < 8; ++j) { const int o = lane ^ j; const float ov = __shfl_xor(bi, j); rk += ((ov > bi) || (ov == bi && o < lane)) ? 1 : 0; }
            float gs = rk < 2 ? bi : 0.f; gs += __shfl_xor(gs, 1); gs += __shfl_xor(gs, 2); gs += __shfl_xor(gs, 4);
            int grk = 0;
#pragma unroll
            for (int gg = 0; gg < 8; ++gg) { const float ov = __builtin_bit_cast(float, __builtin_amdgcn_readlane(__builtin_bit_cast(int, gs), gg * 8)); grk += (gg != grp && ((ov > gs) || (ov == gs && gg < grp))) ? 1 : 0; }
            const float mv = grk < 4 ? bi : -1e30f;
            int erk = 0;
#pragma unroll 16
            for (int j = 0; j < 64; ++j) { const float ov = __builtin_bit_cast(float, __builtin_amdgcn_readlane(__builtin_bit_cast(int, mv), j)); erk += ((ov > mv) || (ov == mv && j < lane)) ? 1 : 0; }
            const bool sel = erk < 8;
            const float wsum = wave_sum(sel ? sc : 0.f);
            if (sel) { const unsigned q = __hip_atomic_fetch_add(lcnt + lane, 1u, __ATOMIC_RELAXED, __HIP_MEMORY_SCOPE_WORKGROUP);
                tope[m * 8 + erk] = lane; wsel[m * 8 + erk] = sc / wsum * 2.5f; le[tl * 8 + erk] = lane; lp[tl * 8 + erk] = q; }
        }
        __syncthreads();
        if (F.tid < 64) lbase[F.tid] = atomicAdd(&cnt[F.tid], lcnt[F.tid]);
        __syncthreads();
        posb[chunk * 512 + F.tid] = (int)(lbase[le[F.tid]] + lp[F.tid]);
    }
}
__device__ __forceinline__ void load_offsets(Frame& F, int l) {
    volatile LAS int* tab = (volatile LAS int*)(F.lds + TAB_OFF);
    __syncthreads();
    if (F.tid < NEXP) {
        int c = (int)__hip_atomic_load(F.ctl + CW_CNT + l * 64 + F.tid, __ATOMIC_RELAXED, __HIP_MEMORY_SCOPE_AGENT); if (c > NT) c = NT;
        const int ntl = (c + 255) >> 8; int incl = ntl;
#pragma unroll
        for (int d = 1; d < 64; d <<= 1) { const int o = __shfl_up(incl, d); if (F.tid >= d) incl += o; }
        const int excl = incl - ntl;
        tab[F.tid] = excl << 8; tab[66 + F.tid] = c;
        for (int t = 0; t < ntl; ++t) if (excl + t < MAXTILES) tab[160 + excl + t] = F.tid;
        if (F.tid == NEXP - 1) { tab[64] = incl << 8; tab[65] = incl; }
    }
    __syncthreads();
}
__device__ __forceinline__ void p_scatter(Frame& F, int l) {
    load_offsets(F, l);
    const LAS int* tab = (const LAS int*)(F.lds + TAB_OFF);
    const int* tope = (const int*)(F.ws + WS_TOPE); int* slot = (int*)(F.ws + WS_SLOT); int* sorted = (int*)(F.ws + WS_SORTED);
    for (int i = F.gw * 64 + F.lane; i < NT * 8; i += F.NGW * 64) { const int e = tope[i]; const int row = tab[e] + slot[i]; sorted[row] = i >> 3; slot[i] = row; }
    for (int i = F.gw * 64 + F.lane; i < NEXP * 256; i += F.NGW * 64) { const int e = i >> 8, j = i & 255; const int r = tab[e] + tab[66 + e] + j; if (r < tab[e + 1]) sorted[r] = 0; }
}

__device__ __forceinline__ void p_l1_thin_a(Frame& F) {
    const bf16* proj = (const bf16*)(F.ws + WS_PROJ); const int* pos = (const int*)kin(1);
    bf16* cqn = (bf16*)(F.ws + WS_CQN); bf16* ckvn = (bf16*)(F.ws + WS_CKVN); bf16* krot = (bf16*)(F.ws + WS_KROT); bf16* cmpkv = (bf16*)(F.ws + WS_CMPKV);
    const float* qn = kin(10); const float* kvn = kin(12);
    for (int m = F.gw; m < NT; m += F.NGW) {
        const bf16* row = proj + (size_t)m * CD_INP;
        { float x[6]; float s = 0.f;
#pragma unroll
          for (int j = 0; j < 6; ++j) { x[j] = bf1(row[2584 + j * 64 + F.lane]); s += x[j] * x[j]; }
          const float r = 1.f / sqrtf(wave_sum(s) * (1.f / 384.f) + NORM_EPS);
#pragma unroll
          for (int j = 0; j < 6; ++j) cqn[(size_t)m * 384 + j * 64 + F.lane] = (bf16)f2bf(x[j] * r * qn[j * 64 + F.lane]); }
        { float x[8]; float s = 0.f;
#pragma unroll
          for (int j = 0; j < 8; ++j) { x[j] = bf1(row[2968 + j * 64 + F.lane]); s += x[j] * x[j]; }
          const float r = 1.f / sqrtf(wave_sum(s) * (1.f / 512.f) + NORM_EPS);
#pragma unroll
          for (int j = 0; j < 8; ++j) ckvn[(size_t)m * 512 + j * 64 + F.lane] = (bf16)f2bf(x[j] * r * kvn[j * 64 + F.lane]); }
        { const int i = F.lane & 31; const float p = (float)pos[m]; const float invf = exp2f(-(float)i * (13.287712379549449f / 32.f));
          float sn, cs; fast_sincos(p * invf, sn, cs);
          const float x1 = bf1(row[3480 + i]), x2 = bf1(row[3480 + 32 + i]);
          if (F.lane < 32) krot[(size_t)m * 64 + i] = (bf16)f2bf(x1 * cs - x2 * sn); else krot[(size_t)m * 64 + 32 + i] = (bf16)f2bf(x1 * sn + x2 * cs); }
        { const int b = m >> 11, s = m & (NS - 1);
          const int q4 = F.lane >> 4, c = F.lane & 15, kv = q4 >> 1, g = q4 & 1;
          const v4u w = *(const v4u*)(row + 1024 + q4 * 128 + c * 8);
          *(v4u*)(cmpkv + ((size_t)((kv * 16 + b * 2 + g) * NS + s)) * 128 + c * 8) = w; }
    }
}
__device__ __forceinline__ void p_l1_thin_b(Frame& F) {
    const float* hid = (const float*)(F.ws + WS_HID); const float* w2 = kin(9); bf16* kvc = (bf16*)(F.ws + WS_KVCMP);
    for (int m = F.gw; m < 4096; m += F.NGW) {
        const int kv = m >> 11;
        float h0 = hid[(size_t)m * 256 + kv * 128 + F.lane], h1 = hid[(size_t)m * 256 + kv * 128 + 64 + F.lane];
        h0 = 0.5f * h0 * (1.f + tanhf(0.7978845608028654f * (h0 + 0.044715f * h0 * h0 * h0)));
        h1 = 0.5f * h1 * (1.f + tanhf(0.7978845608028654f * (h1 + 0.044715f * h1 * h1 * h1)));
        const float* w = w2 + (size_t)kv * 128 * 128; float o0 = 0.f, o1 = 0.f;
        for (int c = 0; c < 64; ++c) { const float a = __shfl(h0, c), bq = __shfl(h1, c);
            o0 += a * w[c * 128 + F.lane] + bq * w[(c + 64) * 128 + F.lane]; o1 += a * w[c * 128 + 64 + F.lane] + bq * w[(c + 64) * 128 + 64 + F.lane]; }
        kvc[(size_t)m * 128 + F.lane] = (bf16)f2bf(o0); kvc[(size_t)m * 128 + 64 + F.lane] = (bf16)f2bf(o1);
    }
}
__device__ __forceinline__ void p_nsa_cmp_mfma(Frame& F) {
    typedef short v4i16_t __attribute__((ext_vector_type(4)));
    const bf16* proj = (const bf16*)(F.ws + WS_PROJ); const bf16* kvc = (const bf16*)(F.ws + WS_KVCMP); float* ocmp = (float*)(F.ws + WS_OCMP); unsigned* selm = (unsigned*)(F.ws + WS_SELM);
    constexpr int P = 272;
    LAS unsigned char* KT = F.lds; LAS unsigned char* VT = F.lds + 128 * P; LAS float* PS = (LAS float*)(F.lds + 2 * 128 * P);
    const int w = F.wave, lane = F.lane, i16 = lane & 15, g = lane >> 4, q4 = (lane & 15) >> 2, p4 = lane & 3;
    const float sscale = 0.08838834764831845f * 1.4426950408889634f;
    for (int bu = blockIdx.x; bu < 256; bu += F.G) {
        const int bg = bu >> 4, qg = bu & 15, b = bg >> 1, gq = bg & 1;
        __syncthreads();
#pragma unroll
        for (int c = 0; c < 4; ++c) { const int idx = F.tid + 512 * c, row = idx >> 4, c8 = idx & 15;
            v4u kk = (v4u){0u, 0u, 0u, 0u}, vv = (v4u){0u, 0u, 0u, 0u};
            if (row < 127) { kk = *(const v4u*)(kvc + ((size_t)(0 * 16 + bg) * 128 + row) * 128 + c8 * 8); vv = *(const v4u*)(kvc + ((size_t)(1 * 16 + bg) * 128 + row) * 128 + c8 * 8); }
            *(LAS v4u*)(KT + row * P + c8 * 16) = kk; *(LAS v4u*)(VT + row * P + c8 * 16) = vv; }
        for (int k = 0; k < 4; ++k) {
            const int q0 = (qg * 4 + k) * 32, h = gq * 4 + (w >> 1), ql = (w & 1) * 16 + i16, spos = q0 + ql;
            bf16x8 qf[4];
#pragma unroll
            for (int ks = 0; ks < 4; ++ks) qf[ks] = *(const bf16x8*)(proj + (size_t)(b * NS + spos) * CD_INP + h * 128 + 32 * ks + 8 * g);
            __syncthreads();
            const int nvalid = spos >= 31 ? ((spos - 31) >> 4) + 1 : 0;
            f32x4 sc[8]; float mx = -1e30f;
#pragma unroll
            for (int mt = 0; mt < 8; ++mt) { sc[mt] = (f32x4){0.f, 0.f, 0.f, 0.f};
#pragma unroll
                for (int ks = 0; ks < 4; ++ks) { const bf16x8 kf = *(const LAS bf16x8*)(KT + (16 * mt + i16) * P + (32 * ks + 8 * g) * 2); sc[mt] = __builtin_amdgcn_mfma_f32_16x16x32_bf16(kf, qf[ks], sc[mt], 0, 0, 0); }
#pragma unroll
                for (int r = 0; r < 4; ++r) { const bool ok = (16 * mt + 4 * g + r) < nvalid; const float x = ok ? sc[mt][r] * sscale : -1e30f; sc[mt][r] = x; mx = fmaxf(mx, x); } }
            mx = fmaxf(mx, __shfl_xor(mx, 16)); mx = fmaxf(mx, __shfl_xor(mx, 32));
            float ps = 0.f;
#pragma unroll
            for (int mt = 0; mt < 8; ++mt)
#pragma unroll
                for (int r = 0; r < 4; ++r) { const bool ok = (16 * mt + 4 * g + r) < nvalid; const float pv = ok ? __builtin_amdgcn_exp2f(sc[mt][r] - mx) : 0.f; sc[mt][r] = pv; ps += pv; }
            ps += __shfl_xor(ps, 16); ps += __shfl_xor(ps, 32);
            const float inv = ps > 0.f ? 1.f / ps : 0.f;
#pragma unroll
            for (int mt = 0; mt < 8; ++mt)
#pragma unroll
                for (int r = 0; r < 4; ++r) sc[mt][r] *= inv;
            { LAS float* slab = PS + (w >> 2) * 4096 + ql * 128 + 4 * g;
              if (((w >> 1) & 1) == 0) {
#pragma unroll
                  for (int mt = 0; mt < 8; ++mt) *(LAS f32x4*)(slab + 16 * mt) = sc[mt]; }
              __syncthreads();
              if (((w >> 1) & 1) == 1) {
#pragma unroll
                  for (int mt = 0; mt < 8; ++mt) { const f32x4 t = *(const LAS f32x4*)(slab + 16 * mt); *(LAS f32x4*)(slab + 16 * mt) = t + sc[mt]; } } }
            f32x4 O[8];
#pragma unroll
            for (int nt = 0; nt < 8; ++nt) O[nt] = (f32x4){0.f, 0.f, 0.f, 0.f};
#pragma unroll
            for (int k2 = 0; k2 < 4; ++k2) { v4u wv; wv.x = pk2(sc[2 * k2][0], sc[2 * k2][1]); wv.y = pk2(sc[2 * k2][2], sc[2 * k2][3]); wv.z = pk2(sc[2 * k2 + 1][0], sc[2 * k2 + 1][1]); wv.w = pk2(sc[2 * k2 + 1][2], sc[2 * k2 + 1][3]);
                const bf16x8 pf = __builtin_bit_cast(bf16x8, wv);
#pragma unroll
                for (int nt = 0; nt < 8; ++nt) {
                    const v4i16_t a = __builtin_amdgcn_ds_read_tr16_b64_v4i16((LAS v4i16_t*)(VT + (32 * k2 + 4 * g + q4) * P + (16 * nt + 4 * p4) * 2));
                    const v4i16_t c = __builtin_amdgcn_ds_read_tr16_b64_v4i16((LAS v4i16_t*)(VT + (32 * k2 + 16 + 4 * g + q4) * P + (16 * nt + 4 * p4) * 2));
                    const bf16x8 vf = (bf16x8){a[0], a[1], a[2], a[3], c[0], c[1], c[2], c[3]};
                    O[nt] = __builtin_amdgcn_mfma_f32_16x16x32_bf16(pf, vf, O[nt], 0, 0, 0); } }
#pragma unroll
            for (int r = 0; r < 4; ++r) { const size_t m = (size_t)(b * NS + q0 + (w & 1) * 16 + 4 * g + r); const float gt = sigmoidf_(bf1(proj[m * CD_INP + 2560 + h * 3 + 0]));
#pragma unroll
                for (int nt = 0; nt < 8; ++nt) ocmp[m * 1024 + h * 128 + 16 * nt + i16] = gt * O[nt][r]; }
            __syncthreads();
#pragma unroll
            for (int qq = 0; qq < 4; ++qq) { const int qi = 4 * w + qq, s = q0 + qi, cur = s >> 6, j = lane & 31;
                float imp = 0.f;
#pragma unroll
                for (int kk = 0; kk < 4; ++kk) { const int n1 = 4 * j + kk; if (n1 <= 126) imp += PS[qi * 128 + n1] + PS[4096 + qi * 128 + n1]; const int n2 = 4 * j - 1 + kk; if (n2 >= 0 && n2 <= 126) imp += PS[qi * 128 + n2] + PS[4096 + qi * 128 + n2]; }
                const bool forced = (j == 0) || (j == cur) || (j == cur - 1);
                const float score = forced ? 1e4f : ((j * 64 <= s) ? imp : -1e30f);
                int rk = 0;
                for (int jj = 0; jj < 32; ++jj) { const float ov = __shfl(score, jj); rk += ((ov > score) || (ov == score && jj < j)) ? 1 : 0; }
                const bool sel = (lane < 32) && (rk < 16) && (j <= cur);
                const unsigned long long bal = __ballot(sel);
                if (lane == 0) selm[(size_t)(b * NS + s) * 2 + gq] = (unsigned)bal; }
        }
    }
}

namespace fa {
typedef short v4i16_t __attribute__((ext_vector_type(4)));
struct Src { const bf16* k1; size_t ks1; const bf16* k2; size_t ks2; const bf16* v; size_t vs; };
template <int DQK> struct Cfg { static constexpr int KPITCH = (DQK + 8) * 2, KBYTES = 64 * KPITCH, VPITCH = 272, VBYTES = 64 * VPITCH, BUF = KBYTES + VBYTES, NKS = DQK / 32, KCH = DQK / 8, NKR = DQK / 64; };

template <int DQK> struct TileOff { unsigned gk[Cfg<DQK>::NKR], gv[2], lk[Cfg<DQK>::NKR], lv[2]; };
template <int DQK>
__device__ __forceinline__ void tile_offsets(const Src& S, int tid, TileOff<DQK>& T) {
#pragma unroll
    for (int i = 0; i < 2; ++i) { const int c = tid + 512 * i, row = c >> 4, c8 = c & 15;
        T.gk[i] = (unsigned)(row * (int)S.ks1 + c8 * 8) * 2u; T.gv[i] = (unsigned)(row * (int)S.vs + c8 * 8) * 2u;
        T.lk[i] = (unsigned)(row * Cfg<DQK>::KPITCH + c8 * 16); T.lv[i] = (unsigned)(Cfg<DQK>::KBYTES + row * Cfg<DQK>::VPITCH + c8 * 16); }
    if (DQK == 192) { const int row = tid >> 3, c8 = tid & 7; T.gk[Cfg<DQK>::NKR - 1] = (unsigned)(row * (int)S.ks2 + c8 * 8) * 2u; T.lk[Cfg<DQK>::NKR - 1] = (unsigned)(row * Cfg<DQK>::KPITCH + 256 + c8 * 16); }
}
template <int DQK>
__device__ __forceinline__ void load_tile(const Src& S, int k0, const TileOff<DQK>& T, v4u (&kr)[Cfg<DQK>::NKR], v4u (&vr)[2]) {
    const char* kb1 = (const char*)S.k1 + (size_t)k0 * S.ks1 * 2; const char* vb = (const char*)S.v + (size_t)k0 * S.vs * 2;
#pragma unroll
    for (int i = 0; i < 2; ++i) { kr[i] = *(const v4u*)(kb1 + T.gk[i]); vr[i] = *(const v4u*)(vb + T.gv[i]); }
    if (DQK == 192) { const char* kb2 = (const char*)S.k2 + (size_t)k0 * S.ks2 * 2; kr[Cfg<DQK>::NKR - 1] = *(const v4u*)(kb2 + T.gk[Cfg<DQK>::NKR - 1]); }
}
template <int DQK>
__device__ __forceinline__ void store_tile(LAS unsigned char* buf, const TileOff<DQK>& T, const v4u (&kr)[Cfg<DQK>::NKR], const v4u (&vr)[2]) {
#pragma unroll
    for (int i = 0; i < Cfg<DQK>::NKR; ++i) *(LAS v4u*)(buf + T.lk[i]) = kr[i];
#pragma unroll
    for (int i = 0; i < 2; ++i) *(LAS v4u*)(buf + T.lv[i]) = vr[i];
}
struct RowState { int spos; unsigned rowmask; float m_run, l_run; };
template <int MODE> __device__ __forceinline__ bool group_needs(int t, const RowState& R) {
    bool row_any = (t * 64 <= R.spos);
    if (MODE == 1) row_any = row_any && ((R.rowmask >> t) & 1u);
    if (MODE == 2) row_any = row_any && (t * 64 + 63 + 512 > R.spos);
    return __ballot(row_any) != 0ull;
}
template <int MODE>
__device__ __forceinline__ void softmax_group(f32x4 (&sc)[4], int t, RowState& R, float sscale, f32x4 (&O)[8], bf16x8 (&pf)[2], int g) {
    float mx = -1e30f;
#pragma unroll
    for (int mt = 0; mt < 4; ++mt)
#pragma unroll
        for (int r = 0; r < 4; ++r) { const int kp = t * 64 + 16 * mt + 4 * g + r; bool ok = kp <= R.spos;
            if (MODE == 1) ok = ok && ((R.rowmask >> t) & 1u);
            if (MODE == 2) ok = ok && (kp + 512 > R.spos);
            const float x = ok ? sc[mt][r] * sscale : -3e38f; sc[mt][r] = x; mx = fmaxf(mx, x); }
    mx = fmaxf(mx, -1e30f);
    mx = fmaxf(mx, __shfl_xor(mx, 16)); mx = fmaxf(mx, __shfl_xor(mx, 32));
    if (__ballot(mx > R.m_run + 8.0f) != 0ull) {
        const float m_new = fmaxf(R.m_run, mx), alpha = __builtin_amdgcn_exp2f(R.m_run - m_new); R.m_run = m_new;
        R.l_run *= alpha;
        float ar[4];
#pragma unroll
        for (int r = 0; r < 4; ++r) ar[r] = __shfl(alpha, 4 * g + r);
#pragma unroll
        for (int nt = 0; nt < 8; ++nt)
#pragma unroll
            for (int r = 0; r < 4; ++r) O[nt][r] *= ar[r];
    }
    float ps = 0.f;
#pragma unroll
    for (int mt = 0; mt < 4; ++mt)
#pragma unroll
        for (int r = 0; r < 4; ++r) { const float pv = __builtin_amdgcn_exp2f(sc[mt][r] - R.m_run); sc[mt][r] = pv; ps += pv; }
    R.l_run += ps;
#pragma unroll
    for (int k2 = 0; k2 < 2; ++k2) { v4u w; w.x = pk2(sc[2 * k2][0], sc[2 * k2][1]); w.y = pk2(sc[2 * k2][2], sc[2 * k2][3]); w.z = pk2(sc[2 * k2 + 1][0], sc[2 * k2 + 1][1]); w.w = pk2(sc[2 * k2 + 1][2], sc[2 * k2 + 1][3]);
        pf[k2] = __builtin_bit_cast(bf16x8, w); }
}
template <int DQK, int MODE>
__device__ __forceinline__ void fa_compute(LAS unsigned char* kb, LAS unsigned char* vb, const bf16x8 (&qf0)[Cfg<DQK>::NKS], const bf16x8 (&qf1)[Cfg<DQK>::NKS], int t, RowState& R0, RowState& R1, float sscale,
                                           f32x4 (&O0)[8], f32x4 (&O1)[8], int i16, int g, int q4, int p4) {
    typedef Cfg<DQK> C;
    const bool n0 = group_needs<MODE>(t, R0), n1 = group_needs<MODE>(t, R1);
    if (!n0 && !n1) return;
    f32x4 s0[4], s1[4];
#pragma unroll
    for (int mt = 0; mt < 4; ++mt) { s0[mt] = (f32x4){0.f, 0.f, 0.f, 0.f}; s1[mt] = (f32x4){0.f, 0.f, 0.f, 0.f};
#pragma unroll
        for (int ks = 0; ks < C::NKS; ++ks) { const bf16x8 kf = *(const LAS bf16x8*)(kb + (16 * mt + i16) * C::KPITCH + (32 * ks + 8 * g) * 2);
            s0[mt] = __builtin_amdgcn_mfma_f32_16x16x32_bf16(kf, qf0[ks], s0[mt], 0, 0, 0);
            s1[mt] = __builtin_amdgcn_mfma_f32_16x16x32_bf16(kf, qf1[ks], s1[mt], 0, 0, 0); } }
    bf16x8 p0[2], p1[2];
    if (n0) softmax_group<MODE>(s0, t, R0, sscale, O0, p0, g); else { p0[0] = (bf16x8){0, 0, 0, 0, 0, 0, 0, 0}; p0[1] = p0[0]; }
    if (n1) softmax_group<MODE>(s1, t, R1, sscale, O1, p1, g); else { p1[0] = (bf16x8){0, 0, 0, 0, 0, 0, 0, 0}; p1[1] = p1[0]; }
#pragma unroll
    for (int nt = 0; nt < 8; ++nt)
#pragma unroll
        for (int k2 = 0; k2 < 2; ++k2) {
            const v4i16_t a = __builtin_amdgcn_ds_read_tr16_b64_v4i16((LAS v4i16_t*)(vb + (32 * k2 + 4 * g + q4) * C::VPITCH + (16 * nt + 4 * p4) * 2));
            const v4i16_t b = __builtin_amdgcn_ds_read_tr16_b64_v4i16((LAS v4i16_t*)(vb + (32 * k2 + 16 + 4 * g + q4) * C::VPITCH + (16 * nt + 4 * p4) * 2));
            const bf16x8 vf = (bf16x8){a[0], a[1], a[2], a[3], b[0], b[1], b[2], b[3]};
            O0[nt] = __builtin_amdgcn_mfma_f32_16x16x32_bf16(p0[k2], vf, O0[nt], 0, 0, 0);
            O1[nt] = __builtin_amdgcn_mfma_f32_16x16x32_bf16(p1[k2], vf, O1[nt], 0, 0, 0); }
}
template <int DQK, int MODE>
__device__ __forceinline__ void fa_pass(LAS unsigned char* lds, const Src& S, const bf16x8 (&qf0)[Cfg<DQK>::NKS], const bf16x8 (&qf1)[Cfg<DQK>::NKS], unsigned tmask, RowState& R0, RowState& R1, float sscale,
                                        f32x4 (&O0)[8], f32x4 (&O1)[8], int tid, int lane) {
    typedef Cfg<DQK> C;
    const int i16 = lane & 15, g = lane >> 4, q4 = (lane & 15) >> 2, p4 = lane & 3;
#pragma unroll
    for (int nt = 0; nt < 8; ++nt) { O0[nt] = (f32x4){0.f, 0.f, 0.f, 0.f}; O1[nt] = (f32x4){0.f, 0.f, 0.f, 0.f}; }
    R0.m_run = -1e30f; R0.l_run = 0.f; R1.m_run = -1e30f; R1.l_run = 0.f;
    unsigned rem = tmask;
    if (rem == 0u) return;
    v4u kr[C::NKR], vr[2]; TileOff<DQK> TO; tile_offsets<DQK>(S, tid, TO);
    int t = __builtin_ctz(rem); rem &= rem - 1u;
    load_tile<DQK>(S, t * 64, TO, kr, vr);
    __syncthreads();
    store_tile<DQK>(lds, TO, kr, vr);
    __syncthreads();
    int cur = 0;
    for (;;) {
        const bool has_next = rem != 0u; int tn = 0;
        if (has_next) { tn = __builtin_ctz(rem); rem &= rem - 1u; load_tile<DQK>(S, tn * 64, TO, kr, vr); }
        LAS unsigned char* kb = lds + cur * C::BUF;
        fa_compute<DQK, MODE>(kb, kb + C::KBYTES, qf0, qf1, t, R0, R1, sscale, O0, O1, i16, g, q4, p4);
        if (has_next) store_tile<DQK>(lds + (cur ^ 1) * C::BUF, TO, kr, vr);
        __syncthreads();
        if (!has_next) break;
        t = tn; cur ^= 1;
    }
}
__device__ __forceinline__ void row_inv(float l_run, int lane, float (&inv)[4]) {
    float l = l_run; l += __shfl_xor(l, 16); l += __shfl_xor(l, 32);
    const float li = l > 0.f ? 1.f / l : 0.f; const int g = lane >> 4;
#pragma unroll
    for (int r = 0; r < 4; ++r) inv[r] = __shfl(li, 4 * g + r);
}
__device__ __forceinline__ void rope_qpe(bf16x8& f4, bf16x8& f5, float pz, int g4) {
    v4u w1 = __builtin_bit_cast(v4u, f4), w2 = __builtin_bit_cast(v4u, f5); float x1[8], x2[8]; unpack8(w1, x1); unpack8(w2, x2);
#pragma unroll
    for (int jj = 0; jj < 8; ++jj) { const float invf = exp2f(-(float)(8 * g4 + jj) * (13.287712379549449f / 32.f)); float sn, cs; fast_sincos(pz * invf, sn, cs);
        const float a = x1[jj] * cs - x2[jj] * sn, c = x1[jj] * sn + x2[jj] * cs; x1[jj] = a; x2[jj] = c; }
    w1.x = pk2(x1[0], x1[1]); w1.y = pk2(x1[2], x1[3]); w1.z = pk2(x1[4], x1[5]); w1.w = pk2(x1[6], x1[7]);
    w2.x = pk2(x2[0], x2[1]); w2.y = pk2(x2[2], x2[3]); w2.z = pk2(x2[4], x2[5]); w2.w = pk2(x2[6], x2[7]);
    f4 = __builtin_bit_cast(bf16x8, w1); f5 = __builtin_bit_cast(bf16x8, w2);
}
}

__device__ __forceinline__ void p_attn_mla(Frame& F, unsigned* queue) {
    const bf16* proj = (const bf16*)(F.ws + WS_PROJ); bf16* mixin = (bf16*)(F.ws + WS_MIXIN); const float* ocmp = (const float*)(F.ws + WS_OCMP); const unsigned* selm = (const unsigned*)(F.ws + WS_SELM);
    const bf16* qmla = (const bf16*)(F.ws + WS_QMLA); const bf16* kvu = (const bf16*)(F.ws + WS_KVU); const bf16* krot = (const bf16*)(F.ws + WS_KROT);
    volatile LAS unsigned* qslot = (volatile LAS unsigned*)(F.lds + LDSCTL_OFF);
    const int lane = F.lane, w = F.wave, i16 = lane & 15, g4 = lane >> 4;
    for (;;) {
        __syncthreads();
        if (F.tid == 0) qslot[0] = atomicAdd(queue, 1u);
        __syncthreads();
        const int u = __builtin_amdgcn_readfirstlane((int)qslot[0]);
        if (u >= 512) break;
        {
            const int qt = 7 - (u >> 6), bh = u & 63, b = bh >> 3, h = bh & 7, q0 = qt * 256;
            fa::RowState R0, R1; R0.spos = q0 + 32 * w + i16; R1.spos = R0.spos + 16; R0.rowmask = 0u; R1.rowmask = 0u;
            bf16x8 qf0[6], qf1[6];
#pragma unroll
            for (int ks = 0; ks < 6; ++ks) { qf0[ks] = *(const bf16x8*)(qmla + (size_t)(b * NS + R0.spos) * 1536 + h * 192 + 32 * ks + 8 * g4); qf1[ks] = *(const bf16x8*)(qmla + (size_t)(b * NS + R1.spos) * 1536 + h * 192 + 32 * ks + 8 * g4); }
            fa::rope_qpe(qf0[4], qf0[5], (float)((const int*)kin(1))[b * NS + R0.spos], g4);
            fa::rope_qpe(qf1[4], qf1[5], (float)((const int*)kin(1))[b * NS + R1.spos], g4);
            fa::Src S; S.k1 = kvu + (size_t)(b * NS) * 2048 + h * 256; S.ks1 = 2048; S.k2 = krot + (size_t)(b * NS) * 64; S.ks2 = 64; S.v = S.k1 + 128; S.vs = 2048;
            const int last = (q0 + 255) >> 6; const unsigned tmask = last >= 31 ? 0xffffffffu : ((1u << (last + 1)) - 1u);
            f32x4 O0[8], O1[8];
            fa::fa_pass<192, 0>(F.lds, S, qf0, qf1, tmask, R0, R1, 0.07216878364870322f * 1.4426950408889634f, O0, O1, F.tid, lane);
            float inv[4];
            fa::row_inv(R0.l_run, lane, inv);
#pragma unroll
            for (int r = 0; r < 4; ++r) { bf16* orow = mixin + (size_t)(b * NS + q0 + 32 * w + 4 * g4 + r) * ND + 1024 + h * 128 + i16;
#pragma unroll
                for (int nt = 0; nt < 8; ++nt) orow[16 * nt] = (bf16)f2bf(O0[nt][r] * inv[r]); }
            fa::row_inv(R1.l_run, lane, inv);
#pragma unroll
            for (int r = 0; r < 4; ++r) { bf16* orow = mixin + (size_t)(b * NS + q0 + 32 * w + 16 + 4 * g4 + r) * ND + 1024 + h * 128 + i16;
#pragma unroll
                for (int nt = 0; nt < 8; ++nt) orow[16 * nt] = (bf16)f2bf(O1[nt][r] * inv[r]); }
        }
    }
    (void)proj; (void)ocmp; (void)selm;
}
__device__ __forceinline__ void p_attn_nsa(Frame& F, unsigned* queue) {
    const bf16* proj = (const bf16*)(F.ws + WS_PROJ); bf16* mixin = (bf16*)(F.ws + WS_MIXIN); const float* ocmp = (const float*)(F.ws + WS_OCMP); const unsigned* selm = (const unsigned*)(F.ws + WS_SELM);
    const bf16* qmla = (const bf16*)(F.ws + WS_QMLA); const bf16* kvu = (const bf16*)(F.ws + WS_KVU); const bf16* krot = (const bf16*)(F.ws + WS_KROT);
    volatile LAS unsigned* qslot = (volatile LAS unsigned*)(F.lds + LDSCTL_OFF);
    const int lane = F.lane, w = F.wave, i16 = lane & 15, g4 = lane >> 4;
    for (;;) {
        __syncthreads();
        if (F.tid == 0) qslot[0] = atomicAdd(queue, 1u);
        __syncthreads();
        const int u = __builtin_amdgcn_readfirstlane((int)qslot[0]);
        if (u >= 512) break;
        {
            const int v = u;
            const int qt = 31 - (v >> 4), bg = v & 15, b = bg >> 1, gq = bg & 1, q0 = qt * 64;
            const int h = gq * 4 + (w >> 1), qb = q0 + (w & 1) * 32;
            fa::RowState R0, R1; R0.spos = qb + i16; R1.spos = qb + 16 + i16;
            bf16x8 qf0[4], qf1[4];
#pragma unroll
            for (int ks = 0; ks < 4; ++ks) { qf0[ks] = *(const bf16x8*)(proj + (size_t)(b * NS + R0.spos) * CD_INP + h * 128 + 32 * ks + 8 * g4); qf1[ks] = *(const bf16x8*)(proj + (size_t)(b * NS + R1.spos) * CD_INP + h * 128 + 32 * ks + 8 * g4); }
            R0.rowmask = selm[(size_t)(b * NS + R0.spos) * 2 + gq]; R1.rowmask = selm[(size_t)(b * NS + R1.spos) * 2 + gq];
            unsigned um = selm[(size_t)(b * NS + q0 + lane) * 2 + gq];
#pragma unroll
            for (int o = 1; o < 64; o <<= 1) um |= (unsigned)__shfl_xor((int)um, o);
            um = (unsigned)__builtin_amdgcn_readfirstlane((int)um);
            const bf16* base = proj + (size_t)(b * NS) * CD_INP;
            const float sscale = 0.08838834764831845f * 1.4426950408889634f;
            f32x4 O0[8], O1[8]; float inv[4];
            { fa::Src S; S.k1 = base + 1024 + ((1 * 2 + 0) * 2 + gq) * 128; S.ks1 = CD_INP; S.k2 = nullptr; S.ks2 = 0; S.v = base + 1024 + ((1 * 2 + 1) * 2 + gq) * 128; S.vs = CD_INP;
              fa::fa_pass<128, 1>(F.lds, S, qf0, qf1, um, R0, R1, sscale, O0, O1, F.tid, lane); }
            fa::row_inv(R0.l_run, lane, inv);
#pragma unroll
            for (int r = 0; r < 4; ++r) { const size_t m = (size_t)(b * NS + qb + 4 * g4 + r); const float g1 = sigmoidf_(bf1(proj[m * CD_INP + 2560 + h * 3 + 1])) * inv[r];
#pragma unroll
                for (int nt = 0; nt < 8; ++nt) mixin[m * ND + h * 128 + 16 * nt + i16] = (bf16)f2bf(ocmp[m * 1024 + h * 128 + 16 * nt + i16] + O0[nt][r] * g1); }
            fa::row_inv(R1.l_run, lane, inv);
#pragma unroll
            for (int r = 0; r < 4; ++r) { const size_t m = (size_t)(b * NS + qb + 16 + 4 * g4 + r); const float g1 = sigmoidf_(bf1(proj[m * CD_INP + 2560 + h * 3 + 1])) * inv[r];
#pragma unroll
                for (int nt = 0; nt < 8; ++nt) mixin[m * ND + h * 128 + 16 * nt + i16] = (bf16)f2bf(ocmp[m * 1024 + h * 128 + 16 * nt + i16] + O1[nt][r] * g1); }
            { fa::Src S; S.k1 = base + 1024 + ((2 * 2 + 0) * 2 + gq) * 128; S.ks1 = CD_INP; S.k2 = nullptr; S.ks2 = 0; S.v = base + 1024 + ((2 * 2 + 1) * 2 + gq) * 128; S.vs = CD_INP;
              const int klo = q0 - 511 > 0 ? q0 - 511 : 0, tlo = klo >> 6, thi = (q0 + 63) >> 6;
              const unsigned hm = thi >= 31 ? 0xffffffffu : ((1u << (thi + 1)) - 1u); const unsigned tmask = hm & ~((1u << tlo) - 1u);
              fa::fa_pass<128, 2>(F.lds, S, qf0, qf1, tmask, R0, R1, sscale, O0, O1, F.tid, lane); }
            fa::row_inv(R0.l_run, lane, inv);
#pragma unroll
            for (int r = 0; r < 4; ++r) { const size_t m = (size_t)(b * NS + qb + 4 * g4 + r); const float g2 = sigmoidf_(bf1(proj[m * CD_INP + 2560 + h * 3 + 2])) * inv[r];
#pragma unroll
                for (int nt = 0; nt < 8; ++nt) { bf16* op = mixin + m * ND + h * 128 + 16 * nt + i16; *op = (bf16)f2bf(bf1(*op) + O0[nt][r] * g2); } }
            fa::row_inv(R1.l_run, lane, inv);
#pragma unroll
            for (int r = 0; r < 4; ++r) { const size_t m = (size_t)(b * NS + qb + 16 + 4 * g4 + r); const float g2 = sigmoidf_(bf1(proj[m * CD_INP + 2560 + h * 3 + 2])) * inv[r];
#pragma unroll
                for (int nt = 0; nt < 8; ++nt) { bf16* op = mixin + m * ND + h * 128 + 16 * nt + i16; *op = (bf16)f2bf(bf1(*op) + O1[nt][r] * g2); } }
        }
    }
    (void)qmla; (void)kvu; (void)krot;
}

constexpr int NPHASE = 33;


#define IN(k) (lo <= (k) && (k) < hi)
#define SEAM(k) do { if (IN(k) && IN((k) + 1)) { if (MK_ONE_LAUNCH) xcd_barrier(bar); else if (F.tid == 0) __hip_atomic_store(F.ctl + CW_TMO, 0xBAD0u | (unsigned)(k), __ATOMIC_RELAXED, __HIP_MEMORY_SCOPE_AGENT); \
    if (MK_PROBE_PHASE >= 0 && blockIdx.x == 0 && F.tid == 0) { if ((k) == MK_PROBE_PHASE - 1) ((volatile LAS unsigned long long*)(F.lds + LDSCTL_OFF + 64))[0] = __builtin_amdgcn_s_memrealtime(); \
        if ((k) == MK_PROBE_LAST) ((volatile LAS unsigned long long*)(F.lds + LDSCTL_OFF + 64))[1] = __builtin_amdgcn_s_memrealtime(); } } } while (0)
template <int l>
__device__ __forceinline__ void layer_body(Frame& F, const XcdBarrier& bar, const int lo, const int hi) {
    unsigned char* ws = F.ws;
    bf16* const XB0 = (bf16*)(ws + WS_XB0); bf16* const X1B = (bf16*)(ws + WS_X1B); bf16* const X2B = (bf16*)(ws + WS_X2B);
    bf16* const PROJ = (bf16*)(ws + WS_PROJ); bf16* const MIXIN = (bf16*)(ws + WS_MIXIN); bf16* const MIXO = (bf16*)(ws + WS_MIXO);
    bf16* const HB = (bf16*)(ws + WS_H); bf16* const Y2 = (bf16*)(ws + WS_Y2);
        const int pb = 1 + l * 16;
        const bf16* xin = l == 0 ? XB0 : X2B;
        if (IN(pb + 0)) {
            if (l == 0) { pg8::DenseProb P; P.init(xin, ND, (const bf16*)(ws + WS_WABIN), NT, AB_IN, ND, F.G, (int)blockIdx.x); pg8::EpiBf16 E{PROJ, AB_IN};
                pg8::gemm_phase<pg8::EpiBf16, pg8::DenseProb, true>(F.lds, P, E); }
            else { pg8::DenseProb P; P.init(xin, ND, (const bf16*)(ws + WS_WCDIN), NT, CD_INP, ND, F.G, (int)blockIdx.x); pg8::EpiBf16 E{PROJ, CD_INP};
                pg8::gemm_phase<pg8::EpiBf16, pg8::DenseProb, true>(F.lds, P, E); }
        } SEAM(pb + 0);
        if (l == 0) {
            if (IN(pb + 2)) { if (blockIdx.x < NB * 6) p_retention_mfma(F, (int)blockIdx.x); else p_pool(F, ((int)blockIdx.x - NB * 6) * NWAVES + F.wave, (F.G - NB * 6) * NWAVES);
                __syncthreads(); p_moe_weights_queue(F, F.ctl + CW_CNT + 320); } SEAM(pb + 2);
        } else {
            if (IN(pb + 1)) { cmp_bias_finish(F); p_l1_thin_a(F); } SEAM(pb + 1);
            if (IN(pb + 2)) {
                if (blockIdx.x < 16) { pg8::CmpProb P; P.K = 4096; P.ldb = 4096; P.Abase = (const char*)(ws + WS_CMPKV); P.Bt = (const char*)(ws + WS_CW1); P.G = 16; P.c = (int)blockIdx.x;
                  pg8::EpiF32 E{(float*)(ws + WS_HID), 256, (const float*)(ws + WS_CMPB)};
                  pg8::gemm_phase<pg8::EpiF32, pg8::CmpProb, true>(F.lds, P, E); }
                else {
                { pg8::DenseProb P; P.init((const bf16*)(ws + WS_CQN), 384, (const bf16*)(ws + WS_WUQ), NT, 1536, 384, F.G - 16, (int)blockIdx.x - 16); pg8::EpiBf16 E{(bf16*)(ws + WS_QMLA), 1536};
                  pg8::gemm_phase<pg8::EpiBf16, pg8::DenseProb, true>(F.lds, P, E); }
                { pg8::DenseProb P; P.init((const bf16*)(ws + WS_CKVN), 512, (const bf16*)(ws + WS_WUKV), NT, 2048, 512, F.G - 16, (int)blockIdx.x - 16); pg8::EpiBf16 E{(bf16*)(ws + WS_KVU), 2048};
                  pg8::gemm_phase<pg8::EpiBf16, pg8::DenseProb, true>(F.lds, P, E); }
                }
            } SEAM(pb + 2);
            if (IN(pb + 3)) { p_l1_thin_b(F); } SEAM(pb + 3);
            if (IN(pb + 4)) { p_nsa_cmp_mfma(F); } SEAM(pb + 4);
            if (IN(pb + 5)) { p_attn_mla(F, F.ctl + CW_CNT + 256); p_attn_nsa(F, F.ctl + CW_CNT + 257); } SEAM(pb + 5);
        }
        if (IN(pb + 6)) { pg8::DenseProb P; P.init(MIXIN, ND, (const bf16*)(ws + (l == 0 ? WS_WABOUT : WS_WCDOUT)), NT, ND, ND, F.G, (int)blockIdx.x); pg8::EpiBf16 E{MIXO, ND};
            pg8::gemm_phase<pg8::EpiBf16, pg8::DenseProb, true>(F.lds, P, E); } SEAM(pb + 6);
        if (IN(pb + 7)) { p_ln1(F, xin, MIXO, kin(15) + l * ND, kin(16) + l * ND, X1B, MK_FP8_MOE ? (unsigned char*)(ws + WS_X1F8) : nullptr); } SEAM(pb + 7);
        if (IN(pb + 8)) { pg8::RouterProb P; P.K = 512; P.ldb = ND; P.Abase = (const char*)X1B; P.Bt = (const char*)(ws + WS_RT + (size_t)l * MiB); P.G = F.G; P.c = (int)blockIdx.x;
            pg8::EpiF32N64 E{(float*)(ws + WS_LOGITS)};
            pg8::gemm_phase<pg8::EpiF32N64, pg8::RouterProb, true>(F.lds, P, E); } SEAM(pb + 8);
        if (IN(pb + 9)) { p_route(F, l); } SEAM(pb + 9);
        if (IN(pb + 10)) { p_scatter(F, l); } SEAM(pb + 10);
        if (IN(pb + 11)) { load_offsets(F, l); const LAS int* tab = (const LAS int*)(F.lds + TAB_OFF);
            pg8::MoeUpProb P; P.W13 = (const char*)(ws + WS_W13 + (size_t)l * WS_MOE_LSTRIDE); P.sorted = (const int*)(ws + WS_SORTED); P.tile_e = tab + 160; P.ntiles = __builtin_amdgcn_readfirstlane(tab[65]);
            P.G = F.G; P.c = (int)blockIdx.x;
            if (MK_FP8_MOE) { P.K = ND / 2; P.ldb = ND / 2; P.arow = ND; P.brow = ND; P.pshift = 3; P.btile = 128; P.nunits = (P.ntiles + NT / 256) * 8; P.Abase = (const char*)(ws + WS_X1F8);
                pg8::EpiSwigluF8 E{(unsigned char*)HB, 1.0f / 64.0f};
                pg8::gemm_phase<pg8::EpiSwigluF8, pg8::MoeUpProb, true, true>(F.lds, P, E); }
            else { P.K = ND; P.ldb = ND; P.arow = ND * 2; P.brow = ND * 2; P.pshift = 2; P.btile = 256; P.nunits = (P.ntiles + NT / 256) * 4; P.Abase = (const char*)X1B;
                pg8::EpiSwiglu E{HB};
                pg8::gemm_phase<pg8::EpiSwiglu, pg8::MoeUpProb, true>(F.lds, P, E); } } SEAM(pb + 11);
        if (IN(pb + 12)) { load_offsets(F, l); const LAS int* tab = (const LAS int*)(F.lds + TAB_OFF);
            pg8::MoeDownProb P; P.Abase = (const char*)HB; P.W2 = (const char*)(ws + WS_W2 + (size_t)l * WS_MOE_LSTRIDE); P.tile_e = tab + 160; P.ntiles = __builtin_amdgcn_readfirstlane(tab[65]);
            P.G = F.G; P.c = (int)blockIdx.x;
            if (MK_FP8_MOE) { P.K = EFF / 2; P.ldb = EFF / 2; P.arow = EFF; P.brow = EFF; P.pshift = 4; P.btile = 128; P.nunits = (P.ntiles + NT / 256) * 16;
                pg8::EpiFp8N128 E{(unsigned char*)Y2, ND, 16.0f / (64.0f * 8.0f)};
                pg8::gemm_phase<pg8::EpiFp8N128, pg8::MoeDownProb, true, true>(F.lds, P, E); }
            else { P.K = EFF; P.ldb = EFF; P.arow = EFF * 2; P.brow = EFF * 2; P.pshift = 3; P.btile = 256; P.nunits = (P.ntiles + NT / 256) * 8;
                pg8::EpiFp8 E{(unsigned char*)Y2, ND, 16.0f};
                pg8::gemm_phase<pg8::EpiFp8, pg8::MoeDownProb, true>(F.lds, P, E); } } SEAM(pb + 12);
        if (IN(pb + 13)) { p_combine_ln2(F, X1B, (const unsigned char*)Y2, (const int*)(ws + WS_SLOT), (const float*)(ws + WS_WSEL), kin(17) + l * ND, kin(18) + l * ND, l == 0 ? X2B : nullptr, l == 0 ? nullptr : F.out); } SEAM(pb + 13);
    }
__global__ void __launch_bounds__(NWAVES * 64, 2) mk_fwd(Args args) {
    extern __shared__ __attribute__((aligned(16))) unsigned char lds[];
    Frame F;
    F.lds = (LAS unsigned char*)lds;
    F.MISC = (volatile LAS unsigned*)(F.lds + MISC_OFF);
    F.tid = threadIdx.x; F.lane = F.tid & 63; F.wave = __builtin_amdgcn_readfirstlane(F.tid >> 6);
    F.G = gridDim.x; { const int bx = blockIdx.x; F.vcu = (F.G % 8 == 0) ? (bx % 8) * (F.G / 8) + bx / 8 : bx; }
    F.gw = F.vcu * NWAVES + F.wave; F.NGW = F.G * NWAVES;
    F.ws = args.ws; F.ctl = (unsigned*)(args.ws + WS_CTL); F.out = args.out;
    for (int u = F.tid; u < (LDS_BYTES - LDSCTL_OFF) / 4; u += NWAVES * 64) ((LAS unsigned*)(F.lds + LDSCTL_OFF))[u] = 0u;
    __syncthreads();
    XcdBarrier bar; bar.bar = F.ctl + CW_BAR; bar.x = 0; bar.st = nullptr;
    if (MK_ONE_LAUNCH) bar = xcd_barrier_post(F.ctl + CW_BAR, F.MISC + 8);
    const int lo = args.ph_lo, hi = args.ph_hi;
    if (MK_PROBE_PHASE == 0 && blockIdx.x == 0 && F.tid == 0) ((volatile LAS unsigned long long*)(F.lds + LDSCTL_OFF + 64))[0] = __builtin_amdgcn_s_memrealtime();
    unsigned char* ws = args.ws;
    bf16* const XB0 = (bf16*)(ws + WS_XB0); bf16* const X1B = (bf16*)(ws + WS_X1B); bf16* const X2B = (bf16*)(ws + WS_X2B);
    bf16* const PROJ = (bf16*)(ws + WS_PROJ); bf16* const MIXIN = (bf16*)(ws + WS_MIXIN); bf16* const MIXO = (bf16*)(ws + WS_MIXO);
    bf16* const HB = (bf16*)(ws + WS_H); bf16* const Y2 = (bf16*)(ws + WS_Y2);

    if (IN(0)) { p_prologue(F); } SEAM(0);

    layer_body<0>(F, bar, lo, hi);
    layer_body<1>(F, bar, lo, hi);
    if (MK_PROBE_PHASE >= 0 && blockIdx.x == 0 && F.tid == 0) {
        volatile LAS unsigned long long* tsl = (volatile LAS unsigned long long*)(F.lds + LDSCTL_OFF + 64);
        if (MK_PROBE_LAST == 30) tsl[1] = __builtin_amdgcn_s_memrealtime();
        const unsigned long long span = (tsl[1] - tsl[0]) * MK_PROBE_AMP, t0 = __builtin_amdgcn_s_memrealtime();
        while (__builtin_amdgcn_s_memrealtime() - t0 < span) __builtin_amdgcn_s_sleep(8);
    }
#undef IN
#undef SEAM
}

extern "C" void kernel_launch(void* const* d_in, const int* in_sizes, int n_in, void* d_out, int out_size, void* d_ws, size_t ws_size, hipStream_t stream) {
    static int grid = 0;
    if (grid == 0) {
        if (n_in != 27 || in_sizes[0] != NT * ND || out_size != NT * ND || ws_size < WS_END) { fprintf(stderr, "kernel_launch: unexpected problem (n_in %d, in0 %d, out %d, ws %zu < %zu); nothing launched\n", n_in, n_in > 0 ? in_sizes[0] : -1, out_size, ws_size, (size_t)WS_END); grid = -1; return; }
        int dev = 0, cus = 0, per_cu = 0;
        if (hipGetDevice(&dev) != hipSuccess || hipDeviceGetAttribute(&cus, hipDeviceAttributeMultiprocessorCount, dev) != hipSuccess) { fprintf(stderr, "kernel_launch: device query failed\n"); grid = -1; return; }
        if (hipFuncSetAttribute((const void*)mk_fwd, hipFuncAttributeMaxDynamicSharedMemorySize, LDS_BYTES) != hipSuccess) { fprintf(stderr, "kernel_launch: hipFuncSetAttribute failed\n"); grid = -1; return; }
        if (hipOccupancyMaxActiveBlocksPerMultiprocessor(&per_cu, (const void*)mk_fwd, NWAVES * 64, LDS_BYTES) != hipSuccess || per_cu < 1) fprintf(stderr, "kernel_launch: note: occupancy query reports %d\n", per_cu);
        (void)hipGetLastError();
        grid = cus;
    }
    if (grid < 0) return;
    if (hipMemsetAsync((char*)d_ws + WS_CTL, 0, CTL_ZERO_BYTES, stream) != hipSuccess) { fprintf(stderr, "kernel_launch: memset failed\n"); return; }
    Args a{};
    for (int i = 0; i < 27; ++i) a.in[i] = (const float*)d_in[i];
    a.out = (float*)d_out; a.ws = (unsigned char*)d_ws;
#if MK_ONE_LAUNCH
    a.ph_lo = 0; a.ph_hi = NPHASE;
    hipLaunchKernelGGL(mk_fwd, dim3(grid), dim3(NWAVES * 64), LDS_BYTES, stream, a);
#else
    for (int p = 0; p < NPHASE; ++p) {
        const int lp = (p - 1) & 15;
        if (p >= 1) { const int l = (p - 1) >> 4; if (lp >= 14) continue; if (l == 0 && lp >= 3 && lp <= 5) continue; }
        a.ph_lo = p; a.ph_hi = p + 1;
        hipLaunchKernelGGL(mk_fwd, dim3(grid), dim3(NWAVES * 64), LDS_BYTES, stream, a);
    }
#endif
    const hipError_t le = hipPeekAtLastError();
    if (le != hipSuccess) fprintf(stderr, "kernel_launch: launch failed: %s\n", hipGetErrorName(le));
}
```

```cpp
#include <hip/hip_runtime.h>
#include <cstdio>
#include <cstdint>

#ifndef MK_ONE_LAUNCH
#define MK_ONE_LAUNCH 1
#endif
#ifndef MK_FP8_MOE
#define MK_FP8_MOE 1
#endif
#ifndef MK_PROBE_PHASE
#define MK_PROBE_PHASE -1
#endif
#ifndef MK_PROBE_LAST
#define MK_PROBE_LAST MK_PROBE_PHASE
#endif
#ifndef MK_PROBE_AMP
#define MK_PROBE_AMP 4
#endif

#define GAS __attribute__((address_space(1)))
#define LAS __attribute__((address_space(3)))
typedef unsigned short bf16;
typedef unsigned v4u __attribute__((ext_vector_type(4)));
typedef unsigned v2u __attribute__((ext_vector_type(2)));
typedef float f32x4 __attribute__((ext_vector_type(4)));
typedef float f32x2 __attribute__((ext_vector_type(2)));
typedef short bf16x8 __attribute__((ext_vector_type(8)));

constexpr int NB = 8, NS = 2048, ND = 2048, NT = NB * NS;
constexpr float DN_ALPHA = 1.41421356237309505f;
constexpr float LN_EPS = 1e-5f, NORM_EPS = 1e-6f;
constexpr int AB_IN = 5120, CD_IN = 3544, CD_INP = 3584;
constexpr int NEXP = 64, EFF = 512;
constexpr int MAXROWS = NT * 8 + NEXP * 256;
constexpr int MAXTILES = MAXROWS / 256;
constexpr int SH_ROW0 = MAXROWS;

constexpr size_t MiB = 1u << 20;
constexpr size_t WS_CTL = 0, CTL_ZERO_BYTES = 1 * MiB;
constexpr size_t WS_TOPE = 1 * MiB, WS_WSEL = WS_TOPE + 512 * 1024, WS_SLOT = 2 * MiB, WS_SORTED = WS_SLOT + 512 * 1024;
constexpr size_t WS_CMPB = 3 * MiB + 256 * 1024, WS_SELM = 3 * MiB + 512 * 1024;
constexpr size_t WS_KVCMP = 4 * MiB;
constexpr size_t WS_HID = 6 * MiB;
constexpr size_t WS_WABIN = 16 * MiB, WS_WABOUT = 36 * MiB, WS_WCDIN = 44 * MiB, WS_WCDOUT = 58 * MiB, WS_WUQ = 66 * MiB, WS_WUKV = 68 * MiB, WS_CW1 = 70 * MiB, WS_RT = 72 * MiB;
constexpr size_t WS_W13 = 74 * MiB, WS_W2 = 334 * MiB, WS_MOE_LSTRIDE = 390 * MiB;
constexpr size_t WS_XB0 = 854 * MiB, WS_X2B = 854 * MiB, WS_X1B = 918 * MiB;
constexpr size_t WS_H = 982 * MiB, WS_Y2 = 1142 * MiB, WS_X1F8 = 1782 * MiB, WS_END = 1814 * MiB;
constexpr size_t WS_PROJ = 982 * MiB, WS_MIXIN = 1142 * MiB, WS_MIXO = 1206 * MiB;
constexpr size_t WS_QR = 1270 * MiB, WS_KR = 1294 * MiB;
constexpr size_t WS_CQN = 1270 * MiB, WS_CKVN = 1282 * MiB, WS_KROT = 1298 * MiB, WS_QMLA = 1302 * MiB, WS_KVU = 1350 * MiB, WS_CMPKV = 1414 * MiB, WS_OCMP = 1434 * MiB;
constexpr size_t WS_LOGITS = 1142 * MiB;
constexpr int CW_TMO = 0, CW_CODE = 1, CW_BAR = 4096, CW_CNT = 16384;

constexpr int RING_BYTES = 131072, LDSCTL_OFF = RING_BYTES, MISC_OFF = LDSCTL_OFF + 320, TAB_OFF = LDSCTL_OFF + 512;
constexpr int LDS_BYTES = 147456;
constexpr int NWAVES = 8;

#define LDS_WAIT() asm volatile("s_waitcnt lgkmcnt(0)" ::: "memory")
#define VM_WAIT() asm volatile("s_waitcnt vmcnt(0)" ::: "memory")
typedef __bf16 hwbf16x2 __attribute__((ext_vector_type(2)));
__device__ __forceinline__ unsigned pk2(float lo, float hi) { const f32x2 v = {lo, hi}; const hwbf16x2 b = __builtin_convertvector(v, hwbf16x2); return __builtin_bit_cast(unsigned, b); }
__device__ __forceinline__ unsigned f2bf(float f) { return pk2(f, 0.f) & 0xffffu; }
__device__ __forceinline__ void fast_sincos(float ang, float& sn, float& cs) { const float r = __builtin_amdgcn_fractf(ang * 0.15915494309189535f); sn = __builtin_amdgcn_sinf(r); cs = __builtin_amdgcn_cosf(r); }
__device__ __forceinline__ float bflo(unsigned w) { return __builtin_bit_cast(float, w << 16); }
__device__ __forceinline__ float bfhi(unsigned w) { return __builtin_bit_cast(float, w & 0xffff0000u); }
__device__ __forceinline__ float bf1(bf16 v) { return __builtin_bit_cast(float, ((unsigned)v) << 16); }
__device__ __forceinline__ float wave_sum(float v) {
#pragma unroll
    for (int o = 1; o < 64; o <<= 1) v += __shfl_xor(v, o);
    return v;
}
__device__ __forceinline__ float wave_max(float v) {
#pragma unroll
    for (int o = 1; o < 64; o <<= 1) v = fmaxf(v, __shfl_xor(v, o));
    return v;
}
__device__ __forceinline__ float sigmoidf_(float x) { return 1.0f / (1.0f + __expf(-x)); }
__device__ __forceinline__ float siluf_(float x) { return x / (1.0f + __expf(-x)); }
__device__ __forceinline__ void unpack8(const v4u w, float (&f)[8]) {
    f[0] = bflo(w.x); f[1] = bfhi(w.x); f[2] = bflo(w.y); f[3] = bfhi(w.y); f[4] = bflo(w.z); f[5] = bfhi(w.z); f[6] = bflo(w.w); f[7] = bfhi(w.w);
}

#define XB_TMO      128
#define XB_XCNT(j)  (256  + 64 * (j))
#define XB_XSUB(j)  (1280 + 64 * (j))
#define XB_XGEN(j)  (2304 + 64 * (j))
#define XB_TOP      3328
#define XB_TOPGEN   3392
#define XCD_BAR_WORDS 3456
#define XB_SPIN_CAP (1u << 18)
__device__ __forceinline__ unsigned xb_ld(unsigned* p)              { return __hip_atomic_load(p, __ATOMIC_RELAXED, __HIP_MEMORY_SCOPE_AGENT); }
__device__ __forceinline__ unsigned xb_add(unsigned* p, unsigned v) { return __hip_atomic_fetch_add(p, v, __ATOMIC_RELAXED, __HIP_MEMORY_SCOPE_AGENT); }
__device__ __forceinline__ unsigned xb_xcc_id() { return (unsigned)__builtin_amdgcn_s_getreg((3 << 11) | 20) & 0xFu; }
#define XB_SPIN(cond, bar) do { unsigned _sp = 0; while (cond) { __builtin_amdgcn_s_sleep(1); \
    if ((++_sp & 255u) == 0u) { if (xb_ld(&(bar)[XB_TMO])) break; if (_sp > XB_SPIN_CAP) { atomicAdd(&(bar)[XB_TMO], 1u); break; } } } } while (0)
struct XcdBarrier { unsigned* bar; unsigned x; volatile LAS unsigned* st; };
__device__ __forceinline__ XcdBarrier xcd_barrier_post(unsigned* bar, volatile LAS unsigned* st) {
    XcdBarrier b; b.bar = bar; b.x = xb_xcc_id(); b.st = st;
    if (threadIdx.x == 0) (void)xb_add(&bar[XB_XCNT(b.x)], 1u);
    return b;
}
__device__ __forceinline__ void xcd_barrier_complete(unsigned* bar, unsigned x, unsigned& nloc, unsigned& nx) {
    const unsigned G = gridDim.x * gridDim.y * gridDim.z;
    unsigned sum, cnt, mine, sp = 0u;
    for (;;) {
        sum = 0u; cnt = 0u; mine = 0u;
#pragma unroll
        for (unsigned j = 0; j < 16; ++j) { const unsigned c = xb_ld(&bar[XB_XCNT(j)]); sum += c; cnt += (c > 0u) ? 1u : 0u; mine = (j == x) ? c : mine; }
        if (sum == G) break;
        __builtin_amdgcn_s_sleep(1);
        if ((++sp & 255u) == 0u) { if (xb_ld(&bar[XB_TMO])) break; if (sp > XB_SPIN_CAP) { atomicAdd(&bar[XB_TMO], 1u); break; } }
    }
    nloc = mine > 0u ? mine : 1u; nx = cnt > 0u ? cnt : 1u;
}
__device__ __forceinline__ void xcd_barrier(const XcdBarrier& b) {
    asm volatile("s_waitcnt vmcnt(0)" ::: "memory");
    __syncthreads();
    if (threadIdx.x == 0) {
        unsigned* bar = b.bar;
        __builtin_amdgcn_s_waitcnt(0);
        unsigned nloc = b.st[0], nx = b.st[1];
        if (nloc == 0u) { xcd_barrier_complete(bar, b.x, nloc, nx); b.st[0] = nloc; b.st[1] = nx; }
        const unsigned old = xb_add(&bar[XB_XSUB(b.x)], 1u);
        const unsigned gen = old / nloc;
        if (old + 1u == (gen + 1u) * nloc) {
            __builtin_amdgcn_fence(__ATOMIC_RELEASE, "agent");
            asm volatile("s_waitcnt vmcnt(0)" ::: "memory");
            const unsigned og = xb_add(&bar[XB_TOP], 1u);
            const unsigned tg = og / nx;
            if (og + 1u == (tg + 1u) * nx) xb_add(&bar[XB_TOPGEN], 1u);
            else XB_SPIN(xb_ld(&bar[XB_TOPGEN]) == tg, bar);
            __builtin_amdgcn_fence(__ATOMIC_ACQUIRE, "agent");
            xb_add(&bar[XB_XGEN(b.x)], 1u);
            asm volatile("s_waitcnt vmcnt(0)" ::: "memory");
        } else {
            XB_SPIN(xb_ld(&bar[XB_XGEN(b.x)]) == gen, bar);
            __builtin_amdgcn_fence(__ATOMIC_ACQUIRE, "agent");
            asm volatile("s_waitcnt vmcnt(0)" ::: "memory");
        }
    }
    __syncthreads();
}

namespace pg8 {
typedef int v4i_t __attribute__((ext_vector_type(4)));
constexpr int BM = 256, BK = 64, HALF = 128, HTB = HALF * BK * 2, STAGE_BYTES = 8 * HTB, NXCD = 8, WGM = 8;
__host__ __device__ __forceinline__ int lds_byte(int r, int c) { const int st = (r >> 4) * 2 + (c >> 5), rr = r & 15, cc = c & 31, ob = rr * 64 + cc * 2; return st * 1024 + (ob ^ (((ob >> 9) & 1) << 5)); }
__host__ __device__ __forceinline__ void stage_rc(int b, int& R, int& C) { const int st = b / 1024, sb = b % 1024, swz = sb ^ (((sb >> 9) & 1) << 5); R = (st >> 1) * 16 + swz / 64; C = (st & 1) * 32 + (swz % 64) / 2; }
__host__ __device__ __forceinline__ int perm32(int rho) { const int n = rho >> 4, i = rho & 15; return 8 * (i >> 2) + 4 * n + (i & 3); }
struct Unit { int pm, pn, e; };

__device__ __forceinline__ unsigned cvt_pk_bf16(float lo, float hi) { unsigned r; asm volatile("v_cvt_pk_bf16_f32 %0, %1, %2" : "=v"(r) : "v"(lo), "v"(hi)); return r; }

struct EpiBf16 {
    static constexpr bool PERM = true;
    bf16* O; int ldc;
    __device__ __forceinline__ void operator()(const f32x4 (&acc)[2][2][4][2], const Unit& u, int wr, int wc, int fr, int fq) const {
        const int row0 = u.pm * BM + wr * 64 + fr, col0 = u.pn * BM + wc * 32 + 8 * fq;
#pragma unroll
        for (int ai = 0; ai < 2; ++ai)
#pragma unroll
            for (int m = 0; m < 4; ++m) { bf16* rowp = O + (size_t)(row0 + ai * HALF + m * 16) * ldc + col0;
#pragma unroll
                for (int bj = 0; bj < 2; ++bj) { const f32x4 v0 = acc[ai][bj][m][0], v1 = acc[ai][bj][m][1];
                    v4u w; w.x = cvt_pk_bf16(v0[0], v0[1]); w.y = cvt_pk_bf16(v0[2], v0[3]); w.z = cvt_pk_bf16(v1[0], v1[1]); w.w = cvt_pk_bf16(v1[2], v1[3]);
                    *(v4u*)(rowp + bj * HALF) = w; } }
    }
};
struct EpiFp8 {
    static constexpr bool PERM = true;
    unsigned char* O; int ldc; float mul;
    __device__ __forceinline__ void operator()(const f32x4 (&acc)[2][2][4][2], const Unit& u, int wr, int wc, int fr, int fq) const {
        const int row0 = u.pm * BM + wr * 64 + fr, col0 = u.pn * BM + wc * 32 + 8 * fq;
#pragma unroll
        for (int ai = 0; ai < 2; ++ai)
#pragma unroll
            for (int m = 0; m < 4; ++m) { unsigned char* rowp = O + (size_t)(row0 + ai * HALF + m * 16) * ldc + col0;
#pragma unroll
                for (int bj = 0; bj < 2; ++bj) { float v[8];
#pragma unroll
                    for (int n = 0; n < 2; ++n)
#pragma unroll
                        for (int j = 0; j < 4; ++j) v[n * 4 + j] = fminf(fmaxf(acc[ai][bj][m][n][j] * mul, -448.0f), 448.0f);
                    int w0 = __builtin_amdgcn_cvt_pk_fp8_f32(v[0], v[1], 0, false); w0 = __builtin_amdgcn_cvt_pk_fp8_f32(v[2], v[3], w0, true);
                    int w1 = __builtin_amdgcn_cvt_pk_fp8_f32(v[4], v[5], 0, false); w1 = __builtin_amdgcn_cvt_pk_fp8_f32(v[6], v[7], w1, true);
                    *(v2u*)(rowp + bj * HALF) = (v2u){(unsigned)w0, (unsigned)w1}; } }
    }
};
struct EpiF32 {
    static constexpr bool PERM = false;
    float* C; int ldc; const float* bias;
    __device__ __forceinline__ void operator()(const f32x4 (&acc)[2][2][4][2], const Unit& u, int wr, int wc, int fr, int fq) const {
        const int row0 = u.pm * BM + wr * 64 + fr, col0 = u.pn * BM + wc * 32 + 4 * fq;
        f32x4 bv[2][2];
#pragma unroll
        for (int bj = 0; bj < 2; ++bj)
#pragma unroll
            for (int n = 0; n < 2; ++n) bv[bj][n] = bias ? *(const f32x4*)(bias + col0 + bj * HALF + n * 16) : (f32x4){0.f, 0.f, 0.f, 0.f};
#pragma unroll
        for (int ai = 0; ai < 2; ++ai)
#pragma unroll
            for (int m = 0; m < 4; ++m) { float* rowp = C + (size_t)(row0 + ai * HALF + m * 16) * ldc + col0;
#pragma unroll
                for (int bj = 0; bj < 2; ++bj)
#pragma unroll
                    for (int n = 0; n < 2; ++n) *(f32x4*)(rowp + bj * HALF + n * 16) = acc[ai][bj][m][n] + bv[bj][n]; }
    }
};
struct EpiSwiglu {
    static constexpr bool PERM = true;
    bf16* H;
    __device__ __forceinline__ void operator()(const f32x4 (&acc)[2][2][4][2], const Unit& u, int wr, int wc, int fr, int fq) const {
        const int row0 = u.pm * BM + wr * 64 + fr, col0 = u.pn * HALF + wc * 32 + 8 * fq;
#pragma unroll
        for (int ai = 0; ai < 2; ++ai)
#pragma unroll
            for (int m = 0; m < 4; ++m) { bf16* rowp = H + (size_t)(row0 + ai * HALF + m * 16) * EFF + col0;
                float o[8];
#pragma unroll
                for (int n = 0; n < 2; ++n)
#pragma unroll
                    for (int j = 0; j < 4; ++j) { const float h1 = acc[ai][0][m][n][j], h3 = acc[ai][1][m][n][j]; o[n * 4 + j] = siluf_(h1) * h3; }
                v4u w; w.x = cvt_pk_bf16(o[0], o[1]); w.y = cvt_pk_bf16(o[2], o[3]); w.z = cvt_pk_bf16(o[4], o[5]); w.w = cvt_pk_bf16(o[6], o[7]);
                *(v4u*)rowp = w; }
    }
};

template <class Epi, class Prob, bool ALIGN_EPI, bool F8 = false>
__device__ __forceinline__ void gemm_phase(LAS unsigned char* lds, const Prob& P, const Epi& E) {
    const int tid = threadIdx.x, wid = __builtin_amdgcn_readfirstlane(tid >> 6), lane = tid & 63, wr = wid >> 2, wc = wid & 3, fr = lane & 15, fq = lane >> 4;
    const int K = P.K, nt = K / BK, ldb = P.ldb;
    unsigned voffB[2];
#pragma unroll
    for (int i = 0; i < 2; ++i) { int R, C; stage_rc(tid * 16 + i * 8192, R, C); const int Rb = Epi::PERM ? ((R & ~31) + perm32(R & 31)) : R;
        voffB[i] = (unsigned)(Rb * ldb + C) * 2u; }
    const size_t kstep = (size_t)(BK * 2);
    const size_t hstep = (size_t)HALF * ldb * 2;
    const unsigned ldsw = (unsigned)wid * 1024u;
    const int aoff = lds_byte(wr * 64 + fr, fq * 8), boff = lds_byte(wc * 32 + fr, fq * 8);
    const char* const Ab = P.Abase;
#define PG8_SA(b, h) (((b) * 2 + (h)) * HTB)
#define PG8_SB(b, h) ((4 + (b) * 2 + (h)) * HTB)
#define PG8_STAGE(bufoff, gbase, voff) do { _Pragma("unroll") for (int _i = 0; _i < 2; ++_i) \
        __builtin_amdgcn_global_load_lds((const unsigned*)((const char*)(gbase) + (voff)[_i]), (LAS unsigned*)(lds + (bufoff) + ldsw + _i * 8192), 16, 0, 0); } while (0)
#define PG8_STAGE_A(bufoff, kb, o0, o1) do { \
        __builtin_amdgcn_global_load_lds((const unsigned*)(Ab + (kb) + (o0)), (LAS unsigned*)(lds + (bufoff) + ldsw), 16, 0, 0); \
        __builtin_amdgcn_global_load_lds((const unsigned*)(Ab + (kb) + (o1)), (LAS unsigned*)(lds + (bufoff) + ldsw + 8192), 16, 0, 0); } while (0)
#define PG8_LDA(dst, b, h) do { _Pragma("unroll") for (int m = 0; m < 4; ++m) _Pragma("unroll") for (int k = 0; k < 2; ++k) dst[m][k] = *(const LAS bf16x8*)(lds + PG8_SA(b, h) + aoff + m * 2048 + k * 1024); } while (0)
#define PG8_LDB(dst, b, h) do { _Pragma("unroll") for (int n = 0; n < 2; ++n) _Pragma("unroll") for (int k = 0; k < 2; ++k) dst[n][k] = *(const LAS bf16x8*)(lds + PG8_SB(b, h) + boff + n * 2048 + k * 1024); } while (0)
#define PG8_CAT(lo, hi) __builtin_shufflevector(__builtin_bit_cast(v4i_t, lo), __builtin_bit_cast(v4i_t, hi), 0, 1, 2, 3, 4, 5, 6, 7)
#define PG8_MMA(ai, bj, At, Bt) do { __builtin_amdgcn_s_setprio(1); \
        if constexpr (F8) { _Pragma("unroll") for (int m = 0; m < 4; ++m) _Pragma("unroll") for (int n = 0; n < 2; ++n) \
            acc[ai][bj][m][n] = __builtin_amdgcn_mfma_scale_f32_16x16x128_f8f6f4(PG8_CAT(Bt[n][0], Bt[n][1]), PG8_CAT(At[m][0], At[m][1]), acc[ai][bj][m][n], 0, 0, 0, 0x7F7F7F7F, 0, 0x7F7F7F7F); } \
        else { _Pragma("unroll") for (int m = 0; m < 4; ++m) _Pragma("unroll") for (int n = 0; n < 2; ++n) _Pragma("unroll") for (int k = 0; k < 2; ++k) \
            acc[ai][bj][m][n] = __builtin_amdgcn_mfma_f32_16x16x32_bf16(Bt[n][k], At[m][k], acc[ai][bj][m][n], 0, 0, 0); } \
        __builtin_amdgcn_s_setprio(0); } while (0)
#define PG8_WAIT_V(n) asm volatile("s_waitcnt vmcnt(" #n ")" ::: "memory")
#define PG8_WAIT_L(n) asm volatile("s_waitcnt lgkmcnt(" #n ")" ::: "memory")
#define PG8_BAR __builtin_amdgcn_s_barrier()
#define PG8_SCHED __builtin_amdgcn_sched_barrier(0)
    Unit cur, nxt; int ui = 0;
    if (!P.next(0, cur)) return;
    f32x4 acc[2][2][4][2];
#pragma unroll
    for (int a = 0; a < 2; ++a)
#pragma unroll
        for (int b = 0; b < 2; ++b)
#pragma unroll
            for (int m = 0; m < 4; ++m)
#pragma unroll
                for (int n = 0; n < 2; ++n) acc[a][b][m][n] = (f32x4){0.f, 0.f, 0.f, 0.f};
    bf16x8 At[4][2], B0[2][2], B1[2][2];
    unsigned oc[4], on[4];
    { int RA[2], CA[2]; stage_rc(tid * 16, RA[0], CA[0]); stage_rc(tid * 16 + 8192, RA[1], CA[1]); P.aoffs(cur, RA, CA, oc); }
    const char* cB = P.bbase(cur);
    if constexpr (F8) {
        PG8_STAGE(PG8_SB(0, 0), cB, voffB); PG8_STAGE_A(PG8_SA(0, 0), (size_t)0, oc[0], oc[1]); PG8_STAGE_A(PG8_SA(0, 1), (size_t)0, oc[2], oc[3]);
        if (wr == 1) PG8_BAR;
        PG8_WAIT_V(2); PG8_BAR;
        PG8_STAGE(PG8_SB(1, 0), cB + kstep, voffB); PG8_STAGE_A(PG8_SA(1, 0), kstep, oc[0], oc[1]);
        PG8_WAIT_V(4); PG8_BAR;
    } else {
    PG8_STAGE(PG8_SB(0, 0), cB, voffB); PG8_STAGE(PG8_SB(0, 1), cB + hstep, voffB); PG8_STAGE_A(PG8_SA(0, 0), (size_t)0, oc[0], oc[1]); PG8_STAGE_A(PG8_SA(0, 1), (size_t)0, oc[2], oc[3]);
    if (wr == 1) PG8_BAR;
    PG8_WAIT_V(2); PG8_BAR;
    PG8_STAGE(PG8_SB(1, 0), cB + kstep, voffB); PG8_STAGE_A(PG8_SA(1, 0), kstep, oc[0], oc[1]); PG8_STAGE(PG8_SB(1, 1), cB + hstep + kstep, voffB);
    PG8_WAIT_V(6); PG8_BAR;
    }
    for (;;) {
        const bool has_next = P.next(ui + 1, nxt);
        const char* nB = cB;
        if (has_next) { int RA[2], CA[2]; stage_rc(tid * 16, RA[0], CA[0]); stage_rc(tid * 16 + 8192, RA[1], CA[1]); P.aoffs(nxt, RA, CA, on); nB = P.bbase(nxt); }
        else { on[0] = oc[0]; on[1] = oc[1]; on[2] = oc[2]; on[3] = oc[3]; }
#pragma clang loop unroll(disable)
        for (int t = 0; t < nt; t += 2) {
            const bool last = (t == nt - 2);
            const size_t kb1 = (size_t)(t + 1) * kstep;
            const size_t kb2 = last ? (size_t)0 : (size_t)(t + 2) * kstep, kb3 = kb2 + kstep;
            const char* b2 = last ? nB : cB + (size_t)(t + 2) * kstep; const char* b3 = b2 + kstep;
            const unsigned o20 = last ? on[0] : oc[0], o21 = last ? on[1] : oc[1], o22 = last ? on[2] : oc[2], o23 = last ? on[3] : oc[3];
            if constexpr (F8) {
            PG8_LDB(B0, 0, 0); PG8_SCHED; PG8_LDA(At, 0, 0); PG8_STAGE_A(PG8_SA(1, 1), kb1, oc[2], oc[3]);
            PG8_WAIT_V(6); PG8_WAIT_L(0); PG8_BAR; PG8_MMA(0, 0, At, B0); PG8_BAR; PG8_SCHED;
            PG8_LDA(At, 0, 1); PG8_STAGE(PG8_SB(0, 0), b2, voffB); PG8_STAGE_A(PG8_SA(0, 0), kb2, o20, o21);
            PG8_WAIT_V(6); PG8_WAIT_L(0); PG8_BAR; PG8_MMA(1, 0, At, B0); PG8_BAR; PG8_SCHED;
            PG8_LDB(B0, 1, 0); PG8_SCHED; PG8_LDA(At, 1, 0); PG8_STAGE_A(PG8_SA(0, 1), kb2, o22, o23);
            PG8_WAIT_V(6); PG8_WAIT_L(0); PG8_BAR; PG8_MMA(0, 0, At, B0); PG8_BAR; PG8_SCHED;
            PG8_LDA(At, 1, 1); PG8_STAGE(PG8_SB(1, 0), b3, voffB); PG8_STAGE_A(PG8_SA(1, 0), kb3, o20, o21);
            PG8_WAIT_V(6); PG8_WAIT_L(0); PG8_BAR; PG8_MMA(1, 0, At, B0); PG8_BAR; PG8_SCHED;
            } else {
            PG8_LDB(B0, 0, 0); PG8_LDB(B1, 0, 1); PG8_SCHED; PG8_LDA(At, 0, 0); PG8_STAGE_A(PG8_SA(1, 1), kb1, oc[2], oc[3]);
            PG8_WAIT_V(8); PG8_WAIT_L(0); PG8_BAR; PG8_MMA(0, 0, At, B0); PG8_MMA(0, 1, At, B1); PG8_BAR; PG8_SCHED;
            PG8_LDA(At, 0, 1); PG8_STAGE(PG8_SB(0, 0), b2, voffB); PG8_STAGE(PG8_SB(0, 1), b2 + hstep, voffB); PG8_STAGE_A(PG8_SA(0, 0), kb2, o20, o21);
            PG8_WAIT_V(8); PG8_WAIT_L(0); PG8_BAR; PG8_MMA(1, 0, At, B0); PG8_MMA(1, 1, At, B1); PG8_BAR; PG8_SCHED;
            PG8_LDB(B0, 1, 0); PG8_LDB(B1, 1, 1); PG8_SCHED; PG8_LDA(At, 1, 0); PG8_STAGE_A(PG8_SA(0, 1), kb2, o22, o23);
            PG8_WAIT_V(8); PG8_WAIT_L(0); PG8_BAR; PG8_MMA(0, 0, At, B0); PG8_MMA(0, 1, At, B1); PG8_BAR; PG8_SCHED;
            PG8_LDA(At, 1, 1); PG8_STAGE(PG8_SB(1, 0), b3, voffB); PG8_STAGE(PG8_SB(1, 1), b3 + hstep, voffB); PG8_STAGE_A(PG8_SA(1, 0), kb3, o20, o21);
            PG8_WAIT_V(8); PG8_WAIT_L(0); PG8_BAR; PG8_MMA(1, 0, At, B0); PG8_MMA(1, 1, At, B1); PG8_BAR; PG8_SCHED;
            }
        }
        if constexpr (ALIGN_EPI) { if (wr == 0) PG8_BAR; }
        E(acc, cur, wr, wc, fr, fq);
        if (!has_next) break;
#pragma unroll
        for (int a = 0; a < 2; ++a)
#pragma unroll
            for (int b = 0; b < 2; ++b)
#pragma unroll
                for (int m = 0; m < 4; ++m)
#pragma unroll
                    for (int n = 0; n < 2; ++n) acc[a][b][m][n] = (f32x4){0.f, 0.f, 0.f, 0.f};
        cur = nxt; cB = nB; oc[0] = on[0]; oc[1] = on[1]; oc[2] = on[2]; oc[3] = on[3]; ++ui;
        if constexpr (ALIGN_EPI) { if (wr == 1) PG8_BAR; }
    }
    PG8_WAIT_V(0);
    if constexpr (!ALIGN_EPI) { if (wr == 0) PG8_BAR; }
    PG8_BAR;
#undef PG8_SA
#undef PG8_SB
#undef PG8_STAGE
#undef PG8_STAGE_A
#undef PG8_LDA
#undef PG8_LDB
#undef PG8_MMA
#undef PG8_CAT
#undef PG8_WAIT_V
#undef PG8_WAIT_L
#undef PG8_BAR
#undef PG8_SCHED
}

struct DenseProb {
    int K, ldb; const char* Abase; const char* Bt; int lda; int nM, nN, nwg, G, c;
    __device__ __forceinline__ void init(const bf16* A, int lda_, const bf16* B, int M, int N, int K_, int G_, int c_) { Abase = (const char*)A; Bt = (const char*)B; lda = lda_; K = K_; ldb = K_; nM = M / BM; nN = N / BM; nwg = nM * nN; G = G_; c = c_; }
    __device__ __forceinline__ bool next(int i, Unit& u) const {
        const long L = (long)i * G + c; if (L >= nwg) return false;
        int wgid = (int)L; { const int q = nwg / NXCD, r = nwg % NXCD, xcd = wgid % NXCD, off = wgid / NXCD; wgid = (xcd < r ? xcd * (q + 1) : r * (q + 1) + (xcd - r) * q) + off; }
        const int nig = WGM * nN, gid = wgid / nig, fm = gid * WGM, gsz = (nM - fm) < WGM ? (nM - fm) : WGM;
        u.pm = fm + ((wgid % nig) % gsz); u.pn = (wgid % nig) / gsz; u.e = 0; return true;
    }
    __device__ __forceinline__ const char* bbase(const Unit& u) const { return Bt + (size_t)u.pn * BM * K * 2; }
    __device__ __forceinline__ void aoffs(const Unit& u, const int (&R)[2], const int (&C)[2], unsigned (&o)[4]) const {
#pragma unroll
        for (int h = 0; h < 2; ++h)
#pragma unroll
            for (int i = 0; i < 2; ++i) o[2 * h + i] = (unsigned)(((size_t)(u.pm * BM + h * HALF + R[i]) * lda + C[i]) * 2);
    }
};
__device__ __forceinline__ bool xcd_range_unit(int i, int nunits, int G, int c, int& L) {
    const int x = c % NXCD, cc = c / NXCD, per = G / NXCD, q = nunits / NXCD, r = nunits % NXCD;
    const int start = x * q + (x < r ? x : r), cnt = q + (x < r ? 1 : 0), li = i * per + cc;
    if (li >= cnt) return false; L = start + li; return true;
}
struct MoeUpProb {
    int K, ldb; int arow, brow;
    int pshift, btile;
    const char* Abase; const char* W13; const int* sorted; const LAS int* tile_e; int ntiles, nunits, G, c;
    __device__ __forceinline__ bool next(int i, Unit& u) const {
        int L; if (!xcd_range_unit(i, nunits, G, c, L)) return false;
        const int tile = L >> pshift; u.pn = L & ((1 << pshift) - 1);
        if (tile < ntiles) { u.pm = tile; u.e = __builtin_amdgcn_readfirstlane(tile_e[tile]); } else { u.pm = MAXTILES + (tile - ntiles); u.e = NEXP; }
        return true;
    }
    __device__ __forceinline__ const char* bbase(const Unit& u) const { return W13 + ((size_t)u.e * 1024 + (size_t)u.pn * btile) * brow; }
    __device__ __forceinline__ void aoffs(const Unit& u, const int (&R)[2], const int (&C)[2], unsigned (&o)[4]) const {
#pragma unroll
        for (int h = 0; h < 2; ++h)
#pragma unroll
            for (int i = 0; i < 2; ++i) { int row;
                if (u.e == NEXP) row = (u.pm - MAXTILES) * BM + h * HALF + R[i];
                else row = sorted[u.pm * BM + h * HALF + R[i]];
                o[2 * h + i] = (unsigned)((size_t)row * arow + C[i] * 2); }
    }
};
struct MoeDownProb {
    int K, ldb; int arow, brow, pshift, btile; const char* Abase; const char* W2; const LAS int* tile_e; int ntiles, nunits, G, c;
    __device__ __forceinline__ bool next(int i, Unit& u) const {
        int L; if (!xcd_range_unit(i, nunits, G, c, L)) return false;
        const int tile = L >> pshift; u.pn = L & ((1 << pshift) - 1);
        if (tile < ntiles) { u.pm = tile; u.e = __builtin_amdgcn_readfirstlane(tile_e[tile]); } else { u.pm = MAXTILES + (tile - ntiles); u.e = NEXP; }
        return true;
    }
    __device__ __forceinline__ const char* bbase(const Unit& u) const { return W2 + ((size_t)u.e * 2048 + (size_t)u.pn * btile) * brow; }
    __device__ __forceinline__ void aoffs(const Unit& u, const int (&R)[2], const int (&C)[2], unsigned (&o)[4]) const {
#pragma unroll
        for (int h = 0; h < 2; ++h)
#pragma unroll
            for (int i = 0; i < 2; ++i) o[2 * h + i] = (unsigned)((size_t)(u.pm * BM + h * HALF + R[i]) * arow + C[i] * 2);
    }
};
struct CmpProb {
    int K, ldb; const char* Abase; const char* Bt; int G, c;
    __device__ __forceinline__ bool next(int i, Unit& u) const { const int L = i * G + c; if (L >= 16) return false; u.pm = L; u.pn = 0; u.e = 0; return true; }
    __device__ __forceinline__ const char* bbase(const Unit&) const { return Bt; }
    __device__ __forceinline__ void aoffs(const Unit& u, const int (&R)[2], const int (&C)[2], unsigned (&o)[4]) const {
#pragma unroll
        for (int h = 0; h < 2; ++h)
#pragma unroll
            for (int i = 0; i < 2; ++i) { const int m = u.pm * BM + h * HALF + R[i], seq = m >> 7, n = m & 127;
                o[2 * h + i] = (unsigned)((((size_t)seq * NS + 16 * n) * 128 + C[i]) * 2); }
    }
};
struct RouterProb {
    int K, ldb; const char* Abase; const char* Bt; int G, c;
    __device__ __forceinline__ bool next(int i, Unit& u) const { const int L = i * G + c; if (L >= (NT / BM) * 4) return false; u.pm = L >> 2; u.pn = 0; u.e = L & 3; return true; }
    __device__ __forceinline__ const char* bbase(const Unit& u) const { return Bt + (size_t)u.e * 512 * 2; }
    __device__ __forceinline__ void aoffs(const Unit& u, const int (&R)[2], const int (&C)[2], unsigned (&o)[4]) const {
#pragma unroll
        for (int h = 0; h < 2; ++h)
#pragma unroll
            for (int i = 0; i < 2; ++i) o[2 * h + i] = (unsigned)(((size_t)(u.pm * BM + h * HALF + R[i]) * ND + u.e * 512 + C[i]) * 2);
    }
};
struct EpiF32N64 {
    static constexpr bool PERM = false;
    float* C;
    __device__ __forceinline__ void operator()(const f32x4 (&acc)[2][2][4][2], const Unit& u, int wr, int wc, int fr, int fq) const {
        if (wc >= 2) return;
        const int row0 = u.pm * BM + wr * 64 + fr, col0 = wc * 32 + 4 * fq;
#pragma unroll
        for (int ai = 0; ai < 2; ++ai)
#pragma unroll
            for (int m = 0; m < 4; ++m) { float* rowp = C + ((size_t)u.e * NT + row0 + ai * HALF + m * 16) * 64 + col0;
#pragma unroll
                for (int n = 0; n < 2; ++n) *(f32x4*)(rowp + n * 16) = acc[ai][0][m][n]; }
    }
};
struct EpiSwigluF8 {
    static constexpr bool PERM = true;
    unsigned char* H; float inmul;
    __device__ __forceinline__ void operator()(const f32x4 (&acc)[2][2][4][2], const Unit& u, int wr, int wc, int fr, int fq) const {
        const int row0 = u.pm * BM + wr * 64 + fr, col0 = u.pn * 64 + wc * 16 + 4 * fq;
#pragma unroll
        for (int ai = 0; ai < 2; ++ai)
#pragma unroll
            for (int m = 0; m < 4; ++m) { unsigned char* rowp = H + (size_t)(row0 + ai * HALF + m * 16) * EFF + col0;
                float o[4];
#pragma unroll
                for (int j = 0; j < 4; ++j) { const float h1 = acc[ai][0][m][0][j] * inmul, h3 = acc[ai][0][m][1][j] * inmul; o[j] = fminf(fmaxf(siluf_(h1) * h3 * 8.0f, -448.0f), 448.0f); }
                int w0 = __builtin_amdgcn_cvt_pk_fp8_f32(o[0], o[1], 0, false); w0 = __builtin_amdgcn_cvt_pk_fp8_f32(o[2], o[3], w0, true);
                *(unsigned*)rowp = (unsigned)w0; }
    }
};
struct EpiFp8N128 {
    static constexpr bool PERM = true;
    unsigned char* O; int ldc; float mul;
    __device__ __forceinline__ void operator()(const f32x4 (&acc)[2][2][4][2], const Unit& u, int wr, int wc, int fr, int fq) const {
        const int row0 = u.pm * BM + wr * 64 + fr, col0 = u.pn * HALF + wc * 32 + 8 * fq;
#pragma unroll
        for (int ai = 0; ai < 2; ++ai)
#pragma unroll
            for (int m = 0; m < 4; ++m) { unsigned char* rowp = O + (size_t)(row0 + ai * HALF + m * 16) * ldc + col0; float v[8];
#pragma unroll
                for (int n = 0; n < 2; ++n)
#pragma unroll
                    for (int j = 0; j < 4; ++j) v[n * 4 + j] = fminf(fmaxf(acc[ai][0][m][n][j] * mul, -448.0f), 448.0f);
                int w0 = __builtin_amdgcn_cvt_pk_fp8_f32(v[0], v[1], 0, false); w0 = __builtin_amdgcn_cvt_pk_fp8_f32(v[2], v[3], w0, true);
                int w1 = __builtin_amdgcn_cvt_pk_fp8_f32(v[4], v[5], 0, false); w1 = __builtin_amdgcn_cvt_pk_fp8_f32(v[6], v[7], w1, true);
                *(v2u*)rowp = (v2u){(unsigned)w0, (unsigned)w1}; }
    }
};
}

struct Args { const float* in[27]; float* out; unsigned char* ws; int ph_lo, ph_hi; };
typedef const __attribute__((address_space(4))) Args* CArgs;
__device__ __forceinline__ const float* kin(int i) { CArgs p = (CArgs)__builtin_amdgcn_kernarg_segment_ptr(); asm volatile("" : "+s"(p)); return p->in[i]; }
struct Frame {
    LAS unsigned char* lds;
    volatile LAS unsigned* MISC;
    unsigned* ctl;
    unsigned char* ws;
    int tid, lane, wave, vcu, G, gw, NGW;
    float* out;
};

__device__ __forceinline__ void tr_item(const float* W, int ldw, int k0, int n0, int nvalid, bf16* WT, int ldt, int drow0, LAS float* scr, int lane) {
    float v[32]; const int n = lane & 31; const bool okn = n < nvalid; const float* src = W + (size_t)(k0 + (lane >> 5)) * ldw + n0 + n;
#pragma unroll
    for (int i = 0; i < 32; ++i) v[i] = okn ? src[(size_t)(2 * i) * ldw] : 0.f;
#pragma unroll
    for (int i = 0; i < 32; ++i) scr[(2 * i + (lane >> 5)) * 33 + n] = v[i];
    LDS_WAIT(); asm volatile("" ::: "memory");
    const int c = lane & 7;
#pragma unroll
    for (int j = 0; j < 4; ++j) { const int nn = (lane >> 3) + 8 * j; const LAS float* sp = scr + (8 * c) * 33 + nn;
        v4u o; o.x = pk2(sp[0 * 33], sp[1 * 33]); o.y = pk2(sp[2 * 33], sp[3 * 33]); o.z = pk2(sp[4 * 33], sp[5 * 33]); o.w = pk2(sp[6 * 33], sp[7 * 33]);
        if (nn < nvalid) *(v4u*)(WT + (size_t)(drow0 + nn) * ldt + k0 + 8 * c) = o; }
    LDS_WAIT(); asm volatile("" ::: "memory");
}
__device__ __forceinline__ void tr_item_f8(const float* W, int ldw, int k0, int n0, unsigned char* WT8, int ldt, int drow0, int rowmode, float mul, LAS float* scr, int lane) {
    float v[32]; const int n = lane & 31; const float* src = W + (size_t)(k0 + (lane >> 5)) * ldw + n0 + n;
#pragma unroll
    for (int i = 0; i < 32; ++i) v[i] = src[(size_t)(2 * i) * ldw];
#pragma unroll
    for (int i = 0; i < 32; ++i) scr[(2 * i + (lane >> 5)) * 33 + n] = v[i];
    LDS_WAIT(); asm volatile("" ::: "memory");
    const int c = lane & 3;
#pragma unroll
    for (int j = 0; j < 2; ++j) { const int nn = (lane >> 2) + 16 * j; const LAS float* sp = scr + (16 * c) * 33 + nn; int w[4];
#pragma unroll
        for (int q = 0; q < 4; ++q) { const float a0 = fminf(fmaxf(sp[(4 * q + 0) * 33] * mul, -448.f), 448.f), a1 = fminf(fmaxf(sp[(4 * q + 1) * 33] * mul, -448.f), 448.f),
                                                  a2 = fminf(fmaxf(sp[(4 * q + 2) * 33] * mul, -448.f), 448.f), a3 = fminf(fmaxf(sp[(4 * q + 3) * 33] * mul, -448.f), 448.f);
            w[q] = __builtin_amdgcn_cvt_pk_fp8_f32(a0, a1, 0, false); w[q] = __builtin_amdgcn_cvt_pk_fp8_f32(a2, a3, w[q], true); }
        const int drow = rowmode ? drow0 + (nn >> 2) * 8 + (nn & 3) : drow0 + nn;
        *(v4u*)(WT8 + (size_t)drow * ldt + k0 + 16 * c) = (v4u){(unsigned)w[0], (unsigned)w[1], (unsigned)w[2], (unsigned)w[3]}; }
    LDS_WAIT(); asm volatile("" ::: "memory");
}
__device__ __forceinline__ bool tr_matrix(int& it, const float* W, int ldw, int K, int c0, int ncols, bf16* WT, int drow0, LAS float* scr, int lane) {
    const int nb = (ncols + 31) / 32, items = (K / 64) * nb;
    if (it >= items) { it -= items; return false; }
    const int kb = it / nb, b = it % nb, nv = ncols - 32 * b;
    tr_item(W, ldw, 64 * kb, c0 + 32 * b, nv < 32 ? nv : 32, WT, K, drow0 + 32 * b, scr, lane);
    return true;
}
__device__ __forceinline__ void zero_rows(Frame& F, bf16* base, size_t nelem) {
    for (size_t i = ((size_t)F.gw * 64 + F.lane) * 8; i < nelem; i += (size_t)F.NGW * 64 * 8) *(v4u*)(base + i) = (v4u){0u, 0u, 0u, 0u};
}

__device__ __forceinline__ void p_prologue(Frame& F) {
    LAS float* scr = (LAS float*)(F.lds + F.wave * 16384);
    unsigned char* ws = F.ws;
    {
        LAS float* wl = (LAS float*)F.lds;
        LAS float* pl = (LAS float*)(F.lds + 32768);
        const float* w_in = kin(2); const float* pool_w = kin(3); const float* pscale = kin(4);
        bf16* WT = (bf16*)(ws + WS_WABIN);
        for (int it = blockIdx.x; it < 4 * 32; it += F.G) {
            const int g = it >> 5, k0 = (it & 31) * 64;
            for (int i = F.tid; i < 64 * 128; i += 512) wl[i] = w_in[(size_t)(k0 + (i >> 7)) * AB_IN + g * 128 + (i & 127)];
            for (int i = F.tid; i < 128 * 128; i += 512) pl[i] = pool_w[(size_t)g * 16384 + i];
            __syncthreads();
            const int d = F.tid & 127, kg = F.tid >> 7; const float sc = pscale[g * 128 + d];
            for (int kk = 0; kk < 16; kk += 8) {
                float a[8];
#pragma unroll
                for (int j = 0; j < 8; ++j) a[j] = 0.f;
                for (int c = 0; c < 128; ++c) { const float pw = pl[c * 128 + d];
#pragma unroll
                    for (int j = 0; j < 8; ++j) a[j] += wl[(kg * 16 + kk + j) * 128 + c] * pw; }
                v4u o; o.x = pk2(a[0] * sc, a[1] * sc); o.y = pk2(a[2] * sc, a[3] * sc); o.z = pk2(a[4] * sc, a[5] * sc); o.w = pk2(a[6] * sc, a[7] * sc);
                *(v4u*)(WT + (size_t)(g * 128 + d) * ND + k0 + kg * 16 + kk) = o;
            }
            __syncthreads();
        }
    }
    __syncthreads();
    for (int it0 = F.gw; ; it0 += F.NGW) {
        int it = it0;
        if (tr_matrix(it, kin(2), AB_IN, ND, 512, AB_IN - 512, (bf16*)(ws + WS_WABIN), 512, scr, F.lane)) continue;
        if (tr_matrix(it, kin(5), ND, ND, 0, ND, (bf16*)(ws + WS_WABOUT), 0, scr, F.lane)) continue;
        if (tr_matrix(it, kin(6), CD_IN, ND, 0, CD_IN, (bf16*)(ws + WS_WCDIN), 0, scr, F.lane)) continue;
        if (tr_matrix(it, kin(14), ND, ND, 0, ND, (bf16*)(ws + WS_WCDOUT), 0, scr, F.lane)) continue;
        if (tr_matrix(it, kin(11), 1536, 384, 0, 1536, (bf16*)(ws + WS_WUQ), 0, scr, F.lane)) continue;
        if (tr_matrix(it, kin(13), 2048, 512, 0, 2048, (bf16*)(ws + WS_WUKV), 0, scr, F.lane)) continue;
        if (tr_matrix(it, kin(8), 128, 4096, 0, 128, (bf16*)(ws + WS_CW1), 0, scr, F.lane)) continue;
        if (tr_matrix(it, kin(8) + (size_t)4096 * 128, 128, 4096, 0, 128, (bf16*)(ws + WS_CW1), 128, scr, F.lane)) continue;
        break;
    }
    zero_rows(F, (bf16*)(ws + WS_WCDIN) + (size_t)CD_IN * ND, (size_t)(CD_INP - CD_IN) * ND);
    { const float* x = kin(0); bf16* xb = (bf16*)(ws + WS_XB0); const size_t stride = (size_t)F.NGW * 64 * 8;
      for (size_t i = ((size_t)F.gw * 64 + F.lane) * 8; i < (size_t)NT * ND; i += 4 * stride) {
          f32x4 a[4], c[4];
#pragma unroll
          for (int u = 0; u < 4; ++u) if (i + u * stride < (size_t)NT * ND) { a[u] = *(const f32x4*)(x + i + u * stride); c[u] = *(const f32x4*)(x + i + u * stride + 4); }
#pragma unroll
          for (int u = 0; u < 4; ++u) if (i + u * stride < (size_t)NT * ND) { v4u o; o.x = pk2(a[u][0], a[u][1]); o.y = pk2(a[u][2], a[u][3]); o.z = pk2(c[u][0], c[u][1]); o.w = pk2(c[u][2], c[u][3]); *(v4u*)(xb + i + u * stride) = o; } } }
    for (int o = F.gw; o < 128; o += F.NGW) { const int kv = o >> 6, fc = o & 63; const float* pos = kin(7) + (size_t)kv * 4096 + fc * 64; const float* w1 = kin(8) + ((size_t)kv * 4096 + fc * 64) * 128;
        float s0 = 0.f, s1 = 0.f;
#pragma unroll 8
        for (int f = 0; f < 64; ++f) { const float pf_ = pos[f]; const f32x2 wv = *(const f32x2*)(w1 + (size_t)f * 128 + F.lane * 2); s0 += pf_ * wv[0]; s1 += pf_ * wv[1]; }
        *(f32x2*)((float*)(ws + WS_CMPB) + 256 + (size_t)o * 128 + F.lane * 2) = (f32x2){s0, s1}; }
}
__device__ __forceinline__ void cmp_bias_finish(Frame& F) {
    if (blockIdx.x == 0 && F.tid < 256) { const int kv = F.tid >> 7, h = F.tid & 127; const float* part = (const float*)(F.ws + WS_CMPB) + 256 + (size_t)kv * 64 * 128 + h;
        float sacc = 0.f; for (int fc = 0; fc < 64; ++fc) sacc += part[fc * 128];
        ((float*)(F.ws + WS_CMPB))[F.tid] = sacc; }
}
constexpr int MW_ITEMS_L = 65 * 1536 + 64;
__device__ __forceinline__ void moe_weight_item(int l, int it, unsigned char* ws, LAS float* scr, int lane) {
    bf16* W13 = (bf16*)(ws + WS_W13 + (size_t)l * WS_MOE_LSTRIDE); bf16* W2 = (bf16*)(ws + WS_W2 + (size_t)l * WS_MOE_LSTRIDE); bf16* RT = (bf16*)(ws + WS_RT + (size_t)l * MiB);
    if (it >= 65 * 1536) { const int r = it - 65 * 1536, kb = r >> 1, b = r & 1;
        tr_item(kin(19) + (size_t)l * ND * NEXP, NEXP, 64 * kb, 32 * b, 32, RT, ND, 32 * b, scr, lane); return; }
    const int e = it / 1536, r = it % 1536;
    const float *w1, *w3, *w2;
    if (e < NEXP) { const size_t o = ((size_t)l * NEXP + e) * ND * EFF; w1 = kin(21) + o; w3 = kin(22) + o; w2 = kin(23) + o; }
    else { const size_t o = (size_t)l * ND * EFF; w1 = kin(24) + o; w3 = kin(25) + o; w2 = kin(26) + o; }
    if (r < 1024) { const int which = r >> 9, rr = r & 511, kb = rr >> 4, nb = rr & 15;
        const int j = nb >> 2, drow = j * 256 + which * 128 + (nb & 3) * 32;
        if (MK_FP8_MOE) tr_item_f8(which ? w3 : w1, EFF, 64 * kb, 32 * nb, (unsigned char*)W13 + (size_t)e * 1024 * ND, ND, (nb >> 1) * 128 + (nb & 1) * 64 + which * 4, 1, 64.0f, scr, lane);
        else tr_item(which ? w3 : w1, EFF, 64 * kb, 32 * nb, 32, W13 + (size_t)e * 1024 * ND, ND, drow, scr, lane); }
    else { const int rr = r - 1024, kb = rr >> 6, nb = rr & 63;
        if (MK_FP8_MOE) tr_item_f8(w2, ND, 64 * kb, 32 * nb, (unsigned char*)W2 + (size_t)e * ND * EFF, EFF, 32 * nb, 0, 64.0f, scr, lane);
        else tr_item(w2, ND, 64 * kb, 32 * nb, 32, W2 + (size_t)e * ND * EFF, EFF, 32 * nb, scr, lane); }
}
struct ConvDesc { const float* src; unsigned char* dst; int ldw, ldt, k0, drow0, rowmode, kind; };
__device__ __forceinline__ ConvDesc conv_desc(int id, unsigned char* ws) {
    ConvDesc d; d.kind = -1; d.src = nullptr; d.dst = nullptr; d.ldw = 0; d.ldt = 0; d.k0 = 0; d.drow0 = 0; d.rowmode = 0;
    if (id >= 2 * MW_ITEMS_L) return d;
    const int l = id >= MW_ITEMS_L ? 1 : 0, it = id - l * MW_ITEMS_L;
    if (it >= 65 * 1536 || !MK_FP8_MOE) { d.kind = 1; d.k0 = it; d.drow0 = l; return d; }
    const int e = it / 1536, r = it % 1536;
    const float *w1, *w3, *w2;
    if (e < NEXP) { const size_t o = ((size_t)l * NEXP + e) * ND * EFF; w1 = kin(21) + o; w3 = kin(22) + o; w2 = kin(23) + o; }
    else { const size_t o = (size_t)l * ND * EFF; w1 = kin(24) + o; w3 = kin(25) + o; w2 = kin(26) + o; }
    d.kind = 0;
    if (r < 1024) { const int which = r >> 9, rr = r & 511, kb = rr >> 4, nb = rr & 15;
        d.src = (which ? w3 : w1) + (size_t)(64 * kb) * EFF + 32 * nb; d.ldw = EFF; d.k0 = 64 * kb;
        d.dst = ws + WS_W13 + (size_t)l * WS_MOE_LSTRIDE + (size_t)e * 1024 * ND; d.ldt = ND; d.drow0 = (nb >> 1) * 128 + (nb & 1) * 64 + which * 4; d.rowmode = 1; }
    else { const int rr = r - 1024, kb = rr >> 6, nb = rr & 63;
        d.src = w2 + (size_t)(64 * kb) * ND + 32 * nb; d.ldw = ND; d.k0 = 64 * kb;
        d.dst = ws + WS_W2 + (size_t)l * WS_MOE_LSTRIDE + (size_t)e * ND * EFF; d.ldt = EFF; d.drow0 = 32 * nb; d.rowmode = 0; }
    return d;
}
__device__ __forceinline__ void conv_load(const ConvDesc& d, float (&v)[32], int lane) {
    if (d.kind != 0) return;
    const float* src = d.src + (size_t)(lane >> 5) * d.ldw + (lane & 31);
#pragma unroll
    for (int i = 0; i < 32; ++i) v[i] = src[(size_t)(2 * i) * d.ldw];
}
__device__ __forceinline__ void conv_finish(const ConvDesc& d, const float (&v)[32], unsigned char* ws, LAS float* scr, int lane) {
    if (d.kind == 1) { moe_weight_item(d.drow0, d.k0, ws, scr, lane); return; }
    if (d.kind != 0) return;
    const int n = lane & 31;
#pragma unroll
    for (int i = 0; i < 32; ++i) scr[(2 * i + (lane >> 5)) * 33 + n] = v[i];
    LDS_WAIT(); asm volatile("" ::: "memory");
    const int c = lane & 3;
#pragma unroll
    for (int j = 0; j < 2; ++j) { const int nn = (lane >> 2) + 16 * j; const LAS float* sp = scr + (16 * c) * 33 + nn; int w[4];
#pragma unroll
        for (int q = 0; q < 4; ++q) { const float a0 = fminf(fmaxf(sp[(4 * q + 0) * 33] * 64.0f, -448.f), 448.f), a1 = fminf(fmaxf(sp[(4 * q + 1) * 33] * 64.0f, -448.f), 448.f),
                                                  a2 = fminf(fmaxf(sp[(4 * q + 2) * 33] * 64.0f, -448.f), 448.f), a3 = fminf(fmaxf(sp[(4 * q + 3) * 33] * 64.0f, -448.f), 448.f);
            w[q] = __builtin_amdgcn_cvt_pk_fp8_f32(a0, a1, 0, false); w[q] = __builtin_amdgcn_cvt_pk_fp8_f32(a2, a3, w[q], true); }
        const int drow = d.rowmode ? d.drow0 + (nn >> 2) * 8 + (nn & 3) : d.drow0 + nn;
        *(v4u*)(d.dst + (size_t)drow * d.ldt + d.k0 + 16 * c) = (v4u){(unsigned)w[0], (unsigned)w[1], (unsigned)w[2], (unsigned)w[3]}; }
    LDS_WAIT(); asm volatile("" ::: "memory");
}
__device__ __forceinline__ void p_moe_weights_queue(Frame& F, unsigned* queue) {
    LAS float* scr = (LAS float*)(F.lds + F.wave * 16384);
    constexpr int BATCH = 16, NB_ = (2 * MW_ITEMS_L + BATCH - 1) / BATCH;
    for (;;) {
        unsigned bq = 0; if (F.lane == 0) bq = atomicAdd(queue, 1u);
        const int bi = __builtin_amdgcn_readfirstlane((int)bq);
        if (bi >= NB_) break;
        const int s0 = bi * BATCH;
        float va[32], vb[32];
        ConvDesc dA = conv_desc(s0, F.ws); conv_load(dA, va, F.lane);
        for (int k = 0; k < BATCH; k += 2) {
            ConvDesc dB = conv_desc(s0 + k + 1, F.ws); conv_load(dB, vb, F.lane);
            conv_finish(dA, va, F.ws, scr, F.lane);
            dA = conv_desc(k + 2 < BATCH ? s0 + k + 2 : 2 * MW_ITEMS_L, F.ws); conv_load(dA, va, F.lane);
            conv_finish(dB, vb, F.ws, scr, F.lane);
        }
    }
    for (int l = 0; l < 2; ++l) zero_rows(F, (bf16*)(F.ws + WS_RT + (size_t)l * MiB) + (size_t)NEXP * ND, (size_t)(256 - NEXP) * ND);
}

__device__ __forceinline__ void ln_finish(float (&v)[4][8], const float* g, const float* b, int lane, bf16* ob, float* of, unsigned char* o8 = nullptr) {
    float s = 0.f;
#pragma unroll
    for (int j = 0; j < 4; ++j)
#pragma unroll
        for (int i = 0; i < 8; ++i) s += v[j][i];
    const float mean = wave_sum(s) * (1.f / ND); float s2 = 0.f;
#pragma unroll
    for (int j = 0; j < 4; ++j)
#pragma unroll
        for (int i = 0; i < 8; ++i) { v[j][i] -= mean; s2 += v[j][i] * v[j][i]; }
    const float rstd = 1.f / sqrtf(wave_sum(s2) * (1.f / ND) + LN_EPS);
#pragma unroll
    for (int j = 0; j < 4; ++j) { unsigned c0 = (unsigned)(j * 64 + lane) * 8u; asm volatile("" : "+v"(c0));
        const f32x4 g0 = *(const f32x4*)((const char*)g + c0 * 4u), g1 = *(const f32x4*)((const char*)g + c0 * 4u + 16u), b0 = *(const f32x4*)((const char*)b + c0 * 4u), b1 = *(const f32x4*)((const char*)b + c0 * 4u + 16u);
        float o[8];
#pragma unroll
        for (int i = 0; i < 4; ++i) { o[i] = v[j][i] * rstd * g0[i] + b0[i]; o[4 + i] = v[j][4 + i] * rstd * g1[i] + b1[i]; }
        if (ob) { v4u w; w.x = pk2(o[0], o[1]); w.y = pk2(o[2], o[3]); w.z = pk2(o[4], o[5]); w.w = pk2(o[6], o[7]); *(v4u*)((char*)ob + c0 * 2u) = w; }
        if (of) { *(f32x4*)((char*)of + c0 * 4u) = (f32x4){o[0], o[1], o[2], o[3]}; *(f32x4*)((char*)of + c0 * 4u + 16u) = (f32x4){o[4], o[5], o[6], o[7]}; }
        if (o8) { int w0 = __builtin_amdgcn_cvt_pk_fp8_f32(o[0], o[1], 0, false); w0 = __builtin_amdgcn_cvt_pk_fp8_f32(o[2], o[3], w0, true);
            int w1 = __builtin_amdgcn_cvt_pk_fp8_f32(o[4], o[5], 0, false); w1 = __builtin_amdgcn_cvt_pk_fp8_f32(o[6], o[7], w1, true);
            *(v2u*)(o8 + c0) = (v2u){(unsigned)w0, (unsigned)w1}; } }
}
__device__ __forceinline__ void p_ln1(Frame& F, const bf16* xin, const bf16* mixo, const float* g, const float* b, bf16* xo, unsigned char* xo8) {
    for (int m = F.gw; m < NT; m += F.NGW) {
        float v[4][8];
#pragma unroll
        for (int j = 0; j < 4; ++j) { const size_t o = (size_t)m * ND + (j * 64 + F.lane) * 8; float a[8], c[8]; unpack8(*(const v4u*)(xin + o), a); unpack8(*(const v4u*)(mixo + o), c);
#pragma unroll
            for (int i = 0; i < 8; ++i) v[j][i] = DN_ALPHA * a[i] + c[i]; }
        ln_finish(v, g, b, F.lane, xo + (size_t)m * ND, nullptr, xo8 ? xo8 + (size_t)m * ND : nullptr);
    }
}
__device__ __forceinline__ void unpack8_fp8(const v2u w, float (&f)[8]) {
    const f32x2 a = __builtin_amdgcn_cvt_pk_f32_fp8((int)w.x, false), b = __builtin_amdgcn_cvt_pk_f32_fp8((int)w.x, true), c = __builtin_amdgcn_cvt_pk_f32_fp8((int)w.y, false), d = __builtin_amdgcn_cvt_pk_f32_fp8((int)w.y, true);
    f[0] = a[0]; f[1] = a[1]; f[2] = b[0]; f[3] = b[1]; f[4] = c[0]; f[5] = c[1]; f[6] = d[0]; f[7] = d[1];
}
__device__ __forceinline__ void p_combine_ln2(Frame& F, const bf16* x1, const unsigned char* y2, const int* slot, const float* wsel, const float* g, const float* b, bf16* xo, float* fo) {
    for (int m = F.gw; m < NT; m += F.NGW) {
        const int myrow = slot[m * 8 + (F.lane & 7)]; const float myw = wsel[m * 8 + (F.lane & 7)] * (1.0f / 16.0f);
        float v[4][8];
        { v4u xa[4]; v2u sa[4];
#pragma unroll
          for (int j = 0; j < 4; ++j) { xa[j] = *(const v4u*)(x1 + (size_t)m * ND + (j * 64 + F.lane) * 8); sa[j] = *(const v2u*)(y2 + (size_t)(SH_ROW0 + m) * ND + (j * 64 + F.lane) * 8); }
#pragma unroll
          for (int j = 0; j < 4; ++j) { float a[8], c[8]; unpack8(xa[j], a); unpack8_fp8(sa[j], c);
#pragma unroll
              for (int i = 0; i < 8; ++i) v[j][i] = DN_ALPHA * a[i] + c[i] * (1.0f / 16.0f); } }
#pragma unroll
        for (int kg = 0; kg < 2; ++kg) { v2u ra[4][4]; float wk[4];
#pragma unroll
            for (int k = 0; k < 4; ++k) { const int row = __builtin_amdgcn_readlane(myrow, kg * 4 + k); wk[k] = __builtin_bit_cast(float, __builtin_amdgcn_readlane(__builtin_bit_cast(int, myw), kg * 4 + k));
#pragma unroll
                for (int j = 0; j < 4; ++j) ra[k][j] = *(const v2u*)(y2 + (size_t)row * ND + (j * 64 + F.lane) * 8); }
#pragma unroll
            for (int k = 0; k < 4; ++k)
#pragma unroll
                for (int j = 0; j < 4; ++j) { float c[8]; unpack8_fp8(ra[k][j], c);
#pragma unroll
                    for (int i = 0; i < 8; ++i) v[j][i] += wk[k] * c[i]; } }
        ln_finish(v, g, b, F.lane, xo ? xo + (size_t)m * ND : nullptr, fo ? fo + (size_t)m * ND : nullptr);
    }
}

__device__ __forceinline__ void p_pool(Frame& F, int wid, int nw) {
    const bf16* proj = (const bf16*)(F.ws + WS_PROJ); bf16* mixin = (bf16*)(F.ws + WS_MIXIN);
    for (int m = wid; m < NT; m += nw) {
        const int s = m & (NS - 1);
        const int g = F.lane >> 4, w = 2 << g; const int lo = (s + 1 - w) > 0 ? (s + 1 - w) : 0; const float cnt = (float)((s + 1) < w ? (s + 1) : w);
        float acc[8], cur[8];
#pragma unroll
        for (int i = 0; i < 8; ++i) acc[i] = 0.f;
        for (int j = lo; j <= s; ++j) { float t[8]; unpack8(*(const v4u*)(proj + (size_t)(m - s + j) * AB_IN + F.lane * 8), t);
#pragma unroll
            for (int i = 0; i < 8; ++i) acc[i] += t[i]; }
        unpack8(*(const v4u*)(proj + (size_t)m * AB_IN + F.lane * 8), cur);
        float o[8];
#pragma unroll
        for (int i = 0; i < 8; ++i) o[i] = acc[i] / cnt - cur[i];
        v4u wv; wv.x = pk2(o[0], o[1]); wv.y = pk2(o[2], o[3]); wv.z = pk2(o[4], o[5]); wv.w = pk2(o[6], o[7]); *(v4u*)(mixin + (size_t)m * ND + F.lane * 8) = wv;
    }
}
namespace ret {
typedef short v4i16_t __attribute__((ext_vector_type(4)));
constexpr int PITCH = 272, TILE = 128 * PITCH;
__device__ __forceinline__ bf16x8 trfrag(LAS unsigned char* trb, int r0, int r1, int c0) {
    const v4i16_t a = __builtin_amdgcn_ds_read_tr16_b64_v4i16((LAS v4i16_t*)(trb + r0 * PITCH + c0 * 2));
    const v4i16_t b = __builtin_amdgcn_ds_read_tr16_b64_v4i16((LAS v4i16_t*)(trb + r1 * PITCH + c0 * 2));
    return (bf16x8){a[0], a[1], a[2], a[3], b[0], b[1], b[2], b[3]};
}
}
__device__ __forceinline__ void p_retention_mfma(Frame& F, int bh) {
    const bf16* proj = (const bf16*)(F.ws + WS_PROJ); bf16* mixin = (bf16*)(F.ws + WS_MIXIN); const int* posv = (const int*)kin(1);
    constexpr int P = ret::PITCH;
    LAS unsigned char* KT = F.lds; LAS unsigned char* VT = F.lds + ret::TILE; LAS unsigned char* ST = F.lds + 2 * ret::TILE;
    const int b = bh / 6, h = bh % 6, w = F.wave, lane = F.lane, i16 = lane & 15, g = lane >> 4, q4 = (lane & 15) >> 2, p4 = lane & 3;
    const float lg = log2f(1.0f - exp2f(-5.0f - (float)h)), gc = exp2f(128.f * lg);
    const int rowb = i16 * P + 16 * g;
    const int trl = q4 * P + 8 * p4;
    LAS unsigned char* const trV4 = VT + trl + 4 * g * P;
    LAS unsigned char* const trV8 = VT + trl + 8 * g * P;
    LAS unsigned char* const trK8 = KT + trl + 8 * g * P;
    f32x4 T[2][8];
#pragma unroll
    for (int a = 0; a < 2; ++a)
#pragma unroll
        for (int d = 0; d < 8; ++d) T[a][d] = (f32x4){0.f, 0.f, 0.f, 0.f};
    const int srow = F.tid >> 2, scb = (F.tid & 3) * 4;
    for (int n = 0; n < NS / 128; ++n) {
        const size_t m0 = (size_t)b * NS + n * 128;
        {
          const float fk = exp2f(-(float)srow * lg) * 0.08838834764831845f, pz = (float)posv[m0 + srow]; const int t4 = F.tid & 3;
          const bf16* krow = proj + (m0 + srow) * AB_IN + 1280 + h * 128;
#pragma unroll
          for (int c = 0; c < 2; ++c) { const int c8 = 2 * t4 + c; float x1[8], x2[8];
              unpack8(*(const v4u*)(krow + c8 * 8), x1); unpack8(*(const v4u*)(krow + 64 + c8 * 8), x2);
#pragma unroll
              for (int j = 0; j < 8; ++j) { const float invf = exp2f(-(float)(c8 * 8 + j) * (13.287712379549449f / 64.f)); float sn, cs; fast_sincos(pz * invf, sn, cs);
                  const float a = (x1[j] * cs - x2[j] * sn) * fk, bq = (x1[j] * sn + x2[j] * cs) * fk; x1[j] = a; x2[j] = bq; }
              v4u o; o.x = pk2(x1[0], x1[1]); o.y = pk2(x1[2], x1[3]); o.z = pk2(x1[4], x1[5]); o.w = pk2(x1[6], x1[7]); *(LAS v4u*)(KT + srow * P + c8 * 16) = o;
              o.x = pk2(x2[0], x2[1]); o.y = pk2(x2[2], x2[3]); o.z = pk2(x2[4], x2[5]); o.w = pk2(x2[6], x2[7]); *(LAS v4u*)(KT + srow * P + (c8 + 8) * 16) = o; } }
        bf16x8 qf[4], pf[4]; float rs[4] = {0.f, 0.f, 0.f, 0.f}, rq[4] = {0.f, 0.f, 0.f, 0.f};
        {
          const float fq = exp2f((float)(16 * w + i16) * lg), pz = (float)posv[m0 + 16 * w + i16];
          const bf16* qrow = proj + (m0 + 16 * w + i16) * AB_IN + 512 + h * 128;
#pragma unroll
          for (int ks = 0; ks < 2; ++ks) { float x1[8], x2[8]; unpack8(*(const v4u*)(qrow + 32 * ks + 8 * g), x1); unpack8(*(const v4u*)(qrow + 64 + 32 * ks + 8 * g), x2);
#pragma unroll
              for (int j = 0; j < 8; ++j) { const float invf = exp2f(-(float)(32 * ks + 8 * g + j) * (13.287712379549449f / 64.f)); float sn, cs; fast_sincos(pz * invf, sn, cs);
                  const float a = (x1[j] * cs - x2[j] * sn) * fq, bq = (x1[j] * sn + x2[j] * cs) * fq; x1[j] = a; x2[j] = bq; }
              v4u o; o.x = pk2(x1[0], x1[1]); o.y = pk2(x1[2], x1[3]); o.z = pk2(x1[4], x1[5]); o.w = pk2(x1[6], x1[7]); qf[ks] = __builtin_bit_cast(bf16x8, o);
              o.x = pk2(x2[0], x2[1]); o.y = pk2(x2[2], x2[3]); o.z = pk2(x2[4], x2[5]); o.w = pk2(x2[6], x2[7]); qf[ks + 2] = __builtin_bit_cast(bf16x8, o); } }
#pragma unroll
        for (int hv = 0; hv < 2; ++hv) {
            if (hv == 1) __syncthreads();
#pragma unroll
            for (int c = 0; c < 4; ++c) { const int c8 = scb + c; *(LAS v4u*)(VT + srow * P + c8 * 16) = *(const v4u*)(proj + (m0 + srow) * AB_IN + 2048 + h * 256 + hv * 128 + c8 * 8); }
            { LAS unsigned char* stw = ST + (16 * w + 4 * g) * P + i16 * 2;
#pragma unroll
              for (int dt = 0; dt < 8; ++dt)
#pragma unroll
                for (int r = 0; r < 4; ++r) { T[hv][dt][r] *= gc; *(LAS bf16*)(stw + r * P + dt * 32) = (bf16)f2bf(T[hv][dt][r]); } }
            __syncthreads();
            if (hv == 0) {
                f32x4 sc[8];
#pragma unroll
                for (int mt = 0; mt < 8; ++mt) { sc[mt] = (f32x4){0.f, 0.f, 0.f, 0.f};
                    if (mt <= w) {
#pragma unroll
                        for (int ks = 0; ks < 4; ++ks) { const bf16x8 kf = *(const LAS bf16x8*)(KT + rowb + mt * 16 * P + ks * 64); sc[mt] = __builtin_amdgcn_mfma_f32_16x16x32_bf16(kf, qf[ks], sc[mt], 0, 0, 0); }
                        if (mt == w) {
#pragma unroll
                            for (int r = 0; r < 4; ++r) sc[mt][r] = (4 * g + r <= i16) ? sc[mt][r] : 0.f; } } }
#pragma unroll
                for (int k2 = 0; k2 < 4; ++k2) { v4u wv; wv.x = pk2(sc[2 * k2][0], sc[2 * k2][1]); wv.y = pk2(sc[2 * k2][2], sc[2 * k2][3]); wv.z = pk2(sc[2 * k2 + 1][0], sc[2 * k2 + 1][1]); wv.w = pk2(sc[2 * k2 + 1][2], sc[2 * k2 + 1][3]);
                    pf[k2] = __builtin_bit_cast(bf16x8, wv); }
            }
#pragma unroll
            for (int nt = 0; nt < 8; ++nt) { f32x4 acc = (f32x4){0.f, 0.f, 0.f, 0.f};
#pragma unroll
                for (int k2 = 0; k2 < 4; ++k2) if (2 * k2 <= w) { const bf16x8 vf = ret::trfrag(trV4, 32 * k2, 32 * k2 + 16, 16 * nt); acc = __builtin_amdgcn_mfma_f32_16x16x32_bf16(pf[k2], vf, acc, 0, 0, 0); }
#pragma unroll
                for (int ks = 0; ks < 4; ++ks) { const bf16x8 sf = *(const LAS bf16x8*)(ST + rowb + nt * 16 * P + ks * 64); acc = __builtin_amdgcn_mfma_f32_16x16x32_bf16(qf[ks], sf, acc, 0, 0, 0); }
#pragma unroll
                for (int r = 0; r < 4; ++r) { rs[r] += acc[r]; rq[r] += acc[r] * acc[r]; mixin[(m0 + 16 * w + 4 * g + r) * ND + 512 + h * 256 + hv * 128 + 16 * nt + i16] = (bf16)f2bf(acc[r]); } }
#pragma unroll
            for (int ks = 0; ks < 4; ++ks) { const bf16x8 af = ret::trfrag(trV8, 32 * ks, 32 * ks + 4, 16 * w);
#pragma unroll
                for (int dt = 0; dt < 8; ++dt) { const bf16x8 bfr = ret::trfrag(trK8, 32 * ks, 32 * ks + 4, 16 * dt); T[hv][dt] = __builtin_amdgcn_mfma_f32_16x16x32_bf16(af, bfr, T[hv][dt], 0, 0, 0); } }
        }
#pragma unroll
        for (int r = 0; r < 4; ++r) { float sm = rs[r], s2 = rq[r];
            sm += __shfl_xor(sm, 1); sm += __shfl_xor(sm, 2); sm += __shfl_xor(sm, 4); sm += __shfl_xor(sm, 8);
            s2 += __shfl_xor(s2, 1); s2 += __shfl_xor(s2, 2); s2 += __shfl_xor(s2, 4); s2 += __shfl_xor(s2, 8);
            const float mean = sm * (1.f / 256.f); const float var = fmaxf(s2 * (1.f / 256.f) - mean * mean, 0.f);
            const float rstd = 1.f / sqrtf(var + NORM_EPS);
            const size_t m = m0 + 16 * w + 4 * g + r;
#pragma unroll
            for (int t = 0; t < 16; ++t) { bf16* yp = mixin + m * ND + 512 + h * 256 + 16 * t + i16; const float gt = bf1(proj[m * AB_IN + 3584 + h * 256 + 16 * t + i16]);
                *yp = (bf16)f2bf((bf1(*yp) - mean) * rstd * siluf_(gt)); } }
        __syncthreads();
    }
}

__device__ __forceinline__ void p_route(Frame& F, int l) {
    const float* logits = (const float*)(F.ws + WS_LOGITS); const float* rbias = kin(20) + l * NEXP;
    int* tope = (int*)(F.ws + WS_TOPE); float* wsel = (float*)(F.ws + WS_WSEL); int* posb = (int*)(F.ws + WS_SLOT); unsigned* cnt = F.ctl + CW_CNT + l * 64;
    LAS unsigned* lcnt = (LAS unsigned*)F.lds; LAS unsigned* lbase = lcnt + 64; LAS int* le = (LAS int*)(lcnt + 128); LAS unsigned* lp = (LAS unsigned*)(lcnt + 128 + 512);
    const float bias = rbias[F.lane]; const int lane = F.lane;
    for (int chunk = blockIdx.x; chunk < NT / 64; chunk += F.G) {
        __syncthreads();
        if (F.tid < 64) lcnt[F.tid] = 0u;
        __syncthreads();
        for (int t = 0; t < 8; ++t) {
            const int tl = F.wave * 8 + t, m = chunk * 64 + tl;
            const float lg = (logits[(size_t)m * 64 + lane] + logits[((size_t)NT + m) * 64 + lane]) + (logits[((size_t)2 * NT + m) * 64 + lane] + logits[((size_t)3 * NT + m) * 64 + lane]);
            const float sc = sigmoidf_(lg), bi = sc + bias;
            const int grp = lane >> 3;
            int rk = 0;
#pragma unroll
            for (int j = 1; j < 8; ++j) { const int o = lane ^ j; const float ov = __shfl_xor(bi, j); rk += ((ov > bi) || (ov == bi && o < lane)) ? 1 : 0; }
            float gs = rk < 2 ? bi : 0.f; gs += __shfl_xor(gs, 1); gs += __shfl_xor(gs, 2); gs += __shfl_xor(gs, 4);
            int grk = 0;
#pragma unroll
            for (int gg = 0; gg < 8; ++gg) { const float ov = __builtin_bit_cast(float, __builtin_amdgcn_readlane(__builtin_bit_cast(int, gs), gg * 8)); grk += (gg != grp && ((ov > gs) || (ov == gs && gg < grp))) ? 1 : 0; }
            const float mv = grk < 4 ? bi : -1e30f;
            int erk = 0;
#pragma unroll 16
            for (int j = 0; j < 64; ++j) { const float ov = __builtin_bit_cast(float, __builtin_amdgcn_readlane(__builtin_bit_cast(int, mv), j)); erk += ((ov > mv) || (ov == mv && j < lane)) ? 1 : 0; }
            const bool sel = erk < 8;
            const float wsum = wave_sum(sel ? sc : 0.f);
            if (sel) { const unsigned q = __hip_atomic_fetch_add(lcnt + lane, 1u, __ATOMIC_RELAXED, __HIP_MEMORY_SCOPE_WORKGROUP);
                tope[m * 8 + erk] = lane; wsel[m * 8 + erk] = sc / wsum * 2.5f; le[tl * 8 + erk] = lane; lp[tl * 8 + erk] = q; }
        }
        __syncthreads();
        if (F.tid < 64) lbase[F.tid] = atomicAdd(&cnt[F.tid], lcnt[F.tid]);
        __syncthreads();
        posb[chunk * 512 + F.tid] = (int)(lbase[le[F.tid]] + lp[F.tid]);
    }
}
__device__ __forceinline__ void load_offsets(Frame& F, int l) {
    volatile LAS int* tab = (volatile LAS int*)(F.lds + TAB_OFF);
    __syncthreads();
    if (F.tid < NEXP) {
        int c = (int)__hip_atomic_load(F.ctl + CW_CNT + l * 64 + F.tid, __ATOMIC_RELAXED, __HIP_MEMORY_SCOPE_AGENT); if (c > NT) c = NT;
        const int ntl = (c + 255) >> 8; int incl = ntl;
#pragma unroll
        for (int d = 1; d < 64; d <<= 1) { const int o = __shfl_up(incl, d); if (F.tid >= d) incl += o; }
        const int excl = incl - ntl;
        tab[F.tid] = excl << 8; tab[66 + F.tid] = c;
        for (int t = 0; t < ntl; ++t) if (excl + t < MAXTILES) tab[160 + excl + t] = F.tid;
        if (F.tid == NEXP - 1) { tab[64] = incl << 8; tab[65] = incl; }
    }
    __syncthreads();
}
__device__ __forceinline__ void p_scatter(Frame& F, int l) {
    load_offsets(F, l);
    const LAS int* tab = (const LAS int*)(F.lds + TAB_OFF);
    const int* tope = (const int*)(F.ws + WS_TOPE); int* slot = (int*)(F.ws + WS_SLOT); int* sorted = (int*)(F.ws + WS_SORTED);
    for (int i = F.gw * 64 + F.lane; i < NT * 8; i += F.NGW * 64) { const int e = tope[i]; const int row = tab[e] + slot[i]; sorted[row] = i >> 3; slot[i] = row; }
    for (int i = F.gw * 64 + F.lane; i < NEXP * 256; i += F.NGW * 64) { const int e = i >> 8, j = i & 255; const int r = tab[e] + tab[66 + e] + j; if (r < tab[e + 1]) sorted[r] = 0; }
}

__device__ __forceinline__ void p_l1_thin_a(Frame& F) {
    const bf16* proj = (const bf16*)(F.ws + WS_PROJ); const int* pos = (const int*)kin(1);
    bf16* cqn = (bf16*)(F.ws + WS_CQN); bf16* ckvn = (bf16*)(F.ws + WS_CKVN); bf16* krot = (bf16*)(F.ws + WS_KROT); bf16* cmpkv = (bf16*)(F.ws + WS_CMPKV);
    const float* qn = kin(10); const float* kvn = kin(12);
    for (int m = F.gw; m < NT; m += F.NGW) {
        const bf16* row = proj + (size_t)m * CD_INP;
        { float x[6]; float s = 0.f;
#pragma unroll
          for (int j = 0; j < 6; ++j) { x[j] = bf1(row[2584 + j * 64 + F.lane]); s += x[j] * x[j]; }
          const float r = 1.f / sqrtf(wave_sum(s) * (1.f / 384.f) + NORM_EPS);
#pragma unroll
          for (int j = 0; j < 6; ++j) cqn[(size_t)m * 384 + j * 64 + F.lane] = (bf16)f2bf(x[j] * r * qn[j * 64 + F.lane]); }
        { float x[8]; float s = 0.f;
#pragma unroll
          for (int j = 0; j < 8; ++j) { x[j] = bf1(row[2968 + j * 64 + F.lane]); s += x[j] * x[j]; }
          const float r = 1.f / sqrtf(wave_sum(s) * (1.f / 512.f) + NORM_EPS);
#pragma unroll
          for (int j = 0; j < 8; ++j) ckvn[(size_t)m * 512 + j * 64 + F.lane] = (bf16)f2bf(x[j] * r * kvn[j * 64 + F.lane]); }
        { const int i = F.lane & 31; const float p = (float)pos[m]; const float invf = exp2f(-(float)i * (13.287712379549449f / 32.f));
          float sn, cs; fast_sincos(p * invf, sn, cs);
          const float x1 = bf1(row[3480 + i]), x2 = bf1(row[3480 + 32 + i]);
          if (F.lane < 32) krot[(size_t)m * 64 + i] = (bf16)f2bf(x1 * cs - x2 * sn); else krot[(size_t)m * 64 + 32 + i] = (bf16)f2bf(x1 * sn + x2 * cs); }
        { const int b = m >> 11, s = m & (NS - 1);
          const int q4 = F.lane >> 4, c = F.lane & 15, kv = q4 >> 1, g = q4 & 1;
          const v4u w = *(const v4u*)(row + 1024 + q4 * 128 + c * 8);
          *(v4u*)(cmpkv + ((size_t)((kv * 16 + b * 2 + g) * NS + s)) * 128 + c * 8) = w; }
    }
}
__device__ __forceinline__ void p_l1_thin_b(Frame& F) {
    const float* hid = (const float*)(F.ws + WS_HID); const float* w2 = kin(9); bf16* kvc = (bf16*)(F.ws + WS_KVCMP);
    for (int m = F.gw; m < 4096; m += F.NGW) {
        const int kv = m >> 11;
        float h0 = hid[(size_t)m * 256 + kv * 128 + F.lane], h1 = hid[(size_t)m * 256 + kv * 128 + 64 + F.lane];
        h0 = 0.5f * h0 * (1.f + tanhf(0.7978845608028654f * (h0 + 0.044715f * h0 * h0 * h0)));
        h1 = 0.5f * h1 * (1.f + tanhf(0.7978845608028654f * (h1 + 0.044715f * h1 * h1 * h1)));
        const float* w = w2 + (size_t)kv * 128 * 128; float o0 = 0.f, o1 = 0.f;
        for (int c = 0; c < 64; ++c) { const float a = __shfl(h0, c), bq = __shfl(h1, c);
            o0 += a * w[c * 128 + F.lane] + bq * w[(c + 64) * 128 + F.lane]; o1 += a * w[c * 128 + 64 + F.lane] + bq * w[(c + 64) * 128 + 64 + F.lane]; }
        kvc[(size_t)m * 128 + F.lane] = (bf16)f2bf(o0); kvc[(size_t)m * 128 + 64 + F.lane] = (bf16)f2bf(o1);
    }
}
__device__ __forceinline__ void p_nsa_cmp_mfma(Frame& F) {
    typedef short v4i16_t __attribute__((ext_vector_type(4)));
    const bf16* proj = (const bf16*)(F.ws + WS_PROJ); const bf16* kvc = (const bf16*)(F.ws + WS_KVCMP); float* ocmp = (float*)(F.ws + WS_OCMP); unsigned* selm = (unsigned*)(F.ws + WS_SELM);
    constexpr int P = 272;
    LAS unsigned char* KT = F.lds; LAS unsigned char* VT = F.lds + 128 * P; LAS float* PS = (LAS float*)(F.lds + 2 * 128 * P);
    const int w = F.wave, lane = F.lane, i16 = lane & 15, g = lane >> 4, q4 = (lane & 15) >> 2, p4 = lane & 3;
    const float sscale = 0.08838834764831845f * 1.4426950408889634f;
    for (int bu = blockIdx.x; bu < 256; bu += F.G) {
        const int bg = bu >> 4, qg = bu & 15, b = bg >> 1, gq = bg & 1;
        __syncthreads();
#pragma unroll
        for (int c = 0; c < 4; ++c) { const int idx = F.tid + 512 * c, row = idx >> 4, c8 = idx & 15;
            v4u kk = (v4u){0u, 0u, 0u, 0u}, vv = (v4u){0u, 0u, 0u, 0u};
            if (row < 127) { kk = *(const v4u*)(kvc + ((size_t)(0 * 16 + bg) * 128 + row) * 128 + c8 * 8); vv = *(const v4u*)(kvc + ((size_t)(1 * 16 + bg) * 128 + row) * 128 + c8 * 8); }
            *(LAS v4u*)(KT + row * P + c8 * 16) = kk; *(LAS v4u*)(VT + row * P + c8 * 16) = vv; }
        for (int k = 0; k < 4; ++k) {
            const int q0 = (qg * 4 + k) * 32, h = gq * 4 + (w >> 1), ql = (w & 1) * 16 + i16, spos = q0 + ql;
            bf16x8 qf[4];
#pragma unroll
            for (int ks = 0; ks < 4; ++ks) qf[ks] = *(const bf16x8*)(proj + (size_t)(b * NS + spos) * CD_INP + h * 128 + 32 * ks + 8 * g);
            __syncthreads();
            const int nvalid = spos >= 31 ? ((spos - 31) >> 4) + 1 : 0;
            f32x4 sc[8]; float mx = -1e30f;
#pragma unroll
            for (int mt = 0; mt < 8; ++mt) { sc[mt] = (f32x4){0.f, 0.f, 0.f, 0.f};
#pragma unroll
                for (int ks = 0; ks < 4; ++ks) { const bf16x8 kf = *(const LAS bf16x8*)(KT + (16 * mt + i16) * P + (32 * ks + 8 * g) * 2); sc[mt] = __builtin_amdgcn_mfma_f32_16x16x32_bf16(kf, qf[ks], sc[mt], 0, 0, 0); }
#pragma unroll
                for (int r = 0; r < 4; ++r) { const bool ok = (16 * mt + 4 * g + r) < nvalid; const float x = ok ? sc[mt][r] * sscale : -1e30f; sc[mt][r] = x; mx = fmaxf(mx, x); } }
            mx = fmaxf(mx, __shfl_xor(mx, 16)); mx = fmaxf(mx, __shfl_xor(mx, 32));
            float ps = 0.f;
#pragma unroll
            for (int mt = 0; mt < 8; ++mt)
#pragma unroll
                for (int r = 0; r < 4; ++r) { const bool ok = (16 * mt + 4 * g + r) < nvalid; const float pv = ok ? __builtin_amdgcn_exp2f(sc[mt][r] - mx) : 0.f; sc[mt][r] = pv; ps += pv; }
            ps += __shfl_xor(ps, 16); ps += __shfl_xor(ps, 32);
            const float inv = ps > 0.f ? 1.f / ps : 0.f;
#pragma unroll
            for (int mt = 0; mt < 8; ++mt)
#pragma unroll
                for (int r = 0; r < 4; ++r) sc[mt][r] *= inv;
            { LAS float* slab = PS + (w >> 2) * 4096 + ql * 128 + 4 * g;
              if (((w >> 1) & 1) == 0) {
#pragma unroll
                  for (int mt = 0; mt < 8; ++mt) *(LAS f32x4*)(slab + 16 * mt) = sc[mt]; }
              __syncthreads();
              if (((w >> 1) & 1) == 1) {
#pragma unroll
                  for (int mt = 0; mt < 8; ++mt) { const f32x4 t = *(const LAS f32x4*)(slab + 16 * mt); *(LAS f32x4*)(slab + 16 * mt) = t + sc[mt]; } } }
            f32x4 O[8];
#pragma unroll
            for (int nt = 0; nt < 8; ++nt) O[nt] = (f32x4){0.f, 0.f, 0.f, 0.f};
#pragma unroll
            for (int k2 = 0; k2 < 4; ++k2) { v4u wv; wv.x = pk2(sc[2 * k2][0], sc[2 * k2][1]); wv.y = pk2(sc[2 * k2][2], sc[2 * k2][3]); wv.z = pk2(sc[2 * k2 + 1][0], sc[2 * k2 + 1][1]); wv.w = pk2(sc[2 * k2 + 1][2], sc[2 * k2 + 1][3]);
                const bf16x8 pf = __builtin_bit_cast(bf16x8, wv);
#pragma unroll
                for (int nt = 0; nt < 8; ++nt) {
                    const v4i16_t a = __builtin_amdgcn_ds_read_tr16_b64_v4i16((LAS v4i16_t*)(VT + (32 * k2 + 4 * g + q4) * P + (16 * nt + 4 * p4) * 2));
                    const v4i16_t c = __builtin_amdgcn_ds_read_tr16_b64_v4i16((LAS v4i16_t*)(VT + (32 * k2 + 16 + 4 * g + q4) * P + (16 * nt + 4 * p4) * 2));
                    const bf16x8 vf = (bf16x8){a[0], a[1], a[2], a[3], c[0], c[1], c[2], c[3]};
                    O[nt] = __builtin_amdgcn_mfma_f32_16x16x32_bf16(pf, vf, O[nt], 0, 0, 0); } }
#pragma unroll
            for (int r = 0; r < 4; ++r) { const size_t m = (size_t)(b * NS + q0 + (w & 1) * 16 + 4 * g + r); const float gt = sigmoidf_(bf1(proj[m * CD_INP + 2560 + h * 3 + 0]));
#pragma unroll
                for (int nt = 0; nt < 8; ++nt) ocmp[m * 1024 + h * 128 + 16 * nt + i16] = gt * O[nt][r]; }
            __syncthreads();
#pragma unroll
            for (int qq = 0; qq < 4; ++qq) { const int qi = 4 * w + qq, s = q0 + qi, cur = s >> 6, j = lane & 31;
                float imp = 0.f;
#pragma unroll
                for (int kk = 0; kk < 4; ++kk) { const int n1 = 4 * j + kk; if (n1 <= 126) imp += PS[qi * 128 + n1] + PS[4096 + qi * 128 + n1]; const int n2 = 4 * j - 1 + kk; if (n2 >= 0 && n2 <= 126) imp += PS[qi * 128 + n2] + PS[4096 + qi * 128 + n2]; }
                const bool forced = (j == 0) || (j == cur) || (j == cur - 1);
                const float score = forced ? 1e4f : ((j * 64 <= s) ? imp : -1e30f);
                int rk = 0;
                for (int jj = 0; jj < 32; ++jj) { const float ov = __shfl(score, jj); rk += ((ov > score) || (ov == score && jj < j)) ? 1 : 0; }
                const bool sel = (lane < 32) && (rk < 16) && (j <= cur);
                const unsigned long long bal = __ballot(sel);
                if (lane == 0) selm[(size_t)(b * NS + s) * 2 + gq] = (unsigned)bal; }
        }
    }
}

namespace fa {
typedef short v4i16_t __attribute__((ext_vector_type(4)));
struct Src { const bf16* k1; size_t ks1; const bf16* k2; size_t ks2; const bf16* v; size_t vs; };
template <int DQK> struct Cfg { static constexpr int KPITCH = (DQK + 8) * 2, KBYTES = 64 * KPITCH, VPITCH = 272, VBYTES = 64 * VPITCH, BUF = KBYTES + VBYTES, NKS = DQK / 32, KCH = DQK / 8, NKR = DQK / 64; };

template <int DQK> struct TileOff { unsigned gk[Cfg<DQK>::NKR], gv[2], lk[Cfg<DQK>::NKR], lv[2]; };
template <int DQK>
__device__ __forceinline__ void tile_offsets(const Src& S, int tid, TileOff<DQK>& T) {
#pragma unroll
    for (int i = 0; i < 2; ++i) { const int c = tid + 512 * i, row = c >> 4, c8 = c & 15;
        T.gk[i] = (unsigned)(row * (int)S.ks1 + c8 * 8) * 2u; T.gv[i] = (unsigned)(row * (int)S.vs + c8 * 8) * 2u;
        T.lk[i] = (unsigned)(row * Cfg<DQK>::KPITCH + c8 * 16); T.lv[i] = (unsigned)(Cfg<DQK>::KBYTES + row * Cfg<DQK>::VPITCH + c8 * 16); }
    if (DQK == 192) { const int row = tid >> 3, c8 = tid & 7; T.gk[Cfg<DQK>::NKR - 1] = (unsigned)(row * (int)S.ks2 + c8 * 8) * 2u; T.lk[Cfg<DQK>::NKR - 1] = (unsigned)(row * Cfg<DQK>::KPITCH + 256 + c8 * 16); }
}
template <int DQK>
__device__ __forceinline__ void load_tile(const Src& S, int k0, const TileOff<DQK>& T, v4u (&kr)[Cfg<DQK>::NKR], v4u (&vr)[2]) {
    const char* kb1 = (const char*)S.k1 + (size_t)k0 * S.ks1 * 2; const char* vb = (const char*)S.v + (size_t)k0 * S.vs * 2;
#pragma unroll
    for (int i = 0; i < 2; ++i) { kr[i] = *(const v4u*)(kb1 + T.gk[i]); vr[i] = *(const v4u*)(vb + T.gv[i]); }
    if (DQK == 192) { const char* kb2 = (const char*)S.k2 + (size_t)k0 * S.ks2 * 2; kr[Cfg<DQK>::NKR - 1] = *(const v4u*)(kb2 + T.gk[Cfg<DQK>::NKR - 1]); }
}
template <int DQK>
__device__ __forceinline__ void store_tile(LAS unsigned char* buf, const TileOff<DQK>& T, const v4u (&kr)[Cfg<DQK>::NKR], const v4u (&vr)[2]) {
#pragma unroll
    for (int i = 0; i < Cfg<DQK>::NKR; ++i) *(LAS v4u*)(buf + T.lk[i]) = kr[i];
#pragma unroll
    for (int i = 0; i < 2; ++i) *(LAS v4u*)(buf + T.lv[i]) = vr[i];
}
struct RowState { int spos; unsigned rowmask; float m_run, l_run; };
template <int MODE> __device__ __forceinline__ bool group_needs(int t, const RowState& R) {
    bool row_any = (t * 64 <= R.spos);
    if (MODE == 1) row_any = row_any && ((R.rowmask >> t) & 1u);
    if (MODE == 2) row_any = row_any && (t * 64 + 63 + 512 > R.spos);
    return __ballot(row_any) != 0ull;
}
template <int MODE>
__device__ __forceinline__ void softmax_group(f32x4 (&sc)[4], int t, RowState& R, f32x4 (&O)[8], bf16x8 (&pf)[2], int g) {
    float mx = -1e30f;
    bool row_full = (t * 64 + 63 <= R.spos);
    if (MODE == 1) row_full = row_full && ((R.rowmask >> t) & 1u);
    if (MODE == 2) row_full = row_full && (t * 64 + 512 > R.spos);
    if (__ballot(row_full) == ~0ull) {
#pragma unroll
        for (int mt = 0; mt < 4; ++mt)
#pragma unroll
            for (int r = 0; r < 4; ++r) mx = fmaxf(mx, sc[mt][r]);
    } else {
#pragma unroll
        for (int mt = 0; mt < 4; ++mt)
#pragma unroll
            for (int r = 0; r < 4; ++r) { const int kp = t * 64 + 16 * mt + 4 * g + r; bool ok = kp <= R.spos;
                if (MODE == 1) ok = ok && ((R.rowmask >> t) & 1u);
                if (MODE == 2) ok = ok && (kp + 512 > R.spos);
                const float x = ok ? sc[mt][r] : -3e38f; sc[mt][r] = x; mx = fmaxf(mx, x); }
        mx = fmaxf(mx, -1e30f);
    }
    mx = fmaxf(mx, __shfl_xor(mx, 16)); mx = fmaxf(mx, __shfl_xor(mx, 32));
    if (__ballot(mx > R.m_run + 8.0f) != 0ull) {
        const float m_new = fmaxf(R.m_run, mx), alpha = __builtin_amdgcn_exp2f(R.m_run - m_new); R.m_run = m_new;
        R.l_run *= alpha;
        float ar[4];
#pragma unroll
        for (int r = 0; r < 4; ++r) ar[r] = __shfl(alpha, 4 * g + r);
#pragma unroll
        for (int nt = 0; nt < 8; ++nt)
#pragma unroll
            for (int r = 0; r < 4; ++r) O[nt][r] *= ar[r];
    }
    float ps = 0.f;
#pragma unroll
    for (int mt = 0; mt < 4; ++mt)
#pragma unroll
        for (int r = 0; r < 4; ++r) { const float pv = __builtin_amdgcn_exp2f(sc[mt][r] - R.m_run); sc[mt][r] = pv; ps += pv; }
    R.l_run += ps;
#pragma unroll
    for (int k2 = 0; k2 < 2; ++k2) { v4u w; w.x = pk2(sc[2 * k2][0], sc[2 * k2][1]); w.y = pk2(sc[2 * k2][2], sc[2 * k2][3]); w.z = pk2(sc[2 * k2 + 1][0], sc[2 * k2 + 1][1]); w.w = pk2(sc[2 * k2 + 1][2], sc[2 * k2 + 1][3]);
        pf[k2] = __builtin_bit_cast(bf16x8, w); }
}
template <int DQK, int MODE>
__device__ __forceinline__ void fa_compute(LAS unsigned char* kb, LAS unsigned char* vb, const bf16x8 (&qf0)[Cfg<DQK>::NKS], const bf16x8 (&qf1)[Cfg<DQK>::NKS], int t, RowState& R0, RowState& R1, float sscale,
                                           f32x4 (&O0)[8], f32x4 (&O1)[8], int i16, int g, int q4, int p4) {
    typedef Cfg<DQK> C;
    const bool n0 = group_needs<MODE>(t, R0), n1 = group_needs<MODE>(t, R1);
    if (!n0 && !n1) return;
    f32x4 s0[4], s1[4];
#pragma unroll
    for (int mt = 0; mt < 4; ++mt) { s0[mt] = (f32x4){0.f, 0.f, 0.f, 0.f}; s1[mt] = (f32x4){0.f, 0.f, 0.f, 0.f};
#pragma unroll
        for (int ks = 0; ks < C::NKS; ++ks) { const bf16x8 kf = *(const LAS bf16x8*)(kb + (16 * mt + i16) * C::KPITCH + (32 * ks + 8 * g) * 2);
            s0[mt] = __builtin_amdgcn_mfma_f32_16x16x32_bf16(kf, qf0[ks], s0[mt], 0, 0, 0);
            s1[mt] = __builtin_amdgcn_mfma_f32_16x16x32_bf16(kf, qf1[ks], s1[mt], 0, 0, 0); } }
    bf16x8 p0[2], p1[2];
    if (n0) softmax_group<MODE>(s0, t, R0, O0, p0, g); else { p0[0] = (bf16x8){0, 0, 0, 0, 0, 0, 0, 0}; p0[1] = p0[0]; }
    if (n1) softmax_group<MODE>(s1, t, R1, O1, p1, g); else { p1[0] = (bf16x8){0, 0, 0, 0, 0, 0, 0, 0}; p1[1] = p1[0]; }
#pragma unroll
    for (int nt = 0; nt < 8; ++nt)
#pragma unroll
        for (int k2 = 0; k2 < 2; ++k2) {
            const v4i16_t a = __builtin_amdgcn_ds_read_tr16_b64_v4i16((LAS v4i16_t*)(vb + (32 * k2 + 4 * g + q4) * C::VPITCH + (16 * nt + 4 * p4) * 2));
            const v4i16_t b = __builtin_amdgcn_ds_read_tr16_b64_v4i16((LAS v4i16_t*)(vb + (32 * k2 + 16 + 4 * g + q4) * C::VPITCH + (16 * nt + 4 * p4) * 2));
            const bf16x8 vf = (bf16x8){a[0], a[1], a[2], a[3], b[0], b[1], b[2], b[3]};
            O0[nt] = __builtin_amdgcn_mfma_f32_16x16x32_bf16(p0[k2], vf, O0[nt], 0, 0, 0);
            O1[nt] = __builtin_amdgcn_mfma_f32_16x16x32_bf16(p1[k2], vf, O1[nt], 0, 0, 0); }
}
template <int DQK, int MODE>
__device__ __forceinline__ void fa_pass(LAS unsigned char* lds, const Src& S, const bf16x8 (&qf0)[Cfg<DQK>::NKS], const bf16x8 (&qf1)[Cfg<DQK>::NKS], unsigned tmask, RowState& R0, RowState& R1, float sscale,
                                        f32x4 (&O0)[8], f32x4 (&O1)[8], int tid, int lane) {
    typedef Cfg<DQK> C;
    const int i16 = lane & 15, g = lane >> 4, q4 = (lane & 15) >> 2, p4 = lane & 3;
#pragma unroll
    for (int nt = 0; nt < 8; ++nt) { O0[nt] = (f32x4){0.f, 0.f, 0.f, 0.f}; O1[nt] = (f32x4){0.f, 0.f, 0.f, 0.f}; }
    R0.m_run = -1e30f; R0.l_run = 0.f; R1.m_run = -1e30f; R1.l_run = 0.f;
    unsigned rem = tmask;
    if (rem == 0u) return;
    v4u kr[C::NKR], vr[2]; TileOff<DQK> TO; tile_offsets<DQK>(S, tid, TO);
    int t = __builtin_ctz(rem); rem &= rem - 1u;
    load_tile<DQK>(S, t * 64, TO, kr, vr);
    __syncthreads();
    store_tile<DQK>(lds, TO, kr, vr);
    __syncthreads();
    int cur = 0;
    for (;;) {
        const bool has_next = rem != 0u; int tn = 0;
        if (has_next) { tn = __builtin_ctz(rem); rem &= rem - 1u; load_tile<DQK>(S, tn * 64, TO, kr, vr); }
        LAS unsigned char* kb = lds + cur * C::BUF;
        fa_compute<DQK, MODE>(kb, kb + C::KBYTES, qf0, qf1, t, R0, R1, sscale, O0, O1, i16, g, q4, p4);
        if (has_next) store_tile<DQK>(lds + (cur ^ 1) * C::BUF, TO, kr, vr);
        __syncthreads();
        if (!has_next) break;
        t = tn; cur ^= 1;
    }
}
__device__ __forceinline__ void row_inv(float l_run, int lane, float (&inv)[4]) {
    float l = l_run; l += __shfl_xor(l, 16); l += __shfl_xor(l, 32);
    const float li = l > 0.f ? 1.f / l : 0.f; const int g = lane >> 4;
#pragma unroll
    for (int r = 0; r < 4; ++r) inv[r] = __shfl(li, 4 * g + r);
}
__device__ __forceinline__ void scale_frag(bf16x8& f, float sc) {
    v4u w = __builtin_bit_cast(v4u, f); float x[8]; unpack8(w, x);
    w.x = pk2(x[0] * sc, x[1] * sc); w.y = pk2(x[2] * sc, x[3] * sc); w.z = pk2(x[4] * sc, x[5] * sc); w.w = pk2(x[6] * sc, x[7] * sc); f = __builtin_bit_cast(bf16x8, w);
}
__device__ __forceinline__ void rope_qpe(bf16x8& f4, bf16x8& f5, float pz, int g4) {
    v4u w1 = __builtin_bit_cast(v4u, f4), w2 = __builtin_bit_cast(v4u, f5); float x1[8], x2[8]; unpack8(w1, x1); unpack8(w2, x2);
#pragma unroll
    for (int jj = 0; jj < 8; ++jj) { const float invf = exp2f(-(float)(8 * g4 + jj) * (13.287712379549449f / 32.f)); float sn, cs; fast_sincos(pz * invf, sn, cs);
        const float a = x1[jj] * cs - x2[jj] * sn, c = x1[jj] * sn + x2[jj] * cs; x1[jj] = a; x2[jj] = c; }
    w1.x = pk2(x1[0], x1[1]); w1.y = pk2(x1[2], x1[3]); w1.z = pk2(x1[4], x1[5]); w1.w = pk2(x1[6], x1[7]);
    w2.x = pk2(x2[0], x2[1]); w2.y = pk2(x2[2], x2[3]); w2.z = pk2(x2[4], x2[5]); w2.w = pk2(x2[6], x2[7]);
    f4 = __builtin_bit_cast(bf16x8, w1); f5 = __builtin_bit_cast(bf16x8, w2);
}
}

__device__ __forceinline__ void p_attn_mla(Frame& F, unsigned* queue) {
    const bf16* proj = (const bf16*)(F.ws + WS_PROJ); bf16* mixin = (bf16*)(F.ws + WS_MIXIN); const float* ocmp = (const float*)(F.ws + WS_OCMP); const unsigned* selm = (const unsigned*)(F.ws + WS_SELM);
    const bf16* qmla = (const bf16*)(F.ws + WS_QMLA); const bf16* kvu = (const bf16*)(F.ws + WS_KVU); const bf16* krot = (const bf16*)(F.ws + WS_KROT);
    volatile LAS unsigned* qslot = (volatile LAS unsigned*)(F.lds + LDSCTL_OFF);
    const int lane = F.lane, w = F.wave, i16 = lane & 15, g4 = lane >> 4;
    for (;;) {
        __syncthreads();
        if (F.tid == 0) qslot[0] = atomicAdd(queue, 1u);
        __syncthreads();
        const int u = __builtin_amdgcn_readfirstlane((int)qslot[0]);
        if (u >= 512) break;
        {
            const int qt = 7 - (u >> 6), bh = u & 63, b = bh >> 3, h = bh & 7, q0 = qt * 256;
            fa::RowState R0, R1; R0.spos = q0 + 32 * w + i16; R1.spos = R0.spos + 16; R0.rowmask = 0u; R1.rowmask = 0u;
            bf16x8 qf0[6], qf1[6];
#pragma unroll
            for (int ks = 0; ks < 6; ++ks) { qf0[ks] = *(const bf16x8*)(qmla + (size_t)(b * NS + R0.spos) * 1536 + h * 192 + 32 * ks + 8 * g4); qf1[ks] = *(const bf16x8*)(qmla + (size_t)(b * NS + R1.spos) * 1536 + h * 192 + 32 * ks + 8 * g4); }
            fa::rope_qpe(qf0[4], qf0[5], (float)((const int*)kin(1))[b * NS + R0.spos], g4);
            fa::rope_qpe(qf1[4], qf1[5], (float)((const int*)kin(1))[b * NS + R1.spos], g4);
#pragma unroll
            for (int ks = 0; ks < 6; ++ks) { fa::scale_frag(qf0[ks], 0.07216878364870322f * 1.4426950408889634f); fa::scale_frag(qf1[ks], 0.07216878364870322f * 1.4426950408889634f); }
            fa::Src S; S.k1 = kvu + (size_t)(b * NS) * 2048 + h * 256; S.ks1 = 2048; S.k2 = krot + (size_t)(b * NS) * 64; S.ks2 = 64; S.v = S.k1 + 128; S.vs = 2048;
            const int last = (q0 + 255) >> 6; const unsigned tmask = last >= 31 ? 0xffffffffu : ((1u << (last + 1)) - 1u);
            f32x4 O0[8], O1[8];
            fa::fa_pass<192, 0>(F.lds, S, qf0, qf1, tmask, R0, R1, 0.07216878364870322f * 1.4426950408889634f, O0, O1, F.tid, lane);
            float inv[4];
            fa::row_inv(R0.l_run, lane, inv);
#pragma unroll
            for (int r = 0; r < 4; ++r) { bf16* orow = mixin + (size_t)(b * NS + q0 + 32 * w + 4 * g4 + r) * ND + 1024 + h * 128 + i16;
#pragma unroll
                for (int nt = 0; nt < 8; ++nt) orow[16 * nt] = (bf16)f2bf(O0[nt][r] * inv[r]); }
            fa::row_inv(R1.l_run, lane, inv);
#pragma unroll
            for (int r = 0; r < 4; ++r) { bf16* orow = mixin + (size_t)(b * NS + q0 + 32 * w + 16 + 4 * g4 + r) * ND + 1024 + h * 128 + i16;
#pragma unroll
                for (int nt = 0; nt < 8; ++nt) orow[16 * nt] = (bf16)f2bf(O1[nt][r] * inv[r]); }
        }
    }
    (void)proj; (void)ocmp; (void)selm;
}
__device__ __forceinline__ void p_attn_nsa(Frame& F, unsigned* queue) {
    const bf16* proj = (const bf16*)(F.ws + WS_PROJ); bf16* mixin = (bf16*)(F.ws + WS_MIXIN); const float* ocmp = (const float*)(F.ws + WS_OCMP); const unsigned* selm = (const unsigned*)(F.ws + WS_SELM);
    const bf16* qmla = (const bf16*)(F.ws + WS_QMLA); const bf16* kvu = (const bf16*)(F.ws + WS_KVU); const bf16* krot = (const bf16*)(F.ws + WS_KROT);
    volatile LAS unsigned* qslot = (volatile LAS unsigned*)(F.lds + LDSCTL_OFF);
    const int lane = F.lane, w = F.wave, i16 = lane & 15, g4 = lane >> 4;
    for (;;) {
        __syncthreads();
        if (F.tid == 0) qslot[0] = atomicAdd(queue, 1u);
        __syncthreads();
        const int u = __builtin_amdgcn_readfirstlane((int)qslot[0]);
        if (u >= 512) break;
        {
            const int v = u;
            const int qt = 31 - (v >> 4), bg = v & 15, b = bg >> 1, gq = bg & 1, q0 = qt * 64;
            const int h = gq * 4 + (w >> 1), qb = q0 + (w & 1) * 32;
            fa::RowState R0, R1; R0.spos = qb + i16; R1.spos = qb + 16 + i16;
            bf16x8 qf0[4], qf1[4];
#pragma unroll
            for (int ks = 0; ks < 4; ++ks) { qf0[ks] = *(const bf16x8*)(proj + (size_t)(b * NS + R0.spos) * CD_INP + h * 128 + 32 * ks + 8 * g4); qf1[ks] = *(const bf16x8*)(proj + (size_t)(b * NS + R1.spos) * CD_INP + h * 128 + 32 * ks + 8 * g4); }
#pragma unroll
            for (int ks = 0; ks < 4; ++ks) { fa::scale_frag(qf0[ks], 0.08838834764831845f * 1.4426950408889634f); fa::scale_frag(qf1[ks], 0.08838834764831845f * 1.4426950408889634f); }
            R0.rowmask = selm[(size_t)(b * NS + R0.spos) * 2 + gq]; R1.rowmask = selm[(size_t)(b * NS + R1.spos) * 2 + gq];
            unsigned um = selm[(size_t)(b * NS + q0 + lane) * 2 + gq];
#pragma unroll
            for (int o = 1; o < 64; o <<= 1) um |= (unsigned)__shfl_xor((int)um, o);
            um = (unsigned)__builtin_amdgcn_readfirstlane((int)um);
            const bf16* base = proj + (size_t)(b * NS) * CD_INP;
            const float sscale = 0.08838834764831845f * 1.4426950408889634f;
            f32x4 O0[8], O1[8]; float inv[4];
            { fa::Src S; S.k1 = base + 1024 + ((1 * 2 + 0) * 2 + gq) * 128; S.ks1 = CD_INP; S.k2 = nullptr; S.ks2 = 0; S.v = base + 1024 + ((1 * 2 + 1) * 2 + gq) * 128; S.vs = CD_INP;
              fa::fa_pass<128, 1>(F.lds, S, qf0, qf1, um, R0, R1, sscale, O0, O1, F.tid, lane); }
            fa::row_inv(R0.l_run, lane, inv);
#pragma unroll
            for (int r = 0; r < 4; ++r) { const size_t m = (size_t)(b * NS + qb + 4 * g4 + r); const float g1 = sigmoidf_(bf1(proj[m * CD_INP + 2560 + h * 3 + 1])) * inv[r];
#pragma unroll
                for (int nt = 0; nt < 8; ++nt) mixin[m * ND + h * 128 + 16 * nt + i16] = (bf16)f2bf(ocmp[m * 1024 + h * 128 + 16 * nt + i16] + O0[nt][r] * g1); }
            fa::row_inv(R1.l_run, lane, inv);
#pragma unroll
            for (int r = 0; r < 4; ++r) { const size_t m = (size_t)(b * NS + qb + 16 + 4 * g4 + r); const float g1 = sigmoidf_(bf1(proj[m * CD_INP + 2560 + h * 3 + 1])) * inv[r];
#pragma unroll
                for (int nt = 0; nt < 8; ++nt) mixin[m * ND + h * 128 + 16 * nt + i16] = (bf16)f2bf(ocmp[m * 1024 + h * 128 + 16 * nt + i16] + O1[nt][r] * g1); }
            { fa::Src S; S.k1 = base + 1024 + ((2 * 2 + 0) * 2 + gq) * 128; S.ks1 = CD_INP; S.k2 = nullptr; S.ks2 = 0; S.v = base + 1024 + ((2 * 2 + 1) * 2 + gq) * 128; S.vs = CD_INP;
              const int klo = q0 - 511 > 0 ? q0 - 511 : 0, tlo = klo >> 6, thi = (q0 + 63) >> 6;
              const unsigned hm = thi >= 31 ? 0xffffffffu : ((1u << (thi + 1)) - 1u); const unsigned tmask = hm & ~((1u << tlo) - 1u);
              fa::fa_pass<128, 2>(F.lds, S, qf0, qf1, tmask, R0, R1, sscale, O0, O1, F.tid, lane); }
            fa::row_inv(R0.l_run, lane, inv);
#pragma unroll
            for (int r = 0; r < 4; ++r) { const size_t m = (size_t)(b * NS + qb + 4 * g4 + r); const float g2 = sigmoidf_(bf1(proj[m * CD_INP + 2560 + h * 3 + 2])) * inv[r];
#pragma unroll
                for (int nt = 0; nt < 8; ++nt) { bf16* op = mixin + m * ND + h * 128 + 16 * nt + i16; *op = (bf16)f2bf(bf1(*op) + O0[nt][r] * g2); } }
            fa::row_inv(R1.l_run, lane, inv);
#pragma unroll
            for (int r = 0; r < 4; ++r) { const size_t m = (size_t)(b * NS + qb + 16 + 4 * g4 + r); const float g2 = sigmoidf_(bf1(proj[m * CD_INP + 2560 + h * 3 + 2])) * inv[r];
#pragma unroll
                for (int nt = 0; nt < 8; ++nt) { bf16* op = mixin + m * ND + h * 128 + 16 * nt + i16; *op = (bf16)f2bf(bf1(*op) + O1[nt][r] * g2); } }
        }
    }
    (void)qmla; (void)kvu; (void)krot;
}

constexpr int NPHASE = 33;


#define IN(k) (lo <= (k) && (k) < hi)
#define SEAM(k) do { if (IN(k) && IN((k) + 1)) { if (MK_ONE_LAUNCH) xcd_barrier(bar); else if (F.tid == 0) __hip_atomic_store(F.ctl + CW_TMO, 0xBAD0u | (unsigned)(k), __ATOMIC_RELAXED, __HIP_MEMORY_SCOPE_AGENT); \
    if (MK_PROBE_PHASE >= 0 && blockIdx.x == 0 && F.tid == 0) { if ((k) == MK_PROBE_PHASE - 1) ((volatile LAS unsigned long long*)(F.lds + LDSCTL_OFF + 64))[0] = __builtin_amdgcn_s_memrealtime(); \
        if ((k) == MK_PROBE_LAST) ((volatile LAS unsigned long long*)(F.lds + LDSCTL_OFF + 64))[1] = __builtin_amdgcn_s_memrealtime(); } } } while (0)
template <int l>
__device__ __forceinline__ void layer_body(Frame& F, const XcdBarrier& bar, const int lo, const int hi) {
    unsigned char* ws = F.ws;
    bf16* const XB0 = (bf16*)(ws + WS_XB0); bf16* const X1B = (bf16*)(ws + WS_X1B); bf16* const X2B = (bf16*)(ws + WS_X2B);
    bf16* const PROJ = (bf16*)(ws + WS_PROJ); bf16* const MIXIN = (bf16*)(ws + WS_MIXIN); bf16* const MIXO = (bf16*)(ws + WS_MIXO);
    bf16* const HB = (bf16*)(ws + WS_H); bf16* const Y2 = (bf16*)(ws + WS_Y2);
        const int pb = 1 + l * 16;
        const bf16* xin = l == 0 ? XB0 : X2B;
        if (IN(pb + 0)) {
            if (l == 0) { pg8::DenseProb P; P.init(xin, ND, (const bf16*)(ws + WS_WABIN), NT, AB_IN, ND, F.G, (int)blockIdx.x); pg8::EpiBf16 E{PROJ, AB_IN};
                pg8::gemm_phase<pg8::EpiBf16, pg8::DenseProb, true>(F.lds, P, E); }
            else { pg8::DenseProb P; P.init(xin, ND, (const bf16*)(ws + WS_WCDIN), NT, CD_INP, ND, F.G, (int)blockIdx.x); pg8::EpiBf16 E{PROJ, CD_INP};
                pg8::gemm_phase<pg8::EpiBf16, pg8::DenseProb, true>(F.lds, P, E); }
        } SEAM(pb + 0);
        if (l == 0) {
            if (IN(pb + 2)) { if (blockIdx.x < NB * 6) p_retention_mfma(F, (int)blockIdx.x); else p_pool(F, ((int)blockIdx.x - NB * 6) * NWAVES + F.wave, (F.G - NB * 6) * NWAVES);
                __syncthreads(); p_moe_weights_queue(F, F.ctl + CW_CNT + 320); } SEAM(pb + 2);
        } else {
            if (IN(pb + 1)) { cmp_bias_finish(F); p_l1_thin_a(F); } SEAM(pb + 1);
            if (IN(pb + 2)) {
                if (blockIdx.x < 16) { pg8::CmpProb P; P.K = 4096; P.ldb = 4096; P.Abase = (const char*)(ws + WS_CMPKV); P.Bt = (const char*)(ws + WS_CW1); P.G = 16; P.c = (int)blockIdx.x;
                  pg8::EpiF32 E{(float*)(ws + WS_HID), 256, (const float*)(ws + WS_CMPB)};
                  pg8::gemm_phase<pg8::EpiF32, pg8::CmpProb, true>(F.lds, P, E); }
                else {
                { pg8::DenseProb P; P.init((const bf16*)(ws + WS_CQN), 384, (const bf16*)(ws + WS_WUQ), NT, 1536, 384, F.G - 16, (int)blockIdx.x - 16); pg8::EpiBf16 E{(bf16*)(ws + WS_QMLA), 1536};
                  pg8::gemm_phase<pg8::EpiBf16, pg8::DenseProb, true>(F.lds, P, E); }
                { pg8::DenseProb P; P.init((const bf16*)(ws + WS_CKVN), 512, (const bf16*)(ws + WS_WUKV), NT, 2048, 512, F.G - 16, (int)blockIdx.x - 16); pg8::EpiBf16 E{(bf16*)(ws + WS_KVU), 2048};
                  pg8::gemm_phase<pg8::EpiBf16, pg8::DenseProb, true>(F.lds, P, E); }
                }
            } SEAM(pb + 2);
            if (IN(pb + 3)) { p_l1_thin_b(F); } SEAM(pb + 3);
            if (IN(pb + 4)) { p_nsa_cmp_mfma(F); } SEAM(pb + 4);
            if (IN(pb + 5)) { p_attn_mla(F, F.ctl + CW_CNT + 256); p_attn_nsa(F, F.ctl + CW_CNT + 257); } SEAM(pb + 5);
        }
        if (IN(pb + 6)) { pg8::DenseProb P; P.init(MIXIN, ND, (const bf16*)(ws + (l == 0 ? WS_WABOUT : WS_WCDOUT)), NT, ND, ND, F.G, (int)blockIdx.x); pg8::EpiBf16 E{MIXO, ND};
            pg8::gemm_phase<pg8::EpiBf16, pg8::DenseProb, true>(F.lds, P, E); } SEAM(pb + 6);
        if (IN(pb + 7)) { p_ln1(F, xin, MIXO, kin(15) + l * ND, kin(16) + l * ND, X1B, MK_FP8_MOE ? (unsigned char*)(ws + WS_X1F8) : nullptr); } SEAM(pb + 7);
        if (IN(pb + 8)) { pg8::RouterProb P; P.K = 512; P.ldb = ND; P.Abase = (const char*)X1B; P.Bt = (const char*)(ws + WS_RT + (size_t)l * MiB); P.G = F.G; P.c = (int)blockIdx.x;
            pg8::EpiF32N64 E{(float*)(ws + WS_LOGITS)};
            pg8::gemm_phase<pg8::EpiF32N64, pg8::RouterProb, true>(F.lds, P, E); } SEAM(pb + 8);
        if (IN(pb + 9)) { p_route(F, l); } SEAM(pb + 9);
        if (IN(pb + 10)) { p_scatter(F, l); } SEAM(pb + 10);
        if (IN(pb + 11)) { load_offsets(F, l); const LAS int* tab = (const LAS int*)(F.lds + TAB_OFF);
            pg8::MoeUpProb P; P.W13 = (const char*)(ws + WS_W13 + (size_t)l * WS_MOE_LSTRIDE); P.sorted = (const int*)(ws + WS_SORTED); P.tile_e = tab + 160; P.ntiles = __builtin_amdgcn_readfirstlane(tab[65]);
            P.G = F.G; P.c = (int)blockIdx.x;
            if (MK_FP8_MOE) { P.K = ND / 2; P.ldb = ND / 2; P.arow = ND; P.brow = ND; P.pshift = 3; P.btile = 128; P.nunits = (P.ntiles + NT / 256) * 8; P.Abase = (const char*)(ws + WS_X1F8);
                pg8::EpiSwigluF8 E{(unsigned char*)HB, 1.0f / 64.0f};
                pg8::gemm_phase<pg8::EpiSwigluF8, pg8::MoeUpProb, true, true>(F.lds, P, E); }
            else { P.K = ND; P.ldb = ND; P.arow = ND * 2; P.brow = ND * 2; P.pshift = 2; P.btile = 256; P.nunits = (P.ntiles + NT / 256) * 4; P.Abase = (const char*)X1B;
                pg8::EpiSwiglu E{HB};
                pg8::gemm_phase<pg8::EpiSwiglu, pg8::MoeUpProb, true>(F.lds, P, E); } } SEAM(pb + 11);
        if (IN(pb + 12)) { load_offsets(F, l); const LAS int* tab = (const LAS int*)(F.lds + TAB_OFF);
            pg8::MoeDownProb P; P.Abase = (const char*)HB; P.W2 = (const char*)(ws + WS_W2 + (size_t)l * WS_MOE_LSTRIDE); P.tile_e = tab + 160; P.ntiles = __builtin_amdgcn_readfirstlane(tab[65]);
            P.G = F.G; P.c = (int)blockIdx.x;
            if (MK_FP8_MOE) { P.K = EFF / 2; P.ldb = EFF / 2; P.arow = EFF; P.brow = EFF; P.pshift = 4; P.btile = 128; P.nunits = (P.ntiles + NT / 256) * 16;
                pg8::EpiFp8N128 E{(unsigned char*)Y2, ND, 16.0f / (64.0f * 8.0f)};
                pg8::gemm_phase<pg8::EpiFp8N128, pg8::MoeDownProb, true, true>(F.lds, P, E); }
            else { P.K = EFF; P.ldb = EFF; P.arow = EFF * 2; P.brow = EFF * 2; P.pshift = 3; P.btile = 256; P.nunits = (P.ntiles + NT / 256) * 8;
                pg8::EpiFp8 E{(unsigned char*)Y2, ND, 16.0f};
                pg8::gemm_phase<pg8::EpiFp8, pg8::MoeDownProb, true>(F.lds, P, E); } } SEAM(pb + 12);
        if (IN(pb + 13)) { p_combine_ln2(F, X1B, (const unsigned char*)Y2, (const int*)(ws + WS_SLOT), (const float*)(ws + WS_WSEL), kin(17) + l * ND, kin(18) + l * ND, l == 0 ? X2B : nullptr, l == 0 ? nullptr : F.out); } SEAM(pb + 13);
    }
__global__ void __launch_bounds__(NWAVES * 64, 2) mk_fwd(Args args) {
    extern __shared__ __attribute__((aligned(16))) unsigned char lds[];
    Frame F;
    F.lds = (LAS unsigned char*)lds;
    F.MISC = (volatile LAS unsigned*)(F.lds + MISC_OFF);
    F.tid = threadIdx.x; F.lane = F.tid & 63; F.wave = __builtin_amdgcn_readfirstlane(F.tid >> 6);
    F.G = gridDim.x; { const int bx = blockIdx.x; F.vcu = (F.G % 8 == 0) ? (bx % 8) * (F.G / 8) + bx / 8 : bx; }
    F.gw = F.vcu * NWAVES + F.wave; F.NGW = F.G * NWAVES;
    F.ws = args.ws; F.ctl = (unsigned*)(args.ws + WS_CTL); F.out = args.out;
    for (int u = F.tid; u < (LDS_BYTES - LDSCTL_OFF) / 4; u += NWAVES * 64) ((LAS unsigned*)(F.lds + LDSCTL_OFF))[u] = 0u;
    __syncthreads();
    XcdBarrier bar; bar.bar = F.ctl + CW_BAR; bar.x = 0; bar.st = nullptr;
    if (MK_ONE_LAUNCH) bar = xcd_barrier_post(F.ctl + CW_BAR, F.MISC + 8);
    const int lo = args.ph_lo, hi = args.ph_hi;
    if (MK_PROBE_PHASE == 0 && blockIdx.x == 0 && F.tid == 0) ((volatile LAS unsigned long long*)(F.lds + LDSCTL_OFF + 64))[0] = __builtin_amdgcn_s_memrealtime();
    unsigned char* ws = args.ws;
    bf16* const XB0 = (bf16*)(ws + WS_XB0); bf16* const X1B = (bf16*)(ws + WS_X1B); bf16* const X2B = (bf16*)(ws + WS_X2B);
    bf16* const PROJ = (bf16*)(ws + WS_PROJ); bf16* const MIXIN = (bf16*)(ws + WS_MIXIN); bf16* const MIXO = (bf16*)(ws + WS_MIXO);
    bf16* const HB = (bf16*)(ws + WS_H); bf16* const Y2 = (bf16*)(ws + WS_Y2);

    if (IN(0)) { p_prologue(F); } SEAM(0);

    layer_body<0>(F, bar, lo, hi);
    layer_body<1>(F, bar, lo, hi);
    if (MK_PROBE_PHASE >= 0 && blockIdx.x == 0 && F.tid == 0) {
        volatile LAS unsigned long long* tsl = (volatile LAS unsigned long long*)(F.lds + LDSCTL_OFF + 64);
        if (MK_PROBE_LAST == 30) tsl[1] = __builtin_amdgcn_s_memrealtime();
        const unsigned long long span = (tsl[1] - tsl[0]) * MK_PROBE_AMP, t0 = __builtin_amdgcn_s_memrealtime();
        while (__builtin_amdgcn_s_memrealtime() - t0 < span) __builtin_amdgcn_s_sleep(8);
    }
#undef IN
#undef SEAM
}

extern "C" void kernel_launch(void* const* d_in, const int* in_sizes, int n_in, void* d_out, int out_size, void* d_ws, size_t ws_size, hipStream_t stream) {
    static int grid = 0;
    if (grid == 0) {
        if (n_in != 27 || in_sizes[0] != NT * ND || out_size != NT * ND || ws_size < WS_END) { fprintf(stderr, "kernel_launch: unexpected problem (n_in %d, in0 %d, out %d, ws %zu < %zu); nothing launched\n", n_in, n_in > 0 ? in_sizes[0] : -1, out_size, ws_size, (size_t)WS_END); grid = -1; return; }
        int dev = 0, cus = 0, per_cu = 0;
        if (hipGetDevice(&dev) != hipSuccess || hipDeviceGetAttribute(&cus, hipDeviceAttributeMultiprocessorCount, dev) != hipSuccess) { fprintf(stderr, "kernel_launch: device query failed\n"); grid = -1; return; }
        if (hipFuncSetAttribute((const void*)mk_fwd, hipFuncAttributeMaxDynamicSharedMemorySize, LDS_BYTES) != hipSuccess) { fprintf(stderr, "kernel_launch: hipFuncSetAttribute failed\n"); grid = -1; return; }
        if (hipOccupancyMaxActiveBlocksPerMultiprocessor(&per_cu, (const void*)mk_fwd, NWAVES * 64, LDS_BYTES) != hipSuccess || per_cu < 1) fprintf(stderr, "kernel_launch: note: occupancy query reports %d\n", per_cu);
        (void)hipGetLastError();
        grid = cus;
    }
    if (grid < 0) return;
    if (hipMemsetAsync((char*)d_ws + WS_CTL, 0, CTL_ZERO_BYTES, stream) != hipSuccess) { fprintf(stderr, "kernel_launch: memset failed\n"); return; }
    Args a{};
    for (int i = 0; i < 27; ++i) a.in[i] = (const float*)d_in[i];
    a.out = (float*)d_out; a.ws = (unsigned char*)d_ws;
#if MK_ONE_LAUNCH
    a.ph_lo = 0; a.ph_hi = NPHASE;
    hipLaunchKernelGGL(mk_fwd, dim3(grid), dim3(NWAVES * 64), LDS_BYTES, stream, a);
#else
    for (int p = 0; p < NPHASE; ++p) {
        const int lp = (p - 1) & 15;
        if (p >= 1) { const int l = (p - 1) >> 4; if (lp >= 14) continue; if (l == 0 && lp >= 3 && lp <= 5) continue; }
        a.ph_lo = p; a.ph_hi = p + 1;
        hipLaunchKernelGGL(mk_fwd, dim3(grid), dim3(NWAVES * 64), LDS_BYTES, stream, a);
    }
#endif
    const hipError_t le = hipPeekAtLastError();
    if (le != hipSuccess) fprintf(stderr, "kernel_launch: launch failed: %s\n", hipGetErrorName(le));
}
```

```cpp
#include <hip/hip_runtime.h>
#include <cstdio>
#include <cstdint>

#ifndef MK_ONE_LAUNCH
#define MK_ONE_LAUNCH 1
#endif
#ifndef MK_FP8_MOE
#define MK_FP8_MOE 1
#endif
#ifndef MK_FP8_INPROJ
#define MK_FP8_INPROJ 2
#endif
#define MK_FP8_IN0 ((MK_FP8_INPROJ & 1) != 0)
#define MK_FP8_IN1 ((MK_FP8_INPROJ & 2) != 0)
#ifndef MK_PROBE_PHASE
#define MK_PROBE_PHASE -1
#endif
#ifndef MK_PROBE_LAST
#define MK_PROBE_LAST MK_PROBE_PHASE
#endif
#ifndef MK_PROBE_AMP
#define MK_PROBE_AMP 4
#endif

#define GAS __attribute__((address_space(1)))
#define LAS __attribute__((address_space(3)))
typedef unsigned short bf16;
typedef unsigned v4u __attribute__((ext_vector_type(4)));
typedef unsigned v2u __attribute__((ext_vector_type(2)));
typedef float f32x4 __attribute__((ext_vector_type(4)));
typedef float f32x2 __attribute__((ext_vector_type(2)));
typedef short bf16x8 __attribute__((ext_vector_type(8)));

constexpr int NB = 8, NS = 2048, ND = 2048, NT = NB * NS;
constexpr float DN_ALPHA = 1.41421356237309505f;
constexpr float LN_EPS = 1e-5f, NORM_EPS = 1e-6f;
constexpr int AB_IN = 5120, CD_IN = 3544, CD_INP = 3584;
constexpr int NEXP = 64, EFF = 512;
constexpr int MAXROWS = NT * 8 + NEXP * 256;
constexpr int MAXTILES = MAXROWS / 256;
constexpr int SH_ROW0 = MAXROWS;

constexpr size_t MiB = 1u << 20;
constexpr size_t WS_CTL = 0, CTL_ZERO_BYTES = 1 * MiB;
constexpr size_t WS_TOPE = 1 * MiB, WS_WSEL = WS_TOPE + 512 * 1024, WS_SLOT = 2 * MiB, WS_SORTED = WS_SLOT + 512 * 1024;
constexpr size_t WS_CMPB = 3 * MiB + 256 * 1024, WS_SELM = 3 * MiB + 512 * 1024;
constexpr size_t WS_KVCMP = 4 * MiB;
constexpr size_t WS_HID = 6 * MiB;
constexpr size_t WS_WABIN = 16 * MiB, WS_WABOUT = 36 * MiB, WS_WCDIN = 44 * MiB, WS_WCDOUT = 58 * MiB, WS_WUQ = 66 * MiB, WS_WUKV = 68 * MiB, WS_CW1 = 70 * MiB, WS_RT = 72 * MiB;
constexpr size_t WS_W13 = 74 * MiB, WS_W2 = 334 * MiB, WS_MOE_LSTRIDE = 390 * MiB;
constexpr size_t WS_XB0 = 854 * MiB, WS_X2B = 854 * MiB, WS_X1B = 918 * MiB;
constexpr size_t WS_H = 982 * MiB, WS_Y2 = 1142 * MiB, WS_X1F8 = 1782 * MiB, WS_END = 1814 * MiB;
constexpr size_t WS_PROJ = 982 * MiB, WS_MIXIN = 1142 * MiB, WS_MIXO = 1206 * MiB;
constexpr size_t WS_QR = 1270 * MiB, WS_KR = 1294 * MiB;
constexpr size_t WS_CQN = 1270 * MiB, WS_CKVN = 1282 * MiB, WS_KROT = 1298 * MiB, WS_QMLA = 1302 * MiB, WS_KVU = 1350 * MiB, WS_CMPKV = 1414 * MiB, WS_OCMP = 1434 * MiB;
constexpr size_t WS_LOGITS = 1142 * MiB;
constexpr int CW_TMO = 0, CW_CODE = 1, CW_BAR = 4096, CW_CNT = 16384;

constexpr int RING_BYTES = 131072, LDSCTL_OFF = RING_BYTES, MISC_OFF = LDSCTL_OFF + 320, TAB_OFF = LDSCTL_OFF + 512;
constexpr int LDS_BYTES = 147456;
constexpr int NWAVES = 8;

#define LDS_WAIT() asm volatile("s_waitcnt lgkmcnt(0)" ::: "memory")
#define VM_WAIT() asm volatile("s_waitcnt vmcnt(0)" ::: "memory")
typedef __bf16 hwbf16x2 __attribute__((ext_vector_type(2)));
__device__ __forceinline__ unsigned pk2(float lo, float hi) { const f32x2 v = {lo, hi}; const hwbf16x2 b = __builtin_convertvector(v, hwbf16x2); return __builtin_bit_cast(unsigned, b); }
__device__ __forceinline__ unsigned f2bf(float f) { return pk2(f, 0.f) & 0xffffu; }
__device__ __forceinline__ void fast_sincos(float ang, float& sn, float& cs) { const float r = __builtin_amdgcn_fractf(ang * 0.15915494309189535f); sn = __builtin_amdgcn_sinf(r); cs = __builtin_amdgcn_cosf(r); }
__device__ __forceinline__ float bflo(unsigned w) { return __builtin_bit_cast(float, w << 16); }
__device__ __forceinline__ float bfhi(unsigned w) { return __builtin_bit_cast(float, w & 0xffff0000u); }
__device__ __forceinline__ float bf1(bf16 v) { return __builtin_bit_cast(float, ((unsigned)v) << 16); }
__device__ __forceinline__ float wave_sum(float v) {
#pragma unroll
    for (int o = 1; o < 64; o <<= 1) v += __shfl_xor(v, o);
    return v;
}
__device__ __forceinline__ float wave_max(float v) {
#pragma unroll
    for (int o = 1; o < 64; o <<= 1) v = fmaxf(v, __shfl_xor(v, o));
    return v;
}
__device__ __forceinline__ float sigmoidf_(float x) { return 1.0f / (1.0f + __expf(-x)); }
__device__ __forceinline__ float siluf_(float x) { return x / (1.0f + __expf(-x)); }
__device__ __forceinline__ void unpack8(const v4u w, float (&f)[8]) {
    f[0] = bflo(w.x); f[1] = bfhi(w.x); f[2] = bflo(w.y); f[3] = bfhi(w.y); f[4] = bflo(w.z); f[5] = bfhi(w.z); f[6] = bflo(w.w); f[7] = bfhi(w.w);
}

#define XB_TMO      128
#define XB_XCNT(j)  (256  + 64 * (j))
#define XB_XSUB(j)  (1280 + 64 * (j))
#define XB_XGEN(j)  (2304 + 64 * (j))
#define XB_TOP      3328
#define XB_TOPGEN   3392
#define XCD_BAR_WORDS 3456
#define XB_SPIN_CAP (1u << 18)
__device__ __forceinline__ unsigned xb_ld(unsigned* p)              { return __hip_atomic_load(p, __ATOMIC_RELAXED, __HIP_MEMORY_SCOPE_AGENT); }
__device__ __forceinline__ unsigned xb_add(unsigned* p, unsigned v) { return __hip_atomic_fetch_add(p, v, __ATOMIC_RELAXED, __HIP_MEMORY_SCOPE_AGENT); }
__device__ __forceinline__ unsigned xb_xcc_id() { return (unsigned)__builtin_amdgcn_s_getreg((3 << 11) | 20) & 0xFu; }
#define XB_SPIN(cond, bar) do { unsigned _sp = 0; while (cond) { __builtin_amdgcn_s_sleep(1); \
    if ((++_sp & 255u) == 0u) { if (xb_ld(&(bar)[XB_TMO])) break; if (_sp > XB_SPIN_CAP) { atomicAdd(&(bar)[XB_TMO], 1u); break; } } } } while (0)
struct XcdBarrier { unsigned* bar; unsigned x; volatile LAS unsigned* st; };
__device__ __forceinline__ XcdBarrier xcd_barrier_post(unsigned* bar, volatile LAS unsigned* st) {
    XcdBarrier b; b.bar = bar; b.x = xb_xcc_id(); b.st = st;
    if (threadIdx.x == 0) (void)xb_add(&bar[XB_XCNT(b.x)], 1u);
    return b;
}
__device__ __forceinline__ void xcd_barrier_complete(unsigned* bar, unsigned x, unsigned& nloc, unsigned& nx) {
    const unsigned G = gridDim.x * gridDim.y * gridDim.z;
    unsigned sum, cnt, mine, sp = 0u;
    for (;;) {
        sum = 0u; cnt = 0u; mine = 0u;
#pragma unroll
        for (unsigned j = 0; j < 16; ++j) { const unsigned c = xb_ld(&bar[XB_XCNT(j)]); sum += c; cnt += (c > 0u) ? 1u : 0u; mine = (j == x) ? c : mine; }
        if (sum == G) break;
        __builtin_amdgcn_s_sleep(1);
        if ((++sp & 255u) == 0u) { if (xb_ld(&bar[XB_TMO])) break; if (sp > XB_SPIN_CAP) { atomicAdd(&bar[XB_TMO], 1u); break; } }
    }
    nloc = mine > 0u ? mine : 1u; nx = cnt > 0u ? cnt : 1u;
}
__device__ __forceinline__ void xcd_barrier(const XcdBarrier& b) {
    asm volatile("s_waitcnt vmcnt(0)" ::: "memory");
    __syncthreads();
    if (threadIdx.x == 0) {
        unsigned* bar = b.bar;
        __builtin_amdgcn_s_waitcnt(0);
        unsigned nloc = b.st[0], nx = b.st[1];
        if (nloc == 0u) { xcd_barrier_complete(bar, b.x, nloc, nx); b.st[0] = nloc; b.st[1] = nx; }
        const unsigned old = xb_add(&bar[XB_XSUB(b.x)], 1u);
        const unsigned gen = old / nloc;
        if (old + 1u == (gen + 1u) * nloc) {
            __builtin_amdgcn_fence(__ATOMIC_RELEASE, "agent");
            asm volatile("s_waitcnt vmcnt(0)" ::: "memory");
            const unsigned og = xb_add(&bar[XB_TOP], 1u);
            const unsigned tg = og / nx;
            if (og + 1u == (tg + 1u) * nx) xb_add(&bar[XB_TOPGEN], 1u);
            else XB_SPIN(xb_ld(&bar[XB_TOPGEN]) == tg, bar);
            __builtin_amdgcn_fence(__ATOMIC_ACQUIRE, "agent");
            xb_add(&bar[XB_XGEN(b.x)], 1u);
            asm volatile("s_waitcnt vmcnt(0)" ::: "memory");
        } else {
            XB_SPIN(xb_ld(&bar[XB_XGEN(b.x)]) == gen, bar);
            __builtin_amdgcn_fence(__ATOMIC_ACQUIRE, "agent");
            asm volatile("s_waitcnt vmcnt(0)" ::: "memory");
        }
    }
    __syncthreads();
}

namespace pg8 {
typedef int v4i_t __attribute__((ext_vector_type(4)));
constexpr int BM = 256, BK = 64, HALF = 128, HTB = HALF * BK * 2, STAGE_BYTES = 8 * HTB, NXCD = 8, WGM = 8;
__host__ __device__ __forceinline__ int lds_byte(int r, int c) { const int st = (r >> 4) * 2 + (c >> 5), rr = r & 15, cc = c & 31, ob = rr * 64 + cc * 2; return st * 1024 + (ob ^ (((ob >> 9) & 1) << 5)); }
__host__ __device__ __forceinline__ void stage_rc(int b, int& R, int& C) { const int st = b / 1024, sb = b % 1024, swz = sb ^ (((sb >> 9) & 1) << 5); R = (st >> 1) * 16 + swz / 64; C = (st & 1) * 32 + (swz % 64) / 2; }
__host__ __device__ __forceinline__ int perm32(int rho) { const int n = rho >> 4, i = rho & 15; return 8 * (i >> 2) + 4 * n + (i & 3); }
struct Unit { int pm, pn, e; };

__device__ __forceinline__ unsigned cvt_pk_bf16(float lo, float hi) { unsigned r; asm volatile("v_cvt_pk_bf16_f32 %0, %1, %2" : "=v"(r) : "v"(lo), "v"(hi)); return r; }

struct EpiBf16 {
    static constexpr bool PERM = true;
    bf16* O; int ldc;
    __device__ __forceinline__ void operator()(const f32x4 (&acc)[2][2][4][2], const Unit& u, int wr, int wc, int fr, int fq) const {
        const int row0 = u.pm * BM + wr * 64 + fr, col0 = u.pn * BM + wc * 32 + 8 * fq;
#pragma unroll
        for (int ai = 0; ai < 2; ++ai)
#pragma unroll
            for (int m = 0; m < 4; ++m) { bf16* rowp = O + (size_t)(row0 + ai * HALF + m * 16) * ldc + col0;
#pragma unroll
                for (int bj = 0; bj < 2; ++bj) { const f32x4 v0 = acc[ai][bj][m][0], v1 = acc[ai][bj][m][1];
                    v4u w; w.x = cvt_pk_bf16(v0[0], v0[1]); w.y = cvt_pk_bf16(v0[2], v0[3]); w.z = cvt_pk_bf16(v1[0], v1[1]); w.w = cvt_pk_bf16(v1[2], v1[3]);
                    *(v4u*)(rowp + bj * HALF) = w; } }
    }
};
struct EpiFp8 {
    static constexpr bool PERM = true;
    unsigned char* O; int ldc; float mul;
    __device__ __forceinline__ void operator()(const f32x4 (&acc)[2][2][4][2], const Unit& u, int wr, int wc, int fr, int fq) const {
        const int row0 = u.pm * BM + wr * 64 + fr, col0 = u.pn * BM + wc * 32 + 8 * fq;
#pragma unroll
        for (int ai = 0; ai < 2; ++ai)
#pragma unroll
            for (int m = 0; m < 4; ++m) { unsigned char* rowp = O + (size_t)(row0 + ai * HALF + m * 16) * ldc + col0;
#pragma unroll
                for (int bj = 0; bj < 2; ++bj) { float v[8];
#pragma unroll
                    for (int n = 0; n < 2; ++n)
#pragma unroll
                        for (int j = 0; j < 4; ++j) v[n * 4 + j] = fminf(fmaxf(acc[ai][bj][m][n][j] * mul, -448.0f), 448.0f);
                    int w0 = __builtin_amdgcn_cvt_pk_fp8_f32(v[0], v[1], 0, false); w0 = __builtin_amdgcn_cvt_pk_fp8_f32(v[2], v[3], w0, true);
                    int w1 = __builtin_amdgcn_cvt_pk_fp8_f32(v[4], v[5], 0, false); w1 = __builtin_amdgcn_cvt_pk_fp8_f32(v[6], v[7], w1, true);
                    *(v2u*)(rowp + bj * HALF) = (v2u){(unsigned)w0, (unsigned)w1}; } }
    }
};
struct EpiF32 {
    static constexpr bool PERM = false;
    float* C; int ldc; const float* bias;
    __device__ __forceinline__ void operator()(const f32x4 (&acc)[2][2][4][2], const Unit& u, int wr, int wc, int fr, int fq) const {
        const int row0 = u.pm * BM + wr * 64 + fr, col0 = u.pn * BM + wc * 32 + 4 * fq;
        f32x4 bv[2][2];
#pragma unroll
        for (int bj = 0; bj < 2; ++bj)
#pragma unroll
            for (int n = 0; n < 2; ++n) bv[bj][n] = bias ? *(const f32x4*)(bias + col0 + bj * HALF + n * 16) : (f32x4){0.f, 0.f, 0.f, 0.f};
#pragma unroll
        for (int ai = 0; ai < 2; ++ai)
#pragma unroll
            for (int m = 0; m < 4; ++m) { float* rowp = C + (size_t)(row0 + ai * HALF + m * 16) * ldc + col0;
#pragma unroll
                for (int bj = 0; bj < 2; ++bj)
#pragma unroll
                    for (int n = 0; n < 2; ++n) *(f32x4*)(rowp + bj * HALF + n * 16) = acc[ai][bj][m][n] + bv[bj][n]; }
    }
};
struct EpiSwiglu {
    static constexpr bool PERM = true;
    bf16* H;
    __device__ __forceinline__ void operator()(const f32x4 (&acc)[2][2][4][2], const Unit& u, int wr, int wc, int fr, int fq) const {
        const int row0 = u.pm * BM + wr * 64 + fr, col0 = u.pn * HALF + wc * 32 + 8 * fq;
#pragma unroll
        for (int ai = 0; ai < 2; ++ai)
#pragma unroll
            for (int m = 0; m < 4; ++m) { bf16* rowp = H + (size_t)(row0 + ai * HALF + m * 16) * EFF + col0;
                float o[8];
#pragma unroll
                for (int n = 0; n < 2; ++n)
#pragma unroll
                    for (int j = 0; j < 4; ++j) { const float h1 = acc[ai][0][m][n][j], h3 = acc[ai][1][m][n][j]; o[n * 4 + j] = siluf_(h1) * h3; }
                v4u w; w.x = cvt_pk_bf16(o[0], o[1]); w.y = cvt_pk_bf16(o[2], o[3]); w.z = cvt_pk_bf16(o[4], o[5]); w.w = cvt_pk_bf16(o[6], o[7]);
                *(v4u*)rowp = w; }
    }
};

template <class Epi, class Prob, bool ALIGN_EPI, bool F8 = false>
__device__ __forceinline__ void gemm_phase(LAS unsigned char* lds, const Prob& P, const Epi& E) {
    const int tid = threadIdx.x, wid = __builtin_amdgcn_readfirstlane(tid >> 6), lane = tid & 63, wr = wid >> 2, wc = wid & 3, fr = lane & 15, fq = lane >> 4;
    const int K = P.K, nt = K / BK, ldb = P.ldb;
    unsigned voffB[2];
#pragma unroll
    for (int i = 0; i < 2; ++i) { int R, C; stage_rc(tid * 16 + i * 8192, R, C); const int Rb = Epi::PERM ? ((R & ~31) + perm32(R & 31)) : R;
        voffB[i] = (unsigned)(Rb * ldb + C) * 2u; }
    const size_t kstep = (size_t)(BK * 2);
    const size_t hstep = (size_t)HALF * ldb * 2;
    const unsigned ldsw = (unsigned)wid * 1024u;
    const int aoff = lds_byte(wr * 64 + fr, fq * 8), boff = lds_byte(wc * 32 + fr, fq * 8);
    const char* const Ab = P.Abase;
#define PG8_SA(b, h) (((b) * 2 + (h)) * HTB)
#define PG8_SB(b, h) ((4 + (b) * 2 + (h)) * HTB)
#define PG8_STAGE(bufoff, gbase, voff) do { _Pragma("unroll") for (int _i = 0; _i < 2; ++_i) \
        __builtin_amdgcn_global_load_lds((const unsigned*)((const char*)(gbase) + (voff)[_i]), (LAS unsigned*)(lds + (bufoff) + ldsw + _i * 8192), 16, 0, 0); } while (0)
#define PG8_STAGE_A(bufoff, kb, o0, o1) do { \
        __builtin_amdgcn_global_load_lds((const unsigned*)(Ab + (kb) + (o0)), (LAS unsigned*)(lds + (bufoff) + ldsw), 16, 0, 0); \
        __builtin_amdgcn_global_load_lds((const unsigned*)(Ab + (kb) + (o1)), (LAS unsigned*)(lds + (bufoff) + ldsw + 8192), 16, 0, 0); } while (0)
#define PG8_LDA(dst, b, h) do { _Pragma("unroll") for (int m = 0; m < 4; ++m) _Pragma("unroll") for (int k = 0; k < 2; ++k) dst[m][k] = *(const LAS bf16x8*)(lds + PG8_SA(b, h) + aoff + m * 2048 + k * 1024); } while (0)
#define PG8_LDB(dst, b, h) do { _Pragma("unroll") for (int n = 0; n < 2; ++n) _Pragma("unroll") for (int k = 0; k < 2; ++k) dst[n][k] = *(const LAS bf16x8*)(lds + PG8_SB(b, h) + boff + n * 2048 + k * 1024); } while (0)
#define PG8_CAT(lo, hi) __builtin_shufflevector(__builtin_bit_cast(v4i_t, lo), __builtin_bit_cast(v4i_t, hi), 0, 1, 2, 3, 4, 5, 6, 7)
#define PG8_MMA(ai, bj, At, Bt) do { __builtin_amdgcn_s_setprio(1); \
        if constexpr (F8) { _Pragma("unroll") for (int m = 0; m < 4; ++m) _Pragma("unroll") for (int n = 0; n < 2; ++n) \
            acc[ai][bj][m][n] = __builtin_amdgcn_mfma_scale_f32_16x16x128_f8f6f4(PG8_CAT(Bt[n][0], Bt[n][1]), PG8_CAT(At[m][0], At[m][1]), acc[ai][bj][m][n], 0, 0, 0, 0x7F7F7F7F, 0, 0x7F7F7F7F); } \
        else { _Pragma("unroll") for (int m = 0; m < 4; ++m) _Pragma("unroll") for (int n = 0; n < 2; ++n) _Pragma("unroll") for (int k = 0; k < 2; ++k) \
            acc[ai][bj][m][n] = __builtin_amdgcn_mfma_f32_16x16x32_bf16(Bt[n][k], At[m][k], acc[ai][bj][m][n], 0, 0, 0); } \
        __builtin_amdgcn_s_setprio(0); } while (0)
#define PG8_WAIT_V(n) asm volatile("s_waitcnt vmcnt(" #n ")" ::: "memory")
#define PG8_WAIT_L(n) asm volatile("s_waitcnt lgkmcnt(" #n ")" ::: "memory")
#define PG8_BAR __builtin_amdgcn_s_barrier()
#define PG8_SCHED __builtin_amdgcn_sched_barrier(0)
    Unit cur, nxt; int ui = 0;
    if (!P.next(0, cur)) return;
    f32x4 acc[2][2][4][2];
#pragma unroll
    for (int a = 0; a < 2; ++a)
#pragma unroll
        for (int b = 0; b < 2; ++b)
#pragma unroll
            for (int m = 0; m < 4; ++m)
#pragma unroll
                for (int n = 0; n < 2; ++n) acc[a][b][m][n] = (f32x4){0.f, 0.f, 0.f, 0.f};
    bf16x8 At[4][2], B0[2][2], B1[2][2];
    unsigned oc[4], on[4];
    { int RA[2], CA[2]; stage_rc(tid * 16, RA[0], CA[0]); stage_rc(tid * 16 + 8192, RA[1], CA[1]); P.aoffs(cur, RA, CA, oc); }
    const char* cB = P.bbase(cur);
    if constexpr (F8) {
        PG8_STAGE(PG8_SB(0, 0), cB, voffB); PG8_STAGE_A(PG8_SA(0, 0), (size_t)0, oc[0], oc[1]); PG8_STAGE_A(PG8_SA(0, 1), (size_t)0, oc[2], oc[3]);
        if (wr == 1) PG8_BAR;
        PG8_WAIT_V(2); PG8_BAR;
        PG8_STAGE(PG8_SB(1, 0), cB + kstep, voffB); PG8_STAGE_A(PG8_SA(1, 0), kstep, oc[0], oc[1]);
        PG8_WAIT_V(4); PG8_BAR;
    } else {
    PG8_STAGE(PG8_SB(0, 0), cB, voffB); PG8_STAGE(PG8_SB(0, 1), cB + hstep, voffB); PG8_STAGE_A(PG8_SA(0, 0), (size_t)0, oc[0], oc[1]); PG8_STAGE_A(PG8_SA(0, 1), (size_t)0, oc[2], oc[3]);
    if (wr == 1) PG8_BAR;
    PG8_WAIT_V(2); PG8_BAR;
    PG8_STAGE(PG8_SB(1, 0), cB + kstep, voffB); PG8_STAGE_A(PG8_SA(1, 0), kstep, oc[0], oc[1]); PG8_STAGE(PG8_SB(1, 1), cB + hstep + kstep, voffB);
    PG8_WAIT_V(6); PG8_BAR;
    }
    for (;;) {
        const bool has_next = P.next(ui + 1, nxt);
        const char* nB = cB;
        if (has_next) { int RA[2], CA[2]; stage_rc(tid * 16, RA[0], CA[0]); stage_rc(tid * 16 + 8192, RA[1], CA[1]); P.aoffs(nxt, RA, CA, on); nB = P.bbase(nxt); }
        else { on[0] = oc[0]; on[1] = oc[1]; on[2] = oc[2]; on[3] = oc[3]; }
#pragma clang loop unroll(disable)
        for (int t = 0; t < nt; t += 2) {
            const bool last = (t == nt - 2);
            const size_t kb1 = (size_t)(t + 1) * kstep;
            const size_t kb2 = last ? (size_t)0 : (size_t)(t + 2) * kstep, kb3 = kb2 + kstep;
            const char* b2 = last ? nB : cB + (size_t)(t + 2) * kstep; const char* b3 = b2 + kstep;
            const unsigned o20 = last ? on[0] : oc[0], o21 = last ? on[1] : oc[1], o22 = last ? on[2] : oc[2], o23 = last ? on[3] : oc[3];
            if constexpr (F8) {
            PG8_LDB(B0, 0, 0); PG8_SCHED; PG8_LDA(At, 0, 0); PG8_STAGE_A(PG8_SA(1, 1), kb1, oc[2], oc[3]);
            PG8_WAIT_V(6); PG8_WAIT_L(0); PG8_BAR; PG8_MMA(0, 0, At, B0); PG8_BAR; PG8_SCHED;
            PG8_LDA(At, 0, 1); PG8_STAGE(PG8_SB(0, 0), b2, voffB); PG8_STAGE_A(PG8_SA(0, 0), kb2, o20, o21);
            PG8_WAIT_V(6); PG8_WAIT_L(0); PG8_BAR; PG8_MMA(1, 0, At, B0); PG8_BAR; PG8_SCHED;
            PG8_LDB(B0, 1, 0); PG8_SCHED; PG8_LDA(At, 1, 0); PG8_STAGE_A(PG8_SA(0, 1), kb2, o22, o23);
            PG8_WAIT_V(6); PG8_WAIT_L(0); PG8_BAR; PG8_MMA(0, 0, At, B0); PG8_BAR; PG8_SCHED;
            PG8_LDA(At, 1, 1); PG8_STAGE(PG8_SB(1, 0), b3, voffB); PG8_STAGE_A(PG8_SA(1, 0), kb3, o20, o21);
            PG8_WAIT_V(6); PG8_WAIT_L(0); PG8_BAR; PG8_MMA(1, 0, At, B0); PG8_BAR; PG8_SCHED;
            } else {
            PG8_LDB(B0, 0, 0); PG8_LDB(B1, 0, 1); PG8_SCHED; PG8_LDA(At, 0, 0); PG8_STAGE_A(PG8_SA(1, 1), kb1, oc[2], oc[3]);
            PG8_WAIT_V(8); PG8_WAIT_L(0); PG8_BAR; PG8_MMA(0, 0, At, B0); PG8_MMA(0, 1, At, B1); PG8_BAR; PG8_SCHED;
            PG8_LDA(At, 0, 1); PG8_STAGE(PG8_SB(0, 0), b2, voffB); PG8_STAGE(PG8_SB(0, 1), b2 + hstep, voffB); PG8_STAGE_A(PG8_SA(0, 0), kb2, o20, o21);
            PG8_WAIT_V(8); PG8_WAIT_L(0); PG8_BAR; PG8_MMA(1, 0, At, B0); PG8_MMA(1, 1, At, B1); PG8_BAR; PG8_SCHED;
            PG8_LDB(B0, 1, 0); PG8_LDB(B1, 1, 1); PG8_SCHED; PG8_LDA(At, 1, 0); PG8_STAGE_A(PG8_SA(0, 1), kb2, o22, o23);
            PG8_WAIT_V(8); PG8_WAIT_L(0); PG8_BAR; PG8_MMA(0, 0, At, B0); PG8_MMA(0, 1, At, B1); PG8_BAR; PG8_SCHED;
            PG8_LDA(At, 1, 1); PG8_STAGE(PG8_SB(1, 0), b3, voffB); PG8_STAGE(PG8_SB(1, 1), b3 + hstep, voffB); PG8_STAGE_A(PG8_SA(1, 0), kb3, o20, o21);
            PG8_WAIT_V(8); PG8_WAIT_L(0); PG8_BAR; PG8_MMA(1, 0, At, B0); PG8_MMA(1, 1, At, B1); PG8_BAR; PG8_SCHED;
            }
        }
        if constexpr (ALIGN_EPI) { if (wr == 0) PG8_BAR; }
        E(acc, cur, wr, wc, fr, fq);
        if (!has_next) break;
#pragma unroll
        for (int a = 0; a < 2; ++a)
#pragma unroll
            for (int b = 0; b < 2; ++b)
#pragma unroll
                for (int m = 0; m < 4; ++m)
#pragma unroll
                    for (int n = 0; n < 2; ++n) acc[a][b][m][n] = (f32x4){0.f, 0.f, 0.f, 0.f};
        cur = nxt; cB = nB; oc[0] = on[0]; oc[1] = on[1]; oc[2] = on[2]; oc[3] = on[3]; ++ui;
        if constexpr (ALIGN_EPI) { if (wr == 1) PG8_BAR; }
    }
    PG8_WAIT_V(0);
    if constexpr (!ALIGN_EPI) { if (wr == 0) PG8_BAR; }
    PG8_BAR;
#undef PG8_SA
#undef PG8_SB
#undef PG8_STAGE
#undef PG8_STAGE_A
#undef PG8_LDA
#undef PG8_LDB
#undef PG8_MMA
#undef PG8_CAT
#undef PG8_WAIT_V
#undef PG8_WAIT_L
#undef PG8_BAR
#undef PG8_SCHED
}

struct DenseProb {
    int K, ldb; const char* Abase; const char* Bt; int lda; int nM, nN, nwg, G, c, bn;
    __device__ __forceinline__ void init(const bf16* A, int lda_, const bf16* B, int M, int N, int K_, int G_, int c_, int bn_ = BM) { Abase = (const char*)A; Bt = (const char*)B; lda = lda_; K = K_; ldb = K_; bn = bn_; nM = M / BM; nN = N / bn_; nwg = nM * nN; G = G_; c = c_; }
    __device__ __forceinline__ bool next(int i, Unit& u) const {
        const long L = (long)i * G + c; if (L >= nwg) return false;
        int wgid = (int)L; { const int q = nwg / NXCD, r = nwg % NXCD, xcd = wgid % NXCD, off = wgid / NXCD; wgid = (xcd < r ? xcd * (q + 1) : r * (q + 1) + (xcd - r) * q) + off; }
        const int nig = WGM * nN, gid = wgid / nig, fm = gid * WGM, gsz = (nM - fm) < WGM ? (nM - fm) : WGM;
        u.pm = fm + ((wgid % nig) % gsz); u.pn = (wgid % nig) / gsz; u.e = 0; return true;
    }
    __device__ __forceinline__ const char* bbase(const Unit& u) const { return Bt + (size_t)u.pn * bn * K * 2; }
    __device__ __forceinline__ void aoffs(const Unit& u, const int (&R)[2], const int (&C)[2], unsigned (&o)[4]) const {
#pragma unroll
        for (int h = 0; h < 2; ++h)
#pragma unroll
            for (int i = 0; i < 2; ++i) o[2 * h + i] = (unsigned)(((size_t)(u.pm * BM + h * HALF + R[i]) * lda + C[i]) * 2);
    }
};
__device__ __forceinline__ bool xcd_range_unit(int i, int nunits, int G, int c, int& L) {
    const int x = c % NXCD, cc = c / NXCD, per = G / NXCD, q = nunits / NXCD, r = nunits % NXCD;
    const int start = x * q + (x < r ? x : r), cnt = q + (x < r ? 1 : 0), li = i * per + cc;
    if (li >= cnt) return false; L = start + li; return true;
}
struct MoeUpProb {
    int K, ldb; int arow, brow;
    int pshift, btile;
    const char* Abase; const char* W13; const int* sorted; const LAS int* tile_e; int ntiles, nunits, G, c;
    __device__ __forceinline__ bool next(int i, Unit& u) const {
        int L; if (!xcd_range_unit(i, nunits, G, c, L)) return false;
        const int tile = L >> pshift; u.pn = L & ((1 << pshift) - 1);
        if (tile < ntiles) { u.pm = tile; u.e = __builtin_amdgcn_readfirstlane(tile_e[tile]); } else { u.pm = MAXTILES + (tile - ntiles); u.e = NEXP; }
        return true;
    }
    __device__ __forceinline__ const char* bbase(const Unit& u) const { return W13 + ((size_t)u.e * 1024 + (size_t)u.pn * btile) * brow; }
    __device__ __forceinline__ void aoffs(const Unit& u, const int (&R)[2], const int (&C)[2], unsigned (&o)[4]) const {
#pragma unroll
        for (int h = 0; h < 2; ++h)
#pragma unroll
            for (int i = 0; i < 2; ++i) { int row;
                if (u.e == NEXP) row = (u.pm - MAXTILES) * BM + h * HALF + R[i];
                else row = sorted[u.pm * BM + h * HALF + R[i]];
                o[2 * h + i] = (unsigned)((size_t)row * arow + C[i] * 2); }
    }
};
struct MoeDownProb {
    int K, ldb; int arow, brow, pshift, btile; const char* Abase; const char* W2; const LAS int* tile_e; int ntiles, nunits, G, c;
    __device__ __forceinline__ bool next(int i, Unit& u) const {
        int L; if (!xcd_range_unit(i, nunits, G, c, L)) return false;
        const int tile = L >> pshift; u.pn = L & ((1 << pshift) - 1);
        if (tile < ntiles) { u.pm = tile; u.e = __builtin_amdgcn_readfirstlane(tile_e[tile]); } else { u.pm = MAXTILES + (tile - ntiles); u.e = NEXP; }
        return true;
    }
    __device__ __forceinline__ const char* bbase(const Unit& u) const { return W2 + ((size_t)u.e * 2048 + (size_t)u.pn * btile) * brow; }
    __device__ __forceinline__ void aoffs(const Unit& u, const int (&R)[2], const int (&C)[2], unsigned (&o)[4]) const {
#pragma unroll
        for (int h = 0; h < 2; ++h)
#pragma unroll
            for (int i = 0; i < 2; ++i) o[2 * h + i] = (unsigned)((size_t)(u.pm * BM + h * HALF + R[i]) * arow + C[i] * 2);
    }
};
struct CmpProb {
    int K, ldb; const char* Abase; const char* Bt; int G, c;
    __device__ __forceinline__ bool next(int i, Unit& u) const { const int L = i * G + c; if (L >= 16) return false; u.pm = L; u.pn = 0; u.e = 0; return true; }
    __device__ __forceinline__ const char* bbase(const Unit&) const { return Bt; }
    __device__ __forceinline__ void aoffs(const Unit& u, const int (&R)[2], const int (&C)[2], unsigned (&o)[4]) const {
#pragma unroll
        for (int h = 0; h < 2; ++h)
#pragma unroll
            for (int i = 0; i < 2; ++i) { const int m = u.pm * BM + h * HALF + R[i], seq = m >> 7, n = m & 127;
                o[2 * h + i] = (unsigned)((((size_t)seq * NS + 16 * n) * 128 + C[i]) * 2); }
    }
};
struct RouterProb {
    int K, ldb; const char* Abase; const char* Bt; int G, c;
    __device__ __forceinline__ bool next(int i, Unit& u) const { const int L = i * G + c; if (L >= (NT / BM) * 4) return false; u.pm = L >> 2; u.pn = 0; u.e = L & 3; return true; }
    __device__ __forceinline__ const char* bbase(const Unit& u) const { return Bt + (size_t)u.e * 512 * 2; }
    __device__ __forceinline__ void aoffs(const Unit& u, const int (&R)[2], const int (&C)[2], unsigned (&o)[4]) const {
#pragma unroll
        for (int h = 0; h < 2; ++h)
#pragma unroll
            for (int i = 0; i < 2; ++i) o[2 * h + i] = (unsigned)(((size_t)(u.pm * BM + h * HALF + R[i]) * ND + u.e * 512 + C[i]) * 2);
    }
};
struct EpiF32N64 {
    static constexpr bool PERM = false;
    float* C;
    __device__ __forceinline__ void operator()(const f32x4 (&acc)[2][2][4][2], const Unit& u, int wr, int wc, int fr, int fq) const {
        if (wc >= 2) return;
        const int row0 = u.pm * BM + wr * 64 + fr, col0 = wc * 32 + 4 * fq;
#pragma unroll
        for (int ai = 0; ai < 2; ++ai)
#pragma unroll
            for (int m = 0; m < 4; ++m) { float* rowp = C + ((size_t)u.e * NT + row0 + ai * HALF + m * 16) * 64 + col0;
#pragma unroll
                for (int n = 0; n < 2; ++n) *(f32x4*)(rowp + n * 16) = acc[ai][0][m][n]; }
    }
};
struct EpiSwigluF8 {
    static constexpr bool PERM = true;
    unsigned char* H; float inmul;
    __device__ __forceinline__ void operator()(const f32x4 (&acc)[2][2][4][2], const Unit& u, int wr, int wc, int fr, int fq) const {
        const int row0 = u.pm * BM + wr * 64 + fr, col0 = u.pn * 64 + wc * 16 + 4 * fq;
#pragma unroll
        for (int ai = 0; ai < 2; ++ai)
#pragma unroll
            for (int m = 0; m < 4; ++m) { unsigned char* rowp = H + (size_t)(row0 + ai * HALF + m * 16) * EFF + col0;
                float o[4];
#pragma unroll
                for (int j = 0; j < 4; ++j) { const float h1 = acc[ai][0][m][0][j] * inmul, h3 = acc[ai][0][m][1][j] * inmul; o[j] = fminf(fmaxf(siluf_(h1) * h3 * 8.0f, -448.0f), 448.0f); }
                int w0 = __builtin_amdgcn_cvt_pk_fp8_f32(o[0], o[1], 0, false); w0 = __builtin_amdgcn_cvt_pk_fp8_f32(o[2], o[3], w0, true);
                *(unsigned*)rowp = (unsigned)w0; }
    }
};
struct EpiBf16N128 {
    static constexpr bool PERM = true;
    bf16* O; int ldc; float mul;
    __device__ __forceinline__ void operator()(const f32x4 (&acc)[2][2][4][2], const Unit& u, int wr, int wc, int fr, int fq) const {
        const int row0 = u.pm * BM + wr * 64 + fr, col0 = u.pn * HALF + wc * 32 + 8 * fq;
#pragma unroll
        for (int ai = 0; ai < 2; ++ai)
#pragma unroll
            for (int m = 0; m < 4; ++m) { bf16* rowp = O + (size_t)(row0 + ai * HALF + m * 16) * ldc + col0; const f32x4 v0 = acc[ai][0][m][0] * mul, v1 = acc[ai][0][m][1] * mul;
                v4u w; w.x = cvt_pk_bf16(v0[0], v0[1]); w.y = cvt_pk_bf16(v0[2], v0[3]); w.z = cvt_pk_bf16(v1[0], v1[1]); w.w = cvt_pk_bf16(v1[2], v1[3]);
                *(v4u*)rowp = w; }
    }
};
struct EpiFp8N128 {
    static constexpr bool PERM = true;
    unsigned char* O; int ldc; float mul;
    __device__ __forceinline__ void operator()(const f32x4 (&acc)[2][2][4][2], const Unit& u, int wr, int wc, int fr, int fq) const {
        const int row0 = u.pm * BM + wr * 64 + fr, col0 = u.pn * HALF + wc * 32 + 8 * fq;
#pragma unroll
        for (int ai = 0; ai < 2; ++ai)
#pragma unroll
            for (int m = 0; m < 4; ++m) { unsigned char* rowp = O + (size_t)(row0 + ai * HALF + m * 16) * ldc + col0; float v[8];
#pragma unroll
                for (int n = 0; n < 2; ++n)
#pragma unroll
                    for (int j = 0; j < 4; ++j) v[n * 4 + j] = fminf(fmaxf(acc[ai][0][m][n][j] * mul, -448.0f), 448.0f);
                int w0 = __builtin_amdgcn_cvt_pk_fp8_f32(v[0], v[1], 0, false); w0 = __builtin_amdgcn_cvt_pk_fp8_f32(v[2], v[3], w0, true);
                int w1 = __builtin_amdgcn_cvt_pk_fp8_f32(v[4], v[5], 0, false); w1 = __builtin_amdgcn_cvt_pk_fp8_f32(v[6], v[7], w1, true);
                *(v2u*)rowp = (v2u){(unsigned)w0, (unsigned)w1}; }
    }
};
}

struct Args { const float* in[27]; float* out; unsigned char* ws; int ph_lo, ph_hi; };
typedef const __attribute__((address_space(4))) Args* CArgs;
__device__ __forceinline__ const float* kin(int i) { CArgs p = (CArgs)__builtin_amdgcn_kernarg_segment_ptr(); asm volatile("" : "+s"(p)); return p->in[i]; }
struct Frame {
    LAS unsigned char* lds;
    volatile LAS unsigned* MISC;
    unsigned* ctl;
    unsigned char* ws;
    int tid, lane, wave, vcu, G, gw, NGW;
    float* out;
};

__device__ __forceinline__ void tr_item(const float* W, int ldw, int k0, int n0, int nvalid, bf16* WT, int ldt, int drow0, LAS float* scr, int lane) {
    float v[32]; const int n = lane & 31; const bool okn = n < nvalid; const float* src = W + (size_t)(k0 + (lane >> 5)) * ldw + n0 + n;
#pragma unroll
    for (int i = 0; i < 32; ++i) v[i] = okn ? src[(size_t)(2 * i) * ldw] : 0.f;
#pragma unroll
    for (int i = 0; i < 32; ++i) scr[(2 * i + (lane >> 5)) * 33 + n] = v[i];
    LDS_WAIT(); asm volatile("" ::: "memory");
    const int c = lane & 7;
#pragma unroll
    for (int j = 0; j < 4; ++j) { const int nn = (lane >> 3) + 8 * j; const LAS float* sp = scr + (8 * c) * 33 + nn;
        v4u o; o.x = pk2(sp[0 * 33], sp[1 * 33]); o.y = pk2(sp[2 * 33], sp[3 * 33]); o.z = pk2(sp[4 * 33], sp[5 * 33]); o.w = pk2(sp[6 * 33], sp[7 * 33]);
        if (nn < nvalid) *(v4u*)(WT + (size_t)(drow0 + nn) * ldt + k0 + 8 * c) = o; }
    LDS_WAIT(); asm volatile("" ::: "memory");
}
__device__ __forceinline__ void tr_item_f8(const float* W, int ldw, int k0, int n0, unsigned char* WT8, int ldt, int drow0, int rowmode, float mul, LAS float* scr, int lane, int nvalid = 32) {
    float v[32]; const int n = lane & 31; const float* src = W + (size_t)(k0 + (lane >> 5)) * ldw + n0 + n; const bool okn = n < nvalid;
#pragma unroll
    for (int i = 0; i < 32; ++i) v[i] = okn ? src[(size_t)(2 * i) * ldw] : 0.f;
#pragma unroll
    for (int i = 0; i < 32; ++i) scr[(2 * i + (lane >> 5)) * 33 + n] = v[i];
    LDS_WAIT(); asm volatile("" ::: "memory");
    const int c = lane & 3;
#pragma unroll
    for (int j = 0; j < 2; ++j) { const int nn = (lane >> 2) + 16 * j; const LAS float* sp = scr + (16 * c) * 33 + nn; int w[4];
#pragma unroll
        for (int q = 0; q < 4; ++q) { const float a0 = fminf(fmaxf(sp[(4 * q + 0) * 33] * mul, -448.f), 448.f), a1 = fminf(fmaxf(sp[(4 * q + 1) * 33] * mul, -448.f), 448.f),
                                                  a2 = fminf(fmaxf(sp[(4 * q + 2) * 33] * mul, -448.f), 448.f), a3 = fminf(fmaxf(sp[(4 * q + 3) * 33] * mul, -448.f), 448.f);
            w[q] = __builtin_amdgcn_cvt_pk_fp8_f32(a0, a1, 0, false); w[q] = __builtin_amdgcn_cvt_pk_fp8_f32(a2, a3, w[q], true); }
        const int drow = rowmode ? drow0 + (nn >> 2) * 8 + (nn & 3) : drow0 + nn;
        *(v4u*)(WT8 + (size_t)drow * ldt + k0 + 16 * c) = (v4u){(unsigned)w[0], (unsigned)w[1], (unsigned)w[2], (unsigned)w[3]}; }
    LDS_WAIT(); asm volatile("" ::: "memory");
}
__device__ __forceinline__ bool tr_matrix_f8(int& it, const float* W, int ldw, int K, int c0, int ncols, unsigned char* WT8, int drow0, int nrows_alloc, LAS float* scr, int lane) {
    const int nb = (ncols + 31) / 32, items = (K / 64) * nb;
    if (it >= items) { it -= items; return false; }
    const int kb = it / nb, b = it % nb, nv = ncols - 32 * b;
    (void)nrows_alloc;
    tr_item_f8(W, ldw, 64 * kb, c0 + 32 * b, WT8, K, drow0 + 32 * b, 0, 64.0f, scr, lane, nv < 32 ? nv : 32);
    return true;
}
__device__ __forceinline__ bool tr_matrix(int& it, const float* W, int ldw, int K, int c0, int ncols, bf16* WT, int drow0, LAS float* scr, int lane) {
    const int nb = (ncols + 31) / 32, items = (K / 64) * nb;
    if (it >= items) { it -= items; return false; }
    const int kb = it / nb, b = it % nb, nv = ncols - 32 * b;
    tr_item(W, ldw, 64 * kb, c0 + 32 * b, nv < 32 ? nv : 32, WT, K, drow0 + 32 * b, scr, lane);
    return true;
}
__device__ __forceinline__ void zero_rows(Frame& F, bf16* base, size_t nelem) {
    for (size_t i = ((size_t)F.gw * 64 + F.lane) * 8; i < nelem; i += (size_t)F.NGW * 64 * 8) *(v4u*)(base + i) = (v4u){0u, 0u, 0u, 0u};
}

__device__ __forceinline__ void p_prologue(Frame& F) {
    LAS float* scr = (LAS float*)(F.lds + F.wave * 16384);
    unsigned char* ws = F.ws;
    {
        LAS float* wl = (LAS float*)F.lds;
        LAS float* pl = (LAS float*)(F.lds + 32768);
        const float* w_in = kin(2); const float* pool_w = kin(3); const float* pscale = kin(4);
        bf16* WT = (bf16*)(ws + WS_WABIN);
        for (int it = blockIdx.x; it < 4 * 32; it += F.G) {
            const int g = it >> 5, k0 = (it & 31) * 64;
            for (int i = F.tid; i < 64 * 128; i += 512) wl[i] = w_in[(size_t)(k0 + (i >> 7)) * AB_IN + g * 128 + (i & 127)];
            for (int i = F.tid; i < 128 * 128; i += 512) pl[i] = pool_w[(size_t)g * 16384 + i];
            __syncthreads();
            const int d = F.tid & 127, kg = F.tid >> 7; const float sc = pscale[g * 128 + d];
            for (int kk = 0; kk < 16; kk += 8) {
                float a[8];
#pragma unroll
                for (int j = 0; j < 8; ++j) a[j] = 0.f;
                for (int c = 0; c < 128; ++c) { const float pw = pl[c * 128 + d];
#pragma unroll
                    for (int j = 0; j < 8; ++j) a[j] += wl[(kg * 16 + kk + j) * 128 + c] * pw; }
                if (MK_FP8_IN0) { float q[8];
#pragma unroll
                    for (int j = 0; j < 8; ++j) q[j] = fminf(fmaxf(a[j] * sc * 64.0f, -448.f), 448.f);
                    int w0 = __builtin_amdgcn_cvt_pk_fp8_f32(q[0], q[1], 0, false); w0 = __builtin_amdgcn_cvt_pk_fp8_f32(q[2], q[3], w0, true);
                    int w1 = __builtin_amdgcn_cvt_pk_fp8_f32(q[4], q[5], 0, false); w1 = __builtin_amdgcn_cvt_pk_fp8_f32(q[6], q[7], w1, true);
                    *(v2u*)((unsigned char*)WT + (size_t)(g * 128 + d) * ND + k0 + kg * 16 + kk) = (v2u){(unsigned)w0, (unsigned)w1}; }
                else { v4u o; o.x = pk2(a[0] * sc, a[1] * sc); o.y = pk2(a[2] * sc, a[3] * sc); o.z = pk2(a[4] * sc, a[5] * sc); o.w = pk2(a[6] * sc, a[7] * sc);
                    *(v4u*)(WT + (size_t)(g * 128 + d) * ND + k0 + kg * 16 + kk) = o; }
            }
            __syncthreads();
        }
    }
    __syncthreads();
    for (int it0 = F.gw; ; it0 += F.NGW) {
        int it = it0;
        if (MK_FP8_IN0 ? tr_matrix_f8(it, kin(2), AB_IN, ND, 512, AB_IN - 512, ws + WS_WABIN, 512, AB_IN, scr, F.lane) : tr_matrix(it, kin(2), AB_IN, ND, 512, AB_IN - 512, (bf16*)(ws + WS_WABIN), 512, scr, F.lane)) continue;
        if (tr_matrix(it, kin(5), ND, ND, 0, ND, (bf16*)(ws + WS_WABOUT), 0, scr, F.lane)) continue;
        if (MK_FP8_IN1 ? tr_matrix_f8(it, kin(6), CD_IN, ND, 0, CD_IN, ws + WS_WCDIN, 0, CD_INP, scr, F.lane) : tr_matrix(it, kin(6), CD_IN, ND, 0, CD_IN, (bf16*)(ws + WS_WCDIN), 0, scr, F.lane)) continue;
        if (tr_matrix(it, kin(14), ND, ND, 0, ND, (bf16*)(ws + WS_WCDOUT), 0, scr, F.lane)) continue;
        if (tr_matrix(it, kin(11), 1536, 384, 0, 1536, (bf16*)(ws + WS_WUQ), 0, scr, F.lane)) continue;
        if (tr_matrix(it, kin(13), 2048, 512, 0, 2048, (bf16*)(ws + WS_WUKV), 0, scr, F.lane)) continue;
        if (tr_matrix(it, kin(8), 128, 4096, 0, 128, (bf16*)(ws + WS_CW1), 0, scr, F.lane)) continue;
        if (tr_matrix(it, kin(8) + (size_t)4096 * 128, 128, 4096, 0, 128, (bf16*)(ws + WS_CW1), 128, scr, F.lane)) continue;
        break;
    }
    if (MK_FP8_IN1) zero_rows(F, (bf16*)(ws + WS_WCDIN + (size_t)3552 * ND), (size_t)(CD_INP - 3552) * ND / 2);
    else zero_rows(F, (bf16*)(ws + WS_WCDIN) + (size_t)CD_IN * ND, (size_t)(CD_INP - CD_IN) * ND);
    { const float* x = kin(0); bf16* xb = (bf16*)(ws + WS_XB0); const size_t stride = (size_t)F.NGW * 64 * 8;
      for (size_t i = ((size_t)F.gw * 64 + F.lane) * 8; i < (size_t)NT * ND; i += 4 * stride) {
          f32x4 a[4], c[4];
#pragma unroll
          for (int u = 0; u < 4; ++u) if (i + u * stride < (size_t)NT * ND) { a[u] = *(const f32x4*)(x + i + u * stride); c[u] = *(const f32x4*)(x + i + u * stride + 4); }
#pragma unroll
          for (int u = 0; u < 4; ++u) if (i + u * stride < (size_t)NT * ND) { v4u o; o.x = pk2(a[u][0], a[u][1]); o.y = pk2(a[u][2], a[u][3]); o.z = pk2(c[u][0], c[u][1]); o.w = pk2(c[u][2], c[u][3]); *(v4u*)(xb + i + u * stride) = o;
              if (MK_FP8_IN0) { int w0 = __builtin_amdgcn_cvt_pk_fp8_f32(a[u][0], a[u][1], 0, false); w0 = __builtin_amdgcn_cvt_pk_fp8_f32(a[u][2], a[u][3], w0, true);
                  int w1 = __builtin_amdgcn_cvt_pk_fp8_f32(c[u][0], c[u][1], 0, false); w1 = __builtin_amdgcn_cvt_pk_fp8_f32(c[u][2], c[u][3], w1, true);
                  *(v2u*)(ws + WS_X1F8 + i + u * stride) = (v2u){(unsigned)w0, (unsigned)w1}; } } } }
    for (int o = F.gw; o < 128; o += F.NGW) { const int kv = o >> 6, fc = o & 63; const float* pos = kin(7) + (size_t)kv * 4096 + fc * 64; const float* w1 = kin(8) + ((size_t)kv * 4096 + fc * 64) * 128;
        float s0 = 0.f, s1 = 0.f;
#pragma unroll 8
        for (int f = 0; f < 64; ++f) { const float pf_ = pos[f]; const f32x2 wv = *(const f32x2*)(w1 + (size_t)f * 128 + F.lane * 2); s0 += pf_ * wv[0]; s1 += pf_ * wv[1]; }
        *(f32x2*)((float*)(ws + WS_CMPB) + 256 + (size_t)o * 128 + F.lane * 2) = (f32x2){s0, s1}; }
}
__device__ __forceinline__ void cmp_bias_finish(Frame& F) {
    if (blockIdx.x == 0 && F.tid < 256) { const int kv = F.tid >> 7, h = F.tid & 127; const float* part = (const float*)(F.ws + WS_CMPB) + 256 + (size_t)kv * 64 * 128 + h;
        float sacc = 0.f; for (int fc = 0; fc < 64; ++fc) sacc += part[fc * 128];
        ((float*)(F.ws + WS_CMPB))[F.tid] = sacc; }
}
constexpr int MW_ITEMS_L = 65 * 1536 + 64;
__device__ __forceinline__ void moe_weight_item(int l, int it, unsigned char* ws, LAS float* scr, int lane) {
    bf16* W13 = (bf16*)(ws + WS_W13 + (size_t)l * WS_MOE_LSTRIDE); bf16* W2 = (bf16*)(ws + WS_W2 + (size_t)l * WS_MOE_LSTRIDE); bf16* RT = (bf16*)(ws + WS_RT + (size_t)l * MiB);
    if (it >= 65 * 1536) { const int r = it - 65 * 1536, kb = r >> 1, b = r & 1;
        tr_item(kin(19) + (size_t)l * ND * NEXP, NEXP, 64 * kb, 32 * b, 32, RT, ND, 32 * b, scr, lane); return; }
    const int e = it / 1536, r = it % 1536;
    const float *w1, *w3, *w2;
    if (e < NEXP) { const size_t o = ((size_t)l * NEXP + e) * ND * EFF; w1 = kin(21) + o; w3 = kin(22) + o; w2 = kin(23) + o; }
    else { const size_t o = (size_t)l * ND * EFF; w1 = kin(24) + o; w3 = kin(25) + o; w2 = kin(26) + o; }
    if (r < 1024) { const int which = r >> 9, rr = r & 511, kb = rr >> 4, nb = rr & 15;
        const int j = nb >> 2, drow = j * 256 + which * 128 + (nb & 3) * 32;
        if (MK_FP8_MOE) tr_item_f8(which ? w3 : w1, EFF, 64 * kb, 32 * nb, (unsigned char*)W13 + (size_t)e * 1024 * ND, ND, (nb >> 1) * 128 + (nb & 1) * 64 + which * 4, 1, 64.0f, scr, lane);
        else tr_item(which ? w3 : w1, EFF, 64 * kb, 32 * nb, 32, W13 + (size_t)e * 1024 * ND, ND, drow, scr, lane); }
    else { const int rr = r - 1024, kb = rr >> 6, nb = rr & 63;
        if (MK_FP8_MOE) tr_item_f8(w2, ND, 64 * kb, 32 * nb, (unsigned char*)W2 + (size_t)e * ND * EFF, EFF, 32 * nb, 0, 64.0f, scr, lane);
        else tr_item(w2, ND, 64 * kb, 32 * nb, 32, W2 + (size_t)e * ND * EFF, EFF, 32 * nb, scr, lane); }
}
struct ConvDesc { const float* src; unsigned char* dst; int ldw, ldt, k0, drow0, rowmode, kind; };
__device__ __forceinline__ ConvDesc conv_desc(int id, unsigned char* ws) {
    ConvDesc d; d.kind = -1; d.src = nullptr; d.dst = nullptr; d.ldw = 0; d.ldt = 0; d.k0 = 0; d.drow0 = 0; d.rowmode = 0;
    if (id >= 2 * MW_ITEMS_L) return d;
    const int l = id >= MW_ITEMS_L ? 1 : 0, it = id - l * MW_ITEMS_L;
    if (it >= 65 * 1536 || !MK_FP8_MOE) { d.kind = 1; d.k0 = it; d.drow0 = l; return d; }
    const int e = it / 1536, r = it % 1536;
    const float *w1, *w3, *w2;
    if (e < NEXP) { const size_t o = ((size_t)l * NEXP + e) * ND * EFF; w1 = kin(21) + o; w3 = kin(22) + o; w2 = kin(23) + o; }
    else { const size_t o = (size_t)l * ND * EFF; w1 = kin(24) + o; w3 = kin(25) + o; w2 = kin(26) + o; }
    d.kind = 0;
    if (r < 1024) { const int which = r >> 9, rr = r & 511, kb = rr >> 4, nb = rr & 15;
        d.src = (which ? w3 : w1) + (size_t)(64 * kb) * EFF + 32 * nb; d.ldw = EFF; d.k0 = 64 * kb;
        d.dst = ws + WS_W13 + (size_t)l * WS_MOE_LSTRIDE + (size_t)e * 1024 * ND; d.ldt = ND; d.drow0 = (nb >> 1) * 128 + (nb & 1) * 64 + which * 4; d.rowmode = 1; }
    else { const int rr = r - 1024, kb = rr >> 6, nb = rr & 63;
        d.src = w2 + (size_t)(64 * kb) * ND + 32 * nb; d.ldw = ND; d.k0 = 64 * kb;
        d.dst = ws + WS_W2 + (size_t)l * WS_MOE_LSTRIDE + (size_t)e * ND * EFF; d.ldt = EFF; d.drow0 = 32 * nb; d.rowmode = 0; }
    return d;
}
__device__ __forceinline__ void conv_load(const ConvDesc& d, float (&v)[32], int lane) {
    if (d.kind != 0) return;
    const float* src = d.src + (size_t)(lane >> 5) * d.ldw + (lane & 31);
#pragma unroll
    for (int i = 0; i < 32; ++i) v[i] = src[(size_t)(2 * i) * d.ldw];
}
__device__ __forceinline__ void conv_finish(const ConvDesc& d, const float (&v)[32], unsigned char* ws, LAS float* scr, int lane) {
    if (d.kind == 1) { moe_weight_item(d.drow0, d.k0, ws, scr, lane); return; }
    if (d.kind != 0) return;
    const int n = lane & 31;
#pragma unroll
    for (int i = 0; i < 32; ++i) scr[(2 * i + (lane >> 5)) * 33 + n] = v[i];
    LDS_WAIT(); asm volatile("" ::: "memory");
    const int c = lane & 3;
#pragma unroll
    for (int j = 0; j < 2; ++j) { const int nn = (lane >> 2) + 16 * j; const LAS float* sp = scr + (16 * c) * 33 + nn; int w[4];
#pragma unroll
        for (int q = 0; q < 4; ++q) { const float a0 = fminf(fmaxf(sp[(4 * q + 0) * 33] * 64.0f, -448.f), 448.f), a1 = fminf(fmaxf(sp[(4 * q + 1) * 33] * 64.0f, -448.f), 448.f),
                                                  a2 = fminf(fmaxf(sp[(4 * q + 2) * 33] * 64.0f, -448.f), 448.f), a3 = fminf(fmaxf(sp[(4 * q + 3) * 33] * 64.0f, -448.f), 448.f);
            w[q] = __builtin_amdgcn_cvt_pk_fp8_f32(a0, a1, 0, false); w[q] = __builtin_amdgcn_cvt_pk_fp8_f32(a2, a3, w[q], true); }
        const int drow = d.rowmode ? d.drow0 + (nn >> 2) * 8 + (nn & 3) : d.drow0 + nn;
        *(v4u*)(d.dst + (size_t)drow * d.ldt + d.k0 + 16 * c) = (v4u){(unsigned)w[0], (unsigned)w[1], (unsigned)w[2], (unsigned)w[3]}; }
    LDS_WAIT(); asm volatile("" ::: "memory");
}
__device__ __forceinline__ void p_moe_weights_queue(Frame& F, unsigned* queue) {
    LAS float* scr = (LAS float*)(F.lds + F.wave * 16384);
    constexpr int BATCH = 16, NB_ = (2 * MW_ITEMS_L + BATCH - 1) / BATCH;
    for (;;) {
        unsigned bq = 0; if (F.lane == 0) bq = atomicAdd(queue, 1u);
        const int bi = __builtin_amdgcn_readfirstlane((int)bq);
        if (bi >= NB_) break;
        const int s0 = bi * BATCH;
        float va[32], vb[32];
        ConvDesc dA = conv_desc(s0, F.ws); conv_load(dA, va, F.lane);
        for (int k = 0; k < BATCH; k += 2) {
            ConvDesc dB = conv_desc(s0 + k + 1, F.ws); conv_load(dB, vb, F.lane);
            conv_finish(dA, va, F.ws, scr, F.lane);
            dA = conv_desc(k + 2 < BATCH ? s0 + k + 2 : 2 * MW_ITEMS_L, F.ws); conv_load(dA, va, F.lane);
            conv_finish(dB, vb, F.ws, scr, F.lane);
        }
    }
    for (int l = 0; l < 2; ++l) zero_rows(F, (bf16*)(F.ws + WS_RT + (size_t)l * MiB) + (size_t)NEXP * ND, (size_t)(256 - NEXP) * ND);
}

__device__ __forceinline__ void ln_finish(float (&v)[4][8], const float* g, const float* b, int lane, bf16* ob, float* of, unsigned char* o8 = nullptr) {
    float s = 0.f;
#pragma unroll
    for (int j = 0; j < 4; ++j)
#pragma unroll
        for (int i = 0; i < 8; ++i) s += v[j][i];
    const float mean = wave_sum(s) * (1.f / ND); float s2 = 0.f;
#pragma unroll
    for (int j = 0; j < 4; ++j)
#pragma unroll
        for (int i = 0; i < 8; ++i) { v[j][i] -= mean; s2 += v[j][i] * v[j][i]; }
    const float rstd = 1.f / sqrtf(wave_sum(s2) * (1.f / ND) + LN_EPS);
#pragma unroll
    for (int j = 0; j < 4; ++j) { unsigned c0 = (unsigned)(j * 64 + lane) * 8u; asm volatile("" : "+v"(c0));
        const f32x4 g0 = *(const f32x4*)((const char*)g + c0 * 4u), g1 = *(const f32x4*)((const char*)g + c0 * 4u + 16u), b0 = *(const f32x4*)((const char*)b + c0 * 4u), b1 = *(const f32x4*)((const char*)b + c0 * 4u + 16u);
        float o[8];
#pragma unroll
        for (int i = 0; i < 4; ++i) { o[i] = v[j][i] * rstd * g0[i] + b0[i]; o[4 + i] = v[j][4 + i] * rstd * g1[i] + b1[i]; }
        if (ob) { v4u w; w.x = pk2(o[0], o[1]); w.y = pk2(o[2], o[3]); w.z = pk2(o[4], o[5]); w.w = pk2(o[6], o[7]); *(v4u*)((char*)ob + c0 * 2u) = w; }
        if (of) { *(f32x4*)((char*)of + c0 * 4u) = (f32x4){o[0], o[1], o[2], o[3]}; *(f32x4*)((char*)of + c0 * 4u + 16u) = (f32x4){o[4], o[5], o[6], o[7]}; }
        if (o8) { int w0 = __builtin_amdgcn_cvt_pk_fp8_f32(o[0], o[1], 0, false); w0 = __builtin_amdgcn_cvt_pk_fp8_f32(o[2], o[3], w0, true);
            int w1 = __builtin_amdgcn_cvt_pk_fp8_f32(o[4], o[5], 0, false); w1 = __builtin_amdgcn_cvt_pk_fp8_f32(o[6], o[7], w1, true);
            *(v2u*)(o8 + c0) = (v2u){(unsigned)w0, (unsigned)w1}; } }
}
__device__ __forceinline__ void p_ln1(Frame& F, const bf16* xin, const bf16* mixo, const float* g, const float* b, bf16* xo, unsigned char* xo8) {
    for (int m = F.gw; m < NT; m += F.NGW) {
        float v[4][8];
#pragma unroll
        for (int j = 0; j < 4; ++j) { const size_t o = (size_t)m * ND + (j * 64 + F.lane) * 8; float a[8], c[8]; unpack8(*(const v4u*)(xin + o), a); unpack8(*(const v4u*)(mixo + o), c);
#pragma unroll
            for (int i = 0; i < 8; ++i) v[j][i] = DN_ALPHA * a[i] + c[i]; }
        ln_finish(v, g, b, F.lane, xo + (size_t)m * ND, nullptr, xo8 ? xo8 + (size_t)m * ND : nullptr);
    }
}
__device__ __forceinline__ void unpack8_fp8(const v2u w, float (&f)[8]) {
    const f32x2 a = __builtin_amdgcn_cvt_pk_f32_fp8((int)w.x, false), b = __builtin_amdgcn_cvt_pk_f32_fp8((int)w.x, true), c = __builtin_amdgcn_cvt_pk_f32_fp8((int)w.y, false), d = __builtin_amdgcn_cvt_pk_f32_fp8((int)w.y, true);
    f[0] = a[0]; f[1] = a[1]; f[2] = b[0]; f[3] = b[1]; f[4] = c[0]; f[5] = c[1]; f[6] = d[0]; f[7] = d[1];
}
__device__ __forceinline__ void p_combine_ln2(Frame& F, const bf16* x1, const unsigned char* y2, const int* slot, const float* wsel, const float* g, const float* b, bf16* xo, float* fo, unsigned char* xo8) {
    for (int m = F.gw; m < NT; m += F.NGW) {
        const int myrow = slot[m * 8 + (F.lane & 7)]; const float myw = wsel[m * 8 + (F.lane & 7)] * (1.0f / 16.0f);
        float v[4][8];
        { v4u xa[4]; v2u sa[4];
#pragma unroll
          for (int j = 0; j < 4; ++j) { xa[j] = *(const v4u*)(x1 + (size_t)m * ND + (j * 64 + F.lane) * 8); sa[j] = *(const v2u*)(y2 + (size_t)(SH_ROW0 + m) * ND + (j * 64 + F.lane) * 8); }
#pragma unroll
          for (int j = 0; j < 4; ++j) { float a[8], c[8]; unpack8(xa[j], a); unpack8_fp8(sa[j], c);
#pragma unroll
              for (int i = 0; i < 8; ++i) v[j][i] = DN_ALPHA * a[i] + c[i] * (1.0f / 16.0f); } }
#pragma unroll
        for (int kg = 0; kg < 2; ++kg) { v2u ra[4][4]; float wk[4];
#pragma unroll
            for (int k = 0; k < 4; ++k) { const int row = __builtin_amdgcn_readlane(myrow, kg * 4 + k); wk[k] = __builtin_bit_cast(float, __builtin_amdgcn_readlane(__builtin_bit_cast(int, myw), kg * 4 + k));
#pragma unroll
                for (int j = 0; j < 4; ++j) ra[k][j] = *(const v2u*)(y2 + (size_t)row * ND + (j * 64 + F.lane) * 8); }
#pragma unroll
            for (int k = 0; k < 4; ++k)
#pragma unroll
                for (int j = 0; j < 4; ++j) { float c[8]; unpack8_fp8(ra[k][j], c);
#pragma unroll
                    for (int i = 0; i < 8; ++i) v[j][i] += wk[k] * c[i]; } }
        ln_finish(v, g, b, F.lane, xo ? xo + (size_t)m * ND : nullptr, fo ? fo + (size_t)m * ND : nullptr, xo8 ? xo8 + (size_t)m * ND : nullptr);
    }
}

__device__ __forceinline__ void p_pool(Frame& F, int wid, int nw) {
    const bf16* proj = (const bf16*)(F.ws + WS_PROJ); bf16* mixin = (bf16*)(F.ws + WS_MIXIN);
    for (int m = wid; m < NT; m += nw) {
        const int s = m & (NS - 1);
        const int g = F.lane >> 4, w = 2 << g; const int lo = (s + 1 - w) > 0 ? (s + 1 - w) : 0; const float cnt = (float)((s + 1) < w ? (s + 1) : w);
        float acc[8], cur[8];
#pragma unroll
        for (int i = 0; i < 8; ++i) acc[i] = 0.f;
        for (int j = lo; j <= s; ++j) { float t[8]; unpack8(*(const v4u*)(proj + (size_t)(m - s + j) * AB_IN + F.lane * 8), t);
#pragma unroll
            for (int i = 0; i < 8; ++i) acc[i] += t[i]; }
        unpack8(*(const v4u*)(proj + (size_t)m * AB_IN + F.lane * 8), cur);
        float o[8];
#pragma unroll
        for (int i = 0; i < 8; ++i) o[i] = acc[i] / cnt - cur[i];
        v4u wv; wv.x = pk2(o[0], o[1]); wv.y = pk2(o[2], o[3]); wv.z = pk2(o[4], o[5]); wv.w = pk2(o[6], o[7]); *(v4u*)(mixin + (size_t)m * ND + F.lane * 8) = wv;
    }
}
namespace ret {
typedef short v4i16_t __attribute__((ext_vector_type(4)));
constexpr int PITCH = 272, TILE = 128 * PITCH;
__device__ __forceinline__ bf16x8 trfrag(LAS unsigned char* trb, int r0, int r1, int c0) {
    const v4i16_t a = __builtin_amdgcn_ds_read_tr16_b64_v4i16((LAS v4i16_t*)(trb + r0 * PITCH + c0 * 2));
    const v4i16_t b = __builtin_amdgcn_ds_read_tr16_b64_v4i16((LAS v4i16_t*)(trb + r1 * PITCH + c0 * 2));
    return (bf16x8){a[0], a[1], a[2], a[3], b[0], b[1], b[2], b[3]};
}
}
__device__ __forceinline__ void p_retention_mfma(Frame& F, int bh) {
    const bf16* proj = (const bf16*)(F.ws + WS_PROJ); bf16* mixin = (bf16*)(F.ws + WS_MIXIN); const int* posv = (const int*)kin(1);
    constexpr int P = ret::PITCH;
    LAS unsigned char* KT = F.lds; LAS unsigned char* VT = F.lds + ret::TILE; LAS unsigned char* ST = F.lds + 2 * ret::TILE;
    const int b = bh / 6, h = bh % 6, w = F.wave, lane = F.lane, i16 = lane & 15, g = lane >> 4, q4 = (lane & 15) >> 2, p4 = lane & 3;
    const float lg = log2f(1.0f - exp2f(-5.0f - (float)h)), gc = exp2f(128.f * lg);
    const int rowb = i16 * P + 16 * g;
    const int trl = q4 * P + 8 * p4;
    LAS unsigned char* const trV4 = VT + trl + 4 * g * P;
    LAS unsigned char* const trV8 = VT + trl + 8 * g * P;
    LAS unsigned char* const trK8 = KT + trl + 8 * g * P;
    f32x4 T[2][8];
#pragma unroll
    for (int a = 0; a < 2; ++a)
#pragma unroll
        for (int d = 0; d < 8; ++d) T[a][d] = (f32x4){0.f, 0.f, 0.f, 0.f};
    const int srow = F.tid >> 2, scb = (F.tid & 3) * 4;
    for (int n = 0; n < NS / 128; ++n) {
        const size_t m0 = (size_t)b * NS + n * 128;
        {
          const float fk = exp2f(-(float)srow * lg) * 0.08838834764831845f, pz = (float)posv[m0 + srow]; const int t4 = F.tid & 3;
          const bf16* krow = proj + (m0 + srow) * AB_IN + 1280 + h * 128;
#pragma unroll
          for (int c = 0; c < 2; ++c) { const int c8 = 2 * t4 + c; float x1[8], x2[8];
              unpack8(*(const v4u*)(krow + c8 * 8), x1); unpack8(*(const v4u*)(krow + 64 + c8 * 8), x2);
#pragma unroll
              for (int j = 0; j < 8; ++j) { const float invf = exp2f(-(float)(c8 * 8 + j) * (13.287712379549449f / 64.f)); float sn, cs; fast_sincos(pz * invf, sn, cs);
                  const float a = (x1[j] * cs - x2[j] * sn) * fk, bq = (x1[j] * sn + x2[j] * cs) * fk; x1[j] = a; x2[j] = bq; }
              v4u o; o.x = pk2(x1[0], x1[1]); o.y = pk2(x1[2], x1[3]); o.z = pk2(x1[4], x1[5]); o.w = pk2(x1[6], x1[7]); *(LAS v4u*)(KT + srow * P + c8 * 16) = o;
              o.x = pk2(x2[0], x2[1]); o.y = pk2(x2[2], x2[3]); o.z = pk2(x2[4], x2[5]); o.w = pk2(x2[6], x2[7]); *(LAS v4u*)(KT + srow * P + (c8 + 8) * 16) = o; } }
        bf16x8 qf[4], pf[4]; float rs[4] = {0.f, 0.f, 0.f, 0.f}, rq[4] = {0.f, 0.f, 0.f, 0.f};
        {
          const float fq = exp2f((float)(16 * w + i16) * lg), pz = (float)posv[m0 + 16 * w + i16];
          const bf16* qrow = proj + (m0 + 16 * w + i16) * AB_IN + 512 + h * 128;
#pragma unroll
          for (int ks = 0; ks < 2; ++ks) { float x1[8], x2[8]; unpack8(*(const v4u*)(qrow + 32 * ks + 8 * g), x1); unpack8(*(const v4u*)(qrow + 64 + 32 * ks + 8 * g), x2);
#pragma unroll
              for (int j = 0; j < 8; ++j) { const float invf = exp2f(-(float)(32 * ks + 8 * g + j) * (13.287712379549449f / 64.f)); float sn, cs; fast_sincos(pz * invf, sn, cs);
                  const float a = (x1[j] * cs - x2[j] * sn) * fq, bq = (x1[j] * sn + x2[j] * cs) * fq; x1[j] = a; x2[j] = bq; }
              v4u o; o.x = pk2(x1[0], x1[1]); o.y = pk2(x1[2], x1[3]); o.z = pk2(x1[4], x1[5]); o.w = pk2(x1[6], x1[7]); qf[ks] = __builtin_bit_cast(bf16x8, o);
              o.x = pk2(x2[0], x2[1]); o.y = pk2(x2[2], x2[3]); o.z = pk2(x2[4], x2[5]); o.w = pk2(x2[6], x2[7]); qf[ks + 2] = __builtin_bit_cast(bf16x8, o); } }
#pragma unroll
        for (int hv = 0; hv < 2; ++hv) {
            if (hv == 1) __syncthreads();
#pragma unroll
            for (int c = 0; c < 4; ++c) { const int c8 = scb + c; *(LAS v4u*)(VT + srow * P + c8 * 16) = *(const v4u*)(proj + (m0 + srow) * AB_IN + 2048 + h * 256 + hv * 128 + c8 * 8); }
            { LAS unsigned char* stw = ST + (16 * w + 4 * g) * P + i16 * 2;
#pragma unroll
              for (int dt = 0; dt < 8; ++dt)
#pragma unroll
                for (int r = 0; r < 4; ++r) { T[hv][dt][r] *= gc; *(LAS bf16*)(stw + r * P + dt * 32) = (bf16)f2bf(T[hv][dt][r]); } }
            __syncthreads();
            if (hv == 0) {
                f32x4 sc[8];
#pragma unroll
                for (int mt = 0; mt < 8; ++mt) { sc[mt] = (f32x4){0.f, 0.f, 0.f, 0.f};
                    if (mt <= w) {
#pragma unroll
                        for (int ks = 0; ks < 4; ++ks) { const bf16x8 kf = *(const LAS bf16x8*)(KT + rowb + mt * 16 * P + ks * 64); sc[mt] = __builtin_amdgcn_mfma_f32_16x16x32_bf16(kf, qf[ks], sc[mt], 0, 0, 0); }
                        if (mt == w) {
#pragma unroll
                            for (int r = 0; r < 4; ++r) sc[mt][r] = (4 * g + r <= i16) ? sc[mt][r] : 0.f; } } }
#pragma unroll
                for (int k2 = 0; k2 < 4; ++k2) { v4u wv; wv.x = pk2(sc[2 * k2][0], sc[2 * k2][1]); wv.y = pk2(sc[2 * k2][2], sc[2 * k2][3]); wv.z = pk2(sc[2 * k2 + 1][0], sc[2 * k2 + 1][1]); wv.w = pk2(sc[2 * k2 + 1][2], sc[2 * k2 + 1][3]);
                    pf[k2] = __builtin_bit_cast(bf16x8, wv); }
            }
#pragma unroll
            for (int nt = 0; nt < 8; ++nt) { f32x4 acc = (f32x4){0.f, 0.f, 0.f, 0.f};
#pragma unroll
                for (int k2 = 0; k2 < 4; ++k2) if (2 * k2 <= w) { const bf16x8 vf = ret::trfrag(trV4, 32 * k2, 32 * k2 + 16, 16 * nt); acc = __builtin_amdgcn_mfma_f32_16x16x32_bf16(pf[k2], vf, acc, 0, 0, 0); }
#pragma unroll
                for (int ks = 0; ks < 4; ++ks) { const bf16x8 sf = *(const LAS bf16x8*)(ST + rowb + nt * 16 * P + ks * 64); acc = __builtin_amdgcn_mfma_f32_16x16x32_bf16(qf[ks], sf, acc, 0, 0, 0); }
#pragma unroll
                for (int r = 0; r < 4; ++r) { rs[r] += acc[r]; rq[r] += acc[r] * acc[r]; mixin[(m0 + 16 * w + 4 * g + r) * ND + 512 + h * 256 + hv * 128 + 16 * nt + i16] = (bf16)f2bf(acc[r]); } }
#pragma unroll
            for (int ks = 0; ks < 4; ++ks) { const bf16x8 af = ret::trfrag(trV8, 32 * ks, 32 * ks + 4, 16 * w);
#pragma unroll
                for (int dt = 0; dt < 8; ++dt) { const bf16x8 bfr = ret::trfrag(trK8, 32 * ks, 32 * ks + 4, 16 * dt); T[hv][dt] = __builtin_amdgcn_mfma_f32_16x16x32_bf16(af, bfr, T[hv][dt], 0, 0, 0); } }
        }
#pragma unroll
        for (int r = 0; r < 4; ++r) { float sm = rs[r], s2 = rq[r];
            sm += __shfl_xor(sm, 1); sm += __shfl_xor(sm, 2); sm += __shfl_xor(sm, 4); sm += __shfl_xor(sm, 8);
            s2 += __shfl_xor(s2, 1); s2 += __shfl_xor(s2, 2); s2 += __shfl_xor(s2, 4); s2 += __shfl_xor(s2, 8);
            const float mean = sm * (1.f / 256.f); const float var = fmaxf(s2 * (1.f / 256.f) - mean * mean, 0.f);
            const float rstd = 1.f / sqrtf(var + NORM_EPS);
            const size_t m = m0 + 16 * w + 4 * g + r;
#pragma unroll
            for (int t = 0; t < 16; ++t) { bf16* yp = mixin + m * ND + 512 + h * 256 + 16 * t + i16; const float gt = bf1(proj[m * AB_IN + 3584 + h * 256 + 16 * t + i16]);
                *yp = (bf16)f2bf((bf1(*yp) - mean) * rstd * siluf_(gt)); } }
        __syncthreads();
    }
}

__device__ __forceinline__ void p_route(Frame& F, int l) {
    const float* logits = (const float*)(F.ws + WS_LOGITS); const float* rbias = kin(20) + l * NEXP;
    int* tope = (int*)(F.ws + WS_TOPE); float* wsel = (float*)(F.ws + WS_WSEL); int* posb = (int*)(F.ws + WS_SLOT); unsigned* cnt = F.ctl + CW_CNT + l * 64;
    LAS unsigned* lcnt = (LAS unsigned*)F.lds; LAS unsigned* lbase = lcnt + 64; LAS int* le = (LAS int*)(lcnt + 128); LAS unsigned* lp = (LAS unsigned*)(lcnt + 128 + 512);
    const float bias = rbias[F.lane]; const int lane = F.lane;
    for (int chunk = blockIdx.x; chunk < NT / 64; chunk += F.G) {
        __syncthreads();
        if (F.tid < 64) lcnt[F.tid] = 0u;
        __syncthreads();
        for (int t = 0; t < 8; ++t) {
            const int tl = F.wave * 8 + t, m = chunk * 64 + tl;
            const float lg = (logits[(size_t)m * 64 + lane] + logits[((size_t)NT + m) * 64 + lane]) + (logits[((size_t)2 * NT + m) * 64 + lane] + logits[((size_t)3 * NT + m) * 64 + lane]);
            const float sc = sigmoidf_(lg), bi = sc + bias;
            const int grp = lane >> 3;
            int rk = 0;
#pragma unroll
            for (int j = 1; j < 8; ++j) { const int o = lane ^ j; const float ov = __shfl_xor(bi, j); rk += ((ov > bi) || (ov == bi && o < lane)) ? 1 : 0; }
            float gs = rk < 2 ? bi : 0.f; gs += __shfl_xor(gs, 1); gs += __shfl_xor(gs, 2); gs += __shfl_xor(gs, 4);
            int grk = 0;
#pragma unroll
            for (int gg = 0; gg < 8; ++gg) { const float ov = __builtin_bit_cast(float, __builtin_amdgcn_readlane(__builtin_bit_cast(int, gs), gg * 8)); grk += (gg != grp && ((ov > gs) || (ov == gs && gg < grp))) ? 1 : 0; }
            const float mv = grk < 4 ? bi : -1e30f;
            int erk = 0;
#pragma unroll 16
            for (int j = 0; j < 64; ++j) { const float ov = __builtin_bit_cast(float, __builtin_amdgcn_readlane(__builtin_bit_cast(int, mv), j)); erk += ((ov > mv) || (ov == mv && j < lane)) ? 1 : 0; }
            const bool sel = erk < 8;
            const float wsum = wave_sum(sel ? sc : 0.f);
            if (sel) { const unsigned q = __hip_atomic_fetch_add(lcnt + lane, 1u, __ATOMIC_RELAXED, __HIP_MEMORY_SCOPE_WORKGROUP);
                tope[m * 8 + erk] = lane; wsel[m * 8 + erk] = sc / wsum * 2.5f; le[tl * 8 + erk] = lane; lp[tl * 8 + erk] = q; }
        }
        __syncthreads();
        if (F.tid < 64) lbase[F.tid] = atomicAdd(&cnt[F.tid], lcnt[F.tid]);
        __syncthreads();
        posb[chunk * 512 + F.tid] = (int)(lbase[le[F.tid]] + lp[F.tid]);
    }
}
__device__ __forceinline__ void load_offsets(Frame& F, int l) {
    volatile LAS int* tab = (volatile LAS int*)(F.lds + TAB_OFF);
    __syncthreads();
    if (F.tid < NEXP) {
        int c = (int)__hip_atomic_load(F.ctl + CW_CNT + l * 64 + F.tid, __ATOMIC_RELAXED, __HIP_MEMORY_SCOPE_AGENT); if (c > NT) c = NT;
        const int ntl = (c + 255) >> 8; int incl = ntl;
#pragma unroll
        for (int d = 1; d < 64; d <<= 1) { const int o = __shfl_up(incl, d); if (F.tid >= d) incl += o; }
        const int excl = incl - ntl;
        tab[F.tid] = excl << 8; tab[66 + F.tid] = c;
        for (int t = 0; t < ntl; ++t) if (excl + t < MAXTILES) tab[160 + excl + t] = F.tid;
        if (F.tid == NEXP - 1) { tab[64] = incl << 8; tab[65] = incl; }
    }
    __syncthreads();
}
__device__ __forceinline__ void p_scatter(Frame& F, int l) {
    load_offsets(F, l);
    const LAS int* tab = (const LAS int*)(F.lds + TAB_OFF);
    const int* tope = (const int*)(F.ws + WS_TOPE); int* slot = (int*)(F.ws + WS_SLOT); int* sorted = (int*)(F.ws + WS_SORTED);
    for (int i = F.gw * 64 + F.lane; i < NT * 8; i += F.NGW * 64) { const int e = tope[i]; const int row = tab[e] + slot[i]; sorted[row] = i >> 3; slot[i] = row; }
    for (int i = F.gw * 64 + F.lane; i < NEXP * 256; i += F.NGW * 64) { const int e = i >> 8, j = i & 255; const int r = tab[e] + tab[66 + e] + j; if (r < tab[e + 1]) sorted[r] = 0; }
}

__device__ __forceinline__ void p_l1_thin_a(Frame& F) {
    const bf16* proj = (const bf16*)(F.ws + WS_PROJ); const int* pos = (const int*)kin(1);
    bf16* cqn = (bf16*)(F.ws + WS_CQN); bf16* ckvn = (bf16*)(F.ws + WS_CKVN); bf16* krot = (bf16*)(F.ws + WS_KROT); bf16* cmpkv = (bf16*)(F.ws + WS_CMPKV);
    const float* qn = kin(10); const float* kvn = kin(12);
    for (int m = F.gw; m < NT; m += F.NGW) {
        const bf16* row = proj + (size_t)m * CD_INP;
        { float x[6]; float s = 0.f;
#pragma unroll
          for (int j = 0; j < 6; ++j) { x[j] = bf1(row[2584 + j * 64 + F.lane]); s += x[j] * x[j]; }
          const float r = 1.f / sqrtf(wave_sum(s) * (1.f / 384.f) + NORM_EPS);
#pragma unroll
          for (int j = 0; j < 6; ++j) cqn[(size_t)m * 384 + j * 64 + F.lane] = (bf16)f2bf(x[j] * r * qn[j * 64 + F.lane]); }
        { float x[8]; float s = 0.f;
#pragma unroll
          for (int j = 0; j < 8; ++j) { x[j] = bf1(row[2968 + j * 64 + F.lane]); s += x[j] * x[j]; }
          const float r = 1.f / sqrtf(wave_sum(s) * (1.f / 512.f) + NORM_EPS);
#pragma unroll
          for (int j = 0; j < 8; ++j) ckvn[(size_t)m * 512 + j * 64 + F.lane] = (bf16)f2bf(x[j] * r * kvn[j * 64 + F.lane]); }
        { const int i = F.lane & 31; const float p = (float)pos[m]; const float invf = exp2f(-(float)i * (13.287712379549449f / 32.f));
          float sn, cs; fast_sincos(p * invf, sn, cs);
          const float x1 = bf1(row[3480 + i]), x2 = bf1(row[3480 + 32 + i]);
          if (F.lane < 32) krot[(size_t)m * 64 + i] = (bf16)f2bf(x1 * cs - x2 * sn); else krot[(size_t)m * 64 + 32 + i] = (bf16)f2bf(x1 * sn + x2 * cs); }
        { const int b = m >> 11, s = m & (NS - 1);
          const int q4 = F.lane >> 4, c = F.lane & 15, kv = q4 >> 1, g = q4 & 1;
          const v4u w = *(const v4u*)(row + 1024 + q4 * 128 + c * 8);
          *(v4u*)(cmpkv + ((size_t)((kv * 16 + b * 2 + g) * NS + s)) * 128 + c * 8) = w; }
    }
}
__device__ __forceinline__ void p_l1_thin_b(Frame& F) {
    const float* hid = (const float*)(F.ws + WS_HID); const float* w2 = kin(9); bf16* kvc = (bf16*)(F.ws + WS_KVCMP);
    for (int m = F.gw; m < 4096; m += F.NGW) {
        const int kv = m >> 11;
        float h0 = hid[(size_t)m * 256 + kv * 128 + F.lane], h1 = hid[(size_t)m * 256 + kv * 128 + 64 + F.lane];
        h0 = 0.5f * h0 * (1.f + tanhf(0.7978845608028654f * (h0 + 0.044715f * h0 * h0 * h0)));
        h1 = 0.5f * h1 * (1.f + tanhf(0.7978845608028654f * (h1 + 0.044715f * h1 * h1 * h1)));
        const float* w = w2 + (size_t)kv * 128 * 128; float o0 = 0.f, o1 = 0.f;
        for (int c = 0; c < 64; ++c) { const float a = __shfl(h0, c), bq = __shfl(h1, c);
            o0 += a * w[c * 128 + F.lane] + bq * w[(c + 64) * 128 + F.lane]; o1 += a * w[c * 128 + 64 + F.lane] + bq * w[(c + 64) * 128 + 64 + F.lane]; }
        kvc[(size_t)m * 128 + F.lane] = (bf16)f2bf(o0); kvc[(size_t)m * 128 + 64 + F.lane] = (bf16)f2bf(o1);
    }
}
__device__ __forceinline__ void p_nsa_cmp_mfma(Frame& F) {
    typedef short v4i16_t __attribute__((ext_vector_type(4)));
    const bf16* proj = (const bf16*)(F.ws + WS_PROJ); const bf16* kvc = (const bf16*)(F.ws + WS_KVCMP); float* ocmp = (float*)(F.ws + WS_OCMP); unsigned* selm = (unsigned*)(F.ws + WS_SELM);
    constexpr int P = 272;
    LAS unsigned char* KT = F.lds; LAS unsigned char* VT = F.lds + 128 * P; LAS float* PS = (LAS float*)(F.lds + 2 * 128 * P);
    const int w = F.wave, lane = F.lane, i16 = lane & 15, g = lane >> 4, q4 = (lane & 15) >> 2, p4 = lane & 3;
    const float sscale = 0.08838834764831845f * 1.4426950408889634f;
    for (int bu = blockIdx.x; bu < 256; bu += F.G) {
        const int bg = bu >> 4, qg = bu & 15, b = bg >> 1, gq = bg & 1;
        __syncthreads();
#pragma unroll
        for (int c = 0; c < 4; ++c) { const int idx = F.tid + 512 * c, row = idx >> 4, c8 = idx & 15;
            v4u kk = (v4u){0u, 0u, 0u, 0u}, vv = (v4u){0u, 0u, 0u, 0u};
            if (row < 127) { kk = *(const v4u*)(kvc + ((size_t)(0 * 16 + bg) * 128 + row) * 128 + c8 * 8); vv = *(const v4u*)(kvc + ((size_t)(1 * 16 + bg) * 128 + row) * 128 + c8 * 8); }
            *(LAS v4u*)(KT + row * P + c8 * 16) = kk; *(LAS v4u*)(VT + row * P + c8 * 16) = vv; }
        for (int k = 0; k < 4; ++k) {
            const int q0 = (qg * 4 + k) * 32, h = gq * 4 + (w >> 1), ql = (w & 1) * 16 + i16, spos = q0 + ql;
            bf16x8 qf[4];
#pragma unroll
            for (int ks = 0; ks < 4; ++ks) qf[ks] = *(const bf16x8*)(proj + (size_t)(b * NS + spos) * CD_INP + h * 128 + 32 * ks + 8 * g);
            __syncthreads();
            const int nvalid = spos >= 31 ? ((spos - 31) >> 4) + 1 : 0;
            f32x4 sc[8]; float mx = -1e30f;
#pragma unroll
            for (int mt = 0; mt < 8; ++mt) { sc[mt] = (f32x4){0.f, 0.f, 0.f, 0.f};
#pragma unroll
                for (int ks = 0; ks < 4; ++ks) { const bf16x8 kf = *(const LAS bf16x8*)(KT + (16 * mt + i16) * P + (32 * ks + 8 * g) * 2); sc[mt] = __builtin_amdgcn_mfma_f32_16x16x32_bf16(kf, qf[ks], sc[mt], 0, 0, 0); }
#pragma unroll
                for (int r = 0; r < 4; ++r) { const bool ok = (16 * mt + 4 * g + r) < nvalid; const float x = ok ? sc[mt][r] * sscale : -1e30f; sc[mt][r] = x; mx = fmaxf(mx, x); } }
            mx = fmaxf(mx, __shfl_xor(mx, 16)); mx = fmaxf(mx, __shfl_xor(mx, 32));
            float ps = 0.f;
#pragma unroll
            for (int mt = 0; mt < 8; ++mt)
#pragma unroll
                for (int r = 0; r < 4; ++r) { const bool ok = (16 * mt + 4 * g + r) < nvalid; const float pv = ok ? __builtin_amdgcn_exp2f(sc[mt][r] - mx) : 0.f; sc[mt][r] = pv; ps += pv; }
            ps += __shfl_xor(ps, 16); ps += __shfl_xor(ps, 32);
            const float inv = ps > 0.f ? 1.f / ps : 0.f;
#pragma unroll
            for (int mt = 0; mt < 8; ++mt)
#pragma unroll
                for (int r = 0; r < 4; ++r) sc[mt][r] *= inv;
            { LAS float* slab = PS + (w >> 2) * 4096 + ql * 128 + 4 * g;
              if (((w >> 1) & 1) == 0) {
#pragma unroll
                  for (int mt = 0; mt < 8; ++mt) *(LAS f32x4*)(slab + 16 * mt) = sc[mt]; }
              __syncthreads();
              if (((w >> 1) & 1) == 1) {
#pragma unroll
                  for (int mt = 0; mt < 8; ++mt) { const f32x4 t = *(const LAS f32x4*)(slab + 16 * mt); *(LAS f32x4*)(slab + 16 * mt) = t + sc[mt]; } } }
            f32x4 O[8];
#pragma unroll
            for (int nt = 0; nt < 8; ++nt) O[nt] = (f32x4){0.f, 0.f, 0.f, 0.f};
#pragma unroll
            for (int k2 = 0; k2 < 4; ++k2) { v4u wv; wv.x = pk2(sc[2 * k2][0], sc[2 * k2][1]); wv.y = pk2(sc[2 * k2][2], sc[2 * k2][3]); wv.z = pk2(sc[2 * k2 + 1][0], sc[2 * k2 + 1][1]); wv.w = pk2(sc[2 * k2 + 1][2], sc[2 * k2 + 1][3]);
                const bf16x8 pf = __builtin_bit_cast(bf16x8, wv);
#pragma unroll
                for (int nt = 0; nt < 8; ++nt) {
                    const v4i16_t a = __builtin_amdgcn_ds_read_tr16_b64_v4i16((LAS v4i16_t*)(VT + (32 * k2 + 4 * g + q4) * P + (16 * nt + 4 * p4) * 2));
                    const v4i16_t c = __builtin_amdgcn_ds_read_tr16_b64_v4i16((LAS v4i16_t*)(VT + (32 * k2 + 16 + 4 * g + q4) * P + (16 * nt + 4 * p4) * 2));
                    const bf16x8 vf = (bf16x8){a[0], a[1], a[2], a[3], c[0], c[1], c[2], c[3]};
                    O[nt] = __builtin_amdgcn_mfma_f32_16x16x32_bf16(pf, vf, O[nt], 0, 0, 0); } }
#pragma unroll
            for (int r = 0; r < 4; ++r) { const size_t m = (size_t)(b * NS + q0 + (w & 1) * 16 + 4 * g + r); const float gt = sigmoidf_(bf1(proj[m * CD_INP + 2560 + h * 3 + 0]));
#pragma unroll
                for (int nt = 0; nt < 8; ++nt) ocmp[m * 1024 + h * 128 + 16 * nt + i16] = gt * O[nt][r]; }
            __syncthreads();
#pragma unroll
            for (int qq = 0; qq < 4; ++qq) { const int qi = 4 * w + qq, s = q0 + qi, cur = s >> 6, j = lane & 31;
                float imp = 0.f;
#pragma unroll
                for (int kk = 0; kk < 4; ++kk) { const int n1 = 4 * j + kk; if (n1 <= 126) imp += PS[qi * 128 + n1] + PS[4096 + qi * 128 + n1]; const int n2 = 4 * j - 1 + kk; if (n2 >= 0 && n2 <= 126) imp += PS[qi * 128 + n2] + PS[4096 + qi * 128 + n2]; }
                const bool forced = (j == 0) || (j == cur) || (j == cur - 1);
                const float score = forced ? 1e4f : ((j * 64 <= s) ? imp : -1e30f);
                int rk = 0;
                for (int jj = 0; jj < 32; ++jj) { const float ov = __shfl(score, jj); rk += ((ov > score) || (ov == score && jj < j)) ? 1 : 0; }
                const bool sel = (lane < 32) && (rk < 16) && (j <= cur);
                const unsigned long long bal = __ballot(sel);
                if (lane == 0) selm[(size_t)(b * NS + s) * 2 + gq] = (unsigned)bal; }
        }
    }
}

namespace fa {
typedef short v4i16_t __attribute__((ext_vector_type(4)));
struct Src { const bf16* k1; size_t ks1; const bf16* k2; size_t ks2; const bf16* v; size_t vs; };
template <int DQK> struct Cfg { static constexpr int KPITCH = (DQK + 8) * 2, KBYTES = 64 * KPITCH, VPITCH = 272, VBYTES = 64 * VPITCH, BUF = KBYTES + VBYTES, NKS = DQK / 32, KCH = DQK / 8, NKR = DQK / 64; };

template <int DQK> struct TileOff { unsigned gk[Cfg<DQK>::NKR], gv[2], lk[Cfg<DQK>::NKR], lv[2]; };
template <int DQK>
__device__ __forceinline__ void tile_offsets(const Src& S, int tid, TileOff<DQK>& T) {
#pragma unroll
    for (int i = 0; i < 2; ++i) { const int c = tid + 512 * i, row = c >> 4, c8 = c & 15;
        T.gk[i] = (unsigned)(row * (int)S.ks1 + c8 * 8) * 2u; T.gv[i] = (unsigned)(row * (int)S.vs + c8 * 8) * 2u;
        T.lk[i] = (unsigned)(row * Cfg<DQK>::KPITCH + c8 * 16); T.lv[i] = (unsigned)(Cfg<DQK>::KBYTES + row * Cfg<DQK>::VPITCH + c8 * 16); }
    if (DQK == 192) { const int row = tid >> 3, c8 = tid & 7; T.gk[Cfg<DQK>::NKR - 1] = (unsigned)(row * (int)S.ks2 + c8 * 8) * 2u; T.lk[Cfg<DQK>::NKR - 1] = (unsigned)(row * Cfg<DQK>::KPITCH + 256 + c8 * 16); }
}
template <int DQK>
__device__ __forceinline__ void load_tile(const Src& S, int k0, const TileOff<DQK>& T, v4u (&kr)[Cfg<DQK>::NKR], v4u (&vr)[2]) {
    const char* kb1 = (const char*)S.k1 + (size_t)k0 * S.ks1 * 2; const char* vb = (const char*)S.v + (size_t)k0 * S.vs * 2;
#pragma unroll
    for (int i = 0; i < 2; ++i) { kr[i] = *(const v4u*)(kb1 + T.gk[i]); vr[i] = *(const v4u*)(vb + T.gv[i]); }
    if (DQK == 192) { const char* kb2 = (const char*)S.k2 + (size_t)k0 * S.ks2 * 2; kr[Cfg<DQK>::NKR - 1] = *(const v4u*)(kb2 + T.gk[Cfg<DQK>::NKR - 1]); }
}
template <int DQK>
__device__ __forceinline__ void store_tile(LAS unsigned char* buf, const TileOff<DQK>& T, const v4u (&kr)[Cfg<DQK>::NKR], const v4u (&vr)[2]) {
#pragma unroll
    for (int i = 0; i < Cfg<DQK>::NKR; ++i) *(LAS v4u*)(buf + T.lk[i]) = kr[i];
#pragma unroll
    for (int i = 0; i < 2; ++i) *(LAS v4u*)(buf + T.lv[i]) = vr[i];
}
struct RowState { int spos; unsigned rowmask; float m_run, l_run; };
template <int MODE> __device__ __forceinline__ bool group_needs(int t, const RowState& R) {
    bool row_any = (t * 64 <= R.spos);
    if (MODE == 1) row_any = row_any && ((R.rowmask >> t) & 1u);
    if (MODE == 2) row_any = row_any && (t * 64 + 63 + 512 > R.spos);
    return __ballot(row_any) != 0ull;
}
template <int MODE>
__device__ __forceinline__ void softmax_group(f32x4 (&sc)[4], int t, RowState& R, f32x4 (&O)[8], bf16x8 (&pf)[2], int g) {
    float mx = -1e30f;
    bool row_full = (t * 64 + 63 <= R.spos);
    if (MODE == 1) row_full = row_full && ((R.rowmask >> t) & 1u);
    if (MODE == 2) row_full = row_full && (t * 64 + 512 > R.spos);
    if (__ballot(row_full) == ~0ull) {
#pragma unroll
        for (int mt = 0; mt < 4; ++mt)
#pragma unroll
            for (int r = 0; r < 4; ++r) mx = fmaxf(mx, sc[mt][r]);
    } else {
#pragma unroll
        for (int mt = 0; mt < 4; ++mt)
#pragma unroll
            for (int r = 0; r < 4; ++r) { const int kp = t * 64 + 16 * mt + 4 * g + r; bool ok = kp <= R.spos;
                if (MODE == 1) ok = ok && ((R.rowmask >> t) & 1u);
                if (MODE == 2) ok = ok && (kp + 512 > R.spos);
                const float x = ok ? sc[mt][r] : -3e38f; sc[mt][r] = x; mx = fmaxf(mx, x); }
        mx = fmaxf(mx, -1e30f);
    }
    mx = fmaxf(mx, __shfl_xor(mx, 16)); mx = fmaxf(mx, __shfl_xor(mx, 32));
    if (__ballot(mx > R.m_run + 8.0f) != 0ull) {
        const float m_new = fmaxf(R.m_run, mx), alpha = __builtin_amdgcn_exp2f(R.m_run - m_new); R.m_run = m_new;
        R.l_run *= alpha;
        float ar[4];
#pragma unroll
        for (int r = 0; r < 4; ++r) ar[r] = __shfl(alpha, 4 * g + r);
#pragma unroll
        for (int nt = 0; nt < 8; ++nt)
#pragma unroll
            for (int r = 0; r < 4; ++r) O[nt][r] *= ar[r];
    }
    float ps = 0.f;
#pragma unroll
    for (int mt = 0; mt < 4; ++mt)
#pragma unroll
        for (int r = 0; r < 4; ++r) { const float pv = __builtin_amdgcn_exp2f(sc[mt][r] - R.m_run); sc[mt][r] = pv; ps += pv; }
    R.l_run += ps;
#pragma unroll
    for (int k2 = 0; k2 < 2; ++k2) { v4u w; w.x = pk2(sc[2 * k2][0], sc[2 * k2][1]); w.y = pk2(sc[2 * k2][2], sc[2 * k2][3]); w.z = pk2(sc[2 * k2 + 1][0], sc[2 * k2 + 1][1]); w.w = pk2(sc[2 * k2 + 1][2], sc[2 * k2 + 1][3]);
        pf[k2] = __builtin_bit_cast(bf16x8, w); }
}
template <int DQK, int MODE>
__device__ __forceinline__ void fa_compute(LAS unsigned char* kb, LAS unsigned char* vb, const bf16x8 (&qf0)[Cfg<DQK>::NKS], const bf16x8 (&qf1)[Cfg<DQK>::NKS], int t, RowState& R0, RowState& R1, float sscale,
                                           f32x4 (&O0)[8], f32x4 (&O1)[8], int i16, int g, int q4, int p4) {
    typedef Cfg<DQK> C;
    const bool n0 = group_needs<MODE>(t, R0), n1 = group_needs<MODE>(t, R1);
    if (!n0 && !n1) return;
    f32x4 s0[4], s1[4];
#pragma unroll
    for (int mt = 0; mt < 4; ++mt) { s0[mt] = (f32x4){0.f, 0.f, 0.f, 0.f}; s1[mt] = (f32x4){0.f, 0.f, 0.f, 0.f};
#pragma unroll
        for (int ks = 0; ks < C::NKS; ++ks) { const bf16x8 kf = *(const LAS bf16x8*)(kb + (16 * mt + i16) * C::KPITCH + (32 * ks + 8 * g) * 2);
            s0[mt] = __builtin_amdgcn_mfma_f32_16x16x32_bf16(kf, qf0[ks], s0[mt], 0, 0, 0);
            s1[mt] = __builtin_amdgcn_mfma_f32_16x16x32_bf16(kf, qf1[ks], s1[mt], 0, 0, 0); } }
    bf16x8 p0[2], p1[2];
    if (n0) softmax_group<MODE>(s0, t, R0, O0, p0, g); else { p0[0] = (bf16x8){0, 0, 0, 0, 0, 0, 0, 0}; p0[1] = p0[0]; }
    if (n1) softmax_group<MODE>(s1, t, R1, O1, p1, g); else { p1[0] = (bf16x8){0, 0, 0, 0, 0, 0, 0, 0}; p1[1] = p1[0]; }
#pragma unroll
    for (int nt = 0; nt < 8; ++nt)
#pragma unroll
        for (int k2 = 0; k2 < 2; ++k2) {
            const v4i16_t a = __builtin_amdgcn_ds_read_tr16_b64_v4i16((LAS v4i16_t*)(vb + (32 * k2 + 4 * g + q4) * C::VPITCH + (16 * nt + 4 * p4) * 2));
            const v4i16_t b = __builtin_amdgcn_ds_read_tr16_b64_v4i16((LAS v4i16_t*)(vb + (32 * k2 + 16 + 4 * g + q4) * C::VPITCH + (16 * nt + 4 * p4) * 2));
            const bf16x8 vf = (bf16x8){a[0], a[1], a[2], a[3], b[0], b[1], b[2], b[3]};
            O0[nt] = __builtin_amdgcn_mfma_f32_16x16x32_bf16(p0[k2], vf, O0[nt], 0, 0, 0);
            O1[nt] = __builtin_amdgcn_mfma_f32_16x16x32_bf16(p1[k2], vf, O1[nt], 0, 0, 0); }
}
template <int DQK, int MODE>
__device__ __forceinline__ void fa_pass(LAS unsigned char* lds, const Src& S, const bf16x8 (&qf0)[Cfg<DQK>::NKS], const bf16x8 (&qf1)[Cfg<DQK>::NKS], unsigned tmask, RowState& R0, RowState& R1, float sscale,
                                        f32x4 (&O0)[8], f32x4 (&O1)[8], int tid, int lane) {
    typedef Cfg<DQK> C;
    const int i16 = lane & 15, g = lane >> 4, q4 = (lane & 15) >> 2, p4 = lane & 3;
#pragma unroll
    for (int nt = 0; nt < 8; ++nt) { O0[nt] = (f32x4){0.f, 0.f, 0.f, 0.f}; O1[nt] = (f32x4){0.f, 0.f, 0.f, 0.f}; }
    R0.m_run = -1e30f; R0.l_run = 0.f; R1.m_run = -1e30f; R1.l_run = 0.f;
    unsigned rem = tmask;
    if (rem == 0u) return;
    v4u kr[C::NKR], vr[2]; TileOff<DQK> TO; tile_offsets<DQK>(S, tid, TO);
    int t = __builtin_ctz(rem); rem &= rem - 1u;
    load_tile<DQK>(S, t * 64, TO, kr, vr);
    __syncthreads();
    store_tile<DQK>(lds, TO, kr, vr);
    __syncthreads();
    int cur = 0;
    for (;;) {
        const bool has_next = rem != 0u; int tn = 0;
        if (has_next) { tn = __builtin_ctz(rem); rem &= rem - 1u; load_tile<DQK>(S, tn * 64, TO, kr, vr); }
        LAS unsigned char* kb = lds + cur * C::BUF;
        fa_compute<DQK, MODE>(kb, kb + C::KBYTES, qf0, qf1, t, R0, R1, sscale, O0, O1, i16, g, q4, p4);
        if (has_next) store_tile<DQK>(lds + (cur ^ 1) * C::BUF, TO, kr, vr);
        __syncthreads();
        if (!has_next) break;
        t = tn; cur ^= 1;
    }
}
__device__ __forceinline__ void row_inv(float l_run, int lane, float (&inv)[4]) {
    float l = l_run; l += __shfl_xor(l, 16); l += __shfl_xor(l, 32);
    const float li = l > 0.f ? 1.f / l : 0.f; const int g = lane >> 4;
#pragma unroll
    for (int r = 0; r < 4; ++r) inv[r] = __shfl(li, 4 * g + r);
}
__device__ __forceinline__ void scale_frag(bf16x8& f, float sc) {
    v4u w = __builtin_bit_cast(v4u, f); float x[8]; unpack8(w, x);
    w.x = pk2(x[0] * sc, x[1] * sc); w.y = pk2(x[2] * sc, x[3] * sc); w.z = pk2(x[4] * sc, x[5] * sc); w.w = pk2(x[6] * sc, x[7] * sc); f = __builtin_bit_cast(bf16x8, w);
}
__device__ __forceinline__ void rope_qpe(bf16x8& f4, bf16x8& f5, float pz, int g4) {
    v4u w1 = __builtin_bit_cast(v4u, f4), w2 = __builtin_bit_cast(v4u, f5); float x1[8], x2[8]; unpack8(w1, x1); unpack8(w2, x2);
#pragma unroll
    for (int jj = 0; jj < 8; ++jj) { const float invf = exp2f(-(float)(8 * g4 + jj) * (13.287712379549449f / 32.f)); float sn, cs; fast_sincos(pz * invf, sn, cs);
        const float a = x1[jj] * cs - x2[jj] * sn, c = x1[jj] * sn + x2[jj] * cs; x1[jj] = a; x2[jj] = c; }
    w1.x = pk2(x1[0], x1[1]); w1.y = pk2(x1[2], x1[3]); w1.z = pk2(x1[4], x1[5]); w1.w = pk2(x1[6], x1[7]);
    w2.x = pk2(x2[0], x2[1]); w2.y = pk2(x2[2], x2[3]); w2.z = pk2(x2[4], x2[5]); w2.w = pk2(x2[6], x2[7]);
    f4 = __builtin_bit_cast(bf16x8, w1); f5 = __builtin_bit_cast(bf16x8, w2);
}
}

__device__ __forceinline__ void p_attn_mla(Frame& F, unsigned* queue) {
    const bf16* proj = (const bf16*)(F.ws + WS_PROJ); bf16* mixin = (bf16*)(F.ws + WS_MIXIN); const float* ocmp = (const float*)(F.ws + WS_OCMP); const unsigned* selm = (const unsigned*)(F.ws + WS_SELM);
    const bf16* qmla = (const bf16*)(F.ws + WS_QMLA); const bf16* kvu = (const bf16*)(F.ws + WS_KVU); const bf16* krot = (const bf16*)(F.ws + WS_KROT);
    volatile LAS unsigned* qslot = (volatile LAS unsigned*)(F.lds + LDSCTL_OFF);
    const int lane = F.lane, w = F.wave, i16 = lane & 15, g4 = lane >> 4;
    for (;;) {
        __syncthreads();
        if (F.tid == 0) qslot[0] = atomicAdd(queue, 1u);
        __syncthreads();
        const int u = __builtin_amdgcn_readfirstlane((int)qslot[0]);
        if (u >= 512) break;
        {
            const int qt = 7 - (u >> 6), bh = u & 63, b = bh >> 3, h = bh & 7, q0 = qt * 256;
            fa::RowState R0, R1; R0.spos = q0 + 32 * w + i16; R1.spos = R0.spos + 16; R0.rowmask = 0u; R1.rowmask = 0u;
            bf16x8 qf0[6], qf1[6];
#pragma unroll
            for (int ks = 0; ks < 6; ++ks) { qf0[ks] = *(const bf16x8*)(qmla + (size_t)(b * NS + R0.spos) * 1536 + h * 192 + 32 * ks + 8 * g4); qf1[ks] = *(const bf16x8*)(qmla + (size_t)(b * NS + R1.spos) * 1536 + h * 192 + 32 * ks + 8 * g4); }
            fa::rope_qpe(qf0[4], qf0[5], (float)((const int*)kin(1))[b * NS + R0.spos], g4);
            fa::rope_qpe(qf1[4], qf1[5], (float)((const int*)kin(1))[b * NS + R1.spos], g4);
#pragma unroll
            for (int ks = 0; ks < 6; ++ks) { fa::scale_frag(qf0[ks], 0.07216878364870322f * 1.4426950408889634f); fa::scale_frag(qf1[ks], 0.07216878364870322f * 1.4426950408889634f); }
            fa::Src S; S.k1 = kvu + (size_t)(b * NS) * 2048 + h * 256; S.ks1 = 2048; S.k2 = krot + (size_t)(b * NS) * 64; S.ks2 = 64; S.v = S.k1 + 128; S.vs = 2048;
            const int last = (q0 + 255) >> 6; const unsigned tmask = last >= 31 ? 0xffffffffu : ((1u << (last + 1)) - 1u);
            f32x4 O0[8], O1[8];
            fa::fa_pass<192, 0>(F.lds, S, qf0, qf1, tmask, R0, R1, 0.07216878364870322f * 1.4426950408889634f, O0, O1, F.tid, lane);
            float inv[4];
            fa::row_inv(R0.l_run, lane, inv);
#pragma unroll
            for (int r = 0; r < 4; ++r) { bf16* orow = mixin + (size_t)(b * NS + q0 + 32 * w + 4 * g4 + r) * ND + 1024 + h * 128 + i16;
#pragma unroll
                for (int nt = 0; nt < 8; ++nt) orow[16 * nt] = (bf16)f2bf(O0[nt][r] * inv[r]); }
            fa::row_inv(R1.l_run, lane, inv);
#pragma unroll
            for (int r = 0; r < 4; ++r) { bf16* orow = mixin + (size_t)(b * NS + q0 + 32 * w + 16 + 4 * g4 + r) * ND + 1024 + h * 128 + i16;
#pragma unroll
                for (int nt = 0; nt < 8; ++nt) orow[16 * nt] = (bf16)f2bf(O1[nt][r] * inv[r]); }
        }
    }
    (void)proj; (void)ocmp; (void)selm;
}
__device__ __forceinline__ void p_attn_nsa(Frame& F, unsigned* queue) {
    const bf16* proj = (const bf16*)(F.ws + WS_PROJ); bf16* mixin = (bf16*)(F.ws + WS_MIXIN); const float* ocmp = (const float*)(F.ws + WS_OCMP); const unsigned* selm = (const unsigned*)(F.ws + WS_SELM);
    const bf16* qmla = (const bf16*)(F.ws + WS_QMLA); const bf16* kvu = (const bf16*)(F.ws + WS_KVU); const bf16* krot = (const bf16*)(F.ws + WS_KROT);
    volatile LAS unsigned* qslot = (volatile LAS unsigned*)(F.lds + LDSCTL_OFF);
    const int lane = F.lane, w = F.wave, i16 = lane & 15, g4 = lane >> 4;
    for (;;) {
        __syncthreads();
        if (F.tid == 0) qslot[0] = atomicAdd(queue, 1u);
        __syncthreads();
        const int u = __builtin_amdgcn_readfirstlane((int)qslot[0]);
        if (u >= 512) break;
        {
            const int v = u;
            const int qt = 31 - (v >> 4), bg = v & 15, b = bg >> 1, gq = bg & 1, q0 = qt * 64;
            const int h = gq * 4 + (w >> 1), qb = q0 + (w & 1) * 32;
            fa::RowState R0, R1; R0.spos = qb + i16; R1.spos = qb + 16 + i16;
            bf16x8 qf0[4], qf1[4];
#pragma unroll
            for (int ks = 0; ks < 4; ++ks) { qf0[ks] = *(const bf16x8*)(proj + (size_t)(b * NS + R0.spos) * CD_INP + h * 128 + 32 * ks + 8 * g4); qf1[ks] = *(const bf16x8*)(proj + (size_t)(b * NS + R1.spos) * CD_INP + h * 128 + 32 * ks + 8 * g4); }
#pragma unroll
            for (int ks = 0; ks < 4; ++ks) { fa::scale_frag(qf0[ks], 0.08838834764831845f * 1.4426950408889634f); fa::scale_frag(qf1[ks], 0.08838834764831845f * 1.4426950408889634f); }
            R0.rowmask = selm[(size_t)(b * NS + R0.spos) * 2 + gq]; R1.rowmask = selm[(size_t)(b * NS + R1.spos) * 2 + gq];
            unsigned um = selm[(size_t)(b * NS + q0 + lane) * 2 + gq];
#pragma unroll
            for (int o = 1; o < 64; o <<= 1) um |= (unsigned)__shfl_xor((int)um, o);
            um = (unsigned)__builtin_amdgcn_readfirstlane((int)um);
            const bf16* base = proj + (size_t)(b * NS) * CD_INP;
            const float sscale = 0.08838834764831845f * 1.4426950408889634f;
            f32x4 O0[8], O1[8]; float inv[4];
            { fa::Src S; S.k1 = base + 1024 + ((1 * 2 + 0) * 2 + gq) * 128; S.ks1 = CD_INP; S.k2 = nullptr; S.ks2 = 0; S.v = base + 1024 + ((1 * 2 + 1) * 2 + gq) * 128; S.vs = CD_INP;
              fa::fa_pass<128, 1>(F.lds, S, qf0, qf1, um, R0, R1, sscale, O0, O1, F.tid, lane); }
            fa::row_inv(R0.l_run, lane, inv);
#pragma unroll
            for (int r = 0; r < 4; ++r) { const size_t m = (size_t)(b * NS + qb + 4 * g4 + r); const float g1 = sigmoidf_(bf1(proj[m * CD_INP + 2560 + h * 3 + 1])) * inv[r];
#pragma unroll
                for (int nt = 0; nt < 8; ++nt) mixin[m * ND + h * 128 + 16 * nt + i16] = (bf16)f2bf(ocmp[m * 1024 + h * 128 + 16 * nt + i16] + O0[nt][r] * g1); }
            fa::row_inv(R1.l_run, lane, inv);
#pragma unroll
            for (int r = 0; r < 4; ++r) { const size_t m = (size_t)(b * NS + qb + 16 + 4 * g4 + r); const float g1 = sigmoidf_(bf1(proj[m * CD_INP + 2560 + h * 3 + 1])) * inv[r];
#pragma unroll
                for (int nt = 0; nt < 8; ++nt) mixin[m * ND + h * 128 + 16 * nt + i16] = (bf16)f2bf(ocmp[m * 1024 + h * 128 + 16 * nt + i16] + O1[nt][r] * g1); }
            { fa::Src S; S.k1 = base + 1024 + ((2 * 2 + 0) * 2 + gq) * 128; S.ks1 = CD_INP; S.k2 = nullptr; S.ks2 = 0; S.v = base + 1024 + ((2 * 2 + 1) * 2 + gq) * 128; S.vs = CD_INP;
              const int klo = q0 - 511 > 0 ? q0 - 511 : 0, tlo = klo >> 6, thi = (q0 + 63) >> 6;
              const unsigned hm = thi >= 31 ? 0xffffffffu : ((1u << (thi + 1)) - 1u); const unsigned tmask = hm & ~((1u << tlo) - 1u);
              fa::fa_pass<128, 2>(F.lds, S, qf0, qf1, tmask, R0, R1, sscale, O0, O1, F.tid, lane); }
            fa::row_inv(R0.l_run, lane, inv);
#pragma unroll
            for (int r = 0; r < 4; ++r) { const size_t m = (size_t)(b * NS + qb + 4 * g4 + r); const float g2 = sigmoidf_(bf1(proj[m * CD_INP + 2560 + h * 3 + 2])) * inv[r];
#pragma unroll
                for (int nt = 0; nt < 8; ++nt) { bf16* op = mixin + m * ND + h * 128 + 16 * nt + i16; *op = (bf16)f2bf(bf1(*op) + O0[nt][r] * g2); } }
            fa::row_inv(R1.l_run, lane, inv);
#pragma unroll
            for (int r = 0; r < 4; ++r) { const size_t m = (size_t)(b * NS + qb + 16 + 4 * g4 + r); const float g2 = sigmoidf_(bf1(proj[m * CD_INP + 2560 + h * 3 + 2])) * inv[r];
#pragma unroll
                for (int nt = 0; nt < 8; ++nt) { bf16* op = mixin + m * ND + h * 128 + 16 * nt + i16; *op = (bf16)f2bf(bf1(*op) + O1[nt][r] * g2); } }
        }
    }
    (void)qmla; (void)kvu; (void)krot;
}

constexpr int NPHASE = 33;


#define IN(k) (lo <= (k) && (k) < hi)
#define SEAM(k) do { if (IN(k) && IN((k) + 1)) { if (MK_ONE_LAUNCH) xcd_barrier(bar); else if (F.tid == 0) __hip_atomic_store(F.ctl + CW_TMO, 0xBAD0u | (unsigned)(k), __ATOMIC_RELAXED, __HIP_MEMORY_SCOPE_AGENT); \
    if (MK_PROBE_PHASE >= 0 && blockIdx.x == 0 && F.tid == 0) { if ((k) == MK_PROBE_PHASE - 1) ((volatile LAS unsigned long long*)(F.lds + LDSCTL_OFF + 64))[0] = __builtin_amdgcn_s_memrealtime(); \
        if ((k) == MK_PROBE_LAST) ((volatile LAS unsigned long long*)(F.lds + LDSCTL_OFF + 64))[1] = __builtin_amdgcn_s_memrealtime(); } } } while (0)
template <int l>
__device__ __forceinline__ void layer_body(Frame& F, const XcdBarrier& bar, const int lo, const int hi) {
    unsigned char* ws = F.ws;
    bf16* const XB0 = (bf16*)(ws + WS_XB0); bf16* const X1B = (bf16*)(ws + WS_X1B); bf16* const X2B = (bf16*)(ws + WS_X2B);
    bf16* const PROJ = (bf16*)(ws + WS_PROJ); bf16* const MIXIN = (bf16*)(ws + WS_MIXIN); bf16* const MIXO = (bf16*)(ws + WS_MIXO);
    bf16* const HB = (bf16*)(ws + WS_H); bf16* const Y2 = (bf16*)(ws + WS_Y2);
        const int pb = 1 + l * 16;
        const bf16* xin = l == 0 ? XB0 : X2B;
        if (IN(pb + 0)) {
            if (l == 0 && MK_FP8_IN0) { pg8::DenseProb P; P.init((const bf16*)(ws + WS_X1F8), ND / 2, (const bf16*)(ws + WS_WABIN), NT, AB_IN, ND / 2, F.G, (int)blockIdx.x, 128); pg8::EpiBf16N128 E{PROJ, AB_IN, 1.0f / 64.0f};
                pg8::gemm_phase<pg8::EpiBf16N128, pg8::DenseProb, true, true>(F.lds, P, E); }
            else if (l == 0) { pg8::DenseProb P; P.init(xin, ND, (const bf16*)(ws + WS_WABIN), NT, AB_IN, ND, F.G, (int)blockIdx.x); pg8::EpiBf16 E{PROJ, AB_IN};
                pg8::gemm_phase<pg8::EpiBf16, pg8::DenseProb, true>(F.lds, P, E); }
            else if (l == 1 && MK_FP8_IN1) { pg8::DenseProb P; P.init((const bf16*)(ws + WS_X1F8), ND / 2, (const bf16*)(ws + WS_WCDIN), NT, CD_INP, ND / 2, F.G, (int)blockIdx.x, 128); pg8::EpiBf16N128 E{PROJ, CD_INP, 1.0f / 64.0f};
                pg8::gemm_phase<pg8::EpiBf16N128, pg8::DenseProb, true, true>(F.lds, P, E); }
            else { pg8::DenseProb P; P.init(xin, ND, (const bf16*)(ws + WS_WCDIN), NT, CD_INP, ND, F.G, (int)blockIdx.x); pg8::EpiBf16 E{PROJ, CD_INP};
                pg8::gemm_phase<pg8::EpiBf16, pg8::DenseProb, true>(F.lds, P, E); }
        } SEAM(pb + 0);
        if (l == 0) {
            if (IN(pb + 2)) { if (blockIdx.x < NB * 6) p_retention_mfma(F, (int)blockIdx.x); else p_pool(F, ((int)blockIdx.x - NB * 6) * NWAVES + F.wave, (F.G - NB * 6) * NWAVES);
                __syncthreads(); p_moe_weights_queue(F, F.ctl + CW_CNT + 320); } SEAM(pb + 2);
        } else {
            if (IN(pb + 1)) { cmp_bias_finish(F); p_l1_thin_a(F); } SEAM(pb + 1);
            if (IN(pb + 2)) {
                if (blockIdx.x < 16) { pg8::CmpProb P; P.K = 4096; P.ldb = 4096; P.Abase = (const char*)(ws + WS_CMPKV); P.Bt = (const char*)(ws + WS_CW1); P.G = 16; P.c = (int)blockIdx.x;
                  pg8::EpiF32 E{(float*)(ws + WS_HID), 256, (const float*)(ws + WS_CMPB)};
                  pg8::gemm_phase<pg8::EpiF32, pg8::CmpProb, true>(F.lds, P, E); }
                else {
                { pg8::DenseProb P; P.init((const bf16*)(ws + WS_CQN), 384, (const bf16*)(ws + WS_WUQ), NT, 1536, 384, F.G - 16, (int)blockIdx.x - 16); pg8::EpiBf16 E{(bf16*)(ws + WS_QMLA), 1536};
                  pg8::gemm_phase<pg8::EpiBf16, pg8::DenseProb, true>(F.lds, P, E); }
                { pg8::DenseProb P; P.init((const bf16*)(ws + WS_CKVN), 512, (const bf16*)(ws + WS_WUKV), NT, 2048, 512, F.G - 16, (int)blockIdx.x - 16); pg8::EpiBf16 E{(bf16*)(ws + WS_KVU), 2048};
                  pg8::gemm_phase<pg8::EpiBf16, pg8::DenseProb, true>(F.lds, P, E); }
                }
            } SEAM(pb + 2);
            if (IN(pb + 3)) { p_l1_thin_b(F); } SEAM(pb + 3);
            if (IN(pb + 4)) { p_nsa_cmp_mfma(F); } SEAM(pb + 4);
            if (IN(pb + 5)) { p_attn_mla(F, F.ctl + CW_CNT + 256); p_attn_nsa(F, F.ctl + CW_CNT + 257); } SEAM(pb + 5);
        }
        if (IN(pb + 6)) { pg8::DenseProb P; P.init(MIXIN, ND, (const bf16*)(ws + (l == 0 ? WS_WABOUT : WS_WCDOUT)), NT, ND, ND, F.G, (int)blockIdx.x); pg8::EpiBf16 E{MIXO, ND};
            pg8::gemm_phase<pg8::EpiBf16, pg8::DenseProb, true>(F.lds, P, E); } SEAM(pb + 6);
        if (IN(pb + 7)) { p_ln1(F, xin, MIXO, kin(15) + l * ND, kin(16) + l * ND, X1B, MK_FP8_MOE ? (unsigned char*)(ws + WS_X1F8) : nullptr); } SEAM(pb + 7);
        if (IN(pb + 8)) { pg8::RouterProb P; P.K = 512; P.ldb = ND; P.Abase = (const char*)X1B; P.Bt = (const char*)(ws + WS_RT + (size_t)l * MiB); P.G = F.G; P.c = (int)blockIdx.x;
            pg8::EpiF32N64 E{(float*)(ws + WS_LOGITS)};
            pg8::gemm_phase<pg8::EpiF32N64, pg8::RouterProb, true>(F.lds, P, E); } SEAM(pb + 8);
        if (IN(pb + 9)) { p_route(F, l); } SEAM(pb + 9);
        if (IN(pb + 10)) { p_scatter(F, l); } SEAM(pb + 10);
        if (IN(pb + 11)) { load_offsets(F, l); const LAS int* tab = (const LAS int*)(F.lds + TAB_OFF);
            pg8::MoeUpProb P; P.W13 = (const char*)(ws + WS_W13 + (size_t)l * WS_MOE_LSTRIDE); P.sorted = (const int*)(ws + WS_SORTED); P.tile_e = tab + 160; P.ntiles = __builtin_amdgcn_readfirstlane(tab[65]);
            P.G = F.G; P.c = (int)blockIdx.x;
            if (MK_FP8_MOE) { P.K = ND / 2; P.ldb = ND / 2; P.arow = ND; P.brow = ND; P.pshift = 3; P.btile = 128; P.nunits = (P.ntiles + NT / 256) * 8; P.Abase = (const char*)(ws + WS_X1F8);
                pg8::EpiSwigluF8 E{(unsigned char*)HB, 1.0f / 64.0f};
                pg8::gemm_phase<pg8::EpiSwigluF8, pg8::MoeUpProb, true, true>(F.lds, P, E); }
            else { P.K = ND; P.ldb = ND; P.arow = ND * 2; P.brow = ND * 2; P.pshift = 2; P.btile = 256; P.nunits = (P.ntiles + NT / 256) * 4; P.Abase = (const char*)X1B;
                pg8::EpiSwiglu E{HB};
                pg8::gemm_phase<pg8::EpiSwiglu, pg8::MoeUpProb, true>(F.lds, P, E); } } SEAM(pb + 11);
        if (IN(pb + 12)) { load_offsets(F, l); const LAS int* tab = (const LAS int*)(F.lds + TAB_OFF);
            pg8::MoeDownProb P; P.Abase = (const char*)HB; P.W2 = (const char*)(ws + WS_W2 + (size_t)l * WS_MOE_LSTRIDE); P.tile_e = tab + 160; P.ntiles = __builtin_amdgcn_readfirstlane(tab[65]);
            P.G = F.G; P.c = (int)blockIdx.x;
            if (MK_FP8_MOE) { P.K = EFF / 2; P.ldb = EFF / 2; P.arow = EFF; P.brow = EFF; P.pshift = 4; P.btile = 128; P.nunits = (P.ntiles + NT / 256) * 16;
                pg8::EpiFp8N128 E{(unsigned char*)Y2, ND, 16.0f / (64.0f * 8.0f)};
                pg8::gemm_phase<pg8::EpiFp8N128, pg8::MoeDownProb, true, true>(F.lds, P, E); }
            else { P.K = EFF; P.ldb = EFF; P.arow = EFF * 2; P.brow = EFF * 2; P.pshift = 3; P.btile = 256; P.nunits = (P.ntiles + NT / 256) * 8;
                pg8::EpiFp8 E{(unsigned char*)Y2, ND, 16.0f};
                pg8::gemm_phase<pg8::EpiFp8, pg8::MoeDownProb, true>(F.lds, P, E); } } SEAM(pb + 12);
        if (IN(pb + 13)) { p_combine_ln2(F, X1B, (const unsigned char*)Y2, (const int*)(ws + WS_SLOT), (const float*)(ws + WS_WSEL), kin(17) + l * ND, kin(18) + l * ND, l == 0 ? X2B : nullptr, l == 0 ? nullptr : F.out, (l == 0 && MK_FP8_IN1) ? (unsigned char*)(ws + WS_X1F8) : nullptr); } SEAM(pb + 13);
    }
__global__ void __launch_bounds__(NWAVES * 64, 2) mk_fwd(Args args) {
    extern __shared__ __attribute__((aligned(16))) unsigned char lds[];
    Frame F;
    F.lds = (LAS unsigned char*)lds;
    F.MISC = (volatile LAS unsigned*)(F.lds + MISC_OFF);
    F.tid = threadIdx.x; F.lane = F.tid & 63; F.wave = __builtin_amdgcn_readfirstlane(F.tid >> 6);
    F.G = gridDim.x; { const int bx = blockIdx.x; F.vcu = (F.G % 8 == 0) ? (bx % 8) * (F.G / 8) + bx / 8 : bx; }
    F.gw = F.vcu * NWAVES + F.wave; F.NGW = F.G * NWAVES;
    F.ws = args.ws; F.ctl = (unsigned*)(args.ws + WS_CTL); F.out = args.out;
    for (int u = F.tid; u < (LDS_BYTES - LDSCTL_OFF) / 4; u += NWAVES * 64) ((LAS unsigned*)(F.lds + LDSCTL_OFF))[u] = 0u;
    __syncthreads();
    XcdBarrier bar; bar.bar = F.ctl + CW_BAR; bar.x = 0; bar.st = nullptr;
    if (MK_ONE_LAUNCH) bar = xcd_barrier_post(F.ctl + CW_BAR, F.MISC + 8);
    const int lo = args.ph_lo, hi = args.ph_hi;
    if (MK_PROBE_PHASE == 0 && blockIdx.x == 0 && F.tid == 0) ((volatile LAS unsigned long long*)(F.lds + LDSCTL_OFF + 64))[0] = __builtin_amdgcn_s_memrealtime();
    unsigned char* ws = args.ws;
    bf16* const XB0 = (bf16*)(ws + WS_XB0); bf16* const X1B = (bf16*)(ws + WS_X1B); bf16* const X2B = (bf16*)(ws + WS_X2B);
    bf16* const PROJ = (bf16*)(ws + WS_PROJ); bf16* const MIXIN = (bf16*)(ws + WS_MIXIN); bf16* const MIXO = (bf16*)(ws + WS_MIXO);
    bf16* const HB = (bf16*)(ws + WS_H); bf16* const Y2 = (bf16*)(ws + WS_Y2);

    if (IN(0)) { p_prologue(F); } SEAM(0);

    layer_body<0>(F, bar, lo, hi);
    layer_body<1>(F, bar, lo, hi);
    if (MK_PROBE_PHASE >= 0 && blockIdx.x == 0 && F.tid == 0) {
        volatile LAS unsigned long long* tsl = (volatile LAS unsigned long long*)(F.lds + LDSCTL_OFF + 64);
        if (MK_PROBE_LAST == 30) tsl[1] = __builtin_amdgcn_s_memrealtime();
        const unsigned long long span = (tsl[1] - tsl[0]) * MK_PROBE_AMP, t0 = __builtin_amdgcn_s_memrealtime();
        while (__builtin_amdgcn_s_memrealtime() - t0 < span) __builtin_amdgcn_s_sleep(8);
    }
#undef IN
#undef SEAM
}

extern "C" void kernel_launch(void* const* d_in, const int* in_sizes, int n_in, void* d_out, int out_size, void* d_ws, size_t ws_size, hipStream_t stream) {
    static int grid = 0;
    if (grid == 0) {
        if (n_in != 27 || in_sizes[0] != NT * ND || out_size != NT * ND || ws_size < WS_END) { fprintf(stderr, "kernel_launch: unexpected problem (n_in %d, in0 %d, out %d, ws %zu < %zu); nothing launched\n", n_in, n_in > 0 ? in_sizes[0] : -1, out_size, ws_size, (size_t)WS_END); grid = -1; return; }
        int dev = 0, cus = 0, per_cu = 0;
        if (hipGetDevice(&dev) != hipSuccess || hipDeviceGetAttribute(&cus, hipDeviceAttributeMultiprocessorCount, dev) != hipSuccess) { fprintf(stderr, "kernel_launch: device query failed\n"); grid = -1; return; }
        if (hipFuncSetAttribute((const void*)mk_fwd, hipFuncAttributeMaxDynamicSharedMemorySize, LDS_BYTES) != hipSuccess) { fprintf(stderr, "kernel_launch: hipFuncSetAttribute failed\n"); grid = -1; return; }
        if (hipOccupancyMaxActiveBlocksPerMultiprocessor(&per_cu, (const void*)mk_fwd, NWAVES * 64, LDS_BYTES) != hipSuccess || per_cu < 1) fprintf(stderr, "kernel_launch: note: occupancy query reports %d\n", per_cu);
        (void)hipGetLastError();
        grid = cus;
    }
    if (grid < 0) return;
    if (hipMemsetAsync((char*)d_ws + WS_CTL, 0, CTL_ZERO_BYTES, stream) != hipSuccess) { fprintf(stderr, "kernel_launch: memset failed\n"); return; }
    Args a{};
    for (int i = 0; i < 27; ++i) a.in[i] = (const float*)d_in[i];
    a.out = (float*)d_out; a.ws = (unsigned char*)d_ws;
#if MK_ONE_LAUNCH
    a.ph_lo = 0; a.ph_hi = NPHASE;
    hipLaunchKernelGGL(mk_fwd, dim3(grid), dim3(NWAVES * 64), LDS_BYTES, stream, a);
#else
    for (int p = 0; p < NPHASE; ++p) {
        const int lp = (p - 1) & 15;
        if (p >= 1) { const int l = (p - 1) >> 4; if (lp >= 14) continue; if (l == 0 && lp >= 3 && lp <= 5) continue; }
        a.ph_lo = p; a.ph_hi = p + 1;
        hipLaunchKernelGGL(mk_fwd, dim3(grid), dim3(NWAVES * 64), LDS_BYTES, stream, a);
    }
#endif
    const hipError_t le = hipPeekAtLastError();
    if (le != hipSuccess) fprintf(stderr, "kernel_launch: launch failed: %s\n", hipGetErrorName(le));
}
```

```cpp
#include <hip/hip_runtime.h>
#include <cstdio>
#include <cstdint>

#ifndef MK_ONE_LAUNCH
#define MK_ONE_LAUNCH 1
#endif
#ifndef MK_FP8_MOE
#define MK_FP8_MOE 1
#endif
#ifndef MK_F8_PIPE
#define MK_F8_PIPE 0
#endif
#ifndef MK_FP8_INPROJ
#define MK_FP8_INPROJ 2
#endif
#define MK_FP8_IN0 ((MK_FP8_INPROJ & 1) != 0)
#define MK_FP8_IN1 ((MK_FP8_INPROJ & 2) != 0)
#ifndef MK_PROBE_PHASE
#define MK_PROBE_PHASE -1
#endif
#ifndef MK_PROBE_LAST
#define MK_PROBE_LAST MK_PROBE_PHASE
#endif
#ifndef MK_PROBE_AMP
#define MK_PROBE_AMP 4
#endif

#define GAS __attribute__((address_space(1)))
#define LAS __attribute__((address_space(3)))
typedef unsigned short bf16;
typedef unsigned v4u __attribute__((ext_vector_type(4)));
typedef unsigned v2u __attribute__((ext_vector_type(2)));
typedef float f32x4 __attribute__((ext_vector_type(4)));
typedef float f32x2 __attribute__((ext_vector_type(2)));
typedef short bf16x8 __attribute__((ext_vector_type(8)));

constexpr int NB = 8, NS = 2048, ND = 2048, NT = NB * NS;
constexpr float DN_ALPHA = 1.41421356237309505f;
constexpr float LN_EPS = 1e-5f, NORM_EPS = 1e-6f;
constexpr int AB_IN = 5120, CD_IN = 3544, CD_INP = 3584;
constexpr int NEXP = 64, EFF = 512;
constexpr int MAXROWS = NT * 8 + NEXP * 256;
constexpr int MAXTILES = MAXROWS / 256;
constexpr int SH_ROW0 = MAXROWS;

constexpr size_t MiB = 1u << 20;
constexpr size_t WS_CTL = 0, CTL_ZERO_BYTES = 1 * MiB;
constexpr size_t WS_TOPE = 1 * MiB, WS_WSEL = WS_TOPE + 512 * 1024, WS_SLOT = 2 * MiB, WS_SORTED = WS_SLOT + 512 * 1024;
constexpr size_t WS_CMPB = 3 * MiB + 256 * 1024, WS_SELM = 3 * MiB + 512 * 1024;
constexpr size_t WS_KVCMP = 4 * MiB;
constexpr size_t WS_HID = 6 * MiB;
constexpr size_t WS_WABIN = 16 * MiB, WS_WABOUT = 36 * MiB, WS_WCDIN = 44 * MiB, WS_WCDOUT = 58 * MiB, WS_WUQ = 66 * MiB, WS_WUKV = 68 * MiB, WS_CW1 = 70 * MiB, WS_RT = 72 * MiB;
constexpr size_t WS_W13 = 74 * MiB, WS_W2 = 334 * MiB, WS_MOE_LSTRIDE = 390 * MiB;
constexpr size_t WS_XB0 = 854 * MiB, WS_X2B = 854 * MiB, WS_X1B = 918 * MiB;
constexpr size_t WS_H = 982 * MiB, WS_Y2 = 1142 * MiB, WS_X1F8 = 1782 * MiB, WS_END = 1814 * MiB;
constexpr size_t WS_PROJ = 982 * MiB, WS_MIXIN = 1142 * MiB, WS_MIXO = 1206 * MiB;
constexpr size_t WS_QR = 1270 * MiB, WS_KR = 1294 * MiB;
constexpr size_t WS_CQN = 1270 * MiB, WS_CKVN = 1282 * MiB, WS_KROT = 1298 * MiB, WS_QMLA = 1302 * MiB, WS_KVU = 1350 * MiB, WS_CMPKV = 1414 * MiB, WS_OCMP = 1434 * MiB;
constexpr size_t WS_LOGITS = 1142 * MiB;
constexpr int CW_TMO = 0, CW_CODE = 1, CW_BAR = 4096, CW_CNT = 16384;

constexpr int RING_BYTES = 131072, LDSCTL_OFF = RING_BYTES, MISC_OFF = LDSCTL_OFF + 320, TAB_OFF = LDSCTL_OFF + 512;
constexpr int LDS_BYTES = 147456;
constexpr int NWAVES = 8;

#define LDS_WAIT() asm volatile("s_waitcnt lgkmcnt(0)" ::: "memory")
#define VM_WAIT() asm volatile("s_waitcnt vmcnt(0)" ::: "memory")
typedef __bf16 hwbf16x2 __attribute__((ext_vector_type(2)));
__device__ __forceinline__ unsigned pk2(float lo, float hi) { const f32x2 v = {lo, hi}; const hwbf16x2 b = __builtin_convertvector(v, hwbf16x2); return __builtin_bit_cast(unsigned, b); }
__device__ __forceinline__ unsigned f2bf(float f) { return pk2(f, 0.f) & 0xffffu; }
__device__ __forceinline__ void fast_sincos(float ang, float& sn, float& cs) { const float r = __builtin_amdgcn_fractf(ang * 0.15915494309189535f); sn = __builtin_amdgcn_sinf(r); cs = __builtin_amdgcn_cosf(r); }
__device__ __forceinline__ float bflo(unsigned w) { return __builtin_bit_cast(float, w << 16); }
__device__ __forceinline__ float bfhi(unsigned w) { return __builtin_bit_cast(float, w & 0xffff0000u); }
__device__ __forceinline__ float bf1(bf16 v) { return __builtin_bit_cast(float, ((unsigned)v) << 16); }
__device__ __forceinline__ float wave_sum(float v) {
#pragma unroll
    for (int o = 1; o < 64; o <<= 1) v += __shfl_xor(v, o);
    return v;
}
__device__ __forceinline__ float wave_max(float v) {
#pragma unroll
    for (int o = 1; o < 64; o <<= 1) v = fmaxf(v, __shfl_xor(v, o));
    return v;
}
__device__ __forceinline__ float sigmoidf_(float x) { return 1.0f / (1.0f + __expf(-x)); }
__device__ __forceinline__ float siluf_(float x) { return x / (1.0f + __expf(-x)); }
__device__ __forceinline__ void unpack8(const v4u w, float (&f)[8]) {
    f[0] = bflo(w.x); f[1] = bfhi(w.x); f[2] = bflo(w.y); f[3] = bfhi(w.y); f[4] = bflo(w.z); f[5] = bfhi(w.z); f[6] = bflo(w.w); f[7] = bfhi(w.w);
}

#define XB_TMO      128
#define XB_XCNT(j)  (256  + 64 * (j))
#define XB_XSUB(j)  (1280 + 64 * (j))
#define XB_XGEN(j)  (2304 + 64 * (j))
#define XB_TOP      3328
#define XB_TOPGEN   3392
#define XCD_BAR_WORDS 3456
#define XB_SPIN_CAP (1u << 18)
__device__ __forceinline__ unsigned xb_ld(unsigned* p)              { return __hip_atomic_load(p, __ATOMIC_RELAXED, __HIP_MEMORY_SCOPE_AGENT); }
__device__ __forceinline__ unsigned xb_add(unsigned* p, unsigned v) { return __hip_atomic_fetch_add(p, v, __ATOMIC_RELAXED, __HIP_MEMORY_SCOPE_AGENT); }
__device__ __forceinline__ unsigned xb_xcc_id() { return (unsigned)__builtin_amdgcn_s_getreg((3 << 11) | 20) & 0xFu; }
#define XB_SPIN(cond, bar) do { unsigned _sp = 0; while (cond) { __builtin_amdgcn_s_sleep(1); \
    if ((++_sp & 255u) == 0u) { if (xb_ld(&(bar)[XB_TMO])) break; if (_sp > XB_SPIN_CAP) { atomicAdd(&(bar)[XB_TMO], 1u); break; } } } } while (0)
struct XcdBarrier { unsigned* bar; unsigned x; volatile LAS unsigned* st; };
__device__ __forceinline__ XcdBarrier xcd_barrier_post(unsigned* bar, volatile LAS unsigned* st) {
    XcdBarrier b; b.bar = bar; b.x = xb_xcc_id(); b.st = st;
    if (threadIdx.x == 0) (void)xb_add(&bar[XB_XCNT(b.x)], 1u);
    return b;
}
__device__ __forceinline__ void xcd_barrier_complete(unsigned* bar, unsigned x, unsigned& nloc, unsigned& nx) {
    const unsigned G = gridDim.x * gridDim.y * gridDim.z;
    unsigned sum, cnt, mine, sp = 0u;
    for (;;) {
        sum = 0u; cnt = 0u; mine = 0u;
#pragma unroll
        for (unsigned j = 0; j < 16; ++j) { const unsigned c = xb_ld(&bar[XB_XCNT(j)]); sum += c; cnt += (c > 0u) ? 1u : 0u; mine = (j == x) ? c : mine; }
        if (sum == G) break;
        __builtin_amdgcn_s_sleep(1);
        if ((++sp & 255u) == 0u) { if (xb_ld(&bar[XB_TMO])) break; if (sp > XB_SPIN_CAP) { atomicAdd(&bar[XB_TMO], 1u); break; } }
    }
    nloc = mine > 0u ? mine : 1u; nx = cnt > 0u ? cnt : 1u;
}
__device__ __forceinline__ void xcd_barrier(const XcdBarrier& b) {
    asm volatile("s_waitcnt vmcnt(0)" ::: "memory");
    __syncthreads();
    if (threadIdx.x == 0) {
        unsigned* bar = b.bar;
        __builtin_amdgcn_s_waitcnt(0);
        unsigned nloc = b.st[0], nx = b.st[1];
        if (nloc == 0u) { xcd_barrier_complete(bar, b.x, nloc, nx); b.st[0] = nloc; b.st[1] = nx; }
        const unsigned old = xb_add(&bar[XB_XSUB(b.x)], 1u);
        const unsigned gen = old / nloc;
        if (old + 1u == (gen + 1u) * nloc) {
            __builtin_amdgcn_fence(__ATOMIC_RELEASE, "agent");
            asm volatile("s_waitcnt vmcnt(0)" ::: "memory");
            const unsigned og = xb_add(&bar[XB_TOP], 1u);
            const unsigned tg = og / nx;
            if (og + 1u == (tg + 1u) * nx) xb_add(&bar[XB_TOPGEN], 1u);
            else XB_SPIN(xb_ld(&bar[XB_TOPGEN]) == tg, bar);
            __builtin_amdgcn_fence(__ATOMIC_ACQUIRE, "agent");
            xb_add(&bar[XB_XGEN(b.x)], 1u);
            asm volatile("s_waitcnt vmcnt(0)" ::: "memory");
        } else {
            XB_SPIN(xb_ld(&bar[XB_XGEN(b.x)]) == gen, bar);
            __builtin_amdgcn_fence(__ATOMIC_ACQUIRE, "agent");
            asm volatile("s_waitcnt vmcnt(0)" ::: "memory");
        }
    }
    __syncthreads();
}

namespace pg8 {
typedef int v4i_t __attribute__((ext_vector_type(4)));
constexpr int BM = 256, BK = 64, HALF = 128, HTB = HALF * BK * 2, STAGE_BYTES = 8 * HTB, NXCD = 8, WGM = 8;
__host__ __device__ __forceinline__ int lds_byte(int r, int c) { const int st = (r >> 4) * 2 + (c >> 5), rr = r & 15, cc = c & 31, ob = rr * 64 + cc * 2; return st * 1024 + (ob ^ (((ob >> 9) & 1) << 5)); }
__host__ __device__ __forceinline__ void stage_rc(int b, int& R, int& C) { const int st = b / 1024, sb = b % 1024, swz = sb ^ (((sb >> 9) & 1) << 5); R = (st >> 1) * 16 + swz / 64; C = (st & 1) * 32 + (swz % 64) / 2; }
__host__ __device__ __forceinline__ int perm32(int rho) { const int n = rho >> 4, i = rho & 15; return 8 * (i >> 2) + 4 * n + (i & 3); }
struct Unit { int pm, pn, e; };

__device__ __forceinline__ unsigned cvt_pk_bf16(float lo, float hi) { unsigned r; asm volatile("v_cvt_pk_bf16_f32 %0, %1, %2" : "=v"(r) : "v"(lo), "v"(hi)); return r; }

struct EpiBf16 {
    static constexpr bool PERM = true;
    bf16* O; int ldc;
    __device__ __forceinline__ void operator()(const f32x4 (&acc)[2][2][4][2], const Unit& u, int wr, int wc, int fr, int fq) const {
        const int row0 = u.pm * BM + wr * 64 + fr, col0 = u.pn * BM + wc * 32 + 8 * fq;
#pragma unroll
        for (int ai = 0; ai < 2; ++ai)
#pragma unroll
            for (int m = 0; m < 4; ++m) { bf16* rowp = O + (size_t)(row0 + ai * HALF + m * 16) * ldc + col0;
#pragma unroll
                for (int bj = 0; bj < 2; ++bj) { const f32x4 v0 = acc[ai][bj][m][0], v1 = acc[ai][bj][m][1];
                    v4u w; w.x = cvt_pk_bf16(v0[0], v0[1]); w.y = cvt_pk_bf16(v0[2], v0[3]); w.z = cvt_pk_bf16(v1[0], v1[1]); w.w = cvt_pk_bf16(v1[2], v1[3]);
                    *(v4u*)(rowp + bj * HALF) = w; } }
    }
};
struct EpiFp8 {
    static constexpr bool PERM = true;
    unsigned char* O; int ldc; float mul;
    __device__ __forceinline__ void operator()(const f32x4 (&acc)[2][2][4][2], const Unit& u, int wr, int wc, int fr, int fq) const {
        const int row0 = u.pm * BM + wr * 64 + fr, col0 = u.pn * BM + wc * 32 + 8 * fq;
#pragma unroll
        for (int ai = 0; ai < 2; ++ai)
#pragma unroll
            for (int m = 0; m < 4; ++m) { unsigned char* rowp = O + (size_t)(row0 + ai * HALF + m * 16) * ldc + col0;
#pragma unroll
                for (int bj = 0; bj < 2; ++bj) { float v[8];
#pragma unroll
                    for (int n = 0; n < 2; ++n)
#pragma unroll
                        for (int j = 0; j < 4; ++j) v[n * 4 + j] = fminf(fmaxf(acc[ai][bj][m][n][j] * mul, -448.0f), 448.0f);
                    int w0 = __builtin_amdgcn_cvt_pk_fp8_f32(v[0], v[1], 0, false); w0 = __builtin_amdgcn_cvt_pk_fp8_f32(v[2], v[3], w0, true);
                    int w1 = __builtin_amdgcn_cvt_pk_fp8_f32(v[4], v[5], 0, false); w1 = __builtin_amdgcn_cvt_pk_fp8_f32(v[6], v[7], w1, true);
                    *(v2u*)(rowp + bj * HALF) = (v2u){(unsigned)w0, (unsigned)w1}; } }
    }
};
struct EpiF32 {
    static constexpr bool PERM = false;
    float* C; int ldc; const float* bias;
    __device__ __forceinline__ void operator()(const f32x4 (&acc)[2][2][4][2], const Unit& u, int wr, int wc, int fr, int fq) const {
        const int row0 = u.pm * BM + wr * 64 + fr, col0 = u.pn * BM + wc * 32 + 4 * fq;
        f32x4 bv[2][2];
#pragma unroll
        for (int bj = 0; bj < 2; ++bj)
#pragma unroll
            for (int n = 0; n < 2; ++n) bv[bj][n] = bias ? *(const f32x4*)(bias + col0 + bj * HALF + n * 16) : (f32x4){0.f, 0.f, 0.f, 0.f};
#pragma unroll
        for (int ai = 0; ai < 2; ++ai)
#pragma unroll
            for (int m = 0; m < 4; ++m) { float* rowp = C + (size_t)(row0 + ai * HALF + m * 16) * ldc + col0;
#pragma unroll
                for (int bj = 0; bj < 2; ++bj)
#pragma unroll
                    for (int n = 0; n < 2; ++n) *(f32x4*)(rowp + bj * HALF + n * 16) = acc[ai][bj][m][n] + bv[bj][n]; }
    }
};
struct EpiSwiglu {
    static constexpr bool PERM = true;
    bf16* H;
    __device__ __forceinline__ void operator()(const f32x4 (&acc)[2][2][4][2], const Unit& u, int wr, int wc, int fr, int fq) const {
        const int row0 = u.pm * BM + wr * 64 + fr, col0 = u.pn * HALF + wc * 32 + 8 * fq;
#pragma unroll
        for (int ai = 0; ai < 2; ++ai)
#pragma unroll
            for (int m = 0; m < 4; ++m) { bf16* rowp = H + (size_t)(row0 + ai * HALF + m * 16) * EFF + col0;
                float o[8];
#pragma unroll
                for (int n = 0; n < 2; ++n)
#pragma unroll
                    for (int j = 0; j < 4; ++j) { const float h1 = acc[ai][0][m][n][j], h3 = acc[ai][1][m][n][j]; o[n * 4 + j] = siluf_(h1) * h3; }
                v4u w; w.x = cvt_pk_bf16(o[0], o[1]); w.y = cvt_pk_bf16(o[2], o[3]); w.z = cvt_pk_bf16(o[4], o[5]); w.w = cvt_pk_bf16(o[6], o[7]);
                *(v4u*)rowp = w; }
    }
};

template <class Epi, class Prob, bool ALIGN_EPI, bool F8 = false, bool NB1 = F8>
__device__ __forceinline__ void gemm_phase(LAS unsigned char* lds, const Prob& P, const Epi& E) {
    const int tid = threadIdx.x, wid = __builtin_amdgcn_readfirstlane(tid >> 6), lane = tid & 63, wr = wid >> 2, wc = wid & 3, fr = lane & 15, fq = lane >> 4;
    const int K = P.K, nt = K / BK, ldb = P.ldb;
    unsigned voffB[2];
#pragma unroll
    for (int i = 0; i < 2; ++i) { int R, C; stage_rc(tid * 16 + i * 8192, R, C); const int Rb = Epi::PERM ? ((R & ~31) + perm32(R & 31)) : R;
        voffB[i] = (unsigned)(Rb * ldb + C) * 2u; }
    const size_t kstep = (size_t)(BK * 2);
    const size_t hstep = (size_t)HALF * ldb * 2;
    const unsigned ldsw = (unsigned)wid * 1024u;
    const int aoff = lds_byte(wr * 64 + fr, fq * 8), boff = lds_byte(wc * 32 + fr, fq * 8);
    const char* const Ab = P.Abase;
#define PG8_SA(b, h) (((b) * 2 + (h)) * HTB)
#define PG8_SB(b, h) ((4 + (b) * 2 + (h)) * HTB)
#define PG8_STAGE(bufoff, gbase, voff) do { _Pragma("unroll") for (int _i = 0; _i < 2; ++_i) \
        __builtin_amdgcn_global_load_lds((const unsigned*)((const char*)(gbase) + (voff)[_i]), (LAS unsigned*)(lds + (bufoff) + ldsw + _i * 8192), 16, 0, 0); } while (0)
#define PG8_STAGE_A(bufoff, kb, o0, o1) do { \
        __builtin_amdgcn_global_load_lds((const unsigned*)(Ab + (kb) + (o0)), (LAS unsigned*)(lds + (bufoff) + ldsw), 16, 0, 0); \
        __builtin_amdgcn_global_load_lds((const unsigned*)(Ab + (kb) + (o1)), (LAS unsigned*)(lds + (bufoff) + ldsw + 8192), 16, 0, 0); } while (0)
#define PG8_STAGE_AH(bufoff, kb, h, nx) do { \
        if constexpr (Prob::DENSE_A) { const char* _b = ((nx) ? nAb : cAb) + (size_t)(h) * hstepA + (kb); \
            __builtin_amdgcn_global_load_lds((const unsigned*)(_b + voffA[0]), (LAS unsigned*)(lds + (bufoff) + ldsw), 16, 0, 0); \
            __builtin_amdgcn_global_load_lds((const unsigned*)(_b + voffA[1]), (LAS unsigned*)(lds + (bufoff) + ldsw + 8192), 16, 0, 0); } \
        else { const unsigned _o0 = (nx) ? on[2 * (h)] : oc[2 * (h)], _o1 = (nx) ? on[2 * (h) + 1] : oc[2 * (h) + 1]; PG8_STAGE_A(bufoff, kb, _o0, _o1); } } while (0)
#define PG8_LDA(dst, b, h) do { _Pragma("unroll") for (int m = 0; m < 4; ++m) _Pragma("unroll") for (int k = 0; k < 2; ++k) dst[m][k] = *(const LAS bf16x8*)(lds + PG8_SA(b, h) + aoff + m * 2048 + k * 1024); } while (0)
#define PG8_LDB(dst, b, h) do { _Pragma("unroll") for (int n = 0; n < 2; ++n) _Pragma("unroll") for (int k = 0; k < 2; ++k) dst[n][k] = *(const LAS bf16x8*)(lds + PG8_SB(b, h) + boff + n * 2048 + k * 1024); } while (0)
#define PG8_CAT(lo, hi) __builtin_shufflevector(__builtin_bit_cast(v4i_t, lo), __builtin_bit_cast(v4i_t, hi), 0, 1, 2, 3, 4, 5, 6, 7)
#define PG8_MMA(ai, bj, At, Bt) do { __builtin_amdgcn_s_setprio(1); \
        if constexpr (F8) { _Pragma("unroll") for (int m = 0; m < 4; ++m) _Pragma("unroll") for (int n = 0; n < 2; ++n) \
            acc[ai][bj][m][n] = __builtin_amdgcn_mfma_scale_f32_16x16x128_f8f6f4(PG8_CAT(Bt[n][0], Bt[n][1]), PG8_CAT(At[m][0], At[m][1]), acc[ai][bj][m][n], 0, 0, 0, 0x7F7F7F7F, 0, 0x7F7F7F7F); } \
        else { _Pragma("unroll") for (int m = 0; m < 4; ++m) _Pragma("unroll") for (int n = 0; n < 2; ++n) _Pragma("unroll") for (int k = 0; k < 2; ++k) \
            acc[ai][bj][m][n] = __builtin_amdgcn_mfma_f32_16x16x32_bf16(Bt[n][k], At[m][k], acc[ai][bj][m][n], 0, 0, 0); } \
        __builtin_amdgcn_s_setprio(0); } while (0)
#define PG8_WAIT_V(n) asm volatile("s_waitcnt vmcnt(" #n ")" ::: "memory")
#define PG8_WAIT_L(n) asm volatile("s_waitcnt lgkmcnt(" #n ")" ::: "memory")
#define PG8_BAR __builtin_amdgcn_s_barrier()
#define PG8_SCHED __builtin_amdgcn_sched_barrier(0)
    Unit cur, nxt; int ui = 0;
    if (!P.next(0, cur)) return;
    f32x4 acc[2][2][4][2];
#pragma unroll
    for (int a = 0; a < 2; ++a)
#pragma unroll
        for (int b = 0; b < 2; ++b)
#pragma unroll
            for (int m = 0; m < 4; ++m)
#pragma unroll
                for (int n = 0; n < 2; ++n) acc[a][b][m][n] = (f32x4){0.f, 0.f, 0.f, 0.f};
    bf16x8 At[4][2], B0[2][2], B1[2][2];
    bf16x8 At2[4][2], B02[2][2];
    unsigned oc[4], on[4], voffA[2]; const char* cAb = nullptr; const char* nAb = nullptr; size_t hstepA = 0;
    if constexpr (Prob::DENSE_A) { int RA[2], CA[2]; stage_rc(tid * 16, RA[0], CA[0]); stage_rc(tid * 16 + 8192, RA[1], CA[1]);
        voffA[0] = (unsigned)(RA[0] * P.arow + CA[0] * 2); voffA[1] = (unsigned)(RA[1] * P.arow + CA[1] * 2); hstepA = (size_t)HALF * P.arow; cAb = P.abase(cur); nAb = cAb;
        oc[0] = oc[1] = oc[2] = oc[3] = 0u; on[0] = on[1] = on[2] = on[3] = 0u; }
    else { int RA[2], CA[2]; stage_rc(tid * 16, RA[0], CA[0]); stage_rc(tid * 16 + 8192, RA[1], CA[1]); P.aoffs(cur, RA, CA, oc); voffA[0] = voffA[1] = 0u; }
    const char* cB = P.bbase(cur);
    if constexpr (NB1) {
        PG8_STAGE(PG8_SB(0, 0), cB, voffB); PG8_STAGE_AH(PG8_SA(0, 0), (size_t)0, 0, false); PG8_STAGE_AH(PG8_SA(0, 1), (size_t)0, 1, false);
        if (wr == 1) PG8_BAR;
        PG8_WAIT_V(2); PG8_BAR;
        PG8_STAGE(PG8_SB(1, 0), cB + kstep, voffB); PG8_STAGE_AH(PG8_SA(1, 0), kstep, 0, false);
        PG8_WAIT_V(4); PG8_BAR;
        if constexpr (MK_F8_PIPE != 0) { PG8_SCHED; PG8_LDB(B0, 0, 0); PG8_LDA(At, 0, 0); }
    } else {
    PG8_STAGE(PG8_SB(0, 0), cB, voffB); PG8_STAGE(PG8_SB(0, 1), cB + hstep, voffB); PG8_STAGE_AH(PG8_SA(0, 0), (size_t)0, 0, false); PG8_STAGE_AH(PG8_SA(0, 1), (size_t)0, 1, false);
    if (wr == 1) PG8_BAR;
    PG8_WAIT_V(2); PG8_BAR;
    PG8_STAGE(PG8_SB(1, 0), cB + kstep, voffB); PG8_STAGE_AH(PG8_SA(1, 0), kstep, 0, false); PG8_STAGE(PG8_SB(1, 1), cB + hstep + kstep, voffB);
    PG8_WAIT_V(6); PG8_BAR;
    }
    for (;;) {
        const bool has_next = P.next(ui + 1, nxt);
        const char* nB = cB;
        if constexpr (Prob::DENSE_A) { nAb = cAb; if (has_next) { nAb = P.abase(nxt); nB = P.bbase(nxt); } }
        else { if (has_next) { int RA[2], CA[2]; stage_rc(tid * 16, RA[0], CA[0]); stage_rc(tid * 16 + 8192, RA[1], CA[1]); P.aoffs(nxt, RA, CA, on); nB = P.bbase(nxt); }
               else { on[0] = oc[0]; on[1] = oc[1]; on[2] = oc[2]; on[3] = oc[3]; } }
#pragma clang loop unroll(disable)
        for (int t = 0; t < nt; t += 2) {
            const bool last = (t == nt - 2);
            const size_t kb1 = (size_t)(t + 1) * kstep;
            const size_t kb2 = last ? (size_t)0 : (size_t)(t + 2) * kstep, kb3 = kb2 + kstep;
            const char* b2 = last ? nB : cB + (size_t)(t + 2) * kstep; const char* b3 = b2 + kstep;
            if constexpr (NB1 && MK_F8_PIPE != 0) {
            PG8_STAGE_AH(PG8_SA(1, 1), kb1, 1, false);
            PG8_WAIT_V(6); PG8_WAIT_L(0); PG8_BAR; PG8_SCHED; PG8_LDA(At2, 0, 1); PG8_MMA(0, 0, At, B0); PG8_BAR; PG8_SCHED;
            PG8_STAGE(PG8_SB(0, 0), b2, voffB); PG8_STAGE_AH(PG8_SA(0, 0), kb2, 0, last);
            PG8_WAIT_V(6); PG8_WAIT_L(0); PG8_BAR; PG8_SCHED; PG8_LDB(B02, 1, 0); PG8_LDA(At, 1, 0); PG8_MMA(1, 0, At2, B0); PG8_BAR; PG8_SCHED;
            PG8_STAGE_AH(PG8_SA(0, 1), kb2, 1, last);
            PG8_WAIT_V(6); PG8_WAIT_L(0); PG8_BAR; PG8_SCHED; PG8_LDA(At2, 1, 1); PG8_MMA(0, 0, At, B02); PG8_BAR; PG8_SCHED;
            PG8_STAGE(PG8_SB(1, 0), b3, voffB); PG8_STAGE_AH(PG8_SA(1, 0), kb3, 0, last);
            PG8_WAIT_V(6); PG8_WAIT_L(0); PG8_BAR; PG8_SCHED; PG8_LDB(B0, 0, 0); PG8_LDA(At, 0, 0); PG8_MMA(1, 0, At2, B02); PG8_BAR; PG8_SCHED;
            } else if constexpr (NB1) {
            PG8_LDB(B0, 0, 0); PG8_SCHED; PG8_LDA(At, 0, 0); PG8_STAGE_AH(PG8_SA(1, 1), kb1, 1, false);
            PG8_WAIT_V(6); PG8_WAIT_L(0); PG8_BAR; PG8_MMA(0, 0, At, B0); PG8_BAR; PG8_SCHED;
            PG8_LDA(At, 0, 1); PG8_STAGE(PG8_SB(0, 0), b2, voffB); PG8_STAGE_AH(PG8_SA(0, 0), kb2, 0, last);
            PG8_WAIT_V(6); PG8_WAIT_L(0); PG8_BAR; PG8_MMA(1, 0, At, B0); PG8_BAR; PG8_SCHED;
            PG8_LDB(B0, 1, 0); PG8_SCHED; PG8_LDA(At, 1, 0); PG8_STAGE_AH(PG8_SA(0, 1), kb2, 1, last);
            PG8_WAIT_V(6); PG8_WAIT_L(0); PG8_BAR; PG8_MMA(0, 0, At, B0); PG8_BAR; PG8_SCHED;
            PG8_LDA(At, 1, 1); PG8_STAGE(PG8_SB(1, 0), b3, voffB); PG8_STAGE_AH(PG8_SA(1, 0), kb3, 0, last);
            PG8_WAIT_V(6); PG8_WAIT_L(0); PG8_BAR; PG8_MMA(1, 0, At, B0); PG8_BAR; PG8_SCHED;
            } else {
            PG8_LDB(B0, 0, 0); PG8_LDB(B1, 0, 1); PG8_SCHED; PG8_LDA(At, 0, 0); PG8_STAGE_AH(PG8_SA(1, 1), kb1, 1, false);
            PG8_WAIT_V(8); PG8_WAIT_L(0); PG8_BAR; PG8_MMA(0, 0, At, B0); PG8_MMA(0, 1, At, B1); PG8_BAR; PG8_SCHED;
            PG8_LDA(At, 0, 1); PG8_STAGE(PG8_SB(0, 0), b2, voffB); PG8_STAGE(PG8_SB(0, 1), b2 + hstep, voffB); PG8_STAGE_AH(PG8_SA(0, 0), kb2, 0, last);
            PG8_WAIT_V(8); PG8_WAIT_L(0); PG8_BAR; PG8_MMA(1, 0, At, B0); PG8_MMA(1, 1, At, B1); PG8_BAR; PG8_SCHED;
            PG8_LDB(B0, 1, 0); PG8_LDB(B1, 1, 1); PG8_SCHED; PG8_LDA(At, 1, 0); PG8_STAGE_AH(PG8_SA(0, 1), kb2, 1, last);
            PG8_WAIT_V(8); PG8_WAIT_L(0); PG8_BAR; PG8_MMA(0, 0, At, B0); PG8_MMA(0, 1, At, B1); PG8_BAR; PG8_SCHED;
            PG8_LDA(At, 1, 1); PG8_STAGE(PG8_SB(1, 0), b3, voffB); PG8_STAGE(PG8_SB(1, 1), b3 + hstep, voffB); PG8_STAGE_AH(PG8_SA(1, 0), kb3, 0, last);
            PG8_WAIT_V(8); PG8_WAIT_L(0); PG8_BAR; PG8_MMA(1, 0, At, B0); PG8_MMA(1, 1, At, B1); PG8_BAR; PG8_SCHED;
            }
        }
        if constexpr (ALIGN_EPI) { if (wr == 0) PG8_BAR; }
        E(acc, cur, wr, wc, fr, fq);
        if (!has_next) break;
#pragma unroll
        for (int a = 0; a < 2; ++a)
#pragma unroll
            for (int b = 0; b < 2; ++b)
#pragma unroll
                for (int m = 0; m < 4; ++m)
#pragma unroll
                    for (int n = 0; n < 2; ++n) acc[a][b][m][n] = (f32x4){0.f, 0.f, 0.f, 0.f};
        cur = nxt; cB = nB; cAb = nAb; oc[0] = on[0]; oc[1] = on[1]; oc[2] = on[2]; oc[3] = on[3]; ++ui;
        if constexpr (ALIGN_EPI) { if (wr == 1) PG8_BAR; }
    }
    PG8_WAIT_V(0);
    if constexpr (!ALIGN_EPI) { if (wr == 0) PG8_BAR; }
    PG8_BAR;
#undef PG8_SA
#undef PG8_SB
#undef PG8_STAGE
#undef PG8_STAGE_A
#undef PG8_STAGE_AH
#undef PG8_LDA
#undef PG8_LDB
#undef PG8_MMA
#undef PG8_CAT
#undef PG8_WAIT_V
#undef PG8_WAIT_L
#undef PG8_BAR
#undef PG8_SCHED
}

struct DenseProb {
    static constexpr bool DENSE_A = true; int arow;
    __device__ __forceinline__ const char* abase(const Unit& u) const { return Abase + (size_t)u.pm * BM * arow; }
    int K, ldb; const char* Abase; const char* Bt; int lda; int nM, nN, nwg, G, c, bn;
    __device__ __forceinline__ void init(const bf16* A, int lda_, const bf16* B, int M, int N, int K_, int G_, int c_, int bn_ = BM) { Abase = (const char*)A; Bt = (const char*)B; lda = lda_; arow = lda_ * 2; K = K_; ldb = K_; bn = bn_; nM = M / BM; nN = N / bn_; nwg = nM * nN; G = G_; c = c_; }
    __device__ __forceinline__ bool next(int i, Unit& u) const {
        const long L = (long)i * G + c; if (L >= nwg) return false;
        int wgid = (int)L; { const int q = nwg / NXCD, r = nwg % NXCD, xcd = wgid % NXCD, off = wgid / NXCD; wgid = (xcd < r ? xcd * (q + 1) : r * (q + 1) + (xcd - r) * q) + off; }
        const int nig = WGM * nN, gid = wgid / nig, fm = gid * WGM, gsz = (nM - fm) < WGM ? (nM - fm) : WGM;
        u.pm = fm + ((wgid % nig) % gsz); u.pn = (wgid % nig) / gsz; u.e = 0; return true;
    }
    __device__ __forceinline__ const char* bbase(const Unit& u) const { return Bt + (size_t)u.pn * bn * K * 2; }
    __device__ __forceinline__ void aoffs(const Unit& u, const int (&R)[2], const int (&C)[2], unsigned (&o)[4]) const {
#pragma unroll
        for (int h = 0; h < 2; ++h)
#pragma unroll
            for (int i = 0; i < 2; ++i) o[2 * h + i] = (unsigned)(((size_t)(u.pm * BM + h * HALF + R[i]) * lda + C[i]) * 2);
    }
};
__device__ __forceinline__ bool xcd_range_unit(int i, int nunits, int G, int c, int& L) {
    const int x = c % NXCD, cc = c / NXCD, per = G / NXCD, q = nunits / NXCD, r = nunits % NXCD;
    const int start = x * q + (x < r ? x : r), cnt = q + (x < r ? 1 : 0), li = i * per + cc;
    if (li >= cnt) return false; L = start + li; return true;
}
struct MoeUpProb {
    static constexpr bool DENSE_A = false;
    __device__ __forceinline__ const char* abase(const Unit&) const { return Abase; }
    int K, ldb; int arow, brow;
    int pshift, btile;
    const char* Abase; const char* W13; const int* sorted; const LAS int* tile_e; int ntiles, nunits, G, c;
    __device__ __forceinline__ bool next(int i, Unit& u) const {
        int L; if (!xcd_range_unit(i, nunits, G, c, L)) return false;
        const int tile = L >> pshift; u.pn = L & ((1 << pshift) - 1);
        if (tile < ntiles) { u.pm = tile; u.e = __builtin_amdgcn_readfirstlane(tile_e[tile]); } else { u.pm = MAXTILES + (tile - ntiles); u.e = NEXP; }
        return true;
    }
    __device__ __forceinline__ const char* bbase(const Unit& u) const { return W13 + ((size_t)u.e * 1024 + (size_t)u.pn * btile) * brow; }
    __device__ __forceinline__ void aoffs(const Unit& u, const int (&R)[2], const int (&C)[2], unsigned (&o)[4]) const {
#pragma unroll
        for (int h = 0; h < 2; ++h)
#pragma unroll
            for (int i = 0; i < 2; ++i) { int row;
                if (u.e == NEXP) row = (u.pm - MAXTILES) * BM + h * HALF + R[i];
                else row = sorted[u.pm * BM + h * HALF + R[i]];
                o[2 * h + i] = (unsigned)((size_t)row * arow + C[i] * 2); }
    }
};
struct MoeDownProb {
    static constexpr bool DENSE_A = true;
    __device__ __forceinline__ const char* abase(const Unit& u) const { return Abase + (size_t)u.pm * BM * arow; }
    int K, ldb; int arow, brow, pshift, btile; const char* Abase; const char* W2; const LAS int* tile_e; int ntiles, nunits, G, c;
    __device__ __forceinline__ bool next(int i, Unit& u) const {
        int L; if (!xcd_range_unit(i, nunits, G, c, L)) return false;
        const int tile = L >> pshift; u.pn = L & ((1 << pshift) - 1);
        if (tile < ntiles) { u.pm = tile; u.e = __builtin_amdgcn_readfirstlane(tile_e[tile]); } else { u.pm = MAXTILES + (tile - ntiles); u.e = NEXP; }
        return true;
    }
    __device__ __forceinline__ const char* bbase(const Unit& u) const { return W2 + ((size_t)u.e * 2048 + (size_t)u.pn * btile) * brow; }
    __device__ __forceinline__ void aoffs(const Unit& u, const int (&R)[2], const int (&C)[2], unsigned (&o)[4]) const {
#pragma unroll
        for (int h = 0; h < 2; ++h)
#pragma unroll
            for (int i = 0; i < 2; ++i) o[2 * h + i] = (unsigned)((size_t)(u.pm * BM + h * HALF + R[i]) * arow + C[i] * 2);
    }
};
struct CmpProb {
    static constexpr bool DENSE_A = false; int arow;
    __device__ __forceinline__ const char* abase(const Unit&) const { return Abase; }
    int K, ldb; const char* Abase; const char* Bt; int G, c;
    __device__ __forceinline__ bool next(int i, Unit& u) const { const int L = i * G + c; if (L >= 16) return false; u.pm = L; u.pn = 0; u.e = 0; return true; }
    __device__ __forceinline__ const char* bbase(const Unit&) const { return Bt; }
    __device__ __forceinline__ void aoffs(const Unit& u, const int (&R)[2], const int (&C)[2], unsigned (&o)[4]) const {
#pragma unroll
        for (int h = 0; h < 2; ++h)
#pragma unroll
            for (int i = 0; i < 2; ++i) { const int m = u.pm * BM + h * HALF + R[i], seq = m >> 7, n = m & 127;
                o[2 * h + i] = (unsigned)((((size_t)seq * NS + 16 * n) * 128 + C[i]) * 2); }
    }
};
struct RouterProb {
    static constexpr bool DENSE_A = false; int arow;
    __device__ __forceinline__ const char* abase(const Unit&) const { return Abase; }
    int K, ldb; const char* Abase; const char* Bt; int G, c;
    __device__ __forceinline__ bool next(int i, Unit& u) const { const int L = i * G + c; if (L >= (NT / BM) * 4) return false; u.pm = L >> 2; u.pn = 0; u.e = L & 3; return true; }
    __device__ __forceinline__ const char* bbase(const Unit& u) const { return Bt + (size_t)u.e * 512 * 2; }
    __device__ __forceinline__ void aoffs(const Unit& u, const int (&R)[2], const int (&C)[2], unsigned (&o)[4]) const {
#pragma unroll
        for (int h = 0; h < 2; ++h)
#pragma unroll
            for (int i = 0; i < 2; ++i) o[2 * h + i] = (unsigned)(((size_t)(u.pm * BM + h * HALF + R[i]) * ND + u.e * 512 + C[i]) * 2);
    }
};
struct EpiF32N64 {
    static constexpr bool PERM = false;
    float* C;
    __device__ __forceinline__ void operator()(const f32x4 (&acc)[2][2][4][2], const Unit& u, int wr, int wc, int fr, int fq) const {
        if (wc >= 2) return;
        const int row0 = u.pm * BM + wr * 64 + fr, col0 = wc * 32 + 4 * fq;
#pragma unroll
        for (int ai = 0; ai < 2; ++ai)
#pragma unroll
            for (int m = 0; m < 4; ++m) { float* rowp = C + ((size_t)u.e * NT + row0 + ai * HALF + m * 16) * 64 + col0;
#pragma unroll
                for (int n = 0; n < 2; ++n) *(f32x4*)(rowp + n * 16) = acc[ai][0][m][n]; }
    }
};
struct EpiSwigluF8 {
    static constexpr bool PERM = true;
    unsigned char* H; float inmul;
    __device__ __forceinline__ void operator()(const f32x4 (&acc)[2][2][4][2], const Unit& u, int wr, int wc, int fr, int fq) const {
        const int row0 = u.pm * BM + wr * 64 + fr, col0 = u.pn * 64 + wc * 16 + 4 * fq;
#pragma unroll
        for (int ai = 0; ai < 2; ++ai)
#pragma unroll
            for (int m = 0; m < 4; ++m) { unsigned char* rowp = H + (size_t)(row0 + ai * HALF + m * 16) * EFF + col0;
                float o[4];
#pragma unroll
                for (int j = 0; j < 4; ++j) { const float h1 = acc[ai][0][m][0][j] * inmul, h3 = acc[ai][0][m][1][j] * inmul; o[j] = fminf(fmaxf(siluf_(h1) * h3 * 8.0f, -448.0f), 448.0f); }
                int w0 = __builtin_amdgcn_cvt_pk_fp8_f32(o[0], o[1], 0, false); w0 = __builtin_amdgcn_cvt_pk_fp8_f32(o[2], o[3], w0, true);
                *(unsigned*)rowp = (unsigned)w0; }
    }
};
struct EpiBf16N128 {
    static constexpr bool PERM = true;
    bf16* O; int ldc; float mul;
    __device__ __forceinline__ void operator()(const f32x4 (&acc)[2][2][4][2], const Unit& u, int wr, int wc, int fr, int fq) const {
        const int row0 = u.pm * BM + wr * 64 + fr, col0 = u.pn * HALF + wc * 32 + 8 * fq;
#pragma unroll
        for (int ai = 0; ai < 2; ++ai)
#pragma unroll
            for (int m = 0; m < 4; ++m) { bf16* rowp = O + (size_t)(row0 + ai * HALF + m * 16) * ldc + col0; const f32x4 v0 = acc[ai][0][m][0] * mul, v1 = acc[ai][0][m][1] * mul;
                v4u w; w.x = cvt_pk_bf16(v0[0], v0[1]); w.y = cvt_pk_bf16(v0[2], v0[3]); w.z = cvt_pk_bf16(v1[0], v1[1]); w.w = cvt_pk_bf16(v1[2], v1[3]);
                *(v4u*)rowp = w; }
    }
};
struct EpiFp8N128 {
    static constexpr bool PERM = true;
    unsigned char* O; int ldc; float mul;
    __device__ __forceinline__ void operator()(const f32x4 (&acc)[2][2][4][2], const Unit& u, int wr, int wc, int fr, int fq) const {
        const int row0 = u.pm * BM + wr * 64 + fr, col0 = u.pn * HALF + wc * 32 + 8 * fq;
#pragma unroll
        for (int ai = 0; ai < 2; ++ai)
#pragma unroll
            for (int m = 0; m < 4; ++m) { unsigned char* rowp = O + (size_t)(row0 + ai * HALF + m * 16) * ldc + col0; float v[8];
#pragma unroll
                for (int n = 0; n < 2; ++n)
#pragma unroll
                    for (int j = 0; j < 4; ++j) v[n * 4 + j] = fminf(fmaxf(acc[ai][0][m][n][j] * mul, -448.0f), 448.0f);
                int w0 = __builtin_amdgcn_cvt_pk_fp8_f32(v[0], v[1], 0, false); w0 = __builtin_amdgcn_cvt_pk_fp8_f32(v[2], v[3], w0, true);
                int w1 = __builtin_amdgcn_cvt_pk_fp8_f32(v[4], v[5], 0, false); w1 = __builtin_amdgcn_cvt_pk_fp8_f32(v[6], v[7], w1, true);
                *(v2u*)rowp = (v2u){(unsigned)w0, (unsigned)w1}; }
    }
};
}

struct Args { const float* in[27]; float* out; unsigned char* ws; int ph_lo, ph_hi; };
typedef const __attribute__((address_space(4))) Args* CArgs;
__device__ __forceinline__ const float* kin(int i) { CArgs p = (CArgs)__builtin_amdgcn_kernarg_segment_ptr(); asm volatile("" : "+s"(p)); return p->in[i]; }
struct Frame {
    LAS unsigned char* lds;
    volatile LAS unsigned* MISC;
    unsigned* ctl;
    unsigned char* ws;
    int tid, lane, wave, vcu, G, gw, NGW;
    float* out;
};

__device__ __forceinline__ void tr_item(const float* W, int ldw, int k0, int n0, int nvalid, bf16* WT, int ldt, int drow0, LAS float* scr, int lane) {
    float v[32]; const int n = lane & 31; const bool okn = n < nvalid; const float* src = W + (size_t)(k0 + (lane >> 5)) * ldw + n0 + n;
#pragma unroll
    for (int i = 0; i < 32; ++i) v[i] = okn ? src[(size_t)(2 * i) * ldw] : 0.f;
#pragma unroll
    for (int i = 0; i < 32; ++i) scr[(2 * i + (lane >> 5)) * 33 + n] = v[i];
    LDS_WAIT(); asm volatile("" ::: "memory");
    const int c = lane & 7;
#pragma unroll
    for (int j = 0; j < 4; ++j) { const int nn = (lane >> 3) + 8 * j; const LAS float* sp = scr + (8 * c) * 33 + nn;
        v4u o; o.x = pk2(sp[0 * 33], sp[1 * 33]); o.y = pk2(sp[2 * 33], sp[3 * 33]); o.z = pk2(sp[4 * 33], sp[5 * 33]); o.w = pk2(sp[6 * 33], sp[7 * 33]);
        if (nn < nvalid) *(v4u*)(WT + (size_t)(drow0 + nn) * ldt + k0 + 8 * c) = o; }
    LDS_WAIT(); asm volatile("" ::: "memory");
}
__device__ __forceinline__ void tr_item_f8(const float* W, int ldw, int k0, int n0, unsigned char* WT8, int ldt, int drow0, int rowmode, float mul, LAS float* scr, int lane, int nvalid = 32) {
    float v[32]; const int n = lane & 31; const float* src = W + (size_t)(k0 + (lane >> 5)) * ldw + n0 + n; const bool okn = n < nvalid;
#pragma unroll
    for (int i = 0; i < 32; ++i) v[i] = okn ? src[(size_t)(2 * i) * ldw] : 0.f;
#pragma unroll
    for (int i = 0; i < 32; ++i) scr[(2 * i + (lane >> 5)) * 33 + n] = v[i];
    LDS_WAIT(); asm volatile("" ::: "memory");
    const int c = lane & 3;
#pragma unroll
    for (int j = 0; j < 2; ++j) { const int nn = (lane >> 2) + 16 * j; const LAS float* sp = scr + (16 * c) * 33 + nn; int w[4];
#pragma unroll
        for (int q = 0; q < 4; ++q) { const float a0 = fminf(fmaxf(sp[(4 * q + 0) * 33] * mul, -448.f), 448.f), a1 = fminf(fmaxf(sp[(4 * q + 1) * 33] * mul, -448.f), 448.f),
                                                  a2 = fminf(fmaxf(sp[(4 * q + 2) * 33] * mul, -448.f), 448.f), a3 = fminf(fmaxf(sp[(4 * q + 3) * 33] * mul, -448.f), 448.f);
            w[q] = __builtin_amdgcn_cvt_pk_fp8_f32(a0, a1, 0, false); w[q] = __builtin_amdgcn_cvt_pk_fp8_f32(a2, a3, w[q], true); }
        const int drow = rowmode ? drow0 + (nn >> 2) * 8 + (nn & 3) : drow0 + nn;
        *(v4u*)(WT8 + (size_t)drow * ldt + k0 + 16 * c) = (v4u){(unsigned)w[0], (unsigned)w[1], (unsigned)w[2], (unsigned)w[3]}; }
    LDS_WAIT(); asm volatile("" ::: "memory");
}
__device__ __forceinline__ bool tr_matrix_f8(int& it, const float* W, int ldw, int K, int c0, int ncols, unsigned char* WT8, int drow0, int nrows_alloc, LAS float* scr, int lane) {
    const int nb = (ncols + 31) / 32, items = (K / 64) * nb;
    if (it >= items) { it -= items; return false; }
    const int kb = it / nb, b = it % nb, nv = ncols - 32 * b;
    (void)nrows_alloc;
    tr_item_f8(W, ldw, 64 * kb, c0 + 32 * b, WT8, K, drow0 + 32 * b, 0, 64.0f, scr, lane, nv < 32 ? nv : 32);
    return true;
}
__device__ __forceinline__ bool tr_matrix(int& it, const float* W, int ldw, int K, int c0, int ncols, bf16* WT, int drow0, LAS float* scr, int lane) {
    const int nb = (ncols + 31) / 32, items = (K / 64) * nb;
    if (it >= items) { it -= items; return false; }
    const int kb = it / nb, b = it % nb, nv = ncols - 32 * b;
    tr_item(W, ldw, 64 * kb, c0 + 32 * b, nv < 32 ? nv : 32, WT, K, drow0 + 32 * b, scr, lane);
    return true;
}
__device__ __forceinline__ void zero_rows(Frame& F, bf16* base, size_t nelem) {
    for (size_t i = ((size_t)F.gw * 64 + F.lane) * 8; i < nelem; i += (size_t)F.NGW * 64 * 8) *(v4u*)(base + i) = (v4u){0u, 0u, 0u, 0u};
}

__device__ __forceinline__ void p_prologue(Frame& F) {
    LAS float* scr = (LAS float*)(F.lds + F.wave * 16384);
    unsigned char* ws = F.ws;
    {
        LAS float* wl = (LAS float*)F.lds;
        LAS float* pl = (LAS float*)(F.lds + 32768);
        const float* w_in = kin(2); const float* pool_w = kin(3); const float* pscale = kin(4);
        bf16* WT = (bf16*)(ws + WS_WABIN);
        for (int it = blockIdx.x; it < 4 * 32; it += F.G) {
            const int g = it >> 5, k0 = (it & 31) * 64;
            for (int i = F.tid; i < 64 * 128; i += 512) wl[i] = w_in[(size_t)(k0 + (i >> 7)) * AB_IN + g * 128 + (i & 127)];
            for (int i = F.tid; i < 128 * 128; i += 512) pl[i] = pool_w[(size_t)g * 16384 + i];
            __syncthreads();
            const int d = F.tid & 127, kg = F.tid >> 7; const float sc = pscale[g * 128 + d];
            for (int kk = 0; kk < 16; kk += 8) {
                float a[8];
#pragma unroll
                for (int j = 0; j < 8; ++j) a[j] = 0.f;
                for (int c = 0; c < 128; ++c) { const float pw = pl[c * 128 + d];
#pragma unroll
                    for (int j = 0; j < 8; ++j) a[j] += wl[(kg * 16 + kk + j) * 128 + c] * pw; }
                if (MK_FP8_IN0) { float q[8];
#pragma unroll
                    for (int j = 0; j < 8; ++j) q[j] = fminf(fmaxf(a[j] * sc * 64.0f, -448.f), 448.f);
                    int w0 = __builtin_amdgcn_cvt_pk_fp8_f32(q[0], q[1], 0, false); w0 = __builtin_amdgcn_cvt_pk_fp8_f32(q[2], q[3], w0, true);
                    int w1 = __builtin_amdgcn_cvt_pk_fp8_f32(q[4], q[5], 0, false); w1 = __builtin_amdgcn_cvt_pk_fp8_f32(q[6], q[7], w1, true);
                    *(v2u*)((unsigned char*)WT + (size_t)(g * 128 + d) * ND + k0 + kg * 16 + kk) = (v2u){(unsigned)w0, (unsigned)w1}; }
                else { v4u o; o.x = pk2(a[0] * sc, a[1] * sc); o.y = pk2(a[2] * sc, a[3] * sc); o.z = pk2(a[4] * sc, a[5] * sc); o.w = pk2(a[6] * sc, a[7] * sc);
                    *(v4u*)(WT + (size_t)(g * 128 + d) * ND + k0 + kg * 16 + kk) = o; }
            }
            __syncthreads();
        }
    }
    __syncthreads();
    for (int it0 = F.gw; ; it0 += F.NGW) {
        int it = it0;
        if (MK_FP8_IN0 ? tr_matrix_f8(it, kin(2), AB_IN, ND, 512, AB_IN - 512, ws + WS_WABIN, 512, AB_IN, scr, F.lane) : tr_matrix(it, kin(2), AB_IN, ND, 512, AB_IN - 512, (bf16*)(ws + WS_WABIN), 512, scr, F.lane)) continue;
        if (tr_matrix(it, kin(5), ND, ND, 0, ND, (bf16*)(ws + WS_WABOUT), 0, scr, F.lane)) continue;
        if (MK_FP8_IN1 ? tr_matrix_f8(it, kin(6), CD_IN, ND, 0, CD_IN, ws + WS_WCDIN, 0, CD_INP, scr, F.lane) : tr_matrix(it, kin(6), CD_IN, ND, 0, CD_IN, (bf16*)(ws + WS_WCDIN), 0, scr, F.lane)) continue;
        if (tr_matrix(it, kin(14), ND, ND, 0, ND, (bf16*)(ws + WS_WCDOUT), 0, scr, F.lane)) continue;
        if (tr_matrix(it, kin(11), 1536, 384, 0, 1536, (bf16*)(ws + WS_WUQ), 0, scr, F.lane)) continue;
        if (tr_matrix(it, kin(13), 2048, 512, 0, 2048, (bf16*)(ws + WS_WUKV), 0, scr, F.lane)) continue;
        if (tr_matrix(it, kin(8), 128, 4096, 0, 128, (bf16*)(ws + WS_CW1), 0, scr, F.lane)) continue;
        if (tr_matrix(it, kin(8) + (size_t)4096 * 128, 128, 4096, 0, 128, (bf16*)(ws + WS_CW1), 128, scr, F.lane)) continue;
        break;
    }
    if (MK_FP8_IN1) zero_rows(F, (bf16*)(ws + WS_WCDIN + (size_t)3552 * ND), (size_t)(CD_INP - 3552) * ND / 2);
    else zero_rows(F, (bf16*)(ws + WS_WCDIN) + (size_t)CD_IN * ND, (size_t)(CD_INP - CD_IN) * ND);
    { const float* x = kin(0); bf16* xb = (bf16*)(ws + WS_XB0); const size_t stride = (size_t)F.NGW * 64 * 8;
      for (size_t i = ((size_t)F.gw * 64 + F.lane) * 8; i < (size_t)NT * ND; i += 4 * stride) {
          f32x4 a[4], c[4];
#pragma unroll
          for (int u = 0; u < 4; ++u) if (i + u * stride < (size_t)NT * ND) { a[u] = *(const f32x4*)(x + i + u * stride); c[u] = *(const f32x4*)(x + i + u * stride + 4); }
#pragma unroll
          for (int u = 0; u < 4; ++u) if (i + u * stride < (size_t)NT * ND) { v4u o; o.x = pk2(a[u][0], a[u][1]); o.y = pk2(a[u][2], a[u][3]); o.z = pk2(c[u][0], c[u][1]); o.w = pk2(c[u][2], c[u][3]); *(v4u*)(xb + i + u * stride) = o;
              if (MK_FP8_IN0) { int w0 = __builtin_amdgcn_cvt_pk_fp8_f32(a[u][0], a[u][1], 0, false); w0 = __builtin_amdgcn_cvt_pk_fp8_f32(a[u][2], a[u][3], w0, true);
                  int w1 = __builtin_amdgcn_cvt_pk_fp8_f32(c[u][0], c[u][1], 0, false); w1 = __builtin_amdgcn_cvt_pk_fp8_f32(c[u][2], c[u][3], w1, true);
                  *(v2u*)(ws + WS_X1F8 + i + u * stride) = (v2u){(unsigned)w0, (unsigned)w1}; } } } }
    for (int o = F.gw; o < 128; o += F.NGW) { const int kv = o >> 6, fc = o & 63; const float* pos = kin(7) + (size_t)kv * 4096 + fc * 64; const float* w1 = kin(8) + ((size_t)kv * 4096 + fc * 64) * 128;
        float s0 = 0.f, s1 = 0.f;
#pragma unroll 8
        for (int f = 0; f < 64; ++f) { const float pf_ = pos[f]; const f32x2 wv = *(const f32x2*)(w1 + (size_t)f * 128 + F.lane * 2); s0 += pf_ * wv[0]; s1 += pf_ * wv[1]; }
        *(f32x2*)((float*)(ws + WS_CMPB) + 256 + (size_t)o * 128 + F.lane * 2) = (f32x2){s0, s1}; }
}
__device__ __forceinline__ void cmp_bias_finish(Frame& F) {
    if (blockIdx.x == 0 && F.tid < 256) { const int kv = F.tid >> 7, h = F.tid & 127; const float* part = (const float*)(F.ws + WS_CMPB) + 256 + (size_t)kv * 64 * 128 + h;
        float sacc = 0.f; for (int fc = 0; fc < 64; ++fc) sacc += part[fc * 128];
        ((float*)(F.ws + WS_CMPB))[F.tid] = sacc; }
}
constexpr int MW_ITEMS_L = 65 * 1536 + 64;
__device__ __forceinline__ void moe_weight_item(int l, int it, unsigned char* ws, LAS float* scr, int lane) {
    bf16* W13 = (bf16*)(ws + WS_W13 + (size_t)l * WS_MOE_LSTRIDE); bf16* W2 = (bf16*)(ws + WS_W2 + (size_t)l * WS_MOE_LSTRIDE); bf16* RT = (bf16*)(ws + WS_RT + (size_t)l * MiB);
    if (it >= 65 * 1536) { const int r = it - 65 * 1536, kb = r >> 1, b = r & 1;
        tr_item(kin(19) + (size_t)l * ND * NEXP, NEXP, 64 * kb, 32 * b, 32, RT, ND, 32 * b, scr, lane); return; }
    const int e = it / 1536, r = it % 1536;
    const float *w1, *w3, *w2;
    if (e < NEXP) { const size_t o = ((size_t)l * NEXP + e) * ND * EFF; w1 = kin(21) + o; w3 = kin(22) + o; w2 = kin(23) + o; }
    else { const size_t o = (size_t)l * ND * EFF; w1 = kin(24) + o; w3 = kin(25) + o; w2 = kin(26) + o; }
    if (r < 1024) { const int which = r >> 9, rr = r & 511, kb = rr >> 4, nb = rr & 15;
        const int j = nb >> 2, drow = j * 256 + which * 128 + (nb & 3) * 32;
        if (MK_FP8_MOE) tr_item_f8(which ? w3 : w1, EFF, 64 * kb, 32 * nb, (unsigned char*)W13 + (size_t)e * 1024 * ND, ND, (nb >> 1) * 128 + (nb & 1) * 64 + which * 4, 1, 64.0f, scr, lane);
        else tr_item(which ? w3 : w1, EFF, 64 * kb, 32 * nb, 32, W13 + (size_t)e * 1024 * ND, ND, drow, scr, lane); }
    else { const int rr = r - 1024, kb = rr >> 6, nb = rr & 63;
        if (MK_FP8_MOE) tr_item_f8(w2, ND, 64 * kb, 32 * nb, (unsigned char*)W2 + (size_t)e * ND * EFF, EFF, 32 * nb, 0, 64.0f, scr, lane);
        else tr_item(w2, ND, 64 * kb, 32 * nb, 32, W2 + (size_t)e * ND * EFF, EFF, 32 * nb, scr, lane); }
}
struct ConvDesc { const float* src; unsigned char* dst; int ldw, ldt, k0, drow0, rowmode, kind; };
__device__ __forceinline__ ConvDesc conv_desc(int id, unsigned char* ws) {
    ConvDesc d; d.kind = -1; d.src = nullptr; d.dst = nullptr; d.ldw = 0; d.ldt = 0; d.k0 = 0; d.drow0 = 0; d.rowmode = 0;
    if (id >= 2 * MW_ITEMS_L) return d;
    const int l = id >= MW_ITEMS_L ? 1 : 0, it = id - l * MW_ITEMS_L;
    if (it >= 65 * 1536 || !MK_FP8_MOE) { d.kind = 1; d.k0 = it; d.drow0 = l; return d; }
    const int e = it / 1536, r = it % 1536;
    const float *w1, *w3, *w2;
    if (e < NEXP) { const size_t o = ((size_t)l * NEXP + e) * ND * EFF; w1 = kin(21) + o; w3 = kin(22) + o; w2 = kin(23) + o; }
    else { const size_t o = (size_t)l * ND * EFF; w1 = kin(24) + o; w3 = kin(25) + o; w2 = kin(26) + o; }
    d.kind = 0;
    if (r < 1024) { const int which = r >> 9, rr = r & 511, kb = rr >> 4, nb = rr & 15;
        d.src = (which ? w3 : w1) + (size_t)(64 * kb) * EFF + 32 * nb; d.ldw = EFF; d.k0 = 64 * kb;
        d.dst = ws + WS_W13 + (size_t)l * WS_MOE_LSTRIDE + (size_t)e * 1024 * ND; d.ldt = ND; d.drow0 = (nb >> 1) * 128 + (nb & 1) * 64 + which * 4; d.rowmode = 1; }
    else { const int rr = r - 1024, kb = rr >> 6, nb = rr & 63;
        d.src = w2 + (size_t)(64 * kb) * ND + 32 * nb; d.ldw = ND; d.k0 = 64 * kb;
        d.dst = ws + WS_W2 + (size_t)l * WS_MOE_LSTRIDE + (size_t)e * ND * EFF; d.ldt = EFF; d.drow0 = 32 * nb; d.rowmode = 0; }
    return d;
}
__device__ __forceinline__ void conv_load(const ConvDesc& d, float (&v)[32], int lane) {
    if (d.kind != 0) return;
    const float* src = d.src + (size_t)(lane >> 5) * d.ldw + (lane & 31);
#pragma unroll
    for (int i = 0; i < 32; ++i) v[i] = src[(size_t)(2 * i) * d.ldw];
}
__device__ __forceinline__ void conv_finish(const ConvDesc& d, const float (&v)[32], unsigned char* ws, LAS float* scr, int lane) {
    if (d.kind == 1) { moe_weight_item(d.drow0, d.k0, ws, scr, lane); return; }
    if (d.kind != 0) return;
    const int n = lane & 31;
#pragma unroll
    for (int i = 0; i < 32; ++i) scr[(2 * i + (lane >> 5)) * 33 + n] = v[i];
    LDS_WAIT(); asm volatile("" ::: "memory");
    const int c = lane & 3;
#pragma unroll
    for (int j = 0; j < 2; ++j) { const int nn = (lane >> 2) + 16 * j; const LAS float* sp = scr + (16 * c) * 33 + nn; int w[4];
#pragma unroll
        for (int q = 0; q < 4; ++q) { const float a0 = fminf(fmaxf(sp[(4 * q + 0) * 33] * 64.0f, -448.f), 448.f), a1 = fminf(fmaxf(sp[(4 * q + 1) * 33] * 64.0f, -448.f), 448.f),
                                                  a2 = fminf(fmaxf(sp[(4 * q + 2) * 33] * 64.0f, -448.f), 448.f), a3 = fminf(fmaxf(sp[(4 * q + 3) * 33] * 64.0f, -448.f), 448.f);
            w[q] = __builtin_amdgcn_cvt_pk_fp8_f32(a0, a1, 0, false); w[q] = __builtin_amdgcn_cvt_pk_fp8_f32(a2, a3, w[q], true); }
        const int drow = d.rowmode ? d.drow0 + (nn >> 2) * 8 + (nn & 3) : d.drow0 + nn;
        *(v4u*)(d.dst + (size_t)drow * d.ldt + d.k0 + 16 * c) = (v4u){(unsigned)w[0], (unsigned)w[1], (unsigned)w[2], (unsigned)w[3]}; }
    LDS_WAIT(); asm volatile("" ::: "memory");
}
__device__ __forceinline__ void p_moe_weights_queue(Frame& F, unsigned* queue) {
    LAS float* scr = (LAS float*)(F.lds + F.wave * 16384);
    constexpr int BATCH = 16, NB_ = (2 * MW_ITEMS_L + BATCH - 1) / BATCH;
    for (;;) {
        unsigned bq = 0; if (F.lane == 0) bq = atomicAdd(queue, 1u);
        const int bi = __builtin_amdgcn_readfirstlane((int)bq);
        if (bi >= NB_) break;
        const int s0 = bi * BATCH;
        float va[32], vb[32];
        ConvDesc dA = conv_desc(s0, F.ws); conv_load(dA, va, F.lane);
        for (int k = 0; k < BATCH; k += 2) {
            ConvDesc dB = conv_desc(s0 + k + 1, F.ws); conv_load(dB, vb, F.lane);
            conv_finish(dA, va, F.ws, scr, F.lane);
            dA = conv_desc(k + 2 < BATCH ? s0 + k + 2 : 2 * MW_ITEMS_L, F.ws); conv_load(dA, va, F.lane);
            conv_finish(dB, vb, F.ws, scr, F.lane);
        }
    }
    for (int l = 0; l < 2; ++l) zero_rows(F, (bf16*)(F.ws + WS_RT + (size_t)l * MiB) + (size_t)NEXP * ND, (size_t)(256 - NEXP) * ND);
}

__device__ __forceinline__ void ln_finish(float (&v)[4][8], const float* g, const float* b, int lane, bf16* ob, float* of, unsigned char* o8 = nullptr) {
    float s = 0.f;
#pragma unroll
    for (int j = 0; j < 4; ++j)
#pragma unroll
        for (int i = 0; i < 8; ++i) s += v[j][i];
    const float mean = wave_sum(s) * (1.f / ND); float s2 = 0.f;
#pragma unroll
    for (int j = 0; j < 4; ++j)
#pragma unroll
        for (int i = 0; i < 8; ++i) { v[j][i] -= mean; s2 += v[j][i] * v[j][i]; }
    const float rstd = 1.f / sqrtf(wave_sum(s2) * (1.f / ND) + LN_EPS);
#pragma unroll
    for (int j = 0; j < 4; ++j) { unsigned c0 = (unsigned)(j * 64 + lane) * 8u; asm volatile("" : "+v"(c0));
        const f32x4 g0 = *(const f32x4*)((const char*)g + c0 * 4u), g1 = *(const f32x4*)((const char*)g + c0 * 4u + 16u), b0 = *(const f32x4*)((const char*)b + c0 * 4u), b1 = *(const f32x4*)((const char*)b + c0 * 4u + 16u);
        float o[8];
#pragma unroll
        for (int i = 0; i < 4; ++i) { o[i] = v[j][i] * rstd * g0[i] + b0[i]; o[4 + i] = v[j][4 + i] * rstd * g1[i] + b1[i]; }
        if (ob) { v4u w; w.x = pk2(o[0], o[1]); w.y = pk2(o[2], o[3]); w.z = pk2(o[4], o[5]); w.w = pk2(o[6], o[7]); *(v4u*)((char*)ob + c0 * 2u) = w; }
        if (of) { *(f32x4*)((char*)of + c0 * 4u) = (f32x4){o[0], o[1], o[2], o[3]}; *(f32x4*)((char*)of + c0 * 4u + 16u) = (f32x4){o[4], o[5], o[6], o[7]}; }
        if (o8) { int w0 = __builtin_amdgcn_cvt_pk_fp8_f32(o[0], o[1], 0, false); w0 = __builtin_amdgcn_cvt_pk_fp8_f32(o[2], o[3], w0, true);
            int w1 = __builtin_amdgcn_cvt_pk_fp8_f32(o[4], o[5], 0, false); w1 = __builtin_amdgcn_cvt_pk_fp8_f32(o[6], o[7], w1, true);
            *(v2u*)(o8 + c0) = (v2u){(unsigned)w0, (unsigned)w1}; } }
}
__device__ __forceinline__ void p_ln1(Frame& F, const bf16* xin, const bf16* mixo, const float* g, const float* b, bf16* xo, unsigned char* xo8) {
    for (int m = F.gw; m < NT; m += F.NGW) {
        float v[4][8];
#pragma unroll
        for (int j = 0; j < 4; ++j) { const size_t o = (size_t)m * ND + (j * 64 + F.lane) * 8; float a[8], c[8]; unpack8(*(const v4u*)(xin + o), a); unpack8(*(const v4u*)(mixo + o), c);
#pragma unroll
            for (int i = 0; i < 8; ++i) v[j][i] = DN_ALPHA * a[i] + c[i]; }
        ln_finish(v, g, b, F.lane, xo + (size_t)m * ND, nullptr, xo8 ? xo8 + (size_t)m * ND : nullptr);
    }
}
__device__ __forceinline__ void unpack8_fp8(const v2u w, float (&f)[8]) {
    const f32x2 a = __builtin_amdgcn_cvt_pk_f32_fp8((int)w.x, false), b = __builtin_amdgcn_cvt_pk_f32_fp8((int)w.x, true), c = __builtin_amdgcn_cvt_pk_f32_fp8((int)w.y, false), d = __builtin_amdgcn_cvt_pk_f32_fp8((int)w.y, true);
    f[0] = a[0]; f[1] = a[1]; f[2] = b[0]; f[3] = b[1]; f[4] = c[0]; f[5] = c[1]; f[6] = d[0]; f[7] = d[1];
}
__device__ __forceinline__ void p_combine_ln2(Frame& F, const bf16* x1, const unsigned char* y2, const int* slot, const float* wsel, const float* g, const float* b, bf16* xo, float* fo, unsigned char* xo8) {
    for (int m = F.gw; m < NT; m += F.NGW) {
        const int myrow = slot[m * 8 + (F.lane & 7)]; const float myw = wsel[m * 8 + (F.lane & 7)] * (1.0f / 16.0f);
        float v[4][8];
        { v4u xa[4]; v2u sa[4];
#pragma unroll
          for (int j = 0; j < 4; ++j) { xa[j] = *(const v4u*)(x1 + (size_t)m * ND + (j * 64 + F.lane) * 8); sa[j] = *(const v2u*)(y2 + (size_t)(SH_ROW0 + m) * ND + (j * 64 + F.lane) * 8); }
#pragma unroll
          for (int j = 0; j < 4; ++j) { float a[8], c[8]; unpack8(xa[j], a); unpack8_fp8(sa[j], c);
#pragma unroll
              for (int i = 0; i < 8; ++i) v[j][i] = DN_ALPHA * a[i] + c[i] * (1.0f / 16.0f); } }
#pragma unroll
        for (int kg = 0; kg < 2; ++kg) { v2u ra[4][4]; float wk[4];
#pragma unroll
            for (int k = 0; k < 4; ++k) { const int row = __builtin_amdgcn_readlane(myrow, kg * 4 + k); wk[k] = __builtin_bit_cast(float, __builtin_amdgcn_readlane(__builtin_bit_cast(int, myw), kg * 4 + k));
#pragma unroll
                for (int j = 0; j < 4; ++j) ra[k][j] = *(const v2u*)(y2 + (size_t)row * ND + (j * 64 + F.lane) * 8); }
#pragma unroll
            for (int k = 0; k < 4; ++k)
#pragma unroll
                for (int j = 0; j < 4; ++j) { float c[8]; unpack8_fp8(ra[k][j], c);
#pragma unroll
                    for (int i = 0; i < 8; ++i) v[j][i] += wk[k] * c[i]; } }
        ln_finish(v, g, b, F.lane, xo ? xo + (size_t)m * ND : nullptr, fo ? fo + (size_t)m * ND : nullptr, xo8 ? xo8 + (size_t)m * ND : nullptr);
    }
}

__device__ __forceinline__ void p_pool(Frame& F, int wid, int nw) {
    const bf16* proj = (const bf16*)(F.ws + WS_PROJ); bf16* mixin = (bf16*)(F.ws + WS_MIXIN);
    for (int m = wid; m < NT; m += nw) {
        const int s = m & (NS - 1);
        const int g = F.lane >> 4, w = 2 << g; const int lo = (s + 1 - w) > 0 ? (s + 1 - w) : 0; const float cnt = (float)((s + 1) < w ? (s + 1) : w);
        float acc[8], cur[8];
#pragma unroll
        for (int i = 0; i < 8; ++i) acc[i] = 0.f;
        for (int j = lo; j <= s; ++j) { float t[8]; unpack8(*(const v4u*)(proj + (size_t)(m - s + j) * AB_IN + F.lane * 8), t);
#pragma unroll
            for (int i = 0; i < 8; ++i) acc[i] += t[i]; }
        unpack8(*(const v4u*)(proj + (size_t)m * AB_IN + F.lane * 8), cur);
        float o[8];
#pragma unroll
        for (int i = 0; i < 8; ++i) o[i] = acc[i] / cnt - cur[i];
        v4u wv; wv.x = pk2(o[0], o[1]); wv.y = pk2(o[2], o[3]); wv.z = pk2(o[4], o[5]); wv.w = pk2(o[6], o[7]); *(v4u*)(mixin + (size_t)m * ND + F.lane * 8) = wv;
    }
}
namespace ret {
typedef short v4i16_t __attribute__((ext_vector_type(4)));
constexpr int PITCH = 272, TILE = 128 * PITCH;
__device__ __forceinline__ bf16x8 trfrag(LAS unsigned char* trb, int r0, int r1, int c0) {
    const v4i16_t a = __builtin_amdgcn_ds_read_tr16_b64_v4i16((LAS v4i16_t*)(trb + r0 * PITCH + c0 * 2));
    const v4i16_t b = __builtin_amdgcn_ds_read_tr16_b64_v4i16((LAS v4i16_t*)(trb + r1 * PITCH + c0 * 2));
    return (bf16x8){a[0], a[1], a[2], a[3], b[0], b[1], b[2], b[3]};
}
}
__device__ __forceinline__ void p_retention_mfma(Frame& F, int bh) {
    const bf16* proj = (const bf16*)(F.ws + WS_PROJ); bf16* mixin = (bf16*)(F.ws + WS_MIXIN); const int* posv = (const int*)kin(1);
    constexpr int P = ret::PITCH;
    LAS unsigned char* KT = F.lds; LAS unsigned char* VT = F.lds + ret::TILE; LAS unsigned char* ST = F.lds + 2 * ret::TILE;
    const int b = bh / 6, h = bh % 6, w = F.wave, lane = F.lane, i16 = lane & 15, g = lane >> 4, q4 = (lane & 15) >> 2, p4 = lane & 3;
    const float lg = log2f(1.0f - exp2f(-5.0f - (float)h)), gc = exp2f(128.f * lg);
    const int rowb = i16 * P + 16 * g;
    const int trl = q4 * P + 8 * p4;
    LAS unsigned char* const trV4 = VT + trl + 4 * g * P;
    LAS unsigned char* const trV8 = VT + trl + 8 * g * P;
    LAS unsigned char* const trK8 = KT + trl + 8 * g * P;
    f32x4 T[2][8];
#pragma unroll
    for (int a = 0; a < 2; ++a)
#pragma unroll
        for (int d = 0; d < 8; ++d) T[a][d] = (f32x4){0.f, 0.f, 0.f, 0.f};
    const int srow = F.tid >> 2, scb = (F.tid & 3) * 4;
    for (int n = 0; n < NS / 128; ++n) {
        const size_t m0 = (size_t)b * NS + n * 128;
        {
          const float fk = exp2f(-(float)srow * lg) * 0.08838834764831845f, pz = (float)posv[m0 + srow]; const int t4 = F.tid & 3;
          const bf16* krow = proj + (m0 + srow) * AB_IN + 1280 + h * 128;
#pragma unroll
          for (int c = 0; c < 2; ++c) { const int c8 = 2 * t4 + c; float x1[8], x2[8];
              unpack8(*(const v4u*)(krow + c8 * 8), x1); unpack8(*(const v4u*)(krow + 64 + c8 * 8), x2);
#pragma unroll
              for (int j = 0; j < 8; ++j) { const float invf = exp2f(-(float)(c8 * 8 + j) * (13.287712379549449f / 64.f)); float sn, cs; fast_sincos(pz * invf, sn, cs);
                  const float a = (x1[j] * cs - x2[j] * sn) * fk, bq = (x1[j] * sn + x2[j] * cs) * fk; x1[j] = a; x2[j] = bq; }
              v4u o; o.x = pk2(x1[0], x1[1]); o.y = pk2(x1[2], x1[3]); o.z = pk2(x1[4], x1[5]); o.w = pk2(x1[6], x1[7]); *(LAS v4u*)(KT + srow * P + c8 * 16) = o;
              o.x = pk2(x2[0], x2[1]); o.y = pk2(x2[2], x2[3]); o.z = pk2(x2[4], x2[5]); o.w = pk2(x2[6], x2[7]); *(LAS v4u*)(KT + srow * P + (c8 + 8) * 16) = o; } }
        bf16x8 qf[4], pf[4]; float rs[4] = {0.f, 0.f, 0.f, 0.f}, rq[4] = {0.f, 0.f, 0.f, 0.f};
        {
          const float fq = exp2f((float)(16 * w + i16) * lg), pz = (float)posv[m0 + 16 * w + i16];
          const bf16* qrow = proj + (m0 + 16 * w + i16) * AB_IN + 512 + h * 128;
#pragma unroll
          for (int ks = 0; ks < 2; ++ks) { float x1[8], x2[8]; unpack8(*(const v4u*)(qrow + 32 * ks + 8 * g), x1); unpack8(*(const v4u*)(qrow + 64 + 32 * ks + 8 * g), x2);
#pragma unroll
              for (int j = 0; j < 8; ++j) { const float invf = exp2f(-(float)(32 * ks + 8 * g + j) * (13.287712379549449f / 64.f)); float sn, cs; fast_sincos(pz * invf, sn, cs);
                  const float a = (x1[j] * cs - x2[j] * sn) * fq, bq = (x1[j] * sn + x2[j] * cs) * fq; x1[j] = a; x2[j] = bq; }
              v4u o; o.x = pk2(x1[0], x1[1]); o.y = pk2(x1[2], x1[3]); o.z = pk2(x1[4], x1[5]); o.w = pk2(x1[6], x1[7]); qf[ks] = __builtin_bit_cast(bf16x8, o);
              o.x = pk2(x2[0], x2[1]); o.y = pk2(x2[2], x2[3]); o.z = pk2(x2[4], x2[5]); o.w = pk2(x2[6], x2[7]); qf[ks + 2] = __builtin_bit_cast(bf16x8, o); } }
#pragma unroll
        for (int hv = 0; hv < 2; ++hv) {
            if (hv == 1) __syncthreads();
#pragma unroll
            for (int c = 0; c < 4; ++c) { const int c8 = scb + c; *(LAS v4u*)(VT + srow * P + c8 * 16) = *(const v4u*)(proj + (m0 + srow) * AB_IN + 2048 + h * 256 + hv * 128 + c8 * 8); }
            { LAS unsigned char* stw = ST + (16 * w + 4 * g) * P + i16 * 2;
#pragma unroll
              for (int dt = 0; dt < 8; ++dt)
#pragma unroll
                for (int r = 0; r < 4; ++r) { T[hv][dt][r] *= gc; *(LAS bf16*)(stw + r * P + dt * 32) = (bf16)f2bf(T[hv][dt][r]); } }
            __syncthreads();
            if (hv == 0) {
                f32x4 sc[8];
#pragma unroll
                for (int mt = 0; mt < 8; ++mt) { sc[mt] = (f32x4){0.f, 0.f, 0.f, 0.f};
                    if (mt <= w) {
#pragma unroll
                        for (int ks = 0; ks < 4; ++ks) { const bf16x8 kf = *(const LAS bf16x8*)(KT + rowb + mt * 16 * P + ks * 64); sc[mt] = __builtin_amdgcn_mfma_f32_16x16x32_bf16(kf, qf[ks], sc[mt], 0, 0, 0); }
                        if (mt == w) {
#pragma unroll
                            for (int r = 0; r < 4; ++r) sc[mt][r] = (4 * g + r <= i16) ? sc[mt][r] : 0.f; } } }
#pragma unroll
                for (int k2 = 0; k2 < 4; ++k2) { v4u wv; wv.x = pk2(sc[2 * k2][0], sc[2 * k2][1]); wv.y = pk2(sc[2 * k2][2], sc[2 * k2][3]); wv.z = pk2(sc[2 * k2 + 1][0], sc[2 * k2 + 1][1]); wv.w = pk2(sc[2 * k2 + 1][2], sc[2 * k2 + 1][3]);
                    pf[k2] = __builtin_bit_cast(bf16x8, wv); }
            }
#pragma unroll
            for (int nt = 0; nt < 8; ++nt) { f32x4 acc = (f32x4){0.f, 0.f, 0.f, 0.f};
#pragma unroll
                for (int k2 = 0; k2 < 4; ++k2) if (2 * k2 <= w) { const bf16x8 vf = ret::trfrag(trV4, 32 * k2, 32 * k2 + 16, 16 * nt); acc = __builtin_amdgcn_mfma_f32_16x16x32_bf16(pf[k2], vf, acc, 0, 0, 0); }
#pragma unroll
                for (int ks = 0; ks < 4; ++ks) { const bf16x8 sf = *(const LAS bf16x8*)(ST + rowb + nt * 16 * P + ks * 64); acc = __builtin_amdgcn_mfma_f32_16x16x32_bf16(qf[ks], sf, acc, 0, 0, 0); }
#pragma unroll
                for (int r = 0; r < 4; ++r) { rs[r] += acc[r]; rq[r] += acc[r] * acc[r]; mixin[(m0 + 16 * w + 4 * g + r) * ND + 512 + h * 256 + hv * 128 + 16 * nt + i16] = (bf16)f2bf(acc[r]); } }
#pragma unroll
            for (int ks = 0; ks < 4; ++ks) { const bf16x8 af = ret::trfrag(trV8, 32 * ks, 32 * ks + 4, 16 * w);
#pragma unroll
                for (int dt = 0; dt < 8; ++dt) { const bf16x8 bfr = ret::trfrag(trK8, 32 * ks, 32 * ks + 4, 16 * dt); T[hv][dt] = __builtin_amdgcn_mfma_f32_16x16x32_bf16(af, bfr, T[hv][dt], 0, 0, 0); } }
        }
#pragma unroll
        for (int r = 0; r < 4; ++r) { float sm = rs[r], s2 = rq[r];
            sm += __shfl_xor(sm, 1); sm += __shfl_xor(sm, 2); sm += __shfl_xor(sm, 4); sm += __shfl_xor(sm, 8);
            s2 += __shfl_xor(s2, 1); s2 += __shfl_xor(s2, 2); s2 += __shfl_xor(s2, 4); s2 += __shfl_xor(s2, 8);
            const float mean = sm * (1.f / 256.f); const float var = fmaxf(s2 * (1.f / 256.f) - mean * mean, 0.f);
            const float rstd = 1.f / sqrtf(var + NORM_EPS);
            const size_t m = m0 + 16 * w + 4 * g + r;
#pragma unroll
            for (int t = 0; t < 16; ++t) { bf16* yp = mixin + m * ND + 512 + h * 256 + 16 * t + i16; const float gt = bf1(proj[m * AB_IN + 3584 + h * 256 + 16 * t + i16]);
                *yp = (bf16)f2bf((bf1(*yp) - mean) * rstd * siluf_(gt)); } }
        __syncthreads();
    }
}

__device__ __forceinline__ void p_route(Frame& F, int l) {
    const float* logits = (const float*)(F.ws + WS_LOGITS); const float* rbias = kin(20) + l * NEXP;
    int* tope = (int*)(F.ws + WS_TOPE); float* wsel = (float*)(F.ws + WS_WSEL); int* posb = (int*)(F.ws + WS_SLOT); unsigned* cnt = F.ctl + CW_CNT + l * 64;
    LAS unsigned* lcnt = (LAS unsigned*)F.lds; LAS unsigned* lbase = lcnt + 64; LAS int* le = (LAS int*)(lcnt + 128); LAS unsigned* lp = (LAS unsigned*)(lcnt + 128 + 512);
    const float bias = rbias[F.lane]; const int lane = F.lane;
    for (int chunk = blockIdx.x; chunk < NT / 64; chunk += F.G) {
        __syncthreads();
        if (F.tid < 64) lcnt[F.tid] = 0u;
        __syncthreads();
        for (int t = 0; t < 8; ++t) {
            const int tl = F.wave * 8 + t, m = chunk * 64 + tl;
            const float lg = (logits[(size_t)m * 64 + lane] + logits[((size_t)NT + m) * 64 + lane]) + (logits[((size_t)2 * NT + m) * 64 + lane] + logits[((size_t)3 * NT + m) * 64 + lane]);
            const float sc = sigmoidf_(lg), bi = sc + bias;
            const int grp = lane >> 3;
            int rk = 0;
#pragma unroll
            for (int j = 1; j < 8; ++j) { const int o = lane ^ j; const float ov = __shfl_xor(bi, j); rk += ((ov > bi) || (ov == bi && o < lane)) ? 1 : 0; }
            float gs = rk < 2 ? bi : 0.f; gs += __shfl_xor(gs, 1); gs += __shfl_xor(gs, 2); gs += __shfl_xor(gs, 4);
            int grk = 0;
#pragma unroll
            for (int gg = 0; gg < 8; ++gg) { const float ov = __builtin_bit_cast(float, __builtin_amdgcn_readlane(__builtin_bit_cast(int, gs), gg * 8)); grk += (gg != grp && ((ov > gs) || (ov == gs && gg < grp))) ? 1 : 0; }
            const float mv = grk < 4 ? bi : -1e30f;
            int erk = 0;
#pragma unroll 16
            for (int j = 0; j < 64; ++j) { const float ov = __builtin_bit_cast(float, __builtin_amdgcn_readlane(__builtin_bit_cast(int, mv), j)); erk += ((ov > mv) || (ov == mv && j < lane)) ? 1 : 0; }
            const bool sel = erk < 8;
            const float wsum = wave_sum(sel ? sc : 0.f);
            if (sel) { const unsigned q = __hip_atomic_fetch_add(lcnt + lane, 1u, __ATOMIC_RELAXED, __HIP_MEMORY_SCOPE_WORKGROUP);
                tope[m * 8 + erk] = lane; wsel[m * 8 + erk] = sc / wsum * 2.5f; le[tl * 8 + erk] = lane; lp[tl * 8 + erk] = q; }
        }
        __syncthreads();
        if (F.tid < 64) lbase[F.tid] = atomicAdd(&cnt[F.tid], lcnt[F.tid]);
        __syncthreads();
        posb[chunk * 512 + F.tid] = (int)(lbase[le[F.tid]] + lp[F.tid]);
    }
}
__device__ __forceinline__ void load_offsets(Frame& F, int l) {
    volatile LAS int* tab = (volatile LAS int*)(F.lds + TAB_OFF);
    __syncthreads();
    if (F.tid < NEXP) {
        int c = (int)__hip_atomic_load(F.ctl + CW_CNT + l * 64 + F.tid, __ATOMIC_RELAXED, __HIP_MEMORY_SCOPE_AGENT); if (c > NT) c = NT;
        const int ntl = (c + 255) >> 8; int incl = ntl;
#pragma unroll
        for (int d = 1; d < 64; d <<= 1) { const int o = __shfl_up(incl, d); if (F.tid >= d) incl += o; }
        const int excl = incl - ntl;
        tab[F.tid] = excl << 8; tab[66 + F.tid] = c;
        for (int t = 0; t < ntl; ++t) if (excl + t < MAXTILES) tab[160 + excl + t] = F.tid;
        if (F.tid == NEXP - 1) { tab[64] = incl << 8; tab[65] = incl; }
    }
    __syncthreads();
}
__device__ __forceinline__ void p_scatter(Frame& F, int l) {
    load_offsets(F, l);
    const LAS int* tab = (const LAS int*)(F.lds + TAB_OFF);
    const int* tope = (const int*)(F.ws + WS_TOPE); int* slot = (int*)(F.ws + WS_SLOT); int* sorted = (int*)(F.ws + WS_SORTED);
    for (int i = F.gw * 64 + F.lane; i < NT * 8; i += F.NGW * 64) { const int e = tope[i]; const int row = tab[e] + slot[i]; sorted[row] = i >> 3; slot[i] = row; }
    for (int i = F.gw * 64 + F.lane; i < NEXP * 256; i += F.NGW * 64) { const int e = i >> 8, j = i & 255; const int r = tab[e] + tab[66 + e] + j; if (r < tab[e + 1]) sorted[r] = 0; }
}

__device__ __forceinline__ void p_l1_thin_a(Frame& F) {
    const bf16* proj = (const bf16*)(F.ws + WS_PROJ); const int* pos = (const int*)kin(1);
    bf16* cqn = (bf16*)(F.ws + WS_CQN); bf16* ckvn = (bf16*)(F.ws + WS_CKVN); bf16* krot = (bf16*)(F.ws + WS_KROT); bf16* cmpkv = (bf16*)(F.ws + WS_CMPKV);
    const float* qn = kin(10); const float* kvn = kin(12);
    for (int m = F.gw; m < NT; m += F.NGW) {
        const bf16* row = proj + (size_t)m * CD_INP;
        { float x[6]; float s = 0.f;
#pragma unroll
          for (int j = 0; j < 6; ++j) { x[j] = bf1(row[2584 + j * 64 + F.lane]); s += x[j] * x[j]; }
          const float r = 1.f / sqrtf(wave_sum(s) * (1.f / 384.f) + NORM_EPS);
#pragma unroll
          for (int j = 0; j < 6; ++j) cqn[(size_t)m * 384 + j * 64 + F.lane] = (bf16)f2bf(x[j] * r * qn[j * 64 + F.lane]); }
        { float x[8]; float s = 0.f;
#pragma unroll
          for (int j = 0; j < 8; ++j) { x[j] = bf1(row[2968 + j * 64 + F.lane]); s += x[j] * x[j]; }
          const float r = 1.f / sqrtf(wave_sum(s) * (1.f / 512.f) + NORM_EPS);
#pragma unroll
          for (int j = 0; j < 8; ++j) ckvn[(size_t)m * 512 + j * 64 + F.lane] = (bf16)f2bf(x[j] * r * kvn[j * 64 + F.lane]); }
        { const int i = F.lane & 31; const float p = (float)pos[m]; const float invf = exp2f(-(float)i * (13.287712379549449f / 32.f));
          float sn, cs; fast_sincos(p * invf, sn, cs);
          const float x1 = bf1(row[3480 + i]), x2 = bf1(row[3480 + 32 + i]);
          if (F.lane < 32) krot[(size_t)m * 64 + i] = (bf16)f2bf(x1 * cs - x2 * sn); else krot[(size_t)m * 64 + 32 + i] = (bf16)f2bf(x1 * sn + x2 * cs); }
        { const int b = m >> 11, s = m & (NS - 1);
          const int q4 = F.lane >> 4, c = F.lane & 15, kv = q4 >> 1, g = q4 & 1;
          const v4u w = *(const v4u*)(row + 1024 + q4 * 128 + c * 8);
          *(v4u*)(cmpkv + ((size_t)((kv * 16 + b * 2 + g) * NS + s)) * 128 + c * 8) = w; }
    }
}
__device__ __forceinline__ void p_l1_thin_b(Frame& F) {
    const float* hid = (const float*)(F.ws + WS_HID); const float* w2 = kin(9); bf16* kvc = (bf16*)(F.ws + WS_KVCMP);
    for (int m = F.gw; m < 4096; m += F.NGW) {
        const int kv = m >> 11;
        float h0 = hid[(size_t)m * 256 + kv * 128 + F.lane], h1 = hid[(size_t)m * 256 + kv * 128 + 64 + F.lane];
        h0 = 0.5f * h0 * (1.f + tanhf(0.7978845608028654f * (h0 + 0.044715f * h0 * h0 * h0)));
        h1 = 0.5f * h1 * (1.f + tanhf(0.7978845608028654f * (h1 + 0.044715f * h1 * h1 * h1)));
        const float* w = w2 + (size_t)kv * 128 * 128; float o0 = 0.f, o1 = 0.f;
        for (int c = 0; c < 64; ++c) { const float a = __shfl(h0, c), bq = __shfl(h1, c);
            o0 += a * w[c * 128 + F.lane] + bq * w[(c + 64) * 128 + F.lane]; o1 += a * w[c * 128 + 64 + F.lane] + bq * w[(c + 64) * 128 + 64 + F.lane]; }
        kvc[(size_t)m * 128 + F.lane] = (bf16)f2bf(o0); kvc[(size_t)m * 128 + 64 + F.lane] = (bf16)f2bf(o1);
    }
}
__device__ __forceinline__ void p_nsa_cmp_mfma(Frame& F) {
    typedef short v4i16_t __attribute__((ext_vector_type(4)));
    const bf16* proj = (const bf16*)(F.ws + WS_PROJ); const bf16* kvc = (const bf16*)(F.ws + WS_KVCMP); float* ocmp = (float*)(F.ws + WS_OCMP); unsigned* selm = (unsigned*)(F.ws + WS_SELM);
    constexpr int P = 272;
    LAS unsigned char* KT = F.lds; LAS unsigned char* VT = F.lds + 128 * P; LAS float* PS = (LAS float*)(F.lds + 2 * 128 * P);
    const int w = F.wave, lane = F.lane, i16 = lane & 15, g = lane >> 4, q4 = (lane & 15) >> 2, p4 = lane & 3;
    const float sscale = 0.08838834764831845f * 1.4426950408889634f;
    for (int bu = blockIdx.x; bu < 256; bu += F.G) {
        const int bg = bu >> 4, qg = bu & 15, b = bg >> 1, gq = bg & 1;
        __syncthreads();
#pragma unroll
        for (int c = 0; c < 4; ++c) { const int idx = F.tid + 512 * c, row = idx >> 4, c8 = idx & 15;
            v4u kk = (v4u){0u, 0u, 0u, 0u}, vv = (v4u){0u, 0u, 0u, 0u};
            if (row < 127) { kk = *(const v4u*)(kvc + ((size_t)(0 * 16 + bg) * 128 + row) * 128 + c8 * 8); vv = *(const v4u*)(kvc + ((size_t)(1 * 16 + bg) * 128 + row) * 128 + c8 * 8); }
            *(LAS v4u*)(KT + row * P + c8 * 16) = kk; *(LAS v4u*)(VT + row * P + c8 * 16) = vv; }
        for (int k = 0; k < 4; ++k) {
            const int q0 = (qg * 4 + k) * 32, h = gq * 4 + (w >> 1), ql = (w & 1) * 16 + i16, spos = q0 + ql;
            bf16x8 qf[4];
#pragma unroll
            for (int ks = 0; ks < 4; ++ks) qf[ks] = *(const bf16x8*)(proj + (size_t)(b * NS + spos) * CD_INP + h * 128 + 32 * ks + 8 * g);
            __syncthreads();
            const int nvalid = spos >= 31 ? ((spos - 31) >> 4) + 1 : 0;
            f32x4 sc[8]; float mx = -1e30f;
#pragma unroll
            for (int mt = 0; mt < 8; ++mt) { sc[mt] = (f32x4){0.f, 0.f, 0.f, 0.f};
#pragma unroll
                for (int ks = 0; ks < 4; ++ks) { const bf16x8 kf = *(const LAS bf16x8*)(KT + (16 * mt + i16) * P + (32 * ks + 8 * g) * 2); sc[mt] = __builtin_amdgcn_mfma_f32_16x16x32_bf16(kf, qf[ks], sc[mt], 0, 0, 0); }
#pragma unroll
                for (int r = 0; r < 4; ++r) { const bool ok = (16 * mt + 4 * g + r) < nvalid; const float x = ok ? sc[mt][r] * sscale : -1e30f; sc[mt][r] = x; mx = fmaxf(mx, x); } }
            mx = fmaxf(mx, __shfl_xor(mx, 16)); mx = fmaxf(mx, __shfl_xor(mx, 32));
            float ps = 0.f;
#pragma unroll
            for (int mt = 0; mt < 8; ++mt)
#pragma unroll
                for (int r = 0; r < 4; ++r) { const bool ok = (16 * mt + 4 * g + r) < nvalid; const float pv = ok ? __builtin_amdgcn_exp2f(sc[mt][r] - mx) : 0.f; sc[mt][r] = pv; ps += pv; }
            ps += __shfl_xor(ps, 16); ps += __shfl_xor(ps, 32);
            const float inv = ps > 0.f ? 1.f / ps : 0.f;
#pragma unroll
            for (int mt = 0; mt < 8; ++mt)
#pragma unroll
                for (int r = 0; r < 4; ++r) sc[mt][r] *= inv;
            { LAS float* slab = PS + (w >> 2) * 4096 + ql * 128 + 4 * g;
              if (((w >> 1) & 1) == 0) {
#pragma unroll
                  for (int mt = 0; mt < 8; ++mt) *(LAS f32x4*)(slab + 16 * mt) = sc[mt]; }
              __syncthreads();
              if (((w >> 1) & 1) == 1) {
#pragma unroll
                  for (int mt = 0; mt < 8; ++mt) { const f32x4 t = *(const LAS f32x4*)(slab + 16 * mt); *(LAS f32x4*)(slab + 16 * mt) = t + sc[mt]; } } }
            f32x4 O[8];
#pragma unroll
            for (int nt = 0; nt < 8; ++nt) O[nt] = (f32x4){0.f, 0.f, 0.f, 0.f};
#pragma unroll
            for (int k2 = 0; k2 < 4; ++k2) { v4u wv; wv.x = pk2(sc[2 * k2][0], sc[2 * k2][1]); wv.y = pk2(sc[2 * k2][2], sc[2 * k2][3]); wv.z = pk2(sc[2 * k2 + 1][0], sc[2 * k2 + 1][1]); wv.w = pk2(sc[2 * k2 + 1][2], sc[2 * k2 + 1][3]);
                const bf16x8 pf = __builtin_bit_cast(bf16x8, wv);
#pragma unroll
                for (int nt = 0; nt < 8; ++nt) {
                    const v4i16_t a = __builtin_amdgcn_ds_read_tr16_b64_v4i16((LAS v4i16_t*)(VT + (32 * k2 + 4 * g + q4) * P + (16 * nt + 4 * p4) * 2));
                    const v4i16_t c = __builtin_amdgcn_ds_read_tr16_b64_v4i16((LAS v4i16_t*)(VT + (32 * k2 + 16 + 4 * g + q4) * P + (16 * nt + 4 * p4) * 2));
                    const bf16x8 vf = (bf16x8){a[0], a[1], a[2], a[3], c[0], c[1], c[2], c[3]};
                    O[nt] = __builtin_amdgcn_mfma_f32_16x16x32_bf16(pf, vf, O[nt], 0, 0, 0); } }
#pragma unroll
            for (int r = 0; r < 4; ++r) { const size_t m = (size_t)(b * NS + q0 + (w & 1) * 16 + 4 * g + r); const float gt = sigmoidf_(bf1(proj[m * CD_INP + 2560 + h * 3 + 0]));
#pragma unroll
                for (int nt = 0; nt < 8; ++nt) ocmp[m * 1024 + h * 128 + 16 * nt + i16] = gt * O[nt][r]; }
            __syncthreads();
#pragma unroll
            for (int qq = 0; qq < 4; ++qq) { const int qi = 4 * w + qq, s = q0 + qi, cur = s >> 6, j = lane & 31;
                float imp = 0.f;
#pragma unroll
                for (int kk = 0; kk < 4; ++kk) { const int n1 = 4 * j + kk; if (n1 <= 126) imp += PS[qi * 128 + n1] + PS[4096 + qi * 128 + n1]; const int n2 = 4 * j - 1 + kk; if (n2 >= 0 && n2 <= 126) imp += PS[qi * 128 + n2] + PS[4096 + qi * 128 + n2]; }
                const bool forced = (j == 0) || (j == cur) || (j == cur - 1);
                const float score = forced ? 1e4f : ((j * 64 <= s) ? imp : -1e30f);
                int rk = 0;
                for (int jj = 0; jj < 32; ++jj) { const float ov = __shfl(score, jj); rk += ((ov > score) || (ov == score && jj < j)) ? 1 : 0; }
                const bool sel = (lane < 32) && (rk < 16) && (j <= cur);
                const unsigned long long bal = __ballot(sel);
                if (lane == 0) selm[(size_t)(b * NS + s) * 2 + gq] = (unsigned)bal; }
        }
    }
}

namespace fa {
typedef short v4i16_t __attribute__((ext_vector_type(4)));
struct Src { const bf16* k1; size_t ks1; const bf16* k2; size_t ks2; const bf16* v; size_t vs; };
template <int DQK> struct Cfg { static constexpr int KPITCH = (DQK + 8) * 2, KBYTES = 64 * KPITCH, VPITCH = 272, VBYTES = 64 * VPITCH, BUF = KBYTES + VBYTES, NKS = DQK / 32, KCH = DQK / 8, NKR = DQK / 64; };

template <int DQK> struct TileOff { unsigned gk[Cfg<DQK>::NKR], gv[2], lk[Cfg<DQK>::NKR], lv[2]; };
template <int DQK>
__device__ __forceinline__ void tile_offsets(const Src& S, int tid, TileOff<DQK>& T) {
#pragma unroll
    for (int i = 0; i < 2; ++i) { const int c = tid + 512 * i, row = c >> 4, c8 = c & 15;
        T.gk[i] = (unsigned)(row * (int)S.ks1 + c8 * 8) * 2u; T.gv[i] = (unsigned)(row * (int)S.vs + c8 * 8) * 2u;
        T.lk[i] = (unsigned)(row * Cfg<DQK>::KPITCH + c8 * 16); T.lv[i] = (unsigned)(Cfg<DQK>::KBYTES + row * Cfg<DQK>::VPITCH + c8 * 16); }
    if (DQK == 192) { const int row = tid >> 3, c8 = tid & 7; T.gk[Cfg<DQK>::NKR - 1] = (unsigned)(row * (int)S.ks2 + c8 * 8) * 2u; T.lk[Cfg<DQK>::NKR - 1] = (unsigned)(row * Cfg<DQK>::KPITCH + 256 + c8 * 16); }
}
template <int DQK>
__device__ __forceinline__ void load_tile(const Src& S, int k0, const TileOff<DQK>& T, v4u (&kr)[Cfg<DQK>::NKR], v4u (&vr)[2]) {
    const char* kb1 = (const char*)S.k1 + (size_t)k0 * S.ks1 * 2; const char* vb = (const char*)S.v + (size_t)k0 * S.vs * 2;
#pragma unroll
    for (int i = 0; i < 2; ++i) { kr[i] = *(const v4u*)(kb1 + T.gk[i]); vr[i] = *(const v4u*)(vb + T.gv[i]); }
    if (DQK == 192) { const char* kb2 = (const char*)S.k2 + (size_t)k0 * S.ks2 * 2; kr[Cfg<DQK>::NKR - 1] = *(const v4u*)(kb2 + T.gk[Cfg<DQK>::NKR - 1]); }
}
template <int DQK>
__device__ __forceinline__ void store_tile(LAS unsigned char* buf, const TileOff<DQK>& T, const v4u (&kr)[Cfg<DQK>::NKR], const v4u (&vr)[2]) {
#pragma unroll
    for (int i = 0; i < Cfg<DQK>::NKR; ++i) *(LAS v4u*)(buf + T.lk[i]) = kr[i];
#pragma unroll
    for (int i = 0; i < 2; ++i) *(LAS v4u*)(buf + T.lv[i]) = vr[i];
}
struct RowState { int spos; unsigned rowmask; float m_run, l_run; };
template <int MODE> __device__ __forceinline__ bool group_needs(int t, const RowState& R) {
    bool row_any = (t * 64 <= R.spos);
    if (MODE == 1) row_any = row_any && ((R.rowmask >> t) & 1u);
    if (MODE == 2) row_any = row_any && (t * 64 + 63 + 512 > R.spos);
    return __ballot(row_any) != 0ull;
}
template <int MODE>
__device__ __forceinline__ void softmax_group(f32x4 (&sc)[4], int t, RowState& R, f32x4 (&O)[8], bf16x8 (&pf)[2], int g) {
    float mx = -1e30f;
    bool row_full = (t * 64 + 63 <= R.spos);
    if (MODE == 1) row_full = row_full && ((R.rowmask >> t) & 1u);
    if (MODE == 2) row_full = row_full && (t * 64 + 512 > R.spos);
    if (__ballot(row_full) == ~0ull) {
#pragma unroll
        for (int mt = 0; mt < 4; ++mt)
#pragma unroll
            for (int r = 0; r < 4; ++r) mx = fmaxf(mx, sc[mt][r]);
    } else {
#pragma unroll
        for (int mt = 0; mt < 4; ++mt)
#pragma unroll
            for (int r = 0; r < 4; ++r) { const int kp = t * 64 + 16 * mt + 4 * g + r; bool ok = kp <= R.spos;
                if (MODE == 1) ok = ok && ((R.rowmask >> t) & 1u);
                if (MODE == 2) ok = ok && (kp + 512 > R.spos);
                const float x = ok ? sc[mt][r] : -3e38f; sc[mt][r] = x; mx = fmaxf(mx, x); }
        mx = fmaxf(mx, -1e30f);
    }
    mx = fmaxf(mx, __shfl_xor(mx, 16)); mx = fmaxf(mx, __shfl_xor(mx, 32));
    if (__ballot(mx > R.m_run + 8.0f) != 0ull) {
        const float m_new = fmaxf(R.m_run, mx), alpha = __builtin_amdgcn_exp2f(R.m_run - m_new); R.m_run = m_new;
        R.l_run *= alpha;
        float ar[4];
#pragma unroll
        for (int r = 0; r < 4; ++r) ar[r] = __shfl(alpha, 4 * g + r);
#pragma unroll
        for (int nt = 0; nt < 8; ++nt)
#pragma unroll
            for (int r = 0; r < 4; ++r) O[nt][r] *= ar[r];
    }
    float ps = 0.f;
#pragma unroll
    for (int mt = 0; mt < 4; ++mt)
#pragma unroll
        for (int r = 0; r < 4; ++r) { const float pv = __builtin_amdgcn_exp2f(sc[mt][r] - R.m_run); sc[mt][r] = pv; ps += pv; }
    R.l_run += ps;
#pragma unroll
    for (int k2 = 0; k2 < 2; ++k2) { v4u w; w.x = pk2(sc[2 * k2][0], sc[2 * k2][1]); w.y = pk2(sc[2 * k2][2], sc[2 * k2][3]); w.z = pk2(sc[2 * k2 + 1][0], sc[2 * k2 + 1][1]); w.w = pk2(sc[2 * k2 + 1][2], sc[2 * k2 + 1][3]);
        pf[k2] = __builtin_bit_cast(bf16x8, w); }
}
template <int DQK, int MODE>
__device__ __forceinline__ void fa_compute(LAS unsigned char* kb, LAS unsigned char* vb, const bf16x8 (&qf0)[Cfg<DQK>::NKS], const bf16x8 (&qf1)[Cfg<DQK>::NKS], int t, RowState& R0, RowState& R1, float sscale,
                                           f32x4 (&O0)[8], f32x4 (&O1)[8], int i16, int g, int q4, int p4) {
    typedef Cfg<DQK> C;
    const bool n0 = group_needs<MODE>(t, R0), n1 = group_needs<MODE>(t, R1);
    if (!n0 && !n1) return;
    f32x4 s0[4], s1[4];
#pragma unroll
    for (int mt = 0; mt < 4; ++mt) { s0[mt] = (f32x4){0.f, 0.f, 0.f, 0.f}; s1[mt] = (f32x4){0.f, 0.f, 0.f, 0.f};
#pragma unroll
        for (int ks = 0; ks < C::NKS; ++ks) { const bf16x8 kf = *(const LAS bf16x8*)(kb + (16 * mt + i16) * C::KPITCH + (32 * ks + 8 * g) * 2);
            s0[mt] = __builtin_amdgcn_mfma_f32_16x16x32_bf16(kf, qf0[ks], s0[mt], 0, 0, 0);
            s1[mt] = __builtin_amdgcn_mfma_f32_16x16x32_bf16(kf, qf1[ks], s1[mt], 0, 0, 0); } }
    bf16x8 p0[2], p1[2];
    if (n0) softmax_group<MODE>(s0, t, R0, O0, p0, g); else { p0[0] = (bf16x8){0, 0, 0, 0, 0, 0, 0, 0}; p0[1] = p0[0]; }
    if (n1) softmax_group<MODE>(s1, t, R1, O1, p1, g); else { p1[0] = (bf16x8){0, 0, 0, 0, 0, 0, 0, 0}; p1[1] = p1[0]; }
#pragma unroll
    for (int nt = 0; nt < 8; ++nt)
#pragma unroll
        for (int k2 = 0; k2 < 2; ++k2) {
            const v4i16_t a = __builtin_amdgcn_ds_read_tr16_b64_v4i16((LAS v4i16_t*)(vb + (32 * k2 + 4 * g + q4) * C::VPITCH + (16 * nt + 4 * p4) * 2));
            const v4i16_t b = __builtin_amdgcn_ds_read_tr16_b64_v4i16((LAS v4i16_t*)(vb + (32 * k2 + 16 + 4 * g + q4) * C::VPITCH + (16 * nt + 4 * p4) * 2));
            const bf16x8 vf = (bf16x8){a[0], a[1], a[2], a[3], b[0], b[1], b[2], b[3]};
            O0[nt] = __builtin_amdgcn_mfma_f32_16x16x32_bf16(p0[k2], vf, O0[nt], 0, 0, 0);
            O1[nt] = __builtin_amdgcn_mfma_f32_16x16x32_bf16(p1[k2], vf, O1[nt], 0, 0, 0); }
}
template <int DQK, int MODE>
__device__ __forceinline__ void fa_pass(LAS unsigned char* lds, const Src& S, const bf16x8 (&qf0)[Cfg<DQK>::NKS], const bf16x8 (&qf1)[Cfg<DQK>::NKS], unsigned tmask, RowState& R0, RowState& R1, float sscale,
                                        f32x4 (&O0)[8], f32x4 (&O1)[8], int tid, int lane) {
    typedef Cfg<DQK> C;
    const int i16 = lane & 15, g = lane >> 4, q4 = (lane & 15) >> 2, p4 = lane & 3;
#pragma unroll
    for (int nt = 0; nt < 8; ++nt) { O0[nt] = (f32x4){0.f, 0.f, 0.f, 0.f}; O1[nt] = (f32x4){0.f, 0.f, 0.f, 0.f}; }
    R0.m_run = -1e30f; R0.l_run = 0.f; R1.m_run = -1e30f; R1.l_run = 0.f;
    unsigned rem = tmask;
    if (rem == 0u) return;
    v4u kr[C::NKR], vr[2]; TileOff<DQK> TO; tile_offsets<DQK>(S, tid, TO);
    int t = __builtin_ctz(rem); rem &= rem - 1u;
    load_tile<DQK>(S, t * 64, TO, kr, vr);
    __syncthreads();
    store_tile<DQK>(lds, TO, kr, vr);
    __syncthreads();
    int cur = 0;
    for (;;) {
        const bool has_next = rem != 0u; int tn = 0;
        if (has_next) { tn = __builtin_ctz(rem); rem &= rem - 1u; load_tile<DQK>(S, tn * 64, TO, kr, vr); }
        LAS unsigned char* kb = lds + cur * C::BUF;
        fa_compute<DQK, MODE>(kb, kb + C::KBYTES, qf0, qf1, t, R0, R1, sscale, O0, O1, i16, g, q4, p4);
        if (has_next) store_tile<DQK>(lds + (cur ^ 1) * C::BUF, TO, kr, vr);
        __syncthreads();
        if (!has_next) break;
        t = tn; cur ^= 1;
    }
}
__device__ __forceinline__ void row_inv(float l_run, int lane, float (&inv)[4]) {
    float l = l_run; l += __shfl_xor(l, 16); l += __shfl_xor(l, 32);
    const float li = l > 0.f ? 1.f / l : 0.f; const int g = lane >> 4;
#pragma unroll
    for (int r = 0; r < 4; ++r) inv[r] = __shfl(li, 4 * g + r);
}
__device__ __forceinline__ void scale_frag(bf16x8& f, float sc) {
    v4u w = __builtin_bit_cast(v4u, f); float x[8]; unpack8(w, x);
    w.x = pk2(x[0] * sc, x[1] * sc); w.y = pk2(x[2] * sc, x[3] * sc); w.z = pk2(x[4] * sc, x[5] * sc); w.w = pk2(x[6] * sc, x[7] * sc); f = __builtin_bit_cast(bf16x8, w);
}
__device__ __forceinline__ void rope_qpe(bf16x8& f4, bf16x8& f5, float pz, int g4) {
    v4u w1 = __builtin_bit_cast(v4u, f4), w2 = __builtin_bit_cast(v4u, f5); float x1[8], x2[8]; unpack8(w1, x1); unpack8(w2, x2);
#pragma unroll
    for (int jj = 0; jj < 8; ++jj) { const float invf = exp2f(-(float)(8 * g4 + jj) * (13.287712379549449f / 32.f)); float sn, cs; fast_sincos(pz * invf, sn, cs);
        const float a = x1[jj] * cs - x2[jj] * sn, c = x1[jj] * sn + x2[jj] * cs; x1[jj] = a; x2[jj] = c; }
    w1.x = pk2(x1[0], x1[1]); w1.y = pk2(x1[2], x1[3]); w1.z = pk2(x1[4], x1[5]); w1.w = pk2(x1[6], x1[7]);
    w2.x = pk2(x2[0], x2[1]); w2.y = pk2(x2[2], x2[3]); w2.z = pk2(x2[4], x2[5]); w2.w = pk2(x2[6], x2[7]);
    f4 = __builtin_bit_cast(bf16x8, w1); f5 = __builtin_bit_cast(bf16x8, w2);
}
}

__device__ __forceinline__ void p_attn_mla(Frame& F, unsigned* queue) {
    const bf16* proj = (const bf16*)(F.ws + WS_PROJ); bf16* mixin = (bf16*)(F.ws + WS_MIXIN); const float* ocmp = (const float*)(F.ws + WS_OCMP); const unsigned* selm = (const unsigned*)(F.ws + WS_SELM);
    const bf16* qmla = (const bf16*)(F.ws + WS_QMLA); const bf16* kvu = (const bf16*)(F.ws + WS_KVU); const bf16* krot = (const bf16*)(F.ws + WS_KROT);
    volatile LAS unsigned* qslot = (volatile LAS unsigned*)(F.lds + LDSCTL_OFF);
    const int lane = F.lane, w = F.wave, i16 = lane & 15, g4 = lane >> 4;
    for (;;) {
        __syncthreads();
        if (F.tid == 0) qslot[0] = atomicAdd(queue, 1u);
        __syncthreads();
        const int u = __builtin_amdgcn_readfirstlane((int)qslot[0]);
        if (u >= 512) break;
        {
            const int qt = 7 - (u >> 6), bh = u & 63, b = bh >> 3, h = bh & 7, q0 = qt * 256;
            fa::RowState R0, R1; R0.spos = q0 + 32 * w + i16; R1.spos = R0.spos + 16; R0.rowmask = 0u; R1.rowmask = 0u;
            bf16x8 qf0[6], qf1[6];
#pragma unroll
            for (int ks = 0; ks < 6; ++ks) { qf0[ks] = *(const bf16x8*)(qmla + (size_t)(b * NS + R0.spos) * 1536 + h * 192 + 32 * ks + 8 * g4); qf1[ks] = *(const bf16x8*)(qmla + (size_t)(b * NS + R1.spos) * 1536 + h * 192 + 32 * ks + 8 * g4); }
            fa::rope_qpe(qf0[4], qf0[5], (float)((const int*)kin(1))[b * NS + R0.spos], g4);
            fa::rope_qpe(qf1[4], qf1[5], (float)((const int*)kin(1))[b * NS + R1.spos], g4);
#pragma unroll
            for (int ks = 0; ks < 6; ++ks) { fa::scale_frag(qf0[ks], 0.07216878364870322f * 1.4426950408889634f); fa::scale_frag(qf1[ks], 0.07216878364870322f * 1.4426950408889634f); }
            fa::Src S; S.k1 = kvu + (size_t)(b * NS) * 2048 + h * 256; S.ks1 = 2048; S.k2 = krot + (size_t)(b * NS) * 64; S.ks2 = 64; S.v = S.k1 + 128; S.vs = 2048;
            const int last = (q0 + 255) >> 6; const unsigned tmask = last >= 31 ? 0xffffffffu : ((1u << (last + 1)) - 1u);
            f32x4 O0[8], O1[8];
            fa::fa_pass<192, 0>(F.lds, S, qf0, qf1, tmask, R0, R1, 0.07216878364870322f * 1.4426950408889634f, O0, O1, F.tid, lane);
            float inv[4];
            fa::row_inv(R0.l_run, lane, inv);
#pragma unroll
            for (int r = 0; r < 4; ++r) { bf16* orow = mixin + (size_t)(b * NS + q0 + 32 * w + 4 * g4 + r) * ND + 1024 + h * 128 + i16;
#pragma unroll
                for (int nt = 0; nt < 8; ++nt) orow[16 * nt] = (bf16)f2bf(O0[nt][r] * inv[r]); }
            fa::row_inv(R1.l_run, lane, inv);
#pragma unroll
            for (int r = 0; r < 4; ++r) { bf16* orow = mixin + (size_t)(b * NS + q0 + 32 * w + 16 + 4 * g4 + r) * ND + 1024 + h * 128 + i16;
#pragma unroll
                for (int nt = 0; nt < 8; ++nt) orow[16 * nt] = (bf16)f2bf(O1[nt][r] * inv[r]); }
        }
    }
    (void)proj; (void)ocmp; (void)selm;
}
__device__ __forceinline__ void p_attn_nsa(Frame& F, unsigned* queue) {
    const bf16* proj = (const bf16*)(F.ws + WS_PROJ); bf16* mixin = (bf16*)(F.ws + WS_MIXIN); const float* ocmp = (const float*)(F.ws + WS_OCMP); const unsigned* selm = (const unsigned*)(F.ws + WS_SELM);
    const bf16* qmla = (const bf16*)(F.ws + WS_QMLA); const bf16* kvu = (const bf16*)(F.ws + WS_KVU); const bf16* krot = (const bf16*)(F.ws + WS_KROT);
    volatile LAS unsigned* qslot = (volatile LAS unsigned*)(F.lds + LDSCTL_OFF);
    const int lane = F.lane, w = F.wave, i16 = lane & 15, g4 = lane >> 4;
    for (;;) {
        __syncthreads();
        if (F.tid == 0) qslot[0] = atomicAdd(queue, 1u);
        __syncthreads();
        const int u = __builtin_amdgcn_readfirstlane((int)qslot[0]);
        if (u >= 512) break;
        {
            const int v = u;
            const int qt = 31 - (v >> 4), bg = v & 15, b = bg >> 1, gq = bg & 1, q0 = qt * 64;
            const int h = gq * 4 + (w >> 1), qb = q0 + (w & 1) * 32;
            fa::RowState R0, R1; R0.spos = qb + i16; R1.spos = qb + 16 + i16;
            bf16x8 qf0[4], qf1[4];
#pragma unroll
            for (int ks = 0; ks < 4; ++ks) { qf0[ks] = *(const bf16x8*)(proj + (size_t)(b * NS + R0.spos) * CD_INP + h * 128 + 32 * ks + 8 * g4); qf1[ks] = *(const bf16x8*)(proj + (size_t)(b * NS + R1.spos) * CD_INP + h * 128 + 32 * ks + 8 * g4); }
#pragma unroll
            for (int ks = 0; ks < 4; ++ks) { fa::scale_frag(qf0[ks], 0.08838834764831845f * 1.4426950408889634f); fa::scale_frag(qf1[ks], 0.08838834764831845f * 1.4426950408889634f); }
            R0.rowmask = selm[(size_t)(b * NS + R0.spos) * 2 + gq]; R1.rowmask = selm[(size_t)(b * NS + R1.spos) * 2 + gq];
            unsigned um = selm[(size_t)(b * NS + q0 + lane) * 2 + gq];
#pragma unroll
            for (int o = 1; o < 64; o <<= 1) um |= (unsigned)__shfl_xor((int)um, o);
            um = (unsigned)__builtin_amdgcn_readfirstlane((int)um);
            const bf16* base = proj + (size_t)(b * NS) * CD_INP;
            const float sscale = 0.08838834764831845f * 1.4426950408889634f;
            f32x4 O0[8], O1[8]; float inv[4];
            { fa::Src S; S.k1 = base + 1024 + ((1 * 2 + 0) * 2 + gq) * 128; S.ks1 = CD_INP; S.k2 = nullptr; S.ks2 = 0; S.v = base + 1024 + ((1 * 2 + 1) * 2 + gq) * 128; S.vs = CD_INP;
              fa::fa_pass<128, 1>(F.lds, S, qf0, qf1, um, R0, R1, sscale, O0, O1, F.tid, lane); }
            fa::row_inv(R0.l_run, lane, inv);
#pragma unroll
            for (int r = 0; r < 4; ++r) { const size_t m = (size_t)(b * NS + qb + 4 * g4 + r); const float g1 = sigmoidf_(bf1(proj[m * CD_INP + 2560 + h * 3 + 1])) * inv[r];
#pragma unroll
                for (int nt = 0; nt < 8; ++nt) mixin[m * ND + h * 128 + 16 * nt + i16] = (bf16)f2bf(ocmp[m * 1024 + h * 128 + 16 * nt + i16] + O0[nt][r] * g1); }
            fa::row_inv(R1.l_run, lane, inv);
#pragma unroll
            for (int r = 0; r < 4; ++r) { const size_t m = (size_t)(b * NS + qb + 16 + 4 * g4 + r); const float g1 = sigmoidf_(bf1(proj[m * CD_INP + 2560 + h * 3 + 1])) * inv[r];
#pragma unroll
                for (int nt = 0; nt < 8; ++nt) mixin[m * ND + h * 128 + 16 * nt + i16] = (bf16)f2bf(ocmp[m * 1024 + h * 128 + 16 * nt + i16] + O1[nt][r] * g1); }
            { fa::Src S; S.k1 = base + 1024 + ((2 * 2 + 0) * 2 + gq) * 128; S.ks1 = CD_INP; S.k2 = nullptr; S.ks2 = 0; S.v = base + 1024 + ((2 * 2 + 1) * 2 + gq) * 128; S.vs = CD_INP;
              const int klo = q0 - 511 > 0 ? q0 - 511 : 0, tlo = klo >> 6, thi = (q0 + 63) >> 6;
              const unsigned hm = thi >= 31 ? 0xffffffffu : ((1u << (thi + 1)) - 1u); const unsigned tmask = hm & ~((1u << tlo) - 1u);
              fa::fa_pass<128, 2>(F.lds, S, qf0, qf1, tmask, R0, R1, sscale, O0, O1, F.tid, lane); }
            fa::row_inv(R0.l_run, lane, inv);
#pragma unroll
            for (int r = 0; r < 4; ++r) { const size_t m = (size_t)(b * NS + qb + 4 * g4 + r); const float g2 = sigmoidf_(bf1(proj[m * CD_INP + 2560 + h * 3 + 2])) * inv[r];
#pragma unroll
                for (int nt = 0; nt < 8; ++nt) { bf16* op = mixin + m * ND + h * 128 + 16 * nt + i16; *op = (bf16)f2bf(bf1(*op) + O0[nt][r] * g2); } }
            fa::row_inv(R1.l_run, lane, inv);
#pragma unroll
            for (int r = 0; r < 4; ++r) { const size_t m = (size_t)(b * NS + qb + 16 + 4 * g4 + r); const float g2 = sigmoidf_(bf1(proj[m * CD_INP + 2560 + h * 3 + 2])) * inv[r];
#pragma unroll
                for (int nt = 0; nt < 8; ++nt) { bf16* op = mixin + m * ND + h * 128 + 16 * nt + i16; *op = (bf16)f2bf(bf1(*op) + O1[nt][r] * g2); } }
        }
    }
    (void)qmla; (void)kvu; (void)krot;
}

constexpr int NPHASE = 33;


#define IN(k) (lo <= (k) && (k) < hi)
#define SEAM(k) do { if (IN(k) && IN((k) + 1)) { if (MK_ONE_LAUNCH) xcd_barrier(bar); else if (F.tid == 0) __hip_atomic_store(F.ctl + CW_TMO, 0xBAD0u | (unsigned)(k), __ATOMIC_RELAXED, __HIP_MEMORY_SCOPE_AGENT); \
    if (MK_PROBE_PHASE >= 0 && blockIdx.x == 0 && F.tid == 0) { if ((k) == MK_PROBE_PHASE - 1) ((volatile LAS unsigned long long*)(F.lds + LDSCTL_OFF + 64))[0] = __builtin_amdgcn_s_memrealtime(); \
        if ((k) == MK_PROBE_LAST) ((volatile LAS unsigned long long*)(F.lds + LDSCTL_OFF + 64))[1] = __builtin_amdgcn_s_memrealtime(); } } } while (0)
template <int l>
__device__ __forceinline__ void layer_body(Frame& F, const XcdBarrier& bar, const int lo, const int hi) {
    unsigned char* ws = F.ws;
    bf16* const XB0 = (bf16*)(ws + WS_XB0); bf16* const X1B = (bf16*)(ws + WS_X1B); bf16* const X2B = (bf16*)(ws + WS_X2B);
    bf16* const PROJ = (bf16*)(ws + WS_PROJ); bf16* const MIXIN = (bf16*)(ws + WS_MIXIN); bf16* const MIXO = (bf16*)(ws + WS_MIXO);
    bf16* const HB = (bf16*)(ws + WS_H); bf16* const Y2 = (bf16*)(ws + WS_Y2);
        const int pb = 1 + l * 16;
        const bf16* xin = l == 0 ? XB0 : X2B;
        if (IN(pb + 0)) {
            if (l == 0 && MK_FP8_IN0) { pg8::DenseProb P; P.init((const bf16*)(ws + WS_X1F8), ND / 2, (const bf16*)(ws + WS_WABIN), NT, AB_IN, ND / 2, F.G, (int)blockIdx.x, 128); pg8::EpiBf16N128 E{PROJ, AB_IN, 1.0f / 64.0f};
                pg8::gemm_phase<pg8::EpiBf16N128, pg8::DenseProb, true, true>(F.lds, P, E); }
            else if (l == 0) { pg8::DenseProb P; P.init(xin, ND, (const bf16*)(ws + WS_WABIN), NT, AB_IN, ND, F.G, (int)blockIdx.x); pg8::EpiBf16 E{PROJ, AB_IN};
                pg8::gemm_phase<pg8::EpiBf16, pg8::DenseProb, true>(F.lds, P, E); }
            else if (l == 1 && MK_FP8_IN1) { pg8::DenseProb P; P.init((const bf16*)(ws + WS_X1F8), ND / 2, (const bf16*)(ws + WS_WCDIN), NT, CD_INP, ND / 2, F.G, (int)blockIdx.x, 128); pg8::EpiBf16N128 E{PROJ, CD_INP, 1.0f / 64.0f};
                pg8::gemm_phase<pg8::EpiBf16N128, pg8::DenseProb, true, true>(F.lds, P, E); }
            else { pg8::DenseProb P; P.init(xin, ND, (const bf16*)(ws + WS_WCDIN), NT, CD_INP, ND, F.G, (int)blockIdx.x); pg8::EpiBf16 E{PROJ, CD_INP};
                pg8::gemm_phase<pg8::EpiBf16, pg8::DenseProb, true>(F.lds, P, E); }
        } SEAM(pb + 0);
        if (l == 0) {
            if (IN(pb + 2)) { if (blockIdx.x < NB * 6) p_retention_mfma(F, (int)blockIdx.x); else p_pool(F, ((int)blockIdx.x - NB * 6) * NWAVES + F.wave, (F.G - NB * 6) * NWAVES);
                __syncthreads(); p_moe_weights_queue(F, F.ctl + CW_CNT + 320); } SEAM(pb + 2);
        } else {
            if (IN(pb + 1)) { cmp_bias_finish(F); p_l1_thin_a(F); } SEAM(pb + 1);
            if (IN(pb + 2)) {
                if (blockIdx.x < 16) { pg8::CmpProb P; P.K = 4096; P.ldb = 4096; P.Abase = (const char*)(ws + WS_CMPKV); P.Bt = (const char*)(ws + WS_CW1); P.G = 16; P.c = (int)blockIdx.x;
                  pg8::EpiF32 E{(float*)(ws + WS_HID), 256, (const float*)(ws + WS_CMPB)};
                  pg8::gemm_phase<pg8::EpiF32, pg8::CmpProb, true>(F.lds, P, E); }
                else {
                { pg8::DenseProb P; P.init((const bf16*)(ws + WS_CQN), 384, (const bf16*)(ws + WS_WUQ), NT, 1536, 384, F.G - 16, (int)blockIdx.x - 16); pg8::EpiBf16 E{(bf16*)(ws + WS_QMLA), 1536};
                  pg8::gemm_phase<pg8::EpiBf16, pg8::DenseProb, true>(F.lds, P, E); }
                { pg8::DenseProb P; P.init((const bf16*)(ws + WS_CKVN), 512, (const bf16*)(ws + WS_WUKV), NT, 2048, 512, F.G - 16, (int)blockIdx.x - 16); pg8::EpiBf16 E{(bf16*)(ws + WS_KVU), 2048};
                  pg8::gemm_phase<pg8::EpiBf16, pg8::DenseProb, true>(F.lds, P, E); }
                }
            } SEAM(pb + 2);
            if (IN(pb + 3)) { p_l1_thin_b(F); } SEAM(pb + 3);
            if (IN(pb + 4)) { p_nsa_cmp_mfma(F); } SEAM(pb + 4);
            if (IN(pb + 5)) { p_attn_mla(F, F.ctl + CW_CNT + 256); p_attn_nsa(F, F.ctl + CW_CNT + 257); } SEAM(pb + 5);
        }
        if (IN(pb + 6)) { pg8::DenseProb P; P.init(MIXIN, ND, (const bf16*)(ws + (l == 0 ? WS_WABOUT : WS_WCDOUT)), NT, ND, ND, F.G, (int)blockIdx.x); pg8::EpiBf16 E{MIXO, ND};
            pg8::gemm_phase<pg8::EpiBf16, pg8::DenseProb, true>(F.lds, P, E); } SEAM(pb + 6);
        if (IN(pb + 7)) { p_ln1(F, xin, MIXO, kin(15) + l * ND, kin(16) + l * ND, X1B, MK_FP8_MOE ? (unsigned char*)(ws + WS_X1F8) : nullptr); } SEAM(pb + 7);
        if (IN(pb + 8)) { pg8::RouterProb P; P.K = 512; P.ldb = ND; P.Abase = (const char*)X1B; P.Bt = (const char*)(ws + WS_RT + (size_t)l * MiB); P.G = F.G; P.c = (int)blockIdx.x;
            pg8::EpiF32N64 E{(float*)(ws + WS_LOGITS)};
            pg8::gemm_phase<pg8::EpiF32N64, pg8::RouterProb, true>(F.lds, P, E); } SEAM(pb + 8);
        if (IN(pb + 9)) { p_route(F, l); } SEAM(pb + 9);
        if (IN(pb + 10)) { p_scatter(F, l); } SEAM(pb + 10);
        if (IN(pb + 11)) { load_offsets(F, l); const LAS int* tab = (const LAS int*)(F.lds + TAB_OFF);
            pg8::MoeUpProb P; P.W13 = (const char*)(ws + WS_W13 + (size_t)l * WS_MOE_LSTRIDE); P.sorted = (const int*)(ws + WS_SORTED); P.tile_e = tab + 160; P.ntiles = __builtin_amdgcn_readfirstlane(tab[65]);
            P.G = F.G; P.c = (int)blockIdx.x;
            if (MK_FP8_MOE) { P.K = ND / 2; P.ldb = ND / 2; P.arow = ND; P.brow = ND; P.pshift = 3; P.btile = 128; P.nunits = (P.ntiles + NT / 256) * 8; P.Abase = (const char*)(ws + WS_X1F8);
                pg8::EpiSwigluF8 E{(unsigned char*)HB, 1.0f / 64.0f};
                pg8::gemm_phase<pg8::EpiSwigluF8, pg8::MoeUpProb, true, true>(F.lds, P, E); }
            else { P.K = ND; P.ldb = ND; P.arow = ND * 2; P.brow = ND * 2; P.pshift = 2; P.btile = 256; P.nunits = (P.ntiles + NT / 256) * 4; P.Abase = (const char*)X1B;
                pg8::EpiSwiglu E{HB};
                pg8::gemm_phase<pg8::EpiSwiglu, pg8::MoeUpProb, true>(F.lds, P, E); } } SEAM(pb + 11);
        if (IN(pb + 12)) { load_offsets(F, l); const LAS int* tab = (const LAS int*)(F.lds + TAB_OFF);
            pg8::MoeDownProb P; P.Abase = (const char*)HB; P.W2 = (const char*)(ws + WS_W2 + (size_t)l * WS_MOE_LSTRIDE); P.tile_e = tab + 160; P.ntiles = __builtin_amdgcn_readfirstlane(tab[65]);
            P.G = F.G; P.c = (int)blockIdx.x;
            if (MK_FP8_MOE) { P.K = EFF / 2; P.ldb = EFF / 2; P.arow = EFF; P.brow = EFF; P.pshift = 4; P.btile = 128; P.nunits = (P.ntiles + NT / 256) * 16;
                pg8::EpiFp8N128 E{(unsigned char*)Y2, ND, 16.0f / (64.0f * 8.0f)};
                pg8::gemm_phase<pg8::EpiFp8N128, pg8::MoeDownProb, true, true>(F.lds, P, E); }
            else { P.K = EFF; P.ldb = EFF; P.arow = EFF * 2; P.brow = EFF * 2; P.pshift = 3; P.btile = 256; P.nunits = (P.ntiles + NT / 256) * 8;
                pg8::EpiFp8 E{(unsigned char*)Y2, ND, 16.0f};
                pg8::gemm_phase<pg8::EpiFp8, pg8::MoeDownProb, true>(F.lds, P, E); } } SEAM(pb + 12);
        if (IN(pb + 13)) { p_combine_ln2(F, X1B, (const unsigned char*)Y2, (const int*)(ws + WS_SLOT), (const float*)(ws + WS_WSEL), kin(17) + l * ND, kin(18) + l * ND, l == 0 ? X2B : nullptr, l == 0 ? nullptr : F.out, (l == 0 && MK_FP8_IN1) ? (unsigned char*)(ws + WS_X1F8) : nullptr); } SEAM(pb + 13);
    }
__global__ void __launch_bounds__(NWAVES * 64, 2) mk_fwd(Args args) {
    extern __shared__ __attribute__((aligned(16))) unsigned char lds[];
    Frame F;
    F.lds = (LAS unsigned char*)lds;
    F.MISC = (volatile LAS unsigned*)(F.lds + MISC_OFF);
    F.tid = threadIdx.x; F.lane = F.tid & 63; F.wave = __builtin_amdgcn_readfirstlane(F.tid >> 6);
    F.G = gridDim.x; { const int bx = blockIdx.x; F.vcu = (F.G % 8 == 0) ? (bx % 8) * (F.G / 8) + bx / 8 : bx; }
    F.gw = F.vcu * NWAVES + F.wave; F.NGW = F.G * NWAVES;
    F.ws = args.ws; F.ctl = (unsigned*)(args.ws + WS_CTL); F.out = args.out;
    for (int u = F.tid; u < (LDS_BYTES - LDSCTL_OFF) / 4; u += NWAVES * 64) ((LAS unsigned*)(F.lds + LDSCTL_OFF))[u] = 0u;
    __syncthreads();
    XcdBarrier bar; bar.bar = F.ctl + CW_BAR; bar.x = 0; bar.st = nullptr;
    if (MK_ONE_LAUNCH) bar = xcd_barrier_post(F.ctl + CW_BAR, F.MISC + 8);
    const int lo = args.ph_lo, hi = args.ph_hi;
    if (MK_PROBE_PHASE == 0 && blockIdx.x == 0 && F.tid == 0) ((volatile LAS unsigned long long*)(F.lds + LDSCTL_OFF + 64))[0] = __builtin_amdgcn_s_memrealtime();
    unsigned char* ws = args.ws;
    bf16* const XB0 = (bf16*)(ws + WS_XB0); bf16* const X1B = (bf16*)(ws + WS_X1B); bf16* const X2B = (bf16*)(ws + WS_X2B);
    bf16* const PROJ = (bf16*)(ws + WS_PROJ); bf16* const MIXIN = (bf16*)(ws + WS_MIXIN); bf16* const MIXO = (bf16*)(ws + WS_MIXO);
    bf16* const HB = (bf16*)(ws + WS_H); bf16* const Y2 = (bf16*)(ws + WS_Y2);

    if (IN(0)) { p_prologue(F); } SEAM(0);

    layer_body<0>(F, bar, lo, hi);
    layer_body<1>(F, bar, lo, hi);
    if (MK_PROBE_PHASE >= 0 && blockIdx.x == 0 && F.tid == 0) {
        volatile LAS unsigned long long* tsl = (volatile LAS unsigned long long*)(F.lds + LDSCTL_OFF + 64);
        if (MK_PROBE_LAST == 30) tsl[1] = __builtin_amdgcn_s_memrealtime();
        const unsigned long long span = (tsl[1] - tsl[0]) * MK_PROBE_AMP, t0 = __builtin_amdgcn_s_memrealtime();
        while (__builtin_amdgcn_s_memrealtime() - t0 < span) __builtin_amdgcn_s_sleep(8);
    }
#undef IN
#undef SEAM
}

extern "C" void kernel_launch(void* const* d_in, const int* in_sizes, int n_in, void* d_out, int out_size, void* d_ws, size_t ws_size, hipStream_t stream) {
    static int grid = 0;
    if (grid == 0) {
        if (n_in != 27 || in_sizes[0] != NT * ND || out_size != NT * ND || ws_size < WS_END) { fprintf(stderr, "kernel_launch: unexpected problem (n_in %d, in0 %d, out %d, ws %zu < %zu); nothing launched\n", n_in, n_in > 0 ? in_sizes[0] : -1, out_size, ws_size, (size_t)WS_END); grid = -1; return; }
        int dev = 0, cus = 0, per_cu = 0;
        if (hipGetDevice(&dev) != hipSuccess || hipDeviceGetAttribute(&cus, hipDeviceAttributeMultiprocessorCount, dev) != hipSuccess) { fprintf(stderr, "kernel_launch: device query failed\n"); grid = -1; return; }
        if (hipFuncSetAttribute((const void*)mk_fwd, hipFuncAttributeMaxDynamicSharedMemorySize, LDS_BYTES) != hipSuccess) { fprintf(stderr, "kernel_launch: hipFuncSetAttribute failed\n"); grid = -1; return; }
        if (hipOccupancyMaxActiveBlocksPerMultiprocessor(&per_cu, (const void*)mk_fwd, NWAVES * 64, LDS_BYTES) != hipSuccess || per_cu < 1) fprintf(stderr, "kernel_launch: note: occupancy query reports %d\n", per_cu);
        (void)hipGetLastError();
        grid = cus;
    }
    if (grid < 0) return;
    if (hipMemsetAsync((char*)d_ws + WS_CTL, 0, CTL_ZERO_BYTES, stream) != hipSuccess) { fprintf(stderr, "kernel_launch: memset failed\n"); return; }
    Args a{};
    for (int i = 0; i < 27; ++i) a.in[i] = (const float*)d_in[i];
    a.out = (float*)d_out; a.ws = (unsigned char*)d_ws;
#if MK_ONE_LAUNCH
    a.ph_lo = 0; a.ph_hi = NPHASE;
    hipLaunchKernelGGL(mk_fwd, dim3(grid), dim3(NWAVES * 64), LDS_BYTES, stream, a);
#else
    for (int p = 0; p < NPHASE; ++p) {
        const int lp = (p - 1) & 15;
        if (p >= 1) { const int l = (p - 1) >> 4; if (lp >= 14) continue; if (l == 0 && lp >= 3 && lp <= 5) continue; }
        a.ph_lo = p; a.ph_hi = p + 1;
        hipLaunchKernelGGL(mk_fwd, dim3(grid), dim3(NWAVES * 64), LDS_BYTES, stream, a);
    }
#endif
    const hipError_t le = hipPeekAtLastError();
    if (le != hipSuccess) fprintf(stderr, "kernel_launch: launch failed: %s\n", hipGetErrorName(le));
}
```

```cpp
#include <hip/hip_runtime.h>
#include <cstdio>
#include <cstdint>

#ifndef MK_ONE_LAUNCH
#define MK_ONE_LAUNCH 1
#endif
#ifndef MK_FP8_MOE
#define MK_FP8_MOE 1
#endif
#ifndef MK_F8_PIPE
#define MK_F8_PIPE 0
#endif
#ifndef MK_FP8_INPROJ
#define MK_FP8_INPROJ 3
#endif
#define MK_FP8_IN0 ((MK_FP8_INPROJ & 1) != 0)
#define MK_FP8_IN1 ((MK_FP8_INPROJ & 2) != 0)
#ifndef MK_F8_NB2
#define MK_F8_NB2 1
#endif
#ifndef MK_F8_NB2_UP
#define MK_F8_NB2_UP 1
#endif
#ifndef MK_F8_NB2_IN
#define MK_F8_NB2_IN 1
#endif
#ifndef MK_ATTN_PRIO
#define MK_ATTN_PRIO 1
#endif
#ifndef MK_PROBE_PHASE
#define MK_PROBE_PHASE -1
#endif
#ifndef MK_PROBE_LAST
#define MK_PROBE_LAST MK_PROBE_PHASE
#endif
#ifndef MK_PROBE_AMP
#define MK_PROBE_AMP 4
#endif

#define GAS __attribute__((address_space(1)))
#define LAS __attribute__((address_space(3)))
typedef unsigned short bf16;
typedef unsigned v4u __attribute__((ext_vector_type(4)));
typedef unsigned v2u __attribute__((ext_vector_type(2)));
typedef float f32x4 __attribute__((ext_vector_type(4)));
typedef float f32x2 __attribute__((ext_vector_type(2)));
typedef short bf16x8 __attribute__((ext_vector_type(8)));

constexpr int NB = 8, NS = 2048, ND = 2048, NT = NB * NS;
constexpr float DN_ALPHA = 1.41421356237309505f;
constexpr float LN_EPS = 1e-5f, NORM_EPS = 1e-6f;
constexpr int AB_IN = 5120, CD_IN = 3544, CD_INP = 3584;
constexpr int NEXP = 64, EFF = 512;
constexpr int MAXROWS = NT * 8 + NEXP * 256;
constexpr int MAXTILES = MAXROWS / 256;
constexpr int SH_ROW0 = MAXROWS;

constexpr size_t MiB = 1u << 20;
constexpr size_t WS_CTL = 0, CTL_ZERO_BYTES = 1 * MiB;
constexpr size_t WS_TOPE = 1 * MiB, WS_WSEL = WS_TOPE + 512 * 1024, WS_SLOT = 2 * MiB, WS_SORTED = WS_SLOT + 512 * 1024;
constexpr size_t WS_CMPB = 3 * MiB + 256 * 1024, WS_SELM = 3 * MiB + 512 * 1024;
constexpr size_t WS_KVCMP = 4 * MiB;
constexpr size_t WS_HID = 6 * MiB;
constexpr size_t WS_SORTED2 = 10 * MiB;
constexpr size_t WS_WABIN = 16 * MiB, WS_WABOUT = 36 * MiB, WS_WCDIN = 44 * MiB, WS_WCDOUT = 58 * MiB, WS_WUQ = 66 * MiB, WS_WUKV = 68 * MiB, WS_CW1 = 70 * MiB, WS_RT = 72 * MiB;
constexpr size_t WS_W13 = 74 * MiB, WS_W2 = 334 * MiB, WS_MOE_LSTRIDE = 390 * MiB;
constexpr size_t WS_XB0 = 854 * MiB, WS_X2B = 854 * MiB, WS_X1B = 918 * MiB;
constexpr size_t WS_H = 982 * MiB, WS_Y2 = 1142 * MiB, WS_X1F8 = 1782 * MiB, WS_END = 1814 * MiB;
constexpr size_t WS_PROJ = 982 * MiB, WS_MIXIN = 1142 * MiB, WS_MIXO = 1206 * MiB;
constexpr size_t WS_HIDP = WS_MIXO;
constexpr size_t WS_QR = 1270 * MiB, WS_KR = 1294 * MiB;
constexpr size_t WS_CQN = 1270 * MiB, WS_CKVN = 1282 * MiB, WS_KROT = 1298 * MiB, WS_QMLA = 1302 * MiB, WS_KVU = 1350 * MiB, WS_CMPKV = 1414 * MiB, WS_OCMP = 1434 * MiB;
constexpr size_t WS_LOGITS = 1142 * MiB;
constexpr int CW_TMO = 0, CW_CODE = 1, CW_BAR = 4096, CW_CNT = 16384;

constexpr int RING_BYTES = 131072, LDSCTL_OFF = RING_BYTES, MISC_OFF = LDSCTL_OFF + 320, TAB_OFF = LDSCTL_OFF + 512;
constexpr int STASH_OFF = 147456;
constexpr int LDS_BYTES = 163840;
constexpr int NWAVES = 8;

#define LDS_WAIT() asm volatile("s_waitcnt lgkmcnt(0)" ::: "memory")
#define VM_WAIT() asm volatile("s_waitcnt vmcnt(0)" ::: "memory")
typedef __bf16 hwbf16x2 __attribute__((ext_vector_type(2)));
__device__ __forceinline__ unsigned pk2(float lo, float hi) { const f32x2 v = {lo, hi}; const hwbf16x2 b = __builtin_convertvector(v, hwbf16x2); return __builtin_bit_cast(unsigned, b); }
__device__ __forceinline__ unsigned f2bf(float f) { return pk2(f, 0.f) & 0xffffu; }
__device__ __forceinline__ void fast_sincos(float ang, float& sn, float& cs) { const float r = __builtin_amdgcn_fractf(ang * 0.15915494309189535f); sn = __builtin_amdgcn_sinf(r); cs = __builtin_amdgcn_cosf(r); }
__device__ __forceinline__ float bflo(unsigned w) { return __builtin_bit_cast(float, w << 16); }
__device__ __forceinline__ float bfhi(unsigned w) { return __builtin_bit_cast(float, w & 0xffff0000u); }
__device__ __forceinline__ float bf1(bf16 v) { return __builtin_bit_cast(float, ((unsigned)v) << 16); }
__device__ __forceinline__ int lane_id_fresh() { unsigned m = ~0u; asm volatile("" : "+s"(m)); return (int)__builtin_amdgcn_mbcnt_hi(m, __builtin_amdgcn_mbcnt_lo(m, 0u)); }
template <class T> __device__ __forceinline__ T mk_shfl_xor(T v, int mask) { return __builtin_bit_cast(T, __builtin_amdgcn_ds_bpermute((lane_id_fresh() ^ mask) << 2, __builtin_bit_cast(int, v))); }
template <class T> __device__ __forceinline__ T mk_shfl(T v, int src) { return __builtin_bit_cast(T, __builtin_amdgcn_ds_bpermute(src << 2, __builtin_bit_cast(int, v))); }
template <class T> __device__ __forceinline__ T mk_shfl_up(T v, int d) { const int l = lane_id_fresh(); return __builtin_bit_cast(T, __builtin_amdgcn_ds_bpermute((l >= d ? l - d : l) << 2, __builtin_bit_cast(int, v))); }
__device__ __forceinline__ float wave_sum(float v) {
#pragma unroll
    for (int o = 1; o < 64; o <<= 1) v += __shfl_xor(v, o);
    return v;
}
__device__ __forceinline__ float wave_max(float v) {
#pragma unroll
    for (int o = 1; o < 64; o <<= 1) v = fmaxf(v, __shfl_xor(v, o));
    return v;
}
__device__ __forceinline__ float sigmoidf_(float x) { return 1.0f / (1.0f + __expf(-x)); }
__device__ __forceinline__ float siluf_(float x) { return x * __builtin_amdgcn_rcpf(1.0f + __expf(-x)); }
__device__ __forceinline__ void unpack8(const v4u w, float (&f)[8]) {
    f[0] = bflo(w.x); f[1] = bfhi(w.x); f[2] = bflo(w.y); f[3] = bfhi(w.y); f[4] = bflo(w.z); f[5] = bfhi(w.z); f[6] = bflo(w.w); f[7] = bfhi(w.w);
}

#define XB_TMO      128
#define XB_XCNT(j)  (256  + 64 * (j))
#define XB_XSUB(j)  (1280 + 64 * (j))
#define XB_XGEN(j)  (2304 + 64 * (j))
#define XB_TOP      3328
#define XB_TOPGEN   3392
#define XCD_BAR_WORDS 3456
#define XB_SPIN_CAP (1u << 18)
__device__ __forceinline__ unsigned xb_ld(unsigned* p)              { return __hip_atomic_load(p, __ATOMIC_RELAXED, __HIP_MEMORY_SCOPE_AGENT); }
__device__ __forceinline__ unsigned xb_add(unsigned* p, unsigned v) { return __hip_atomic_fetch_add(p, v, __ATOMIC_RELAXED, __HIP_MEMORY_SCOPE_AGENT); }
__device__ __forceinline__ unsigned xb_xcc_id() { return (unsigned)__builtin_amdgcn_s_getreg((3 << 11) | 20) & 0xFu; }
#define XB_SPIN(cond, bar) do { unsigned _sp = 0; while (cond) { __builtin_amdgcn_s_sleep(1); \
    if ((++_sp & 255u) == 0u) { if (xb_ld(&(bar)[XB_TMO])) break; if (_sp > XB_SPIN_CAP) { atomicAdd(&(bar)[XB_TMO], 1u); break; } } } } while (0)
struct XcdBarrier { unsigned* bar; unsigned x; volatile LAS unsigned* st; int wave; };
__device__ __forceinline__ XcdBarrier xcd_barrier_post(unsigned* bar, volatile LAS unsigned* st) {
    XcdBarrier b; b.bar = bar; b.x = xb_xcc_id(); b.st = st; b.wave = __builtin_amdgcn_readfirstlane((int)(threadIdx.x >> 6));
    if (threadIdx.x == 0) (void)xb_add(&bar[XB_XCNT(b.x)], 1u);
    return b;
}
__device__ __forceinline__ void xcd_barrier_complete(unsigned* bar, unsigned x, unsigned& nloc, unsigned& nx) {
    const unsigned G = gridDim.x * gridDim.y * gridDim.z;
    unsigned sum, cnt, mine, sp = 0u;
    for (;;) {
        sum = 0u; cnt = 0u; mine = 0u;
#pragma unroll
        for (unsigned j = 0; j < 16; ++j) { const unsigned c = xb_ld(&bar[XB_XCNT(j)]); sum += c; cnt += (c > 0u) ? 1u : 0u; mine = (j == x) ? c : mine; }
        if (sum == G) break;
        __builtin_amdgcn_s_sleep(1);
        if ((++sp & 255u) == 0u) { if (xb_ld(&bar[XB_TMO])) break; if (sp > XB_SPIN_CAP) { atomicAdd(&bar[XB_TMO], 1u); break; } }
    }
    nloc = mine > 0u ? mine : 1u; nx = cnt > 0u ? cnt : 1u;
}
__device__ __forceinline__ void xcd_barrier(const XcdBarrier& b) {
    asm volatile("s_waitcnt vmcnt(0)" ::: "memory");
    __syncthreads();
    if (b.wave == 0 && lane_id_fresh() == 0) {
        unsigned* bar = b.bar;
        __builtin_amdgcn_s_waitcnt(0);
        unsigned nloc = b.st[0], nx = b.st[1];
        if (nloc == 0u) { xcd_barrier_complete(bar, b.x, nloc, nx); b.st[0] = nloc; b.st[1] = nx; }
        const unsigned old = xb_add(&bar[XB_XSUB(b.x)], 1u);
        const unsigned gen = old / nloc;
        if (old + 1u == (gen + 1u) * nloc) {
            __builtin_amdgcn_fence(__ATOMIC_RELEASE, "agent");
            asm volatile("s_waitcnt vmcnt(0)" ::: "memory");
            const unsigned og = xb_add(&bar[XB_TOP], 1u);
            const unsigned tg = og / nx;
            if (og + 1u == (tg + 1u) * nx) xb_add(&bar[XB_TOPGEN], 1u);
            else XB_SPIN(xb_ld(&bar[XB_TOPGEN]) == tg, bar);
            __builtin_amdgcn_fence(__ATOMIC_ACQUIRE, "agent");
            xb_add(&bar[XB_XGEN(b.x)], 1u);
            asm volatile("s_waitcnt vmcnt(0)" ::: "memory");
        } else {
            XB_SPIN(xb_ld(&bar[XB_XGEN(b.x)]) == gen, bar);
            __builtin_amdgcn_fence(__ATOMIC_ACQUIRE, "agent");
            asm volatile("s_waitcnt vmcnt(0)" ::: "memory");
        }
    }
    __syncthreads();
}

namespace pg8 {
typedef int v4i_t __attribute__((ext_vector_type(4)));
constexpr int BM = 256, BK = 64, HALF = 128, HTB = HALF * BK * 2, STAGE_BYTES = 8 * HTB, NXCD = 8, WGM = 8;
__host__ __device__ __forceinline__ int lds_byte(int r, int c) { const int st = (r >> 4) * 2 + (c >> 5), rr = r & 15, cc = c & 31, ob = rr * 64 + cc * 2; return st * 1024 + (ob ^ (((ob >> 9) & 1) << 5)); }
__host__ __device__ __forceinline__ void stage_rc(int b, int& R, int& C) { const int st = b / 1024, sb = b % 1024, swz = sb ^ (((sb >> 9) & 1) << 5); R = (st >> 1) * 16 + swz / 64; C = (st & 1) * 32 + (swz % 64) / 2; }
__host__ __device__ __forceinline__ int perm32(int rho) { const int n = rho >> 4, i = rho & 15; return 8 * (i >> 2) + 4 * n + (i & 3); }
struct Unit { int pm, pn, e; };

__device__ __forceinline__ unsigned cvt_pk_bf16(float lo, float hi) { unsigned r; asm volatile("v_cvt_pk_bf16_f32 %0, %1, %2" : "=v"(r) : "v"(lo), "v"(hi)); return r; }

struct EpiBf16 {
    static constexpr bool PERM = true; static constexpr bool PERM2 = false; static constexpr unsigned SCALE_A = 0x7F7F7F7Fu;
    bf16* O; int ldc;
    __device__ __forceinline__ void operator()(const f32x4 (&acc)[2][2][4][2], const Unit& u, int wr, int wc, int fr, int fq) const {
        const int row0 = u.pm * BM + wr * 64 + fr, col0 = u.pn * BM + wc * 32 + 8 * fq;
#pragma unroll
        for (int ai = 0; ai < 2; ++ai)
#pragma unroll
            for (int m = 0; m < 4; ++m) { bf16* rowp = O + (size_t)(row0 + ai * HALF + m * 16) * ldc + col0;
#pragma unroll
                for (int bj = 0; bj < 2; ++bj) { const f32x4 v0 = acc[ai][bj][m][0], v1 = acc[ai][bj][m][1];
                    v4u w; w.x = cvt_pk_bf16(v0[0], v0[1]); w.y = cvt_pk_bf16(v0[2], v0[3]); w.z = cvt_pk_bf16(v1[0], v1[1]); w.w = cvt_pk_bf16(v1[2], v1[3]);
                    *(v4u*)(rowp + bj * HALF) = w; } }
    }
};
struct EpiFp8 {
    static constexpr bool PERM = true; static constexpr bool PERM2 = false; static constexpr unsigned SCALE_A = 0x7A7A7A7Au;
    unsigned char* O; int ldc; float mul;
    __device__ __forceinline__ void operator()(const f32x4 (&acc)[2][2][4][2], const Unit& u, int wr, int wc, int fr, int fq) const {
        const int row0 = u.pm * BM + wr * 64 + fr, col0 = u.pn * BM + wc * 32 + 8 * fq;
#pragma unroll
        for (int ai = 0; ai < 2; ++ai)
#pragma unroll
            for (int m = 0; m < 4; ++m) { unsigned char* rowp = O + (size_t)(row0 + ai * HALF + m * 16) * ldc + col0;
#pragma unroll
                for (int bj = 0; bj < 2; ++bj) { float v[8];
#pragma unroll
                    for (int n = 0; n < 2; ++n)
#pragma unroll
                        for (int j = 0; j < 4; ++j) v[n * 4 + j] = __builtin_amdgcn_fmed3f(acc[ai][bj][m][n][j] * mul, -448.0f, 448.0f);
                    int w0 = __builtin_amdgcn_cvt_pk_fp8_f32(v[0], v[1], 0, false); w0 = __builtin_amdgcn_cvt_pk_fp8_f32(v[2], v[3], w0, true);
                    int w1 = __builtin_amdgcn_cvt_pk_fp8_f32(v[4], v[5], 0, false); w1 = __builtin_amdgcn_cvt_pk_fp8_f32(v[6], v[7], w1, true);
                    *(v2u*)(rowp + bj * HALF) = (v2u){(unsigned)w0, (unsigned)w1}; } }
    }
};
struct EpiBf16P2 {
    static constexpr bool PERM = true; static constexpr bool PERM2 = true; static constexpr unsigned SCALE_A = 0x79797979u;
    bf16* O; int ldc;
    __device__ __forceinline__ void operator()(const f32x4 (&acc)[2][2][4][2], const Unit& u, int wr, int wc, int fr, int fq) const {
        const int row0 = u.pm * BM + wr * 64 + fr, col0 = u.pn * BM + wc * 64 + 16 * fq;
#pragma unroll
        for (int ai = 0; ai < 2; ++ai)
#pragma unroll
            for (int m = 0; m < 4; ++m) { bf16* rowp = O + (size_t)(row0 + ai * HALF + m * 16) * ldc + col0;
#pragma unroll
                for (int bj = 0; bj < 2; ++bj) { const f32x4 v0 = acc[ai][bj][m][0], v1 = acc[ai][bj][m][1];
                    v4u w; w.x = cvt_pk_bf16(v0[0], v0[1]); w.y = cvt_pk_bf16(v0[2], v0[3]); w.z = cvt_pk_bf16(v1[0], v1[1]); w.w = cvt_pk_bf16(v1[2], v1[3]);
                    *(v4u*)(rowp + bj * 8) = w; } }
    }
};
struct EpiSwigluF8P2 {
    static constexpr bool PERM = true; static constexpr bool PERM2 = true; static constexpr unsigned SCALE_A = 0x79797979u;
    unsigned char* H;
    __device__ __forceinline__ v2u pack(const f32x4 (&acc)[2][2][4][2], int ai, int m) const { v2u w;
#pragma unroll
        for (int bj = 0; bj < 2; ++bj) { float o[4];
#pragma unroll
            for (int j = 0; j < 4; ++j) { const float h1 = acc[ai][bj][m][0][j], h3 = acc[ai][bj][m][1][j]; o[j] = __builtin_amdgcn_fmed3f(siluf_(h1) * h3 * 8.0f, -448.0f, 448.0f); }
            int w0 = __builtin_amdgcn_cvt_pk_fp8_f32(o[0], o[1], 0, false); w0 = __builtin_amdgcn_cvt_pk_fp8_f32(o[2], o[3], w0, true);
            if (bj == 0) w.x = (unsigned)w0; else w.y = (unsigned)w0; }
        return w; }
    __device__ __forceinline__ void operator()(const f32x4 (&acc)[2][2][4][2], const Unit& u, int wr, int wc, int fr, int fq) const {
        const int odd = fq & 1;
        const int row0 = u.pm * BM + wr * 64 + fr + 16 * odd, col0 = u.pn * 128 + wc * 32 + 8 * (fq - odd);
#pragma unroll
        for (int ai = 0; ai < 2; ++ai)
#pragma unroll
            for (int mp = 0; mp < 2; ++mp) { const v2u a = pack(acc, ai, 2 * mp), b = pack(acc, ai, 2 * mp + 1);
                const auto sx = __builtin_amdgcn_permlane16_swap(a.x, b.x, false, false); const auto sy = __builtin_amdgcn_permlane16_swap(a.y, b.y, false, false);
                *(v4u*)(H + (size_t)(row0 + ai * HALF + mp * 32) * EFF + col0) = (v4u){(unsigned)sx[0], (unsigned)sy[0], (unsigned)sx[1], (unsigned)sy[1]}; }
    }
};
struct EpiFp8P2 {
    static constexpr bool PERM = true; static constexpr bool PERM2 = true; static constexpr unsigned SCALE_A = 0x7A7A7A7Au;
    unsigned char* O; int ldc;
    __device__ __forceinline__ void operator()(const f32x4 (&acc)[2][2][4][2], const Unit& u, int wr, int wc, int fr, int fq) const {
        const int row0 = u.pm * BM + wr * 64 + fr, col0 = u.pn * BM + wc * 64 + 16 * fq;
#pragma unroll
        for (int ai = 0; ai < 2; ++ai)
#pragma unroll
            for (int m = 0; m < 4; ++m) { unsigned char* rowp = O + (size_t)(row0 + ai * HALF + m * 16) * ldc + col0; v4u w;
#pragma unroll
                for (int bj = 0; bj < 2; ++bj) { float v[8];
#pragma unroll
                    for (int n = 0; n < 2; ++n)
#pragma unroll
                        for (int j = 0; j < 4; ++j) v[n * 4 + j] = __builtin_amdgcn_fmed3f(acc[ai][bj][m][n][j], -448.0f, 448.0f);
                    int w0 = __builtin_amdgcn_cvt_pk_fp8_f32(v[0], v[1], 0, false); w0 = __builtin_amdgcn_cvt_pk_fp8_f32(v[2], v[3], w0, true);
                    int w1 = __builtin_amdgcn_cvt_pk_fp8_f32(v[4], v[5], 0, false); w1 = __builtin_amdgcn_cvt_pk_fp8_f32(v[6], v[7], w1, true);
                    if (bj == 0) { w.x = (unsigned)w0; w.y = (unsigned)w1; } else { w.z = (unsigned)w0; w.w = (unsigned)w1; } }
                *(v4u*)rowp = w; }
    }
};
struct EpiF32 {
    static constexpr bool PERM = false; static constexpr bool PERM2 = false; static constexpr unsigned SCALE_A = 0x7F7F7F7Fu;
    float* C; int ldc; const float* bias;
    __device__ __forceinline__ void operator()(const f32x4 (&acc)[2][2][4][2], const Unit& u, int wr, int wc, int fr, int fq) const {
        const int row0 = u.pm * BM + wr * 64 + fr, col0 = u.pn * BM + wc * 32 + 4 * fq;
        f32x4 bv[2][2];
#pragma unroll
        for (int bj = 0; bj < 2; ++bj)
#pragma unroll
            for (int n = 0; n < 2; ++n) bv[bj][n] = bias ? *(const f32x4*)(bias + col0 + bj * HALF + n * 16) : (f32x4){0.f, 0.f, 0.f, 0.f};
#pragma unroll
        for (int ai = 0; ai < 2; ++ai)
#pragma unroll
            for (int m = 0; m < 4; ++m) { float* rowp = C + (size_t)(row0 + ai * HALF + m * 16) * ldc + col0;
#pragma unroll
                for (int bj = 0; bj < 2; ++bj)
#pragma unroll
                    for (int n = 0; n < 2; ++n) *(f32x4*)(rowp + bj * HALF + n * 16) = acc[ai][bj][m][n] + bv[bj][n]; }
    }
};
struct EpiF32Split {
    static constexpr bool PERM = false; static constexpr bool PERM2 = false; static constexpr unsigned SCALE_A = 0x7F7F7F7Fu;
    float* C; const float* bias;
    __device__ __forceinline__ void operator()(const f32x4 (&acc)[2][2][4][2], const Unit& u, int wr, int wc, int fr, int fq) const {
        const int row0 = u.pm * BM + wr * 64 + fr, col0 = wc * 32 + 4 * fq;
        f32x4 bv[2][2];
#pragma unroll
        for (int bj = 0; bj < 2; ++bj)
#pragma unroll
            for (int n = 0; n < 2; ++n) bv[bj][n] = u.e == 0 ? *(const f32x4*)(bias + col0 + bj * HALF + n * 16) : (f32x4){0.f, 0.f, 0.f, 0.f};
#pragma unroll
        for (int ai = 0; ai < 2; ++ai)
#pragma unroll
            for (int m = 0; m < 4; ++m) { float* rowp = C + ((size_t)u.e * 4096 + row0 + ai * HALF + m * 16) * 256 + col0;
#pragma unroll
                for (int bj = 0; bj < 2; ++bj)
#pragma unroll
                    for (int n = 0; n < 2; ++n) *(f32x4*)(rowp + bj * HALF + n * 16) = acc[ai][bj][m][n] + bv[bj][n]; }
    }
};
struct EpiSwiglu {
    static constexpr bool PERM = true; static constexpr bool PERM2 = false; static constexpr unsigned SCALE_A = 0x7F7F7F7Fu;
    bf16* H;
    __device__ __forceinline__ void operator()(const f32x4 (&acc)[2][2][4][2], const Unit& u, int wr, int wc, int fr, int fq) const {
        const int row0 = u.pm * BM + wr * 64 + fr, col0 = u.pn * HALF + wc * 32 + 8 * fq;
#pragma unroll
        for (int ai = 0; ai < 2; ++ai)
#pragma unroll
            for (int m = 0; m < 4; ++m) { bf16* rowp = H + (size_t)(row0 + ai * HALF + m * 16) * EFF + col0;
                float o[8];
#pragma unroll
                for (int n = 0; n < 2; ++n)
#pragma unroll
                    for (int j = 0; j < 4; ++j) { const float h1 = acc[ai][0][m][n][j], h3 = acc[ai][1][m][n][j]; o[n * 4 + j] = siluf_(h1) * h3; }
                v4u w; w.x = cvt_pk_bf16(o[0], o[1]); w.y = cvt_pk_bf16(o[2], o[3]); w.z = cvt_pk_bf16(o[4], o[5]); w.w = cvt_pk_bf16(o[6], o[7]);
                *(v4u*)rowp = w; }
    }
};

template <class Epi, class Prob, bool ALIGN_EPI, bool F8 = false, bool NB1 = F8, bool STASH = false>
__device__ __forceinline__ void gemm_phase(LAS unsigned char* lds, const Prob& P, const Epi& E, const int wave) {
    const int wid = __builtin_amdgcn_readfirstlane(wave), lane = lane_id_fresh(), tid = wid * 64 + lane, wr = wid >> 2, wc = wid & 3, fr = lane & 15, fq = lane >> 4;
    const int K = P.K, nt = K / BK, ldb = P.ldb;
    unsigned voffB[2];
#pragma unroll
    for (int i = 0; i < 2; ++i) { int R, C; stage_rc(tid * 16 + i * 8192, R, C);
        const int Rb = Epi::PERM2 ? (64 * (R >> 5) + 16 * ((R & 15) >> 2) + 4 * ((R >> 4) & 1) + (R & 3)) : Epi::PERM ? ((R & ~31) + perm32(R & 31)) : R;
        voffB[i] = (unsigned)(Rb * ldb + C) * 2u; }
    const size_t kstep = (size_t)(BK * 2);
    const size_t hstep = (size_t)(Epi::PERM2 ? 8 : HALF) * ldb * 2, b64step = (size_t)(Epi::PERM2 ? 128 : 64) * ldb * 2;
    const unsigned ldsw = (unsigned)wid * 1024u;
    const int aoff = lds_byte(wr * 64 + fr, fq * 8), boff = lds_byte(wc * 32 + fr, fq * 8);
    const char* const Ab = P.Abase;
#define PG8_SA(b, h) (((b) * 2 + (h)) * HTB)
#define PG8_SB(b, h) ((4 + (b) * 2 + (h)) * HTB)
#define PG8_OPQ(x) ({ unsigned _v = (x); asm volatile("" : "+v"(_v)); _v; })
#define PG8_STAGE(bufoff, gbase, voff) do { _Pragma("unroll") for (int _i = 0; _i < 2; ++_i) \
        __builtin_amdgcn_global_load_lds((const unsigned*)((const char*)(gbase) + (size_t)_i * b64step + PG8_OPQ((voff)[0])), (LAS unsigned*)(lds + (bufoff) + ldsw + _i * 8192), 16, 0, 0); } while (0)
#define PG8_STAGE_A(bufoff, kb, o0, o1) do { \
        __builtin_amdgcn_global_load_lds((const unsigned*)(Ab + (kb) + PG8_OPQ(o0)), (LAS unsigned*)(lds + (bufoff) + ldsw), 16, 0, 0); \
        __builtin_amdgcn_global_load_lds((const unsigned*)(Ab + (kb) + PG8_OPQ(o1)), (LAS unsigned*)(lds + (bufoff) + ldsw + 8192), 16, 0, 0); } while (0)
#define PG8_STAGE_AH(bufoff, kb, h, nx) do { \
        if constexpr (Prob::DENSE_A) { const char* _b = ((nx) ? nAb : cAb) + (size_t)(h) * hstepA + (kb); \
            __builtin_amdgcn_global_load_lds((const unsigned*)(_b + PG8_OPQ(voffA[0])), (LAS unsigned*)(lds + (bufoff) + ldsw), 16, 0, 0); \
            __builtin_amdgcn_global_load_lds((const unsigned*)(_b + a64step + PG8_OPQ(voffA[0])), (LAS unsigned*)(lds + (bufoff) + ldsw + 8192), 16, 0, 0); } \
        else if constexpr (STASH) { const v2u _o = *(const LAS v2u*)(stashp + ((nx) ? nslot : cslot) * 16 + (h) * 8); PG8_STAGE_A(bufoff, kb, _o.x, _o.y); } \
        else { const unsigned _o0 = (nx) ? on[2 * (h)] : oc[2 * (h)], _o1 = (nx) ? on[2 * (h) + 1] : oc[2 * (h) + 1]; PG8_STAGE_A(bufoff, kb, _o0, _o1); } } while (0)
#define PG8_STASH_PRE(h, nx) do { if constexpr (STASH) so_ = *(const LAS v2u*)(stashp + ((nx) ? nslot : cslot) * 16 + (h) * 8); } while (0)
#define PG8_STAGE_AHP(bufoff, kb, h, nx) do { if constexpr (STASH) { PG8_STAGE_A(bufoff, kb, so_.x, so_.y); } else { PG8_STAGE_AH(bufoff, kb, h, nx); } } while (0)
#define PG8_LDA(dst, b, h) do { _Pragma("unroll") for (int m = 0; m < 4; ++m) _Pragma("unroll") for (int k = 0; k < 2; ++k) dst[m][k] = *(const LAS bf16x8*)(lds + PG8_SA(b, h) + aoff + m * 2048 + k * 1024); } while (0)
#define PG8_LDB(dst, b, h) do { _Pragma("unroll") for (int n = 0; n < 2; ++n) _Pragma("unroll") for (int k = 0; k < 2; ++k) dst[n][k] = *(const LAS bf16x8*)(lds + PG8_SB(b, h) + boff + n * 2048 + k * 1024); } while (0)
#define PG8_CAT(lo, hi) __builtin_shufflevector(__builtin_bit_cast(v4i_t, lo), __builtin_bit_cast(v4i_t, hi), 0, 1, 2, 3, 4, 5, 6, 7)
#define PG8_MMA(ai, bj, At, Bt) do { __builtin_amdgcn_s_setprio(1); \
        if constexpr (F8) { _Pragma("unroll") for (int m = 0; m < 4; ++m) _Pragma("unroll") for (int n = 0; n < 2; ++n) \
            acc[ai][bj][m][n] = __builtin_amdgcn_mfma_scale_f32_16x16x128_f8f6f4(PG8_CAT(Bt[n][0], Bt[n][1]), PG8_CAT(At[m][0], At[m][1]), acc[ai][bj][m][n], 0, 0, 0, (int)Epi::SCALE_A, 0, 0x7F7F7F7F); } \
        else { _Pragma("unroll") for (int m = 0; m < 4; ++m) _Pragma("unroll") for (int n = 0; n < 2; ++n) _Pragma("unroll") for (int k = 0; k < 2; ++k) \
            acc[ai][bj][m][n] = __builtin_amdgcn_mfma_f32_16x16x32_bf16(Bt[n][k], At[m][k], acc[ai][bj][m][n], 0, 0, 0); } \
        __builtin_amdgcn_s_setprio(0); } while (0)
#define PG8_WAIT_V(n) asm volatile("s_waitcnt vmcnt(" #n ")" ::: "memory")
#define PG8_WAIT_L(n) asm volatile("s_waitcnt lgkmcnt(" #n ")" ::: "memory")
#define PG8_BAR __builtin_amdgcn_s_barrier()
#define PG8_SCHED __builtin_amdgcn_sched_barrier(0)
    Unit cur, nxt; int ui = 0;
    if (!P.next(0, cur)) return;
    f32x4 acc[2][2][4][2];
#pragma unroll
    for (int a = 0; a < 2; ++a)
#pragma unroll
        for (int b = 0; b < 2; ++b)
#pragma unroll
            for (int m = 0; m < 4; ++m)
#pragma unroll
                for (int n = 0; n < 2; ++n) acc[a][b][m][n] = (f32x4){0.f, 0.f, 0.f, 0.f};
    bf16x8 At[4][2], B0[2][2], B1[2][2];
    bf16x8 At2[4][2], B02[2][2];
    LAS unsigned char* const stashp = lds + STASH_OFF + tid * 32; int cslot = 0, nslot = 0; v2u so_ = {0u, 0u};
    unsigned oc[4], on[4], voffA[2]; const char* cAb = nullptr; const char* nAb = nullptr; size_t hstepA = 0, a64step = 0;
    if constexpr (Prob::DENSE_A) { int RA[2], CA[2]; stage_rc(tid * 16, RA[0], CA[0]); stage_rc(tid * 16 + 8192, RA[1], CA[1]);
        voffA[0] = (unsigned)(RA[0] * P.arow + CA[0] * 2); voffA[1] = (unsigned)(RA[1] * P.arow + CA[1] * 2); hstepA = (size_t)HALF * P.arow; a64step = (size_t)64 * P.arow; cAb = P.abase(cur); nAb = cAb;
        oc[0] = oc[1] = oc[2] = oc[3] = 0u; on[0] = on[1] = on[2] = on[3] = 0u; }
    else { int RA[2], CA[2]; stage_rc(tid * 16, RA[0], CA[0]); stage_rc(tid * 16 + 8192, RA[1], CA[1]); P.aoffs(cur, RA, CA, oc); voffA[0] = voffA[1] = 0u;
        if constexpr (STASH) *(LAS v4u*)stashp = (v4u){oc[0], oc[1], oc[2], oc[3]}; }
    const char* cB = P.bbase(cur);
    if constexpr (NB1) {
        PG8_STAGE(PG8_SB(0, 0), cB, voffB); PG8_STAGE_AH(PG8_SA(0, 0), (size_t)0, 0, false); PG8_STAGE_AH(PG8_SA(0, 1), (size_t)0, 1, false);
        if (wr == 1) PG8_BAR;
        PG8_WAIT_V(2); PG8_BAR;
        PG8_STAGE(PG8_SB(1, 0), cB + kstep, voffB); PG8_STAGE_AH(PG8_SA(1, 0), kstep, 0, false);
        PG8_WAIT_V(4); PG8_BAR;
        if constexpr (MK_F8_PIPE != 0) { PG8_SCHED; PG8_LDB(B0, 0, 0); PG8_LDA(At, 0, 0); }
    } else {
    PG8_STAGE(PG8_SB(0, 0), cB, voffB); PG8_STAGE(PG8_SB(0, 1), cB + hstep, voffB); PG8_STAGE_AH(PG8_SA(0, 0), (size_t)0, 0, false); PG8_STAGE_AH(PG8_SA(0, 1), (size_t)0, 1, false);
    if (wr == 1) PG8_BAR;
    PG8_WAIT_V(2); PG8_BAR;
    PG8_STAGE(PG8_SB(1, 0), cB + kstep, voffB); PG8_STAGE_AH(PG8_SA(1, 0), kstep, 0, false); PG8_STAGE(PG8_SB(1, 1), cB + hstep + kstep, voffB);
    PG8_WAIT_V(6); PG8_BAR;
    }
    for (;;) {
        const bool has_next = P.next(ui + 1, nxt);
        const char* nB = cB;
        if constexpr (Prob::DENSE_A) { nAb = cAb; if (has_next) { nAb = P.abase(nxt); nB = P.bbase(nxt); } }
        else if constexpr (STASH) { cslot = ui & 1; nslot = cslot;
               if (has_next) { int RA[2], CA[2]; stage_rc(tid * 16, RA[0], CA[0]); stage_rc(tid * 16 + 8192, RA[1], CA[1]); P.aoffs(nxt, RA, CA, on); nB = P.bbase(nxt); nslot = cslot ^ 1;
                   *(LAS v4u*)(stashp + nslot * 16) = (v4u){on[0], on[1], on[2], on[3]}; } }
        else { if (has_next) { int RA[2], CA[2]; stage_rc(tid * 16, RA[0], CA[0]); stage_rc(tid * 16 + 8192, RA[1], CA[1]); P.aoffs(nxt, RA, CA, on); nB = P.bbase(nxt); }
               else { on[0] = oc[0]; on[1] = oc[1]; on[2] = oc[2]; on[3] = oc[3]; } }
#pragma clang loop unroll(disable)
        for (int t = 0; t < nt; t += 2) {
            const bool last = (t == nt - 2);
            const size_t kb1 = (size_t)(t + 1) * kstep;
            const size_t kb2 = last ? (size_t)0 : (size_t)(t + 2) * kstep, kb3 = kb2 + kstep;
            const char* b2 = last ? nB : cB + (size_t)(t + 2) * kstep; const char* b3 = b2 + kstep;
            if constexpr (NB1 && MK_F8_PIPE != 0) {
            PG8_STAGE_AH(PG8_SA(1, 1), kb1, 1, false);
            PG8_WAIT_V(6); PG8_WAIT_L(0); PG8_BAR; PG8_SCHED; PG8_LDA(At2, 0, 1); PG8_MMA(0, 0, At, B0); PG8_BAR; PG8_SCHED;
            PG8_STAGE(PG8_SB(0, 0), b2, voffB); PG8_STAGE_AH(PG8_SA(0, 0), kb2, 0, last);
            PG8_WAIT_V(6); PG8_WAIT_L(0); PG8_BAR; PG8_SCHED; PG8_LDB(B02, 1, 0); PG8_LDA(At, 1, 0); PG8_MMA(1, 0, At2, B0); PG8_BAR; PG8_SCHED;
            PG8_STAGE_AH(PG8_SA(0, 1), kb2, 1, last);
            PG8_WAIT_V(6); PG8_WAIT_L(0); PG8_BAR; PG8_SCHED; PG8_LDA(At2, 1, 1); PG8_MMA(0, 0, At, B02); PG8_BAR; PG8_SCHED;
            PG8_STAGE(PG8_SB(1, 0), b3, voffB); PG8_STAGE_AH(PG8_SA(1, 0), kb3, 0, last);
            PG8_WAIT_V(6); PG8_WAIT_L(0); PG8_BAR; PG8_SCHED; PG8_LDB(B0, 0, 0); PG8_LDA(At, 0, 0); PG8_MMA(1, 0, At2, B02); PG8_BAR; PG8_SCHED;
            } else if constexpr (NB1) {
            PG8_LDB(B0, 0, 0); PG8_SCHED; PG8_LDA(At, 0, 0); PG8_STAGE_AH(PG8_SA(1, 1), kb1, 1, false);
            PG8_WAIT_V(6); PG8_WAIT_L(0); PG8_BAR; PG8_MMA(0, 0, At, B0); PG8_BAR; PG8_SCHED;
            PG8_LDA(At, 0, 1); PG8_STAGE(PG8_SB(0, 0), b2, voffB); PG8_STAGE_AH(PG8_SA(0, 0), kb2, 0, last);
            PG8_WAIT_V(6); PG8_WAIT_L(0); PG8_BAR; PG8_MMA(1, 0, At, B0); PG8_BAR; PG8_SCHED;
            PG8_LDB(B0, 1, 0); PG8_SCHED; PG8_LDA(At, 1, 0); PG8_STAGE_AH(PG8_SA(0, 1), kb2, 1, last);
            PG8_WAIT_V(6); PG8_WAIT_L(0); PG8_BAR; PG8_MMA(0, 0, At, B0); PG8_BAR; PG8_SCHED;
            PG8_LDA(At, 1, 1); PG8_STAGE(PG8_SB(1, 0), b3, voffB); PG8_STAGE_AH(PG8_SA(1, 0), kb3, 0, last);
            PG8_WAIT_V(6); PG8_WAIT_L(0); PG8_BAR; PG8_MMA(1, 0, At, B0); PG8_BAR; PG8_SCHED;
            } else {
            PG8_STASH_PRE(1, false); PG8_LDB(B0, 0, 0); PG8_LDB(B1, 0, 1); PG8_SCHED; PG8_LDA(At, 0, 0); PG8_STAGE_AHP(PG8_SA(1, 1), kb1, 1, false);
            PG8_WAIT_V(8); PG8_WAIT_L(0); PG8_BAR; PG8_MMA(0, 0, At, B0); PG8_MMA(0, 1, At, B1); PG8_BAR; PG8_SCHED;
            PG8_STASH_PRE(0, last); PG8_LDA(At, 0, 1); PG8_STAGE(PG8_SB(0, 0), b2, voffB); PG8_STAGE(PG8_SB(0, 1), b2 + hstep, voffB); PG8_STAGE_AHP(PG8_SA(0, 0), kb2, 0, last);
            PG8_WAIT_V(8); PG8_WAIT_L(0); PG8_BAR; PG8_MMA(1, 0, At, B0); PG8_MMA(1, 1, At, B1); PG8_BAR; PG8_SCHED;
            PG8_STASH_PRE(1, last); PG8_LDB(B0, 1, 0); PG8_LDB(B1, 1, 1); PG8_SCHED; PG8_LDA(At, 1, 0); PG8_STAGE_AHP(PG8_SA(0, 1), kb2, 1, last);
            PG8_WAIT_V(8); PG8_WAIT_L(0); PG8_BAR; PG8_MMA(0, 0, At, B0); PG8_MMA(0, 1, At, B1); PG8_BAR; PG8_SCHED;
            PG8_STASH_PRE(0, last); PG8_LDA(At, 1, 1); PG8_STAGE(PG8_SB(1, 0), b3, voffB); PG8_STAGE(PG8_SB(1, 1), b3 + hstep, voffB); PG8_STAGE_AHP(PG8_SA(1, 0), kb3, 0, last);
            PG8_WAIT_V(8); PG8_WAIT_L(0); PG8_BAR; PG8_MMA(1, 0, At, B0); PG8_MMA(1, 1, At, B1); PG8_BAR; PG8_SCHED;
            }
        }
        if constexpr (ALIGN_EPI) { if (wr == 0) PG8_BAR; }
        { const int l2 = lane_id_fresh(); E(acc, cur, wr, wc, l2 & 15, l2 >> 4); }
        if (!has_next) break;
#pragma unroll
        for (int a = 0; a < 2; ++a)
#pragma unroll
            for (int b = 0; b < 2; ++b)
#pragma unroll
                for (int m = 0; m < 4; ++m)
#pragma unroll
                    for (int n = 0; n < 2; ++n) acc[a][b][m][n] = (f32x4){0.f, 0.f, 0.f, 0.f};
        cur = nxt; cB = nB; cAb = nAb; if constexpr (!STASH) { oc[0] = on[0]; oc[1] = on[1]; oc[2] = on[2]; oc[3] = on[3]; } ++ui;
        if constexpr (ALIGN_EPI) { if (wr == 1) PG8_BAR; }
    }
    PG8_WAIT_V(0);
    if constexpr (!ALIGN_EPI) { if (wr == 0) PG8_BAR; }
    PG8_BAR;
#undef PG8_SA
#undef PG8_SB
#undef PG8_STAGE
#undef PG8_OPQ
#undef PG8_STAGE_A
#undef PG8_STAGE_AH
#undef PG8_STAGE_AHP
#undef PG8_STASH_PRE
#undef PG8_LDA
#undef PG8_LDB
#undef PG8_MMA
#undef PG8_CAT
#undef PG8_WAIT_V
#undef PG8_WAIT_L
#undef PG8_BAR
#undef PG8_SCHED
}

struct DenseProb {
    static constexpr bool DENSE_A = true; int arow;
    __device__ __forceinline__ const char* abase(const Unit& u) const { return Abase + (size_t)u.pm * BM * arow; }
    int K, ldb; const char* Abase; const char* Bt; int lda; int nM, nN, nwg, G, c, bn;
    __device__ __forceinline__ void init(const bf16* A, int lda_, const bf16* B, int M, int N, int K_, int G_, int c_, int bn_ = BM) { Abase = (const char*)A; Bt = (const char*)B; lda = lda_; arow = lda_ * 2; K = K_; ldb = K_; bn = bn_; nM = M / BM; nN = N / bn_; nwg = nM * nN; G = G_; c = c_; }
    __device__ __forceinline__ bool next(int i, Unit& u) const {
        const long L = (long)i * G + c; if (L >= nwg) return false;
        int wgid = (int)L; { const int q = nwg / NXCD, r = nwg % NXCD, xcd = wgid % NXCD, off = wgid / NXCD; wgid = (xcd < r ? xcd * (q + 1) : r * (q + 1) + (xcd - r) * q) + off; }
        const int nig = WGM * nN, gid = wgid / nig, fm = gid * WGM, gsz = (nM - fm) < WGM ? (nM - fm) : WGM;
        u.pm = fm + ((wgid % nig) % gsz); u.pn = (wgid % nig) / gsz; u.e = 0; return true;
    }
    __device__ __forceinline__ const char* bbase(const Unit& u) const { return Bt + (size_t)u.pn * bn * K * 2; }
    __device__ __forceinline__ void aoffs(const Unit& u, const int (&R)[2], const int (&C)[2], unsigned (&o)[4]) const {
#pragma unroll
        for (int h = 0; h < 2; ++h)
#pragma unroll
            for (int i = 0; i < 2; ++i) o[2 * h + i] = (unsigned)(((size_t)(u.pm * BM + h * HALF + R[i]) * lda + C[i]) * 2);
    }
};
__device__ __forceinline__ bool xcd_range_unit(int i, int nunits, int G, int c, int& L) {
    const int x = c % NXCD, cc = c / NXCD, per = G / NXCD, q = nunits / NXCD, r = nunits % NXCD;
    const int start = x * q + (x < r ? x : r), cnt = q + (x < r ? 1 : 0), li = i * per + cc;
    if (li >= cnt) return false; L = start + li; return true;
}
struct MoeUpProb {
    static constexpr bool DENSE_A = false;
    __device__ __forceinline__ const char* abase(const Unit&) const { return Abase; }
    int K, ldb; int arow, brow;
    int pshift, btile;
    const char* Abase; const char* W13; const int* sorted; const LAS int* tile_e; int ntiles, nunits, G, c;
    __device__ __forceinline__ bool next(int i, Unit& u) const {
        int L; if (!xcd_range_unit(i, nunits, G, c, L)) return false;
        const int tile = L >> pshift; u.pn = L & ((1 << pshift) - 1);
        if (tile < ntiles) { u.pm = tile; u.e = __builtin_amdgcn_readfirstlane(tile_e[tile]); } else { u.pm = MAXTILES + (tile - ntiles); u.e = NEXP; }
        return true;
    }
    __device__ __forceinline__ const char* bbase(const Unit& u) const { return W13 + ((size_t)u.e * 1024 + (size_t)u.pn * btile) * brow; }
    __device__ __forceinline__ void aoffs(const Unit& u, const int (&R)[2], const int (&C)[2], unsigned (&o)[4]) const {
#pragma unroll
        for (int h = 0; h < 2; ++h)
#pragma unroll
            for (int i = 0; i < 2; ++i) { int row;
                if (u.e == NEXP) row = (u.pm - MAXTILES) * BM + h * HALF + R[i];
                else { const LAS int* tab = tile_e - 160; const int idx = u.pm * BM - tab[u.e] + h * HALF + R[i]; row = idx < tab[66 + u.e] ? sorted[(size_t)u.e * NT + idx] : 0; }
                o[2 * h + i] = (unsigned)((size_t)row * arow + C[i] * 2); }
    }
};
struct MoeDownProb {
    static constexpr bool DENSE_A = true;
    __device__ __forceinline__ const char* abase(const Unit& u) const { return Abase + (size_t)u.pm * BM * arow; }
    int K, ldb; int arow, brow, pshift, btile; const char* Abase; const char* W2; const LAS int* tile_e; int ntiles, nunits, G, c;
    __device__ __forceinline__ bool next(int i, Unit& u) const {
        int L; if (!xcd_range_unit(i, nunits, G, c, L)) return false;
        const int tile = L >> pshift; u.pn = L & ((1 << pshift) - 1);
        if (tile < ntiles) { u.pm = tile; u.e = __builtin_amdgcn_readfirstlane(tile_e[tile]); } else { u.pm = MAXTILES + (tile - ntiles); u.e = NEXP; }
        return true;
    }
    __device__ __forceinline__ const char* bbase(const Unit& u) const { return W2 + ((size_t)u.e * 2048 + (size_t)u.pn * btile) * brow; }
    __device__ __forceinline__ void aoffs(const Unit& u, const int (&R)[2], const int (&C)[2], unsigned (&o)[4]) const {
#pragma unroll
        for (int h = 0; h < 2; ++h)
#pragma unroll
            for (int i = 0; i < 2; ++i) o[2 * h + i] = (unsigned)((size_t)(u.pm * BM + h * HALF + R[i]) * arow + C[i] * 2);
    }
};
constexpr int CMP_SPLIT = 4;
struct CmpProb {
    static constexpr bool DENSE_A = false; int arow;
    __device__ __forceinline__ const char* abase(const Unit&) const { return Abase; }
    int K, ldb; const char* Abase; const char* Bt; int G, c;
    __device__ __forceinline__ bool next(int i, Unit& u) const { const int L = i * G + c; if (L >= 16 * CMP_SPLIT) return false; u.pm = L / CMP_SPLIT; u.pn = 0; u.e = L % CMP_SPLIT; return true; }
    __device__ __forceinline__ const char* bbase(const Unit& u) const { return Bt + (size_t)u.e * (4096 / CMP_SPLIT) * 2; }
    __device__ __forceinline__ void aoffs(const Unit& u, const int (&R)[2], const int (&C)[2], unsigned (&o)[4]) const {
#pragma unroll
        for (int h = 0; h < 2; ++h)
#pragma unroll
            for (int i = 0; i < 2; ++i) { const int m = u.pm * BM + h * HALF + R[i], seq = m >> 7, n = m & 127;
                o[2 * h + i] = (unsigned)((((size_t)seq * NS + 16 * n) * 128 + u.e * (4096 / CMP_SPLIT) + C[i]) * 2); }
    }
};
struct RouterProb {
    static constexpr bool DENSE_A = false; int arow;
    __device__ __forceinline__ const char* abase(const Unit&) const { return Abase; }
    int K, ldb; const char* Abase; const char* Bt; int G, c;
    __device__ __forceinline__ bool next(int i, Unit& u) const { const int L = i * G + c; if (L >= (NT / BM) * 4) return false; u.pm = L >> 2; u.pn = 0; u.e = L & 3; return true; }
    __device__ __forceinline__ const char* bbase(const Unit& u) const { return Bt + (size_t)u.e * 512 * 2; }
    __device__ __forceinline__ void aoffs(const Unit& u, const int (&R)[2], const int (&C)[2], unsigned (&o)[4]) const {
#pragma unroll
        for (int h = 0; h < 2; ++h)
#pragma unroll
            for (int i = 0; i < 2; ++i) o[2 * h + i] = (unsigned)(((size_t)(u.pm * BM + h * HALF + R[i]) * ND + u.e * 512 + C[i]) * 2);
    }
};
struct EpiF32N64 {
    static constexpr bool PERM = false; static constexpr bool PERM2 = false; static constexpr unsigned SCALE_A = 0x7F7F7F7Fu;
    float* C;
    __device__ __forceinline__ void operator()(const f32x4 (&acc)[2][2][4][2], const Unit& u, int wr, int wc, int fr, int fq) const {
        if (wc >= 2) return;
        const int row0 = u.pm * BM + wr * 64 + fr, col0 = wc * 32 + 4 * fq;
#pragma unroll
        for (int ai = 0; ai < 2; ++ai)
#pragma unroll
            for (int m = 0; m < 4; ++m) { float* rowp = C + ((size_t)u.e * NT + row0 + ai * HALF + m * 16) * 64 + col0;
#pragma unroll
                for (int n = 0; n < 2; ++n) *(f32x4*)(rowp + n * 16) = acc[ai][0][m][n]; }
    }
};
struct EpiSwigluF8 {
    static constexpr bool PERM = true; static constexpr bool PERM2 = false; static constexpr unsigned SCALE_A = 0x7F7F7F7Fu;
    unsigned char* H; float inmul;
    __device__ __forceinline__ void operator()(const f32x4 (&acc)[2][2][4][2], const Unit& u, int wr, int wc, int fr, int fq) const {
        const int row0 = u.pm * BM + wr * 64 + fr, col0 = u.pn * 64 + wc * 16 + 4 * fq;
#pragma unroll
        for (int ai = 0; ai < 2; ++ai)
#pragma unroll
            for (int m = 0; m < 4; ++m) { unsigned char* rowp = H + (size_t)(row0 + ai * HALF + m * 16) * EFF + col0;
                float o[4];
#pragma unroll
                for (int j = 0; j < 4; ++j) { const float h1 = acc[ai][0][m][0][j] * inmul, h3 = acc[ai][0][m][1][j] * inmul; o[j] = __builtin_amdgcn_fmed3f(siluf_(h1) * h3 * 8.0f, -448.0f, 448.0f); }
                int w0 = __builtin_amdgcn_cvt_pk_fp8_f32(o[0], o[1], 0, false); w0 = __builtin_amdgcn_cvt_pk_fp8_f32(o[2], o[3], w0, true);
                *(unsigned*)rowp = (unsigned)w0; }
    }
};
struct EpiSwigluF8x2 {
    static constexpr bool PERM = true; static constexpr bool PERM2 = false; static constexpr unsigned SCALE_A = 0x79797979u;
    unsigned char* H; float inmul;
    __device__ __forceinline__ void operator()(const f32x4 (&acc)[2][2][4][2], const Unit& u, int wr, int wc, int fr, int fq) const {
        const int row0 = u.pm * BM + wr * 64 + fr, col0 = u.pn * 128 + wc * 16 + 4 * fq;
#pragma unroll
        for (int ai = 0; ai < 2; ++ai)
#pragma unroll
            for (int m = 0; m < 4; ++m) { unsigned char* rowp = H + (size_t)(row0 + ai * HALF + m * 16) * EFF + col0;
#pragma unroll
                for (int bj = 0; bj < 2; ++bj) { float o[4];
#pragma unroll
                    for (int j = 0; j < 4; ++j) { const float h1 = acc[ai][bj][m][0][j] * inmul, h3 = acc[ai][bj][m][1][j] * inmul; o[j] = __builtin_amdgcn_fmed3f(siluf_(h1) * h3 * 8.0f, -448.0f, 448.0f); }
                    int w0 = __builtin_amdgcn_cvt_pk_fp8_f32(o[0], o[1], 0, false); w0 = __builtin_amdgcn_cvt_pk_fp8_f32(o[2], o[3], w0, true);
                    *(unsigned*)(rowp + bj * 64) = (unsigned)w0; } }
    }
};
struct EpiBf16M {
    static constexpr bool PERM = true; static constexpr bool PERM2 = false; static constexpr unsigned SCALE_A = 0x79797979u;
    bf16* O; int ldc; float mul;
    __device__ __forceinline__ void operator()(const f32x4 (&acc)[2][2][4][2], const Unit& u, int wr, int wc, int fr, int fq) const {
        const int row0 = u.pm * BM + wr * 64 + fr, col0 = u.pn * BM + wc * 32 + 8 * fq;
#pragma unroll
        for (int ai = 0; ai < 2; ++ai)
#pragma unroll
            for (int m = 0; m < 4; ++m) { bf16* rowp = O + (size_t)(row0 + ai * HALF + m * 16) * ldc + col0;
#pragma unroll
                for (int bj = 0; bj < 2; ++bj) { const f32x4 v0 = acc[ai][bj][m][0] * mul, v1 = acc[ai][bj][m][1] * mul;
                    v4u w; w.x = cvt_pk_bf16(v0[0], v0[1]); w.y = cvt_pk_bf16(v0[2], v0[3]); w.z = cvt_pk_bf16(v1[0], v1[1]); w.w = cvt_pk_bf16(v1[2], v1[3]);
                    *(v4u*)(rowp + bj * HALF) = w; } }
    }
};
struct EpiBf16N128 {
    static constexpr bool PERM = true; static constexpr bool PERM2 = false; static constexpr unsigned SCALE_A = 0x7F7F7F7Fu;
    bf16* O; int ldc; float mul;
    __device__ __forceinline__ void operator()(const f32x4 (&acc)[2][2][4][2], const Unit& u, int wr, int wc, int fr, int fq) const {
        const int row0 = u.pm * BM + wr * 64 + fr, col0 = u.pn * HALF + wc * 32 + 8 * fq;
#pragma unroll
        for (int ai = 0; ai < 2; ++ai)
#pragma unroll
            for (int m = 0; m < 4; ++m) { bf16* rowp = O + (size_t)(row0 + ai * HALF + m * 16) * ldc + col0; const f32x4 v0 = acc[ai][0][m][0] * mul, v1 = acc[ai][0][m][1] * mul;
                v4u w; w.x = cvt_pk_bf16(v0[0], v0[1]); w.y = cvt_pk_bf16(v0[2], v0[3]); w.z = cvt_pk_bf16(v1[0], v1[1]); w.w = cvt_pk_bf16(v1[2], v1[3]);
                *(v4u*)rowp = w; }
    }
};
struct EpiFp8N128 {
    static constexpr bool PERM = true; static constexpr bool PERM2 = false; static constexpr unsigned SCALE_A = 0x7F7F7F7Fu;
    unsigned char* O; int ldc; float mul;
    __device__ __forceinline__ void operator()(const f32x4 (&acc)[2][2][4][2], const Unit& u, int wr, int wc, int fr, int fq) const {
        const int row0 = u.pm * BM + wr * 64 + fr, col0 = u.pn * HALF + wc * 32 + 8 * fq;
#pragma unroll
        for (int ai = 0; ai < 2; ++ai)
#pragma unroll
            for (int m = 0; m < 4; ++m) { unsigned char* rowp = O + (size_t)(row0 + ai * HALF + m * 16) * ldc + col0; float v[8];
#pragma unroll
                for (int n = 0; n < 2; ++n)
#pragma unroll
                    for (int j = 0; j < 4; ++j) v[n * 4 + j] = __builtin_amdgcn_fmed3f(acc[ai][0][m][n][j] * mul, -448.0f, 448.0f);
                int w0 = __builtin_amdgcn_cvt_pk_fp8_f32(v[0], v[1], 0, false); w0 = __builtin_amdgcn_cvt_pk_fp8_f32(v[2], v[3], w0, true);
                int w1 = __builtin_amdgcn_cvt_pk_fp8_f32(v[4], v[5], 0, false); w1 = __builtin_amdgcn_cvt_pk_fp8_f32(v[6], v[7], w1, true);
                *(v2u*)rowp = (v2u){(unsigned)w0, (unsigned)w1}; }
    }
};
}

struct Args { const float* in[27]; float* out; unsigned char* ws; int ph_lo, ph_hi; };
typedef const __attribute__((address_space(4))) Args* CArgs;
__device__ __forceinline__ const float* kin(int i) { CArgs p = (CArgs)__builtin_amdgcn_kernarg_segment_ptr(); asm volatile("" : "+s"(p)); return p->in[i]; }
struct Frame {
    LAS unsigned char* lds;
    volatile LAS unsigned* MISC;
    unsigned* ctl;
    unsigned char* ws;
    int tid, lane, wave, vcu, G, gw, NGW;
    float* out;
};

__device__ __forceinline__ void tr_item(const float* W, int ldw, int k0, int n0, int nvalid, bf16* WT, int ldt, int drow0, LAS float* scr, int lane) {
    float v[32]; const int n = lane & 31; const bool okn = n < nvalid; const float* src = W + (size_t)(k0 + (lane >> 5)) * ldw + n0 + n;
#pragma unroll
    for (int i = 0; i < 32; ++i) v[i] = okn ? src[(size_t)(2 * i) * ldw] : 0.f;
#pragma unroll
    for (int i = 0; i < 32; ++i) scr[(2 * i + (lane >> 5)) * 33 + n] = v[i];
    LDS_WAIT(); asm volatile("" ::: "memory");
    const int c = lane & 7;
#pragma unroll
    for (int j = 0; j < 4; ++j) { const int nn = (lane >> 3) + 8 * j; const LAS float* sp = scr + (8 * c) * 33 + nn;
        v4u o; o.x = pk2(sp[0 * 33], sp[1 * 33]); o.y = pk2(sp[2 * 33], sp[3 * 33]); o.z = pk2(sp[4 * 33], sp[5 * 33]); o.w = pk2(sp[6 * 33], sp[7 * 33]);
        if (nn < nvalid) *(v4u*)(WT + (size_t)(drow0 + nn) * ldt + k0 + 8 * c) = o; }
    LDS_WAIT(); asm volatile("" ::: "memory");
}
__device__ __forceinline__ void tr_item_f8(const float* W, int ldw, int k0, int n0, unsigned char* WT8, int ldt, int drow0, int rowmode, float mul, LAS float* scr, int lane, int nvalid = 32) {
    float v[32]; const int n = lane & 31; const float* src = W + (size_t)(k0 + (lane >> 5)) * ldw + n0 + n; const bool okn = n < nvalid;
#pragma unroll
    for (int i = 0; i < 32; ++i) v[i] = okn ? src[(size_t)(2 * i) * ldw] : 0.f;
#pragma unroll
    for (int i = 0; i < 32; ++i) scr[(2 * i + (lane >> 5)) * 33 + n] = v[i];
    LDS_WAIT(); asm volatile("" ::: "memory");
    const int c = lane & 3;
#pragma unroll
    for (int j = 0; j < 2; ++j) { const int nn = (lane >> 2) + 16 * j; const LAS float* sp = scr + (16 * c) * 33 + nn; int w[4];
#pragma unroll
        for (int q = 0; q < 4; ++q) { const float a0 = __builtin_amdgcn_fmed3f(sp[(4 * q + 0) * 33] * mul, -448.0f, 448.0f), a1 = __builtin_amdgcn_fmed3f(sp[(4 * q + 1) * 33] * mul, -448.0f, 448.0f),
                                                  a2 = __builtin_amdgcn_fmed3f(sp[(4 * q + 2) * 33] * mul, -448.0f, 448.0f), a3 = __builtin_amdgcn_fmed3f(sp[(4 * q + 3) * 33] * mul, -448.0f, 448.0f);
            w[q] = __builtin_amdgcn_cvt_pk_fp8_f32(a0, a1, 0, false); w[q] = __builtin_amdgcn_cvt_pk_fp8_f32(a2, a3, w[q], true); }
        const int drow = rowmode ? drow0 + (nn >> 2) * 8 + (nn & 3) : drow0 + nn;
        *(v4u*)(WT8 + (size_t)drow * ldt + k0 + 16 * c) = (v4u){(unsigned)w[0], (unsigned)w[1], (unsigned)w[2], (unsigned)w[3]}; }
    LDS_WAIT(); asm volatile("" ::: "memory");
}
__device__ __forceinline__ bool tr_matrix_f8(int& it, const float* W, int ldw, int K, int c0, int ncols, unsigned char* WT8, int drow0, int nrows_alloc, LAS float* scr, int lane) {
    const int nb = (ncols + 31) / 32, items = (K / 64) * nb;
    if (it >= items) { it -= items; return false; }
    const int kb = it / nb, b = it % nb, nv = ncols - 32 * b;
    (void)nrows_alloc;
    tr_item_f8(W, ldw, 64 * kb, c0 + 32 * b, WT8, K, drow0 + 32 * b, 0, 64.0f, scr, lane, nv < 32 ? nv : 32);
    return true;
}
__device__ __forceinline__ bool tr_matrix(int& it, const float* W, int ldw, int K, int c0, int ncols, bf16* WT, int drow0, LAS float* scr, int lane) {
    const int nb = (ncols + 31) / 32, items = (K / 64) * nb;
    if (it >= items) { it -= items; return false; }
    const int kb = it / nb, b = it % nb, nv = ncols - 32 * b;
    tr_item(W, ldw, 64 * kb, c0 + 32 * b, nv < 32 ? nv : 32, WT, K, drow0 + 32 * b, scr, lane);
    return true;
}
__device__ __forceinline__ void zero_rows(Frame& F, bf16* base, size_t nelem) {
    for (size_t i = ((size_t)F.gw * 64 + F.lane) * 8; i < nelem; i += (size_t)F.NGW * 64 * 8) *(v4u*)(base + i) = (v4u){0u, 0u, 0u, 0u};
}

__device__ __forceinline__ void p_prologue(Frame& F) {
    LAS float* scr = (LAS float*)(F.lds + F.wave * 16384);
    unsigned char* ws = F.ws;
    {
        LAS float* wl = (LAS float*)F.lds;
        LAS float* pl = (LAS float*)(F.lds + 32768);
        const float* w_in = kin(2); const float* pool_w = kin(3); const float* pscale = kin(4);
        bf16* WT = (bf16*)(ws + WS_WABIN);
        for (int it = blockIdx.x; it < 4 * 32; it += F.G) {
            const int g = it >> 5, k0 = (it & 31) * 64;
            for (int i = F.tid; i < 64 * 128; i += 512) wl[i] = w_in[(size_t)(k0 + (i >> 7)) * AB_IN + g * 128 + (i & 127)];
            for (int i = F.tid; i < 128 * 128; i += 512) pl[i] = pool_w[(size_t)g * 16384 + i];
            __syncthreads();
            const int d = F.tid & 127, kg = F.tid >> 7; const float sc = pscale[g * 128 + d];
            for (int kk = 0; kk < 16; kk += 8) {
                float a[8];
#pragma unroll
                for (int j = 0; j < 8; ++j) a[j] = 0.f;
                for (int c = 0; c < 128; ++c) { const float pw = pl[c * 128 + d];
#pragma unroll
                    for (int j = 0; j < 8; ++j) a[j] += wl[(kg * 16 + kk + j) * 128 + c] * pw; }
                if (MK_FP8_IN0) { float q[8];
#pragma unroll
                    for (int j = 0; j < 8; ++j) q[j] = __builtin_amdgcn_fmed3f(a[j] * sc * 64.0f, -448.0f, 448.0f);
                    int w0 = __builtin_amdgcn_cvt_pk_fp8_f32(q[0], q[1], 0, false); w0 = __builtin_amdgcn_cvt_pk_fp8_f32(q[2], q[3], w0, true);
                    int w1 = __builtin_amdgcn_cvt_pk_fp8_f32(q[4], q[5], 0, false); w1 = __builtin_amdgcn_cvt_pk_fp8_f32(q[6], q[7], w1, true);
                    *(v2u*)((unsigned char*)WT + (size_t)(g * 128 + d) * ND + k0 + kg * 16 + kk) = (v2u){(unsigned)w0, (unsigned)w1}; }
                else { v4u o; o.x = pk2(a[0] * sc, a[1] * sc); o.y = pk2(a[2] * sc, a[3] * sc); o.z = pk2(a[4] * sc, a[5] * sc); o.w = pk2(a[6] * sc, a[7] * sc);
                    *(v4u*)(WT + (size_t)(g * 128 + d) * ND + k0 + kg * 16 + kk) = o; }
            }
            __syncthreads();
        }
    }
    __syncthreads();
    for (int it0 = F.gw; ; it0 += F.NGW) {
        int it = it0;
        if (MK_FP8_IN0 ? tr_matrix_f8(it, kin(2), AB_IN, ND, 512, AB_IN - 512, ws + WS_WABIN, 512, AB_IN, scr, F.lane) : tr_matrix(it, kin(2), AB_IN, ND, 512, AB_IN - 512, (bf16*)(ws + WS_WABIN), 512, scr, F.lane)) continue;
        if (tr_matrix(it, kin(5), ND, ND, 0, ND, (bf16*)(ws + WS_WABOUT), 0, scr, F.lane)) continue;
        if (MK_FP8_IN1 ? tr_matrix_f8(it, kin(6), CD_IN, ND, 0, CD_IN, ws + WS_WCDIN, 0, CD_INP, scr, F.lane) : tr_matrix(it, kin(6), CD_IN, ND, 0, CD_IN, (bf16*)(ws + WS_WCDIN), 0, scr, F.lane)) continue;
        if (tr_matrix(it, kin(14), ND, ND, 0, ND, (bf16*)(ws + WS_WCDOUT), 0, scr, F.lane)) continue;
        if (tr_matrix(it, kin(11), 1536, 384, 0, 1536, (bf16*)(ws + WS_WUQ), 0, scr, F.lane)) continue;
        if (tr_matrix(it, kin(13), 2048, 512, 0, 2048, (bf16*)(ws + WS_WUKV), 0, scr, F.lane)) continue;
        if (tr_matrix(it, kin(8), 128, 4096, 0, 128, (bf16*)(ws + WS_CW1), 0, scr, F.lane)) continue;
        if (tr_matrix(it, kin(8) + (size_t)4096 * 128, 128, 4096, 0, 128, (bf16*)(ws + WS_CW1), 128, scr, F.lane)) continue;
        break;
    }
    if (MK_FP8_IN1) zero_rows(F, (bf16*)(ws + WS_WCDIN + (size_t)3552 * ND), (size_t)(CD_INP - 3552) * ND / 2);
    else zero_rows(F, (bf16*)(ws + WS_WCDIN) + (size_t)CD_IN * ND, (size_t)(CD_INP - CD_IN) * ND);
    { const float* x = kin(0); bf16* xb = (bf16*)(ws + WS_XB0); const size_t stride = (size_t)F.NGW * 64 * 8;
      for (size_t i = ((size_t)F.gw * 64 + F.lane) * 8; i < (size_t)NT * ND; i += 4 * stride) {
          f32x4 a[4], c[4];
#pragma unroll
          for (int u = 0; u < 4; ++u) if (i + u * stride < (size_t)NT * ND) { a[u] = *(const f32x4*)(x + i + u * stride); c[u] = *(const f32x4*)(x + i + u * stride + 4); }
#pragma unroll
          for (int u = 0; u < 4; ++u) if (i + u * stride < (size_t)NT * ND) { v4u o; o.x = pk2(a[u][0], a[u][1]); o.y = pk2(a[u][2], a[u][3]); o.z = pk2(c[u][0], c[u][1]); o.w = pk2(c[u][2], c[u][3]); *(v4u*)(xb + i + u * stride) = o;
              if (MK_FP8_IN0) { int w0 = __builtin_amdgcn_cvt_pk_fp8_f32(a[u][0], a[u][1], 0, false); w0 = __builtin_amdgcn_cvt_pk_fp8_f32(a[u][2], a[u][3], w0, true);
                  int w1 = __builtin_amdgcn_cvt_pk_fp8_f32(c[u][0], c[u][1], 0, false); w1 = __builtin_amdgcn_cvt_pk_fp8_f32(c[u][2], c[u][3], w1, true);
                  *(v2u*)(ws + WS_X1F8 + i + u * stride) = (v2u){(unsigned)w0, (unsigned)w1}; } } } }
    for (int o = F.gw; o < 128; o += F.NGW) { const int kv = o >> 6, fc = o & 63; const float* pos = kin(7) + (size_t)kv * 4096 + fc * 64; const float* w1 = kin(8) + ((size_t)kv * 4096 + fc * 64) * 128;
        float s0 = 0.f, s1 = 0.f;
#pragma unroll 8
        for (int f = 0; f < 64; ++f) { const float pf_ = pos[f]; const f32x2 wv = *(const f32x2*)(w1 + (size_t)f * 128 + F.lane * 2); s0 += pf_ * wv[0]; s1 += pf_ * wv[1]; }
        *(f32x2*)((float*)(ws + WS_CMPB) + 256 + (size_t)o * 128 + F.lane * 2) = (f32x2){s0, s1}; }
}
__device__ __forceinline__ void cmp_bias_finish(Frame& F) {
    if (blockIdx.x == 0 && F.tid < 256) { const int kv = F.tid >> 7, h = F.tid & 127; const float* part = (const float*)(F.ws + WS_CMPB) + 256 + (size_t)kv * 64 * 128 + h;
        float sacc = 0.f; for (int fc = 0; fc < 64; ++fc) sacc += part[fc * 128];
        ((float*)(F.ws + WS_CMPB))[F.tid] = sacc; }
}
constexpr int MW_ITEMS_L = 65 * 1536 + 64;
__device__ __forceinline__ void moe_weight_item(int l, int it, unsigned char* ws, LAS float* scr, int lane) {
    bf16* W13 = (bf16*)(ws + WS_W13 + (size_t)l * WS_MOE_LSTRIDE); bf16* W2 = (bf16*)(ws + WS_W2 + (size_t)l * WS_MOE_LSTRIDE); bf16* RT = (bf16*)(ws + WS_RT + (size_t)l * MiB);
    if (it >= 65 * 1536) { const int r = it - 65 * 1536, kb = r >> 1, b = r & 1;
        tr_item(kin(19) + (size_t)l * ND * NEXP, NEXP, 64 * kb, 32 * b, 32, RT, ND, 32 * b, scr, lane); return; }
    const int e = it / 1536, r = it % 1536;
    const float *w1, *w3, *w2;
    if (e < NEXP) { const size_t o = ((size_t)l * NEXP + e) * ND * EFF; w1 = kin(21) + o; w3 = kin(22) + o; w2 = kin(23) + o; }
    else { const size_t o = (size_t)l * ND * EFF; w1 = kin(24) + o; w3 = kin(25) + o; w2 = kin(26) + o; }
    if (r < 1024) { const int which = r >> 9, rr = r & 511, kb = rr >> 4, nb = rr & 15;
        const int j = nb >> 2, drow = j * 256 + which * 128 + (nb & 3) * 32;
        if (MK_FP8_MOE) tr_item_f8(which ? w3 : w1, EFF, 64 * kb, 32 * nb, (unsigned char*)W13 + (size_t)e * 1024 * ND, ND, (nb >> 1) * 128 + (nb & 1) * 64 + which * 4, 1, 64.0f, scr, lane);
        else tr_item(which ? w3 : w1, EFF, 64 * kb, 32 * nb, 32, W13 + (size_t)e * 1024 * ND, ND, drow, scr, lane); }
    else { const int rr = r - 1024, kb = rr >> 6, nb = rr & 63;
        if (MK_FP8_MOE) tr_item_f8(w2, ND, 64 * kb, 32 * nb, (unsigned char*)W2 + (size_t)e * ND * EFF, EFF, 32 * nb, 0, 64.0f, scr, lane);
        else tr_item(w2, ND, 64 * kb, 32 * nb, 32, W2 + (size_t)e * ND * EFF, EFF, 32 * nb, scr, lane); }
}
struct ConvDesc { const float* src; unsigned char* dst; int ldw, ldt, k0, drow0, rowmode, kind; };
__device__ __forceinline__ ConvDesc conv_desc(int id, unsigned char* ws) {
    ConvDesc d; d.kind = -1; d.src = nullptr; d.dst = nullptr; d.ldw = 0; d.ldt = 0; d.k0 = 0; d.drow0 = 0; d.rowmode = 0;
    if (id >= 2 * MW_ITEMS_L) return d;
    const int l = id >= MW_ITEMS_L ? 1 : 0, it = id - l * MW_ITEMS_L;
    if (it >= 65 * 1536 || !MK_FP8_MOE) { d.kind = 1; d.k0 = it; d.drow0 = l; return d; }
    const int e = it / 1536, r = it % 1536;
    const float *w1, *w3, *w2;
    if (e < NEXP) { const size_t o = ((size_t)l * NEXP + e) * ND * EFF; w1 = kin(21) + o; w3 = kin(22) + o; w2 = kin(23) + o; }
    else { const size_t o = (size_t)l * ND * EFF; w1 = kin(24) + o; w3 = kin(25) + o; w2 = kin(26) + o; }
    d.kind = 0;
    if (r < 1024) { const int which = r >> 9, rr = r & 511, kb = rr >> 4, nb = rr & 15;
        d.src = (which ? w3 : w1) + (size_t)(64 * kb) * EFF + 32 * nb; d.ldw = EFF; d.k0 = 64 * kb;
        d.dst = ws + WS_W13 + (size_t)l * WS_MOE_LSTRIDE + (size_t)e * 1024 * ND; d.ldt = ND; d.drow0 = (nb >> 1) * 128 + (nb & 1) * 64 + which * 4; d.rowmode = 1; }
    else { const int rr = r - 1024, kb = rr >> 6, nb = rr & 63;
        d.src = w2 + (size_t)(64 * kb) * ND + 32 * nb; d.ldw = ND; d.k0 = 64 * kb;
        d.dst = ws + WS_W2 + (size_t)l * WS_MOE_LSTRIDE + (size_t)e * ND * EFF; d.ldt = EFF; d.drow0 = 32 * nb; d.rowmode = 0; }
    return d;
}
__device__ __forceinline__ void conv_load(const ConvDesc& d, float (&v)[32], int lane) {
    if (d.kind != 0) return;
    const float* src = d.src + (size_t)(lane >> 5) * d.ldw + (lane & 31);
#pragma unroll
    for (int i = 0; i < 32; ++i) v[i] = src[(size_t)(2 * i) * d.ldw];
}
__device__ __forceinline__ void conv_finish(const ConvDesc& d, const float (&v)[32], unsigned char* ws, LAS float* scr, int lane) {
    if (d.kind == 1) { moe_weight_item(d.drow0, d.k0, ws, scr, lane); return; }
    if (d.kind != 0) return;
    const int n = lane & 31;
#pragma unroll
    for (int i = 0; i < 32; ++i) scr[(2 * i + (lane >> 5)) * 33 + n] = v[i];
    LDS_WAIT(); asm volatile("" ::: "memory");
    const int c = lane & 3;
#pragma unroll
    for (int j = 0; j < 2; ++j) { const int nn = (lane >> 2) + 16 * j; const LAS float* sp = scr + (16 * c) * 33 + nn; int w[4];
#pragma unroll
        for (int q = 0; q < 4; ++q) { const float a0 = __builtin_amdgcn_fmed3f(sp[(4 * q + 0) * 33] * 64.0f, -448.0f, 448.0f), a1 = __builtin_amdgcn_fmed3f(sp[(4 * q + 1) * 33] * 64.0f, -448.0f, 448.0f),
                                                  a2 = __builtin_amdgcn_fmed3f(sp[(4 * q + 2) * 33] * 64.0f, -448.0f, 448.0f), a3 = __builtin_amdgcn_fmed3f(sp[(4 * q + 3) * 33] * 64.0f, -448.0f, 448.0f);
            w[q] = __builtin_amdgcn_cvt_pk_fp8_f32(a0, a1, 0, false); w[q] = __builtin_amdgcn_cvt_pk_fp8_f32(a2, a3, w[q], true); }
        const int drow = d.rowmode ? d.drow0 + (nn >> 2) * 8 + (nn & 3) : d.drow0 + nn;
        *(v4u*)(d.dst + (size_t)drow * d.ldt + d.k0 + 16 * c) = (v4u){(unsigned)w[0], (unsigned)w[1], (unsigned)w[2], (unsigned)w[3]}; }
    LDS_WAIT(); asm volatile("" ::: "memory");
}
__device__ __forceinline__ void p_moe_weights_queue(Frame& F, unsigned* queue) {
    LAS float* scr = (LAS float*)(F.lds + F.wave * 16384);
    constexpr int BATCH = 16, NB_ = (2 * MW_ITEMS_L + BATCH - 1) / BATCH;
    for (;;) {
        unsigned bq = 0; if (F.lane == 0) bq = atomicAdd(queue, 1u);
        const int bi = __builtin_amdgcn_readfirstlane((int)bq);
        if (bi >= NB_) break;
        const int s0 = bi * BATCH;
        float va[32], vb[32];
        ConvDesc dA = conv_desc(s0, F.ws); conv_load(dA, va, F.lane);
        for (int k = 0; k < BATCH; k += 2) {
            ConvDesc dB = conv_desc(s0 + k + 1, F.ws); conv_load(dB, vb, F.lane);
            conv_finish(dA, va, F.ws, scr, F.lane);
            dA = conv_desc(k + 2 < BATCH ? s0 + k + 2 : 2 * MW_ITEMS_L, F.ws); conv_load(dA, va, F.lane);
            conv_finish(dB, vb, F.ws, scr, F.lane);
        }
    }
    for (int l = 0; l < 2; ++l) zero_rows(F, (bf16*)(F.ws + WS_RT + (size_t)l * MiB) + (size_t)NEXP * ND, (size_t)(256 - NEXP) * ND);
}

__device__ __forceinline__ void ln_finish(float (&v)[4][8], const float* g, const float* b, int lane, bf16* ob, float* of, unsigned char* o8 = nullptr) {
    float s = 0.f;
#pragma unroll
    for (int j = 0; j < 4; ++j)
#pragma unroll
        for (int i = 0; i < 8; ++i) s += v[j][i];
    const float mean = wave_sum(s) * (1.f / ND); float s2 = 0.f;
#pragma unroll
    for (int j = 0; j < 4; ++j)
#pragma unroll
        for (int i = 0; i < 8; ++i) { v[j][i] -= mean; s2 += v[j][i] * v[j][i]; }
    const float rstd = 1.f / sqrtf(wave_sum(s2) * (1.f / ND) + LN_EPS);
#pragma unroll
    for (int j = 0; j < 4; ++j) { unsigned c0 = (unsigned)(j * 64 + lane) * 8u; asm volatile("" : "+v"(c0));
        const f32x4 g0 = *(const f32x4*)((const char*)g + c0 * 4u), g1 = *(const f32x4*)((const char*)g + c0 * 4u + 16u), b0 = *(const f32x4*)((const char*)b + c0 * 4u), b1 = *(const f32x4*)((const char*)b + c0 * 4u + 16u);
        float o[8];
#pragma unroll
        for (int i = 0; i < 4; ++i) { o[i] = v[j][i] * rstd * g0[i] + b0[i]; o[4 + i] = v[j][4 + i] * rstd * g1[i] + b1[i]; }
        if (ob) { v4u w; w.x = pk2(o[0], o[1]); w.y = pk2(o[2], o[3]); w.z = pk2(o[4], o[5]); w.w = pk2(o[6], o[7]); *(v4u*)((char*)ob + c0 * 2u) = w; }
        if (of) { *(f32x4*)((char*)of + c0 * 4u) = (f32x4){o[0], o[1], o[2], o[3]}; *(f32x4*)((char*)of + c0 * 4u + 16u) = (f32x4){o[4], o[5], o[6], o[7]}; }
        if (o8) { int w0 = __builtin_amdgcn_cvt_pk_fp8_f32(o[0], o[1], 0, false); w0 = __builtin_amdgcn_cvt_pk_fp8_f32(o[2], o[3], w0, true);
            int w1 = __builtin_amdgcn_cvt_pk_fp8_f32(o[4], o[5], 0, false); w1 = __builtin_amdgcn_cvt_pk_fp8_f32(o[6], o[7], w1, true);
            *(v2u*)(o8 + c0) = (v2u){(unsigned)w0, (unsigned)w1}; } }
}
__device__ __forceinline__ void p_ln1(Frame& F, const bf16* xin, const bf16* mixo, const float* g, const float* b, bf16* xo, unsigned char* xo8) {
    for (int m = F.gw; m < NT; m += F.NGW) {
        float v[4][8];
#pragma unroll
        for (int j = 0; j < 4; ++j) { const size_t o = (size_t)m * ND + (j * 64 + F.lane) * 8; float a[8], c[8]; unpack8(*(const v4u*)(xin + o), a); unpack8(*(const v4u*)(mixo + o), c);
#pragma unroll
            for (int i = 0; i < 8; ++i) v[j][i] = DN_ALPHA * a[i] + c[i]; }
        ln_finish(v, g, b, F.lane, xo + (size_t)m * ND, nullptr, xo8 ? xo8 + (size_t)m * ND : nullptr);
    }
}
__device__ __forceinline__ void unpack8_fp8(const v2u w, float (&f)[8]) {
    const f32x2 a = __builtin_amdgcn_cvt_pk_f32_fp8((int)w.x, false), b = __builtin_amdgcn_cvt_pk_f32_fp8((int)w.x, true), c = __builtin_amdgcn_cvt_pk_f32_fp8((int)w.y, false), d = __builtin_amdgcn_cvt_pk_f32_fp8((int)w.y, true);
    f[0] = a[0]; f[1] = a[1]; f[2] = b[0]; f[3] = b[1]; f[4] = c[0]; f[5] = c[1]; f[6] = d[0]; f[7] = d[1];
}
__device__ __forceinline__ void p_combine_ln2(Frame& F, const LAS int* tab, const bf16* x1, const unsigned char* y2, const int* slot, const float* wsel, const float* g, const float* b, bf16* xo, float* fo, unsigned char* xo8) {
    for (int m = F.gw; m < NT; m += F.NGW) {
        const int mysl = slot[m * 8 + (F.lane & 7)]; const int myrow = tab[mysl >> 16] + (mysl & 0xFFFF); const float myw = wsel[m * 8 + (F.lane & 7)] * (1.0f / 16.0f);
        float v[4][8];
        { v4u xa[4]; v2u sa[4];
#pragma unroll
          for (int j = 0; j < 4; ++j) { xa[j] = *(const v4u*)(x1 + (size_t)m * ND + (j * 64 + F.lane) * 8); sa[j] = *(const v2u*)(y2 + (size_t)(SH_ROW0 + m) * ND + (j * 64 + F.lane) * 8); }
#pragma unroll
          for (int j = 0; j < 4; ++j) { float a[8], c[8]; unpack8(xa[j], a); unpack8_fp8(sa[j], c);
#pragma unroll
              for (int i = 0; i < 8; ++i) v[j][i] = DN_ALPHA * a[i] + c[i] * (1.0f / 16.0f); } }
#pragma unroll
        for (int kg = 0; kg < 2; ++kg) { v2u ra[4][4]; float wk[4];
#pragma unroll
            for (int k = 0; k < 4; ++k) { const int row = __builtin_amdgcn_readlane(myrow, kg * 4 + k); wk[k] = __builtin_bit_cast(float, __builtin_amdgcn_readlane(__builtin_bit_cast(int, myw), kg * 4 + k));
#pragma unroll
                for (int j = 0; j < 4; ++j) ra[k][j] = *(const v2u*)(y2 + (size_t)row * ND + (j * 64 + F.lane) * 8); }
#pragma unroll
            for (int k = 0; k < 4; ++k)
#pragma unroll
                for (int j = 0; j < 4; ++j) { float c[8]; unpack8_fp8(ra[k][j], c);
#pragma unroll
                    for (int i = 0; i < 8; ++i) v[j][i] += wk[k] * c[i]; } }
        ln_finish(v, g, b, F.lane, xo ? xo + (size_t)m * ND : nullptr, fo ? fo + (size_t)m * ND : nullptr, xo8 ? xo8 + (size_t)m * ND : nullptr);
    }
}

__device__ __forceinline__ void p_pool(Frame& F, int wid, int nw) {
    const bf16* proj = (const bf16*)(F.ws + WS_PROJ); bf16* mixin = (bf16*)(F.ws + WS_MIXIN);
    for (int m = wid; m < NT; m += nw) {
        const int s = m & (NS - 1);
        const int g = F.lane >> 4, w = 2 << g; const int lo = (s + 1 - w) > 0 ? (s + 1 - w) : 0; const float cnt = (float)((s + 1) < w ? (s + 1) : w);
        float acc[8], cur[8];
#pragma unroll
        for (int i = 0; i < 8; ++i) acc[i] = 0.f;
        for (int j = lo; j <= s; ++j) { float t[8]; unpack8(*(const v4u*)(proj + (size_t)(m - s + j) * AB_IN + F.lane * 8), t);
#pragma unroll
            for (int i = 0; i < 8; ++i) acc[i] += t[i]; }
        unpack8(*(const v4u*)(proj + (size_t)m * AB_IN + F.lane * 8), cur);
        float o[8];
#pragma unroll
        for (int i = 0; i < 8; ++i) o[i] = acc[i] / cnt - cur[i];
        v4u wv; wv.x = pk2(o[0], o[1]); wv.y = pk2(o[2], o[3]); wv.z = pk2(o[4], o[5]); wv.w = pk2(o[6], o[7]); *(v4u*)(mixin + (size_t)m * ND + F.lane * 8) = wv;
    }
}
namespace ret {
typedef short v4i16_t __attribute__((ext_vector_type(4)));
constexpr int PITCH = 272, TILE = 128 * PITCH;
__device__ __forceinline__ bf16x8 trfrag(LAS unsigned char* trb, int r0, int r1, int c0) {
    const v4i16_t a = __builtin_amdgcn_ds_read_tr16_b64_v4i16((LAS v4i16_t*)(trb + r0 * PITCH + c0 * 2));
    const v4i16_t b = __builtin_amdgcn_ds_read_tr16_b64_v4i16((LAS v4i16_t*)(trb + r1 * PITCH + c0 * 2));
    return (bf16x8){a[0], a[1], a[2], a[3], b[0], b[1], b[2], b[3]};
}
}
__device__ __forceinline__ void p_retention_mfma(Frame& F, int bh) {
    const bf16* proj = (const bf16*)(F.ws + WS_PROJ); bf16* mixin = (bf16*)(F.ws + WS_MIXIN); const int* posv = (const int*)kin(1);
    constexpr int P = ret::PITCH;
    LAS unsigned char* KT = F.lds; LAS unsigned char* VT = F.lds + ret::TILE; LAS unsigned char* ST = F.lds + 2 * ret::TILE;
    const int b = bh / 6, h = bh % 6, w = F.wave, lane = F.lane, i16 = lane & 15, g = lane >> 4, q4 = (lane & 15) >> 2, p4 = lane & 3;
    const float lg = log2f(1.0f - exp2f(-5.0f - (float)h)), gc = exp2f(128.f * lg);
    const int rowb = i16 * P + 16 * g;
    const int trl = q4 * P + 8 * p4;
    LAS unsigned char* const trV4 = VT + trl + 4 * g * P;
    LAS unsigned char* const trV8 = VT + trl + 8 * g * P;
    LAS unsigned char* const trK8 = KT + trl + 8 * g * P;
    f32x4 T[2][8];
#pragma unroll
    for (int a = 0; a < 2; ++a)
#pragma unroll
        for (int d = 0; d < 8; ++d) T[a][d] = (f32x4){0.f, 0.f, 0.f, 0.f};
    const int srow = F.tid >> 2, scb = (F.tid & 3) * 4;
    for (int n = 0; n < NS / 128; ++n) {
        const size_t m0 = (size_t)b * NS + n * 128;
        v4u vpre[4];
#pragma unroll
        for (int c = 0; c < 4; ++c) vpre[c] = *(const v4u*)(proj + (m0 + srow) * AB_IN + 2048 + h * 256 + (scb + c) * 8);
        {
          const float fk = exp2f(-(float)srow * lg) * 0.08838834764831845f, pz = (float)posv[m0 + srow]; const int t4 = F.tid & 3;
          const bf16* krow = proj + (m0 + srow) * AB_IN + 1280 + h * 128;
#pragma unroll
          for (int c = 0; c < 2; ++c) { const int c8 = 2 * t4 + c; float x1[8], x2[8];
              unpack8(*(const v4u*)(krow + c8 * 8), x1); unpack8(*(const v4u*)(krow + 64 + c8 * 8), x2);
#pragma unroll
              for (int j = 0; j < 8; ++j) { const float invf = exp2f(-(float)(c8 * 8 + j) * (13.287712379549449f / 64.f)); float sn, cs; fast_sincos(pz * invf, sn, cs);
                  const float a = (x1[j] * cs - x2[j] * sn) * fk, bq = (x1[j] * sn + x2[j] * cs) * fk; x1[j] = a; x2[j] = bq; }
              v4u o; o.x = pk2(x1[0], x1[1]); o.y = pk2(x1[2], x1[3]); o.z = pk2(x1[4], x1[5]); o.w = pk2(x1[6], x1[7]); *(LAS v4u*)(KT + srow * P + c8 * 16) = o;
              o.x = pk2(x2[0], x2[1]); o.y = pk2(x2[2], x2[3]); o.z = pk2(x2[4], x2[5]); o.w = pk2(x2[6], x2[7]); *(LAS v4u*)(KT + srow * P + (c8 + 8) * 16) = o; } }
        bf16x8 qf[4], pf[4]; float rs[4] = {0.f, 0.f, 0.f, 0.f}, rq[4] = {0.f, 0.f, 0.f, 0.f};
        {
          const float fq = exp2f((float)(16 * w + i16) * lg), pz = (float)posv[m0 + 16 * w + i16];
          const bf16* qrow = proj + (m0 + 16 * w + i16) * AB_IN + 512 + h * 128;
#pragma unroll
          for (int ks = 0; ks < 2; ++ks) { float x1[8], x2[8]; unpack8(*(const v4u*)(qrow + 32 * ks + 8 * g), x1); unpack8(*(const v4u*)(qrow + 64 + 32 * ks + 8 * g), x2);
#pragma unroll
              for (int j = 0; j < 8; ++j) { const float invf = exp2f(-(float)(32 * ks + 8 * g + j) * (13.287712379549449f / 64.f)); float sn, cs; fast_sincos(pz * invf, sn, cs);
                  const float a = (x1[j] * cs - x2[j] * sn) * fq, bq = (x1[j] * sn + x2[j] * cs) * fq; x1[j] = a; x2[j] = bq; }
              v4u o; o.x = pk2(x1[0], x1[1]); o.y = pk2(x1[2], x1[3]); o.z = pk2(x1[4], x1[5]); o.w = pk2(x1[6], x1[7]); qf[ks] = __builtin_bit_cast(bf16x8, o);
              o.x = pk2(x2[0], x2[1]); o.y = pk2(x2[2], x2[3]); o.z = pk2(x2[4], x2[5]); o.w = pk2(x2[6], x2[7]); qf[ks + 2] = __builtin_bit_cast(bf16x8, o); } }
#pragma unroll
        for (int hv = 0; hv < 2; ++hv) {
            if (hv == 1) __syncthreads();
#pragma unroll
            for (int c = 0; c < 4; ++c) { const int c8 = scb + c; *(LAS v4u*)(VT + srow * P + c8 * 16) = vpre[c]; }
            if (hv == 0) {
#pragma unroll
                for (int c = 0; c < 4; ++c) vpre[c] = *(const v4u*)(proj + (m0 + srow) * AB_IN + 2048 + h * 256 + 128 + (scb + c) * 8); }
            { LAS unsigned char* stw = ST + (16 * w + 4 * g) * P + i16 * 2;
#pragma unroll
              for (int dt = 0; dt < 8; ++dt)
#pragma unroll
                for (int r = 0; r < 4; ++r) { T[hv][dt][r] *= gc; *(LAS bf16*)(stw + r * P + dt * 32) = (bf16)f2bf(T[hv][dt][r]); } }
            __syncthreads();
            if (hv == 0) {
                f32x4 sc[8];
#pragma unroll
                for (int mt = 0; mt < 8; ++mt) { sc[mt] = (f32x4){0.f, 0.f, 0.f, 0.f};
                    if (mt <= w) {
#pragma unroll
                        for (int ks = 0; ks < 4; ++ks) { const bf16x8 kf = *(const LAS bf16x8*)(KT + rowb + mt * 16 * P + ks * 64); sc[mt] = __builtin_amdgcn_mfma_f32_16x16x32_bf16(kf, qf[ks], sc[mt], 0, 0, 0); }
                        if (mt == w) {
#pragma unroll
                            for (int r = 0; r < 4; ++r) sc[mt][r] = (4 * g + r <= i16) ? sc[mt][r] : 0.f; } } }
#pragma unroll
                for (int k2 = 0; k2 < 4; ++k2) { v4u wv; wv.x = pk2(sc[2 * k2][0], sc[2 * k2][1]); wv.y = pk2(sc[2 * k2][2], sc[2 * k2][3]); wv.z = pk2(sc[2 * k2 + 1][0], sc[2 * k2 + 1][1]); wv.w = pk2(sc[2 * k2 + 1][2], sc[2 * k2 + 1][3]);
                    pf[k2] = __builtin_bit_cast(bf16x8, wv); }
            }
#pragma unroll
            for (int nt = 0; nt < 8; ++nt) { f32x4 acc = (f32x4){0.f, 0.f, 0.f, 0.f};
#pragma unroll
                for (int k2 = 0; k2 < 4; ++k2) if (2 * k2 <= w) { const bf16x8 vf = ret::trfrag(trV4, 32 * k2, 32 * k2 + 16, 16 * nt); acc = __builtin_amdgcn_mfma_f32_16x16x32_bf16(pf[k2], vf, acc, 0, 0, 0); }
#pragma unroll
                for (int ks = 0; ks < 4; ++ks) { const bf16x8 sf = *(const LAS bf16x8*)(ST + rowb + nt * 16 * P + ks * 64); acc = __builtin_amdgcn_mfma_f32_16x16x32_bf16(qf[ks], sf, acc, 0, 0, 0); }
#pragma unroll
                for (int r = 0; r < 4; ++r) { rs[r] += acc[r]; rq[r] += acc[r] * acc[r]; mixin[(m0 + 16 * w + 4 * g + r) * ND + 512 + h * 256 + hv * 128 + 16 * nt + i16] = (bf16)f2bf(acc[r]); } }
#pragma unroll
            for (int ks = 0; ks < 4; ++ks) { const bf16x8 af = ret::trfrag(trV8, 32 * ks, 32 * ks + 4, 16 * w);
#pragma unroll
                for (int dt = 0; dt < 8; ++dt) { const bf16x8 bfr = ret::trfrag(trK8, 32 * ks, 32 * ks + 4, 16 * dt); T[hv][dt] = __builtin_amdgcn_mfma_f32_16x16x32_bf16(af, bfr, T[hv][dt], 0, 0, 0); } }
        }
#pragma unroll
        for (int r = 0; r < 4; ++r) { float sm = rs[r], s2 = rq[r];
            sm += __shfl_xor(sm, 1); sm += __shfl_xor(sm, 2); sm += __shfl_xor(sm, 4); sm += __shfl_xor(sm, 8);
            s2 += __shfl_xor(s2, 1); s2 += __shfl_xor(s2, 2); s2 += __shfl_xor(s2, 4); s2 += __shfl_xor(s2, 8);
            const float mean = sm * (1.f / 256.f); const float var = fmaxf(s2 * (1.f / 256.f) - mean * mean, 0.f);
            const float rstd = 1.f / sqrtf(var + NORM_EPS);
            const size_t m = m0 + 16 * w + 4 * g + r;
#pragma unroll
            for (int t = 0; t < 16; ++t) { bf16* yp = mixin + m * ND + 512 + h * 256 + 16 * t + i16; const float gt = bf1(proj[m * AB_IN + 3584 + h * 256 + 16 * t + i16]);
                *yp = (bf16)f2bf((bf1(*yp) - mean) * rstd * siluf_(gt)); } }
        __syncthreads();
    }
}

__device__ __forceinline__ void p_route(Frame& F, int l) {
    const float* logits = (const float*)(F.ws + WS_LOGITS); const float* rbias = kin(20) + l * NEXP;
    int* tope = (int*)(F.ws + WS_TOPE); float* wsel = (float*)(F.ws + WS_WSEL); int* posb = (int*)(F.ws + WS_SLOT); unsigned* cnt = F.ctl + CW_CNT + l * 64; int* sorted2 = (int*)(F.ws + WS_SORTED2);
    LAS unsigned* lcnt = (LAS unsigned*)F.lds; LAS unsigned* lbase = lcnt + 64; LAS int* le = (LAS int*)(lcnt + 128); LAS unsigned* lp = (LAS unsigned*)(lcnt + 128 + 512);
    const float bias = rbias[F.lane]; const int lane = F.lane;
    for (int chunk = blockIdx.x; chunk < NT / 64; chunk += F.G) {
        __syncthreads();
        if (F.tid < 64) lcnt[F.tid] = 0u;
        __syncthreads();
        float lgv[8];
#pragma unroll
        for (int t = 0; t < 8; ++t) { const int m = chunk * 64 + F.wave * 8 + t;
            lgv[t] = (logits[(size_t)m * 64 + lane] + logits[((size_t)NT + m) * 64 + lane]) + (logits[((size_t)2 * NT + m) * 64 + lane] + logits[((size_t)3 * NT + m) * 64 + lane]); }
#pragma unroll
        for (int t = 0; t < 8; ++t) {
            const int tl = F.wave * 8 + t, m = chunk * 64 + tl;
            const float lg = lgv[t];
            const float sc = sigmoidf_(lg), bi = sc + bias;
            const int grp = lane >> 3;
            int rk = 0;
#pragma unroll
            for (int j = 1; j < 8; ++j) { const int o = lane ^ j; const float ov = __shfl_xor(bi, j); rk += ((ov > bi) || (ov == bi && o < lane)) ? 1 : 0; }
            float gs = rk < 2 ? bi : 0.f; gs += __shfl_xor(gs, 1); gs += __shfl_xor(gs, 2); gs += __shfl_xor(gs, 4);
            int grk = 0;
#pragma unroll
            for (int gg = 0; gg < 8; ++gg) { const float ov = __builtin_bit_cast(float, __builtin_amdgcn_readlane(__builtin_bit_cast(int, gs), gg * 8)); grk += (gg != grp && ((ov > gs) || (ov == gs && gg < grp))) ? 1 : 0; }
            const float mv = grk < 4 ? bi : -1e30f;
            int erk = 0;
#pragma unroll 16
            for (int j = 0; j < 64; ++j) { const float ov = __builtin_bit_cast(float, __builtin_amdgcn_readlane(__builtin_bit_cast(int, mv), j)); erk += ((ov > mv) || (ov == mv && j < lane)) ? 1 : 0; }
            const bool sel = erk < 8;
            const float wsum = wave_sum(sel ? sc : 0.f);
            if (sel) { const unsigned q = __hip_atomic_fetch_add(lcnt + lane, 1u, __ATOMIC_RELAXED, __HIP_MEMORY_SCOPE_WORKGROUP);
                tope[m * 8 + erk] = lane; wsel[m * 8 + erk] = sc / wsum * 2.5f; le[tl * 8 + erk] = lane; lp[tl * 8 + erk] = q; }
        }
        __syncthreads();
        if (F.tid < 64) lbase[F.tid] = atomicAdd(&cnt[F.tid], lcnt[F.tid]);
        __syncthreads();
        { const int e = le[F.tid]; const int pos = (int)(lbase[e] + lp[F.tid]);
          posb[chunk * 512 + F.tid] = (e << 16) | pos; sorted2[(size_t)e * NT + pos] = chunk * 64 + (F.tid >> 3); }
    }
}
__device__ __forceinline__ void load_offsets(Frame& F, int l) {
    volatile LAS int* tab = (volatile LAS int*)(F.lds + TAB_OFF);
    __syncthreads();
    if (F.tid < NEXP) {
        int c = (int)__hip_atomic_load(F.ctl + CW_CNT + l * 64 + F.tid, __ATOMIC_RELAXED, __HIP_MEMORY_SCOPE_AGENT); if (c > NT) c = NT;
        const int ntl = (c + 255) >> 8; int incl = ntl;
#pragma unroll
        for (int d = 1; d < 64; d <<= 1) { const int o = __shfl_up(incl, d); if (F.tid >= d) incl += o; }
        const int excl = incl - ntl;
        tab[F.tid] = excl << 8; tab[66 + F.tid] = c;
        for (int t = 0; t < ntl; ++t) if (excl + t < MAXTILES) tab[160 + excl + t] = F.tid;
        if (F.tid == NEXP - 1) { tab[64] = incl << 8; tab[65] = incl; }
    }
    __syncthreads();
}
__device__ __forceinline__ void p_scatter(Frame& F, int l) {
    load_offsets(F, l);
    const LAS int* tab = (const LAS int*)(F.lds + TAB_OFF);
    const int* tope = (const int*)(F.ws + WS_TOPE); int* slot = (int*)(F.ws + WS_SLOT); int* sorted = (int*)(F.ws + WS_SORTED);
    for (int i = F.gw * 64 + F.lane; i < NT * 8; i += F.NGW * 64) { const int e = tope[i]; const int row = tab[e] + slot[i]; sorted[row] = i >> 3; slot[i] = row; }
    for (int i = F.gw * 64 + F.lane; i < NEXP * 256; i += F.NGW * 64) { const int e = i >> 8, j = i & 255; const int r = tab[e] + tab[66 + e] + j; if (r < tab[e + 1]) sorted[r] = 0; }
}

__device__ __forceinline__ void p_l1_thin_a(Frame& F) {
    const bf16* proj = (const bf16*)(F.ws + WS_PROJ); const int* pos = (const int*)kin(1);
    bf16* cqn = (bf16*)(F.ws + WS_CQN); bf16* ckvn = (bf16*)(F.ws + WS_CKVN); bf16* krot = (bf16*)(F.ws + WS_KROT); bf16* cmpkv = (bf16*)(F.ws + WS_CMPKV);
    const float* qn = kin(10); const float* kvn = kin(12);
    for (int m = F.gw; m < NT; m += F.NGW) {
        const bf16* row = proj + (size_t)m * CD_INP;
        { float x[6]; float s = 0.f;
#pragma unroll
          for (int j = 0; j < 6; ++j) { x[j] = bf1(row[2584 + j * 64 + F.lane]); s += x[j] * x[j]; }
          const float r = 1.f / sqrtf(wave_sum(s) * (1.f / 384.f) + NORM_EPS);
#pragma unroll
          for (int j = 0; j < 6; ++j) cqn[(size_t)m * 384 + j * 64 + F.lane] = (bf16)f2bf(x[j] * r * qn[j * 64 + F.lane]); }
        { float x[8]; float s = 0.f;
#pragma unroll
          for (int j = 0; j < 8; ++j) { x[j] = bf1(row[2968 + j * 64 + F.lane]); s += x[j] * x[j]; }
          const float r = 1.f / sqrtf(wave_sum(s) * (1.f / 512.f) + NORM_EPS);
#pragma unroll
          for (int j = 0; j < 8; ++j) ckvn[(size_t)m * 512 + j * 64 + F.lane] = (bf16)f2bf(x[j] * r * kvn[j * 64 + F.lane]); }
        { const int i = F.lane & 31; const float p = (float)pos[m]; const float invf = exp2f(-(float)i * (13.287712379549449f / 32.f));
          float sn, cs; fast_sincos(p * invf, sn, cs);
          const float x1 = bf1(row[3480 + i]), x2 = bf1(row[3480 + 32 + i]);
          if (F.lane < 32) krot[(size_t)m * 64 + i] = (bf16)f2bf(x1 * cs - x2 * sn); else krot[(size_t)m * 64 + 32 + i] = (bf16)f2bf(x1 * sn + x2 * cs); }
        { const int b = m >> 11, s = m & (NS - 1);
          const int q4 = F.lane >> 4, c = F.lane & 15, kv = q4 >> 1, g = q4 & 1;
          const v4u w = *(const v4u*)(row + 1024 + q4 * 128 + c * 8);
          *(v4u*)(cmpkv + ((size_t)((kv * 16 + b * 2 + g) * NS + s)) * 128 + c * 8) = w; }
    }
}
__device__ __forceinline__ void p_l1_thin_b(Frame& F) {
    const float* hid = (const float*)(F.ws + WS_HIDP); const float* w2 = kin(9); bf16* kvc = (bf16*)(F.ws + WS_KVCMP);
    for (int m = F.gw; m < 4096; m += F.NGW) {
        const int kv = m >> 11;
        float h0 = 0.f, h1 = 0.f;
#pragma unroll
        for (int sp = 0; sp < pg8::CMP_SPLIT; ++sp) { h0 += hid[((size_t)sp * 4096 + m) * 256 + kv * 128 + F.lane]; h1 += hid[((size_t)sp * 4096 + m) * 256 + kv * 128 + 64 + F.lane]; }
        h0 = 0.5f * h0 * (1.f + tanhf(0.7978845608028654f * (h0 + 0.044715f * h0 * h0 * h0)));
        h1 = 0.5f * h1 * (1.f + tanhf(0.7978845608028654f * (h1 + 0.044715f * h1 * h1 * h1)));
        const float* w = w2 + (size_t)kv * 128 * 128; float o0 = 0.f, o1 = 0.f;
#pragma unroll 16
        for (int c = 0; c < 64; ++c) { const float a = __builtin_bit_cast(float, __builtin_amdgcn_readlane(__builtin_bit_cast(int, h0), c)), bq = __builtin_bit_cast(float, __builtin_amdgcn_readlane(__builtin_bit_cast(int, h1), c));
            o0 += a * w[c * 128 + F.lane] + bq * w[(c + 64) * 128 + F.lane]; o1 += a * w[c * 128 + 64 + F.lane] + bq * w[(c + 64) * 128 + 64 + F.lane]; }
        kvc[(size_t)m * 128 + F.lane] = (bf16)f2bf(o0); kvc[(size_t)m * 128 + 64 + F.lane] = (bf16)f2bf(o1);
    }
}
__device__ __forceinline__ void p_nsa_cmp_mfma(Frame& F) {
    typedef short v4i16_t __attribute__((ext_vector_type(4)));
    const bf16* proj = (const bf16*)(F.ws + WS_PROJ); const bf16* kvc = (const bf16*)(F.ws + WS_KVCMP); float* ocmp = (float*)(F.ws + WS_OCMP); unsigned* selm = (unsigned*)(F.ws + WS_SELM);
    constexpr int P = 272;
    LAS unsigned char* KT = F.lds; LAS unsigned char* VT = F.lds + 128 * P; LAS float* PS = (LAS float*)(F.lds + 2 * 128 * P);
    const int w = F.wave, lane = F.lane, i16 = lane & 15, g = lane >> 4, q4 = (lane & 15) >> 2, p4 = lane & 3;
    const float sscale = 0.08838834764831845f * 1.4426950408889634f;
    for (int bu = blockIdx.x; bu < 256; bu += F.G) {
        const int bg = bu >> 4, qg = bu & 15, b = bg >> 1, gq = bg & 1;
        __syncthreads();
#pragma unroll
        for (int c = 0; c < 4; ++c) { const int idx = F.tid + 512 * c, row = idx >> 4, c8 = idx & 15;
            v4u kk = (v4u){0u, 0u, 0u, 0u}, vv = (v4u){0u, 0u, 0u, 0u};
            if (row < 127) { kk = *(const v4u*)(kvc + ((size_t)(0 * 16 + bg) * 128 + row) * 128 + c8 * 8); vv = *(const v4u*)(kvc + ((size_t)(1 * 16 + bg) * 128 + row) * 128 + c8 * 8); }
            *(LAS v4u*)(KT + row * P + c8 * 16) = kk; *(LAS v4u*)(VT + row * P + c8 * 16) = vv; }
        bf16x8 qf[4];
        { const int h = gq * 4 + (w >> 1), spos = qg * 128 + (w & 1) * 16 + i16;
#pragma unroll
          for (int ks = 0; ks < 4; ++ks) qf[ks] = *(const bf16x8*)(proj + (size_t)(b * NS + spos) * CD_INP + h * 128 + 32 * ks + 8 * g); }
        for (int k = 0; k < 4; ++k) {
            const int q0 = (qg * 4 + k) * 32, h = gq * 4 + (w >> 1), ql = (w & 1) * 16 + i16, spos = q0 + ql;
            float gt[4];
#pragma unroll
            for (int r = 0; r < 4; ++r) gt[r] = bf1(proj[(size_t)(b * NS + q0 + (w & 1) * 16 + 4 * g + r) * CD_INP + 2560 + h * 3 + 0]);
            __syncthreads();
            const int nvalid = spos >= 31 ? ((spos - 31) >> 4) + 1 : 0;
            f32x4 sc[8]; float mx = -1e30f;
#pragma unroll
            for (int mt = 0; mt < 8; ++mt) { sc[mt] = (f32x4){0.f, 0.f, 0.f, 0.f};
#pragma unroll
                for (int ks = 0; ks < 4; ++ks) { const bf16x8 kf = *(const LAS bf16x8*)(KT + (16 * mt + i16) * P + (32 * ks + 8 * g) * 2); sc[mt] = __builtin_amdgcn_mfma_f32_16x16x32_bf16(kf, qf[ks], sc[mt], 0, 0, 0); }
#pragma unroll
                for (int r = 0; r < 4; ++r) { const bool ok = (16 * mt + 4 * g + r) < nvalid; const float x = ok ? sc[mt][r] * sscale : -1e30f; sc[mt][r] = x; mx = fmaxf(mx, x); } }
            if (k < 3) {
#pragma unroll
                for (int ks = 0; ks < 4; ++ks) qf[ks] = *(const bf16x8*)(proj + (size_t)(b * NS + spos + 32) * CD_INP + h * 128 + 32 * ks + 8 * g); }
            mx = fmaxf(mx, __shfl_xor(mx, 16)); mx = fmaxf(mx, __shfl_xor(mx, 32));
            float ps = 0.f;
#pragma unroll
            for (int mt = 0; mt < 8; ++mt)
#pragma unroll
                for (int r = 0; r < 4; ++r) { const bool ok = (16 * mt + 4 * g + r) < nvalid; const float pv = ok ? __builtin_amdgcn_exp2f(sc[mt][r] - mx) : 0.f; sc[mt][r] = pv; ps += pv; }
            ps += __shfl_xor(ps, 16); ps += __shfl_xor(ps, 32);
            const float inv = ps > 0.f ? 1.f / ps : 0.f;
#pragma unroll
            for (int mt = 0; mt < 8; ++mt)
#pragma unroll
                for (int r = 0; r < 4; ++r) sc[mt][r] *= inv;
            { LAS float* slab = PS + (w >> 2) * 4096 + ql * 128 + 4 * g;
              if (((w >> 1) & 1) == 0) {
#pragma unroll
                  for (int mt = 0; mt < 8; ++mt) *(LAS f32x4*)(slab + 16 * mt) = sc[mt]; }
              __syncthreads();
              if (((w >> 1) & 1) == 1) {
#pragma unroll
                  for (int mt = 0; mt < 8; ++mt) { const f32x4 t = *(const LAS f32x4*)(slab + 16 * mt); *(LAS f32x4*)(slab + 16 * mt) = t + sc[mt]; } } }
            f32x4 O[8];
#pragma unroll
            for (int nt = 0; nt < 8; ++nt) O[nt] = (f32x4){0.f, 0.f, 0.f, 0.f};
#pragma unroll
            for (int k2 = 0; k2 < 4; ++k2) { v4u wv; wv.x = pk2(sc[2 * k2][0], sc[2 * k2][1]); wv.y = pk2(sc[2 * k2][2], sc[2 * k2][3]); wv.z = pk2(sc[2 * k2 + 1][0], sc[2 * k2 + 1][1]); wv.w = pk2(sc[2 * k2 + 1][2], sc[2 * k2 + 1][3]);
                const bf16x8 pf = __builtin_bit_cast(bf16x8, wv);
#pragma unroll
                for (int nt = 0; nt < 8; ++nt) {
                    const v4i16_t a = __builtin_amdgcn_ds_read_tr16_b64_v4i16((LAS v4i16_t*)(VT + (32 * k2 + 4 * g + q4) * P + (16 * nt + 4 * p4) * 2));
                    const v4i16_t c = __builtin_amdgcn_ds_read_tr16_b64_v4i16((LAS v4i16_t*)(VT + (32 * k2 + 16 + 4 * g + q4) * P + (16 * nt + 4 * p4) * 2));
                    const bf16x8 vf = (bf16x8){a[0], a[1], a[2], a[3], c[0], c[1], c[2], c[3]};
                    O[nt] = __builtin_amdgcn_mfma_f32_16x16x32_bf16(pf, vf, O[nt], 0, 0, 0); } }
#pragma unroll
            for (int r = 0; r < 4; ++r) { const size_t m = (size_t)(b * NS + q0 + (w & 1) * 16 + 4 * g + r); const float gs = sigmoidf_(gt[r]);
#pragma unroll
                for (int nt = 0; nt < 8; ++nt) ocmp[m * 1024 + h * 128 + 16 * nt + i16] = gs * O[nt][r]; }
            __syncthreads();
#pragma unroll
            for (int qq = 0; qq < 4; ++qq) { const int qi = 4 * w + qq, s = q0 + qi, cur = s >> 6, j = lane & 31;
                float imp = 0.f;
#pragma unroll
                for (int kk = 0; kk < 4; ++kk) { const int n1 = 4 * j + kk; if (n1 <= 126) imp += PS[qi * 128 + n1] + PS[4096 + qi * 128 + n1]; const int n2 = 4 * j - 1 + kk; if (n2 >= 0 && n2 <= 126) imp += PS[qi * 128 + n2] + PS[4096 + qi * 128 + n2]; }
                const bool forced = (j == 0) || (j == cur) || (j == cur - 1);
                const float score = forced ? 1e4f : ((j * 64 <= s) ? imp : -1e30f);
                int rk = 0;
#pragma unroll
                for (int jj = 0; jj < 32; ++jj) { const float ov = __builtin_bit_cast(float, __builtin_amdgcn_readlane(__builtin_bit_cast(int, score), jj)); rk += ((ov > score) || (ov == score && jj < j)) ? 1 : 0; }
                const bool sel = (lane < 32) && (rk < 16) && (j <= cur);
                const unsigned long long bal = __ballot(sel);
                if (lane == 0) selm[(size_t)(b * NS + s) * 2 + gq] = (unsigned)bal; }
        }
    }
}

namespace fa {
typedef short v4i16_t __attribute__((ext_vector_type(4)));
struct Src { const bf16* k1; size_t ks1; const bf16* k2; size_t ks2; const bf16* v; size_t vs; };
template <int DQK> struct Cfg { static constexpr int KPITCH = (DQK + 8) * 2, KBYTES = 64 * KPITCH, VPITCH = 272, VBYTES = 64 * VPITCH, BUF = KBYTES + VBYTES, NKS = DQK / 32, KCH = DQK / 8, NKR = DQK / 64; };

template <int DQK> struct TileOff { unsigned gk[Cfg<DQK>::NKR], gv[2], lk[Cfg<DQK>::NKR], lv[2]; };
template <int DQK>
__device__ __forceinline__ void tile_offsets(const Src& S, int tid, TileOff<DQK>& T) {
#pragma unroll
    for (int i = 0; i < 2; ++i) { const int c = tid + 512 * i, row = c >> 4, c8 = c & 15;
        T.gk[i] = (unsigned)(row * (int)S.ks1 + c8 * 8) * 2u; T.gv[i] = (unsigned)(row * (int)S.vs + c8 * 8) * 2u;
        T.lk[i] = (unsigned)(row * Cfg<DQK>::KPITCH + c8 * 16); T.lv[i] = (unsigned)(Cfg<DQK>::KBYTES + row * Cfg<DQK>::VPITCH + c8 * 16); }
    if (DQK == 192) { const int row = tid >> 3, c8 = tid & 7; T.gk[Cfg<DQK>::NKR - 1] = (unsigned)(row * (int)S.ks2 + c8 * 8) * 2u; T.lk[Cfg<DQK>::NKR - 1] = (unsigned)(row * Cfg<DQK>::KPITCH + 256 + c8 * 16); }
}
template <int DQK>
__device__ __forceinline__ void load_tile(const Src& S, int k0, const TileOff<DQK>& T, v4u (&kr)[Cfg<DQK>::NKR], v4u (&vr)[2]) {
    const char* kb1 = (const char*)S.k1 + (size_t)k0 * S.ks1 * 2; const char* vb = (const char*)S.v + (size_t)k0 * S.vs * 2;
#pragma unroll
    for (int i = 0; i < 2; ++i) { kr[i] = *(const v4u*)(kb1 + T.gk[i]); vr[i] = *(const v4u*)(vb + T.gv[i]); }
    if (DQK == 192) { const char* kb2 = (const char*)S.k2 + (size_t)k0 * S.ks2 * 2; kr[Cfg<DQK>::NKR - 1] = *(const v4u*)(kb2 + T.gk[Cfg<DQK>::NKR - 1]); }
}
template <int DQK>
__device__ __forceinline__ void store_tile(LAS unsigned char* buf, const TileOff<DQK>& T, const v4u (&kr)[Cfg<DQK>::NKR], const v4u (&vr)[2]) {
#pragma unroll
    for (int i = 0; i < Cfg<DQK>::NKR; ++i) *(LAS v4u*)(buf + T.lk[i]) = kr[i];
#pragma unroll
    for (int i = 0; i < 2; ++i) *(LAS v4u*)(buf + T.lv[i]) = vr[i];
}
struct RowState { int spos; unsigned rowmask; float m_run, l_run; };
template <int MODE> __device__ __forceinline__ bool group_needs(int t, const RowState& R) {
    bool row_any = (t * 64 <= R.spos);
    if (MODE == 1) row_any = row_any && ((R.rowmask >> t) & 1u);
    if (MODE == 2) row_any = row_any && (t * 64 + 63 + 512 > R.spos);
    return __ballot(row_any) != 0ull;
}
template <int MODE>
__device__ __forceinline__ void softmax_group(f32x4 (&sc)[4], int t, RowState& R, f32x4 (&O)[8], bf16x8 (&pf)[2], int g) {
    float mx = -1e30f;
    bool row_full = (t * 64 + 63 <= R.spos);
    if (MODE == 1) row_full = row_full && ((R.rowmask >> t) & 1u);
    if (MODE == 2) row_full = row_full && (t * 64 + 512 > R.spos);
    if (__ballot(row_full) == ~0ull) {
#pragma unroll
        for (int mt = 0; mt < 4; ++mt)
#pragma unroll
            for (int r = 0; r < 4; ++r) mx = fmaxf(mx, sc[mt][r]);
    } else {
#pragma unroll
        for (int mt = 0; mt < 4; ++mt)
#pragma unroll
            for (int r = 0; r < 4; ++r) { const int kp = t * 64 + 16 * mt + 4 * g + r; bool ok = kp <= R.spos;
                if (MODE == 1) ok = ok && ((R.rowmask >> t) & 1u);
                if (MODE == 2) ok = ok && (kp + 512 > R.spos);
                const float x = ok ? sc[mt][r] : -3e38f; sc[mt][r] = x; mx = fmaxf(mx, x); }
        mx = fmaxf(mx, -1e30f);
    }
    mx = fmaxf(mx, __shfl_xor(mx, 16)); mx = fmaxf(mx, __shfl_xor(mx, 32));
    if (__ballot(mx > R.m_run + 8.0f) != 0ull) {
        const float m_new = fmaxf(R.m_run, mx), alpha = __builtin_amdgcn_exp2f(R.m_run - m_new); R.m_run = m_new;
        R.l_run *= alpha;
        float ar[4];
#pragma unroll
        for (int r = 0; r < 4; ++r) ar[r] = __shfl(alpha, 4 * g + r);
#pragma unroll
        for (int nt = 0; nt < 8; ++nt)
#pragma unroll
            for (int r = 0; r < 4; ++r) O[nt][r] *= ar[r];
    }
    float ps = 0.f;
#pragma unroll
    for (int mt = 0; mt < 4; ++mt)
#pragma unroll
        for (int r = 0; r < 4; ++r) { const float pv = __builtin_amdgcn_exp2f(sc[mt][r] - R.m_run); sc[mt][r] = pv; ps += pv; }
    R.l_run += ps;
#pragma unroll
    for (int k2 = 0; k2 < 2; ++k2) { v4u w; w.x = pk2(sc[2 * k2][0], sc[2 * k2][1]); w.y = pk2(sc[2 * k2][2], sc[2 * k2][3]); w.z = pk2(sc[2 * k2 + 1][0], sc[2 * k2 + 1][1]); w.w = pk2(sc[2 * k2 + 1][2], sc[2 * k2 + 1][3]);
        pf[k2] = __builtin_bit_cast(bf16x8, w); }
}
template <int DQK, int MODE>
__device__ __forceinline__ void fa_compute(LAS unsigned char* kb, LAS unsigned char* vb, const bf16x8 (&qf0)[Cfg<DQK>::NKS], const bf16x8 (&qf1)[Cfg<DQK>::NKS], int t, RowState& R0, RowState& R1, float sscale,
                                           f32x4 (&O0)[8], f32x4 (&O1)[8], int i16, int g, int q4, int p4) {
    typedef Cfg<DQK> C;
    const bool n0 = group_needs<MODE>(t, R0), n1 = group_needs<MODE>(t, R1);
    if (!n0 && !n1) return;
    f32x4 s0[4], s1[4];
#pragma unroll
    for (int mt = 0; mt < 4; ++mt) { s0[mt] = (f32x4){0.f, 0.f, 0.f, 0.f}; s1[mt] = (f32x4){0.f, 0.f, 0.f, 0.f};
#pragma unroll
        for (int ks = 0; ks < C::NKS; ++ks) { const bf16x8 kf = *(const LAS bf16x8*)(kb + (16 * mt + i16) * C::KPITCH + (32 * ks + 8 * g) * 2);
            s0[mt] = __builtin_amdgcn_mfma_f32_16x16x32_bf16(kf, qf0[ks], s0[mt], 0, 0, 0);
            s1[mt] = __builtin_amdgcn_mfma_f32_16x16x32_bf16(kf, qf1[ks], s1[mt], 0, 0, 0); } }
    bf16x8 p0[2], p1[2];
    if (n0) softmax_group<MODE>(s0, t, R0, O0, p0, g); else { p0[0] = (bf16x8){0, 0, 0, 0, 0, 0, 0, 0}; p0[1] = p0[0]; }
    if (n1) softmax_group<MODE>(s1, t, R1, O1, p1, g); else { p1[0] = (bf16x8){0, 0, 0, 0, 0, 0, 0, 0}; p1[1] = p1[0]; }
#pragma unroll
    for (int nt = 0; nt < 8; ++nt)
#pragma unroll
        for (int k2 = 0; k2 < 2; ++k2) {
            const v4i16_t a = __builtin_amdgcn_ds_read_tr16_b64_v4i16((LAS v4i16_t*)(vb + (32 * k2 + 4 * g + q4) * C::VPITCH + (16 * nt + 4 * p4) * 2));
            const v4i16_t b = __builtin_amdgcn_ds_read_tr16_b64_v4i16((LAS v4i16_t*)(vb + (32 * k2 + 16 + 4 * g + q4) * C::VPITCH + (16 * nt + 4 * p4) * 2));
            const bf16x8 vf = (bf16x8){a[0], a[1], a[2], a[3], b[0], b[1], b[2], b[3]};
            O0[nt] = __builtin_amdgcn_mfma_f32_16x16x32_bf16(p0[k2], vf, O0[nt], 0, 0, 0);
            O1[nt] = __builtin_amdgcn_mfma_f32_16x16x32_bf16(p1[k2], vf, O1[nt], 0, 0, 0); }
}
template <int DQK, int MODE>
__device__ __forceinline__ void fa_pass(LAS unsigned char* lds, const Src& S, const bf16x8 (&qf0)[Cfg<DQK>::NKS], const bf16x8 (&qf1)[Cfg<DQK>::NKS], unsigned tmask, RowState& R0, RowState& R1, float sscale,
                                        f32x4 (&O0)[8], f32x4 (&O1)[8], int tid, int lane) {
    typedef Cfg<DQK> C;
    const int i16 = lane & 15, g = lane >> 4, q4 = (lane & 15) >> 2, p4 = lane & 3;
#pragma unroll
    for (int nt = 0; nt < 8; ++nt) { O0[nt] = (f32x4){0.f, 0.f, 0.f, 0.f}; O1[nt] = (f32x4){0.f, 0.f, 0.f, 0.f}; }
    R0.m_run = -1e30f; R0.l_run = 0.f; R1.m_run = -1e30f; R1.l_run = 0.f;
    unsigned rem = tmask;
    if (rem == 0u) return;
    v4u kr[C::NKR], vr[2]; TileOff<DQK> TO; tile_offsets<DQK>(S, tid, TO);
    int t = __builtin_ctz(rem); rem &= rem - 1u;
    load_tile<DQK>(S, t * 64, TO, kr, vr);
    __syncthreads();
    store_tile<DQK>(lds, TO, kr, vr);
    __syncthreads();
    int cur = 0;
    for (;;) {
        const bool has_next = rem != 0u; int tn = 0;
        if (has_next) { tn = __builtin_ctz(rem); rem &= rem - 1u; load_tile<DQK>(S, tn * 64, TO, kr, vr); }
        LAS unsigned char* kb = lds + cur * C::BUF;
        fa_compute<DQK, MODE>(kb, kb + C::KBYTES, qf0, qf1, t, R0, R1, sscale, O0, O1, i16, g, q4, p4);
        if (has_next) store_tile<DQK>(lds + (cur ^ 1) * C::BUF, TO, kr, vr);
        __syncthreads();
        if (!has_next) break;
        t = tn; cur ^= 1;
    }
}
__device__ __forceinline__ void row_inv(float l_run, int lane, float (&inv)[4]) {
    float l = l_run; l += __shfl_xor(l, 16); l += __shfl_xor(l, 32);
    const float li = l > 0.f ? 1.f / l : 0.f; const int g = lane >> 4;
#pragma unroll
    for (int r = 0; r < 4; ++r) inv[r] = __shfl(li, 4 * g + r);
}
__device__ __forceinline__ void scale_frag(bf16x8& f, float sc) {
    v4u w = __builtin_bit_cast(v4u, f); float x[8]; unpack8(w, x);
    w.x = pk2(x[0] * sc, x[1] * sc); w.y = pk2(x[2] * sc, x[3] * sc); w.z = pk2(x[4] * sc, x[5] * sc); w.w = pk2(x[6] * sc, x[7] * sc); f = __builtin_bit_cast(bf16x8, w);
}
__device__ __forceinline__ void rope_qpe(bf16x8& f4, bf16x8& f5, float pz, int g4) {
    v4u w1 = __builtin_bit_cast(v4u, f4), w2 = __builtin_bit_cast(v4u, f5); float x1[8], x2[8]; unpack8(w1, x1); unpack8(w2, x2);
#pragma unroll
    for (int jj = 0; jj < 8; ++jj) { const float invf = exp2f(-(float)(8 * g4 + jj) * (13.287712379549449f / 32.f)); float sn, cs; fast_sincos(pz * invf, sn, cs);
        const float a = x1[jj] * cs - x2[jj] * sn, c = x1[jj] * sn + x2[jj] * cs; x1[jj] = a; x2[jj] = c; }
    w1.x = pk2(x1[0], x1[1]); w1.y = pk2(x1[2], x1[3]); w1.z = pk2(x1[4], x1[5]); w1.w = pk2(x1[6], x1[7]);
    w2.x = pk2(x2[0], x2[1]); w2.y = pk2(x2[2], x2[3]); w2.z = pk2(x2[4], x2[5]); w2.w = pk2(x2[6], x2[7]);
    f4 = __builtin_bit_cast(bf16x8, w1); f5 = __builtin_bit_cast(bf16x8, w2);
}
}

__device__ __forceinline__ void p_attn_mla(Frame& F, unsigned* queue) {
    const bf16* proj = (const bf16*)(F.ws + WS_PROJ); bf16* mixin = (bf16*)(F.ws + WS_MIXIN); const float* ocmp = (const float*)(F.ws + WS_OCMP); const unsigned* selm = (const unsigned*)(F.ws + WS_SELM);
    const bf16* qmla = (const bf16*)(F.ws + WS_QMLA); const bf16* kvu = (const bf16*)(F.ws + WS_KVU); const bf16* krot = (const bf16*)(F.ws + WS_KROT);
    volatile LAS unsigned* qslot = (volatile LAS unsigned*)(F.lds + LDSCTL_OFF);
    const int lane = F.lane, w = F.wave, i16 = lane & 15, g4 = lane >> 4;
    for (;;) {
        __syncthreads();
        if (F.tid == 0) qslot[0] = atomicAdd(queue, 1u);
        __syncthreads();
        const int u = __builtin_amdgcn_readfirstlane((int)qslot[0]);
        if (u >= 512) break;
        {
            const int qt = 7 - (u >> 6), bh = u & 63, b = bh >> 3, h = bh & 7, q0 = qt * 256;
            fa::RowState R0, R1; R0.spos = q0 + 32 * w + i16; R1.spos = R0.spos + 16; R0.rowmask = 0u; R1.rowmask = 0u;
            bf16x8 qf0[6], qf1[6];
#pragma unroll
            for (int ks = 0; ks < 6; ++ks) { qf0[ks] = *(const bf16x8*)(qmla + (size_t)(b * NS + R0.spos) * 1536 + h * 192 + 32 * ks + 8 * g4); qf1[ks] = *(const bf16x8*)(qmla + (size_t)(b * NS + R1.spos) * 1536 + h * 192 + 32 * ks + 8 * g4); }
            fa::rope_qpe(qf0[4], qf0[5], (float)((const int*)kin(1))[b * NS + R0.spos], g4);
            fa::rope_qpe(qf1[4], qf1[5], (float)((const int*)kin(1))[b * NS + R1.spos], g4);
#pragma unroll
            for (int ks = 0; ks < 6; ++ks) { fa::scale_frag(qf0[ks], 0.07216878364870322f * 1.4426950408889634f); fa::scale_frag(qf1[ks], 0.07216878364870322f * 1.4426950408889634f); }
            fa::Src S; S.k1 = kvu + (size_t)(b * NS) * 2048 + h * 256; S.ks1 = 2048; S.k2 = krot + (size_t)(b * NS) * 64; S.ks2 = 64; S.v = S.k1 + 128; S.vs = 2048;
            const int last = (q0 + 255) >> 6; const unsigned tmask = last >= 31 ? 0xffffffffu : ((1u << (last + 1)) - 1u);
            f32x4 O0[8], O1[8];
            fa::fa_pass<192, 0>(F.lds, S, qf0, qf1, tmask, R0, R1, 0.07216878364870322f * 1.4426950408889634f, O0, O1, F.tid, lane);
            float inv[4];
            fa::row_inv(R0.l_run, lane, inv);
#pragma unroll
            for (int r = 0; r < 4; ++r) { bf16* orow = mixin + (size_t)(b * NS + q0 + 32 * w + 4 * g4 + r) * ND + 1024 + h * 128 + i16;
#pragma unroll
                for (int nt = 0; nt < 8; ++nt) orow[16 * nt] = (bf16)f2bf(O0[nt][r] * inv[r]); }
            fa::row_inv(R1.l_run, lane, inv);
#pragma unroll
            for (int r = 0; r < 4; ++r) { bf16* orow = mixin + (size_t)(b * NS + q0 + 32 * w + 16 + 4 * g4 + r) * ND + 1024 + h * 128 + i16;
#pragma unroll
                for (int nt = 0; nt < 8; ++nt) orow[16 * nt] = (bf16)f2bf(O1[nt][r] * inv[r]); }
        }
    }
    (void)proj; (void)ocmp; (void)selm;
}
__device__ __forceinline__ void p_attn_nsa(Frame& F, unsigned* queue) {
    const bf16* proj = (const bf16*)(F.ws + WS_PROJ); bf16* mixin = (bf16*)(F.ws + WS_MIXIN); const float* ocmp = (const float*)(F.ws + WS_OCMP); const unsigned* selm = (const unsigned*)(F.ws + WS_SELM);
    const bf16* qmla = (const bf16*)(F.ws + WS_QMLA); const bf16* kvu = (const bf16*)(F.ws + WS_KVU); const bf16* krot = (const bf16*)(F.ws + WS_KROT);
    volatile LAS unsigned* qslot = (volatile LAS unsigned*)(F.lds + LDSCTL_OFF);
    const int lane = F.lane, w = F.wave, i16 = lane & 15, g4 = lane >> 4;
    for (;;) {
        __syncthreads();
        if (F.tid == 0) qslot[0] = atomicAdd(queue, 1u);
        __syncthreads();
        const int u = __builtin_amdgcn_readfirstlane((int)qslot[0]);
        if (u >= 512) break;
        {
            const int v = u;
            const int qt = 31 - (v >> 4), bg = v & 15, b = bg >> 1, gq = bg & 1, q0 = qt * 64;
            const int h = gq * 4 + (w >> 1), qb = q0 + (w & 1) * 32;
            fa::RowState R0, R1; R0.spos = qb + i16; R1.spos = qb + 16 + i16;
            bf16x8 qf0[4], qf1[4];
#pragma unroll
            for (int ks = 0; ks < 4; ++ks) { qf0[ks] = *(const bf16x8*)(proj + (size_t)(b * NS + R0.spos) * CD_INP + h * 128 + 32 * ks + 8 * g4); qf1[ks] = *(const bf16x8*)(proj + (size_t)(b * NS + R1.spos) * CD_INP + h * 128 + 32 * ks + 8 * g4); }
#pragma unroll
            for (int ks = 0; ks < 4; ++ks) { fa::scale_frag(qf0[ks], 0.08838834764831845f * 1.4426950408889634f); fa::scale_frag(qf1[ks], 0.08838834764831845f * 1.4426950408889634f); }
            R0.rowmask = selm[(size_t)(b * NS + R0.spos) * 2 + gq]; R1.rowmask = selm[(size_t)(b * NS + R1.spos) * 2 + gq];
            unsigned um = selm[(size_t)(b * NS + q0 + lane) * 2 + gq];
#pragma unroll
            for (int o = 1; o < 64; o <<= 1) um |= (unsigned)__shfl_xor((int)um, o);
            um = (unsigned)__builtin_amdgcn_readfirstlane((int)um);
            const bf16* base = proj + (size_t)(b * NS) * CD_INP;
            const float sscale = 0.08838834764831845f * 1.4426950408889634f;
            f32x4 O0[8], O1[8]; float inv[4];
            { fa::Src S; S.k1 = base + 1024 + ((1 * 2 + 0) * 2 + gq) * 128; S.ks1 = CD_INP; S.k2 = nullptr; S.ks2 = 0; S.v = base + 1024 + ((1 * 2 + 1) * 2 + gq) * 128; S.vs = CD_INP;
              fa::fa_pass<128, 1>(F.lds, S, qf0, qf1, um, R0, R1, sscale, O0, O1, F.tid, lane); }
            fa::row_inv(R0.l_run, lane, inv);
#pragma unroll
            for (int r = 0; r < 4; ++r) { const size_t m = (size_t)(b * NS + qb + 4 * g4 + r); const float g1 = sigmoidf_(bf1(proj[m * CD_INP + 2560 + h * 3 + 1])) * inv[r];
#pragma unroll
                for (int nt = 0; nt < 8; ++nt) mixin[m * ND + h * 128 + 16 * nt + i16] = (bf16)f2bf(ocmp[m * 1024 + h * 128 + 16 * nt + i16] + O0[nt][r] * g1); }
            fa::row_inv(R1.l_run, lane, inv);
#pragma unroll
            for (int r = 0; r < 4; ++r) { const size_t m = (size_t)(b * NS + qb + 16 + 4 * g4 + r); const float g1 = sigmoidf_(bf1(proj[m * CD_INP + 2560 + h * 3 + 1])) * inv[r];
#pragma unroll
                for (int nt = 0; nt < 8; ++nt) mixin[m * ND + h * 128 + 16 * nt + i16] = (bf16)f2bf(ocmp[m * 1024 + h * 128 + 16 * nt + i16] + O1[nt][r] * g1); }
            { fa::Src S; S.k1 = base + 1024 + ((2 * 2 + 0) * 2 + gq) * 128; S.ks1 = CD_INP; S.k2 = nullptr; S.ks2 = 0; S.v = base + 1024 + ((2 * 2 + 1) * 2 + gq) * 128; S.vs = CD_INP;
              const int klo = q0 - 511 > 0 ? q0 - 511 : 0, tlo = klo >> 6, thi = (q0 + 63) >> 6;
              const unsigned hm = thi >= 31 ? 0xffffffffu : ((1u << (thi + 1)) - 1u); const unsigned tmask = hm & ~((1u << tlo) - 1u);
              fa::fa_pass<128, 2>(F.lds, S, qf0, qf1, tmask, R0, R1, sscale, O0, O1, F.tid, lane); }
            fa::row_inv(R0.l_run, lane, inv);
#pragma unroll
            for (int r = 0; r < 4; ++r) { const size_t m = (size_t)(b * NS + qb + 4 * g4 + r); const float g2 = sigmoidf_(bf1(proj[m * CD_INP + 2560 + h * 3 + 2])) * inv[r];
#pragma unroll
                for (int nt = 0; nt < 8; ++nt) { bf16* op = mixin + m * ND + h * 128 + 16 * nt + i16; *op = (bf16)f2bf(bf1(*op) + O0[nt][r] * g2); } }
            fa::row_inv(R1.l_run, lane, inv);
#pragma unroll
            for (int r = 0; r < 4; ++r) { const size_t m = (size_t)(b * NS + qb + 16 + 4 * g4 + r); const float g2 = sigmoidf_(bf1(proj[m * CD_INP + 2560 + h * 3 + 2])) * inv[r];
#pragma unroll
                for (int nt = 0; nt < 8; ++nt) { bf16* op = mixin + m * ND + h * 128 + 16 * nt + i16; *op = (bf16)f2bf(bf1(*op) + O1[nt][r] * g2); } }
        }
    }
    (void)qmla; (void)kvu; (void)krot;
}

constexpr int NPHASE = 33;


#define IN(k) (lo <= (k) && (k) < hi)
#define SEAM(k) do { F.lane = lane_id_fresh(); F.tid = F.wave * 64 + F.lane; if (IN(k) && IN((k) + 1)) { if (MK_ONE_LAUNCH) xcd_barrier(bar); else if (F.tid == 0) __hip_atomic_store(F.ctl + CW_TMO, 0xBAD0u | (unsigned)(k), __ATOMIC_RELAXED, __HIP_MEMORY_SCOPE_AGENT); \
    if (MK_PROBE_PHASE >= 0 && blockIdx.x == 0 && F.tid == 0) { if ((k) == MK_PROBE_PHASE - 1) ((volatile LAS unsigned long long*)(F.lds + LDSCTL_OFF + 64))[0] = __builtin_amdgcn_s_memrealtime(); \
        if ((k) == MK_PROBE_LAST) ((volatile LAS unsigned long long*)(F.lds + LDSCTL_OFF + 64))[1] = __builtin_amdgcn_s_memrealtime(); } } } while (0)
template <int l>
__device__ __forceinline__ void layer_body(Frame& F, const XcdBarrier& bar, const int lo, const int hi) {
    unsigned char* ws = F.ws;
    bf16* const XB0 = (bf16*)(ws + WS_XB0); bf16* const X1B = (bf16*)(ws + WS_X1B); bf16* const X2B = (bf16*)(ws + WS_X2B);
    bf16* const PROJ = (bf16*)(ws + WS_PROJ); bf16* const MIXIN = (bf16*)(ws + WS_MIXIN); bf16* const MIXO = (bf16*)(ws + WS_MIXO);
    bf16* const HB = (bf16*)(ws + WS_H); bf16* const Y2 = (bf16*)(ws + WS_Y2);
        const int pb = 1 + l * 16;
        const bf16* xin = l == 0 ? XB0 : X2B;
        if (IN(pb + 0)) {
            if (l == 0 && MK_FP8_IN0) { pg8::DenseProb P; P.init((const bf16*)(ws + WS_X1F8), ND / 2, (const bf16*)(ws + WS_WABIN), NT, AB_IN, ND / 2, F.G, (int)blockIdx.x); pg8::EpiBf16P2 E{PROJ, AB_IN};
                pg8::gemm_phase<pg8::EpiBf16P2, pg8::DenseProb, true, true, false>(F.lds, P, E, F.wave); }
            else if (l == 0) { pg8::DenseProb P; P.init(xin, ND, (const bf16*)(ws + WS_WABIN), NT, AB_IN, ND, F.G, (int)blockIdx.x); pg8::EpiBf16P2 E{PROJ, AB_IN};
                pg8::gemm_phase<pg8::EpiBf16P2, pg8::DenseProb, true>(F.lds, P, E, F.wave); }
            else if (l == 1 && MK_FP8_IN1 && MK_F8_NB2_IN) { pg8::DenseProb P; P.init((const bf16*)(ws + WS_X1F8), ND / 2, (const bf16*)(ws + WS_WCDIN), NT, CD_INP, ND / 2, F.G, (int)blockIdx.x); pg8::EpiBf16P2 E{PROJ, CD_INP};
                pg8::gemm_phase<pg8::EpiBf16P2, pg8::DenseProb, true, true, false>(F.lds, P, E, F.wave); }
            else if (l == 1 && MK_FP8_IN1) { pg8::DenseProb P; P.init((const bf16*)(ws + WS_X1F8), ND / 2, (const bf16*)(ws + WS_WCDIN), NT, CD_INP, ND / 2, F.G, (int)blockIdx.x, 128); pg8::EpiBf16N128 E{PROJ, CD_INP, 1.0f / 64.0f};
                pg8::gemm_phase<pg8::EpiBf16N128, pg8::DenseProb, true, true>(F.lds, P, E, F.wave); }
            else { pg8::DenseProb P; P.init(xin, ND, (const bf16*)(ws + WS_WCDIN), NT, CD_INP, ND, F.G, (int)blockIdx.x); pg8::EpiBf16P2 E{PROJ, CD_INP};
                pg8::gemm_phase<pg8::EpiBf16P2, pg8::DenseProb, true>(F.lds, P, E, F.wave); }
        } SEAM(pb + 0);
        if (l == 0) {
            if (IN(pb + 2)) { if (blockIdx.x < NB * 6) p_retention_mfma(F, (int)blockIdx.x); else p_pool(F, ((int)blockIdx.x - NB * 6) * NWAVES + F.wave, (F.G - NB * 6) * NWAVES);
                __syncthreads(); p_moe_weights_queue(F, F.ctl + CW_CNT + 320); } SEAM(pb + 2);
        } else {
            if (IN(pb + 1)) { cmp_bias_finish(F); p_l1_thin_a(F); } SEAM(pb + 1);
            if (IN(pb + 2)) {
                constexpr int NCMP = 16 * pg8::CMP_SPLIT;
                { pg8::DenseProb P; P.init((const bf16*)(ws + WS_CKVN), 512, (const bf16*)(ws + WS_WUKV), NT, 2048, 512, F.G, (int)blockIdx.x); pg8::EpiBf16P2 E{(bf16*)(ws + WS_KVU), 2048};
                  pg8::gemm_phase<pg8::EpiBf16P2, pg8::DenseProb, true>(F.lds, P, E, F.wave); }
                if (blockIdx.x < NCMP) { pg8::CmpProb P; P.K = 4096 / pg8::CMP_SPLIT; P.ldb = 4096; P.Abase = (const char*)(ws + WS_CMPKV); P.Bt = (const char*)(ws + WS_CW1); P.G = NCMP; P.c = (int)blockIdx.x;
                  pg8::EpiF32Split E{(float*)(ws + WS_HIDP), (const float*)(ws + WS_CMPB)};
                  pg8::gemm_phase<pg8::EpiF32Split, pg8::CmpProb, true>(F.lds, P, E, F.wave); }
                else {
                { pg8::DenseProb P; P.init((const bf16*)(ws + WS_CQN), 384, (const bf16*)(ws + WS_WUQ), NT, 1536, 384, F.G - NCMP, (int)blockIdx.x - NCMP); pg8::EpiBf16P2 E{(bf16*)(ws + WS_QMLA), 1536};
                  pg8::gemm_phase<pg8::EpiBf16P2, pg8::DenseProb, true>(F.lds, P, E, F.wave); }
                }
            } SEAM(pb + 2);
            if (IN(pb + 3)) { p_l1_thin_b(F); } SEAM(pb + 3);
            if (IN(pb + 4)) { p_nsa_cmp_mfma(F); } SEAM(pb + 4);
            if (IN(pb + 5)) { if (MK_ATTN_PRIO && F.wave < 4) __builtin_amdgcn_s_setprio(2);
                p_attn_nsa(F, F.ctl + CW_CNT + 257); p_attn_mla(F, F.ctl + CW_CNT + 256);     __builtin_amdgcn_s_setprio(0); } SEAM(pb + 5);
        }
        if (IN(pb + 6)) { pg8::DenseProb P; P.init(MIXIN, ND, (const bf16*)(ws + (l == 0 ? WS_WABOUT : WS_WCDOUT)), NT, ND, ND, F.G, (int)blockIdx.x); pg8::EpiBf16P2 E{MIXO, ND};
            pg8::gemm_phase<pg8::EpiBf16P2, pg8::DenseProb, true>(F.lds, P, E, F.wave); } SEAM(pb + 6);
        if (IN(pb + 7)) { p_ln1(F, xin, MIXO, kin(15) + l * ND, kin(16) + l * ND, X1B, MK_FP8_MOE ? (unsigned char*)(ws + WS_X1F8) : nullptr); } SEAM(pb + 7);
        if (IN(pb + 8)) { pg8::RouterProb P; P.K = 512; P.ldb = ND; P.Abase = (const char*)X1B; P.Bt = (const char*)(ws + WS_RT + (size_t)l * MiB); P.G = F.G; P.c = (int)blockIdx.x;
            pg8::EpiF32N64 E{(float*)(ws + WS_LOGITS)};
            pg8::gemm_phase<pg8::EpiF32N64, pg8::RouterProb, true>(F.lds, P, E, F.wave); } SEAM(pb + 8);
        if (IN(pb + 9)) { p_route(F, l); } SEAM(pb + 9);
        if (IN(pb + 11)) { load_offsets(F, l); const LAS int* tab = (const LAS int*)(F.lds + TAB_OFF);
            pg8::MoeUpProb P; P.W13 = (const char*)(ws + WS_W13 + (size_t)l * WS_MOE_LSTRIDE); P.sorted = (const int*)(ws + WS_SORTED2); P.tile_e = tab + 160; P.ntiles = __builtin_amdgcn_readfirstlane(tab[65]);
            P.G = F.G; P.c = (int)blockIdx.x;
            if (MK_FP8_MOE && MK_F8_NB2_UP) { P.K = ND / 2; P.ldb = ND / 2; P.arow = ND; P.brow = ND; P.pshift = 2; P.btile = 256; P.nunits = (P.ntiles + NT / 256) * 4; P.Abase = (const char*)(ws + WS_X1F8);
                pg8::EpiSwigluF8P2 E{(unsigned char*)HB};
                pg8::gemm_phase<pg8::EpiSwigluF8P2, pg8::MoeUpProb, true, true, false, true>(F.lds, P, E, F.wave); }
            else if (MK_FP8_MOE) { P.K = ND / 2; P.ldb = ND / 2; P.arow = ND; P.brow = ND; P.pshift = 3; P.btile = 128; P.nunits = (P.ntiles + NT / 256) * 8; P.Abase = (const char*)(ws + WS_X1F8);
                pg8::EpiSwigluF8 E{(unsigned char*)HB, 1.0f / 64.0f};
                pg8::gemm_phase<pg8::EpiSwigluF8, pg8::MoeUpProb, true, true>(F.lds, P, E, F.wave); }
            else { P.K = ND; P.ldb = ND; P.arow = ND * 2; P.brow = ND * 2; P.pshift = 2; P.btile = 256; P.nunits = (P.ntiles + NT / 256) * 4; P.Abase = (const char*)X1B;
                pg8::EpiSwiglu E{HB};
                pg8::gemm_phase<pg8::EpiSwiglu, pg8::MoeUpProb, true>(F.lds, P, E, F.wave); } } SEAM(pb + 11);
        if (IN(pb + 12)) { load_offsets(F, l); const LAS int* tab = (const LAS int*)(F.lds + TAB_OFF);
            pg8::MoeDownProb P; P.Abase = (const char*)HB; P.W2 = (const char*)(ws + WS_W2 + (size_t)l * WS_MOE_LSTRIDE); P.tile_e = tab + 160; P.ntiles = __builtin_amdgcn_readfirstlane(tab[65]);
            P.G = F.G; P.c = (int)blockIdx.x;
            if (MK_FP8_MOE && MK_F8_NB2) { P.K = EFF / 2; P.ldb = EFF / 2; P.arow = EFF; P.brow = EFF; P.pshift = 3; P.btile = 256; P.nunits = (P.ntiles + NT / 256) * 8;
                pg8::EpiFp8P2 E{(unsigned char*)Y2, ND};
                pg8::gemm_phase<pg8::EpiFp8P2, pg8::MoeDownProb, true, true, false>(F.lds, P, E, F.wave); }
            else if (MK_FP8_MOE) { P.K = EFF / 2; P.ldb = EFF / 2; P.arow = EFF; P.brow = EFF; P.pshift = 4; P.btile = 128; P.nunits = (P.ntiles + NT / 256) * 16;
                pg8::EpiFp8N128 E{(unsigned char*)Y2, ND, 16.0f / (64.0f * 8.0f)};
                pg8::gemm_phase<pg8::EpiFp8N128, pg8::MoeDownProb, true, true>(F.lds, P, E, F.wave); }
            else { P.K = EFF; P.ldb = EFF; P.arow = EFF * 2; P.brow = EFF * 2; P.pshift = 3; P.btile = 256; P.nunits = (P.ntiles + NT / 256) * 8;
                pg8::EpiFp8 E{(unsigned char*)Y2, ND, 16.0f};
                pg8::gemm_phase<pg8::EpiFp8, pg8::MoeDownProb, true>(F.lds, P, E, F.wave); } } SEAM(pb + 12);
        if (IN(pb + 13)) { load_offsets(F, l); p_combine_ln2(F, (const LAS int*)(F.lds + TAB_OFF), X1B, (const unsigned char*)Y2, (const int*)(ws + WS_SLOT), (const float*)(ws + WS_WSEL), kin(17) + l * ND, kin(18) + l * ND, l == 0 ? X2B : nullptr, l == 0 ? nullptr : F.out, (l == 0 && MK_FP8_IN1) ? (unsigned char*)(ws + WS_X1F8) : nullptr); } SEAM(pb + 13);
    }
__global__ void __launch_bounds__(NWAVES * 64, 2) mk_fwd(Args args) {
    extern __shared__ __attribute__((aligned(16))) unsigned char lds[];
    Frame F;
    F.lds = (LAS unsigned char*)lds;
    F.MISC = (volatile LAS unsigned*)(F.lds + MISC_OFF);
    F.tid = threadIdx.x; F.lane = F.tid & 63; F.wave = __builtin_amdgcn_readfirstlane(F.tid >> 6);
    F.G = gridDim.x; { const int bx = blockIdx.x; F.vcu = (F.G % 8 == 0) ? (bx % 8) * (F.G / 8) + bx / 8 : bx; }
    F.gw = F.vcu * NWAVES + F.wave; F.NGW = F.G * NWAVES;
    F.ws = args.ws; F.ctl = (unsigned*)(args.ws + WS_CTL); F.out = args.out;
    for (int u = F.tid; u < (LDS_BYTES - LDSCTL_OFF) / 4; u += NWAVES * 64) ((LAS unsigned*)(F.lds + LDSCTL_OFF))[u] = 0u;
    __syncthreads();
    XcdBarrier bar; bar.bar = F.ctl + CW_BAR; bar.x = 0; bar.st = nullptr; bar.wave = F.wave;
    if (MK_ONE_LAUNCH) bar = xcd_barrier_post(F.ctl + CW_BAR, F.MISC + 8);
    const int lo = args.ph_lo, hi = args.ph_hi;
    if (MK_PROBE_PHASE == 0 && blockIdx.x == 0 && F.tid == 0) ((volatile LAS unsigned long long*)(F.lds + LDSCTL_OFF + 64))[0] = __builtin_amdgcn_s_memrealtime();
    unsigned char* ws = args.ws;
    bf16* const XB0 = (bf16*)(ws + WS_XB0); bf16* const X1B = (bf16*)(ws + WS_X1B); bf16* const X2B = (bf16*)(ws + WS_X2B);
    bf16* const PROJ = (bf16*)(ws + WS_PROJ); bf16* const MIXIN = (bf16*)(ws + WS_MIXIN); bf16* const MIXO = (bf16*)(ws + WS_MIXO);
    bf16* const HB = (bf16*)(ws + WS_H); bf16* const Y2 = (bf16*)(ws + WS_Y2);

    if (IN(0)) { p_prologue(F); } SEAM(0);

    layer_body<0>(F, bar, lo, hi);
    layer_body<1>(F, bar, lo, hi);
    if (MK_PROBE_PHASE >= 0 && blockIdx.x == 0 && F.tid == 0) {
        volatile LAS unsigned long long* tsl = (volatile LAS unsigned long long*)(F.lds + LDSCTL_OFF + 64);
        if (MK_PROBE_LAST == 30) tsl[1] = __builtin_amdgcn_s_memrealtime();
        const unsigned long long span = (tsl[1] - tsl[0]) * MK_PROBE_AMP, t0 = __builtin_amdgcn_s_memrealtime();
        while (__builtin_amdgcn_s_memrealtime() - t0 < span) __builtin_amdgcn_s_sleep(8);
    }
#undef IN
#undef SEAM
}

extern "C" void kernel_launch(void* const* d_in, const int* in_sizes, int n_in, void* d_out, int out_size, void* d_ws, size_t ws_size, hipStream_t stream) {
    static int grid = 0;
    if (grid == 0) {
        if (n_in != 27 || in_sizes[0] != NT * ND || out_size != NT * ND || ws_size < WS_END) { fprintf(stderr, "kernel_launch: unexpected problem (n_in %d, in0 %d, out %d, ws %zu < %zu); nothing launched\n", n_in, n_in > 0 ? in_sizes[0] : -1, out_size, ws_size, (size_t)WS_END); grid = -1; return; }
        int dev = 0, cus = 0, per_cu = 0;
        if (hipGetDevice(&dev) != hipSuccess || hipDeviceGetAttribute(&cus, hipDeviceAttributeMultiprocessorCount, dev) != hipSuccess) { fprintf(stderr, "kernel_launch: device query failed\n"); grid = -1; return; }
        if (hipFuncSetAttribute((const void*)mk_fwd, hipFuncAttributeMaxDynamicSharedMemorySize, LDS_BYTES) != hipSuccess) { fprintf(stderr, "kernel_launch: hipFuncSetAttribute failed\n"); grid = -1; return; }
        if (hipOccupancyMaxActiveBlocksPerMultiprocessor(&per_cu, (const void*)mk_fwd, NWAVES * 64, LDS_BYTES) != hipSuccess || per_cu < 1) fprintf(stderr, "kernel_launch: note: occupancy query reports %d\n", per_cu);
        (void)hipGetLastError();
        grid = cus;
    }
    if (grid < 0) return;
    if (hipMemsetAsync((char*)d_ws + WS_CTL, 0, CTL_ZERO_BYTES, stream) != hipSuccess) { fprintf(stderr, "kernel_launch: memset failed\n"); return; }
    Args a{};
    for (int i = 0; i < 27; ++i) a.in[i] = (const float*)d_in[i];
    a.out = (float*)d_out; a.ws = (unsigned char*)d_ws;
#if MK_ONE_LAUNCH
    a.ph_lo = 0; a.ph_hi = NPHASE;
    hipLaunchKernelGGL(mk_fwd, dim3(grid), dim3(NWAVES * 64), LDS_BYTES, stream, a);
#else
    for (int p = 0; p < NPHASE; ++p) {
        const int lp = (p - 1) & 15;
        if (p >= 1) { const int l = (p - 1) >> 4; if (lp >= 14) continue; if (l == 0 && lp >= 3 && lp <= 5) continue; if (lp == 10) continue; }
        a.ph_lo = p; a.ph_hi = p + 1;
        hipLaunchKernelGGL(mk_fwd, dim3(grid), dim3(NWAVES * 64), LDS_BYTES, stream, a);
    }
#endif
    const hipError_t le = hipPeekAtLastError();
    if (le != hipSuccess) fprintf(stderr, "kernel_launch: launch failed: %s\n", hipGetErrorName(le));
}
```

```cpp
#include <hip/hip_runtime.h>
#include <cstdio>
#include <cstdint>

#ifndef MK_ONE_LAUNCH
#define MK_ONE_LAUNCH 1
#endif
#ifndef MK_FP8_MOE
#define MK_FP8_MOE 1
#endif
#ifndef MK_F8_PIPE
#define MK_F8_PIPE 0
#endif
#ifndef MK_FP8_INPROJ
#define MK_FP8_INPROJ 3
#endif
#define MK_FP8_IN0 ((MK_FP8_INPROJ & 1) != 0)
#define MK_FP8_IN1 ((MK_FP8_INPROJ & 2) != 0)
#ifndef MK_F8_NB2
#define MK_F8_NB2 1
#endif
#ifndef MK_F8_NB2_UP
#define MK_F8_NB2_UP 1
#endif
#ifndef MK_F8_NB2_IN
#define MK_F8_NB2_IN 1
#endif
#ifndef MK_ATTN_PRIO
#define MK_ATTN_PRIO 1
#endif
#ifndef MK_PROBE_PHASE
#define MK_PROBE_PHASE -1
#endif
#ifndef MK_PROBE_LAST
#define MK_PROBE_LAST MK_PROBE_PHASE
#endif
#ifndef MK_PROBE_AMP
#define MK_PROBE_AMP 4
#endif

#define GAS __attribute__((address_space(1)))
#define LAS __attribute__((address_space(3)))
typedef unsigned short bf16;
typedef unsigned v4u __attribute__((ext_vector_type(4)));
typedef unsigned v2u __attribute__((ext_vector_type(2)));
typedef float f32x4 __attribute__((ext_vector_type(4)));
typedef float f32x2 __attribute__((ext_vector_type(2)));
typedef short bf16x8 __attribute__((ext_vector_type(8)));

constexpr int NB = 8, NS = 2048, ND = 2048, NT = NB * NS;
constexpr float DN_ALPHA = 1.41421356237309505f;
constexpr float LN_EPS = 1e-5f, NORM_EPS = 1e-6f;
constexpr int AB_IN = 5120, CD_IN = 3544, CD_INP = 3584;
constexpr int NEXP = 64, EFF = 512;
constexpr int MAXROWS = NT * 8 + NEXP * 256;
constexpr int MAXTILES = MAXROWS / 256;
constexpr int SH_ROW0 = MAXROWS;

constexpr size_t MiB = 1u << 20;
constexpr size_t WS_CTL = 0, CTL_ZERO_BYTES = 1 * MiB;
constexpr size_t WS_TOPE = 1 * MiB, WS_WSEL = WS_TOPE + 512 * 1024, WS_SLOT = 2 * MiB, WS_SORTED = WS_SLOT + 512 * 1024;
constexpr size_t WS_CMPB = 3 * MiB + 256 * 1024, WS_SELM = 3 * MiB + 512 * 1024;
constexpr size_t WS_KVCMP = 4 * MiB;
constexpr size_t WS_HID = 6 * MiB;
constexpr size_t WS_SORTED2 = 10 * MiB;
constexpr size_t WS_WABIN = 16 * MiB, WS_WABOUT = 36 * MiB, WS_WCDIN = 44 * MiB, WS_WCDOUT = 58 * MiB, WS_WUQ = 66 * MiB, WS_WUKV = 68 * MiB, WS_CW1 = 70 * MiB, WS_RT = 72 * MiB;
constexpr size_t WS_W13 = 74 * MiB, WS_W2 = 334 * MiB, WS_MOE_LSTRIDE = 390 * MiB;
constexpr size_t WS_XB0 = 854 * MiB, WS_X2B = 854 * MiB, WS_X1B = 918 * MiB;
constexpr size_t WS_H = 982 * MiB, WS_Y2 = 1142 * MiB, WS_X1F8 = 1782 * MiB, WS_END = 1814 * MiB;
constexpr size_t WS_PROJ = 982 * MiB, WS_MIXIN = 1142 * MiB, WS_MIXO = 1206 * MiB;
constexpr size_t WS_HIDP = WS_MIXO;
constexpr size_t WS_QR = 1270 * MiB, WS_KR = 1294 * MiB;
constexpr size_t WS_CQN = 1270 * MiB, WS_CKVN = 1282 * MiB, WS_KROT = 1298 * MiB, WS_QMLA = 1302 * MiB, WS_KVU = 1350 * MiB, WS_CMPKV = 1414 * MiB, WS_OCMP = 1434 * MiB;
constexpr size_t WS_LOGITS = 1142 * MiB;
constexpr int CW_TMO = 0, CW_CODE = 1, CW_BAR = 4096, CW_CNT = 16384;

constexpr int RING_BYTES = 131072, LDSCTL_OFF = RING_BYTES, MISC_OFF = LDSCTL_OFF + 320, TAB_OFF = LDSCTL_OFF + 512;
constexpr int STASH_OFF = 147456;
constexpr int LDS_BYTES = 163840;
constexpr int NWAVES = 8;

#define LDS_WAIT() asm volatile("s_waitcnt lgkmcnt(0)" ::: "memory")
#define VM_WAIT() asm volatile("s_waitcnt vmcnt(0)" ::: "memory")
typedef __bf16 hwbf16x2 __attribute__((ext_vector_type(2)));
__device__ __forceinline__ unsigned pk2(float lo, float hi) { const f32x2 v = {lo, hi}; const hwbf16x2 b = __builtin_convertvector(v, hwbf16x2); return __builtin_bit_cast(unsigned, b); }
__device__ __forceinline__ unsigned f2bf(float f) { return pk2(f, 0.f) & 0xffffu; }
__device__ __forceinline__ void fast_sincos(float ang, float& sn, float& cs) { const float r = __builtin_amdgcn_fractf(ang * 0.15915494309189535f); sn = __builtin_amdgcn_sinf(r); cs = __builtin_amdgcn_cosf(r); }
__device__ __forceinline__ float bflo(unsigned w) { return __builtin_bit_cast(float, w << 16); }
__device__ __forceinline__ float bfhi(unsigned w) { return __builtin_bit_cast(float, w & 0xffff0000u); }
__device__ __forceinline__ float bf1(bf16 v) { return __builtin_bit_cast(float, ((unsigned)v) << 16); }
__device__ __forceinline__ int lane_id_fresh() { unsigned m = ~0u; asm volatile("" : "+s"(m)); return (int)__builtin_amdgcn_mbcnt_hi(m, __builtin_amdgcn_mbcnt_lo(m, 0u)); }
template <class T> __device__ __forceinline__ T mk_shfl_xor(T v, int mask) { return __builtin_bit_cast(T, __builtin_amdgcn_ds_bpermute((lane_id_fresh() ^ mask) << 2, __builtin_bit_cast(int, v))); }
template <class T> __device__ __forceinline__ T mk_shfl(T v, int src) { return __builtin_bit_cast(T, __builtin_amdgcn_ds_bpermute(src << 2, __builtin_bit_cast(int, v))); }
template <class T> __device__ __forceinline__ T mk_shfl_up(T v, int d) { const int l = lane_id_fresh(); return __builtin_bit_cast(T, __builtin_amdgcn_ds_bpermute((l >= d ? l - d : l) << 2, __builtin_bit_cast(int, v))); }
__device__ __forceinline__ float wave_sum(float v) {
#pragma unroll
    for (int o = 1; o < 64; o <<= 1) v += __shfl_xor(v, o);
    return v;
}
__device__ __forceinline__ float wave_max(float v) {
#pragma unroll
    for (int o = 1; o < 64; o <<= 1) v = fmaxf(v, __shfl_xor(v, o));
    return v;
}
__device__ __forceinline__ float sigmoidf_(float x) { return 1.0f / (1.0f + __expf(-x)); }
__device__ __forceinline__ float siluf_(float x) { return x * __builtin_amdgcn_rcpf(1.0f + __expf(-x)); }
__device__ __forceinline__ void unpack8(const v4u w, float (&f)[8]) {
    f[0] = bflo(w.x); f[1] = bfhi(w.x); f[2] = bflo(w.y); f[3] = bfhi(w.y); f[4] = bflo(w.z); f[5] = bfhi(w.z); f[6] = bflo(w.w); f[7] = bfhi(w.w);
}

#define XB_TMO      128
#define XB_XCNT(j)  (256  + 64 * (j))
#define XB_XSUB(j)  (1280 + 64 * (j))
#define XB_XGEN(j)  (2304 + 64 * (j))
#define XB_TOP      3328
#define XB_TOPGEN   3392
#define XCD_BAR_WORDS 3456
#define XB_SPIN_CAP (1u << 18)
__device__ __forceinline__ unsigned xb_ld(unsigned* p)              { return __hip_atomic_load(p, __ATOMIC_RELAXED, __HIP_MEMORY_SCOPE_AGENT); }
__device__ __forceinline__ unsigned xb_add(unsigned* p, unsigned v) { return __hip_atomic_fetch_add(p, v, __ATOMIC_RELAXED, __HIP_MEMORY_SCOPE_AGENT); }
__device__ __forceinline__ unsigned xb_xcc_id() { return (unsigned)__builtin_amdgcn_s_getreg((3 << 11) | 20) & 0xFu; }
#define XB_SPIN(cond, bar) do { unsigned _sp = 0; while (cond) { __builtin_amdgcn_s_sleep(1); \
    if ((++_sp & 255u) == 0u) { if (xb_ld(&(bar)[XB_TMO])) break; if (_sp > XB_SPIN_CAP) { atomicAdd(&(bar)[XB_TMO], 1u); break; } } } } while (0)
struct XcdBarrier { unsigned* bar; unsigned x; volatile LAS unsigned* st; int wave; };
__device__ __forceinline__ XcdBarrier xcd_barrier_post(unsigned* bar, volatile LAS unsigned* st) {
    XcdBarrier b; b.bar = bar; b.x = xb_xcc_id(); b.st = st; b.wave = __builtin_amdgcn_readfirstlane((int)(threadIdx.x >> 6));
    if (threadIdx.x == 0) (void)xb_add(&bar[XB_XCNT(b.x)], 1u);
    return b;
}
__device__ __forceinline__ void xcd_barrier_complete(unsigned* bar, unsigned x, unsigned& nloc, unsigned& nx) {
    const unsigned G = gridDim.x * gridDim.y * gridDim.z;
    unsigned sum, cnt, mine, sp = 0u;
    for (;;) {
        sum = 0u; cnt = 0u; mine = 0u;
#pragma unroll
        for (unsigned j = 0; j < 16; ++j) { const unsigned c = xb_ld(&bar[XB_XCNT(j)]); sum += c; cnt += (c > 0u) ? 1u : 0u; mine = (j == x) ? c : mine; }
        if (sum == G) break;
        __builtin_amdgcn_s_sleep(1);
        if ((++sp & 255u) == 0u) { if (xb_ld(&bar[XB_TMO])) break; if (sp > XB_SPIN_CAP) { atomicAdd(&bar[XB_TMO], 1u); break; } }
    }
    nloc = mine > 0u ? mine : 1u; nx = cnt > 0u ? cnt : 1u;
}
__device__ __forceinline__ void xcd_barrier(const XcdBarrier& b) {
    asm volatile("s_waitcnt vmcnt(0)" ::: "memory");
    __syncthreads();
    if (b.wave == 0 && lane_id_fresh() == 0) {
        unsigned* bar = b.bar;
        __builtin_amdgcn_s_waitcnt(0);
        unsigned nloc = b.st[0], nx = b.st[1];
        if (nloc == 0u) { xcd_barrier_complete(bar, b.x, nloc, nx); b.st[0] = nloc; b.st[1] = nx; }
        const unsigned old = xb_add(&bar[XB_XSUB(b.x)], 1u);
        const unsigned gen = old / nloc;
        if (old + 1u == (gen + 1u) * nloc) {
            __builtin_amdgcn_fence(__ATOMIC_RELEASE, "agent");
            asm volatile("s_waitcnt vmcnt(0)" ::: "memory");
            const unsigned og = xb_add(&bar[XB_TOP], 1u);
            const unsigned tg = og / nx;
            if (og + 1u == (tg + 1u) * nx) xb_add(&bar[XB_TOPGEN], 1u);
            else XB_SPIN(xb_ld(&bar[XB_TOPGEN]) == tg, bar);
            __builtin_amdgcn_fence(__ATOMIC_ACQUIRE, "agent");
            xb_add(&bar[XB_XGEN(b.x)], 1u);
            asm volatile("s_waitcnt vmcnt(0)" ::: "memory");
        } else {
            XB_SPIN(xb_ld(&bar[XB_XGEN(b.x)]) == gen, bar);
            __builtin_amdgcn_fence(__ATOMIC_ACQUIRE, "agent");
            asm volatile("s_waitcnt vmcnt(0)" ::: "memory");
        }
    }
    __syncthreads();
}

namespace pg8 {
typedef int v4i_t __attribute__((ext_vector_type(4)));
constexpr int BM = 256, BK = 64, HALF = 128, HTB = HALF * BK * 2, STAGE_BYTES = 8 * HTB, NXCD = 8, WGM = 8;
__host__ __device__ __forceinline__ int lds_byte(int r, int c) { const int st = (r >> 4) * 2 + (c >> 5), rr = r & 15, cc = c & 31, ob = rr * 64 + cc * 2; return st * 1024 + (ob ^ (((ob >> 9) & 1) << 5)); }
__host__ __device__ __forceinline__ void stage_rc(int b, int& R, int& C) { const int st = b / 1024, sb = b % 1024, swz = sb ^ (((sb >> 9) & 1) << 5); R = (st >> 1) * 16 + swz / 64; C = (st & 1) * 32 + (swz % 64) / 2; }
__host__ __device__ __forceinline__ int perm32(int rho) { const int n = rho >> 4, i = rho & 15; return 8 * (i >> 2) + 4 * n + (i & 3); }
struct Unit { int pm, pn, e; };

__device__ __forceinline__ unsigned cvt_pk_bf16(float lo, float hi) { unsigned r; asm volatile("v_cvt_pk_bf16_f32 %0, %1, %2" : "=v"(r) : "v"(lo), "v"(hi)); return r; }

struct EpiBf16 {
    static constexpr bool PERM = true; static constexpr bool PERM2 = false; static constexpr unsigned SCALE_A = 0x7F7F7F7Fu;
    bf16* O; int ldc;
    __device__ __forceinline__ void operator()(const f32x4 (&acc)[2][2][4][2], const Unit& u, int wr, int wc, int fr, int fq) const {
        const int row0 = u.pm * BM + wr * 64 + fr, col0 = u.pn * BM + wc * 32 + 8 * fq;
#pragma unroll
        for (int ai = 0; ai < 2; ++ai)
#pragma unroll
            for (int m = 0; m < 4; ++m) { bf16* rowp = O + (size_t)(row0 + ai * HALF + m * 16) * ldc + col0;
#pragma unroll
                for (int bj = 0; bj < 2; ++bj) { const f32x4 v0 = acc[ai][bj][m][0], v1 = acc[ai][bj][m][1];
                    v4u w; w.x = cvt_pk_bf16(v0[0], v0[1]); w.y = cvt_pk_bf16(v0[2], v0[3]); w.z = cvt_pk_bf16(v1[0], v1[1]); w.w = cvt_pk_bf16(v1[2], v1[3]);
                    *(v4u*)(rowp + bj * HALF) = w; } }
    }
};
struct EpiFp8 {
    static constexpr bool PERM = true; static constexpr bool PERM2 = false; static constexpr unsigned SCALE_A = 0x7A7A7A7Au;
    unsigned char* O; int ldc; float mul;
    __device__ __forceinline__ void operator()(const f32x4 (&acc)[2][2][4][2], const Unit& u, int wr, int wc, int fr, int fq) const {
        const int row0 = u.pm * BM + wr * 64 + fr, col0 = u.pn * BM + wc * 32 + 8 * fq;
#pragma unroll
        for (int ai = 0; ai < 2; ++ai)
#pragma unroll
            for (int m = 0; m < 4; ++m) { unsigned char* rowp = O + (size_t)(row0 + ai * HALF + m * 16) * ldc + col0;
#pragma unroll
                for (int bj = 0; bj < 2; ++bj) { float v[8];
#pragma unroll
                    for (int n = 0; n < 2; ++n)
#pragma unroll
                        for (int j = 0; j < 4; ++j) v[n * 4 + j] = fminf(fmaxf(acc[ai][bj][m][n][j] * mul, -448.0f), 448.0f);
                    int w0 = __builtin_amdgcn_cvt_pk_fp8_f32(v[0], v[1], 0, false); w0 = __builtin_amdgcn_cvt_pk_fp8_f32(v[2], v[3], w0, true);
                    int w1 = __builtin_amdgcn_cvt_pk_fp8_f32(v[4], v[5], 0, false); w1 = __builtin_amdgcn_cvt_pk_fp8_f32(v[6], v[7], w1, true);
                    *(v2u*)(rowp + bj * HALF) = (v2u){(unsigned)w0, (unsigned)w1}; } }
    }
};
struct EpiBf16P2 {
    static constexpr bool PERM = true; static constexpr bool PERM2 = true; static constexpr unsigned SCALE_A = 0x79797979u;
    bf16* O; int ldc;
    __device__ __forceinline__ void operator()(const f32x4 (&acc)[2][2][4][2], const Unit& u, int wr, int wc, int fr, int fq) const {
        const int row0 = u.pm * BM + wr * 64 + fr, col0 = u.pn * BM + wc * 64 + 16 * fq;
#pragma unroll
        for (int ai = 0; ai < 2; ++ai)
#pragma unroll
            for (int m = 0; m < 4; ++m) { bf16* rowp = O + (size_t)(row0 + ai * HALF + m * 16) * ldc + col0;
#pragma unroll
                for (int bj = 0; bj < 2; ++bj) { const f32x4 v0 = acc[ai][bj][m][0], v1 = acc[ai][bj][m][1];
                    v4u w; w.x = cvt_pk_bf16(v0[0], v0[1]); w.y = cvt_pk_bf16(v0[2], v0[3]); w.z = cvt_pk_bf16(v1[0], v1[1]); w.w = cvt_pk_bf16(v1[2], v1[3]);
                    *(v4u*)(rowp + bj * 8) = w; } }
    }
};
struct EpiSwigluF8P2 {
    static constexpr bool PERM = true; static constexpr bool PERM2 = true; static constexpr unsigned SCALE_A = 0x79797979u;
    unsigned char* H;
    __device__ __forceinline__ v2u pack(const f32x4 (&acc)[2][2][4][2], int ai, int m) const { v2u w;
#pragma unroll
        for (int bj = 0; bj < 2; ++bj) { float o[4];
#pragma unroll
            for (int j = 0; j < 4; j += 2) {
                const f32x2 a = {acc[ai][bj][m][0][j], acc[ai][bj][m][0][j + 1]}, b3 = {acc[ai][bj][m][1][j], acc[ai][bj][m][1][j + 1]};
                f32x2 t = a * (f32x2){-1.4426950408889634f, -1.4426950408889634f};
                t = (f32x2){__builtin_amdgcn_exp2f(t[0]), __builtin_amdgcn_exp2f(t[1])} + (f32x2){1.0f, 1.0f};
                t = (f32x2){__builtin_amdgcn_rcpf(t[0]), __builtin_amdgcn_rcpf(t[1])};
                t = (a * t) * (b3 * (f32x2){8.0f, 8.0f});
                o[j] = __builtin_amdgcn_fmed3f(t[0], -448.0f, 448.0f); o[j + 1] = __builtin_amdgcn_fmed3f(t[1], -448.0f, 448.0f); }
            int w0 = __builtin_amdgcn_cvt_pk_fp8_f32(o[0], o[1], 0, false); w0 = __builtin_amdgcn_cvt_pk_fp8_f32(o[2], o[3], w0, true);
            if (bj == 0) w.x = (unsigned)w0; else w.y = (unsigned)w0; }
        return w; }
    __device__ __forceinline__ void operator()(const f32x4 (&acc)[2][2][4][2], const Unit& u, int wr, int wc, int fr, int fq) const {
        const int odd = fq & 1;
        const int row0 = u.pm * BM + wr * 64 + fr + 16 * odd, col0 = u.pn * 128 + wc * 32 + 8 * (fq - odd);
#pragma unroll
        for (int ai = 0; ai < 2; ++ai)
#pragma unroll
            for (int mp = 0; mp < 2; ++mp) { const v2u a = pack(acc, ai, 2 * mp), b = pack(acc, ai, 2 * mp + 1);
                const auto sx = __builtin_amdgcn_permlane16_swap(a.x, b.x, false, false); const auto sy = __builtin_amdgcn_permlane16_swap(a.y, b.y, false, false);
                *(v4u*)(H + (size_t)(row0 + ai * HALF + mp * 32) * EFF + col0) = (v4u){(unsigned)sx[0], (unsigned)sy[0], (unsigned)sx[1], (unsigned)sy[1]}; }
    }
};
struct EpiFp8P2 {
    static constexpr bool PERM = true; static constexpr bool PERM2 = true; static constexpr unsigned SCALE_A = 0x7A7A7A7Au;
    unsigned char* O; int ldc;
    __device__ __forceinline__ void operator()(const f32x4 (&acc)[2][2][4][2], const Unit& u, int wr, int wc, int fr, int fq) const {
        const int row0 = u.pm * BM + wr * 64 + fr, col0 = u.pn * BM + wc * 64 + 16 * fq;
#pragma unroll
        for (int ai = 0; ai < 2; ++ai)
#pragma unroll
            for (int m = 0; m < 4; ++m) { unsigned char* rowp = O + (size_t)(row0 + ai * HALF + m * 16) * ldc + col0; v4u w;
#pragma unroll
                for (int bj = 0; bj < 2; ++bj) { float v[8];
#pragma unroll
                    for (int n = 0; n < 2; ++n)
#pragma unroll
                        for (int j = 0; j < 4; ++j) v[n * 4 + j] = fminf(fmaxf(acc[ai][bj][m][n][j], -448.0f), 448.0f);
                    int w0 = __builtin_amdgcn_cvt_pk_fp8_f32(v[0], v[1], 0, false); w0 = __builtin_amdgcn_cvt_pk_fp8_f32(v[2], v[3], w0, true);
                    int w1 = __builtin_amdgcn_cvt_pk_fp8_f32(v[4], v[5], 0, false); w1 = __builtin_amdgcn_cvt_pk_fp8_f32(v[6], v[7], w1, true);
                    if (bj == 0) { w.x = (unsigned)w0; w.y = (unsigned)w1; } else { w.z = (unsigned)w0; w.w = (unsigned)w1; } }
                *(v4u*)rowp = w; }
    }
};
struct EpiF32 {
    static constexpr bool PERM = false; static constexpr bool PERM2 = false; static constexpr unsigned SCALE_A = 0x7F7F7F7Fu;
    float* C; int ldc; const float* bias;
    __device__ __forceinline__ void operator()(const f32x4 (&acc)[2][2][4][2], const Unit& u, int wr, int wc, int fr, int fq) const {
        const int row0 = u.pm * BM + wr * 64 + fr, col0 = u.pn * BM + wc * 32 + 4 * fq;
        f32x4 bv[2][2];
#pragma unroll
        for (int bj = 0; bj < 2; ++bj)
#pragma unroll
            for (int n = 0; n < 2; ++n) bv[bj][n] = bias ? *(const f32x4*)(bias + col0 + bj * HALF + n * 16) : (f32x4){0.f, 0.f, 0.f, 0.f};
#pragma unroll
        for (int ai = 0; ai < 2; ++ai)
#pragma unroll
            for (int m = 0; m < 4; ++m) { float* rowp = C + (size_t)(row0 + ai * HALF + m * 16) * ldc + col0;
#pragma unroll
                for (int bj = 0; bj < 2; ++bj)
#pragma unroll
                    for (int n = 0; n < 2; ++n) *(f32x4*)(rowp + bj * HALF + n * 16) = acc[ai][bj][m][n] + bv[bj][n]; }
    }
};
struct EpiF32Split {
    static constexpr bool PERM = false; static constexpr bool PERM2 = false; static constexpr unsigned SCALE_A = 0x7F7F7F7Fu;
    float* C; const float* bias;
    __device__ __forceinline__ void operator()(const f32x4 (&acc)[2][2][4][2], const Unit& u, int wr, int wc, int fr, int fq) const {
        const int row0 = u.pm * BM + wr * 64 + fr, col0 = wc * 32 + 4 * fq;
        f32x4 bv[2][2];
#pragma unroll
        for (int bj = 0; bj < 2; ++bj)
#pragma unroll
            for (int n = 0; n < 2; ++n) bv[bj][n] = u.e == 0 ? *(const f32x4*)(bias + col0 + bj * HALF + n * 16) : (f32x4){0.f, 0.f, 0.f, 0.f};
#pragma unroll
        for (int ai = 0; ai < 2; ++ai)
#pragma unroll
            for (int m = 0; m < 4; ++m) { float* rowp = C + ((size_t)u.e * 4096 + row0 + ai * HALF + m * 16) * 256 + col0;
#pragma unroll
                for (int bj = 0; bj < 2; ++bj)
#pragma unroll
                    for (int n = 0; n < 2; ++n) *(f32x4*)(rowp + bj * HALF + n * 16) = acc[ai][bj][m][n] + bv[bj][n]; }
    }
};
struct EpiSwiglu {
    static constexpr bool PERM = true; static constexpr bool PERM2 = false; static constexpr unsigned SCALE_A = 0x7F7F7F7Fu;
    bf16* H;
    __device__ __forceinline__ void operator()(const f32x4 (&acc)[2][2][4][2], const Unit& u, int wr, int wc, int fr, int fq) const {
        const int row0 = u.pm * BM + wr * 64 + fr, col0 = u.pn * HALF + wc * 32 + 8 * fq;
#pragma unroll
        for (int ai = 0; ai < 2; ++ai)
#pragma unroll
            for (int m = 0; m < 4; ++m) { bf16* rowp = H + (size_t)(row0 + ai * HALF + m * 16) * EFF + col0;
                float o[8];
#pragma unroll
                for (int n = 0; n < 2; ++n)
#pragma unroll
                    for (int j = 0; j < 4; ++j) { const float h1 = acc[ai][0][m][n][j], h3 = acc[ai][1][m][n][j]; o[n * 4 + j] = siluf_(h1) * h3; }
                v4u w; w.x = cvt_pk_bf16(o[0], o[1]); w.y = cvt_pk_bf16(o[2], o[3]); w.z = cvt_pk_bf16(o[4], o[5]); w.w = cvt_pk_bf16(o[6], o[7]);
                *(v4u*)rowp = w; }
    }
};

template <class Epi, class Prob, bool ALIGN_EPI, bool F8 = false, bool NB1 = F8, bool STASH = false>
__device__ __forceinline__ void gemm_phase(LAS unsigned char* lds, const Prob& P, const Epi& E, const int wave) {
    const int wid = __builtin_amdgcn_readfirstlane(wave), lane = lane_id_fresh(), tid = wid * 64 + lane, wr = wid >> 2, wc = wid & 3, fr = lane & 15, fq = lane >> 4;
    const int K = P.K, nt = K / BK, ldb = P.ldb;
    unsigned voffB[2];
#pragma unroll
    for (int i = 0; i < 2; ++i) { int R, C; stage_rc(tid * 16 + i * 8192, R, C);
        const int Rb = Epi::PERM2 ? (64 * (R >> 5) + 16 * ((R & 15) >> 2) + 4 * ((R >> 4) & 1) + (R & 3)) : Epi::PERM ? ((R & ~31) + perm32(R & 31)) : R;
        voffB[i] = (unsigned)(Rb * ldb + C) * 2u; }
    const size_t kstep = (size_t)(BK * 2);
    const size_t hstep = (size_t)(Epi::PERM2 ? 8 : HALF) * ldb * 2, b64step = (size_t)(Epi::PERM2 ? 128 : 64) * ldb * 2;
    const unsigned ldsw = (unsigned)wid * 1024u;
    const int aoff = lds_byte(wr * 64 + fr, fq * 8), boff = lds_byte(wc * 32 + fr, fq * 8);
    const char* const Ab = P.Abase;
#define PG8_SA(b, h) (((b) * 2 + (h)) * HTB)
#define PG8_SB(b, h) ((4 + (b) * 2 + (h)) * HTB)
#define PG8_OPQ(x) ({ unsigned _v = (x); asm volatile("" : "+v"(_v)); _v; })
#define PG8_STAGE(bufoff, gbase, voff) do { _Pragma("unroll") for (int _i = 0; _i < 2; ++_i) \
        __builtin_amdgcn_global_load_lds((const unsigned*)((const char*)(gbase) + (size_t)_i * b64step + PG8_OPQ((voff)[0])), (LAS unsigned*)(lds + (bufoff) + ldsw + _i * 8192), 16, 0, 0); } while (0)
#define PG8_STAGE_A(bufoff, kb, o0, o1) do { \
        __builtin_amdgcn_global_load_lds((const unsigned*)(Ab + (kb) + PG8_OPQ(o0)), (LAS unsigned*)(lds + (bufoff) + ldsw), 16, 0, 0); \
        __builtin_amdgcn_global_load_lds((const unsigned*)(Ab + (kb) + PG8_OPQ(o1)), (LAS unsigned*)(lds + (bufoff) + ldsw + 8192), 16, 0, 0); } while (0)
#define PG8_STAGE_AH(bufoff, kb, h, nx) do { \
        if constexpr (Prob::DENSE_A) { const char* _b = ((nx) ? nAb : cAb) + (size_t)(h) * hstepA + (kb); \
            __builtin_amdgcn_global_load_lds((const unsigned*)(_b + PG8_OPQ(voffA[0])), (LAS unsigned*)(lds + (bufoff) + ldsw), 16, 0, 0); \
            __builtin_amdgcn_global_load_lds((const unsigned*)(_b + a64step + PG8_OPQ(voffA[0])), (LAS unsigned*)(lds + (bufoff) + ldsw + 8192), 16, 0, 0); } \
        else if constexpr (STASH) { const v2u _o = *(const LAS v2u*)(stashp + ((nx) ? nslot : cslot) * 16 + (h) * 8); PG8_STAGE_A(bufoff, kb, _o.x, _o.y); } \
        else { const unsigned _o0 = (nx) ? on[2 * (h)] : oc[2 * (h)], _o1 = (nx) ? on[2 * (h) + 1] : oc[2 * (h) + 1]; PG8_STAGE_A(bufoff, kb, _o0, _o1); } } while (0)
#define PG8_STASH_PRE(h, nx) do { if constexpr (STASH) so_ = *(const LAS v2u*)(stashp + ((nx) ? nslot : cslot) * 16 + (h) * 8); } while (0)
#define PG8_STAGE_AHP(bufoff, kb, h, nx) do { if constexpr (STASH) { PG8_STAGE_A(bufoff, kb, so_.x, so_.y); } else { PG8_STAGE_AH(bufoff, kb, h, nx); } } while (0)
#define PG8_LDA(dst, b, h) do { _Pragma("unroll") for (int m = 0; m < 4; ++m) _Pragma("unroll") for (int k = 0; k < 2; ++k) dst[m][k] = *(const LAS bf16x8*)(lds + PG8_SA(b, h) + aoff + m * 2048 + k * 1024); } while (0)
#define PG8_LDB(dst, b, h) do { _Pragma("unroll") for (int n = 0; n < 2; ++n) _Pragma("unroll") for (int k = 0; k < 2; ++k) dst[n][k] = *(const LAS bf16x8*)(lds + PG8_SB(b, h) + boff + n * 2048 + k * 1024); } while (0)
#define PG8_CAT(lo, hi) __builtin_shufflevector(__builtin_bit_cast(v4i_t, lo), __builtin_bit_cast(v4i_t, hi), 0, 1, 2, 3, 4, 5, 6, 7)
#define PG8_MMA(ai, bj, At, Bt) do { __builtin_amdgcn_s_setprio(1); \
        if constexpr (F8) { _Pragma("unroll") for (int m = 0; m < 4; ++m) _Pragma("unroll") for (int n = 0; n < 2; ++n) \
            acc[ai][bj][m][n] = __builtin_amdgcn_mfma_scale_f32_16x16x128_f8f6f4(PG8_CAT(Bt[n][0], Bt[n][1]), PG8_CAT(At[m][0], At[m][1]), acc[ai][bj][m][n], 0, 0, 0, (int)Epi::SCALE_A, 0, 0x7F7F7F7F); } \
        else { _Pragma("unroll") for (int m = 0; m < 4; ++m) _Pragma("unroll") for (int n = 0; n < 2; ++n) _Pragma("unroll") for (int k = 0; k < 2; ++k) \
            acc[ai][bj][m][n] = __builtin_amdgcn_mfma_f32_16x16x32_bf16(Bt[n][k], At[m][k], acc[ai][bj][m][n], 0, 0, 0); } \
        __builtin_amdgcn_s_setprio(0); } while (0)
#define PG8_WAIT_V(n) asm volatile("s_waitcnt vmcnt(" #n ")" ::: "memory")
#define PG8_WAIT_L(n) asm volatile("s_waitcnt lgkmcnt(" #n ")" ::: "memory")
#define PG8_BAR __builtin_amdgcn_s_barrier()
#define PG8_SCHED __builtin_amdgcn_sched_barrier(0)
    Unit cur, nxt; int ui = 0;
    if (!P.next(0, cur)) return;
    f32x4 acc[2][2][4][2];
#pragma unroll
    for (int a = 0; a < 2; ++a)
#pragma unroll
        for (int b = 0; b < 2; ++b)
#pragma unroll
            for (int m = 0; m < 4; ++m)
#pragma unroll
                for (int n = 0; n < 2; ++n) acc[a][b][m][n] = (f32x4){0.f, 0.f, 0.f, 0.f};
    bf16x8 At[4][2], B0[2][2], B1[2][2];
    bf16x8 At2[4][2], B02[2][2];
    LAS unsigned char* const stashp = lds + STASH_OFF + tid * 32; int cslot = 0, nslot = 0; v2u so_ = {0u, 0u};
    unsigned oc[4], on[4], voffA[2]; const char* cAb = nullptr; const char* nAb = nullptr; size_t hstepA = 0, a64step = 0;
    if constexpr (Prob::DENSE_A) { int RA[2], CA[2]; stage_rc(tid * 16, RA[0], CA[0]); stage_rc(tid * 16 + 8192, RA[1], CA[1]);
        voffA[0] = (unsigned)(RA[0] * P.arow + CA[0] * 2); voffA[1] = (unsigned)(RA[1] * P.arow + CA[1] * 2); hstepA = (size_t)HALF * P.arow; a64step = (size_t)64 * P.arow; cAb = P.abase(cur); nAb = cAb;
        oc[0] = oc[1] = oc[2] = oc[3] = 0u; on[0] = on[1] = on[2] = on[3] = 0u; }
    else { int RA[2], CA[2]; stage_rc(tid * 16, RA[0], CA[0]); stage_rc(tid * 16 + 8192, RA[1], CA[1]); P.aoffs(cur, RA, CA, oc); voffA[0] = voffA[1] = 0u;
        if constexpr (STASH) *(LAS v4u*)stashp = (v4u){oc[0], oc[1], oc[2], oc[3]}; }
    const char* cB = P.bbase(cur);
    if constexpr (NB1) {
        PG8_STAGE(PG8_SB(0, 0), cB, voffB); PG8_STAGE_AH(PG8_SA(0, 0), (size_t)0, 0, false); PG8_STAGE_AH(PG8_SA(0, 1), (size_t)0, 1, false);
        if (wr == 1) PG8_BAR;
        PG8_WAIT_V(2); PG8_BAR;
        PG8_STAGE(PG8_SB(1, 0), cB + kstep, voffB); PG8_STAGE_AH(PG8_SA(1, 0), kstep, 0, false);
        PG8_WAIT_V(4); PG8_BAR;
        if constexpr (MK_F8_PIPE != 0) { PG8_SCHED; PG8_LDB(B0, 0, 0); PG8_LDA(At, 0, 0); }
    } else {
    PG8_STAGE(PG8_SB(0, 0), cB, voffB); PG8_STAGE(PG8_SB(0, 1), cB + hstep, voffB); PG8_STAGE_AH(PG8_SA(0, 0), (size_t)0, 0, false); PG8_STAGE_AH(PG8_SA(0, 1), (size_t)0, 1, false);
    if (wr == 1) PG8_BAR;
    PG8_WAIT_V(2); PG8_BAR;
    PG8_STAGE(PG8_SB(1, 0), cB + kstep, voffB); PG8_STAGE_AH(PG8_SA(1, 0), kstep, 0, false); PG8_STAGE(PG8_SB(1, 1), cB + hstep + kstep, voffB);
    PG8_WAIT_V(6); PG8_BAR;
    }
    for (;;) {
        const bool has_next = P.next(ui + 1, nxt);
        const char* nB = cB;
        if constexpr (Prob::DENSE_A) { nAb = cAb; if (has_next) { nAb = P.abase(nxt); nB = P.bbase(nxt); } }
        else if constexpr (STASH) { cslot = ui & 1; nslot = cslot;
               if (has_next) { int RA[2], CA[2]; stage_rc(tid * 16, RA[0], CA[0]); stage_rc(tid * 16 + 8192, RA[1], CA[1]); P.aoffs(nxt, RA, CA, on); nB = P.bbase(nxt); nslot = cslot ^ 1;
                   *(LAS v4u*)(stashp + nslot * 16) = (v4u){on[0], on[1], on[2], on[3]}; } }
        else { if (has_next) { int RA[2], CA[2]; stage_rc(tid * 16, RA[0], CA[0]); stage_rc(tid * 16 + 8192, RA[1], CA[1]); P.aoffs(nxt, RA, CA, on); nB = P.bbase(nxt); }
               else { on[0] = oc[0]; on[1] = oc[1]; on[2] = oc[2]; on[3] = oc[3]; } }
#pragma clang loop unroll(disable)
        for (int t = 0; t < nt; t += 2) {
            const bool last = (t == nt - 2);
            const size_t kb1 = (size_t)(t + 1) * kstep;
            const size_t kb2 = last ? (size_t)0 : (size_t)(t + 2) * kstep, kb3 = kb2 + kstep;
            const char* b2 = last ? nB : cB + (size_t)(t + 2) * kstep; const char* b3 = b2 + kstep;
            if constexpr (NB1 && MK_F8_PIPE != 0) {
            PG8_STAGE_AH(PG8_SA(1, 1), kb1, 1, false);
            PG8_WAIT_V(6); PG8_WAIT_L(0); PG8_BAR; PG8_SCHED; PG8_LDA(At2, 0, 1); PG8_MMA(0, 0, At, B0); PG8_BAR; PG8_SCHED;
            PG8_STAGE(PG8_SB(0, 0), b2, voffB); PG8_STAGE_AH(PG8_SA(0, 0), kb2, 0, last);
            PG8_WAIT_V(6); PG8_WAIT_L(0); PG8_BAR; PG8_SCHED; PG8_LDB(B02, 1, 0); PG8_LDA(At, 1, 0); PG8_MMA(1, 0, At2, B0); PG8_BAR; PG8_SCHED;
            PG8_STAGE_AH(PG8_SA(0, 1), kb2, 1, last);
            PG8_WAIT_V(6); PG8_WAIT_L(0); PG8_BAR; PG8_SCHED; PG8_LDA(At2, 1, 1); PG8_MMA(0, 0, At, B02); PG8_BAR; PG8_SCHED;
            PG8_STAGE(PG8_SB(1, 0), b3, voffB); PG8_STAGE_AH(PG8_SA(1, 0), kb3, 0, last);
            PG8_WAIT_V(6); PG8_WAIT_L(0); PG8_BAR; PG8_SCHED; PG8_LDB(B0, 0, 0); PG8_LDA(At, 0, 0); PG8_MMA(1, 0, At2, B02); PG8_BAR; PG8_SCHED;
            } else if constexpr (NB1) {
            PG8_LDB(B0, 0, 0); PG8_SCHED; PG8_LDA(At, 0, 0); PG8_STAGE_AH(PG8_SA(1, 1), kb1, 1, false);
            PG8_WAIT_V(6); PG8_WAIT_L(0); PG8_BAR; PG8_MMA(0, 0, At, B0); PG8_BAR; PG8_SCHED;
            PG8_LDA(At, 0, 1); PG8_STAGE(PG8_SB(0, 0), b2, voffB); PG8_STAGE_AH(PG8_SA(0, 0), kb2, 0, last);
            PG8_WAIT_V(6); PG8_WAIT_L(0); PG8_BAR; PG8_MMA(1, 0, At, B0); PG8_BAR; PG8_SCHED;
            PG8_LDB(B0, 1, 0); PG8_SCHED; PG8_LDA(At, 1, 0); PG8_STAGE_AH(PG8_SA(0, 1), kb2, 1, last);
            PG8_WAIT_V(6); PG8_WAIT_L(0); PG8_BAR; PG8_MMA(0, 0, At, B0); PG8_BAR; PG8_SCHED;
            PG8_LDA(At, 1, 1); PG8_STAGE(PG8_SB(1, 0), b3, voffB); PG8_STAGE_AH(PG8_SA(1, 0), kb3, 0, last);
            PG8_WAIT_V(6); PG8_WAIT_L(0); PG8_BAR; PG8_MMA(1, 0, At, B0); PG8_BAR; PG8_SCHED;
            } else {
            PG8_STASH_PRE(1, false); PG8_LDB(B0, 0, 0); PG8_LDB(B1, 0, 1); PG8_SCHED; PG8_LDA(At, 0, 0); PG8_STAGE_AHP(PG8_SA(1, 1), kb1, 1, false);
            PG8_WAIT_V(8); PG8_WAIT_L(0); PG8_BAR; PG8_MMA(0, 0, At, B0); PG8_MMA(0, 1, At, B1); PG8_BAR; PG8_SCHED;
            PG8_STASH_PRE(0, last); PG8_LDA(At, 0, 1); PG8_STAGE(PG8_SB(0, 0), b2, voffB); PG8_STAGE(PG8_SB(0, 1), b2 + hstep, voffB); PG8_STAGE_AHP(PG8_SA(0, 0), kb2, 0, last);
            PG8_WAIT_V(8); PG8_WAIT_L(0); PG8_BAR; PG8_MMA(1, 0, At, B0); PG8_MMA(1, 1, At, B1); PG8_BAR; PG8_SCHED;
            PG8_STASH_PRE(1, last); PG8_LDB(B0, 1, 0); PG8_LDB(B1, 1, 1); PG8_SCHED; PG8_LDA(At, 1, 0); PG8_STAGE_AHP(PG8_SA(0, 1), kb2, 1, last);
            PG8_WAIT_V(8); PG8_WAIT_L(0); PG8_BAR; PG8_MMA(0, 0, At, B0); PG8_MMA(0, 1, At, B1); PG8_BAR; PG8_SCHED;
            PG8_STASH_PRE(0, last); PG8_LDA(At, 1, 1); PG8_STAGE(PG8_SB(1, 0), b3, voffB); PG8_STAGE(PG8_SB(1, 1), b3 + hstep, voffB); PG8_STAGE_AHP(PG8_SA(1, 0), kb3, 0, last);
            PG8_WAIT_V(8); PG8_WAIT_L(0); PG8_BAR; PG8_MMA(1, 0, At, B0); PG8_MMA(1, 1, At, B1); PG8_BAR; PG8_SCHED;
            }
        }
        if constexpr (ALIGN_EPI) { if (wr == 0) PG8_BAR; }
        { const int l2 = lane_id_fresh(); E(acc, cur, wr, wc, l2 & 15, l2 >> 4); }
        if (!has_next) break;
#pragma unroll
        for (int a = 0; a < 2; ++a)
#pragma unroll
            for (int b = 0; b < 2; ++b)
#pragma unroll
                for (int m = 0; m < 4; ++m)
#pragma unroll
                    for (int n = 0; n < 2; ++n) acc[a][b][m][n] = (f32x4){0.f, 0.f, 0.f, 0.f};
        cur = nxt; cB = nB; cAb = nAb; if constexpr (!STASH) { oc[0] = on[0]; oc[1] = on[1]; oc[2] = on[2]; oc[3] = on[3]; } ++ui;
        if constexpr (ALIGN_EPI) { if (wr == 1) PG8_BAR; }
    }
    PG8_WAIT_V(0);
    if constexpr (!ALIGN_EPI) { if (wr == 0) PG8_BAR; }
    PG8_BAR;
#undef PG8_SA
#undef PG8_SB
#undef PG8_STAGE
#undef PG8_OPQ
#undef PG8_STAGE_A
#undef PG8_STAGE_AH
#undef PG8_STAGE_AHP
#undef PG8_STASH_PRE
#undef PG8_LDA
#undef PG8_LDB
#undef PG8_MMA
#undef PG8_CAT
#undef PG8_WAIT_V
#undef PG8_WAIT_L
#undef PG8_BAR
#undef PG8_SCHED
}

struct DenseProb {
    static constexpr bool DENSE_A = true; int arow;
    __device__ __forceinline__ const char* abase(const Unit& u) const { return Abase + (size_t)u.pm * BM * arow; }
    int K, ldb; const char* Abase; const char* Bt; int lda; int nM, nN, nwg, G, c, bn;
    __device__ __forceinline__ void init(const bf16* A, int lda_, const bf16* B, int M, int N, int K_, int G_, int c_, int bn_ = BM) { Abase = (const char*)A; Bt = (const char*)B; lda = lda_; arow = lda_ * 2; K = K_; ldb = K_; bn = bn_; nM = M / BM; nN = N / bn_; nwg = nM * nN; G = G_; c = c_; }
    __device__ __forceinline__ bool next(int i, Unit& u) const {
        const long L = (long)i * G + c; if (L >= nwg) return false;
        int wgid = (int)L; { const int q = nwg / NXCD, r = nwg % NXCD, xcd = wgid % NXCD, off = wgid / NXCD; wgid = (xcd < r ? xcd * (q + 1) : r * (q + 1) + (xcd - r) * q) + off; }
        const int nig = WGM * nN, gid = wgid / nig, fm = gid * WGM, gsz = (nM - fm) < WGM ? (nM - fm) : WGM;
        u.pm = fm + ((wgid % nig) % gsz); u.pn = (wgid % nig) / gsz; u.e = 0; return true;
    }
    __device__ __forceinline__ const char* bbase(const Unit& u) const { return Bt + (size_t)u.pn * bn * K * 2; }
    __device__ __forceinline__ void aoffs(const Unit& u, const int (&R)[2], const int (&C)[2], unsigned (&o)[4]) const {
#pragma unroll
        for (int h = 0; h < 2; ++h)
#pragma unroll
            for (int i = 0; i < 2; ++i) o[2 * h + i] = (unsigned)(((size_t)(u.pm * BM + h * HALF + R[i]) * lda + C[i]) * 2);
    }
};
__device__ __forceinline__ bool xcd_range_unit(int i, int nunits, int G, int c, int& L) {
    const int x = c % NXCD, cc = c / NXCD, per = G / NXCD, q = nunits / NXCD, r = nunits % NXCD;
    const int start = x * q + (x < r ? x : r), cnt = q + (x < r ? 1 : 0), li = i * per + cc;
    if (li >= cnt) return false; L = start + li; return true;
}
struct MoeUpProb {
    static constexpr bool DENSE_A = false;
    __device__ __forceinline__ const char* abase(const Unit&) const { return Abase; }
    int K, ldb; int arow, brow;
    int pshift, btile;
    const char* Abase; const char* W13; const int* sorted; const LAS int* tile_e; int ntiles, nunits, G, c;
    __device__ __forceinline__ bool next(int i, Unit& u) const {
        int L; if (!xcd_range_unit(i, nunits, G, c, L)) return false;
        const int tile = L >> pshift; u.pn = L & ((1 << pshift) - 1);
        if (tile < ntiles) { u.pm = tile; u.e = __builtin_amdgcn_readfirstlane(tile_e[tile]); } else { u.pm = MAXTILES + (tile - ntiles); u.e = NEXP; }
        return true;
    }
    __device__ __forceinline__ const char* bbase(const Unit& u) const { return W13 + ((size_t)u.e * 1024 + (size_t)u.pn * btile) * brow; }
    __device__ __forceinline__ void aoffs(const Unit& u, const int (&R)[2], const int (&C)[2], unsigned (&o)[4]) const {
#pragma unroll
        for (int h = 0; h < 2; ++h)
#pragma unroll
            for (int i = 0; i < 2; ++i) { int row;
                if (u.e == NEXP) row = (u.pm - MAXTILES) * BM + h * HALF + R[i];
                else { const LAS int* tab = tile_e - 160; const int idx = u.pm * BM - tab[u.e] + h * HALF + R[i]; row = idx < tab[66 + u.e] ? sorted[(size_t)u.e * NT + idx] : 0; }
                o[2 * h + i] = (unsigned)((size_t)row * arow + C[i] * 2); }
    }
};
struct MoeDownProb {
    static constexpr bool DENSE_A = true;
    __device__ __forceinline__ const char* abase(const Unit& u) const { return Abase + (size_t)u.pm * BM * arow; }
    int K, ldb; int arow, brow, pshift, btile; const char* Abase; const char* W2; const LAS int* tile_e; int ntiles, nunits, G, c;
    __device__ __forceinline__ bool next(int i, Unit& u) const {
        int L; if (!xcd_range_unit(i, nunits, G, c, L)) return false;
        const int tile = L >> pshift; u.pn = L & ((1 << pshift) - 1);
        if (tile < ntiles) { u.pm = tile; u.e = __builtin_amdgcn_readfirstlane(tile_e[tile]); } else { u.pm = MAXTILES + (tile - ntiles); u.e = NEXP; }
        return true;
    }
    __device__ __forceinline__ const char* bbase(const Unit& u) const { return W2 + ((size_t)u.e * 2048 + (size_t)u.pn * btile) * brow; }
    __device__ __forceinline__ void aoffs(const Unit& u, const int (&R)[2], const int (&C)[2], unsigned (&o)[4]) const {
#pragma unroll
        for (int h = 0; h < 2; ++h)
#pragma unroll
            for (int i = 0; i < 2; ++i) o[2 * h + i] = (unsigned)((size_t)(u.pm * BM + h * HALF + R[i]) * arow + C[i] * 2);
    }
};
constexpr int CMP_SPLIT = 4;
struct CmpProb {
    static constexpr bool DENSE_A = false; int arow;
    __device__ __forceinline__ const char* abase(const Unit&) const { return Abase; }
    int K, ldb; const char* Abase; const char* Bt; int G, c;
    __device__ __forceinline__ bool next(int i, Unit& u) const { const int L = i * G + c; if (L >= 16 * CMP_SPLIT) return false; u.pm = L / CMP_SPLIT; u.pn = 0; u.e = L % CMP_SPLIT; return true; }
    __device__ __forceinline__ const char* bbase(const Unit& u) const { return Bt + (size_t)u.e * (4096 / CMP_SPLIT) * 2; }
    __device__ __forceinline__ void aoffs(const Unit& u, const int (&R)[2], const int (&C)[2], unsigned (&o)[4]) const {
#pragma unroll
        for (int h = 0; h < 2; ++h)
#pragma unroll
            for (int i = 0; i < 2; ++i) { const int m = u.pm * BM + h * HALF + R[i], seq = m >> 7, n = m & 127;
                o[2 * h + i] = (unsigned)((((size_t)seq * NS + 16 * n) * 128 + u.e * (4096 / CMP_SPLIT) + C[i]) * 2); }
    }
};
struct RouterProb {
    static constexpr bool DENSE_A = false; int arow;
    __device__ __forceinline__ const char* abase(const Unit&) const { return Abase; }
    int K, ldb; const char* Abase; const char* Bt; int G, c;
    __device__ __forceinline__ bool next(int i, Unit& u) const { const int L = i * G + c; if (L >= (NT / BM) * 4) return false; u.pm = L >> 2; u.pn = 0; u.e = L & 3; return true; }
    __device__ __forceinline__ const char* bbase(const Unit& u) const { return Bt + (size_t)u.e * 512 * 2; }
    __device__ __forceinline__ void aoffs(const Unit& u, const int (&R)[2], const int (&C)[2], unsigned (&o)[4]) const {
#pragma unroll
        for (int h = 0; h < 2; ++h)
#pragma unroll
            for (int i = 0; i < 2; ++i) o[2 * h + i] = (unsigned)(((size_t)(u.pm * BM + h * HALF + R[i]) * ND + u.e * 512 + C[i]) * 2);
    }
};
struct EpiF32N64 {
    static constexpr bool PERM = false; static constexpr bool PERM2 = false; static constexpr unsigned SCALE_A = 0x7F7F7F7Fu;
    float* C;
    __device__ __forceinline__ void operator()(const f32x4 (&acc)[2][2][4][2], const Unit& u, int wr, int wc, int fr, int fq) const {
        if (wc >= 2) return;
        const int row0 = u.pm * BM + wr * 64 + fr, col0 = wc * 32 + 4 * fq;
#pragma unroll
        for (int ai = 0; ai < 2; ++ai)
#pragma unroll
            for (int m = 0; m < 4; ++m) { float* rowp = C + ((size_t)u.e * NT + row0 + ai * HALF + m * 16) * 64 + col0;
#pragma unroll
                for (int n = 0; n < 2; ++n) *(f32x4*)(rowp + n * 16) = acc[ai][0][m][n]; }
    }
};
struct EpiSwigluF8 {
    static constexpr bool PERM = true; static constexpr bool PERM2 = false; static constexpr unsigned SCALE_A = 0x7F7F7F7Fu;
    unsigned char* H; float inmul;
    __device__ __forceinline__ void operator()(const f32x4 (&acc)[2][2][4][2], const Unit& u, int wr, int wc, int fr, int fq) const {
        const int row0 = u.pm * BM + wr * 64 + fr, col0 = u.pn * 64 + wc * 16 + 4 * fq;
#pragma unroll
        for (int ai = 0; ai < 2; ++ai)
#pragma unroll
            for (int m = 0; m < 4; ++m) { unsigned char* rowp = H + (size_t)(row0 + ai * HALF + m * 16) * EFF + col0;
                float o[4];
#pragma unroll
                for (int j = 0; j < 4; ++j) { const float h1 = acc[ai][0][m][0][j] * inmul, h3 = acc[ai][0][m][1][j] * inmul; o[j] = fminf(fmaxf(siluf_(h1) * h3 * 8.0f, -448.0f), 448.0f); }
                int w0 = __builtin_amdgcn_cvt_pk_fp8_f32(o[0], o[1], 0, false); w0 = __builtin_amdgcn_cvt_pk_fp8_f32(o[2], o[3], w0, true);
                *(unsigned*)rowp = (unsigned)w0; }
    }
};
struct EpiSwigluF8x2 {
    static constexpr bool PERM = true; static constexpr bool PERM2 = false; static constexpr unsigned SCALE_A = 0x79797979u;
    unsigned char* H; float inmul;
    __device__ __forceinline__ void operator()(const f32x4 (&acc)[2][2][4][2], const Unit& u, int wr, int wc, int fr, int fq) const {
        const int row0 = u.pm * BM + wr * 64 + fr, col0 = u.pn * 128 + wc * 16 + 4 * fq;
#pragma unroll
        for (int ai = 0; ai < 2; ++ai)
#pragma unroll
            for (int m = 0; m < 4; ++m) { unsigned char* rowp = H + (size_t)(row0 + ai * HALF + m * 16) * EFF + col0;
#pragma unroll
                for (int bj = 0; bj < 2; ++bj) { float o[4];
#pragma unroll
                    for (int j = 0; j < 4; ++j) { const float h1 = acc[ai][bj][m][0][j] * inmul, h3 = acc[ai][bj][m][1][j] * inmul; o[j] = fminf(fmaxf(siluf_(h1) * h3 * 8.0f, -448.0f), 448.0f); }
                    int w0 = __builtin_amdgcn_cvt_pk_fp8_f32(o[0], o[1], 0, false); w0 = __builtin_amdgcn_cvt_pk_fp8_f32(o[2], o[3], w0, true);
                    *(unsigned*)(rowp + bj * 64) = (unsigned)w0; } }
    }
};
struct EpiBf16M {
    static constexpr bool PERM = true; static constexpr bool PERM2 = false; static constexpr unsigned SCALE_A = 0x79797979u;
    bf16* O; int ldc; float mul;
    __device__ __forceinline__ void operator()(const f32x4 (&acc)[2][2][4][2], const Unit& u, int wr, int wc, int fr, int fq) const {
        const int row0 = u.pm * BM + wr * 64 + fr, col0 = u.pn * BM + wc * 32 + 8 * fq;
#pragma unroll
        for (int ai = 0; ai < 2; ++ai)
#pragma unroll
            for (int m = 0; m < 4; ++m) { bf16* rowp = O + (size_t)(row0 + ai * HALF + m * 16) * ldc + col0;
#pragma unroll
                for (int bj = 0; bj < 2; ++bj) { const f32x4 v0 = acc[ai][bj][m][0] * mul, v1 = acc[ai][bj][m][1] * mul;
                    v4u w; w.x = cvt_pk_bf16(v0[0], v0[1]); w.y = cvt_pk_bf16(v0[2], v0[3]); w.z = cvt_pk_bf16(v1[0], v1[1]); w.w = cvt_pk_bf16(v1[2], v1[3]);
                    *(v4u*)(rowp + bj * HALF) = w; } }
    }
};
struct EpiBf16N128 {
    static constexpr bool PERM = true; static constexpr bool PERM2 = false; static constexpr unsigned SCALE_A = 0x7F7F7F7Fu;
    bf16* O; int ldc; float mul;
    __device__ __forceinline__ void operator()(const f32x4 (&acc)[2][2][4][2], const Unit& u, int wr, int wc, int fr, int fq) const {
        const int row0 = u.pm * BM + wr * 64 + fr, col0 = u.pn * HALF + wc * 32 + 8 * fq;
#pragma unroll
        for (int ai = 0; ai < 2; ++ai)
#pragma unroll
            for (int m = 0; m < 4; ++m) { bf16* rowp = O + (size_t)(row0 + ai * HALF + m * 16) * ldc + col0; const f32x4 v0 = acc[ai][0][m][0] * mul, v1 = acc[ai][0][m][1] * mul;
                v4u w; w.x = cvt_pk_bf16(v0[0], v0[1]); w.y = cvt_pk_bf16(v0[2], v0[3]); w.z = cvt_pk_bf16(v1[0], v1[1]); w.w = cvt_pk_bf16(v1[2], v1[3]);
                *(v4u*)rowp = w; }
    }
};
struct EpiFp8N128 {
    static constexpr bool PERM = true; static constexpr bool PERM2 = false; static constexpr unsigned SCALE_A = 0x7F7F7F7Fu;
    unsigned char* O; int ldc; float mul;
    __device__ __forceinline__ void operator()(const f32x4 (&acc)[2][2][4][2], const Unit& u, int wr, int wc, int fr, int fq) const {
        const int row0 = u.pm * BM + wr * 64 + fr, col0 = u.pn * HALF + wc * 32 + 8 * fq;
#pragma unroll
        for (int ai = 0; ai < 2; ++ai)
#pragma unroll
            for (int m = 0; m < 4; ++m) { unsigned char* rowp = O + (size_t)(row0 + ai * HALF + m * 16) * ldc + col0; float v[8];
#pragma unroll
                for (int n = 0; n < 2; ++n)
#pragma unroll
                    for (int j = 0; j < 4; ++j) v[n * 4 + j] = fminf(fmaxf(acc[ai][0][m][n][j] * mul, -448.0f), 448.0f);
                int w0 = __builtin_amdgcn_cvt_pk_fp8_f32(v[0], v[1], 0, false); w0 = __builtin_amdgcn_cvt_pk_fp8_f32(v[2], v[3], w0, true);
                int w1 = __builtin_amdgcn_cvt_pk_fp8_f32(v[4], v[5], 0, false); w1 = __builtin_amdgcn_cvt_pk_fp8_f32(v[6], v[7], w1, true);
                *(v2u*)rowp = (v2u){(unsigned)w0, (unsigned)w1}; }
    }
};
}

struct Args { const float* in[27]; float* out; unsigned char* ws; int ph_lo, ph_hi; };
typedef const __attribute__((address_space(4))) Args* CArgs;
__device__ __forceinline__ const float* kin(int i) { CArgs p = (CArgs)__builtin_amdgcn_kernarg_segment_ptr(); asm volatile("" : "+s"(p)); return p->in[i]; }
struct Frame {
    LAS unsigned char* lds;
    volatile LAS unsigned* MISC;
    unsigned* ctl;
    unsigned char* ws;
    int tid, lane, wave, vcu, G, gw, NGW;
    float* out;
};

__device__ __forceinline__ void tr_item(const float* W, int ldw, int k0, int n0, int nvalid, bf16* WT, int ldt, int drow0, LAS float* scr, int lane) {
    float v[32]; const int n = lane & 31; const bool okn = n < nvalid; const float* src = W + (size_t)(k0 + (lane >> 5)) * ldw + n0 + n;
#pragma unroll
    for (int i = 0; i < 32; ++i) v[i] = okn ? src[(size_t)(2 * i) * ldw] : 0.f;
#pragma unroll
    for (int i = 0; i < 32; ++i) scr[(2 * i + (lane >> 5)) * 33 + n] = v[i];
    LDS_WAIT(); asm volatile("" ::: "memory");
    const int c = lane & 7;
#pragma unroll
    for (int j = 0; j < 4; ++j) { const int nn = (lane >> 3) + 8 * j; const LAS float* sp = scr + (8 * c) * 33 + nn;
        v4u o; o.x = pk2(sp[0 * 33], sp[1 * 33]); o.y = pk2(sp[2 * 33], sp[3 * 33]); o.z = pk2(sp[4 * 33], sp[5 * 33]); o.w = pk2(sp[6 * 33], sp[7 * 33]);
        if (nn < nvalid) *(v4u*)(WT + (size_t)(drow0 + nn) * ldt + k0 + 8 * c) = o; }
    LDS_WAIT(); asm volatile("" ::: "memory");
}
__device__ __forceinline__ void tr_item_f8(const float* W, int ldw, int k0, int n0, unsigned char* WT8, int ldt, int drow0, int rowmode, float mul, LAS float* scr, int lane, int nvalid = 32) {
    float v[32]; const int n = lane & 31; const float* src = W + (size_t)(k0 + (lane >> 5)) * ldw + n0 + n; const bool okn = n < nvalid;
#pragma unroll
    for (int i = 0; i < 32; ++i) v[i] = okn ? src[(size_t)(2 * i) * ldw] : 0.f;
#pragma unroll
    for (int i = 0; i < 32; ++i) scr[(2 * i + (lane >> 5)) * 33 + n] = v[i];
    LDS_WAIT(); asm volatile("" ::: "memory");
    const int c = lane & 3;
#pragma unroll
    for (int j = 0; j < 2; ++j) { const int nn = (lane >> 2) + 16 * j; const LAS float* sp = scr + (16 * c) * 33 + nn; int w[4];
#pragma unroll
        for (int q = 0; q < 4; ++q) { const float a0 = fminf(fmaxf(sp[(4 * q + 0) * 33] * mul, -448.f), 448.f), a1 = fminf(fmaxf(sp[(4 * q + 1) * 33] * mul, -448.f), 448.f),
                                                  a2 = fminf(fmaxf(sp[(4 * q + 2) * 33] * mul, -448.f), 448.f), a3 = fminf(fmaxf(sp[(4 * q + 3) * 33] * mul, -448.f), 448.f);
            w[q] = __builtin_amdgcn_cvt_pk_fp8_f32(a0, a1, 0, false); w[q] = __builtin_amdgcn_cvt_pk_fp8_f32(a2, a3, w[q], true); }
        const int drow = rowmode ? drow0 + (nn >> 2) * 8 + (nn & 3) : drow0 + nn;
        *(v4u*)(WT8 + (size_t)drow * ldt + k0 + 16 * c) = (v4u){(unsigned)w[0], (unsigned)w[1], (unsigned)w[2], (unsigned)w[3]}; }
    LDS_WAIT(); asm volatile("" ::: "memory");
}
__device__ __forceinline__ bool tr_matrix_f8(int& it, const float* W, int ldw, int K, int c0, int ncols, unsigned char* WT8, int drow0, int nrows_alloc, LAS float* scr, int lane) {
    const int nb = (ncols + 31) / 32, items = (K / 64) * nb;
    if (it >= items) { it -= items; return false; }
    const int kb = it / nb, b = it % nb, nv = ncols - 32 * b;
    (void)nrows_alloc;
    tr_item_f8(W, ldw, 64 * kb, c0 + 32 * b, WT8, K, drow0 + 32 * b, 0, 64.0f, scr, lane, nv < 32 ? nv : 32);
    return true;
}
__device__ __forceinline__ bool tr_matrix(int& it, const float* W, int ldw, int K, int c0, int ncols, bf16* WT, int drow0, LAS float* scr, int lane) {
    const int nb = (ncols + 31) / 32, items = (K / 64) * nb;
    if (it >= items) { it -= items; return false; }
    const int kb = it / nb, b = it % nb, nv = ncols - 32 * b;
    tr_item(W, ldw, 64 * kb, c0 + 32 * b, nv < 32 ? nv : 32, WT, K, drow0 + 32 * b, scr, lane);
    return true;
}
__device__ __forceinline__ void zero_rows(Frame& F, bf16* base, size_t nelem) {
    for (size_t i = ((size_t)F.gw * 64 + F.lane) * 8; i < nelem; i += (size_t)F.NGW * 64 * 8) *(v4u*)(base + i) = (v4u){0u, 0u, 0u, 0u};
}

__device__ __forceinline__ void p_prologue(Frame& F) {
    LAS float* scr = (LAS float*)(F.lds + F.wave * 16384);
    unsigned char* ws = F.ws;
    {
        LAS float* wl = (LAS float*)F.lds;
        LAS float* pl = (LAS float*)(F.lds + 32768);
        const float* w_in = kin(2); const float* pool_w = kin(3); const float* pscale = kin(4);
        bf16* WT = (bf16*)(ws + WS_WABIN);
        for (int it = blockIdx.x; it < 4 * 32; it += F.G) {
            const int g = it >> 5, k0 = (it & 31) * 64;
            for (int i = F.tid; i < 64 * 128; i += 512) wl[i] = w_in[(size_t)(k0 + (i >> 7)) * AB_IN + g * 128 + (i & 127)];
            for (int i = F.tid; i < 128 * 128; i += 512) pl[i] = pool_w[(size_t)g * 16384 + i];
            __syncthreads();
            const int d = F.tid & 127, kg = F.tid >> 7; const float sc = pscale[g * 128 + d];
            for (int kk = 0; kk < 16; kk += 8) {
                float a[8];
#pragma unroll
                for (int j = 0; j < 8; ++j) a[j] = 0.f;
                for (int c = 0; c < 128; ++c) { const float pw = pl[c * 128 + d];
#pragma unroll
                    for (int j = 0; j < 8; ++j) a[j] += wl[(kg * 16 + kk + j) * 128 + c] * pw; }
                if (MK_FP8_IN0) { float q[8];
#pragma unroll
                    for (int j = 0; j < 8; ++j) q[j] = fminf(fmaxf(a[j] * sc * 64.0f, -448.f), 448.f);
                    int w0 = __builtin_amdgcn_cvt_pk_fp8_f32(q[0], q[1], 0, false); w0 = __builtin_amdgcn_cvt_pk_fp8_f32(q[2], q[3], w0, true);
                    int w1 = __builtin_amdgcn_cvt_pk_fp8_f32(q[4], q[5], 0, false); w1 = __builtin_amdgcn_cvt_pk_fp8_f32(q[6], q[7], w1, true);
                    *(v2u*)((unsigned char*)WT + (size_t)(g * 128 + d) * ND + k0 + kg * 16 + kk) = (v2u){(unsigned)w0, (unsigned)w1}; }
                else { v4u o; o.x = pk2(a[0] * sc, a[1] * sc); o.y = pk2(a[2] * sc, a[3] * sc); o.z = pk2(a[4] * sc, a[5] * sc); o.w = pk2(a[6] * sc, a[7] * sc);
                    *(v4u*)(WT + (size_t)(g * 128 + d) * ND + k0 + kg * 16 + kk) = o; }
            }
            __syncthreads();
        }
    }
    __syncthreads();
    for (int it0 = F.gw; ; it0 += F.NGW) {
        int it = it0;
        if (MK_FP8_IN0 ? tr_matrix_f8(it, kin(2), AB_IN, ND, 512, AB_IN - 512, ws + WS_WABIN, 512, AB_IN, scr, F.lane) : tr_matrix(it, kin(2), AB_IN, ND, 512, AB_IN - 512, (bf16*)(ws + WS_WABIN), 512, scr, F.lane)) continue;
        if (tr_matrix(it, kin(5), ND, ND, 0, ND, (bf16*)(ws + WS_WABOUT), 0, scr, F.lane)) continue;
        if (MK_FP8_IN1 ? tr_matrix_f8(it, kin(6), CD_IN, ND, 0, CD_IN, ws + WS_WCDIN, 0, CD_INP, scr, F.lane) : tr_matrix(it, kin(6), CD_IN, ND, 0, CD_IN, (bf16*)(ws + WS_WCDIN), 0, scr, F.lane)) continue;
        if (tr_matrix(it, kin(14), ND, ND, 0, ND, (bf16*)(ws + WS_WCDOUT), 0, scr, F.lane)) continue;
        if (tr_matrix(it, kin(11), 1536, 384, 0, 1536, (bf16*)(ws + WS_WUQ), 0, scr, F.lane)) continue;
        if (tr_matrix(it, kin(13), 2048, 512, 0, 2048, (bf16*)(ws + WS_WUKV), 0, scr, F.lane)) continue;
        if (tr_matrix(it, kin(8), 128, 4096, 0, 128, (bf16*)(ws + WS_CW1), 0, scr, F.lane)) continue;
        if (tr_matrix(it, kin(8) + (size_t)4096 * 128, 128, 4096, 0, 128, (bf16*)(ws + WS_CW1), 128, scr, F.lane)) continue;
        break;
    }
    if (MK_FP8_IN1) zero_rows(F, (bf16*)(ws + WS_WCDIN + (size_t)3552 * ND), (size_t)(CD_INP - 3552) * ND / 2);
    else zero_rows(F, (bf16*)(ws + WS_WCDIN) + (size_t)CD_IN * ND, (size_t)(CD_INP - CD_IN) * ND);
    { const float* x = kin(0); bf16* xb = (bf16*)(ws + WS_XB0); const size_t stride = (size_t)F.NGW * 64 * 8;
      for (size_t i = ((size_t)F.gw * 64 + F.lane) * 8; i < (size_t)NT * ND; i += 4 * stride) {
          f32x4 a[4], c[4];
#pragma unroll
          for (int u = 0; u < 4; ++u) if (i + u * stride < (size_t)NT * ND) { a[u] = *(const f32x4*)(x + i + u * stride); c[u] = *(const f32x4*)(x + i + u * stride + 4); }
#pragma unroll
          for (int u = 0; u < 4; ++u) if (i + u * stride < (size_t)NT * ND) { v4u o; o.x = pk2(a[u][0], a[u][1]); o.y = pk2(a[u][2], a[u][3]); o.z = pk2(c[u][0], c[u][1]); o.w = pk2(c[u][2], c[u][3]); *(v4u*)(xb + i + u * stride) = o;
              if (MK_FP8_IN0) { int w0 = __builtin_amdgcn_cvt_pk_fp8_f32(a[u][0], a[u][1], 0, false); w0 = __builtin_amdgcn_cvt_pk_fp8_f32(a[u][2], a[u][3], w0, true);
                  int w1 = __builtin_amdgcn_cvt_pk_fp8_f32(c[u][0], c[u][1], 0, false); w1 = __builtin_amdgcn_cvt_pk_fp8_f32(c[u][2], c[u][3], w1, true);
                  *(v2u*)(ws + WS_X1F8 + i + u * stride) = (v2u){(unsigned)w0, (unsigned)w1}; } } } }
    for (int o = F.gw; o < 128; o += F.NGW) { const int kv = o >> 6, fc = o & 63; const float* pos = kin(7) + (size_t)kv * 4096 + fc * 64; const float* w1 = kin(8) + ((size_t)kv * 4096 + fc * 64) * 128;
        float s0 = 0.f, s1 = 0.f;
#pragma unroll 8
        for (int f = 0; f < 64; ++f) { const float pf_ = pos[f]; const f32x2 wv = *(const f32x2*)(w1 + (size_t)f * 128 + F.lane * 2); s0 += pf_ * wv[0]; s1 += pf_ * wv[1]; }
        *(f32x2*)((float*)(ws + WS_CMPB) + 256 + (size_t)o * 128 + F.lane * 2) = (f32x2){s0, s1}; }
}
__device__ __forceinline__ void cmp_bias_finish(Frame& F) {
    if (blockIdx.x == 0 && F.tid < 256) { const int kv = F.tid >> 7, h = F.tid & 127; const float* part = (const float*)(F.ws + WS_CMPB) + 256 + (size_t)kv * 64 * 128 + h;
        float sacc = 0.f; for (int fc = 0; fc < 64; ++fc) sacc += part[fc * 128];
        ((float*)(F.ws + WS_CMPB))[F.tid] = sacc; }
}
constexpr int MW_ITEMS_L = 65 * 1536 + 64;
__device__ __forceinline__ void moe_weight_item(int l, int it, unsigned char* ws, LAS float* scr, int lane) {
    bf16* W13 = (bf16*)(ws + WS_W13 + (size_t)l * WS_MOE_LSTRIDE); bf16* W2 = (bf16*)(ws + WS_W2 + (size_t)l * WS_MOE_LSTRIDE); bf16* RT = (bf16*)(ws + WS_RT + (size_t)l * MiB);
    if (it >= 65 * 1536) { const int r = it - 65 * 1536, kb = r >> 1, b = r & 1;
        tr_item(kin(19) + (size_t)l * ND * NEXP, NEXP, 64 * kb, 32 * b, 32, RT, ND, 32 * b, scr, lane); return; }
    const int e = it / 1536, r = it % 1536;
    const float *w1, *w3, *w2;
    if (e < NEXP) { const size_t o = ((size_t)l * NEXP + e) * ND * EFF; w1 = kin(21) + o; w3 = kin(22) + o; w2 = kin(23) + o; }
    else { const size_t o = (size_t)l * ND * EFF; w1 = kin(24) + o; w3 = kin(25) + o; w2 = kin(26) + o; }
    if (r < 1024) { const int which = r >> 9, rr = r & 511, kb = rr >> 4, nb = rr & 15;
        const int j = nb >> 2, drow = j * 256 + which * 128 + (nb & 3) * 32;
        if (MK_FP8_MOE) tr_item_f8(which ? w3 : w1, EFF, 64 * kb, 32 * nb, (unsigned char*)W13 + (size_t)e * 1024 * ND, ND, (nb >> 1) * 128 + (nb & 1) * 64 + which * 4, 1, 64.0f, scr, lane);
        else tr_item(which ? w3 : w1, EFF, 64 * kb, 32 * nb, 32, W13 + (size_t)e * 1024 * ND, ND, drow, scr, lane); }
    else { const int rr = r - 1024, kb = rr >> 6, nb = rr & 63;
        if (MK_FP8_MOE) tr_item_f8(w2, ND, 64 * kb, 32 * nb, (unsigned char*)W2 + (size_t)e * ND * EFF, EFF, 32 * nb, 0, 64.0f, scr, lane);
        else tr_item(w2, ND, 64 * kb, 32 * nb, 32, W2 + (size_t)e * ND * EFF, EFF, 32 * nb, scr, lane); }
}
struct ConvDesc { const float* src; unsigned char* dst; int ldw, ldt, k0, drow0, rowmode, kind; };
__device__ __forceinline__ ConvDesc conv_desc(int id, unsigned char* ws) {
    ConvDesc d; d.kind = -1; d.src = nullptr; d.dst = nullptr; d.ldw = 0; d.ldt = 0; d.k0 = 0; d.drow0 = 0; d.rowmode = 0;
    if (id >= 2 * MW_ITEMS_L) return d;
    const int l = id >= MW_ITEMS_L ? 1 : 0, it = id - l * MW_ITEMS_L;
    if (it >= 65 * 1536 || !MK_FP8_MOE) { d.kind = 1; d.k0 = it; d.drow0 = l; return d; }
    const int e = it / 1536, r = it % 1536;
    const float *w1, *w3, *w2;
    if (e < NEXP) { const size_t o = ((size_t)l * NEXP + e) * ND * EFF; w1 = kin(21) + o; w3 = kin(22) + o; w2 = kin(23) + o; }
    else { const size_t o = (size_t)l * ND * EFF; w1 = kin(24) + o; w3 = kin(25) + o; w2 = kin(26) + o; }
    d.kind = 0;
    if (r < 1024) { const int which = r >> 9, rr = r & 511, kb = rr >> 4, nb = rr & 15;
        d.src = (which ? w3 : w1) + (size_t)(64 * kb) * EFF + 32 * nb; d.ldw = EFF; d.k0 = 64 * kb;
        d.dst = ws + WS_W13 + (size_t)l * WS_MOE_LSTRIDE + (size_t)e * 1024 * ND; d.ldt = ND; d.drow0 = (nb >> 1) * 128 + (nb & 1) * 64 + which * 4; d.rowmode = 1; }
    else { const int rr = r - 1024, kb = rr >> 6, nb = rr & 63;
        d.src = w2 + (size_t)(64 * kb) * ND + 32 * nb; d.ldw = ND; d.k0 = 64 * kb;
        d.dst = ws + WS_W2 + (size_t)l * WS_MOE_LSTRIDE + (size_t)e * ND * EFF; d.ldt = EFF; d.drow0 = 32 * nb; d.rowmode = 0; }
    return d;
}
__device__ __forceinline__ void conv_load(const ConvDesc& d, float (&v)[32], int lane) {
    if (d.kind != 0) return;
    const float* src = d.src + (size_t)(lane >> 5) * d.ldw + (lane & 31);
#pragma unroll
    for (int i = 0; i < 32; ++i) v[i] = src[(size_t)(2 * i) * d.ldw];
}
__device__ __forceinline__ void conv_finish(const ConvDesc& d, const float (&v)[32], unsigned char* ws, LAS float* scr, int lane) {
    if (d.kind == 1) { moe_weight_item(d.drow0, d.k0, ws, scr, lane); return; }
    if (d.kind != 0) return;
    const int n = lane & 31;
#pragma unroll
    for (int i = 0; i < 32; ++i) scr[(2 * i + (lane >> 5)) * 33 + n] = v[i];
    LDS_WAIT(); asm volatile("" ::: "memory");
    const int c = lane & 3;
#pragma unroll
    for (int j = 0; j < 2; ++j) { const int nn = (lane >> 2) + 16 * j; const LAS float* sp = scr + (16 * c) * 33 + nn; int w[4];
#pragma unroll
        for (int q = 0; q < 4; ++q) { const float a0 = fminf(fmaxf(sp[(4 * q + 0) * 33] * 64.0f, -448.f), 448.f), a1 = fminf(fmaxf(sp[(4 * q + 1) * 33] * 64.0f, -448.f), 448.f),
                                                  a2 = fminf(fmaxf(sp[(4 * q + 2) * 33] * 64.0f, -448.f), 448.f), a3 = fminf(fmaxf(sp[(4 * q + 3) * 33] * 64.0f, -448.f), 448.f);
            w[q] = __builtin_amdgcn_cvt_pk_fp8_f32(a0, a1, 0, false); w[q] = __builtin_amdgcn_cvt_pk_fp8_f32(a2, a3, w[q], true); }
        const int drow = d.rowmode ? d.drow0 + (nn >> 2) * 8 + (nn & 3) : d.drow0 + nn;
        *(v4u*)(d.dst + (size_t)drow * d.ldt + d.k0 + 16 * c) = (v4u){(unsigned)w[0], (unsigned)w[1], (unsigned)w[2], (unsigned)w[3]}; }
    LDS_WAIT(); asm volatile("" ::: "memory");
}
__device__ __forceinline__ void p_moe_weights_queue(Frame& F, unsigned* queue) {
    LAS float* scr = (LAS float*)(F.lds + F.wave * 16384);
    constexpr int BATCH = 16, NB_ = (2 * MW_ITEMS_L + BATCH - 1) / BATCH;
    for (;;) {
        unsigned bq = 0; if (F.lane == 0) bq = atomicAdd(queue, 1u);
        const int bi = __builtin_amdgcn_readfirstlane((int)bq);
        if (bi >= NB_) break;
        const int s0 = bi * BATCH;
        float va[32], vb[32];
        ConvDesc dA = conv_desc(s0, F.ws); conv_load(dA, va, F.lane);
        for (int k = 0; k < BATCH; k += 2) {
            ConvDesc dB = conv_desc(s0 + k + 1, F.ws); conv_load(dB, vb, F.lane);
            conv_finish(dA, va, F.ws, scr, F.lane);
            dA = conv_desc(k + 2 < BATCH ? s0 + k + 2 : 2 * MW_ITEMS_L, F.ws); conv_load(dA, va, F.lane);
            conv_finish(dB, vb, F.ws, scr, F.lane);
        }
    }
    for (int l = 0; l < 2; ++l) zero_rows(F, (bf16*)(F.ws + WS_RT + (size_t)l * MiB) + (size_t)NEXP * ND, (size_t)(256 - NEXP) * ND);
}

__device__ __forceinline__ void ln_finish(float (&v)[4][8], const float* g, const float* b, int lane, bf16* ob, float* of, unsigned char* o8 = nullptr) {
    float s = 0.f;
#pragma unroll
    for (int j = 0; j < 4; ++j)
#pragma unroll
        for (int i = 0; i < 8; ++i) s += v[j][i];
    const float mean = wave_sum(s) * (1.f / ND); float s2 = 0.f;
#pragma unroll
    for (int j = 0; j < 4; ++j)
#pragma unroll
        for (int i = 0; i < 8; ++i) { v[j][i] -= mean; s2 += v[j][i] * v[j][i]; }
    const float rstd = 1.f / sqrtf(wave_sum(s2) * (1.f / ND) + LN_EPS);
#pragma unroll
    for (int j = 0; j < 4; ++j) { unsigned c0 = (unsigned)(j * 64 + lane) * 8u; asm volatile("" : "+v"(c0));
        const f32x4 g0 = *(const f32x4*)((const char*)g + c0 * 4u), g1 = *(const f32x4*)((const char*)g + c0 * 4u + 16u), b0 = *(const f32x4*)((const char*)b + c0 * 4u), b1 = *(const f32x4*)((const char*)b + c0 * 4u + 16u);
        float o[8];
#pragma unroll
        for (int i = 0; i < 4; ++i) { o[i] = v[j][i] * rstd * g0[i] + b0[i]; o[4 + i] = v[j][4 + i] * rstd * g1[i] + b1[i]; }
        if (ob) { v4u w; w.x = pk2(o[0], o[1]); w.y = pk2(o[2], o[3]); w.z = pk2(o[4], o[5]); w.w = pk2(o[6], o[7]); *(v4u*)((char*)ob + c0 * 2u) = w; }
        if (of) { *(f32x4*)((char*)of + c0 * 4u) = (f32x4){o[0], o[1], o[2], o[3]}; *(f32x4*)((char*)of + c0 * 4u + 16u) = (f32x4){o[4], o[5], o[6], o[7]}; }
        if (o8) { int w0 = __builtin_amdgcn_cvt_pk_fp8_f32(o[0], o[1], 0, false); w0 = __builtin_amdgcn_cvt_pk_fp8_f32(o[2], o[3], w0, true);
            int w1 = __builtin_amdgcn_cvt_pk_fp8_f32(o[4], o[5], 0, false); w1 = __builtin_amdgcn_cvt_pk_fp8_f32(o[6], o[7], w1, true);
            *(v2u*)(o8 + c0) = (v2u){(unsigned)w0, (unsigned)w1}; } }
}
__device__ __forceinline__ void p_ln1(Frame& F, const bf16* xin, const bf16* mixo, const float* g, const float* b, bf16* xo, unsigned char* xo8) {
    for (int m = F.gw; m < NT; m += F.NGW) {
        float v[4][8];
#pragma unroll
        for (int j = 0; j < 4; ++j) { const size_t o = (size_t)m * ND + (j * 64 + F.lane) * 8; float a[8], c[8]; unpack8(*(const v4u*)(xin + o), a); unpack8(*(const v4u*)(mixo + o), c);
#pragma unroll
            for (int i = 0; i < 8; ++i) v[j][i] = DN_ALPHA * a[i] + c[i]; }
        ln_finish(v, g, b, F.lane, xo + (size_t)m * ND, nullptr, xo8 ? xo8 + (size_t)m * ND : nullptr);
    }
}
__device__ __forceinline__ void unpack8_fp8(const v2u w, float (&f)[8]) {
    const f32x2 a = __builtin_amdgcn_cvt_pk_f32_fp8((int)w.x, false), b = __builtin_amdgcn_cvt_pk_f32_fp8((int)w.x, true), c = __builtin_amdgcn_cvt_pk_f32_fp8((int)w.y, false), d = __builtin_amdgcn_cvt_pk_f32_fp8((int)w.y, true);
    f[0] = a[0]; f[1] = a[1]; f[2] = b[0]; f[3] = b[1]; f[4] = c[0]; f[5] = c[1]; f[6] = d[0]; f[7] = d[1];
}
__device__ __forceinline__ void p_combine_ln2(Frame& F, const LAS int* tab, const bf16* x1, const unsigned char* y2, const int* slot, const float* wsel, const float* g, const float* b, bf16* xo, float* fo, unsigned char* xo8) {
    for (int m = F.gw; m < NT; m += F.NGW) {
        const int mysl = slot[m * 8 + (F.lane & 7)]; const int myrow = tab[mysl >> 16] + (mysl & 0xFFFF); const float myw = wsel[m * 8 + (F.lane & 7)] * (1.0f / 16.0f);
        float v[4][8];
        { v4u xa[4]; v2u sa[4];
#pragma unroll
          for (int j = 0; j < 4; ++j) { xa[j] = *(const v4u*)(x1 + (size_t)m * ND + (j * 64 + F.lane) * 8); sa[j] = *(const v2u*)(y2 + (size_t)(SH_ROW0 + m) * ND + (j * 64 + F.lane) * 8); }
#pragma unroll
          for (int j = 0; j < 4; ++j) { float a[8], c[8]; unpack8(xa[j], a); unpack8_fp8(sa[j], c);
#pragma unroll
              for (int i = 0; i < 8; ++i) v[j][i] = DN_ALPHA * a[i] + c[i] * (1.0f / 16.0f); } }
#pragma unroll
        for (int kg = 0; kg < 2; ++kg) { v2u ra[4][4]; float wk[4];
#pragma unroll
            for (int k = 0; k < 4; ++k) { const int row = __builtin_amdgcn_readlane(myrow, kg * 4 + k); wk[k] = __builtin_bit_cast(float, __builtin_amdgcn_readlane(__builtin_bit_cast(int, myw), kg * 4 + k));
#pragma unroll
                for (int j = 0; j < 4; ++j) ra[k][j] = *(const v2u*)(y2 + (size_t)row * ND + (j * 64 + F.lane) * 8); }
#pragma unroll
            for (int k = 0; k < 4; ++k)
#pragma unroll
                for (int j = 0; j < 4; ++j) { float c[8]; unpack8_fp8(ra[k][j], c);
#pragma unroll
                    for (int i = 0; i < 8; ++i) v[j][i] += wk[k] * c[i]; } }
        ln_finish(v, g, b, F.lane, xo ? xo + (size_t)m * ND : nullptr, fo ? fo + (size_t)m * ND : nullptr, xo8 ? xo8 + (size_t)m * ND : nullptr);
    }
}

__device__ __forceinline__ void p_pool(Frame& F, int wid, int nw) {
    const bf16* proj = (const bf16*)(F.ws + WS_PROJ); bf16* mixin = (bf16*)(F.ws + WS_MIXIN);
    for (int m = wid; m < NT; m += nw) {
        const int s = m & (NS - 1);
        const int g = F.lane >> 4, w = 2 << g; const int lo = (s + 1 - w) > 0 ? (s + 1 - w) : 0; const float cnt = (float)((s + 1) < w ? (s + 1) : w);
        float acc[8], cur[8];
#pragma unroll
        for (int i = 0; i < 8; ++i) acc[i] = 0.f;
        for (int j = lo; j <= s; ++j) { float t[8]; unpack8(*(const v4u*)(proj + (size_t)(m - s + j) * AB_IN + F.lane * 8), t);
#pragma unroll
            for (int i = 0; i < 8; ++i) acc[i] += t[i]; }
        unpack8(*(const v4u*)(proj + (size_t)m * AB_IN + F.lane * 8), cur);
        float o[8];
#pragma unroll
        for (int i = 0; i < 8; ++i) o[i] = acc[i] / cnt - cur[i];
        v4u wv; wv.x = pk2(o[0], o[1]); wv.y = pk2(o[2], o[3]); wv.z = pk2(o[4], o[5]); wv.w = pk2(o[6], o[7]); *(v4u*)(mixin + (size_t)m * ND + F.lane * 8) = wv;
    }
}
namespace ret {
typedef short v4i16_t __attribute__((ext_vector_type(4)));
constexpr int PITCH = 272, TILE = 128 * PITCH;
__device__ __forceinline__ bf16x8 trfrag(LAS unsigned char* trb, int r0, int r1, int c0) {
    const v4i16_t a = __builtin_amdgcn_ds_read_tr16_b64_v4i16((LAS v4i16_t*)(trb + r0 * PITCH + c0 * 2));
    const v4i16_t b = __builtin_amdgcn_ds_read_tr16_b64_v4i16((LAS v4i16_t*)(trb + r1 * PITCH + c0 * 2));
    return (bf16x8){a[0], a[1], a[2], a[3], b[0], b[1], b[2], b[3]};
}
}
__device__ __forceinline__ void p_retention_mfma(Frame& F, int bh) {
    const bf16* proj = (const bf16*)(F.ws + WS_PROJ); bf16* mixin = (bf16*)(F.ws + WS_MIXIN); const int* posv = (const int*)kin(1);
    constexpr int P = ret::PITCH;
    LAS unsigned char* KT = F.lds; LAS unsigned char* VT = F.lds + ret::TILE; LAS unsigned char* ST = F.lds + 2 * ret::TILE;
    const int b = bh / 6, h = bh % 6, w = F.wave, lane = F.lane, i16 = lane & 15, g = lane >> 4, q4 = (lane & 15) >> 2, p4 = lane & 3;
    const float lg = log2f(1.0f - exp2f(-5.0f - (float)h)), gc = exp2f(128.f * lg);
    const int rowb = i16 * P + 16 * g;
    const int trl = q4 * P + 8 * p4;
    LAS unsigned char* const trV4 = VT + trl + 4 * g * P;
    LAS unsigned char* const trV8 = VT + trl + 8 * g * P;
    LAS unsigned char* const trK8 = KT + trl + 8 * g * P;
    f32x4 T[2][8];
#pragma unroll
    for (int a = 0; a < 2; ++a)
#pragma unroll
        for (int d = 0; d < 8; ++d) T[a][d] = (f32x4){0.f, 0.f, 0.f, 0.f};
    const int srow = F.tid >> 2, scb = (F.tid & 3) * 4;
    for (int n = 0; n < NS / 128; ++n) {
        const size_t m0 = (size_t)b * NS + n * 128;
        v4u vpre[4];
#pragma unroll
        for (int c = 0; c < 4; ++c) vpre[c] = *(const v4u*)(proj + (m0 + srow) * AB_IN + 2048 + h * 256 + (scb + c) * 8);
        {
          const float fk = exp2f(-(float)srow * lg) * 0.08838834764831845f, pz = (float)posv[m0 + srow]; const int t4 = F.tid & 3;
          const bf16* krow = proj + (m0 + srow) * AB_IN + 1280 + h * 128;
#pragma unroll
          for (int c = 0; c < 2; ++c) { const int c8 = 2 * t4 + c; float x1[8], x2[8];
              unpack8(*(const v4u*)(krow + c8 * 8), x1); unpack8(*(const v4u*)(krow + 64 + c8 * 8), x2);
#pragma unroll
              for (int j = 0; j < 8; ++j) { const float invf = exp2f(-(float)(c8 * 8 + j) * (13.287712379549449f / 64.f)); float sn, cs; fast_sincos(pz * invf, sn, cs);
                  const float a = (x1[j] * cs - x2[j] * sn) * fk, bq = (x1[j] * sn + x2[j] * cs) * fk; x1[j] = a; x2[j] = bq; }
              v4u o; o.x = pk2(x1[0], x1[1]); o.y = pk2(x1[2], x1[3]); o.z = pk2(x1[4], x1[5]); o.w = pk2(x1[6], x1[7]); *(LAS v4u*)(KT + srow * P + c8 * 16) = o;
              o.x = pk2(x2[0], x2[1]); o.y = pk2(x2[2], x2[3]); o.z = pk2(x2[4], x2[5]); o.w = pk2(x2[6], x2[7]); *(LAS v4u*)(KT + srow * P + (c8 + 8) * 16) = o; } }
        bf16x8 qf[4], pf[4]; float rs[4] = {0.f, 0.f, 0.f, 0.f}, rq[4] = {0.f, 0.f, 0.f, 0.f};
        {
          const float fq = exp2f((float)(16 * w + i16) * lg), pz = (float)posv[m0 + 16 * w + i16];
          const bf16* qrow = proj + (m0 + 16 * w + i16) * AB_IN + 512 + h * 128;
#pragma unroll
          for (int ks = 0; ks < 2; ++ks) { float x1[8], x2[8]; unpack8(*(const v4u*)(qrow + 32 * ks + 8 * g), x1); unpack8(*(const v4u*)(qrow + 64 + 32 * ks + 8 * g), x2);
#pragma unroll
              for (int j = 0; j < 8; ++j) { const float invf = exp2f(-(float)(32 * ks + 8 * g + j) * (13.287712379549449f / 64.f)); float sn, cs; fast_sincos(pz * invf, sn, cs);
                  const float a = (x1[j] * cs - x2[j] * sn) * fq, bq = (x1[j] * sn + x2[j] * cs) * fq; x1[j] = a; x2[j] = bq; }
              v4u o; o.x = pk2(x1[0], x1[1]); o.y = pk2(x1[2], x1[3]); o.z = pk2(x1[4], x1[5]); o.w = pk2(x1[6], x1[7]); qf[ks] = __builtin_bit_cast(bf16x8, o);
              o.x = pk2(x2[0], x2[1]); o.y = pk2(x2[2], x2[3]); o.z = pk2(x2[4], x2[5]); o.w = pk2(x2[6], x2[7]); qf[ks + 2] = __builtin_bit_cast(bf16x8, o); } }
#pragma unroll
        for (int hv = 0; hv < 2; ++hv) {
            if (hv == 1) __syncthreads();
#pragma unroll
            for (int c = 0; c < 4; ++c) { const int c8 = scb + c; *(LAS v4u*)(VT + srow * P + c8 * 16) = vpre[c]; }
            if (hv == 0) {
#pragma unroll
                for (int c = 0; c < 4; ++c) vpre[c] = *(const v4u*)(proj + (m0 + srow) * AB_IN + 2048 + h * 256 + 128 + (scb + c) * 8); }
            { LAS unsigned char* stw = ST + (16 * w + 4 * g) * P + i16 * 2;
#pragma unroll
              for (int dt = 0; dt < 8; ++dt)
#pragma unroll
                for (int r = 0; r < 4; ++r) { T[hv][dt][r] *= gc; *(LAS bf16*)(stw + r * P + dt * 32) = (bf16)f2bf(T[hv][dt][r]); } }
            __syncthreads();
            if (hv == 0) {
                f32x4 sc[8];
#pragma unroll
                for (int mt = 0; mt < 8; ++mt) { sc[mt] = (f32x4){0.f, 0.f, 0.f, 0.f};
                    if (mt <= w) {
#pragma unroll
                        for (int ks = 0; ks < 4; ++ks) { const bf16x8 kf = *(const LAS bf16x8*)(KT + rowb + mt * 16 * P + ks * 64); sc[mt] = __builtin_amdgcn_mfma_f32_16x16x32_bf16(kf, qf[ks], sc[mt], 0, 0, 0); }
                        if (mt == w) {
#pragma unroll
                            for (int r = 0; r < 4; ++r) sc[mt][r] = (4 * g + r <= i16) ? sc[mt][r] : 0.f; } } }
#pragma unroll
                for (int k2 = 0; k2 < 4; ++k2) { v4u wv; wv.x = pk2(sc[2 * k2][0], sc[2 * k2][1]); wv.y = pk2(sc[2 * k2][2], sc[2 * k2][3]); wv.z = pk2(sc[2 * k2 + 1][0], sc[2 * k2 + 1][1]); wv.w = pk2(sc[2 * k2 + 1][2], sc[2 * k2 + 1][3]);
                    pf[k2] = __builtin_bit_cast(bf16x8, wv); }
            }
#pragma unroll
            for (int nt = 0; nt < 8; ++nt) { f32x4 acc = (f32x4){0.f, 0.f, 0.f, 0.f};
#pragma unroll
                for (int k2 = 0; k2 < 4; ++k2) if (2 * k2 <= w) { const bf16x8 vf = ret::trfrag(trV4, 32 * k2, 32 * k2 + 16, 16 * nt); acc = __builtin_amdgcn_mfma_f32_16x16x32_bf16(pf[k2], vf, acc, 0, 0, 0); }
#pragma unroll
                for (int ks = 0; ks < 4; ++ks) { const bf16x8 sf = *(const LAS bf16x8*)(ST + rowb + nt * 16 * P + ks * 64); acc = __builtin_amdgcn_mfma_f32_16x16x32_bf16(qf[ks], sf, acc, 0, 0, 0); }
#pragma unroll
                for (int r = 0; r < 4; ++r) { rs[r] += acc[r]; rq[r] += acc[r] * acc[r]; mixin[(m0 + 16 * w + 4 * g + r) * ND + 512 + h * 256 + hv * 128 + 16 * nt + i16] = (bf16)f2bf(acc[r]); } }
#pragma unroll
            for (int ks = 0; ks < 4; ++ks) { const bf16x8 af = ret::trfrag(trV8, 32 * ks, 32 * ks + 4, 16 * w);
#pragma unroll
                for (int dt = 0; dt < 8; ++dt) { const bf16x8 bfr = ret::trfrag(trK8, 32 * ks, 32 * ks + 4, 16 * dt); T[hv][dt] = __builtin_amdgcn_mfma_f32_16x16x32_bf16(af, bfr, T[hv][dt], 0, 0, 0); } }
        }
#pragma unroll
        for (int r = 0; r < 4; ++r) { float sm = rs[r], s2 = rq[r];
            sm += __shfl_xor(sm, 1); sm += __shfl_xor(sm, 2); sm += __shfl_xor(sm, 4); sm += __shfl_xor(sm, 8);
            s2 += __shfl_xor(s2, 1); s2 += __shfl_xor(s2, 2); s2 += __shfl_xor(s2, 4); s2 += __shfl_xor(s2, 8);
            const float mean = sm * (1.f / 256.f); const float var = fmaxf(s2 * (1.f / 256.f) - mean * mean, 0.f);
            const float rstd = 1.f / sqrtf(var + NORM_EPS);
            const size_t m = m0 + 16 * w + 4 * g + r;
#pragma unroll
            for (int t = 0; t < 16; ++t) { bf16* yp = mixin + m * ND + 512 + h * 256 + 16 * t + i16; const float gt = bf1(proj[m * AB_IN + 3584 + h * 256 + 16 * t + i16]);
                *yp = (bf16)f2bf((bf1(*yp) - mean) * rstd * siluf_(gt)); } }
        __syncthreads();
    }
}

__device__ __forceinline__ void p_route(Frame& F, int l) {
    const float* logits = (const float*)(F.ws + WS_LOGITS); const float* rbias = kin(20) + l * NEXP;
    int* tope = (int*)(F.ws + WS_TOPE); float* wsel = (float*)(F.ws + WS_WSEL); int* posb = (int*)(F.ws + WS_SLOT); unsigned* cnt = F.ctl + CW_CNT + l * 64; int* sorted2 = (int*)(F.ws + WS_SORTED2);
    LAS unsigned* lcnt = (LAS unsigned*)F.lds; LAS unsigned* lbase = lcnt + 64; LAS int* le = (LAS int*)(lcnt + 128); LAS unsigned* lp = (LAS unsigned*)(lcnt + 128 + 512);
    const float bias = rbias[F.lane]; const int lane = F.lane;
    for (int chunk = blockIdx.x; chunk < NT / 64; chunk += F.G) {
        __syncthreads();
        if (F.tid < 64) lcnt[F.tid] = 0u;
        __syncthreads();
        float lgv[8];
#pragma unroll
        for (int t = 0; t < 8; ++t) { const int m = chunk * 64 + F.wave * 8 + t;
            lgv[t] = (logits[(size_t)m * 64 + lane] + logits[((size_t)NT + m) * 64 + lane]) + (logits[((size_t)2 * NT + m) * 64 + lane] + logits[((size_t)3 * NT + m) * 64 + lane]); }
#pragma unroll
        for (int t = 0; t < 8; ++t) {
            const int tl = F.wave * 8 + t, m = chunk * 64 + tl;
            const float lg = lgv[t];
            const float sc = sigmoidf_(lg), bi = sc + bias;
            const int grp = lane >> 3;
            int rk = 0;
#pragma unroll
            for (int j = 1; j < 8; ++j) { const int o = lane ^ j; const float ov = __shfl_xor(bi, j); rk += ((ov > bi) || (ov == bi && o < lane)) ? 1 : 0; }
            float gs = rk < 2 ? bi : 0.f; gs += __shfl_xor(gs, 1); gs += __shfl_xor(gs, 2); gs += __shfl_xor(gs, 4);
            int grk = 0;
#pragma unroll
            for (int gg = 0; gg < 8; ++gg) { const float ov = __builtin_bit_cast(float, __builtin_amdgcn_readlane(__builtin_bit_cast(int, gs), gg * 8)); grk += (gg != grp && ((ov > gs) || (ov == gs && gg < grp))) ? 1 : 0; }
            const float mv = grk < 4 ? bi : -1e30f;
            int erk = 0;
#pragma unroll 16
            for (int j = 0; j < 64; ++j) { const float ov = __builtin_bit_cast(float, __builtin_amdgcn_readlane(__builtin_bit_cast(int, mv), j)); erk += ((ov > mv) || (ov == mv && j < lane)) ? 1 : 0; }
            const bool sel = erk < 8;
            const float wsum = wave_sum(sel ? sc : 0.f);
            if (sel) { const unsigned q = __hip_atomic_fetch_add(lcnt + lane, 1u, __ATOMIC_RELAXED, __HIP_MEMORY_SCOPE_WORKGROUP);
                tope[m * 8 + erk] = lane; wsel[m * 8 + erk] = sc / wsum * 2.5f; le[tl * 8 + erk] = lane; lp[tl * 8 + erk] = q; }
        }
        __syncthreads();
        if (F.tid < 64) lbase[F.tid] = atomicAdd(&cnt[F.tid], lcnt[F.tid]);
        __syncthreads();
        { const int e = le[F.tid]; const int pos = (int)(lbase[e] + lp[F.tid]);
          posb[chunk * 512 + F.tid] = (e << 16) | pos; sorted2[(size_t)e * NT + pos] = chunk * 64 + (F.tid >> 3); }
    }
}
__device__ __forceinline__ void load_offsets(Frame& F, int l) {
    volatile LAS int* tab = (volatile LAS int*)(F.lds + TAB_OFF);
    __syncthreads();
    if (F.tid < NEXP) {
        int c = (int)__hip_atomic_load(F.ctl + CW_CNT + l * 64 + F.tid, __ATOMIC_RELAXED, __HIP_MEMORY_SCOPE_AGENT); if (c > NT) c = NT;
        const int ntl = (c + 255) >> 8; int incl = ntl;
#pragma unroll
        for (int d = 1; d < 64; d <<= 1) { const int o = __shfl_up(incl, d); if (F.tid >= d) incl += o; }
        const int excl = incl - ntl;
        tab[F.tid] = excl << 8; tab[66 + F.tid] = c;
        for (int t = 0; t < ntl; ++t) if (excl + t < MAXTILES) tab[160 + excl + t] = F.tid;
        if (F.tid == NEXP - 1) { tab[64] = incl << 8; tab[65] = incl; }
    }
    __syncthreads();
}
__device__ __forceinline__ void p_scatter(Frame& F, int l) {
    load_offsets(F, l);
    const LAS int* tab = (const LAS int*)(F.lds + TAB_OFF);
    const int* tope = (const int*)(F.ws + WS_TOPE); int* slot = (int*)(F.ws + WS_SLOT); int* sorted = (int*)(F.ws + WS_SORTED);
    for (int i = F.gw * 64 + F.lane; i < NT * 8; i += F.NGW * 64) { const int e = tope[i]; const int row = tab[e] + slot[i]; sorted[row] = i >> 3; slot[i] = row; }
    for (int i = F.gw * 64 + F.lane; i < NEXP * 256; i += F.NGW * 64) { const int e = i >> 8, j = i & 255; const int r = tab[e] + tab[66 + e] + j; if (r < tab[e + 1]) sorted[r] = 0; }
}

__device__ __forceinline__ void p_l1_thin_a(Frame& F) {
    const bf16* proj = (const bf16*)(F.ws + WS_PROJ); const int* pos = (const int*)kin(1);
    bf16* cqn = (bf16*)(F.ws + WS_CQN); bf16* ckvn = (bf16*)(F.ws + WS_CKVN); bf16* krot = (bf16*)(F.ws + WS_KROT); bf16* cmpkv = (bf16*)(F.ws + WS_CMPKV);
    const float* qn = kin(10); const float* kvn = kin(12);
    for (int m = F.gw; m < NT; m += F.NGW) {
        const bf16* row = proj + (size_t)m * CD_INP;
        { float x[6]; float s = 0.f;
#pragma unroll
          for (int j = 0; j < 6; ++j) { x[j] = bf1(row[2584 + j * 64 + F.lane]); s += x[j] * x[j]; }
          const float r = 1.f / sqrtf(wave_sum(s) * (1.f / 384.f) + NORM_EPS);
#pragma unroll
          for (int j = 0; j < 6; ++j) cqn[(size_t)m * 384 + j * 64 + F.lane] = (bf16)f2bf(x[j] * r * qn[j * 64 + F.lane]); }
        { float x[8]; float s = 0.f;
#pragma unroll
          for (int j = 0; j < 8; ++j) { x[j] = bf1(row[2968 + j * 64 + F.lane]); s += x[j] * x[j]; }
          const float r = 1.f / sqrtf(wave_sum(s) * (1.f / 512.f) + NORM_EPS);
#pragma unroll
          for (int j = 0; j < 8; ++j) ckvn[(size_t)m * 512 + j * 64 + F.lane] = (bf16)f2bf(x[j] * r * kvn[j * 64 + F.lane]); }
        { const int i = F.lane & 31; const float p = (float)pos[m]; const float invf = exp2f(-(float)i * (13.287712379549449f / 32.f));
          float sn, cs; fast_sincos(p * invf, sn, cs);
          const float x1 = bf1(row[3480 + i]), x2 = bf1(row[3480 + 32 + i]);
          if (F.lane < 32) krot[(size_t)m * 64 + i] = (bf16)f2bf(x1 * cs - x2 * sn); else krot[(size_t)m * 64 + 32 + i] = (bf16)f2bf(x1 * sn + x2 * cs); }
        { const int b = m >> 11, s = m & (NS - 1);
          const int q4 = F.lane >> 4, c = F.lane & 15, kv = q4 >> 1, g = q4 & 1;
          const v4u w = *(const v4u*)(row + 1024 + q4 * 128 + c * 8);
          *(v4u*)(cmpkv + ((size_t)((kv * 16 + b * 2 + g) * NS + s)) * 128 + c * 8) = w; }
    }
}
__device__ __forceinline__ void p_l1_thin_b(Frame& F) {
    const float* hid = (const float*)(F.ws + WS_HIDP); const float* w2 = kin(9); bf16* kvc = (bf16*)(F.ws + WS_KVCMP);
    for (int m = F.gw; m < 4096; m += F.NGW) {
        const int kv = m >> 11;
        float h0 = 0.f, h1 = 0.f;
#pragma unroll
        for (int sp = 0; sp < pg8::CMP_SPLIT; ++sp) { h0 += hid[((size_t)sp * 4096 + m) * 256 + kv * 128 + F.lane]; h1 += hid[((size_t)sp * 4096 + m) * 256 + kv * 128 + 64 + F.lane]; }
        h0 = 0.5f * h0 * (1.f + tanhf(0.7978845608028654f * (h0 + 0.044715f * h0 * h0 * h0)));
        h1 = 0.5f * h1 * (1.f + tanhf(0.7978845608028654f * (h1 + 0.044715f * h1 * h1 * h1)));
        const float* w = w2 + (size_t)kv * 128 * 128; float o0 = 0.f, o1 = 0.f;
#pragma unroll 16
        for (int c = 0; c < 64; ++c) { const float a = __builtin_bit_cast(float, __builtin_amdgcn_readlane(__builtin_bit_cast(int, h0), c)), bq = __builtin_bit_cast(float, __builtin_amdgcn_readlane(__builtin_bit_cast(int, h1), c));
            o0 += a * w[c * 128 + F.lane] + bq * w[(c + 64) * 128 + F.lane]; o1 += a * w[c * 128 + 64 + F.lane] + bq * w[(c + 64) * 128 + 64 + F.lane]; }
        kvc[(size_t)m * 128 + F.lane] = (bf16)f2bf(o0); kvc[(size_t)m * 128 + 64 + F.lane] = (bf16)f2bf(o1);
    }
}
__device__ __forceinline__ void p_nsa_cmp_mfma(Frame& F) {
    typedef short v4i16_t __attribute__((ext_vector_type(4)));
    const bf16* proj = (const bf16*)(F.ws + WS_PROJ); const bf16* kvc = (const bf16*)(F.ws + WS_KVCMP); float* ocmp = (float*)(F.ws + WS_OCMP); unsigned* selm = (unsigned*)(F.ws + WS_SELM);
    constexpr int P = 272;
    LAS unsigned char* KT = F.lds; LAS unsigned char* VT = F.lds + 128 * P; LAS float* PS = (LAS float*)(F.lds + 2 * 128 * P);
    const int w = F.wave, lane = F.lane, i16 = lane & 15, g = lane >> 4, q4 = (lane & 15) >> 2, p4 = lane & 3;
    const float sscale = 0.08838834764831845f * 1.4426950408889634f;
    for (int bu = blockIdx.x; bu < 256; bu += F.G) {
        const int bg = bu >> 4, qg = bu & 15, b = bg >> 1, gq = bg & 1;
        __syncthreads();
#pragma unroll
        for (int c = 0; c < 4; ++c) { const int idx = F.tid + 512 * c, row = idx >> 4, c8 = idx & 15;
            v4u kk = (v4u){0u, 0u, 0u, 0u}, vv = (v4u){0u, 0u, 0u, 0u};
            if (row < 127) { kk = *(const v4u*)(kvc + ((size_t)(0 * 16 + bg) * 128 + row) * 128 + c8 * 8); vv = *(const v4u*)(kvc + ((size_t)(1 * 16 + bg) * 128 + row) * 128 + c8 * 8); }
            *(LAS v4u*)(KT + row * P + c8 * 16) = kk; *(LAS v4u*)(VT + row * P + c8 * 16) = vv; }
        bf16x8 qf[4];
        { const int h = gq * 4 + (w >> 1), spos = qg * 128 + (w & 1) * 16 + i16;
#pragma unroll
          for (int ks = 0; ks < 4; ++ks) qf[ks] = *(const bf16x8*)(proj + (size_t)(b * NS + spos) * CD_INP + h * 128 + 32 * ks + 8 * g); }
        for (int k = 0; k < 4; ++k) {
            const int q0 = (qg * 4 + k) * 32, h = gq * 4 + (w >> 1), ql = (w & 1) * 16 + i16, spos = q0 + ql;
            float gt[4];
#pragma unroll
            for (int r = 0; r < 4; ++r) gt[r] = bf1(proj[(size_t)(b * NS + q0 + (w & 1) * 16 + 4 * g + r) * CD_INP + 2560 + h * 3 + 0]);
            __syncthreads();
            const int nvalid = spos >= 31 ? ((spos - 31) >> 4) + 1 : 0;
            f32x4 sc[8]; float mx = -1e30f;
#pragma unroll
            for (int mt = 0; mt < 8; ++mt) { sc[mt] = (f32x4){0.f, 0.f, 0.f, 0.f};
#pragma unroll
                for (int ks = 0; ks < 4; ++ks) { const bf16x8 kf = *(const LAS bf16x8*)(KT + (16 * mt + i16) * P + (32 * ks + 8 * g) * 2); sc[mt] = __builtin_amdgcn_mfma_f32_16x16x32_bf16(kf, qf[ks], sc[mt], 0, 0, 0); }
#pragma unroll
                for (int r = 0; r < 4; ++r) { const bool ok = (16 * mt + 4 * g + r) < nvalid; const float x = ok ? sc[mt][r] * sscale : -1e30f; sc[mt][r] = x; mx = fmaxf(mx, x); } }
            if (k < 3) {
#pragma unroll
                for (int ks = 0; ks < 4; ++ks) qf[ks] = *(const bf16x8*)(proj + (size_t)(b * NS + spos + 32) * CD_INP + h * 128 + 32 * ks + 8 * g); }
            mx = fmaxf(mx, __shfl_xor(mx, 16)); mx = fmaxf(mx, __shfl_xor(mx, 32));
            float ps = 0.f;
#pragma unroll
            for (int mt = 0; mt < 8; ++mt)
#pragma unroll
                for (int r = 0; r < 4; ++r) { const bool ok = (16 * mt + 4 * g + r) < nvalid; const float pv = ok ? __builtin_amdgcn_exp2f(sc[mt][r] - mx) : 0.f; sc[mt][r] = pv; ps += pv; }
            ps += __shfl_xor(ps, 16); ps += __shfl_xor(ps, 32);
            const float inv = ps > 0.f ? 1.f / ps : 0.f;
#pragma unroll
            for (int mt = 0; mt < 8; ++mt)
#pragma unroll
                for (int r = 0; r < 4; ++r) sc[mt][r] *= inv;
            { LAS float* slab = PS + (w >> 2) * 4096 + ql * 128 + 4 * g;
              if (((w >> 1) & 1) == 0) {
#pragma unroll
                  for (int mt = 0; mt < 8; ++mt) *(LAS f32x4*)(slab + 16 * mt) = sc[mt]; }
              __syncthreads();
              if (((w >> 1) & 1) == 1) {
#pragma unroll
                  for (int mt = 0; mt < 8; ++mt) { const f32x4 t = *(const LAS f32x4*)(slab + 16 * mt); *(LAS f32x4*)(slab + 16 * mt) = t + sc[mt]; } } }
            f32x4 O[8];
#pragma unroll
            for (int nt = 0; nt < 8; ++nt) O[nt] = (f32x4){0.f, 0.f, 0.f, 0.f};
#pragma unroll
            for (int k2 = 0; k2 < 4; ++k2) { v4u wv; wv.x = pk2(sc[2 * k2][0], sc[2 * k2][1]); wv.y = pk2(sc[2 * k2][2], sc[2 * k2][3]); wv.z = pk2(sc[2 * k2 + 1][0], sc[2 * k2 + 1][1]); wv.w = pk2(sc[2 * k2 + 1][2], sc[2 * k2 + 1][3]);
                const bf16x8 pf = __builtin_bit_cast(bf16x8, wv);
#pragma unroll
                for (int nt = 0; nt < 8; ++nt) {
                    const v4i16_t a = __builtin_amdgcn_ds_read_tr16_b64_v4i16((LAS v4i16_t*)(VT + (32 * k2 + 4 * g + q4) * P + (16 * nt + 4 * p4) * 2));
                    const v4i16_t c = __builtin_amdgcn_ds_read_tr16_b64_v4i16((LAS v4i16_t*)(VT + (32 * k2 + 16 + 4 * g + q4) * P + (16 * nt + 4 * p4) * 2));
                    const bf16x8 vf = (bf16x8){a[0], a[1], a[2], a[3], c[0], c[1], c[2], c[3]};
                    O[nt] = __builtin_amdgcn_mfma_f32_16x16x32_bf16(pf, vf, O[nt], 0, 0, 0); } }
#pragma unroll
            for (int r = 0; r < 4; ++r) { const size_t m = (size_t)(b * NS + q0 + (w & 1) * 16 + 4 * g + r); const float gs = sigmoidf_(gt[r]);
#pragma unroll
                for (int nt = 0; nt < 8; ++nt) ocmp[m * 1024 + h * 128 + 16 * nt + i16] = gs * O[nt][r]; }
            __syncthreads();
#pragma unroll
            for (int qq = 0; qq < 4; ++qq) { const int qi = 4 * w + qq, s = q0 + qi, cur = s >> 6, j = lane & 31;
                float imp = 0.f;
#pragma unroll
                for (int kk = 0; kk < 4; ++kk) { const int n1 = 4 * j + kk; if (n1 <= 126) imp += PS[qi * 128 + n1] + PS[4096 + qi * 128 + n1]; const int n2 = 4 * j - 1 + kk; if (n2 >= 0 && n2 <= 126) imp += PS[qi * 128 + n2] + PS[4096 + qi * 128 + n2]; }
                const bool forced = (j == 0) || (j == cur) || (j == cur - 1);
                const float score = forced ? 1e4f : ((j * 64 <= s) ? imp : -1e30f);
                int rk = 0;
#pragma unroll
                for (int jj = 0; jj < 32; ++jj) { const float ov = __builtin_bit_cast(float, __builtin_amdgcn_readlane(__builtin_bit_cast(int, score), jj)); rk += ((ov > score) || (ov == score && jj < j)) ? 1 : 0; }
                const bool sel = (lane < 32) && (rk < 16) && (j <= cur);
                const unsigned long long bal = __ballot(sel);
                if (lane == 0) selm[(size_t)(b * NS + s) * 2 + gq] = (unsigned)bal; }
        }
    }
}

namespace fa {
typedef short v4i16_t __attribute__((ext_vector_type(4)));
struct Src { const bf16* k1; size_t ks1; const bf16* k2; size_t ks2; const bf16* v; size_t vs; };
template <int DQK> struct Cfg { static constexpr int KPITCH = (DQK + 8) * 2, KBYTES = 64 * KPITCH, VPITCH = 272, VBYTES = 64 * VPITCH, BUF = KBYTES + VBYTES, NKS = DQK / 32, KCH = DQK / 8, NKR = DQK / 64; };

template <int DQK> struct TileOff { unsigned gk[Cfg<DQK>::NKR], gv[2], lk[Cfg<DQK>::NKR], lv[2]; };
template <int DQK>
__device__ __forceinline__ void tile_offsets(const Src& S, int tid, TileOff<DQK>& T) {
#pragma unroll
    for (int i = 0; i < 2; ++i) { const int c = tid + 512 * i, row = c >> 4, c8 = c & 15;
        T.gk[i] = (unsigned)(row * (int)S.ks1 + c8 * 8) * 2u; T.gv[i] = (unsigned)(row * (int)S.vs + c8 * 8) * 2u;
        T.lk[i] = (unsigned)(row * Cfg<DQK>::KPITCH + c8 * 16); T.lv[i] = (unsigned)(Cfg<DQK>::KBYTES + row * Cfg<DQK>::VPITCH + c8 * 16); }
    if (DQK == 192) { const int row = tid >> 3, c8 = tid & 7; T.gk[Cfg<DQK>::NKR - 1] = (unsigned)(row * (int)S.ks2 + c8 * 8) * 2u; T.lk[Cfg<DQK>::NKR - 1] = (unsigned)(row * Cfg<DQK>::KPITCH + 256 + c8 * 16); }
}
template <int DQK>
__device__ __forceinline__ void load_tile(const Src& S, int k0, const TileOff<DQK>& T, v4u (&kr)[Cfg<DQK>::NKR], v4u (&vr)[2]) {
    const char* kb1 = (const char*)S.k1 + (size_t)k0 * S.ks1 * 2; const char* vb = (const char*)S.v + (size_t)k0 * S.vs * 2;
#pragma unroll
    for (int i = 0; i < 2; ++i) { kr[i] = *(const v4u*)(kb1 + T.gk[i]); vr[i] = *(const v4u*)(vb + T.gv[i]); }
    if (DQK == 192) { const char* kb2 = (const char*)S.k2 + (size_t)k0 * S.ks2 * 2; kr[Cfg<DQK>::NKR - 1] = *(const v4u*)(kb2 + T.gk[Cfg<DQK>::NKR - 1]); }
}
template <int DQK>
__device__ __forceinline__ void store_tile(LAS unsigned char* buf, const TileOff<DQK>& T, const v4u (&kr)[Cfg<DQK>::NKR], const v4u (&vr)[2]) {
#pragma unroll
    for (int i = 0; i < Cfg<DQK>::NKR; ++i) *(LAS v4u*)(buf + T.lk[i]) = kr[i];
#pragma unroll
    for (int i = 0; i < 2; ++i) *(LAS v4u*)(buf + T.lv[i]) = vr[i];
}
struct RowState { int spos; unsigned rowmask; float m_run, l_run; };
template <int MODE> __device__ __forceinline__ bool group_needs(int t, const RowState& R) {
    bool row_any = (t * 64 <= R.spos);
    if (MODE == 1) row_any = row_any && ((R.rowmask >> t) & 1u);
    if (MODE == 2) row_any = row_any && (t * 64 + 63 + 512 > R.spos);
    return __ballot(row_any) != 0ull;
}
template <int MODE>
__device__ __forceinline__ void softmax_group(f32x4 (&sc)[4], int t, RowState& R, f32x4 (&O)[8], bf16x8 (&pf)[2], int g) {
    float mx = -1e30f;
    bool row_full = (t * 64 + 63 <= R.spos);
    if (MODE == 1) row_full = row_full && ((R.rowmask >> t) & 1u);
    if (MODE == 2) row_full = row_full && (t * 64 + 512 > R.spos);
    if (__ballot(row_full) == ~0ull) {
#pragma unroll
        for (int mt = 0; mt < 4; ++mt)
#pragma unroll
            for (int r = 0; r < 4; ++r) mx = fmaxf(mx, sc[mt][r]);
    } else {
#pragma unroll
        for (int mt = 0; mt < 4; ++mt)
#pragma unroll
            for (int r = 0; r < 4; ++r) { const int kp = t * 64 + 16 * mt + 4 * g + r; bool ok = kp <= R.spos;
                if (MODE == 1) ok = ok && ((R.rowmask >> t) & 1u);
                if (MODE == 2) ok = ok && (kp + 512 > R.spos);
                const float x = ok ? sc[mt][r] : -3e38f; sc[mt][r] = x; mx = fmaxf(mx, x); }
        mx = fmaxf(mx, -1e30f);
    }
    mx = fmaxf(mx, __shfl_xor(mx, 16)); mx = fmaxf(mx, __shfl_xor(mx, 32));
    if (__ballot(mx > R.m_run + 8.0f) != 0ull) {
        const float m_new = fmaxf(R.m_run, mx), alpha = __builtin_amdgcn_exp2f(R.m_run - m_new); R.m_run = m_new;
        R.l_run *= alpha;
        float ar[4];
#pragma unroll
        for (int r = 0; r < 4; ++r) ar[r] = __shfl(alpha, 4 * g + r);
#pragma unroll
        for (int nt = 0; nt < 8; ++nt)
#pragma unroll
            for (int r = 0; r < 4; ++r) O[nt][r] *= ar[r];
    }
    float ps = 0.f;
#pragma unroll
    for (int mt = 0; mt < 4; ++mt)
#pragma unroll
        for (int r = 0; r < 4; ++r) { const float pv = __builtin_amdgcn_exp2f(sc[mt][r] - R.m_run); sc[mt][r] = pv; ps += pv; }
    R.l_run += ps;
#pragma unroll
    for (int k2 = 0; k2 < 2; ++k2) { v4u w; w.x = pk2(sc[2 * k2][0], sc[2 * k2][1]); w.y = pk2(sc[2 * k2][2], sc[2 * k2][3]); w.z = pk2(sc[2 * k2 + 1][0], sc[2 * k2 + 1][1]); w.w = pk2(sc[2 * k2 + 1][2], sc[2 * k2 + 1][3]);
        pf[k2] = __builtin_bit_cast(bf16x8, w); }
}
template <int DQK, int MODE>
__device__ __forceinline__ void fa_compute(LAS unsigned char* kb, LAS unsigned char* vb, const bf16x8 (&qf0)[Cfg<DQK>::NKS], const bf16x8 (&qf1)[Cfg<DQK>::NKS], int t, RowState& R0, RowState& R1, float sscale,
                                           f32x4 (&O0)[8], f32x4 (&O1)[8], int i16, int g, int q4, int p4) {
    typedef Cfg<DQK> C;
    const bool n0 = group_needs<MODE>(t, R0), n1 = group_needs<MODE>(t, R1);
    if (!n0 && !n1) return;
    f32x4 s0[4], s1[4];
#pragma unroll
    for (int mt = 0; mt < 4; ++mt) { s0[mt] = (f32x4){0.f, 0.f, 0.f, 0.f}; s1[mt] = (f32x4){0.f, 0.f, 0.f, 0.f};
#pragma unroll
        for (int ks = 0; ks < C::NKS; ++ks) { const bf16x8 kf = *(const LAS bf16x8*)(kb + (16 * mt + i16) * C::KPITCH + (32 * ks + 8 * g) * 2);
            s0[mt] = __builtin_amdgcn_mfma_f32_16x16x32_bf16(kf, qf0[ks], s0[mt], 0, 0, 0);
            s1[mt] = __builtin_amdgcn_mfma_f32_16x16x32_bf16(kf, qf1[ks], s1[mt], 0, 0, 0); } }
    bf16x8 p0[2], p1[2];
    if (n0) softmax_group<MODE>(s0, t, R0, O0, p0, g); else { p0[0] = (bf16x8){0, 0, 0, 0, 0, 0, 0, 0}; p0[1] = p0[0]; }
    if (n1) softmax_group<MODE>(s1, t, R1, O1, p1, g); else { p1[0] = (bf16x8){0, 0, 0, 0, 0, 0, 0, 0}; p1[1] = p1[0]; }
#pragma unroll
    for (int nt = 0; nt < 8; ++nt)
#pragma unroll
        for (int k2 = 0; k2 < 2; ++k2) {
            const v4i16_t a = __builtin_amdgcn_ds_read_tr16_b64_v4i16((LAS v4i16_t*)(vb + (32 * k2 + 4 * g + q4) * C::VPITCH + (16 * nt + 4 * p4) * 2));
            const v4i16_t b = __builtin_amdgcn_ds_read_tr16_b64_v4i16((LAS v4i16_t*)(vb + (32 * k2 + 16 + 4 * g + q4) * C::VPITCH + (16 * nt + 4 * p4) * 2));
            const bf16x8 vf = (bf16x8){a[0], a[1], a[2], a[3], b[0], b[1], b[2], b[3]};
            O0[nt] = __builtin_amdgcn_mfma_f32_16x16x32_bf16(p0[k2], vf, O0[nt], 0, 0, 0);
            O1[nt] = __builtin_amdgcn_mfma_f32_16x16x32_bf16(p1[k2], vf, O1[nt], 0, 0, 0); }
}
template <int DQK, int MODE>
__device__ __forceinline__ void fa_pass(LAS unsigned char* lds, const Src& S, const bf16x8 (&qf0)[Cfg<DQK>::NKS], const bf16x8 (&qf1)[Cfg<DQK>::NKS], unsigned tmask, RowState& R0, RowState& R1, float sscale,
                                        f32x4 (&O0)[8], f32x4 (&O1)[8], int tid, int lane) {
    typedef Cfg<DQK> C;
    const int i16 = lane & 15, g = lane >> 4, q4 = (lane & 15) >> 2, p4 = lane & 3;
#pragma unroll
    for (int nt = 0; nt < 8; ++nt) { O0[nt] = (f32x4){0.f, 0.f, 0.f, 0.f}; O1[nt] = (f32x4){0.f, 0.f, 0.f, 0.f}; }
    R0.m_run = -1e30f; R0.l_run = 0.f; R1.m_run = -1e30f; R1.l_run = 0.f;
    unsigned rem = tmask;
    if (rem == 0u) return;
    v4u kr[C::NKR], vr[2]; TileOff<DQK> TO; tile_offsets<DQK>(S, tid, TO);
    int t = __builtin_ctz(rem); rem &= rem - 1u;
    load_tile<DQK>(S, t * 64, TO, kr, vr);
    __syncthreads();
    store_tile<DQK>(lds, TO, kr, vr);
    __syncthreads();
    int cur = 0;
    for (;;) {
        const bool has_next = rem != 0u; int tn = 0;
        if (has_next) { tn = __builtin_ctz(rem); rem &= rem - 1u; load_tile<DQK>(S, tn * 64, TO, kr, vr); }
        LAS unsigned char* kb = lds + cur * C::BUF;
        fa_compute<DQK, MODE>(kb, kb + C::KBYTES, qf0, qf1, t, R0, R1, sscale, O0, O1, i16, g, q4, p4);
        if (has_next) store_tile<DQK>(lds + (cur ^ 1) * C::BUF, TO, kr, vr);
        __syncthreads();
        if (!has_next) break;
        t = tn; cur ^= 1;
    }
}
__device__ __forceinline__ void row_inv(float l_run, int lane, float (&inv)[4]) {
    float l = l_run; l += __shfl_xor(l, 16); l += __shfl_xor(l, 32);
    const float li = l > 0.f ? 1.f / l : 0.f; const int g = lane >> 4;
#pragma unroll
    for (int r = 0; r < 4; ++r) inv[r] = __shfl(li, 4 * g + r);
}
__device__ __forceinline__ void scale_frag(bf16x8& f, float sc) {
    v4u w = __builtin_bit_cast(v4u, f); float x[8]; unpack8(w, x);
    w.x = pk2(x[0] * sc, x[1] * sc); w.y = pk2(x[2] * sc, x[3] * sc); w.z = pk2(x[4] * sc, x[5] * sc); w.w = pk2(x[6] * sc, x[7] * sc); f = __builtin_bit_cast(bf16x8, w);
}
__device__ __forceinline__ void rope_qpe(bf16x8& f4, bf16x8& f5, float pz, int g4) {
    v4u w1 = __builtin_bit_cast(v4u, f4), w2 = __builtin_bit_cast(v4u, f5); float x1[8], x2[8]; unpack8(w1, x1); unpack8(w2, x2);
#pragma unroll
    for (int jj = 0; jj < 8; ++jj) { const float invf = exp2f(-(float)(8 * g4 + jj) * (13.287712379549449f / 32.f)); float sn, cs; fast_sincos(pz * invf, sn, cs);
        const float a = x1[jj] * cs - x2[jj] * sn, c = x1[jj] * sn + x2[jj] * cs; x1[jj] = a; x2[jj] = c; }
    w1.x = pk2(x1[0], x1[1]); w1.y = pk2(x1[2], x1[3]); w1.z = pk2(x1[4], x1[5]); w1.w = pk2(x1[6], x1[7]);
    w2.x = pk2(x2[0], x2[1]); w2.y = pk2(x2[2], x2[3]); w2.z = pk2(x2[4], x2[5]); w2.w = pk2(x2[6], x2[7]);
    f4 = __builtin_bit_cast(bf16x8, w1); f5 = __builtin_bit_cast(bf16x8, w2);
}
}

__device__ __forceinline__ void p_attn_mla(Frame& F, unsigned* queue) {
    const bf16* proj = (const bf16*)(F.ws + WS_PROJ); bf16* mixin = (bf16*)(F.ws + WS_MIXIN); const float* ocmp = (const float*)(F.ws + WS_OCMP); const unsigned* selm = (const unsigned*)(F.ws + WS_SELM);
    const bf16* qmla = (const bf16*)(F.ws + WS_QMLA); const bf16* kvu = (const bf16*)(F.ws + WS_KVU); const bf16* krot = (const bf16*)(F.ws + WS_KROT);
    volatile LAS unsigned* qslot = (volatile LAS unsigned*)(F.lds + LDSCTL_OFF);
    const int lane = F.lane, w = F.wave, i16 = lane & 15, g4 = lane >> 4;
    for (;;) {
        __syncthreads();
        if (F.tid == 0) qslot[0] = atomicAdd(queue, 1u);
        __syncthreads();
        const int u = __builtin_amdgcn_readfirstlane((int)qslot[0]);
        if (u >= 512) break;
        {
            const int qt = 7 - (u >> 6), bh = u & 63, b = bh >> 3, h = bh & 7, q0 = qt * 256;
            fa::RowState R0, R1; R0.spos = q0 + 32 * w + i16; R1.spos = R0.spos + 16; R0.rowmask = 0u; R1.rowmask = 0u;
            bf16x8 qf0[6], qf1[6];
#pragma unroll
            for (int ks = 0; ks < 6; ++ks) { qf0[ks] = *(const bf16x8*)(qmla + (size_t)(b * NS + R0.spos) * 1536 + h * 192 + 32 * ks + 8 * g4); qf1[ks] = *(const bf16x8*)(qmla + (size_t)(b * NS + R1.spos) * 1536 + h * 192 + 32 * ks + 8 * g4); }
            fa::rope_qpe(qf0[4], qf0[5], (float)((const int*)kin(1))[b * NS + R0.spos], g4);
            fa::rope_qpe(qf1[4], qf1[5], (float)((const int*)kin(1))[b * NS + R1.spos], g4);
#pragma unroll
            for (int ks = 0; ks < 6; ++ks) { fa::scale_frag(qf0[ks], 0.07216878364870322f * 1.4426950408889634f); fa::scale_frag(qf1[ks], 0.07216878364870322f * 1.4426950408889634f); }
            fa::Src S; S.k1 = kvu + (size_t)(b * NS) * 2048 + h * 256; S.ks1 = 2048; S.k2 = krot + (size_t)(b * NS) * 64; S.ks2 = 64; S.v = S.k1 + 128; S.vs = 2048;
            const int last = (q0 + 255) >> 6; const unsigned tmask = last >= 31 ? 0xffffffffu : ((1u << (last + 1)) - 1u);
            f32x4 O0[8], O1[8];
            fa::fa_pass<192, 0>(F.lds, S, qf0, qf1, tmask, R0, R1, 0.07216878364870322f * 1.4426950408889634f, O0, O1, F.tid, lane);
            float inv[4];
            fa::row_inv(R0.l_run, lane, inv);
#pragma unroll
            for (int r = 0; r < 4; ++r) { bf16* orow = mixin + (size_t)(b * NS + q0 + 32 * w + 4 * g4 + r) * ND + 1024 + h * 128 + i16;
#pragma unroll
                for (int nt = 0; nt < 8; ++nt) orow[16 * nt] = (bf16)f2bf(O0[nt][r] * inv[r]); }
            fa::row_inv(R1.l_run, lane, inv);
#pragma unroll
            for (int r = 0; r < 4; ++r) { bf16* orow = mixin + (size_t)(b * NS + q0 + 32 * w + 16 + 4 * g4 + r) * ND + 1024 + h * 128 + i16;
#pragma unroll
                for (int nt = 0; nt < 8; ++nt) orow[16 * nt] = (bf16)f2bf(O1[nt][r] * inv[r]); }
        }
    }
    (void)proj; (void)ocmp; (void)selm;
}
__device__ __forceinline__ void p_attn_nsa(Frame& F, unsigned* queue) {
    const bf16* proj = (const bf16*)(F.ws + WS_PROJ); bf16* mixin = (bf16*)(F.ws + WS_MIXIN); const float* ocmp = (const float*)(F.ws + WS_OCMP); const unsigned* selm = (const unsigned*)(F.ws + WS_SELM);
    const bf16* qmla = (const bf16*)(F.ws + WS_QMLA); const bf16* kvu = (const bf16*)(F.ws + WS_KVU); const bf16* krot = (const bf16*)(F.ws + WS_KROT);
    volatile LAS unsigned* qslot = (volatile LAS unsigned*)(F.lds + LDSCTL_OFF);
    const int lane = F.lane, w = F.wave, i16 = lane & 15, g4 = lane >> 4;
    for (;;) {
        __syncthreads();
        if (F.tid == 0) qslot[0] = atomicAdd(queue, 1u);
        __syncthreads();
        const int u = __builtin_amdgcn_readfirstlane((int)qslot[0]);
        if (u >= 512) break;
        {
            const int v = u;
            const int qt = 31 - (v >> 4), bg = v & 15, b = bg >> 1, gq = bg & 1, q0 = qt * 64;
            const int h = gq * 4 + (w >> 1), qb = q0 + (w & 1) * 32;
            fa::RowState R0, R1; R0.spos = qb + i16; R1.spos = qb + 16 + i16;
            bf16x8 qf0[4], qf1[4];
#pragma unroll
            for (int ks = 0; ks < 4; ++ks) { qf0[ks] = *(const bf16x8*)(proj + (size_t)(b * NS + R0.spos) * CD_INP + h * 128 + 32 * ks + 8 * g4); qf1[ks] = *(const bf16x8*)(proj + (size_t)(b * NS + R1.spos) * CD_INP + h * 128 + 32 * ks + 8 * g4); }
#pragma unroll
            for (int ks = 0; ks < 4; ++ks) { fa::scale_frag(qf0[ks], 0.08838834764831845f * 1.4426950408889634f); fa::scale_frag(qf1[ks], 0.08838834764831845f * 1.4426950408889634f); }
            R0.rowmask = selm[(size_t)(b * NS + R0.spos) * 2 + gq]; R1.rowmask = selm[(size_t)(b * NS + R1.spos) * 2 + gq];
            unsigned um = selm[(size_t)(b * NS + q0 + lane) * 2 + gq];
#pragma unroll
            for (int o = 1; o < 64; o <<= 1) um |= (unsigned)__shfl_xor((int)um, o);
            um = (unsigned)__builtin_amdgcn_readfirstlane((int)um);
            const bf16* base = proj + (size_t)(b * NS) * CD_INP;
            const float sscale = 0.08838834764831845f * 1.4426950408889634f;
            f32x4 O0[8], O1[8]; float inv[4];
            { fa::Src S; S.k1 = base + 1024 + ((1 * 2 + 0) * 2 + gq) * 128; S.ks1 = CD_INP; S.k2 = nullptr; S.ks2 = 0; S.v = base + 1024 + ((1 * 2 + 1) * 2 + gq) * 128; S.vs = CD_INP;
              fa::fa_pass<128, 1>(F.lds, S, qf0, qf1, um, R0, R1, sscale, O0, O1, F.tid, lane); }
            fa::row_inv(R0.l_run, lane, inv);
#pragma unroll
            for (int r = 0; r < 4; ++r) { const size_t m = (size_t)(b * NS + qb + 4 * g4 + r); const float g1 = sigmoidf_(bf1(proj[m * CD_INP + 2560 + h * 3 + 1])) * inv[r];
#pragma unroll
                for (int nt = 0; nt < 8; ++nt) mixin[m * ND + h * 128 + 16 * nt + i16] = (bf16)f2bf(ocmp[m * 1024 + h * 128 + 16 * nt + i16] + O0[nt][r] * g1); }
            fa::row_inv(R1.l_run, lane, inv);
#pragma unroll
            for (int r = 0; r < 4; ++r) { const size_t m = (size_t)(b * NS + qb + 16 + 4 * g4 + r); const float g1 = sigmoidf_(bf1(proj[m * CD_INP + 2560 + h * 3 + 1])) * inv[r];
#pragma unroll
                for (int nt = 0; nt < 8; ++nt) mixin[m * ND + h * 128 + 16 * nt + i16] = (bf16)f2bf(ocmp[m * 1024 + h * 128 + 16 * nt + i16] + O1[nt][r] * g1); }
            { fa::Src S; S.k1 = base + 1024 + ((2 * 2 + 0) * 2 + gq) * 128; S.ks1 = CD_INP; S.k2 = nullptr; S.ks2 = 0; S.v = base + 1024 + ((2 * 2 + 1) * 2 + gq) * 128; S.vs = CD_INP;
              const int klo = q0 - 511 > 0 ? q0 - 511 : 0, tlo = klo >> 6, thi = (q0 + 63) >> 6;
              const unsigned hm = thi >= 31 ? 0xffffffffu : ((1u << (thi + 1)) - 1u); const unsigned tmask = hm & ~((1u << tlo) - 1u);
              fa::fa_pass<128, 2>(F.lds, S, qf0, qf1, tmask, R0, R1, sscale, O0, O1, F.tid, lane); }
            fa::row_inv(R0.l_run, lane, inv);
#pragma unroll
            for (int r = 0; r < 4; ++r) { const size_t m = (size_t)(b * NS + qb + 4 * g4 + r); const float g2 = sigmoidf_(bf1(proj[m * CD_INP + 2560 + h * 3 + 2])) * inv[r];
#pragma unroll
                for (int nt = 0; nt < 8; ++nt) { bf16* op = mixin + m * ND + h * 128 + 16 * nt + i16; *op = (bf16)f2bf(bf1(*op) + O0[nt][r] * g2); } }
            fa::row_inv(R1.l_run, lane, inv);
#pragma unroll
            for (int r = 0; r < 4; ++r) { const size_t m = (size_t)(b * NS + qb + 16 + 4 * g4 + r); const float g2 = sigmoidf_(bf1(proj[m * CD_INP + 2560 + h * 3 + 2])) * inv[r];
#pragma unroll
                for (int nt = 0; nt < 8; ++nt) { bf16* op = mixin + m * ND + h * 128 + 16 * nt + i16; *op = (bf16)f2bf(bf1(*op) + O1[nt][r] * g2); } }
        }
    }
    (void)qmla; (void)kvu; (void)krot;
}

constexpr int NPHASE = 33;


#define IN(k) (lo <= (k) && (k) < hi)
#define SEAM(k) do { F.lane = lane_id_fresh(); F.tid = F.wave * 64 + F.lane; if (IN(k) && IN((k) + 1)) { if (MK_ONE_LAUNCH) xcd_barrier(bar); else if (F.tid == 0) __hip_atomic_store(F.ctl + CW_TMO, 0xBAD0u | (unsigned)(k), __ATOMIC_RELAXED, __HIP_MEMORY_SCOPE_AGENT); \
    if (MK_PROBE_PHASE >= 0 && blockIdx.x == 0 && F.tid == 0) { if ((k) == MK_PROBE_PHASE - 1) ((volatile LAS unsigned long long*)(F.lds + LDSCTL_OFF + 64))[0] = __builtin_amdgcn_s_memrealtime(); \
        if ((k) == MK_PROBE_LAST) ((volatile LAS unsigned long long*)(F.lds + LDSCTL_OFF + 64))[1] = __builtin_amdgcn_s_memrealtime(); } } } while (0)
template <int l>
__device__ __forceinline__ void layer_body(Frame& F, const XcdBarrier& bar, const int lo, const int hi) {
    unsigned char* ws = F.ws;
    bf16* const XB0 = (bf16*)(ws + WS_XB0); bf16* const X1B = (bf16*)(ws + WS_X1B); bf16* const X2B = (bf16*)(ws + WS_X2B);
    bf16* const PROJ = (bf16*)(ws + WS_PROJ); bf16* const MIXIN = (bf16*)(ws + WS_MIXIN); bf16* const MIXO = (bf16*)(ws + WS_MIXO);
    bf16* const HB = (bf16*)(ws + WS_H); bf16* const Y2 = (bf16*)(ws + WS_Y2);
        const int pb = 1 + l * 16;
        const bf16* xin = l == 0 ? XB0 : X2B;
        if (IN(pb + 0)) {
            if (l == 0 && MK_FP8_IN0) { pg8::DenseProb P; P.init((const bf16*)(ws + WS_X1F8), ND / 2, (const bf16*)(ws + WS_WABIN), NT, AB_IN, ND / 2, F.G, (int)blockIdx.x); pg8::EpiBf16P2 E{PROJ, AB_IN};
                pg8::gemm_phase<pg8::EpiBf16P2, pg8::DenseProb, true, true, false>(F.lds, P, E, F.wave); }
            else if (l == 0) { pg8::DenseProb P; P.init(xin, ND, (const bf16*)(ws + WS_WABIN), NT, AB_IN, ND, F.G, (int)blockIdx.x); pg8::EpiBf16P2 E{PROJ, AB_IN};
                pg8::gemm_phase<pg8::EpiBf16P2, pg8::DenseProb, true>(F.lds, P, E, F.wave); }
            else if (l == 1 && MK_FP8_IN1 && MK_F8_NB2_IN) { pg8::DenseProb P; P.init((const bf16*)(ws + WS_X1F8), ND / 2, (const bf16*)(ws + WS_WCDIN), NT, CD_INP, ND / 2, F.G, (int)blockIdx.x); pg8::EpiBf16P2 E{PROJ, CD_INP};
                pg8::gemm_phase<pg8::EpiBf16P2, pg8::DenseProb, true, true, false>(F.lds, P, E, F.wave); }
            else if (l == 1 && MK_FP8_IN1) { pg8::DenseProb P; P.init((const bf16*)(ws + WS_X1F8), ND / 2, (const bf16*)(ws + WS_WCDIN), NT, CD_INP, ND / 2, F.G, (int)blockIdx.x, 128); pg8::EpiBf16N128 E{PROJ, CD_INP, 1.0f / 64.0f};
                pg8::gemm_phase<pg8::EpiBf16N128, pg8::DenseProb, true, true>(F.lds, P, E, F.wave); }
            else { pg8::DenseProb P; P.init(xin, ND, (const bf16*)(ws + WS_WCDIN), NT, CD_INP, ND, F.G, (int)blockIdx.x); pg8::EpiBf16P2 E{PROJ, CD_INP};
                pg8::gemm_phase<pg8::EpiBf16P2, pg8::DenseProb, true>(F.lds, P, E, F.wave); }
        } SEAM(pb + 0);
        if (l == 0) {
            if (IN(pb + 2)) { if (blockIdx.x < NB * 6) p_retention_mfma(F, (int)blockIdx.x); else p_pool(F, ((int)blockIdx.x - NB * 6) * NWAVES + F.wave, (F.G - NB * 6) * NWAVES);
                __syncthreads(); p_moe_weights_queue(F, F.ctl + CW_CNT + 320); } SEAM(pb + 2);
        } else {
            if (IN(pb + 1)) { cmp_bias_finish(F); p_l1_thin_a(F); } SEAM(pb + 1);
            if (IN(pb + 2)) {
                constexpr int NCMP = 16 * pg8::CMP_SPLIT;
                { pg8::DenseProb P; P.init((const bf16*)(ws + WS_CKVN), 512, (const bf16*)(ws + WS_WUKV), NT, 2048, 512, F.G, (int)blockIdx.x); pg8::EpiBf16P2 E{(bf16*)(ws + WS_KVU), 2048};
                  pg8::gemm_phase<pg8::EpiBf16P2, pg8::DenseProb, true>(F.lds, P, E, F.wave); }
                if (blockIdx.x < NCMP) { pg8::CmpProb P; P.K = 4096 / pg8::CMP_SPLIT; P.ldb = 4096; P.Abase = (const char*)(ws + WS_CMPKV); P.Bt = (const char*)(ws + WS_CW1); P.G = NCMP; P.c = (int)blockIdx.x;
                  pg8::EpiF32Split E{(float*)(ws + WS_HIDP), (const float*)(ws + WS_CMPB)};
                  pg8::gemm_phase<pg8::EpiF32Split, pg8::CmpProb, true>(F.lds, P, E, F.wave); }
                else {
                { pg8::DenseProb P; P.init((const bf16*)(ws + WS_CQN), 384, (const bf16*)(ws + WS_WUQ), NT, 1536, 384, F.G - NCMP, (int)blockIdx.x - NCMP); pg8::EpiBf16P2 E{(bf16*)(ws + WS_QMLA), 1536};
                  pg8::gemm_phase<pg8::EpiBf16P2, pg8::DenseProb, true>(F.lds, P, E, F.wave); }
                }
            } SEAM(pb + 2);
            if (IN(pb + 3)) { p_l1_thin_b(F); } SEAM(pb + 3);
            if (IN(pb + 4)) { p_nsa_cmp_mfma(F); } SEAM(pb + 4);
            if (IN(pb + 5)) { if (MK_ATTN_PRIO && F.wave < 4) __builtin_amdgcn_s_setprio(2);
                p_attn_nsa(F, F.ctl + CW_CNT + 257); p_attn_mla(F, F.ctl + CW_CNT + 256);     __builtin_amdgcn_s_setprio(0); } SEAM(pb + 5);
        }
        if (IN(pb + 6)) { pg8::DenseProb P; P.init(MIXIN, ND, (const bf16*)(ws + (l == 0 ? WS_WABOUT : WS_WCDOUT)), NT, ND, ND, F.G, (int)blockIdx.x); pg8::EpiBf16P2 E{MIXO, ND};
            pg8::gemm_phase<pg8::EpiBf16P2, pg8::DenseProb, true>(F.lds, P, E, F.wave); } SEAM(pb + 6);
        if (IN(pb + 7)) { p_ln1(F, xin, MIXO, kin(15) + l * ND, kin(16) + l * ND, X1B, MK_FP8_MOE ? (unsigned char*)(ws + WS_X1F8) : nullptr); } SEAM(pb + 7);
        if (IN(pb + 8)) { pg8::RouterProb P; P.K = 512; P.ldb = ND; P.Abase = (const char*)X1B; P.Bt = (const char*)(ws + WS_RT + (size_t)l * MiB); P.G = F.G; P.c = (int)blockIdx.x;
            pg8::EpiF32N64 E{(float*)(ws + WS_LOGITS)};
            pg8::gemm_phase<pg8::EpiF32N64, pg8::RouterProb, true>(F.lds, P, E, F.wave); } SEAM(pb + 8);
        if (IN(pb + 9)) { p_route(F, l); } SEAM(pb + 9);
        if (IN(pb + 11)) { load_offsets(F, l); const LAS int* tab = (const LAS int*)(F.lds + TAB_OFF);
            pg8::MoeUpProb P; P.W13 = (const char*)(ws + WS_W13 + (size_t)l * WS_MOE_LSTRIDE); P.sorted = (const int*)(ws + WS_SORTED2); P.tile_e = tab + 160; P.ntiles = __builtin_amdgcn_readfirstlane(tab[65]);
            P.G = F.G; P.c = (int)blockIdx.x;
            if (MK_FP8_MOE && MK_F8_NB2_UP) { P.K = ND / 2; P.ldb = ND / 2; P.arow = ND; P.brow = ND; P.pshift = 2; P.btile = 256; P.nunits = (P.ntiles + NT / 256) * 4; P.Abase = (const char*)(ws + WS_X1F8);
                pg8::EpiSwigluF8P2 E{(unsigned char*)HB};
                pg8::gemm_phase<pg8::EpiSwigluF8P2, pg8::MoeUpProb, true, true, false, true>(F.lds, P, E, F.wave); }
            else if (MK_FP8_MOE) { P.K = ND / 2; P.ldb = ND / 2; P.arow = ND; P.brow = ND; P.pshift = 3; P.btile = 128; P.nunits = (P.ntiles + NT / 256) * 8; P.Abase = (const char*)(ws + WS_X1F8);
                pg8::EpiSwigluF8 E{(unsigned char*)HB, 1.0f / 64.0f};
                pg8::gemm_phase<pg8::EpiSwigluF8, pg8::MoeUpProb, true, true>(F.lds, P, E, F.wave); }
            else { P.K = ND; P.ldb = ND; P.arow = ND * 2; P.brow = ND * 2; P.pshift = 2; P.btile = 256; P.nunits = (P.ntiles + NT / 256) * 4; P.Abase = (const char*)X1B;
                pg8::EpiSwiglu E{HB};
                pg8::gemm_phase<pg8::EpiSwiglu, pg8::MoeUpProb, true>(F.lds, P, E, F.wave); } } SEAM(pb + 11);
        if (IN(pb + 12)) { load_offsets(F, l); const LAS int* tab = (const LAS int*)(F.lds + TAB_OFF);
            pg8::MoeDownProb P; P.Abase = (const char*)HB; P.W2 = (const char*)(ws + WS_W2 + (size_t)l * WS_MOE_LSTRIDE); P.tile_e = tab + 160; P.ntiles = __builtin_amdgcn_readfirstlane(tab[65]);
            P.G = F.G; P.c = (int)blockIdx.x;
            if (MK_FP8_MOE && MK_F8_NB2) { P.K = EFF / 2; P.ldb = EFF / 2; P.arow = EFF; P.brow = EFF; P.pshift = 3; P.btile = 256; P.nunits = (P.ntiles + NT / 256) * 8;
                pg8::EpiFp8P2 E{(unsigned char*)Y2, ND};
                pg8::gemm_phase<pg8::EpiFp8P2, pg8::MoeDownProb, true, true, false>(F.lds, P, E, F.wave); }
            else if (MK_FP8_MOE) { P.K = EFF / 2; P.ldb = EFF / 2; P.arow = EFF; P.brow = EFF; P.pshift = 4; P.btile = 128; P.nunits = (P.ntiles + NT / 256) * 16;
                pg8::EpiFp8N128 E{(unsigned char*)Y2, ND, 16.0f / (64.0f * 8.0f)};
                pg8::gemm_phase<pg8::EpiFp8N128, pg8::MoeDownProb, true, true>(F.lds, P, E, F.wave); }
            else { P.K = EFF; P.ldb = EFF; P.arow = EFF * 2; P.brow = EFF * 2; P.pshift = 3; P.btile = 256; P.nunits = (P.ntiles + NT / 256) * 8;
                pg8::EpiFp8 E{(unsigned char*)Y2, ND, 16.0f};
                pg8::gemm_phase<pg8::EpiFp8, pg8::MoeDownProb, true>(F.lds, P, E, F.wave); } } SEAM(pb + 12);
        if (IN(pb + 13)) { load_offsets(F, l); p_combine_ln2(F, (const LAS int*)(F.lds + TAB_OFF), X1B, (const unsigned char*)Y2, (const int*)(ws + WS_SLOT), (const float*)(ws + WS_WSEL), kin(17) + l * ND, kin(18) + l * ND, l == 0 ? X2B : nullptr, l == 0 ? nullptr : F.out, (l == 0 && MK_FP8_IN1) ? (unsigned char*)(ws + WS_X1F8) : nullptr); } SEAM(pb + 13);
    }
__global__ void __launch_bounds__(NWAVES * 64, 2) mk_fwd(Args args) {
    extern __shared__ __attribute__((aligned(16))) unsigned char lds[];
    Frame F;
    F.lds = (LAS unsigned char*)lds;
    F.MISC = (volatile LAS unsigned*)(F.lds + MISC_OFF);
    F.tid = threadIdx.x; F.lane = F.tid & 63; F.wave = __builtin_amdgcn_readfirstlane(F.tid >> 6);
    F.G = gridDim.x; { const int bx = blockIdx.x; F.vcu = (F.G % 8 == 0) ? (bx % 8) * (F.G / 8) + bx / 8 : bx; }
    F.gw = F.vcu * NWAVES + F.wave; F.NGW = F.G * NWAVES;
    F.ws = args.ws; F.ctl = (unsigned*)(args.ws + WS_CTL); F.out = args.out;
    for (int u = F.tid; u < (LDS_BYTES - LDSCTL_OFF) / 4; u += NWAVES * 64) ((LAS unsigned*)(F.lds + LDSCTL_OFF))[u] = 0u;
    __syncthreads();
    XcdBarrier bar; bar.bar = F.ctl + CW_BAR; bar.x = 0; bar.st = nullptr; bar.wave = F.wave;
    if (MK_ONE_LAUNCH) bar = xcd_barrier_post(F.ctl + CW_BAR, F.MISC + 8);
    const int lo = args.ph_lo, hi = args.ph_hi;
    if (MK_PROBE_PHASE == 0 && blockIdx.x == 0 && F.tid == 0) ((volatile LAS unsigned long long*)(F.lds + LDSCTL_OFF + 64))[0] = __builtin_amdgcn_s_memrealtime();
    unsigned char* ws = args.ws;
    bf16* const XB0 = (bf16*)(ws + WS_XB0); bf16* const X1B = (bf16*)(ws + WS_X1B); bf16* const X2B = (bf16*)(ws + WS_X2B);
    bf16* const PROJ = (bf16*)(ws + WS_PROJ); bf16* const MIXIN = (bf16*)(ws + WS_MIXIN); bf16* const MIXO = (bf16*)(ws + WS_MIXO);
    bf16* const HB = (bf16*)(ws + WS_H); bf16* const Y2 = (bf16*)(ws + WS_Y2);

    if (IN(0)) { p_prologue(F); } SEAM(0);

    layer_body<0>(F, bar, lo, hi);
    layer_body<1>(F, bar, lo, hi);
    if (MK_PROBE_PHASE >= 0 && blockIdx.x == 0 && F.tid == 0) {
        volatile LAS unsigned long long* tsl = (volatile LAS unsigned long long*)(F.lds + LDSCTL_OFF + 64);
        if (MK_PROBE_LAST == 30) tsl[1] = __builtin_amdgcn_s_memrealtime();
        const unsigned long long span = (tsl[1] - tsl[0]) * MK_PROBE_AMP, t0 = __builtin_amdgcn_s_memrealtime();
        while (__builtin_amdgcn_s_memrealtime() - t0 < span) __builtin_amdgcn_s_sleep(8);
    }
#undef IN
#undef SEAM
}

extern "C" void kernel_launch(void* const* d_in, const int* in_sizes, int n_in, void* d_out, int out_size, void* d_ws, size_t ws_size, hipStream_t stream) {
    static int grid = 0;
    if (grid == 0) {
        if (n_in != 27 || in_sizes[0] != NT * ND || out_size != NT * ND || ws_size < WS_END) { fprintf(stderr, "kernel_launch: unexpected problem (n_in %d, in0 %d, out %d, ws %zu < %zu); nothing launched\n", n_in, n_in > 0 ? in_sizes[0] : -1, out_size, ws_size, (size_t)WS_END); grid = -1; return; }
        int dev = 0, cus = 0, per_cu = 0;
        if (hipGetDevice(&dev) != hipSuccess || hipDeviceGetAttribute(&cus, hipDeviceAttributeMultiprocessorCount, dev) != hipSuccess) { fprintf(stderr, "kernel_launch: device query failed\n"); grid = -1; return; }
        if (hipFuncSetAttribute((const void*)mk_fwd, hipFuncAttributeMaxDynamicSharedMemorySize, LDS_BYTES) != hipSuccess) { fprintf(stderr, "kernel_launch: hipFuncSetAttribute failed\n"); grid = -1; return; }
        if (hipOccupancyMaxActiveBlocksPerMultiprocessor(&per_cu, (const void*)mk_fwd, NWAVES * 64, LDS_BYTES) != hipSuccess || per_cu < 1) fprintf(stderr, "kernel_launch: note: occupancy query reports %d\n", per_cu);
        (void)hipGetLastError();
        grid = cus;
    }
    if (grid < 0) return;
    if (hipMemsetAsync((char*)d_ws + WS_CTL, 0, CTL_ZERO_BYTES, stream) != hipSuccess) { fprintf(stderr, "kernel_launch: memset failed\n"); return; }
    Args a{};
    for (int i = 0; i < 27; ++i) a.in[i] = (const float*)d_in[i];
    a.out = (float*)d_out; a.ws = (unsigned char*)d_ws;
#if MK_ONE_LAUNCH
    a.ph_lo = 0; a.ph_hi = NPHASE;
    hipLaunchKernelGGL(mk_fwd, dim3(grid), dim3(NWAVES * 64), LDS_BYTES, stream, a);
#else
    for (int p = 0; p < NPHASE; ++p) {
        const int lp = (p - 1) & 15;
        if (p >= 1) { const int l = (p - 1) >> 4; if (lp >= 14) continue; if (l == 0 && lp >= 3 && lp <= 5) continue; if (lp == 10) continue; }
        a.ph_lo = p; a.ph_hi = p + 1;
        hipLaunchKernelGGL(mk_fwd, dim3(grid), dim3(NWAVES * 64), LDS_BYTES, stream, a);
    }
#endif
    const hipError_t le = hipPeekAtLastError();
    if (le != hipSuccess) fprintf(stderr, "kernel_launch: launch failed: %s\n", hipGetErrorName(le));
}
```
